# Optimizing an MI355X kernel written in HIP

```python
import jax, jax.numpy as jnp
from jax import lax
import numpy as np

D_MODEL = 1024
BATCH = 4
SEQ = 4096
DEPTH = 2

HEAD_DIM = 64
MOBA_HEADS = 4
MOBA_BLOCK = 256
MOBA_TOPK = 3
MOBA_QCHUNK = 128
LRU_WIDTH = 256
LRU_BLOCKS = 4
LRU_BLOCK_DIM = LRU_WIDTH // LRU_BLOCKS
CONV_WIDTH = 4
LRU_C = 8.0
DIL_HEADS = 4
DIL_CONFIGS = ((128, 1), (512, 4), (2048, 16))
DIL_QBLOCK = 128
GLA_HEADS = 4
GLA_DK = 32
GLA_DV = 64
GLA_LOWRANK = 16
GLA_TAU = 16.0
GLA_CHUNK = 32

ROPE_THETA = 10000.0
LN_EPS = 1e-5
NEG = -1e30
MOD_SCALE = 0.1

A_W = MOBA_HEADS * HEAD_DIM
B_W = LRU_WIDTH
C_W = DIL_HEADS * HEAD_DIM
D_KW = GLA_HEADS * GLA_DK
D_W = GLA_HEADS * GLA_DV
D_MIX = A_W + B_W + C_W + D_W
COLS = (('a_q', A_W), ('a_k', A_W), ('a_v', A_W), ('a_g', A_W),
        ('b_x', B_W), ('b_g', B_W),
        ('c_q', C_W), ('c_k', C_W), ('c_v', C_W), ('c_g', C_W),
        ('d_q', D_KW), ('d_k', D_KW), ('d_v', D_W), ('d_g', D_W), ('d_r', GLA_LOWRANK))
D_IN = sum(w for _, w in COLS)
DEEPNORM_ALPHA = (2 * DEPTH) ** 0.25
DEEPNORM_BETA = (8 * DEPTH) ** -0.25

kernel_name = 'hybrid_moba_rglru_dilated_gla_deepnorm'

F32 = jnp.float32


def _layer_norm(x, g=None, b=None):
    xf = x.astype(F32)
    mu = jnp.mean(xf, -1, keepdims=True)
    var = jnp.mean(jnp.square(xf - mu), -1, keepdims=True)
    y = (xf - mu) * lax.rsqrt(var + LN_EPS)
    if g is not None:
        y = y * g + b
    return y.astype(x.dtype)


def _softmax_lse(s):
    m = jnp.max(s, -1, keepdims=True)
    e = jnp.exp(s - m)
    zsum = jnp.sum(e, -1, keepdims=True)
    return e / zsum, (m + jnp.log(zsum))[..., 0]


def _heads(z, n, dh):
    B, S, _ = z.shape
    return z.reshape(B, S, n, dh)


def _to_bhsd(t):
    return t.transpose(0, 2, 1, 3)


def _rope(x, pos):
    half = x.shape[-1] // 2
    inv = ROPE_THETA ** (-jnp.arange(half, dtype=F32) / half)
    ang = pos.astype(F32)[..., None] * inv
    cos = jnp.cos(ang)[:, :, None, :]
    sin = jnp.sin(ang)[:, :, None, :]
    xf = x.astype(F32)
    x1, x2 = xf[..., :half], xf[..., half:]
    return jnp.concatenate([x1 * cos - x2 * sin, x1 * sin + x2 * cos], -1).astype(x.dtype)


def _moba(q, k, v):
    B, H, S, hd = q.shape
    nb = -(-S // MOBA_BLOCK)
    sp = nb * MOBA_BLOCK
    padw = ((0, 0), (0, 0), (0, sp - S), (0, 0))
    qp = jnp.pad(q, padw).astype(F32) * hd ** -0.5
    kp = jnp.pad(k, padw).astype(F32)
    vp = jnp.pad(v, padw).astype(F32)
    qb = qp.reshape(B, H, nb, MOBA_BLOCK, hd)
    kb = kp.reshape(B, H, nb, MOBA_BLOCK, hd)
    vb = vp.reshape(B, H, nb, MOBA_BLOCK, hd)
    causal = jnp.tril(jnp.ones((MOBA_BLOCK, MOBA_BLOCK), bool))
    s_own = jnp.where(causal, jnp.einsum('bhnqd,bhnkd->bhnqk', qb, kb), NEG)
    p_own, lse_own = _softmax_lse(s_own)
    o_own = jnp.einsum('bhnqk,bhnkd->bhnqd', p_own, vb).reshape(B, H, sp, hd)
    lse_own = lse_own.reshape(B, H, sp)
    topk = min(MOBA_TOPK, nb - 1)
    if topk == 0:
        return o_own[:, :, :S].astype(q.dtype)
    qblk = jnp.arange(sp) // MOBA_BLOCK
    k_mean = jnp.mean(kb, axis=3)
    gate = jnp.einsum('bhsd,bhnd->bhsn', qp, k_mean)
    gate = jnp.where(jnp.arange(nb)[None, :] < qblk[:, None], gate, NEG)
    _, sel = lax.top_k(gate, topk)
    valid = sel < qblk[:, None]
    nc = sp // MOBA_QCHUNK

    def to_chunks(t):
        return jnp.moveaxis(t.reshape(B, H, nc, MOBA_QCHUNK, t.shape[-1]), 2, 0)

    bi = jnp.arange(B)[:, None, None, None]
    hi = jnp.arange(H)[None, :, None, None]

    def chunk(args):
        qc, selc, validc = args
        kg = kb[bi, hi, selc]
        vg = vb[bi, hi, selc]
        s = jnp.einsum('bhqd,bhqnkd->bhqnk', qc, kg)
        s = jnp.where(validc[..., None], s, NEG).reshape(B, H, MOBA_QCHUNK, topk * MOBA_BLOCK)
        p, lse = _softmax_lse(s)
        o = jnp.einsum('bhqnk,bhqnkd->bhqd', p.reshape(B, H, MOBA_QCHUNK, topk, MOBA_BLOCK), vg)
        return o, lse

    o_sel, lse_sel = lax.map(chunk, (to_chunks(qp), to_chunks(sel), to_chunks(valid)))
    o_sel = jnp.moveaxis(o_sel, 0, 2).reshape(B, H, sp, hd)
    lse_sel = jnp.moveaxis(lse_sel, 0, 2).reshape(B, H, sp)
    m = jnp.maximum(lse_own, lse_sel)
    w_own = jnp.exp(lse_own - m)
    w_sel = jnp.exp(lse_sel - m)
    o = (w_own[..., None] * o_own + w_sel[..., None] * o_sel) / (w_own + w_sel)[..., None]
    return o[:, :, :S].astype(q.dtype)


def _dilated_branch(q, k, v, window, dil):
    B, H, S, hd = q.shape
    n_steps = window // dil
    QB = DIL_QBLOCK
    L = -(-S // (dil * QB)) * QB
    sp = L * dil
    nb = L // QB

    def regroup(t):
        t = jnp.pad(t, ((0, 0), (0, 0), (0, sp - S), (0, 0)))
        return t.reshape(B, H, L, dil, hd).transpose(0, 1, 3, 2, 4).reshape(B, H, dil, nb, QB, hd)

    def prev_block(t):
        return jnp.pad(t[:, :, :, :-1], ((0, 0), (0, 0), (0, 0), (1, 0), (0, 0), (0, 0)))

    qb, kb, vb = regroup(q), regroup(k), regroup(v)
    kk = jnp.concatenate([prev_block(kb), kb], axis=4)
    vv = jnp.concatenate([prev_block(vb), vb], axis=4)
    qi = jnp.arange(QB)[:, None]
    kj = jnp.arange(2 * QB)[None, :]
    dist = qi + QB - kj
    band = (dist >= 0) & (dist <= n_steps)
    first = (jnp.arange(nb) == 0)[:, None, None] & (kj < QB)[None]
    valid = band[None] & ~first
    s = jnp.where(valid, jnp.einsum('bhrnqd,bhrnkd->bhrnqk', qb, kk), NEG)
    p, lse = _softmax_lse(s)
    o = jnp.einsum('bhrnqk,bhrnkd->bhrnqd', p, vv)
    o = o.reshape(B, H, dil, L, hd).transpose(0, 1, 3, 2, 4).reshape(B, H, sp, hd)[:, :, :S]
    lse = lse.reshape(B, H, dil, L).transpose(0, 1, 3, 2).reshape(B, H, sp)[:, :, :S]
    return o, lse


def _dilated(q, k, v):
    hd = q.shape[-1]
    qf = q.astype(F32) * hd ** -0.5
    kf = k.astype(F32)
    vf = v.astype(F32)
    outs, lses = [], []
    for window, dil in DIL_CONFIGS:
        o, l = _dilated_branch(qf, kf, vf, window, dil)
        outs.append(o)
        lses.append(l)
    wts = jax.nn.softmax(jnp.stack(lses, 0), axis=0)
    o = jnp.einsum('cbhs,cbhsd->bhsd', wts, jnp.stack(outs, 0))
    return o.astype(q.dtype)


def _causal_conv(x, w, b):
    C = x.shape[-1]
    y = lax.conv_general_dilated(x, w[:, None, :], window_strides=(1,),
                                 padding=[(CONV_WIDTH - 1, 0)],
                                 dimension_numbers=('NWC', 'WIO', 'NWC'),
                                 feature_group_count=C)
    return y + b


def _rg_lru(x, w_a, b_a, w_x, b_x, lam):
    B, S, W = x.shape
    xb = x.reshape(B, S, LRU_BLOCKS, LRU_BLOCK_DIM)
    r = jax.nn.sigmoid(jnp.einsum('bsgi,gio->bsgo', xb, w_a).reshape(B, S, W) + b_a).astype(F32)
    i = jax.nn.sigmoid(jnp.einsum('bsgi,gio->bsgo', xb, w_x).reshape(B, S, W) + b_x).astype(F32)
    log_a = -LRU_C * r * jax.nn.softplus(-lam.astype(F32))
    a = jnp.exp(log_a)
    u = jnp.sqrt(-jnp.expm1(2.0 * log_a)) * (i * x.astype(F32))

    def combine(left, right):
        a1, b1 = left
        a2, b2 = right
        return a1 * a2, a2 * b1 + b2

    _, h = lax.associative_scan(combine, (a, u), axis=1)
    return h.astype(x.dtype)


def _gla(q, k, v, log_alpha):
    B, H, S, dk = q.shape
    dv = v.shape[-1]
    C = GLA_CHUNK
    nc = S // C

    def rs(t):
        return t.astype(F32).reshape(B, H, nc, C, t.shape[-1])

    qc = rs(q) * dk ** -0.5
    kc, vc, gc = rs(k), rs(v), rs(log_alpha)
    bcum = jnp.cumsum(gc, axis=3)
    causal = jnp.tril(jnp.ones((C, C), bool))
    diff = bcum[..., :, None, :] - bcum[..., None, :, :]
    decay = jnp.exp(jnp.where(causal[..., None], diff, NEG))
    A = jnp.einsum('bhnid,bhnjd,bhnijd->bhnij', qc, kc, decay)
    o_intra = jnp.einsum('bhnij,bhnjv->bhniv', A, vc)
    q_in = qc * jnp.exp(bcum)
    b_last = bcum[..., -1:, :]
    kv = jnp.einsum('bhnjd,bhnjv->bhndv', kc * jnp.exp(b_last - bcum), vc)
    chunk_decay = jnp.exp(b_last[..., 0, :])

    def step(state, inp):
        qi, kvi, dec = inp
        o = jnp.einsum('bhid,bhdv->bhiv', qi, state)
        return dec[..., None] * state + kvi, o

    xs = (jnp.moveaxis(q_in, 2, 0), jnp.moveaxis(kv, 2, 0), jnp.moveaxis(chunk_decay, 2, 0))
    _, o_inter = lax.scan(step, jnp.zeros((B, H, dk, dv), F32), xs)
    o = o_intra + jnp.moveaxis(o_inter, 0, 2)
    return o.reshape(B, H, S, dv)


def _layer(x, c, pos, w_mod, b_mod, w_in, conv_w, conv_b, lru_wa, lru_ba, lru_wx, lru_bx,
           lru_lam, gla_wr, gla_br, gla_gn, w_out, ln_g, ln_b):
    B, S, _ = x.shape
    shift, scale, gate = jnp.split(c @ w_mod + b_mod, 3, axis=-1)
    u = _layer_norm(x) * (1 + scale[:, None]) + shift[:, None]
    z = u @ w_in
    p = {}
    off = 0
    for name, w in COLS:
        p[name] = z[..., off:off + w]
        off += w
    qa = _rope(_heads(p['a_q'], MOBA_HEADS, HEAD_DIM), pos)
    ka = _rope(_heads(p['a_k'], MOBA_HEADS, HEAD_DIM), pos)
    va = _heads(p['a_v'], MOBA_HEADS, HEAD_DIM)
    ya = _moba(_to_bhsd(qa), _to_bhsd(ka), _to_bhsd(va)).transpose(0, 2, 1, 3).reshape(B, S, A_W)
    yb = _rg_lru(_causal_conv(p['b_x'], conv_w, conv_b), lru_wa, lru_ba, lru_wx, lru_bx, lru_lam)
    qc = _rope(_heads(p['c_q'], DIL_HEADS, HEAD_DIM), pos)
    kc = _rope(_heads(p['c_k'], DIL_HEADS, HEAD_DIM), pos)
    vc = _heads(p['c_v'], DIL_HEADS, HEAD_DIM)
    yc = _dilated(_to_bhsd(qc), _to_bhsd(kc), _to_bhsd(vc)).transpose(0, 2, 1, 3).reshape(B, S, C_W)
    log_alpha = jax.nn.log_sigmoid((p['d_r'] @ gla_wr + gla_br).astype(F32)) / GLA_TAU
    yd = _gla(_to_bhsd(_heads(p['d_q'], GLA_HEADS, GLA_DK)),
              _to_bhsd(_heads(p['d_k'], GLA_HEADS, GLA_DK)),
              _to_bhsd(_heads(p['d_v'], GLA_HEADS, GLA_DV)),
              _to_bhsd(_heads(log_alpha, GLA_HEADS, GLA_DK)))
    yd = yd * lax.rsqrt(jnp.mean(yd * yd, -1, keepdims=True) + LN_EPS) * gla_gn.astype(F32)
    yd = yd.transpose(0, 2, 1, 3).reshape(B, S, D_W).astype(x.dtype)
    mix = jnp.concatenate([ya * jax.nn.silu(p['a_g']), yb * jax.nn.silu(p['b_g']),
                           yc * jax.nn.silu(p['c_g']), yd * jax.nn.silu(p['d_g'])], -1)
    y = mix @ w_out
    return _layer_norm(DEEPNORM_ALPHA * x + (1 + gate[:, None]) * y, ln_g, ln_b)


def setup_inputs(seed: int = 0) -> dict:
    key = jax.random.key(seed)
    ks = jax.random.split(key, 20)

    def nrm(k, shape, s):
        return jax.random.normal(k, shape, F32) * s

    x = nrm(ks[0], (BATCH, SEQ, D_MODEL), 1.0)
    c = nrm(ks[1], (BATCH, D_MODEL), 1.0)
    positions = (jnp.arange(SEQ, dtype=jnp.int32)[None, :]
                 + jax.random.randint(ks[2], (BATCH, 1), 0, 1024, dtype=jnp.int32))
    w_mod = nrm(ks[3], (DEPTH, D_MODEL, 3 * D_MODEL), MOD_SCALE * D_MODEL ** -0.5)
    b_mod = nrm(ks[4], (DEPTH, 3 * D_MODEL), 0.01)
    w_in = nrm(ks[5], (DEPTH, D_MODEL, D_IN), D_MODEL ** -0.5)
    conv_w = nrm(ks[6], (DEPTH, CONV_WIDTH, LRU_WIDTH), CONV_WIDTH ** -0.5)
    conv_b = nrm(ks[7], (DEPTH, LRU_WIDTH), 0.01)
    lru_wa = nrm(ks[8], (DEPTH, LRU_BLOCKS, LRU_BLOCK_DIM, LRU_BLOCK_DIM), LRU_BLOCK_DIM ** -0.5)
    lru_ba = nrm(ks[9], (DEPTH, LRU_WIDTH), 0.01)
    lru_wx = nrm(ks[10], (DEPTH, LRU_BLOCKS, LRU_BLOCK_DIM, LRU_BLOCK_DIM), LRU_BLOCK_DIM ** -0.5)
    lru_bx = nrm(ks[11], (DEPTH, LRU_WIDTH), 0.01)
    a_c = jax.random.uniform(ks[12], (DEPTH, LRU_WIDTH), F32, 0.9, 0.999)
    s = a_c ** (1.0 / LRU_C)
    lru_lam = jnp.log(s) - jnp.log1p(-s)
    gla_wr = nrm(ks[13], (DEPTH, GLA_LOWRANK, D_KW), GLA_LOWRANK ** -0.5)
    gla_br = nrm(ks[14], (DEPTH, D_KW), 0.1)
    gla_gn = 1.0 + nrm(ks[15], (DEPTH, GLA_DV), 0.02)
    w_out = nrm(ks[16], (DEPTH, D_MIX, D_MODEL), DEEPNORM_BETA * D_MIX ** -0.5)
    ln_g = 1.0 + nrm(ks[17], (DEPTH, D_MODEL), 0.02)
    ln_b = nrm(ks[18], (DEPTH, D_MODEL), 0.02)
    return {'x': x, 'c': c, 'positions': positions, 'w_mod': w_mod, 'b_mod': b_mod,
            'w_in': w_in, 'conv_w': conv_w, 'conv_b': conv_b, 'lru_wa': lru_wa,
            'lru_ba': lru_ba, 'lru_wx': lru_wx, 'lru_bx': lru_bx, 'lru_lam': lru_lam,
            'gla_wr': gla_wr, 'gla_br': gla_br, 'gla_gn': gla_gn, 'w_out': w_out,
            'ln_g': ln_g, 'ln_b': ln_b}


def reference(x, c, positions, w_mod, b_mod, w_in, conv_w, conv_b, lru_wa, lru_ba, lru_wx,
              lru_bx, lru_lam, gla_wr, gla_br, gla_gn, w_out, ln_g, ln_b):
    for l in range(DEPTH):
        x = _layer(x, c, positions, w_mod[l], b_mod[l], w_in[l], conv_w[l], conv_b[l],
                   lru_wa[l], lru_ba[l], lru_wx[l], lru_bx[l], lru_lam[l], gla_wr[l],
                   gla_br[l], gla_gn[l], w_out[l], ln_g[l], ln_b[l])
    return x
```

```cpp
#include <hip/hip_runtime.h>
#include <hip/hip_cooperative_groups.h>
#include <cstdio>
#include <cstdint>
namespace cg = cooperative_groups;

typedef unsigned short bf16_t;
typedef short bf16x8 __attribute__((ext_vector_type(8)));
typedef short bf16x4 __attribute__((ext_vector_type(4)));
typedef float f32x4 __attribute__((ext_vector_type(4)));
typedef unsigned u32x4 __attribute__((ext_vector_type(4)));
typedef unsigned u32x2 __attribute__((ext_vector_type(2)));

constexpr int D = 1024, NB = 4, S = 4096, T = NB * S, DEPTH = 2;
constexpr int DIN = 3344, ZP = 3344, NPAD = 3456;
constexpr int C_AQ = 0, C_AK = 256, C_AV = 512, C_AG = 768, C_BX = 1024, C_BG = 1280, C_CQ = 1536, C_CK = 1792,
              C_CV = 2048, C_CG = 2304, C_DQ = 2560, C_DK = 2688, C_DV = 2816, C_DG = 3072, C_DR = 3328;
constexpr float DN_ALPHA = 1.4142135623730951f;
constexpr int LDP = 72;
constexpr int SMEM_BYTES = 51200;
constexpr int BIG = 1000000;

constexpr size_t WS_CTL = 0;
constexpr size_t WS_WINT = 1024;
constexpr size_t WS_WOUTT = WS_WINT + (size_t)DEPTH * NPAD * 1024 * 2;
constexpr size_t WS_MOD = WS_WOUTT + (size_t)DEPTH * 1024 * 1024 * 2;
constexpr size_t WS_COS = WS_MOD + (size_t)DEPTH * NB * 3072 * 4;
constexpr size_t WS_SIN = WS_COS + (size_t)T * 32 * 4;
constexpr size_t WS_U = WS_SIN + (size_t)T * 32 * 4;
constexpr size_t WS_Z = WS_U + (size_t)T * 1024 * 2;
constexpr size_t WS_KPART = WS_Z + (size_t)T * ZP * 2;
constexpr size_t WS_DILO = WS_KPART + (size_t)256 * 256 * 4;
constexpr size_t WS_DILL = WS_DILO + (size_t)3 * T * 256 * 2;
constexpr size_t WS_GKV = WS_DILL + (size_t)3 * T * 4 * 4;
constexpr size_t WS_GDEC = WS_GKV + (size_t)2048 * 2048 * 4;
constexpr size_t WS_LH = WS_GDEC + (size_t)2048 * 32 * 4;
constexpr size_t WS_LP = WS_LH + (size_t)T * 256 * 4;
constexpr size_t WS_LC = WS_LP + (size_t)T * 256 * 4;
constexpr size_t WS_END = WS_LC + (size_t)NB * 128 * 256 * 4;

struct Params {
    const float *x, *c; const int* pos;
    const float *w_mod, *b_mod, *w_in, *conv_w, *conv_b, *lru_wa, *lru_ba, *lru_wx, *lru_bx, *lru_lam, *gla_wr, *gla_br, *gla_gn, *w_out, *ln_g, *ln_b;
    float* out; unsigned char* ws;
};

__device__ __forceinline__ float bf2f(bf16_t h) { return __uint_as_float(((unsigned)h) << 16); }
__device__ __forceinline__ bf16_t f2bf(float f) { unsigned u = __float_as_uint(f); u += 0x7fffu + ((u >> 16) & 1u); return (bf16_t)(u >> 16); }
__device__ __forceinline__ unsigned pack2(float a, float b) { return (unsigned)f2bf(a) | ((unsigned)f2bf(b) << 16); }
__device__ __forceinline__ float silu_f(float x) { return x / (1.f + __expf(-x)); }
__device__ __forceinline__ float sigmoid_f(float x) { return 1.f / (1.f + __expf(-x)); }
__device__ __forceinline__ int tid_opq() { int t = threadIdx.x; asm volatile("" : "+v"(t)); return t; }
__device__ __forceinline__ float wsum(float v) {
#pragma unroll
    for (int o = 32; o; o >>= 1) v += __shfl_xor(v, o);
    return v;
}

__device__ void prologue_phase(const Params& p, char* smem) {
    const int t = tid_opq();
    bf16_t* WinT = (bf16_t*)(p.ws + WS_WINT); bf16_t* WoutT = (bf16_t*)(p.ws + WS_WOUTT);
    float* mod = (float*)(p.ws + WS_MOD); float* cosT = (float*)(p.ws + WS_COS); float* sinT = (float*)(p.ws + WS_SIN);
    float* tl = (float*)smem;
    constexpr int N_TIN = DEPTH * 16 * 54, N_TOUT = DEPTH * 16 * 16, N_MOD = DEPTH * 192, N_ROPE = T * 32 / 256;
    constexpr int NITEMS = N_TIN + N_TOUT + N_MOD + N_ROPE;
    for (int it = blockIdx.x; it < NITEMS; it += gridDim.x) {
        if (it < N_TIN + N_TOUT) {
            const float* src; bf16_t* dst; int ncols, kt, nt;
            if (it < N_TIN) { int l = it / (16 * 54), r = it % (16 * 54); kt = r / 54; nt = r % 54; src = p.w_in + (size_t)l * 1024 * DIN; dst = WinT + (size_t)l * NPAD * 1024; ncols = DIN; }
            else { int i2 = it - N_TIN; int l = i2 / 256, r = i2 % 256; kt = r / 16; nt = r % 16; src = p.w_out + (size_t)l * 1024 * 1024; dst = WoutT + (size_t)l * 1024 * 1024; ncols = 1024; }
            __syncthreads();
            { const int c = t & 63, r0 = t >> 6; const int n = nt * 64 + c;
#pragma unroll
              for (int i = 0; i < 16; ++i) { int r = r0 + 4 * i; tl[r * 65 + c] = (n < ncols) ? src[(size_t)(kt * 64 + r) * ncols + n] : 0.f; } }
            __syncthreads();
            { const int kk = t & 63, n0 = t >> 6;
#pragma unroll
              for (int i = 0; i < 16; ++i) { int n = n0 + 4 * i; dst[(size_t)(nt * 64 + n) * 1024 + kt * 64 + kk] = f2bf(tl[kk * 65 + n]); } }
        } else if (it < N_TIN + N_TOUT + N_MOD) {
            const int i2 = it - N_TIN - N_TOUT; const int l = i2 / 192, jg = i2 % 192;
            const int jj = t & 15, ks = t >> 4; const int j = jg * 16 + jj;
            float a0 = 0.f, a1 = 0.f, a2 = 0.f, a3 = 0.f;
            const float* wm = p.w_mod + (size_t)l * 1024 * 3072 + j;
#pragma unroll 8
            for (int k = ks * 64; k < ks * 64 + 64; ++k) { float wv = wm[(size_t)k * 3072]; a0 += p.c[k] * wv; a1 += p.c[1024 + k] * wv; a2 += p.c[2048 + k] * wv; a3 += p.c[3072 + k] * wv; }
            __syncthreads();
            tl[(0 * 16 + ks) * 16 + jj] = a0; tl[(1 * 16 + ks) * 16 + jj] = a1; tl[(2 * 16 + ks) * 16 + jj] = a2; tl[(3 * 16 + ks) * 16 + jj] = a3;
            __syncthreads();
            if (t < 64) { const int b = t >> 4, j2 = t & 15; float s = 0.f;
#pragma unroll
              for (int k2 = 0; k2 < 16; ++k2) s += tl[(b * 16 + k2) * 16 + j2];
              mod[((size_t)l * NB + b) * 3072 + jg * 16 + j2] = s + p.b_mod[l * 3072 + jg * 16 + j2]; }
        } else {
            const int i2 = it - N_TIN - N_TOUT - N_MOD; const int e = i2 * 256 + t; const int tok = e >> 5, f = e & 31;
            const float inv = exp2f(-(float)f * (13.287712379549449f / 32.f));
            const float ang = (float)p.pos[tok] * inv;
            cosT[e] = cosf(ang); sinT[e] = sinf(ang);
        }
    }
}

__device__ void ln_phase(const Params& p, int l) {
    const int t = tid_opq(), lane = t & 63, w = t >> 6;
    bf16_t* ubuf = (bf16_t*)(p.ws + WS_U); const float* mod = (const float*)(p.ws + WS_MOD);
    for (int rg = blockIdx.x; rg < T / 4; rg += gridDim.x) {
        const int row = rg * 4 + w; const int b = row / S;
        const float* src = (l == 0) ? p.x + (size_t)row * 1024 : p.out + (size_t)row * 1024;
        f32x4 v[4];
#pragma unroll
        for (int i = 0; i < 4; ++i) v[i] = *(const f32x4*)(src + i * 256 + lane * 4);
        if (l > 0) {
            float s = 0.f;
#pragma unroll
            for (int i = 0; i < 4; ++i) s += (v[i][0] + v[i][1]) + (v[i][2] + v[i][3]);
            const float mu = wsum(s) * (1.f / 1024.f); float q = 0.f;
#pragma unroll
            for (int i = 0; i < 4; ++i) { f32x4 d = v[i] - mu; q += (d[0] * d[0] + d[1] * d[1]) + (d[2] * d[2] + d[3] * d[3]); }
            const float rstd = rsqrtf(wsum(q) * (1.f / 1024.f) + 1e-5f);
#pragma unroll
            for (int i = 0; i < 4; ++i) { const f32x4 g = *(const f32x4*)(p.ln_g + (l - 1) * 1024 + i * 256 + lane * 4), bb = *(const f32x4*)(p.ln_b + (l - 1) * 1024 + i * 256 + lane * 4);
                v[i] = (v[i] - mu) * rstd * g + bb; *(f32x4*)(p.out + (size_t)row * 1024 + i * 256 + lane * 4) = v[i]; }
        }
        if (l < DEPTH) {
            float s = 0.f;
#pragma unroll
            for (int i = 0; i < 4; ++i) s += (v[i][0] + v[i][1]) + (v[i][2] + v[i][3]);
            const float mu = wsum(s) * (1.f / 1024.f); float q = 0.f;
#pragma unroll
            for (int i = 0; i < 4; ++i) { f32x4 d = v[i] - mu; q += (d[0] * d[0] + d[1] * d[1]) + (d[2] * d[2] + d[3] * d[3]); }
            const float rstd = rsqrtf(wsum(q) * (1.f / 1024.f) + 1e-5f);
            const float* mb = mod + ((size_t)l * NB + b) * 3072;
#pragma unroll
            for (int i = 0; i < 4; ++i) { const int col = i * 256 + lane * 4; const f32x4 sh = *(const f32x4*)(mb + col), sc = *(const f32x4*)(mb + 1024 + col);
                f32x4 u = (v[i] - mu) * rstd * (sc + 1.f) + sh; u32x2 pk; pk.x = pack2(u[0], u[1]); pk.y = pack2(u[2], u[3]);
                *(u32x2*)(ubuf + (size_t)row * 1024 + col) = pk; }
        }
    }
}

__device__ __forceinline__ void gemm_core(const bf16_t* __restrict__ A, const bf16_t* __restrict__ Bt, int tm, int tn, bf16_t* sA, bf16_t* sB, f32x4 (&acc)[4][4]) {
    const int t = tid_opq(), lane = t & 63, w = t >> 6, wm = w >> 1, wn = w & 1, r16 = lane & 15, quad = lane >> 4;
    const int lrow = t >> 3, lch = t & 7;
    const bf16_t* Ag = A + (size_t)(tm * 128 + lrow) * 1024 + lch * 8;
    const bf16_t* Bg = Bt + (size_t)(tn * 128 + lrow) * 1024 + lch * 8;
    u32x4 ra[4], rb[4];
#pragma unroll
    for (int i = 0; i < 4; ++i) { ra[i] = *(const u32x4*)(Ag + (size_t)i * 32 * 1024); rb[i] = *(const u32x4*)(Bg + (size_t)i * 32 * 1024); }
#pragma unroll
    for (int a = 0; a < 4; ++a)
#pragma unroll
        for (int b = 0; b < 4; ++b) acc[a][b] = (f32x4){0.f, 0.f, 0.f, 0.f};
    for (int kt = 0; kt < 16; ++kt) {
        __syncthreads();
#pragma unroll
        for (int i = 0; i < 4; ++i) { *(u32x4*)(sA + (lrow + 32 * i) * LDP + lch * 8) = ra[i]; *(u32x4*)(sB + (lrow + 32 * i) * LDP + lch * 8) = rb[i]; }
        __syncthreads();
        if (kt + 1 < 16) {
#pragma unroll
            for (int i = 0; i < 4; ++i) { ra[i] = *(const u32x4*)(Ag + (size_t)i * 32 * 1024 + (kt + 1) * 64); rb[i] = *(const u32x4*)(Bg + (size_t)i * 32 * 1024 + (kt + 1) * 64); }
        }
#pragma unroll
        for (int ks = 0; ks < 2; ++ks) {
            bf16x8 af[4], bfr[4];
#pragma unroll
            for (int mt = 0; mt < 4; ++mt) af[mt] = *(const bf16x8*)(sA + (wm * 64 + mt * 16 + r16) * LDP + ks * 32 + quad * 8);
#pragma unroll
            for (int nt = 0; nt < 4; ++nt) bfr[nt] = *(const bf16x8*)(sB + (wn * 64 + nt * 16 + r16) * LDP + ks * 32 + quad * 8);
#pragma unroll
            for (int mt = 0; mt < 4; ++mt)
#pragma unroll
                for (int nt = 0; nt < 4; ++nt) acc[mt][nt] = __builtin_amdgcn_mfma_f32_16x16x32_bf16(af[mt], bfr[nt], acc[mt][nt], 0, 0, 0);
        }
    }
}

__device__ void g1_phase(const Params& p, int l, char* smem) {
    const int t = tid_opq(), lane = t & 63, w = t >> 6, wm = w >> 1, wn = w & 1, r16 = lane & 15, quad = lane >> 4;
    bf16_t* sA = (bf16_t*)smem; bf16_t* sB = sA + 128 * LDP; bf16_t* sC = (bf16_t*)smem;
    const bf16_t* ubuf = (const bf16_t*)(p.ws + WS_U); const bf16_t* WinT = (const bf16_t*)(p.ws + WS_WINT) + (size_t)l * NPAD * 1024;
    bf16_t* z = (bf16_t*)(p.ws + WS_Z); float* kpart = (float*)(p.ws + WS_KPART);
    const float* cosT = (const float*)(p.ws + WS_COS); const float* sinT = (const float*)(p.ws + WS_SIN);
    for (int tile = blockIdx.x; tile < 128 * 27; tile += gridDim.x) {
        const int tm = tile / 27, tn = tile % 27;
        f32x4 acc[4][4];
        gemm_core(ubuf, WinT, tm, tn, sA, sB, acc);
        const bool rope = (tn < 4) || (tn >= 12 && tn < 16);
        if (rope) {
#pragma unroll
            for (int mt = 0; mt < 4; ++mt)
#pragma unroll
                for (int j = 0; j < 4; ++j) {
                    const int tok = tm * 128 + wm * 64 + mt * 16 + quad * 4 + j;
#pragma unroll
                    for (int nt = 0; nt < 2; ++nt) { const int f = nt * 16 + r16; const float cs = cosT[tok * 32 + f], sn = sinT[tok * 32 + f];
                        const float x1 = acc[mt][nt][j], x2 = acc[mt][nt + 2][j]; acc[mt][nt][j] = x1 * cs - x2 * sn; acc[mt][nt + 2][j] = x1 * sn + x2 * cs; }
                }
        }
        if (tn == 2 || tn == 3) {
#pragma unroll
            for (int nt = 0; nt < 4; ++nt) { float s = 0.f;
#pragma unroll
                for (int mt = 0; mt < 4; ++mt) s += (acc[mt][nt][0] + acc[mt][nt][1]) + (acc[mt][nt][2] + acc[mt][nt][3]);
                s += __shfl_xor(s, 16); s += __shfl_xor(s, 32);
                if (quad == 0) kpart[(size_t)(tm * 2 + wm) * 256 + (tn - 2) * 128 + wn * 64 + nt * 16 + r16] = s; }
        }
        __syncthreads();
#pragma unroll
        for (int mt = 0; mt < 4; ++mt)
#pragma unroll
            for (int nt = 0; nt < 4; ++nt)
#pragma unroll
                for (int j = 0; j < 4; ++j) sC[(wm * 64 + mt * 16 + quad * 4 + j) * 136 + wn * 64 + nt * 16 + r16] = f2bf(acc[mt][nt][j]);
        __syncthreads();
#pragma unroll
        for (int i = 0; i < 8; ++i) { const int c = t + 256 * i; const int row = c >> 4, ch = c & 15; const int col = tn * 128 + ch * 8;
            if (col < DIN) *(u32x4*)(z + (size_t)(tm * 128 + row) * ZP + col) = *(const u32x4*)(sC + row * 136 + ch * 8); }
    }
}

__device__ void g2_phase(const Params& p, int l, char* smem) {
    const int t = tid_opq(), lane = t & 63, w = t >> 6, wm = w >> 1, wn = w & 1, r16 = lane & 15, quad = lane >> 4;
    bf16_t* sA = (bf16_t*)smem; bf16_t* sB = sA + 128 * LDP;
    const bf16_t* mix = (const bf16_t*)(p.ws + WS_U); const bf16_t* WoutT = (const bf16_t*)(p.ws + WS_WOUTT) + (size_t)l * 1024 * 1024;
    const float* mod = (const float*)(p.ws + WS_MOD);
    const float* xres = (l == 0) ? p.x : p.out;
    for (int tile = blockIdx.x; tile < 128 * 8; tile += gridDim.x) {
        const int tm = tile >> 3, tn = tile & 7;
        f32x4 acc[4][4];
        gemm_core(mix, WoutT, tm, tn, sA, sB, acc);
        const int b = (tm * 128) / S;
        const float* gate = mod + ((size_t)l * NB + b) * 3072 + 2048;
#pragma unroll
        for (int nt = 0; nt < 4; ++nt) { const int col = tn * 128 + wn * 64 + nt * 16 + r16; const float g1 = 1.f + gate[col];
#pragma unroll
            for (int mt = 0; mt < 4; ++mt)
#pragma unroll
                for (int j = 0; j < 4; ++j) { const size_t o = (size_t)(tm * 128 + wm * 64 + mt * 16 + quad * 4 + j) * 1024 + col;
                    p.out[o] = DN_ALPHA * xres[o] + g1 * acc[mt][nt][j]; } }
    }
}

constexpr float ATT_SC = 0.18033688011112042f;
__device__ __forceinline__ void attn_tile(const bf16_t* sK, const bf16_t* sV, const bf16x8 (&qf)[2][2], int lo, int hi, bool qfl0, bool qfl1,
                                          float (&m)[2], float (&l)[2], f32x4 (&O)[2][4], int wq0) {
    const int lane = tid_opq() & 63, r16 = lane & 15, quad = lane >> 4;
    f32x4 s[2][4];
#pragma unroll
    for (int a = 0; a < 2; ++a)
#pragma unroll
        for (int b = 0; b < 4; ++b) s[a][b] = (f32x4){0.f, 0.f, 0.f, 0.f};
#pragma unroll
    for (int ks = 0; ks < 2; ++ks)
#pragma unroll
        for (int k16 = 0; k16 < 4; ++k16) {
            const bf16x8 kf = *(const bf16x8*)(sK + (k16 * 16 + r16) * LDP + ks * 32 + quad * 8);
#pragma unroll
            for (int qt = 0; qt < 2; ++qt) s[qt][k16] = __builtin_amdgcn_mfma_f32_16x16x32_bf16(kf, qf[qt][ks], s[qt][k16], 0, 0, 0);
        }
#pragma unroll
    for (int qt = 0; qt < 2; ++qt) {
        const int ql = wq0 + qt * 16 + r16; const bool qfl = qt ? qfl1 : qfl0;
        float mx = -1e30f;
#pragma unroll
        for (int k16 = 0; k16 < 4; ++k16)
#pragma unroll
            for (int j = 0; j < 4; ++j) { const int dd = ql - (k16 * 16 + quad * 4 + j); const bool valid = qfl && dd >= lo && dd <= hi;
                const float sv = valid ? s[qt][k16][j] : -1e30f; s[qt][k16][j] = sv; mx = fmaxf(mx, sv); }
        mx = fmaxf(mx, __shfl_xor(mx, 16)); mx = fmaxf(mx, __shfl_xor(mx, 32));
        const float mn = fmaxf(m[qt], mx); const float alpha = exp2f((m[qt] - mn) * ATT_SC); m[qt] = mn;
        float ps = 0.f;
#pragma unroll
        for (int k16 = 0; k16 < 4; ++k16)
#pragma unroll
            for (int j = 0; j < 4; ++j) { const float sv = s[qt][k16][j]; const float pv = (sv > -1e29f) ? exp2f((sv - mn) * ATT_SC) : 0.f; ps += pv; s[qt][k16][j] = pv; }
        l[qt] = l[qt] * alpha + ps;
#pragma unroll
        for (int dt = 0; dt < 4; ++dt) O[qt][dt] = O[qt][dt] * alpha;
    }
#pragma unroll
    for (int G = 0; G < 2; ++G) {
        bf16x8 pf[2];
#pragma unroll
        for (int qt = 0; qt < 2; ++qt) {
            const unsigned a0 = pack2(s[qt][G * 2][0], s[qt][G * 2][1]), a1 = pack2(s[qt][G * 2][2], s[qt][G * 2][3]);
            const unsigned a2 = pack2(s[qt][G * 2 + 1][0], s[qt][G * 2 + 1][1]), a3 = pack2(s[qt][G * 2 + 1][2], s[qt][G * 2 + 1][3]);
            u32x4 pk = {a0, a1, a2, a3}; pf[qt] = __builtin_bit_cast(bf16x8, pk);
        }
#pragma unroll
        for (int dt = 0; dt < 4; ++dt) {
            const bf16_t* v0p = sV + (G * 32 + quad * 4 + (r16 >> 2)) * LDP + dt * 16 + (r16 & 3) * 4;
            const bf16x4 v0 = __builtin_amdgcn_ds_read_tr16_b64_v4i16((__attribute__((address_space(3))) bf16x4*)(v0p));
            const bf16x4 v1 = __builtin_amdgcn_ds_read_tr16_b64_v4i16((__attribute__((address_space(3))) bf16x4*)(v0p + 16 * LDP));
            const bf16x8 vf = {v0[0], v0[1], v0[2], v0[3], v1[0], v1[1], v1[2], v1[3]};
#pragma unroll
            for (int qt = 0; qt < 2; ++qt) O[qt][dt] = __builtin_amdgcn_mfma_f32_16x16x32_bf16(vf, pf[qt], O[qt][dt], 0, 0, 0);
        }
    }
}

__device__ void attn_item(const Params& p, int kind, int idx, char* smem) {
    const int t = tid_opq(), lane = t & 63, w = t >> 6, r16 = lane & 15, quad = lane >> 4;
    bf16_t* sK = (bf16_t*)smem; bf16_t* sV = sK + 64 * LDP;
    float* kmean = (float*)(smem + 18432); float* gates = (float*)(smem + 22528); unsigned* selm = (unsigned*)(smem + 30720);
    int4* desc = (int4*)(smem + 31232); int* misc = (int*)(smem + 32320);
    const bf16_t* z = (const bf16_t*)(p.ws + WS_Z);
    int b, h, qbase, stride, qcol, kcol, vcol, cfg = 0;
    __syncthreads();
    if (kind == 0) {
        const int n = 15 - (idx >> 5); const int rem = idx & 31; b = rem >> 3; h = (rem >> 1) & 3; const int qh = rem & 1;
        qbase = b * S + n * 256 + qh * 128; stride = 1; qcol = C_AQ + h * 64; kcol = C_AK + h * 64; vcol = C_AV + h * 64;
        const float* kpart = (const float*)(p.ws + WS_KPART);
        for (int e = t; e < n * 64; e += 256) { const int j = e >> 6, d = e & 63; const float* kp = kpart + (size_t)(b * 64 + j * 4) * 256 + h * 64 + d;
            kmean[e] = ((kp[0] + kp[256]) + (kp[512] + kp[768])) * (1.f / 256.f); }
        if (t == 0) misc[1] = 0;
        __syncthreads();
        {
            const int ql = t >> 1, half = t & 1; const bf16_t* qp = z + (size_t)(qbase + ql) * ZP + qcol;
            float g[8];
#pragma unroll
            for (int jj = 0; jj < 8; ++jj) g[jj] = 0.f;
#pragma unroll 1
            for (int dc = 0; dc < 8; ++dc) {
                const u32x4 qv = *(const u32x4*)(qp + dc * 8); float qq[8];
#pragma unroll
                for (int e = 0; e < 4; ++e) { qq[2 * e] = __uint_as_float(qv[e] << 16); qq[2 * e + 1] = __uint_as_float(qv[e] & 0xffff0000u); }
#pragma unroll
                for (int jj = 0; jj < 8; ++jj) { const int j = half + 2 * jj; if (j < n) { const float* km = kmean + j * 64 + dc * 8;
#pragma unroll
                    for (int e = 0; e < 8; ++e) g[jj] += qq[e] * km[e]; } }
            }
#pragma unroll
            for (int jj = 0; jj < 8; ++jj) gates[ql * 16 + half + 2 * jj] = g[jj];
        }
        __syncthreads();
        if (t < 128) {
            unsigned msk = 0;
            for (int k = 0; k < 3 && k < n; ++k) { float best = -3.0e38f; int bi = -1;
                for (int j = 0; j < n; ++j) if (!((msk >> j) & 1u)) { const float gv = gates[t * 16 + j]; if (gv > best) { best = gv; bi = j; } }
                if (bi >= 0) msk |= 1u << bi; }
            selm[t] = msk; atomicOr((unsigned*)&misc[1], msk);
        }
        __syncthreads();
        if (t == 0) {
            int nd = 0; const unsigned bm = (unsigned)misc[1];
            for (int kt = 0; kt <= qh * 2 + 1; ++kt) desc[nd++] = make_int4(b * S + n * 256 + kt * 64, kt * 64 - qh * 128, BIG, -1);
            for (int j = 0; j < n; ++j) if ((bm >> j) & 1u) for (int kt = 0; kt < 4; ++kt) desc[nd++] = make_int4(b * S + j * 256 + kt * 64, -BIG, BIG, j);
            misc[0] = nd;
        }
    } else {
        cfg = idx >> 9; const int rem = idx & 511; b = rem >> 7; h = (rem >> 5) & 3; const int rb = rem & 31;
        const int dil = 1 << (2 * cfg); const int res = rb & (dil - 1), blk = rb >> (2 * cfg);
        qbase = b * S + blk * 128 * dil + res; stride = dil; qcol = C_CQ + h * 64; kcol = C_CK + h * 64; vcol = C_CV + h * 64;
        if (t < 128) selm[t] = 0xffffffffu;
        if (t == 0) { int nd = 0; for (int kt = (blk == 0 ? 2 : 0); kt < 4; ++kt) desc[nd++] = make_int4(b * S + (blk * 128 - 128 + kt * 64) * dil + res, kt * 64 - 128, kt * 64, -1); misc[0] = nd; }
    }
    __syncthreads();
    const int nd = misc[0];
    bf16x8 qf[2][2];
#pragma unroll
    for (int qt = 0; qt < 2; ++qt)
#pragma unroll
        for (int ks = 0; ks < 2; ++ks) qf[qt][ks] = *(const bf16x8*)(z + (size_t)(qbase + (w * 32 + qt * 16 + r16) * stride) * ZP + qcol + ks * 32 + quad * 8);
    const unsigned sel0 = selm[w * 32 + r16], sel1 = selm[w * 32 + 16 + r16];
    float m[2] = {-1e30f, -1e30f}, l[2] = {0.f, 0.f}; f32x4 O[2][4];
#pragma unroll
    for (int a = 0; a < 2; ++a)
#pragma unroll
        for (int c = 0; c < 4; ++c) O[a][c] = (f32x4){0.f, 0.f, 0.f, 0.f};
    const int lrow = t >> 2, lch = (t & 3) * 2;
    u32x4 rk0, rk1, rv0, rv1;
    if (nd > 0) { const int4 d = desc[0]; const bf16_t* rp = z + (size_t)(d.x + lrow * stride) * ZP + lch * 8;
        rk0 = *(const u32x4*)(rp + kcol); rk1 = *(const u32x4*)(rp + kcol + 8); rv0 = *(const u32x4*)(rp + vcol); rv1 = *(const u32x4*)(rp + vcol + 8); }
    for (int i = 0; i < nd; ++i) {
        __syncthreads();
        *(u32x4*)(sK + lrow * LDP + lch * 8) = rk0; *(u32x4*)(sK + lrow * LDP + lch * 8 + 8) = rk1;
        *(u32x4*)(sV + lrow * LDP + lch * 8) = rv0; *(u32x4*)(sV + lrow * LDP + lch * 8 + 8) = rv1;
        __syncthreads();
        if (i + 1 < nd) { const int4 d = desc[i + 1]; const bf16_t* rp = z + (size_t)(d.x + lrow * stride) * ZP + lch * 8;
            rk0 = *(const u32x4*)(rp + kcol); rk1 = *(const u32x4*)(rp + kcol + 8); rv0 = *(const u32x4*)(rp + vcol); rv1 = *(const u32x4*)(rp + vcol + 8); }
        const int4 d = desc[i];
        bool need = (w * 32 + 31 >= d.y) && (w * 32 - 63 <= d.z);
        bool q0 = true, q1 = true;
        if (d.w >= 0) { q0 = (sel0 >> d.w) & 1u; q1 = (sel1 >> d.w) & 1u; need = need && (__ballot(q0 || q1) != 0ull); }
        if (need) attn_tile(sK, sV, qf, d.y, d.z, q0, q1, m, l, O, w * 32);
    }
#pragma unroll
    for (int qt = 0; qt < 2; ++qt) {
        float lt = l[qt]; lt += __shfl_xor(lt, 16); lt += __shfl_xor(lt, 32);
        const float inv = 1.f / lt; const size_t tok = (size_t)(qbase + (w * 32 + qt * 16 + r16) * stride);
        if (kind == 0) {
            bf16_t* mix = (bf16_t*)(p.ws + WS_U);
#pragma unroll
            for (int dt = 0; dt < 4; ++dt) { const int d0 = dt * 16 + quad * 4; const u32x2 gv = *(const u32x2*)(z + tok * ZP + C_AG + h * 64 + d0);
                const float g0 = __uint_as_float(gv.x << 16), g1 = __uint_as_float(gv.x & 0xffff0000u), g2 = __uint_as_float(gv.y << 16), g3 = __uint_as_float(gv.y & 0xffff0000u);
                u32x2 o; o.x = pack2(O[qt][dt][0] * inv * silu_f(g0), O[qt][dt][1] * inv * silu_f(g1)); o.y = pack2(O[qt][dt][2] * inv * silu_f(g2), O[qt][dt][3] * inv * silu_f(g3));
                *(u32x2*)(mix + tok * 1024 + h * 64 + d0) = o; }
        } else {
            bf16_t* dilo = (bf16_t*)(p.ws + WS_DILO); float* dill = (float*)(p.ws + WS_DILL);
#pragma unroll
            for (int dt = 0; dt < 4; ++dt) { const int d0 = dt * 16 + quad * 4; u32x2 o; o.x = pack2(O[qt][dt][0] * inv, O[qt][dt][1] * inv); o.y = pack2(O[qt][dt][2] * inv, O[qt][dt][3] * inv);
                *(u32x2*)(dilo + ((size_t)cfg * T + tok) * 256 + h * 64 + d0) = o; }
            if (quad == 0) dill[((size_t)cfg * T + tok) * 4 + h] = m[qt] * 0.125f + __logf(lt);
        }
    }
}

__device__ __forceinline__ void gla_bcum(const Params& p, int l, const bf16_t* z, int tok0, float* bc, float* drs) {
    const int t = tid_opq();
    for (int e = t; e < 512; e += 256) { const int i = e >> 4, r = e & 15; drs[e] = bf2f(z[(size_t)(tok0 + i) * ZP + C_DR + r]); }
    __syncthreads();
    const int hd = t & 127, ih = t >> 7;
    float wr[16];
#pragma unroll
    for (int r = 0; r < 16; ++r) wr[r] = p.gla_wr[l * 2048 + r * 128 + hd];
    const float br = p.gla_br[l * 128 + hd];
#pragma unroll
    for (int ii = 0; ii < 16; ++ii) { const int i = ih * 16 + ii; float x = br;
#pragma unroll
        for (int r = 0; r < 16; ++r) x += drs[i * 16 + r] * wr[r];
        bc[i * 128 + hd] = (fminf(x, 0.f) - log1pf(__expf(-fabsf(x)))) * (1.f / 16.f); }
    __syncthreads();
    if (t < 128) { float s = 0.f; for (int i = 0; i < 32; ++i) { s += bc[i * 128 + t]; bc[i * 128 + t] = s; } }
    __syncthreads();
}

__device__ void gla1_item(const Params& p, int l, int idx, char* smem) {
    const int t = tid_opq(), lane = t & 63, w = t >> 6;
    const int b = idx >> 7, c = idx & 127; const int tok0 = b * S + c * 32;
    const bf16_t* z = (const bf16_t*)(p.ws + WS_Z);
    float* bc = (float*)smem; float* drs = (float*)(smem + 16384); float* kdec = (float*)(smem + 18432) + w * 1024;
    float* gkv = (float*)(p.ws + WS_GKV); float* gdec = (float*)(p.ws + WS_GDEC);
    __syncthreads();
    gla_bcum(p, l, z, tok0, bc, drs);
    for (int e = lane; e < 1024; e += 64) { const int j = e >> 5, d = e & 31; const float kk = bf2f(z[(size_t)(tok0 + j) * ZP + C_DK + w * 32 + d]);
        kdec[j * 32 + d] = kk * __expf(bc[31 * 128 + w * 32 + d] - bc[j * 128 + w * 32 + d]); }
    __syncthreads();
    float acc[32];
#pragma unroll
    for (int d = 0; d < 32; ++d) acc[d] = 0.f;
#pragma unroll 4
    for (int j = 0; j < 32; ++j) { const float vv = bf2f(z[(size_t)(tok0 + j) * ZP + C_DV + w * 64 + lane]);
#pragma unroll
        for (int d4 = 0; d4 < 8; ++d4) { const f32x4 kd = *(const f32x4*)(kdec + j * 32 + d4 * 4); acc[d4 * 4] += kd[0] * vv; acc[d4 * 4 + 1] += kd[1] * vv; acc[d4 * 4 + 2] += kd[2] * vv; acc[d4 * 4 + 3] += kd[3] * vv; } }
    const int bh = b * 4 + w; float* dst = gkv + (size_t)(bh * 128 + c) * 2048;
#pragma unroll
    for (int d = 0; d < 32; ++d) dst[d * 64 + lane] = acc[d];
    if (lane < 32) gdec[(bh * 128 + c) * 32 + lane] = __expf(bc[31 * 128 + w * 32 + lane]);
}

__device__ void gla3_item(const Params& p, int l, int idx, char* smem) {
    const int t = tid_opq(), lane = t & 63, w = t >> 6;
    const int b = idx >> 7, c = idx & 127; const int tok0 = b * S + c * 32;
    const bf16_t* z = (const bf16_t*)(p.ws + WS_Z); bf16_t* mix = (bf16_t*)(p.ws + WS_U);
    float* bc = (float*)smem; float* As = (float*)smem + w * 1024; float* drs = (float*)(smem + 16384);
    float* qeT = (float*)(smem + 18432) + w * 1024; float* keT = (float*)(smem + 34816) + w * 1024;
    const float* gkv = (const float*)(p.ws + WS_GKV);
    __syncthreads();
    gla_bcum(p, l, z, tok0, bc, drs);
    for (int e = lane; e < 1024; e += 64) { const int i = e >> 5, d = e & 31; const float bcv = bc[i * 128 + w * 32 + d];
        const float qv = bf2f(z[(size_t)(tok0 + i) * ZP + C_DQ + w * 32 + d]), kv = bf2f(z[(size_t)(tok0 + i) * ZP + C_DK + w * 32 + d]);
        qeT[d * 32 + i] = qv * __expf(bcv) * 0.17677669529663687f; keT[d * 32 + i] = kv * __expf(-bcv); }
    __syncthreads();
    {
        const int i = lane & 31, jh = lane >> 5; float a[16];
#pragma unroll
        for (int jj = 0; jj < 16; ++jj) a[jj] = 0.f;
#pragma unroll 4
        for (int d = 0; d < 32; ++d) { const float qv = qeT[d * 32 + i];
#pragma unroll
            for (int j4 = 0; j4 < 4; ++j4) { const f32x4 k4 = *(const f32x4*)(keT + d * 32 + jh * 16 + j4 * 4); a[j4 * 4] += qv * k4[0]; a[j4 * 4 + 1] += qv * k4[1]; a[j4 * 4 + 2] += qv * k4[2]; a[j4 * 4 + 3] += qv * k4[3]; } }
#pragma unroll
        for (int jj = 0; jj < 16; ++jj) { const int j = jh * 16 + jj; As[j * 32 + i] = (j <= i) ? a[jj] : 0.f; }
    }
    __syncthreads();
    float o[32];
#pragma unroll
    for (int i = 0; i < 32; ++i) o[i] = 0.f;
#pragma unroll 4
    for (int j = 0; j < 32; ++j) { const float vv = bf2f(z[(size_t)(tok0 + j) * ZP + C_DV + w * 64 + lane]);
#pragma unroll
        for (int i4 = 0; i4 < 8; ++i4) { const f32x4 a4 = *(const f32x4*)(As + j * 32 + i4 * 4); o[i4 * 4] += a4[0] * vv; o[i4 * 4 + 1] += a4[1] * vv; o[i4 * 4 + 2] += a4[2] * vv; o[i4 * 4 + 3] += a4[3] * vv; } }
    const int bh = b * 4 + w; const float* Sp = gkv + (size_t)(bh * 128 + c) * 2048;
#pragma unroll 4
    for (int d = 0; d < 32; ++d) { const float sv = Sp[d * 64 + lane];
#pragma unroll
        for (int i4 = 0; i4 < 8; ++i4) { const f32x4 q4 = *(const f32x4*)(qeT + d * 32 + i4 * 4); o[i4 * 4] += q4[0] * sv; o[i4 * 4 + 1] += q4[1] * sv; o[i4 * 4 + 2] += q4[2] * sv; o[i4 * 4 + 3] += q4[3] * sv; } }
    const float gn = p.gla_gn[l * 64 + lane];
#pragma unroll
    for (int i = 0; i < 32; ++i) { const float ss = wsum(o[i] * o[i]); const float y = o[i] * rsqrtf(ss * (1.f / 64.f) + 1e-5f) * gn;
        const size_t tok = (size_t)(tok0 + i); const float g = bf2f(z[tok * ZP + C_DG + w * 64 + lane]);
        mix[tok * 1024 + 768 + w * 64 + lane] = f2bf(y * silu_f(g)); }
}

__device__ void lru1_item(const Params& p, int l, int idx, char* smem) {
    const int t = tid_opq(), lane = t & 63, g = t >> 6; const int ch = t;
    const int b = idx >> 7, c = idx & 127; const int s0 = c * 32; const int tok0 = b * S + s0;
    const bf16_t* z = (const bf16_t*)(p.ws + WS_Z); float* xcs = (float*)smem;
    float* lh = (float*)(p.ws + WS_LH); float* lp = (float*)(p.ws + WS_LP);
    const float cw0 = p.conv_w[l * 1024 + ch], cw1 = p.conv_w[l * 1024 + 256 + ch], cw2 = p.conv_w[l * 1024 + 512 + ch], cw3 = p.conv_w[l * 1024 + 768 + ch];
    const float cb = p.conv_b[l * 256 + ch];
    __syncthreads();
    float x0 = (s0 >= 3) ? bf2f(z[(size_t)(tok0 - 3) * ZP + C_BX + ch]) : 0.f;
    float x1 = (s0 >= 2) ? bf2f(z[(size_t)(tok0 - 2) * ZP + C_BX + ch]) : 0.f;
    float x2 = (s0 >= 1) ? bf2f(z[(size_t)(tok0 - 1) * ZP + C_BX + ch]) : 0.f;
#pragma unroll 8
    for (int i = 0; i < 32; ++i) { const float x3 = bf2f(z[(size_t)(tok0 + i) * ZP + C_BX + ch]);
        xcs[i * 256 + ch] = cb + cw0 * x0 + cw1 * x1 + cw2 * x2 + cw3 * x3; x0 = x1; x1 = x2; x2 = x3; }
    __syncthreads();
    float aA[32], aX[32];
#pragma unroll
    for (int i = 0; i < 32; ++i) { aA[i] = 0.f; aX[i] = 0.f; }
    const float* wa = p.lru_wa + l * 16384 + g * 4096 + lane; const float* wx = p.lru_wx + l * 16384 + g * 4096 + lane;
#pragma unroll 1
    for (int k4 = 0; k4 < 16; ++k4) {
        const float wa0 = wa[(k4 * 4) * 64], wa1 = wa[(k4 * 4 + 1) * 64], wa2 = wa[(k4 * 4 + 2) * 64], wa3 = wa[(k4 * 4 + 3) * 64];
        const float wx0 = wx[(k4 * 4) * 64], wx1 = wx[(k4 * 4 + 1) * 64], wx2 = wx[(k4 * 4 + 2) * 64], wx3 = wx[(k4 * 4 + 3) * 64];
#pragma unroll
        for (int i = 0; i < 32; ++i) { const f32x4 xv = *(const f32x4*)(xcs + i * 256 + g * 64 + k4 * 4);
            aA[i] += (xv[0] * wa0 + xv[1] * wa1) + (xv[2] * wa2 + xv[3] * wa3); aX[i] += (xv[0] * wx0 + xv[1] * wx1) + (xv[2] * wx2 + xv[3] * wx3); }
    }
    const float ba = p.lru_ba[l * 256 + ch], bx = p.lru_bx[l * 256 + ch], lam = p.lru_lam[l * 256 + ch];
    const float sp = fmaxf(-lam, 0.f) + log1pf(__expf(-fabsf(lam)));
    float hh = 0.f, P = 1.f;
#pragma unroll
    for (int i = 0; i < 32; ++i) { const float r = sigmoid_f(aA[i] + ba), ig = sigmoid_f(aX[i] + bx); const float la = -8.f * r * sp; const float a = __expf(la);
        const float u = sqrtf(-expm1f(2.f * la)) * (ig * xcs[i * 256 + ch]); hh = a * hh + u; P *= a;
        lh[(size_t)(tok0 + i) * 256 + ch] = hh; lp[(size_t)(tok0 + i) * 256 + ch] = P; }
}

__device__ void lru3_item(const Params& p, int idx) {
    const int ch = tid_opq(); const int b = idx >> 7, c = idx & 127; const int tok0 = b * S + c * 32;
    const bf16_t* z = (const bf16_t*)(p.ws + WS_Z); bf16_t* mix = (bf16_t*)(p.ws + WS_U);
    const float* lh = (const float*)(p.ws + WS_LH); const float* lp = (const float*)(p.ws + WS_LP); const float* lc = (const float*)(p.ws + WS_LC);
    const float carry = lc[(size_t)(b * 128 + c) * 256 + ch];
#pragma unroll 8
    for (int i = 0; i < 32; ++i) { const size_t tok = (size_t)(tok0 + i); const float hv = lh[tok * 256 + ch] + lp[tok * 256 + ch] * carry;
        const float g = bf2f(z[tok * ZP + C_BG + ch]); mix[tok * 1024 + 256 + ch] = f2bf(hv * silu_f(g)); }
}

__device__ void dilc_item(const Params& p, int idx) {
    const int t = tid_opq(); const size_t tok = (size_t)idx * 8 + (t >> 5); const int chn = t & 31; const int h = chn >> 3;
    const bf16_t* z = (const bf16_t*)(p.ws + WS_Z); bf16_t* mix = (bf16_t*)(p.ws + WS_U);
    const bf16_t* dilo = (const bf16_t*)(p.ws + WS_DILO); const float* dill = (const float*)(p.ws + WS_DILL);
    const float l0 = dill[((size_t)0 * T + tok) * 4 + h], l1 = dill[((size_t)1 * T + tok) * 4 + h], l2 = dill[((size_t)2 * T + tok) * 4 + h];
    const float mx = fmaxf(l0, fmaxf(l1, l2)); float w0 = __expf(l0 - mx), w1 = __expf(l1 - mx), w2 = __expf(l2 - mx); const float inv = 1.f / (w0 + w1 + w2); w0 *= inv; w1 *= inv; w2 *= inv;
    const u32x4 o0 = *(const u32x4*)(dilo + ((size_t)0 * T + tok) * 256 + chn * 8), o1 = *(const u32x4*)(dilo + ((size_t)1 * T + tok) * 256 + chn * 8), o2 = *(const u32x4*)(dilo + ((size_t)2 * T + tok) * 256 + chn * 8);
    const u32x4 gv = *(const u32x4*)(z + tok * ZP + C_CG + chn * 8);
    u32x4 r;
#pragma unroll
    for (int e = 0; e < 4; ++e) {
        const float a = w0 * __uint_as_float(o0[e] << 16) + w1 * __uint_as_float(o1[e] << 16) + w2 * __uint_as_float(o2[e] << 16);
        const float bq = w0 * __uint_as_float(o0[e] & 0xffff0000u) + w1 * __uint_as_float(o1[e] & 0xffff0000u) + w2 * __uint_as_float(o2[e] & 0xffff0000u);
        r[e] = pack2(a * silu_f(__uint_as_float(gv[e] << 16)), bq * silu_f(__uint_as_float(gv[e] & 0xffff0000u)));
    }
    *(u32x4*)(mix + tok * 1024 + 512 + chn * 8) = r;
}

__device__ void m2_phase(const Params& p) {
    float* gkv = (float*)(p.ws + WS_GKV); const float* gdec = (const float*)(p.ws + WS_GDEC);
    const float* lh = (const float*)(p.ws + WS_LH); const float* lp = (const float*)(p.ws + WS_LP); float* lc = (float*)(p.ws + WS_LC);
    for (int it = blockIdx.x; it < 128 + 4; it += gridDim.x) {
        if (it < 128) {
            const int gid = it * 256 + tid_opq(); const int bh = gid >> 11, dv = gid & 2047, d = dv >> 6;
            float* base = gkv + (size_t)bh * 128 * 2048 + dv; const float* dc = gdec + (size_t)bh * 128 * 32 + d;
            float st = 0.f;
#pragma unroll 8
            for (int n = 0; n < 128; ++n) { const float kvv = base[(size_t)n * 2048]; const float de = dc[n * 32]; base[(size_t)n * 2048] = st; st = de * st + kvv; }
        } else {
            const int gid = (it - 128) * 256 + tid_opq(); const int b = gid >> 8, ch = gid & 255;
            float carry = 0.f;
#pragma unroll 8
            for (int n = 0; n < 128; ++n) { const size_t ix = (size_t)(b * S + n * 32 + 31) * 256 + ch; const float Pl = lp[ix], hl = lh[ix];
                lc[(size_t)(b * 128 + n) * 256 + ch] = carry; carry = Pl * carry + hl; }
        }
    }
}

__global__ void __launch_bounds__(256, 2) fwd_megakernel(Params p) {
    __shared__ __attribute__((aligned(16))) char smem[SMEM_BYTES];
    cg::grid_group grid = cg::this_grid();
    prologue_phase(p, smem);
    grid.sync();
#pragma unroll 1
    for (int l = 0; l < DEPTH; ++l) {
        ln_phase(p, l);
        grid.sync();
        g1_phase(p, l, smem);
        grid.sync();
        for (int it = blockIdx.x; it < 2048; it += gridDim.x) attn_item(p, it < 512 ? 0 : 1, it < 512 ? it : it - 512, smem);
        for (int it = blockIdx.x; it < 512; it += gridDim.x) gla1_item(p, l, it, smem);
        for (int it = blockIdx.x; it < 512; it += gridDim.x) lru1_item(p, l, it, smem);
        grid.sync();
        m2_phase(p);
        grid.sync();
        for (int it = blockIdx.x; it < 512; it += gridDim.x) gla3_item(p, l, it, smem);
        for (int it = blockIdx.x; it < 512; it += gridDim.x) lru3_item(p, it);
        for (int it = blockIdx.x; it < 2048; it += gridDim.x) dilc_item(p, it);
        grid.sync();
        g2_phase(p, l, smem);
        grid.sync();
    }
    ln_phase(p, DEPTH);
}

extern "C" void kernel_launch(void* const* d_in, const int* in_sizes, int n_in, void* d_out, int out_size, void* d_ws, size_t ws_size, hipStream_t stream) {
    static int grid_blocks = 0;
    if (!grid_blocks) {
        int dev = 0, cus = 0, per_cu = 0;
        hipGetDevice(&dev);
        hipDeviceGetAttribute(&cus, hipDeviceAttributeMultiprocessorCount, dev);
        hipOccupancyMaxActiveBlocksPerMultiprocessor(&per_cu, (const void*)fwd_megakernel, 256, 0);
        if (per_cu < 1) per_cu = 1;
        if (per_cu > 2) per_cu = 2;
        grid_blocks = cus * per_cu;
        if (ws_size < WS_END) fprintf(stderr, "kernel_launch: workspace too small: %zu < %zu\n", ws_size, (size_t)WS_END);
    }
    Params p{};
    p.x = (const float*)d_in[0]; p.c = (const float*)d_in[1]; p.pos = (const int*)d_in[2];
    p.w_mod = (const float*)d_in[3]; p.b_mod = (const float*)d_in[4]; p.w_in = (const float*)d_in[5];
    p.conv_w = (const float*)d_in[6]; p.conv_b = (const float*)d_in[7]; p.lru_wa = (const float*)d_in[8]; p.lru_ba = (const float*)d_in[9];
    p.lru_wx = (const float*)d_in[10]; p.lru_bx = (const float*)d_in[11]; p.lru_lam = (const float*)d_in[12];
    p.gla_wr = (const float*)d_in[13]; p.gla_br = (const float*)d_in[14]; p.gla_gn = (const float*)d_in[15];
    p.w_out = (const float*)d_in[16]; p.ln_g = (const float*)d_in[17]; p.ln_b = (const float*)d_in[18];
    p.out = (float*)d_out; p.ws = (unsigned char*)d_ws;
    void* args[] = {&p};
    hipError_t e = hipLaunchCooperativeKernel((const void*)fwd_megakernel, dim3(grid_blocks), dim3(256), args, 0, stream);
    if (e != hipSuccess) fprintf(stderr, "cooperative launch failed: %s (grid %d)\n", hipGetErrorString(e), grid_blocks);
}
```

```cpp
#include <hip/hip_runtime.h>
#include <hip/hip_cooperative_groups.h>
#include <cstdio>
#include <cstdint>
namespace cg = cooperative_groups;

typedef unsigned short bf16_t;
typedef short bf16x8 __attribute__((ext_vector_type(8)));
typedef short bf16x4 __attribute__((ext_vector_type(4)));
typedef float f32x4 __attribute__((ext_vector_type(4)));
typedef unsigned u32x4 __attribute__((ext_vector_type(4)));
typedef unsigned u32x2 __attribute__((ext_vector_type(2)));

constexpr int D = 1024, NB = 4, S = 4096, T = NB * S, DEPTH = 2;
constexpr int DIN = 3344, ZP = 3344, NPAD = 3456;
constexpr int C_AQ = 0, C_AK = 256, C_AV = 512, C_AG = 768, C_BX = 1024, C_BG = 1280, C_CQ = 1536, C_CK = 1792,
              C_CV = 2048, C_CG = 2304, C_DQ = 2560, C_DK = 2688, C_DV = 2816, C_DG = 3072, C_DR = 3328;
constexpr float DN_ALPHA = 1.4142135623730951f;
constexpr int LDP = 72;
constexpr int SMEM_BYTES = 73728;
constexpr int BIG = 1000000;

constexpr size_t WS_CTL = 0;
constexpr size_t WS_CNT = 16384;
constexpr size_t WS_WINT = 32768;
constexpr size_t WS_WOUTT = WS_WINT + (size_t)DEPTH * NPAD * 1024 * 2;
constexpr size_t WS_MOD = WS_WOUTT + (size_t)DEPTH * 1024 * 1024 * 2;
constexpr size_t WS_COS = WS_MOD + (size_t)DEPTH * NB * 3072 * 4;
constexpr size_t WS_SIN = WS_COS + (size_t)T * 32 * 4;
constexpr size_t WS_U = WS_SIN + (size_t)T * 32 * 4;
constexpr size_t WS_Z = WS_U + (size_t)T * 1024 * 2;
constexpr size_t WS_KPART = WS_Z + (size_t)T * ZP * 2;
constexpr size_t WS_DILO = WS_KPART + (size_t)256 * 256 * 4;
constexpr size_t WS_DILL = WS_DILO + (size_t)3 * T * 256 * 2;
constexpr size_t WS_GKV = WS_DILL + (size_t)3 * T * 4 * 4;
constexpr size_t WS_GDEC = WS_GKV + (size_t)2048 * 2048 * 4;
constexpr size_t WS_LH = WS_GDEC + (size_t)2048 * 32 * 4;
constexpr size_t WS_LP = WS_LH + (size_t)T * 256 * 4;
constexpr size_t WS_LC = WS_LP + (size_t)T * 256 * 4;
constexpr size_t WS_END = WS_LC + (size_t)NB * 128 * 256 * 4;

struct Params {
    const float *x, *c; const int* pos;
    const float *w_mod, *b_mod, *w_in, *conv_w, *conv_b, *lru_wa, *lru_ba, *lru_wx, *lru_bx, *lru_lam, *gla_wr, *gla_br, *gla_gn, *w_out, *ln_g, *ln_b;
    float* out; unsigned char* ws;
};

__device__ __forceinline__ float bf2f(bf16_t h) { return __uint_as_float(((unsigned)h) << 16); }
typedef __bf16 hbf16x2 __attribute__((ext_vector_type(2)));
typedef float f32x2 __attribute__((ext_vector_type(2)));
__device__ __forceinline__ unsigned pack2(float a, float b) { f32x2 v = {a, b}; hbf16x2 r = __builtin_convertvector(v, hbf16x2); return __builtin_bit_cast(unsigned, r); }
__device__ __forceinline__ bf16_t f2bf(float f) { return (bf16_t)(pack2(f, 0.f) & 0xffffu); }
__device__ __forceinline__ float silu_f(float x) { return x / (1.f + __expf(-x)); }
__device__ __forceinline__ float sigmoid_f(float x) { return 1.f / (1.f + __expf(-x)); }
__device__ __forceinline__ int tid_opq() { int t = threadIdx.x; asm volatile("" : "+v"(t)); return t; }
__device__ __forceinline__ float wsum(float v) {
#pragma unroll
    for (int o = 32; o; o >>= 1) v += __shfl_xor(v, o);
    return v;
}

#define XB_TMO      128
#define XB_XCNT(j)  (256  + 64 * (j))
#define XB_XSUB(j)  (1280 + 64 * (j))
#define XB_XGEN(j)  (2304 + 64 * (j))
#define XB_TOP      3328
#define XB_TOPGEN   3392
#define XCD_BAR_WORDS 3456
#define XB_SPIN_CAP (1u << 18)
#define LAS __attribute__((address_space(3)))
__device__ __forceinline__ unsigned xb_ld(unsigned* p)              { return __hip_atomic_load(p, __ATOMIC_RELAXED, __HIP_MEMORY_SCOPE_AGENT); }
__device__ __forceinline__ unsigned xb_add(unsigned* p, unsigned v) { return __hip_atomic_fetch_add(p, v, __ATOMIC_RELAXED, __HIP_MEMORY_SCOPE_AGENT); }
__device__ __forceinline__ unsigned xb_xcc_id() { return (unsigned)__builtin_amdgcn_s_getreg((3 << 11) | 20) & 0xFu; }
#define XB_SPIN(cond, bar) do { unsigned _sp = 0; while (cond) { __builtin_amdgcn_s_sleep(1); \
    if ((++_sp & 255u) == 0u) { if (xb_ld(&(bar)[XB_TMO])) break; if (_sp > XB_SPIN_CAP) { atomicAdd(&(bar)[XB_TMO], 1u); break; } } } } while (0)
struct XcdBarrier { unsigned* bar; unsigned x; volatile LAS unsigned* st; };
__device__ __forceinline__ XcdBarrier xcd_barrier_post(unsigned* bar, volatile LAS unsigned* st) {
    XcdBarrier b; b.bar = bar; b.x = xb_xcc_id(); b.st = st;
    if (threadIdx.x == 0) (void)xb_add(&bar[XB_XCNT(b.x)], 1u);
    return b;
}
__device__ __forceinline__ void xcd_barrier_complete(unsigned* bar, unsigned x, unsigned& nloc, unsigned& nx) {
    const unsigned G = gridDim.x * gridDim.y * gridDim.z;
    unsigned sum, cnt, mine, sp = 0u;
    for (;;) {
        sum = 0u; cnt = 0u; mine = 0u;
#pragma unroll
        for (unsigned j = 0; j < 16; ++j) { const unsigned c = xb_ld(&bar[XB_XCNT(j)]); sum += c; cnt += (c > 0u) ? 1u : 0u; mine = (j == x) ? c : mine; }
        if (sum == G) break;
        __builtin_amdgcn_s_sleep(1);
        if ((++sp & 255u) == 0u) { if (xb_ld(&bar[XB_TMO])) break; if (sp > XB_SPIN_CAP) { atomicAdd(&bar[XB_TMO], 1u); break; } }
    }
    nloc = mine > 0u ? mine : 1u; nx = cnt > 0u ? cnt : 1u;
}
__device__ __forceinline__ void xcd_barrier(const XcdBarrier& b) {
    asm volatile("s_waitcnt vmcnt(0)" ::: "memory");
    __syncthreads();
    if (threadIdx.x == 0) {
        unsigned* bar = b.bar;
        __builtin_amdgcn_s_waitcnt(0);
        unsigned nloc = b.st[0], nx = b.st[1];
        if (nloc == 0u) { xcd_barrier_complete(bar, b.x, nloc, nx); b.st[0] = nloc; b.st[1] = nx; }
        const unsigned old = xb_add(&bar[XB_XSUB(b.x)], 1u);
        const unsigned gen = old / nloc;
        if (old + 1u == (gen + 1u) * nloc) {
            __builtin_amdgcn_fence(__ATOMIC_RELEASE, "agent");
            asm volatile("s_waitcnt vmcnt(0)" ::: "memory");
            const unsigned og = xb_add(&bar[XB_TOP], 1u);
            const unsigned tg = og / nx;
            if (og + 1u == (tg + 1u) * nx) xb_add(&bar[XB_TOPGEN], 1u);
            else XB_SPIN(xb_ld(&bar[XB_TOPGEN]) == tg, bar);
            __builtin_amdgcn_fence(__ATOMIC_ACQUIRE, "agent");
            xb_add(&bar[XB_XGEN(b.x)], 1u);
            asm volatile("s_waitcnt vmcnt(0)" ::: "memory");
        } else {
            XB_SPIN(xb_ld(&bar[XB_XGEN(b.x)]) == gen, bar);
            __builtin_amdgcn_fence(__ATOMIC_ACQUIRE, "agent");
            asm volatile("s_waitcnt vmcnt(0)" ::: "memory");
        }
    }
    __syncthreads();
}
__device__ __forceinline__ int next_item(unsigned* ctr, volatile int* slot) {
    __syncthreads();
    if (threadIdx.x == 0) *slot = (int)atomicAdd(ctr, 1u);
    __syncthreads();
    return *slot;
}

__device__ void prologue_phase(const Params& p, char* smem) {
    const int t = tid_opq();
    bf16_t* WinT = (bf16_t*)(p.ws + WS_WINT); bf16_t* WoutT = (bf16_t*)(p.ws + WS_WOUTT);
    float* mod = (float*)(p.ws + WS_MOD); float* cosT = (float*)(p.ws + WS_COS); float* sinT = (float*)(p.ws + WS_SIN);
    float* tl = (float*)smem;
    constexpr int N_TIN = DEPTH * 16 * 54, N_TOUT = DEPTH * 16 * 16, N_MOD = DEPTH * 192, N_ROPE = T * 32 / 256;
    constexpr int NITEMS = N_TIN + N_TOUT + N_MOD + N_ROPE;
    for (int it = blockIdx.x; it < NITEMS; it += gridDim.x) {
        if (it < N_TIN + N_TOUT) {
            const float* src; bf16_t* dst; int ncols, kt, nt;
            if (it < N_TIN) { int l = it / (16 * 54), r = it % (16 * 54); kt = r / 54; nt = r % 54; src = p.w_in + (size_t)l * 1024 * DIN; dst = WinT + (size_t)l * NPAD * 1024; ncols = DIN; }
            else { int i2 = it - N_TIN; int l = i2 / 256, r = i2 % 256; kt = r / 16; nt = r % 16; src = p.w_out + (size_t)l * 1024 * 1024; dst = WoutT + (size_t)l * 1024 * 1024; ncols = 1024; }
            __syncthreads();
            { const int c = t & 63, r0 = t >> 6; const int n = nt * 64 + c;
#pragma unroll
              for (int i = 0; i < 16; ++i) { int r = r0 + 4 * i; tl[r * 65 + c] = (n < ncols) ? src[(size_t)(kt * 64 + r) * ncols + n] : 0.f; } }
            __syncthreads();
            { const int kk = t & 63, n0 = t >> 6;
#pragma unroll
              for (int i = 0; i < 16; ++i) { int n = n0 + 4 * i; dst[(size_t)(nt * 64 + n) * 1024 + kt * 64 + kk] = f2bf(tl[kk * 65 + n]); } }
        } else if (it < N_TIN + N_TOUT + N_MOD) {
            const int i2 = it - N_TIN - N_TOUT; const int l = i2 / 192, jg = i2 % 192;
            const int jj = t & 15, ks = t >> 4; const int j = jg * 16 + jj;
            float a0 = 0.f, a1 = 0.f, a2 = 0.f, a3 = 0.f;
            const float* wm = p.w_mod + (size_t)l * 1024 * 3072 + j;
#pragma unroll 8
            for (int k = ks * 64; k < ks * 64 + 64; ++k) { float wv = wm[(size_t)k * 3072]; a0 += p.c[k] * wv; a1 += p.c[1024 + k] * wv; a2 += p.c[2048 + k] * wv; a3 += p.c[3072 + k] * wv; }
            __syncthreads();
            tl[(0 * 16 + ks) * 16 + jj] = a0; tl[(1 * 16 + ks) * 16 + jj] = a1; tl[(2 * 16 + ks) * 16 + jj] = a2; tl[(3 * 16 + ks) * 16 + jj] = a3;
            __syncthreads();
            if (t < 64) { const int b = t >> 4, j2 = t & 15; float s = 0.f;
#pragma unroll
              for (int k2 = 0; k2 < 16; ++k2) s += tl[(b * 16 + k2) * 16 + j2];
              mod[((size_t)l * NB + b) * 3072 + jg * 16 + j2] = s + p.b_mod[l * 3072 + jg * 16 + j2]; }
        } else {
            const int i2 = it - N_TIN - N_TOUT - N_MOD; const int e = i2 * 256 + t; const int tok = e >> 5, f = e & 31;
            const float inv = exp2f(-(float)f * (13.287712379549449f / 32.f));
            const float ang = (float)p.pos[tok] * inv;
            cosT[e] = cosf(ang); sinT[e] = sinf(ang);
        }
    }
}

__device__ void ln_phase(const Params& p, int l) {
    const int t = tid_opq(), lane = t & 63, w = t >> 6;
    bf16_t* ubuf = (bf16_t*)(p.ws + WS_U); const float* mod = (const float*)(p.ws + WS_MOD);
    for (int rg = blockIdx.x; rg < T / 4; rg += gridDim.x) {
        const int row = rg * 4 + w; const int b = row / S;
        const float* src = (l == 0) ? p.x + (size_t)row * 1024 : p.out + (size_t)row * 1024;
        f32x4 v[4];
#pragma unroll
        for (int i = 0; i < 4; ++i) v[i] = *(const f32x4*)(src + i * 256 + lane * 4);
        if (l > 0) {
            float s = 0.f;
#pragma unroll
            for (int i = 0; i < 4; ++i) s += (v[i][0] + v[i][1]) + (v[i][2] + v[i][3]);
            const float mu = wsum(s) * (1.f / 1024.f); float q = 0.f;
#pragma unroll
            for (int i = 0; i < 4; ++i) { f32x4 d = v[i] - mu; q += (d[0] * d[0] + d[1] * d[1]) + (d[2] * d[2] + d[3] * d[3]); }
            const float rstd = rsqrtf(wsum(q) * (1.f / 1024.f) + 1e-5f);
#pragma unroll
            for (int i = 0; i < 4; ++i) { const f32x4 g = *(const f32x4*)(p.ln_g + (l - 1) * 1024 + i * 256 + lane * 4), bb = *(const f32x4*)(p.ln_b + (l - 1) * 1024 + i * 256 + lane * 4);
                v[i] = (v[i] - mu) * rstd * g + bb; *(f32x4*)(p.out + (size_t)row * 1024 + i * 256 + lane * 4) = v[i]; }
        }
        if (l < DEPTH) {
            float s = 0.f;
#pragma unroll
            for (int i = 0; i < 4; ++i) s += (v[i][0] + v[i][1]) + (v[i][2] + v[i][3]);
            const float mu = wsum(s) * (1.f / 1024.f); float q = 0.f;
#pragma unroll
            for (int i = 0; i < 4; ++i) { f32x4 d = v[i] - mu; q += (d[0] * d[0] + d[1] * d[1]) + (d[2] * d[2] + d[3] * d[3]); }
            const float rstd = rsqrtf(wsum(q) * (1.f / 1024.f) + 1e-5f);
            const float* mb = mod + ((size_t)l * NB + b) * 3072;
#pragma unroll
            for (int i = 0; i < 4; ++i) { const int col = i * 256 + lane * 4; const f32x4 sh = *(const f32x4*)(mb + col), sc = *(const f32x4*)(mb + 1024 + col);
                f32x4 u = (v[i] - mu) * rstd * (sc + 1.f) + sh; u32x2 pk; pk.x = pack2(u[0], u[1]); pk.y = pack2(u[2], u[3]);
                *(u32x2*)(ubuf + (size_t)row * 1024 + col) = pk; }
        }
    }
}

__device__ __forceinline__ void gemm_core(const bf16_t* __restrict__ A, const bf16_t* __restrict__ Bt, int tm, int tn, bf16_t* sm, f32x4 (&acc)[4][4]) {
    const int t = tid_opq(), lane = t & 63, w = t >> 6, wm = w >> 1, wn = w & 1, r16 = lane & 15, quad = lane >> 4;
    const int lrow = t >> 3, lch = t & 7;
    constexpr int BUF = 256 * LDP;
    const bf16_t* Ag = A + (size_t)(tm * 128 + lrow) * 1024 + lch * 8;
    const bf16_t* Bg = Bt + (size_t)(tn * 128 + lrow) * 1024 + lch * 8;
    u32x4 ra[4], rb[4];
#pragma unroll
    for (int i = 0; i < 4; ++i) { ra[i] = *(const u32x4*)(Ag + (size_t)i * 32 * 1024); rb[i] = *(const u32x4*)(Bg + (size_t)i * 32 * 1024); }
#pragma unroll
    for (int a = 0; a < 4; ++a)
#pragma unroll
        for (int b = 0; b < 4; ++b) acc[a][b] = (f32x4){0.f, 0.f, 0.f, 0.f};
    __syncthreads();
#pragma unroll
    for (int i = 0; i < 4; ++i) { *(u32x4*)(sm + (lrow + 32 * i) * LDP + lch * 8) = ra[i]; *(u32x4*)(sm + 128 * LDP + (lrow + 32 * i) * LDP + lch * 8) = rb[i]; }
#pragma unroll
    for (int i = 0; i < 4; ++i) { ra[i] = *(const u32x4*)(Ag + (size_t)i * 32 * 1024 + 64); rb[i] = *(const u32x4*)(Bg + (size_t)i * 32 * 1024 + 64); }
    __syncthreads();
    for (int kt = 0; kt < 16; ++kt) {
        const bf16_t* sA = sm + (kt & 1) * BUF; const bf16_t* sB = sA + 128 * LDP;
        bf16_t* nA = sm + ((kt + 1) & 1) * BUF; bf16_t* nB = nA + 128 * LDP;
        if (kt + 1 < 16) {
#pragma unroll
            for (int i = 0; i < 4; ++i) { *(u32x4*)(nA + (lrow + 32 * i) * LDP + lch * 8) = ra[i]; *(u32x4*)(nB + (lrow + 32 * i) * LDP + lch * 8) = rb[i]; }
        }
        if (kt + 2 < 16) {
#pragma unroll
            for (int i = 0; i < 4; ++i) { ra[i] = *(const u32x4*)(Ag + (size_t)i * 32 * 1024 + (kt + 2) * 64); rb[i] = *(const u32x4*)(Bg + (size_t)i * 32 * 1024 + (kt + 2) * 64); }
        }
#pragma unroll
        for (int ks = 0; ks < 2; ++ks) {
            bf16x8 af[4], bfr[4];
#pragma unroll
            for (int mt = 0; mt < 4; ++mt) af[mt] = *(const bf16x8*)(sA + (wm * 64 + mt * 16 + r16) * LDP + ks * 32 + quad * 8);
#pragma unroll
            for (int nt = 0; nt < 4; ++nt) bfr[nt] = *(const bf16x8*)(sB + (wn * 64 + nt * 16 + r16) * LDP + ks * 32 + quad * 8);
#pragma unroll
            for (int mt = 0; mt < 4; ++mt)
#pragma unroll
                for (int nt = 0; nt < 4; ++nt) acc[mt][nt] = __builtin_amdgcn_mfma_f32_16x16x32_bf16(bfr[nt], af[mt], acc[mt][nt], 0, 0, 0);
        }
        __syncthreads();
    }
}

__device__ void g1_phase(const Params& p, int l, char* smem) {
    const int t = tid_opq(), lane = t & 63, w = t >> 6, wm = w >> 1, wn = w & 1, r16 = lane & 15, quad = lane >> 4;
    bf16_t* sm = (bf16_t*)smem; bf16_t* sC = (bf16_t*)smem;
    const bf16_t* ubuf = (const bf16_t*)(p.ws + WS_U); const bf16_t* WinT = (const bf16_t*)(p.ws + WS_WINT) + (size_t)l * NPAD * 1024;
    bf16_t* z = (bf16_t*)(p.ws + WS_Z); float* kpart = (float*)(p.ws + WS_KPART);
    const float* cosT = (const float*)(p.ws + WS_COS); const float* sinT = (const float*)(p.ws + WS_SIN);
    for (int tile = blockIdx.x; tile < 128 * 27; tile += gridDim.x) {
        const int tm = tile / 27, tn = tile % 27;
        f32x4 acc[4][4];
        gemm_core(ubuf, WinT, tm, tn, sm, acc);
        const bool rope = (tn < 4) || (tn >= 12 && tn < 16);
        if (rope) {
#pragma unroll
            for (int mt = 0; mt < 4; ++mt) {
                const int tok = tm * 128 + wm * 64 + mt * 16 + r16;
#pragma unroll
                for (int nt = 0; nt < 2; ++nt) {
                    const f32x4 cs = *(const f32x4*)(cosT + (size_t)tok * 32 + nt * 16 + quad * 4), sn = *(const f32x4*)(sinT + (size_t)tok * 32 + nt * 16 + quad * 4);
                    const f32x4 x1 = acc[mt][nt], x2 = acc[mt][nt + 2];
                    acc[mt][nt] = x1 * cs - x2 * sn; acc[mt][nt + 2] = x1 * sn + x2 * cs;
                }
            }
        }
        if (tn == 2 || tn == 3) {
#pragma unroll
            for (int nt = 0; nt < 4; ++nt) {
                f32x4 sv = (acc[0][nt] + acc[1][nt]) + (acc[2][nt] + acc[3][nt]);
#pragma unroll
                for (int jj = 0; jj < 4; ++jj) { float sx = sv[jj]; sx += __shfl_xor(sx, 1); sx += __shfl_xor(sx, 2); sx += __shfl_xor(sx, 4); sx += __shfl_xor(sx, 8); sv[jj] = sx; }
                if (r16 == 0) *(f32x4*)(kpart + (size_t)(tm * 2 + wm) * 256 + (tn - 2) * 128 + wn * 64 + nt * 16 + quad * 4) = sv;
            }
        }
#pragma unroll
        for (int mt = 0; mt < 4; ++mt)
#pragma unroll
            for (int nt = 0; nt < 4; ++nt) { u32x2 pk; pk.x = pack2(acc[mt][nt][0], acc[mt][nt][1]); pk.y = pack2(acc[mt][nt][2], acc[mt][nt][3]);
                *(u32x2*)(sC + (wm * 64 + mt * 16 + r16) * 136 + wn * 64 + nt * 16 + quad * 4) = pk; }
        __syncthreads();
#pragma unroll
        for (int i = 0; i < 8; ++i) { const int c = t + 256 * i; const int row = c >> 4, ch = c & 15; const int col = tn * 128 + ch * 8;
            if (col < DIN) *(u32x4*)(z + (size_t)(tm * 128 + row) * ZP + col) = *(const u32x4*)(sC + row * 136 + ch * 8); }
    }
}

__device__ void g2_phase(const Params& p, int l, char* smem) {
    const int t = tid_opq(), lane = t & 63, w = t >> 6, wm = w >> 1, wn = w & 1, r16 = lane & 15, quad = lane >> 4;
    bf16_t* sm = (bf16_t*)smem;
    const bf16_t* mix = (const bf16_t*)(p.ws + WS_U); const bf16_t* WoutT = (const bf16_t*)(p.ws + WS_WOUTT) + (size_t)l * 1024 * 1024;
    const float* mod = (const float*)(p.ws + WS_MOD);
    const float* xres = (l == 0) ? p.x : p.out;
    for (int tile = blockIdx.x; tile < 128 * 8; tile += gridDim.x) {
        const int tm = tile >> 3, tn = tile & 7;
        f32x4 acc[4][4];
        gemm_core(mix, WoutT, tm, tn, sm, acc);
        const int b = (tm * 128) / S;
        const float* gate = mod + ((size_t)l * NB + b) * 3072 + 2048;
#pragma unroll
        for (int nt = 0; nt < 4; ++nt) { const int col = tn * 128 + wn * 64 + nt * 16 + quad * 4; const f32x4 g1 = *(const f32x4*)(gate + col) + 1.f;
#pragma unroll
            for (int mt = 0; mt < 4; ++mt) { const size_t o = (size_t)(tm * 128 + wm * 64 + mt * 16 + r16) * 1024 + col;
                const f32x4 xr = *(const f32x4*)(xres + o); *(f32x4*)(p.out + o) = xr * DN_ALPHA + g1 * acc[mt][nt]; } }
    }
}

constexpr float ATT_SC = 0.18033688011112042f;
__device__ __forceinline__ void attn_tile(const bf16_t* sK, const bf16_t* sV, const bf16x8 (&qf)[2][2], int lo, int hi, bool full, bool hasq, bool qfl0, bool qfl1,
                                          float (&m)[2], float (&l)[2], f32x4 (&O)[2][4], int wq0) {
    const int lane = tid_opq() & 63, r16 = lane & 15, quad = lane >> 4;
    f32x4 s[2][4];
#pragma unroll
    for (int a = 0; a < 2; ++a)
#pragma unroll
        for (int b = 0; b < 4; ++b) s[a][b] = (f32x4){0.f, 0.f, 0.f, 0.f};
#pragma unroll
    for (int ks = 0; ks < 2; ++ks)
#pragma unroll
        for (int k16 = 0; k16 < 4; ++k16) {
            const bf16x8 kf = *(const bf16x8*)(sK + (k16 * 16 + r16) * LDP + ks * 32 + quad * 8);
#pragma unroll
            for (int qt = 0; qt < 2; ++qt) s[qt][k16] = __builtin_amdgcn_mfma_f32_16x16x32_bf16(kf, qf[qt][ks], s[qt][k16], 0, 0, 0);
        }
#pragma unroll
    for (int qt = 0; qt < 2; ++qt) {
        const int ql = wq0 + qt * 16 + r16; const bool qfl = qt ? qfl1 : qfl0;
        if (!full) {
#pragma unroll
            for (int k16 = 0; k16 < 4; ++k16)
#pragma unroll
                for (int j = 0; j < 4; ++j) { const int dd = ql - (k16 * 16 + quad * 4 + j); const bool valid = dd >= lo && dd <= hi; s[qt][k16][j] = valid ? s[qt][k16][j] : -1e30f; }
        }
        if (hasq) {
#pragma unroll
            for (int k16 = 0; k16 < 4; ++k16)
#pragma unroll
                for (int j = 0; j < 4; ++j) s[qt][k16][j] = qfl ? s[qt][k16][j] : -1e30f;
        }
        float mx = -1e30f;
#pragma unroll
        for (int k16 = 0; k16 < 4; ++k16) mx = fmaxf(mx, fmaxf(fmaxf(s[qt][k16][0], s[qt][k16][1]), fmaxf(s[qt][k16][2], s[qt][k16][3])));
        mx = fmaxf(mx, __shfl_xor(mx, 16)); mx = fmaxf(mx, __shfl_xor(mx, 32));
        const float mn = fmaxf(m[qt], mx); const float alpha = exp2f((m[qt] - mn) * ATT_SC); m[qt] = mn;
        const float mb = (mn < -1e29f) ? 0.f : mn * ATT_SC;
        float ps = 0.f;
#pragma unroll
        for (int k16 = 0; k16 < 4; ++k16)
#pragma unroll
            for (int j = 0; j < 4; ++j) { const float pv = exp2f(s[qt][k16][j] * ATT_SC - mb); ps += pv; s[qt][k16][j] = pv; }
        l[qt] = l[qt] * alpha + ps;
#pragma unroll
        for (int dt = 0; dt < 4; ++dt) O[qt][dt] = O[qt][dt] * alpha;
    }
#pragma unroll
    for (int G = 0; G < 2; ++G) {
        bf16x8 pf[2];
#pragma unroll
        for (int qt = 0; qt < 2; ++qt) {
            const unsigned a0 = pack2(s[qt][G * 2][0], s[qt][G * 2][1]), a1 = pack2(s[qt][G * 2][2], s[qt][G * 2][3]);
            const unsigned a2 = pack2(s[qt][G * 2 + 1][0], s[qt][G * 2 + 1][1]), a3 = pack2(s[qt][G * 2 + 1][2], s[qt][G * 2 + 1][3]);
            u32x4 pk = {a0, a1, a2, a3}; pf[qt] = __builtin_bit_cast(bf16x8, pk);
        }
#pragma unroll
        for (int dt = 0; dt < 4; ++dt) {
            const bf16_t* v0p = sV + (G * 32 + quad * 4 + (r16 >> 2)) * LDP + dt * 16 + (r16 & 3) * 4;
            const bf16x4 v0 = __builtin_amdgcn_ds_read_tr16_b64_v4i16((__attribute__((address_space(3))) bf16x4*)(v0p));
            const bf16x4 v1 = __builtin_amdgcn_ds_read_tr16_b64_v4i16((__attribute__((address_space(3))) bf16x4*)(v0p + 16 * LDP));
            const bf16x8 vf = {v0[0], v0[1], v0[2], v0[3], v1[0], v1[1], v1[2], v1[3]};
#pragma unroll
            for (int qt = 0; qt < 2; ++qt) O[qt][dt] = __builtin_amdgcn_mfma_f32_16x16x32_bf16(vf, pf[qt], O[qt][dt], 0, 0, 0);
        }
    }
}

__device__ void attn_item(const Params& p, int kind, int idx, char* smem) {
    const int t = tid_opq(), lane = t & 63, w = t >> 6, r16 = lane & 15, quad = lane >> 4;
    bf16_t* sK = (bf16_t*)smem; bf16_t* sV = sK + 64 * LDP;
    float* kmean = (float*)(smem + 18432); float* gates = (float*)(smem + 22528); unsigned* selm = (unsigned*)(smem + 30720);
    int4* desc = (int4*)(smem + 31232); int* misc = (int*)(smem + 32320);
    const bf16_t* z = (const bf16_t*)(p.ws + WS_Z);
    int b, h, qbase, stride, qcol, kcol, vcol, cfg = 0;
    __syncthreads();
    if (kind == 0) {
        const int n = 15 - (idx >> 5); const int rem = idx & 31; b = rem >> 3; h = (rem >> 1) & 3; const int qh = rem & 1;
        qbase = b * S + n * 256 + qh * 128; stride = 1; qcol = C_AQ + h * 64; kcol = C_AK + h * 64; vcol = C_AV + h * 64;
        const float* kpart = (const float*)(p.ws + WS_KPART);
        for (int e = t; e < n * 64; e += 256) { const int j = e >> 6, d = e & 63; const float* kp = kpart + (size_t)(b * 64 + j * 4) * 256 + h * 64 + d;
            kmean[e] = ((kp[0] + kp[256]) + (kp[512] + kp[768])) * (1.f / 256.f); }
        if (t == 0) misc[1] = 0;
        __syncthreads();
        {
            const int ql = t >> 1, half = t & 1; const bf16_t* qp = z + (size_t)(qbase + ql) * ZP + qcol;
            float g[8];
#pragma unroll
            for (int jj = 0; jj < 8; ++jj) g[jj] = 0.f;
#pragma unroll 1
            for (int dc = 0; dc < 8; ++dc) {
                const u32x4 qv = *(const u32x4*)(qp + dc * 8); float qq[8];
#pragma unroll
                for (int e = 0; e < 4; ++e) { qq[2 * e] = __uint_as_float(qv[e] << 16); qq[2 * e + 1] = __uint_as_float(qv[e] & 0xffff0000u); }
#pragma unroll
                for (int jj = 0; jj < 8; ++jj) { const int j = half + 2 * jj; if (j < n) { const float* km = kmean + j * 64 + dc * 8;
#pragma unroll
                    for (int e = 0; e < 8; ++e) g[jj] += qq[e] * km[e]; } }
            }
#pragma unroll
            for (int jj = 0; jj < 8; ++jj) gates[ql * 16 + half + 2 * jj] = g[jj];
        }
        __syncthreads();
        if (t < 128) {
            unsigned msk = 0;
            for (int k = 0; k < 3 && k < n; ++k) { float best = -3.0e38f; int bi = -1;
                for (int j = 0; j < n; ++j) if (!((msk >> j) & 1u)) { const float gv = gates[t * 16 + j]; if (gv > best) { best = gv; bi = j; } }
                if (bi >= 0) msk |= 1u << bi; }
            selm[t] = msk; atomicOr((unsigned*)&misc[1], msk);
        }
        __syncthreads();
        if (t == 0) {
            int nd = 0; const unsigned bm = (unsigned)misc[1];
            for (int kt = 0; kt <= qh * 2 + 1; ++kt) desc[nd++] = make_int4(b * S + n * 256 + kt * 64, kt * 64 - qh * 128, BIG, -1);
            for (int j = 0; j < n; ++j) if ((bm >> j) & 1u) for (int kt = 0; kt < 4; ++kt) desc[nd++] = make_int4(b * S + j * 256 + kt * 64, -BIG, BIG, j);
            misc[0] = nd;
        }
    } else {
        cfg = idx >> 9; const int rem = idx & 511; b = rem >> 7; h = (rem >> 5) & 3; const int rb = rem & 31;
        const int dil = 1 << (2 * cfg); const int res = rb & (dil - 1), blk = rb >> (2 * cfg);
        qbase = b * S + blk * 128 * dil + res; stride = dil; qcol = C_CQ + h * 64; kcol = C_CK + h * 64; vcol = C_CV + h * 64;
        if (t < 128) selm[t] = 0xffffffffu;
        if (t == 0) { int nd = 0; for (int kt = (blk == 0 ? 2 : 0); kt < 4; ++kt) desc[nd++] = make_int4(b * S + (blk * 128 - 128 + kt * 64) * dil + res, kt * 64 - 128, kt * 64, -1); misc[0] = nd; }
    }
    __syncthreads();
    const int nd = misc[0];
    bf16x8 qf[2][2];
#pragma unroll
    for (int qt = 0; qt < 2; ++qt)
#pragma unroll
        for (int ks = 0; ks < 2; ++ks) qf[qt][ks] = *(const bf16x8*)(z + (size_t)(qbase + (w * 32 + qt * 16 + r16) * stride) * ZP + qcol + ks * 32 + quad * 8);
    const unsigned sel0 = selm[w * 32 + r16], sel1 = selm[w * 32 + 16 + r16];
    float m[2] = {-1e30f, -1e30f}, l[2] = {0.f, 0.f}; f32x4 O[2][4];
#pragma unroll
    for (int a = 0; a < 2; ++a)
#pragma unroll
        for (int c = 0; c < 4; ++c) O[a][c] = (f32x4){0.f, 0.f, 0.f, 0.f};
    const int lrow = t >> 2, lch = (t & 3) * 2;
    u32x4 rk0, rk1, rv0, rv1;
    if (nd > 0) { const int4 d = desc[0]; const bf16_t* rp = z + (size_t)(d.x + lrow * stride) * ZP + lch * 8;
        rk0 = *(const u32x4*)(rp + kcol); rk1 = *(const u32x4*)(rp + kcol + 8); rv0 = *(const u32x4*)(rp + vcol); rv1 = *(const u32x4*)(rp + vcol + 8); }
    for (int i = 0; i < nd; ++i) {
        __syncthreads();
        *(u32x4*)(sK + lrow * LDP + lch * 8) = rk0; *(u32x4*)(sK + lrow * LDP + lch * 8 + 8) = rk1;
        *(u32x4*)(sV + lrow * LDP + lch * 8) = rv0; *(u32x4*)(sV + lrow * LDP + lch * 8 + 8) = rv1;
        __syncthreads();
        if (i + 1 < nd) { const int4 d = desc[i + 1]; const bf16_t* rp = z + (size_t)(d.x + lrow * stride) * ZP + lch * 8;
            rk0 = *(const u32x4*)(rp + kcol); rk1 = *(const u32x4*)(rp + kcol + 8); rv0 = *(const u32x4*)(rp + vcol); rv1 = *(const u32x4*)(rp + vcol + 8); }
        const int4 d = desc[i];
        bool need = (w * 32 + 31 >= d.y) && (w * 32 - 63 <= d.z);
        bool q0 = true, q1 = true;
        if (d.w >= 0) { q0 = (sel0 >> d.w) & 1u; q1 = (sel1 >> d.w) & 1u; need = need && (__ballot(q0 || q1) != 0ull); }
        const bool full = (w * 32 - 63 >= d.y) && (w * 32 + 31 <= d.z);
        if (need) attn_tile(sK, sV, qf, d.y, d.z, full, d.w >= 0, q0, q1, m, l, O, w * 32);
    }
#pragma unroll
    for (int qt = 0; qt < 2; ++qt) {
        float lt = l[qt]; lt += __shfl_xor(lt, 16); lt += __shfl_xor(lt, 32);
        const float inv = 1.f / lt; const size_t tok = (size_t)(qbase + (w * 32 + qt * 16 + r16) * stride);
        if (kind == 0) {
            bf16_t* mix = (bf16_t*)(p.ws + WS_U);
#pragma unroll
            for (int dt = 0; dt < 4; ++dt) { const int d0 = dt * 16 + quad * 4; const u32x2 gv = *(const u32x2*)(z + tok * ZP + C_AG + h * 64 + d0);
                const float g0 = __uint_as_float(gv.x << 16), g1 = __uint_as_float(gv.x & 0xffff0000u), g2 = __uint_as_float(gv.y << 16), g3 = __uint_as_float(gv.y & 0xffff0000u);
                u32x2 o; o.x = pack2(O[qt][dt][0] * inv * silu_f(g0), O[qt][dt][1] * inv * silu_f(g1)); o.y = pack2(O[qt][dt][2] * inv * silu_f(g2), O[qt][dt][3] * inv * silu_f(g3));
                *(u32x2*)(mix + tok * 1024 + h * 64 + d0) = o; }
        } else {
            bf16_t* dilo = (bf16_t*)(p.ws + WS_DILO); float* dill = (float*)(p.ws + WS_DILL);
#pragma unroll
            for (int dt = 0; dt < 4; ++dt) { const int d0 = dt * 16 + quad * 4; u32x2 o; o.x = pack2(O[qt][dt][0] * inv, O[qt][dt][1] * inv); o.y = pack2(O[qt][dt][2] * inv, O[qt][dt][3] * inv);
                *(u32x2*)(dilo + ((size_t)cfg * T + tok) * 256 + h * 64 + d0) = o; }
            if (quad == 0) dill[((size_t)cfg * T + tok) * 4 + h] = m[qt] * 0.125f + __logf(lt);
        }
    }
}

__device__ __forceinline__ void gla_bcum(const Params& p, int l, const bf16_t* z, int tok0, float* bc, float* drs) {
    const int t = tid_opq();
    for (int e = t; e < 512; e += 256) { const int i = e >> 4, r = e & 15; drs[e] = bf2f(z[(size_t)(tok0 + i) * ZP + C_DR + r]); }
    __syncthreads();
    const int hd = t & 127, ih = t >> 7;
    float wr[16];
#pragma unroll
    for (int r = 0; r < 16; ++r) wr[r] = p.gla_wr[l * 2048 + r * 128 + hd];
    const float br = p.gla_br[l * 128 + hd];
#pragma unroll
    for (int ii = 0; ii < 16; ++ii) { const int i = ih * 16 + ii; float x = br;
#pragma unroll
        for (int r = 0; r < 16; ++r) x += drs[i * 16 + r] * wr[r];
        bc[i * 128 + hd] = (fminf(x, 0.f) - log1pf(__expf(-fabsf(x)))) * (1.f / 16.f); }
    __syncthreads();
    if (t < 128) { float s = 0.f; for (int i = 0; i < 32; ++i) { s += bc[i * 128 + t]; bc[i * 128 + t] = s; } }
    __syncthreads();
}

__device__ void gla1_item(const Params& p, int l, int idx, char* smem) {
    const int t = tid_opq(), lane = t & 63, w = t >> 6;
    const int b = idx >> 7, c = idx & 127; const int tok0 = b * S + c * 32;
    const bf16_t* z = (const bf16_t*)(p.ws + WS_Z);
    float* bc = (float*)smem; float* drs = (float*)(smem + 16384); float* kdec = (float*)(smem + 18432) + w * 1024;
    float* gkv = (float*)(p.ws + WS_GKV); float* gdec = (float*)(p.ws + WS_GDEC);
    __syncthreads();
    gla_bcum(p, l, z, tok0, bc, drs);
    for (int e = lane; e < 1024; e += 64) { const int j = e >> 5, d = e & 31; const float kk = bf2f(z[(size_t)(tok0 + j) * ZP + C_DK + w * 32 + d]);
        kdec[j * 32 + d] = kk * __expf(bc[31 * 128 + w * 32 + d] - bc[j * 128 + w * 32 + d]); }
    __syncthreads();
    float acc[32];
#pragma unroll
    for (int d = 0; d < 32; ++d) acc[d] = 0.f;
#pragma unroll 4
    for (int j = 0; j < 32; ++j) { const float vv = bf2f(z[(size_t)(tok0 + j) * ZP + C_DV + w * 64 + lane]);
#pragma unroll
        for (int d4 = 0; d4 < 8; ++d4) { const f32x4 kd = *(const f32x4*)(kdec + j * 32 + d4 * 4); acc[d4 * 4] += kd[0] * vv; acc[d4 * 4 + 1] += kd[1] * vv; acc[d4 * 4 + 2] += kd[2] * vv; acc[d4 * 4 + 3] += kd[3] * vv; } }
    const int bh = b * 4 + w; float* dst = gkv + (size_t)(bh * 128 + c) * 2048;
#pragma unroll
    for (int d = 0; d < 32; ++d) dst[d * 64 + lane] = acc[d];
    if (lane < 32) gdec[(bh * 128 + c) * 32 + lane] = __expf(bc[31 * 128 + w * 32 + lane]);
}

__device__ void gla3_item(const Params& p, int l, int idx, char* smem) {
    const int t = tid_opq(), lane = t & 63, w = t >> 6;
    const int b = idx >> 7, c = idx & 127; const int tok0 = b * S + c * 32;
    const bf16_t* z = (const bf16_t*)(p.ws + WS_Z); bf16_t* mix = (bf16_t*)(p.ws + WS_U);
    float* bc = (float*)smem; float* As = (float*)smem + w * 1024; float* drs = (float*)(smem + 16384);
    float* qeT = (float*)(smem + 18432) + w * 1024; float* keT = (float*)(smem + 34816) + w * 1024;
    const float* gkv = (const float*)(p.ws + WS_GKV);
    __syncthreads();
    gla_bcum(p, l, z, tok0, bc, drs);
    for (int e = lane; e < 1024; e += 64) { const int i = e >> 5, d = e & 31; const float bcv = bc[i * 128 + w * 32 + d];
        const float qv = bf2f(z[(size_t)(tok0 + i) * ZP + C_DQ + w * 32 + d]), kv = bf2f(z[(size_t)(tok0 + i) * ZP + C_DK + w * 32 + d]);
        qeT[d * 32 + i] = qv * __expf(bcv) * 0.17677669529663687f; keT[d * 32 + i] = kv * __expf(-bcv); }
    __syncthreads();
    {
        const int i = lane & 31, jh = lane >> 5; float a[16];
#pragma unroll
        for (int jj = 0; jj < 16; ++jj) a[jj] = 0.f;
#pragma unroll 4
        for (int d = 0; d < 32; ++d) { const float qv = qeT[d * 32 + i];
#pragma unroll
            for (int j4 = 0; j4 < 4; ++j4) { const f32x4 k4 = *(const f32x4*)(keT + d * 32 + jh * 16 + j4 * 4); a[j4 * 4] += qv * k4[0]; a[j4 * 4 + 1] += qv * k4[1]; a[j4 * 4 + 2] += qv * k4[2]; a[j4 * 4 + 3] += qv * k4[3]; } }
#pragma unroll
        for (int jj = 0; jj < 16; ++jj) { const int j = jh * 16 + jj; As[j * 32 + i] = (j <= i) ? a[jj] : 0.f; }
    }
    __syncthreads();
    float o[32];
#pragma unroll
    for (int i = 0; i < 32; ++i) o[i] = 0.f;
#pragma unroll 4
    for (int j = 0; j < 32; ++j) { const float vv = bf2f(z[(size_t)(tok0 + j) * ZP + C_DV + w * 64 + lane]);
#pragma unroll
        for (int i4 = 0; i4 < 8; ++i4) { const f32x4 a4 = *(const f32x4*)(As + j * 32 + i4 * 4); o[i4 * 4] += a4[0] * vv; o[i4 * 4 + 1] += a4[1] * vv; o[i4 * 4 + 2] += a4[2] * vv; o[i4 * 4 + 3] += a4[3] * vv; } }
    const int bh = b * 4 + w; const float* Sp = gkv + (size_t)(bh * 128 + c) * 2048;
#pragma unroll 4
    for (int d = 0; d < 32; ++d) { const float sv = Sp[d * 64 + lane];
#pragma unroll
        for (int i4 = 0; i4 < 8; ++i4) { const f32x4 q4 = *(const f32x4*)(qeT + d * 32 + i4 * 4); o[i4 * 4] += q4[0] * sv; o[i4 * 4 + 1] += q4[1] * sv; o[i4 * 4 + 2] += q4[2] * sv; o[i4 * 4 + 3] += q4[3] * sv; } }
    const float gn = p.gla_gn[l * 64 + lane];
#pragma unroll
    for (int i = 0; i < 32; ++i) { const float ss = wsum(o[i] * o[i]); const float y = o[i] * rsqrtf(ss * (1.f / 64.f) + 1e-5f) * gn;
        const size_t tok = (size_t)(tok0 + i); const float g = bf2f(z[tok * ZP + C_DG + w * 64 + lane]);
        mix[tok * 1024 + 768 + w * 64 + lane] = f2bf(y * silu_f(g)); }
}

__device__ void lru1_item(const Params& p, int l, int idx, char* smem) {
    const int t = tid_opq(), lane = t & 63, g = t >> 6; const int ch = t;
    const int b = idx >> 7, c = idx & 127; const int s0 = c * 32; const int tok0 = b * S + s0;
    const bf16_t* z = (const bf16_t*)(p.ws + WS_Z); float* xcs = (float*)smem;
    float* lh = (float*)(p.ws + WS_LH); float* lp = (float*)(p.ws + WS_LP);
    const float cw0 = p.conv_w[l * 1024 + ch], cw1 = p.conv_w[l * 1024 + 256 + ch], cw2 = p.conv_w[l * 1024 + 512 + ch], cw3 = p.conv_w[l * 1024 + 768 + ch];
    const float cb = p.conv_b[l * 256 + ch];
    __syncthreads();
    float x0 = (s0 >= 3) ? bf2f(z[(size_t)(tok0 - 3) * ZP + C_BX + ch]) : 0.f;
    float x1 = (s0 >= 2) ? bf2f(z[(size_t)(tok0 - 2) * ZP + C_BX + ch]) : 0.f;
    float x2 = (s0 >= 1) ? bf2f(z[(size_t)(tok0 - 1) * ZP + C_BX + ch]) : 0.f;
#pragma unroll 8
    for (int i = 0; i < 32; ++i) { const float x3 = bf2f(z[(size_t)(tok0 + i) * ZP + C_BX + ch]);
        xcs[i * 256 + ch] = cb + cw0 * x0 + cw1 * x1 + cw2 * x2 + cw3 * x3; x0 = x1; x1 = x2; x2 = x3; }
    __syncthreads();
    float aA[32], aX[32];
#pragma unroll
    for (int i = 0; i < 32; ++i) { aA[i] = 0.f; aX[i] = 0.f; }
    const float* wa = p.lru_wa + l * 16384 + g * 4096 + lane; const float* wx = p.lru_wx + l * 16384 + g * 4096 + lane;
#pragma unroll 1
    for (int k4 = 0; k4 < 16; ++k4) {
        const float wa0 = wa[(k4 * 4) * 64], wa1 = wa[(k4 * 4 + 1) * 64], wa2 = wa[(k4 * 4 + 2) * 64], wa3 = wa[(k4 * 4 + 3) * 64];
        const float wx0 = wx[(k4 * 4) * 64], wx1 = wx[(k4 * 4 + 1) * 64], wx2 = wx[(k4 * 4 + 2) * 64], wx3 = wx[(k4 * 4 + 3) * 64];
#pragma unroll
        for (int i = 0; i < 32; ++i) { const f32x4 xv = *(const f32x4*)(xcs + i * 256 + g * 64 + k4 * 4);
            aA[i] += (xv[0] * wa0 + xv[1] * wa1) + (xv[2] * wa2 + xv[3] * wa3); aX[i] += (xv[0] * wx0 + xv[1] * wx1) + (xv[2] * wx2 + xv[3] * wx3); }
    }
    const float ba = p.lru_ba[l * 256 + ch], bx = p.lru_bx[l * 256 + ch], lam = p.lru_lam[l * 256 + ch];
    const float sp = fmaxf(-lam, 0.f) + log1pf(__expf(-fabsf(lam)));
    float hh = 0.f, P = 1.f;
#pragma unroll
    for (int i = 0; i < 32; ++i) { const float r = sigmoid_f(aA[i] + ba), ig = sigmoid_f(aX[i] + bx); const float la = -8.f * r * sp; const float a = __expf(la);
        const float u = sqrtf(-expm1f(2.f * la)) * (ig * xcs[i * 256 + ch]); hh = a * hh + u; P *= a;
        lh[(size_t)(tok0 + i) * 256 + ch] = hh; lp[(size_t)(tok0 + i) * 256 + ch] = P; }
}

__device__ void lru3_item(const Params& p, int idx) {
    const int ch = tid_opq(); const int b = idx >> 7, c = idx & 127; const int tok0 = b * S + c * 32;
    const bf16_t* z = (const bf16_t*)(p.ws + WS_Z); bf16_t* mix = (bf16_t*)(p.ws + WS_U);
    const float* lh = (const float*)(p.ws + WS_LH); const float* lp = (const float*)(p.ws + WS_LP); const float* lc = (const float*)(p.ws + WS_LC);
    const float carry = lc[(size_t)(b * 128 + c) * 256 + ch];
#pragma unroll 8
    for (int i = 0; i < 32; ++i) { const size_t tok = (size_t)(tok0 + i); const float hv = lh[tok * 256 + ch] + lp[tok * 256 + ch] * carry;
        const float g = bf2f(z[tok * ZP + C_BG + ch]); mix[tok * 1024 + 256 + ch] = f2bf(hv * silu_f(g)); }
}

__device__ void dilc_item(const Params& p, int idx) {
    const int t = tid_opq(); const size_t tok = (size_t)idx * 8 + (t >> 5); const int chn = t & 31; const int h = chn >> 3;
    const bf16_t* z = (const bf16_t*)(p.ws + WS_Z); bf16_t* mix = (bf16_t*)(p.ws + WS_U);
    const bf16_t* dilo = (const bf16_t*)(p.ws + WS_DILO); const float* dill = (const float*)(p.ws + WS_DILL);
    const float l0 = dill[((size_t)0 * T + tok) * 4 + h], l1 = dill[((size_t)1 * T + tok) * 4 + h], l2 = dill[((size_t)2 * T + tok) * 4 + h];
    const float mx = fmaxf(l0, fmaxf(l1, l2)); float w0 = __expf(l0 - mx), w1 = __expf(l1 - mx), w2 = __expf(l2 - mx); const float inv = 1.f / (w0 + w1 + w2); w0 *= inv; w1 *= inv; w2 *= inv;
    const u32x4 o0 = *(const u32x4*)(dilo + ((size_t)0 * T + tok) * 256 + chn * 8), o1 = *(const u32x4*)(dilo + ((size_t)1 * T + tok) * 256 + chn * 8), o2 = *(const u32x4*)(dilo + ((size_t)2 * T + tok) * 256 + chn * 8);
    const u32x4 gv = *(const u32x4*)(z + tok * ZP + C_CG + chn * 8);
    u32x4 r;
#pragma unroll
    for (int e = 0; e < 4; ++e) {
        const float a = w0 * __uint_as_float(o0[e] << 16) + w1 * __uint_as_float(o1[e] << 16) + w2 * __uint_as_float(o2[e] << 16);
        const float bq = w0 * __uint_as_float(o0[e] & 0xffff0000u) + w1 * __uint_as_float(o1[e] & 0xffff0000u) + w2 * __uint_as_float(o2[e] & 0xffff0000u);
        r[e] = pack2(a * silu_f(__uint_as_float(gv[e] << 16)), bq * silu_f(__uint_as_float(gv[e] & 0xffff0000u)));
    }
    *(u32x4*)(mix + tok * 1024 + 512 + chn * 8) = r;
}

__device__ void m2_phase(const Params& p) {
    float* gkv = (float*)(p.ws + WS_GKV); const float* gdec = (const float*)(p.ws + WS_GDEC);
    const float* lh = (const float*)(p.ws + WS_LH); const float* lp = (const float*)(p.ws + WS_LP); float* lc = (float*)(p.ws + WS_LC);
    for (int it = blockIdx.x; it < 128 + 4; it += gridDim.x) {
        if (it < 128) {
            const int gid = it * 256 + tid_opq(); const int bh = gid >> 11, dv = gid & 2047, d = dv >> 6;
            float* base = gkv + (size_t)bh * 128 * 2048 + dv; const float* dc = gdec + (size_t)bh * 128 * 32 + d;
            float st = 0.f;
            float ka[16], da[16], kb[16], db[16];
#pragma unroll
            for (int k = 0; k < 16; ++k) { ka[k] = base[(size_t)k * 2048]; da[k] = dc[k * 32]; }
#pragma unroll 1
            for (int n0 = 0; n0 < 128; n0 += 32) {
#pragma unroll
                for (int k = 0; k < 16; ++k) { kb[k] = base[(size_t)(n0 + 16 + k) * 2048]; db[k] = dc[(n0 + 16 + k) * 32]; }
#pragma unroll
                for (int k = 0; k < 16; ++k) { base[(size_t)(n0 + k) * 2048] = st; st = da[k] * st + ka[k]; }
                if (n0 + 32 < 128) {
#pragma unroll
                    for (int k = 0; k < 16; ++k) { ka[k] = base[(size_t)(n0 + 32 + k) * 2048]; da[k] = dc[(n0 + 32 + k) * 32]; }
                }
#pragma unroll
                for (int k = 0; k < 16; ++k) { base[(size_t)(n0 + 16 + k) * 2048] = st; st = db[k] * st + kb[k]; }
            }
        } else {
            const int gid = (it - 128) * 256 + tid_opq(); const int b = gid >> 8, ch = gid & 255;
            float carry = 0.f;
#pragma unroll 1
            for (int n0 = 0; n0 < 128; n0 += 16) {
                float Pl[16], hl[16];
#pragma unroll
                for (int k = 0; k < 16; ++k) { const size_t ix = (size_t)(b * S + (n0 + k) * 32 + 31) * 256 + ch; Pl[k] = lp[ix]; hl[k] = lh[ix]; }
#pragma unroll
                for (int k = 0; k < 16; ++k) { lc[(size_t)(b * 128 + n0 + k) * 256 + ch] = carry; carry = Pl[k] * carry + hl[k]; }
            }
        }
    }
}

__global__ void __launch_bounds__(256, 2) fwd_megakernel(Params p) {
    __shared__ __attribute__((aligned(16))) char smem[SMEM_BYTES];
    __shared__ uint4 xb_words;
    __shared__ int s_slot;
    cg::grid_group grid = cg::this_grid();
    if (p.out == nullptr) grid.sync();
    if (threadIdx.x == 0) xb_words = make_uint4(0u, 0u, 0u, 0u);
    __syncthreads();
    const XcdBarrier xb = xcd_barrier_post((unsigned*)(p.ws + WS_CTL), (volatile LAS unsigned*)&xb_words);
    unsigned* cnt = (unsigned*)(p.ws + WS_CNT);
    prologue_phase(p, smem);
    xcd_barrier(xb);
#pragma unroll 1
    for (int l = 0; l < DEPTH; ++l) {
        ln_phase(p, l);
        xcd_barrier(xb);
        g1_phase(p, l, smem);
        xcd_barrier(xb);
        for (;;) { const int it = next_item(cnt + (0 + l) * 64, &s_slot); if (it >= 2048) break; attn_item(p, it < 512 ? 0 : 1, it < 512 ? it : it - 512, smem); }
        for (;;) { const int it = next_item(cnt + (2 + l) * 64, &s_slot); if (it >= 512) break; gla1_item(p, l, it, smem); }
        for (;;) { const int it = next_item(cnt + (4 + l) * 64, &s_slot); if (it >= 512) break; lru1_item(p, l, it, smem); }
        xcd_barrier(xb);
        m2_phase(p);
        xcd_barrier(xb);
        for (int it = blockIdx.x; it < 512; it += gridDim.x) gla3_item(p, l, it, smem);
        for (int it = blockIdx.x; it < 512; it += gridDim.x) lru3_item(p, it);
        for (int it = blockIdx.x; it < 2048; it += gridDim.x) dilc_item(p, it);
        xcd_barrier(xb);
        g2_phase(p, l, smem);
        xcd_barrier(xb);
    }
    ln_phase(p, DEPTH);
}

extern "C" void kernel_launch(void* const* d_in, const int* in_sizes, int n_in, void* d_out, int out_size, void* d_ws, size_t ws_size, hipStream_t stream) {
    static int grid_blocks = 0;
    if (!grid_blocks) {
        int dev = 0, cus = 0, per_cu = 0;
        hipGetDevice(&dev);
        hipDeviceGetAttribute(&cus, hipDeviceAttributeMultiprocessorCount, dev);
        hipOccupancyMaxActiveBlocksPerMultiprocessor(&per_cu, (const void*)fwd_megakernel, 256, 0);
        if (per_cu < 1) per_cu = 1;
        if (per_cu > 2) per_cu = 2;
        grid_blocks = cus * per_cu;
        if (ws_size < WS_END) fprintf(stderr, "kernel_launch: workspace too small: %zu < %zu\n", ws_size, (size_t)WS_END);
    }
    Params p{};
    p.x = (const float*)d_in[0]; p.c = (const float*)d_in[1]; p.pos = (const int*)d_in[2];
    p.w_mod = (const float*)d_in[3]; p.b_mod = (const float*)d_in[4]; p.w_in = (const float*)d_in[5];
    p.conv_w = (const float*)d_in[6]; p.conv_b = (const float*)d_in[7]; p.lru_wa = (const float*)d_in[8]; p.lru_ba = (const float*)d_in[9];
    p.lru_wx = (const float*)d_in[10]; p.lru_bx = (const float*)d_in[11]; p.lru_lam = (const float*)d_in[12];
    p.gla_wr = (const float*)d_in[13]; p.gla_br = (const float*)d_in[14]; p.gla_gn = (const float*)d_in[15];
    p.w_out = (const float*)d_in[16]; p.ln_g = (const float*)d_in[17]; p.ln_b = (const float*)d_in[18];
    p.out = (float*)d_out; p.ws = (unsigned char*)d_ws;
    (void)hipMemsetAsync(d_ws, 0, 32768, stream);
    void* args[] = {&p};
    hipError_t e = hipLaunchCooperativeKernel((const void*)fwd_megakernel, dim3(grid_blocks), dim3(256), args, 0, stream);
    if (e != hipSuccess) fprintf(stderr, "cooperative launch failed: %s (grid %d)\n", hipGetErrorString(e), grid_blocks);
}
```

```cpp
#include <hip/hip_runtime.h>
#include <hip/hip_cooperative_groups.h>
#include <cstdio>
#include <cstdint>
namespace cg = cooperative_groups;

typedef unsigned short bf16_t;
typedef short bf16x8 __attribute__((ext_vector_type(8)));
typedef short bf16x4 __attribute__((ext_vector_type(4)));
typedef float f32x4 __attribute__((ext_vector_type(4)));
typedef unsigned u32x4 __attribute__((ext_vector_type(4)));
typedef unsigned u32x2 __attribute__((ext_vector_type(2)));

constexpr int D = 1024, NB = 4, S = 4096, T = NB * S, DEPTH = 2;
constexpr int DIN = 3344, ZP = 3344, NPAD = 3456;
constexpr int C_AQ = 0, C_AK = 256, C_AV = 512, C_AG = 768, C_BX = 1024, C_BG = 1280, C_CQ = 1536, C_CK = 1792,
              C_CV = 2048, C_CG = 2304, C_DQ = 2560, C_DK = 2688, C_DV = 2816, C_DG = 3072, C_DR = 3328;
constexpr float DN_ALPHA = 1.4142135623730951f;
constexpr int LDP = 72;
constexpr int SMEM_BYTES = 65536;
constexpr int BIG = 1000000;

constexpr size_t WS_CTL = 0;
constexpr size_t WS_CNT = 16384;
constexpr size_t WS_WINT = 32768;
constexpr size_t WS_WOUTT = WS_WINT + (size_t)DEPTH * NPAD * 1024 * 2;
constexpr size_t WS_MOD = WS_WOUTT + (size_t)DEPTH * 1024 * 1024 * 2;
constexpr size_t WS_COS = WS_MOD + (size_t)DEPTH * NB * 3072 * 4;
constexpr size_t WS_SIN = WS_COS + (size_t)T * 32 * 4;
constexpr size_t WS_U = WS_SIN + (size_t)T * 32 * 4;
constexpr size_t WS_Z = WS_U + (size_t)T * 1024 * 2;
constexpr size_t WS_KPART = WS_Z + (size_t)T * ZP * 2;
constexpr size_t WS_DILO = WS_KPART + (size_t)256 * 256 * 4;
constexpr size_t WS_DILL = WS_DILO + (size_t)3 * T * 256 * 2;
constexpr size_t WS_GKV = WS_DILL + (size_t)3 * T * 4 * 4;
constexpr size_t WS_GDEC = WS_GKV + (size_t)2048 * 2048 * 4;
constexpr size_t WS_LH = WS_GDEC + (size_t)2048 * 32 * 4;
constexpr size_t WS_LP = WS_LH + (size_t)T * 256 * 4;
constexpr size_t WS_LC = WS_LP + (size_t)T * 256 * 4;
constexpr size_t WS_END = WS_LC + (size_t)NB * 128 * 256 * 4;

struct Params {
    const float *x, *c; const int* pos;
    const float *w_mod, *b_mod, *w_in, *conv_w, *conv_b, *lru_wa, *lru_ba, *lru_wx, *lru_bx, *lru_lam, *gla_wr, *gla_br, *gla_gn, *w_out, *ln_g, *ln_b;
    float* out; unsigned char* ws;
};

__device__ __forceinline__ float bf2f(bf16_t h) { return __uint_as_float(((unsigned)h) << 16); }
typedef __bf16 hbf16x2 __attribute__((ext_vector_type(2)));
typedef float f32x2 __attribute__((ext_vector_type(2)));
__device__ __forceinline__ unsigned pack2(float a, float b) { f32x2 v = {a, b}; hbf16x2 r = __builtin_convertvector(v, hbf16x2); return __builtin_bit_cast(unsigned, r); }
__device__ __forceinline__ bf16_t f2bf(float f) { return (bf16_t)(pack2(f, 0.f) & 0xffffu); }
__device__ __forceinline__ float silu_f(float x) { return x / (1.f + __expf(-x)); }
__device__ __forceinline__ float sigmoid_f(float x) { return 1.f / (1.f + __expf(-x)); }
__device__ __forceinline__ int tid_opq() { int t = threadIdx.x; asm volatile("" : "+v"(t)); return t; }
__device__ __forceinline__ float wsum(float v) {
#pragma unroll
    for (int o = 32; o; o >>= 1) v += __shfl_xor(v, o);
    return v;
}

#define XB_TMO      128
#define XB_XCNT(j)  (256  + 64 * (j))
#define XB_XSUB(j)  (1280 + 64 * (j))
#define XB_XGEN(j)  (2304 + 64 * (j))
#define XB_TOP      3328
#define XB_TOPGEN   3392
#define XCD_BAR_WORDS 3456
#define XB_SPIN_CAP (1u << 18)
#define LAS __attribute__((address_space(3)))
__device__ __forceinline__ unsigned xb_ld(unsigned* p)              { return __hip_atomic_load(p, __ATOMIC_RELAXED, __HIP_MEMORY_SCOPE_AGENT); }
__device__ __forceinline__ unsigned xb_add(unsigned* p, unsigned v) { return __hip_atomic_fetch_add(p, v, __ATOMIC_RELAXED, __HIP_MEMORY_SCOPE_AGENT); }
__device__ __forceinline__ unsigned xb_xcc_id() { return (unsigned)__builtin_amdgcn_s_getreg((3 << 11) | 20) & 0xFu; }
#define XB_SPIN(cond, bar) do { unsigned _sp = 0; while (cond) { __builtin_amdgcn_s_sleep(1); \
    if ((++_sp & 255u) == 0u) { if (xb_ld(&(bar)[XB_TMO])) break; if (_sp > XB_SPIN_CAP) { atomicAdd(&(bar)[XB_TMO], 1u); break; } } } } while (0)
struct XcdBarrier { unsigned* bar; unsigned x; volatile LAS unsigned* st; };
__device__ __forceinline__ XcdBarrier xcd_barrier_post(unsigned* bar, volatile LAS unsigned* st) {
    XcdBarrier b; b.bar = bar; b.x = xb_xcc_id(); b.st = st;
    if (threadIdx.x == 0) (void)xb_add(&bar[XB_XCNT(b.x)], 1u);
    return b;
}
__device__ __forceinline__ void xcd_barrier_complete(unsigned* bar, unsigned x, unsigned& nloc, unsigned& nx) {
    const unsigned G = gridDim.x * gridDim.y * gridDim.z;
    unsigned sum, cnt, mine, sp = 0u;
    for (;;) {
        sum = 0u; cnt = 0u; mine = 0u;
#pragma unroll
        for (unsigned j = 0; j < 16; ++j) { const unsigned c = xb_ld(&bar[XB_XCNT(j)]); sum += c; cnt += (c > 0u) ? 1u : 0u; mine = (j == x) ? c : mine; }
        if (sum == G) break;
        __builtin_amdgcn_s_sleep(1);
        if ((++sp & 255u) == 0u) { if (xb_ld(&bar[XB_TMO])) break; if (sp > XB_SPIN_CAP) { atomicAdd(&bar[XB_TMO], 1u); break; } }
    }
    nloc = mine > 0u ? mine : 1u; nx = cnt > 0u ? cnt : 1u;
}
__device__ __forceinline__ void xcd_barrier(const XcdBarrier& b) {
    asm volatile("s_waitcnt vmcnt(0)" ::: "memory");
    __syncthreads();
    if (threadIdx.x == 0) {
        unsigned* bar = b.bar;
        __builtin_amdgcn_s_waitcnt(0);
        unsigned nloc = b.st[0], nx = b.st[1];
        if (nloc == 0u) { xcd_barrier_complete(bar, b.x, nloc, nx); b.st[0] = nloc; b.st[1] = nx; }
        const unsigned old = xb_add(&bar[XB_XSUB(b.x)], 1u);
        const unsigned gen = old / nloc;
        if (old + 1u == (gen + 1u) * nloc) {
            __builtin_amdgcn_fence(__ATOMIC_RELEASE, "agent");
            asm volatile("s_waitcnt vmcnt(0)" ::: "memory");
            const unsigned og = xb_add(&bar[XB_TOP], 1u);
            const unsigned tg = og / nx;
            if (og + 1u == (tg + 1u) * nx) xb_add(&bar[XB_TOPGEN], 1u);
            else XB_SPIN(xb_ld(&bar[XB_TOPGEN]) == tg, bar);
            __builtin_amdgcn_fence(__ATOMIC_ACQUIRE, "agent");
            xb_add(&bar[XB_XGEN(b.x)], 1u);
            asm volatile("s_waitcnt vmcnt(0)" ::: "memory");
        } else {
            XB_SPIN(xb_ld(&bar[XB_XGEN(b.x)]) == gen, bar);
            __builtin_amdgcn_fence(__ATOMIC_ACQUIRE, "agent");
            asm volatile("s_waitcnt vmcnt(0)" ::: "memory");
        }
    }
    __syncthreads();
}
__device__ __forceinline__ int next_item(unsigned* ctr, volatile int* slot) {
    __syncthreads();
    if (threadIdx.x == 0) *slot = (int)atomicAdd(ctr, 1u);
    __syncthreads();
    return *slot;
}

__device__ void prologue_phase(const Params& p, char* smem) {
    const int t = tid_opq();
    bf16_t* WinT = (bf16_t*)(p.ws + WS_WINT); bf16_t* WoutT = (bf16_t*)(p.ws + WS_WOUTT);
    float* mod = (float*)(p.ws + WS_MOD); float* cosT = (float*)(p.ws + WS_COS); float* sinT = (float*)(p.ws + WS_SIN);
    float* tl = (float*)smem;
    constexpr int N_TIN = DEPTH * 16 * 54, N_TOUT = DEPTH * 16 * 16, N_MOD = DEPTH * 192, N_ROPE = T * 32 / 256;
    constexpr int NITEMS = N_TIN + N_TOUT + N_MOD + N_ROPE;
    for (int it = blockIdx.x; it < NITEMS; it += gridDim.x) {
        if (it < N_TIN + N_TOUT) {
            const float* src; bf16_t* dst; int ncols, kt, nt;
            if (it < N_TIN) { int l = it / (16 * 54), r = it % (16 * 54); kt = r / 54; nt = r % 54; src = p.w_in + (size_t)l * 1024 * DIN; dst = WinT + (size_t)l * NPAD * 1024; ncols = DIN; }
            else { int i2 = it - N_TIN; int l = i2 / 256, r = i2 % 256; kt = r / 16; nt = r % 16; src = p.w_out + (size_t)l * 1024 * 1024; dst = WoutT + (size_t)l * 1024 * 1024; ncols = 1024; }
            __syncthreads();
            { const int c = t & 63, r0 = t >> 6; const int n = nt * 64 + c;
#pragma unroll
              for (int i = 0; i < 16; ++i) { int r = r0 + 4 * i; tl[r * 65 + c] = (n < ncols) ? src[(size_t)(kt * 64 + r) * ncols + n] : 0.f; } }
            __syncthreads();
            { const int kk = t & 63, n0 = t >> 6;
#pragma unroll
              for (int i = 0; i < 16; ++i) { int n = n0 + 4 * i; dst[(size_t)(nt * 64 + n) * 1024 + kt * 64 + kk] = f2bf(tl[kk * 65 + n]); } }
        } else if (it < N_TIN + N_TOUT + N_MOD) {
            const int i2 = it - N_TIN - N_TOUT; const int l = i2 / 192, jg = i2 % 192;
            const int jj = t & 15, ks = t >> 4; const int j = jg * 16 + jj;
            float a0 = 0.f, a1 = 0.f, a2 = 0.f, a3 = 0.f;
            const float* wm = p.w_mod + (size_t)l * 1024 * 3072 + j;
#pragma unroll 8
            for (int k = ks * 64; k < ks * 64 + 64; ++k) { float wv = wm[(size_t)k * 3072]; a0 += p.c[k] * wv; a1 += p.c[1024 + k] * wv; a2 += p.c[2048 + k] * wv; a3 += p.c[3072 + k] * wv; }
            __syncthreads();
            tl[(0 * 16 + ks) * 16 + jj] = a0; tl[(1 * 16 + ks) * 16 + jj] = a1; tl[(2 * 16 + ks) * 16 + jj] = a2; tl[(3 * 16 + ks) * 16 + jj] = a3;
            __syncthreads();
            if (t < 64) { const int b = t >> 4, j2 = t & 15; float s = 0.f;
#pragma unroll
              for (int k2 = 0; k2 < 16; ++k2) s += tl[(b * 16 + k2) * 16 + j2];
              mod[((size_t)l * NB + b) * 3072 + jg * 16 + j2] = s + p.b_mod[l * 3072 + jg * 16 + j2]; }
        } else {
            const int i2 = it - N_TIN - N_TOUT - N_MOD; const int e = i2 * 256 + t; const int tok = e >> 5, f = e & 31;
            const float inv = exp2f(-(float)f * (13.287712379549449f / 32.f));
            const float ang = (float)p.pos[tok] * inv;
            double rev = (double)ang * 0.15915494309189535; rev -= __builtin_rint(rev);
            const float rr = (float)rev; cosT[e] = __builtin_amdgcn_cosf(rr); sinT[e] = __builtin_amdgcn_sinf(rr);
        }
    }
}

__device__ void ln_phase(const Params& p, int l) {
    const int t = tid_opq(), lane = t & 63, w = t >> 6;
    bf16_t* ubuf = (bf16_t*)(p.ws + WS_U); const float* mod = (const float*)(p.ws + WS_MOD);
    for (int rg = blockIdx.x; rg < T / 16; rg += gridDim.x) {
        f32x4 v[4][4];
#pragma unroll
        for (int r = 0; r < 4; ++r) { const int row = rg * 16 + w * 4 + r; const float* src = (l == 0) ? p.x + (size_t)row * 1024 : p.out + (size_t)row * 1024;
#pragma unroll
            for (int i = 0; i < 4; ++i) v[r][i] = *(const f32x4*)(src + i * 256 + lane * 4); }
#pragma unroll
        for (int r = 0; r < 4; ++r) {
            const int row = rg * 16 + w * 4 + r; const int b = row / S;
            if (l > 0) {
                float s = 0.f;
#pragma unroll
                for (int i = 0; i < 4; ++i) s += (v[r][i][0] + v[r][i][1]) + (v[r][i][2] + v[r][i][3]);
                const float mu = wsum(s) * (1.f / 1024.f); float q = 0.f;
#pragma unroll
                for (int i = 0; i < 4; ++i) { f32x4 d = v[r][i] - mu; q += (d[0] * d[0] + d[1] * d[1]) + (d[2] * d[2] + d[3] * d[3]); }
                const float rstd = rsqrtf(wsum(q) * (1.f / 1024.f) + 1e-5f);
#pragma unroll
                for (int i = 0; i < 4; ++i) { const f32x4 g = *(const f32x4*)(p.ln_g + (l - 1) * 1024 + i * 256 + lane * 4), bb = *(const f32x4*)(p.ln_b + (l - 1) * 1024 + i * 256 + lane * 4);
                    v[r][i] = (v[r][i] - mu) * rstd * g + bb; *(f32x4*)(p.out + (size_t)row * 1024 + i * 256 + lane * 4) = v[r][i]; }
            }
            if (l < DEPTH) {
                float s = 0.f;
#pragma unroll
                for (int i = 0; i < 4; ++i) s += (v[r][i][0] + v[r][i][1]) + (v[r][i][2] + v[r][i][3]);
                const float mu = wsum(s) * (1.f / 1024.f); float q = 0.f;
#pragma unroll
                for (int i = 0; i < 4; ++i) { f32x4 d = v[r][i] - mu; q += (d[0] * d[0] + d[1] * d[1]) + (d[2] * d[2] + d[3] * d[3]); }
                const float rstd = rsqrtf(wsum(q) * (1.f / 1024.f) + 1e-5f);
                const float* mb = mod + ((size_t)l * NB + b) * 3072;
#pragma unroll
                for (int i = 0; i < 4; ++i) { const int col = i * 256 + lane * 4; const f32x4 sh = *(const f32x4*)(mb + col), sc = *(const f32x4*)(mb + 1024 + col);
                    f32x4 u = (v[r][i] - mu) * rstd * (sc + 1.f) + sh; u32x2 pk; pk.x = pack2(u[0], u[1]); pk.y = pack2(u[2], u[3]);
                    *(u32x2*)(ubuf + (size_t)row * 1024 + col) = pk; }
            }
        }
    }
}

__device__ __forceinline__ int lds_off(int r, int c8) {
    const int st = (r >> 4) * 2 + (c8 >> 2); const int ob = (r & 15) * 64 + (c8 & 3) * 16;
    return st * 1024 + (ob ^ (((ob >> 9) & 1) << 5));
}
__device__ __forceinline__ void gemm_core(const bf16_t* __restrict__ A, const bf16_t* __restrict__ Bt, int tm, int tn, char* sm, f32x4 (&acc)[4][4]) {
    const int t = tid_opq(), lane = t & 63, w = t >> 6, wm = w >> 1, wn = w & 1, r16 = lane & 15, quad = lane >> 4;
    const int lrow = t >> 3, lch = t & 7;
    constexpr int BUF = 32768;
    const bf16_t* Ag = A + (size_t)(tm * 128 + lrow) * 1024 + lch * 8;
    const bf16_t* Bg = Bt + (size_t)(tn * 128 + lrow) * 1024 + lch * 8;
    int woff[4];
#pragma unroll
    for (int i = 0; i < 4; ++i) woff[i] = lds_off(lrow + 32 * i, lch);
    const int fo = lds_off(r16, quad);
    u32x4 ra[4], rb[4];
#pragma unroll
    for (int i = 0; i < 4; ++i) { ra[i] = *(const u32x4*)(Ag + (size_t)i * 32 * 1024); rb[i] = *(const u32x4*)(Bg + (size_t)i * 32 * 1024); }
#pragma unroll
    for (int a = 0; a < 4; ++a)
#pragma unroll
        for (int b = 0; b < 4; ++b) acc[a][b] = (f32x4){0.f, 0.f, 0.f, 0.f};
    __syncthreads();
#pragma unroll
    for (int i = 0; i < 4; ++i) { *(u32x4*)(sm + woff[i]) = ra[i]; *(u32x4*)(sm + 16384 + woff[i]) = rb[i]; }
#pragma unroll
    for (int i = 0; i < 4; ++i) { ra[i] = *(const u32x4*)(Ag + (size_t)i * 32 * 1024 + 64); rb[i] = *(const u32x4*)(Bg + (size_t)i * 32 * 1024 + 64); }
    __syncthreads();
    for (int kt = 0; kt < 16; ++kt) {
        const char* sA = sm + (kt & 1) * BUF; const char* sB = sA + 16384;
        char* nA = sm + ((kt + 1) & 1) * BUF; char* nB = nA + 16384;
        if (kt + 1 < 16) {
#pragma unroll
            for (int i = 0; i < 4; ++i) { *(u32x4*)(nA + woff[i]) = ra[i]; *(u32x4*)(nB + woff[i]) = rb[i]; }
        }
        if (kt + 2 < 16) {
#pragma unroll
            for (int i = 0; i < 4; ++i) { ra[i] = *(const u32x4*)(Ag + (size_t)i * 32 * 1024 + (kt + 2) * 64); rb[i] = *(const u32x4*)(Bg + (size_t)i * 32 * 1024 + (kt + 2) * 64); }
        }
        __builtin_amdgcn_sched_barrier(0);
#pragma unroll
        for (int ks = 0; ks < 2; ++ks) {
            bf16x8 af[4], bfr[4];
#pragma unroll
            for (int mt = 0; mt < 4; ++mt) af[mt] = *(const bf16x8*)(sA + ((wm * 4 + mt) * 2 + ks) * 1024 + fo);
#pragma unroll
            for (int nt = 0; nt < 4; ++nt) bfr[nt] = *(const bf16x8*)(sB + ((wn * 4 + nt) * 2 + ks) * 1024 + fo);
#pragma unroll
            for (int mt = 0; mt < 4; ++mt)
#pragma unroll
                for (int nt = 0; nt < 4; ++nt) acc[mt][nt] = __builtin_amdgcn_mfma_f32_16x16x32_bf16(bfr[nt], af[mt], acc[mt][nt], 0, 0, 0);
        }
        __syncthreads();
    }
}

__device__ void g1_phase(const Params& p, int l, char* smem) {
    const int t = tid_opq(), lane = t & 63, w = t >> 6, wm = w >> 1, wn = w & 1, r16 = lane & 15, quad = lane >> 4;
    char* sm = smem; bf16_t* sC = (bf16_t*)smem;
    const bf16_t* ubuf = (const bf16_t*)(p.ws + WS_U); const bf16_t* WinT = (const bf16_t*)(p.ws + WS_WINT) + (size_t)l * NPAD * 1024;
    bf16_t* z = (bf16_t*)(p.ws + WS_Z); float* kpart = (float*)(p.ws + WS_KPART);
    const float* cosT = (const float*)(p.ws + WS_COS); const float* sinT = (const float*)(p.ws + WS_SIN);
    const bool xo = (gridDim.x & 7) == 0; const int xcd = blockIdx.x & 7, nloc = xo ? (int)(gridDim.x >> 3) : (int)gridDim.x, j0 = xo ? (int)(blockIdx.x >> 3) : (int)blockIdx.x;
    for (int L = j0; L < (xo ? 16 * 27 : 128 * 27); L += nloc) {
        const int tm = xo ? xcd * 16 + (L & 15) : L / 27, tn = xo ? (L >> 4) : L % 27;
        f32x4 acc[4][4];
        gemm_core(ubuf, WinT, tm, tn, sm, acc);
        const bool rope = (tn < 4) || (tn >= 12 && tn < 16);
        if (rope) {
#pragma unroll
            for (int mt = 0; mt < 4; ++mt) {
                const int tok = tm * 128 + wm * 64 + mt * 16 + r16;
#pragma unroll
                for (int nt = 0; nt < 2; ++nt) {
                    const f32x4 cs = *(const f32x4*)(cosT + (size_t)tok * 32 + nt * 16 + quad * 4), sn = *(const f32x4*)(sinT + (size_t)tok * 32 + nt * 16 + quad * 4);
                    const f32x4 x1 = acc[mt][nt], x2 = acc[mt][nt + 2];
                    acc[mt][nt] = x1 * cs - x2 * sn; acc[mt][nt + 2] = x1 * sn + x2 * cs;
                }
            }
        }
        if (tn == 2 || tn == 3) {
#pragma unroll
            for (int nt = 0; nt < 4; ++nt) {
                f32x4 sv = (acc[0][nt] + acc[1][nt]) + (acc[2][nt] + acc[3][nt]);
#pragma unroll
                for (int jj = 0; jj < 4; ++jj) { float sx = sv[jj]; sx += __shfl_xor(sx, 1); sx += __shfl_xor(sx, 2); sx += __shfl_xor(sx, 4); sx += __shfl_xor(sx, 8); sv[jj] = sx; }
                if (r16 == 0) *(f32x4*)(kpart + (size_t)(tm * 2 + wm) * 256 + (tn - 2) * 128 + wn * 64 + nt * 16 + quad * 4) = sv;
            }
        }
#pragma unroll
        for (int mt = 0; mt < 4; ++mt)
#pragma unroll
            for (int nt = 0; nt < 4; ++nt) { u32x2 pk; pk.x = pack2(acc[mt][nt][0], acc[mt][nt][1]); pk.y = pack2(acc[mt][nt][2], acc[mt][nt][3]);
                *(u32x2*)(sC + (wm * 64 + mt * 16 + r16) * 136 + wn * 64 + nt * 16 + quad * 4) = pk; }
        __syncthreads();
#pragma unroll
        for (int i = 0; i < 8; ++i) { const int c = t + 256 * i; const int row = c >> 4, ch = c & 15; const int col = tn * 128 + ch * 8;
            if (col < DIN) *(u32x4*)(z + (size_t)(tm * 128 + row) * ZP + col) = *(const u32x4*)(sC + row * 136 + ch * 8); }
    }
}

__device__ void g2_phase(const Params& p, int l, char* smem) {
    const int t = tid_opq(), lane = t & 63, w = t >> 6, wm = w >> 1, wn = w & 1, r16 = lane & 15, quad = lane >> 4;
    char* sm = smem;
    const bf16_t* mix = (const bf16_t*)(p.ws + WS_U); const bf16_t* WoutT = (const bf16_t*)(p.ws + WS_WOUTT) + (size_t)l * 1024 * 1024;
    const float* mod = (const float*)(p.ws + WS_MOD);
    const float* xres = (l == 0) ? p.x : p.out;
    const bool xo = (gridDim.x & 7) == 0; const int xcd = blockIdx.x & 7, nloc = xo ? (int)(gridDim.x >> 3) : (int)gridDim.x, j0 = xo ? (int)(blockIdx.x >> 3) : (int)blockIdx.x;
    for (int L = j0; L < (xo ? 16 * 8 : 128 * 8); L += nloc) {
        const int tm = xo ? xcd * 16 + (L & 15) : (L >> 3), tn = xo ? (L >> 4) : (L & 7);
        f32x4 acc[4][4];
        gemm_core(mix, WoutT, tm, tn, sm, acc);
        const int b = (tm * 128) / S;
        const float* gate = mod + ((size_t)l * NB + b) * 3072 + 2048;
#pragma unroll
        for (int nt = 0; nt < 4; ++nt) { const int col = tn * 128 + wn * 64 + nt * 16 + quad * 4; const f32x4 g1 = *(const f32x4*)(gate + col) + 1.f;
#pragma unroll
            for (int mt = 0; mt < 4; ++mt) { const size_t o = (size_t)(tm * 128 + wm * 64 + mt * 16 + r16) * 1024 + col;
                const f32x4 xr = *(const f32x4*)(xres + o); *(f32x4*)(p.out + o) = xr * DN_ALPHA + g1 * acc[mt][nt]; } }
    }
}

constexpr float ATT_SC = 0.18033688011112042f;
__device__ __forceinline__ void attn_tile(const bf16_t* sK, const bf16_t* sV, const bf16x8 (&qf)[2][2], int lo, int hi, bool full, bool hasq, bool qfl0, bool qfl1,
                                          float (&m)[2], float (&l)[2], f32x4 (&O)[2][4], int wq0) {
    const int lane = tid_opq() & 63, r16 = lane & 15, quad = lane >> 4;
    f32x4 s[2][4];
#pragma unroll
    for (int a = 0; a < 2; ++a)
#pragma unroll
        for (int b = 0; b < 4; ++b) s[a][b] = (f32x4){0.f, 0.f, 0.f, 0.f};
#pragma unroll
    for (int ks = 0; ks < 2; ++ks)
#pragma unroll
        for (int k16 = 0; k16 < 4; ++k16) {
            const bf16x8 kf = *(const bf16x8*)(sK + (k16 * 16 + r16) * LDP + ks * 32 + quad * 8);
#pragma unroll
            for (int qt = 0; qt < 2; ++qt) s[qt][k16] = __builtin_amdgcn_mfma_f32_16x16x32_bf16(kf, qf[qt][ks], s[qt][k16], 0, 0, 0);
        }
#pragma unroll
    for (int qt = 0; qt < 2; ++qt) {
        const int ql = wq0 + qt * 16 + r16; const bool qfl = qt ? qfl1 : qfl0;
        if (!full) {
#pragma unroll
            for (int k16 = 0; k16 < 4; ++k16)
#pragma unroll
                for (int j = 0; j < 4; ++j) { const int dd = ql - (k16 * 16 + quad * 4 + j); const bool valid = dd >= lo && dd <= hi; s[qt][k16][j] = valid ? s[qt][k16][j] : -1e30f; }
        }
        if (hasq) {
#pragma unroll
            for (int k16 = 0; k16 < 4; ++k16)
#pragma unroll
                for (int j = 0; j < 4; ++j) s[qt][k16][j] = qfl ? s[qt][k16][j] : -1e30f;
        }
        float mx = -1e30f;
#pragma unroll
        for (int k16 = 0; k16 < 4; ++k16) mx = fmaxf(mx, fmaxf(fmaxf(s[qt][k16][0], s[qt][k16][1]), fmaxf(s[qt][k16][2], s[qt][k16][3])));
        mx = fmaxf(mx, __shfl_xor(mx, 16)); mx = fmaxf(mx, __shfl_xor(mx, 32));
        const float mn = fmaxf(m[qt], mx); const float alpha = __builtin_amdgcn_exp2f((m[qt] - mn) * ATT_SC); m[qt] = mn;
        const float mb = (mn < -1e29f) ? 0.f : mn * ATT_SC;
        float ps = 0.f;
#pragma unroll
        for (int k16 = 0; k16 < 4; ++k16)
#pragma unroll
            for (int j = 0; j < 4; ++j) { const float pv = __builtin_amdgcn_exp2f(s[qt][k16][j] * ATT_SC - mb); ps += pv; s[qt][k16][j] = pv; }
        l[qt] = l[qt] * alpha + ps;
#pragma unroll
        for (int dt = 0; dt < 4; ++dt) O[qt][dt] = O[qt][dt] * alpha;
    }
#pragma unroll
    for (int G = 0; G < 2; ++G) {
        bf16x8 pf[2];
#pragma unroll
        for (int qt = 0; qt < 2; ++qt) {
            const unsigned a0 = pack2(s[qt][G * 2][0], s[qt][G * 2][1]), a1 = pack2(s[qt][G * 2][2], s[qt][G * 2][3]);
            const unsigned a2 = pack2(s[qt][G * 2 + 1][0], s[qt][G * 2 + 1][1]), a3 = pack2(s[qt][G * 2 + 1][2], s[qt][G * 2 + 1][3]);
            u32x4 pk = {a0, a1, a2, a3}; pf[qt] = __builtin_bit_cast(bf16x8, pk);
        }
#pragma unroll
        for (int dt = 0; dt < 4; ++dt) {
            const bf16_t* v0p = sV + (G * 32 + quad * 4 + (r16 >> 2)) * LDP + dt * 16 + (r16 & 3) * 4;
            const bf16x4 v0 = __builtin_amdgcn_ds_read_tr16_b64_v4i16((__attribute__((address_space(3))) bf16x4*)(v0p));
            const bf16x4 v1 = __builtin_amdgcn_ds_read_tr16_b64_v4i16((__attribute__((address_space(3))) bf16x4*)(v0p + 16 * LDP));
            const bf16x8 vf = {v0[0], v0[1], v0[2], v0[3], v1[0], v1[1], v1[2], v1[3]};
#pragma unroll
            for (int qt = 0; qt < 2; ++qt) O[qt][dt] = __builtin_amdgcn_mfma_f32_16x16x32_bf16(vf, pf[qt], O[qt][dt], 0, 0, 0);
        }
    }
}

__device__ void attn_item(const Params& p, int kind, int idx, char* smem) {
    const int t = tid_opq(), lane = t & 63, w = t >> 6, r16 = lane & 15, quad = lane >> 4;
    bf16_t* sK = (bf16_t*)smem; bf16_t* sV = sK + 64 * LDP;
    float* kmean = (float*)(smem + 18432); float* gates = (float*)(smem + 22528); unsigned* selm = (unsigned*)(smem + 30720);
    int4* desc = (int4*)(smem + 31232); int* misc = (int*)(smem + 32320);
    const bf16_t* z = (const bf16_t*)(p.ws + WS_Z);
    int b, h, qbase, stride, qcol, kcol, vcol, cfg = 0;
    __syncthreads();
    if (kind == 0) {
        const int n = 15 - (idx >> 5); const int rem = idx & 31; b = rem >> 3; h = (rem >> 1) & 3; const int qh = rem & 1;
        qbase = b * S + n * 256 + qh * 128; stride = 1; qcol = C_AQ + h * 64; kcol = C_AK + h * 64; vcol = C_AV + h * 64;
        const float* kpart = (const float*)(p.ws + WS_KPART);
        for (int e = t; e < n * 64; e += 256) { const int j = e >> 6, d = e & 63; const float* kp = kpart + (size_t)(b * 64 + j * 4) * 256 + h * 64 + d;
            kmean[e] = ((kp[0] + kp[256]) + (kp[512] + kp[768])) * (1.f / 256.f); }
        if (t == 0) misc[1] = 0;
        __syncthreads();
        {
            const int ql = t >> 1, half = t & 1; const bf16_t* qp = z + (size_t)(qbase + ql) * ZP + qcol;
            float g[8];
#pragma unroll
            for (int jj = 0; jj < 8; ++jj) g[jj] = 0.f;
#pragma unroll 1
            for (int dc = 0; dc < 8; ++dc) {
                const u32x4 qv = *(const u32x4*)(qp + dc * 8); float qq[8];
#pragma unroll
                for (int e = 0; e < 4; ++e) { qq[2 * e] = __uint_as_float(qv[e] << 16); qq[2 * e + 1] = __uint_as_float(qv[e] & 0xffff0000u); }
#pragma unroll
                for (int jj = 0; jj < 8; ++jj) { const int j = half + 2 * jj; if (j < n) { const float* km = kmean + j * 64 + dc * 8;
#pragma unroll
                    for (int e = 0; e < 8; ++e) g[jj] += qq[e] * km[e]; } }
            }
#pragma unroll
            for (int jj = 0; jj < 8; ++jj) gates[ql * 16 + half + 2 * jj] = g[jj];
        }
        __syncthreads();
        if (t < 128) {
            unsigned msk = 0;
            for (int k = 0; k < 3 && k < n; ++k) { float best = -3.0e38f; int bi = -1;
                for (int j = 0; j < n; ++j) if (!((msk >> j) & 1u)) { const float gv = gates[t * 16 + j]; if (gv > best) { best = gv; bi = j; } }
                if (bi >= 0) msk |= 1u << bi; }
            selm[t] = msk; atomicOr((unsigned*)&misc[1], msk);
        }
        __syncthreads();
        if (t == 0) {
            int nd = 0; const unsigned bm = (unsigned)misc[1];
            for (int kt = 0; kt <= qh * 2 + 1; ++kt) desc[nd++] = make_int4(b * S + n * 256 + kt * 64, kt * 64 - qh * 128, BIG, -1);
            for (int j = 0; j < n; ++j) if ((bm >> j) & 1u) for (int kt = 0; kt < 4; ++kt) desc[nd++] = make_int4(b * S + j * 256 + kt * 64, -BIG, BIG, j);
            misc[0] = nd;
        }
    } else {
        cfg = idx >> 9; const int rem = idx & 511; b = rem >> 7; h = (rem >> 5) & 3; const int rb = rem & 31;
        const int dil = 1 << (2 * cfg); const int res = rb & (dil - 1), blk = rb >> (2 * cfg);
        qbase = b * S + blk * 128 * dil + res; stride = dil; qcol = C_CQ + h * 64; kcol = C_CK + h * 64; vcol = C_CV + h * 64;
        if (t < 128) selm[t] = 0xffffffffu;
        if (t == 0) { int nd = 0; for (int kt = (blk == 0 ? 2 : 0); kt < 4; ++kt) desc[nd++] = make_int4(b * S + (blk * 128 - 128 + kt * 64) * dil + res, kt * 64 - 128, kt * 64, -1); misc[0] = nd; }
    }
    __syncthreads();
    const int nd = misc[0];
    bf16x8 qf[2][2];
#pragma unroll
    for (int qt = 0; qt < 2; ++qt)
#pragma unroll
        for (int ks = 0; ks < 2; ++ks) qf[qt][ks] = *(const bf16x8*)(z + (size_t)(qbase + (w * 32 + qt * 16 + r16) * stride) * ZP + qcol + ks * 32 + quad * 8);
    const unsigned sel0 = selm[w * 32 + r16], sel1 = selm[w * 32 + 16 + r16];
    float m[2] = {-1e30f, -1e30f}, l[2] = {0.f, 0.f}; f32x4 O[2][4];
#pragma unroll
    for (int a = 0; a < 2; ++a)
#pragma unroll
        for (int c = 0; c < 4; ++c) O[a][c] = (f32x4){0.f, 0.f, 0.f, 0.f};
    const int lrow = t >> 2, lch = (t & 3) * 2;
    u32x4 rk0, rk1, rv0, rv1;
    if (nd > 0) { const int4 d = desc[0]; const bf16_t* rp = z + (size_t)(d.x + lrow * stride) * ZP + lch * 8;
        rk0 = *(const u32x4*)(rp + kcol); rk1 = *(const u32x4*)(rp + kcol + 8); rv0 = *(const u32x4*)(rp + vcol); rv1 = *(const u32x4*)(rp + vcol + 8); }
    for (int i = 0; i < nd; ++i) {
        __syncthreads();
        *(u32x4*)(sK + lrow * LDP + lch * 8) = rk0; *(u32x4*)(sK + lrow * LDP + lch * 8 + 8) = rk1;
        *(u32x4*)(sV + lrow * LDP + lch * 8) = rv0; *(u32x4*)(sV + lrow * LDP + lch * 8 + 8) = rv1;
        __syncthreads();
        if (i + 1 < nd) { const int4 d = desc[i + 1]; const bf16_t* rp = z + (size_t)(d.x + lrow * stride) * ZP + lch * 8;
            rk0 = *(const u32x4*)(rp + kcol); rk1 = *(const u32x4*)(rp + kcol + 8); rv0 = *(const u32x4*)(rp + vcol); rv1 = *(const u32x4*)(rp + vcol + 8); }
        const int4 d = desc[i];
        bool need = (w * 32 + 31 >= d.y) && (w * 32 - 63 <= d.z);
        bool q0 = true, q1 = true;
        if (d.w >= 0) { q0 = (sel0 >> d.w) & 1u; q1 = (sel1 >> d.w) & 1u; need = need && (__ballot(q0 || q1) != 0ull); }
        const bool full = (w * 32 - 63 >= d.y) && (w * 32 + 31 <= d.z);
        if (need) attn_tile(sK, sV, qf, d.y, d.z, full, d.w >= 0, q0, q1, m, l, O, w * 32);
    }
#pragma unroll
    for (int qt = 0; qt < 2; ++qt) {
        float lt = l[qt]; lt += __shfl_xor(lt, 16); lt += __shfl_xor(lt, 32);
        const float inv = 1.f / lt; const size_t tok = (size_t)(qbase + (w * 32 + qt * 16 + r16) * stride);
        if (kind == 0) {
            bf16_t* mix = (bf16_t*)(p.ws + WS_U);
#pragma unroll
            for (int dt = 0; dt < 4; ++dt) { const int d0 = dt * 16 + quad * 4; const u32x2 gv = *(const u32x2*)(z + tok * ZP + C_AG + h * 64 + d0);
                const float g0 = __uint_as_float(gv.x << 16), g1 = __uint_as_float(gv.x & 0xffff0000u), g2 = __uint_as_float(gv.y << 16), g3 = __uint_as_float(gv.y & 0xffff0000u);
                u32x2 o; o.x = pack2(O[qt][dt][0] * inv * silu_f(g0), O[qt][dt][1] * inv * silu_f(g1)); o.y = pack2(O[qt][dt][2] * inv * silu_f(g2), O[qt][dt][3] * inv * silu_f(g3));
                *(u32x2*)(mix + tok * 1024 + h * 64 + d0) = o; }
        } else {
            bf16_t* dilo = (bf16_t*)(p.ws + WS_DILO); float* dill = (float*)(p.ws + WS_DILL);
#pragma unroll
            for (int dt = 0; dt < 4; ++dt) { const int d0 = dt * 16 + quad * 4; u32x2 o; o.x = pack2(O[qt][dt][0] * inv, O[qt][dt][1] * inv); o.y = pack2(O[qt][dt][2] * inv, O[qt][dt][3] * inv);
                *(u32x2*)(dilo + ((size_t)cfg * T + tok) * 256 + h * 64 + d0) = o; }
            if (quad == 0) dill[((size_t)cfg * T + tok) * 4 + h] = m[qt] * 0.125f + __logf(lt);
        }
    }
}

__device__ __forceinline__ void gla_bcum(const Params& p, int l, const bf16_t* z, int tok0, float* bc, float* drs) {
    const int t = tid_opq();
    const int hd = t & 127, ih = t >> 7;
    float wr[16];
#pragma unroll
    for (int r = 0; r < 16; ++r) wr[r] = p.gla_wr[l * 2048 + r * 128 + hd];
    const float br = p.gla_br[l * 128 + hd];
    { const int e0 = t, e1 = t + 256; const bf16_t d0 = z[(size_t)(tok0 + (e0 >> 4)) * ZP + C_DR + (e0 & 15)], d1 = z[(size_t)(tok0 + (e1 >> 4)) * ZP + C_DR + (e1 & 15)];
      drs[e0] = bf2f(d0); drs[e1] = bf2f(d1); }
    __syncthreads();
#pragma unroll
    for (int ii = 0; ii < 16; ++ii) { const int i = ih * 16 + ii; float x = br;
#pragma unroll
        for (int r4 = 0; r4 < 4; ++r4) { const f32x4 dv = *(const f32x4*)(drs + i * 16 + r4 * 4); x += (dv[0] * wr[r4 * 4] + dv[1] * wr[r4 * 4 + 1]) + (dv[2] * wr[r4 * 4 + 2] + dv[3] * wr[r4 * 4 + 3]); }
        bc[i * 128 + hd] = (fminf(x, 0.f) - __logf(1.f + __expf(-fabsf(x)))) * (1.f / 16.f); }
    __syncthreads();
    if (t < 128) { float sacc = 0.f;
#pragma unroll
        for (int i = 0; i < 32; ++i) { sacc += bc[i * 128 + t]; bc[i * 128 + t] = sacc; } }
    __syncthreads();
}

__device__ void gla1_item(const Params& p, int l, int idx, char* smem) {
    const int t = tid_opq(), lane = t & 63, w = t >> 6;
    const int b = idx >> 7, c = idx & 127; const int tok0 = b * S + c * 32;
    const bf16_t* z = (const bf16_t*)(p.ws + WS_Z);
    float* bc = (float*)smem; float* drs = (float*)(smem + 16384); float* kdec = (float*)(smem + 18432) + w * 1024;
    float* gkv = (float*)(p.ws + WS_GKV); float* gdec = (float*)(p.ws + WS_GDEC);
    bf16_t vraw[32], kraw[16];
#pragma unroll
    for (int j = 0; j < 32; ++j) vraw[j] = z[(size_t)(tok0 + j) * ZP + C_DV + w * 64 + lane];
#pragma unroll
    for (int i = 0; i < 16; ++i) { const int e = lane + 64 * i; kraw[i] = z[(size_t)(tok0 + (e >> 5)) * ZP + C_DK + w * 32 + (e & 31)]; }
    __syncthreads();
    gla_bcum(p, l, z, tok0, bc, drs);
#pragma unroll
    for (int i = 0; i < 16; ++i) { const int e = lane + 64 * i; const int j = e >> 5, d = e & 31;
        kdec[j * 32 + d] = bf2f(kraw[i]) * __expf(bc[31 * 128 + w * 32 + d] - bc[j * 128 + w * 32 + d]); }
    __syncthreads();
    float acc[32];
#pragma unroll
    for (int d = 0; d < 32; ++d) acc[d] = 0.f;
#pragma unroll
    for (int j = 0; j < 32; ++j) { const float vv = bf2f(vraw[j]);
#pragma unroll
        for (int d4 = 0; d4 < 8; ++d4) { const f32x4 kd = *(const f32x4*)(kdec + j * 32 + d4 * 4); acc[d4 * 4] += kd[0] * vv; acc[d4 * 4 + 1] += kd[1] * vv; acc[d4 * 4 + 2] += kd[2] * vv; acc[d4 * 4 + 3] += kd[3] * vv; } }
    const int bh = b * 4 + w; float* dst = gkv + (size_t)(bh * 128 + c) * 2048;
#pragma unroll
    for (int d = 0; d < 32; ++d) dst[d * 64 + lane] = acc[d];
    if (lane < 32) gdec[(bh * 128 + c) * 32 + lane] = __expf(bc[31 * 128 + w * 32 + lane]);
}

#define OPQ(ptr) asm volatile("" : "+v"(ptr))
__device__ void gla3_item(const Params& p, int l, int idx, char* smem) {
    const int t = tid_opq(), lane = t & 63, w = t >> 6;
    const int b = idx >> 7, c = idx & 127; const int tok0 = b * S + c * 32;
    const bf16_t* z = (const bf16_t*)(p.ws + WS_Z); bf16_t* mix = (bf16_t*)(p.ws + WS_U);
    float* bc = (float*)smem; float* As = (float*)smem + w * 1024; float* drs = (float*)(smem + 16384);
    float* qeT = (float*)(smem + 18432) + w * 1024; float* keT = (float*)(smem + 34816) + w * 1024;
    const float* gkv = (const float*)(p.ws + WS_GKV);
    const int bh = b * 4 + w;
    bf16_t qraw[16], kraw[16], vraw[32]; float sv[32];
    { const bf16_t* qp = z + (size_t)(tok0 + (lane >> 5)) * ZP + w * 32 + (lane & 31);
#pragma unroll
      for (int i = 0; i < 16; ++i) { qraw[i] = qp[C_DQ]; kraw[i] = qp[C_DK]; qp += 2 * ZP; OPQ(qp); } }
    { const bf16_t* vp = z + (size_t)tok0 * ZP + C_DV + w * 64 + lane;
#pragma unroll
      for (int j = 0; j < 32; ++j) { vraw[j] = *vp; vp += ZP; OPQ(vp); } }
    __syncthreads();
    gla_bcum(p, l, z, tok0, bc, drs);
#pragma unroll
    for (int i2 = 0; i2 < 16; ++i2) { const int e = lane + 64 * i2; const int i = e >> 5, d = e & 31; const float bcv = bc[i * 128 + w * 32 + d];
        qeT[d * 32 + i] = bf2f(qraw[i2]) * __expf(bcv) * 0.17677669529663687f; keT[d * 32 + i] = bf2f(kraw[i2]) * __expf(-bcv); }
    __syncthreads();
    { const float* Sp = gkv + (size_t)(bh * 128 + c) * 2048 + lane;
#pragma unroll
      for (int d = 0; d < 32; ++d) sv[d] = Sp[d * 64]; }
    {
        const int i = lane & 31, jh = lane >> 5; float a[16];
#pragma unroll
        for (int jj = 0; jj < 16; ++jj) a[jj] = 0.f;
#pragma unroll 8
        for (int d = 0; d < 32; ++d) { const float qv = qeT[d * 32 + i];
#pragma unroll
            for (int j4 = 0; j4 < 4; ++j4) { const f32x4 k4 = *(const f32x4*)(keT + d * 32 + jh * 16 + j4 * 4); a[j4 * 4] += qv * k4[0]; a[j4 * 4 + 1] += qv * k4[1]; a[j4 * 4 + 2] += qv * k4[2]; a[j4 * 4 + 3] += qv * k4[3]; } }
#pragma unroll
        for (int jj = 0; jj < 16; ++jj) { const int j = jh * 16 + jj; As[j * 32 + i] = (j <= i) ? a[jj] : 0.f; }
    }
    __syncthreads();
    float o[32];
#pragma unroll
    for (int i = 0; i < 32; ++i) o[i] = 0.f;
#pragma unroll
    for (int j = 0; j < 32; ++j) { const float vv = bf2f(vraw[j]);
#pragma unroll
        for (int i4 = 0; i4 < 8; ++i4) { const f32x4 a4 = *(const f32x4*)(As + j * 32 + i4 * 4); o[i4 * 4] += a4[0] * vv; o[i4 * 4 + 1] += a4[1] * vv; o[i4 * 4 + 2] += a4[2] * vv; o[i4 * 4 + 3] += a4[3] * vv; } }
#pragma unroll
    for (int d = 0; d < 32; ++d) { const float s1 = sv[d];
#pragma unroll
        for (int i4 = 0; i4 < 8; ++i4) { const f32x4 q4 = *(const f32x4*)(qeT + d * 32 + i4 * 4); o[i4 * 4] += q4[0] * s1; o[i4 * 4 + 1] += q4[1] * s1; o[i4 * 4 + 2] += q4[2] * s1; o[i4 * 4 + 3] += q4[3] * s1; } }
    const float gn = p.gla_gn[l * 64 + lane];
    const bf16_t* gp = z + (size_t)tok0 * ZP + C_DG + w * 64 + lane;
    bf16_t* mp = mix + (size_t)tok0 * 1024 + 768 + w * 64 + lane;
#pragma unroll
    for (int grp = 0; grp < 4; ++grp) {
        bf16_t ga[8];
#pragma unroll
        for (int e = 0; e < 8; ++e) { ga[e] = *gp; gp += ZP; OPQ(gp); }
#pragma unroll
        for (int e = 0; e < 8; ++e) { const int i = grp * 8 + e; const float ss = wsum(o[i] * o[i]); const float y = o[i] * rsqrtf(ss * (1.f / 64.f) + 1e-5f) * gn;
            *mp = f2bf(y * silu_f(bf2f(ga[e]))); mp += 1024; OPQ(mp); }
    }
}

__device__ void lru1_item(const Params& p, int l, int idx, char* smem) {
    const int t = tid_opq(), lane = t & 63, g = t >> 6; const int ch = t;
    const int b = idx >> 7, c = idx & 127; const int s0 = c * 32; const int tok0 = b * S + s0;
    const bf16_t* z = (const bf16_t*)(p.ws + WS_Z); float* xcs = (float*)smem;
    float* lh = (float*)(p.ws + WS_LH); float* lp = (float*)(p.ws + WS_LP);
    bf16_t xr[35];
#pragma unroll
    for (int i = 0; i < 35; ++i) { const int sidx = s0 + i - 3; xr[i] = (sidx >= 0) ? z[(size_t)(tok0 + i - 3) * ZP + C_BX + ch] : (bf16_t)0; }
    const float cw0 = p.conv_w[l * 1024 + ch], cw1 = p.conv_w[l * 1024 + 256 + ch], cw2 = p.conv_w[l * 1024 + 512 + ch], cw3 = p.conv_w[l * 1024 + 768 + ch];
    const float cb = p.conv_b[l * 256 + ch];
    const float* wa = p.lru_wa + l * 16384 + g * 4096 + lane; const float* wx = p.lru_wx + l * 16384 + g * 4096 + lane;
    float nwa[4], nwx[4];
#pragma unroll
    for (int e = 0; e < 4; ++e) { nwa[e] = wa[e * 64]; nwx[e] = wx[e * 64]; }
    __syncthreads();
#pragma unroll
    for (int i = 0; i < 32; ++i) xcs[i * 256 + ch] = cb + (cw0 * bf2f(xr[i]) + cw1 * bf2f(xr[i + 1])) + (cw2 * bf2f(xr[i + 2]) + cw3 * bf2f(xr[i + 3]));
    __syncthreads();
    float aA[32], aX[32];
#pragma unroll
    for (int i = 0; i < 32; ++i) { aA[i] = 0.f; aX[i] = 0.f; }
#pragma unroll 1
    for (int k4 = 0; k4 < 16; ++k4) {
        const float wa0 = nwa[0], wa1 = nwa[1], wa2 = nwa[2], wa3 = nwa[3], wx0 = nwx[0], wx1 = nwx[1], wx2 = nwx[2], wx3 = nwx[3];
        const int kn = (k4 + 1) & 15;
#pragma unroll
        for (int e = 0; e < 4; ++e) { nwa[e] = wa[(kn * 4 + e) * 64]; nwx[e] = wx[(kn * 4 + e) * 64]; }
#pragma unroll
        for (int i = 0; i < 32; ++i) { const f32x4 xv = *(const f32x4*)(xcs + i * 256 + g * 64 + k4 * 4);
            aA[i] += (xv[0] * wa0 + xv[1] * wa1) + (xv[2] * wa2 + xv[3] * wa3); aX[i] += (xv[0] * wx0 + xv[1] * wx1) + (xv[2] * wx2 + xv[3] * wx3); }
    }
    const float ba = p.lru_ba[l * 256 + ch], bx = p.lru_bx[l * 256 + ch], lam = p.lru_lam[l * 256 + ch];
    const float sp = fmaxf(-lam, 0.f) + log1pf(__expf(-fabsf(lam)));
    float hh = 0.f, P = 1.f;
#pragma unroll
    for (int i = 0; i < 32; ++i) { const float r = sigmoid_f(aA[i] + ba), ig = sigmoid_f(aX[i] + bx); const float la = -8.f * r * sp; const float a = __expf(la);
        const float u = sqrtf(-expm1f(2.f * la)) * (ig * xcs[i * 256 + ch]); hh = a * hh + u; P *= a;
        lh[(size_t)(tok0 + i) * 256 + ch] = hh; lp[(size_t)(tok0 + i) * 256 + ch] = P; }
}

__device__ void lru3_item(const Params& p, int idx) {
    const int ch = tid_opq(); const int b = idx >> 7, c = idx & 127; const int tok0 = b * S + c * 32;
    const bf16_t* z = (const bf16_t*)(p.ws + WS_Z); bf16_t* mix = (bf16_t*)(p.ws + WS_U);
    const float* lh = (const float*)(p.ws + WS_LH); const float* lp = (const float*)(p.ws + WS_LP); const float* lc = (const float*)(p.ws + WS_LC);
    const float carry = lc[(size_t)(b * 128 + c) * 256 + ch];
    float hv[32], pv[32]; bf16_t gv[32];
#pragma unroll
    for (int i = 0; i < 32; ++i) { const size_t tok = (size_t)(tok0 + i); hv[i] = lh[tok * 256 + ch]; pv[i] = lp[tok * 256 + ch]; gv[i] = z[tok * ZP + C_BG + ch]; }
#pragma unroll
    for (int i = 0; i < 32; ++i) { const size_t tok = (size_t)(tok0 + i); mix[tok * 1024 + 256 + ch] = f2bf((hv[i] + pv[i] * carry) * silu_f(bf2f(gv[i]))); }
}

__device__ void dilc_item(const Params& p, int idx) {
    const int t = tid_opq(); const size_t tok = (size_t)idx * 8 + (t >> 5); const int chn = t & 31; const int h = chn >> 3;
    const bf16_t* z = (const bf16_t*)(p.ws + WS_Z); bf16_t* mix = (bf16_t*)(p.ws + WS_U);
    const bf16_t* dilo = (const bf16_t*)(p.ws + WS_DILO); const float* dill = (const float*)(p.ws + WS_DILL);
    const float l0 = dill[((size_t)0 * T + tok) * 4 + h], l1 = dill[((size_t)1 * T + tok) * 4 + h], l2 = dill[((size_t)2 * T + tok) * 4 + h];
    const float mx = fmaxf(l0, fmaxf(l1, l2)); float w0 = __expf(l0 - mx), w1 = __expf(l1 - mx), w2 = __expf(l2 - mx); const float inv = 1.f / (w0 + w1 + w2); w0 *= inv; w1 *= inv; w2 *= inv;
    const u32x4 o0 = *(const u32x4*)(dilo + ((size_t)0 * T + tok) * 256 + chn * 8), o1 = *(const u32x4*)(dilo + ((size_t)1 * T + tok) * 256 + chn * 8), o2 = *(const u32x4*)(dilo + ((size_t)2 * T + tok) * 256 + chn * 8);
    const u32x4 gv = *(const u32x4*)(z + tok * ZP + C_CG + chn * 8);
    u32x4 r;
#pragma unroll
    for (int e = 0; e < 4; ++e) {
        const float a = w0 * __uint_as_float(o0[e] << 16) + w1 * __uint_as_float(o1[e] << 16) + w2 * __uint_as_float(o2[e] << 16);
        const float bq = w0 * __uint_as_float(o0[e] & 0xffff0000u) + w1 * __uint_as_float(o1[e] & 0xffff0000u) + w2 * __uint_as_float(o2[e] & 0xffff0000u);
        r[e] = pack2(a * silu_f(__uint_as_float(gv[e] << 16)), bq * silu_f(__uint_as_float(gv[e] & 0xffff0000u)));
    }
    *(u32x4*)(mix + tok * 1024 + 512 + chn * 8) = r;
}

__device__ void m2_phase(const Params& p, char* smem) {
    float* gkv = (float*)(p.ws + WS_GKV); const float* gdec = (const float*)(p.ws + WS_GDEC);
    const float* lh = (const float*)(p.ws + WS_LH); const float* lp = (const float*)(p.ws + WS_LP); float* lc = (float*)(p.ws + WS_LC);
    float* aggP = (float*)smem; float* aggS = aggP + 256;
    const int t = tid_opq(); const int e = t & 31, seg = t >> 5;
    for (int it = blockIdx.x; it < 1024 + 32; it += gridDim.x) {
        float a[16], x[16];
        size_t ostride;
        float* outp;
        if (it < 1024) {
            const int gid = it * 32 + e; const int bh = gid >> 11, dv = gid & 2047, d = dv >> 6;
            float* base = gkv + (size_t)bh * 128 * 2048 + dv + (size_t)(seg * 16) * 2048; const float* dc = gdec + (size_t)bh * 128 * 32 + d + (seg * 16) * 32;
#pragma unroll
            for (int k = 0; k < 16; ++k) { x[k] = base[(size_t)k * 2048]; a[k] = dc[k * 32]; }
            outp = base; ostride = 2048;
        } else {
            const int i2 = it - 1024; const int b = i2 >> 3, ch = (i2 & 7) * 32 + e;
#pragma unroll
            for (int k = 0; k < 16; ++k) { const size_t ix = (size_t)(b * S + (seg * 16 + k) * 32 + 31) * 256 + ch; a[k] = lp[ix]; x[k] = lh[ix]; }
            outp = lc + (size_t)(b * 128 + seg * 16) * 256 + ch; ostride = 256;
        }
        float st = 0.f, pr = 1.f;
#pragma unroll
        for (int k = 0; k < 16; ++k) { const float ak = a[k], xk = x[k]; a[k] = pr; x[k] = st; st = ak * st + xk; pr *= ak; }
        __syncthreads();
        aggP[seg * 32 + e] = pr; aggS[seg * 32 + e] = st;
        __syncthreads();
        float carry = 0.f;
        for (int s2 = 0; s2 < seg; ++s2) carry = aggP[s2 * 32 + e] * carry + aggS[s2 * 32 + e];
#pragma unroll
        for (int k = 0; k < 16; ++k) outp[(size_t)k * ostride] = x[k] + a[k] * carry;
    }
}

__global__ void __launch_bounds__(256, 2) fwd_megakernel(Params p) {
    __shared__ __attribute__((aligned(16))) char smem[SMEM_BYTES];
    __shared__ uint4 xb_words;
    __shared__ int s_slot;
    cg::grid_group grid = cg::this_grid();
    if (p.out == nullptr) grid.sync();
    if (threadIdx.x == 0) xb_words = make_uint4(0u, 0u, 0u, 0u);
    __syncthreads();
    const XcdBarrier xb = xcd_barrier_post((unsigned*)(p.ws + WS_CTL), (volatile LAS unsigned*)&xb_words);
    unsigned* cnt = (unsigned*)(p.ws + WS_CNT);
    prologue_phase(p, smem);
    xcd_barrier(xb);
#pragma unroll 1
    for (int l = 0; l < DEPTH; ++l) {
        ln_phase(p, l);
        xcd_barrier(xb);
        g1_phase(p, l, smem);
        xcd_barrier(xb);
        for (;;) { const int it = next_item(cnt + (0 + l) * 64, &s_slot); if (it >= 2048) break; attn_item(p, it < 512 ? 0 : 1, it < 512 ? it : it - 512, smem); }
        for (;;) { const int it = next_item(cnt + (2 + l) * 64, &s_slot); if (it >= 512) break; gla1_item(p, l, it, smem); }
        for (;;) { const int it = next_item(cnt + (4 + l) * 64, &s_slot); if (it >= 512) break; lru1_item(p, l, it, smem); }
        xcd_barrier(xb);
        m2_phase(p, smem);
        xcd_barrier(xb);
        for (int it = blockIdx.x; it < 512; it += gridDim.x) gla3_item(p, l, it, smem);
        for (int it = blockIdx.x; it < 512; it += gridDim.x) lru3_item(p, it);
        for (int it = blockIdx.x; it < 2048; it += gridDim.x) dilc_item(p, it);
        xcd_barrier(xb);
        g2_phase(p, l, smem);
        xcd_barrier(xb);
    }
    ln_phase(p, DEPTH);
}

extern "C" void kernel_launch(void* const* d_in, const int* in_sizes, int n_in, void* d_out, int out_size, void* d_ws, size_t ws_size, hipStream_t stream) {
    static int grid_blocks = 0;
    if (!grid_blocks) {
        int dev = 0, cus = 0, per_cu = 0;
        hipGetDevice(&dev);
        hipDeviceGetAttribute(&cus, hipDeviceAttributeMultiprocessorCount, dev);
        hipOccupancyMaxActiveBlocksPerMultiprocessor(&per_cu, (const void*)fwd_megakernel, 256, 0);
        if (per_cu < 1) per_cu = 1;
        if (per_cu > 2) per_cu = 2;
        grid_blocks = cus * per_cu;
        if (ws_size < WS_END) fprintf(stderr, "kernel_launch: workspace too small: %zu < %zu\n", ws_size, (size_t)WS_END);
    }
    Params p{};
    p.x = (const float*)d_in[0]; p.c = (const float*)d_in[1]; p.pos = (const int*)d_in[2];
    p.w_mod = (const float*)d_in[3]; p.b_mod = (const float*)d_in[4]; p.w_in = (const float*)d_in[5];
    p.conv_w = (const float*)d_in[6]; p.conv_b = (const float*)d_in[7]; p.lru_wa = (const float*)d_in[8]; p.lru_ba = (const float*)d_in[9];
    p.lru_wx = (const float*)d_in[10]; p.lru_bx = (const float*)d_in[11]; p.lru_lam = (const float*)d_in[12];
    p.gla_wr = (const float*)d_in[13]; p.gla_br = (const float*)d_in[14]; p.gla_gn = (const float*)d_in[15];
    p.w_out = (const float*)d_in[16]; p.ln_g = (const float*)d_in[17]; p.ln_b = (const float*)d_in[18];
    p.out = (float*)d_out; p.ws = (unsigned char*)d_ws;
    (void)hipMemsetAsync(d_ws, 0, 32768, stream);
    void* args[] = {&p};
    hipError_t e = hipLaunchCooperativeKernel((const void*)fwd_megakernel, dim3(grid_blocks), dim3(256), args, 0, stream);
    if (e != hipSuccess) fprintf(stderr, "cooperative launch failed: %s (grid %d)\n", hipGetErrorString(e), grid_blocks);
}
```

```cpp
#include <hip/hip_runtime.h>
#include <hip/hip_cooperative_groups.h>
#include <cstdio>
#include <cstdint>
namespace cg = cooperative_groups;

typedef unsigned short bf16_t;
typedef short bf16x8 __attribute__((ext_vector_type(8)));
typedef short bf16x4 __attribute__((ext_vector_type(4)));
typedef float f32x4 __attribute__((ext_vector_type(4)));
typedef unsigned u32x4 __attribute__((ext_vector_type(4)));
typedef unsigned u32x2 __attribute__((ext_vector_type(2)));

constexpr int D = 1024, NB = 4, S = 4096, T = NB * S, DEPTH = 2;
constexpr int DIN = 3344, ZP = 3344, NPAD = 3456;
constexpr int C_AQ = 0, C_AK = 256, C_AV = 512, C_AG = 768, C_BX = 1024, C_BG = 1280, C_CQ = 1536, C_CK = 1792,
              C_CV = 2048, C_CG = 2304, C_DQ = 2560, C_DK = 2688, C_DV = 2816, C_DG = 3072, C_DR = 3328;
constexpr float DN_ALPHA = 1.4142135623730951f;
constexpr int LDP = 72;
constexpr int SMEM_BYTES = 65536;
constexpr int BIG = 1000000;

constexpr size_t WS_CTL = 0;
constexpr size_t WS_CNT = 16384;
constexpr size_t WS_WINT = 32768;
constexpr size_t WS_WOUTT = WS_WINT + (size_t)DEPTH * NPAD * 1024 * 2;
constexpr size_t WS_MOD = WS_WOUTT + (size_t)DEPTH * 1024 * 1024 * 2;
constexpr size_t WS_COS = WS_MOD + (size_t)DEPTH * NB * 3072 * 4;
constexpr size_t WS_SIN = WS_COS + (size_t)T * 32 * 4;
constexpr size_t WS_U = WS_SIN + (size_t)T * 32 * 4;
constexpr size_t WS_Z = WS_U + (size_t)T * 1024 * 2;
constexpr size_t WS_KPART = WS_Z + (size_t)T * ZP * 2;
constexpr size_t WS_DILO = WS_KPART + (size_t)256 * 256 * 4;
constexpr size_t WS_DILL = WS_DILO + (size_t)3 * T * 256 * 2;
constexpr size_t WS_GKV = WS_DILL + (size_t)3 * T * 4 * 4;
constexpr size_t WS_GDEC = WS_GKV + (size_t)2048 * 2048 * 4;
constexpr size_t WS_LH = WS_GDEC + (size_t)2048 * 32 * 4;
constexpr size_t WS_LP = WS_LH + (size_t)T * 256 * 4;
constexpr size_t WS_LC = WS_LP + (size_t)T * 256 * 4;
constexpr size_t WS_END = WS_LC + (size_t)NB * 128 * 256 * 4;

struct Params {
    const float *x, *c; const int* pos;
    const float *w_mod, *b_mod, *w_in, *conv_w, *conv_b, *lru_wa, *lru_ba, *lru_wx, *lru_bx, *lru_lam, *gla_wr, *gla_br, *gla_gn, *w_out, *ln_g, *ln_b;
    float* out; unsigned char* ws;
};

__device__ __forceinline__ float bf2f(bf16_t h) { return __uint_as_float(((unsigned)h) << 16); }
typedef __bf16 hbf16x2 __attribute__((ext_vector_type(2)));
typedef float f32x2 __attribute__((ext_vector_type(2)));
__device__ __forceinline__ unsigned pack2(float a, float b) { f32x2 v = {a, b}; hbf16x2 r = __builtin_convertvector(v, hbf16x2); return __builtin_bit_cast(unsigned, r); }
__device__ __forceinline__ bf16_t f2bf(float f) { return (bf16_t)(pack2(f, 0.f) & 0xffffu); }
__device__ __forceinline__ float silu_f(float x) { return x / (1.f + __expf(-x)); }
__device__ __forceinline__ float sigmoid_f(float x) { return 1.f / (1.f + __expf(-x)); }
__device__ __forceinline__ int tid_opq() { int t = threadIdx.x; asm volatile("" : "+v"(t)); return t; }
__device__ __forceinline__ float wsum(float v) {
#pragma unroll
    for (int o = 32; o; o >>= 1) v += __shfl_xor(v, o);
    return v;
}

#define XB_TMO      128
#define XB_XCNT(j)  (256  + 64 * (j))
#define XB_XSUB(j)  (1280 + 64 * (j))
#define XB_XGEN(j)  (2304 + 64 * (j))
#define XB_TOP      3328
#define XB_TOPGEN   3392
#define XCD_BAR_WORDS 3456
#define XB_SPIN_CAP (1u << 18)
#define LAS __attribute__((address_space(3)))
__device__ __forceinline__ unsigned xb_ld(unsigned* p)              { return __hip_atomic_load(p, __ATOMIC_RELAXED, __HIP_MEMORY_SCOPE_AGENT); }
__device__ __forceinline__ unsigned xb_add(unsigned* p, unsigned v) { return __hip_atomic_fetch_add(p, v, __ATOMIC_RELAXED, __HIP_MEMORY_SCOPE_AGENT); }
__device__ __forceinline__ unsigned xb_xcc_id() { return (unsigned)__builtin_amdgcn_s_getreg((3 << 11) | 20) & 0xFu; }
#define XB_SPIN(cond, bar) do { unsigned _sp = 0; while (cond) { __builtin_amdgcn_s_sleep(1); \
    if ((++_sp & 255u) == 0u) { if (xb_ld(&(bar)[XB_TMO])) break; if (_sp > XB_SPIN_CAP) { atomicAdd(&(bar)[XB_TMO], 1u); break; } } } } while (0)
struct XcdBarrier { unsigned* bar; unsigned x; volatile LAS unsigned* st; };
__device__ __forceinline__ XcdBarrier xcd_barrier_post(unsigned* bar, volatile LAS unsigned* st) {
    XcdBarrier b; b.bar = bar; b.x = xb_xcc_id(); b.st = st;
    if (threadIdx.x == 0) (void)xb_add(&bar[XB_XCNT(b.x)], 1u);
    return b;
}
__device__ __forceinline__ void xcd_barrier_complete(unsigned* bar, unsigned x, unsigned& nloc, unsigned& nx) {
    const unsigned G = gridDim.x * gridDim.y * gridDim.z;
    unsigned sum, cnt, mine, sp = 0u;
    for (;;) {
        sum = 0u; cnt = 0u; mine = 0u;
#pragma unroll
        for (unsigned j = 0; j < 16; ++j) { const unsigned c = xb_ld(&bar[XB_XCNT(j)]); sum += c; cnt += (c > 0u) ? 1u : 0u; mine = (j == x) ? c : mine; }
        if (sum == G) break;
        __builtin_amdgcn_s_sleep(1);
        if ((++sp & 255u) == 0u) { if (xb_ld(&bar[XB_TMO])) break; if (sp > XB_SPIN_CAP) { atomicAdd(&bar[XB_TMO], 1u); break; } }
    }
    nloc = mine > 0u ? mine : 1u; nx = cnt > 0u ? cnt : 1u;
}
__device__ __forceinline__ void xcd_barrier(const XcdBarrier& b) {
    asm volatile("s_waitcnt vmcnt(0)" ::: "memory");
    __syncthreads();
    if (threadIdx.x == 0) {
        unsigned* bar = b.bar;
        __builtin_amdgcn_s_waitcnt(0);
        unsigned nloc = b.st[0], nx = b.st[1];
        if (nloc == 0u) { xcd_barrier_complete(bar, b.x, nloc, nx); b.st[0] = nloc; b.st[1] = nx; }
        const unsigned old = xb_add(&bar[XB_XSUB(b.x)], 1u);
        const unsigned gen = old / nloc;
        if (old + 1u == (gen + 1u) * nloc) {
            __builtin_amdgcn_fence(__ATOMIC_RELEASE, "agent");
            asm volatile("s_waitcnt vmcnt(0)" ::: "memory");
            const unsigned og = xb_add(&bar[XB_TOP], 1u);
            const unsigned tg = og / nx;
            if (og + 1u == (tg + 1u) * nx) xb_add(&bar[XB_TOPGEN], 1u);
            else XB_SPIN(xb_ld(&bar[XB_TOPGEN]) == tg, bar);
            __builtin_amdgcn_fence(__ATOMIC_ACQUIRE, "agent");
            xb_add(&bar[XB_XGEN(b.x)], 1u);
            asm volatile("s_waitcnt vmcnt(0)" ::: "memory");
        } else {
            XB_SPIN(xb_ld(&bar[XB_XGEN(b.x)]) == gen, bar);
            __builtin_amdgcn_fence(__ATOMIC_ACQUIRE, "agent");
            asm volatile("s_waitcnt vmcnt(0)" ::: "memory");
        }
    }
    __syncthreads();
}
__device__ __forceinline__ int next_item(unsigned* ctr, volatile int* slot) {
    __syncthreads();
    if (threadIdx.x == 0) *slot = (int)atomicAdd(ctr, 1u);
    __syncthreads();
    return *slot;
}

__device__ void prologue_phase(const Params& p, char* smem) {
    const int t = tid_opq();
    bf16_t* WinT = (bf16_t*)(p.ws + WS_WINT); bf16_t* WoutT = (bf16_t*)(p.ws + WS_WOUTT);
    float* mod = (float*)(p.ws + WS_MOD); float* cosT = (float*)(p.ws + WS_COS); float* sinT = (float*)(p.ws + WS_SIN);
    float* tl = (float*)smem;
    constexpr int N_TIN = DEPTH * 16 * 54, N_TOUT = DEPTH * 16 * 16, N_MOD = DEPTH * 192, N_ROPE = T * 32 / 256;
    constexpr int NITEMS = N_TIN + N_TOUT + N_MOD + N_ROPE;
    for (int it = blockIdx.x; it < NITEMS; it += gridDim.x) {
        if (it < N_TIN + N_TOUT) {
            const float* src; bf16_t* dst; int ncols, kt, nt;
            if (it < N_TIN) { int l = it / (16 * 54), r = it % (16 * 54); kt = r / 54; nt = r % 54; src = p.w_in + (size_t)l * 1024 * DIN; dst = WinT + (size_t)l * NPAD * 1024; ncols = DIN; }
            else { int i2 = it - N_TIN; int l = i2 / 256, r = i2 % 256; kt = r / 16; nt = r % 16; src = p.w_out + (size_t)l * 1024 * 1024; dst = WoutT + (size_t)l * 1024 * 1024; ncols = 1024; }
            __syncthreads();
            { const int c = t & 63, r0 = t >> 6; const int n = nt * 64 + c;
#pragma unroll
              for (int i = 0; i < 16; ++i) { int r = r0 + 4 * i; tl[r * 65 + c] = (n < ncols) ? src[(size_t)(kt * 64 + r) * ncols + n] : 0.f; } }
            __syncthreads();
            { const int kk = t & 63, n0 = t >> 6;
#pragma unroll
              for (int i = 0; i < 16; ++i) { int n = n0 + 4 * i; dst[(size_t)(nt * 64 + n) * 1024 + kt * 64 + kk] = f2bf(tl[kk * 65 + n]); } }
        } else if (it < N_TIN + N_TOUT + N_MOD) {
            const int i2 = it - N_TIN - N_TOUT; const int l = i2 / 192, jg = i2 % 192;
            const int jj = t & 15, ks = t >> 4; const int j = jg * 16 + jj;
            float a0 = 0.f, a1 = 0.f, a2 = 0.f, a3 = 0.f;
            const float* wm = p.w_mod + (size_t)l * 1024 * 3072 + j;
#pragma unroll 8
            for (int k = ks * 64; k < ks * 64 + 64; ++k) { float wv = wm[(size_t)k * 3072]; a0 += p.c[k] * wv; a1 += p.c[1024 + k] * wv; a2 += p.c[2048 + k] * wv; a3 += p.c[3072 + k] * wv; }
            __syncthreads();
            tl[(0 * 16 + ks) * 16 + jj] = a0; tl[(1 * 16 + ks) * 16 + jj] = a1; tl[(2 * 16 + ks) * 16 + jj] = a2; tl[(3 * 16 + ks) * 16 + jj] = a3;
            __syncthreads();
            if (t < 64) { const int b = t >> 4, j2 = t & 15; float s = 0.f;
#pragma unroll
              for (int k2 = 0; k2 < 16; ++k2) s += tl[(b * 16 + k2) * 16 + j2];
              mod[((size_t)l * NB + b) * 3072 + jg * 16 + j2] = s + p.b_mod[l * 3072 + jg * 16 + j2]; }
        } else {
            const int i2 = it - N_TIN - N_TOUT - N_MOD; const int e = i2 * 256 + t; const int tok = e >> 5, f = e & 31;
            const float inv = exp2f(-(float)f * (13.287712379549449f / 32.f));
            const float ang = (float)p.pos[tok] * inv;
            double rev = (double)ang * 0.15915494309189535; rev -= __builtin_rint(rev);
            const float rr = (float)rev; cosT[e] = __builtin_amdgcn_cosf(rr); sinT[e] = __builtin_amdgcn_sinf(rr);
        }
    }
}

__device__ void ln_phase(const Params& p, int l) {
    const int t = tid_opq(), lane = t & 63, w = t >> 6;
    bf16_t* ubuf = (bf16_t*)(p.ws + WS_U); const float* mod = (const float*)(p.ws + WS_MOD);
    for (int rg = blockIdx.x; rg < T / 16; rg += gridDim.x) {
        f32x4 v[4][4];
#pragma unroll
        for (int r = 0; r < 4; ++r) { const int row = rg * 16 + w * 4 + r; const float* src = (l <= 1) ? p.x + (size_t)row * 1024 : p.out + (size_t)row * 1024;
#pragma unroll
            for (int i = 0; i < 4; ++i) v[r][i] = *(const f32x4*)(src + i * 256 + lane * 4);
            if (l > 0) {
                const bf16_t* yr = (const bf16_t*)(p.ws + WS_Z) + (size_t)row * 1024; const float* gate = mod + ((size_t)(l - 1) * NB + row / S) * 3072 + 2048;
#pragma unroll
                for (int i = 0; i < 4; ++i) { const u32x2 yv = *(const u32x2*)(yr + i * 256 + lane * 4); const f32x4 g1 = *(const f32x4*)(gate + i * 256 + lane * 4) + 1.f;
                    const f32x4 yf = {__uint_as_float(yv.x << 16), __uint_as_float(yv.x & 0xffff0000u), __uint_as_float(yv.y << 16), __uint_as_float(yv.y & 0xffff0000u)};
                    v[r][i] = v[r][i] * DN_ALPHA + g1 * yf; }
            } }
#pragma unroll
        for (int r = 0; r < 4; ++r) {
            const int row = rg * 16 + w * 4 + r; const int b = row / S;
            if (l > 0) {
                float s = 0.f;
#pragma unroll
                for (int i = 0; i < 4; ++i) s += (v[r][i][0] + v[r][i][1]) + (v[r][i][2] + v[r][i][3]);
                const float mu = wsum(s) * (1.f / 1024.f); float q = 0.f;
#pragma unroll
                for (int i = 0; i < 4; ++i) { f32x4 d = v[r][i] - mu; q += (d[0] * d[0] + d[1] * d[1]) + (d[2] * d[2] + d[3] * d[3]); }
                const float rstd = rsqrtf(wsum(q) * (1.f / 1024.f) + 1e-5f);
#pragma unroll
                for (int i = 0; i < 4; ++i) { const f32x4 g = *(const f32x4*)(p.ln_g + (l - 1) * 1024 + i * 256 + lane * 4), bb = *(const f32x4*)(p.ln_b + (l - 1) * 1024 + i * 256 + lane * 4);
                    v[r][i] = (v[r][i] - mu) * rstd * g + bb; *(f32x4*)(p.out + (size_t)row * 1024 + i * 256 + lane * 4) = v[r][i]; }
            }
            if (l < DEPTH) {
                float s = 0.f;
#pragma unroll
                for (int i = 0; i < 4; ++i) s += (v[r][i][0] + v[r][i][1]) + (v[r][i][2] + v[r][i][3]);
                const float mu = wsum(s) * (1.f / 1024.f); float q = 0.f;
#pragma unroll
                for (int i = 0; i < 4; ++i) { f32x4 d = v[r][i] - mu; q += (d[0] * d[0] + d[1] * d[1]) + (d[2] * d[2] + d[3] * d[3]); }
                const float rstd = rsqrtf(wsum(q) * (1.f / 1024.f) + 1e-5f);
                const float* mb = mod + ((size_t)l * NB + b) * 3072;
#pragma unroll
                for (int i = 0; i < 4; ++i) { const int col = i * 256 + lane * 4; const f32x4 sh = *(const f32x4*)(mb + col), sc = *(const f32x4*)(mb + 1024 + col);
                    f32x4 u = (v[r][i] - mu) * rstd * (sc + 1.f) + sh; u32x2 pk; pk.x = pack2(u[0], u[1]); pk.y = pack2(u[2], u[3]);
                    *(u32x2*)(ubuf + (size_t)row * 1024 + col) = pk; }
            }
        }
    }
}

__device__ __forceinline__ int lds_off(int r, int c8) {
    const int st = (r >> 4) * 2 + (c8 >> 2); const int ob = (r & 15) * 64 + (c8 & 3) * 16;
    return st * 1024 + (ob ^ (((ob >> 9) & 1) << 5));
}
struct RegSet { u32x4 a[4], b[4]; };
__device__ __forceinline__ void gemm_tile(const bf16_t* __restrict__ A, const bf16_t* __restrict__ Bt, int tm, int tn, bool first, bool has_next, int ntm, int ntn,
                                          char* sm, f32x4 (&acc)[4][4], RegSet& r0, RegSet& r1) {
    const int t = tid_opq(), lane = t & 63, w = t >> 6, wm = w >> 1, wn = w & 1, r16 = lane & 15, quad = lane >> 4;
    const int lrow = t >> 3, lch = t & 7;
    constexpr int BUF = 32768;
    const bf16_t* Ag = A + (size_t)(tm * 128 + lrow) * 1024 + lch * 8;
    const bf16_t* Bg = Bt + (size_t)(tn * 128 + lrow) * 1024 + lch * 8;
    const bf16_t* nAg = A + (size_t)(ntm * 128 + lrow) * 1024 + lch * 8;
    const bf16_t* nBg = Bt + (size_t)(ntn * 128 + lrow) * 1024 + lch * 8;
    int woff[4];
#pragma unroll
    for (int i = 0; i < 4; ++i) woff[i] = lds_off(lrow + 32 * i, lch);
    const int fo = lds_off(r16, quad);
#pragma unroll
    for (int a = 0; a < 4; ++a)
#pragma unroll
        for (int b = 0; b < 4; ++b) acc[a][b] = (f32x4){0.f, 0.f, 0.f, 0.f};
    if (first) {
#pragma unroll
        for (int i = 0; i < 4; ++i) { r0.a[i] = *(const u32x4*)(Ag + (size_t)i * 32 * 1024); r0.b[i] = *(const u32x4*)(Bg + (size_t)i * 32 * 1024); }
#pragma unroll
        for (int i = 0; i < 4; ++i) { r1.a[i] = *(const u32x4*)(Ag + (size_t)i * 32 * 1024 + 64); r1.b[i] = *(const u32x4*)(Bg + (size_t)i * 32 * 1024 + 64); }
        __syncthreads();
#pragma unroll
        for (int i = 0; i < 4; ++i) { *(u32x4*)(sm + woff[i]) = r0.a[i]; *(u32x4*)(sm + 16384 + woff[i]) = r0.b[i]; }
#pragma unroll
        for (int i = 0; i < 4; ++i) { r0.a[i] = *(const u32x4*)(Ag + (size_t)i * 32 * 1024 + 128); r0.b[i] = *(const u32x4*)(Bg + (size_t)i * 32 * 1024 + 128); }
    }
    __syncthreads();
    auto step = [&](int kt, RegSet& rs) {
        const char* sA = sm + (kt & 1) * BUF; const char* sB = sA + 16384;
        char* nA = sm + ((kt + 1) & 1) * BUF; char* nB = nA + 16384;
        if (kt + 1 < 16 || has_next) {
#pragma unroll
            for (int i = 0; i < 4; ++i) { *(u32x4*)(nA + woff[i]) = rs.a[i]; *(u32x4*)(nB + woff[i]) = rs.b[i]; }
        }
        if (kt + 3 < 16) {
#pragma unroll
            for (int i = 0; i < 4; ++i) { rs.a[i] = *(const u32x4*)(Ag + (size_t)i * 32 * 1024 + (kt + 3) * 64); rs.b[i] = *(const u32x4*)(Bg + (size_t)i * 32 * 1024 + (kt + 3) * 64); }
        } else if (has_next) {
#pragma unroll
            for (int i = 0; i < 4; ++i) { rs.a[i] = *(const u32x4*)(nAg + (size_t)i * 32 * 1024 + (kt - 13) * 64); rs.b[i] = *(const u32x4*)(nBg + (size_t)i * 32 * 1024 + (kt - 13) * 64); }
        }
        __builtin_amdgcn_sched_barrier(0);
#pragma unroll
        for (int ks = 0; ks < 2; ++ks) {
            bf16x8 af[4], bfr[4];
#pragma unroll
            for (int mt = 0; mt < 4; ++mt) af[mt] = *(const bf16x8*)(sA + ((wm * 4 + mt) * 2 + ks) * 1024 + fo);
#pragma unroll
            for (int nt = 0; nt < 4; ++nt) bfr[nt] = *(const bf16x8*)(sB + ((wn * 4 + nt) * 2 + ks) * 1024 + fo);
#pragma unroll
            for (int mt = 0; mt < 4; ++mt)
#pragma unroll
                for (int nt = 0; nt < 4; ++nt) acc[mt][nt] = __builtin_amdgcn_mfma_f32_16x16x32_bf16(bfr[nt], af[mt], acc[mt][nt], 0, 0, 0);
        }
        __syncthreads();
    };
    for (int k2 = 0; k2 < 8; ++k2) { step(2 * k2, r1); step(2 * k2 + 1, r0); }
}

__device__ void g1_phase(const Params& p, int l, char* smem) {
    const int t = tid_opq(), lane = t & 63, w = t >> 6, wm = w >> 1, wn = w & 1, r16 = lane & 15, quad = lane >> 4;
    char* sm = smem; char* sC = smem + 32768;
    const bf16_t* ubuf = (const bf16_t*)(p.ws + WS_U); const bf16_t* WinT = (const bf16_t*)(p.ws + WS_WINT) + (size_t)l * NPAD * 1024;
    bf16_t* z = (bf16_t*)(p.ws + WS_Z); float* kpart = (float*)(p.ws + WS_KPART);
    const float* cosT = (const float*)(p.ws + WS_COS); const float* sinT = (const float*)(p.ws + WS_SIN);
    const bool xo = (gridDim.x & 7) == 0; const int xcd = blockIdx.x & 7, nloc = xo ? (int)(gridDim.x >> 3) : (int)gridDim.x, j0 = xo ? (int)(blockIdx.x >> 3) : (int)blockIdx.x;
    const int lim = xo ? 16 * 27 : 128 * 27;
    RegSet r0, r1;
    for (int L = j0; L < lim; L += nloc) {
        const int tm = xo ? xcd * 16 + (L & 15) : L / 27, tn = xo ? (L >> 4) : L % 27;
        const int L2 = L + nloc; const bool has_next = L2 < lim;
        const int ntm = has_next ? (xo ? xcd * 16 + (L2 & 15) : L2 / 27) : tm, ntn = has_next ? (xo ? (L2 >> 4) : L2 % 27) : tn;
        f32x4 acc[4][4];
        gemm_tile(ubuf, WinT, tm, tn, L == j0, has_next, ntm, ntn, sm, acc, r0, r1);
        const bool rope = (tn < 4) || (tn >= 12 && tn < 16);
        if (rope) {
#pragma unroll
            for (int mt = 0; mt < 4; ++mt) {
                const int tok = tm * 128 + wm * 64 + mt * 16 + r16;
#pragma unroll
                for (int nt = 0; nt < 2; ++nt) {
                    const f32x4 cs = *(const f32x4*)(cosT + (size_t)tok * 32 + nt * 16 + quad * 4), sn = *(const f32x4*)(sinT + (size_t)tok * 32 + nt * 16 + quad * 4);
                    const f32x4 x1 = acc[mt][nt], x2 = acc[mt][nt + 2];
                    acc[mt][nt] = x1 * cs - x2 * sn; acc[mt][nt + 2] = x1 * sn + x2 * cs;
                }
            }
        }
        if (tn == 2 || tn == 3) {
#pragma unroll
            for (int nt = 0; nt < 4; ++nt) {
                f32x4 sv = (acc[0][nt] + acc[1][nt]) + (acc[2][nt] + acc[3][nt]);
#pragma unroll
                for (int jj = 0; jj < 4; ++jj) { float sx = sv[jj]; sx += __shfl_xor(sx, 1); sx += __shfl_xor(sx, 2); sx += __shfl_xor(sx, 4); sx += __shfl_xor(sx, 8); sv[jj] = sx; }
                if (r16 == 0) *(f32x4*)(kpart + (size_t)(tm * 2 + wm) * 256 + (tn - 2) * 128 + wn * 64 + nt * 16 + quad * 4) = sv;
            }
        }
#pragma unroll
        for (int mt = 0; mt < 4; ++mt)
#pragma unroll
            for (int nt = 0; nt < 4; ++nt) { u32x2 pk; pk.x = pack2(acc[mt][nt][0], acc[mt][nt][1]); pk.y = pack2(acc[mt][nt][2], acc[mt][nt][3]);
                const int row = wm * 64 + mt * 16 + r16; const int c16 = wn * 8 + nt * 2 + (quad >> 1);
                *(u32x2*)(sC + row * 256 + ((c16 ^ (row & 15)) << 4) + (quad & 1) * 8) = pk; }
        __syncthreads();
#pragma unroll
        for (int i = 0; i < 8; ++i) { const int c = t + 256 * i; const int row = c >> 4, ch = c & 15; const int col = tn * 128 + ch * 8;
            if (col < DIN) *(u32x4*)(z + (size_t)(tm * 128 + row) * ZP + col) = *(const u32x4*)(sC + row * 256 + ((ch ^ (row & 15)) << 4)); }
    }
}

__device__ void g2_phase(const Params& p, int l, char* smem) {
    const int t = tid_opq(), lane = t & 63, w = t >> 6, wm = w >> 1, wn = w & 1, r16 = lane & 15, quad = lane >> 4;
    char* sm = smem; char* sC = smem + 32768;
    const bf16_t* mix = (const bf16_t*)(p.ws + WS_U); const bf16_t* WoutT = (const bf16_t*)(p.ws + WS_WOUTT) + (size_t)l * 1024 * 1024;
    bf16_t* ybuf = (bf16_t*)(p.ws + WS_Z);
    const bool xo = (gridDim.x & 7) == 0; const int xcd = blockIdx.x & 7, nloc = xo ? (int)(gridDim.x >> 3) : (int)gridDim.x, j0 = xo ? (int)(blockIdx.x >> 3) : (int)blockIdx.x;
    const int lim = xo ? 16 * 8 : 128 * 8;
    RegSet r0, r1;
    for (int L = j0; L < lim; L += nloc) {
        const int tm = xo ? xcd * 16 + (L & 15) : (L >> 3), tn = xo ? (L >> 4) : (L & 7);
        const int L2 = L + nloc; const bool has_next = L2 < lim;
        const int ntm = has_next ? (xo ? xcd * 16 + (L2 & 15) : (L2 >> 3)) : tm, ntn = has_next ? (xo ? (L2 >> 4) : (L2 & 7)) : tn;
        f32x4 acc[4][4];
        gemm_tile(mix, WoutT, tm, tn, L == j0, has_next, ntm, ntn, sm, acc, r0, r1);
#pragma unroll
        for (int mt = 0; mt < 4; ++mt)
#pragma unroll
            for (int nt = 0; nt < 4; ++nt) { u32x2 pk; pk.x = pack2(acc[mt][nt][0], acc[mt][nt][1]); pk.y = pack2(acc[mt][nt][2], acc[mt][nt][3]);
                const int row = wm * 64 + mt * 16 + r16; const int c16 = wn * 8 + nt * 2 + (quad >> 1);
                *(u32x2*)(sC + row * 256 + ((c16 ^ (row & 15)) << 4) + (quad & 1) * 8) = pk; }
        __syncthreads();
#pragma unroll
        for (int i = 0; i < 8; ++i) { const int c = t + 256 * i; const int row = c >> 4, ch = c & 15;
            *(u32x4*)(ybuf + (size_t)(tm * 128 + row) * 1024 + tn * 128 + ch * 8) = *(const u32x4*)(sC + row * 256 + ((ch ^ (row & 15)) << 4)); }
    }
}

constexpr float ATT_SC = 0.18033688011112042f;
__device__ __forceinline__ void attn_tile(const bf16_t* sK, const bf16_t* sV, const bf16x8 (&qf)[2][2], int lo, int hi, bool full, bool hasq, bool qfl0, bool qfl1,
                                          float (&m)[2], float (&l)[2], f32x4 (&O)[2][4], int wq0) {
    const int lane = tid_opq() & 63, r16 = lane & 15, quad = lane >> 4;
    f32x4 s[2][4];
#pragma unroll
    for (int a = 0; a < 2; ++a)
#pragma unroll
        for (int b = 0; b < 4; ++b) s[a][b] = (f32x4){0.f, 0.f, 0.f, 0.f};
#pragma unroll
    for (int ks = 0; ks < 2; ++ks)
#pragma unroll
        for (int k16 = 0; k16 < 4; ++k16) {
            const bf16x8 kf = *(const bf16x8*)(sK + (k16 * 16 + r16) * LDP + ks * 32 + quad * 8);
#pragma unroll
            for (int qt = 0; qt < 2; ++qt) s[qt][k16] = __builtin_amdgcn_mfma_f32_16x16x32_bf16(kf, qf[qt][ks], s[qt][k16], 0, 0, 0);
        }
#pragma unroll
    for (int qt = 0; qt < 2; ++qt) {
        const int ql = wq0 + qt * 16 + r16; const bool qfl = qt ? qfl1 : qfl0;
        if (!full) {
#pragma unroll
            for (int k16 = 0; k16 < 4; ++k16)
#pragma unroll
                for (int j = 0; j < 4; ++j) { const int dd = ql - (k16 * 16 + quad * 4 + j); const bool valid = dd >= lo && dd <= hi; s[qt][k16][j] = valid ? s[qt][k16][j] : -1e30f; }
        }
        if (hasq) {
#pragma unroll
            for (int k16 = 0; k16 < 4; ++k16)
#pragma unroll
                for (int j = 0; j < 4; ++j) s[qt][k16][j] = qfl ? s[qt][k16][j] : -1e30f;
        }
        float mx = -1e30f;
#pragma unroll
        for (int k16 = 0; k16 < 4; ++k16) mx = fmaxf(mx, fmaxf(fmaxf(s[qt][k16][0], s[qt][k16][1]), fmaxf(s[qt][k16][2], s[qt][k16][3])));
        mx = fmaxf(mx, __shfl_xor(mx, 16)); mx = fmaxf(mx, __shfl_xor(mx, 32));
        const float mn = fmaxf(m[qt], mx); const float alpha = __builtin_amdgcn_exp2f((m[qt] - mn) * ATT_SC); m[qt] = mn;
        const float mb = (mn < -1e29f) ? 0.f : mn * ATT_SC;
        float ps = 0.f;
#pragma unroll
        for (int k16 = 0; k16 < 4; ++k16)
#pragma unroll
            for (int j = 0; j < 4; ++j) { const float pv = __builtin_amdgcn_exp2f(s[qt][k16][j] * ATT_SC - mb); ps += pv; s[qt][k16][j] = pv; }
        l[qt] = l[qt] * alpha + ps;
#pragma unroll
        for (int dt = 0; dt < 4; ++dt) O[qt][dt] = O[qt][dt] * alpha;
    }
#pragma unroll
    for (int G = 0; G < 2; ++G) {
        bf16x8 pf[2];
#pragma unroll
        for (int qt = 0; qt < 2; ++qt) {
            const unsigned a0 = pack2(s[qt][G * 2][0], s[qt][G * 2][1]), a1 = pack2(s[qt][G * 2][2], s[qt][G * 2][3]);
            const unsigned a2 = pack2(s[qt][G * 2 + 1][0], s[qt][G * 2 + 1][1]), a3 = pack2(s[qt][G * 2 + 1][2], s[qt][G * 2 + 1][3]);
            u32x4 pk = {a0, a1, a2, a3}; pf[qt] = __builtin_bit_cast(bf16x8, pk);
        }
#pragma unroll
        for (int dt = 0; dt < 4; ++dt) {
            const bf16_t* v0p = sV + (G * 32 + quad * 4 + (r16 >> 2)) * LDP + dt * 16 + (r16 & 3) * 4;
            const bf16x4 v0 = __builtin_amdgcn_ds_read_tr16_b64_v4i16((__attribute__((address_space(3))) bf16x4*)(v0p));
            const bf16x4 v1 = __builtin_amdgcn_ds_read_tr16_b64_v4i16((__attribute__((address_space(3))) bf16x4*)(v0p + 16 * LDP));
            const bf16x8 vf = {v0[0], v0[1], v0[2], v0[3], v1[0], v1[1], v1[2], v1[3]};
#pragma unroll
            for (int qt = 0; qt < 2; ++qt) O[qt][dt] = __builtin_amdgcn_mfma_f32_16x16x32_bf16(vf, pf[qt], O[qt][dt], 0, 0, 0);
        }
    }
}

__device__ void attn_item(const Params& p, int kind, int idx, char* smem) {
    const int t = tid_opq(), lane = t & 63, w = t >> 6, r16 = lane & 15, quad = lane >> 4;
    bf16_t* sK = (bf16_t*)smem; bf16_t* sV = sK + 64 * LDP;
    float* kmean = (float*)(smem + 18432); float* gates = (float*)(smem + 22528); unsigned* selm = (unsigned*)(smem + 30720);
    int4* desc = (int4*)(smem + 31232); int* misc = (int*)(smem + 32320);
    const bf16_t* z = (const bf16_t*)(p.ws + WS_Z);
    int b, h, qbase, stride, qcol, kcol, vcol, cfg = 0;
    __syncthreads();
    if (kind == 0) {
        const int n = 15 - (idx >> 5); const int rem = idx & 31; b = rem >> 3; h = (rem >> 1) & 3; const int qh = rem & 1;
        qbase = b * S + n * 256 + qh * 128; stride = 1; qcol = C_AQ + h * 64; kcol = C_AK + h * 64; vcol = C_AV + h * 64;
        const float* kpart = (const float*)(p.ws + WS_KPART);
        for (int e = t; e < n * 64; e += 256) { const int j = e >> 6, d = e & 63; const float* kp = kpart + (size_t)(b * 64 + j * 4) * 256 + h * 64 + d;
            kmean[e] = ((kp[0] + kp[256]) + (kp[512] + kp[768])) * (1.f / 256.f); }
        if (t == 0) misc[1] = 0;
        __syncthreads();
        {
            const int ql = t >> 1, half = t & 1; const bf16_t* qp = z + (size_t)(qbase + ql) * ZP + qcol;
            float g[8];
#pragma unroll
            for (int jj = 0; jj < 8; ++jj) g[jj] = 0.f;
#pragma unroll 1
            for (int dc = 0; dc < 8; ++dc) {
                const u32x4 qv = *(const u32x4*)(qp + dc * 8); float qq[8];
#pragma unroll
                for (int e = 0; e < 4; ++e) { qq[2 * e] = __uint_as_float(qv[e] << 16); qq[2 * e + 1] = __uint_as_float(qv[e] & 0xffff0000u); }
#pragma unroll
                for (int jj = 0; jj < 8; ++jj) { const int j = half + 2 * jj; if (j < n) { const float* km = kmean + j * 64 + dc * 8;
#pragma unroll
                    for (int e = 0; e < 8; ++e) g[jj] += qq[e] * km[e]; } }
            }
#pragma unroll
            for (int jj = 0; jj < 8; ++jj) gates[ql * 16 + half + 2 * jj] = g[jj];
        }
        __syncthreads();
        if (t < 128) {
            unsigned msk = 0;
            for (int k = 0; k < 3 && k < n; ++k) { float best = -3.0e38f; int bi = -1;
                for (int j = 0; j < n; ++j) if (!((msk >> j) & 1u)) { const float gv = gates[t * 16 + j]; if (gv > best) { best = gv; bi = j; } }
                if (bi >= 0) msk |= 1u << bi; }
            selm[t] = msk; atomicOr((unsigned*)&misc[1], msk);
        }
        __syncthreads();
        if (t == 0) {
            int nd = 0; const unsigned bm = (unsigned)misc[1];
            for (int kt = 0; kt <= qh * 2 + 1; ++kt) desc[nd++] = make_int4(b * S + n * 256 + kt * 64, kt * 64 - qh * 128, BIG, -1);
            for (int j = 0; j < n; ++j) if ((bm >> j) & 1u) for (int kt = 0; kt < 4; ++kt) desc[nd++] = make_int4(b * S + j * 256 + kt * 64, -BIG, BIG, j);
            misc[0] = nd;
        }
    } else {
        cfg = idx >> 9; const int rem = idx & 511; b = rem >> 7; h = (rem >> 5) & 3; const int rb = rem & 31;
        const int dil = 1 << (2 * cfg); const int res = rb & (dil - 1), blk = rb >> (2 * cfg);
        qbase = b * S + blk * 128 * dil + res; stride = dil; qcol = C_CQ + h * 64; kcol = C_CK + h * 64; vcol = C_CV + h * 64;
        if (t < 128) selm[t] = 0xffffffffu;
        if (t == 0) { int nd = 0; for (int kt = (blk == 0 ? 2 : 0); kt < 4; ++kt) desc[nd++] = make_int4(b * S + (blk * 128 - 128 + kt * 64) * dil + res, kt * 64 - 128, kt * 64, -1); misc[0] = nd; }
    }
    __syncthreads();
    const int nd = misc[0];
    bf16x8 qf[2][2];
#pragma unroll
    for (int qt = 0; qt < 2; ++qt)
#pragma unroll
        for (int ks = 0; ks < 2; ++ks) qf[qt][ks] = *(const bf16x8*)(z + (size_t)(qbase + (w * 32 + qt * 16 + r16) * stride) * ZP + qcol + ks * 32 + quad * 8);
    const unsigned sel0 = selm[w * 32 + r16], sel1 = selm[w * 32 + 16 + r16];
    float m[2] = {-1e30f, -1e30f}, l[2] = {0.f, 0.f}; f32x4 O[2][4];
#pragma unroll
    for (int a = 0; a < 2; ++a)
#pragma unroll
        for (int c = 0; c < 4; ++c) O[a][c] = (f32x4){0.f, 0.f, 0.f, 0.f};
    const int lrow = t >> 2, lch = (t & 3) * 2;
    u32x4 rk0, rk1, rv0, rv1;
    if (nd > 0) { const int4 d = desc[0]; const bf16_t* rp = z + (size_t)(d.x + lrow * stride) * ZP + lch * 8;
        rk0 = *(const u32x4*)(rp + kcol); rk1 = *(const u32x4*)(rp + kcol + 8); rv0 = *(const u32x4*)(rp + vcol); rv1 = *(const u32x4*)(rp + vcol + 8); }
    for (int i = 0; i < nd; ++i) {
        __syncthreads();
        *(u32x4*)(sK + lrow * LDP + lch * 8) = rk0; *(u32x4*)(sK + lrow * LDP + lch * 8 + 8) = rk1;
        *(u32x4*)(sV + lrow * LDP + lch * 8) = rv0; *(u32x4*)(sV + lrow * LDP + lch * 8 + 8) = rv1;
        __syncthreads();
        if (i + 1 < nd) { const int4 d = desc[i + 1]; const bf16_t* rp = z + (size_t)(d.x + lrow * stride) * ZP + lch * 8;
            rk0 = *(const u32x4*)(rp + kcol); rk1 = *(const u32x4*)(rp + kcol + 8); rv0 = *(const u32x4*)(rp + vcol); rv1 = *(const u32x4*)(rp + vcol + 8); }
        const int4 d = desc[i];
        bool need = (w * 32 + 31 >= d.y) && (w * 32 - 63 <= d.z);
        bool q0 = true, q1 = true;
        if (d.w >= 0) { q0 = (sel0 >> d.w) & 1u; q1 = (sel1 >> d.w) & 1u; need = need && (__ballot(q0 || q1) != 0ull); }
        const bool full = (w * 32 - 63 >= d.y) && (w * 32 + 31 <= d.z);
        if (need) attn_tile(sK, sV, qf, d.y, d.z, full, d.w >= 0, q0, q1, m, l, O, w * 32);
    }
#pragma unroll
    for (int qt = 0; qt < 2; ++qt) {
        float lt = l[qt]; lt += __shfl_xor(lt, 16); lt += __shfl_xor(lt, 32);
        const float inv = 1.f / lt; const size_t tok = (size_t)(qbase + (w * 32 + qt * 16 + r16) * stride);
        if (kind == 0) {
            bf16_t* mix = (bf16_t*)(p.ws + WS_U);
#pragma unroll
            for (int dt = 0; dt < 4; ++dt) { const int d0 = dt * 16 + quad * 4; const u32x2 gv = *(const u32x2*)(z + tok * ZP + C_AG + h * 64 + d0);
                const float g0 = __uint_as_float(gv.x << 16), g1 = __uint_as_float(gv.x & 0xffff0000u), g2 = __uint_as_float(gv.y << 16), g3 = __uint_as_float(gv.y & 0xffff0000u);
                u32x2 o; o.x = pack2(O[qt][dt][0] * inv * silu_f(g0), O[qt][dt][1] * inv * silu_f(g1)); o.y = pack2(O[qt][dt][2] * inv * silu_f(g2), O[qt][dt][3] * inv * silu_f(g3));
                *(u32x2*)(mix + tok * 1024 + h * 64 + d0) = o; }
        } else {
            bf16_t* dilo = (bf16_t*)(p.ws + WS_DILO); float* dill = (float*)(p.ws + WS_DILL);
#pragma unroll
            for (int dt = 0; dt < 4; ++dt) { const int d0 = dt * 16 + quad * 4; u32x2 o; o.x = pack2(O[qt][dt][0] * inv, O[qt][dt][1] * inv); o.y = pack2(O[qt][dt][2] * inv, O[qt][dt][3] * inv);
                *(u32x2*)(dilo + ((size_t)cfg * T + tok) * 256 + h * 64 + d0) = o; }
            if (quad == 0) dill[((size_t)cfg * T + tok) * 4 + h] = m[qt] * 0.125f + __logf(lt);
        }
    }
}

__device__ __forceinline__ void gla_bcum(const Params& p, int l, const bf16_t* z, int tok0, float* bc, float* drs) {
    const int t = tid_opq();
    const int hd = t & 127, ih = t >> 7;
    float wr[16];
#pragma unroll
    for (int r = 0; r < 16; ++r) wr[r] = p.gla_wr[l * 2048 + r * 128 + hd];
    const float br = p.gla_br[l * 128 + hd];
    { const int e0 = t, e1 = t + 256; const bf16_t d0 = z[(size_t)(tok0 + (e0 >> 4)) * ZP + C_DR + (e0 & 15)], d1 = z[(size_t)(tok0 + (e1 >> 4)) * ZP + C_DR + (e1 & 15)];
      drs[e0] = bf2f(d0); drs[e1] = bf2f(d1); }
    __syncthreads();
#pragma unroll
    for (int ii = 0; ii < 16; ++ii) { const int i = ih * 16 + ii; float x = br;
#pragma unroll
        for (int r4 = 0; r4 < 4; ++r4) { const f32x4 dv = *(const f32x4*)(drs + i * 16 + r4 * 4); x += (dv[0] * wr[r4 * 4] + dv[1] * wr[r4 * 4 + 1]) + (dv[2] * wr[r4 * 4 + 2] + dv[3] * wr[r4 * 4 + 3]); }
        bc[i * 128 + hd] = (fminf(x, 0.f) - __logf(1.f + __expf(-fabsf(x)))) * (1.f / 16.f); }
    __syncthreads();
    if (t < 128) { float sacc = 0.f;
#pragma unroll
        for (int i = 0; i < 32; ++i) { sacc += bc[i * 128 + t]; bc[i * 128 + t] = sacc; } }
    __syncthreads();
}

__device__ void gla1_item(const Params& p, int l, int idx, char* smem) {
    const int t = tid_opq(), lane = t & 63, w = t >> 6, r16 = lane & 15, quad = lane >> 4;
    const int b = idx >> 7, c = idx & 127; const int tok0 = b * S + c * 32;
    const bf16_t* z = (const bf16_t*)(p.ws + WS_Z);
    float* bc = (float*)smem; float* drs = (float*)(smem + 16384);
    bf16_t* kdT = (bf16_t*)(smem + 18432) + w * 1024;
    bf16_t* vL = (bf16_t*)(smem + 26624) + w * (32 * LDP);
    float* gkv = (float*)(p.ws + WS_GKV); float* gdec = (float*)(p.ws + WS_GDEC);
    bf16_t kraw[16]; u32x4 vr[4];
#pragma unroll
    for (int i = 0; i < 16; ++i) { const int e = lane + 64 * i; kraw[i] = z[(size_t)(tok0 + (e >> 5)) * ZP + C_DK + w * 32 + (e & 31)]; }
#pragma unroll
    for (int i = 0; i < 4; ++i) { const int cc = lane + 64 * i; vr[i] = *(const u32x4*)(z + (size_t)(tok0 + (cc >> 3)) * ZP + C_DV + w * 64 + (cc & 7) * 8); }
    __syncthreads();
#pragma unroll
    for (int i = 0; i < 4; ++i) { const int cc = lane + 64 * i; *(u32x4*)(vL + (cc >> 3) * LDP + (cc & 7) * 8) = vr[i]; }
    gla_bcum(p, l, z, tok0, bc, drs);
#pragma unroll
    for (int i = 0; i < 16; ++i) { const int e = lane + 64 * i; const int j = e >> 5, d = e & 31;
        kdT[d * 32 + j] = f2bf(bf2f(kraw[i]) * __expf(bc[31 * 128 + w * 32 + d] - bc[j * 128 + w * 32 + d])); }
    const int bh = b * 4 + w;
    if (lane < 32) gdec[(bh * 128 + c) * 32 + lane] = __expf(bc[31 * 128 + w * 32 + lane]);
    __syncthreads();
    bf16x8 kf[2];
#pragma unroll
    for (int x = 0; x < 2; ++x) kf[x] = *(const bf16x8*)(kdT + (x * 16 + r16) * 32 + quad * 8);
    float* dst = gkv + (size_t)(bh * 128 + c) * 2048;
#pragma unroll
    for (int dt = 0; dt < 4; ++dt) {
        const bf16_t* v0p = vL + (quad * 8 + (r16 >> 2)) * LDP + dt * 16 + (r16 & 3) * 4;
        const bf16x4 v0 = __builtin_amdgcn_ds_read_tr16_b64_v4i16((__attribute__((address_space(3))) bf16x4*)(v0p));
        const bf16x4 v1 = __builtin_amdgcn_ds_read_tr16_b64_v4i16((__attribute__((address_space(3))) bf16x4*)(v0p + 4 * LDP));
        const bf16x8 vf = {v0[0], v0[1], v0[2], v0[3], v1[0], v1[1], v1[2], v1[3]};
#pragma unroll
        for (int x = 0; x < 2; ++x) {
            const f32x4 r = __builtin_amdgcn_mfma_f32_16x16x32_bf16(vf, kf[x], (f32x4){0.f, 0.f, 0.f, 0.f}, 0, 0, 0);
            *(f32x4*)(dst + (x * 16 + r16) * 64 + dt * 16 + quad * 4) = r;
        }
    }
}

#define OPQ(ptr) asm volatile("" : "+v"(ptr))
__device__ void gla3_item(const Params& p, int l, int idx, char* smem) {
    const int t = tid_opq(), lane = t & 63, w = t >> 6, r16 = lane & 15, quad = lane >> 4;
    const int b = idx >> 7, c = idx & 127; const int tok0 = b * S + c * 32;
    const bf16_t* z = (const bf16_t*)(p.ws + WS_Z); bf16_t* mix = (bf16_t*)(p.ws + WS_U);
    float* bc = (float*)smem; float* drs = (float*)(smem + 16384);
    bf16_t* SL = (bf16_t*)smem + w * (32 * LDP);
    bf16_t* qe = (bf16_t*)(smem + 18432) + w * 1024;
    bf16_t* ke = (bf16_t*)(smem + 26624) + w * 1024;
    bf16_t* vL = (bf16_t*)(smem + 34816) + w * (32 * LDP);
    const float* gkv = (const float*)(p.ws + WS_GKV);
    const int bh = b * 4 + w;
    bf16_t qraw[16], kraw[16];
    { const bf16_t* qp = z + (size_t)(tok0 + (lane >> 5)) * ZP + w * 32 + (lane & 31);
#pragma unroll
      for (int i = 0; i < 16; ++i) { qraw[i] = qp[C_DQ]; kraw[i] = qp[C_DK]; qp += 2 * ZP; OPQ(qp); } }
    u32x4 vr[4]; f32x4 sr[8];
#pragma unroll
    for (int i = 0; i < 4; ++i) { const int cc = lane + 64 * i; vr[i] = *(const u32x4*)(z + (size_t)(tok0 + (cc >> 3)) * ZP + C_DV + w * 64 + (cc & 7) * 8); }
    { const float* Sp = gkv + (size_t)(bh * 128 + c) * 2048;
#pragma unroll
      for (int i = 0; i < 8; ++i) sr[i] = *(const f32x4*)(Sp + (lane + 64 * i) * 4); }
    __syncthreads();
#pragma unroll
    for (int i = 0; i < 4; ++i) { const int cc = lane + 64 * i; *(u32x4*)(vL + (cc >> 3) * LDP + (cc & 7) * 8) = vr[i]; }
    gla_bcum(p, l, z, tok0, bc, drs);
#pragma unroll
    for (int i2 = 0; i2 < 16; ++i2) { const int e = lane + 64 * i2; const int i = e >> 5, d = e & 31; const float bcv = bc[i * 128 + w * 32 + d];
        qe[i * 32 + d] = f2bf(bf2f(qraw[i2]) * __expf(bcv) * 0.17677669529663687f); ke[i * 32 + d] = f2bf(bf2f(kraw[i2]) * __expf(-bcv)); }
    __syncthreads();
#pragma unroll
    for (int i = 0; i < 8; ++i) { const int cc = lane + 64 * i; const int d = cc >> 4, v4 = cc & 15; u32x2 pk; pk.x = pack2(sr[i][0], sr[i][1]); pk.y = pack2(sr[i][2], sr[i][3]);
        *(u32x2*)(SL + d * LDP + v4 * 4) = pk; }
    __syncthreads();
    bf16x8 qf[2], kf[2];
#pragma unroll
    for (int x = 0; x < 2; ++x) { qf[x] = *(const bf16x8*)(qe + (x * 16 + r16) * 32 + quad * 8); kf[x] = *(const bf16x8*)(ke + (x * 16 + r16) * 32 + quad * 8); }
    bf16x8 pf[2];
#pragma unroll
    for (int it = 0; it < 2; ++it) {
        f32x4 at[2];
#pragma unroll
        for (int jt = 0; jt < 2; ++jt) { at[jt] = __builtin_amdgcn_mfma_f32_16x16x32_bf16(kf[jt], qf[it], (f32x4){0.f, 0.f, 0.f, 0.f}, 0, 0, 0);
#pragma unroll
            for (int jj = 0; jj < 4; ++jj) at[jt][jj] = (jt * 16 + quad * 4 + jj <= it * 16 + r16) ? at[jt][jj] : 0.f; }
        u32x4 pk = {pack2(at[0][0], at[0][1]), pack2(at[0][2], at[0][3]), pack2(at[1][0], at[1][1]), pack2(at[1][2], at[1][3])};
        pf[it] = __builtin_bit_cast(bf16x8, pk);
    }
    f32x4 O[2][4];
#pragma unroll
    for (int dt = 0; dt < 4; ++dt) {
        const bf16_t* v0p = vL + (quad * 4 + (r16 >> 2)) * LDP + dt * 16 + (r16 & 3) * 4;
        const bf16x4 v0 = __builtin_amdgcn_ds_read_tr16_b64_v4i16((__attribute__((address_space(3))) bf16x4*)(v0p));
        const bf16x4 v1 = __builtin_amdgcn_ds_read_tr16_b64_v4i16((__attribute__((address_space(3))) bf16x4*)(v0p + 16 * LDP));
        const bf16x8 vf = {v0[0], v0[1], v0[2], v0[3], v1[0], v1[1], v1[2], v1[3]};
        const bf16_t* s0p = SL + (quad * 8 + (r16 >> 2)) * LDP + dt * 16 + (r16 & 3) * 4;
        const bf16x4 s0 = __builtin_amdgcn_ds_read_tr16_b64_v4i16((__attribute__((address_space(3))) bf16x4*)(s0p));
        const bf16x4 s1 = __builtin_amdgcn_ds_read_tr16_b64_v4i16((__attribute__((address_space(3))) bf16x4*)(s0p + 4 * LDP));
        const bf16x8 sf = {s0[0], s0[1], s0[2], s0[3], s1[0], s1[1], s1[2], s1[3]};
#pragma unroll
        for (int it = 0; it < 2; ++it) {
            O[it][dt] = __builtin_amdgcn_mfma_f32_16x16x32_bf16(vf, pf[it], (f32x4){0.f, 0.f, 0.f, 0.f}, 0, 0, 0);
            O[it][dt] = __builtin_amdgcn_mfma_f32_16x16x32_bf16(sf, qf[it], O[it][dt], 0, 0, 0);
        }
    }
#pragma unroll
    for (int it = 0; it < 2; ++it) {
        float ss = 0.f;
#pragma unroll
        for (int dt = 0; dt < 4; ++dt) ss += (O[it][dt][0] * O[it][dt][0] + O[it][dt][1] * O[it][dt][1]) + (O[it][dt][2] * O[it][dt][2] + O[it][dt][3] * O[it][dt][3]);
        ss += __shfl_xor(ss, 16); ss += __shfl_xor(ss, 32);
        const float rn = rsqrtf(ss * (1.f / 64.f) + 1e-5f);
        const size_t tok = (size_t)(tok0 + it * 16 + r16);
#pragma unroll
        for (int dt = 0; dt < 4; ++dt) { const int v0i = dt * 16 + quad * 4; const f32x4 gn = *(const f32x4*)(p.gla_gn + l * 64 + v0i);
            const u32x2 gv = *(const u32x2*)(z + tok * ZP + C_DG + w * 64 + v0i);
            const float g0 = __uint_as_float(gv.x << 16), g1 = __uint_as_float(gv.x & 0xffff0000u), g2 = __uint_as_float(gv.y << 16), g3 = __uint_as_float(gv.y & 0xffff0000u);
            u32x2 o; o.x = pack2(O[it][dt][0] * rn * gn[0] * silu_f(g0), O[it][dt][1] * rn * gn[1] * silu_f(g1));
            o.y = pack2(O[it][dt][2] * rn * gn[2] * silu_f(g2), O[it][dt][3] * rn * gn[3] * silu_f(g3));
            *(u32x2*)(mix + tok * 1024 + 768 + w * 64 + v0i) = o; }
    }
}

__device__ void lru1_item(const Params& p, int l, int idx, char* smem) {
    const int t = tid_opq(), lane = t & 63, g = t >> 6; const int ch = t;
    const int b = idx >> 7, c = idx & 127; const int s0 = c * 32; const int tok0 = b * S + s0;
    const bf16_t* z = (const bf16_t*)(p.ws + WS_Z); float* xcs = (float*)smem;
    float* lh = (float*)(p.ws + WS_LH); float* lp = (float*)(p.ws + WS_LP);
    bf16_t xr[35];
#pragma unroll
    for (int i = 0; i < 35; ++i) { const int sidx = s0 + i - 3; xr[i] = (sidx >= 0) ? z[(size_t)(tok0 + i - 3) * ZP + C_BX + ch] : (bf16_t)0; }
    const float cw0 = p.conv_w[l * 1024 + ch], cw1 = p.conv_w[l * 1024 + 256 + ch], cw2 = p.conv_w[l * 1024 + 512 + ch], cw3 = p.conv_w[l * 1024 + 768 + ch];
    const float cb = p.conv_b[l * 256 + ch];
    const float* wa = p.lru_wa + l * 16384 + g * 4096 + lane; const float* wx = p.lru_wx + l * 16384 + g * 4096 + lane;
    float nwa[4], nwx[4];
#pragma unroll
    for (int e = 0; e < 4; ++e) { nwa[e] = wa[e * 64]; nwx[e] = wx[e * 64]; }
    __syncthreads();
#pragma unroll
    for (int i = 0; i < 32; ++i) xcs[i * 256 + ch] = cb + (cw0 * bf2f(xr[i]) + cw1 * bf2f(xr[i + 1])) + (cw2 * bf2f(xr[i + 2]) + cw3 * bf2f(xr[i + 3]));
    __syncthreads();
    float aA[32], aX[32];
#pragma unroll
    for (int i = 0; i < 32; ++i) { aA[i] = 0.f; aX[i] = 0.f; }
#pragma unroll 1
    for (int k4 = 0; k4 < 16; ++k4) {
        const float wa0 = nwa[0], wa1 = nwa[1], wa2 = nwa[2], wa3 = nwa[3], wx0 = nwx[0], wx1 = nwx[1], wx2 = nwx[2], wx3 = nwx[3];
        const int kn = (k4 + 1) & 15;
#pragma unroll
        for (int e = 0; e < 4; ++e) { nwa[e] = wa[(kn * 4 + e) * 64]; nwx[e] = wx[(kn * 4 + e) * 64]; }
#pragma unroll
        for (int i = 0; i < 32; ++i) { const f32x4 xv = *(const f32x4*)(xcs + i * 256 + g * 64 + k4 * 4);
            aA[i] += (xv[0] * wa0 + xv[1] * wa1) + (xv[2] * wa2 + xv[3] * wa3); aX[i] += (xv[0] * wx0 + xv[1] * wx1) + (xv[2] * wx2 + xv[3] * wx3); }
    }
    const float ba = p.lru_ba[l * 256 + ch], bx = p.lru_bx[l * 256 + ch], lam = p.lru_lam[l * 256 + ch];
    const float sp = fmaxf(-lam, 0.f) + log1pf(__expf(-fabsf(lam)));
    float hh = 0.f, P = 1.f;
#pragma unroll
    for (int i = 0; i < 32; ++i) { const float r = sigmoid_f(aA[i] + ba), ig = sigmoid_f(aX[i] + bx); const float la = -8.f * r * sp; const float a = __expf(la);
        const float u = sqrtf(-expm1f(2.f * la)) * (ig * xcs[i * 256 + ch]); hh = a * hh + u; P *= a;
        lh[(size_t)(tok0 + i) * 256 + ch] = hh; lp[(size_t)(tok0 + i) * 256 + ch] = P; }
}

__device__ void lru3_item(const Params& p, int idx) {
    const int ch = tid_opq(); const int b = idx >> 7, c = idx & 127; const int tok0 = b * S + c * 32;
    const bf16_t* z = (const bf16_t*)(p.ws + WS_Z); bf16_t* mix = (bf16_t*)(p.ws + WS_U);
    const float* lh = (const float*)(p.ws + WS_LH); const float* lp = (const float*)(p.ws + WS_LP); const float* lc = (const float*)(p.ws + WS_LC);
    const float carry = lc[(size_t)(b * 128 + c) * 256 + ch];
    float hv[32], pv[32]; bf16_t gv[32];
#pragma unroll
    for (int i = 0; i < 32; ++i) { const size_t tok = (size_t)(tok0 + i); hv[i] = lh[tok * 256 + ch]; pv[i] = lp[tok * 256 + ch]; gv[i] = z[tok * ZP + C_BG + ch]; }
#pragma unroll
    for (int i = 0; i < 32; ++i) { const size_t tok = (size_t)(tok0 + i); mix[tok * 1024 + 256 + ch] = f2bf((hv[i] + pv[i] * carry) * silu_f(bf2f(gv[i]))); }
}

__device__ void dilc_item(const Params& p, int idx) {
    const int t = tid_opq(); const size_t tok = (size_t)idx * 8 + (t >> 5); const int chn = t & 31; const int h = chn >> 3;
    const bf16_t* z = (const bf16_t*)(p.ws + WS_Z); bf16_t* mix = (bf16_t*)(p.ws + WS_U);
    const bf16_t* dilo = (const bf16_t*)(p.ws + WS_DILO); const float* dill = (const float*)(p.ws + WS_DILL);
    const float l0 = dill[((size_t)0 * T + tok) * 4 + h], l1 = dill[((size_t)1 * T + tok) * 4 + h], l2 = dill[((size_t)2 * T + tok) * 4 + h];
    const float mx = fmaxf(l0, fmaxf(l1, l2)); float w0 = __expf(l0 - mx), w1 = __expf(l1 - mx), w2 = __expf(l2 - mx); const float inv = 1.f / (w0 + w1 + w2); w0 *= inv; w1 *= inv; w2 *= inv;
    const u32x4 o0 = *(const u32x4*)(dilo + ((size_t)0 * T + tok) * 256 + chn * 8), o1 = *(const u32x4*)(dilo + ((size_t)1 * T + tok) * 256 + chn * 8), o2 = *(const u32x4*)(dilo + ((size_t)2 * T + tok) * 256 + chn * 8);
    const u32x4 gv = *(const u32x4*)(z + tok * ZP + C_CG + chn * 8);
    u32x4 r;
#pragma unroll
    for (int e = 0; e < 4; ++e) {
        const float a = w0 * __uint_as_float(o0[e] << 16) + w1 * __uint_as_float(o1[e] << 16) + w2 * __uint_as_float(o2[e] << 16);
        const float bq = w0 * __uint_as_float(o0[e] & 0xffff0000u) + w1 * __uint_as_float(o1[e] & 0xffff0000u) + w2 * __uint_as_float(o2[e] & 0xffff0000u);
        r[e] = pack2(a * silu_f(__uint_as_float(gv[e] << 16)), bq * silu_f(__uint_as_float(gv[e] & 0xffff0000u)));
    }
    *(u32x4*)(mix + tok * 1024 + 512 + chn * 8) = r;
}

__device__ void m2_phase(const Params& p, char* smem) {
    float* gkv = (float*)(p.ws + WS_GKV); const float* gdec = (const float*)(p.ws + WS_GDEC);
    const float* lh = (const float*)(p.ws + WS_LH); const float* lp = (const float*)(p.ws + WS_LP); float* lc = (float*)(p.ws + WS_LC);
    float* aggP = (float*)smem; float* aggS = aggP + 256;
    const int t = tid_opq(); const int e = t & 31, seg = t >> 5;
    for (int it = blockIdx.x; it < 1024 + 32; it += gridDim.x) {
        float a[16], x[16];
        size_t ostride;
        float* outp;
        if (it < 1024) {
            const int gid = it * 32 + e; const int bh = gid >> 11, dv = gid & 2047, d = dv >> 6;
            float* base = gkv + (size_t)bh * 128 * 2048 + dv + (size_t)(seg * 16) * 2048; const float* dc = gdec + (size_t)bh * 128 * 32 + d + (seg * 16) * 32;
#pragma unroll
            for (int k = 0; k < 16; ++k) { x[k] = base[(size_t)k * 2048]; a[k] = dc[k * 32]; }
            outp = base; ostride = 2048;
        } else {
            const int i2 = it - 1024; const int b = i2 >> 3, ch = (i2 & 7) * 32 + e;
#pragma unroll
            for (int k = 0; k < 16; ++k) { const size_t ix = (size_t)(b * S + (seg * 16 + k) * 32 + 31) * 256 + ch; a[k] = lp[ix]; x[k] = lh[ix]; }
            outp = lc + (size_t)(b * 128 + seg * 16) * 256 + ch; ostride = 256;
        }
        float st = 0.f, pr = 1.f;
#pragma unroll
        for (int k = 0; k < 16; ++k) { const float ak = a[k], xk = x[k]; a[k] = pr; x[k] = st; st = ak * st + xk; pr *= ak; }
        __syncthreads();
        aggP[seg * 32 + e] = pr; aggS[seg * 32 + e] = st;
        __syncthreads();
        float carry = 0.f;
        for (int s2 = 0; s2 < seg; ++s2) carry = aggP[s2 * 32 + e] * carry + aggS[s2 * 32 + e];
#pragma unroll
        for (int k = 0; k < 16; ++k) outp[(size_t)k * ostride] = x[k] + a[k] * carry;
    }
}

__global__ void __launch_bounds__(256, 2) fwd_megakernel(Params p) {
    __shared__ __attribute__((aligned(16))) char smem[SMEM_BYTES];
    __shared__ uint4 xb_words;
    __shared__ int s_slot;
    cg::grid_group grid = cg::this_grid();
    if (p.out == nullptr) grid.sync();
    if (threadIdx.x == 0) xb_words = make_uint4(0u, 0u, 0u, 0u);
    __syncthreads();
    const XcdBarrier xb = xcd_barrier_post((unsigned*)(p.ws + WS_CTL), (volatile LAS unsigned*)&xb_words);
    unsigned* cnt = (unsigned*)(p.ws + WS_CNT);
    prologue_phase(p, smem);
    xcd_barrier(xb);
#pragma unroll 1
    for (int l = 0; l < DEPTH; ++l) {
        ln_phase(p, l);
        xcd_barrier(xb);
        g1_phase(p, l, smem);
        xcd_barrier(xb);
        for (;;) { const int it = next_item(cnt + (0 + l) * 64, &s_slot); if (it >= 2048) break; attn_item(p, it < 512 ? 0 : 1, it < 512 ? it : it - 512, smem); }
        for (;;) { const int it = next_item(cnt + (2 + l) * 64, &s_slot); if (it >= 512) break; gla1_item(p, l, it, smem); }
        for (;;) { const int it = next_item(cnt + (4 + l) * 64, &s_slot); if (it >= 512) break; lru1_item(p, l, it, smem); }
        xcd_barrier(xb);
        m2_phase(p, smem);
        xcd_barrier(xb);
        for (int it = blockIdx.x; it < 512; it += gridDim.x) gla3_item(p, l, it, smem);
        for (int it = blockIdx.x; it < 512; it += gridDim.x) lru3_item(p, it);
        for (int it = blockIdx.x; it < 2048; it += gridDim.x) dilc_item(p, it);
        xcd_barrier(xb);
        g2_phase(p, l, smem);
        xcd_barrier(xb);
    }
    ln_phase(p, DEPTH);
}

extern "C" void kernel_launch(void* const* d_in, const int* in_sizes, int n_in, void* d_out, int out_size, void* d_ws, size_t ws_size, hipStream_t stream) {
    static int grid_blocks = 0;
    if (!grid_blocks) {
        int dev = 0, cus = 0, per_cu = 0;
        hipGetDevice(&dev);
        hipDeviceGetAttribute(&cus, hipDeviceAttributeMultiprocessorCount, dev);
        hipOccupancyMaxActiveBlocksPerMultiprocessor(&per_cu, (const void*)fwd_megakernel, 256, 0);
        if (per_cu < 1) per_cu = 1;
        if (per_cu > 2) per_cu = 2;
        grid_blocks = cus * per_cu;
        if (ws_size < WS_END) fprintf(stderr, "kernel_launch: workspace too small: %zu < %zu\n", ws_size, (size_t)WS_END);
    }
    Params p{};
    p.x = (const float*)d_in[0]; p.c = (const float*)d_in[1]; p.pos = (const int*)d_in[2];
    p.w_mod = (const float*)d_in[3]; p.b_mod = (const float*)d_in[4]; p.w_in = (const float*)d_in[5];
    p.conv_w = (const float*)d_in[6]; p.conv_b = (const float*)d_in[7]; p.lru_wa = (const float*)d_in[8]; p.lru_ba = (const float*)d_in[9];
    p.lru_wx = (const float*)d_in[10]; p.lru_bx = (const float*)d_in[11]; p.lru_lam = (const float*)d_in[12];
    p.gla_wr = (const float*)d_in[13]; p.gla_br = (const float*)d_in[14]; p.gla_gn = (const float*)d_in[15];
    p.w_out = (const float*)d_in[16]; p.ln_g = (const float*)d_in[17]; p.ln_b = (const float*)d_in[18];
    p.out = (float*)d_out; p.ws = (unsigned char*)d_ws;
    (void)hipMemsetAsync(d_ws, 0, 32768, stream);
    void* args[] = {&p};
    hipError_t e = hipLaunchCooperativeKernel((const void*)fwd_megakernel, dim3(grid_blocks), dim3(256), args, 0, stream);
    if (e != hipSuccess) fprintf(stderr, "cooperative launch failed: %s (grid %d)\n", hipGetErrorString(e), grid_blocks);
}
```

```cpp
#include <hip/hip_runtime.h>
#include <hip/hip_cooperative_groups.h>
#include <cstdio>
#include <cstdint>
namespace cg = cooperative_groups;

typedef unsigned short bf16_t;
typedef short bf16x8 __attribute__((ext_vector_type(8)));
typedef short bf16x4 __attribute__((ext_vector_type(4)));
typedef float f32x4 __attribute__((ext_vector_type(4)));
typedef unsigned u32x4 __attribute__((ext_vector_type(4)));
typedef unsigned u32x2 __attribute__((ext_vector_type(2)));

constexpr int D = 1024, NB = 4, S = 4096, T = NB * S, DEPTH = 2;
constexpr int DIN = 3344, ZP = 3344, NPAD = 3456;
constexpr int C_AQ = 0, C_AK = 256, C_AV = 512, C_AG = 768, C_BX = 1024, C_BG = 1280, C_CQ = 1536, C_CK = 1792,
              C_CV = 2048, C_CG = 2304, C_DQ = 2560, C_DK = 2688, C_DV = 2816, C_DG = 3072, C_DR = 3328;
constexpr float DN_ALPHA = 1.4142135623730951f;
constexpr int LDP = 72;
constexpr int SMEM_BYTES = 65536;
constexpr int BIG = 1000000;

constexpr size_t WS_CTL = 0;
constexpr size_t WS_CNT = 16384;
constexpr size_t WS_WINT = 32768;
constexpr size_t WS_WOUTT = WS_WINT + (size_t)DEPTH * NPAD * 1024 * 2;
constexpr size_t WS_MOD = WS_WOUTT + (size_t)DEPTH * 1024 * 1024 * 2;
constexpr size_t WS_COS = WS_MOD + (size_t)DEPTH * NB * 3072 * 4;
constexpr size_t WS_SIN = WS_COS + (size_t)T * 32 * 4;
constexpr size_t WS_U = WS_SIN + (size_t)T * 32 * 4;
constexpr size_t WS_Z = WS_U + (size_t)T * 1024 * 2;
constexpr size_t WS_KPART = WS_Z + (size_t)T * ZP * 2;
constexpr size_t WS_DILO = WS_KPART + (size_t)256 * 256 * 4;
constexpr size_t WS_DILL = WS_DILO + (size_t)3 * T * 256 * 2;
constexpr size_t WS_GKV = WS_DILL + (size_t)3 * T * 4 * 4;
constexpr size_t WS_GDEC = WS_GKV + (size_t)2048 * 2048 * 4;
constexpr size_t WS_LH = WS_GDEC + (size_t)2048 * 32 * 4;
constexpr size_t WS_LP = WS_LH + (size_t)T * 256 * 4;
constexpr size_t WS_LC = WS_LP + (size_t)T * 256 * 4;
constexpr size_t WS_LWT = WS_LC + (size_t)NB * 128 * 256 * 4;
constexpr size_t WS_END = WS_LWT + (size_t)DEPTH * 2 * 4 * 64 * 64 * 2;

struct Params {
    const float *x, *c; const int* pos;
    const float *w_mod, *b_mod, *w_in, *conv_w, *conv_b, *lru_wa, *lru_ba, *lru_wx, *lru_bx, *lru_lam, *gla_wr, *gla_br, *gla_gn, *w_out, *ln_g, *ln_b;
    float* out; unsigned char* ws;
};

__device__ __forceinline__ float bf2f(bf16_t h) { return __uint_as_float(((unsigned)h) << 16); }
typedef __bf16 hbf16x2 __attribute__((ext_vector_type(2)));
typedef float f32x2 __attribute__((ext_vector_type(2)));
__device__ __forceinline__ unsigned pack2(float a, float b) { f32x2 v = {a, b}; hbf16x2 r = __builtin_convertvector(v, hbf16x2); return __builtin_bit_cast(unsigned, r); }
__device__ __forceinline__ bf16_t f2bf(float f) { return (bf16_t)(pack2(f, 0.f) & 0xffffu); }
__device__ __forceinline__ float silu_f(float x) { return x / (1.f + __expf(-x)); }
__device__ __forceinline__ float sigmoid_f(float x) { return 1.f / (1.f + __expf(-x)); }
__device__ __forceinline__ int tid_opq() { int t = threadIdx.x; asm volatile("" : "+v"(t)); return t; }
__device__ __forceinline__ float wsum(float v) {
#pragma unroll
    for (int o = 32; o; o >>= 1) v += __shfl_xor(v, o);
    return v;
}

#define XB_TMO      128
#define XB_XCNT(j)  (256  + 64 * (j))
#define XB_XSUB(j)  (1280 + 64 * (j))
#define XB_XGEN(j)  (2304 + 64 * (j))
#define XB_TOP      3328
#define XB_TOPGEN   3392
#define XCD_BAR_WORDS 3456
#define XB_SPIN_CAP (1u << 18)
#define LAS __attribute__((address_space(3)))
__device__ __forceinline__ unsigned xb_ld(unsigned* p)              { return __hip_atomic_load(p, __ATOMIC_RELAXED, __HIP_MEMORY_SCOPE_AGENT); }
__device__ __forceinline__ unsigned xb_add(unsigned* p, unsigned v) { return __hip_atomic_fetch_add(p, v, __ATOMIC_RELAXED, __HIP_MEMORY_SCOPE_AGENT); }
__device__ __forceinline__ unsigned xb_xcc_id() { return (unsigned)__builtin_amdgcn_s_getreg((3 << 11) | 20) & 0xFu; }
#define XB_SPIN(cond, bar) do { unsigned _sp = 0; while (cond) { __builtin_amdgcn_s_sleep(1); \
    if ((++_sp & 255u) == 0u) { if (xb_ld(&(bar)[XB_TMO])) break; if (_sp > XB_SPIN_CAP) { atomicAdd(&(bar)[XB_TMO], 1u); break; } } } } while (0)
struct XcdBarrier { unsigned* bar; unsigned x; volatile LAS unsigned* st; };
__device__ __forceinline__ XcdBarrier xcd_barrier_post(unsigned* bar, volatile LAS unsigned* st) {
    XcdBarrier b; b.bar = bar; b.x = xb_xcc_id(); b.st = st;
    if (threadIdx.x == 0) (void)xb_add(&bar[XB_XCNT(b.x)], 1u);
    return b;
}
__device__ __forceinline__ void xcd_barrier_complete(unsigned* bar, unsigned x, unsigned& nloc, unsigned& nx) {
    const unsigned G = gridDim.x * gridDim.y * gridDim.z;
    unsigned sum, cnt, mine, sp = 0u;
    for (;;) {
        sum = 0u; cnt = 0u; mine = 0u;
#pragma unroll
        for (unsigned j = 0; j < 16; ++j) { const unsigned c = xb_ld(&bar[XB_XCNT(j)]); sum += c; cnt += (c > 0u) ? 1u : 0u; mine = (j == x) ? c : mine; }
        if (sum == G) break;
        __builtin_amdgcn_s_sleep(1);
        if ((++sp & 255u) == 0u) { if (xb_ld(&bar[XB_TMO])) break; if (sp > XB_SPIN_CAP) { atomicAdd(&bar[XB_TMO], 1u); break; } }
    }
    nloc = mine > 0u ? mine : 1u; nx = cnt > 0u ? cnt : 1u;
}
__device__ __forceinline__ void xcd_barrier(const XcdBarrier& b) {
    asm volatile("s_waitcnt vmcnt(0)" ::: "memory");
    __syncthreads();
    if (threadIdx.x == 0) {
        unsigned* bar = b.bar;
        __builtin_amdgcn_s_waitcnt(0);
        unsigned nloc = b.st[0], nx = b.st[1];
        if (nloc == 0u) { xcd_barrier_complete(bar, b.x, nloc, nx); b.st[0] = nloc; b.st[1] = nx; }
        const unsigned old = xb_add(&bar[XB_XSUB(b.x)], 1u);
        const unsigned gen = old / nloc;
        if (old + 1u == (gen + 1u) * nloc) {
            __builtin_amdgcn_fence(__ATOMIC_RELEASE, "agent");
            asm volatile("s_waitcnt vmcnt(0)" ::: "memory");
            const unsigned og = xb_add(&bar[XB_TOP], 1u);
            const unsigned tg = og / nx;
            if (og + 1u == (tg + 1u) * nx) xb_add(&bar[XB_TOPGEN], 1u);
            else XB_SPIN(xb_ld(&bar[XB_TOPGEN]) == tg, bar);
            __builtin_amdgcn_fence(__ATOMIC_ACQUIRE, "agent");
            xb_add(&bar[XB_XGEN(b.x)], 1u);
            asm volatile("s_waitcnt vmcnt(0)" ::: "memory");
        } else {
            XB_SPIN(xb_ld(&bar[XB_XGEN(b.x)]) == gen, bar);
            __builtin_amdgcn_fence(__ATOMIC_ACQUIRE, "agent");
            asm volatile("s_waitcnt vmcnt(0)" ::: "memory");
        }
    }
    __syncthreads();
}
__device__ __forceinline__ int next_item(unsigned* ctr, volatile int* slot) {
    __syncthreads();
    if (threadIdx.x == 0) *slot = (int)atomicAdd(ctr, 1u);
    __syncthreads();
    return *slot;
}

__device__ void prologue_phase(const Params& p, char* smem) {
    const int t = tid_opq();
    bf16_t* WinT = (bf16_t*)(p.ws + WS_WINT); bf16_t* WoutT = (bf16_t*)(p.ws + WS_WOUTT);
    float* mod = (float*)(p.ws + WS_MOD); float* cosT = (float*)(p.ws + WS_COS); float* sinT = (float*)(p.ws + WS_SIN);
    float* tl = (float*)smem;
    constexpr int N_TIN = DEPTH * 16 * 54, N_TOUT = DEPTH * 16 * 16, N_MOD = DEPTH * 192, N_ROPE = T * 32 / 256, N_LWT = DEPTH * 2 * 4 * 64 * 64 / 256;
    constexpr int NITEMS = N_TIN + N_TOUT + N_MOD + N_ROPE + N_LWT;
    for (int it = blockIdx.x; it < NITEMS; it += gridDim.x) {
        if (it < N_TIN + N_TOUT) {
            const float* src; bf16_t* dst; int ncols, kt, nt;
            if (it < N_TIN) { int l = it / (16 * 54), r = it % (16 * 54); kt = r / 54; nt = r % 54; src = p.w_in + (size_t)l * 1024 * DIN; dst = WinT + (size_t)l * NPAD * 1024; ncols = DIN; }
            else { int i2 = it - N_TIN; int l = i2 / 256, r = i2 % 256; kt = r / 16; nt = r % 16; src = p.w_out + (size_t)l * 1024 * 1024; dst = WoutT + (size_t)l * 1024 * 1024; ncols = 1024; }
            __syncthreads();
            { const int c = t & 63, r0 = t >> 6; const int n = nt * 64 + c;
#pragma unroll
              for (int i = 0; i < 16; ++i) { int r = r0 + 4 * i; tl[r * 65 + c] = (n < ncols) ? src[(size_t)(kt * 64 + r) * ncols + n] : 0.f; } }
            __syncthreads();
            { const int kk = t & 63, n0 = t >> 6;
#pragma unroll
              for (int i = 0; i < 16; ++i) { int n = n0 + 4 * i; dst[(size_t)(nt * 64 + n) * 1024 + kt * 64 + kk] = f2bf(tl[kk * 65 + n]); } }
        } else if (it < N_TIN + N_TOUT + N_MOD) {
            const int i2 = it - N_TIN - N_TOUT; const int l = i2 / 192, jg = i2 % 192;
            const int jj = t & 15, ks = t >> 4; const int j = jg * 16 + jj;
            float a0 = 0.f, a1 = 0.f, a2 = 0.f, a3 = 0.f;
            const float* wm = p.w_mod + (size_t)l * 1024 * 3072 + j;
#pragma unroll 8
            for (int k = ks * 64; k < ks * 64 + 64; ++k) { float wv = wm[(size_t)k * 3072]; a0 += p.c[k] * wv; a1 += p.c[1024 + k] * wv; a2 += p.c[2048 + k] * wv; a3 += p.c[3072 + k] * wv; }
            __syncthreads();
            tl[(0 * 16 + ks) * 16 + jj] = a0; tl[(1 * 16 + ks) * 16 + jj] = a1; tl[(2 * 16 + ks) * 16 + jj] = a2; tl[(3 * 16 + ks) * 16 + jj] = a3;
            __syncthreads();
            if (t < 64) { const int b = t >> 4, j2 = t & 15; float s = 0.f;
#pragma unroll
              for (int k2 = 0; k2 < 16; ++k2) s += tl[(b * 16 + k2) * 16 + j2];
              mod[((size_t)l * NB + b) * 3072 + jg * 16 + j2] = s + p.b_mod[l * 3072 + jg * 16 + j2]; }
        } else if (it >= N_TIN + N_TOUT + N_MOD + N_ROPE) {
            const int e = (it - N_TIN - N_TOUT - N_MOD - N_ROPE) * 256 + t;
            const int in = e & 63, out = (e >> 6) & 63, g = (e >> 12) & 3, mat = (e >> 14) & 1, l = e >> 15;
            const float* src = mat ? p.lru_wx : p.lru_wa;
            ((bf16_t*)(p.ws + WS_LWT))[e] = f2bf(src[l * 16384 + g * 4096 + in * 64 + out]);
        } else {
            const int i2 = it - N_TIN - N_TOUT - N_MOD; const int e = i2 * 256 + t; const int tok = e >> 5, f = e & 31;
            const float inv = exp2f(-(float)f * (13.287712379549449f / 32.f));
            const float ang = (float)p.pos[tok] * inv;
            double rev = (double)ang * 0.15915494309189535; rev -= __builtin_rint(rev);
            const float rr = (float)rev; cosT[e] = __builtin_amdgcn_cosf(rr); sinT[e] = __builtin_amdgcn_sinf(rr);
        }
    }
}

__device__ void ln_phase(const Params& p, int l) {
    const int t = tid_opq(), lane = t & 63, w = t >> 6;
    bf16_t* ubuf = (bf16_t*)(p.ws + WS_U); const float* mod = (const float*)(p.ws + WS_MOD);
    for (int rg = blockIdx.x; rg < T / 16; rg += gridDim.x) {
        f32x4 v[4][4];
#pragma unroll
        for (int r = 0; r < 4; ++r) { const int row = rg * 16 + w * 4 + r; const float* src = (l <= 1) ? p.x + (size_t)row * 1024 : p.out + (size_t)row * 1024;
#pragma unroll
            for (int i = 0; i < 4; ++i) v[r][i] = *(const f32x4*)(src + i * 256 + lane * 4);
            if (l > 0) {
                const bf16_t* yr = (const bf16_t*)(p.ws + WS_Z) + (size_t)row * 1024; const float* gate = mod + ((size_t)(l - 1) * NB + row / S) * 3072 + 2048;
#pragma unroll
                for (int i = 0; i < 4; ++i) { const u32x2 yv = *(const u32x2*)(yr + i * 256 + lane * 4); const f32x4 g1 = *(const f32x4*)(gate + i * 256 + lane * 4) + 1.f;
                    const f32x4 yf = {__uint_as_float(yv.x << 16), __uint_as_float(yv.x & 0xffff0000u), __uint_as_float(yv.y << 16), __uint_as_float(yv.y & 0xffff0000u)};
                    v[r][i] = v[r][i] * DN_ALPHA + g1 * yf; }
            } }
#pragma unroll
        for (int r = 0; r < 4; ++r) {
            const int row = rg * 16 + w * 4 + r; const int b = row / S;
            if (l > 0) {
                float s = 0.f;
#pragma unroll
                for (int i = 0; i < 4; ++i) s += (v[r][i][0] + v[r][i][1]) + (v[r][i][2] + v[r][i][3]);
                const float mu = wsum(s) * (1.f / 1024.f); float q = 0.f;
#pragma unroll
                for (int i = 0; i < 4; ++i) { f32x4 d = v[r][i] - mu; q += (d[0] * d[0] + d[1] * d[1]) + (d[2] * d[2] + d[3] * d[3]); }
                const float rstd = rsqrtf(wsum(q) * (1.f / 1024.f) + 1e-5f);
#pragma unroll
                for (int i = 0; i < 4; ++i) { const f32x4 g = *(const f32x4*)(p.ln_g + (l - 1) * 1024 + i * 256 + lane * 4), bb = *(const f32x4*)(p.ln_b + (l - 1) * 1024 + i * 256 + lane * 4);
                    v[r][i] = (v[r][i] - mu) * rstd * g + bb; *(f32x4*)(p.out + (size_t)row * 1024 + i * 256 + lane * 4) = v[r][i]; }
            }
            if (l < DEPTH) {
                float s = 0.f;
#pragma unroll
                for (int i = 0; i < 4; ++i) s += (v[r][i][0] + v[r][i][1]) + (v[r][i][2] + v[r][i][3]);
                const float mu = wsum(s) * (1.f / 1024.f); float q = 0.f;
#pragma unroll
                for (int i = 0; i < 4; ++i) { f32x4 d = v[r][i] - mu; q += (d[0] * d[0] + d[1] * d[1]) + (d[2] * d[2] + d[3] * d[3]); }
                const float rstd = rsqrtf(wsum(q) * (1.f / 1024.f) + 1e-5f);
                const float* mb = mod + ((size_t)l * NB + b) * 3072;
#pragma unroll
                for (int i = 0; i < 4; ++i) { const int col = i * 256 + lane * 4; const f32x4 sh = *(const f32x4*)(mb + col), sc = *(const f32x4*)(mb + 1024 + col);
                    f32x4 u = (v[r][i] - mu) * rstd * (sc + 1.f) + sh; u32x2 pk; pk.x = pack2(u[0], u[1]); pk.y = pack2(u[2], u[3]);
                    *(u32x2*)(ubuf + (size_t)row * 1024 + col) = pk; }
            }
        }
    }
}

__device__ __forceinline__ int lds_off(int r, int c8) {
    const int st = (r >> 4) * 2 + (c8 >> 2); const int ob = (r & 15) * 64 + (c8 & 3) * 16;
    return st * 1024 + (ob ^ (((ob >> 9) & 1) << 5));
}
struct RegSet { u32x4 a[4], b[4]; };
__device__ __forceinline__ void gemm_tile(const bf16_t* __restrict__ A, const bf16_t* __restrict__ Bt, int tm, int tn, bool first, bool has_next, int ntm, int ntn,
                                          char* sm, f32x4 (&acc)[4][4], RegSet& r0, RegSet& r1) {
    const int t = tid_opq(), lane = t & 63, w = t >> 6, wm = w >> 1, wn = w & 1, r16 = lane & 15, quad = lane >> 4;
    const int lrow = t >> 3, lch = t & 7;
    constexpr int BUF = 32768;
    const unsigned loff = (unsigned)(lrow * 1024 + lch * 8);
    const bf16_t* At0 = A + (size_t)tm * (128 * 1024); const bf16_t* Bt0 = Bt + (size_t)tn * (128 * 1024);
    const bf16_t* At1 = A + (size_t)ntm * (128 * 1024); const bf16_t* Bt1 = Bt + (size_t)ntn * (128 * 1024);
#define Ag (At0 + loff)
#define Bg (Bt0 + loff)
#define nAg (At1 + loff)
#define nBg (Bt1 + loff)
    int woff[4];
#pragma unroll
    for (int i = 0; i < 4; ++i) woff[i] = lds_off(lrow + 32 * i, lch);
    const int fo = lds_off(r16, quad);
#pragma unroll
    for (int a = 0; a < 4; ++a)
#pragma unroll
        for (int b = 0; b < 4; ++b) acc[a][b] = (f32x4){0.f, 0.f, 0.f, 0.f};
    if (first) {
#pragma unroll
        for (int i = 0; i < 4; ++i) { r0.a[i] = *(const u32x4*)(Ag + (size_t)i * 32 * 1024); r0.b[i] = *(const u32x4*)(Bg + (size_t)i * 32 * 1024); }
#pragma unroll
        for (int i = 0; i < 4; ++i) { r1.a[i] = *(const u32x4*)(Ag + (size_t)i * 32 * 1024 + 64); r1.b[i] = *(const u32x4*)(Bg + (size_t)i * 32 * 1024 + 64); }
        __syncthreads();
#pragma unroll
        for (int i = 0; i < 4; ++i) { *(u32x4*)(sm + woff[i]) = r0.a[i]; *(u32x4*)(sm + 16384 + woff[i]) = r0.b[i]; }
#pragma unroll
        for (int i = 0; i < 4; ++i) { r0.a[i] = *(const u32x4*)(Ag + (size_t)i * 32 * 1024 + 128); r0.b[i] = *(const u32x4*)(Bg + (size_t)i * 32 * 1024 + 128); }
    }
    __syncthreads();
    auto step = [&](int kt, RegSet& rs) {
        const char* sA = sm + (kt & 1) * BUF; const char* sB = sA + 16384;
        char* nA = sm + ((kt + 1) & 1) * BUF; char* nB = nA + 16384;
        if (kt + 1 < 16 || has_next) {
#pragma unroll
            for (int i = 0; i < 4; ++i) { *(u32x4*)(nA + woff[i]) = rs.a[i]; *(u32x4*)(nB + woff[i]) = rs.b[i]; }
        }
        if (kt + 3 < 16) {
#pragma unroll
            for (int i = 0; i < 4; ++i) { rs.a[i] = *(const u32x4*)(Ag + (size_t)i * 32 * 1024 + (kt + 3) * 64); rs.b[i] = *(const u32x4*)(Bg + (size_t)i * 32 * 1024 + (kt + 3) * 64); }
        } else if (has_next) {
#pragma unroll
            for (int i = 0; i < 4; ++i) { rs.a[i] = *(const u32x4*)(nAg + (size_t)i * 32 * 1024 + (kt - 13) * 64); rs.b[i] = *(const u32x4*)(nBg + (size_t)i * 32 * 1024 + (kt - 13) * 64); }
        }
        __builtin_amdgcn_sched_barrier(0);
#pragma unroll
        for (int ks = 0; ks < 2; ++ks) {
            bf16x8 af[4], bfr[4];
#pragma unroll
            for (int mt = 0; mt < 4; ++mt) af[mt] = *(const bf16x8*)(sA + ((wm * 4 + mt) * 2 + ks) * 1024 + fo);
#pragma unroll
            for (int nt = 0; nt < 4; ++nt) bfr[nt] = *(const bf16x8*)(sB + ((wn * 4 + nt) * 2 + ks) * 1024 + fo);
#pragma unroll
            for (int mt = 0; mt < 4; ++mt)
#pragma unroll
                for (int nt = 0; nt < 4; ++nt) acc[mt][nt] = __builtin_amdgcn_mfma_f32_16x16x32_bf16(bfr[nt], af[mt], acc[mt][nt], 0, 0, 0);
        }
        __syncthreads();
    };
    for (int k2 = 0; k2 < 8; ++k2) { step(2 * k2, r1); step(2 * k2 + 1, r0); }
#undef Ag
#undef Bg
#undef nAg
#undef nBg
}

__device__ void g1_phase(const Params& p, int l, char* smem) {
    const int t = tid_opq(), lane = t & 63, w = t >> 6, wm = w >> 1, wn = w & 1, r16 = lane & 15, quad = lane >> 4;
    char* sm = smem; char* sC = smem + 32768;
    const bf16_t* ubuf = (const bf16_t*)(p.ws + WS_U); const bf16_t* WinT = (const bf16_t*)(p.ws + WS_WINT) + (size_t)l * NPAD * 1024;
    bf16_t* z = (bf16_t*)(p.ws + WS_Z); float* kpart = (float*)(p.ws + WS_KPART);
    const float* cosT = (const float*)(p.ws + WS_COS); const float* sinT = (const float*)(p.ws + WS_SIN);
    const bool xo = (gridDim.x & 7) == 0; const int xcd = blockIdx.x & 7, nloc = xo ? (int)(gridDim.x >> 3) : (int)gridDim.x, j0 = xo ? (int)(blockIdx.x >> 3) : (int)blockIdx.x;
    const int lim = xo ? 16 * 27 : 128 * 27;
    RegSet r0, r1;
    for (int L = j0; L < lim; L += nloc) {
        const int tm = xo ? xcd * 16 + (L & 15) : L / 27, tn = xo ? (L >> 4) : L % 27;
        const int L2 = L + nloc; const bool has_next = L2 < lim;
        const int ntm = has_next ? (xo ? xcd * 16 + (L2 & 15) : L2 / 27) : tm, ntn = has_next ? (xo ? (L2 >> 4) : L2 % 27) : tn;
        f32x4 acc[4][4];
        gemm_tile(ubuf, WinT, tm, tn, L == j0, has_next, ntm, ntn, sm, acc, r0, r1);
        const bool rope = (tn < 4) || (tn >= 12 && tn < 16);
        if (rope) {
#pragma unroll
            for (int mt = 0; mt < 4; ++mt) {
                const int tok = tm * 128 + wm * 64 + mt * 16 + r16;
#pragma unroll
                for (int nt = 0; nt < 2; ++nt) {
                    const f32x4 cs = *(const f32x4*)(cosT + (size_t)tok * 32 + nt * 16 + quad * 4), sn = *(const f32x4*)(sinT + (size_t)tok * 32 + nt * 16 + quad * 4);
                    const f32x4 x1 = acc[mt][nt], x2 = acc[mt][nt + 2];
                    acc[mt][nt] = x1 * cs - x2 * sn; acc[mt][nt + 2] = x1 * sn + x2 * cs;
                }
            }
        }
        if (tn == 2 || tn == 3) {
#pragma unroll
            for (int nt = 0; nt < 4; ++nt) {
                f32x4 sv = (acc[0][nt] + acc[1][nt]) + (acc[2][nt] + acc[3][nt]);
#pragma unroll
                for (int jj = 0; jj < 4; ++jj) { float sx = sv[jj]; sx += __shfl_xor(sx, 1); sx += __shfl_xor(sx, 2); sx += __shfl_xor(sx, 4); sx += __shfl_xor(sx, 8); sv[jj] = sx; }
                if (r16 == 0) *(f32x4*)(kpart + (size_t)(tm * 2 + wm) * 256 + (tn - 2) * 128 + wn * 64 + nt * 16 + quad * 4) = sv;
            }
        }
#pragma unroll
        for (int mt = 0; mt < 4; ++mt)
#pragma unroll
            for (int nt = 0; nt < 4; ++nt) { u32x2 pk; pk.x = pack2(acc[mt][nt][0], acc[mt][nt][1]); pk.y = pack2(acc[mt][nt][2], acc[mt][nt][3]);
                const int row = wm * 64 + mt * 16 + r16; const int c16 = wn * 8 + nt * 2 + (quad >> 1);
                *(u32x2*)(sC + row * 256 + ((c16 ^ (row & 15)) << 4) + (quad & 1) * 8) = pk; }
        __syncthreads();
#pragma unroll
        for (int i = 0; i < 8; ++i) { const int c = t + 256 * i; const int row = c >> 4, ch = c & 15; const int col = tn * 128 + ch * 8;
            if (col < DIN) *(u32x4*)(z + (size_t)(tm * 128 + row) * ZP + col) = *(const u32x4*)(sC + row * 256 + ((ch ^ (row & 15)) << 4)); }
    }
}

__device__ void g2_phase(const Params& p, int l, char* smem) {
    const int t = tid_opq(), lane = t & 63, w = t >> 6, wm = w >> 1, wn = w & 1, r16 = lane & 15, quad = lane >> 4;
    char* sm = smem; char* sC = smem + 32768;
    const bf16_t* mix = (const bf16_t*)(p.ws + WS_U); const bf16_t* WoutT = (const bf16_t*)(p.ws + WS_WOUTT) + (size_t)l * 1024 * 1024;
    bf16_t* ybuf = (bf16_t*)(p.ws + WS_Z);
    const bool xo = (gridDim.x & 7) == 0; const int xcd = blockIdx.x & 7, nloc = xo ? (int)(gridDim.x >> 3) : (int)gridDim.x, j0 = xo ? (int)(blockIdx.x >> 3) : (int)blockIdx.x;
    const int lim = xo ? 16 * 8 : 128 * 8;
    RegSet r0, r1;
    for (int L = j0; L < lim; L += nloc) {
        const int tm = xo ? xcd * 16 + (L & 15) : (L >> 3), tn = xo ? (L >> 4) : (L & 7);
        const int L2 = L + nloc; const bool has_next = L2 < lim;
        const int ntm = has_next ? (xo ? xcd * 16 + (L2 & 15) : (L2 >> 3)) : tm, ntn = has_next ? (xo ? (L2 >> 4) : (L2 & 7)) : tn;
        f32x4 acc[4][4];
        gemm_tile(mix, WoutT, tm, tn, L == j0, has_next, ntm, ntn, sm, acc, r0, r1);
#pragma unroll
        for (int mt = 0; mt < 4; ++mt)
#pragma unroll
            for (int nt = 0; nt < 4; ++nt) { u32x2 pk; pk.x = pack2(acc[mt][nt][0], acc[mt][nt][1]); pk.y = pack2(acc[mt][nt][2], acc[mt][nt][3]);
                const int row = wm * 64 + mt * 16 + r16; const int c16 = wn * 8 + nt * 2 + (quad >> 1);
                *(u32x2*)(sC + row * 256 + ((c16 ^ (row & 15)) << 4) + (quad & 1) * 8) = pk; }
        __syncthreads();
#pragma unroll
        for (int i = 0; i < 8; ++i) { const int c = t + 256 * i; const int row = c >> 4, ch = c & 15;
            *(u32x4*)(ybuf + (size_t)(tm * 128 + row) * 1024 + tn * 128 + ch * 8) = *(const u32x4*)(sC + row * 256 + ((ch ^ (row & 15)) << 4)); }
    }
}

constexpr float ATT_SC = 0.18033688011112042f;
template <int QT>
__device__ __forceinline__ void attn_tile(const bf16_t* sK, const bf16_t* sV, const bf16x8 (&qf)[QT][2], int lo, int hi, bool full, bool hasq, bool qfl0, bool qfl1,
                                          float (&m)[QT], float (&l)[QT], f32x4 (&O)[QT][4], int wq0) {
    const int lane = tid_opq() & 63, r16 = lane & 15, quad = lane >> 4;
    f32x4 s[QT][4];
#pragma unroll
    for (int a = 0; a < QT; ++a)
#pragma unroll
        for (int b = 0; b < 4; ++b) s[a][b] = (f32x4){0.f, 0.f, 0.f, 0.f};
#pragma unroll
    for (int ks = 0; ks < 2; ++ks)
#pragma unroll
        for (int k16 = 0; k16 < 4; ++k16) {
            const bf16x8 kf = *(const bf16x8*)(sK + (k16 * 16 + r16) * LDP + ks * 32 + quad * 8);
#pragma unroll
            for (int qt = 0; qt < QT; ++qt) s[qt][k16] = __builtin_amdgcn_mfma_f32_16x16x32_bf16(kf, qf[qt][ks], s[qt][k16], 0, 0, 0);
        }
#pragma unroll
    for (int qt = 0; qt < QT; ++qt) {
        const int ql = wq0 + qt * 16 + r16; const bool qfl = qt ? qfl1 : qfl0;
        if (!full) {
#pragma unroll
            for (int k16 = 0; k16 < 4; ++k16)
#pragma unroll
                for (int j = 0; j < 4; ++j) { const int dd = ql - (k16 * 16 + quad * 4 + j); const bool valid = dd >= lo && dd <= hi; s[qt][k16][j] = valid ? s[qt][k16][j] : -1e30f; }
        }
        if (hasq) {
#pragma unroll
            for (int k16 = 0; k16 < 4; ++k16)
#pragma unroll
                for (int j = 0; j < 4; ++j) s[qt][k16][j] = qfl ? s[qt][k16][j] : -1e30f;
        }
        float mx = -1e30f;
#pragma unroll
        for (int k16 = 0; k16 < 4; ++k16) mx = fmaxf(mx, fmaxf(fmaxf(s[qt][k16][0], s[qt][k16][1]), fmaxf(s[qt][k16][2], s[qt][k16][3])));
        mx = fmaxf(mx, __shfl_xor(mx, 16)); mx = fmaxf(mx, __shfl_xor(mx, 32));
        const float mn = fmaxf(m[qt], mx); const float alpha = __builtin_amdgcn_exp2f((m[qt] - mn) * ATT_SC); m[qt] = mn;
        const float mb = (mn < -1e29f) ? 0.f : mn * ATT_SC;
        float ps = 0.f;
#pragma unroll
        for (int k16 = 0; k16 < 4; ++k16)
#pragma unroll
            for (int j = 0; j < 4; ++j) { const float pv = __builtin_amdgcn_exp2f(s[qt][k16][j] * ATT_SC - mb); ps += pv; s[qt][k16][j] = pv; }
        l[qt] = l[qt] * alpha + ps;
#pragma unroll
        for (int dt = 0; dt < 4; ++dt) O[qt][dt] = O[qt][dt] * alpha;
    }
#pragma unroll
    for (int G = 0; G < 2; ++G) {
        bf16x8 pf[QT];
#pragma unroll
        for (int qt = 0; qt < QT; ++qt) {
            const unsigned a0 = pack2(s[qt][G * 2][0], s[qt][G * 2][1]), a1 = pack2(s[qt][G * 2][2], s[qt][G * 2][3]);
            const unsigned a2 = pack2(s[qt][G * 2 + 1][0], s[qt][G * 2 + 1][1]), a3 = pack2(s[qt][G * 2 + 1][2], s[qt][G * 2 + 1][3]);
            u32x4 pk = {a0, a1, a2, a3}; pf[qt] = __builtin_bit_cast(bf16x8, pk);
        }
#pragma unroll
        for (int dt = 0; dt < 4; ++dt) {
            const bf16_t* v0p = sV + (G * 32 + quad * 4 + (r16 >> 2)) * LDP + dt * 16 + (r16 & 3) * 4;
            const bf16x4 v0 = __builtin_amdgcn_ds_read_tr16_b64_v4i16((__attribute__((address_space(3))) bf16x4*)(v0p));
            const bf16x4 v1 = __builtin_amdgcn_ds_read_tr16_b64_v4i16((__attribute__((address_space(3))) bf16x4*)(v0p + 16 * LDP));
            const bf16x8 vf = {v0[0], v0[1], v0[2], v0[3], v1[0], v1[1], v1[2], v1[3]};
#pragma unroll
            for (int qt = 0; qt < QT; ++qt) O[qt][dt] = __builtin_amdgcn_mfma_f32_16x16x32_bf16(vf, pf[qt], O[qt][dt], 0, 0, 0);
        }
    }
}

__device__ void attn_item(const Params& p, int kind, int idx, char* smem) {
    const int t = tid_opq(), lane = t & 63, w = t >> 6, r16 = lane & 15, quad = lane >> 4;
    bf16_t* sK = (bf16_t*)smem; bf16_t* sV = sK + 64 * LDP;
    float* kmean = (float*)(smem + 18432); float* gates = (float*)(smem + 22528); unsigned* selm = (unsigned*)(smem + 30720);
    int4* desc = (int4*)(smem + 31232); int* misc = (int*)(smem + 32320);
    const bf16_t* z = (const bf16_t*)(p.ws + WS_Z);
    int b, h, qbase, stride, qcol, kcol, vcol, cfg = 0;
    __syncthreads();
    if (kind == 0) {
        const int n = 15 - (idx >> 5); const int rem = idx & 31; b = rem >> 3; h = (rem >> 1) & 3; const int qh = rem & 1;
        qbase = b * S + n * 256 + qh * 128; stride = 1; qcol = C_AQ + h * 64; kcol = C_AK + h * 64; vcol = C_AV + h * 64;
        const float* kpart = (const float*)(p.ws + WS_KPART);
        for (int e = t; e < n * 64; e += 256) { const int j = e >> 6, d = e & 63; const float* kp = kpart + (size_t)(b * 64 + j * 4) * 256 + h * 64 + d;
            kmean[e] = ((kp[0] + kp[256]) + (kp[512] + kp[768])) * (1.f / 256.f); }
        if (t == 0) misc[1] = 0;
        __syncthreads();
        {
            const int ql = t >> 1, half = t & 1; const bf16_t* qp = z + (size_t)(qbase + ql) * ZP + qcol;
            float g[8];
#pragma unroll
            for (int jj = 0; jj < 8; ++jj) g[jj] = 0.f;
#pragma unroll 1
            for (int dc = 0; dc < 8; ++dc) {
                const u32x4 qv = *(const u32x4*)(qp + dc * 8); float qq[8];
#pragma unroll
                for (int e = 0; e < 4; ++e) { qq[2 * e] = __uint_as_float(qv[e] << 16); qq[2 * e + 1] = __uint_as_float(qv[e] & 0xffff0000u); }
#pragma unroll
                for (int jj = 0; jj < 8; ++jj) { const int j = half + 2 * jj; if (j < n) { const float* km = kmean + j * 64 + dc * 8;
#pragma unroll
                    for (int e = 0; e < 8; ++e) g[jj] += qq[e] * km[e]; } }
            }
#pragma unroll
            for (int jj = 0; jj < 8; ++jj) gates[ql * 16 + half + 2 * jj] = g[jj];
        }
        __syncthreads();
        if (t < 128) {
            unsigned msk = 0;
            for (int k = 0; k < 3 && k < n; ++k) { float best = -3.0e38f; int bi = -1;
                for (int j = 0; j < n; ++j) if (!((msk >> j) & 1u)) { const float gv = gates[t * 16 + j]; if (gv > best) { best = gv; bi = j; } }
                if (bi >= 0) msk |= 1u << bi; }
            selm[t] = msk; atomicOr((unsigned*)&misc[1], msk);
        }
        __syncthreads();
        if (t == 0) {
            int nd = 0; const unsigned bm = (unsigned)misc[1];
            for (int kt = 0; kt <= qh * 2 + 1; ++kt) desc[nd++] = make_int4(b * S + n * 256 + kt * 64, kt * 64 - qh * 128, BIG, -1);
            for (int j = 0; j < n; ++j) if ((bm >> j) & 1u) for (int kt = 0; kt < 4; ++kt) desc[nd++] = make_int4(b * S + j * 256 + kt * 64, -BIG, BIG, j);
            misc[0] = nd;
        }
    } else {
        cfg = idx >> 9; const int rem = idx & 511; b = rem >> 7; h = (rem >> 5) & 3; const int rb = rem & 31;
        const int dil = 1 << (2 * cfg); const int res = rb & (dil - 1), blk = rb >> (2 * cfg);
        qbase = b * S + blk * 128 * dil + res; stride = dil; qcol = C_CQ + h * 64; kcol = C_CK + h * 64; vcol = C_CV + h * 64;
        if (t < 128) selm[t] = 0xffffffffu;
        if (t == 0) { int nd = 0; for (int kt = (blk == 0 ? 2 : 0); kt < 4; ++kt) desc[nd++] = make_int4(b * S + (blk * 128 - 128 + kt * 64) * dil + res, kt * 64 - 128, kt * 64, -1); misc[0] = nd; }
    }
    __syncthreads();
    const int nd = misc[0];
    bf16x8 qf[2][2];
#pragma unroll
    for (int qt = 0; qt < 2; ++qt)
#pragma unroll
        for (int ks = 0; ks < 2; ++ks) qf[qt][ks] = *(const bf16x8*)(z + (size_t)(qbase + (w * 32 + qt * 16 + r16) * stride) * ZP + qcol + ks * 32 + quad * 8);
    const unsigned sel0 = selm[w * 32 + r16], sel1 = selm[w * 32 + 16 + r16];
    float m[2] = {-1e30f, -1e30f}, l[2] = {0.f, 0.f}; f32x4 O[2][4];
#pragma unroll
    for (int a = 0; a < 2; ++a)
#pragma unroll
        for (int c = 0; c < 4; ++c) O[a][c] = (f32x4){0.f, 0.f, 0.f, 0.f};
    const int lrow = t >> 2, lch = (t & 3) * 2;
    u32x4 rk0, rk1, rv0, rv1;
    if (nd > 0) { const int4 d = desc[0]; const bf16_t* rp = z + (size_t)(d.x + lrow * stride) * ZP + lch * 8;
        rk0 = *(const u32x4*)(rp + kcol); rk1 = *(const u32x4*)(rp + kcol + 8); rv0 = *(const u32x4*)(rp + vcol); rv1 = *(const u32x4*)(rp + vcol + 8); }
    for (int i = 0; i < nd; ++i) {
        __syncthreads();
        *(u32x4*)(sK + lrow * LDP + lch * 8) = rk0; *(u32x4*)(sK + lrow * LDP + lch * 8 + 8) = rk1;
        *(u32x4*)(sV + lrow * LDP + lch * 8) = rv0; *(u32x4*)(sV + lrow * LDP + lch * 8 + 8) = rv1;
        __syncthreads();
        if (i + 1 < nd) { const int4 d = desc[i + 1]; const bf16_t* rp = z + (size_t)(d.x + lrow * stride) * ZP + lch * 8;
            rk0 = *(const u32x4*)(rp + kcol); rk1 = *(const u32x4*)(rp + kcol + 8); rv0 = *(const u32x4*)(rp + vcol); rv1 = *(const u32x4*)(rp + vcol + 8); }
        const int4 d = desc[i];
        bool need = (w * 32 + 31 >= d.y) && (w * 32 - 63 <= d.z);
        bool q0 = true, q1 = true;
        if (d.w >= 0) { q0 = (sel0 >> d.w) & 1u; q1 = (sel1 >> d.w) & 1u; need = need && (__ballot(q0 || q1) != 0ull); }
        const bool full = (w * 32 - 63 >= d.y) && (w * 32 + 31 <= d.z);
        if (need) attn_tile<2>(sK, sV, qf, d.y, d.z, full, d.w >= 0, q0, q1, m, l, O, w * 32);
    }
#pragma unroll
    for (int qt = 0; qt < 2; ++qt) {
        float lt = l[qt]; lt += __shfl_xor(lt, 16); lt += __shfl_xor(lt, 32);
        const float inv = 1.f / lt; const size_t tok = (size_t)(qbase + (w * 32 + qt * 16 + r16) * stride);
        if (kind == 0) {
            bf16_t* mix = (bf16_t*)(p.ws + WS_U);
#pragma unroll
            for (int dt = 0; dt < 4; ++dt) { const int d0 = dt * 16 + quad * 4; const u32x2 gv = *(const u32x2*)(z + tok * ZP + C_AG + h * 64 + d0);
                const float g0 = __uint_as_float(gv.x << 16), g1 = __uint_as_float(gv.x & 0xffff0000u), g2 = __uint_as_float(gv.y << 16), g3 = __uint_as_float(gv.y & 0xffff0000u);
                u32x2 o; o.x = pack2(O[qt][dt][0] * inv * silu_f(g0), O[qt][dt][1] * inv * silu_f(g1)); o.y = pack2(O[qt][dt][2] * inv * silu_f(g2), O[qt][dt][3] * inv * silu_f(g3));
                *(u32x2*)(mix + tok * 1024 + h * 64 + d0) = o; }
        } else {
            bf16_t* dilo = (bf16_t*)(p.ws + WS_DILO); float* dill = (float*)(p.ws + WS_DILL);
#pragma unroll
            for (int dt = 0; dt < 4; ++dt) { const int d0 = dt * 16 + quad * 4; u32x2 o; o.x = pack2(O[qt][dt][0] * inv, O[qt][dt][1] * inv); o.y = pack2(O[qt][dt][2] * inv, O[qt][dt][3] * inv);
                *(u32x2*)(dilo + ((size_t)cfg * T + tok) * 256 + h * 64 + d0) = o; }
            if (quad == 0) dill[((size_t)cfg * T + tok) * 4 + h] = m[qt] * 0.125f + __logf(lt);
        }
    }
}

__device__ void moba_item(const Params& p, int idx, char* smem, bf16_t* outp) {
    const int t = tid_opq(), lane = t & 63, w = t >> 6, r16 = lane & 15, quad = lane >> 4;
    bf16_t* sK = (bf16_t*)smem; bf16_t* sV = sK + 64 * LDP;
    float* stO = (float*)(smem + 18432);
    float* kmean = (float*)(smem + 18432); float* gates = (float*)(smem + 22528);
    float* stM = (float*)(smem + 53248); float* stL = (float*)(smem + 53760);
    unsigned* selm = (unsigned*)(smem + 54272); unsigned char* lists = (unsigned char*)(smem + 54784);
    int* cnt = (int*)(smem + 56832); int4* desc = (int4*)(smem + 56960); int* misc = (int*)(smem + 59008);
    const bf16_t* z = (const bf16_t*)(p.ws + WS_Z);
    const int n = 15 - (idx >> 5); const int rem = idx & 31; const int b = rem >> 3, h = (rem >> 1) & 3, qh = rem & 1;
    const int qbase = b * S + n * 256 + qh * 128, qcol = C_AQ + h * 64, kcol = C_AK + h * 64, vcol = C_AV + h * 64;
    __syncthreads();
    {
        const float* kpart = (const float*)(p.ws + WS_KPART);
        for (int e = t; e < n * 64; e += 256) { const int j = e >> 6, d = e & 63; const float* kp = kpart + (size_t)(b * 64 + j * 4) * 256 + h * 64 + d;
            kmean[e] = ((kp[0] + kp[256]) + (kp[512] + kp[768])) * (1.f / 256.f); }
        if (t < 16) cnt[t] = 0;
        __syncthreads();
        {
            const int ql = t >> 1, half = t & 1; const bf16_t* qp = z + (size_t)(qbase + ql) * ZP + qcol;
            float g[8];
#pragma unroll
            for (int jj = 0; jj < 8; ++jj) g[jj] = 0.f;
#pragma unroll 1
            for (int dc = 0; dc < 8; ++dc) {
                const u32x4 qv = *(const u32x4*)(qp + dc * 8); float qq[8];
#pragma unroll
                for (int e = 0; e < 4; ++e) { qq[2 * e] = __uint_as_float(qv[e] << 16); qq[2 * e + 1] = __uint_as_float(qv[e] & 0xffff0000u); }
#pragma unroll
                for (int jj = 0; jj < 8; ++jj) { const int j = half + 2 * jj; if (j < n) { const float* km = kmean + j * 64 + dc * 8;
#pragma unroll
                    for (int e = 0; e < 8; ++e) g[jj] += qq[e] * km[e]; } }
            }
#pragma unroll
            for (int jj = 0; jj < 8; ++jj) gates[ql * 16 + half + 2 * jj] = g[jj];
        }
        __syncthreads();
        if (t < 128) {
            unsigned msk = 0;
            for (int k = 0; k < 3 && k < n; ++k) { float best = -3.0e38f; int bi = -1;
                for (int j = 0; j < n; ++j) if (!((msk >> j) & 1u)) { const float gv = gates[t * 16 + j]; if (gv > best) { best = gv; bi = j; } }
                if (bi >= 0) msk |= 1u << bi; }
            selm[t] = msk;
            for (int j = 0; j < n; ++j) if ((msk >> j) & 1u) { const int pos = atomicAdd(&cnt[j], 1); lists[j * 128 + pos] = (unsigned char)t; }
        }
        __syncthreads();
        if (t < 128) { for (int j = 0; j < n; ++j) { const int cj = cnt[j]; if (t >= cj && t < ((cj + 15) & ~15)) lists[j * 128 + t] = 255; } }
        if (t == 0) {
            int nd = 0;
            for (int kt = 0; kt <= qh * 2 + 1; ++kt) desc[nd++] = make_int4(b * S + n * 256 + kt * 64, kt * 64 - qh * 128, BIG, -1);
            misc[1] = nd;
            for (int j = 0; j < n; ++j) { const int ntl = (cnt[j] + 15) >> 4;
                for (int ps = 0; ps * 4 < ntl; ++ps) for (int kt = 0; kt < 4; ++kt) desc[nd++] = make_int4(b * S + j * 256 + kt * 64, ps, kt, j); }
            misc[0] = nd;
        }
    }
    __syncthreads();
    const int nd = misc[0], nown = misc[1];
    const int lrow = t >> 2, lch = (t & 3) * 2;
    u32x4 rk0, rk1, rv0, rv1;
    { const int4 d = desc[0]; const bf16_t* rp = z + (size_t)(d.x + lrow) * ZP + lch * 8;
      rk0 = *(const u32x4*)(rp + kcol); rk1 = *(const u32x4*)(rp + kcol + 8); rv0 = *(const u32x4*)(rp + vcol); rv1 = *(const u32x4*)(rp + vcol + 8); }
    bf16x8 nqf[2]; int ngq = 0; bool ngv = false, nhas = false;
    auto prefetch_group = [&](int gi) {
        nhas = false;
        if (gi < nd) { const int4 dg = desc[gi]; const int slot = dg.y * 4 + w; nhas = slot * 16 < cnt[dg.w];
            if (nhas) { const int qi = lists[dg.w * 128 + slot * 16 + r16]; ngv = qi != 255; ngq = ngv ? qi : 0;
#pragma unroll
                for (int ks = 0; ks < 2; ++ks) nqf[ks] = *(const bf16x8*)(z + (size_t)(qbase + ngq) * ZP + qcol + ks * 32 + quad * 8); } }
    };
    prefetch_group(nown);
    {
        bf16x8 qf[2][2];
#pragma unroll
        for (int qt = 0; qt < 2; ++qt)
#pragma unroll
            for (int ks = 0; ks < 2; ++ks) qf[qt][ks] = *(const bf16x8*)(z + (size_t)(qbase + w * 32 + qt * 16 + r16) * ZP + qcol + ks * 32 + quad * 8);
        float m[2] = {-1e30f, -1e30f}, l[2] = {0.f, 0.f}; f32x4 O[2][4];
#pragma unroll
        for (int a = 0; a < 2; ++a)
#pragma unroll
            for (int c = 0; c < 4; ++c) O[a][c] = (f32x4){0.f, 0.f, 0.f, 0.f};
        for (int i = 0; i < nown; ++i) {
            __syncthreads();
            *(u32x4*)(sK + lrow * LDP + lch * 8) = rk0; *(u32x4*)(sK + lrow * LDP + lch * 8 + 8) = rk1;
            *(u32x4*)(sV + lrow * LDP + lch * 8) = rv0; *(u32x4*)(sV + lrow * LDP + lch * 8 + 8) = rv1;
            __syncthreads();
            if (i + 1 < nd) { const int4 d = desc[i + 1]; const bf16_t* rp = z + (size_t)(d.x + lrow) * ZP + lch * 8;
                rk0 = *(const u32x4*)(rp + kcol); rk1 = *(const u32x4*)(rp + kcol + 8); rv0 = *(const u32x4*)(rp + vcol); rv1 = *(const u32x4*)(rp + vcol + 8); }
            const int4 d = desc[i];
            const bool need = (w * 32 + 31 >= d.y) && (w * 32 - 63 <= d.z);
            const bool full = (w * 32 - 63 >= d.y) && (w * 32 + 31 <= d.z);
            if (need) attn_tile<2>(sK, sV, qf, d.y, d.z, full, false, true, true, m, l, O, w * 32);
        }
#pragma unroll
        for (int qt = 0; qt < 2; ++qt) {
            float lt = l[qt]; lt += __shfl_xor(lt, 16); lt += __shfl_xor(lt, 32);
            const int ql = w * 32 + qt * 16 + r16;
            if (quad == 0) { stM[ql] = m[qt]; stL[ql] = lt; }
#pragma unroll
            for (int dt = 0; dt < 4; ++dt) *(f32x4*)(stO + ql * 68 + dt * 16 + quad * 4) = O[qt][dt];
        }
    }
    {
        bf16x8 qf[1][2]; float m[1] = {-1e30f}, l[1] = {0.f}; f32x4 O[1][4];
        int gq = 0; bool gv = false, has = false;
        for (int i = nown; i < nd; ++i) {
            __syncthreads();
            *(u32x4*)(sK + lrow * LDP + lch * 8) = rk0; *(u32x4*)(sK + lrow * LDP + lch * 8 + 8) = rk1;
            *(u32x4*)(sV + lrow * LDP + lch * 8) = rv0; *(u32x4*)(sV + lrow * LDP + lch * 8 + 8) = rv1;
            __syncthreads();
            if (i + 1 < nd) { const int4 d = desc[i + 1]; const bf16_t* rp = z + (size_t)(d.x + lrow) * ZP + lch * 8;
                rk0 = *(const u32x4*)(rp + kcol); rk1 = *(const u32x4*)(rp + kcol + 8); rv0 = *(const u32x4*)(rp + vcol); rv1 = *(const u32x4*)(rp + vcol + 8); }
            const int4 d = desc[i];
            if (d.z == 0) {
                has = nhas; gv = ngv; gq = ngq; qf[0][0] = nqf[0]; qf[0][1] = nqf[1];
                m[0] = -1e30f; l[0] = 0.f;
#pragma unroll
                for (int c = 0; c < 4; ++c) O[0][c] = (f32x4){0.f, 0.f, 0.f, 0.f};
                prefetch_group(i + 4);
            }
            if (has) {
                attn_tile<1>(sK, sV, qf, -BIG, BIG, true, false, true, true, m, l, O, 0);
                if (d.z == 3) {
                    float lt = l[0]; lt += __shfl_xor(lt, 16); lt += __shfl_xor(lt, 32);
                    if (gv) {
                        const float mo = stM[gq], lo_ = stL[gq]; const float mn = fmaxf(mo, m[0]);
                        const float fa = __builtin_amdgcn_exp2f((mo - mn) * ATT_SC), fb = __builtin_amdgcn_exp2f((m[0] - mn) * ATT_SC);
#pragma unroll
                        for (int dt = 0; dt < 4; ++dt) { float* sp = stO + gq * 68 + dt * 16 + quad * 4; const f32x4 so = *(const f32x4*)sp; *(f32x4*)sp = so * fa + O[0][dt] * fb; }
                        if (quad == 0) { stM[gq] = mn; stL[gq] = lo_ * fa + lt * fb; }
                    }
                }
            }
        }
    }
    __syncthreads();
#pragma unroll
    for (int qt = 0; qt < 2; ++qt) {
        const int ql = w * 32 + qt * 16 + r16; const float inv = 1.f / stL[ql]; const size_t tok = (size_t)(qbase + ql);
#pragma unroll
        for (int dt = 0; dt < 4; ++dt) { const int d0 = dt * 16 + quad * 4; const f32x4 ov = *(const f32x4*)(stO + ql * 68 + d0);
            const u32x2 gvv = *(const u32x2*)(z + tok * ZP + C_AG + h * 64 + d0);
            const float g0 = __uint_as_float(gvv.x << 16), g1 = __uint_as_float(gvv.x & 0xffff0000u), g2 = __uint_as_float(gvv.y << 16), g3 = __uint_as_float(gvv.y & 0xffff0000u);
            u32x2 o; o.x = pack2(ov[0] * inv * silu_f(g0), ov[1] * inv * silu_f(g1)); o.y = pack2(ov[2] * inv * silu_f(g2), ov[3] * inv * silu_f(g3));
            *(u32x2*)(outp + tok * 1024 + h * 64 + d0) = o; }
    }
}

__device__ __forceinline__ void gla_bcum(const Params& p, int l, const bf16_t* z, int tok0, float* bc, float* drs) {
    const int t = tid_opq();
    const int hd = t & 127, ih = t >> 7;
    float wr[16];
#pragma unroll
    for (int r = 0; r < 16; ++r) wr[r] = p.gla_wr[l * 2048 + r * 128 + hd];
    const float br = p.gla_br[l * 128 + hd];
    { const int e0 = t, e1 = t + 256; const bf16_t d0 = z[(size_t)(tok0 + (e0 >> 4)) * ZP + C_DR + (e0 & 15)], d1 = z[(size_t)(tok0 + (e1 >> 4)) * ZP + C_DR + (e1 & 15)];
      drs[e0] = bf2f(d0); drs[e1] = bf2f(d1); }
    __syncthreads();
#pragma unroll
    for (int ii = 0; ii < 16; ++ii) { const int i = ih * 16 + ii; float x = br;
#pragma unroll
        for (int r4 = 0; r4 < 4; ++r4) { const f32x4 dv = *(const f32x4*)(drs + i * 16 + r4 * 4); x += (dv[0] * wr[r4 * 4] + dv[1] * wr[r4 * 4 + 1]) + (dv[2] * wr[r4 * 4 + 2] + dv[3] * wr[r4 * 4 + 3]); }
        bc[i * 128 + hd] = (fminf(x, 0.f) - __logf(1.f + __expf(-fabsf(x)))) * (1.f / 16.f); }
    __syncthreads();
    if (t < 128) { float sacc = 0.f;
#pragma unroll
        for (int i = 0; i < 32; ++i) { sacc += bc[i * 128 + t]; bc[i * 128 + t] = sacc; } }
    __syncthreads();
}

__device__ void gla1_item(const Params& p, int l, int idx, char* smem) {
    const int t = tid_opq(), lane = t & 63, w = t >> 6, r16 = lane & 15, quad = lane >> 4;
    const int b = idx >> 7, c = idx & 127; const int tok0 = b * S + c * 32;
    const bf16_t* z = (const bf16_t*)(p.ws + WS_Z);
    float* bc = (float*)smem; float* drs = (float*)(smem + 16384);
    bf16_t* kdT = (bf16_t*)(smem + 18432) + w * 1024;
    bf16_t* vL = (bf16_t*)(smem + 26624) + w * (32 * LDP);
    float* gkv = (float*)(p.ws + WS_GKV); float* gdec = (float*)(p.ws + WS_GDEC);
    bf16_t kraw[16]; u32x4 vr[4];
#pragma unroll
    for (int i = 0; i < 16; ++i) { const int e = lane + 64 * i; kraw[i] = z[(size_t)(tok0 + (e >> 5)) * ZP + C_DK + w * 32 + (e & 31)]; }
#pragma unroll
    for (int i = 0; i < 4; ++i) { const int cc = lane + 64 * i; vr[i] = *(const u32x4*)(z + (size_t)(tok0 + (cc >> 3)) * ZP + C_DV + w * 64 + (cc & 7) * 8); }
    __syncthreads();
#pragma unroll
    for (int i = 0; i < 4; ++i) { const int cc = lane + 64 * i; *(u32x4*)(vL + (cc >> 3) * LDP + (cc & 7) * 8) = vr[i]; }
    gla_bcum(p, l, z, tok0, bc, drs);
#pragma unroll
    for (int i = 0; i < 16; ++i) { const int e = lane + 64 * i; const int j = e >> 5, d = e & 31;
        kdT[d * 32 + j] = f2bf(bf2f(kraw[i]) * __expf(bc[31 * 128 + w * 32 + d] - bc[j * 128 + w * 32 + d])); }
    const int bh = b * 4 + w;
    if (lane < 32) gdec[(bh * 128 + c) * 32 + lane] = __expf(bc[31 * 128 + w * 32 + lane]);
    __syncthreads();
    bf16x8 kf[2];
#pragma unroll
    for (int x = 0; x < 2; ++x) kf[x] = *(const bf16x8*)(kdT + (x * 16 + r16) * 32 + quad * 8);
    float* dst = gkv + (size_t)(bh * 128 + c) * 2048;
#pragma unroll
    for (int dt = 0; dt < 4; ++dt) {
        const bf16_t* v0p = vL + (quad * 8 + (r16 >> 2)) * LDP + dt * 16 + (r16 & 3) * 4;
        const bf16x4 v0 = __builtin_amdgcn_ds_read_tr16_b64_v4i16((__attribute__((address_space(3))) bf16x4*)(v0p));
        const bf16x4 v1 = __builtin_amdgcn_ds_read_tr16_b64_v4i16((__attribute__((address_space(3))) bf16x4*)(v0p + 4 * LDP));
        const bf16x8 vf = {v0[0], v0[1], v0[2], v0[3], v1[0], v1[1], v1[2], v1[3]};
#pragma unroll
        for (int x = 0; x < 2; ++x) {
            const f32x4 r = __builtin_amdgcn_mfma_f32_16x16x32_bf16(vf, kf[x], (f32x4){0.f, 0.f, 0.f, 0.f}, 0, 0, 0);
            *(f32x4*)(dst + (x * 16 + r16) * 64 + dt * 16 + quad * 4) = r;
        }
    }
}

#define OPQ(ptr) asm volatile("" : "+v"(ptr))
__device__ void gla3_item(const Params& p, int l, int idx, char* smem) {
    const int t = tid_opq(), lane = t & 63, w = t >> 6, r16 = lane & 15, quad = lane >> 4;
    const int b = idx >> 7, c = idx & 127; const int tok0 = b * S + c * 32;
    const bf16_t* z = (const bf16_t*)(p.ws + WS_Z); bf16_t* mix = (bf16_t*)(p.ws + WS_U);
    float* bc = (float*)smem; float* drs = (float*)(smem + 16384);
    bf16_t* SL = (bf16_t*)smem + w * (32 * LDP);
    bf16_t* qe = (bf16_t*)(smem + 18432) + w * 1024;
    bf16_t* ke = (bf16_t*)(smem + 26624) + w * 1024;
    bf16_t* vL = (bf16_t*)(smem + 34816) + w * (32 * LDP);
    const float* gkv = (const float*)(p.ws + WS_GKV);
    const int bh = b * 4 + w;
    bf16_t qraw[16], kraw[16];
    { const bf16_t* qp = z + (size_t)(tok0 + (lane >> 5)) * ZP + w * 32 + (lane & 31);
#pragma unroll
      for (int i = 0; i < 16; ++i) { qraw[i] = qp[C_DQ]; kraw[i] = qp[C_DK]; qp += 2 * ZP; OPQ(qp); } }
    u32x4 vr[4]; f32x4 sr[8];
#pragma unroll
    for (int i = 0; i < 4; ++i) { const int cc = lane + 64 * i; vr[i] = *(const u32x4*)(z + (size_t)(tok0 + (cc >> 3)) * ZP + C_DV + w * 64 + (cc & 7) * 8); }
    { const float* Sp = gkv + (size_t)(bh * 128 + c) * 2048;
#pragma unroll
      for (int i = 0; i < 8; ++i) sr[i] = *(const f32x4*)(Sp + (lane + 64 * i) * 4); }
    __syncthreads();
#pragma unroll
    for (int i = 0; i < 4; ++i) { const int cc = lane + 64 * i; *(u32x4*)(vL + (cc >> 3) * LDP + (cc & 7) * 8) = vr[i]; }
    gla_bcum(p, l, z, tok0, bc, drs);
#pragma unroll
    for (int i2 = 0; i2 < 16; ++i2) { const int e = lane + 64 * i2; const int i = e >> 5, d = e & 31; const float bcv = bc[i * 128 + w * 32 + d];
        qe[i * 32 + d] = f2bf(bf2f(qraw[i2]) * __expf(bcv) * 0.17677669529663687f); ke[i * 32 + d] = f2bf(bf2f(kraw[i2]) * __expf(-bcv)); }
    __syncthreads();
#pragma unroll
    for (int i = 0; i < 8; ++i) { const int cc = lane + 64 * i; const int d = cc >> 4, v4 = cc & 15; u32x2 pk; pk.x = pack2(sr[i][0], sr[i][1]); pk.y = pack2(sr[i][2], sr[i][3]);
        *(u32x2*)(SL + d * LDP + v4 * 4) = pk; }
    __syncthreads();
    bf16x8 qf[2], kf[2];
#pragma unroll
    for (int x = 0; x < 2; ++x) { qf[x] = *(const bf16x8*)(qe + (x * 16 + r16) * 32 + quad * 8); kf[x] = *(const bf16x8*)(ke + (x * 16 + r16) * 32 + quad * 8); }
    bf16x8 pf[2];
#pragma unroll
    for (int it = 0; it < 2; ++it) {
        f32x4 at[2];
#pragma unroll
        for (int jt = 0; jt < 2; ++jt) { at[jt] = __builtin_amdgcn_mfma_f32_16x16x32_bf16(kf[jt], qf[it], (f32x4){0.f, 0.f, 0.f, 0.f}, 0, 0, 0);
#pragma unroll
            for (int jj = 0; jj < 4; ++jj) at[jt][jj] = (jt * 16 + quad * 4 + jj <= it * 16 + r16) ? at[jt][jj] : 0.f; }
        u32x4 pk = {pack2(at[0][0], at[0][1]), pack2(at[0][2], at[0][3]), pack2(at[1][0], at[1][1]), pack2(at[1][2], at[1][3])};
        pf[it] = __builtin_bit_cast(bf16x8, pk);
    }
    f32x4 O[2][4];
#pragma unroll
    for (int dt = 0; dt < 4; ++dt) {
        const bf16_t* v0p = vL + (quad * 4 + (r16 >> 2)) * LDP + dt * 16 + (r16 & 3) * 4;
        const bf16x4 v0 = __builtin_amdgcn_ds_read_tr16_b64_v4i16((__attribute__((address_space(3))) bf16x4*)(v0p));
        const bf16x4 v1 = __builtin_amdgcn_ds_read_tr16_b64_v4i16((__attribute__((address_space(3))) bf16x4*)(v0p + 16 * LDP));
        const bf16x8 vf = {v0[0], v0[1], v0[2], v0[3], v1[0], v1[1], v1[2], v1[3]};
        const bf16_t* s0p = SL + (quad * 8 + (r16 >> 2)) * LDP + dt * 16 + (r16 & 3) * 4;
        const bf16x4 s0 = __builtin_amdgcn_ds_read_tr16_b64_v4i16((__attribute__((address_space(3))) bf16x4*)(s0p));
        const bf16x4 s1 = __builtin_amdgcn_ds_read_tr16_b64_v4i16((__attribute__((address_space(3))) bf16x4*)(s0p + 4 * LDP));
        const bf16x8 sf = {s0[0], s0[1], s0[2], s0[3], s1[0], s1[1], s1[2], s1[3]};
#pragma unroll
        for (int it = 0; it < 2; ++it) {
            O[it][dt] = __builtin_amdgcn_mfma_f32_16x16x32_bf16(vf, pf[it], (f32x4){0.f, 0.f, 0.f, 0.f}, 0, 0, 0);
            O[it][dt] = __builtin_amdgcn_mfma_f32_16x16x32_bf16(sf, qf[it], O[it][dt], 0, 0, 0);
        }
    }
#pragma unroll
    for (int it = 0; it < 2; ++it) {
        float ss = 0.f;
#pragma unroll
        for (int dt = 0; dt < 4; ++dt) ss += (O[it][dt][0] * O[it][dt][0] + O[it][dt][1] * O[it][dt][1]) + (O[it][dt][2] * O[it][dt][2] + O[it][dt][3] * O[it][dt][3]);
        ss += __shfl_xor(ss, 16); ss += __shfl_xor(ss, 32);
        const float rn = rsqrtf(ss * (1.f / 64.f) + 1e-5f);
        const size_t tok = (size_t)(tok0 + it * 16 + r16);
#pragma unroll
        for (int dt = 0; dt < 4; ++dt) { const int v0i = dt * 16 + quad * 4; const f32x4 gn = *(const f32x4*)(p.gla_gn + l * 64 + v0i);
            const u32x2 gv = *(const u32x2*)(z + tok * ZP + C_DG + w * 64 + v0i);
            const float g0 = __uint_as_float(gv.x << 16), g1 = __uint_as_float(gv.x & 0xffff0000u), g2 = __uint_as_float(gv.y << 16), g3 = __uint_as_float(gv.y & 0xffff0000u);
            u32x2 o; o.x = pack2(O[it][dt][0] * rn * gn[0] * silu_f(g0), O[it][dt][1] * rn * gn[1] * silu_f(g1));
            o.y = pack2(O[it][dt][2] * rn * gn[2] * silu_f(g2), O[it][dt][3] * rn * gn[3] * silu_f(g3));
            *(u32x2*)(mix + tok * 1024 + 768 + w * 64 + v0i) = o; }
    }
}

__device__ void lru1_item(const Params& p, int l, int idx, char* smem) {
    const int t = tid_opq(), lane = t & 63, g = t >> 6, r16 = lane & 15, quad = lane >> 4; const int ch = t;
    const int b = idx >> 7, c = idx & 127; const int s0 = c * 32; const int tok0 = b * S + s0;
    const bf16_t* z = (const bf16_t*)(p.ws + WS_Z); float* xcs = (float*)smem;
    bf16_t* preA = (bf16_t*)(smem + 32768); bf16_t* preX = (bf16_t*)(smem + 49152);
    float* lh = (float*)(p.ws + WS_LH); float* lp = (float*)(p.ws + WS_LP);
    bf16_t xr[35];
#pragma unroll
    for (int i = 0; i < 35; ++i) { const int sidx = s0 + i - 3; xr[i] = (sidx >= 0) ? z[(size_t)(tok0 + i - 3) * ZP + C_BX + ch] : (bf16_t)0; }
    const float cw0 = p.conv_w[l * 1024 + ch], cw1 = p.conv_w[l * 1024 + 256 + ch], cw2 = p.conv_w[l * 1024 + 512 + ch], cw3 = p.conv_w[l * 1024 + 768 + ch];
    const float cb = p.conv_b[l * 256 + ch];
    const bf16_t* lwt = (const bf16_t*)(p.ws + WS_LWT) + (size_t)l * 32768 + g * 4096;
    bf16x8 wfa[4][2], wfx[4][2];
#pragma unroll
    for (int nt = 0; nt < 4; ++nt)
#pragma unroll
        for (int ks = 0; ks < 2; ++ks) { wfa[nt][ks] = *(const bf16x8*)(lwt + (nt * 16 + r16) * 64 + ks * 32 + quad * 8); wfx[nt][ks] = *(const bf16x8*)(lwt + 16384 + (nt * 16 + r16) * 64 + ks * 32 + quad * 8); }
    __syncthreads();
#pragma unroll
    for (int i = 0; i < 32; ++i) xcs[i * 256 + ch] = cb + (cw0 * bf2f(xr[i]) + cw1 * bf2f(xr[i + 1])) + (cw2 * bf2f(xr[i + 2]) + cw3 * bf2f(xr[i + 3]));
    __syncthreads();
#pragma unroll
    for (int tt = 0; tt < 2; ++tt) {
        bf16x8 xf[2];
#pragma unroll
        for (int ks = 0; ks < 2; ++ks) { const float* xp = xcs + (tt * 16 + r16) * 256 + g * 64 + ks * 32 + quad * 8; const f32x4 x0 = *(const f32x4*)xp, x1 = *(const f32x4*)(xp + 4);
            u32x4 pk = {pack2(x0[0], x0[1]), pack2(x0[2], x0[3]), pack2(x1[0], x1[1]), pack2(x1[2], x1[3])}; xf[ks] = __builtin_bit_cast(bf16x8, pk); }
#pragma unroll
        for (int nt = 0; nt < 4; ++nt) {
            f32x4 ra = __builtin_amdgcn_mfma_f32_16x16x32_bf16(wfa[nt][0], xf[0], (f32x4){0.f, 0.f, 0.f, 0.f}, 0, 0, 0); ra = __builtin_amdgcn_mfma_f32_16x16x32_bf16(wfa[nt][1], xf[1], ra, 0, 0, 0);
            f32x4 rx = __builtin_amdgcn_mfma_f32_16x16x32_bf16(wfx[nt][0], xf[0], (f32x4){0.f, 0.f, 0.f, 0.f}, 0, 0, 0); rx = __builtin_amdgcn_mfma_f32_16x16x32_bf16(wfx[nt][1], xf[1], rx, 0, 0, 0);
            u32x2 pa; pa.x = pack2(ra[0], ra[1]); pa.y = pack2(ra[2], ra[3]); u32x2 px; px.x = pack2(rx[0], rx[1]); px.y = pack2(rx[2], rx[3]);
            *(u32x2*)(preA + (tt * 16 + r16) * 256 + g * 64 + nt * 16 + quad * 4) = pa; *(u32x2*)(preX + (tt * 16 + r16) * 256 + g * 64 + nt * 16 + quad * 4) = px;
        }
    }
    __syncthreads();
    const float ba = p.lru_ba[l * 256 + ch], bx = p.lru_bx[l * 256 + ch], lam = p.lru_lam[l * 256 + ch];
    const float sp = fmaxf(-lam, 0.f) + log1pf(__expf(-fabsf(lam)));
    float hh = 0.f, P = 1.f;
    float* lhp = lh + (size_t)tok0 * 256 + ch; float* lpp = lp + (size_t)tok0 * 256 + ch;
#pragma unroll 4
    for (int i = 0; i < 32; ++i) { const float r = sigmoid_f(bf2f(preA[i * 256 + ch]) + ba), ig = sigmoid_f(bf2f(preX[i * 256 + ch]) + bx); const float la = -8.f * r * sp; const float a = __expf(la);
        const float u = sqrtf(-expm1f(2.f * la)) * (ig * xcs[i * 256 + ch]); hh = a * hh + u; P *= a;
        lhp[(size_t)i * 256] = hh; lpp[(size_t)i * 256] = P; }
}

__device__ void lru3_item(const Params& p, int idx) {
    const int ch = tid_opq(); const int b = idx >> 7, c = idx & 127; const int tok0 = b * S + c * 32;
    const bf16_t* z = (const bf16_t*)(p.ws + WS_Z); bf16_t* mix = (bf16_t*)(p.ws + WS_U);
    const float* lh = (const float*)(p.ws + WS_LH); const float* lp = (const float*)(p.ws + WS_LP); const float* lc = (const float*)(p.ws + WS_LC);
    const float carry = lc[(size_t)(b * 128 + c) * 256 + ch];
    float hv[32], pv[32]; bf16_t gv[32];
#pragma unroll
    for (int i = 0; i < 32; ++i) { const size_t tok = (size_t)(tok0 + i); hv[i] = lh[tok * 256 + ch]; pv[i] = lp[tok * 256 + ch]; gv[i] = z[tok * ZP + C_BG + ch]; }
#pragma unroll
    for (int i = 0; i < 32; ++i) { const size_t tok = (size_t)(tok0 + i); mix[tok * 1024 + 256 + ch] = f2bf((hv[i] + pv[i] * carry) * silu_f(bf2f(gv[i]))); }
}

__device__ void dilc_item(const Params& p, int idx) {
    const int t = tid_opq(); const size_t tok = (size_t)idx * 8 + (t >> 5); const int chn = t & 31; const int h = chn >> 3;
    const bf16_t* z = (const bf16_t*)(p.ws + WS_Z); bf16_t* mix = (bf16_t*)(p.ws + WS_U);
    const bf16_t* dilo = (const bf16_t*)(p.ws + WS_DILO); const float* dill = (const float*)(p.ws + WS_DILL);
    const float l0 = dill[((size_t)0 * T + tok) * 4 + h], l1 = dill[((size_t)1 * T + tok) * 4 + h], l2 = dill[((size_t)2 * T + tok) * 4 + h];
    const float mx = fmaxf(l0, fmaxf(l1, l2)); float w0 = __expf(l0 - mx), w1 = __expf(l1 - mx), w2 = __expf(l2 - mx); const float inv = 1.f / (w0 + w1 + w2); w0 *= inv; w1 *= inv; w2 *= inv;
    const u32x4 o0 = *(const u32x4*)(dilo + ((size_t)0 * T + tok) * 256 + chn * 8), o1 = *(const u32x4*)(dilo + ((size_t)1 * T + tok) * 256 + chn * 8), o2 = *(const u32x4*)(dilo + ((size_t)2 * T + tok) * 256 + chn * 8);
    const u32x4 gv = *(const u32x4*)(z + tok * ZP + C_CG + chn * 8);
    u32x4 r;
#pragma unroll
    for (int e = 0; e < 4; ++e) {
        const float a = w0 * __uint_as_float(o0[e] << 16) + w1 * __uint_as_float(o1[e] << 16) + w2 * __uint_as_float(o2[e] << 16);
        const float bq = w0 * __uint_as_float(o0[e] & 0xffff0000u) + w1 * __uint_as_float(o1[e] & 0xffff0000u) + w2 * __uint_as_float(o2[e] & 0xffff0000u);
        r[e] = pack2(a * silu_f(__uint_as_float(gv[e] << 16)), bq * silu_f(__uint_as_float(gv[e] & 0xffff0000u)));
    }
    *(u32x4*)(mix + tok * 1024 + 512 + chn * 8) = r;
}

__device__ void m2_phase(const Params& p, char* smem) {
    float* gkv = (float*)(p.ws + WS_GKV); const float* gdec = (const float*)(p.ws + WS_GDEC);
    const float* lh = (const float*)(p.ws + WS_LH); const float* lp = (const float*)(p.ws + WS_LP); float* lc = (float*)(p.ws + WS_LC);
    float* aggP = (float*)smem; float* aggS = aggP + 256;
    const int t = tid_opq(); const int e = t & 31, seg = t >> 5;
    for (int it = blockIdx.x; it < 1024 + 32; it += gridDim.x) {
        float a[16], x[16];
        size_t ostride;
        float* outp;
        if (it < 1024) {
            const int gid = it * 32 + e; const int bh = gid >> 11, dv = gid & 2047, d = dv >> 6;
            float* base = gkv + (size_t)bh * 128 * 2048 + dv + (size_t)(seg * 16) * 2048; const float* dc = gdec + (size_t)bh * 128 * 32 + d + (seg * 16) * 32;
#pragma unroll
            for (int k = 0; k < 16; ++k) { x[k] = base[(size_t)k * 2048]; a[k] = dc[k * 32]; }
            outp = base; ostride = 2048;
        } else {
            const int i2 = it - 1024; const int b = i2 >> 3, ch = (i2 & 7) * 32 + e;
#pragma unroll
            for (int k = 0; k < 16; ++k) { const size_t ix = (size_t)(b * S + (seg * 16 + k) * 32 + 31) * 256 + ch; a[k] = lp[ix]; x[k] = lh[ix]; }
            outp = lc + (size_t)(b * 128 + seg * 16) * 256 + ch; ostride = 256;
        }
        float st = 0.f, pr = 1.f;
#pragma unroll
        for (int k = 0; k < 16; ++k) { const float ak = a[k], xk = x[k]; a[k] = pr; x[k] = st; st = ak * st + xk; pr *= ak; }
        __syncthreads();
        aggP[seg * 32 + e] = pr; aggS[seg * 32 + e] = st;
        __syncthreads();
        float carry = 0.f;
        for (int s2 = 0; s2 < seg; ++s2) carry = aggP[s2 * 32 + e] * carry + aggS[s2 * 32 + e];
#pragma unroll
        for (int k = 0; k < 16; ++k) outp[(size_t)k * ostride] = x[k] + a[k] * carry;
    }
}

__global__ void __launch_bounds__(256, 2) fwd_megakernel(Params p) {
    __shared__ __attribute__((aligned(16))) char smem[SMEM_BYTES];
    __shared__ uint4 xb_words;
    __shared__ int s_slot;
    cg::grid_group grid = cg::this_grid();
    if (p.out == nullptr) grid.sync();
    if (threadIdx.x == 0) xb_words = make_uint4(0u, 0u, 0u, 0u);
    __syncthreads();
    const XcdBarrier xb = xcd_barrier_post((unsigned*)(p.ws + WS_CTL), (volatile LAS unsigned*)&xb_words);
    unsigned* cnt = (unsigned*)(p.ws + WS_CNT);
    prologue_phase(p, smem);
    xcd_barrier(xb);
#pragma unroll 1
    for (int l = 0; l < DEPTH; ++l) {
        ln_phase(p, l);
        xcd_barrier(xb);
        g1_phase(p, l, smem);
        xcd_barrier(xb);
        for (;;) { const int it = next_item(cnt + (0 + l) * 64, &s_slot); if (it >= 512) break; moba_item(p, it, smem, (bf16_t*)(p.ws + WS_U)); }
        for (;;) { const int it = next_item(cnt + (6 + l) * 64, &s_slot); if (it >= 1536) break; attn_item(p, 1, it, smem); }
        for (;;) { const int it = next_item(cnt + (2 + l) * 64, &s_slot); if (it >= 512) break; gla1_item(p, l, it, smem); }
        for (;;) { const int it = next_item(cnt + (4 + l) * 64, &s_slot); if (it >= 512) break; lru1_item(p, l, it, smem); }
        xcd_barrier(xb);
        m2_phase(p, smem);
        xcd_barrier(xb);
        for (int it = blockIdx.x; it < 512; it += gridDim.x) gla3_item(p, l, it, smem);
        for (int it = blockIdx.x; it < 512; it += gridDim.x) lru3_item(p, it);
        for (int it = blockIdx.x; it < 2048; it += gridDim.x) dilc_item(p, it);
        xcd_barrier(xb);
        g2_phase(p, l, smem);
        xcd_barrier(xb);
    }
    ln_phase(p, DEPTH);
}

extern "C" void kernel_launch(void* const* d_in, const int* in_sizes, int n_in, void* d_out, int out_size, void* d_ws, size_t ws_size, hipStream_t stream) {
    static int grid_blocks = 0;
    if (!grid_blocks) {
        int dev = 0, cus = 0, per_cu = 0;
        hipGetDevice(&dev);
        hipDeviceGetAttribute(&cus, hipDeviceAttributeMultiprocessorCount, dev);
        hipOccupancyMaxActiveBlocksPerMultiprocessor(&per_cu, (const void*)fwd_megakernel, 256, 0);
        if (per_cu < 1) per_cu = 1;
        if (per_cu > 2) per_cu = 2;
        grid_blocks = cus * per_cu;
        if (ws_size < WS_END) fprintf(stderr, "kernel_launch: workspace too small: %zu < %zu\n", ws_size, (size_t)WS_END);
    }
    Params p{};
    p.x = (const float*)d_in[0]; p.c = (const float*)d_in[1]; p.pos = (const int*)d_in[2];
    p.w_mod = (const float*)d_in[3]; p.b_mod = (const float*)d_in[4]; p.w_in = (const float*)d_in[5];
    p.conv_w = (const float*)d_in[6]; p.conv_b = (const float*)d_in[7]; p.lru_wa = (const float*)d_in[8]; p.lru_ba = (const float*)d_in[9];
    p.lru_wx = (const float*)d_in[10]; p.lru_bx = (const float*)d_in[11]; p.lru_lam = (const float*)d_in[12];
    p.gla_wr = (const float*)d_in[13]; p.gla_br = (const float*)d_in[14]; p.gla_gn = (const float*)d_in[15];
    p.w_out = (const float*)d_in[16]; p.ln_g = (const float*)d_in[17]; p.ln_b = (const float*)d_in[18];
    p.out = (float*)d_out; p.ws = (unsigned char*)d_ws;
    (void)hipMemsetAsync(d_ws, 0, 32768, stream);
    void* args[] = {&p};
    hipError_t e = hipLaunchCooperativeKernel((const void*)fwd_megakernel, dim3(grid_blocks), dim3(256), args, 0, stream);
    if (e != hipSuccess) fprintf(stderr, "cooperative launch failed: %s (grid %d)\n", hipGetErrorString(e), grid_blocks);
}
```

```cpp
#include <hip/hip_runtime.h>
#include <hip/hip_cooperative_groups.h>
#include <cstdio>
#include <cstdint>
#include <type_traits>
namespace cg = cooperative_groups;

typedef unsigned short bf16_t;
typedef short bf16x8 __attribute__((ext_vector_type(8)));
typedef short bf16x4 __attribute__((ext_vector_type(4)));
typedef float f32x4 __attribute__((ext_vector_type(4)));
typedef unsigned u32x4 __attribute__((ext_vector_type(4)));
typedef unsigned u32x2 __attribute__((ext_vector_type(2)));

constexpr int D = 1024, NB = 4, S = 4096, T = NB * S, DEPTH = 2;
constexpr int DIN = 3344, ZP = 3344, NPAD = 3456;
constexpr int C_AQ = 0, C_AK = 256, C_AV = 512, C_AG = 768, C_BX = 1024, C_BG = 1280, C_CQ = 1536, C_CK = 1792,
              C_CV = 2048, C_CG = 2304, C_DQ = 2560, C_DK = 2688, C_DV = 2816, C_DG = 3072, C_DR = 3328;
constexpr float DN_ALPHA = 1.4142135623730951f;
constexpr int LDP = 72;
constexpr int SMEM_BYTES = 65536;
constexpr int BIG = 1000000;

constexpr size_t WS_CTL = 0;
constexpr size_t WS_CNT = 16384;
constexpr size_t WS_WINT = 32768;
constexpr size_t WS_WOUTT = WS_WINT + (size_t)DEPTH * NPAD * 1024 * 2;
constexpr size_t WS_MOD = WS_WOUTT + (size_t)DEPTH * 1024 * 1024 * 2;
constexpr size_t WS_COS = WS_MOD + (size_t)DEPTH * NB * 3072 * 4;
constexpr size_t WS_SIN = WS_COS + (size_t)T * 32 * 4;
constexpr size_t WS_U = WS_SIN + (size_t)T * 32 * 4;
constexpr size_t WS_Z = WS_U + (size_t)T * 1024 * 2;
constexpr size_t WS_KPART = WS_Z + (size_t)T * ZP * 2;
constexpr size_t WS_DILO = WS_KPART + (size_t)256 * 256 * 4;
constexpr size_t WS_DILL = WS_DILO + (size_t)3 * T * 256 * 2;
constexpr size_t WS_GKV = WS_DILL + (size_t)3 * T * 4 * 4;
constexpr size_t WS_GDEC = WS_GKV + (size_t)2048 * 2048 * 4;
constexpr size_t WS_LH = WS_GDEC + (size_t)2048 * 32 * 4;
constexpr size_t WS_LP = WS_LH + (size_t)T * 256 * 4;
constexpr size_t WS_LC = WS_LP + (size_t)T * 256 * 4;
constexpr size_t WS_LWT = WS_LC + (size_t)NB * 128 * 256 * 4;
constexpr size_t WS_END = WS_LWT + (size_t)DEPTH * 2 * 4 * 64 * 64 * 2;

struct Params {
    const float *x, *c; const int* pos;
    const float *w_mod, *b_mod, *w_in, *conv_w, *conv_b, *lru_wa, *lru_ba, *lru_wx, *lru_bx, *lru_lam, *gla_wr, *gla_br, *gla_gn, *w_out, *ln_g, *ln_b;
    float* out; unsigned char* ws;
};

__device__ __forceinline__ float bf2f(bf16_t h) { return __uint_as_float(((unsigned)h) << 16); }
typedef __bf16 hbf16x2 __attribute__((ext_vector_type(2)));
typedef float f32x2 __attribute__((ext_vector_type(2)));
__device__ __forceinline__ unsigned pack2(float a, float b) { f32x2 v = {a, b}; hbf16x2 r = __builtin_convertvector(v, hbf16x2); return __builtin_bit_cast(unsigned, r); }
__device__ __forceinline__ bf16_t f2bf(float f) { return (bf16_t)(pack2(f, 0.f) & 0xffffu); }
__device__ __forceinline__ float silu_f(float x) { return x / (1.f + __expf(-x)); }
__device__ __forceinline__ float sigmoid_f(float x) { return 1.f / (1.f + __expf(-x)); }
__device__ __forceinline__ int tid_opq() { int t = threadIdx.x; asm volatile("" : "+v"(t)); return t; }
__device__ __forceinline__ float wsum(float v) {
#pragma unroll
    for (int o = 32; o; o >>= 1) v += __shfl_xor(v, o);
    return v;
}

#define XB_TMO      128
#define XB_XCNT(j)  (256  + 64 * (j))
#define XB_XSUB(j)  (1280 + 64 * (j))
#define XB_XGEN(j)  (2304 + 64 * (j))
#define XB_TOP      3328
#define XB_TOPGEN   3392
#define XCD_BAR_WORDS 3456
#define XB_SPIN_CAP (1u << 18)
#define LAS __attribute__((address_space(3)))
__device__ __forceinline__ unsigned xb_ld(unsigned* p)              { return __hip_atomic_load(p, __ATOMIC_RELAXED, __HIP_MEMORY_SCOPE_AGENT); }
__device__ __forceinline__ unsigned xb_add(unsigned* p, unsigned v) { return __hip_atomic_fetch_add(p, v, __ATOMIC_RELAXED, __HIP_MEMORY_SCOPE_AGENT); }
__device__ __forceinline__ unsigned xb_xcc_id() { return (unsigned)__builtin_amdgcn_s_getreg((3 << 11) | 20) & 0xFu; }
#define XB_SPIN(cond, bar) do { unsigned _sp = 0; while (cond) { __builtin_amdgcn_s_sleep(1); \
    if ((++_sp & 255u) == 0u) { if (xb_ld(&(bar)[XB_TMO])) break; if (_sp > XB_SPIN_CAP) { atomicAdd(&(bar)[XB_TMO], 1u); break; } } } } while (0)
struct XcdBarrier { unsigned* bar; unsigned x; volatile LAS unsigned* st; };
__device__ __forceinline__ XcdBarrier xcd_barrier_post(unsigned* bar, volatile LAS unsigned* st) {
    XcdBarrier b; b.bar = bar; b.x = xb_xcc_id(); b.st = st;
    if (threadIdx.x == 0) (void)xb_add(&bar[XB_XCNT(b.x)], 1u);
    return b;
}
__device__ __forceinline__ void xcd_barrier_complete(unsigned* bar, unsigned x, unsigned& nloc, unsigned& nx) {
    const unsigned G = gridDim.x * gridDim.y * gridDim.z;
    unsigned sum, cnt, mine, sp = 0u;
    for (;;) {
        sum = 0u; cnt = 0u; mine = 0u;
#pragma unroll
        for (unsigned j = 0; j < 16; ++j) { const unsigned c = xb_ld(&bar[XB_XCNT(j)]); sum += c; cnt += (c > 0u) ? 1u : 0u; mine = (j == x) ? c : mine; }
        if (sum == G) break;
        __builtin_amdgcn_s_sleep(1);
        if ((++sp & 255u) == 0u) { if (xb_ld(&bar[XB_TMO])) break; if (sp > XB_SPIN_CAP) { atomicAdd(&bar[XB_TMO], 1u); break; } }
    }
    nloc = mine > 0u ? mine : 1u; nx = cnt > 0u ? cnt : 1u;
}
__device__ __forceinline__ void xcd_barrier(const XcdBarrier& b) {
    asm volatile("s_waitcnt vmcnt(0)" ::: "memory");
    __syncthreads();
    if (threadIdx.x == 0) {
        unsigned* bar = b.bar;
        __builtin_amdgcn_s_waitcnt(0);
        unsigned nloc = b.st[0], nx = b.st[1];
        if (nloc == 0u) { xcd_barrier_complete(bar, b.x, nloc, nx); b.st[0] = nloc; b.st[1] = nx; }
        const unsigned old = xb_add(&bar[XB_XSUB(b.x)], 1u);
        const unsigned gen = old / nloc;
        if (old + 1u == (gen + 1u) * nloc) {
            __builtin_amdgcn_fence(__ATOMIC_RELEASE, "agent");
            asm volatile("s_waitcnt vmcnt(0)" ::: "memory");
            const unsigned og = xb_add(&bar[XB_TOP], 1u);
            const unsigned tg = og / nx;
            if (og + 1u == (tg + 1u) * nx) xb_add(&bar[XB_TOPGEN], 1u);
            else XB_SPIN(xb_ld(&bar[XB_TOPGEN]) == tg, bar);
            __builtin_amdgcn_fence(__ATOMIC_ACQUIRE, "agent");
            xb_add(&bar[XB_XGEN(b.x)], 1u);
            asm volatile("s_waitcnt vmcnt(0)" ::: "memory");
        } else {
            XB_SPIN(xb_ld(&bar[XB_XGEN(b.x)]) == gen, bar);
            __builtin_amdgcn_fence(__ATOMIC_ACQUIRE, "agent");
            asm volatile("s_waitcnt vmcnt(0)" ::: "memory");
        }
    }
    __syncthreads();
}
__device__ __forceinline__ int next_item(unsigned* ctr, volatile int* slot) {
    __syncthreads();
    if (threadIdx.x == 0) *slot = (int)atomicAdd(ctr, 1u);
    __syncthreads();
    return *slot;
}

__device__ void prologue_phase(const Params& p, char* smem) {
    const int t = tid_opq();
    bf16_t* WinT = (bf16_t*)(p.ws + WS_WINT); bf16_t* WoutT = (bf16_t*)(p.ws + WS_WOUTT);
    float* mod = (float*)(p.ws + WS_MOD); float* cosT = (float*)(p.ws + WS_COS); float* sinT = (float*)(p.ws + WS_SIN);
    float* tl = (float*)smem;
    constexpr int N_TIN = DEPTH * 16 * 54, N_TOUT = DEPTH * 16 * 16, N_MOD = DEPTH * 192, N_ROPE = T * 32 / 256, N_LWT = DEPTH * 2 * 4 * 64 * 64 / 256;
    constexpr int NITEMS = N_TIN + N_TOUT + N_MOD + N_ROPE + N_LWT;
    for (int it = blockIdx.x; it < NITEMS; it += gridDim.x) {
        if (it < N_TIN + N_TOUT) {
            const float* src; bf16_t* dst; int ncols, kt, nt;
            if (it < N_TIN) { int l = it / (16 * 54), r = it % (16 * 54); kt = r / 54; nt = r % 54; src = p.w_in + (size_t)l * 1024 * DIN; dst = WinT + (size_t)l * NPAD * 1024; ncols = DIN; }
            else { int i2 = it - N_TIN; int l = i2 / 256, r = i2 % 256; kt = r / 16; nt = r % 16; src = p.w_out + (size_t)l * 1024 * 1024; dst = WoutT + (size_t)l * 1024 * 1024; ncols = 1024; }
            __syncthreads();
            { const int c = t & 63, r0 = t >> 6; const int n = nt * 64 + c;
#pragma unroll
              for (int i = 0; i < 16; ++i) { int r = r0 + 4 * i; tl[r * 65 + c] = (n < ncols) ? src[(size_t)(kt * 64 + r) * ncols + n] : 0.f; } }
            __syncthreads();
            { const int kk = t & 63, n0 = t >> 6;
#pragma unroll
              for (int i = 0; i < 16; ++i) { int n = n0 + 4 * i; dst[(size_t)(nt * 64 + n) * 1024 + kt * 64 + kk] = f2bf(tl[kk * 65 + n]); } }
        } else if (it < N_TIN + N_TOUT + N_MOD) {
            const int i2 = it - N_TIN - N_TOUT; const int l = i2 / 192, jg = i2 % 192;
            const int jj = t & 15, ks = t >> 4; const int j = jg * 16 + jj;
            float a0 = 0.f, a1 = 0.f, a2 = 0.f, a3 = 0.f;
            const float* wm = p.w_mod + (size_t)l * 1024 * 3072 + j;
#pragma unroll 8
            for (int k = ks * 64; k < ks * 64 + 64; ++k) { float wv = wm[(size_t)k * 3072]; a0 += p.c[k] * wv; a1 += p.c[1024 + k] * wv; a2 += p.c[2048 + k] * wv; a3 += p.c[3072 + k] * wv; }
            __syncthreads();
            tl[(0 * 16 + ks) * 16 + jj] = a0; tl[(1 * 16 + ks) * 16 + jj] = a1; tl[(2 * 16 + ks) * 16 + jj] = a2; tl[(3 * 16 + ks) * 16 + jj] = a3;
            __syncthreads();
            if (t < 64) { const int b = t >> 4, j2 = t & 15; float s = 0.f;
#pragma unroll
              for (int k2 = 0; k2 < 16; ++k2) s += tl[(b * 16 + k2) * 16 + j2];
              mod[((size_t)l * NB + b) * 3072 + jg * 16 + j2] = s + p.b_mod[l * 3072 + jg * 16 + j2]; }
        } else if (it >= N_TIN + N_TOUT + N_MOD + N_ROPE) {
            const int e = (it - N_TIN - N_TOUT - N_MOD - N_ROPE) * 256 + t;
            const int in = e & 63, out = (e >> 6) & 63, g = (e >> 12) & 3, mat = (e >> 14) & 1, l = e >> 15;
            const float* src = mat ? p.lru_wx : p.lru_wa;
            ((bf16_t*)(p.ws + WS_LWT))[e] = f2bf(src[l * 16384 + g * 4096 + in * 64 + out]);
        } else {
            const int i2 = it - N_TIN - N_TOUT - N_MOD; const int e = i2 * 256 + t; const int tok = e >> 5, f = e & 31;
            const float inv = exp2f(-(float)f * (13.287712379549449f / 32.f));
            const float ang = (float)p.pos[tok] * inv;
            double rev = (double)ang * 0.15915494309189535; rev -= __builtin_rint(rev);
            const float rr = (float)rev; cosT[e] = __builtin_amdgcn_cosf(rr); sinT[e] = __builtin_amdgcn_sinf(rr);
        }
    }
}

__device__ void ln_phase(const Params& p, int l) {
    const int t = tid_opq(), lane = t & 63, w = t >> 6;
    bf16_t* ubuf = (bf16_t*)(p.ws + WS_U); const float* mod = (const float*)(p.ws + WS_MOD);
    for (int rg = blockIdx.x; rg < T / 16; rg += gridDim.x) {
        f32x4 v[4][4];
#pragma unroll
        for (int r = 0; r < 4; ++r) { const int row = rg * 16 + w * 4 + r; const float* src = (l <= 1) ? p.x + (size_t)row * 1024 : p.out + (size_t)row * 1024;
#pragma unroll
            for (int i = 0; i < 4; ++i) v[r][i] = *(const f32x4*)(src + i * 256 + lane * 4);
            if (l > 0) {
                const bf16_t* yr = (const bf16_t*)(p.ws + WS_Z) + (size_t)row * 1024; const float* gate = mod + ((size_t)(l - 1) * NB + row / S) * 3072 + 2048;
#pragma unroll
                for (int i = 0; i < 4; ++i) { const u32x2 yv = *(const u32x2*)(yr + i * 256 + lane * 4); const f32x4 g1 = *(const f32x4*)(gate + i * 256 + lane * 4) + 1.f;
                    const f32x4 yf = {__uint_as_float(yv.x << 16), __uint_as_float(yv.x & 0xffff0000u), __uint_as_float(yv.y << 16), __uint_as_float(yv.y & 0xffff0000u)};
                    v[r][i] = v[r][i] * DN_ALPHA + g1 * yf; }
            } }
#pragma unroll
        for (int r = 0; r < 4; ++r) {
            const int row = rg * 16 + w * 4 + r; const int b = row / S;
            if (l > 0) {
                float s = 0.f;
#pragma unroll
                for (int i = 0; i < 4; ++i) s += (v[r][i][0] + v[r][i][1]) + (v[r][i][2] + v[r][i][3]);
                const float mu = wsum(s) * (1.f / 1024.f); float q = 0.f;
#pragma unroll
                for (int i = 0; i < 4; ++i) { f32x4 d = v[r][i] - mu; q += (d[0] * d[0] + d[1] * d[1]) + (d[2] * d[2] + d[3] * d[3]); }
                const float rstd = rsqrtf(wsum(q) * (1.f / 1024.f) + 1e-5f);
#pragma unroll
                for (int i = 0; i < 4; ++i) { const f32x4 g = *(const f32x4*)(p.ln_g + (l - 1) * 1024 + i * 256 + lane * 4), bb = *(const f32x4*)(p.ln_b + (l - 1) * 1024 + i * 256 + lane * 4);
                    v[r][i] = (v[r][i] - mu) * rstd * g + bb; *(f32x4*)(p.out + (size_t)row * 1024 + i * 256 + lane * 4) = v[r][i]; }
            }
            if (l < DEPTH) {
                float s = 0.f;
#pragma unroll
                for (int i = 0; i < 4; ++i) s += (v[r][i][0] + v[r][i][1]) + (v[r][i][2] + v[r][i][3]);
                const float mu = wsum(s) * (1.f / 1024.f); float q = 0.f;
#pragma unroll
                for (int i = 0; i < 4; ++i) { f32x4 d = v[r][i] - mu; q += (d[0] * d[0] + d[1] * d[1]) + (d[2] * d[2] + d[3] * d[3]); }
                const float rstd = rsqrtf(wsum(q) * (1.f / 1024.f) + 1e-5f);
                const float* mb = mod + ((size_t)l * NB + b) * 3072;
#pragma unroll
                for (int i = 0; i < 4; ++i) { const int col = i * 256 + lane * 4; const f32x4 sh = *(const f32x4*)(mb + col), sc = *(const f32x4*)(mb + 1024 + col);
                    f32x4 u = (v[r][i] - mu) * rstd * (sc + 1.f) + sh; u32x2 pk; pk.x = pack2(u[0], u[1]); pk.y = pack2(u[2], u[3]);
                    *(u32x2*)(ubuf + (size_t)row * 1024 + col) = pk; }
            }
        }
    }
}

__device__ __forceinline__ int lds_off(int r, int c8) {
    const int st = (r >> 4) * 2 + (c8 >> 2); const int ob = (r & 15) * 64 + (c8 & 3) * 16;
    return st * 1024 + (ob ^ (((ob >> 9) & 1) << 5));
}
struct RegSet { u32x4 a[4], b[4]; };
__device__ __forceinline__ void gemm_tile(const bf16_t* __restrict__ A, const bf16_t* __restrict__ Bt, int tm, int tn, bool first, bool has_next, int ntm, int ntn,
                                          char* sm, f32x4 (&acc)[4][4], RegSet& r0, RegSet& r1) {
    const int t = tid_opq(), lane = t & 63, w = t >> 6, wm = w >> 1, wn = w & 1, r16 = lane & 15, quad = lane >> 4;
    const int lrow = t >> 3, lch = t & 7;
    constexpr int BUF = 32768;
    const unsigned loff = (unsigned)(lrow * 1024 + lch * 8);
    const bf16_t* At0 = A + (size_t)tm * (128 * 1024); const bf16_t* Bt0 = Bt + (size_t)tn * (128 * 1024);
    const bf16_t* At1 = A + (size_t)ntm * (128 * 1024); const bf16_t* Bt1 = Bt + (size_t)ntn * (128 * 1024);
#define Ag (At0 + loff)
#define Bg (Bt0 + loff)
#define nAg (At1 + loff)
#define nBg (Bt1 + loff)
    const int woff0 = lds_off(lrow, lch);
#define woff(i) (woff0 + 4096 * (i))
    const int fo = lds_off(r16, quad);
#pragma unroll
    for (int a = 0; a < 4; ++a)
#pragma unroll
        for (int b = 0; b < 4; ++b) acc[a][b] = (f32x4){0.f, 0.f, 0.f, 0.f};
    if (first) {
#pragma unroll
        for (int i = 0; i < 4; ++i) { r0.a[i] = *(const u32x4*)(Ag + (size_t)i * 32 * 1024); r0.b[i] = *(const u32x4*)(Bg + (size_t)i * 32 * 1024); }
        __syncthreads();
#pragma unroll
        for (int i = 0; i < 4; ++i) { *(u32x4*)(sm + woff(i)) = r0.a[i]; *(u32x4*)(sm + 16384 + woff(i)) = r0.b[i]; }
#pragma unroll
        for (int i = 0; i < 4; ++i) { r0.a[i] = *(const u32x4*)(Ag + (size_t)i * 32 * 1024 + 64); r0.b[i] = *(const u32x4*)(Bg + (size_t)i * 32 * 1024 + 64); }
    }
    __syncthreads();
    auto step = [&](auto main_tag, int kt) {
        constexpr bool MAIN = decltype(main_tag)::value;
        const char* sA = sm + (kt & 1) * BUF; const char* sB = sA + 16384;
        char* nA = sm + ((kt + 1) & 1) * BUF; char* nB = nA + 16384;
        const bool wr = MAIN || kt + 1 < 16 || has_next;
        const bool own = MAIN || kt + 2 < 16;
        const bf16_t* la = own ? Ag + (kt + 2) * 64 : nAg + (kt - 14) * 64; const bf16_t* lb = own ? Bg + (kt + 2) * 64 : nBg + (kt - 14) * 64;
        {
            bf16x8 af[2][4], bfr[2][4];
#pragma unroll
            for (int mt = 0; mt < 4; ++mt) af[0][mt] = *(const bf16x8*)(sA + ((wm * 4 + mt) * 2 + 0) * 1024 + fo);
#pragma unroll
            for (int nt = 0; nt < 4; ++nt) bfr[0][nt] = *(const bf16x8*)(sB + ((wn * 4 + nt) * 2 + 0) * 1024 + fo);
#pragma unroll
            for (int ks = 0; ks < 2; ++ks) {
#pragma unroll
                for (int mt = 0; mt < 4; ++mt) {
#pragma unroll
                    for (int nt = 0; nt < 4; ++nt) acc[mt][nt] = __builtin_amdgcn_mfma_f32_16x16x32_bf16(bfr[ks][nt], af[ks][mt], acc[mt][nt], 0, 0, 0);
                    const int i = ks * 2 + (mt >> 1);
                    __builtin_amdgcn_sched_barrier(0);
                    if (ks == 0) { af[1][mt] = *(const bf16x8*)(sA + ((wm * 4 + mt) * 2 + 1) * 1024 + fo); bfr[1][mt] = *(const bf16x8*)(sB + ((wn * 4 + mt) * 2 + 1) * 1024 + fo); }
                    if ((mt & 1) == 0) { if (wr) *(u32x4*)(nA + woff(i)) = r0.a[i]; if (own || has_next) r0.a[i] = *(const u32x4*)(la + (size_t)i * 32 * 1024); }
                    else               { if (wr) *(u32x4*)(nB + woff(i)) = r0.b[i]; if (own || has_next) r0.b[i] = *(const u32x4*)(lb + (size_t)i * 32 * 1024); }
                    __builtin_amdgcn_sched_barrier(0);
                }
            }
        }
        __syncthreads();
    };
    {
        std::true_type mt_; std::false_type tl_;
        for (int kt = 0; kt < 14; ++kt) step(mt_, kt);
        step(tl_, 14); step(tl_, 15);
    }
#undef Ag
#undef Bg
#undef nAg
#undef nBg
#undef woff
}

__device__ void g1_phase(const Params& p, int l, char* smem) {
    const int t = tid_opq(), lane = t & 63, w = t >> 6, wm = w >> 1, wn = w & 1, r16 = lane & 15, quad = lane >> 4;
    char* sm = smem; char* sC = smem + 32768;
    const bf16_t* ubuf = (const bf16_t*)(p.ws + WS_U); const bf16_t* WinT = (const bf16_t*)(p.ws + WS_WINT) + (size_t)l * NPAD * 1024;
    bf16_t* z = (bf16_t*)(p.ws + WS_Z); float* kpart = (float*)(p.ws + WS_KPART);
    const float* cosT = (const float*)(p.ws + WS_COS); const float* sinT = (const float*)(p.ws + WS_SIN);
    const bool xo = (gridDim.x & 7) == 0; const int xcd = blockIdx.x & 7, nloc = xo ? (int)(gridDim.x >> 3) : (int)gridDim.x, j0 = xo ? (int)(blockIdx.x >> 3) : (int)blockIdx.x;
    const int lim = xo ? 16 * 27 : 128 * 27;
    RegSet r0, r1;
    for (int L = j0; L < lim; L += nloc) {
        const int tm = xo ? xcd * 16 + (L / 216) * 8 + (L & 7) : L / 27, tn = xo ? ((L % 216) >> 3) : L % 27;
        const int L2 = L + nloc; const bool has_next = L2 < lim;
        const int ntm = has_next ? (xo ? xcd * 16 + (L2 / 216) * 8 + (L2 & 7) : L2 / 27) : tm, ntn = has_next ? (xo ? ((L2 % 216) >> 3) : L2 % 27) : tn;
        f32x4 acc[4][4];
        gemm_tile(ubuf, WinT, tm, tn, L == j0, has_next, ntm, ntn, sm, acc, r0, r1);
        const bool rope = (tn < 4) || (tn >= 12 && tn < 16);
        if (rope) {
#pragma unroll
            for (int mt = 0; mt < 4; ++mt) {
                const int tok = tm * 128 + wm * 64 + mt * 16 + r16;
#pragma unroll
                for (int nt = 0; nt < 2; ++nt) {
                    const f32x4 cs = *(const f32x4*)(cosT + (size_t)tok * 32 + nt * 16 + quad * 4), sn = *(const f32x4*)(sinT + (size_t)tok * 32 + nt * 16 + quad * 4);
                    const f32x4 x1 = acc[mt][nt], x2 = acc[mt][nt + 2];
                    acc[mt][nt] = x1 * cs - x2 * sn; acc[mt][nt + 2] = x1 * sn + x2 * cs;
                }
            }
        }
        if (tn == 2 || tn == 3) {
#pragma unroll
            for (int nt = 0; nt < 4; ++nt) {
                f32x4 sv = (acc[0][nt] + acc[1][nt]) + (acc[2][nt] + acc[3][nt]);
#pragma unroll
                for (int jj = 0; jj < 4; ++jj) { float sx = sv[jj]; sx += __shfl_xor(sx, 1); sx += __shfl_xor(sx, 2); sx += __shfl_xor(sx, 4); sx += __shfl_xor(sx, 8); sv[jj] = sx; }
                if (r16 == 0) *(f32x4*)(kpart + (size_t)(tm * 2 + wm) * 256 + (tn - 2) * 128 + wn * 64 + nt * 16 + quad * 4) = sv;
            }
        }
#pragma unroll
        for (int mt = 0; mt < 4; ++mt)
#pragma unroll
            for (int nt = 0; nt < 4; ++nt) { u32x2 pk; pk.x = pack2(acc[mt][nt][0], acc[mt][nt][1]); pk.y = pack2(acc[mt][nt][2], acc[mt][nt][3]);
                const int row = wm * 64 + mt * 16 + r16; const int c16 = wn * 8 + nt * 2 + (quad >> 1);
                *(u32x2*)(sC + row * 256 + ((c16 ^ (row & 15)) << 4) + (quad & 1) * 8) = pk; }
        __syncthreads();
#pragma unroll
        for (int i = 0; i < 8; ++i) { const int c = t + 256 * i; const int row = c >> 4, ch = c & 15; const int col = tn * 128 + ch * 8;
            if (col < DIN) *(u32x4*)(z + (size_t)(tm * 128 + row) * ZP + col) = *(const u32x4*)(sC + row * 256 + ((ch ^ (row & 15)) << 4)); }
    }
}

__device__ void g2_phase(const Params& p, int l, char* smem) {
    const int t = tid_opq(), lane = t & 63, w = t >> 6, wm = w >> 1, wn = w & 1, r16 = lane & 15, quad = lane >> 4;
    char* sm = smem; char* sC = smem + 32768;
    const bf16_t* mix = (const bf16_t*)(p.ws + WS_U); const bf16_t* WoutT = (const bf16_t*)(p.ws + WS_WOUTT) + (size_t)l * 1024 * 1024;
    bf16_t* ybuf = (bf16_t*)(p.ws + WS_Z);
    const bool xo = (gridDim.x & 7) == 0; const int xcd = blockIdx.x & 7, nloc = xo ? (int)(gridDim.x >> 3) : (int)gridDim.x, j0 = xo ? (int)(blockIdx.x >> 3) : (int)blockIdx.x;
    const int lim = xo ? 16 * 8 : 128 * 8;
    RegSet r0, r1;
    for (int L = j0; L < lim; L += nloc) {
        const int tm = xo ? xcd * 16 + (L & 15) : (L >> 3), tn = xo ? (L >> 4) : (L & 7);
        const int L2 = L + nloc; const bool has_next = L2 < lim;
        const int ntm = has_next ? (xo ? xcd * 16 + (L2 & 15) : (L2 >> 3)) : tm, ntn = has_next ? (xo ? (L2 >> 4) : (L2 & 7)) : tn;
        f32x4 acc[4][4];
        gemm_tile(mix, WoutT, tm, tn, L == j0, has_next, ntm, ntn, sm, acc, r0, r1);
#pragma unroll
        for (int mt = 0; mt < 4; ++mt)
#pragma unroll
            for (int nt = 0; nt < 4; ++nt) { u32x2 pk; pk.x = pack2(acc[mt][nt][0], acc[mt][nt][1]); pk.y = pack2(acc[mt][nt][2], acc[mt][nt][3]);
                const int row = wm * 64 + mt * 16 + r16; const int c16 = wn * 8 + nt * 2 + (quad >> 1);
                *(u32x2*)(sC + row * 256 + ((c16 ^ (row & 15)) << 4) + (quad & 1) * 8) = pk; }
        __syncthreads();
#pragma unroll
        for (int i = 0; i < 8; ++i) { const int c = t + 256 * i; const int row = c >> 4, ch = c & 15;
            *(u32x4*)(ybuf + (size_t)(tm * 128 + row) * 1024 + tn * 128 + ch * 8) = *(const u32x4*)(sC + row * 256 + ((ch ^ (row & 15)) << 4)); }
    }
}

constexpr float ATT_SC = 0.18033688011112042f;
template <int QT>
__device__ __forceinline__ void attn_tile(const bf16_t* sK, const bf16_t* sV, const bf16x8 (&qf)[QT][2], int lo, int hi, bool full, bool hasq, bool qfl0, bool qfl1,
                                          float (&m)[QT], float (&l)[QT], f32x4 (&O)[QT][4], int wq0) {
    const int lane = tid_opq() & 63, r16 = lane & 15, quad = lane >> 4;
    f32x4 s[QT][4];
#pragma unroll
    for (int a = 0; a < QT; ++a)
#pragma unroll
        for (int b = 0; b < 4; ++b) s[a][b] = (f32x4){0.f, 0.f, 0.f, 0.f};
#pragma unroll
    for (int ks = 0; ks < 2; ++ks)
#pragma unroll
        for (int k16 = 0; k16 < 4; ++k16) {
            const bf16x8 kf = *(const bf16x8*)(sK + (k16 * 16 + r16) * LDP + ks * 32 + quad * 8);
#pragma unroll
            for (int qt = 0; qt < QT; ++qt) s[qt][k16] = __builtin_amdgcn_mfma_f32_16x16x32_bf16(kf, qf[qt][ks], s[qt][k16], 0, 0, 0);
        }
#pragma unroll
    for (int qt = 0; qt < QT; ++qt) {
        const int ql = wq0 + qt * 16 + r16; const bool qfl = qt ? qfl1 : qfl0;
        if (!full) {
#pragma unroll
            for (int k16 = 0; k16 < 4; ++k16)
#pragma unroll
                for (int j = 0; j < 4; ++j) { const int dd = ql - (k16 * 16 + quad * 4 + j); const bool valid = dd >= lo && dd <= hi; s[qt][k16][j] = valid ? s[qt][k16][j] : -1e30f; }
        }
        if (hasq) {
#pragma unroll
            for (int k16 = 0; k16 < 4; ++k16)
#pragma unroll
                for (int j = 0; j < 4; ++j) s[qt][k16][j] = qfl ? s[qt][k16][j] : -1e30f;
        }
        float mx = -1e30f;
#pragma unroll
        for (int k16 = 0; k16 < 4; ++k16) mx = fmaxf(mx, fmaxf(fmaxf(s[qt][k16][0], s[qt][k16][1]), fmaxf(s[qt][k16][2], s[qt][k16][3])));
        mx = fmaxf(mx, __shfl_xor(mx, 16)); mx = fmaxf(mx, __shfl_xor(mx, 32));
        const float mn = fmaxf(m[qt], mx); const float alpha = __builtin_amdgcn_exp2f((m[qt] - mn) * ATT_SC); m[qt] = mn;
        const float mb = (mn < -1e29f) ? 0.f : mn * ATT_SC;
        float ps = 0.f;
#pragma unroll
        for (int k16 = 0; k16 < 4; ++k16)
#pragma unroll
            for (int j = 0; j < 4; ++j) { const float pv = __builtin_amdgcn_exp2f(s[qt][k16][j] * ATT_SC - mb); ps += pv; s[qt][k16][j] = pv; }
        l[qt] = l[qt] * alpha + ps;
#pragma unroll
        for (int dt = 0; dt < 4; ++dt) O[qt][dt] = O[qt][dt] * alpha;
    }
#pragma unroll
    for (int G = 0; G < 2; ++G) {
        bf16x8 pf[QT];
#pragma unroll
        for (int qt = 0; qt < QT; ++qt) {
            const unsigned a0 = pack2(s[qt][G * 2][0], s[qt][G * 2][1]), a1 = pack2(s[qt][G * 2][2], s[qt][G * 2][3]);
            const unsigned a2 = pack2(s[qt][G * 2 + 1][0], s[qt][G * 2 + 1][1]), a3 = pack2(s[qt][G * 2 + 1][2], s[qt][G * 2 + 1][3]);
            u32x4 pk = {a0, a1, a2, a3}; pf[qt] = __builtin_bit_cast(bf16x8, pk);
        }
#pragma unroll
        for (int dt = 0; dt < 4; ++dt) {
            const bf16_t* v0p = sV + (G * 32 + quad * 4 + (r16 >> 2)) * LDP + dt * 16 + (r16 & 3) * 4;
            const bf16x4 v0 = __builtin_amdgcn_ds_read_tr16_b64_v4i16((__attribute__((address_space(3))) bf16x4*)(v0p));
            const bf16x4 v1 = __builtin_amdgcn_ds_read_tr16_b64_v4i16((__attribute__((address_space(3))) bf16x4*)(v0p + 16 * LDP));
            const bf16x8 vf = {v0[0], v0[1], v0[2], v0[3], v1[0], v1[1], v1[2], v1[3]};
#pragma unroll
            for (int qt = 0; qt < QT; ++qt) O[qt][dt] = __builtin_amdgcn_mfma_f32_16x16x32_bf16(vf, pf[qt], O[qt][dt], 0, 0, 0);
        }
    }
}

__device__ void attn_item(const Params& p, int kind, int idx, char* smem) {
    const int t = tid_opq(), lane = t & 63, w = t >> 6, r16 = lane & 15, quad = lane >> 4;
    bf16_t* sK = (bf16_t*)smem; bf16_t* sV = sK + 64 * LDP;
    float* kmean = (float*)(smem + 18432); float* gates = (float*)(smem + 22528); unsigned* selm = (unsigned*)(smem + 30720);
    int4* desc = (int4*)(smem + 31232); int* misc = (int*)(smem + 32320);
    const bf16_t* z = (const bf16_t*)(p.ws + WS_Z);
    int b, h, qbase, stride, qcol, kcol, vcol, cfg = 0;
    __syncthreads();
    if (kind == 0) {
        const int n = 15 - (idx >> 5); const int rem = idx & 31; b = rem >> 3; h = (rem >> 1) & 3; const int qh = rem & 1;
        qbase = b * S + n * 256 + qh * 128; stride = 1; qcol = C_AQ + h * 64; kcol = C_AK + h * 64; vcol = C_AV + h * 64;
        const float* kpart = (const float*)(p.ws + WS_KPART);
        for (int e = t; e < n * 64; e += 256) { const int j = e >> 6, d = e & 63; const float* kp = kpart + (size_t)(b * 64 + j * 4) * 256 + h * 64 + d;
            kmean[e] = ((kp[0] + kp[256]) + (kp[512] + kp[768])) * (1.f / 256.f); }
        if (t == 0) misc[1] = 0;
        __syncthreads();
        {
            const int ql = t >> 1, half = t & 1; const bf16_t* qp = z + (size_t)(qbase + ql) * ZP + qcol;
            float g[8];
#pragma unroll
            for (int jj = 0; jj < 8; ++jj) g[jj] = 0.f;
#pragma unroll 1
            for (int dc = 0; dc < 8; ++dc) {
                const u32x4 qv = *(const u32x4*)(qp + dc * 8); float qq[8];
#pragma unroll
                for (int e = 0; e < 4; ++e) { qq[2 * e] = __uint_as_float(qv[e] << 16); qq[2 * e + 1] = __uint_as_float(qv[e] & 0xffff0000u); }
#pragma unroll
                for (int jj = 0; jj < 8; ++jj) { const int j = half + 2 * jj; if (j < n) { const float* km = kmean + j * 64 + dc * 8;
#pragma unroll
                    for (int e = 0; e < 8; ++e) g[jj] += qq[e] * km[e]; } }
            }
#pragma unroll
            for (int jj = 0; jj < 8; ++jj) gates[ql * 16 + half + 2 * jj] = g[jj];
        }
        __syncthreads();
        if (t < 128) {
            unsigned msk = 0;
            for (int k = 0; k < 3 && k < n; ++k) { float best = -3.0e38f; int bi = -1;
                for (int j = 0; j < n; ++j) if (!((msk >> j) & 1u)) { const float gv = gates[t * 16 + j]; if (gv > best) { best = gv; bi = j; } }
                if (bi >= 0) msk |= 1u << bi; }
            selm[t] = msk; atomicOr((unsigned*)&misc[1], msk);
        }
        __syncthreads();
        if (t == 0) {
            int nd = 0; const unsigned bm = (unsigned)misc[1];
            for (int kt = 0; kt <= qh * 2 + 1; ++kt) desc[nd++] = make_int4(b * S + n * 256 + kt * 64, kt * 64 - qh * 128, BIG, -1);
            for (int j = 0; j < n; ++j) if ((bm >> j) & 1u) for (int kt = 0; kt < 4; ++kt) desc[nd++] = make_int4(b * S + j * 256 + kt * 64, -BIG, BIG, j);
            misc[0] = nd;
        }
    } else {
        cfg = idx >> 9; const int rem = idx & 511; b = rem >> 7; h = (rem >> 5) & 3; const int rb = rem & 31;
        const int dil = 1 << (2 * cfg); const int res = rb & (dil - 1), blk = rb >> (2 * cfg);
        qbase = b * S + blk * 128 * dil + res; stride = dil; qcol = C_CQ + h * 64; kcol = C_CK + h * 64; vcol = C_CV + h * 64;
        if (t < 128) selm[t] = 0xffffffffu;
        if (t == 0) { int nd = 0; for (int kt = (blk == 0 ? 2 : 0); kt < 4; ++kt) desc[nd++] = make_int4(b * S + (blk * 128 - 128 + kt * 64) * dil + res, kt * 64 - 128, kt * 64, -1); misc[0] = nd; }
    }
    __syncthreads();
    const int nd = misc[0];
    bf16x8 qf[2][2];
#pragma unroll
    for (int qt = 0; qt < 2; ++qt)
#pragma unroll
        for (int ks = 0; ks < 2; ++ks) qf[qt][ks] = *(const bf16x8*)(z + (size_t)(qbase + (w * 32 + qt * 16 + r16) * stride) * ZP + qcol + ks * 32 + quad * 8);
    const unsigned sel0 = selm[w * 32 + r16], sel1 = selm[w * 32 + 16 + r16];
    float m[2] = {-1e30f, -1e30f}, l[2] = {0.f, 0.f}; f32x4 O[2][4];
#pragma unroll
    for (int a = 0; a < 2; ++a)
#pragma unroll
        for (int c = 0; c < 4; ++c) O[a][c] = (f32x4){0.f, 0.f, 0.f, 0.f};
    const int lrow = t >> 2, lch = (t & 3) * 2;
    u32x4 rk0, rk1, rv0, rv1;
    if (nd > 0) { const int4 d = desc[0]; const bf16_t* rp = z + (size_t)(d.x + lrow * stride) * ZP + lch * 8;
        rk0 = *(const u32x4*)(rp + kcol); rk1 = *(const u32x4*)(rp + kcol + 8); rv0 = *(const u32x4*)(rp + vcol); rv1 = *(const u32x4*)(rp + vcol + 8); }
    for (int i = 0; i < nd; ++i) {
        __syncthreads();
        *(u32x4*)(sK + lrow * LDP + lch * 8) = rk0; *(u32x4*)(sK + lrow * LDP + lch * 8 + 8) = rk1;
        *(u32x4*)(sV + lrow * LDP + lch * 8) = rv0; *(u32x4*)(sV + lrow * LDP + lch * 8 + 8) = rv1;
        __syncthreads();
        if (i + 1 < nd) { const int4 d = desc[i + 1]; const bf16_t* rp = z + (size_t)(d.x + lrow * stride) * ZP + lch * 8;
            rk0 = *(const u32x4*)(rp + kcol); rk1 = *(const u32x4*)(rp + kcol + 8); rv0 = *(const u32x4*)(rp + vcol); rv1 = *(const u32x4*)(rp + vcol + 8); }
        const int4 d = desc[i];
        bool need = (w * 32 + 31 >= d.y) && (w * 32 - 63 <= d.z);
        bool q0 = true, q1 = true;
        if (d.w >= 0) { q0 = (sel0 >> d.w) & 1u; q1 = (sel1 >> d.w) & 1u; need = need && (__ballot(q0 || q1) != 0ull); }
        const bool full = (w * 32 - 63 >= d.y) && (w * 32 + 31 <= d.z);
        if (need) attn_tile<2>(sK, sV, qf, d.y, d.z, full, d.w >= 0, q0, q1, m, l, O, w * 32);
    }
#pragma unroll
    for (int qt = 0; qt < 2; ++qt) {
        float lt = l[qt]; lt += __shfl_xor(lt, 16); lt += __shfl_xor(lt, 32);
        const float inv = 1.f / lt; const size_t tok = (size_t)(qbase + (w * 32 + qt * 16 + r16) * stride);
        if (kind == 0) {
            bf16_t* mix = (bf16_t*)(p.ws + WS_U);
#pragma unroll
            for (int dt = 0; dt < 4; ++dt) { const int d0 = dt * 16 + quad * 4; const u32x2 gv = *(const u32x2*)(z + tok * ZP + C_AG + h * 64 + d0);
                const float g0 = __uint_as_float(gv.x << 16), g1 = __uint_as_float(gv.x & 0xffff0000u), g2 = __uint_as_float(gv.y << 16), g3 = __uint_as_float(gv.y & 0xffff0000u);
                u32x2 o; o.x = pack2(O[qt][dt][0] * inv * silu_f(g0), O[qt][dt][1] * inv * silu_f(g1)); o.y = pack2(O[qt][dt][2] * inv * silu_f(g2), O[qt][dt][3] * inv * silu_f(g3));
                *(u32x2*)(mix + tok * 1024 + h * 64 + d0) = o; }
        } else {
            bf16_t* dilo = (bf16_t*)(p.ws + WS_DILO); float* dill = (float*)(p.ws + WS_DILL);
#pragma unroll
            for (int dt = 0; dt < 4; ++dt) { const int d0 = dt * 16 + quad * 4; u32x2 o; o.x = pack2(O[qt][dt][0] * inv, O[qt][dt][1] * inv); o.y = pack2(O[qt][dt][2] * inv, O[qt][dt][3] * inv);
                *(u32x2*)(dilo + ((size_t)cfg * T + tok) * 256 + h * 64 + d0) = o; }
            if (quad == 0) dill[((size_t)cfg * T + tok) * 4 + h] = m[qt] * 0.125f + __logf(lt);
        }
    }
}

__device__ void moba_item(const Params& p, int idx, char* smem, bf16_t* outp) {
    const int t = tid_opq(), lane = t & 63, w = t >> 6, r16 = lane & 15, quad = lane >> 4;
    bf16_t* sK = (bf16_t*)smem; bf16_t* sV = sK + 64 * LDP;
    float* stO = (float*)(smem + 18432);
    float* kmean = (float*)(smem + 18432); float* gates = (float*)(smem + 22528);
    float* stM = (float*)(smem + 53248); float* stL = (float*)(smem + 53760);
    unsigned* selm = (unsigned*)(smem + 54272); unsigned char* lists = (unsigned char*)(smem + 54784);
    int* cnt = (int*)(smem + 56832); int4* desc = (int4*)(smem + 56960); int* misc = (int*)(smem + 59008);
    const bf16_t* z = (const bf16_t*)(p.ws + WS_Z);
    const int n = 15 - (idx >> 5); const int rem = idx & 31; const int b = rem >> 3, h = (rem >> 1) & 3, qh = rem & 1;
    const int qbase = b * S + n * 256 + qh * 128, qcol = C_AQ + h * 64, kcol = C_AK + h * 64, vcol = C_AV + h * 64;
    __syncthreads();
    {
        const float* kpart = (const float*)(p.ws + WS_KPART);
        for (int e = t; e < n * 64; e += 256) { const int j = e >> 6, d = e & 63; const float* kp = kpart + (size_t)(b * 64 + j * 4) * 256 + h * 64 + d;
            kmean[e] = ((kp[0] + kp[256]) + (kp[512] + kp[768])) * (1.f / 256.f); }
        if (t < 16) cnt[t] = 0;
        __syncthreads();
        {
            const int ql = t >> 1, half = t & 1; const bf16_t* qp = z + (size_t)(qbase + ql) * ZP + qcol;
            float g[8];
#pragma unroll
            for (int jj = 0; jj < 8; ++jj) g[jj] = 0.f;
#pragma unroll 1
            for (int dc = 0; dc < 8; ++dc) {
                const u32x4 qv = *(const u32x4*)(qp + dc * 8); float qq[8];
#pragma unroll
                for (int e = 0; e < 4; ++e) { qq[2 * e] = __uint_as_float(qv[e] << 16); qq[2 * e + 1] = __uint_as_float(qv[e] & 0xffff0000u); }
#pragma unroll
                for (int jj = 0; jj < 8; ++jj) { const int j = half + 2 * jj; if (j < n) { const float* km = kmean + j * 64 + dc * 8;
#pragma unroll
                    for (int e = 0; e < 8; ++e) g[jj] += qq[e] * km[e]; } }
            }
#pragma unroll
            for (int jj = 0; jj < 8; ++jj) gates[ql * 16 + half + 2 * jj] = g[jj];
        }
        __syncthreads();
        if (t < 128) {
            unsigned msk = 0;
            for (int k = 0; k < 3 && k < n; ++k) { float best = -3.0e38f; int bi = -1;
                for (int j = 0; j < n; ++j) if (!((msk >> j) & 1u)) { const float gv = gates[t * 16 + j]; if (gv > best) { best = gv; bi = j; } }
                if (bi >= 0) msk |= 1u << bi; }
            selm[t] = msk;
            for (int j = 0; j < n; ++j) if ((msk >> j) & 1u) { const int pos = atomicAdd(&cnt[j], 1); lists[j * 128 + pos] = (unsigned char)t; }
        }
        __syncthreads();
        if (t < 128) { for (int j = 0; j < n; ++j) { const int cj = cnt[j]; if (t >= cj && t < ((cj + 15) & ~15)) lists[j * 128 + t] = 255; } }
        if (t == 0) {
            int nd = 0;
            for (int kt = 0; kt <= qh * 2 + 1; ++kt) desc[nd++] = make_int4(b * S + n * 256 + kt * 64, kt * 64 - qh * 128, BIG, -1);
            misc[1] = nd;
            for (int j = 0; j < n; ++j) { const int ntl = (cnt[j] + 15) >> 4;
                for (int ps = 0; ps * 4 < ntl; ++ps) for (int kt = 0; kt < 4; ++kt) desc[nd++] = make_int4(b * S + j * 256 + kt * 64, ps, kt, j); }
            misc[0] = nd;
        }
    }
    __syncthreads();
    const int nd = misc[0], nown = misc[1];
    const int lrow = t >> 2, lch = (t & 3) * 2;
    u32x4 rk0, rk1, rv0, rv1;
    { const int4 d = desc[0]; const bf16_t* rp = z + (size_t)(d.x + lrow) * ZP + lch * 8;
      rk0 = *(const u32x4*)(rp + kcol); rk1 = *(const u32x4*)(rp + kcol + 8); rv0 = *(const u32x4*)(rp + vcol); rv1 = *(const u32x4*)(rp + vcol + 8); }
    bf16x8 nqf[2]; int ngq = 0; bool ngv = false, nhas = false;
    auto prefetch_group = [&](int gi) {
        nhas = false;
        if (gi < nd) { const int4 dg = desc[gi]; const int slot = dg.y * 4 + w; nhas = slot * 16 < cnt[dg.w];
            if (nhas) { const int qi = lists[dg.w * 128 + slot * 16 + r16]; ngv = qi != 255; ngq = ngv ? qi : 0;
#pragma unroll
                for (int ks = 0; ks < 2; ++ks) nqf[ks] = *(const bf16x8*)(z + (size_t)(qbase + ngq) * ZP + qcol + ks * 32 + quad * 8); } }
    };
    prefetch_group(nown);
    {
        bf16x8 qf[2][2];
#pragma unroll
        for (int qt = 0; qt < 2; ++qt)
#pragma unroll
            for (int ks = 0; ks < 2; ++ks) qf[qt][ks] = *(const bf16x8*)(z + (size_t)(qbase + w * 32 + qt * 16 + r16) * ZP + qcol + ks * 32 + quad * 8);
        float m[2] = {-1e30f, -1e30f}, l[2] = {0.f, 0.f}; f32x4 O[2][4];
#pragma unroll
        for (int a = 0; a < 2; ++a)
#pragma unroll
            for (int c = 0; c < 4; ++c) O[a][c] = (f32x4){0.f, 0.f, 0.f, 0.f};
        for (int i = 0; i < nown; ++i) {
            __syncthreads();
            *(u32x4*)(sK + lrow * LDP + lch * 8) = rk0; *(u32x4*)(sK + lrow * LDP + lch * 8 + 8) = rk1;
            *(u32x4*)(sV + lrow * LDP + lch * 8) = rv0; *(u32x4*)(sV + lrow * LDP + lch * 8 + 8) = rv1;
            __syncthreads();
            if (i + 1 < nd) { const int4 d = desc[i + 1]; const bf16_t* rp = z + (size_t)(d.x + lrow) * ZP + lch * 8;
                rk0 = *(const u32x4*)(rp + kcol); rk1 = *(const u32x4*)(rp + kcol + 8); rv0 = *(const u32x4*)(rp + vcol); rv1 = *(const u32x4*)(rp + vcol + 8); }
            const int4 d = desc[i];
            const bool need = (w * 32 + 31 >= d.y) && (w * 32 - 63 <= d.z);
            const bool full = (w * 32 - 63 >= d.y) && (w * 32 + 31 <= d.z);
            if (need) attn_tile<2>(sK, sV, qf, d.y, d.z, full, false, true, true, m, l, O, w * 32);
        }
#pragma unroll
        for (int qt = 0; qt < 2; ++qt) {
            float lt = l[qt]; lt += __shfl_xor(lt, 16); lt += __shfl_xor(lt, 32);
            const int ql = w * 32 + qt * 16 + r16;
            if (quad == 0) { stM[ql] = m[qt]; stL[ql] = lt; }
#pragma unroll
            for (int dt = 0; dt < 4; ++dt) *(f32x4*)(stO + ql * 68 + dt * 16 + quad * 4) = O[qt][dt];
        }
    }
    {
        bf16x8 qf[1][2]; float m[1] = {-1e30f}, l[1] = {0.f}; f32x4 O[1][4];
        int gq = 0; bool gv = false, has = false;
        for (int i = nown; i < nd; ++i) {
            __syncthreads();
            *(u32x4*)(sK + lrow * LDP + lch * 8) = rk0; *(u32x4*)(sK + lrow * LDP + lch * 8 + 8) = rk1;
            *(u32x4*)(sV + lrow * LDP + lch * 8) = rv0; *(u32x4*)(sV + lrow * LDP + lch * 8 + 8) = rv1;
            __syncthreads();
            if (i + 1 < nd) { const int4 d = desc[i + 1]; const bf16_t* rp = z + (size_t)(d.x + lrow) * ZP + lch * 8;
                rk0 = *(const u32x4*)(rp + kcol); rk1 = *(const u32x4*)(rp + kcol + 8); rv0 = *(const u32x4*)(rp + vcol); rv1 = *(const u32x4*)(rp + vcol + 8); }
            const int4 d = desc[i];
            if (d.z == 0) {
                has = nhas; gv = ngv; gq = ngq; qf[0][0] = nqf[0]; qf[0][1] = nqf[1];
                m[0] = -1e30f; l[0] = 0.f;
#pragma unroll
                for (int c = 0; c < 4; ++c) O[0][c] = (f32x4){0.f, 0.f, 0.f, 0.f};
                prefetch_group(i + 4);
            }
            if (has) {
                attn_tile<1>(sK, sV, qf, -BIG, BIG, true, false, true, true, m, l, O, 0);
                if (d.z == 3) {
                    float lt = l[0]; lt += __shfl_xor(lt, 16); lt += __shfl_xor(lt, 32);
                    if (gv) {
                        const float mo = stM[gq], lo_ = stL[gq]; const float mn = fmaxf(mo, m[0]);
                        const float fa = __builtin_amdgcn_exp2f((mo - mn) * ATT_SC), fb = __builtin_amdgcn_exp2f((m[0] - mn) * ATT_SC);
#pragma unroll
                        for (int dt = 0; dt < 4; ++dt) { float* sp = stO + gq * 68 + dt * 16 + quad * 4; const f32x4 so = *(const f32x4*)sp; *(f32x4*)sp = so * fa + O[0][dt] * fb; }
                        if (quad == 0) { stM[gq] = mn; stL[gq] = lo_ * fa + lt * fb; }
                    }
                }
            }
        }
    }
    __syncthreads();
#pragma unroll
    for (int qt = 0; qt < 2; ++qt) {
        const int ql = w * 32 + qt * 16 + r16; const float inv = 1.f / stL[ql]; const size_t tok = (size_t)(qbase + ql);
#pragma unroll
        for (int dt = 0; dt < 4; ++dt) { const int d0 = dt * 16 + quad * 4; const f32x4 ov = *(const f32x4*)(stO + ql * 68 + d0);
            const u32x2 gvv = *(const u32x2*)(z + tok * ZP + C_AG + h * 64 + d0);
            const float g0 = __uint_as_float(gvv.x << 16), g1 = __uint_as_float(gvv.x & 0xffff0000u), g2 = __uint_as_float(gvv.y << 16), g3 = __uint_as_float(gvv.y & 0xffff0000u);
            u32x2 o; o.x = pack2(ov[0] * inv * silu_f(g0), ov[1] * inv * silu_f(g1)); o.y = pack2(ov[2] * inv * silu_f(g2), ov[3] * inv * silu_f(g3));
            *(u32x2*)(outp + tok * 1024 + h * 64 + d0) = o; }
    }
}

__device__ __forceinline__ void gla_bcum(const Params& p, int l, const bf16_t* z, int tok0, float* bc, float* drs) {
    const int t = tid_opq();
    const int hd = t & 127, ih = t >> 7;
    float wr[16];
#pragma unroll
    for (int r = 0; r < 16; ++r) wr[r] = p.gla_wr[l * 2048 + r * 128 + hd];
    const float br = p.gla_br[l * 128 + hd];
    { const int e0 = t, e1 = t + 256; const bf16_t d0 = z[(size_t)(tok0 + (e0 >> 4)) * ZP + C_DR + (e0 & 15)], d1 = z[(size_t)(tok0 + (e1 >> 4)) * ZP + C_DR + (e1 & 15)];
      drs[e0] = bf2f(d0); drs[e1] = bf2f(d1); }
    __syncthreads();
#pragma unroll
    for (int ii = 0; ii < 16; ++ii) { const int i = ih * 16 + ii; float x = br;
#pragma unroll
        for (int r4 = 0; r4 < 4; ++r4) { const f32x4 dv = *(const f32x4*)(drs + i * 16 + r4 * 4); x += (dv[0] * wr[r4 * 4] + dv[1] * wr[r4 * 4 + 1]) + (dv[2] * wr[r4 * 4 + 2] + dv[3] * wr[r4 * 4 + 3]); }
        bc[i * 128 + hd] = (fminf(x, 0.f) - __logf(1.f + __expf(-fabsf(x)))) * (1.f / 16.f); }
    __syncthreads();
    if (t < 128) { float sacc = 0.f;
#pragma unroll
        for (int i = 0; i < 32; ++i) { sacc += bc[i * 128 + t]; bc[i * 128 + t] = sacc; } }
    __syncthreads();
}

__device__ void gla1_item(const Params& p, int l, int idx, char* smem) {
    const int t = tid_opq(), lane = t & 63, w = t >> 6, r16 = lane & 15, quad = lane >> 4;
    const int b = idx >> 7, c = idx & 127; const int tok0 = b * S + c * 32;
    const bf16_t* z = (const bf16_t*)(p.ws + WS_Z);
    float* bc = (float*)smem; float* drs = (float*)(smem + 16384);
    bf16_t* kdT = (bf16_t*)(smem + 18432) + w * 1024;
    bf16_t* vL = (bf16_t*)(smem + 26624) + w * (32 * LDP);
    float* gkv = (float*)(p.ws + WS_GKV); float* gdec = (float*)(p.ws + WS_GDEC);
    bf16_t kraw[16]; u32x4 vr[4];
#pragma unroll
    for (int i = 0; i < 16; ++i) { const int e = lane + 64 * i; kraw[i] = z[(size_t)(tok0 + (e >> 5)) * ZP + C_DK + w * 32 + (e & 31)]; }
#pragma unroll
    for (int i = 0; i < 4; ++i) { const int cc = lane + 64 * i; vr[i] = *(const u32x4*)(z + (size_t)(tok0 + (cc >> 3)) * ZP + C_DV + w * 64 + (cc & 7) * 8); }
    __syncthreads();
#pragma unroll
    for (int i = 0; i < 4; ++i) { const int cc = lane + 64 * i; *(u32x4*)(vL + (cc >> 3) * LDP + (cc & 7) * 8) = vr[i]; }
    gla_bcum(p, l, z, tok0, bc, drs);
#pragma unroll
    for (int i = 0; i < 16; ++i) { const int e = lane + 64 * i; const int j = e >> 5, d = e & 31;
        kdT[d * 32 + j] = f2bf(bf2f(kraw[i]) * __expf(bc[31 * 128 + w * 32 + d] - bc[j * 128 + w * 32 + d])); }
    const int bh = b * 4 + w;
    if (lane < 32) gdec[(bh * 128 + c) * 32 + lane] = __expf(bc[31 * 128 + w * 32 + lane]);
    __syncthreads();
    bf16x8 kf[2];
#pragma unroll
    for (int x = 0; x < 2; ++x) kf[x] = *(const bf16x8*)(kdT + (x * 16 + r16) * 32 + quad * 8);
    float* dst = gkv + (size_t)(bh * 128 + c) * 2048;
#pragma unroll
    for (int dt = 0; dt < 4; ++dt) {
        const bf16_t* v0p = vL + (quad * 8 + (r16 >> 2)) * LDP + dt * 16 + (r16 & 3) * 4;
        const bf16x4 v0 = __builtin_amdgcn_ds_read_tr16_b64_v4i16((__attribute__((address_space(3))) bf16x4*)(v0p));
        const bf16x4 v1 = __builtin_amdgcn_ds_read_tr16_b64_v4i16((__attribute__((address_space(3))) bf16x4*)(v0p + 4 * LDP));
        const bf16x8 vf = {v0[0], v0[1], v0[2], v0[3], v1[0], v1[1], v1[2], v1[3]};
#pragma unroll
        for (int x = 0; x < 2; ++x) {
            const f32x4 r = __builtin_amdgcn_mfma_f32_16x16x32_bf16(vf, kf[x], (f32x4){0.f, 0.f, 0.f, 0.f}, 0, 0, 0);
            *(f32x4*)(dst + (x * 16 + r16) * 64 + dt * 16 + quad * 4) = r;
        }
    }
}

#define OPQ(ptr) asm volatile("" : "+v"(ptr))
__device__ void gla3_item(const Params& p, int l, int idx, char* smem) {
    const int t = tid_opq(), lane = t & 63, w = t >> 6, r16 = lane & 15, quad = lane >> 4;
    const int b = idx >> 7, c = idx & 127; const int tok0 = b * S + c * 32;
    const bf16_t* z = (const bf16_t*)(p.ws + WS_Z); bf16_t* mix = (bf16_t*)(p.ws + WS_U);
    float* bc = (float*)smem; float* drs = (float*)(smem + 16384);
    bf16_t* SL = (bf16_t*)smem + w * (32 * LDP);
    bf16_t* qe = (bf16_t*)(smem + 18432) + w * 1024;
    bf16_t* ke = (bf16_t*)(smem + 26624) + w * 1024;
    bf16_t* vL = (bf16_t*)(smem + 34816) + w * (32 * LDP);
    const float* gkv = (const float*)(p.ws + WS_GKV);
    const int bh = b * 4 + w;
    bf16_t qraw[16], kraw[16];
    { const bf16_t* qp = z + (size_t)(tok0 + (lane >> 5)) * ZP + w * 32 + (lane & 31);
#pragma unroll
      for (int i = 0; i < 16; ++i) { qraw[i] = qp[C_DQ]; kraw[i] = qp[C_DK]; qp += 2 * ZP; OPQ(qp); } }
    u32x4 vr[4]; f32x4 sr[8];
#pragma unroll
    for (int i = 0; i < 4; ++i) { const int cc = lane + 64 * i; vr[i] = *(const u32x4*)(z + (size_t)(tok0 + (cc >> 3)) * ZP + C_DV + w * 64 + (cc & 7) * 8); }
    { const float* Sp = gkv + (size_t)(bh * 128 + c) * 2048;
#pragma unroll
      for (int i = 0; i < 8; ++i) sr[i] = *(const f32x4*)(Sp + (lane + 64 * i) * 4); }
    __syncthreads();
#pragma unroll
    for (int i = 0; i < 4; ++i) { const int cc = lane + 64 * i; *(u32x4*)(vL + (cc >> 3) * LDP + (cc & 7) * 8) = vr[i]; }
    gla_bcum(p, l, z, tok0, bc, drs);
#pragma unroll
    for (int i2 = 0; i2 < 16; ++i2) { const int e = lane + 64 * i2; const int i = e >> 5, d = e & 31; const float bcv = bc[i * 128 + w * 32 + d];
        qe[i * 32 + d] = f2bf(bf2f(qraw[i2]) * __expf(bcv) * 0.17677669529663687f); ke[i * 32 + d] = f2bf(bf2f(kraw[i2]) * __expf(-bcv)); }
    __syncthreads();
#pragma unroll
    for (int i = 0; i < 8; ++i) { const int cc = lane + 64 * i; const int d = cc >> 4, v4 = cc & 15; u32x2 pk; pk.x = pack2(sr[i][0], sr[i][1]); pk.y = pack2(sr[i][2], sr[i][3]);
        *(u32x2*)(SL + d * LDP + v4 * 4) = pk; }
    __syncthreads();
    bf16x8 qf[2], kf[2];
#pragma unroll
    for (int x = 0; x < 2; ++x) { qf[x] = *(const bf16x8*)(qe + (x * 16 + r16) * 32 + quad * 8); kf[x] = *(const bf16x8*)(ke + (x * 16 + r16) * 32 + quad * 8); }
    bf16x8 pf[2];
#pragma unroll
    for (int it = 0; it < 2; ++it) {
        f32x4 at[2];
#pragma unroll
        for (int jt = 0; jt < 2; ++jt) { at[jt] = __builtin_amdgcn_mfma_f32_16x16x32_bf16(kf[jt], qf[it], (f32x4){0.f, 0.f, 0.f, 0.f}, 0, 0, 0);
#pragma unroll
            for (int jj = 0; jj < 4; ++jj) at[jt][jj] = (jt * 16 + quad * 4 + jj <= it * 16 + r16) ? at[jt][jj] : 0.f; }
        u32x4 pk = {pack2(at[0][0], at[0][1]), pack2(at[0][2], at[0][3]), pack2(at[1][0], at[1][1]), pack2(at[1][2], at[1][3])};
        pf[it] = __builtin_bit_cast(bf16x8, pk);
    }
    f32x4 O[2][4];
#pragma unroll
    for (int dt = 0; dt < 4; ++dt) {
        const bf16_t* v0p = vL + (quad * 4 + (r16 >> 2)) * LDP + dt * 16 + (r16 & 3) * 4;
        const bf16x4 v0 = __builtin_amdgcn_ds_read_tr16_b64_v4i16((__attribute__((address_space(3))) bf16x4*)(v0p));
        const bf16x4 v1 = __builtin_amdgcn_ds_read_tr16_b64_v4i16((__attribute__((address_space(3))) bf16x4*)(v0p + 16 * LDP));
        const bf16x8 vf = {v0[0], v0[1], v0[2], v0[3], v1[0], v1[1], v1[2], v1[3]};
        const bf16_t* s0p = SL + (quad * 8 + (r16 >> 2)) * LDP + dt * 16 + (r16 & 3) * 4;
        const bf16x4 s0 = __builtin_amdgcn_ds_read_tr16_b64_v4i16((__attribute__((address_space(3))) bf16x4*)(s0p));
        const bf16x4 s1 = __builtin_amdgcn_ds_read_tr16_b64_v4i16((__attribute__((address_space(3))) bf16x4*)(s0p + 4 * LDP));
        const bf16x8 sf = {s0[0], s0[1], s0[2], s0[3], s1[0], s1[1], s1[2], s1[3]};
#pragma unroll
        for (int it = 0; it < 2; ++it) {
            O[it][dt] = __builtin_amdgcn_mfma_f32_16x16x32_bf16(vf, pf[it], (f32x4){0.f, 0.f, 0.f, 0.f}, 0, 0, 0);
            O[it][dt] = __builtin_amdgcn_mfma_f32_16x16x32_bf16(sf, qf[it], O[it][dt], 0, 0, 0);
        }
    }
#pragma unroll
    for (int it = 0; it < 2; ++it) {
        float ss = 0.f;
#pragma unroll
        for (int dt = 0; dt < 4; ++dt) ss += (O[it][dt][0] * O[it][dt][0] + O[it][dt][1] * O[it][dt][1]) + (O[it][dt][2] * O[it][dt][2] + O[it][dt][3] * O[it][dt][3]);
        ss += __shfl_xor(ss, 16); ss += __shfl_xor(ss, 32);
        const float rn = rsqrtf(ss * (1.f / 64.f) + 1e-5f);
        const size_t tok = (size_t)(tok0 + it * 16 + r16);
#pragma unroll
        for (int dt = 0; dt < 4; ++dt) { const int v0i = dt * 16 + quad * 4; const f32x4 gn = *(const f32x4*)(p.gla_gn + l * 64 + v0i);
            const u32x2 gv = *(const u32x2*)(z + tok * ZP + C_DG + w * 64 + v0i);
            const float g0 = __uint_as_float(gv.x << 16), g1 = __uint_as_float(gv.x & 0xffff0000u), g2 = __uint_as_float(gv.y << 16), g3 = __uint_as_float(gv.y & 0xffff0000u);
            u32x2 o; o.x = pack2(O[it][dt][0] * rn * gn[0] * silu_f(g0), O[it][dt][1] * rn * gn[1] * silu_f(g1));
            o.y = pack2(O[it][dt][2] * rn * gn[2] * silu_f(g2), O[it][dt][3] * rn * gn[3] * silu_f(g3));
            *(u32x2*)(mix + tok * 1024 + 768 + w * 64 + v0i) = o; }
    }
}

__device__ void lru1_item(const Params& p, int l, int idx, char* smem) {
    const int t = tid_opq(), lane = t & 63, g = t >> 6, r16 = lane & 15, quad = lane >> 4; const int ch = t;
    const int b = idx >> 7, c = idx & 127; const int s0 = c * 32; const int tok0 = b * S + s0;
    const bf16_t* z = (const bf16_t*)(p.ws + WS_Z); float* xcs = (float*)smem;
    bf16_t* preA = (bf16_t*)(smem + 32768); bf16_t* preX = (bf16_t*)(smem + 49152);
    float* lh = (float*)(p.ws + WS_LH); float* lp = (float*)(p.ws + WS_LP);
    bf16_t xr[35];
#pragma unroll
    for (int i = 0; i < 35; ++i) { const int sidx = s0 + i - 3; xr[i] = (sidx >= 0) ? z[(size_t)(tok0 + i - 3) * ZP + C_BX + ch] : (bf16_t)0; }
    const float cw0 = p.conv_w[l * 1024 + ch], cw1 = p.conv_w[l * 1024 + 256 + ch], cw2 = p.conv_w[l * 1024 + 512 + ch], cw3 = p.conv_w[l * 1024 + 768 + ch];
    const float cb = p.conv_b[l * 256 + ch];
    const bf16_t* lwt = (const bf16_t*)(p.ws + WS_LWT) + (size_t)l * 32768 + g * 4096;
    bf16x8 wfa[4][2], wfx[4][2];
#pragma unroll
    for (int nt = 0; nt < 4; ++nt)
#pragma unroll
        for (int ks = 0; ks < 2; ++ks) { wfa[nt][ks] = *(const bf16x8*)(lwt + (nt * 16 + r16) * 64 + ks * 32 + quad * 8); wfx[nt][ks] = *(const bf16x8*)(lwt + 16384 + (nt * 16 + r16) * 64 + ks * 32 + quad * 8); }
    __syncthreads();
#pragma unroll
    for (int i = 0; i < 32; ++i) xcs[i * 256 + ch] = cb + (cw0 * bf2f(xr[i]) + cw1 * bf2f(xr[i + 1])) + (cw2 * bf2f(xr[i + 2]) + cw3 * bf2f(xr[i + 3]));
    __syncthreads();
#pragma unroll
    for (int tt = 0; tt < 2; ++tt) {
        bf16x8 xf[2];
#pragma unroll
        for (int ks = 0; ks < 2; ++ks) { const float* xp = xcs + (tt * 16 + r16) * 256 + g * 64 + ks * 32 + quad * 8; const f32x4 x0 = *(const f32x4*)xp, x1 = *(const f32x4*)(xp + 4);
            u32x4 pk = {pack2(x0[0], x0[1]), pack2(x0[2], x0[3]), pack2(x1[0], x1[1]), pack2(x1[2], x1[3])}; xf[ks] = __builtin_bit_cast(bf16x8, pk); }
#pragma unroll
        for (int nt = 0; nt < 4; ++nt) {
            f32x4 ra = __builtin_amdgcn_mfma_f32_16x16x32_bf16(wfa[nt][0], xf[0], (f32x4){0.f, 0.f, 0.f, 0.f}, 0, 0, 0); ra = __builtin_amdgcn_mfma_f32_16x16x32_bf16(wfa[nt][1], xf[1], ra, 0, 0, 0);
            f32x4 rx = __builtin_amdgcn_mfma_f32_16x16x32_bf16(wfx[nt][0], xf[0], (f32x4){0.f, 0.f, 0.f, 0.f}, 0, 0, 0); rx = __builtin_amdgcn_mfma_f32_16x16x32_bf16(wfx[nt][1], xf[1], rx, 0, 0, 0);
            u32x2 pa; pa.x = pack2(ra[0], ra[1]); pa.y = pack2(ra[2], ra[3]); u32x2 px; px.x = pack2(rx[0], rx[1]); px.y = pack2(rx[2], rx[3]);
            *(u32x2*)(preA + (tt * 16 + r16) * 256 + g * 64 + nt * 16 + quad * 4) = pa; *(u32x2*)(preX + (tt * 16 + r16) * 256 + g * 64 + nt * 16 + quad * 4) = px;
        }
    }
    __syncthreads();
    const float ba = p.lru_ba[l * 256 + ch], bx = p.lru_bx[l * 256 + ch], lam = p.lru_lam[l * 256 + ch];
    const float sp = fmaxf(-lam, 0.f) + log1pf(__expf(-fabsf(lam)));
    float hh = 0.f, P = 1.f;
    float* lhp = lh + (size_t)tok0 * 256 + ch; float* lpp = lp + (size_t)tok0 * 256 + ch;
#pragma unroll 4
    for (int i = 0; i < 32; ++i) { const float r = sigmoid_f(bf2f(preA[i * 256 + ch]) + ba), ig = sigmoid_f(bf2f(preX[i * 256 + ch]) + bx); const float la = -8.f * r * sp; const float a = __expf(la);
        const float u = sqrtf(-expm1f(2.f * la)) * (ig * xcs[i * 256 + ch]); hh = a * hh + u; P *= a;
        lhp[(size_t)i * 256] = hh; lpp[(size_t)i * 256] = P; }
}

__device__ void lru3_item(const Params& p, int idx) {
    const int ch = tid_opq(); const int b = idx >> 7, c = idx & 127; const int tok0 = b * S + c * 32;
    const bf16_t* z = (const bf16_t*)(p.ws + WS_Z); bf16_t* mix = (bf16_t*)(p.ws + WS_U);
    const float* lh = (const float*)(p.ws + WS_LH); const float* lp = (const float*)(p.ws + WS_LP); const float* lc = (const float*)(p.ws + WS_LC);
    const float carry = lc[(size_t)(b * 128 + c) * 256 + ch];
    float hv[32], pv[32]; bf16_t gv[32];
#pragma unroll
    for (int i = 0; i < 32; ++i) { const size_t tok = (size_t)(tok0 + i); hv[i] = lh[tok * 256 + ch]; pv[i] = lp[tok * 256 + ch]; gv[i] = z[tok * ZP + C_BG + ch]; }
#pragma unroll
    for (int i = 0; i < 32; ++i) { const size_t tok = (size_t)(tok0 + i); mix[tok * 1024 + 256 + ch] = f2bf((hv[i] + pv[i] * carry) * silu_f(bf2f(gv[i]))); }
}

__device__ void dilc_item(const Params& p, int idx) {
    const int t = tid_opq(); const size_t tok = (size_t)idx * 8 + (t >> 5); const int chn = t & 31; const int h = chn >> 3;
    const bf16_t* z = (const bf16_t*)(p.ws + WS_Z); bf16_t* mix = (bf16_t*)(p.ws + WS_U);
    const bf16_t* dilo = (const bf16_t*)(p.ws + WS_DILO); const float* dill = (const float*)(p.ws + WS_DILL);
    const float l0 = dill[((size_t)0 * T + tok) * 4 + h], l1 = dill[((size_t)1 * T + tok) * 4 + h], l2 = dill[((size_t)2 * T + tok) * 4 + h];
    const float mx = fmaxf(l0, fmaxf(l1, l2)); float w0 = __expf(l0 - mx), w1 = __expf(l1 - mx), w2 = __expf(l2 - mx); const float inv = 1.f / (w0 + w1 + w2); w0 *= inv; w1 *= inv; w2 *= inv;
    const u32x4 o0 = *(const u32x4*)(dilo + ((size_t)0 * T + tok) * 256 + chn * 8), o1 = *(const u32x4*)(dilo + ((size_t)1 * T + tok) * 256 + chn * 8), o2 = *(const u32x4*)(dilo + ((size_t)2 * T + tok) * 256 + chn * 8);
    const u32x4 gv = *(const u32x4*)(z + tok * ZP + C_CG + chn * 8);
    u32x4 r;
#pragma unroll
    for (int e = 0; e < 4; ++e) {
        const float a = w0 * __uint_as_float(o0[e] << 16) + w1 * __uint_as_float(o1[e] << 16) + w2 * __uint_as_float(o2[e] << 16);
        const float bq = w0 * __uint_as_float(o0[e] & 0xffff0000u) + w1 * __uint_as_float(o1[e] & 0xffff0000u) + w2 * __uint_as_float(o2[e] & 0xffff0000u);
        r[e] = pack2(a * silu_f(__uint_as_float(gv[e] << 16)), bq * silu_f(__uint_as_float(gv[e] & 0xffff0000u)));
    }
    *(u32x4*)(mix + tok * 1024 + 512 + chn * 8) = r;
}

__device__ void m2_phase(const Params& p, char* smem) {
    float* gkv = (float*)(p.ws + WS_GKV); const float* gdec = (const float*)(p.ws + WS_GDEC);
    const float* lh = (const float*)(p.ws + WS_LH); const float* lp = (const float*)(p.ws + WS_LP); float* lc = (float*)(p.ws + WS_LC);
    float* aggP = (float*)smem; float* aggS = aggP + 256;
    const int t = tid_opq(); const int e = t & 31, seg = t >> 5;
    for (int it = blockIdx.x; it < 1024 + 32; it += gridDim.x) {
        float a[16], x[16];
        size_t ostride;
        float* outp;
        if (it < 1024) {
            const int gid = it * 32 + e; const int bh = gid >> 11, dv = gid & 2047, d = dv >> 6;
            float* base = gkv + (size_t)bh * 128 * 2048 + dv + (size_t)(seg * 16) * 2048; const float* dc = gdec + (size_t)bh * 128 * 32 + d + (seg * 16) * 32;
#pragma unroll
            for (int k = 0; k < 16; ++k) { x[k] = base[(size_t)k * 2048]; a[k] = dc[k * 32]; }
            outp = base; ostride = 2048;
        } else {
            const int i2 = it - 1024; const int b = i2 >> 3, ch = (i2 & 7) * 32 + e;
#pragma unroll
            for (int k = 0; k < 16; ++k) { const size_t ix = (size_t)(b * S + (seg * 16 + k) * 32 + 31) * 256 + ch; a[k] = lp[ix]; x[k] = lh[ix]; }
            outp = lc + (size_t)(b * 128 + seg * 16) * 256 + ch; ostride = 256;
        }
        float st = 0.f, pr = 1.f;
#pragma unroll
        for (int k = 0; k < 16; ++k) { const float ak = a[k], xk = x[k]; a[k] = pr; x[k] = st; st = ak * st + xk; pr *= ak; }
        __syncthreads();
        aggP[seg * 32 + e] = pr; aggS[seg * 32 + e] = st;
        __syncthreads();
        float carry = 0.f;
        for (int s2 = 0; s2 < seg; ++s2) carry = aggP[s2 * 32 + e] * carry + aggS[s2 * 32 + e];
#pragma unroll
        for (int k = 0; k < 16; ++k) outp[(size_t)k * ostride] = x[k] + a[k] * carry;
    }
}

__global__ void __launch_bounds__(256, 2) fwd_megakernel(Params p) {
    __shared__ __attribute__((aligned(16))) char smem[SMEM_BYTES];
    __shared__ uint4 xb_words;
    __shared__ int s_slot;
    cg::grid_group grid = cg::this_grid();
    if (p.out == nullptr) grid.sync();
    if (threadIdx.x == 0) xb_words = make_uint4(0u, 0u, 0u, 0u);
    __syncthreads();
    const XcdBarrier xb = xcd_barrier_post((unsigned*)(p.ws + WS_CTL), (volatile LAS unsigned*)&xb_words);
    unsigned* cnt = (unsigned*)(p.ws + WS_CNT);
    prologue_phase(p, smem);
    xcd_barrier(xb);
#pragma unroll 1
    for (int l = 0; l < DEPTH; ++l) {
        ln_phase(p, l);
        xcd_barrier(xb);
        g1_phase(p, l, smem);
        xcd_barrier(xb);
        for (;;) { const int it = next_item(cnt + (0 + l) * 64, &s_slot); if (it >= 512) break; moba_item(p, it, smem, (bf16_t*)(p.ws + WS_U)); }
        for (;;) { const int it = next_item(cnt + (6 + l) * 64, &s_slot); if (it >= 1536) break; attn_item(p, 1, it, smem); }
        for (;;) { const int it = next_item(cnt + (2 + l) * 64, &s_slot); if (it >= 512) break; gla1_item(p, l, it, smem); }
        for (;;) { const int it = next_item(cnt + (4 + l) * 64, &s_slot); if (it >= 512) break; lru1_item(p, l, it, smem); }
        xcd_barrier(xb);
        m2_phase(p, smem);
        xcd_barrier(xb);
        for (int it = blockIdx.x; it < 512; it += gridDim.x) gla3_item(p, l, it, smem);
        for (int it = blockIdx.x; it < 512; it += gridDim.x) lru3_item(p, it);
        for (int it = blockIdx.x; it < 2048; it += gridDim.x) dilc_item(p, it);
        xcd_barrier(xb);
        g2_phase(p, l, smem);
        xcd_barrier(xb);
    }
    ln_phase(p, DEPTH);
}

extern "C" void kernel_launch(void* const* d_in, const int* in_sizes, int n_in, void* d_out, int out_size, void* d_ws, size_t ws_size, hipStream_t stream) {
    static int grid_blocks = 0;
    if (!grid_blocks) {
        int dev = 0, cus = 0, per_cu = 0;
        hipGetDevice(&dev);
        hipDeviceGetAttribute(&cus, hipDeviceAttributeMultiprocessorCount, dev);
        hipOccupancyMaxActiveBlocksPerMultiprocessor(&per_cu, (const void*)fwd_megakernel, 256, 0);
        if (per_cu < 1) per_cu = 1;
        if (per_cu > 2) per_cu = 2;
        grid_blocks = cus * per_cu;
        if (ws_size < WS_END) fprintf(stderr, "kernel_launch: workspace too small: %zu < %zu\n", ws_size, (size_t)WS_END);
    }
    Params p{};
    p.x = (const float*)d_in[0]; p.c = (const float*)d_in[1]; p.pos = (const int*)d_in[2];
    p.w_mod = (const float*)d_in[3]; p.b_mod = (const float*)d_in[4]; p.w_in = (const float*)d_in[5];
    p.conv_w = (const float*)d_in[6]; p.conv_b = (const float*)d_in[7]; p.lru_wa = (const float*)d_in[8]; p.lru_ba = (const float*)d_in[9];
    p.lru_wx = (const float*)d_in[10]; p.lru_bx = (const float*)d_in[11]; p.lru_lam = (const float*)d_in[12];
    p.gla_wr = (const float*)d_in[13]; p.gla_br = (const float*)d_in[14]; p.gla_gn = (const float*)d_in[15];
    p.w_out = (const float*)d_in[16]; p.ln_g = (const float*)d_in[17]; p.ln_b = (const float*)d_in[18];
    p.out = (float*)d_out; p.ws = (unsigned char*)d_ws;
    (void)hipMemsetAsync(d_ws, 0, 32768, stream);
    void* args[] = {&p};
    hipError_t e = hipLaunchCooperativeKernel((const void*)fwd_megakernel, dim3(grid_blocks), dim3(256), args, 0, stream);
    if (e != hipSuccess) fprintf(stderr, "cooperative launch failed: %s (grid %d)\n", hipGetErrorString(e), grid_blocks);
}
```

```cpp
#include <hip/hip_runtime.h>
#include <hip/hip_cooperative_groups.h>
#include <cstdio>
#include <cstdint>
#include <type_traits>
namespace cg = cooperative_groups;

typedef unsigned short bf16_t;
typedef short bf16x8 __attribute__((ext_vector_type(8)));
typedef short bf16x4 __attribute__((ext_vector_type(4)));
typedef float f32x4 __attribute__((ext_vector_type(4)));
typedef unsigned u32x4 __attribute__((ext_vector_type(4)));
typedef unsigned u32x2 __attribute__((ext_vector_type(2)));

constexpr int D = 1024, NB = 4, S = 4096, T = NB * S, DEPTH = 2;
constexpr int DIN = 3344, ZP = 3344, NPAD = 3456;
constexpr int C_AQ = 0, C_AK = 256, C_AV = 512, C_AG = 768, C_BX = 1024, C_BG = 1280, C_CQ = 1536, C_CK = 1792,
              C_CV = 2048, C_CG = 2304, C_DQ = 2560, C_DK = 2688, C_DV = 2816, C_DG = 3072, C_DR = 3328;
constexpr float DN_ALPHA = 1.4142135623730951f;
constexpr int LDP = 72;
constexpr int SMEM_BYTES = 65536;
constexpr int BIG = 1000000;

constexpr size_t WS_CTL = 0;
constexpr size_t WS_CNT = 16384;
constexpr size_t WS_WINT = 32768;
constexpr size_t WS_WOUTT = WS_WINT + (size_t)DEPTH * NPAD * 1024 * 2;
constexpr size_t WS_MOD = WS_WOUTT + (size_t)DEPTH * 1024 * 1024 * 2;
constexpr size_t WS_COS = WS_MOD + (size_t)DEPTH * NB * 3072 * 4;
constexpr size_t WS_SIN = WS_COS + (size_t)T * 32 * 4;
constexpr size_t WS_U = WS_SIN + (size_t)T * 32 * 4;
constexpr size_t WS_Z = WS_U + (size_t)T * 1024 * 2;
constexpr size_t WS_KPART = WS_Z + (size_t)T * ZP * 2;
constexpr size_t WS_DILO = WS_KPART + (size_t)256 * 256 * 4;
constexpr size_t WS_DILL = WS_DILO + (size_t)3 * T * 256 * 2;
constexpr size_t WS_GKV = WS_DILL + (size_t)3 * T * 4 * 4;
constexpr size_t WS_GDEC = WS_GKV + (size_t)2048 * 2048 * 4;
constexpr size_t WS_LH = WS_GDEC + (size_t)2048 * 32 * 4;
constexpr size_t WS_LP = WS_LH + (size_t)T * 256 * 4;
constexpr size_t WS_LC = WS_LP + (size_t)T * 256 * 4;
constexpr size_t WS_LWT = WS_LC + (size_t)NB * 128 * 256 * 4;
constexpr size_t WS_END = WS_LWT + (size_t)DEPTH * 2 * 4 * 64 * 64 * 2;

struct Params {
    const float *x, *c; const int* pos;
    const float *w_mod, *b_mod, *w_in, *conv_w, *conv_b, *lru_wa, *lru_ba, *lru_wx, *lru_bx, *lru_lam, *gla_wr, *gla_br, *gla_gn, *w_out, *ln_g, *ln_b;
    float* out; unsigned char* ws;
};

__device__ __forceinline__ float bf2f(bf16_t h) { return __uint_as_float(((unsigned)h) << 16); }
typedef __bf16 hbf16x2 __attribute__((ext_vector_type(2)));
typedef float f32x2 __attribute__((ext_vector_type(2)));
__device__ __forceinline__ unsigned pack2(float a, float b) { f32x2 v = {a, b}; hbf16x2 r = __builtin_convertvector(v, hbf16x2); return __builtin_bit_cast(unsigned, r); }
__device__ __forceinline__ bf16_t f2bf(float f) { return (bf16_t)(pack2(f, 0.f) & 0xffffu); }
__device__ __forceinline__ float silu_f(float x) { return x / (1.f + __expf(-x)); }
__device__ __forceinline__ float sigmoid_f(float x) { return 1.f / (1.f + __expf(-x)); }
__device__ __forceinline__ int tid_opq() { int t = threadIdx.x; asm volatile("" : "+v"(t)); return t; }
__device__ __forceinline__ float wsum(float v) {
#pragma unroll
    for (int o = 32; o; o >>= 1) v += __shfl_xor(v, o);
    return v;
}

#define XB_TMO      128
#define XB_XCNT(j)  (256  + 64 * (j))
#define XB_XSUB(j)  (1280 + 64 * (j))
#define XB_XGEN(j)  (2304 + 64 * (j))
#define XB_TOP      3328
#define XB_TOPGEN   3392
#define XCD_BAR_WORDS 3456
#define XB_SPIN_CAP (1u << 18)
#define LAS __attribute__((address_space(3)))
__device__ __forceinline__ unsigned xb_ld(unsigned* p)              { return __hip_atomic_load(p, __ATOMIC_RELAXED, __HIP_MEMORY_SCOPE_AGENT); }
__device__ __forceinline__ unsigned xb_add(unsigned* p, unsigned v) { return __hip_atomic_fetch_add(p, v, __ATOMIC_RELAXED, __HIP_MEMORY_SCOPE_AGENT); }
__device__ __forceinline__ unsigned xb_xcc_id() { return (unsigned)__builtin_amdgcn_s_getreg((3 << 11) | 20) & 0xFu; }
#define XB_SPIN(cond, bar) do { unsigned _sp = 0; while (cond) { __builtin_amdgcn_s_sleep(1); \
    if ((++_sp & 255u) == 0u) { if (xb_ld(&(bar)[XB_TMO])) break; if (_sp > XB_SPIN_CAP) { atomicAdd(&(bar)[XB_TMO], 1u); break; } } } } while (0)
struct XcdBarrier { unsigned* bar; unsigned x; volatile LAS unsigned* st; };
__device__ __forceinline__ XcdBarrier xcd_barrier_post(unsigned* bar, volatile LAS unsigned* st) {
    XcdBarrier b; b.bar = bar; b.x = xb_xcc_id(); b.st = st;
    if (threadIdx.x == 0) (void)xb_add(&bar[XB_XCNT(b.x)], 1u);
    return b;
}
__device__ __forceinline__ void xcd_barrier_complete(unsigned* bar, unsigned x, unsigned& nloc, unsigned& nx) {
    const unsigned G = gridDim.x * gridDim.y * gridDim.z;
    unsigned sum, cnt, mine, sp = 0u;
    for (;;) {
        sum = 0u; cnt = 0u; mine = 0u;
#pragma unroll
        for (unsigned j = 0; j < 16; ++j) { const unsigned c = xb_ld(&bar[XB_XCNT(j)]); sum += c; cnt += (c > 0u) ? 1u : 0u; mine = (j == x) ? c : mine; }
        if (sum == G) break;
        __builtin_amdgcn_s_sleep(1);
        if ((++sp & 255u) == 0u) { if (xb_ld(&bar[XB_TMO])) break; if (sp > XB_SPIN_CAP) { atomicAdd(&bar[XB_TMO], 1u); break; } }
    }
    nloc = mine > 0u ? mine : 1u; nx = cnt > 0u ? cnt : 1u;
}
__device__ __forceinline__ void xcd_barrier(const XcdBarrier& b) {
    asm volatile("s_waitcnt vmcnt(0)" ::: "memory");
    __syncthreads();
    if (threadIdx.x == 0) {
        unsigned* bar = b.bar;
        __builtin_amdgcn_s_waitcnt(0);
        unsigned nloc = b.st[0], nx = b.st[1];
        if (nloc == 0u) { xcd_barrier_complete(bar, b.x, nloc, nx); b.st[0] = nloc; b.st[1] = nx; }
        const unsigned old = xb_add(&bar[XB_XSUB(b.x)], 1u);
        const unsigned gen = old / nloc;
        if (old + 1u == (gen + 1u) * nloc) {
            __builtin_amdgcn_fence(__ATOMIC_RELEASE, "agent");
            asm volatile("s_waitcnt vmcnt(0)" ::: "memory");
            const unsigned og = xb_add(&bar[XB_TOP], 1u);
            const unsigned tg = og / nx;
            if (og + 1u == (tg + 1u) * nx) xb_add(&bar[XB_TOPGEN], 1u);
            else XB_SPIN(xb_ld(&bar[XB_TOPGEN]) == tg, bar);
            __builtin_amdgcn_fence(__ATOMIC_ACQUIRE, "agent");
            xb_add(&bar[XB_XGEN(b.x)], 1u);
            asm volatile("s_waitcnt vmcnt(0)" ::: "memory");
        } else {
            XB_SPIN(xb_ld(&bar[XB_XGEN(b.x)]) == gen, bar);
            __builtin_amdgcn_fence(__ATOMIC_ACQUIRE, "agent");
            asm volatile("s_waitcnt vmcnt(0)" ::: "memory");
        }
    }
    __syncthreads();
}
__device__ __forceinline__ int next_item(unsigned* ctr, volatile int* slot) {
    __syncthreads();
    if (threadIdx.x == 0) *slot = (int)atomicAdd(ctr, 1u);
    __syncthreads();
    return *slot;
}

__device__ void prologue_phase(const Params& p, char* smem) {
    const int t = tid_opq();
    bf16_t* WinT = (bf16_t*)(p.ws + WS_WINT); bf16_t* WoutT = (bf16_t*)(p.ws + WS_WOUTT);
    float* mod = (float*)(p.ws + WS_MOD); float* cosT = (float*)(p.ws + WS_COS); float* sinT = (float*)(p.ws + WS_SIN);
    float* tl = (float*)smem;
    constexpr int N_TIN = DEPTH * 16 * 54, N_TOUT = DEPTH * 16 * 16, N_MOD = DEPTH * 192, N_ROPE = T * 32 / 256, N_LWT = DEPTH * 2 * 4 * 64 * 64 / 256;
    constexpr int NITEMS = N_TIN + N_TOUT + N_MOD + N_ROPE + N_LWT;
    for (int it = blockIdx.x; it < NITEMS; it += gridDim.x) {
        if (it < N_TIN + N_TOUT) {
            const float* src; bf16_t* dst; int ncols, kt, nt;
            if (it < N_TIN) { int l = it / (16 * 54), r = it % (16 * 54); kt = r / 54; nt = r % 54; src = p.w_in + (size_t)l * 1024 * DIN; dst = WinT + (size_t)l * NPAD * 1024; ncols = DIN; }
            else { int i2 = it - N_TIN; int l = i2 / 256, r = i2 % 256; kt = r / 16; nt = r % 16; src = p.w_out + (size_t)l * 1024 * 1024; dst = WoutT + (size_t)l * 1024 * 1024; ncols = 1024; }
            __syncthreads();
            { const int c = t & 63, r0 = t >> 6; const int n = nt * 64 + c;
#pragma unroll
              for (int i = 0; i < 16; ++i) { int r = r0 + 4 * i; tl[r * 65 + c] = (n < ncols) ? src[(size_t)(kt * 64 + r) * ncols + n] : 0.f; } }
            __syncthreads();
            { const int kk = t & 63, n0 = t >> 6;
#pragma unroll
              for (int i = 0; i < 16; ++i) { int n = n0 + 4 * i; dst[(size_t)(nt * 64 + n) * 1024 + kt * 64 + kk] = f2bf(tl[kk * 65 + n]); } }
        } else if (it < N_TIN + N_TOUT + N_MOD) {
            const int i2 = it - N_TIN - N_TOUT; const int l = i2 / 192, jg = i2 % 192;
            const int jj = t & 15, ks = t >> 4; const int j = jg * 16 + jj;
            float a0 = 0.f, a1 = 0.f, a2 = 0.f, a3 = 0.f;
            const float* wm = p.w_mod + (size_t)l * 1024 * 3072 + j;
#pragma unroll 8
            for (int k = ks * 64; k < ks * 64 + 64; ++k) { float wv = wm[(size_t)k * 3072]; a0 += p.c[k] * wv; a1 += p.c[1024 + k] * wv; a2 += p.c[2048 + k] * wv; a3 += p.c[3072 + k] * wv; }
            __syncthreads();
            tl[(0 * 16 + ks) * 16 + jj] = a0; tl[(1 * 16 + ks) * 16 + jj] = a1; tl[(2 * 16 + ks) * 16 + jj] = a2; tl[(3 * 16 + ks) * 16 + jj] = a3;
            __syncthreads();
            if (t < 64) { const int b = t >> 4, j2 = t & 15; float s = 0.f;
#pragma unroll
              for (int k2 = 0; k2 < 16; ++k2) s += tl[(b * 16 + k2) * 16 + j2];
              mod[((size_t)l * NB + b) * 3072 + jg * 16 + j2] = s + p.b_mod[l * 3072 + jg * 16 + j2]; }
        } else if (it >= N_TIN + N_TOUT + N_MOD + N_ROPE) {
            const int e = (it - N_TIN - N_TOUT - N_MOD - N_ROPE) * 256 + t;
            const int in = e & 63, out = (e >> 6) & 63, g = (e >> 12) & 3, mat = (e >> 14) & 1, l = e >> 15;
            const float* src = mat ? p.lru_wx : p.lru_wa;
            ((bf16_t*)(p.ws + WS_LWT))[e] = f2bf(src[l * 16384 + g * 4096 + in * 64 + out]);
        } else {
            const int i2 = it - N_TIN - N_TOUT - N_MOD; const int e = i2 * 256 + t; const int tok = e >> 5, f = e & 31;
            const float inv = exp2f(-(float)f * (13.287712379549449f / 32.f));
            const float ang = (float)p.pos[tok] * inv;
            double rev = (double)ang * 0.15915494309189535; rev -= __builtin_rint(rev);
            const float rr = (float)rev; cosT[e] = __builtin_amdgcn_cosf(rr); sinT[e] = __builtin_amdgcn_sinf(rr);
        }
    }
}

__device__ void ln_phase(const Params& p, int l) {
    const int t = tid_opq(), lane = t & 63, w = t >> 6;
    bf16_t* ubuf = (bf16_t*)(p.ws + WS_U); const float* mod = (const float*)(p.ws + WS_MOD);
    for (int rg = blockIdx.x; rg < T / 16; rg += gridDim.x) {
        f32x4 v[4][4];
#pragma unroll
        for (int r = 0; r < 4; ++r) { const int row = rg * 16 + w * 4 + r; const float* src = (l <= 1) ? p.x + (size_t)row * 1024 : p.out + (size_t)row * 1024;
#pragma unroll
            for (int i = 0; i < 4; ++i) v[r][i] = *(const f32x4*)(src + i * 256 + lane * 4);
            if (l > 0) {
                const bf16_t* yr = (const bf16_t*)(p.ws + WS_Z) + (size_t)row * 1024; const float* gate = mod + ((size_t)(l - 1) * NB + row / S) * 3072 + 2048;
#pragma unroll
                for (int i = 0; i < 4; ++i) { const u32x2 yv = *(const u32x2*)(yr + i * 256 + lane * 4); const f32x4 g1 = *(const f32x4*)(gate + i * 256 + lane * 4) + 1.f;
                    const f32x4 yf = {__uint_as_float(yv.x << 16), __uint_as_float(yv.x & 0xffff0000u), __uint_as_float(yv.y << 16), __uint_as_float(yv.y & 0xffff0000u)};
                    v[r][i] = v[r][i] * DN_ALPHA + g1 * yf; }
            } }
#pragma unroll
        for (int r = 0; r < 4; ++r) {
            const int row = rg * 16 + w * 4 + r; const int b = row / S;
            if (l > 0) {
                float s = 0.f;
#pragma unroll
                for (int i = 0; i < 4; ++i) s += (v[r][i][0] + v[r][i][1]) + (v[r][i][2] + v[r][i][3]);
                const float mu = wsum(s) * (1.f / 1024.f); float q = 0.f;
#pragma unroll
                for (int i = 0; i < 4; ++i) { f32x4 d = v[r][i] - mu; q += (d[0] * d[0] + d[1] * d[1]) + (d[2] * d[2] + d[3] * d[3]); }
                const float rstd = rsqrtf(wsum(q) * (1.f / 1024.f) + 1e-5f);
#pragma unroll
                for (int i = 0; i < 4; ++i) { const f32x4 g = *(const f32x4*)(p.ln_g + (l - 1) * 1024 + i * 256 + lane * 4), bb = *(const f32x4*)(p.ln_b + (l - 1) * 1024 + i * 256 + lane * 4);
                    v[r][i] = (v[r][i] - mu) * rstd * g + bb; *(f32x4*)(p.out + (size_t)row * 1024 + i * 256 + lane * 4) = v[r][i]; }
            }
            if (l < DEPTH) {
                float s = 0.f;
#pragma unroll
                for (int i = 0; i < 4; ++i) s += (v[r][i][0] + v[r][i][1]) + (v[r][i][2] + v[r][i][3]);
                const float mu = wsum(s) * (1.f / 1024.f); float q = 0.f;
#pragma unroll
                for (int i = 0; i < 4; ++i) { f32x4 d = v[r][i] - mu; q += (d[0] * d[0] + d[1] * d[1]) + (d[2] * d[2] + d[3] * d[3]); }
                const float rstd = rsqrtf(wsum(q) * (1.f / 1024.f) + 1e-5f);
                const float* mb = mod + ((size_t)l * NB + b) * 3072;
#pragma unroll
                for (int i = 0; i < 4; ++i) { const int col = i * 256 + lane * 4; const f32x4 sh = *(const f32x4*)(mb + col), sc = *(const f32x4*)(mb + 1024 + col);
                    f32x4 u = (v[r][i] - mu) * rstd * (sc + 1.f) + sh; u32x2 pk; pk.x = pack2(u[0], u[1]); pk.y = pack2(u[2], u[3]);
                    *(u32x2*)(ubuf + (size_t)row * 1024 + col) = pk; }
            }
        }
    }
}

__device__ __forceinline__ int lds_off(int r, int c8) {
    const int st = (r >> 4) * 2 + (c8 >> 2); const int ob = (r & 15) * 64 + (c8 & 3) * 16;
    return st * 1024 + (ob ^ (((ob >> 9) & 1) << 5));
}
struct RegSet { u32x4 a[4], b[4]; };
__device__ __forceinline__ void gemm_tile(const bf16_t* __restrict__ A, const bf16_t* __restrict__ Bt, int tm, int tn, bool first, bool has_next, int ntm, int ntn,
                                          char* sm, f32x4 (&acc)[4][4], RegSet& r0, RegSet& r1) {
    const int t = tid_opq(), lane = t & 63, w = t >> 6, wm = w >> 1, wn = w & 1, r16 = lane & 15, quad = lane >> 4;
    const int lrow = t >> 3, lch = t & 7;
    constexpr int BUF = 32768;
    const unsigned loff = (unsigned)(lrow * 1024 + lch * 8);
    const bf16_t* At0 = A + (size_t)tm * (128 * 1024); const bf16_t* Bt0 = Bt + (size_t)tn * (128 * 1024);
    const bf16_t* At1 = A + (size_t)ntm * (128 * 1024); const bf16_t* Bt1 = Bt + (size_t)ntn * (128 * 1024);
#define Ag (At0 + loff)
#define Bg (Bt0 + loff)
#define nAg (At1 + loff)
#define nBg (Bt1 + loff)
    const int woff0 = lds_off(lrow, lch);
#define woff(i) (woff0 + 4096 * (i))
    const int fo = lds_off(r16, quad);
#pragma unroll
    for (int a = 0; a < 4; ++a)
#pragma unroll
        for (int b = 0; b < 4; ++b) acc[a][b] = (f32x4){0.f, 0.f, 0.f, 0.f};
    if (first) {
#pragma unroll
        for (int i = 0; i < 4; ++i) { r0.a[i] = *(const u32x4*)(Ag + (size_t)i * 32 * 1024); r0.b[i] = *(const u32x4*)(Bg + (size_t)i * 32 * 1024); }
        __syncthreads();
#pragma unroll
        for (int i = 0; i < 4; ++i) { *(u32x4*)(sm + woff(i)) = r0.a[i]; *(u32x4*)(sm + 16384 + woff(i)) = r0.b[i]; }
#pragma unroll
        for (int i = 0; i < 4; ++i) { r0.a[i] = *(const u32x4*)(Ag + (size_t)i * 32 * 1024 + 64); r0.b[i] = *(const u32x4*)(Bg + (size_t)i * 32 * 1024 + 64); }
    }
    __syncthreads();
    auto step = [&](auto main_tag, int kt) {
        constexpr bool MAIN = decltype(main_tag)::value;
        const char* sA = sm + (kt & 1) * BUF; const char* sB = sA + 16384;
        char* nA = sm + ((kt + 1) & 1) * BUF; char* nB = nA + 16384;
        const bool wr = MAIN || kt + 1 < 16 || has_next;
        const bool own = MAIN || kt + 2 < 16;
        const bf16_t* la = own ? Ag + (kt + 2) * 64 : nAg + (kt - 14) * 64; const bf16_t* lb = own ? Bg + (kt + 2) * 64 : nBg + (kt - 14) * 64;
        {
            bf16x8 af[2][4], bfr[2][4];
#pragma unroll
            for (int mt = 0; mt < 4; ++mt) af[0][mt] = *(const bf16x8*)(sA + ((wm * 4 + mt) * 2 + 0) * 1024 + fo);
#pragma unroll
            for (int nt = 0; nt < 4; ++nt) bfr[0][nt] = *(const bf16x8*)(sB + ((wn * 4 + nt) * 2 + 0) * 1024 + fo);
            __builtin_amdgcn_s_setprio(1);
#pragma unroll
            for (int ks = 0; ks < 2; ++ks) {
#pragma unroll
                for (int mt = 0; mt < 4; ++mt) {
#pragma unroll
                    for (int nt = 0; nt < 4; ++nt) acc[mt][nt] = __builtin_amdgcn_mfma_f32_16x16x32_bf16(bfr[ks][nt], af[ks][mt], acc[mt][nt], 0, 0, 0);
                    const int i = ks * 2 + (mt >> 1);
                    __builtin_amdgcn_sched_barrier(0);
                    if (ks == 0) { af[1][mt] = *(const bf16x8*)(sA + ((wm * 4 + mt) * 2 + 1) * 1024 + fo); bfr[1][mt] = *(const bf16x8*)(sB + ((wn * 4 + mt) * 2 + 1) * 1024 + fo); }
                    if ((mt & 1) == 0) { if (wr) *(u32x4*)(nA + woff(i)) = r0.a[i]; if (own || has_next) r0.a[i] = *(const u32x4*)(la + (size_t)i * 32 * 1024); }
                    else               { if (wr) *(u32x4*)(nB + woff(i)) = r0.b[i]; if (own || has_next) r0.b[i] = *(const u32x4*)(lb + (size_t)i * 32 * 1024); }
                    __builtin_amdgcn_sched_barrier(0);
                }
            }
            __builtin_amdgcn_s_setprio(0);
        }
        __syncthreads();
    };
    {
        std::true_type mt_; std::false_type tl_;
        for (int kt = 0; kt < 14; ++kt) step(mt_, kt);
        step(tl_, 14); step(tl_, 15);
    }
#undef Ag
#undef Bg
#undef nAg
#undef nBg
#undef woff
}

__device__ void g1_phase(const Params& p, int l, char* smem) {
    const int t = tid_opq(), lane = t & 63, w = t >> 6, wm = w >> 1, wn = w & 1, r16 = lane & 15, quad = lane >> 4;
    char* sm = smem; char* sC = smem + 32768;
    const bf16_t* ubuf = (const bf16_t*)(p.ws + WS_U); const bf16_t* WinT = (const bf16_t*)(p.ws + WS_WINT) + (size_t)l * NPAD * 1024;
    bf16_t* z = (bf16_t*)(p.ws + WS_Z); float* kpart = (float*)(p.ws + WS_KPART);
    const float* cosT = (const float*)(p.ws + WS_COS); const float* sinT = (const float*)(p.ws + WS_SIN);
    const bool xo = (gridDim.x & 7) == 0; const int xcd = blockIdx.x & 7, nloc = xo ? (int)(gridDim.x >> 3) : (int)gridDim.x, j0 = xo ? (int)(blockIdx.x >> 3) : (int)blockIdx.x;
    const int lim = xo ? 16 * 27 : 128 * 27;
    RegSet r0, r1;
    for (int L = j0; L < lim; L += nloc) {
        const int tm = xo ? xcd * 16 + (L / 216) * 8 + (L & 7) : L / 27, tn = xo ? ((L % 216) >> 3) : L % 27;
        const int L2 = L + nloc; const bool has_next = L2 < lim;
        const int ntm = has_next ? (xo ? xcd * 16 + (L2 / 216) * 8 + (L2 & 7) : L2 / 27) : tm, ntn = has_next ? (xo ? ((L2 % 216) >> 3) : L2 % 27) : tn;
        f32x4 acc[4][4];
        gemm_tile(ubuf, WinT, tm, tn, L == j0, has_next, ntm, ntn, sm, acc, r0, r1);
        const bool rope = (tn < 4) || (tn >= 12 && tn < 16);
        if (rope) {
#pragma unroll
            for (int mt = 0; mt < 4; ++mt) {
                const int tok = tm * 128 + wm * 64 + mt * 16 + r16;
#pragma unroll
                for (int nt = 0; nt < 2; ++nt) {
                    const f32x4 cs = *(const f32x4*)(cosT + (size_t)tok * 32 + nt * 16 + quad * 4), sn = *(const f32x4*)(sinT + (size_t)tok * 32 + nt * 16 + quad * 4);
                    const f32x4 x1 = acc[mt][nt], x2 = acc[mt][nt + 2];
                    acc[mt][nt] = x1 * cs - x2 * sn; acc[mt][nt + 2] = x1 * sn + x2 * cs;
                }
            }
        }
        if (tn == 2 || tn == 3) {
#pragma unroll
            for (int nt = 0; nt < 4; ++nt) {
                f32x4 sv = (acc[0][nt] + acc[1][nt]) + (acc[2][nt] + acc[3][nt]);
#pragma unroll
                for (int jj = 0; jj < 4; ++jj) { float sx = sv[jj]; sx += __shfl_xor(sx, 1); sx += __shfl_xor(sx, 2); sx += __shfl_xor(sx, 4); sx += __shfl_xor(sx, 8); sv[jj] = sx; }
                if (r16 == 0) *(f32x4*)(kpart + (size_t)(tm * 2 + wm) * 256 + (tn - 2) * 128 + wn * 64 + nt * 16 + quad * 4) = sv;
            }
        }
#pragma unroll
        for (int mt = 0; mt < 4; ++mt)
#pragma unroll
            for (int nt = 0; nt < 4; ++nt) { u32x2 pk; pk.x = pack2(acc[mt][nt][0], acc[mt][nt][1]); pk.y = pack2(acc[mt][nt][2], acc[mt][nt][3]);
                const int row = wm * 64 + mt * 16 + r16; const int c16 = wn * 8 + nt * 2 + (quad >> 1);
                *(u32x2*)(sC + row * 256 + ((c16 ^ (row & 15)) << 4) + (quad & 1) * 8) = pk; }
        __syncthreads();
#pragma unroll
        for (int i = 0; i < 8; ++i) { const int c = t + 256 * i; const int row = c >> 4, ch = c & 15; const int col = tn * 128 + ch * 8;
            if (col < DIN) *(u32x4*)(z + (size_t)(tm * 128 + row) * ZP + col) = *(const u32x4*)(sC + row * 256 + ((ch ^ (row & 15)) << 4)); }
    }
}

__device__ void g2_phase(const Params& p, int l, char* smem) {
    const int t = tid_opq(), lane = t & 63, w = t >> 6, wm = w >> 1, wn = w & 1, r16 = lane & 15, quad = lane >> 4;
    char* sm = smem; char* sC = smem + 32768;
    const bf16_t* mix = (const bf16_t*)(p.ws + WS_U); const bf16_t* WoutT = (const bf16_t*)(p.ws + WS_WOUTT) + (size_t)l * 1024 * 1024;
    bf16_t* ybuf = (bf16_t*)(p.ws + WS_Z);
    const bool xo = (gridDim.x & 7) == 0; const int xcd = blockIdx.x & 7, nloc = xo ? (int)(gridDim.x >> 3) : (int)gridDim.x, j0 = xo ? (int)(blockIdx.x >> 3) : (int)blockIdx.x;
    const int lim = xo ? 16 * 8 : 128 * 8;
    RegSet r0, r1;
    for (int L = j0; L < lim; L += nloc) {
        const int tm = xo ? xcd * 16 + (L & 15) : (L >> 3), tn = xo ? (L >> 4) : (L & 7);
        const int L2 = L + nloc; const bool has_next = L2 < lim;
        const int ntm = has_next ? (xo ? xcd * 16 + (L2 & 15) : (L2 >> 3)) : tm, ntn = has_next ? (xo ? (L2 >> 4) : (L2 & 7)) : tn;
        f32x4 acc[4][4];
        gemm_tile(mix, WoutT, tm, tn, L == j0, has_next, ntm, ntn, sm, acc, r0, r1);
#pragma unroll
        for (int mt = 0; mt < 4; ++mt)
#pragma unroll
            for (int nt = 0; nt < 4; ++nt) { u32x2 pk; pk.x = pack2(acc[mt][nt][0], acc[mt][nt][1]); pk.y = pack2(acc[mt][nt][2], acc[mt][nt][3]);
                const int row = wm * 64 + mt * 16 + r16; const int c16 = wn * 8 + nt * 2 + (quad >> 1);
                *(u32x2*)(sC + row * 256 + ((c16 ^ (row & 15)) << 4) + (quad & 1) * 8) = pk; }
        __syncthreads();
#pragma unroll
        for (int i = 0; i < 8; ++i) { const int c = t + 256 * i; const int row = c >> 4, ch = c & 15;
            *(u32x4*)(ybuf + (size_t)(tm * 128 + row) * 1024 + tn * 128 + ch * 8) = *(const u32x4*)(sC + row * 256 + ((ch ^ (row & 15)) << 4)); }
    }
}

constexpr float ATT_SC = 0.18033688011112042f;
template <int QT>
__device__ __forceinline__ void attn_tile(const bf16_t* sK, const bf16_t* sV, const bf16x8 (&qf)[QT][2], int lo, int hi, bool full, bool hasq, bool qfl0, bool qfl1,
                                          float (&m)[QT], float (&l)[QT], f32x4 (&O)[QT][4], int wq0) {
    const int lane = tid_opq() & 63, r16 = lane & 15, quad = lane >> 4;
    f32x4 s[QT][4];
#pragma unroll
    for (int a = 0; a < QT; ++a)
#pragma unroll
        for (int b = 0; b < 4; ++b) s[a][b] = (f32x4){0.f, 0.f, 0.f, 0.f};
#pragma unroll
    for (int ks = 0; ks < 2; ++ks)
#pragma unroll
        for (int k16 = 0; k16 < 4; ++k16) {
            const bf16x8 kf = *(const bf16x8*)(sK + (k16 * 16 + r16) * LDP + ks * 32 + quad * 8);
#pragma unroll
            for (int qt = 0; qt < QT; ++qt) s[qt][k16] = __builtin_amdgcn_mfma_f32_16x16x32_bf16(kf, qf[qt][ks], s[qt][k16], 0, 0, 0);
        }
#pragma unroll
    for (int qt = 0; qt < QT; ++qt) {
        const int ql = wq0 + qt * 16 + r16; const bool qfl = qt ? qfl1 : qfl0;
        if (!full) {
#pragma unroll
            for (int k16 = 0; k16 < 4; ++k16)
#pragma unroll
                for (int j = 0; j < 4; ++j) { const int dd = ql - (k16 * 16 + quad * 4 + j); const bool valid = dd >= lo && dd <= hi; s[qt][k16][j] = valid ? s[qt][k16][j] : -1e30f; }
        }
        if (hasq) {
#pragma unroll
            for (int k16 = 0; k16 < 4; ++k16)
#pragma unroll
                for (int j = 0; j < 4; ++j) s[qt][k16][j] = qfl ? s[qt][k16][j] : -1e30f;
        }
        float mx = -1e30f;
#pragma unroll
        for (int k16 = 0; k16 < 4; ++k16) mx = fmaxf(mx, fmaxf(fmaxf(s[qt][k16][0], s[qt][k16][1]), fmaxf(s[qt][k16][2], s[qt][k16][3])));
        mx = fmaxf(mx, __shfl_xor(mx, 16)); mx = fmaxf(mx, __shfl_xor(mx, 32));
        const float mn = fmaxf(m[qt], mx); const float alpha = __builtin_amdgcn_exp2f((m[qt] - mn) * ATT_SC); m[qt] = mn;
        const float mb = (mn < -1e29f) ? 0.f : mn * ATT_SC;
        float ps = 0.f;
#pragma unroll
        for (int k16 = 0; k16 < 4; ++k16)
#pragma unroll
            for (int j = 0; j < 4; ++j) { const float pv = __builtin_amdgcn_exp2f(s[qt][k16][j] * ATT_SC - mb); ps += pv; s[qt][k16][j] = pv; }
        l[qt] = l[qt] * alpha + ps;
#pragma unroll
        for (int dt = 0; dt < 4; ++dt) O[qt][dt] = O[qt][dt] * alpha;
    }
#pragma unroll
    for (int G = 0; G < 2; ++G) {
        bf16x8 pf[QT];
#pragma unroll
        for (int qt = 0; qt < QT; ++qt) {
            const unsigned a0 = pack2(s[qt][G * 2][0], s[qt][G * 2][1]), a1 = pack2(s[qt][G * 2][2], s[qt][G * 2][3]);
            const unsigned a2 = pack2(s[qt][G * 2 + 1][0], s[qt][G * 2 + 1][1]), a3 = pack2(s[qt][G * 2 + 1][2], s[qt][G * 2 + 1][3]);
            u32x4 pk = {a0, a1, a2, a3}; pf[qt] = __builtin_bit_cast(bf16x8, pk);
        }
#pragma unroll
        for (int dt = 0; dt < 4; ++dt) {
            const bf16_t* v0p = sV + (G * 32 + quad * 4 + (r16 >> 2)) * LDP + dt * 16 + (r16 & 3) * 4;
            const bf16x4 v0 = __builtin_amdgcn_ds_read_tr16_b64_v4i16((__attribute__((address_space(3))) bf16x4*)(v0p));
            const bf16x4 v1 = __builtin_amdgcn_ds_read_tr16_b64_v4i16((__attribute__((address_space(3))) bf16x4*)(v0p + 16 * LDP));
            const bf16x8 vf = {v0[0], v0[1], v0[2], v0[3], v1[0], v1[1], v1[2], v1[3]};
#pragma unroll
            for (int qt = 0; qt < QT; ++qt) O[qt][dt] = __builtin_amdgcn_mfma_f32_16x16x32_bf16(vf, pf[qt], O[qt][dt], 0, 0, 0);
        }
    }
}

__device__ void attn_item(const Params& p, int kind, int idx, char* smem) {
    const int t = tid_opq(), lane = t & 63, w = t >> 6, r16 = lane & 15, quad = lane >> 4;
    bf16_t* sK = (bf16_t*)smem; bf16_t* sV = sK + 64 * LDP;
    float* kmean = (float*)(smem + 18432); float* gates = (float*)(smem + 22528); unsigned* selm = (unsigned*)(smem + 30720);
    int4* desc = (int4*)(smem + 31232); int* misc = (int*)(smem + 32320);
    const bf16_t* z = (const bf16_t*)(p.ws + WS_Z);
    int b, h, qbase, stride, qcol, kcol, vcol, cfg = 0;
    __syncthreads();
    if (kind == 0) {
        const int n = 15 - (idx >> 5); const int rem = idx & 31; b = rem >> 3; h = (rem >> 1) & 3; const int qh = rem & 1;
        qbase = b * S + n * 256 + qh * 128; stride = 1; qcol = C_AQ + h * 64; kcol = C_AK + h * 64; vcol = C_AV + h * 64;
        const float* kpart = (const float*)(p.ws + WS_KPART);
        for (int e = t; e < n * 64; e += 256) { const int j = e >> 6, d = e & 63; const float* kp = kpart + (size_t)(b * 64 + j * 4) * 256 + h * 64 + d;
            kmean[e] = ((kp[0] + kp[256]) + (kp[512] + kp[768])) * (1.f / 256.f); }
        if (t == 0) misc[1] = 0;
        __syncthreads();
        {
            const int ql = t >> 1, half = t & 1; const bf16_t* qp = z + (size_t)(qbase + ql) * ZP + qcol;
            float g[8];
#pragma unroll
            for (int jj = 0; jj < 8; ++jj) g[jj] = 0.f;
#pragma unroll 1
            for (int dc = 0; dc < 8; ++dc) {
                const u32x4 qv = *(const u32x4*)(qp + dc * 8); float qq[8];
#pragma unroll
                for (int e = 0; e < 4; ++e) { qq[2 * e] = __uint_as_float(qv[e] << 16); qq[2 * e + 1] = __uint_as_float(qv[e] & 0xffff0000u); }
#pragma unroll
                for (int jj = 0; jj < 8; ++jj) { const int j = half + 2 * jj; if (j < n) { const float* km = kmean + j * 64 + dc * 8;
#pragma unroll
                    for (int e = 0; e < 8; ++e) g[jj] += qq[e] * km[e]; } }
            }
#pragma unroll
            for (int jj = 0; jj < 8; ++jj) gates[ql * 16 + half + 2 * jj] = g[jj];
        }
        __syncthreads();
        if (t < 128) {
            unsigned msk = 0;
            for (int k = 0; k < 3 && k < n; ++k) { float best = -3.0e38f; int bi = -1;
                for (int j = 0; j < n; ++j) if (!((msk >> j) & 1u)) { const float gv = gates[t * 16 + j]; if (gv > best) { best = gv; bi = j; } }
                if (bi >= 0) msk |= 1u << bi; }
            selm[t] = msk; atomicOr((unsigned*)&misc[1], msk);
        }
        __syncthreads();
        if (t == 0) {
            int nd = 0; const unsigned bm = (unsigned)misc[1];
            for (int kt = 0; kt <= qh * 2 + 1; ++kt) desc[nd++] = make_int4(b * S + n * 256 + kt * 64, kt * 64 - qh * 128, BIG, -1);
            for (int j = 0; j < n; ++j) if ((bm >> j) & 1u) for (int kt = 0; kt < 4; ++kt) desc[nd++] = make_int4(b * S + j * 256 + kt * 64, -BIG, BIG, j);
            misc[0] = nd;
        }
    } else {
        cfg = idx >> 9; const int rem = idx & 511; b = rem >> 7; h = (rem >> 5) & 3; const int rb = rem & 31;
        const int dil = 1 << (2 * cfg); const int res = rb & (dil - 1), blk = rb >> (2 * cfg);
        qbase = b * S + blk * 128 * dil + res; stride = dil; qcol = C_CQ + h * 64; kcol = C_CK + h * 64; vcol = C_CV + h * 64;
        if (t < 128) selm[t] = 0xffffffffu;
        if (t == 0) { int nd = 0; for (int kt = (blk == 0 ? 2 : 0); kt < 4; ++kt) desc[nd++] = make_int4(b * S + (blk * 128 - 128 + kt * 64) * dil + res, kt * 64 - 128, kt * 64, -1); misc[0] = nd; }
    }
    __syncthreads();
    const int nd = misc[0];
    bf16x8 qf[2][2];
#pragma unroll
    for (int qt = 0; qt < 2; ++qt)
#pragma unroll
        for (int ks = 0; ks < 2; ++ks) qf[qt][ks] = *(const bf16x8*)(z + (size_t)(qbase + (w * 32 + qt * 16 + r16) * stride) * ZP + qcol + ks * 32 + quad * 8);
    const unsigned sel0 = selm[w * 32 + r16], sel1 = selm[w * 32 + 16 + r16];
    float m[2] = {-1e30f, -1e30f}, l[2] = {0.f, 0.f}; f32x4 O[2][4];
#pragma unroll
    for (int a = 0; a < 2; ++a)
#pragma unroll
        for (int c = 0; c < 4; ++c) O[a][c] = (f32x4){0.f, 0.f, 0.f, 0.f};
    const int lrow = t >> 2, lch = (t & 3) * 2;
    u32x4 rk0, rk1, rv0, rv1;
    if (nd > 0) { const int4 d = desc[0]; const bf16_t* rp = z + (size_t)(d.x + lrow * stride) * ZP + lch * 8;
        rk0 = *(const u32x4*)(rp + kcol); rk1 = *(const u32x4*)(rp + kcol + 8); rv0 = *(const u32x4*)(rp + vcol); rv1 = *(const u32x4*)(rp + vcol + 8); }
    for (int i = 0; i < nd; ++i) {
        __syncthreads();
        *(u32x4*)(sK + lrow * LDP + lch * 8) = rk0; *(u32x4*)(sK + lrow * LDP + lch * 8 + 8) = rk1;
        *(u32x4*)(sV + lrow * LDP + lch * 8) = rv0; *(u32x4*)(sV + lrow * LDP + lch * 8 + 8) = rv1;
        __syncthreads();
        if (i + 1 < nd) { const int4 d = desc[i + 1]; const bf16_t* rp = z + (size_t)(d.x + lrow * stride) * ZP + lch * 8;
            rk0 = *(const u32x4*)(rp + kcol); rk1 = *(const u32x4*)(rp + kcol + 8); rv0 = *(const u32x4*)(rp + vcol); rv1 = *(const u32x4*)(rp + vcol + 8); }
        const int4 d = desc[i];
        bool need = (w * 32 + 31 >= d.y) && (w * 32 - 63 <= d.z);
        bool q0 = true, q1 = true;
        if (d.w >= 0) { q0 = (sel0 >> d.w) & 1u; q1 = (sel1 >> d.w) & 1u; need = need && (__ballot(q0 || q1) != 0ull); }
        const bool full = (w * 32 - 63 >= d.y) && (w * 32 + 31 <= d.z);
        if (need) attn_tile<2>(sK, sV, qf, d.y, d.z, full, d.w >= 0, q0, q1, m, l, O, w * 32);
    }
#pragma unroll
    for (int qt = 0; qt < 2; ++qt) {
        float lt = l[qt]; lt += __shfl_xor(lt, 16); lt += __shfl_xor(lt, 32);
        const float inv = 1.f / lt; const size_t tok = (size_t)(qbase + (w * 32 + qt * 16 + r16) * stride);
        if (kind == 0) {
            bf16_t* mix = (bf16_t*)(p.ws + WS_U);
#pragma unroll
            for (int dt = 0; dt < 4; ++dt) { const int d0 = dt * 16 + quad * 4; const u32x2 gv = *(const u32x2*)(z + tok * ZP + C_AG + h * 64 + d0);
                const float g0 = __uint_as_float(gv.x << 16), g1 = __uint_as_float(gv.x & 0xffff0000u), g2 = __uint_as_float(gv.y << 16), g3 = __uint_as_float(gv.y & 0xffff0000u);
                u32x2 o; o.x = pack2(O[qt][dt][0] * inv * silu_f(g0), O[qt][dt][1] * inv * silu_f(g1)); o.y = pack2(O[qt][dt][2] * inv * silu_f(g2), O[qt][dt][3] * inv * silu_f(g3));
                *(u32x2*)(mix + tok * 1024 + h * 64 + d0) = o; }
        } else {
            bf16_t* dilo = (bf16_t*)(p.ws + WS_DILO); float* dill = (float*)(p.ws + WS_DILL);
#pragma unroll
            for (int dt = 0; dt < 4; ++dt) { const int d0 = dt * 16 + quad * 4; u32x2 o; o.x = pack2(O[qt][dt][0] * inv, O[qt][dt][1] * inv); o.y = pack2(O[qt][dt][2] * inv, O[qt][dt][3] * inv);
                *(u32x2*)(dilo + ((size_t)cfg * T + tok) * 256 + h * 64 + d0) = o; }
            if (quad == 0) dill[((size_t)cfg * T + tok) * 4 + h] = m[qt] * 0.125f + __logf(lt);
        }
    }
}

__device__ void moba_item(const Params& p, int idx, char* smem, bf16_t* outp) {
    const int t = tid_opq(), lane = t & 63, w = t >> 6, r16 = lane & 15, quad = lane >> 4;
    bf16_t* sK = (bf16_t*)smem; bf16_t* sV = sK + 64 * LDP;
    float* stO = (float*)(smem + 18432);
    float* kmean = (float*)(smem + 18432); float* gates = (float*)(smem + 22528);
    float* stM = (float*)(smem + 53248); float* stL = (float*)(smem + 53760);
    unsigned* selm = (unsigned*)(smem + 54272); unsigned char* lists = (unsigned char*)(smem + 54784);
    int* cnt = (int*)(smem + 56832); int4* desc = (int4*)(smem + 56960); int* misc = (int*)(smem + 59008);
    const bf16_t* z = (const bf16_t*)(p.ws + WS_Z);
    const int n = 15 - (idx >> 5); const int rem = idx & 31; const int b = rem >> 3, h = (rem >> 1) & 3, qh = rem & 1;
    const int qbase = b * S + n * 256 + qh * 128, qcol = C_AQ + h * 64, kcol = C_AK + h * 64, vcol = C_AV + h * 64;
    __syncthreads();
    {
        const float* kpart = (const float*)(p.ws + WS_KPART);
        for (int e = t; e < n * 64; e += 256) { const int j = e >> 6, d = e & 63; const float* kp = kpart + (size_t)(b * 64 + j * 4) * 256 + h * 64 + d;
            kmean[e] = ((kp[0] + kp[256]) + (kp[512] + kp[768])) * (1.f / 256.f); }
        if (t < 16) cnt[t] = 0;
        __syncthreads();
        {
            const int ql = t >> 1, half = t & 1; const bf16_t* qp = z + (size_t)(qbase + ql) * ZP + qcol;
            float g[8];
#pragma unroll
            for (int jj = 0; jj < 8; ++jj) g[jj] = 0.f;
#pragma unroll 1
            for (int dc = 0; dc < 8; ++dc) {
                const u32x4 qv = *(const u32x4*)(qp + dc * 8); float qq[8];
#pragma unroll
                for (int e = 0; e < 4; ++e) { qq[2 * e] = __uint_as_float(qv[e] << 16); qq[2 * e + 1] = __uint_as_float(qv[e] & 0xffff0000u); }
#pragma unroll
                for (int jj = 0; jj < 8; ++jj) { const int j = half + 2 * jj; if (j < n) { const float* km = kmean + j * 64 + dc * 8;
#pragma unroll
                    for (int e = 0; e < 8; ++e) g[jj] += qq[e] * km[e]; } }
            }
#pragma unroll
            for (int jj = 0; jj < 8; ++jj) gates[ql * 16 + half + 2 * jj] = g[jj];
        }
        __syncthreads();
        if (t < 128) {
            unsigned msk = 0;
            for (int k = 0; k < 3 && k < n; ++k) { float best = -3.0e38f; int bi = -1;
                for (int j = 0; j < n; ++j) if (!((msk >> j) & 1u)) { const float gv = gates[t * 16 + j]; if (gv > best) { best = gv; bi = j; } }
                if (bi >= 0) msk |= 1u << bi; }
            selm[t] = msk;
            for (int j = 0; j < n; ++j) if ((msk >> j) & 1u) { const int pos = atomicAdd(&cnt[j], 1); lists[j * 128 + pos] = (unsigned char)t; }
        }
        __syncthreads();
        if (t < 128) { for (int j = 0; j < n; ++j) { const int cj = cnt[j]; if (t >= cj && t < ((cj + 15) & ~15)) lists[j * 128 + t] = 255; } }
        if (t == 0) {
            int nd = 0;
            for (int kt = 0; kt <= qh * 2 + 1; ++kt) desc[nd++] = make_int4(b * S + n * 256 + kt * 64, kt * 64 - qh * 128, BIG, -1);
            misc[1] = nd;
            for (int j = 0; j < n; ++j) { const int ntl = (cnt[j] + 15) >> 4;
                for (int ps = 0; ps * 4 < ntl; ++ps) for (int kt = 0; kt < 4; ++kt) desc[nd++] = make_int4(b * S + j * 256 + kt * 64, ps, kt, j); }
            misc[0] = nd;
        }
    }
    __syncthreads();
    const int nd = misc[0], nown = misc[1];
    const int lrow = t >> 2, lch = (t & 3) * 2;
    u32x4 rk0, rk1, rv0, rv1;
    { const int4 d = desc[0]; const bf16_t* rp = z + (size_t)(d.x + lrow) * ZP + lch * 8;
      rk0 = *(const u32x4*)(rp + kcol); rk1 = *(const u32x4*)(rp + kcol + 8); rv0 = *(const u32x4*)(rp + vcol); rv1 = *(const u32x4*)(rp + vcol + 8); }
    bf16x8 nqf[2]; int ngq = 0; bool ngv = false, nhas = false;
    auto prefetch_group = [&](int gi) {
        nhas = false;
        if (gi < nd) { const int4 dg = desc[gi]; const int slot = dg.y * 4 + w; nhas = slot * 16 < cnt[dg.w];
            if (nhas) { const int qi = lists[dg.w * 128 + slot * 16 + r16]; ngv = qi != 255; ngq = ngv ? qi : 0;
#pragma unroll
                for (int ks = 0; ks < 2; ++ks) nqf[ks] = *(const bf16x8*)(z + (size_t)(qbase + ngq) * ZP + qcol + ks * 32 + quad * 8); } }
    };
    prefetch_group(nown);
    {
        bf16x8 qf[2][2];
#pragma unroll
        for (int qt = 0; qt < 2; ++qt)
#pragma unroll
            for (int ks = 0; ks < 2; ++ks) qf[qt][ks] = *(const bf16x8*)(z + (size_t)(qbase + w * 32 + qt * 16 + r16) * ZP + qcol + ks * 32 + quad * 8);
        float m[2] = {-1e30f, -1e30f}, l[2] = {0.f, 0.f}; f32x4 O[2][4];
#pragma unroll
        for (int a = 0; a < 2; ++a)
#pragma unroll
            for (int c = 0; c < 4; ++c) O[a][c] = (f32x4){0.f, 0.f, 0.f, 0.f};
        for (int i = 0; i < nown; ++i) {
            __syncthreads();
            *(u32x4*)(sK + lrow * LDP + lch * 8) = rk0; *(u32x4*)(sK + lrow * LDP + lch * 8 + 8) = rk1;
            *(u32x4*)(sV + lrow * LDP + lch * 8) = rv0; *(u32x4*)(sV + lrow * LDP + lch * 8 + 8) = rv1;
            __syncthreads();
            if (i + 1 < nd) { const int4 d = desc[i + 1]; const bf16_t* rp = z + (size_t)(d.x + lrow) * ZP + lch * 8;
                rk0 = *(const u32x4*)(rp + kcol); rk1 = *(const u32x4*)(rp + kcol + 8); rv0 = *(const u32x4*)(rp + vcol); rv1 = *(const u32x4*)(rp + vcol + 8); }
            const int4 d = desc[i];
            const bool need = (w * 32 + 31 >= d.y) && (w * 32 - 63 <= d.z);
            const bool full = (w * 32 - 63 >= d.y) && (w * 32 + 31 <= d.z);
            if (need) attn_tile<2>(sK, sV, qf, d.y, d.z, full, false, true, true, m, l, O, w * 32);
        }
#pragma unroll
        for (int qt = 0; qt < 2; ++qt) {
            float lt = l[qt]; lt += __shfl_xor(lt, 16); lt += __shfl_xor(lt, 32);
            const int ql = w * 32 + qt * 16 + r16;
            if (quad == 0) { stM[ql] = m[qt]; stL[ql] = lt; }
#pragma unroll
            for (int dt = 0; dt < 4; ++dt) *(f32x4*)(stO + ql * 68 + dt * 16 + quad * 4) = O[qt][dt];
        }
    }
    {
        bf16x8 qf[1][2]; float m[1] = {-1e30f}, l[1] = {0.f}; f32x4 O[1][4];
        int gq = 0; bool gv = false, has = false;
        for (int i = nown; i < nd; ++i) {
            __syncthreads();
            *(u32x4*)(sK + lrow * LDP + lch * 8) = rk0; *(u32x4*)(sK + lrow * LDP + lch * 8 + 8) = rk1;
            *(u32x4*)(sV + lrow * LDP + lch * 8) = rv0; *(u32x4*)(sV + lrow * LDP + lch * 8 + 8) = rv1;
            __syncthreads();
            if (i + 1 < nd) { const int4 d = desc[i + 1]; const bf16_t* rp = z + (size_t)(d.x + lrow) * ZP + lch * 8;
                rk0 = *(const u32x4*)(rp + kcol); rk1 = *(const u32x4*)(rp + kcol + 8); rv0 = *(const u32x4*)(rp + vcol); rv1 = *(const u32x4*)(rp + vcol + 8); }
            const int4 d = desc[i];
            if (d.z == 0) {
                has = nhas; gv = ngv; gq = ngq; qf[0][0] = nqf[0]; qf[0][1] = nqf[1];
                m[0] = -1e30f; l[0] = 0.f;
#pragma unroll
                for (int c = 0; c < 4; ++c) O[0][c] = (f32x4){0.f, 0.f, 0.f, 0.f};
                prefetch_group(i + 4);
            }
            if (has) {
                attn_tile<1>(sK, sV, qf, -BIG, BIG, true, false, true, true, m, l, O, 0);
                if (d.z == 3) {
                    float lt = l[0]; lt += __shfl_xor(lt, 16); lt += __shfl_xor(lt, 32);
                    if (gv) {
                        const float mo = stM[gq], lo_ = stL[gq]; const float mn = fmaxf(mo, m[0]);
                        const float fa = __builtin_amdgcn_exp2f((mo - mn) * ATT_SC), fb = __builtin_amdgcn_exp2f((m[0] - mn) * ATT_SC);
#pragma unroll
                        for (int dt = 0; dt < 4; ++dt) { float* sp = stO + gq * 68 + dt * 16 + quad * 4; const f32x4 so = *(const f32x4*)sp; *(f32x4*)sp = so * fa + O[0][dt] * fb; }
                        if (quad == 0) { stM[gq] = mn; stL[gq] = lo_ * fa + lt * fb; }
                    }
                }
            }
        }
    }
    __syncthreads();
#pragma unroll
    for (int qt = 0; qt < 2; ++qt) {
        const int ql = w * 32 + qt * 16 + r16; const float inv = 1.f / stL[ql]; const size_t tok = (size_t)(qbase + ql);
#pragma unroll
        for (int dt = 0; dt < 4; ++dt) { const int d0 = dt * 16 + quad * 4; const f32x4 ov = *(const f32x4*)(stO + ql * 68 + d0);
            const u32x2 gvv = *(const u32x2*)(z + tok * ZP + C_AG + h * 64 + d0);
            const float g0 = __uint_as_float(gvv.x << 16), g1 = __uint_as_float(gvv.x & 0xffff0000u), g2 = __uint_as_float(gvv.y << 16), g3 = __uint_as_float(gvv.y & 0xffff0000u);
            u32x2 o; o.x = pack2(ov[0] * inv * silu_f(g0), ov[1] * inv * silu_f(g1)); o.y = pack2(ov[2] * inv * silu_f(g2), ov[3] * inv * silu_f(g3));
            *(u32x2*)(outp + tok * 1024 + h * 64 + d0) = o; }
    }
}

__device__ __forceinline__ void gla_bcum(const Params& p, int l, const bf16_t* z, int tok0, float* bc, float* drs) {
    const int t = tid_opq();
    const int hd = t & 127, ih = t >> 7;
    float wr[16];
#pragma unroll
    for (int r = 0; r < 16; ++r) wr[r] = p.gla_wr[l * 2048 + r * 128 + hd];
    const float br = p.gla_br[l * 128 + hd];
    { const int e0 = t, e1 = t + 256; const bf16_t d0 = z[(size_t)(tok0 + (e0 >> 4)) * ZP + C_DR + (e0 & 15)], d1 = z[(size_t)(tok0 + (e1 >> 4)) * ZP + C_DR + (e1 & 15)];
      drs[e0] = bf2f(d0); drs[e1] = bf2f(d1); }
    __syncthreads();
#pragma unroll
    for (int ii = 0; ii < 16; ++ii) { const int i = ih * 16 + ii; float x = br;
#pragma unroll
        for (int r4 = 0; r4 < 4; ++r4) { const f32x4 dv = *(const f32x4*)(drs + i * 16 + r4 * 4); x += (dv[0] * wr[r4 * 4] + dv[1] * wr[r4 * 4 + 1]) + (dv[2] * wr[r4 * 4 + 2] + dv[3] * wr[r4 * 4 + 3]); }
        bc[i * 128 + hd] = (fminf(x, 0.f) - __logf(1.f + __expf(-fabsf(x)))) * (1.f / 16.f); }
    __syncthreads();
    if (t < 128) { float sacc = 0.f;
#pragma unroll
        for (int i = 0; i < 32; ++i) { sacc += bc[i * 128 + t]; bc[i * 128 + t] = sacc; } }
    __syncthreads();
}

__device__ void gla1_item(const Params& p, int l, int idx, char* smem) {
    const int t = tid_opq(), lane = t & 63, w = t >> 6, r16 = lane & 15, quad = lane >> 4;
    const int b = idx >> 7, c = idx & 127; const int tok0 = b * S + c * 32;
    const bf16_t* z = (const bf16_t*)(p.ws + WS_Z);
    float* bc = (float*)smem; float* drs = (float*)(smem + 16384);
    bf16_t* kdT = (bf16_t*)(smem + 18432) + w * 1024;
    bf16_t* vL = (bf16_t*)(smem + 26624) + w * (32 * LDP);
    float* gkv = (float*)(p.ws + WS_GKV); float* gdec = (float*)(p.ws + WS_GDEC);
    bf16_t kraw[16]; u32x4 vr[4];
#pragma unroll
    for (int i = 0; i < 16; ++i) { const int e = lane + 64 * i; kraw[i] = z[(size_t)(tok0 + (e >> 5)) * ZP + C_DK + w * 32 + (e & 31)]; }
#pragma unroll
    for (int i = 0; i < 4; ++i) { const int cc = lane + 64 * i; vr[i] = *(const u32x4*)(z + (size_t)(tok0 + (cc >> 3)) * ZP + C_DV + w * 64 + (cc & 7) * 8); }
    __syncthreads();
#pragma unroll
    for (int i = 0; i < 4; ++i) { const int cc = lane + 64 * i; *(u32x4*)(vL + (cc >> 3) * LDP + (cc & 7) * 8) = vr[i]; }
    gla_bcum(p, l, z, tok0, bc, drs);
#pragma unroll
    for (int i = 0; i < 16; ++i) { const int e = lane + 64 * i; const int j = e >> 5, d = e & 31;
        kdT[d * 32 + j] = f2bf(bf2f(kraw[i]) * __expf(bc[31 * 128 + w * 32 + d] - bc[j * 128 + w * 32 + d])); }
    const int bh = b * 4 + w;
    if (lane < 32) gdec[(bh * 128 + c) * 32 + lane] = __expf(bc[31 * 128 + w * 32 + lane]);
    __syncthreads();
    bf16x8 kf[2];
#pragma unroll
    for (int x = 0; x < 2; ++x) kf[x] = *(const bf16x8*)(kdT + (x * 16 + r16) * 32 + quad * 8);
    float* dst = gkv + (size_t)(bh * 128 + c) * 2048;
#pragma unroll
    for (int dt = 0; dt < 4; ++dt) {
        const bf16_t* v0p = vL + (quad * 8 + (r16 >> 2)) * LDP + dt * 16 + (r16 & 3) * 4;
        const bf16x4 v0 = __builtin_amdgcn_ds_read_tr16_b64_v4i16((__attribute__((address_space(3))) bf16x4*)(v0p));
        const bf16x4 v1 = __builtin_amdgcn_ds_read_tr16_b64_v4i16((__attribute__((address_space(3))) bf16x4*)(v0p + 4 * LDP));
        const bf16x8 vf = {v0[0], v0[1], v0[2], v0[3], v1[0], v1[1], v1[2], v1[3]};
#pragma unroll
        for (int x = 0; x < 2; ++x) {
            const f32x4 r = __builtin_amdgcn_mfma_f32_16x16x32_bf16(vf, kf[x], (f32x4){0.f, 0.f, 0.f, 0.f}, 0, 0, 0);
            *(f32x4*)(dst + (x * 16 + r16) * 64 + dt * 16 + quad * 4) = r;
        }
    }
}

#define OPQ(ptr) asm volatile("" : "+v"(ptr))
__device__ void gla3_item(const Params& p, int l, int idx, char* smem) {
    const int t = tid_opq(), lane = t & 63, w = t >> 6, r16 = lane & 15, quad = lane >> 4;
    const int b = idx >> 7, c = idx & 127; const int tok0 = b * S + c * 32;
    const bf16_t* z = (const bf16_t*)(p.ws + WS_Z); bf16_t* mix = (bf16_t*)(p.ws + WS_U);
    float* bc = (float*)smem; float* drs = (float*)(smem + 16384);
    bf16_t* SL = (bf16_t*)smem + w * (32 * LDP);
    bf16_t* qe = (bf16_t*)(smem + 18432) + w * 1024;
    bf16_t* ke = (bf16_t*)(smem + 26624) + w * 1024;
    bf16_t* vL = (bf16_t*)(smem + 34816) + w * (32 * LDP);
    const float* gkv = (const float*)(p.ws + WS_GKV);
    const int bh = b * 4 + w;
    bf16_t qraw[16], kraw[16];
    { const bf16_t* qp = z + (size_t)(tok0 + (lane >> 5)) * ZP + w * 32 + (lane & 31);
#pragma unroll
      for (int i = 0; i < 16; ++i) { qraw[i] = qp[C_DQ]; kraw[i] = qp[C_DK]; qp += 2 * ZP; OPQ(qp); } }
    u32x4 vr[4]; f32x4 sr[8];
#pragma unroll
    for (int i = 0; i < 4; ++i) { const int cc = lane + 64 * i; vr[i] = *(const u32x4*)(z + (size_t)(tok0 + (cc >> 3)) * ZP + C_DV + w * 64 + (cc & 7) * 8); }
    { const float* Sp = gkv + (size_t)(bh * 128 + c) * 2048;
#pragma unroll
      for (int i = 0; i < 8; ++i) sr[i] = *(const f32x4*)(Sp + (lane + 64 * i) * 4); }
    __syncthreads();
#pragma unroll
    for (int i = 0; i < 4; ++i) { const int cc = lane + 64 * i; *(u32x4*)(vL + (cc >> 3) * LDP + (cc & 7) * 8) = vr[i]; }
    gla_bcum(p, l, z, tok0, bc, drs);
#pragma unroll
    for (int i2 = 0; i2 < 16; ++i2) { const int e = lane + 64 * i2; const int i = e >> 5, d = e & 31; const float bcv = bc[i * 128 + w * 32 + d];
        qe[i * 32 + d] = f2bf(bf2f(qraw[i2]) * __expf(bcv) * 0.17677669529663687f); ke[i * 32 + d] = f2bf(bf2f(kraw[i2]) * __expf(-bcv)); }
    __syncthreads();
#pragma unroll
    for (int i = 0; i < 8; ++i) { const int cc = lane + 64 * i; const int d = cc >> 4, v4 = cc & 15; u32x2 pk; pk.x = pack2(sr[i][0], sr[i][1]); pk.y = pack2(sr[i][2], sr[i][3]);
        *(u32x2*)(SL + d * LDP + v4 * 4) = pk; }
    __syncthreads();
    bf16x8 qf[2], kf[2];
#pragma unroll
    for (int x = 0; x < 2; ++x) { qf[x] = *(const bf16x8*)(qe + (x * 16 + r16) * 32 + quad * 8); kf[x] = *(const bf16x8*)(ke + (x * 16 + r16) * 32 + quad * 8); }
    bf16x8 pf[2];
#pragma unroll
    for (int it = 0; it < 2; ++it) {
        f32x4 at[2];
#pragma unroll
        for (int jt = 0; jt < 2; ++jt) { at[jt] = __builtin_amdgcn_mfma_f32_16x16x32_bf16(kf[jt], qf[it], (f32x4){0.f, 0.f, 0.f, 0.f}, 0, 0, 0);
#pragma unroll
            for (int jj = 0; jj < 4; ++jj) at[jt][jj] = (jt * 16 + quad * 4 + jj <= it * 16 + r16) ? at[jt][jj] : 0.f; }
        u32x4 pk = {pack2(at[0][0], at[0][1]), pack2(at[0][2], at[0][3]), pack2(at[1][0], at[1][1]), pack2(at[1][2], at[1][3])};
        pf[it] = __builtin_bit_cast(bf16x8, pk);
    }
    f32x4 O[2][4];
#pragma unroll
    for (int dt = 0; dt < 4; ++dt) {
        const bf16_t* v0p = vL + (quad * 4 + (r16 >> 2)) * LDP + dt * 16 + (r16 & 3) * 4;
        const bf16x4 v0 = __builtin_amdgcn_ds_read_tr16_b64_v4i16((__attribute__((address_space(3))) bf16x4*)(v0p));
        const bf16x4 v1 = __builtin_amdgcn_ds_read_tr16_b64_v4i16((__attribute__((address_space(3))) bf16x4*)(v0p + 16 * LDP));
        const bf16x8 vf = {v0[0], v0[1], v0[2], v0[3], v1[0], v1[1], v1[2], v1[3]};
        const bf16_t* s0p = SL + (quad * 8 + (r16 >> 2)) * LDP + dt * 16 + (r16 & 3) * 4;
        const bf16x4 s0 = __builtin_amdgcn_ds_read_tr16_b64_v4i16((__attribute__((address_space(3))) bf16x4*)(s0p));
        const bf16x4 s1 = __builtin_amdgcn_ds_read_tr16_b64_v4i16((__attribute__((address_space(3))) bf16x4*)(s0p + 4 * LDP));
        const bf16x8 sf = {s0[0], s0[1], s0[2], s0[3], s1[0], s1[1], s1[2], s1[3]};
#pragma unroll
        for (int it = 0; it < 2; ++it) {
            O[it][dt] = __builtin_amdgcn_mfma_f32_16x16x32_bf16(vf, pf[it], (f32x4){0.f, 0.f, 0.f, 0.f}, 0, 0, 0);
            O[it][dt] = __builtin_amdgcn_mfma_f32_16x16x32_bf16(sf, qf[it], O[it][dt], 0, 0, 0);
        }
    }
#pragma unroll
    for (int it = 0; it < 2; ++it) {
        float ss = 0.f;
#pragma unroll
        for (int dt = 0; dt < 4; ++dt) ss += (O[it][dt][0] * O[it][dt][0] + O[it][dt][1] * O[it][dt][1]) + (O[it][dt][2] * O[it][dt][2] + O[it][dt][3] * O[it][dt][3]);
        ss += __shfl_xor(ss, 16); ss += __shfl_xor(ss, 32);
        const float rn = rsqrtf(ss * (1.f / 64.f) + 1e-5f);
        const size_t tok = (size_t)(tok0 + it * 16 + r16);
#pragma unroll
        for (int dt = 0; dt < 4; ++dt) { const int v0i = dt * 16 + quad * 4; const f32x4 gn = *(const f32x4*)(p.gla_gn + l * 64 + v0i);
            const u32x2 gv = *(const u32x2*)(z + tok * ZP + C_DG + w * 64 + v0i);
            const float g0 = __uint_as_float(gv.x << 16), g1 = __uint_as_float(gv.x & 0xffff0000u), g2 = __uint_as_float(gv.y << 16), g3 = __uint_as_float(gv.y & 0xffff0000u);
            u32x2 o; o.x = pack2(O[it][dt][0] * rn * gn[0] * silu_f(g0), O[it][dt][1] * rn * gn[1] * silu_f(g1));
            o.y = pack2(O[it][dt][2] * rn * gn[2] * silu_f(g2), O[it][dt][3] * rn * gn[3] * silu_f(g3));
            *(u32x2*)(mix + tok * 1024 + 768 + w * 64 + v0i) = o; }
    }
}

__device__ void lru1_item(const Params& p, int l, int idx, char* smem) {
    const int t = tid_opq(), lane = t & 63, g = t >> 6, r16 = lane & 15, quad = lane >> 4; const int ch = t;
    const int b = idx >> 7, c = idx & 127; const int s0 = c * 32; const int tok0 = b * S + s0;
    const bf16_t* z = (const bf16_t*)(p.ws + WS_Z); float* xcs = (float*)smem;
    bf16_t* preA = (bf16_t*)(smem + 32768); bf16_t* preX = (bf16_t*)(smem + 49152);
    float* lh = (float*)(p.ws + WS_LH); float* lp = (float*)(p.ws + WS_LP);
    bf16_t xr[35];
#pragma unroll
    for (int i = 0; i < 35; ++i) { const int sidx = s0 + i - 3; xr[i] = (sidx >= 0) ? z[(size_t)(tok0 + i - 3) * ZP + C_BX + ch] : (bf16_t)0; }
    const float cw0 = p.conv_w[l * 1024 + ch], cw1 = p.conv_w[l * 1024 + 256 + ch], cw2 = p.conv_w[l * 1024 + 512 + ch], cw3 = p.conv_w[l * 1024 + 768 + ch];
    const float cb = p.conv_b[l * 256 + ch];
    const bf16_t* lwt = (const bf16_t*)(p.ws + WS_LWT) + (size_t)l * 32768 + g * 4096;
    bf16x8 wfa[4][2], wfx[4][2];
#pragma unroll
    for (int nt = 0; nt < 4; ++nt)
#pragma unroll
        for (int ks = 0; ks < 2; ++ks) { wfa[nt][ks] = *(const bf16x8*)(lwt + (nt * 16 + r16) * 64 + ks * 32 + quad * 8); wfx[nt][ks] = *(const bf16x8*)(lwt + 16384 + (nt * 16 + r16) * 64 + ks * 32 + quad * 8); }
    __syncthreads();
#pragma unroll
    for (int i = 0; i < 32; ++i) xcs[i * 256 + ch] = cb + (cw0 * bf2f(xr[i]) + cw1 * bf2f(xr[i + 1])) + (cw2 * bf2f(xr[i + 2]) + cw3 * bf2f(xr[i + 3]));
    __syncthreads();
#pragma unroll
    for (int tt = 0; tt < 2; ++tt) {
        bf16x8 xf[2];
#pragma unroll
        for (int ks = 0; ks < 2; ++ks) { const float* xp = xcs + (tt * 16 + r16) * 256 + g * 64 + ks * 32 + quad * 8; const f32x4 x0 = *(const f32x4*)xp, x1 = *(const f32x4*)(xp + 4);
            u32x4 pk = {pack2(x0[0], x0[1]), pack2(x0[2], x0[3]), pack2(x1[0], x1[1]), pack2(x1[2], x1[3])}; xf[ks] = __builtin_bit_cast(bf16x8, pk); }
#pragma unroll
        for (int nt = 0; nt < 4; ++nt) {
            f32x4 ra = __builtin_amdgcn_mfma_f32_16x16x32_bf16(wfa[nt][0], xf[0], (f32x4){0.f, 0.f, 0.f, 0.f}, 0, 0, 0); ra = __builtin_amdgcn_mfma_f32_16x16x32_bf16(wfa[nt][1], xf[1], ra, 0, 0, 0);
            f32x4 rx = __builtin_amdgcn_mfma_f32_16x16x32_bf16(wfx[nt][0], xf[0], (f32x4){0.f, 0.f, 0.f, 0.f}, 0, 0, 0); rx = __builtin_amdgcn_mfma_f32_16x16x32_bf16(wfx[nt][1], xf[1], rx, 0, 0, 0);
            u32x2 pa; pa.x = pack2(ra[0], ra[1]); pa.y = pack2(ra[2], ra[3]); u32x2 px; px.x = pack2(rx[0], rx[1]); px.y = pack2(rx[2], rx[3]);
            *(u32x2*)(preA + (tt * 16 + r16) * 256 + g * 64 + nt * 16 + quad * 4) = pa; *(u32x2*)(preX + (tt * 16 + r16) * 256 + g * 64 + nt * 16 + quad * 4) = px;
        }
    }
    __syncthreads();
    const float ba = p.lru_ba[l * 256 + ch], bx = p.lru_bx[l * 256 + ch], lam = p.lru_lam[l * 256 + ch];
    const float sp = fmaxf(-lam, 0.f) + log1pf(__expf(-fabsf(lam)));
    float hh = 0.f, P = 1.f;
    float* lhp = lh + (size_t)tok0 * 256 + ch; float* lpp = lp + (size_t)tok0 * 256 + ch;
#pragma unroll 4
    for (int i = 0; i < 32; ++i) { const float r = sigmoid_f(bf2f(preA[i * 256 + ch]) + ba), ig = sigmoid_f(bf2f(preX[i * 256 + ch]) + bx); const float la = -8.f * r * sp; const float a = __expf(la);
        const float u = sqrtf(-expm1f(2.f * la)) * (ig * xcs[i * 256 + ch]); hh = a * hh + u; P *= a;
        lhp[(size_t)i * 256] = hh; lpp[(size_t)i * 256] = P; }
}

__device__ void lru3_item(const Params& p, int idx) {
    const int ch = tid_opq(); const int b = idx >> 7, c = idx & 127; const int tok0 = b * S + c * 32;
    const bf16_t* z = (const bf16_t*)(p.ws + WS_Z); bf16_t* mix = (bf16_t*)(p.ws + WS_U);
    const float* lh = (const float*)(p.ws + WS_LH); const float* lp = (const float*)(p.ws + WS_LP); const float* lc = (const float*)(p.ws + WS_LC);
    const float carry = lc[(size_t)(b * 128 + c) * 256 + ch];
    float hv[32], pv[32]; bf16_t gv[32];
#pragma unroll
    for (int i = 0; i < 32; ++i) { const size_t tok = (size_t)(tok0 + i); hv[i] = lh[tok * 256 + ch]; pv[i] = lp[tok * 256 + ch]; gv[i] = z[tok * ZP + C_BG + ch]; }
#pragma unroll
    for (int i = 0; i < 32; ++i) { const size_t tok = (size_t)(tok0 + i); mix[tok * 1024 + 256 + ch] = f2bf((hv[i] + pv[i] * carry) * silu_f(bf2f(gv[i]))); }
}

__device__ void dilc_item(const Params& p, int idx) {
    const int t = tid_opq(); const size_t tok = (size_t)idx * 8 + (t >> 5); const int chn = t & 31; const int h = chn >> 3;
    const bf16_t* z = (const bf16_t*)(p.ws + WS_Z); bf16_t* mix = (bf16_t*)(p.ws + WS_U);
    const bf16_t* dilo = (const bf16_t*)(p.ws + WS_DILO); const float* dill = (const float*)(p.ws + WS_DILL);
    const float l0 = dill[((size_t)0 * T + tok) * 4 + h], l1 = dill[((size_t)1 * T + tok) * 4 + h], l2 = dill[((size_t)2 * T + tok) * 4 + h];
    const float mx = fmaxf(l0, fmaxf(l1, l2)); float w0 = __expf(l0 - mx), w1 = __expf(l1 - mx), w2 = __expf(l2 - mx); const float inv = 1.f / (w0 + w1 + w2); w0 *= inv; w1 *= inv; w2 *= inv;
    const u32x4 o0 = *(const u32x4*)(dilo + ((size_t)0 * T + tok) * 256 + chn * 8), o1 = *(const u32x4*)(dilo + ((size_t)1 * T + tok) * 256 + chn * 8), o2 = *(const u32x4*)(dilo + ((size_t)2 * T + tok) * 256 + chn * 8);
    const u32x4 gv = *(const u32x4*)(z + tok * ZP + C_CG + chn * 8);
    u32x4 r;
#pragma unroll
    for (int e = 0; e < 4; ++e) {
        const float a = w0 * __uint_as_float(o0[e] << 16) + w1 * __uint_as_float(o1[e] << 16) + w2 * __uint_as_float(o2[e] << 16);
        const float bq = w0 * __uint_as_float(o0[e] & 0xffff0000u) + w1 * __uint_as_float(o1[e] & 0xffff0000u) + w2 * __uint_as_float(o2[e] & 0xffff0000u);
        r[e] = pack2(a * silu_f(__uint_as_float(gv[e] << 16)), bq * silu_f(__uint_as_float(gv[e] & 0xffff0000u)));
    }
    *(u32x4*)(mix + tok * 1024 + 512 + chn * 8) = r;
}

__device__ void m2_phase(const Params& p, char* smem) {
    float* gkv = (float*)(p.ws + WS_GKV); const float* gdec = (const float*)(p.ws + WS_GDEC);
    const float* lh = (const float*)(p.ws + WS_LH); const float* lp = (const float*)(p.ws + WS_LP); float* lc = (float*)(p.ws + WS_LC);
    float* aggP = (float*)smem; float* aggS = aggP + 256;
    const int t = tid_opq(); const int e = t & 31, seg = t >> 5;
    for (int it = blockIdx.x; it < 1024 + 32; it += gridDim.x) {
        float a[16], x[16];
        size_t ostride;
        float* outp;
        if (it < 1024) {
            const int gid = it * 32 + e; const int bh = gid >> 11, dv = gid & 2047, d = dv >> 6;
            float* base = gkv + (size_t)bh * 128 * 2048 + dv + (size_t)(seg * 16) * 2048; const float* dc = gdec + (size_t)bh * 128 * 32 + d + (seg * 16) * 32;
#pragma unroll
            for (int k = 0; k < 16; ++k) { x[k] = base[(size_t)k * 2048]; a[k] = dc[k * 32]; }
            outp = base; ostride = 2048;
        } else {
            const int i2 = it - 1024; const int b = i2 >> 3, ch = (i2 & 7) * 32 + e;
#pragma unroll
            for (int k = 0; k < 16; ++k) { const size_t ix = (size_t)(b * S + (seg * 16 + k) * 32 + 31) * 256 + ch; a[k] = lp[ix]; x[k] = lh[ix]; }
            outp = lc + (size_t)(b * 128 + seg * 16) * 256 + ch; ostride = 256;
        }
        float st = 0.f, pr = 1.f;
#pragma unroll
        for (int k = 0; k < 16; ++k) { const float ak = a[k], xk = x[k]; a[k] = pr; x[k] = st; st = ak * st + xk; pr *= ak; }
        __syncthreads();
        aggP[seg * 32 + e] = pr; aggS[seg * 32 + e] = st;
        __syncthreads();
        float carry = 0.f;
        for (int s2 = 0; s2 < seg; ++s2) carry = aggP[s2 * 32 + e] * carry + aggS[s2 * 32 + e];
#pragma unroll
        for (int k = 0; k < 16; ++k) outp[(size_t)k * ostride] = x[k] + a[k] * carry;
    }
}

__global__ void __launch_bounds__(256, 2) fwd_megakernel(Params p) {
    __shared__ __attribute__((aligned(16))) char smem[SMEM_BYTES];
    __shared__ uint4 xb_words;
    __shared__ int s_slot;
    cg::grid_group grid = cg::this_grid();
    if (p.out == nullptr) grid.sync();
    if (threadIdx.x == 0) xb_words = make_uint4(0u, 0u, 0u, 0u);
    __syncthreads();
    const XcdBarrier xb = xcd_barrier_post((unsigned*)(p.ws + WS_CTL), (volatile LAS unsigned*)&xb_words);
    unsigned* cnt = (unsigned*)(p.ws + WS_CNT);
    prologue_phase(p, smem);
    xcd_barrier(xb);
#pragma unroll 1
    for (int l = 0; l < DEPTH; ++l) {
        ln_phase(p, l);
        xcd_barrier(xb);
        g1_phase(p, l, smem);
        xcd_barrier(xb);
        for (;;) { const int it = next_item(cnt + (0 + l) * 64, &s_slot); if (it >= 512) break; moba_item(p, it, smem, (bf16_t*)(p.ws + WS_U)); }
        for (;;) { const int it = next_item(cnt + (6 + l) * 64, &s_slot); if (it >= 1536) break; attn_item(p, 1, it, smem); }
        for (;;) { const int it = next_item(cnt + (2 + l) * 64, &s_slot); if (it >= 512) break; gla1_item(p, l, it, smem); }
        for (;;) { const int it = next_item(cnt + (4 + l) * 64, &s_slot); if (it >= 512) break; lru1_item(p, l, it, smem); }
        xcd_barrier(xb);
        m2_phase(p, smem);
        xcd_barrier(xb);
        for (int it = blockIdx.x; it < 512; it += gridDim.x) gla3_item(p, l, it, smem);
        for (int it = blockIdx.x; it < 512; it += gridDim.x) lru3_item(p, it);
        for (int it = blockIdx.x; it < 2048; it += gridDim.x) dilc_item(p, it);
        xcd_barrier(xb);
        g2_phase(p, l, smem);
        xcd_barrier(xb);
    }
    ln_phase(p, DEPTH);
}

extern "C" void kernel_launch(void* const* d_in, const int* in_sizes, int n_in, void* d_out, int out_size, void* d_ws, size_t ws_size, hipStream_t stream) {
    static int grid_blocks = 0;
    if (!grid_blocks) {
        int dev = 0, cus = 0, per_cu = 0;
        hipGetDevice(&dev);
        hipDeviceGetAttribute(&cus, hipDeviceAttributeMultiprocessorCount, dev);
        hipOccupancyMaxActiveBlocksPerMultiprocessor(&per_cu, (const void*)fwd_megakernel, 256, 0);
        if (per_cu < 1) per_cu = 1;
        if (per_cu > 2) per_cu = 2;
        grid_blocks = cus * per_cu;
        if (ws_size < WS_END) fprintf(stderr, "kernel_launch: workspace too small: %zu < %zu\n", ws_size, (size_t)WS_END);
    }
    Params p{};
    p.x = (const float*)d_in[0]; p.c = (const float*)d_in[1]; p.pos = (const int*)d_in[2];
    p.w_mod = (const float*)d_in[3]; p.b_mod = (const float*)d_in[4]; p.w_in = (const float*)d_in[5];
    p.conv_w = (const float*)d_in[6]; p.conv_b = (const float*)d_in[7]; p.lru_wa = (const float*)d_in[8]; p.lru_ba = (const float*)d_in[9];
    p.lru_wx = (const float*)d_in[10]; p.lru_bx = (const float*)d_in[11]; p.lru_lam = (const float*)d_in[12];
    p.gla_wr = (const float*)d_in[13]; p.gla_br = (const float*)d_in[14]; p.gla_gn = (const float*)d_in[15];
    p.w_out = (const float*)d_in[16]; p.ln_g = (const float*)d_in[17]; p.ln_b = (const float*)d_in[18];
    p.out = (float*)d_out; p.ws = (unsigned char*)d_ws;
    (void)hipMemsetAsync(d_ws, 0, 32768, stream);
    void* args[] = {&p};
    hipError_t e = hipLaunchCooperativeKernel((const void*)fwd_megakernel, dim3(grid_blocks), dim3(256), args, 0, stream);
    if (e != hipSuccess) fprintf(stderr, "cooperative launch failed: %s (grid %d)\n", hipGetErrorString(e), grid_blocks);
}
```

```cpp
#include <hip/hip_runtime.h>
#include <hip/hip_cooperative_groups.h>
#include <cstdio>
#include <cstdint>
#include <type_traits>
namespace cg = cooperative_groups;

typedef unsigned short bf16_t;
typedef short bf16x8 __attribute__((ext_vector_type(8)));
typedef short bf16x4 __attribute__((ext_vector_type(4)));
typedef float f32x4 __attribute__((ext_vector_type(4)));
typedef unsigned u32x4 __attribute__((ext_vector_type(4)));
typedef unsigned u32x2 __attribute__((ext_vector_type(2)));

constexpr int D = 1024, NB = 4, S = 4096, T = NB * S, DEPTH = 2;
constexpr int DIN = 3344, ZP = 3344, NPAD = 3456;
constexpr int C_AQ = 0, C_AK = 256, C_AV = 512, C_AG = 768, C_BX = 1024, C_BG = 1280, C_CQ = 1536, C_CK = 1792,
              C_CV = 2048, C_CG = 2304, C_DQ = 2560, C_DK = 2688, C_DV = 2816, C_DG = 3072, C_DR = 3328;
constexpr float DN_ALPHA = 1.4142135623730951f;
constexpr int LDP = 72;
constexpr int SMEM_BYTES = 65536;
constexpr int BIG = 1000000;

constexpr size_t WS_CTL = 0;
constexpr size_t WS_CNT = 16384;
constexpr size_t WS_WINT = 32768;
constexpr size_t WS_WOUTT = WS_WINT + (size_t)DEPTH * NPAD * 1024 * 2;
constexpr size_t WS_MOD = WS_WOUTT + (size_t)DEPTH * 1024 * 1024 * 2;
constexpr size_t WS_COS = WS_MOD + (size_t)DEPTH * NB * 3072 * 4;
constexpr size_t WS_SIN = WS_COS + (size_t)T * 32 * 4;
constexpr size_t WS_U = WS_SIN + (size_t)T * 32 * 4;
constexpr size_t WS_Z = WS_U + (size_t)T * 1024 * 2;
constexpr size_t WS_KPART = WS_Z + (size_t)T * ZP * 2;
constexpr size_t WS_DILO = WS_KPART + (size_t)256 * 256 * 4;
constexpr size_t WS_DILL = WS_DILO + (size_t)3 * T * 256 * 2;
constexpr size_t WS_GKV = WS_DILL + (size_t)3 * T * 4 * 4;
constexpr size_t WS_GDEC = WS_GKV + (size_t)2048 * 2048 * 4;
constexpr size_t WS_LH = WS_GDEC + (size_t)2048 * 32 * 4;
constexpr size_t WS_LP = WS_LH + (size_t)T * 256 * 4;
constexpr size_t WS_LC = WS_LP + (size_t)T * 256 * 4;
constexpr size_t WS_LWT = WS_LC + (size_t)NB * 128 * 256 * 4;
constexpr size_t WS_END = WS_LWT + (size_t)DEPTH * 2 * 4 * 64 * 64 * 2;

struct Params {
    const float *x, *c; const int* pos;
    const float *w_mod, *b_mod, *w_in, *conv_w, *conv_b, *lru_wa, *lru_ba, *lru_wx, *lru_bx, *lru_lam, *gla_wr, *gla_br, *gla_gn, *w_out, *ln_g, *ln_b;
    float* out; unsigned char* ws;
};

__device__ __forceinline__ float bf2f(bf16_t h) { return __uint_as_float(((unsigned)h) << 16); }
typedef __bf16 hbf16x2 __attribute__((ext_vector_type(2)));
typedef float f32x2 __attribute__((ext_vector_type(2)));
__device__ __forceinline__ unsigned pack2(float a, float b) { f32x2 v = {a, b}; hbf16x2 r = __builtin_convertvector(v, hbf16x2); return __builtin_bit_cast(unsigned, r); }
__device__ __forceinline__ bf16_t f2bf(float f) { return (bf16_t)(pack2(f, 0.f) & 0xffffu); }
__device__ __forceinline__ float silu_f(float x) { return x / (1.f + __expf(-x)); }
__device__ __forceinline__ float sigmoid_f(float x) { return 1.f / (1.f + __expf(-x)); }
__device__ __forceinline__ int tid_opq() { int t = threadIdx.x; asm volatile("" : "+v"(t)); return t; }
__device__ __forceinline__ float wsum(float v) {
#pragma unroll
    for (int o = 32; o; o >>= 1) v += __shfl_xor(v, o);
    return v;
}

#define XB_TMO      128
#define XB_XCNT(j)  (256  + 64 * (j))
#define XB_XSUB(j)  (1280 + 64 * (j))
#define XB_XGEN(j)  (2304 + 64 * (j))
#define XB_TOP      3328
#define XB_TOPGEN   3392
#define XCD_BAR_WORDS 3456
#define XB_SPIN_CAP (1u << 18)
#define LAS __attribute__((address_space(3)))
__device__ __forceinline__ unsigned xb_ld(unsigned* p)              { return __hip_atomic_load(p, __ATOMIC_RELAXED, __HIP_MEMORY_SCOPE_AGENT); }
__device__ __forceinline__ unsigned xb_add(unsigned* p, unsigned v) { return __hip_atomic_fetch_add(p, v, __ATOMIC_RELAXED, __HIP_MEMORY_SCOPE_AGENT); }
__device__ __forceinline__ unsigned xb_xcc_id() { return (unsigned)__builtin_amdgcn_s_getreg((3 << 11) | 20) & 0xFu; }
#define XB_SPIN(cond, bar) do { unsigned _sp = 0; while (cond) { __builtin_amdgcn_s_sleep(1); \
    if ((++_sp & 255u) == 0u) { if (xb_ld(&(bar)[XB_TMO])) break; if (_sp > XB_SPIN_CAP) { atomicAdd(&(bar)[XB_TMO], 1u); break; } } } } while (0)
struct XcdBarrier { unsigned* bar; unsigned x; volatile LAS unsigned* st; };
__device__ __forceinline__ XcdBarrier xcd_barrier_post(unsigned* bar, volatile LAS unsigned* st) {
    XcdBarrier b; b.bar = bar; b.x = xb_xcc_id(); b.st = st;
    if (threadIdx.x == 0) (void)xb_add(&bar[XB_XCNT(b.x)], 1u);
    return b;
}
__device__ __forceinline__ void xcd_barrier_complete(unsigned* bar, unsigned x, unsigned& nloc, unsigned& nx) {
    const unsigned G = gridDim.x * gridDim.y * gridDim.z;
    unsigned sum, cnt, mine, sp = 0u;
    for (;;) {
        sum = 0u; cnt = 0u; mine = 0u;
#pragma unroll
        for (unsigned j = 0; j < 16; ++j) { const unsigned c = xb_ld(&bar[XB_XCNT(j)]); sum += c; cnt += (c > 0u) ? 1u : 0u; mine = (j == x) ? c : mine; }
        if (sum == G) break;
        __builtin_amdgcn_s_sleep(1);
        if ((++sp & 255u) == 0u) { if (xb_ld(&bar[XB_TMO])) break; if (sp > XB_SPIN_CAP) { atomicAdd(&bar[XB_TMO], 1u); break; } }
    }
    nloc = mine > 0u ? mine : 1u; nx = cnt > 0u ? cnt : 1u;
}
__device__ __forceinline__ void xcd_barrier(const XcdBarrier& b) {
    asm volatile("s_waitcnt vmcnt(0)" ::: "memory");
    __syncthreads();
    if (threadIdx.x == 0) {
        unsigned* bar = b.bar;
        __builtin_amdgcn_s_waitcnt(0);
        unsigned nloc = b.st[0], nx = b.st[1];
        if (nloc == 0u) { xcd_barrier_complete(bar, b.x, nloc, nx); b.st[0] = nloc; b.st[1] = nx; }
        const unsigned old = xb_add(&bar[XB_XSUB(b.x)], 1u);
        const unsigned gen = old / nloc;
        if (old + 1u == (gen + 1u) * nloc) {
            __builtin_amdgcn_fence(__ATOMIC_RELEASE, "agent");
            asm volatile("s_waitcnt vmcnt(0)" ::: "memory");
            const unsigned og = xb_add(&bar[XB_TOP], 1u);
            const unsigned tg = og / nx;
            if (og + 1u == (tg + 1u) * nx) xb_add(&bar[XB_TOPGEN], 1u);
            else XB_SPIN(xb_ld(&bar[XB_TOPGEN]) == tg, bar);
            __builtin_amdgcn_fence(__ATOMIC_ACQUIRE, "agent");
            xb_add(&bar[XB_XGEN(b.x)], 1u);
            asm volatile("s_waitcnt vmcnt(0)" ::: "memory");
        } else {
            XB_SPIN(xb_ld(&bar[XB_XGEN(b.x)]) == gen, bar);
            __builtin_amdgcn_fence(__ATOMIC_ACQUIRE, "agent");
            asm volatile("s_waitcnt vmcnt(0)" ::: "memory");
        }
    }
    __syncthreads();
}
__device__ __forceinline__ int next_item(unsigned* ctr, volatile int* slot) {
    __syncthreads();
    if (threadIdx.x == 0) *slot = (int)atomicAdd(ctr, 1u);
    __syncthreads();
    return *slot;
}

__device__ void prologue_phase(const Params& p, char* smem) {
    const int t = tid_opq();
    bf16_t* WinT = (bf16_t*)(p.ws + WS_WINT); bf16_t* WoutT = (bf16_t*)(p.ws + WS_WOUTT);
    float* mod = (float*)(p.ws + WS_MOD); float* cosT = (float*)(p.ws + WS_COS); float* sinT = (float*)(p.ws + WS_SIN);
    float* tl = (float*)smem;
    constexpr int N_TIN = DEPTH * 16 * 54, N_TOUT = DEPTH * 16 * 16, N_MOD = DEPTH * 192, N_ROPE = T * 32 / 256, N_LWT = DEPTH * 2 * 4 * 64 * 64 / 256;
    constexpr int NITEMS = N_TIN + N_TOUT + N_MOD + N_ROPE + N_LWT;
    for (int it = blockIdx.x; it < NITEMS; it += gridDim.x) {
        if (it < N_TIN + N_TOUT) {
            const float* src; bf16_t* dst; int ncols, kt, nt;
            if (it < N_TIN) { int l = it / (16 * 54), r = it % (16 * 54); kt = r / 54; nt = r % 54; src = p.w_in + (size_t)l * 1024 * DIN; dst = WinT + (size_t)l * NPAD * 1024; ncols = DIN; }
            else { int i2 = it - N_TIN; int l = i2 / 256, r = i2 % 256; kt = r / 16; nt = r % 16; src = p.w_out + (size_t)l * 1024 * 1024; dst = WoutT + (size_t)l * 1024 * 1024; ncols = 1024; }
            __syncthreads();
            { const int c = t & 63, r0 = t >> 6; const int n = nt * 64 + c;
#pragma unroll
              for (int i = 0; i < 16; ++i) { int r = r0 + 4 * i; tl[r * 65 + c] = (n < ncols) ? src[(size_t)(kt * 64 + r) * ncols + n] : 0.f; } }
            __syncthreads();
            { const int kk = t & 63, n0 = t >> 6;
#pragma unroll
              for (int i = 0; i < 16; ++i) { int n = n0 + 4 * i; dst[(size_t)(nt * 64 + n) * 1024 + kt * 64 + kk] = f2bf(tl[kk * 65 + n]); } }
        } else if (it < N_TIN + N_TOUT + N_MOD) {
            const int i2 = it - N_TIN - N_TOUT; const int l = i2 / 192, jg = i2 % 192;
            const int jj = t & 15, ks = t >> 4; const int j = jg * 16 + jj;
            float a0 = 0.f, a1 = 0.f, a2 = 0.f, a3 = 0.f;
            const float* wm = p.w_mod + (size_t)l * 1024 * 3072 + j;
#pragma unroll 8
            for (int k = ks * 64; k < ks * 64 + 64; ++k) { float wv = wm[(size_t)k * 3072]; a0 += p.c[k] * wv; a1 += p.c[1024 + k] * wv; a2 += p.c[2048 + k] * wv; a3 += p.c[3072 + k] * wv; }
            __syncthreads();
            tl[(0 * 16 + ks) * 16 + jj] = a0; tl[(1 * 16 + ks) * 16 + jj] = a1; tl[(2 * 16 + ks) * 16 + jj] = a2; tl[(3 * 16 + ks) * 16 + jj] = a3;
            __syncthreads();
            if (t < 64) { const int b = t >> 4, j2 = t & 15; float s = 0.f;
#pragma unroll
              for (int k2 = 0; k2 < 16; ++k2) s += tl[(b * 16 + k2) * 16 + j2];
              mod[((size_t)l * NB + b) * 3072 + jg * 16 + j2] = s + p.b_mod[l * 3072 + jg * 16 + j2]; }
        } else if (it >= N_TIN + N_TOUT + N_MOD + N_ROPE) {
            const int e = (it - N_TIN - N_TOUT - N_MOD - N_ROPE) * 256 + t;
            const int in = e & 63, out = (e >> 6) & 63, g = (e >> 12) & 3, mat = (e >> 14) & 1, l = e >> 15;
            const float* src = mat ? p.lru_wx : p.lru_wa;
            ((bf16_t*)(p.ws + WS_LWT))[e] = f2bf(src[l * 16384 + g * 4096 + in * 64 + out]);
        } else {
            const int i2 = it - N_TIN - N_TOUT - N_MOD; const int e = i2 * 256 + t; const int tok = e >> 5, f = e & 31;
            const float inv = exp2f(-(float)f * (13.287712379549449f / 32.f));
            const float ang = (float)p.pos[tok] * inv;
            double rev = (double)ang * 0.15915494309189535; rev -= __builtin_rint(rev);
            const float rr = (float)rev; cosT[e] = __builtin_amdgcn_cosf(rr); sinT[e] = __builtin_amdgcn_sinf(rr);
        }
    }
}

__device__ void ln_phase(const Params& p, int l) {
    const int t = tid_opq(), lane = t & 63, w = t >> 6;
    bf16_t* ubuf = (bf16_t*)(p.ws + WS_U); const float* mod = (const float*)(p.ws + WS_MOD);
    for (int rg = blockIdx.x; rg < T / 16; rg += gridDim.x) {
        f32x4 v[4][4];
#pragma unroll
        for (int r = 0; r < 4; ++r) { const int row = rg * 16 + w * 4 + r; const float* src = (l <= 1) ? p.x + (size_t)row * 1024 : p.out + (size_t)row * 1024;
#pragma unroll
            for (int i = 0; i < 4; ++i) v[r][i] = *(const f32x4*)(src + i * 256 + lane * 4);
            if (l > 0) {
                const bf16_t* yr = (const bf16_t*)(p.ws + WS_Z) + (size_t)row * 1024; const float* gate = mod + ((size_t)(l - 1) * NB + row / S) * 3072 + 2048;
#pragma unroll
                for (int i = 0; i < 4; ++i) { const u32x2 yv = *(const u32x2*)(yr + i * 256 + lane * 4); const f32x4 g1 = *(const f32x4*)(gate + i * 256 + lane * 4) + 1.f;
                    const f32x4 yf = {__uint_as_float(yv.x << 16), __uint_as_float(yv.x & 0xffff0000u), __uint_as_float(yv.y << 16), __uint_as_float(yv.y & 0xffff0000u)};
                    v[r][i] = v[r][i] * DN_ALPHA + g1 * yf; }
            } }
#pragma unroll
        for (int r = 0; r < 4; ++r) {
            const int row = rg * 16 + w * 4 + r; const int b = row / S;
            if (l > 0) {
                float s = 0.f;
#pragma unroll
                for (int i = 0; i < 4; ++i) s += (v[r][i][0] + v[r][i][1]) + (v[r][i][2] + v[r][i][3]);
                const float mu = wsum(s) * (1.f / 1024.f); float q = 0.f;
#pragma unroll
                for (int i = 0; i < 4; ++i) { f32x4 d = v[r][i] - mu; q += (d[0] * d[0] + d[1] * d[1]) + (d[2] * d[2] + d[3] * d[3]); }
                const float rstd = rsqrtf(wsum(q) * (1.f / 1024.f) + 1e-5f);
#pragma unroll
                for (int i = 0; i < 4; ++i) { const f32x4 g = *(const f32x4*)(p.ln_g + (l - 1) * 1024 + i * 256 + lane * 4), bb = *(const f32x4*)(p.ln_b + (l - 1) * 1024 + i * 256 + lane * 4);
                    v[r][i] = (v[r][i] - mu) * rstd * g + bb; *(f32x4*)(p.out + (size_t)row * 1024 + i * 256 + lane * 4) = v[r][i]; }
            }
            if (l < DEPTH) {
                float s = 0.f;
#pragma unroll
                for (int i = 0; i < 4; ++i) s += (v[r][i][0] + v[r][i][1]) + (v[r][i][2] + v[r][i][3]);
                const float mu = wsum(s) * (1.f / 1024.f); float q = 0.f;
#pragma unroll
                for (int i = 0; i < 4; ++i) { f32x4 d = v[r][i] - mu; q += (d[0] * d[0] + d[1] * d[1]) + (d[2] * d[2] + d[3] * d[3]); }
                const float rstd = rsqrtf(wsum(q) * (1.f / 1024.f) + 1e-5f);
                const float* mb = mod + ((size_t)l * NB + b) * 3072;
#pragma unroll
                for (int i = 0; i < 4; ++i) { const int col = i * 256 + lane * 4; const f32x4 sh = *(const f32x4*)(mb + col), sc = *(const f32x4*)(mb + 1024 + col);
                    f32x4 u = (v[r][i] - mu) * rstd * (sc + 1.f) + sh; u32x2 pk; pk.x = pack2(u[0], u[1]); pk.y = pack2(u[2], u[3]);
                    *(u32x2*)(ubuf + (size_t)row * 1024 + col) = pk; }
            }
        }
    }
}

__device__ __forceinline__ int lds_off(int r, int c8) {
    const int st = (r >> 4) * 2 + (c8 >> 2); const int ob = (r & 15) * 64 + (c8 & 3) * 16;
    return st * 1024 + (ob ^ (((ob >> 9) & 1) << 5));
}
struct RegSet { u32x4 a[4], b[4]; };
__device__ __forceinline__ void gemm_tile(const bf16_t* __restrict__ A, const bf16_t* __restrict__ Bt, int tm, int tn, bool first, bool has_next, int ntm, int ntn,
                                          char* sm, f32x4 (&acc)[4][4], RegSet& r0, RegSet& r1) {
    const int t = tid_opq(), lane = t & 63, w = t >> 6, wm = w >> 1, wn = w & 1, r16 = lane & 15, quad = lane >> 4;
    const int lrow = t >> 3, lch = t & 7;
    constexpr int BUF = 32768;
    const unsigned loff = (unsigned)(lrow * 1024 + lch * 8);
    const bf16_t* At0 = A + (size_t)tm * (128 * 1024); const bf16_t* Bt0 = Bt + (size_t)tn * (128 * 1024);
    const bf16_t* At1 = A + (size_t)ntm * (128 * 1024); const bf16_t* Bt1 = Bt + (size_t)ntn * (128 * 1024);
#define Ag (At0 + loff)
#define Bg (Bt0 + loff)
#define nAg (At1 + loff)
#define nBg (Bt1 + loff)
    const int woff0 = lds_off(lrow, lch);
#define woff(i) (woff0 + 4096 * (i))
    const int fo = lds_off(r16, quad);
#pragma unroll
    for (int a = 0; a < 4; ++a)
#pragma unroll
        for (int b = 0; b < 4; ++b) acc[a][b] = (f32x4){0.f, 0.f, 0.f, 0.f};
    if (first) {
#pragma unroll
        for (int i = 0; i < 4; ++i) { r0.a[i] = *(const u32x4*)(Ag + (size_t)i * 32 * 1024); r0.b[i] = *(const u32x4*)(Bg + (size_t)i * 32 * 1024); }
        __syncthreads();
#pragma unroll
        for (int i = 0; i < 4; ++i) { *(u32x4*)(sm + woff(i)) = r0.a[i]; *(u32x4*)(sm + 16384 + woff(i)) = r0.b[i]; }
#pragma unroll
        for (int i = 0; i < 4; ++i) { r0.a[i] = *(const u32x4*)(Ag + (size_t)i * 32 * 1024 + 64); r0.b[i] = *(const u32x4*)(Bg + (size_t)i * 32 * 1024 + 64); }
    }
    __syncthreads();
    auto step = [&](auto main_tag, int kt) {
        constexpr bool MAIN = decltype(main_tag)::value;
        const char* sA = sm + (kt & 1) * BUF; const char* sB = sA + 16384;
        char* nA = sm + ((kt + 1) & 1) * BUF; char* nB = nA + 16384;
        const bool wr = MAIN || kt + 1 < 16 || has_next;
        const bool own = MAIN || kt + 2 < 16;
        const bf16_t* la = own ? Ag + (kt + 2) * 64 : nAg + (kt - 14) * 64; const bf16_t* lb = own ? Bg + (kt + 2) * 64 : nBg + (kt - 14) * 64;
        {
            bf16x8 af[2][4], bfr[2][4];
#pragma unroll
            for (int mt = 0; mt < 4; ++mt) af[0][mt] = *(const bf16x8*)(sA + ((wm * 4 + mt) * 2 + 0) * 1024 + fo);
#pragma unroll
            for (int nt = 0; nt < 4; ++nt) bfr[0][nt] = *(const bf16x8*)(sB + ((wn * 4 + nt) * 2 + 0) * 1024 + fo);
            __builtin_amdgcn_s_setprio(1);
#pragma unroll
            for (int ks = 0; ks < 2; ++ks) {
#pragma unroll
                for (int mt = 0; mt < 4; ++mt) {
#pragma unroll
                    for (int nt = 0; nt < 4; ++nt) acc[mt][nt] = __builtin_amdgcn_mfma_f32_16x16x32_bf16(bfr[ks][nt], af[ks][mt], acc[mt][nt], 0, 0, 0);
                    const int i = ks * 2 + (mt >> 1);
                    __builtin_amdgcn_sched_barrier(0);
                    if (ks == 0) { af[1][mt] = *(const bf16x8*)(sA + ((wm * 4 + mt) * 2 + 1) * 1024 + fo); bfr[1][mt] = *(const bf16x8*)(sB + ((wn * 4 + mt) * 2 + 1) * 1024 + fo); }
                    if ((mt & 1) == 0) { if (wr) *(u32x4*)(nA + woff(i)) = r0.a[i]; if (own || has_next) r0.a[i] = *(const u32x4*)(la + (size_t)i * 32 * 1024); }
                    else               { if (wr) *(u32x4*)(nB + woff(i)) = r0.b[i]; if (own || has_next) r0.b[i] = *(const u32x4*)(lb + (size_t)i * 32 * 1024); }
                    __builtin_amdgcn_sched_barrier(0);
                }
            }
            __builtin_amdgcn_s_setprio(0);
        }
        __syncthreads();
    };
    {
        std::true_type mt_; std::false_type tl_;
        for (int kt = 0; kt < 14; ++kt) step(mt_, kt);
        step(tl_, 14); step(tl_, 15);
    }
#undef Ag
#undef Bg
#undef nAg
#undef nBg
#undef woff
}

__device__ void g1_phase(const Params& p, int l, char* smem) {
    const int t = tid_opq(), lane = t & 63, w = t >> 6, wm = w >> 1, wn = w & 1, r16 = lane & 15, quad = lane >> 4;
    char* sm = smem; char* sC = smem + 32768;
    const bf16_t* ubuf = (const bf16_t*)(p.ws + WS_U); const bf16_t* WinT = (const bf16_t*)(p.ws + WS_WINT) + (size_t)l * NPAD * 1024;
    bf16_t* z = (bf16_t*)(p.ws + WS_Z); float* kpart = (float*)(p.ws + WS_KPART);
    const float* cosT = (const float*)(p.ws + WS_COS); const float* sinT = (const float*)(p.ws + WS_SIN);
    const bool xo = (gridDim.x & 7) == 0; const int xcd = blockIdx.x & 7, nloc = xo ? (int)(gridDim.x >> 3) : (int)gridDim.x, j0 = xo ? (int)(blockIdx.x >> 3) : (int)blockIdx.x;
    const int lim = xo ? 16 * 27 : 128 * 27;
    RegSet r0, r1;
    for (int L = j0; L < lim; L += nloc) {
        const int tm = xo ? xcd * 16 + (L / 216) * 8 + (L & 7) : L / 27, tn = xo ? ((L % 216) >> 3) : L % 27;
        const int L2 = L + nloc; const bool has_next = L2 < lim;
        const int ntm = has_next ? (xo ? xcd * 16 + (L2 / 216) * 8 + (L2 & 7) : L2 / 27) : tm, ntn = has_next ? (xo ? ((L2 % 216) >> 3) : L2 % 27) : tn;
        f32x4 acc[4][4];
        gemm_tile(ubuf, WinT, tm, tn, L == j0, has_next, ntm, ntn, sm, acc, r0, r1);
        const bool rope = (tn < 4) || (tn >= 12 && tn < 16);
        if (rope) {
#pragma unroll
            for (int mt = 0; mt < 4; ++mt) {
                const int tok = tm * 128 + wm * 64 + mt * 16 + r16;
#pragma unroll
                for (int nt = 0; nt < 2; ++nt) {
                    const f32x4 cs = *(const f32x4*)(cosT + (size_t)tok * 32 + nt * 16 + quad * 4), sn = *(const f32x4*)(sinT + (size_t)tok * 32 + nt * 16 + quad * 4);
                    const f32x4 x1 = acc[mt][nt], x2 = acc[mt][nt + 2];
                    acc[mt][nt] = x1 * cs - x2 * sn; acc[mt][nt + 2] = x1 * sn + x2 * cs;
                }
            }
        }
        if (tn == 2 || tn == 3) {
#pragma unroll
            for (int nt = 0; nt < 4; ++nt) {
                f32x4 sv = (acc[0][nt] + acc[1][nt]) + (acc[2][nt] + acc[3][nt]);
#pragma unroll
                for (int jj = 0; jj < 4; ++jj) { float sx = sv[jj]; sx += __shfl_xor(sx, 1); sx += __shfl_xor(sx, 2); sx += __shfl_xor(sx, 4); sx += __shfl_xor(sx, 8); sv[jj] = sx; }
                if (r16 == 0) *(f32x4*)(kpart + (size_t)(tm * 2 + wm) * 256 + (tn - 2) * 128 + wn * 64 + nt * 16 + quad * 4) = sv;
            }
        }
#pragma unroll
        for (int mt = 0; mt < 4; ++mt)
#pragma unroll
            for (int nt = 0; nt < 4; ++nt) { u32x2 pk; pk.x = pack2(acc[mt][nt][0], acc[mt][nt][1]); pk.y = pack2(acc[mt][nt][2], acc[mt][nt][3]);
                const int row = wm * 64 + mt * 16 + r16; const int c16 = wn * 8 + nt * 2 + (quad >> 1);
                *(u32x2*)(sC + row * 256 + ((c16 ^ (row & 15)) << 4) + (quad & 1) * 8) = pk; }
        __syncthreads();
#pragma unroll
        for (int i = 0; i < 8; ++i) { const int c = t + 256 * i; const int row = c >> 4, ch = c & 15; const int col = tn * 128 + ch * 8;
            if (col < DIN) *(u32x4*)(z + (size_t)(tm * 128 + row) * ZP + col) = *(const u32x4*)(sC + row * 256 + ((ch ^ (row & 15)) << 4)); }
    }
}

__device__ void g2_phase(const Params& p, int l, char* smem) {
    const int t = tid_opq(), lane = t & 63, w = t >> 6, wm = w >> 1, wn = w & 1, r16 = lane & 15, quad = lane >> 4;
    char* sm = smem; char* sC = smem + 32768;
    const bf16_t* mix = (const bf16_t*)(p.ws + WS_U); const bf16_t* WoutT = (const bf16_t*)(p.ws + WS_WOUTT) + (size_t)l * 1024 * 1024;
    bf16_t* ybuf = (bf16_t*)(p.ws + WS_Z);
    const bool xo = (gridDim.x & 7) == 0; const int xcd = blockIdx.x & 7, nloc = xo ? (int)(gridDim.x >> 3) : (int)gridDim.x, j0 = xo ? (int)(blockIdx.x >> 3) : (int)blockIdx.x;
    const int lim = xo ? 16 * 8 : 128 * 8;
    RegSet r0, r1;
    for (int L = j0; L < lim; L += nloc) {
        const int tm = xo ? xcd * 16 + (L & 15) : (L >> 3), tn = xo ? (L >> 4) : (L & 7);
        const int L2 = L + nloc; const bool has_next = L2 < lim;
        const int ntm = has_next ? (xo ? xcd * 16 + (L2 & 15) : (L2 >> 3)) : tm, ntn = has_next ? (xo ? (L2 >> 4) : (L2 & 7)) : tn;
        f32x4 acc[4][4];
        gemm_tile(mix, WoutT, tm, tn, L == j0, has_next, ntm, ntn, sm, acc, r0, r1);
#pragma unroll
        for (int mt = 0; mt < 4; ++mt)
#pragma unroll
            for (int nt = 0; nt < 4; ++nt) { u32x2 pk; pk.x = pack2(acc[mt][nt][0], acc[mt][nt][1]); pk.y = pack2(acc[mt][nt][2], acc[mt][nt][3]);
                const int row = wm * 64 + mt * 16 + r16; const int c16 = wn * 8 + nt * 2 + (quad >> 1);
                *(u32x2*)(sC + row * 256 + ((c16 ^ (row & 15)) << 4) + (quad & 1) * 8) = pk; }
        __syncthreads();
#pragma unroll
        for (int i = 0; i < 8; ++i) { const int c = t + 256 * i; const int row = c >> 4, ch = c & 15;
            *(u32x4*)(ybuf + (size_t)(tm * 128 + row) * 1024 + tn * 128 + ch * 8) = *(const u32x4*)(sC + row * 256 + ((ch ^ (row & 15)) << 4)); }
    }
}

constexpr float ATT_SC = 0.18033688011112042f;
template <int QT>
__device__ __forceinline__ void attn_tile(const bf16_t* sK, const bf16_t* sV, const bf16x8 (&qf)[QT][2], int lo, int hi, bool full, bool hasq, bool qfl0, bool qfl1,
                                          float (&m)[QT], float (&l)[QT], f32x4 (&O)[QT][4], int wq0) {
    const int lane = tid_opq() & 63, r16 = lane & 15, quad = lane >> 4;
    f32x4 s[QT][4];
#pragma unroll
    for (int a = 0; a < QT; ++a)
#pragma unroll
        for (int b = 0; b < 4; ++b) s[a][b] = (f32x4){0.f, 0.f, 0.f, 0.f};
#pragma unroll
    for (int ks = 0; ks < 2; ++ks)
#pragma unroll
        for (int k16 = 0; k16 < 4; ++k16) {
            const bf16x8 kf = *(const bf16x8*)(sK + (k16 * 16 + r16) * LDP + ks * 32 + quad * 8);
#pragma unroll
            for (int qt = 0; qt < QT; ++qt) s[qt][k16] = __builtin_amdgcn_mfma_f32_16x16x32_bf16(kf, qf[qt][ks], s[qt][k16], 0, 0, 0);
        }
#pragma unroll
    for (int qt = 0; qt < QT; ++qt) {
        const int ql = wq0 + qt * 16 + r16; const bool qfl = qt ? qfl1 : qfl0;
        if (!full) {
#pragma unroll
            for (int k16 = 0; k16 < 4; ++k16)
#pragma unroll
                for (int j = 0; j < 4; ++j) { const int dd = ql - (k16 * 16 + quad * 4 + j); const bool valid = dd >= lo && dd <= hi; s[qt][k16][j] = valid ? s[qt][k16][j] : -1e30f; }
        }
        if (hasq) {
#pragma unroll
            for (int k16 = 0; k16 < 4; ++k16)
#pragma unroll
                for (int j = 0; j < 4; ++j) s[qt][k16][j] = qfl ? s[qt][k16][j] : -1e30f;
        }
        float mx = -1e30f;
#pragma unroll
        for (int k16 = 0; k16 < 4; ++k16) mx = fmaxf(mx, fmaxf(fmaxf(s[qt][k16][0], s[qt][k16][1]), fmaxf(s[qt][k16][2], s[qt][k16][3])));
        mx = fmaxf(mx, __shfl_xor(mx, 16)); mx = fmaxf(mx, __shfl_xor(mx, 32));
        const float mn = fmaxf(m[qt], mx); const float alpha = __builtin_amdgcn_exp2f((m[qt] - mn) * ATT_SC); m[qt] = mn;
        const float mb = (mn < -1e29f) ? 0.f : mn * ATT_SC;
        float ps = 0.f;
#pragma unroll
        for (int k16 = 0; k16 < 4; ++k16)
#pragma unroll
            for (int j = 0; j < 4; ++j) { const float pv = __builtin_amdgcn_exp2f(s[qt][k16][j] * ATT_SC - mb); ps += pv; s[qt][k16][j] = pv; }
        l[qt] = l[qt] * alpha + ps;
#pragma unroll
        for (int dt = 0; dt < 4; ++dt) O[qt][dt] = O[qt][dt] * alpha;
    }
#pragma unroll
    for (int G = 0; G < 2; ++G) {
        bf16x8 pf[QT];
#pragma unroll
        for (int qt = 0; qt < QT; ++qt) {
            const unsigned a0 = pack2(s[qt][G * 2][0], s[qt][G * 2][1]), a1 = pack2(s[qt][G * 2][2], s[qt][G * 2][3]);
            const unsigned a2 = pack2(s[qt][G * 2 + 1][0], s[qt][G * 2 + 1][1]), a3 = pack2(s[qt][G * 2 + 1][2], s[qt][G * 2 + 1][3]);
            u32x4 pk = {a0, a1, a2, a3}; pf[qt] = __builtin_bit_cast(bf16x8, pk);
        }
#pragma unroll
        for (int dt = 0; dt < 4; ++dt) {
            const bf16_t* v0p = sV + (G * 32 + quad * 4 + (r16 >> 2)) * LDP + dt * 16 + (r16 & 3) * 4;
            const bf16x4 v0 = __builtin_amdgcn_ds_read_tr16_b64_v4i16((__attribute__((address_space(3))) bf16x4*)(v0p));
            const bf16x4 v1 = __builtin_amdgcn_ds_read_tr16_b64_v4i16((__attribute__((address_space(3))) bf16x4*)(v0p + 16 * LDP));
            const bf16x8 vf = {v0[0], v0[1], v0[2], v0[3], v1[0], v1[1], v1[2], v1[3]};
#pragma unroll
            for (int qt = 0; qt < QT; ++qt) O[qt][dt] = __builtin_amdgcn_mfma_f32_16x16x32_bf16(vf, pf[qt], O[qt][dt], 0, 0, 0);
        }
    }
}

__device__ void attn_item(const Params& p, int kind, int idx, char* smem) {
    const int t = tid_opq(), lane = t & 63, w = t >> 6, r16 = lane & 15, quad = lane >> 4;
    bf16_t* sK = (bf16_t*)smem; bf16_t* sV = sK + 64 * LDP;
    float* kmean = (float*)(smem + 18432); float* gates = (float*)(smem + 22528); unsigned* selm = (unsigned*)(smem + 30720);
    int4* desc = (int4*)(smem + 31232); int* misc = (int*)(smem + 32320);
    const bf16_t* z = (const bf16_t*)(p.ws + WS_Z);
    int b, h, qbase, stride, qcol, kcol, vcol, cfg = 0;
    __syncthreads();
    if (kind == 0) {
        const int n = 15 - (idx >> 5); const int rem = idx & 31; b = rem >> 3; h = (rem >> 1) & 3; const int qh = rem & 1;
        qbase = b * S + n * 256 + qh * 128; stride = 1; qcol = C_AQ + h * 64; kcol = C_AK + h * 64; vcol = C_AV + h * 64;
        const float* kpart = (const float*)(p.ws + WS_KPART);
        for (int e = t; e < n * 64; e += 256) { const int j = e >> 6, d = e & 63; const float* kp = kpart + (size_t)(b * 64 + j * 4) * 256 + h * 64 + d;
            kmean[e] = ((kp[0] + kp[256]) + (kp[512] + kp[768])) * (1.f / 256.f); }
        if (t == 0) misc[1] = 0;
        __syncthreads();
        {
            const int ql = t >> 1, half = t & 1; const bf16_t* qp = z + (size_t)(qbase + ql) * ZP + qcol;
            float g[8];
#pragma unroll
            for (int jj = 0; jj < 8; ++jj) g[jj] = 0.f;
#pragma unroll 1
            for (int dc = 0; dc < 8; ++dc) {
                const u32x4 qv = *(const u32x4*)(qp + dc * 8); float qq[8];
#pragma unroll
                for (int e = 0; e < 4; ++e) { qq[2 * e] = __uint_as_float(qv[e] << 16); qq[2 * e + 1] = __uint_as_float(qv[e] & 0xffff0000u); }
#pragma unroll
                for (int jj = 0; jj < 8; ++jj) { const int j = half + 2 * jj; if (j < n) { const float* km = kmean + j * 64 + dc * 8;
#pragma unroll
                    for (int e = 0; e < 8; ++e) g[jj] += qq[e] * km[e]; } }
            }
#pragma unroll
            for (int jj = 0; jj < 8; ++jj) gates[ql * 16 + half + 2 * jj] = g[jj];
        }
        __syncthreads();
        if (t < 128) {
            unsigned msk = 0;
            for (int k = 0; k < 3 && k < n; ++k) { float best = -3.0e38f; int bi = -1;
                for (int j = 0; j < n; ++j) if (!((msk >> j) & 1u)) { const float gv = gates[t * 16 + j]; if (gv > best) { best = gv; bi = j; } }
                if (bi >= 0) msk |= 1u << bi; }
            selm[t] = msk; atomicOr((unsigned*)&misc[1], msk);
        }
        __syncthreads();
        if (t == 0) {
            int nd = 0; const unsigned bm = (unsigned)misc[1];
            for (int kt = 0; kt <= qh * 2 + 1; ++kt) desc[nd++] = make_int4(b * S + n * 256 + kt * 64, kt * 64 - qh * 128, BIG, -1);
            for (int j = 0; j < n; ++j) if ((bm >> j) & 1u) for (int kt = 0; kt < 4; ++kt) desc[nd++] = make_int4(b * S + j * 256 + kt * 64, -BIG, BIG, j);
            misc[0] = nd;
        }
    } else {
        cfg = idx >> 9; const int rem = idx & 511; b = rem >> 7; h = (rem >> 5) & 3; const int rb = rem & 31;
        const int dil = 1 << (2 * cfg); const int res = rb & (dil - 1), blk = rb >> (2 * cfg);
        qbase = b * S + blk * 128 * dil + res; stride = dil; qcol = C_CQ + h * 64; kcol = C_CK + h * 64; vcol = C_CV + h * 64;
        if (t < 128) selm[t] = 0xffffffffu;
        if (t == 0) { int nd = 0; for (int kt = (blk == 0 ? 2 : 0); kt < 4; ++kt) desc[nd++] = make_int4(b * S + (blk * 128 - 128 + kt * 64) * dil + res, kt * 64 - 128, kt * 64, -1); misc[0] = nd; }
    }
    __syncthreads();
    const int nd = misc[0];
    bf16x8 qf[2][2];
#pragma unroll
    for (int qt = 0; qt < 2; ++qt)
#pragma unroll
        for (int ks = 0; ks < 2; ++ks) qf[qt][ks] = *(const bf16x8*)(z + (size_t)(qbase + (w * 32 + qt * 16 + r16) * stride) * ZP + qcol + ks * 32 + quad * 8);
    const unsigned sel0 = selm[w * 32 + r16], sel1 = selm[w * 32 + 16 + r16];
    float m[2] = {-1e30f, -1e30f}, l[2] = {0.f, 0.f}; f32x4 O[2][4];
#pragma unroll
    for (int a = 0; a < 2; ++a)
#pragma unroll
        for (int c = 0; c < 4; ++c) O[a][c] = (f32x4){0.f, 0.f, 0.f, 0.f};
    const int lrow = t >> 2, lch = (t & 3) * 2;
    u32x4 rk0, rk1, rv0, rv1;
    if (nd > 0) { const int4 d = desc[0]; const bf16_t* rp = z + (size_t)(d.x + lrow * stride) * ZP + lch * 8;
        rk0 = *(const u32x4*)(rp + kcol); rk1 = *(const u32x4*)(rp + kcol + 8); rv0 = *(const u32x4*)(rp + vcol); rv1 = *(const u32x4*)(rp + vcol + 8); }
    for (int i = 0; i < nd; ++i) {
        __syncthreads();
        *(u32x4*)(sK + lrow * LDP + lch * 8) = rk0; *(u32x4*)(sK + lrow * LDP + lch * 8 + 8) = rk1;
        *(u32x4*)(sV + lrow * LDP + lch * 8) = rv0; *(u32x4*)(sV + lrow * LDP + lch * 8 + 8) = rv1;
        __syncthreads();
        if (i + 1 < nd) { const int4 d = desc[i + 1]; const bf16_t* rp = z + (size_t)(d.x + lrow * stride) * ZP + lch * 8;
            rk0 = *(const u32x4*)(rp + kcol); rk1 = *(const u32x4*)(rp + kcol + 8); rv0 = *(const u32x4*)(rp + vcol); rv1 = *(const u32x4*)(rp + vcol + 8); }
        const int4 d = desc[i];
        bool need = (w * 32 + 31 >= d.y) && (w * 32 - 63 <= d.z);
        bool q0 = true, q1 = true;
        if (d.w >= 0) { q0 = (sel0 >> d.w) & 1u; q1 = (sel1 >> d.w) & 1u; need = need && (__ballot(q0 || q1) != 0ull); }
        const bool full = (w * 32 - 63 >= d.y) && (w * 32 + 31 <= d.z);
        if (need) attn_tile<2>(sK, sV, qf, d.y, d.z, full, d.w >= 0, q0, q1, m, l, O, w * 32);
    }
#pragma unroll
    for (int qt = 0; qt < 2; ++qt) {
        float lt = l[qt]; lt += __shfl_xor(lt, 16); lt += __shfl_xor(lt, 32);
        const float inv = 1.f / lt; const size_t tok = (size_t)(qbase + (w * 32 + qt * 16 + r16) * stride);
        if (kind == 0) {
            bf16_t* mix = (bf16_t*)(p.ws + WS_U);
#pragma unroll
            for (int dt = 0; dt < 4; ++dt) { const int d0 = dt * 16 + quad * 4; const u32x2 gv = *(const u32x2*)(z + tok * ZP + C_AG + h * 64 + d0);
                const float g0 = __uint_as_float(gv.x << 16), g1 = __uint_as_float(gv.x & 0xffff0000u), g2 = __uint_as_float(gv.y << 16), g3 = __uint_as_float(gv.y & 0xffff0000u);
                u32x2 o; o.x = pack2(O[qt][dt][0] * inv * silu_f(g0), O[qt][dt][1] * inv * silu_f(g1)); o.y = pack2(O[qt][dt][2] * inv * silu_f(g2), O[qt][dt][3] * inv * silu_f(g3));
                *(u32x2*)(mix + tok * 1024 + h * 64 + d0) = o; }
        } else {
            bf16_t* dilo = (bf16_t*)(p.ws + WS_DILO); float* dill = (float*)(p.ws + WS_DILL);
#pragma unroll
            for (int dt = 0; dt < 4; ++dt) { const int d0 = dt * 16 + quad * 4; u32x2 o; o.x = pack2(O[qt][dt][0] * inv, O[qt][dt][1] * inv); o.y = pack2(O[qt][dt][2] * inv, O[qt][dt][3] * inv);
                *(u32x2*)(dilo + ((size_t)cfg * T + tok) * 256 + h * 64 + d0) = o; }
            if (quad == 0) dill[((size_t)cfg * T + tok) * 4 + h] = m[qt] * 0.125f + __logf(lt);
        }
    }
}

__device__ void moba_item(const Params& p, int idx, char* smem, bf16_t* outp) {
    const int t = tid_opq(), lane = t & 63, w = t >> 6, r16 = lane & 15, quad = lane >> 4;
    bf16_t* sK = (bf16_t*)smem; bf16_t* sV = sK + 64 * LDP;
    float* stO = (float*)(smem + 18432);
    float* kmean = (float*)(smem + 18432); float* gates = (float*)(smem + 22528);
    float* stM = (float*)(smem + 53248); float* stL = (float*)(smem + 53760);
    unsigned* selm = (unsigned*)(smem + 54272); unsigned char* lists = (unsigned char*)(smem + 54784);
    int* cnt = (int*)(smem + 56832); int4* desc = (int4*)(smem + 56960); int* misc = (int*)(smem + 59008);
    const bf16_t* z = (const bf16_t*)(p.ws + WS_Z);
    const int n = 15 - (idx >> 5); const int rem = idx & 31; const int b = rem >> 3, h = (rem >> 1) & 3, qh = rem & 1;
    const int qbase = b * S + n * 256 + qh * 128, qcol = C_AQ + h * 64, kcol = C_AK + h * 64, vcol = C_AV + h * 64;
    __syncthreads();
    {
        const float* kpart = (const float*)(p.ws + WS_KPART);
        for (int e = t; e < n * 64; e += 256) { const int j = e >> 6, d = e & 63; const float* kp = kpart + (size_t)(b * 64 + j * 4) * 256 + h * 64 + d;
            kmean[e] = ((kp[0] + kp[256]) + (kp[512] + kp[768])) * (1.f / 256.f); }
        if (t < 16) cnt[t] = 0;
        __syncthreads();
        {
            const int ql = t >> 1, half = t & 1; const bf16_t* qp = z + (size_t)(qbase + ql) * ZP + qcol;
            float g[8];
#pragma unroll
            for (int jj = 0; jj < 8; ++jj) g[jj] = 0.f;
#pragma unroll 1
            for (int dc = 0; dc < 8; ++dc) {
                const u32x4 qv = *(const u32x4*)(qp + dc * 8); float qq[8];
#pragma unroll
                for (int e = 0; e < 4; ++e) { qq[2 * e] = __uint_as_float(qv[e] << 16); qq[2 * e + 1] = __uint_as_float(qv[e] & 0xffff0000u); }
#pragma unroll
                for (int jj = 0; jj < 8; ++jj) { const int j = half + 2 * jj; if (j < n) { const float* km = kmean + j * 64 + dc * 8;
#pragma unroll
                    for (int e = 0; e < 8; ++e) g[jj] += qq[e] * km[e]; } }
            }
#pragma unroll
            for (int jj = 0; jj < 8; ++jj) gates[ql * 16 + half + 2 * jj] = g[jj];
        }
        __syncthreads();
        if (t < 128) {
            unsigned msk = 0;
            for (int k = 0; k < 3 && k < n; ++k) { float best = -3.0e38f; int bi = -1;
                for (int j = 0; j < n; ++j) if (!((msk >> j) & 1u)) { const float gv = gates[t * 16 + j]; if (gv > best) { best = gv; bi = j; } }
                if (bi >= 0) msk |= 1u << bi; }
            selm[t] = msk;
            for (int j = 0; j < n; ++j) if ((msk >> j) & 1u) { const int pos = atomicAdd(&cnt[j], 1); lists[j * 128 + pos] = (unsigned char)t; }
        }
        __syncthreads();
        if (t < 128) { for (int j = 0; j < n; ++j) { const int cj = cnt[j]; if (t >= cj && t < ((cj + 15) & ~15)) lists[j * 128 + t] = 255; } }
        if (t == 0) {
            int nd = 0;
            for (int kt = 0; kt <= qh * 2 + 1; ++kt) desc[nd++] = make_int4(b * S + n * 256 + kt * 64, kt * 64 - qh * 128, BIG, -1);
            misc[1] = nd;
            for (int j = 0; j < n; ++j) { const int ntl = (cnt[j] + 15) >> 4;
                for (int ps = 0; ps * 4 < ntl; ++ps) for (int kt = 0; kt < 4; ++kt) desc[nd++] = make_int4(b * S + j * 256 + kt * 64, ps, kt, j); }
            misc[0] = nd;
        }
    }
    __syncthreads();
    const int nd = misc[0], nown = misc[1];
    const int lrow = t >> 2, lch = (t & 3) * 2;
    u32x4 rk0, rk1, rv0, rv1;
    { const int4 d = desc[0]; const bf16_t* rp = z + (size_t)(d.x + lrow) * ZP + lch * 8;
      rk0 = *(const u32x4*)(rp + kcol); rk1 = *(const u32x4*)(rp + kcol + 8); rv0 = *(const u32x4*)(rp + vcol); rv1 = *(const u32x4*)(rp + vcol + 8); }
    bf16x8 nqf[2]; int ngq = 0; bool ngv = false, nhas = false;
    auto prefetch_group = [&](int gi) {
        nhas = false;
        if (gi < nd) { const int4 dg = desc[gi]; const int slot = dg.y * 4 + w; nhas = slot * 16 < cnt[dg.w];
            if (nhas) { const int qi = lists[dg.w * 128 + slot * 16 + r16]; ngv = qi != 255; ngq = ngv ? qi : 0;
#pragma unroll
                for (int ks = 0; ks < 2; ++ks) nqf[ks] = *(const bf16x8*)(z + (size_t)(qbase + ngq) * ZP + qcol + ks * 32 + quad * 8); } }
    };
    prefetch_group(nown);
    {
        bf16x8 qf[2][2];
#pragma unroll
        for (int qt = 0; qt < 2; ++qt)
#pragma unroll
            for (int ks = 0; ks < 2; ++ks) qf[qt][ks] = *(const bf16x8*)(z + (size_t)(qbase + w * 32 + qt * 16 + r16) * ZP + qcol + ks * 32 + quad * 8);
        float m[2] = {-1e30f, -1e30f}, l[2] = {0.f, 0.f}; f32x4 O[2][4];
#pragma unroll
        for (int a = 0; a < 2; ++a)
#pragma unroll
            for (int c = 0; c < 4; ++c) O[a][c] = (f32x4){0.f, 0.f, 0.f, 0.f};
        for (int i = 0; i < nown; ++i) {
            __syncthreads();
            *(u32x4*)(sK + lrow * LDP + lch * 8) = rk0; *(u32x4*)(sK + lrow * LDP + lch * 8 + 8) = rk1;
            *(u32x4*)(sV + lrow * LDP + lch * 8) = rv0; *(u32x4*)(sV + lrow * LDP + lch * 8 + 8) = rv1;
            __syncthreads();
            if (i + 1 < nd) { const int4 d = desc[i + 1]; const bf16_t* rp = z + (size_t)(d.x + lrow) * ZP + lch * 8;
                rk0 = *(const u32x4*)(rp + kcol); rk1 = *(const u32x4*)(rp + kcol + 8); rv0 = *(const u32x4*)(rp + vcol); rv1 = *(const u32x4*)(rp + vcol + 8); }
            const int4 d = desc[i];
            const bool need = (w * 32 + 31 >= d.y) && (w * 32 - 63 <= d.z);
            const bool full = (w * 32 - 63 >= d.y) && (w * 32 + 31 <= d.z);
            if (need) attn_tile<2>(sK, sV, qf, d.y, d.z, full, false, true, true, m, l, O, w * 32);
        }
#pragma unroll
        for (int qt = 0; qt < 2; ++qt) {
            float lt = l[qt]; lt += __shfl_xor(lt, 16); lt += __shfl_xor(lt, 32);
            const int ql = w * 32 + qt * 16 + r16;
            if (quad == 0) { stM[ql] = m[qt]; stL[ql] = lt; }
#pragma unroll
            for (int dt = 0; dt < 4; ++dt) *(f32x4*)(stO + ql * 68 + dt * 16 + quad * 4) = O[qt][dt];
        }
    }
    {
        bf16x8 qf[1][2]; float m[1] = {-1e30f}, l[1] = {0.f}; f32x4 O[1][4];
        int gq = 0; bool gv = false, has = false;
        for (int i = nown; i < nd; ++i) {
            __syncthreads();
            *(u32x4*)(sK + lrow * LDP + lch * 8) = rk0; *(u32x4*)(sK + lrow * LDP + lch * 8 + 8) = rk1;
            *(u32x4*)(sV + lrow * LDP + lch * 8) = rv0; *(u32x4*)(sV + lrow * LDP + lch * 8 + 8) = rv1;
            __syncthreads();
            if (i + 1 < nd) { const int4 d = desc[i + 1]; const bf16_t* rp = z + (size_t)(d.x + lrow) * ZP + lch * 8;
                rk0 = *(const u32x4*)(rp + kcol); rk1 = *(const u32x4*)(rp + kcol + 8); rv0 = *(const u32x4*)(rp + vcol); rv1 = *(const u32x4*)(rp + vcol + 8); }
            const int4 d = desc[i];
            if (d.z == 0) {
                has = nhas; gv = ngv; gq = ngq; qf[0][0] = nqf[0]; qf[0][1] = nqf[1];
                m[0] = -1e30f; l[0] = 0.f;
#pragma unroll
                for (int c = 0; c < 4; ++c) O[0][c] = (f32x4){0.f, 0.f, 0.f, 0.f};
                prefetch_group(i + 4);
            }
            if (has) {
                attn_tile<1>(sK, sV, qf, -BIG, BIG, true, false, true, true, m, l, O, 0);
                if (d.z == 3) {
                    float lt = l[0]; lt += __shfl_xor(lt, 16); lt += __shfl_xor(lt, 32);
                    if (gv) {
                        const float mo = stM[gq], lo_ = stL[gq]; const float mn = fmaxf(mo, m[0]);
                        const float fa = __builtin_amdgcn_exp2f((mo - mn) * ATT_SC), fb = __builtin_amdgcn_exp2f((m[0] - mn) * ATT_SC);
#pragma unroll
                        for (int dt = 0; dt < 4; ++dt) { float* sp = stO + gq * 68 + dt * 16 + quad * 4; const f32x4 so = *(const f32x4*)sp; *(f32x4*)sp = so * fa + O[0][dt] * fb; }
                        if (quad == 0) { stM[gq] = mn; stL[gq] = lo_ * fa + lt * fb; }
                    }
                }
            }
        }
    }
    __syncthreads();
#pragma unroll
    for (int qt = 0; qt < 2; ++qt) {
        const int ql = w * 32 + qt * 16 + r16; const float inv = 1.f / stL[ql]; const size_t tok = (size_t)(qbase + ql);
#pragma unroll
        for (int dt = 0; dt < 4; ++dt) { const int d0 = dt * 16 + quad * 4; const f32x4 ov = *(const f32x4*)(stO + ql * 68 + d0);
            const u32x2 gvv = *(const u32x2*)(z + tok * ZP + C_AG + h * 64 + d0);
            const float g0 = __uint_as_float(gvv.x << 16), g1 = __uint_as_float(gvv.x & 0xffff0000u), g2 = __uint_as_float(gvv.y << 16), g3 = __uint_as_float(gvv.y & 0xffff0000u);
            u32x2 o; o.x = pack2(ov[0] * inv * silu_f(g0), ov[1] * inv * silu_f(g1)); o.y = pack2(ov[2] * inv * silu_f(g2), ov[3] * inv * silu_f(g3));
            *(u32x2*)(outp + tok * 1024 + h * 64 + d0) = o; }
    }
}

__device__ __forceinline__ void gla_bcum(const Params& p, int l, const bf16_t* z, int tok0, float* bc, float* drs) {
    const int t = tid_opq();
    const int hd = t & 127, ih = t >> 7;
    float wr[16];
#pragma unroll
    for (int r = 0; r < 16; ++r) wr[r] = p.gla_wr[l * 2048 + r * 128 + hd];
    const float br = p.gla_br[l * 128 + hd];
    { const int e0 = t, e1 = t + 256; const bf16_t d0 = z[(size_t)(tok0 + (e0 >> 4)) * ZP + C_DR + (e0 & 15)], d1 = z[(size_t)(tok0 + (e1 >> 4)) * ZP + C_DR + (e1 & 15)];
      drs[e0] = bf2f(d0); drs[e1] = bf2f(d1); }
    __syncthreads();
#pragma unroll
    for (int ii = 0; ii < 16; ++ii) { const int i = ih * 16 + ii; float x = br;
#pragma unroll
        for (int r4 = 0; r4 < 4; ++r4) { const f32x4 dv = *(const f32x4*)(drs + i * 16 + r4 * 4); x += (dv[0] * wr[r4 * 4] + dv[1] * wr[r4 * 4 + 1]) + (dv[2] * wr[r4 * 4 + 2] + dv[3] * wr[r4 * 4 + 3]); }
        bc[i * 128 + hd] = (fminf(x, 0.f) - __logf(1.f + __expf(-fabsf(x)))) * (1.f / 16.f); }
    __syncthreads();
    if (t < 128) { float sacc = 0.f;
#pragma unroll
        for (int i = 0; i < 32; ++i) { sacc += bc[i * 128 + t]; bc[i * 128 + t] = sacc; } }
    __syncthreads();
}

__device__ void gla1_item(const Params& p, int l, int idx, char* smem) {
    const int t = tid_opq(), lane = t & 63, w = t >> 6, r16 = lane & 15, quad = lane >> 4;
    const int b = idx >> 7, c = idx & 127; const int tok0 = b * S + c * 32;
    const bf16_t* z = (const bf16_t*)(p.ws + WS_Z);
    float* bc = (float*)smem; float* drs = (float*)(smem + 16384);
    bf16_t* kdT = (bf16_t*)(smem + 18432) + w * 1024;
    bf16_t* vL = (bf16_t*)(smem + 26624) + w * (32 * LDP);
    float* gkv = (float*)(p.ws + WS_GKV); float* gdec = (float*)(p.ws + WS_GDEC);
    bf16_t kraw[16]; u32x4 vr[4];
#pragma unroll
    for (int i = 0; i < 16; ++i) { const int e = lane + 64 * i; kraw[i] = z[(size_t)(tok0 + (e >> 5)) * ZP + C_DK + w * 32 + (e & 31)]; }
#pragma unroll
    for (int i = 0; i < 4; ++i) { const int cc = lane + 64 * i; vr[i] = *(const u32x4*)(z + (size_t)(tok0 + (cc >> 3)) * ZP + C_DV + w * 64 + (cc & 7) * 8); }
    __syncthreads();
#pragma unroll
    for (int i = 0; i < 4; ++i) { const int cc = lane + 64 * i; *(u32x4*)(vL + (cc >> 3) * LDP + (cc & 7) * 8) = vr[i]; }
    gla_bcum(p, l, z, tok0, bc, drs);
#pragma unroll
    for (int i = 0; i < 16; ++i) { const int e = lane + 64 * i; const int j = e >> 5, d = e & 31;
        kdT[d * 32 + j] = f2bf(bf2f(kraw[i]) * __expf(bc[31 * 128 + w * 32 + d] - bc[j * 128 + w * 32 + d])); }
    const int bh = b * 4 + w;
    if (lane < 32) gdec[(bh * 128 + c) * 32 + lane] = __expf(bc[31 * 128 + w * 32 + lane]);
    __syncthreads();
    bf16x8 kf[2];
#pragma unroll
    for (int x = 0; x < 2; ++x) kf[x] = *(const bf16x8*)(kdT + (x * 16 + r16) * 32 + quad * 8);
    float* dst = gkv + (size_t)(bh * 128 + c) * 2048;
#pragma unroll
    for (int dt = 0; dt < 4; ++dt) {
        const bf16_t* v0p = vL + (quad * 8 + (r16 >> 2)) * LDP + dt * 16 + (r16 & 3) * 4;
        const bf16x4 v0 = __builtin_amdgcn_ds_read_tr16_b64_v4i16((__attribute__((address_space(3))) bf16x4*)(v0p));
        const bf16x4 v1 = __builtin_amdgcn_ds_read_tr16_b64_v4i16((__attribute__((address_space(3))) bf16x4*)(v0p + 4 * LDP));
        const bf16x8 vf = {v0[0], v0[1], v0[2], v0[3], v1[0], v1[1], v1[2], v1[3]};
#pragma unroll
        for (int x = 0; x < 2; ++x) {
            const f32x4 r = __builtin_amdgcn_mfma_f32_16x16x32_bf16(vf, kf[x], (f32x4){0.f, 0.f, 0.f, 0.f}, 0, 0, 0);
            *(f32x4*)(dst + (x * 16 + r16) * 64 + dt * 16 + quad * 4) = r;
        }
    }
}

#define OPQ(ptr) asm volatile("" : "+v"(ptr))
__device__ void gla3_item(const Params& p, int l, int idx, char* smem) {
    const int t = tid_opq(), lane = t & 63, w = t >> 6, r16 = lane & 15, quad = lane >> 4;
    const int b = idx >> 7, c = idx & 127; const int tok0 = b * S + c * 32;
    const bf16_t* z = (const bf16_t*)(p.ws + WS_Z); bf16_t* mix = (bf16_t*)(p.ws + WS_U);
    float* bc = (float*)smem; float* drs = (float*)(smem + 16384);
    bf16_t* SL = (bf16_t*)smem + w * (32 * LDP);
    bf16_t* qe = (bf16_t*)(smem + 18432) + w * 1024;
    bf16_t* ke = (bf16_t*)(smem + 26624) + w * 1024;
    bf16_t* vL = (bf16_t*)(smem + 34816) + w * (32 * LDP);
    const float* gkv = (const float*)(p.ws + WS_GKV);
    const int bh = b * 4 + w;
    bf16_t qraw[16], kraw[16];
    { const bf16_t* qp = z + (size_t)(tok0 + (lane >> 5)) * ZP + w * 32 + (lane & 31);
#pragma unroll
      for (int i = 0; i < 16; ++i) { qraw[i] = qp[C_DQ]; kraw[i] = qp[C_DK]; qp += 2 * ZP; OPQ(qp); } }
    u32x4 vr[4]; f32x4 sr[8];
#pragma unroll
    for (int i = 0; i < 4; ++i) { const int cc = lane + 64 * i; vr[i] = *(const u32x4*)(z + (size_t)(tok0 + (cc >> 3)) * ZP + C_DV + w * 64 + (cc & 7) * 8); }
    { const float* Sp = gkv + (size_t)(bh * 128 + c) * 2048;
#pragma unroll
      for (int i = 0; i < 8; ++i) sr[i] = *(const f32x4*)(Sp + (lane + 64 * i) * 4); }
    __syncthreads();
#pragma unroll
    for (int i = 0; i < 4; ++i) { const int cc = lane + 64 * i; *(u32x4*)(vL + (cc >> 3) * LDP + (cc & 7) * 8) = vr[i]; }
    gla_bcum(p, l, z, tok0, bc, drs);
#pragma unroll
    for (int i2 = 0; i2 < 16; ++i2) { const int e = lane + 64 * i2; const int i = e >> 5, d = e & 31; const float bcv = bc[i * 128 + w * 32 + d];
        qe[i * 32 + d] = f2bf(bf2f(qraw[i2]) * __expf(bcv) * 0.17677669529663687f); ke[i * 32 + d] = f2bf(bf2f(kraw[i2]) * __expf(-bcv)); }
    __syncthreads();
#pragma unroll
    for (int i = 0; i < 8; ++i) { const int cc = lane + 64 * i; const int d = cc >> 4, v4 = cc & 15; u32x2 pk; pk.x = pack2(sr[i][0], sr[i][1]); pk.y = pack2(sr[i][2], sr[i][3]);
        *(u32x2*)(SL + d * LDP + v4 * 4) = pk; }
    __syncthreads();
    bf16x8 qf[2], kf[2];
#pragma unroll
    for (int x = 0; x < 2; ++x) { qf[x] = *(const bf16x8*)(qe + (x * 16 + r16) * 32 + quad * 8); kf[x] = *(const bf16x8*)(ke + (x * 16 + r16) * 32 + quad * 8); }
    bf16x8 pf[2];
#pragma unroll
    for (int it = 0; it < 2; ++it) {
        f32x4 at[2];
#pragma unroll
        for (int jt = 0; jt < 2; ++jt) { at[jt] = __builtin_amdgcn_mfma_f32_16x16x32_bf16(kf[jt], qf[it], (f32x4){0.f, 0.f, 0.f, 0.f}, 0, 0, 0);
#pragma unroll
            for (int jj = 0; jj < 4; ++jj) at[jt][jj] = (jt * 16 + quad * 4 + jj <= it * 16 + r16) ? at[jt][jj] : 0.f; }
        u32x4 pk = {pack2(at[0][0], at[0][1]), pack2(at[0][2], at[0][3]), pack2(at[1][0], at[1][1]), pack2(at[1][2], at[1][3])};
        pf[it] = __builtin_bit_cast(bf16x8, pk);
    }
    f32x4 O[2][4];
#pragma unroll
    for (int dt = 0; dt < 4; ++dt) {
        const bf16_t* v0p = vL + (quad * 4 + (r16 >> 2)) * LDP + dt * 16 + (r16 & 3) * 4;
        const bf16x4 v0 = __builtin_amdgcn_ds_read_tr16_b64_v4i16((__attribute__((address_space(3))) bf16x4*)(v0p));
        const bf16x4 v1 = __builtin_amdgcn_ds_read_tr16_b64_v4i16((__attribute__((address_space(3))) bf16x4*)(v0p + 16 * LDP));
        const bf16x8 vf = {v0[0], v0[1], v0[2], v0[3], v1[0], v1[1], v1[2], v1[3]};
        const bf16_t* s0p = SL + (quad * 8 + (r16 >> 2)) * LDP + dt * 16 + (r16 & 3) * 4;
        const bf16x4 s0 = __builtin_amdgcn_ds_read_tr16_b64_v4i16((__attribute__((address_space(3))) bf16x4*)(s0p));
        const bf16x4 s1 = __builtin_amdgcn_ds_read_tr16_b64_v4i16((__attribute__((address_space(3))) bf16x4*)(s0p + 4 * LDP));
        const bf16x8 sf = {s0[0], s0[1], s0[2], s0[3], s1[0], s1[1], s1[2], s1[3]};
#pragma unroll
        for (int it = 0; it < 2; ++it) {
            O[it][dt] = __builtin_amdgcn_mfma_f32_16x16x32_bf16(vf, pf[it], (f32x4){0.f, 0.f, 0.f, 0.f}, 0, 0, 0);
            O[it][dt] = __builtin_amdgcn_mfma_f32_16x16x32_bf16(sf, qf[it], O[it][dt], 0, 0, 0);
        }
    }
#pragma unroll
    for (int it = 0; it < 2; ++it) {
        float ss = 0.f;
#pragma unroll
        for (int dt = 0; dt < 4; ++dt) ss += (O[it][dt][0] * O[it][dt][0] + O[it][dt][1] * O[it][dt][1]) + (O[it][dt][2] * O[it][dt][2] + O[it][dt][3] * O[it][dt][3]);
        ss += __shfl_xor(ss, 16); ss += __shfl_xor(ss, 32);
        const float rn = rsqrtf(ss * (1.f / 64.f) + 1e-5f);
        const size_t tok = (size_t)(tok0 + it * 16 + r16);
#pragma unroll
        for (int dt = 0; dt < 4; ++dt) { const int v0i = dt * 16 + quad * 4; const f32x4 gn = *(const f32x4*)(p.gla_gn + l * 64 + v0i);
            const u32x2 gv = *(const u32x2*)(z + tok * ZP + C_DG + w * 64 + v0i);
            const float g0 = __uint_as_float(gv.x << 16), g1 = __uint_as_float(gv.x & 0xffff0000u), g2 = __uint_as_float(gv.y << 16), g3 = __uint_as_float(gv.y & 0xffff0000u);
            u32x2 o; o.x = pack2(O[it][dt][0] * rn * gn[0] * silu_f(g0), O[it][dt][1] * rn * gn[1] * silu_f(g1));
            o.y = pack2(O[it][dt][2] * rn * gn[2] * silu_f(g2), O[it][dt][3] * rn * gn[3] * silu_f(g3));
            *(u32x2*)(mix + tok * 1024 + 768 + w * 64 + v0i) = o; }
    }
}

__device__ void lru1_item(const Params& p, int l, int idx, char* smem) {
    const int t = tid_opq(), lane = t & 63, g = t >> 6, r16 = lane & 15, quad = lane >> 4; const int ch = t;
    const int b = idx >> 7, c = idx & 127; const int s0 = c * 32; const int tok0 = b * S + s0;
    const bf16_t* z = (const bf16_t*)(p.ws + WS_Z); float* xcs = (float*)smem;
    bf16_t* preA = (bf16_t*)(smem + 32768); bf16_t* preX = (bf16_t*)(smem + 49152);
    float* lh = (float*)(p.ws + WS_LH); float* lp = (float*)(p.ws + WS_LP);
    bf16_t xr[35];
#pragma unroll
    for (int i = 0; i < 35; ++i) { const int sidx = s0 + i - 3; xr[i] = (sidx >= 0) ? z[(size_t)(tok0 + i - 3) * ZP + C_BX + ch] : (bf16_t)0; }
    const float cw0 = p.conv_w[l * 1024 + ch], cw1 = p.conv_w[l * 1024 + 256 + ch], cw2 = p.conv_w[l * 1024 + 512 + ch], cw3 = p.conv_w[l * 1024 + 768 + ch];
    const float cb = p.conv_b[l * 256 + ch];
    const bf16_t* lwt = (const bf16_t*)(p.ws + WS_LWT) + (size_t)l * 32768 + g * 4096;
    bf16x8 wfa[4][2], wfx[4][2];
#pragma unroll
    for (int nt = 0; nt < 4; ++nt)
#pragma unroll
        for (int ks = 0; ks < 2; ++ks) { wfa[nt][ks] = *(const bf16x8*)(lwt + (nt * 16 + r16) * 64 + ks * 32 + quad * 8); wfx[nt][ks] = *(const bf16x8*)(lwt + 16384 + (nt * 16 + r16) * 64 + ks * 32 + quad * 8); }
    __syncthreads();
#pragma unroll
    for (int i = 0; i < 32; ++i) xcs[i * 256 + ch] = cb + (cw0 * bf2f(xr[i]) + cw1 * bf2f(xr[i + 1])) + (cw2 * bf2f(xr[i + 2]) + cw3 * bf2f(xr[i + 3]));
    __syncthreads();
#pragma unroll
    for (int tt = 0; tt < 2; ++tt) {
        bf16x8 xf[2];
#pragma unroll
        for (int ks = 0; ks < 2; ++ks) { const float* xp = xcs + (tt * 16 + r16) * 256 + g * 64 + ks * 32 + quad * 8; const f32x4 x0 = *(const f32x4*)xp, x1 = *(const f32x4*)(xp + 4);
            u32x4 pk = {pack2(x0[0], x0[1]), pack2(x0[2], x0[3]), pack2(x1[0], x1[1]), pack2(x1[2], x1[3])}; xf[ks] = __builtin_bit_cast(bf16x8, pk); }
#pragma unroll
        for (int nt = 0; nt < 4; ++nt) {
            f32x4 ra = __builtin_amdgcn_mfma_f32_16x16x32_bf16(wfa[nt][0], xf[0], (f32x4){0.f, 0.f, 0.f, 0.f}, 0, 0, 0); ra = __builtin_amdgcn_mfma_f32_16x16x32_bf16(wfa[nt][1], xf[1], ra, 0, 0, 0);
            f32x4 rx = __builtin_amdgcn_mfma_f32_16x16x32_bf16(wfx[nt][0], xf[0], (f32x4){0.f, 0.f, 0.f, 0.f}, 0, 0, 0); rx = __builtin_amdgcn_mfma_f32_16x16x32_bf16(wfx[nt][1], xf[1], rx, 0, 0, 0);
            u32x2 pa; pa.x = pack2(ra[0], ra[1]); pa.y = pack2(ra[2], ra[3]); u32x2 px; px.x = pack2(rx[0], rx[1]); px.y = pack2(rx[2], rx[3]);
            *(u32x2*)(preA + (tt * 16 + r16) * 256 + g * 64 + nt * 16 + quad * 4) = pa; *(u32x2*)(preX + (tt * 16 + r16) * 256 + g * 64 + nt * 16 + quad * 4) = px;
        }
    }
    __syncthreads();
    const float ba = p.lru_ba[l * 256 + ch], bx = p.lru_bx[l * 256 + ch], lam = p.lru_lam[l * 256 + ch];
    const float sp = fmaxf(-lam, 0.f) + log1pf(__expf(-fabsf(lam)));
    float hh = 0.f, P = 1.f;
    float* lhp = lh + (size_t)tok0 * 256 + ch; float* lpp = lp + (size_t)tok0 * 256 + ch;
#pragma unroll 4
    for (int i = 0; i < 32; ++i) { const float r = sigmoid_f(bf2f(preA[i * 256 + ch]) + ba), ig = sigmoid_f(bf2f(preX[i * 256 + ch]) + bx); const float la = -8.f * r * sp; const float a = __expf(la);
        const float u = sqrtf(-expm1f(2.f * la)) * (ig * xcs[i * 256 + ch]); hh = a * hh + u; P *= a;
        lhp[(size_t)i * 256] = hh; lpp[(size_t)i * 256] = P; }
}

__device__ void lru3_item(const Params& p, int idx) {
    const int ch = tid_opq(); const int b = idx >> 7, c = idx & 127; const int tok0 = b * S + c * 32;
    const bf16_t* z = (const bf16_t*)(p.ws + WS_Z); bf16_t* mix = (bf16_t*)(p.ws + WS_U);
    const float* lh = (const float*)(p.ws + WS_LH); const float* lp = (const float*)(p.ws + WS_LP); const float* lc = (const float*)(p.ws + WS_LC);
    const float carry = lc[(size_t)(b * 128 + c) * 256 + ch];
    float hv[32], pv[32]; bf16_t gv[32];
#pragma unroll
    for (int i = 0; i < 32; ++i) { const size_t tok = (size_t)(tok0 + i); hv[i] = lh[tok * 256 + ch]; pv[i] = lp[tok * 256 + ch]; gv[i] = z[tok * ZP + C_BG + ch]; }
#pragma unroll
    for (int i = 0; i < 32; ++i) { const size_t tok = (size_t)(tok0 + i); mix[tok * 1024 + 256 + ch] = f2bf((hv[i] + pv[i] * carry) * silu_f(bf2f(gv[i]))); }
}

__device__ void dilc_item(const Params& p, int idx) {
    const int t = tid_opq(); const size_t tok = (size_t)idx * 8 + (t >> 5); const int chn = t & 31; const int h = chn >> 3;
    const bf16_t* z = (const bf16_t*)(p.ws + WS_Z); bf16_t* mix = (bf16_t*)(p.ws + WS_U);
    const bf16_t* dilo = (const bf16_t*)(p.ws + WS_DILO); const float* dill = (const float*)(p.ws + WS_DILL);
    const float l0 = dill[((size_t)0 * T + tok) * 4 + h], l1 = dill[((size_t)1 * T + tok) * 4 + h], l2 = dill[((size_t)2 * T + tok) * 4 + h];
    const float mx = fmaxf(l0, fmaxf(l1, l2)); float w0 = __expf(l0 - mx), w1 = __expf(l1 - mx), w2 = __expf(l2 - mx); const float inv = 1.f / (w0 + w1 + w2); w0 *= inv; w1 *= inv; w2 *= inv;
    const u32x4 o0 = *(const u32x4*)(dilo + ((size_t)0 * T + tok) * 256 + chn * 8), o1 = *(const u32x4*)(dilo + ((size_t)1 * T + tok) * 256 + chn * 8), o2 = *(const u32x4*)(dilo + ((size_t)2 * T + tok) * 256 + chn * 8);
    const u32x4 gv = *(const u32x4*)(z + tok * ZP + C_CG + chn * 8);
    u32x4 r;
#pragma unroll
    for (int e = 0; e < 4; ++e) {
        const float a = w0 * __uint_as_float(o0[e] << 16) + w1 * __uint_as_float(o1[e] << 16) + w2 * __uint_as_float(o2[e] << 16);
        const float bq = w0 * __uint_as_float(o0[e] & 0xffff0000u) + w1 * __uint_as_float(o1[e] & 0xffff0000u) + w2 * __uint_as_float(o2[e] & 0xffff0000u);
        r[e] = pack2(a * silu_f(__uint_as_float(gv[e] << 16)), bq * silu_f(__uint_as_float(gv[e] & 0xffff0000u)));
    }
    *(u32x4*)(mix + tok * 1024 + 512 + chn * 8) = r;
}

__device__ void m2_phase(const Params& p, char* smem) {
    float* gkv = (float*)(p.ws + WS_GKV); const float* gdec = (const float*)(p.ws + WS_GDEC);
    const float* lh = (const float*)(p.ws + WS_LH); const float* lp = (const float*)(p.ws + WS_LP); float* lc = (float*)(p.ws + WS_LC);
    float* aggP = (float*)smem; float* aggS = aggP + 256;
    const int t = tid_opq(); const int e = t & 31, seg = t >> 5;
    for (int it = blockIdx.x; it < 1024 + 32; it += gridDim.x) {
        float a[16], x[16];
        size_t ostride;
        float* outp;
        if (it < 1024) {
            const int gid = it * 32 + e; const int bh = gid >> 11, dv = gid & 2047, d = dv >> 6;
            float* base = gkv + (size_t)bh * 128 * 2048 + dv + (size_t)(seg * 16) * 2048; const float* dc = gdec + (size_t)bh * 128 * 32 + d + (seg * 16) * 32;
#pragma unroll
            for (int k = 0; k < 16; ++k) { x[k] = base[(size_t)k * 2048]; a[k] = dc[k * 32]; }
            outp = base; ostride = 2048;
        } else {
            const int i2 = it - 1024; const int b = i2 >> 3, ch = (i2 & 7) * 32 + e;
#pragma unroll
            for (int k = 0; k < 16; ++k) { const size_t ix = (size_t)(b * S + (seg * 16 + k) * 32 + 31) * 256 + ch; a[k] = lp[ix]; x[k] = lh[ix]; }
            outp = lc + (size_t)(b * 128 + seg * 16) * 256 + ch; ostride = 256;
        }
        float st = 0.f, pr = 1.f;
#pragma unroll
        for (int k = 0; k < 16; ++k) { const float ak = a[k], xk = x[k]; a[k] = pr; x[k] = st; st = ak * st + xk; pr *= ak; }
        __syncthreads();
        aggP[seg * 32 + e] = pr; aggS[seg * 32 + e] = st;
        __syncthreads();
        float carry = 0.f;
        for (int s2 = 0; s2 < seg; ++s2) carry = aggP[s2 * 32 + e] * carry + aggS[s2 * 32 + e];
#pragma unroll
        for (int k = 0; k < 16; ++k) outp[(size_t)k * ostride] = x[k] + a[k] * carry;
    }
}

__global__ void __launch_bounds__(256, 2) fwd_megakernel(Params p) {
    __shared__ __attribute__((aligned(16))) char smem[SMEM_BYTES];
    __shared__ uint4 xb_words;
    __shared__ int s_slot;
    cg::grid_group grid = cg::this_grid();
    if (p.out == nullptr) grid.sync();
    if (threadIdx.x == 0) xb_words = make_uint4(0u, 0u, 0u, 0u);
    __syncthreads();
    const XcdBarrier xb = xcd_barrier_post((unsigned*)(p.ws + WS_CTL), (volatile LAS unsigned*)&xb_words);
    unsigned* cnt = (unsigned*)(p.ws + WS_CNT);
    prologue_phase(p, smem);
    xcd_barrier(xb);
#pragma unroll 1
    for (int l = 0; l < DEPTH; ++l) {
        ln_phase(p, l);
        xcd_barrier(xb);
        g1_phase(p, l, smem);
        xcd_barrier(xb);
        for (;;) { const int it = next_item(cnt + (4 + l) * 64, &s_slot); if (it >= 512) break; lru1_item(p, l, it, smem); }
        for (;;) { const int it = next_item(cnt + (0 + l) * 64, &s_slot); if (it >= 512) break; moba_item(p, it, smem, (bf16_t*)(p.ws + WS_U)); }
        for (;;) { const int it = next_item(cnt + (2 + l) * 64, &s_slot); if (it >= 512) break; gla1_item(p, l, it, smem); }
        for (;;) { const int it = next_item(cnt + (6 + l) * 64, &s_slot); if (it >= 1536) break; attn_item(p, 1, it, smem); }
        xcd_barrier(xb);
        m2_phase(p, smem);
        xcd_barrier(xb);
        for (int it = blockIdx.x; it < 512; it += gridDim.x) gla3_item(p, l, it, smem);
        for (int it = blockIdx.x; it < 512; it += gridDim.x) lru3_item(p, it);
        for (int it = blockIdx.x; it < 2048; it += gridDim.x) dilc_item(p, it);
        xcd_barrier(xb);
        g2_phase(p, l, smem);
        xcd_barrier(xb);
    }
    ln_phase(p, DEPTH);
}

extern "C" void kernel_launch(void* const* d_in, const int* in_sizes, int n_in, void* d_out, int out_size, void* d_ws, size_t ws_size, hipStream_t stream) {
    static int grid_blocks = 0;
    if (!grid_blocks) {
        int dev = 0, cus = 0, per_cu = 0;
        hipGetDevice(&dev);
        hipDeviceGetAttribute(&cus, hipDeviceAttributeMultiprocessorCount, dev);
        hipOccupancyMaxActiveBlocksPerMultiprocessor(&per_cu, (const void*)fwd_megakernel, 256, 0);
        if (per_cu < 1) per_cu = 1;
        if (per_cu > 2) per_cu = 2;
        grid_blocks = cus * per_cu;
        if (ws_size < WS_END) fprintf(stderr, "kernel_launch: workspace too small: %zu < %zu\n", ws_size, (size_t)WS_END);
    }
    Params p{};
    p.x = (const float*)d_in[0]; p.c = (const float*)d_in[1]; p.pos = (const int*)d_in[2];
    p.w_mod = (const float*)d_in[3]; p.b_mod = (const float*)d_in[4]; p.w_in = (const float*)d_in[5];
    p.conv_w = (const float*)d_in[6]; p.conv_b = (const float*)d_in[7]; p.lru_wa = (const float*)d_in[8]; p.lru_ba = (const float*)d_in[9];
    p.lru_wx = (const float*)d_in[10]; p.lru_bx = (const float*)d_in[11]; p.lru_lam = (const float*)d_in[12];
    p.gla_wr = (const float*)d_in[13]; p.gla_br = (const float*)d_in[14]; p.gla_gn = (const float*)d_in[15];
    p.w_out = (const float*)d_in[16]; p.ln_g = (const float*)d_in[17]; p.ln_b = (const float*)d_in[18];
    p.out = (float*)d_out; p.ws = (unsigned char*)d_ws;
    (void)hipMemsetAsync(d_ws, 0, 32768, stream);
    void* args[] = {&p};
    hipError_t e = hipLaunchCooperativeKernel((const void*)fwd_megakernel, dim3(grid_blocks), dim3(256), args, 0, stream);
    if (e != hipSuccess) fprintf(stderr, "cooperative launch failed: %s (grid %d)\n", hipGetErrorString(e), grid_blocks);
}
```

```cpp
#include <hip/hip_runtime.h>
#include <hip/hip_cooperative_groups.h>
#include <cstdio>
#include <cstdint>
#include <type_traits>
namespace cg = cooperative_groups;

typedef unsigned short bf16_t;
typedef short bf16x8 __attribute__((ext_vector_type(8)));
typedef short bf16x4 __attribute__((ext_vector_type(4)));
typedef float f32x4 __attribute__((ext_vector_type(4)));
typedef unsigned u32x4 __attribute__((ext_vector_type(4)));
typedef unsigned u32x2 __attribute__((ext_vector_type(2)));

constexpr int D = 1024, NB = 4, S = 4096, T = NB * S, DEPTH = 2;
constexpr int DIN = 3344, ZP = 3344, NPAD = 3456;
constexpr int C_AQ = 0, C_AK = 256, C_AV = 512, C_AG = 768, C_BX = 1024, C_BG = 1280, C_CQ = 1536, C_CK = 1792,
              C_CV = 2048, C_CG = 2304, C_DQ = 2560, C_DK = 2688, C_DV = 2816, C_DG = 3072, C_DR = 3328;
constexpr float DN_ALPHA = 1.4142135623730951f;
constexpr int LDP = 72;
constexpr int SMEM_BYTES = 65536;
constexpr int BIG = 1000000;

constexpr size_t WS_CTL = 0;
constexpr size_t WS_CNT = 16384;
constexpr size_t WS_WINT = 32768;
constexpr size_t WS_WOUTT = WS_WINT + (size_t)DEPTH * NPAD * 1024 * 2;
constexpr size_t WS_MOD = WS_WOUTT + (size_t)DEPTH * 1024 * 1024 * 2;
constexpr size_t WS_COS = WS_MOD + (size_t)DEPTH * NB * 3072 * 4;
constexpr size_t WS_SIN = WS_COS + (size_t)T * 32 * 4;
constexpr size_t WS_U = WS_SIN + (size_t)T * 32 * 4;
constexpr size_t WS_Z = WS_U + (size_t)T * 1024 * 2;
constexpr size_t WS_KPART = WS_Z + (size_t)T * ZP * 2;
constexpr size_t WS_DILO = WS_KPART + (size_t)256 * 256 * 4;
constexpr size_t WS_DILL = WS_DILO + (size_t)3 * T * 256 * 2;
constexpr size_t WS_GKV = WS_DILL + (size_t)3 * T * 4 * 4;
constexpr size_t WS_GDEC = WS_GKV + (size_t)2048 * 2048 * 4;
constexpr size_t WS_LH = WS_GDEC + (size_t)2048 * 32 * 4;
constexpr size_t WS_LP = WS_LH + (size_t)T * 256 * 4;
constexpr size_t WS_LC = WS_LP + (size_t)T * 256 * 4;
constexpr size_t WS_LWT = WS_LC + (size_t)NB * 128 * 256 * 4;
constexpr size_t WS_END = WS_LWT + (size_t)DEPTH * 2 * 4 * 64 * 64 * 2;

struct Params {
    const float *x, *c; const int* pos;
    const float *w_mod, *b_mod, *w_in, *conv_w, *conv_b, *lru_wa, *lru_ba, *lru_wx, *lru_bx, *lru_lam, *gla_wr, *gla_br, *gla_gn, *w_out, *ln_g, *ln_b;
    float* out; unsigned char* ws;
};

__device__ __forceinline__ float bf2f(bf16_t h) { return __uint_as_float(((unsigned)h) << 16); }
typedef __bf16 hbf16x2 __attribute__((ext_vector_type(2)));
typedef float f32x2 __attribute__((ext_vector_type(2)));
__device__ __forceinline__ unsigned pack2(float a, float b) { f32x2 v = {a, b}; hbf16x2 r = __builtin_convertvector(v, hbf16x2); return __builtin_bit_cast(unsigned, r); }
__device__ __forceinline__ bf16_t f2bf(float f) { return (bf16_t)(pack2(f, 0.f) & 0xffffu); }
__device__ __forceinline__ float silu_f(float x) { return x / (1.f + __expf(-x)); }
__device__ __forceinline__ float sigmoid_f(float x) { return 1.f / (1.f + __expf(-x)); }
__device__ __forceinline__ int tid_opq() { int t = threadIdx.x; asm volatile("" : "+v"(t)); return t; }
__device__ __forceinline__ float wsum(float v) {
#pragma unroll
    for (int o = 32; o; o >>= 1) v += __shfl_xor(v, o);
    return v;
}

#define XB_TMO      128
#define XB_XCNT(j)  (256  + 64 * (j))
#define XB_XSUB(j)  (1280 + 64 * (j))
#define XB_XGEN(j)  (2304 + 64 * (j))
#define XB_TOP      3328
#define XB_TOPGEN   3392
#define XCD_BAR_WORDS 3456
#define XB_SPIN_CAP (1u << 18)
#define LAS __attribute__((address_space(3)))
__device__ __forceinline__ unsigned xb_ld(unsigned* p)              { return __hip_atomic_load(p, __ATOMIC_RELAXED, __HIP_MEMORY_SCOPE_AGENT); }
__device__ __forceinline__ unsigned xb_add(unsigned* p, unsigned v) { return __hip_atomic_fetch_add(p, v, __ATOMIC_RELAXED, __HIP_MEMORY_SCOPE_AGENT); }
__device__ __forceinline__ unsigned xb_xcc_id() { return (unsigned)__builtin_amdgcn_s_getreg((3 << 11) | 20) & 0xFu; }
#define XB_SPIN(cond, bar) do { unsigned _sp = 0; while (cond) { __builtin_amdgcn_s_sleep(1); \
    if ((++_sp & 255u) == 0u) { if (xb_ld(&(bar)[XB_TMO])) break; if (_sp > XB_SPIN_CAP) { atomicAdd(&(bar)[XB_TMO], 1u); break; } } } } while (0)
struct XcdBarrier { unsigned* bar; unsigned x; volatile LAS unsigned* st; };
__device__ __forceinline__ XcdBarrier xcd_barrier_post(unsigned* bar, volatile LAS unsigned* st) {
    XcdBarrier b; b.bar = bar; b.x = xb_xcc_id(); b.st = st;
    if (threadIdx.x == 0) (void)xb_add(&bar[XB_XCNT(b.x)], 1u);
    return b;
}
__device__ __forceinline__ void xcd_barrier_complete(unsigned* bar, unsigned x, unsigned& nloc, unsigned& nx) {
    const unsigned G = gridDim.x * gridDim.y * gridDim.z;
    unsigned sum, cnt, mine, sp = 0u;
    for (;;) {
        sum = 0u; cnt = 0u; mine = 0u;
#pragma unroll
        for (unsigned j = 0; j < 16; ++j) { const unsigned c = xb_ld(&bar[XB_XCNT(j)]); sum += c; cnt += (c > 0u) ? 1u : 0u; mine = (j == x) ? c : mine; }
        if (sum == G) break;
        __builtin_amdgcn_s_sleep(1);
        if ((++sp & 255u) == 0u) { if (xb_ld(&bar[XB_TMO])) break; if (sp > XB_SPIN_CAP) { atomicAdd(&bar[XB_TMO], 1u); break; } }
    }
    nloc = mine > 0u ? mine : 1u; nx = cnt > 0u ? cnt : 1u;
}
__device__ __forceinline__ void xcd_barrier(const XcdBarrier& b) {
    asm volatile("s_waitcnt vmcnt(0)" ::: "memory");
    __syncthreads();
    if (threadIdx.x == 0) {
        unsigned* bar = b.bar;
        __builtin_amdgcn_s_waitcnt(0);
        unsigned nloc = b.st[0], nx = b.st[1];
        if (nloc == 0u) { xcd_barrier_complete(bar, b.x, nloc, nx); b.st[0] = nloc; b.st[1] = nx; }
        const unsigned old = xb_add(&bar[XB_XSUB(b.x)], 1u);
        const unsigned gen = old / nloc;
        if (old + 1u == (gen + 1u) * nloc) {
            __builtin_amdgcn_fence(__ATOMIC_RELEASE, "agent");
            asm volatile("s_waitcnt vmcnt(0)" ::: "memory");
            const unsigned og = xb_add(&bar[XB_TOP], 1u);
            const unsigned tg = og / nx;
            if (og + 1u == (tg + 1u) * nx) xb_add(&bar[XB_TOPGEN], 1u);
            else XB_SPIN(xb_ld(&bar[XB_TOPGEN]) == tg, bar);
            __builtin_amdgcn_fence(__ATOMIC_ACQUIRE, "agent");
            xb_add(&bar[XB_XGEN(b.x)], 1u);
            asm volatile("s_waitcnt vmcnt(0)" ::: "memory");
        } else {
            XB_SPIN(xb_ld(&bar[XB_XGEN(b.x)]) == gen, bar);
            __builtin_amdgcn_fence(__ATOMIC_ACQUIRE, "agent");
            asm volatile("s_waitcnt vmcnt(0)" ::: "memory");
        }
    }
    __syncthreads();
}
__device__ __forceinline__ int next_item(unsigned* ctr, volatile int* slot) {
    __syncthreads();
    if (threadIdx.x == 0) *slot = (int)atomicAdd(ctr, 1u);
    __syncthreads();
    return *slot;
}

__device__ void prologue_phase(const Params& p, char* smem) {
    const int t = tid_opq();
    bf16_t* WinT = (bf16_t*)(p.ws + WS_WINT); bf16_t* WoutT = (bf16_t*)(p.ws + WS_WOUTT);
    float* mod = (float*)(p.ws + WS_MOD); float* cosT = (float*)(p.ws + WS_COS); float* sinT = (float*)(p.ws + WS_SIN);
    float* tl = (float*)smem;
    constexpr int N_TIN = DEPTH * 16 * 54, N_TOUT = DEPTH * 16 * 16, N_MOD = DEPTH * 192, N_ROPE = T * 32 / 256, N_LWT = DEPTH * 2 * 4 * 64 * 64 / 256;
    constexpr int NITEMS = N_TIN + N_TOUT + N_MOD + N_ROPE + N_LWT;
    for (int it = blockIdx.x; it < NITEMS; it += gridDim.x) {
        if (it < N_TIN + N_TOUT) {
            const float* src; bf16_t* dst; int ncols, kt, nt;
            if (it < N_TIN) { int l = it / (16 * 54), r = it % (16 * 54); kt = r / 54; nt = r % 54; src = p.w_in + (size_t)l * 1024 * DIN; dst = WinT + (size_t)l * NPAD * 1024; ncols = DIN; }
            else { int i2 = it - N_TIN; int l = i2 / 256, r = i2 % 256; kt = r / 16; nt = r % 16; src = p.w_out + (size_t)l * 1024 * 1024; dst = WoutT + (size_t)l * 1024 * 1024; ncols = 1024; }
            __syncthreads();
            { const int c = t & 63, r0 = t >> 6; const int n = nt * 64 + c;
#pragma unroll
              for (int i = 0; i < 16; ++i) { int r = r0 + 4 * i; tl[r * 65 + c] = (n < ncols) ? src[(size_t)(kt * 64 + r) * ncols + n] : 0.f; } }
            __syncthreads();
            { const int kk = t & 63, n0 = t >> 6;
#pragma unroll
              for (int i = 0; i < 16; ++i) { int n = n0 + 4 * i; dst[(size_t)(nt * 64 + n) * 1024 + kt * 64 + kk] = f2bf(tl[kk * 65 + n]); } }
        } else if (it < N_TIN + N_TOUT + N_MOD) {
            const int i2 = it - N_TIN - N_TOUT; const int l = i2 / 192, jg = i2 % 192;
            const int jj = t & 15, ks = t >> 4; const int j = jg * 16 + jj;
            float a0 = 0.f, a1 = 0.f, a2 = 0.f, a3 = 0.f;
            const float* wm = p.w_mod + (size_t)l * 1024 * 3072 + j;
#pragma unroll 8
            for (int k = ks * 64; k < ks * 64 + 64; ++k) { float wv = wm[(size_t)k * 3072]; a0 += p.c[k] * wv; a1 += p.c[1024 + k] * wv; a2 += p.c[2048 + k] * wv; a3 += p.c[3072 + k] * wv; }
            __syncthreads();
            tl[(0 * 16 + ks) * 16 + jj] = a0; tl[(1 * 16 + ks) * 16 + jj] = a1; tl[(2 * 16 + ks) * 16 + jj] = a2; tl[(3 * 16 + ks) * 16 + jj] = a3;
            __syncthreads();
            if (t < 64) { const int b = t >> 4, j2 = t & 15; float s = 0.f;
#pragma unroll
              for (int k2 = 0; k2 < 16; ++k2) s += tl[(b * 16 + k2) * 16 + j2];
              mod[((size_t)l * NB + b) * 3072 + jg * 16 + j2] = s + p.b_mod[l * 3072 + jg * 16 + j2]; }
        } else if (it >= N_TIN + N_TOUT + N_MOD + N_ROPE) {
            const int e = (it - N_TIN - N_TOUT - N_MOD - N_ROPE) * 256 + t;
            const int in = e & 63, out = (e >> 6) & 63, g = (e >> 12) & 3, mat = (e >> 14) & 1, l = e >> 15;
            const float* src = mat ? p.lru_wx : p.lru_wa;
            ((bf16_t*)(p.ws + WS_LWT))[e] = f2bf(src[l * 16384 + g * 4096 + in * 64 + out]);
        } else {
            const int i2 = it - N_TIN - N_TOUT - N_MOD; const int e = i2 * 256 + t; const int tok = e >> 5, f = e & 31;
            const float inv = exp2f(-(float)f * (13.287712379549449f / 32.f));
            const float ang = (float)p.pos[tok] * inv;
            double rev = (double)ang * 0.15915494309189535; rev -= __builtin_rint(rev);
            const float rr = (float)rev; cosT[e] = __builtin_amdgcn_cosf(rr); sinT[e] = __builtin_amdgcn_sinf(rr);
        }
    }
}

__device__ void ln_phase(const Params& p, int l) {
    const int t = tid_opq(), lane = t & 63, w = t >> 6;
    bf16_t* ubuf = (bf16_t*)(p.ws + WS_U); const float* mod = (const float*)(p.ws + WS_MOD);
    for (int rg = blockIdx.x; rg < T / 16; rg += gridDim.x) {
        f32x4 v[4][4];
#pragma unroll
        for (int r = 0; r < 4; ++r) { const int row = rg * 16 + w * 4 + r; const float* src = (l <= 1) ? p.x + (size_t)row * 1024 : p.out + (size_t)row * 1024;
#pragma unroll
            for (int i = 0; i < 4; ++i) v[r][i] = *(const f32x4*)(src + i * 256 + lane * 4);
            if (l > 0) {
                const bf16_t* yr = (const bf16_t*)(p.ws + WS_Z) + (size_t)row * 1024; const float* gate = mod + ((size_t)(l - 1) * NB + row / S) * 3072 + 2048;
#pragma unroll
                for (int i = 0; i < 4; ++i) { const u32x2 yv = *(const u32x2*)(yr + i * 256 + lane * 4); const f32x4 g1 = *(const f32x4*)(gate + i * 256 + lane * 4) + 1.f;
                    const f32x4 yf = {__uint_as_float(yv.x << 16), __uint_as_float(yv.x & 0xffff0000u), __uint_as_float(yv.y << 16), __uint_as_float(yv.y & 0xffff0000u)};
                    v[r][i] = v[r][i] * DN_ALPHA + g1 * yf; }
            } }
#pragma unroll
        for (int r = 0; r < 4; ++r) {
            const int row = rg * 16 + w * 4 + r; const int b = row / S;
            if (l > 0) {
                float s = 0.f;
#pragma unroll
                for (int i = 0; i < 4; ++i) s += (v[r][i][0] + v[r][i][1]) + (v[r][i][2] + v[r][i][3]);
                const float mu = wsum(s) * (1.f / 1024.f); float q = 0.f;
#pragma unroll
                for (int i = 0; i < 4; ++i) { f32x4 d = v[r][i] - mu; q += (d[0] * d[0] + d[1] * d[1]) + (d[2] * d[2] + d[3] * d[3]); }
                const float rstd = rsqrtf(wsum(q) * (1.f / 1024.f) + 1e-5f);
#pragma unroll
                for (int i = 0; i < 4; ++i) { const f32x4 g = *(const f32x4*)(p.ln_g + (l - 1) * 1024 + i * 256 + lane * 4), bb = *(const f32x4*)(p.ln_b + (l - 1) * 1024 + i * 256 + lane * 4);
                    v[r][i] = (v[r][i] - mu) * rstd * g + bb; *(f32x4*)(p.out + (size_t)row * 1024 + i * 256 + lane * 4) = v[r][i]; }
            }
            if (l < DEPTH) {
                float s = 0.f;
#pragma unroll
                for (int i = 0; i < 4; ++i) s += (v[r][i][0] + v[r][i][1]) + (v[r][i][2] + v[r][i][3]);
                const float mu = wsum(s) * (1.f / 1024.f); float q = 0.f;
#pragma unroll
                for (int i = 0; i < 4; ++i) { f32x4 d = v[r][i] - mu; q += (d[0] * d[0] + d[1] * d[1]) + (d[2] * d[2] + d[3] * d[3]); }
                const float rstd = rsqrtf(wsum(q) * (1.f / 1024.f) + 1e-5f);
                const float* mb = mod + ((size_t)l * NB + b) * 3072;
#pragma unroll
                for (int i = 0; i < 4; ++i) { const int col = i * 256 + lane * 4; const f32x4 sh = *(const f32x4*)(mb + col), sc = *(const f32x4*)(mb + 1024 + col);
                    f32x4 u = (v[r][i] - mu) * rstd * (sc + 1.f) + sh; u32x2 pk; pk.x = pack2(u[0], u[1]); pk.y = pack2(u[2], u[3]);
                    *(u32x2*)(ubuf + (size_t)row * 1024 + col) = pk; }
            }
        }
    }
}

__device__ __forceinline__ int lds_off(int r, int c8) {
    const int st = (r >> 4) * 2 + (c8 >> 2); const int ob = (r & 15) * 64 + (c8 & 3) * 16;
    return st * 1024 + (ob ^ (((ob >> 9) & 1) << 5));
}
struct RegSet { u32x4 a[4], b[4]; };
__device__ __forceinline__ void gemm_tile(const bf16_t* __restrict__ A, const bf16_t* __restrict__ Bt, int tm, int tn, bool first, bool has_next, int ntm, int ntn,
                                          char* sm, f32x4 (&acc)[4][4], RegSet& r0, RegSet& r1) {
    const int t = tid_opq(), lane = t & 63, w = t >> 6, wm = w >> 1, wn = w & 1, r16 = lane & 15, quad = lane >> 4;
    const int lrow = t >> 3, lch = t & 7;
    constexpr int BUF = 32768;
    const unsigned loff = (unsigned)(lrow * 1024 + lch * 8);
    const bf16_t* At0 = A + (size_t)tm * (128 * 1024); const bf16_t* Bt0 = Bt + (size_t)tn * (128 * 1024);
    const bf16_t* At1 = A + (size_t)ntm * (128 * 1024); const bf16_t* Bt1 = Bt + (size_t)ntn * (128 * 1024);
#define Ag (At0 + loff)
#define Bg (Bt0 + loff)
#define nAg (At1 + loff)
#define nBg (Bt1 + loff)
    const int woff0 = lds_off(lrow, lch);
#define woff(i) (woff0 + 4096 * (i))
    const int fo = lds_off(r16, quad);
#pragma unroll
    for (int a = 0; a < 4; ++a)
#pragma unroll
        for (int b = 0; b < 4; ++b) acc[a][b] = (f32x4){0.f, 0.f, 0.f, 0.f};
    if (first) {
#pragma unroll
        for (int i = 0; i < 4; ++i) { r0.a[i] = *(const u32x4*)(Ag + (size_t)i * 32 * 1024); r0.b[i] = *(const u32x4*)(Bg + (size_t)i * 32 * 1024); }
        __syncthreads();
#pragma unroll
        for (int i = 0; i < 4; ++i) { *(u32x4*)(sm + woff(i)) = r0.a[i]; *(u32x4*)(sm + 16384 + woff(i)) = r0.b[i]; }
#pragma unroll
        for (int i = 0; i < 4; ++i) { r0.a[i] = *(const u32x4*)(Ag + (size_t)i * 32 * 1024 + 64); r0.b[i] = *(const u32x4*)(Bg + (size_t)i * 32 * 1024 + 64); }
    }
    __syncthreads();
    auto step = [&](auto main_tag, int kt) {
        constexpr bool MAIN = decltype(main_tag)::value;
        const char* sA = sm + (kt & 1) * BUF; const char* sB = sA + 16384;
        char* nA = sm + ((kt + 1) & 1) * BUF; char* nB = nA + 16384;
        const bool wr = MAIN || kt + 1 < 16 || has_next;
        const bool own = MAIN || kt + 2 < 16;
        const bf16_t* la = own ? Ag + (kt + 2) * 64 : nAg + (kt - 14) * 64; const bf16_t* lb = own ? Bg + (kt + 2) * 64 : nBg + (kt - 14) * 64;
        {
            bf16x8 af[2][4], bfr[2][4];
#pragma unroll
            for (int mt = 0; mt < 4; ++mt) af[0][mt] = *(const bf16x8*)(sA + ((wm * 4 + mt) * 2 + 0) * 1024 + fo);
#pragma unroll
            for (int nt = 0; nt < 4; ++nt) bfr[0][nt] = *(const bf16x8*)(sB + ((wn * 4 + nt) * 2 + 0) * 1024 + fo);
            __builtin_amdgcn_s_setprio(1);
#pragma unroll
            for (int ks = 0; ks < 2; ++ks) {
#pragma unroll
                for (int mt = 0; mt < 4; ++mt) {
#pragma unroll
                    for (int nt = 0; nt < 4; ++nt) acc[mt][nt] = __builtin_amdgcn_mfma_f32_16x16x32_bf16(bfr[ks][nt], af[ks][mt], acc[mt][nt], 0, 0, 0);
                    const int i = ks * 2 + (mt >> 1);
                    __builtin_amdgcn_sched_barrier(0);
                    if (ks == 0) { af[1][mt] = *(const bf16x8*)(sA + ((wm * 4 + mt) * 2 + 1) * 1024 + fo); bfr[1][mt] = *(const bf16x8*)(sB + ((wn * 4 + mt) * 2 + 1) * 1024 + fo); }
                    if ((mt & 1) == 0) { if (wr) *(u32x4*)(nA + woff(i)) = r0.a[i]; if (own || has_next) r0.a[i] = *(const u32x4*)(la + (size_t)i * 32 * 1024); }
                    else               { if (wr) *(u32x4*)(nB + woff(i)) = r0.b[i]; if (own || has_next) r0.b[i] = *(const u32x4*)(lb + (size_t)i * 32 * 1024); }
                    __builtin_amdgcn_sched_barrier(0);
                }
            }
            __builtin_amdgcn_s_setprio(0);
        }
        __syncthreads();
    };
    {
        std::true_type mt_; std::false_type tl_;
        for (int kt = 0; kt < 14; ++kt) step(mt_, kt);
        step(tl_, 14); step(tl_, 15);
    }
#undef Ag
#undef Bg
#undef nAg
#undef nBg
#undef woff
}

__device__ void g1_phase(const Params& p, int l, char* smem) {
    const int t = tid_opq(), lane = t & 63, w = t >> 6, wm = w >> 1, wn = w & 1, r16 = lane & 15, quad = lane >> 4;
    char* sm = smem; char* sC = smem + 32768;
    const bf16_t* ubuf = (const bf16_t*)(p.ws + WS_U); const bf16_t* WinT = (const bf16_t*)(p.ws + WS_WINT) + (size_t)l * NPAD * 1024;
    bf16_t* z = (bf16_t*)(p.ws + WS_Z); float* kpart = (float*)(p.ws + WS_KPART);
    const float* cosT = (const float*)(p.ws + WS_COS); const float* sinT = (const float*)(p.ws + WS_SIN);
    const bool xo = (gridDim.x & 7) == 0; const int xcd = blockIdx.x & 7, nloc = xo ? (int)(gridDim.x >> 3) : (int)gridDim.x, j0 = xo ? (int)(blockIdx.x >> 3) : (int)blockIdx.x;
    const int lim = xo ? 16 * 27 : 128 * 27;
    RegSet r0, r1;
    for (int L = j0; L < lim; L += nloc) {
        const int tm = xo ? xcd * 16 + (L / 216) * 8 + (L & 7) : L / 27, tn = xo ? ((L % 216) >> 3) : L % 27;
        const int L2 = L + nloc; const bool has_next = L2 < lim;
        const int ntm = has_next ? (xo ? xcd * 16 + (L2 / 216) * 8 + (L2 & 7) : L2 / 27) : tm, ntn = has_next ? (xo ? ((L2 % 216) >> 3) : L2 % 27) : tn;
        f32x4 acc[4][4];
        gemm_tile(ubuf, WinT, tm, tn, L == j0, has_next, ntm, ntn, sm, acc, r0, r1);
        const bool rope = (tn < 4) || (tn >= 12 && tn < 16);
        if (rope) {
#pragma unroll
            for (int mt = 0; mt < 4; ++mt) {
                const int tok = tm * 128 + wm * 64 + mt * 16 + r16;
#pragma unroll
                for (int nt = 0; nt < 2; ++nt) {
                    const f32x4 cs = *(const f32x4*)(cosT + (size_t)tok * 32 + nt * 16 + quad * 4), sn = *(const f32x4*)(sinT + (size_t)tok * 32 + nt * 16 + quad * 4);
                    const f32x4 x1 = acc[mt][nt], x2 = acc[mt][nt + 2];
                    acc[mt][nt] = x1 * cs - x2 * sn; acc[mt][nt + 2] = x1 * sn + x2 * cs;
                }
            }
        }
        if (tn == 2 || tn == 3) {
#pragma unroll
            for (int nt = 0; nt < 4; ++nt) {
                f32x4 sv = (acc[0][nt] + acc[1][nt]) + (acc[2][nt] + acc[3][nt]);
#pragma unroll
                for (int jj = 0; jj < 4; ++jj) { float sx = sv[jj]; sx += __shfl_xor(sx, 1); sx += __shfl_xor(sx, 2); sx += __shfl_xor(sx, 4); sx += __shfl_xor(sx, 8); sv[jj] = sx; }
                if (r16 == 0) *(f32x4*)(kpart + (size_t)(tm * 2 + wm) * 256 + (tn - 2) * 128 + wn * 64 + nt * 16 + quad * 4) = sv;
            }
        }
#pragma unroll
        for (int mt = 0; mt < 4; ++mt)
#pragma unroll
            for (int nt = 0; nt < 4; ++nt) { u32x2 pk; pk.x = pack2(acc[mt][nt][0], acc[mt][nt][1]); pk.y = pack2(acc[mt][nt][2], acc[mt][nt][3]);
                const int row = wm * 64 + mt * 16 + r16; const int c16 = wn * 8 + nt * 2 + (quad >> 1);
                *(u32x2*)(sC + row * 256 + ((c16 ^ (row & 15)) << 4) + (quad & 1) * 8) = pk; }
        __syncthreads();
#pragma unroll
        for (int i = 0; i < 8; ++i) { const int c = t + 256 * i; const int row = c >> 4, ch = c & 15; const int col = tn * 128 + ch * 8;
            if (col < DIN) *(u32x4*)(z + (size_t)(tm * 128 + row) * ZP + col) = *(const u32x4*)(sC + row * 256 + ((ch ^ (row & 15)) << 4)); }
    }
}

__device__ void g2_phase(const Params& p, int l, char* smem) {
    const int t = tid_opq(), lane = t & 63, w = t >> 6, wm = w >> 1, wn = w & 1, r16 = lane & 15, quad = lane >> 4;
    char* sm = smem; char* sC = smem + 32768;
    const bf16_t* mix = (const bf16_t*)(p.ws + WS_U); const bf16_t* WoutT = (const bf16_t*)(p.ws + WS_WOUTT) + (size_t)l * 1024 * 1024;
    bf16_t* ybuf = (bf16_t*)(p.ws + WS_Z);
    const bool xo = (gridDim.x & 7) == 0; const int xcd = blockIdx.x & 7, nloc = xo ? (int)(gridDim.x >> 3) : (int)gridDim.x, j0 = xo ? (int)(blockIdx.x >> 3) : (int)blockIdx.x;
    const int lim = xo ? 16 * 8 : 128 * 8;
    RegSet r0, r1;
    for (int L = j0; L < lim; L += nloc) {
        const int tm = xo ? xcd * 16 + (L & 15) : (L >> 3), tn = xo ? (L >> 4) : (L & 7);
        const int L2 = L + nloc; const bool has_next = L2 < lim;
        const int ntm = has_next ? (xo ? xcd * 16 + (L2 & 15) : (L2 >> 3)) : tm, ntn = has_next ? (xo ? (L2 >> 4) : (L2 & 7)) : tn;
        f32x4 acc[4][4];
        gemm_tile(mix, WoutT, tm, tn, L == j0, has_next, ntm, ntn, sm, acc, r0, r1);
#pragma unroll
        for (int mt = 0; mt < 4; ++mt)
#pragma unroll
            for (int nt = 0; nt < 4; ++nt) { u32x2 pk; pk.x = pack2(acc[mt][nt][0], acc[mt][nt][1]); pk.y = pack2(acc[mt][nt][2], acc[mt][nt][3]);
                const int row = wm * 64 + mt * 16 + r16; const int c16 = wn * 8 + nt * 2 + (quad >> 1);
                *(u32x2*)(sC + row * 256 + ((c16 ^ (row & 15)) << 4) + (quad & 1) * 8) = pk; }
        __syncthreads();
#pragma unroll
        for (int i = 0; i < 8; ++i) { const int c = t + 256 * i; const int row = c >> 4, ch = c & 15;
            *(u32x4*)(ybuf + (size_t)(tm * 128 + row) * 1024 + tn * 128 + ch * 8) = *(const u32x4*)(sC + row * 256 + ((ch ^ (row & 15)) << 4)); }
    }
}

constexpr float ATT_SC = 0.18033688011112042f;
template <int QT>
__device__ __forceinline__ void attn_tile(const bf16_t* sK, const bf16_t* sV, const bf16x8 (&qf)[QT][2], int lo, int hi, bool full, bool hasq, bool qfl0, bool qfl1,
                                          float (&m)[QT], float (&l)[QT], f32x4 (&O)[QT][4], int wq0) {
    const int lane = tid_opq() & 63, r16 = lane & 15, quad = lane >> 4;
    f32x4 s[QT][4];
#pragma unroll
    for (int a = 0; a < QT; ++a)
#pragma unroll
        for (int b = 0; b < 4; ++b) s[a][b] = (f32x4){0.f, 0.f, 0.f, 0.f};
#pragma unroll
    for (int ks = 0; ks < 2; ++ks)
#pragma unroll
        for (int k16 = 0; k16 < 4; ++k16) {
            const bf16x8 kf = *(const bf16x8*)(sK + (k16 * 16 + r16) * LDP + ks * 32 + quad * 8);
#pragma unroll
            for (int qt = 0; qt < QT; ++qt) s[qt][k16] = __builtin_amdgcn_mfma_f32_16x16x32_bf16(kf, qf[qt][ks], s[qt][k16], 0, 0, 0);
        }
#pragma unroll
    for (int qt = 0; qt < QT; ++qt) {
        const int ql = wq0 + qt * 16 + r16; const bool qfl = qt ? qfl1 : qfl0;
        if (!full) {
#pragma unroll
            for (int k16 = 0; k16 < 4; ++k16)
#pragma unroll
                for (int j = 0; j < 4; ++j) { const int dd = ql - (k16 * 16 + quad * 4 + j); const bool valid = dd >= lo && dd <= hi; s[qt][k16][j] = valid ? s[qt][k16][j] : -1e30f; }
        }
        if (hasq) {
#pragma unroll
            for (int k16 = 0; k16 < 4; ++k16)
#pragma unroll
                for (int j = 0; j < 4; ++j) s[qt][k16][j] = qfl ? s[qt][k16][j] : -1e30f;
        }
        float mx = -1e30f;
#pragma unroll
        for (int k16 = 0; k16 < 4; ++k16) mx = fmaxf(mx, fmaxf(fmaxf(s[qt][k16][0], s[qt][k16][1]), fmaxf(s[qt][k16][2], s[qt][k16][3])));
        mx = fmaxf(mx, __shfl_xor(mx, 16)); mx = fmaxf(mx, __shfl_xor(mx, 32));
        const float mn = fmaxf(m[qt], mx); const float alpha = __builtin_amdgcn_exp2f((m[qt] - mn) * ATT_SC); m[qt] = mn;
        const float mb = (mn < -1e29f) ? 0.f : mn * ATT_SC;
        float ps = 0.f;
#pragma unroll
        for (int k16 = 0; k16 < 4; ++k16)
#pragma unroll
            for (int j = 0; j < 4; ++j) { const float pv = __builtin_amdgcn_exp2f(s[qt][k16][j] * ATT_SC - mb); ps += pv; s[qt][k16][j] = pv; }
        l[qt] = l[qt] * alpha + ps;
#pragma unroll
        for (int dt = 0; dt < 4; ++dt) O[qt][dt] = O[qt][dt] * alpha;
    }
#pragma unroll
    for (int G = 0; G < 2; ++G) {
        bf16x8 pf[QT];
#pragma unroll
        for (int qt = 0; qt < QT; ++qt) {
            const unsigned a0 = pack2(s[qt][G * 2][0], s[qt][G * 2][1]), a1 = pack2(s[qt][G * 2][2], s[qt][G * 2][3]);
            const unsigned a2 = pack2(s[qt][G * 2 + 1][0], s[qt][G * 2 + 1][1]), a3 = pack2(s[qt][G * 2 + 1][2], s[qt][G * 2 + 1][3]);
            u32x4 pk = {a0, a1, a2, a3}; pf[qt] = __builtin_bit_cast(bf16x8, pk);
        }
#pragma unroll
        for (int dt = 0; dt < 4; ++dt) {
            const bf16_t* v0p = sV + (G * 32 + quad * 4 + (r16 >> 2)) * LDP + dt * 16 + (r16 & 3) * 4;
            const bf16x4 v0 = __builtin_amdgcn_ds_read_tr16_b64_v4i16((__attribute__((address_space(3))) bf16x4*)(v0p));
            const bf16x4 v1 = __builtin_amdgcn_ds_read_tr16_b64_v4i16((__attribute__((address_space(3))) bf16x4*)(v0p + 16 * LDP));
            const bf16x8 vf = {v0[0], v0[1], v0[2], v0[3], v1[0], v1[1], v1[2], v1[3]};
#pragma unroll
            for (int qt = 0; qt < QT; ++qt) O[qt][dt] = __builtin_amdgcn_mfma_f32_16x16x32_bf16(vf, pf[qt], O[qt][dt], 0, 0, 0);
        }
    }
}

__device__ void attn_item(const Params& p, int kind, int idx, char* smem) {
    const int t = tid_opq(), lane = t & 63, w = t >> 6, r16 = lane & 15, quad = lane >> 4;
    bf16_t* sK = (bf16_t*)smem; bf16_t* sV = sK + 64 * LDP;
    float* kmean = (float*)(smem + 18432); float* gates = (float*)(smem + 22528); unsigned* selm = (unsigned*)(smem + 30720);
    int4* desc = (int4*)(smem + 31232); int* misc = (int*)(smem + 32320);
    const bf16_t* z = (const bf16_t*)(p.ws + WS_Z);
    int b, h, qbase, stride, qcol, kcol, vcol, cfg = 0;
    __syncthreads();
    if (kind == 0) {
        const int n = 15 - (idx >> 5); const int rem = idx & 31; b = rem >> 3; h = (rem >> 1) & 3; const int qh = rem & 1;
        qbase = b * S + n * 256 + qh * 128; stride = 1; qcol = C_AQ + h * 64; kcol = C_AK + h * 64; vcol = C_AV + h * 64;
        const float* kpart = (const float*)(p.ws + WS_KPART);
        for (int e = t; e < n * 64; e += 256) { const int j = e >> 6, d = e & 63; const float* kp = kpart + (size_t)(b * 64 + j * 4) * 256 + h * 64 + d;
            kmean[e] = ((kp[0] + kp[256]) + (kp[512] + kp[768])) * (1.f / 256.f); }
        if (t == 0) misc[1] = 0;
        __syncthreads();
        {
            const int ql = t >> 1, half = t & 1; const bf16_t* qp = z + (size_t)(qbase + ql) * ZP + qcol;
            float g[8];
#pragma unroll
            for (int jj = 0; jj < 8; ++jj) g[jj] = 0.f;
#pragma unroll 1
            for (int dc = 0; dc < 8; ++dc) {
                const u32x4 qv = *(const u32x4*)(qp + dc * 8); float qq[8];
#pragma unroll
                for (int e = 0; e < 4; ++e) { qq[2 * e] = __uint_as_float(qv[e] << 16); qq[2 * e + 1] = __uint_as_float(qv[e] & 0xffff0000u); }
#pragma unroll
                for (int jj = 0; jj < 8; ++jj) { const int j = half + 2 * jj; if (j < n) { const float* km = kmean + j * 64 + dc * 8;
#pragma unroll
                    for (int e = 0; e < 8; ++e) g[jj] += qq[e] * km[e]; } }
            }
#pragma unroll
            for (int jj = 0; jj < 8; ++jj) gates[ql * 16 + half + 2 * jj] = g[jj];
        }
        __syncthreads();
        if (t < 128) {
            unsigned msk = 0;
            for (int k = 0; k < 3 && k < n; ++k) { float best = -3.0e38f; int bi = -1;
                for (int j = 0; j < n; ++j) if (!((msk >> j) & 1u)) { const float gv = gates[t * 16 + j]; if (gv > best) { best = gv; bi = j; } }
                if (bi >= 0) msk |= 1u << bi; }
            selm[t] = msk; atomicOr((unsigned*)&misc[1], msk);
        }
        __syncthreads();
        if (t == 0) {
            int nd = 0; const unsigned bm = (unsigned)misc[1];
            for (int kt = 0; kt <= qh * 2 + 1; ++kt) desc[nd++] = make_int4(b * S + n * 256 + kt * 64, kt * 64 - qh * 128, BIG, -1);
            for (int j = 0; j < n; ++j) if ((bm >> j) & 1u) for (int kt = 0; kt < 4; ++kt) desc[nd++] = make_int4(b * S + j * 256 + kt * 64, -BIG, BIG, j);
            misc[0] = nd;
        }
    } else {
        cfg = idx >> 9; const int rem = idx & 511; b = rem >> 7; h = (rem >> 5) & 3; const int rb = rem & 31;
        const int dil = 1 << (2 * cfg); const int res = rb & (dil - 1), blk = rb >> (2 * cfg);
        qbase = b * S + blk * 128 * dil + res; stride = dil; qcol = C_CQ + h * 64; kcol = C_CK + h * 64; vcol = C_CV + h * 64;
        if (t < 128) selm[t] = 0xffffffffu;
        if (t == 0) { int nd = 0; for (int kt = (blk == 0 ? 2 : 0); kt < 4; ++kt) desc[nd++] = make_int4(b * S + (blk * 128 - 128 + kt * 64) * dil + res, kt * 64 - 128, kt * 64, -1); misc[0] = nd; }
    }
    __syncthreads();
    const int nd = misc[0];
    bf16x8 qf[2][2];
#pragma unroll
    for (int qt = 0; qt < 2; ++qt)
#pragma unroll
        for (int ks = 0; ks < 2; ++ks) qf[qt][ks] = *(const bf16x8*)(z + (size_t)(qbase + (w * 32 + qt * 16 + r16) * stride) * ZP + qcol + ks * 32 + quad * 8);
    const unsigned sel0 = selm[w * 32 + r16], sel1 = selm[w * 32 + 16 + r16];
    float m[2] = {-1e30f, -1e30f}, l[2] = {0.f, 0.f}; f32x4 O[2][4];
#pragma unroll
    for (int a = 0; a < 2; ++a)
#pragma unroll
        for (int c = 0; c < 4; ++c) O[a][c] = (f32x4){0.f, 0.f, 0.f, 0.f};
    const int lrow = t >> 2, lch = (t & 3) * 2;
    u32x4 rk0, rk1, rv0, rv1;
    if (nd > 0) { const int4 d = desc[0]; const bf16_t* rp = z + (size_t)(d.x + lrow * stride) * ZP + lch * 8;
        rk0 = *(const u32x4*)(rp + kcol); rk1 = *(const u32x4*)(rp + kcol + 8); rv0 = *(const u32x4*)(rp + vcol); rv1 = *(const u32x4*)(rp + vcol + 8); }
    for (int i = 0; i < nd; ++i) {
        __syncthreads();
        *(u32x4*)(sK + lrow * LDP + lch * 8) = rk0; *(u32x4*)(sK + lrow * LDP + lch * 8 + 8) = rk1;
        *(u32x4*)(sV + lrow * LDP + lch * 8) = rv0; *(u32x4*)(sV + lrow * LDP + lch * 8 + 8) = rv1;
        __syncthreads();
        if (i + 1 < nd) { const int4 d = desc[i + 1]; const bf16_t* rp = z + (size_t)(d.x + lrow * stride) * ZP + lch * 8;
            rk0 = *(const u32x4*)(rp + kcol); rk1 = *(const u32x4*)(rp + kcol + 8); rv0 = *(const u32x4*)(rp + vcol); rv1 = *(const u32x4*)(rp + vcol + 8); }
        const int4 d = desc[i];
        bool need = (w * 32 + 31 >= d.y) && (w * 32 - 63 <= d.z);
        bool q0 = true, q1 = true;
        if (d.w >= 0) { q0 = (sel0 >> d.w) & 1u; q1 = (sel1 >> d.w) & 1u; need = need && (__ballot(q0 || q1) != 0ull); }
        const bool full = (w * 32 - 63 >= d.y) && (w * 32 + 31 <= d.z);
        if (need) attn_tile<2>(sK, sV, qf, d.y, d.z, full, d.w >= 0, q0, q1, m, l, O, w * 32);
    }
#pragma unroll
    for (int qt = 0; qt < 2; ++qt) {
        float lt = l[qt]; lt += __shfl_xor(lt, 16); lt += __shfl_xor(lt, 32);
        const float inv = 1.f / lt; const size_t tok = (size_t)(qbase + (w * 32 + qt * 16 + r16) * stride);
        if (kind == 0) {
            bf16_t* mix = (bf16_t*)(p.ws + WS_U);
#pragma unroll
            for (int dt = 0; dt < 4; ++dt) { const int d0 = dt * 16 + quad * 4; const u32x2 gv = *(const u32x2*)(z + tok * ZP + C_AG + h * 64 + d0);
                const float g0 = __uint_as_float(gv.x << 16), g1 = __uint_as_float(gv.x & 0xffff0000u), g2 = __uint_as_float(gv.y << 16), g3 = __uint_as_float(gv.y & 0xffff0000u);
                u32x2 o; o.x = pack2(O[qt][dt][0] * inv * silu_f(g0), O[qt][dt][1] * inv * silu_f(g1)); o.y = pack2(O[qt][dt][2] * inv * silu_f(g2), O[qt][dt][3] * inv * silu_f(g3));
                *(u32x2*)(mix + tok * 1024 + h * 64 + d0) = o; }
        } else {
            bf16_t* dilo = (bf16_t*)(p.ws + WS_DILO); float* dill = (float*)(p.ws + WS_DILL);
#pragma unroll
            for (int dt = 0; dt < 4; ++dt) { const int d0 = dt * 16 + quad * 4; u32x2 o; o.x = pack2(O[qt][dt][0] * inv, O[qt][dt][1] * inv); o.y = pack2(O[qt][dt][2] * inv, O[qt][dt][3] * inv);
                *(u32x2*)(dilo + ((size_t)cfg * T + tok) * 256 + h * 64 + d0) = o; }
            if (quad == 0) dill[((size_t)cfg * T + tok) * 4 + h] = m[qt] * 0.125f + __logf(lt);
        }
    }
}

__device__ void moba_item(const Params& p, int idx, char* smem, bf16_t* outp) {
    const int t = tid_opq(), lane = t & 63, w = t >> 6, r16 = lane & 15, quad = lane >> 4;
    bf16_t* sK = (bf16_t*)smem; bf16_t* sV = sK + 64 * LDP;
    float* stO = (float*)(smem + 18432);
    float* kmean = (float*)(smem + 18432); float* gates = (float*)(smem + 22528);
    float* stM = (float*)(smem + 53248); float* stL = (float*)(smem + 53760);
    unsigned* selm = (unsigned*)(smem + 54272); unsigned char* lists = (unsigned char*)(smem + 54784);
    int* cnt = (int*)(smem + 56832); int4* desc = (int4*)(smem + 56960); int* misc = (int*)(smem + 59008);
    const bf16_t* z = (const bf16_t*)(p.ws + WS_Z);
    const int n = 15 - (idx >> 5); const int rem = idx & 31; const int b = rem >> 3, h = (rem >> 1) & 3, qh = rem & 1;
    const int qbase = b * S + n * 256 + qh * 128, qcol = C_AQ + h * 64, kcol = C_AK + h * 64, vcol = C_AV + h * 64;
    __syncthreads();
    {
        const float* kpart = (const float*)(p.ws + WS_KPART);
        for (int e = t; e < n * 64; e += 256) { const int j = e >> 6, d = e & 63; const float* kp = kpart + (size_t)(b * 64 + j * 4) * 256 + h * 64 + d;
            kmean[e] = ((kp[0] + kp[256]) + (kp[512] + kp[768])) * (1.f / 256.f); }
        if (t < 16) cnt[t] = 0;
        __syncthreads();
        {
            const int ql = t >> 1, half = t & 1; const bf16_t* qp = z + (size_t)(qbase + ql) * ZP + qcol;
            float g[8];
#pragma unroll
            for (int jj = 0; jj < 8; ++jj) g[jj] = 0.f;
#pragma unroll 1
            for (int dc = 0; dc < 8; ++dc) {
                const u32x4 qv = *(const u32x4*)(qp + dc * 8); float qq[8];
#pragma unroll
                for (int e = 0; e < 4; ++e) { qq[2 * e] = __uint_as_float(qv[e] << 16); qq[2 * e + 1] = __uint_as_float(qv[e] & 0xffff0000u); }
#pragma unroll
                for (int jj = 0; jj < 8; ++jj) { const int j = half + 2 * jj; if (j < n) { const float* km = kmean + j * 64 + dc * 8;
#pragma unroll
                    for (int e = 0; e < 8; ++e) g[jj] += qq[e] * km[e]; } }
            }
#pragma unroll
            for (int jj = 0; jj < 8; ++jj) gates[ql * 16 + half + 2 * jj] = g[jj];
        }
        __syncthreads();
        if (t < 128) {
            unsigned msk = 0;
            for (int k = 0; k < 3 && k < n; ++k) { float best = -3.0e38f; int bi = -1;
                for (int j = 0; j < n; ++j) if (!((msk >> j) & 1u)) { const float gv = gates[t * 16 + j]; if (gv > best) { best = gv; bi = j; } }
                if (bi >= 0) msk |= 1u << bi; }
            selm[t] = msk;
            for (int j = 0; j < n; ++j) if ((msk >> j) & 1u) { const int pos = atomicAdd(&cnt[j], 1); lists[j * 128 + pos] = (unsigned char)t; }
        }
        __syncthreads();
        if (t < 128) { for (int j = 0; j < n; ++j) { const int cj = cnt[j]; if (t >= cj && t < ((cj + 15) & ~15)) lists[j * 128 + t] = 255; } }
        if (t == 0) {
            int nd = 0;
            for (int kt = 0; kt <= qh * 2 + 1; ++kt) desc[nd++] = make_int4(b * S + n * 256 + kt * 64, kt * 64 - qh * 128, BIG, -1);
            misc[1] = nd;
            for (int j = 0; j < n; ++j) { const int ntl = (cnt[j] + 15) >> 4;
                for (int ps = 0; ps * 4 < ntl; ++ps) for (int kt = 0; kt < 4; ++kt) desc[nd++] = make_int4(b * S + j * 256 + kt * 64, ps, kt, j); }
            misc[0] = nd;
        }
    }
    __syncthreads();
    const int nd = misc[0], nown = misc[1];
    const int lrow = t >> 2, lch = (t & 3) * 2;
    u32x4 rk0, rk1, rv0, rv1;
    { const int4 d = desc[0]; const bf16_t* rp = z + (size_t)(d.x + lrow) * ZP + lch * 8;
      rk0 = *(const u32x4*)(rp + kcol); rk1 = *(const u32x4*)(rp + kcol + 8); rv0 = *(const u32x4*)(rp + vcol); rv1 = *(const u32x4*)(rp + vcol + 8); }
    bf16x8 nqf[2]; int ngq = 0; bool ngv = false, nhas = false;
    auto prefetch_group = [&](int gi) {
        nhas = false;
        if (gi < nd) { const int4 dg = desc[gi]; const int slot = dg.y * 4 + w; nhas = slot * 16 < cnt[dg.w];
            if (nhas) { const int qi = lists[dg.w * 128 + slot * 16 + r16]; ngv = qi != 255; ngq = ngv ? qi : 0;
#pragma unroll
                for (int ks = 0; ks < 2; ++ks) nqf[ks] = *(const bf16x8*)(z + (size_t)(qbase + ngq) * ZP + qcol + ks * 32 + quad * 8); } }
    };
    prefetch_group(nown);
    {
        bf16x8 qf[2][2];
#pragma unroll
        for (int qt = 0; qt < 2; ++qt)
#pragma unroll
            for (int ks = 0; ks < 2; ++ks) qf[qt][ks] = *(const bf16x8*)(z + (size_t)(qbase + w * 32 + qt * 16 + r16) * ZP + qcol + ks * 32 + quad * 8);
        float m[2] = {-1e30f, -1e30f}, l[2] = {0.f, 0.f}; f32x4 O[2][4];
#pragma unroll
        for (int a = 0; a < 2; ++a)
#pragma unroll
            for (int c = 0; c < 4; ++c) O[a][c] = (f32x4){0.f, 0.f, 0.f, 0.f};
        for (int i = 0; i < nown; ++i) {
            __syncthreads();
            *(u32x4*)(sK + lrow * LDP + lch * 8) = rk0; *(u32x4*)(sK + lrow * LDP + lch * 8 + 8) = rk1;
            *(u32x4*)(sV + lrow * LDP + lch * 8) = rv0; *(u32x4*)(sV + lrow * LDP + lch * 8 + 8) = rv1;
            __syncthreads();
            if (i + 1 < nd) { const int4 d = desc[i + 1]; const bf16_t* rp = z + (size_t)(d.x + lrow) * ZP + lch * 8;
                rk0 = *(const u32x4*)(rp + kcol); rk1 = *(const u32x4*)(rp + kcol + 8); rv0 = *(const u32x4*)(rp + vcol); rv1 = *(const u32x4*)(rp + vcol + 8); }
            const int4 d = desc[i];
            const bool need = (w * 32 + 31 >= d.y) && (w * 32 - 63 <= d.z);
            const bool full = (w * 32 - 63 >= d.y) && (w * 32 + 31 <= d.z);
            if (need) attn_tile<2>(sK, sV, qf, d.y, d.z, full, false, true, true, m, l, O, w * 32);
        }
#pragma unroll
        for (int qt = 0; qt < 2; ++qt) {
            float lt = l[qt]; lt += __shfl_xor(lt, 16); lt += __shfl_xor(lt, 32);
            const int ql = w * 32 + qt * 16 + r16;
            if (quad == 0) { stM[ql] = m[qt]; stL[ql] = lt; }
#pragma unroll
            for (int dt = 0; dt < 4; ++dt) *(f32x4*)(stO + ql * 68 + dt * 16 + quad * 4) = O[qt][dt];
        }
    }
    {
        bf16x8 qf[1][2]; float m[1] = {-1e30f}, l[1] = {0.f}; f32x4 O[1][4];
        int gq = 0; bool gv = false, has = false;
        for (int i = nown; i < nd; ++i) {
            __syncthreads();
            *(u32x4*)(sK + lrow * LDP + lch * 8) = rk0; *(u32x4*)(sK + lrow * LDP + lch * 8 + 8) = rk1;
            *(u32x4*)(sV + lrow * LDP + lch * 8) = rv0; *(u32x4*)(sV + lrow * LDP + lch * 8 + 8) = rv1;
            __syncthreads();
            if (i + 1 < nd) { const int4 d = desc[i + 1]; const bf16_t* rp = z + (size_t)(d.x + lrow) * ZP + lch * 8;
                rk0 = *(const u32x4*)(rp + kcol); rk1 = *(const u32x4*)(rp + kcol + 8); rv0 = *(const u32x4*)(rp + vcol); rv1 = *(const u32x4*)(rp + vcol + 8); }
            const int4 d = desc[i];
            if (d.z == 0) {
                has = nhas; gv = ngv; gq = ngq; qf[0][0] = nqf[0]; qf[0][1] = nqf[1];
                m[0] = -1e30f; l[0] = 0.f;
#pragma unroll
                for (int c = 0; c < 4; ++c) O[0][c] = (f32x4){0.f, 0.f, 0.f, 0.f};
                prefetch_group(i + 4);
            }
            if (has) {
                attn_tile<1>(sK, sV, qf, -BIG, BIG, true, false, true, true, m, l, O, 0);
                if (d.z == 3) {
                    float lt = l[0]; lt += __shfl_xor(lt, 16); lt += __shfl_xor(lt, 32);
                    if (gv) {
                        const float mo = stM[gq], lo_ = stL[gq]; const float mn = fmaxf(mo, m[0]);
                        const float fa = __builtin_amdgcn_exp2f((mo - mn) * ATT_SC), fb = __builtin_amdgcn_exp2f((m[0] - mn) * ATT_SC);
#pragma unroll
                        for (int dt = 0; dt < 4; ++dt) { float* sp = stO + gq * 68 + dt * 16 + quad * 4; const f32x4 so = *(const f32x4*)sp; *(f32x4*)sp = so * fa + O[0][dt] * fb; }
                        if (quad == 0) { stM[gq] = mn; stL[gq] = lo_ * fa + lt * fb; }
                    }
                }
            }
        }
    }
    __syncthreads();
#pragma unroll
    for (int qt = 0; qt < 2; ++qt) {
        const int ql = w * 32 + qt * 16 + r16; const float inv = 1.f / stL[ql]; const size_t tok = (size_t)(qbase + ql);
#pragma unroll
        for (int dt = 0; dt < 4; ++dt) { const int d0 = dt * 16 + quad * 4; const f32x4 ov = *(const f32x4*)(stO + ql * 68 + d0);
            const u32x2 gvv = *(const u32x2*)(z + tok * ZP + C_AG + h * 64 + d0);
            const float g0 = __uint_as_float(gvv.x << 16), g1 = __uint_as_float(gvv.x & 0xffff0000u), g2 = __uint_as_float(gvv.y << 16), g3 = __uint_as_float(gvv.y & 0xffff0000u);
            u32x2 o; o.x = pack2(ov[0] * inv * silu_f(g0), ov[1] * inv * silu_f(g1)); o.y = pack2(ov[2] * inv * silu_f(g2), ov[3] * inv * silu_f(g3));
            *(u32x2*)(outp + tok * 1024 + h * 64 + d0) = o; }
    }
}

__device__ __forceinline__ void gla_bcum(const Params& p, int l, const bf16_t* z, int tok0, float* bc, float* drs) {
    const int t = tid_opq();
    const int hd = t & 127, ih = t >> 7;
    float wr[16];
#pragma unroll
    for (int r = 0; r < 16; ++r) wr[r] = p.gla_wr[l * 2048 + r * 128 + hd];
    const float br = p.gla_br[l * 128 + hd];
    { const int e0 = t, e1 = t + 256; const bf16_t d0 = z[(size_t)(tok0 + (e0 >> 4)) * ZP + C_DR + (e0 & 15)], d1 = z[(size_t)(tok0 + (e1 >> 4)) * ZP + C_DR + (e1 & 15)];
      drs[e0] = bf2f(d0); drs[e1] = bf2f(d1); }
    __syncthreads();
#pragma unroll
    for (int ii = 0; ii < 16; ++ii) { const int i = ih * 16 + ii; float x = br;
#pragma unroll
        for (int r4 = 0; r4 < 4; ++r4) { const f32x4 dv = *(const f32x4*)(drs + i * 16 + r4 * 4); x += (dv[0] * wr[r4 * 4] + dv[1] * wr[r4 * 4 + 1]) + (dv[2] * wr[r4 * 4 + 2] + dv[3] * wr[r4 * 4 + 3]); }
        bc[i * 128 + hd] = (fminf(x, 0.f) - __logf(1.f + __expf(-fabsf(x)))) * (1.f / 16.f); }
    __syncthreads();
    if (t < 128) { float sacc = 0.f;
#pragma unroll
        for (int i = 0; i < 32; ++i) { sacc += bc[i * 128 + t]; bc[i * 128 + t] = sacc; } }
    __syncthreads();
}

__device__ void gla1_item(const Params& p, int l, int idx, char* smem) {
    const int t = tid_opq(), lane = t & 63, w = t >> 6, r16 = lane & 15, quad = lane >> 4;
    const int b = idx >> 7, c = idx & 127; const int tok0 = b * S + c * 32;
    const bf16_t* z = (const bf16_t*)(p.ws + WS_Z);
    float* bc = (float*)smem; float* drs = (float*)(smem + 16384);
    bf16_t* kdT = (bf16_t*)(smem + 18432) + w * 1024;
    bf16_t* vL = (bf16_t*)(smem + 26624) + w * (32 * LDP);
    float* gkv = (float*)(p.ws + WS_GKV); float* gdec = (float*)(p.ws + WS_GDEC);
    bf16_t kraw[16]; u32x4 vr[4];
#pragma unroll
    for (int i = 0; i < 16; ++i) { const int e = lane + 64 * i; kraw[i] = z[(size_t)(tok0 + (e >> 5)) * ZP + C_DK + w * 32 + (e & 31)]; }
#pragma unroll
    for (int i = 0; i < 4; ++i) { const int cc = lane + 64 * i; vr[i] = *(const u32x4*)(z + (size_t)(tok0 + (cc >> 3)) * ZP + C_DV + w * 64 + (cc & 7) * 8); }
    __syncthreads();
#pragma unroll
    for (int i = 0; i < 4; ++i) { const int cc = lane + 64 * i; *(u32x4*)(vL + (cc >> 3) * LDP + (cc & 7) * 8) = vr[i]; }
    gla_bcum(p, l, z, tok0, bc, drs);
#pragma unroll
    for (int i = 0; i < 16; ++i) { const int e = lane + 64 * i; const int j = e >> 5, d = e & 31;
        kdT[d * 32 + j] = f2bf(bf2f(kraw[i]) * __expf(bc[31 * 128 + w * 32 + d] - bc[j * 128 + w * 32 + d])); }
    const int bh = b * 4 + w;
    if (lane < 32) gdec[(bh * 128 + c) * 32 + lane] = __expf(bc[31 * 128 + w * 32 + lane]);
    __syncthreads();
    bf16x8 kf[2];
#pragma unroll
    for (int x = 0; x < 2; ++x) kf[x] = *(const bf16x8*)(kdT + (x * 16 + r16) * 32 + quad * 8);
    float* dst = gkv + (size_t)(bh * 128 + c) * 2048;
#pragma unroll
    for (int dt = 0; dt < 4; ++dt) {
        const bf16_t* v0p = vL + (quad * 8 + (r16 >> 2)) * LDP + dt * 16 + (r16 & 3) * 4;
        const bf16x4 v0 = __builtin_amdgcn_ds_read_tr16_b64_v4i16((__attribute__((address_space(3))) bf16x4*)(v0p));
        const bf16x4 v1 = __builtin_amdgcn_ds_read_tr16_b64_v4i16((__attribute__((address_space(3))) bf16x4*)(v0p + 4 * LDP));
        const bf16x8 vf = {v0[0], v0[1], v0[2], v0[3], v1[0], v1[1], v1[2], v1[3]};
#pragma unroll
        for (int x = 0; x < 2; ++x) {
            const f32x4 r = __builtin_amdgcn_mfma_f32_16x16x32_bf16(vf, kf[x], (f32x4){0.f, 0.f, 0.f, 0.f}, 0, 0, 0);
            *(f32x4*)(dst + (x * 16 + r16) * 64 + dt * 16 + quad * 4) = r;
        }
    }
}

#define OPQ(ptr) asm volatile("" : "+v"(ptr))
__device__ void gla3_item(const Params& p, int l, int idx, char* smem) {
    const int t = tid_opq(), lane = t & 63, w = t >> 6, r16 = lane & 15, quad = lane >> 4;
    const int b = idx >> 7, c = idx & 127; const int tok0 = b * S + c * 32;
    const bf16_t* z = (const bf16_t*)(p.ws + WS_Z); bf16_t* mix = (bf16_t*)(p.ws + WS_U);
    float* bc = (float*)smem; float* drs = (float*)(smem + 16384);
    bf16_t* SL = (bf16_t*)smem + w * (32 * LDP);
    bf16_t* qe = (bf16_t*)(smem + 18432) + w * 1024;
    bf16_t* ke = (bf16_t*)(smem + 26624) + w * 1024;
    bf16_t* vL = (bf16_t*)(smem + 34816) + w * (32 * LDP);
    const float* gkv = (const float*)(p.ws + WS_GKV);
    const int bh = b * 4 + w;
    bf16_t qraw[16], kraw[16];
    { const bf16_t* qp = z + (size_t)(tok0 + (lane >> 5)) * ZP + w * 32 + (lane & 31);
#pragma unroll
      for (int i = 0; i < 16; ++i) { qraw[i] = qp[C_DQ]; kraw[i] = qp[C_DK]; qp += 2 * ZP; OPQ(qp); } }
    u32x4 vr[4]; f32x4 sr[8];
#pragma unroll
    for (int i = 0; i < 4; ++i) { const int cc = lane + 64 * i; vr[i] = *(const u32x4*)(z + (size_t)(tok0 + (cc >> 3)) * ZP + C_DV + w * 64 + (cc & 7) * 8); }
    { const float* Sp = gkv + (size_t)(bh * 128 + c) * 2048;
#pragma unroll
      for (int i = 0; i < 8; ++i) sr[i] = *(const f32x4*)(Sp + (lane + 64 * i) * 4); }
    __syncthreads();
#pragma unroll
    for (int i = 0; i < 4; ++i) { const int cc = lane + 64 * i; *(u32x4*)(vL + (cc >> 3) * LDP + (cc & 7) * 8) = vr[i]; }
    gla_bcum(p, l, z, tok0, bc, drs);
#pragma unroll
    for (int i2 = 0; i2 < 16; ++i2) { const int e = lane + 64 * i2; const int i = e >> 5, d = e & 31; const float bcv = bc[i * 128 + w * 32 + d];
        qe[i * 32 + d] = f2bf(bf2f(qraw[i2]) * __expf(bcv) * 0.17677669529663687f); ke[i * 32 + d] = f2bf(bf2f(kraw[i2]) * __expf(-bcv)); }
    __syncthreads();
#pragma unroll
    for (int i = 0; i < 8; ++i) { const int cc = lane + 64 * i; const int d = cc >> 4, v4 = cc & 15; u32x2 pk; pk.x = pack2(sr[i][0], sr[i][1]); pk.y = pack2(sr[i][2], sr[i][3]);
        *(u32x2*)(SL + d * LDP + v4 * 4) = pk; }
    __syncthreads();
    bf16x8 qf[2], kf[2];
#pragma unroll
    for (int x = 0; x < 2; ++x) { qf[x] = *(const bf16x8*)(qe + (x * 16 + r16) * 32 + quad * 8); kf[x] = *(const bf16x8*)(ke + (x * 16 + r16) * 32 + quad * 8); }
    bf16x8 pf[2];
#pragma unroll
    for (int it = 0; it < 2; ++it) {
        f32x4 at[2];
#pragma unroll
        for (int jt = 0; jt < 2; ++jt) { at[jt] = __builtin_amdgcn_mfma_f32_16x16x32_bf16(kf[jt], qf[it], (f32x4){0.f, 0.f, 0.f, 0.f}, 0, 0, 0);
#pragma unroll
            for (int jj = 0; jj < 4; ++jj) at[jt][jj] = (jt * 16 + quad * 4 + jj <= it * 16 + r16) ? at[jt][jj] : 0.f; }
        u32x4 pk = {pack2(at[0][0], at[0][1]), pack2(at[0][2], at[0][3]), pack2(at[1][0], at[1][1]), pack2(at[1][2], at[1][3])};
        pf[it] = __builtin_bit_cast(bf16x8, pk);
    }
    f32x4 O[2][4];
#pragma unroll
    for (int dt = 0; dt < 4; ++dt) {
        const bf16_t* v0p = vL + (quad * 4 + (r16 >> 2)) * LDP + dt * 16 + (r16 & 3) * 4;
        const bf16x4 v0 = __builtin_amdgcn_ds_read_tr16_b64_v4i16((__attribute__((address_space(3))) bf16x4*)(v0p));
        const bf16x4 v1 = __builtin_amdgcn_ds_read_tr16_b64_v4i16((__attribute__((address_space(3))) bf16x4*)(v0p + 16 * LDP));
        const bf16x8 vf = {v0[0], v0[1], v0[2], v0[3], v1[0], v1[1], v1[2], v1[3]};
        const bf16_t* s0p = SL + (quad * 8 + (r16 >> 2)) * LDP + dt * 16 + (r16 & 3) * 4;
        const bf16x4 s0 = __builtin_amdgcn_ds_read_tr16_b64_v4i16((__attribute__((address_space(3))) bf16x4*)(s0p));
        const bf16x4 s1 = __builtin_amdgcn_ds_read_tr16_b64_v4i16((__attribute__((address_space(3))) bf16x4*)(s0p + 4 * LDP));
        const bf16x8 sf = {s0[0], s0[1], s0[2], s0[3], s1[0], s1[1], s1[2], s1[3]};
#pragma unroll
        for (int it = 0; it < 2; ++it) {
            O[it][dt] = __builtin_amdgcn_mfma_f32_16x16x32_bf16(vf, pf[it], (f32x4){0.f, 0.f, 0.f, 0.f}, 0, 0, 0);
            O[it][dt] = __builtin_amdgcn_mfma_f32_16x16x32_bf16(sf, qf[it], O[it][dt], 0, 0, 0);
        }
    }
#pragma unroll
    for (int it = 0; it < 2; ++it) {
        float ss = 0.f;
#pragma unroll
        for (int dt = 0; dt < 4; ++dt) ss += (O[it][dt][0] * O[it][dt][0] + O[it][dt][1] * O[it][dt][1]) + (O[it][dt][2] * O[it][dt][2] + O[it][dt][3] * O[it][dt][3]);
        ss += __shfl_xor(ss, 16); ss += __shfl_xor(ss, 32);
        const float rn = rsqrtf(ss * (1.f / 64.f) + 1e-5f);
        const size_t tok = (size_t)(tok0 + it * 16 + r16);
#pragma unroll
        for (int dt = 0; dt < 4; ++dt) { const int v0i = dt * 16 + quad * 4; const f32x4 gn = *(const f32x4*)(p.gla_gn + l * 64 + v0i);
            const u32x2 gv = *(const u32x2*)(z + tok * ZP + C_DG + w * 64 + v0i);
            const float g0 = __uint_as_float(gv.x << 16), g1 = __uint_as_float(gv.x & 0xffff0000u), g2 = __uint_as_float(gv.y << 16), g3 = __uint_as_float(gv.y & 0xffff0000u);
            u32x2 o; o.x = pack2(O[it][dt][0] * rn * gn[0] * silu_f(g0), O[it][dt][1] * rn * gn[1] * silu_f(g1));
            o.y = pack2(O[it][dt][2] * rn * gn[2] * silu_f(g2), O[it][dt][3] * rn * gn[3] * silu_f(g3));
            *(u32x2*)(mix + tok * 1024 + 768 + w * 64 + v0i) = o; }
    }
}

__device__ void lru1_item(const Params& p, int l, int idx, char* smem) {
    const int t = tid_opq(), lane = t & 63, g = t >> 6, r16 = lane & 15, quad = lane >> 4; const int ch = t;
    const int b = idx >> 7, c = idx & 127; const int s0 = c * 32; const int tok0 = b * S + s0;
    const bf16_t* z = (const bf16_t*)(p.ws + WS_Z); float* xcs = (float*)smem;
    bf16_t* preA = (bf16_t*)(smem + 32768); bf16_t* preX = (bf16_t*)(smem + 49152);
    float* lh = (float*)(p.ws + WS_LH); float* lp = (float*)(p.ws + WS_LP);
    bf16_t xr[35];
#pragma unroll
    for (int i = 0; i < 35; ++i) { const int sidx = s0 + i - 3; xr[i] = (sidx >= 0) ? z[(size_t)(tok0 + i - 3) * ZP + C_BX + ch] : (bf16_t)0; }
    const float cw0 = p.conv_w[l * 1024 + ch], cw1 = p.conv_w[l * 1024 + 256 + ch], cw2 = p.conv_w[l * 1024 + 512 + ch], cw3 = p.conv_w[l * 1024 + 768 + ch];
    const float cb = p.conv_b[l * 256 + ch];
    const bf16_t* lwt = (const bf16_t*)(p.ws + WS_LWT) + (size_t)l * 32768 + g * 4096;
    bf16x8 wfa[4][2], wfx[4][2];
#pragma unroll
    for (int nt = 0; nt < 4; ++nt)
#pragma unroll
        for (int ks = 0; ks < 2; ++ks) { wfa[nt][ks] = *(const bf16x8*)(lwt + (nt * 16 + r16) * 64 + ks * 32 + quad * 8); wfx[nt][ks] = *(const bf16x8*)(lwt + 16384 + (nt * 16 + r16) * 64 + ks * 32 + quad * 8); }
    __syncthreads();
#pragma unroll
    for (int i = 0; i < 32; ++i) xcs[i * 256 + ch] = cb + (cw0 * bf2f(xr[i]) + cw1 * bf2f(xr[i + 1])) + (cw2 * bf2f(xr[i + 2]) + cw3 * bf2f(xr[i + 3]));
    __syncthreads();
#pragma unroll
    for (int tt = 0; tt < 2; ++tt) {
        bf16x8 xf[2];
#pragma unroll
        for (int ks = 0; ks < 2; ++ks) { const float* xp = xcs + (tt * 16 + r16) * 256 + g * 64 + ks * 32 + quad * 8; const f32x4 x0 = *(const f32x4*)xp, x1 = *(const f32x4*)(xp + 4);
            u32x4 pk = {pack2(x0[0], x0[1]), pack2(x0[2], x0[3]), pack2(x1[0], x1[1]), pack2(x1[2], x1[3])}; xf[ks] = __builtin_bit_cast(bf16x8, pk); }
#pragma unroll
        for (int nt = 0; nt < 4; ++nt) {
            f32x4 ra = __builtin_amdgcn_mfma_f32_16x16x32_bf16(wfa[nt][0], xf[0], (f32x4){0.f, 0.f, 0.f, 0.f}, 0, 0, 0); ra = __builtin_amdgcn_mfma_f32_16x16x32_bf16(wfa[nt][1], xf[1], ra, 0, 0, 0);
            f32x4 rx = __builtin_amdgcn_mfma_f32_16x16x32_bf16(wfx[nt][0], xf[0], (f32x4){0.f, 0.f, 0.f, 0.f}, 0, 0, 0); rx = __builtin_amdgcn_mfma_f32_16x16x32_bf16(wfx[nt][1], xf[1], rx, 0, 0, 0);
            u32x2 pa; pa.x = pack2(ra[0], ra[1]); pa.y = pack2(ra[2], ra[3]); u32x2 px; px.x = pack2(rx[0], rx[1]); px.y = pack2(rx[2], rx[3]);
            *(u32x2*)(preA + (tt * 16 + r16) * 256 + g * 64 + nt * 16 + quad * 4) = pa; *(u32x2*)(preX + (tt * 16 + r16) * 256 + g * 64 + nt * 16 + quad * 4) = px;
        }
    }
    __syncthreads();
    const float ba = p.lru_ba[l * 256 + ch], bx = p.lru_bx[l * 256 + ch], lam = p.lru_lam[l * 256 + ch];
    const float sp = fmaxf(-lam, 0.f) + log1pf(__expf(-fabsf(lam)));
    float hh = 0.f, P = 1.f;
    float* lhp = lh + (size_t)tok0 * 256 + ch; float* lpp = lp + (size_t)tok0 * 256 + ch;
#pragma unroll 4
    for (int i = 0; i < 32; ++i) { const float r = sigmoid_f(bf2f(preA[i * 256 + ch]) + ba), ig = sigmoid_f(bf2f(preX[i * 256 + ch]) + bx); const float la = -8.f * r * sp; const float a = __expf(la);
        const float w2 = 2.f * la;
        const float em_s = -w2 * (1.f + w2 * (0.5f + w2 * (0.16666667f + w2 * (0.041666668f + w2 * (0.0083333338f + w2 * 0.0013888889f)))));
        const float em = (w2 > -0.25f) ? em_s : (1.f - a * a);
        const float u = __builtin_amdgcn_sqrtf(em) * (ig * xcs[i * 256 + ch]); hh = a * hh + u; P *= a;
        lhp[(size_t)i * 256] = hh; lpp[(size_t)i * 256] = P; }
}

__device__ void lru3_item(const Params& p, int idx) {
    const int ch = tid_opq(); const int b = idx >> 7, c = idx & 127; const int tok0 = b * S + c * 32;
    const bf16_t* z = (const bf16_t*)(p.ws + WS_Z); bf16_t* mix = (bf16_t*)(p.ws + WS_U);
    const float* lh = (const float*)(p.ws + WS_LH); const float* lp = (const float*)(p.ws + WS_LP); const float* lc = (const float*)(p.ws + WS_LC);
    const float carry = lc[(size_t)(b * 128 + c) * 256 + ch];
    float hv[32], pv[32]; bf16_t gv[32];
#pragma unroll
    for (int i = 0; i < 32; ++i) { const size_t tok = (size_t)(tok0 + i); hv[i] = lh[tok * 256 + ch]; pv[i] = lp[tok * 256 + ch]; gv[i] = z[tok * ZP + C_BG + ch]; }
#pragma unroll
    for (int i = 0; i < 32; ++i) { const size_t tok = (size_t)(tok0 + i); mix[tok * 1024 + 256 + ch] = f2bf((hv[i] + pv[i] * carry) * silu_f(bf2f(gv[i]))); }
}

__device__ void dilc_item(const Params& p, int idx) {
    const int t = tid_opq(); const size_t tok = (size_t)idx * 8 + (t >> 5); const int chn = t & 31; const int h = chn >> 3;
    const bf16_t* z = (const bf16_t*)(p.ws + WS_Z); bf16_t* mix = (bf16_t*)(p.ws + WS_U);
    const bf16_t* dilo = (const bf16_t*)(p.ws + WS_DILO); const float* dill = (const float*)(p.ws + WS_DILL);
    const float l0 = dill[((size_t)0 * T + tok) * 4 + h], l1 = dill[((size_t)1 * T + tok) * 4 + h], l2 = dill[((size_t)2 * T + tok) * 4 + h];
    const float mx = fmaxf(l0, fmaxf(l1, l2)); float w0 = __expf(l0 - mx), w1 = __expf(l1 - mx), w2 = __expf(l2 - mx); const float inv = 1.f / (w0 + w1 + w2); w0 *= inv; w1 *= inv; w2 *= inv;
    const u32x4 o0 = *(const u32x4*)(dilo + ((size_t)0 * T + tok) * 256 + chn * 8), o1 = *(const u32x4*)(dilo + ((size_t)1 * T + tok) * 256 + chn * 8), o2 = *(const u32x4*)(dilo + ((size_t)2 * T + tok) * 256 + chn * 8);
    const u32x4 gv = *(const u32x4*)(z + tok * ZP + C_CG + chn * 8);
    u32x4 r;
#pragma unroll
    for (int e = 0; e < 4; ++e) {
        const float a = w0 * __uint_as_float(o0[e] << 16) + w1 * __uint_as_float(o1[e] << 16) + w2 * __uint_as_float(o2[e] << 16);
        const float bq = w0 * __uint_as_float(o0[e] & 0xffff0000u) + w1 * __uint_as_float(o1[e] & 0xffff0000u) + w2 * __uint_as_float(o2[e] & 0xffff0000u);
        r[e] = pack2(a * silu_f(__uint_as_float(gv[e] << 16)), bq * silu_f(__uint_as_float(gv[e] & 0xffff0000u)));
    }
    *(u32x4*)(mix + tok * 1024 + 512 + chn * 8) = r;
}

__device__ void m2_phase(const Params& p, char* smem) {
    float* gkv = (float*)(p.ws + WS_GKV); const float* gdec = (const float*)(p.ws + WS_GDEC);
    const float* lh = (const float*)(p.ws + WS_LH); const float* lp = (const float*)(p.ws + WS_LP); float* lc = (float*)(p.ws + WS_LC);
    float* aggP = (float*)smem; float* aggS = aggP + 256;
    const int t = tid_opq(); const int e = t & 31, seg = t >> 5;
    for (int it = blockIdx.x; it < 1024 + 32; it += gridDim.x) {
        float a[16], x[16];
        size_t ostride;
        float* outp;
        if (it < 1024) {
            const int gid = it * 32 + e; const int bh = gid >> 11, dv = gid & 2047, d = dv >> 6;
            float* base = gkv + (size_t)bh * 128 * 2048 + dv + (size_t)(seg * 16) * 2048; const float* dc = gdec + (size_t)bh * 128 * 32 + d + (seg * 16) * 32;
#pragma unroll
            for (int k = 0; k < 16; ++k) { x[k] = base[(size_t)k * 2048]; a[k] = dc[k * 32]; }
            outp = base; ostride = 2048;
        } else {
            const int i2 = it - 1024; const int b = i2 >> 3, ch = (i2 & 7) * 32 + e;
#pragma unroll
            for (int k = 0; k < 16; ++k) { const size_t ix = (size_t)(b * S + (seg * 16 + k) * 32 + 31) * 256 + ch; a[k] = lp[ix]; x[k] = lh[ix]; }
            outp = lc + (size_t)(b * 128 + seg * 16) * 256 + ch; ostride = 256;
        }
        float st = 0.f, pr = 1.f;
#pragma unroll
        for (int k = 0; k < 16; ++k) { const float ak = a[k], xk = x[k]; a[k] = pr; x[k] = st; st = ak * st + xk; pr *= ak; }
        __syncthreads();
        aggP[seg * 32 + e] = pr; aggS[seg * 32 + e] = st;
        __syncthreads();
        float carry = 0.f;
        for (int s2 = 0; s2 < seg; ++s2) carry = aggP[s2 * 32 + e] * carry + aggS[s2 * 32 + e];
#pragma unroll
        for (int k = 0; k < 16; ++k) outp[(size_t)k * ostride] = x[k] + a[k] * carry;
    }
}

__global__ void __launch_bounds__(256, 2) fwd_megakernel(Params p) {
    __shared__ __attribute__((aligned(16))) char smem[SMEM_BYTES];
    __shared__ uint4 xb_words;
    __shared__ int s_slot;
    cg::grid_group grid = cg::this_grid();
    if (p.out == nullptr) grid.sync();
    if (threadIdx.x == 0) xb_words = make_uint4(0u, 0u, 0u, 0u);
    __syncthreads();
    const XcdBarrier xb = xcd_barrier_post((unsigned*)(p.ws + WS_CTL), (volatile LAS unsigned*)&xb_words);
    unsigned* cnt = (unsigned*)(p.ws + WS_CNT);
    prologue_phase(p, smem);
    xcd_barrier(xb);
#pragma unroll 1
    for (int l = 0; l < DEPTH; ++l) {
        ln_phase(p, l);
        xcd_barrier(xb);
        g1_phase(p, l, smem);
        xcd_barrier(xb);
        for (;;) { const int it = next_item(cnt + (4 + l) * 64, &s_slot); if (it >= 512) break; lru1_item(p, l, it, smem); }
        for (;;) { const int it = next_item(cnt + (0 + l) * 64, &s_slot); if (it >= 512) break; moba_item(p, it, smem, (bf16_t*)(p.ws + WS_U)); }
        for (;;) { const int it = next_item(cnt + (2 + l) * 64, &s_slot); if (it >= 512) break; gla1_item(p, l, it, smem); }
        for (;;) { const int it = next_item(cnt + (6 + l) * 64, &s_slot); if (it >= 1536) break; attn_item(p, 1, it, smem); }
        xcd_barrier(xb);
        m2_phase(p, smem);
        xcd_barrier(xb);
        for (int it = blockIdx.x; it < 512; it += gridDim.x) gla3_item(p, l, it, smem);
        for (int it = blockIdx.x; it < 512; it += gridDim.x) lru3_item(p, it);
        for (int it = blockIdx.x; it < 2048; it += gridDim.x) dilc_item(p, it);
        xcd_barrier(xb);
        g2_phase(p, l, smem);
        xcd_barrier(xb);
    }
    ln_phase(p, DEPTH);
}

extern "C" void kernel_launch(void* const* d_in, const int* in_sizes, int n_in, void* d_out, int out_size, void* d_ws, size_t ws_size, hipStream_t stream) {
    static int grid_blocks = 0;
    if (!grid_blocks) {
        int dev = 0, cus = 0, per_cu = 0;
        hipGetDevice(&dev);
        hipDeviceGetAttribute(&cus, hipDeviceAttributeMultiprocessorCount, dev);
        hipOccupancyMaxActiveBlocksPerMultiprocessor(&per_cu, (const void*)fwd_megakernel, 256, 0);
        if (per_cu < 1) per_cu = 1;
        if (per_cu > 2) per_cu = 2;
        grid_blocks = cus * per_cu;
        if (ws_size < WS_END) fprintf(stderr, "kernel_launch: workspace too small: %zu < %zu\n", ws_size, (size_t)WS_END);
    }
    Params p{};
    p.x = (const float*)d_in[0]; p.c = (const float*)d_in[1]; p.pos = (const int*)d_in[2];
    p.w_mod = (const float*)d_in[3]; p.b_mod = (const float*)d_in[4]; p.w_in = (const float*)d_in[5];
    p.conv_w = (const float*)d_in[6]; p.conv_b = (const float*)d_in[7]; p.lru_wa = (const float*)d_in[8]; p.lru_ba = (const float*)d_in[9];
    p.lru_wx = (const float*)d_in[10]; p.lru_bx = (const float*)d_in[11]; p.lru_lam = (const float*)d_in[12];
    p.gla_wr = (const float*)d_in[13]; p.gla_br = (const float*)d_in[14]; p.gla_gn = (const float*)d_in[15];
    p.w_out = (const float*)d_in[16]; p.ln_g = (const float*)d_in[17]; p.ln_b = (const float*)d_in[18];
    p.out = (float*)d_out; p.ws = (unsigned char*)d_ws;
    (void)hipMemsetAsync(d_ws, 0, 32768, stream);
    void* args[] = {&p};
    hipError_t e = hipLaunchCooperativeKernel((const void*)fwd_megakernel, dim3(grid_blocks), dim3(256), args, 0, stream);
    if (e != hipSuccess) fprintf(stderr, "cooperative launch failed: %s (grid %d)\n", hipGetErrorString(e), grid_blocks);
}
```

```cpp
#include <hip/hip_runtime.h>
#include <hip/hip_cooperative_groups.h>
#include <cstdio>
#include <cstdint>
#include <type_traits>
namespace cg = cooperative_groups;

typedef unsigned short bf16_t;
typedef short bf16x8 __attribute__((ext_vector_type(8)));
typedef short bf16x4 __attribute__((ext_vector_type(4)));
typedef float f32x4 __attribute__((ext_vector_type(4)));
typedef unsigned u32x4 __attribute__((ext_vector_type(4)));
typedef unsigned u32x2 __attribute__((ext_vector_type(2)));

constexpr int D = 1024, NB = 4, S = 4096, T = NB * S, DEPTH = 2;
constexpr int DIN = 3344, ZP = 3344, NPAD = 3456;
constexpr int C_AQ = 0, C_AK = 256, C_AV = 512, C_AG = 768, C_BX = 1024, C_BG = 1280, C_CQ = 1536, C_CK = 1792,
              C_CV = 2048, C_CG = 2304, C_DQ = 2560, C_DK = 2688, C_DV = 2816, C_DG = 3072, C_DR = 3328;
constexpr float DN_ALPHA = 1.4142135623730951f;
constexpr int LDP = 72;
constexpr int SMEM_BYTES = 65536;
constexpr int BIG = 1000000;

constexpr size_t WS_CTL = 0;
constexpr size_t WS_CNT = 16384;
constexpr size_t WS_WINT = 32768;
constexpr size_t WS_WOUTT = WS_WINT + (size_t)DEPTH * NPAD * 1024 * 2;
constexpr size_t WS_MOD = WS_WOUTT + (size_t)DEPTH * 1024 * 1024 * 2;
constexpr size_t WS_COS = WS_MOD + (size_t)DEPTH * NB * 3072 * 4;
constexpr size_t WS_SIN = WS_COS + (size_t)T * 32 * 4;
constexpr size_t WS_U = WS_SIN + (size_t)T * 32 * 4;
constexpr size_t WS_Z = WS_U + (size_t)T * 1024 * 2;
constexpr size_t WS_KPART = WS_Z + (size_t)T * ZP * 2;
constexpr size_t WS_DILO = WS_KPART + (size_t)256 * 256 * 4;
constexpr size_t WS_DILL = WS_DILO + (size_t)3 * T * 256 * 2;
constexpr size_t WS_GKV = WS_DILL + (size_t)3 * T * 4 * 4;
constexpr size_t WS_GDEC = WS_GKV + (size_t)2048 * 2048 * 4;
constexpr size_t WS_LH = WS_GDEC + (size_t)2048 * 32 * 4;
constexpr size_t WS_LP = WS_LH + (size_t)T * 256 * 4;
constexpr size_t WS_LC = WS_LP + (size_t)T * 256 * 4;
constexpr size_t WS_LWT = WS_LC + (size_t)NB * 128 * 256 * 4;
constexpr size_t WS_BC = WS_LWT + (size_t)DEPTH * 2 * 4 * 64 * 64 * 2;
constexpr size_t WS_END = WS_BC + (size_t)512 * 32 * 128 * 4;

struct Params {
    const float *x, *c; const int* pos;
    const float *w_mod, *b_mod, *w_in, *conv_w, *conv_b, *lru_wa, *lru_ba, *lru_wx, *lru_bx, *lru_lam, *gla_wr, *gla_br, *gla_gn, *w_out, *ln_g, *ln_b;
    float* out; unsigned char* ws;
};

__device__ __forceinline__ float bf2f(bf16_t h) { return __uint_as_float(((unsigned)h) << 16); }
typedef __bf16 hbf16x2 __attribute__((ext_vector_type(2)));
typedef float f32x2 __attribute__((ext_vector_type(2)));
__device__ __forceinline__ unsigned pack2(float a, float b) { f32x2 v = {a, b}; hbf16x2 r = __builtin_convertvector(v, hbf16x2); return __builtin_bit_cast(unsigned, r); }
__device__ __forceinline__ bf16_t f2bf(float f) { return (bf16_t)(pack2(f, 0.f) & 0xffffu); }
__device__ __forceinline__ float silu_f(float x) { return x / (1.f + __expf(-x)); }
__device__ __forceinline__ float sigmoid_f(float x) { return 1.f / (1.f + __expf(-x)); }
__device__ __forceinline__ int tid_opq() { int t = threadIdx.x; asm volatile("" : "+v"(t)); return t; }
__device__ __forceinline__ float wsum(float v) {
#pragma unroll
    for (int o = 32; o; o >>= 1) v += __shfl_xor(v, o);
    return v;
}

#define XB_TMO      128
#define XB_XCNT(j)  (256  + 64 * (j))
#define XB_XSUB(j)  (1280 + 64 * (j))
#define XB_XGEN(j)  (2304 + 64 * (j))
#define XB_TOP      3328
#define XB_TOPGEN   3392
#define XCD_BAR_WORDS 3456
#define XB_SPIN_CAP (1u << 18)
#define LAS __attribute__((address_space(3)))
__device__ __forceinline__ unsigned xb_ld(unsigned* p)              { return __hip_atomic_load(p, __ATOMIC_RELAXED, __HIP_MEMORY_SCOPE_AGENT); }
__device__ __forceinline__ unsigned xb_add(unsigned* p, unsigned v) { return __hip_atomic_fetch_add(p, v, __ATOMIC_RELAXED, __HIP_MEMORY_SCOPE_AGENT); }
__device__ __forceinline__ unsigned xb_xcc_id() { return (unsigned)__builtin_amdgcn_s_getreg((3 << 11) | 20) & 0xFu; }
#define XB_SPIN(cond, bar) do { unsigned _sp = 0; while (cond) { __builtin_amdgcn_s_sleep(1); \
    if ((++_sp & 255u) == 0u) { if (xb_ld(&(bar)[XB_TMO])) break; if (_sp > XB_SPIN_CAP) { atomicAdd(&(bar)[XB_TMO], 1u); break; } } } } while (0)
struct XcdBarrier { unsigned* bar; unsigned x; volatile LAS unsigned* st; };
__device__ __forceinline__ XcdBarrier xcd_barrier_post(unsigned* bar, volatile LAS unsigned* st) {
    XcdBarrier b; b.bar = bar; b.x = xb_xcc_id(); b.st = st;
    if (threadIdx.x == 0) (void)xb_add(&bar[XB_XCNT(b.x)], 1u);
    return b;
}
__device__ __forceinline__ void xcd_barrier_complete(unsigned* bar, unsigned x, unsigned& nloc, unsigned& nx) {
    const unsigned G = gridDim.x * gridDim.y * gridDim.z;
    unsigned sum, cnt, mine, sp = 0u;
    for (;;) {
        sum = 0u; cnt = 0u; mine = 0u;
#pragma unroll
        for (unsigned j = 0; j < 16; ++j) { const unsigned c = xb_ld(&bar[XB_XCNT(j)]); sum += c; cnt += (c > 0u) ? 1u : 0u; mine = (j == x) ? c : mine; }
        if (sum == G) break;
        __builtin_amdgcn_s_sleep(1);
        if ((++sp & 255u) == 0u) { if (xb_ld(&bar[XB_TMO])) break; if (sp > XB_SPIN_CAP) { atomicAdd(&bar[XB_TMO], 1u); break; } }
    }
    nloc = mine > 0u ? mine : 1u; nx = cnt > 0u ? cnt : 1u;
}
__device__ __forceinline__ void xcd_barrier(const XcdBarrier& b) {
    asm volatile("s_waitcnt vmcnt(0)" ::: "memory");
    __syncthreads();
    if (threadIdx.x == 0) {
        unsigned* bar = b.bar;
        __builtin_amdgcn_s_waitcnt(0);
        unsigned nloc = b.st[0], nx = b.st[1];
        if (nloc == 0u) { xcd_barrier_complete(bar, b.x, nloc, nx); b.st[0] = nloc; b.st[1] = nx; }
        const unsigned old = xb_add(&bar[XB_XSUB(b.x)], 1u);
        const unsigned gen = old / nloc;
        if (old + 1u == (gen + 1u) * nloc) {
            __builtin_amdgcn_fence(__ATOMIC_RELEASE, "agent");
            asm volatile("s_waitcnt vmcnt(0)" ::: "memory");
            const unsigned og = xb_add(&bar[XB_TOP], 1u);
            const unsigned tg = og / nx;
            if (og + 1u == (tg + 1u) * nx) xb_add(&bar[XB_TOPGEN], 1u);
            else XB_SPIN(xb_ld(&bar[XB_TOPGEN]) == tg, bar);
            __builtin_amdgcn_fence(__ATOMIC_ACQUIRE, "agent");
            xb_add(&bar[XB_XGEN(b.x)], 1u);
            asm volatile("s_waitcnt vmcnt(0)" ::: "memory");
        } else {
            XB_SPIN(xb_ld(&bar[XB_XGEN(b.x)]) == gen, bar);
            __builtin_amdgcn_fence(__ATOMIC_ACQUIRE, "agent");
            asm volatile("s_waitcnt vmcnt(0)" ::: "memory");
        }
    }
    __syncthreads();
}
__device__ __forceinline__ int next_item(unsigned* ctr, volatile int* slot) {
    __syncthreads();
    if (threadIdx.x == 0) *slot = (int)atomicAdd(ctr, 1u);
    __syncthreads();
    return *slot;
}

__device__ void prologue_phase(const Params& p, char* smem) {
    const int t = tid_opq();
    bf16_t* WinT = (bf16_t*)(p.ws + WS_WINT); bf16_t* WoutT = (bf16_t*)(p.ws + WS_WOUTT);
    float* mod = (float*)(p.ws + WS_MOD); float* cosT = (float*)(p.ws + WS_COS); float* sinT = (float*)(p.ws + WS_SIN);
    float* tl = (float*)smem;
    constexpr int N_TIN = DEPTH * 16 * 54, N_TOUT = DEPTH * 16 * 16, N_MOD = DEPTH * 192, N_ROPE = T * 32 / 256, N_LWT = DEPTH * 2 * 4 * 64 * 64 / 256;
    constexpr int NITEMS = N_TIN + N_TOUT + N_MOD + N_ROPE + N_LWT;
    for (int it = blockIdx.x; it < NITEMS; it += gridDim.x) {
        if (it < N_TIN + N_TOUT) {
            const float* src; bf16_t* dst; int ncols, kt, nt;
            if (it < N_TIN) { int l = it / (16 * 54), r = it % (16 * 54); kt = r / 54; nt = r % 54; src = p.w_in + (size_t)l * 1024 * DIN; dst = WinT + (size_t)l * NPAD * 1024; ncols = DIN; }
            else { int i2 = it - N_TIN; int l = i2 / 256, r = i2 % 256; kt = r / 16; nt = r % 16; src = p.w_out + (size_t)l * 1024 * 1024; dst = WoutT + (size_t)l * 1024 * 1024; ncols = 1024; }
            __syncthreads();
            { const int c = t & 63, r0 = t >> 6; const int n = nt * 64 + c;
#pragma unroll
              for (int i = 0; i < 16; ++i) { int r = r0 + 4 * i; tl[r * 65 + c] = (n < ncols) ? src[(size_t)(kt * 64 + r) * ncols + n] : 0.f; } }
            __syncthreads();
            { const int kk = t & 63, n0 = t >> 6;
#pragma unroll
              for (int i = 0; i < 16; ++i) { int n = n0 + 4 * i; dst[(size_t)(nt * 64 + n) * 1024 + kt * 64 + kk] = f2bf(tl[kk * 65 + n]); } }
        } else if (it < N_TIN + N_TOUT + N_MOD) {
            const int i2 = it - N_TIN - N_TOUT; const int l = i2 / 192, jg = i2 % 192;
            const int jj = t & 15, ks = t >> 4; const int j = jg * 16 + jj;
            float a0 = 0.f, a1 = 0.f, a2 = 0.f, a3 = 0.f;
            const float* wm = p.w_mod + (size_t)l * 1024 * 3072 + j;
#pragma unroll 8
            for (int k = ks * 64; k < ks * 64 + 64; ++k) { float wv = wm[(size_t)k * 3072]; a0 += p.c[k] * wv; a1 += p.c[1024 + k] * wv; a2 += p.c[2048 + k] * wv; a3 += p.c[3072 + k] * wv; }
            __syncthreads();
            tl[(0 * 16 + ks) * 16 + jj] = a0; tl[(1 * 16 + ks) * 16 + jj] = a1; tl[(2 * 16 + ks) * 16 + jj] = a2; tl[(3 * 16 + ks) * 16 + jj] = a3;
            __syncthreads();
            if (t < 64) { const int b = t >> 4, j2 = t & 15; float s = 0.f;
#pragma unroll
              for (int k2 = 0; k2 < 16; ++k2) s += tl[(b * 16 + k2) * 16 + j2];
              mod[((size_t)l * NB + b) * 3072 + jg * 16 + j2] = s + p.b_mod[l * 3072 + jg * 16 + j2]; }
        } else if (it >= N_TIN + N_TOUT + N_MOD + N_ROPE) {
            const int e = (it - N_TIN - N_TOUT - N_MOD - N_ROPE) * 256 + t;
            const int in = e & 63, out = (e >> 6) & 63, g = (e >> 12) & 3, mat = (e >> 14) & 1, l = e >> 15;
            const float* src = mat ? p.lru_wx : p.lru_wa;
            ((bf16_t*)(p.ws + WS_LWT))[e] = f2bf(src[l * 16384 + g * 4096 + in * 64 + out]);
        } else {
            const int i2 = it - N_TIN - N_TOUT - N_MOD; const int e = i2 * 256 + t; const int tok = e >> 5, f = e & 31;
            const float inv = exp2f(-(float)f * (13.287712379549449f / 32.f));
            const float ang = (float)p.pos[tok] * inv;
            double rev = (double)ang * 0.15915494309189535; rev -= __builtin_rint(rev);
            const float rr = (float)rev; cosT[e] = __builtin_amdgcn_cosf(rr); sinT[e] = __builtin_amdgcn_sinf(rr);
        }
    }
}

__device__ void ln_phase(const Params& p, int l) {
    const int t = tid_opq(), lane = t & 63, w = t >> 6;
    bf16_t* ubuf = (bf16_t*)(p.ws + WS_U); const float* mod = (const float*)(p.ws + WS_MOD);
    for (int rg = blockIdx.x; rg < T / 16; rg += gridDim.x) {
        f32x4 v[4][4];
#pragma unroll
        for (int r = 0; r < 4; ++r) { const int row = rg * 16 + w * 4 + r; const float* src = (l <= 1) ? p.x + (size_t)row * 1024 : p.out + (size_t)row * 1024;
#pragma unroll
            for (int i = 0; i < 4; ++i) v[r][i] = *(const f32x4*)(src + i * 256 + lane * 4);
            if (l > 0) {
                const bf16_t* yr = (const bf16_t*)(p.ws + WS_Z) + (size_t)row * 1024; const float* gate = mod + ((size_t)(l - 1) * NB + row / S) * 3072 + 2048;
#pragma unroll
                for (int i = 0; i < 4; ++i) { const u32x2 yv = *(const u32x2*)(yr + i * 256 + lane * 4); const f32x4 g1 = *(const f32x4*)(gate + i * 256 + lane * 4) + 1.f;
                    const f32x4 yf = {__uint_as_float(yv.x << 16), __uint_as_float(yv.x & 0xffff0000u), __uint_as_float(yv.y << 16), __uint_as_float(yv.y & 0xffff0000u)};
                    v[r][i] = v[r][i] * DN_ALPHA + g1 * yf; }
            } }
#pragma unroll
        for (int r = 0; r < 4; ++r) {
            const int row = rg * 16 + w * 4 + r; const int b = row / S;
            if (l > 0) {
                float s = 0.f;
#pragma unroll
                for (int i = 0; i < 4; ++i) s += (v[r][i][0] + v[r][i][1]) + (v[r][i][2] + v[r][i][3]);
                const float mu = wsum(s) * (1.f / 1024.f); float q = 0.f;
#pragma unroll
                for (int i = 0; i < 4; ++i) { f32x4 d = v[r][i] - mu; q += (d[0] * d[0] + d[1] * d[1]) + (d[2] * d[2] + d[3] * d[3]); }
                const float rstd = rsqrtf(wsum(q) * (1.f / 1024.f) + 1e-5f);
#pragma unroll
                for (int i = 0; i < 4; ++i) { const f32x4 g = *(const f32x4*)(p.ln_g + (l - 1) * 1024 + i * 256 + lane * 4), bb = *(const f32x4*)(p.ln_b + (l - 1) * 1024 + i * 256 + lane * 4);
                    v[r][i] = (v[r][i] - mu) * rstd * g + bb; *(f32x4*)(p.out + (size_t)row * 1024 + i * 256 + lane * 4) = v[r][i]; }
            }
            if (l < DEPTH) {
                float s = 0.f;
#pragma unroll
                for (int i = 0; i < 4; ++i) s += (v[r][i][0] + v[r][i][1]) + (v[r][i][2] + v[r][i][3]);
                const float mu = wsum(s) * (1.f / 1024.f); float q = 0.f;
#pragma unroll
                for (int i = 0; i < 4; ++i) { f32x4 d = v[r][i] - mu; q += (d[0] * d[0] + d[1] * d[1]) + (d[2] * d[2] + d[3] * d[3]); }
                const float rstd = rsqrtf(wsum(q) * (1.f / 1024.f) + 1e-5f);
                const float* mb = mod + ((size_t)l * NB + b) * 3072;
#pragma unroll
                for (int i = 0; i < 4; ++i) { const int col = i * 256 + lane * 4; const f32x4 sh = *(const f32x4*)(mb + col), sc = *(const f32x4*)(mb + 1024 + col);
                    f32x4 u = (v[r][i] - mu) * rstd * (sc + 1.f) + sh; u32x2 pk; pk.x = pack2(u[0], u[1]); pk.y = pack2(u[2], u[3]);
                    *(u32x2*)(ubuf + (size_t)row * 1024 + col) = pk; }
            }
        }
    }
}

__device__ __forceinline__ int lds_off(int r, int c8) {
    const int st = (r >> 4) * 2 + (c8 >> 2); const int ob = (r & 15) * 64 + (c8 & 3) * 16;
    return st * 1024 + (ob ^ (((ob >> 9) & 1) << 5));
}
struct RegSet { u32x4 a[4], b[4]; };
__device__ __forceinline__ void gemm_tile(const bf16_t* __restrict__ A, const bf16_t* __restrict__ Bt, int tm, int tn, bool first, bool has_next, int ntm, int ntn,
                                          char* sm, f32x4 (&acc)[4][4], RegSet& r0, RegSet& r1) {
    const int t = tid_opq(), lane = t & 63, w = t >> 6, wm = w >> 1, wn = w & 1, r16 = lane & 15, quad = lane >> 4;
    const int lrow = t >> 3, lch = t & 7;
    constexpr int BUF = 32768;
    const unsigned loff = (unsigned)(lrow * 1024 + lch * 8);
    const bf16_t* At0 = A + (size_t)tm * (128 * 1024); const bf16_t* Bt0 = Bt + (size_t)tn * (128 * 1024);
    const bf16_t* At1 = A + (size_t)ntm * (128 * 1024); const bf16_t* Bt1 = Bt + (size_t)ntn * (128 * 1024);
#define Ag (At0 + loff)
#define Bg (Bt0 + loff)
#define nAg (At1 + loff)
#define nBg (Bt1 + loff)
    const int woff0 = lds_off(lrow, lch);
#define woff(i) (woff0 + 4096 * (i))
    const int fo = lds_off(r16, quad);
#pragma unroll
    for (int a = 0; a < 4; ++a)
#pragma unroll
        for (int b = 0; b < 4; ++b) acc[a][b] = (f32x4){0.f, 0.f, 0.f, 0.f};
    if (first) {
#pragma unroll
        for (int i = 0; i < 4; ++i) { r0.a[i] = *(const u32x4*)(Ag + (size_t)i * 32 * 1024); r0.b[i] = *(const u32x4*)(Bg + (size_t)i * 32 * 1024); }
        __syncthreads();
#pragma unroll
        for (int i = 0; i < 4; ++i) { *(u32x4*)(sm + woff(i)) = r0.a[i]; *(u32x4*)(sm + 16384 + woff(i)) = r0.b[i]; }
#pragma unroll
        for (int i = 0; i < 4; ++i) { r0.a[i] = *(const u32x4*)(Ag + (size_t)i * 32 * 1024 + 64); r0.b[i] = *(const u32x4*)(Bg + (size_t)i * 32 * 1024 + 64); }
    }
    __syncthreads();
    auto step = [&](auto main_tag, int kt) {
        constexpr bool MAIN = decltype(main_tag)::value;
        const char* sA = sm + (kt & 1) * BUF; const char* sB = sA + 16384;
        char* nA = sm + ((kt + 1) & 1) * BUF; char* nB = nA + 16384;
        const bool wr = MAIN || kt + 1 < 16 || has_next;
        const bool own = MAIN || kt + 2 < 16;
        const bf16_t* la = own ? Ag + (kt + 2) * 64 : nAg + (kt - 14) * 64; const bf16_t* lb = own ? Bg + (kt + 2) * 64 : nBg + (kt - 14) * 64;
        {
            bf16x8 af[2][4], bfr[2][4];
#pragma unroll
            for (int mt = 0; mt < 4; ++mt) af[0][mt] = *(const bf16x8*)(sA + ((wm * 4 + mt) * 2 + 0) * 1024 + fo);
#pragma unroll
            for (int nt = 0; nt < 4; ++nt) bfr[0][nt] = *(const bf16x8*)(sB + ((wn * 4 + nt) * 2 + 0) * 1024 + fo);
            __builtin_amdgcn_s_setprio(1);
#pragma unroll
            for (int ks = 0; ks < 2; ++ks) {
#pragma unroll
                for (int mt = 0; mt < 4; ++mt) {
#pragma unroll
                    for (int nt = 0; nt < 4; ++nt) acc[mt][nt] = __builtin_amdgcn_mfma_f32_16x16x32_bf16(bfr[ks][nt], af[ks][mt], acc[mt][nt], 0, 0, 0);
                    const int i = ks * 2 + (mt >> 1);
                    __builtin_amdgcn_sched_barrier(0);
                    if (ks == 0) { af[1][mt] = *(const bf16x8*)(sA + ((wm * 4 + mt) * 2 + 1) * 1024 + fo); bfr[1][mt] = *(const bf16x8*)(sB + ((wn * 4 + mt) * 2 + 1) * 1024 + fo); }
                    if ((mt & 1) == 0) { if (wr) *(u32x4*)(nA + woff(i)) = r0.a[i]; if (own || has_next) r0.a[i] = *(const u32x4*)(la + (size_t)i * 32 * 1024); }
                    else               { if (wr) *(u32x4*)(nB + woff(i)) = r0.b[i]; if (own || has_next) r0.b[i] = *(const u32x4*)(lb + (size_t)i * 32 * 1024); }
                    __builtin_amdgcn_sched_barrier(0);
                }
            }
            __builtin_amdgcn_s_setprio(0);
        }
        __syncthreads();
    };
    {
        std::true_type mt_; std::false_type tl_;
        for (int kt = 0; kt < 14; ++kt) step(mt_, kt);
        step(tl_, 14); step(tl_, 15);
    }
#undef Ag
#undef Bg
#undef nAg
#undef nBg
#undef woff
}

__device__ void g1_phase(const Params& p, int l, char* smem) {
    const int t = tid_opq(), lane = t & 63, w = t >> 6, wm = w >> 1, wn = w & 1, r16 = lane & 15, quad = lane >> 4;
    char* sm = smem; char* sC = smem + 32768;
    const bf16_t* ubuf = (const bf16_t*)(p.ws + WS_U); const bf16_t* WinT = (const bf16_t*)(p.ws + WS_WINT) + (size_t)l * NPAD * 1024;
    bf16_t* z = (bf16_t*)(p.ws + WS_Z); float* kpart = (float*)(p.ws + WS_KPART);
    const float* cosT = (const float*)(p.ws + WS_COS); const float* sinT = (const float*)(p.ws + WS_SIN);
    const bool xo = (gridDim.x & 7) == 0; const int xcd = blockIdx.x & 7, nloc = xo ? (int)(gridDim.x >> 3) : (int)gridDim.x, j0 = xo ? (int)(blockIdx.x >> 3) : (int)blockIdx.x;
    const int lim = xo ? 16 * 27 : 128 * 27;
    RegSet r0, r1;
    for (int L = j0; L < lim; L += nloc) {
        const int tm = xo ? xcd * 16 + (L / 216) * 8 + (L & 7) : L / 27, tn = xo ? ((L % 216) >> 3) : L % 27;
        const int L2 = L + nloc; const bool has_next = L2 < lim;
        const int ntm = has_next ? (xo ? xcd * 16 + (L2 / 216) * 8 + (L2 & 7) : L2 / 27) : tm, ntn = has_next ? (xo ? ((L2 % 216) >> 3) : L2 % 27) : tn;
        f32x4 acc[4][4];
        gemm_tile(ubuf, WinT, tm, tn, L == j0, has_next, ntm, ntn, sm, acc, r0, r1);
        const bool rope = (tn < 4) || (tn >= 12 && tn < 16);
        if (rope) {
#pragma unroll
            for (int mt = 0; mt < 4; ++mt) {
                const int tok = tm * 128 + wm * 64 + mt * 16 + r16;
#pragma unroll
                for (int nt = 0; nt < 2; ++nt) {
                    const f32x4 cs = *(const f32x4*)(cosT + (size_t)tok * 32 + nt * 16 + quad * 4), sn = *(const f32x4*)(sinT + (size_t)tok * 32 + nt * 16 + quad * 4);
                    const f32x4 x1 = acc[mt][nt], x2 = acc[mt][nt + 2];
                    acc[mt][nt] = x1 * cs - x2 * sn; acc[mt][nt + 2] = x1 * sn + x2 * cs;
                }
            }
        }
        if (tn == 2 || tn == 3) {
#pragma unroll
            for (int nt = 0; nt < 4; ++nt) {
                f32x4 sv = (acc[0][nt] + acc[1][nt]) + (acc[2][nt] + acc[3][nt]);
#pragma unroll
                for (int jj = 0; jj < 4; ++jj) { float sx = sv[jj]; sx += __shfl_xor(sx, 1); sx += __shfl_xor(sx, 2); sx += __shfl_xor(sx, 4); sx += __shfl_xor(sx, 8); sv[jj] = sx; }
                if (r16 == 0) *(f32x4*)(kpart + (size_t)(tm * 2 + wm) * 256 + (tn - 2) * 128 + wn * 64 + nt * 16 + quad * 4) = sv;
            }
        }
#pragma unroll
        for (int mt = 0; mt < 4; ++mt)
#pragma unroll
            for (int nt = 0; nt < 4; ++nt) { u32x2 pk; pk.x = pack2(acc[mt][nt][0], acc[mt][nt][1]); pk.y = pack2(acc[mt][nt][2], acc[mt][nt][3]);
                const int row = wm * 64 + mt * 16 + r16; const int c16 = wn * 8 + nt * 2 + (quad >> 1);
                *(u32x2*)(sC + row * 256 + ((c16 ^ (row & 15)) << 4) + (quad & 1) * 8) = pk; }
        __syncthreads();
#pragma unroll
        for (int i = 0; i < 8; ++i) { const int c = t + 256 * i; const int row = c >> 4, ch = c & 15; const int col = tn * 128 + ch * 8;
            if (col < DIN) *(u32x4*)(z + (size_t)(tm * 128 + row) * ZP + col) = *(const u32x4*)(sC + row * 256 + ((ch ^ (row & 15)) << 4)); }
    }
}

__device__ void g2_phase(const Params& p, int l, char* smem) {
    const int t = tid_opq(), lane = t & 63, w = t >> 6, wm = w >> 1, wn = w & 1, r16 = lane & 15, quad = lane >> 4;
    char* sm = smem; char* sC = smem + 32768;
    const bf16_t* mix = (const bf16_t*)(p.ws + WS_U); const bf16_t* WoutT = (const bf16_t*)(p.ws + WS_WOUTT) + (size_t)l * 1024 * 1024;
    bf16_t* ybuf = (bf16_t*)(p.ws + WS_Z);
    const bool xo = (gridDim.x & 7) == 0; const int xcd = blockIdx.x & 7, nloc = xo ? (int)(gridDim.x >> 3) : (int)gridDim.x, j0 = xo ? (int)(blockIdx.x >> 3) : (int)blockIdx.x;
    const int lim = xo ? 16 * 8 : 128 * 8;
    RegSet r0, r1;
    for (int L = j0; L < lim; L += nloc) {
        const int tm = xo ? xcd * 16 + (L & 15) : (L >> 3), tn = xo ? (L >> 4) : (L & 7);
        const int L2 = L + nloc; const bool has_next = L2 < lim;
        const int ntm = has_next ? (xo ? xcd * 16 + (L2 & 15) : (L2 >> 3)) : tm, ntn = has_next ? (xo ? (L2 >> 4) : (L2 & 7)) : tn;
        f32x4 acc[4][4];
        gemm_tile(mix, WoutT, tm, tn, L == j0, has_next, ntm, ntn, sm, acc, r0, r1);
#pragma unroll
        for (int mt = 0; mt < 4; ++mt)
#pragma unroll
            for (int nt = 0; nt < 4; ++nt) { u32x2 pk; pk.x = pack2(acc[mt][nt][0], acc[mt][nt][1]); pk.y = pack2(acc[mt][nt][2], acc[mt][nt][3]);
                const int row = wm * 64 + mt * 16 + r16; const int c16 = wn * 8 + nt * 2 + (quad >> 1);
                *(u32x2*)(sC + row * 256 + ((c16 ^ (row & 15)) << 4) + (quad & 1) * 8) = pk; }
        __syncthreads();
#pragma unroll
        for (int i = 0; i < 8; ++i) { const int c = t + 256 * i; const int row = c >> 4, ch = c & 15;
            *(u32x4*)(ybuf + (size_t)(tm * 128 + row) * 1024 + tn * 128 + ch * 8) = *(const u32x4*)(sC + row * 256 + ((ch ^ (row & 15)) << 4)); }
    }
}

constexpr float ATT_SC = 0.18033688011112042f;
template <int QT>
__device__ __forceinline__ void attn_tile(const bf16_t* sK, const bf16_t* sV, const bf16x8 (&qf)[QT][2], int lo, int hi, bool full, bool hasq, bool qfl0, bool qfl1,
                                          float (&m)[QT], float (&l)[QT], f32x4 (&O)[QT][4], int wq0) {
    const int lane = tid_opq() & 63, r16 = lane & 15, quad = lane >> 4;
    f32x4 s[QT][4];
#pragma unroll
    for (int a = 0; a < QT; ++a)
#pragma unroll
        for (int b = 0; b < 4; ++b) s[a][b] = (f32x4){0.f, 0.f, 0.f, 0.f};
#pragma unroll
    for (int ks = 0; ks < 2; ++ks)
#pragma unroll
        for (int k16 = 0; k16 < 4; ++k16) {
            const bf16x8 kf = *(const bf16x8*)(sK + (k16 * 16 + r16) * LDP + ks * 32 + quad * 8);
#pragma unroll
            for (int qt = 0; qt < QT; ++qt) s[qt][k16] = __builtin_amdgcn_mfma_f32_16x16x32_bf16(kf, qf[qt][ks], s[qt][k16], 0, 0, 0);
        }
#pragma unroll
    for (int qt = 0; qt < QT; ++qt) {
        const int ql = wq0 + qt * 16 + r16; const bool qfl = qt ? qfl1 : qfl0;
        if (!full) {
#pragma unroll
            for (int k16 = 0; k16 < 4; ++k16)
#pragma unroll
                for (int j = 0; j < 4; ++j) { const int dd = ql - (k16 * 16 + quad * 4 + j); const bool valid = dd >= lo && dd <= hi; s[qt][k16][j] = valid ? s[qt][k16][j] : -1e30f; }
        }
        if (hasq) {
#pragma unroll
            for (int k16 = 0; k16 < 4; ++k16)
#pragma unroll
                for (int j = 0; j < 4; ++j) s[qt][k16][j] = qfl ? s[qt][k16][j] : -1e30f;
        }
        float mx = -1e30f;
#pragma unroll
        for (int k16 = 0; k16 < 4; ++k16) mx = fmaxf(mx, fmaxf(fmaxf(s[qt][k16][0], s[qt][k16][1]), fmaxf(s[qt][k16][2], s[qt][k16][3])));
        mx = fmaxf(mx, __shfl_xor(mx, 16)); mx = fmaxf(mx, __shfl_xor(mx, 32));
        const float mn = fmaxf(m[qt], mx); const float alpha = __builtin_amdgcn_exp2f((m[qt] - mn) * ATT_SC); m[qt] = mn;
        const float mb = (mn < -1e29f) ? 0.f : mn * ATT_SC;
        float ps = 0.f;
#pragma unroll
        for (int k16 = 0; k16 < 4; ++k16)
#pragma unroll
            for (int j = 0; j < 4; ++j) { const float pv = __builtin_amdgcn_exp2f(s[qt][k16][j] * ATT_SC - mb); ps += pv; s[qt][k16][j] = pv; }
        l[qt] = l[qt] * alpha + ps;
#pragma unroll
        for (int dt = 0; dt < 4; ++dt) O[qt][dt] = O[qt][dt] * alpha;
    }
#pragma unroll
    for (int G = 0; G < 2; ++G) {
        bf16x8 pf[QT];
#pragma unroll
        for (int qt = 0; qt < QT; ++qt) {
            const unsigned a0 = pack2(s[qt][G * 2][0], s[qt][G * 2][1]), a1 = pack2(s[qt][G * 2][2], s[qt][G * 2][3]);
            const unsigned a2 = pack2(s[qt][G * 2 + 1][0], s[qt][G * 2 + 1][1]), a3 = pack2(s[qt][G * 2 + 1][2], s[qt][G * 2 + 1][3]);
            u32x4 pk = {a0, a1, a2, a3}; pf[qt] = __builtin_bit_cast(bf16x8, pk);
        }
#pragma unroll
        for (int dt = 0; dt < 4; ++dt) {
            const bf16_t* v0p = sV + (G * 32 + quad * 4 + (r16 >> 2)) * LDP + dt * 16 + (r16 & 3) * 4;
            const bf16x4 v0 = __builtin_amdgcn_ds_read_tr16_b64_v4i16((__attribute__((address_space(3))) bf16x4*)(v0p));
            const bf16x4 v1 = __builtin_amdgcn_ds_read_tr16_b64_v4i16((__attribute__((address_space(3))) bf16x4*)(v0p + 16 * LDP));
            const bf16x8 vf = {v0[0], v0[1], v0[2], v0[3], v1[0], v1[1], v1[2], v1[3]};
#pragma unroll
            for (int qt = 0; qt < QT; ++qt) O[qt][dt] = __builtin_amdgcn_mfma_f32_16x16x32_bf16(vf, pf[qt], O[qt][dt], 0, 0, 0);
        }
    }
}

__device__ void attn_item(const Params& p, int kind, int idx, char* smem) {
    const int t = tid_opq(), lane = t & 63, w = t >> 6, r16 = lane & 15, quad = lane >> 4;
    bf16_t* sK = (bf16_t*)smem; bf16_t* sV = sK + 64 * LDP;
    float* kmean = (float*)(smem + 18432); float* gates = (float*)(smem + 22528); unsigned* selm = (unsigned*)(smem + 30720);
    int4* desc = (int4*)(smem + 31232); int* misc = (int*)(smem + 32320);
    const bf16_t* z = (const bf16_t*)(p.ws + WS_Z);
    int b, h, qbase, stride, qcol, kcol, vcol, cfg = 0;
    __syncthreads();
    if (kind == 0) {
        const int n = 15 - (idx >> 5); const int rem = idx & 31; b = rem >> 3; h = (rem >> 1) & 3; const int qh = rem & 1;
        qbase = b * S + n * 256 + qh * 128; stride = 1; qcol = C_AQ + h * 64; kcol = C_AK + h * 64; vcol = C_AV + h * 64;
        const float* kpart = (const float*)(p.ws + WS_KPART);
        for (int e = t; e < n * 64; e += 256) { const int j = e >> 6, d = e & 63; const float* kp = kpart + (size_t)(b * 64 + j * 4) * 256 + h * 64 + d;
            kmean[e] = ((kp[0] + kp[256]) + (kp[512] + kp[768])) * (1.f / 256.f); }
        if (t == 0) misc[1] = 0;
        __syncthreads();
        {
            const int ql = t >> 1, half = t & 1; const bf16_t* qp = z + (size_t)(qbase + ql) * ZP + qcol;
            float g[8];
#pragma unroll
            for (int jj = 0; jj < 8; ++jj) g[jj] = 0.f;
#pragma unroll 1
            for (int dc = 0; dc < 8; ++dc) {
                const u32x4 qv = *(const u32x4*)(qp + dc * 8); float qq[8];
#pragma unroll
                for (int e = 0; e < 4; ++e) { qq[2 * e] = __uint_as_float(qv[e] << 16); qq[2 * e + 1] = __uint_as_float(qv[e] & 0xffff0000u); }
#pragma unroll
                for (int jj = 0; jj < 8; ++jj) { const int j = half + 2 * jj; if (j < n) { const float* km = kmean + j * 64 + dc * 8;
#pragma unroll
                    for (int e = 0; e < 8; ++e) g[jj] += qq[e] * km[e]; } }
            }
#pragma unroll
            for (int jj = 0; jj < 8; ++jj) gates[ql * 16 + half + 2 * jj] = g[jj];
        }
        __syncthreads();
        if (t < 128) {
            unsigned msk = 0;
            for (int k = 0; k < 3 && k < n; ++k) { float best = -3.0e38f; int bi = -1;
                for (int j = 0; j < n; ++j) if (!((msk >> j) & 1u)) { const float gv = gates[t * 16 + j]; if (gv > best) { best = gv; bi = j; } }
                if (bi >= 0) msk |= 1u << bi; }
            selm[t] = msk; atomicOr((unsigned*)&misc[1], msk);
        }
        __syncthreads();
        if (t == 0) {
            int nd = 0; const unsigned bm = (unsigned)misc[1];
            for (int kt = 0; kt <= qh * 2 + 1; ++kt) desc[nd++] = make_int4(b * S + n * 256 + kt * 64, kt * 64 - qh * 128, BIG, -1);
            for (int j = 0; j < n; ++j) if ((bm >> j) & 1u) for (int kt = 0; kt < 4; ++kt) desc[nd++] = make_int4(b * S + j * 256 + kt * 64, -BIG, BIG, j);
            misc[0] = nd;
        }
    } else {
        cfg = idx >> 9; const int rem = idx & 511; b = rem >> 7; h = (rem >> 5) & 3; const int rb = rem & 31;
        const int dil = 1 << (2 * cfg); const int res = rb & (dil - 1), blk = rb >> (2 * cfg);
        qbase = b * S + blk * 128 * dil + res; stride = dil; qcol = C_CQ + h * 64; kcol = C_CK + h * 64; vcol = C_CV + h * 64;
        if (t < 128) selm[t] = 0xffffffffu;
        if (t == 0) { int nd = 0; for (int kt = (blk == 0 ? 2 : 0); kt < 4; ++kt) desc[nd++] = make_int4(b * S + (blk * 128 - 128 + kt * 64) * dil + res, kt * 64 - 128, kt * 64, -1); misc[0] = nd; }
    }
    __syncthreads();
    const int nd = misc[0];
    bf16x8 qf[2][2];
#pragma unroll
    for (int qt = 0; qt < 2; ++qt)
#pragma unroll
        for (int ks = 0; ks < 2; ++ks) qf[qt][ks] = *(const bf16x8*)(z + (size_t)(qbase + (w * 32 + qt * 16 + r16) * stride) * ZP + qcol + ks * 32 + quad * 8);
    const unsigned sel0 = selm[w * 32 + r16], sel1 = selm[w * 32 + 16 + r16];
    float m[2] = {-1e30f, -1e30f}, l[2] = {0.f, 0.f}; f32x4 O[2][4];
#pragma unroll
    for (int a = 0; a < 2; ++a)
#pragma unroll
        for (int c = 0; c < 4; ++c) O[a][c] = (f32x4){0.f, 0.f, 0.f, 0.f};
    const int lrow = t >> 2, lch = (t & 3) * 2;
    u32x4 rk0, rk1, rv0, rv1;
    if (nd > 0) { const int4 d = desc[0]; const bf16_t* rp = z + (size_t)(d.x + lrow * stride) * ZP + lch * 8;
        rk0 = *(const u32x4*)(rp + kcol); rk1 = *(const u32x4*)(rp + kcol + 8); rv0 = *(const u32x4*)(rp + vcol); rv1 = *(const u32x4*)(rp + vcol + 8); }
    for (int i = 0; i < nd; ++i) {
        __syncthreads();
        *(u32x4*)(sK + lrow * LDP + lch * 8) = rk0; *(u32x4*)(sK + lrow * LDP + lch * 8 + 8) = rk1;
        *(u32x4*)(sV + lrow * LDP + lch * 8) = rv0; *(u32x4*)(sV + lrow * LDP + lch * 8 + 8) = rv1;
        __syncthreads();
        if (i + 1 < nd) { const int4 d = desc[i + 1]; const bf16_t* rp = z + (size_t)(d.x + lrow * stride) * ZP + lch * 8;
            rk0 = *(const u32x4*)(rp + kcol); rk1 = *(const u32x4*)(rp + kcol + 8); rv0 = *(const u32x4*)(rp + vcol); rv1 = *(const u32x4*)(rp + vcol + 8); }
        const int4 d = desc[i];
        bool need = (w * 32 + 31 >= d.y) && (w * 32 - 63 <= d.z);
        bool q0 = true, q1 = true;
        if (d.w >= 0) { q0 = (sel0 >> d.w) & 1u; q1 = (sel1 >> d.w) & 1u; need = need && (__ballot(q0 || q1) != 0ull); }
        const bool full = (w * 32 - 63 >= d.y) && (w * 32 + 31 <= d.z);
        if (need) attn_tile<2>(sK, sV, qf, d.y, d.z, full, d.w >= 0, q0, q1, m, l, O, w * 32);
    }
#pragma unroll
    for (int qt = 0; qt < 2; ++qt) {
        float lt = l[qt]; lt += __shfl_xor(lt, 16); lt += __shfl_xor(lt, 32);
        const float inv = 1.f / lt; const size_t tok = (size_t)(qbase + (w * 32 + qt * 16 + r16) * stride);
        if (kind == 0) {
            bf16_t* mix = (bf16_t*)(p.ws + WS_U);
#pragma unroll
            for (int dt = 0; dt < 4; ++dt) { const int d0 = dt * 16 + quad * 4; const u32x2 gv = *(const u32x2*)(z + tok * ZP + C_AG + h * 64 + d0);
                const float g0 = __uint_as_float(gv.x << 16), g1 = __uint_as_float(gv.x & 0xffff0000u), g2 = __uint_as_float(gv.y << 16), g3 = __uint_as_float(gv.y & 0xffff0000u);
                u32x2 o; o.x = pack2(O[qt][dt][0] * inv * silu_f(g0), O[qt][dt][1] * inv * silu_f(g1)); o.y = pack2(O[qt][dt][2] * inv * silu_f(g2), O[qt][dt][3] * inv * silu_f(g3));
                *(u32x2*)(mix + tok * 1024 + h * 64 + d0) = o; }
        } else {
            bf16_t* dilo = (bf16_t*)(p.ws + WS_DILO); float* dill = (float*)(p.ws + WS_DILL);
#pragma unroll
            for (int dt = 0; dt < 4; ++dt) { const int d0 = dt * 16 + quad * 4; u32x2 o; o.x = pack2(O[qt][dt][0] * inv, O[qt][dt][1] * inv); o.y = pack2(O[qt][dt][2] * inv, O[qt][dt][3] * inv);
                *(u32x2*)(dilo + ((size_t)cfg * T + tok) * 256 + h * 64 + d0) = o; }
            if (quad == 0) dill[((size_t)cfg * T + tok) * 4 + h] = m[qt] * 0.125f + __logf(lt);
        }
    }
}

__device__ void moba_item(const Params& p, int idx, char* smem, bf16_t* outp) {
    const int t = tid_opq(), lane = t & 63, w = t >> 6, r16 = lane & 15, quad = lane >> 4;
    bf16_t* sK = (bf16_t*)smem; bf16_t* sV = sK + 64 * LDP;
    float* stO = (float*)(smem + 18432);
    float* kmean = (float*)(smem + 18432); float* gates = (float*)(smem + 22528);
    float* stM = (float*)(smem + 53248); float* stL = (float*)(smem + 53760);
    unsigned* selm = (unsigned*)(smem + 54272); unsigned char* lists = (unsigned char*)(smem + 54784);
    int* cnt = (int*)(smem + 56832); int4* desc = (int4*)(smem + 56960); int* misc = (int*)(smem + 59008);
    const bf16_t* z = (const bf16_t*)(p.ws + WS_Z);
    const int n = 15 - (idx >> 5); const int rem = idx & 31; const int b = rem >> 3, h = (rem >> 1) & 3, qh = rem & 1;
    const int qbase = b * S + n * 256 + qh * 128, qcol = C_AQ + h * 64, kcol = C_AK + h * 64, vcol = C_AV + h * 64;
    __syncthreads();
    {
        const float* kpart = (const float*)(p.ws + WS_KPART);
        for (int e = t; e < n * 64; e += 256) { const int j = e >> 6, d = e & 63; const float* kp = kpart + (size_t)(b * 64 + j * 4) * 256 + h * 64 + d;
            kmean[e] = ((kp[0] + kp[256]) + (kp[512] + kp[768])) * (1.f / 256.f); }
        if (t < 16) cnt[t] = 0;
        __syncthreads();
        {
            const int ql = t >> 1, half = t & 1; const bf16_t* qp = z + (size_t)(qbase + ql) * ZP + qcol;
            float g[8];
#pragma unroll
            for (int jj = 0; jj < 8; ++jj) g[jj] = 0.f;
#pragma unroll 1
            for (int dc = 0; dc < 8; ++dc) {
                const u32x4 qv = *(const u32x4*)(qp + dc * 8); float qq[8];
#pragma unroll
                for (int e = 0; e < 4; ++e) { qq[2 * e] = __uint_as_float(qv[e] << 16); qq[2 * e + 1] = __uint_as_float(qv[e] & 0xffff0000u); }
#pragma unroll
                for (int jj = 0; jj < 8; ++jj) { const int j = half + 2 * jj; if (j < n) { const float* km = kmean + j * 64 + dc * 8;
#pragma unroll
                    for (int e = 0; e < 8; ++e) g[jj] += qq[e] * km[e]; } }
            }
#pragma unroll
            for (int jj = 0; jj < 8; ++jj) gates[ql * 16 + half + 2 * jj] = g[jj];
        }
        __syncthreads();
        if (t < 128) {
            unsigned msk = 0;
            for (int k = 0; k < 3 && k < n; ++k) { float best = -3.0e38f; int bi = -1;
                for (int j = 0; j < n; ++j) if (!((msk >> j) & 1u)) { const float gv = gates[t * 16 + j]; if (gv > best) { best = gv; bi = j; } }
                if (bi >= 0) msk |= 1u << bi; }
            selm[t] = msk;
            for (int j = 0; j < n; ++j) if ((msk >> j) & 1u) { const int pos = atomicAdd(&cnt[j], 1); lists[j * 128 + pos] = (unsigned char)t; }
        }
        __syncthreads();
        if (t < 128) { for (int j = 0; j < n; ++j) { const int cj = cnt[j]; if (t >= cj && t < ((cj + 15) & ~15)) lists[j * 128 + t] = 255; } }
        if (t == 0) {
            int nd = 0;
            for (int kt = 0; kt <= qh * 2 + 1; ++kt) desc[nd++] = make_int4(b * S + n * 256 + kt * 64, kt * 64 - qh * 128, BIG, -1);
            misc[1] = nd;
            for (int j = 0; j < n; ++j) { const int ntl = (cnt[j] + 15) >> 4;
                for (int ps = 0; ps * 4 < ntl; ++ps) for (int kt = 0; kt < 4; ++kt) desc[nd++] = make_int4(b * S + j * 256 + kt * 64, ps, kt, j); }
            misc[0] = nd;
        }
    }
    __syncthreads();
    const int nd = misc[0], nown = misc[1];
    const int lrow = t >> 2, lch = (t & 3) * 2;
    u32x4 rk0, rk1, rv0, rv1;
    { const int4 d = desc[0]; const bf16_t* rp = z + (size_t)(d.x + lrow) * ZP + lch * 8;
      rk0 = *(const u32x4*)(rp + kcol); rk1 = *(const u32x4*)(rp + kcol + 8); rv0 = *(const u32x4*)(rp + vcol); rv1 = *(const u32x4*)(rp + vcol + 8); }
    bf16x8 nqf[2]; int ngq = 0; bool ngv = false, nhas = false;
    auto prefetch_group = [&](int gi) {
        nhas = false;
        if (gi < nd) { const int4 dg = desc[gi]; const int slot = dg.y * 4 + w; nhas = slot * 16 < cnt[dg.w];
            if (nhas) { const int qi = lists[dg.w * 128 + slot * 16 + r16]; ngv = qi != 255; ngq = ngv ? qi : 0;
#pragma unroll
                for (int ks = 0; ks < 2; ++ks) nqf[ks] = *(const bf16x8*)(z + (size_t)(qbase + ngq) * ZP + qcol + ks * 32 + quad * 8); } }
    };
    prefetch_group(nown);
    {
        bf16x8 qf[2][2];
#pragma unroll
        for (int qt = 0; qt < 2; ++qt)
#pragma unroll
            for (int ks = 0; ks < 2; ++ks) qf[qt][ks] = *(const bf16x8*)(z + (size_t)(qbase + w * 32 + qt * 16 + r16) * ZP + qcol + ks * 32 + quad * 8);
        float m[2] = {-1e30f, -1e30f}, l[2] = {0.f, 0.f}; f32x4 O[2][4];
#pragma unroll
        for (int a = 0; a < 2; ++a)
#pragma unroll
            for (int c = 0; c < 4; ++c) O[a][c] = (f32x4){0.f, 0.f, 0.f, 0.f};
        for (int i = 0; i < nown; ++i) {
            __syncthreads();
            *(u32x4*)(sK + lrow * LDP + lch * 8) = rk0; *(u32x4*)(sK + lrow * LDP + lch * 8 + 8) = rk1;
            *(u32x4*)(sV + lrow * LDP + lch * 8) = rv0; *(u32x4*)(sV + lrow * LDP + lch * 8 + 8) = rv1;
            __syncthreads();
            if (i + 1 < nd) { const int4 d = desc[i + 1]; const bf16_t* rp = z + (size_t)(d.x + lrow) * ZP + lch * 8;
                rk0 = *(const u32x4*)(rp + kcol); rk1 = *(const u32x4*)(rp + kcol + 8); rv0 = *(const u32x4*)(rp + vcol); rv1 = *(const u32x4*)(rp + vcol + 8); }
            const int4 d = desc[i];
            const bool need = (w * 32 + 31 >= d.y) && (w * 32 - 63 <= d.z);
            const bool full = (w * 32 - 63 >= d.y) && (w * 32 + 31 <= d.z);
            if (need) attn_tile<2>(sK, sV, qf, d.y, d.z, full, false, true, true, m, l, O, w * 32);
        }
#pragma unroll
        for (int qt = 0; qt < 2; ++qt) {
            float lt = l[qt]; lt += __shfl_xor(lt, 16); lt += __shfl_xor(lt, 32);
            const int ql = w * 32 + qt * 16 + r16;
            if (quad == 0) { stM[ql] = m[qt]; stL[ql] = lt; }
#pragma unroll
            for (int dt = 0; dt < 4; ++dt) *(f32x4*)(stO + ql * 68 + dt * 16 + quad * 4) = O[qt][dt];
        }
    }
    {
        bf16x8 qf[1][2]; float m[1] = {-1e30f}, l[1] = {0.f}; f32x4 O[1][4];
        int gq = 0; bool gv = false, has = false;
        for (int i = nown; i < nd; ++i) {
            __syncthreads();
            *(u32x4*)(sK + lrow * LDP + lch * 8) = rk0; *(u32x4*)(sK + lrow * LDP + lch * 8 + 8) = rk1;
            *(u32x4*)(sV + lrow * LDP + lch * 8) = rv0; *(u32x4*)(sV + lrow * LDP + lch * 8 + 8) = rv1;
            __syncthreads();
            if (i + 1 < nd) { const int4 d = desc[i + 1]; const bf16_t* rp = z + (size_t)(d.x + lrow) * ZP + lch * 8;
                rk0 = *(const u32x4*)(rp + kcol); rk1 = *(const u32x4*)(rp + kcol + 8); rv0 = *(const u32x4*)(rp + vcol); rv1 = *(const u32x4*)(rp + vcol + 8); }
            const int4 d = desc[i];
            if (d.z == 0) {
                has = nhas; gv = ngv; gq = ngq; qf[0][0] = nqf[0]; qf[0][1] = nqf[1];
                m[0] = -1e30f; l[0] = 0.f;
#pragma unroll
                for (int c = 0; c < 4; ++c) O[0][c] = (f32x4){0.f, 0.f, 0.f, 0.f};
                prefetch_group(i + 4);
            }
            if (has) {
                attn_tile<1>(sK, sV, qf, -BIG, BIG, true, false, true, true, m, l, O, 0);
                if (d.z == 3) {
                    float lt = l[0]; lt += __shfl_xor(lt, 16); lt += __shfl_xor(lt, 32);
                    if (gv) {
                        const float mo = stM[gq], lo_ = stL[gq]; const float mn = fmaxf(mo, m[0]);
                        const float fa = __builtin_amdgcn_exp2f((mo - mn) * ATT_SC), fb = __builtin_amdgcn_exp2f((m[0] - mn) * ATT_SC);
#pragma unroll
                        for (int dt = 0; dt < 4; ++dt) { float* sp = stO + gq * 68 + dt * 16 + quad * 4; const f32x4 so = *(const f32x4*)sp; *(f32x4*)sp = so * fa + O[0][dt] * fb; }
                        if (quad == 0) { stM[gq] = mn; stL[gq] = lo_ * fa + lt * fb; }
                    }
                }
            }
        }
    }
    __syncthreads();
#pragma unroll
    for (int qt = 0; qt < 2; ++qt) {
        const int ql = w * 32 + qt * 16 + r16; const float inv = 1.f / stL[ql]; const size_t tok = (size_t)(qbase + ql);
#pragma unroll
        for (int dt = 0; dt < 4; ++dt) { const int d0 = dt * 16 + quad * 4; const f32x4 ov = *(const f32x4*)(stO + ql * 68 + d0);
            const u32x2 gvv = *(const u32x2*)(z + tok * ZP + C_AG + h * 64 + d0);
            const float g0 = __uint_as_float(gvv.x << 16), g1 = __uint_as_float(gvv.x & 0xffff0000u), g2 = __uint_as_float(gvv.y << 16), g3 = __uint_as_float(gvv.y & 0xffff0000u);
            u32x2 o; o.x = pack2(ov[0] * inv * silu_f(g0), ov[1] * inv * silu_f(g1)); o.y = pack2(ov[2] * inv * silu_f(g2), ov[3] * inv * silu_f(g3));
            *(u32x2*)(outp + tok * 1024 + h * 64 + d0) = o; }
    }
}

__device__ __forceinline__ void gla_bcum(const Params& p, int l, const bf16_t* z, int tok0, float* bc, float* drs) {
    const int t = tid_opq();
    const int hd = t & 127, ih = t >> 7;
    float wr[16];
#pragma unroll
    for (int r = 0; r < 16; ++r) wr[r] = p.gla_wr[l * 2048 + r * 128 + hd];
    const float br = p.gla_br[l * 128 + hd];
    { const int e0 = t, e1 = t + 256; const bf16_t d0 = z[(size_t)(tok0 + (e0 >> 4)) * ZP + C_DR + (e0 & 15)], d1 = z[(size_t)(tok0 + (e1 >> 4)) * ZP + C_DR + (e1 & 15)];
      drs[e0] = bf2f(d0); drs[e1] = bf2f(d1); }
    __syncthreads();
#pragma unroll
    for (int ii = 0; ii < 16; ++ii) { const int i = ih * 16 + ii; float x = br;
#pragma unroll
        for (int r4 = 0; r4 < 4; ++r4) { const f32x4 dv = *(const f32x4*)(drs + i * 16 + r4 * 4); x += (dv[0] * wr[r4 * 4] + dv[1] * wr[r4 * 4 + 1]) + (dv[2] * wr[r4 * 4 + 2] + dv[3] * wr[r4 * 4 + 3]); }
        bc[i * 128 + hd] = (fminf(x, 0.f) - __logf(1.f + __expf(-fabsf(x)))) * (1.f / 16.f); }
    __syncthreads();
    if (t < 128) { float sacc = 0.f;
#pragma unroll
        for (int i = 0; i < 32; ++i) { sacc += bc[i * 128 + t]; bc[i * 128 + t] = sacc; } }
    __syncthreads();
}

__device__ void gla1_item(const Params& p, int l, int idx, char* smem) {
    const int t = tid_opq(), lane = t & 63, w = t >> 6, r16 = lane & 15, quad = lane >> 4;
    const int b = idx >> 7, c = idx & 127; const int tok0 = b * S + c * 32;
    const bf16_t* z = (const bf16_t*)(p.ws + WS_Z);
    float* bc = (float*)smem; float* drs = (float*)(smem + 16384);
    bf16_t* kdT = (bf16_t*)(smem + 18432) + w * 1024;
    bf16_t* vL = (bf16_t*)(smem + 26624) + w * (32 * LDP);
    float* gkv = (float*)(p.ws + WS_GKV); float* gdec = (float*)(p.ws + WS_GDEC);
    bf16_t kraw[16]; u32x4 vr[4];
#pragma unroll
    for (int i = 0; i < 16; ++i) { const int e = lane + 64 * i; kraw[i] = z[(size_t)(tok0 + (e >> 5)) * ZP + C_DK + w * 32 + (e & 31)]; }
#pragma unroll
    for (int i = 0; i < 4; ++i) { const int cc = lane + 64 * i; vr[i] = *(const u32x4*)(z + (size_t)(tok0 + (cc >> 3)) * ZP + C_DV + w * 64 + (cc & 7) * 8); }
    __syncthreads();
#pragma unroll
    for (int i = 0; i < 4; ++i) { const int cc = lane + 64 * i; *(u32x4*)(vL + (cc >> 3) * LDP + (cc & 7) * 8) = vr[i]; }
    gla_bcum(p, l, z, tok0, bc, drs);
    { float* bcg = (float*)(p.ws + WS_BC) + (size_t)idx * 4096;
#pragma unroll
      for (int i = 0; i < 4; ++i) *(f32x4*)(bcg + (t + 256 * i) * 4) = *(const f32x4*)(bc + (t + 256 * i) * 4); }
#pragma unroll
    for (int i = 0; i < 16; ++i) { const int e = lane + 64 * i; const int j = e >> 5, d = e & 31;
        kdT[d * 32 + j] = f2bf(bf2f(kraw[i]) * __expf(bc[31 * 128 + w * 32 + d] - bc[j * 128 + w * 32 + d])); }
    const int bh = b * 4 + w;
    if (lane < 32) gdec[(bh * 128 + c) * 32 + lane] = __expf(bc[31 * 128 + w * 32 + lane]);
    __syncthreads();
    bf16x8 kf[2];
#pragma unroll
    for (int x = 0; x < 2; ++x) kf[x] = *(const bf16x8*)(kdT + (x * 16 + r16) * 32 + quad * 8);
    float* dst = gkv + (size_t)(bh * 128 + c) * 2048;
#pragma unroll
    for (int dt = 0; dt < 4; ++dt) {
        const bf16_t* v0p = vL + (quad * 8 + (r16 >> 2)) * LDP + dt * 16 + (r16 & 3) * 4;
        const bf16x4 v0 = __builtin_amdgcn_ds_read_tr16_b64_v4i16((__attribute__((address_space(3))) bf16x4*)(v0p));
        const bf16x4 v1 = __builtin_amdgcn_ds_read_tr16_b64_v4i16((__attribute__((address_space(3))) bf16x4*)(v0p + 4 * LDP));
        const bf16x8 vf = {v0[0], v0[1], v0[2], v0[3], v1[0], v1[1], v1[2], v1[3]};
#pragma unroll
        for (int x = 0; x < 2; ++x) {
            const f32x4 r = __builtin_amdgcn_mfma_f32_16x16x32_bf16(vf, kf[x], (f32x4){0.f, 0.f, 0.f, 0.f}, 0, 0, 0);
            *(f32x4*)(dst + (x * 16 + r16) * 64 + dt * 16 + quad * 4) = r;
        }
    }
}

#define OPQ(ptr) asm volatile("" : "+v"(ptr))
__device__ void gla3_item(const Params& p, int l, int idx, char* smem) {
    const int t = tid_opq(), lane = t & 63, w = t >> 6, r16 = lane & 15, quad = lane >> 4;
    const int b = idx >> 7, c = idx & 127; const int tok0 = b * S + c * 32;
    const bf16_t* z = (const bf16_t*)(p.ws + WS_Z); bf16_t* mix = (bf16_t*)(p.ws + WS_U);
    float* bc = (float*)smem; float* drs = (float*)(smem + 16384);
    bf16_t* SL = (bf16_t*)smem + w * (32 * LDP);
    bf16_t* qe = (bf16_t*)(smem + 18432) + w * 1024;
    bf16_t* ke = (bf16_t*)(smem + 26624) + w * 1024;
    bf16_t* vL = (bf16_t*)(smem + 34816) + w * (32 * LDP);
    const float* gkv = (const float*)(p.ws + WS_GKV);
    const int bh = b * 4 + w;
    bf16_t qraw[16], kraw[16];
    { const bf16_t* qp = z + (size_t)(tok0 + (lane >> 5)) * ZP + w * 32 + (lane & 31);
#pragma unroll
      for (int i = 0; i < 16; ++i) { qraw[i] = qp[C_DQ]; kraw[i] = qp[C_DK]; qp += 2 * ZP; OPQ(qp); } }
    u32x4 vr[4]; f32x4 sr[8];
#pragma unroll
    for (int i = 0; i < 4; ++i) { const int cc = lane + 64 * i; vr[i] = *(const u32x4*)(z + (size_t)(tok0 + (cc >> 3)) * ZP + C_DV + w * 64 + (cc & 7) * 8); }
    { const float* Sp = gkv + (size_t)(bh * 128 + c) * 2048;
#pragma unroll
      for (int i = 0; i < 8; ++i) sr[i] = *(const f32x4*)(Sp + (lane + 64 * i) * 4); }
    f32x4 bcr[4];
    { const float* bcg = (const float*)(p.ws + WS_BC) + (size_t)idx * 4096;
#pragma unroll
      for (int i = 0; i < 4; ++i) bcr[i] = *(const f32x4*)(bcg + (t + 256 * i) * 4); }
    __syncthreads();
#pragma unroll
    for (int i = 0; i < 4; ++i) { const int cc = lane + 64 * i; *(u32x4*)(vL + (cc >> 3) * LDP + (cc & 7) * 8) = vr[i]; }
#pragma unroll
    for (int i = 0; i < 4; ++i) *(f32x4*)(bc + (t + 256 * i) * 4) = bcr[i];
    __syncthreads();
#pragma unroll
    for (int i2 = 0; i2 < 16; ++i2) { const int e = lane + 64 * i2; const int i = e >> 5, d = e & 31; const float bcv = bc[i * 128 + w * 32 + d];
        qe[i * 32 + d] = f2bf(bf2f(qraw[i2]) * __expf(bcv) * 0.17677669529663687f); ke[i * 32 + d] = f2bf(bf2f(kraw[i2]) * __expf(-bcv)); }
    __syncthreads();
#pragma unroll
    for (int i = 0; i < 8; ++i) { const int cc = lane + 64 * i; const int d = cc >> 4, v4 = cc & 15; u32x2 pk; pk.x = pack2(sr[i][0], sr[i][1]); pk.y = pack2(sr[i][2], sr[i][3]);
        *(u32x2*)(SL + d * LDP + v4 * 4) = pk; }
    __syncthreads();
    bf16x8 qf[2], kf[2];
#pragma unroll
    for (int x = 0; x < 2; ++x) { qf[x] = *(const bf16x8*)(qe + (x * 16 + r16) * 32 + quad * 8); kf[x] = *(const bf16x8*)(ke + (x * 16 + r16) * 32 + quad * 8); }
    bf16x8 pf[2];
#pragma unroll
    for (int it = 0; it < 2; ++it) {
        f32x4 at[2];
#pragma unroll
        for (int jt = 0; jt < 2; ++jt) { at[jt] = __builtin_amdgcn_mfma_f32_16x16x32_bf16(kf[jt], qf[it], (f32x4){0.f, 0.f, 0.f, 0.f}, 0, 0, 0);
#pragma unroll
            for (int jj = 0; jj < 4; ++jj) at[jt][jj] = (jt * 16 + quad * 4 + jj <= it * 16 + r16) ? at[jt][jj] : 0.f; }
        u32x4 pk = {pack2(at[0][0], at[0][1]), pack2(at[0][2], at[0][3]), pack2(at[1][0], at[1][1]), pack2(at[1][2], at[1][3])};
        pf[it] = __builtin_bit_cast(bf16x8, pk);
    }
    f32x4 O[2][4];
#pragma unroll
    for (int dt = 0; dt < 4; ++dt) {
        const bf16_t* v0p = vL + (quad * 4 + (r16 >> 2)) * LDP + dt * 16 + (r16 & 3) * 4;
        const bf16x4 v0 = __builtin_amdgcn_ds_read_tr16_b64_v4i16((__attribute__((address_space(3))) bf16x4*)(v0p));
        const bf16x4 v1 = __builtin_amdgcn_ds_read_tr16_b64_v4i16((__attribute__((address_space(3))) bf16x4*)(v0p + 16 * LDP));
        const bf16x8 vf = {v0[0], v0[1], v0[2], v0[3], v1[0], v1[1], v1[2], v1[3]};
        const bf16_t* s0p = SL + (quad * 8 + (r16 >> 2)) * LDP + dt * 16 + (r16 & 3) * 4;
        const bf16x4 s0 = __builtin_amdgcn_ds_read_tr16_b64_v4i16((__attribute__((address_space(3))) bf16x4*)(s0p));
        const bf16x4 s1 = __builtin_amdgcn_ds_read_tr16_b64_v4i16((__attribute__((address_space(3))) bf16x4*)(s0p + 4 * LDP));
        const bf16x8 sf = {s0[0], s0[1], s0[2], s0[3], s1[0], s1[1], s1[2], s1[3]};
#pragma unroll
        for (int it = 0; it < 2; ++it) {
            O[it][dt] = __builtin_amdgcn_mfma_f32_16x16x32_bf16(vf, pf[it], (f32x4){0.f, 0.f, 0.f, 0.f}, 0, 0, 0);
            O[it][dt] = __builtin_amdgcn_mfma_f32_16x16x32_bf16(sf, qf[it], O[it][dt], 0, 0, 0);
        }
    }
#pragma unroll
    for (int it = 0; it < 2; ++it) {
        float ss = 0.f;
#pragma unroll
        for (int dt = 0; dt < 4; ++dt) ss += (O[it][dt][0] * O[it][dt][0] + O[it][dt][1] * O[it][dt][1]) + (O[it][dt][2] * O[it][dt][2] + O[it][dt][3] * O[it][dt][3]);
        ss += __shfl_xor(ss, 16); ss += __shfl_xor(ss, 32);
        const float rn = rsqrtf(ss * (1.f / 64.f) + 1e-5f);
        const size_t tok = (size_t)(tok0 + it * 16 + r16);
#pragma unroll
        for (int dt = 0; dt < 4; ++dt) { const int v0i = dt * 16 + quad * 4; const f32x4 gn = *(const f32x4*)(p.gla_gn + l * 64 + v0i);
            const u32x2 gv = *(const u32x2*)(z + tok * ZP + C_DG + w * 64 + v0i);
            const float g0 = __uint_as_float(gv.x << 16), g1 = __uint_as_float(gv.x & 0xffff0000u), g2 = __uint_as_float(gv.y << 16), g3 = __uint_as_float(gv.y & 0xffff0000u);
            u32x2 o; o.x = pack2(O[it][dt][0] * rn * gn[0] * silu_f(g0), O[it][dt][1] * rn * gn[1] * silu_f(g1));
            o.y = pack2(O[it][dt][2] * rn * gn[2] * silu_f(g2), O[it][dt][3] * rn * gn[3] * silu_f(g3));
            *(u32x2*)(mix + tok * 1024 + 768 + w * 64 + v0i) = o; }
    }
}

__device__ void lru1_item(const Params& p, int l, int idx, char* smem) {
    const int t = tid_opq(), lane = t & 63, g = t >> 6, r16 = lane & 15, quad = lane >> 4; const int ch = t;
    const int b = idx >> 7, c = idx & 127; const int s0 = c * 32; const int tok0 = b * S + s0;
    const bf16_t* z = (const bf16_t*)(p.ws + WS_Z); float* xcs = (float*)smem;
    bf16_t* preA = (bf16_t*)(smem + 32768); bf16_t* preX = (bf16_t*)(smem + 49152);
    float* lh = (float*)(p.ws + WS_LH); float* lp = (float*)(p.ws + WS_LP);
    bf16_t xr[35];
#pragma unroll
    for (int i = 0; i < 35; ++i) { const int sidx = s0 + i - 3; xr[i] = (sidx >= 0) ? z[(size_t)(tok0 + i - 3) * ZP + C_BX + ch] : (bf16_t)0; }
    const float cw0 = p.conv_w[l * 1024 + ch], cw1 = p.conv_w[l * 1024 + 256 + ch], cw2 = p.conv_w[l * 1024 + 512 + ch], cw3 = p.conv_w[l * 1024 + 768 + ch];
    const float cb = p.conv_b[l * 256 + ch];
    const bf16_t* lwt = (const bf16_t*)(p.ws + WS_LWT) + (size_t)l * 32768 + g * 4096;
    bf16x8 wfa[4][2], wfx[4][2];
#pragma unroll
    for (int nt = 0; nt < 4; ++nt)
#pragma unroll
        for (int ks = 0; ks < 2; ++ks) { wfa[nt][ks] = *(const bf16x8*)(lwt + (nt * 16 + r16) * 64 + ks * 32 + quad * 8); wfx[nt][ks] = *(const bf16x8*)(lwt + 16384 + (nt * 16 + r16) * 64 + ks * 32 + quad * 8); }
    __syncthreads();
#pragma unroll
    for (int i = 0; i < 32; ++i) xcs[i * 256 + ch] = cb + (cw0 * bf2f(xr[i]) + cw1 * bf2f(xr[i + 1])) + (cw2 * bf2f(xr[i + 2]) + cw3 * bf2f(xr[i + 3]));
    __syncthreads();
#pragma unroll
    for (int tt = 0; tt < 2; ++tt) {
        bf16x8 xf[2];
#pragma unroll
        for (int ks = 0; ks < 2; ++ks) { const float* xp = xcs + (tt * 16 + r16) * 256 + g * 64 + ks * 32 + quad * 8; const f32x4 x0 = *(const f32x4*)xp, x1 = *(const f32x4*)(xp + 4);
            u32x4 pk = {pack2(x0[0], x0[1]), pack2(x0[2], x0[3]), pack2(x1[0], x1[1]), pack2(x1[2], x1[3])}; xf[ks] = __builtin_bit_cast(bf16x8, pk); }
#pragma unroll
        for (int nt = 0; nt < 4; ++nt) {
            f32x4 ra = __builtin_amdgcn_mfma_f32_16x16x32_bf16(wfa[nt][0], xf[0], (f32x4){0.f, 0.f, 0.f, 0.f}, 0, 0, 0); ra = __builtin_amdgcn_mfma_f32_16x16x32_bf16(wfa[nt][1], xf[1], ra, 0, 0, 0);
            f32x4 rx = __builtin_amdgcn_mfma_f32_16x16x32_bf16(wfx[nt][0], xf[0], (f32x4){0.f, 0.f, 0.f, 0.f}, 0, 0, 0); rx = __builtin_amdgcn_mfma_f32_16x16x32_bf16(wfx[nt][1], xf[1], rx, 0, 0, 0);
            u32x2 pa; pa.x = pack2(ra[0], ra[1]); pa.y = pack2(ra[2], ra[3]); u32x2 px; px.x = pack2(rx[0], rx[1]); px.y = pack2(rx[2], rx[3]);
            *(u32x2*)(preA + (tt * 16 + r16) * 256 + g * 64 + nt * 16 + quad * 4) = pa; *(u32x2*)(preX + (tt * 16 + r16) * 256 + g * 64 + nt * 16 + quad * 4) = px;
        }
    }
    __syncthreads();
    const float ba = p.lru_ba[l * 256 + ch], bx = p.lru_bx[l * 256 + ch], lam = p.lru_lam[l * 256 + ch];
    const float sp = fmaxf(-lam, 0.f) + log1pf(__expf(-fabsf(lam)));
    float hh = 0.f, P = 1.f;
    float* lhp = lh + (size_t)tok0 * 256 + ch; float* lpp = lp + (size_t)tok0 * 256 + ch;
#pragma unroll 4
    for (int i = 0; i < 32; ++i) { const float r = sigmoid_f(bf2f(preA[i * 256 + ch]) + ba), ig = sigmoid_f(bf2f(preX[i * 256 + ch]) + bx); const float la = -8.f * r * sp; const float a = __expf(la);
        const float w2 = 2.f * la;
        const float em_s = -w2 * (1.f + w2 * (0.5f + w2 * (0.16666667f + w2 * (0.041666668f + w2 * (0.0083333338f + w2 * 0.0013888889f)))));
        const float em = (w2 > -0.25f) ? em_s : (1.f - a * a);
        const float u = __builtin_amdgcn_sqrtf(em) * (ig * xcs[i * 256 + ch]); hh = a * hh + u; P *= a;
        lhp[(size_t)i * 256] = hh; lpp[(size_t)i * 256] = P; }
}

__device__ void lru3_item(const Params& p, int idx) {
    const int ch = tid_opq(); const int b = idx >> 7, c = idx & 127; const int tok0 = b * S + c * 32;
    const bf16_t* z = (const bf16_t*)(p.ws + WS_Z); bf16_t* mix = (bf16_t*)(p.ws + WS_U);
    const float* lh = (const float*)(p.ws + WS_LH); const float* lp = (const float*)(p.ws + WS_LP); const float* lc = (const float*)(p.ws + WS_LC);
    const float carry = lc[(size_t)(b * 128 + c) * 256 + ch];
    float hv[32], pv[32]; bf16_t gv[32];
#pragma unroll
    for (int i = 0; i < 32; ++i) { const size_t tok = (size_t)(tok0 + i); hv[i] = lh[tok * 256 + ch]; pv[i] = lp[tok * 256 + ch]; gv[i] = z[tok * ZP + C_BG + ch]; }
#pragma unroll
    for (int i = 0; i < 32; ++i) { const size_t tok = (size_t)(tok0 + i); mix[tok * 1024 + 256 + ch] = f2bf((hv[i] + pv[i] * carry) * silu_f(bf2f(gv[i]))); }
}

__device__ void dilc_item(const Params& p, int idx) {
    const int t = tid_opq(); const size_t tok = (size_t)idx * 8 + (t >> 5); const int chn = t & 31; const int h = chn >> 3;
    const bf16_t* z = (const bf16_t*)(p.ws + WS_Z); bf16_t* mix = (bf16_t*)(p.ws + WS_U);
    const bf16_t* dilo = (const bf16_t*)(p.ws + WS_DILO); const float* dill = (const float*)(p.ws + WS_DILL);
    const float l0 = dill[((size_t)0 * T + tok) * 4 + h], l1 = dill[((size_t)1 * T + tok) * 4 + h], l2 = dill[((size_t)2 * T + tok) * 4 + h];
    const float mx = fmaxf(l0, fmaxf(l1, l2)); float w0 = __expf(l0 - mx), w1 = __expf(l1 - mx), w2 = __expf(l2 - mx); const float inv = 1.f / (w0 + w1 + w2); w0 *= inv; w1 *= inv; w2 *= inv;
    const u32x4 o0 = *(const u32x4*)(dilo + ((size_t)0 * T + tok) * 256 + chn * 8), o1 = *(const u32x4*)(dilo + ((size_t)1 * T + tok) * 256 + chn * 8), o2 = *(const u32x4*)(dilo + ((size_t)2 * T + tok) * 256 + chn * 8);
    const u32x4 gv = *(const u32x4*)(z + tok * ZP + C_CG + chn * 8);
    u32x4 r;
#pragma unroll
    for (int e = 0; e < 4; ++e) {
        const float a = w0 * __uint_as_float(o0[e] << 16) + w1 * __uint_as_float(o1[e] << 16) + w2 * __uint_as_float(o2[e] << 16);
        const float bq = w0 * __uint_as_float(o0[e] & 0xffff0000u) + w1 * __uint_as_float(o1[e] & 0xffff0000u) + w2 * __uint_as_float(o2[e] & 0xffff0000u);
        r[e] = pack2(a * silu_f(__uint_as_float(gv[e] << 16)), bq * silu_f(__uint_as_float(gv[e] & 0xffff0000u)));
    }
    *(u32x4*)(mix + tok * 1024 + 512 + chn * 8) = r;
}

__device__ void m2_phase(const Params& p, char* smem) {
    float* gkv = (float*)(p.ws + WS_GKV); const float* gdec = (const float*)(p.ws + WS_GDEC);
    const float* lh = (const float*)(p.ws + WS_LH); const float* lp = (const float*)(p.ws + WS_LP); float* lc = (float*)(p.ws + WS_LC);
    float* aggP = (float*)smem; float* aggS = aggP + 256;
    const int t = tid_opq(); const int e = t & 31, seg = t >> 5;
    for (int it = blockIdx.x; it < 1024 + 32; it += gridDim.x) {
        float a[16], x[16];
        size_t ostride;
        float* outp;
        if (it < 1024) {
            const int gid = it * 32 + e; const int bh = gid >> 11, dv = gid & 2047, d = dv >> 6;
            float* base = gkv + (size_t)bh * 128 * 2048 + dv + (size_t)(seg * 16) * 2048; const float* dc = gdec + (size_t)bh * 128 * 32 + d + (seg * 16) * 32;
#pragma unroll
            for (int k = 0; k < 16; ++k) { x[k] = base[(size_t)k * 2048]; a[k] = dc[k * 32]; }
            outp = base; ostride = 2048;
        } else {
            const int i2 = it - 1024; const int b = i2 >> 3, ch = (i2 & 7) * 32 + e;
#pragma unroll
            for (int k = 0; k < 16; ++k) { const size_t ix = (size_t)(b * S + (seg * 16 + k) * 32 + 31) * 256 + ch; a[k] = lp[ix]; x[k] = lh[ix]; }
            outp = lc + (size_t)(b * 128 + seg * 16) * 256 + ch; ostride = 256;
        }
        float st = 0.f, pr = 1.f;
#pragma unroll
        for (int k = 0; k < 16; ++k) { const float ak = a[k], xk = x[k]; a[k] = pr; x[k] = st; st = ak * st + xk; pr *= ak; }
        __syncthreads();
        aggP[seg * 32 + e] = pr; aggS[seg * 32 + e] = st;
        __syncthreads();
        float carry = 0.f;
        for (int s2 = 0; s2 < seg; ++s2) carry = aggP[s2 * 32 + e] * carry + aggS[s2 * 32 + e];
#pragma unroll
        for (int k = 0; k < 16; ++k) outp[(size_t)k * ostride] = x[k] + a[k] * carry;
    }
}

__global__ void __launch_bounds__(256, 2) fwd_megakernel(Params p) {
    __shared__ __attribute__((aligned(16))) char smem[SMEM_BYTES];
    __shared__ uint4 xb_words;
    __shared__ int s_slot;
    cg::grid_group grid = cg::this_grid();
    if (p.out == nullptr) grid.sync();
    if (threadIdx.x == 0) xb_words = make_uint4(0u, 0u, 0u, 0u);
    __syncthreads();
    const XcdBarrier xb = xcd_barrier_post((unsigned*)(p.ws + WS_CTL), (volatile LAS unsigned*)&xb_words);
    unsigned* cnt = (unsigned*)(p.ws + WS_CNT);
    prologue_phase(p, smem);
    xcd_barrier(xb);
#pragma unroll 1
    for (int l = 0; l < DEPTH; ++l) {
        ln_phase(p, l);
        xcd_barrier(xb);
        g1_phase(p, l, smem);
        xcd_barrier(xb);
        for (;;) { const int it = next_item(cnt + (4 + l) * 64, &s_slot); if (it >= 512) break; lru1_item(p, l, it, smem); }
        for (;;) { const int it = next_item(cnt + (0 + l) * 64, &s_slot); if (it >= 512) break; moba_item(p, it, smem, (bf16_t*)(p.ws + WS_U)); }
        for (;;) { const int it = next_item(cnt + (2 + l) * 64, &s_slot); if (it >= 512) break; gla1_item(p, l, it, smem); }
        for (;;) { const int it = next_item(cnt + (6 + l) * 64, &s_slot); if (it >= 1536) break; attn_item(p, 1, it, smem); }
        xcd_barrier(xb);
        m2_phase(p, smem);
        xcd_barrier(xb);
        for (int it = blockIdx.x; it < 512; it += gridDim.x) gla3_item(p, l, it, smem);
        for (int it = blockIdx.x; it < 512; it += gridDim.x) lru3_item(p, it);
        for (int it = blockIdx.x; it < 2048; it += gridDim.x) dilc_item(p, it);
        xcd_barrier(xb);
        g2_phase(p, l, smem);
        xcd_barrier(xb);
    }
    ln_phase(p, DEPTH);
}

extern "C" void kernel_launch(void* const* d_in, const int* in_sizes, int n_in, void* d_out, int out_size, void* d_ws, size_t ws_size, hipStream_t stream) {
    static int grid_blocks = 0;
    if (!grid_blocks) {
        int dev = 0, cus = 0, per_cu = 0;
        hipGetDevice(&dev);
        hipDeviceGetAttribute(&cus, hipDeviceAttributeMultiprocessorCount, dev);
        hipOccupancyMaxActiveBlocksPerMultiprocessor(&per_cu, (const void*)fwd_megakernel, 256, 0);
        if (per_cu < 1) per_cu = 1;
        if (per_cu > 2) per_cu = 2;
        grid_blocks = cus * per_cu;
        if (ws_size < WS_END) fprintf(stderr, "kernel_launch: workspace too small: %zu < %zu\n", ws_size, (size_t)WS_END);
    }
    Params p{};
    p.x = (const float*)d_in[0]; p.c = (const float*)d_in[1]; p.pos = (const int*)d_in[2];
    p.w_mod = (const float*)d_in[3]; p.b_mod = (const float*)d_in[4]; p.w_in = (const float*)d_in[5];
    p.conv_w = (const float*)d_in[6]; p.conv_b = (const float*)d_in[7]; p.lru_wa = (const float*)d_in[8]; p.lru_ba = (const float*)d_in[9];
    p.lru_wx = (const float*)d_in[10]; p.lru_bx = (const float*)d_in[11]; p.lru_lam = (const float*)d_in[12];
    p.gla_wr = (const float*)d_in[13]; p.gla_br = (const float*)d_in[14]; p.gla_gn = (const float*)d_in[15];
    p.w_out = (const float*)d_in[16]; p.ln_g = (const float*)d_in[17]; p.ln_b = (const float*)d_in[18];
    p.out = (float*)d_out; p.ws = (unsigned char*)d_ws;
    (void)hipMemsetAsync(d_ws, 0, 32768, stream);
    void* args[] = {&p};
    hipError_t e = hipLaunchCooperativeKernel((const void*)fwd_megakernel, dim3(grid_blocks), dim3(256), args, 0, stream);
    if (e != hipSuccess) fprintf(stderr, "cooperative launch failed: %s (grid %d)\n", hipGetErrorString(e), grid_blocks);
}
```

```cpp
#include <hip/hip_runtime.h>
#include <hip/hip_cooperative_groups.h>
#include <cstdio>
#include <cstdint>
#include <type_traits>
namespace cg = cooperative_groups;

typedef unsigned short bf16_t;
typedef short bf16x8 __attribute__((ext_vector_type(8)));
typedef short bf16x4 __attribute__((ext_vector_type(4)));
typedef float f32x4 __attribute__((ext_vector_type(4)));
typedef unsigned u32x4 __attribute__((ext_vector_type(4)));
typedef unsigned u32x2 __attribute__((ext_vector_type(2)));

constexpr int D = 1024, NB = 4, S = 4096, T = NB * S, DEPTH = 2;
constexpr int DIN = 3344, ZP = 3344, NPAD = 3456;
constexpr int C_AQ = 0, C_AK = 256, C_AV = 512, C_AG = 768, C_BX = 1024, C_BG = 1280, C_CQ = 1536, C_CK = 1792,
              C_CV = 2048, C_CG = 2304, C_DQ = 2560, C_DK = 2688, C_DV = 2816, C_DG = 3072, C_DR = 3328;
constexpr float DN_ALPHA = 1.4142135623730951f;
constexpr int LDP = 72;
constexpr int SMEM_BYTES = 65536;
constexpr int BIG = 1000000;

constexpr size_t WS_CTL = 0;
constexpr size_t WS_CNT = 16384;
constexpr size_t WS_WINT = 32768;
constexpr size_t WS_WOUTT = WS_WINT + (size_t)DEPTH * NPAD * 1024 * 2;
constexpr size_t WS_MOD = WS_WOUTT + (size_t)DEPTH * 1024 * 1024 * 2;
constexpr size_t WS_COS = WS_MOD + (size_t)DEPTH * NB * 3072 * 4;
constexpr size_t WS_SIN = WS_COS + (size_t)T * 32 * 4;
constexpr size_t WS_U = WS_SIN + (size_t)T * 32 * 4;
constexpr size_t WS_Z = WS_U + (size_t)T * 1024 * 2;
constexpr size_t WS_KPART = WS_Z + (size_t)T * ZP * 2;
constexpr size_t WS_DILO = WS_KPART + (size_t)256 * 256 * 4;
constexpr size_t WS_DILL = WS_DILO + (size_t)3 * T * 256 * 2;
constexpr size_t WS_GKV = WS_DILL + (size_t)3 * T * 4 * 4;
constexpr size_t WS_GDEC = WS_GKV + (size_t)2048 * 2048 * 4;
constexpr size_t WS_LH = WS_GDEC + (size_t)2048 * 32 * 4;
constexpr size_t WS_LP = WS_LH + (size_t)T * 256 * 4;
constexpr size_t WS_LC = WS_LP + (size_t)T * 256 * 4;
constexpr size_t WS_LWT = WS_LC + (size_t)NB * 128 * 256 * 4;
constexpr size_t WS_BC = WS_LWT + (size_t)DEPTH * 2 * 4 * 64 * 64 * 2;
constexpr size_t WS_END = WS_BC + (size_t)512 * 32 * 128 * 4;

struct Params {
    const float *x, *c; const int* pos;
    const float *w_mod, *b_mod, *w_in, *conv_w, *conv_b, *lru_wa, *lru_ba, *lru_wx, *lru_bx, *lru_lam, *gla_wr, *gla_br, *gla_gn, *w_out, *ln_g, *ln_b;
    float* out; unsigned char* ws;
};

__device__ __forceinline__ float bf2f(bf16_t h) { return __uint_as_float(((unsigned)h) << 16); }
typedef __bf16 hbf16x2 __attribute__((ext_vector_type(2)));
typedef float f32x2 __attribute__((ext_vector_type(2)));
__device__ __forceinline__ unsigned pack2(float a, float b) { f32x2 v = {a, b}; hbf16x2 r = __builtin_convertvector(v, hbf16x2); return __builtin_bit_cast(unsigned, r); }
__device__ __forceinline__ bf16_t f2bf(float f) { return (bf16_t)(pack2(f, 0.f) & 0xffffu); }
__device__ __forceinline__ float silu_f(float x) { return x / (1.f + __expf(-x)); }
__device__ __forceinline__ float sigmoid_f(float x) { return 1.f / (1.f + __expf(-x)); }
__device__ __forceinline__ int tid_opq() { int t = threadIdx.x; asm volatile("" : "+v"(t)); return t; }
__device__ __forceinline__ float wsum(float v) {
#pragma unroll
    for (int o = 32; o; o >>= 1) v += __shfl_xor(v, o);
    return v;
}

#define XB_TMO      128
#define XB_XCNT(j)  (256  + 64 * (j))
#define XB_XSUB(j)  (1280 + 64 * (j))
#define XB_XGEN(j)  (2304 + 64 * (j))
#define XB_TOP      3328
#define XB_TOPGEN   3392
#define XCD_BAR_WORDS 3456
#define XB_SPIN_CAP (1u << 18)
#define LAS __attribute__((address_space(3)))
__device__ __forceinline__ unsigned xb_ld(unsigned* p)              { return __hip_atomic_load(p, __ATOMIC_RELAXED, __HIP_MEMORY_SCOPE_AGENT); }
__device__ __forceinline__ unsigned xb_add(unsigned* p, unsigned v) { return __hip_atomic_fetch_add(p, v, __ATOMIC_RELAXED, __HIP_MEMORY_SCOPE_AGENT); }
__device__ __forceinline__ unsigned xb_xcc_id() { return (unsigned)__builtin_amdgcn_s_getreg((3 << 11) | 20) & 0xFu; }
#define XB_SPIN(cond, bar) do { unsigned _sp = 0; while (cond) { __builtin_amdgcn_s_sleep(1); \
    if ((++_sp & 255u) == 0u) { if (xb_ld(&(bar)[XB_TMO])) break; if (_sp > XB_SPIN_CAP) { atomicAdd(&(bar)[XB_TMO], 1u); break; } } } } while (0)
struct XcdBarrier { unsigned* bar; unsigned x; volatile LAS unsigned* st; };
__device__ __forceinline__ XcdBarrier xcd_barrier_post(unsigned* bar, volatile LAS unsigned* st) {
    XcdBarrier b; b.bar = bar; b.x = xb_xcc_id(); b.st = st;
    if (threadIdx.x == 0) (void)xb_add(&bar[XB_XCNT(b.x)], 1u);
    return b;
}
__device__ __forceinline__ void xcd_barrier_complete(unsigned* bar, unsigned x, unsigned& nloc, unsigned& nx) {
    const unsigned G = gridDim.x * gridDim.y * gridDim.z;
    unsigned sum, cnt, mine, sp = 0u;
    for (;;) {
        sum = 0u; cnt = 0u; mine = 0u;
#pragma unroll
        for (unsigned j = 0; j < 16; ++j) { const unsigned c = xb_ld(&bar[XB_XCNT(j)]); sum += c; cnt += (c > 0u) ? 1u : 0u; mine = (j == x) ? c : mine; }
        if (sum == G) break;
        __builtin_amdgcn_s_sleep(1);
        if ((++sp & 255u) == 0u) { if (xb_ld(&bar[XB_TMO])) break; if (sp > XB_SPIN_CAP) { atomicAdd(&bar[XB_TMO], 1u); break; } }
    }
    nloc = mine > 0u ? mine : 1u; nx = cnt > 0u ? cnt : 1u;
}
__device__ __forceinline__ void xcd_barrier(const XcdBarrier& b) {
    asm volatile("s_waitcnt vmcnt(0)" ::: "memory");
    __syncthreads();
    if (threadIdx.x == 0) {
        unsigned* bar = b.bar;
        __builtin_amdgcn_s_waitcnt(0);
        unsigned nloc = b.st[0], nx = b.st[1];
        if (nloc == 0u) { xcd_barrier_complete(bar, b.x, nloc, nx); b.st[0] = nloc; b.st[1] = nx; }
        const unsigned old = xb_add(&bar[XB_XSUB(b.x)], 1u);
        const unsigned gen = old / nloc;
        if (old + 1u == (gen + 1u) * nloc) {
            __builtin_amdgcn_fence(__ATOMIC_RELEASE, "agent");
            asm volatile("s_waitcnt vmcnt(0)" ::: "memory");
            const unsigned og = xb_add(&bar[XB_TOP], 1u);
            const unsigned tg = og / nx;
            if (og + 1u == (tg + 1u) * nx) xb_add(&bar[XB_TOPGEN], 1u);
            else XB_SPIN(xb_ld(&bar[XB_TOPGEN]) == tg, bar);
            __builtin_amdgcn_fence(__ATOMIC_ACQUIRE, "agent");
            xb_add(&bar[XB_XGEN(b.x)], 1u);
            asm volatile("s_waitcnt vmcnt(0)" ::: "memory");
        } else {
            XB_SPIN(xb_ld(&bar[XB_XGEN(b.x)]) == gen, bar);
            __builtin_amdgcn_fence(__ATOMIC_ACQUIRE, "agent");
            asm volatile("s_waitcnt vmcnt(0)" ::: "memory");
        }
    }
    __syncthreads();
}
__device__ __forceinline__ int next_item(unsigned* ctr, volatile int* slot) {
    __syncthreads();
    if (threadIdx.x == 0) *slot = (int)atomicAdd(ctr, 1u);
    __syncthreads();
    return *slot;
}

__device__ void prologue_phase(const Params& p, char* smem) {
    const int t = tid_opq();
    bf16_t* WinT = (bf16_t*)(p.ws + WS_WINT); bf16_t* WoutT = (bf16_t*)(p.ws + WS_WOUTT);
    float* mod = (float*)(p.ws + WS_MOD); float* cosT = (float*)(p.ws + WS_COS); float* sinT = (float*)(p.ws + WS_SIN);
    float* tl = (float*)smem;
    constexpr int N_TIN = DEPTH * 16 * 54, N_TOUT = DEPTH * 16 * 16, N_MOD = DEPTH * 192, N_ROPE = T * 32 / 256, N_LWT = DEPTH * 2 * 4 * 64 * 64 / 256;
    constexpr int NITEMS = N_TIN + N_TOUT + N_MOD + N_ROPE + N_LWT;
    for (int it = blockIdx.x; it < NITEMS; it += gridDim.x) {
        if (it < N_TIN + N_TOUT) {
            const float* src; bf16_t* dst; int ncols, kt, nt;
            if (it < N_TIN) { int l = it / (16 * 54), r = it % (16 * 54); kt = r / 54; nt = r % 54; src = p.w_in + (size_t)l * 1024 * DIN; dst = WinT + (size_t)l * NPAD * 1024; ncols = DIN; }
            else { int i2 = it - N_TIN; int l = i2 / 256, r = i2 % 256; kt = r / 16; nt = r % 16; src = p.w_out + (size_t)l * 1024 * 1024; dst = WoutT + (size_t)l * 1024 * 1024; ncols = 1024; }
            __syncthreads();
            { const int c = t & 63, r0 = t >> 6; const int n = nt * 64 + c;
#pragma unroll
              for (int i = 0; i < 16; ++i) { int r = r0 + 4 * i; tl[r * 65 + c] = (n < ncols) ? src[(size_t)(kt * 64 + r) * ncols + n] : 0.f; } }
            __syncthreads();
            { const int kk = t & 63, n0 = t >> 6;
#pragma unroll
              for (int i = 0; i < 16; ++i) { int n = n0 + 4 * i; dst[(size_t)(nt * 64 + n) * 1024 + kt * 64 + kk] = f2bf(tl[kk * 65 + n]); } }
        } else if (it < N_TIN + N_TOUT + N_MOD) {
            const int i2 = it - N_TIN - N_TOUT; const int l = i2 / 192, jg = i2 % 192;
            const int jj = t & 15, ks = t >> 4; const int j = jg * 16 + jj;
            float a0 = 0.f, a1 = 0.f, a2 = 0.f, a3 = 0.f;
            const float* wm = p.w_mod + (size_t)l * 1024 * 3072 + j;
#pragma unroll 8
            for (int k = ks * 64; k < ks * 64 + 64; ++k) { float wv = wm[(size_t)k * 3072]; a0 += p.c[k] * wv; a1 += p.c[1024 + k] * wv; a2 += p.c[2048 + k] * wv; a3 += p.c[3072 + k] * wv; }
            __syncthreads();
            tl[(0 * 16 + ks) * 16 + jj] = a0; tl[(1 * 16 + ks) * 16 + jj] = a1; tl[(2 * 16 + ks) * 16 + jj] = a2; tl[(3 * 16 + ks) * 16 + jj] = a3;
            __syncthreads();
            if (t < 64) { const int b = t >> 4, j2 = t & 15; float s = 0.f;
#pragma unroll
              for (int k2 = 0; k2 < 16; ++k2) s += tl[(b * 16 + k2) * 16 + j2];
              mod[((size_t)l * NB + b) * 3072 + jg * 16 + j2] = s + p.b_mod[l * 3072 + jg * 16 + j2]; }
        } else if (it >= N_TIN + N_TOUT + N_MOD + N_ROPE) {
            const int e = (it - N_TIN - N_TOUT - N_MOD - N_ROPE) * 256 + t;
            const int in = e & 63, out = (e >> 6) & 63, g = (e >> 12) & 3, mat = (e >> 14) & 1, l = e >> 15;
            const float* src = mat ? p.lru_wx : p.lru_wa;
            ((bf16_t*)(p.ws + WS_LWT))[e] = f2bf(src[l * 16384 + g * 4096 + in * 64 + out]);
        } else {
            const int i2 = it - N_TIN - N_TOUT - N_MOD; const int e = i2 * 256 + t; const int tok = e >> 5, f = e & 31;
            const float inv = exp2f(-(float)f * (13.287712379549449f / 32.f));
            const float ang = (float)p.pos[tok] * inv;
            double rev = (double)ang * 0.15915494309189535; rev -= __builtin_rint(rev);
            const float rr = (float)rev; cosT[e] = __builtin_amdgcn_cosf(rr); sinT[e] = __builtin_amdgcn_sinf(rr);
        }
    }
}

__device__ void ln_phase(const Params& p, int l) {
    const int t = tid_opq(), lane = t & 63, w = t >> 6;
    bf16_t* ubuf = (bf16_t*)(p.ws + WS_U); const float* mod = (const float*)(p.ws + WS_MOD);
    for (int rg = blockIdx.x; rg < T / 16; rg += gridDim.x) {
        f32x4 v[4][4];
#pragma unroll
        for (int r = 0; r < 4; ++r) { const int row = rg * 16 + w * 4 + r; const float* src = (l <= 1) ? p.x + (size_t)row * 1024 : p.out + (size_t)row * 1024;
#pragma unroll
            for (int i = 0; i < 4; ++i) v[r][i] = *(const f32x4*)(src + i * 256 + lane * 4);
            if (l > 0) {
                const bf16_t* yr = (const bf16_t*)(p.ws + WS_Z) + (size_t)row * 1024; const float* gate = mod + ((size_t)(l - 1) * NB + row / S) * 3072 + 2048;
#pragma unroll
                for (int i = 0; i < 4; ++i) { const u32x2 yv = *(const u32x2*)(yr + i * 256 + lane * 4); const f32x4 g1 = *(const f32x4*)(gate + i * 256 + lane * 4) + 1.f;
                    const f32x4 yf = {__uint_as_float(yv.x << 16), __uint_as_float(yv.x & 0xffff0000u), __uint_as_float(yv.y << 16), __uint_as_float(yv.y & 0xffff0000u)};
                    v[r][i] = v[r][i] * DN_ALPHA + g1 * yf; }
            } }
#pragma unroll
        for (int r = 0; r < 4; ++r) {
            const int row = rg * 16 + w * 4 + r; const int b = row / S;
            if (l > 0) {
                float s = 0.f;
#pragma unroll
                for (int i = 0; i < 4; ++i) s += (v[r][i][0] + v[r][i][1]) + (v[r][i][2] + v[r][i][3]);
                const float mu = wsum(s) * (1.f / 1024.f); float q = 0.f;
#pragma unroll
                for (int i = 0; i < 4; ++i) { f32x4 d = v[r][i] - mu; q += (d[0] * d[0] + d[1] * d[1]) + (d[2] * d[2] + d[3] * d[3]); }
                const float rstd = rsqrtf(wsum(q) * (1.f / 1024.f) + 1e-5f);
#pragma unroll
                for (int i = 0; i < 4; ++i) { const f32x4 g = *(const f32x4*)(p.ln_g + (l - 1) * 1024 + i * 256 + lane * 4), bb = *(const f32x4*)(p.ln_b + (l - 1) * 1024 + i * 256 + lane * 4);
                    v[r][i] = (v[r][i] - mu) * rstd * g + bb; *(f32x4*)(p.out + (size_t)row * 1024 + i * 256 + lane * 4) = v[r][i]; }
            }
            if (l < DEPTH) {
                float s = 0.f;
#pragma unroll
                for (int i = 0; i < 4; ++i) s += (v[r][i][0] + v[r][i][1]) + (v[r][i][2] + v[r][i][3]);
                const float mu = wsum(s) * (1.f / 1024.f); float q = 0.f;
#pragma unroll
                for (int i = 0; i < 4; ++i) { f32x4 d = v[r][i] - mu; q += (d[0] * d[0] + d[1] * d[1]) + (d[2] * d[2] + d[3] * d[3]); }
                const float rstd = rsqrtf(wsum(q) * (1.f / 1024.f) + 1e-5f);
                const float* mb = mod + ((size_t)l * NB + b) * 3072;
#pragma unroll
                for (int i = 0; i < 4; ++i) { const int col = i * 256 + lane * 4; const f32x4 sh = *(const f32x4*)(mb + col), sc = *(const f32x4*)(mb + 1024 + col);
                    f32x4 u = (v[r][i] - mu) * rstd * (sc + 1.f) + sh; u32x2 pk; pk.x = pack2(u[0], u[1]); pk.y = pack2(u[2], u[3]);
                    *(u32x2*)(ubuf + (size_t)row * 1024 + col) = pk; }
            }
        }
    }
}

__device__ __forceinline__ int lds_off(int r, int c8) {
    const int st = (r >> 4) * 2 + (c8 >> 2); const int ob = (r & 15) * 64 + (c8 & 3) * 16;
    return st * 1024 + (ob ^ (((ob >> 9) & 1) << 5));
}
struct RegSet { u32x4 a[4], b[4]; };
__device__ __forceinline__ void gemm_tile(const bf16_t* __restrict__ A, const bf16_t* __restrict__ Bt, int tm, int tn, bool first, bool has_next, int ntm, int ntn,
                                          char* sm, f32x4 (&acc)[4][4], RegSet& r0, RegSet& r1) {
    const int t = tid_opq(), lane = t & 63, w = t >> 6, wm = w >> 1, wn = w & 1, r16 = lane & 15, quad = lane >> 4;
    const int lrow = t >> 3, lch = t & 7;
    constexpr int BUF = 32768;
    const unsigned loff = (unsigned)(lrow * 1024 + lch * 8);
    const bf16_t* At0 = A + (size_t)tm * (128 * 1024); const bf16_t* Bt0 = Bt + (size_t)tn * (128 * 1024);
    const bf16_t* At1 = A + (size_t)ntm * (128 * 1024); const bf16_t* Bt1 = Bt + (size_t)ntn * (128 * 1024);
#define Ag (At0 + loff)
#define Bg (Bt0 + loff)
#define nAg (At1 + loff)
#define nBg (Bt1 + loff)
    const int woff0 = lds_off(lrow, lch);
#define woff(i) (woff0 + 4096 * (i))
    const int fo = lds_off(r16, quad);
#pragma unroll
    for (int a = 0; a < 4; ++a)
#pragma unroll
        for (int b = 0; b < 4; ++b) acc[a][b] = (f32x4){0.f, 0.f, 0.f, 0.f};
    if (first) {
#pragma unroll
        for (int i = 0; i < 4; ++i) { r0.a[i] = *(const u32x4*)(Ag + (size_t)i * 32 * 1024); r0.b[i] = *(const u32x4*)(Bg + (size_t)i * 32 * 1024); }
        __syncthreads();
#pragma unroll
        for (int i = 0; i < 4; ++i) { *(u32x4*)(sm + woff(i)) = r0.a[i]; *(u32x4*)(sm + 16384 + woff(i)) = r0.b[i]; }
#pragma unroll
        for (int i = 0; i < 4; ++i) { r0.a[i] = *(const u32x4*)(Ag + (size_t)i * 32 * 1024 + 64); r0.b[i] = *(const u32x4*)(Bg + (size_t)i * 32 * 1024 + 64); }
    }
    __syncthreads();
    auto step = [&](auto main_tag, int kt) {
        constexpr bool MAIN = decltype(main_tag)::value;
        const char* sA = sm + (kt & 1) * BUF; const char* sB = sA + 16384;
        char* nA = sm + ((kt + 1) & 1) * BUF; char* nB = nA + 16384;
        const bool wr = MAIN || kt + 1 < 16 || has_next;
        const bool own = MAIN || kt + 2 < 16;
        const bf16_t* la = own ? Ag + (kt + 2) * 64 : nAg + (kt - 14) * 64; const bf16_t* lb = own ? Bg + (kt + 2) * 64 : nBg + (kt - 14) * 64;
        {
            bf16x8 af[2][4], bfr[2][4];
#pragma unroll
            for (int mt = 0; mt < 4; ++mt) af[0][mt] = *(const bf16x8*)(sA + ((wm * 4 + mt) * 2 + 0) * 1024 + fo);
#pragma unroll
            for (int nt = 0; nt < 4; ++nt) bfr[0][nt] = *(const bf16x8*)(sB + ((wn * 4 + nt) * 2 + 0) * 1024 + fo);
            __builtin_amdgcn_s_setprio(1);
#pragma unroll
            for (int ks = 0; ks < 2; ++ks) {
#pragma unroll
                for (int mt = 0; mt < 4; ++mt) {
#pragma unroll
                    for (int nt = 0; nt < 4; ++nt) acc[mt][nt] = __builtin_amdgcn_mfma_f32_16x16x32_bf16(bfr[ks][nt], af[ks][mt], acc[mt][nt], 0, 0, 0);
                    const int i = ks * 2 + (mt >> 1);
                    __builtin_amdgcn_sched_barrier(0);
                    if (ks == 0) { af[1][mt] = *(const bf16x8*)(sA + ((wm * 4 + mt) * 2 + 1) * 1024 + fo); bfr[1][mt] = *(const bf16x8*)(sB + ((wn * 4 + mt) * 2 + 1) * 1024 + fo); }
                    if ((mt & 1) == 0) { if (wr) *(u32x4*)(nA + woff(i)) = r0.a[i]; if (own || has_next) r0.a[i] = *(const u32x4*)(la + (size_t)i * 32 * 1024); }
                    else               { if (wr) *(u32x4*)(nB + woff(i)) = r0.b[i]; if (own || has_next) r0.b[i] = *(const u32x4*)(lb + (size_t)i * 32 * 1024); }
                    __builtin_amdgcn_sched_barrier(0);
                }
            }
            __builtin_amdgcn_s_setprio(0);
        }
        __syncthreads();
    };
    {
        std::true_type mt_; std::false_type tl_;
        for (int kt = 0; kt < 14; ++kt) step(mt_, kt);
        step(tl_, 14); step(tl_, 15);
    }
#undef Ag
#undef Bg
#undef nAg
#undef nBg
#undef woff
}

__device__ void g1_phase(const Params& p, int l, char* smem) {
    const int t = tid_opq(), lane = t & 63, w = t >> 6, wm = w >> 1, wn = w & 1, r16 = lane & 15, quad = lane >> 4;
    char* sm = smem; char* sC = smem + 32768;
    const bf16_t* ubuf = (const bf16_t*)(p.ws + WS_U); const bf16_t* WinT = (const bf16_t*)(p.ws + WS_WINT) + (size_t)l * NPAD * 1024;
    bf16_t* z = (bf16_t*)(p.ws + WS_Z); float* kpart = (float*)(p.ws + WS_KPART);
    const float* cosT = (const float*)(p.ws + WS_COS); const float* sinT = (const float*)(p.ws + WS_SIN);
    const bool xo = (gridDim.x & 7) == 0; const int xcd = blockIdx.x & 7, nloc = xo ? (int)(gridDim.x >> 3) : (int)gridDim.x, j0 = xo ? (int)(blockIdx.x >> 3) : (int)blockIdx.x;
    const int lim = xo ? 16 * 27 : 128 * 27;
    RegSet r0, r1;
    for (int L = j0; L < lim; L += nloc) {
        const int tm = xo ? xcd * 16 + (L / 216) * 8 + (L & 7) : L / 27, tn = xo ? ((L % 216) >> 3) : L % 27;
        const int L2 = L + nloc; const bool has_next = L2 < lim;
        const int ntm = has_next ? (xo ? xcd * 16 + (L2 / 216) * 8 + (L2 & 7) : L2 / 27) : tm, ntn = has_next ? (xo ? ((L2 % 216) >> 3) : L2 % 27) : tn;
        f32x4 acc[4][4];
        gemm_tile(ubuf, WinT, tm, tn, L == j0, has_next, ntm, ntn, sm, acc, r0, r1);
        const bool rope = (tn < 4) || (tn >= 12 && tn < 16);
        if (rope) {
#pragma unroll
            for (int mt = 0; mt < 4; ++mt) {
                const int tok = tm * 128 + wm * 64 + mt * 16 + r16;
#pragma unroll
                for (int nt = 0; nt < 2; ++nt) {
                    const f32x4 cs = *(const f32x4*)(cosT + (size_t)tok * 32 + nt * 16 + quad * 4), sn = *(const f32x4*)(sinT + (size_t)tok * 32 + nt * 16 + quad * 4);
                    const f32x4 x1 = acc[mt][nt], x2 = acc[mt][nt + 2];
                    acc[mt][nt] = x1 * cs - x2 * sn; acc[mt][nt + 2] = x1 * sn + x2 * cs;
                }
            }
        }
        if (tn == 2 || tn == 3) {
#pragma unroll
            for (int nt = 0; nt < 4; ++nt) {
                f32x4 sv = (acc[0][nt] + acc[1][nt]) + (acc[2][nt] + acc[3][nt]);
#pragma unroll
                for (int jj = 0; jj < 4; ++jj) { float sx = sv[jj]; sx += __shfl_xor(sx, 1); sx += __shfl_xor(sx, 2); sx += __shfl_xor(sx, 4); sx += __shfl_xor(sx, 8); sv[jj] = sx; }
                if (r16 == 0) *(f32x4*)(kpart + (size_t)(tm * 2 + wm) * 256 + (tn - 2) * 128 + wn * 64 + nt * 16 + quad * 4) = sv;
            }
        }
#pragma unroll
        for (int mt = 0; mt < 4; ++mt)
#pragma unroll
            for (int nt = 0; nt < 4; ++nt) { u32x2 pk; pk.x = pack2(acc[mt][nt][0], acc[mt][nt][1]); pk.y = pack2(acc[mt][nt][2], acc[mt][nt][3]);
                const int row = wm * 64 + mt * 16 + r16; const int c16 = wn * 8 + nt * 2 + (quad >> 1);
                *(u32x2*)(sC + row * 256 + ((c16 ^ (row & 15)) << 4) + (quad & 1) * 8) = pk; }
        __syncthreads();
#pragma unroll
        for (int i = 0; i < 8; ++i) { const int c = t + 256 * i; const int row = c >> 4, ch = c & 15; const int col = tn * 128 + ch * 8;
            if (col < DIN) *(u32x4*)(z + (size_t)(tm * 128 + row) * ZP + col) = *(const u32x4*)(sC + row * 256 + ((ch ^ (row & 15)) << 4)); }
    }
}

__device__ void g2_phase(const Params& p, int l, char* smem) {
    const int t = tid_opq(), lane = t & 63, w = t >> 6, wm = w >> 1, wn = w & 1, r16 = lane & 15, quad = lane >> 4;
    char* sm = smem; char* sC = smem + 32768;
    const bf16_t* mix = (const bf16_t*)(p.ws + WS_U); const bf16_t* WoutT = (const bf16_t*)(p.ws + WS_WOUTT) + (size_t)l * 1024 * 1024;
    bf16_t* ybuf = (bf16_t*)(p.ws + WS_Z);
    const bool xo = (gridDim.x & 7) == 0; const int xcd = blockIdx.x & 7, nloc = xo ? (int)(gridDim.x >> 3) : (int)gridDim.x, j0 = xo ? (int)(blockIdx.x >> 3) : (int)blockIdx.x;
    const int lim = xo ? 16 * 8 : 128 * 8;
    RegSet r0, r1;
    for (int L = j0; L < lim; L += nloc) {
        const int tm = xo ? xcd * 16 + (L & 15) : (L >> 3), tn = xo ? (L >> 4) : (L & 7);
        const int L2 = L + nloc; const bool has_next = L2 < lim;
        const int ntm = has_next ? (xo ? xcd * 16 + (L2 & 15) : (L2 >> 3)) : tm, ntn = has_next ? (xo ? (L2 >> 4) : (L2 & 7)) : tn;
        f32x4 acc[4][4];
        gemm_tile(mix, WoutT, tm, tn, L == j0, has_next, ntm, ntn, sm, acc, r0, r1);
#pragma unroll
        for (int mt = 0; mt < 4; ++mt)
#pragma unroll
            for (int nt = 0; nt < 4; ++nt) { u32x2 pk; pk.x = pack2(acc[mt][nt][0], acc[mt][nt][1]); pk.y = pack2(acc[mt][nt][2], acc[mt][nt][3]);
                const int row = wm * 64 + mt * 16 + r16; const int c16 = wn * 8 + nt * 2 + (quad >> 1);
                *(u32x2*)(sC + row * 256 + ((c16 ^ (row & 15)) << 4) + (quad & 1) * 8) = pk; }
        __syncthreads();
#pragma unroll
        for (int i = 0; i < 8; ++i) { const int c = t + 256 * i; const int row = c >> 4, ch = c & 15;
            *(u32x4*)(ybuf + (size_t)(tm * 128 + row) * 1024 + tn * 128 + ch * 8) = *(const u32x4*)(sC + row * 256 + ((ch ^ (row & 15)) << 4)); }
    }
}

constexpr float ATT_SC = 0.18033688011112042f;
template <int QT>
__device__ __forceinline__ void attn_tile(const bf16_t* sK, const bf16_t* sV, const bf16x8 (&qf)[QT][2], int lo, int hi, bool full, bool hasq, bool qfl0, bool qfl1,
                                          float (&m)[QT], float (&l)[QT], f32x4 (&O)[QT][4], int wq0) {
    const int lane = tid_opq() & 63, r16 = lane & 15, quad = lane >> 4;
    f32x4 s[QT][4];
#pragma unroll
    for (int a = 0; a < QT; ++a)
#pragma unroll
        for (int b = 0; b < 4; ++b) s[a][b] = (f32x4){0.f, 0.f, 0.f, 0.f};
#pragma unroll
    for (int ks = 0; ks < 2; ++ks)
#pragma unroll
        for (int k16 = 0; k16 < 4; ++k16) {
            const bf16x8 kf = *(const bf16x8*)(sK + (k16 * 16 + r16) * LDP + ks * 32 + quad * 8);
#pragma unroll
            for (int qt = 0; qt < QT; ++qt) s[qt][k16] = __builtin_amdgcn_mfma_f32_16x16x32_bf16(kf, qf[qt][ks], s[qt][k16], 0, 0, 0);
        }
#pragma unroll
    for (int qt = 0; qt < QT; ++qt) {
        const int ql = wq0 + qt * 16 + r16; const bool qfl = qt ? qfl1 : qfl0;
        if (!full) {
#pragma unroll
            for (int k16 = 0; k16 < 4; ++k16)
#pragma unroll
                for (int j = 0; j < 4; ++j) { const int dd = ql - (k16 * 16 + quad * 4 + j); const bool valid = dd >= lo && dd <= hi; s[qt][k16][j] = valid ? s[qt][k16][j] : -1e30f; }
        }
        if (hasq) {
#pragma unroll
            for (int k16 = 0; k16 < 4; ++k16)
#pragma unroll
                for (int j = 0; j < 4; ++j) s[qt][k16][j] = qfl ? s[qt][k16][j] : -1e30f;
        }
        float mx = -1e30f;
#pragma unroll
        for (int k16 = 0; k16 < 4; ++k16) mx = fmaxf(mx, fmaxf(fmaxf(s[qt][k16][0], s[qt][k16][1]), fmaxf(s[qt][k16][2], s[qt][k16][3])));
        mx = fmaxf(mx, __shfl_xor(mx, 16)); mx = fmaxf(mx, __shfl_xor(mx, 32));
        const float mn = fmaxf(m[qt], mx); const float alpha = __builtin_amdgcn_exp2f((m[qt] - mn) * ATT_SC); m[qt] = mn;
        const float mb = (mn < -1e29f) ? 0.f : mn * ATT_SC;
        float ps = 0.f;
#pragma unroll
        for (int k16 = 0; k16 < 4; ++k16)
#pragma unroll
            for (int j = 0; j < 4; ++j) { const float pv = __builtin_amdgcn_exp2f(s[qt][k16][j] * ATT_SC - mb); ps += pv; s[qt][k16][j] = pv; }
        l[qt] = l[qt] * alpha + ps;
#pragma unroll
        for (int dt = 0; dt < 4; ++dt) O[qt][dt] = O[qt][dt] * alpha;
    }
#pragma unroll
    for (int G = 0; G < 2; ++G) {
        bf16x8 pf[QT];
#pragma unroll
        for (int qt = 0; qt < QT; ++qt) {
            const unsigned a0 = pack2(s[qt][G * 2][0], s[qt][G * 2][1]), a1 = pack2(s[qt][G * 2][2], s[qt][G * 2][3]);
            const unsigned a2 = pack2(s[qt][G * 2 + 1][0], s[qt][G * 2 + 1][1]), a3 = pack2(s[qt][G * 2 + 1][2], s[qt][G * 2 + 1][3]);
            u32x4 pk = {a0, a1, a2, a3}; pf[qt] = __builtin_bit_cast(bf16x8, pk);
        }
#pragma unroll
        for (int dt = 0; dt < 4; ++dt) {
            const bf16_t* v0p = sV + (G * 32 + quad * 4 + (r16 >> 2)) * LDP + dt * 16 + (r16 & 3) * 4;
            const bf16x4 v0 = __builtin_amdgcn_ds_read_tr16_b64_v4i16((__attribute__((address_space(3))) bf16x4*)(v0p));
            const bf16x4 v1 = __builtin_amdgcn_ds_read_tr16_b64_v4i16((__attribute__((address_space(3))) bf16x4*)(v0p + 16 * LDP));
            const bf16x8 vf = {v0[0], v0[1], v0[2], v0[3], v1[0], v1[1], v1[2], v1[3]};
#pragma unroll
            for (int qt = 0; qt < QT; ++qt) O[qt][dt] = __builtin_amdgcn_mfma_f32_16x16x32_bf16(vf, pf[qt], O[qt][dt], 0, 0, 0);
        }
    }
}

__device__ void attn_item(const Params& p, int kind, int idx, char* smem) {
    const int t = tid_opq(), lane = t & 63, w = t >> 6, r16 = lane & 15, quad = lane >> 4;
    bf16_t* sK = (bf16_t*)smem; bf16_t* sV = sK + 64 * LDP;
    float* kmean = (float*)(smem + 18432); float* gates = (float*)(smem + 22528); unsigned* selm = (unsigned*)(smem + 30720);
    int4* desc = (int4*)(smem + 31232); int* misc = (int*)(smem + 32320);
    const bf16_t* z = (const bf16_t*)(p.ws + WS_Z);
    int b, h, qbase, stride, qcol, kcol, vcol, cfg = 0;
    __syncthreads();
    if (kind == 0) {
        const int n = 15 - (idx >> 5); const int rem = idx & 31; b = rem >> 3; h = (rem >> 1) & 3; const int qh = rem & 1;
        qbase = b * S + n * 256 + qh * 128; stride = 1; qcol = C_AQ + h * 64; kcol = C_AK + h * 64; vcol = C_AV + h * 64;
        const float* kpart = (const float*)(p.ws + WS_KPART);
        for (int e = t; e < n * 64; e += 256) { const int j = e >> 6, d = e & 63; const float* kp = kpart + (size_t)(b * 64 + j * 4) * 256 + h * 64 + d;
            kmean[e] = ((kp[0] + kp[256]) + (kp[512] + kp[768])) * (1.f / 256.f); }
        if (t == 0) misc[1] = 0;
        __syncthreads();
        {
            const int ql = t >> 1, half = t & 1; const bf16_t* qp = z + (size_t)(qbase + ql) * ZP + qcol;
            float g[8];
#pragma unroll
            for (int jj = 0; jj < 8; ++jj) g[jj] = 0.f;
#pragma unroll 1
            for (int dc = 0; dc < 8; ++dc) {
                const u32x4 qv = *(const u32x4*)(qp + dc * 8); float qq[8];
#pragma unroll
                for (int e = 0; e < 4; ++e) { qq[2 * e] = __uint_as_float(qv[e] << 16); qq[2 * e + 1] = __uint_as_float(qv[e] & 0xffff0000u); }
#pragma unroll
                for (int jj = 0; jj < 8; ++jj) { const int j = half + 2 * jj; if (j < n) { const float* km = kmean + j * 64 + dc * 8;
#pragma unroll
                    for (int e = 0; e < 8; ++e) g[jj] += qq[e] * km[e]; } }
            }
#pragma unroll
            for (int jj = 0; jj < 8; ++jj) gates[ql * 16 + half + 2 * jj] = g[jj];
        }
        __syncthreads();
        if (t < 128) {
            unsigned msk = 0;
            for (int k = 0; k < 3 && k < n; ++k) { float best = -3.0e38f; int bi = -1;
                for (int j = 0; j < n; ++j) if (!((msk >> j) & 1u)) { const float gv = gates[t * 16 + j]; if (gv > best) { best = gv; bi = j; } }
                if (bi >= 0) msk |= 1u << bi; }
            selm[t] = msk; atomicOr((unsigned*)&misc[1], msk);
        }
        __syncthreads();
        if (t == 0) {
            int nd = 0; const unsigned bm = (unsigned)misc[1];
            for (int kt = 0; kt <= qh * 2 + 1; ++kt) desc[nd++] = make_int4(b * S + n * 256 + kt * 64, kt * 64 - qh * 128, BIG, -1);
            for (int j = 0; j < n; ++j) if ((bm >> j) & 1u) for (int kt = 0; kt < 4; ++kt) desc[nd++] = make_int4(b * S + j * 256 + kt * 64, -BIG, BIG, j);
            misc[0] = nd;
        }
    } else {
        cfg = idx >> 9; const int rem = idx & 511; b = rem >> 7; h = (rem >> 5) & 3; const int rb = rem & 31;
        const int dil = 1 << (2 * cfg); const int res = rb & (dil - 1), blk = rb >> (2 * cfg);
        qbase = b * S + blk * 128 * dil + res; stride = dil; qcol = C_CQ + h * 64; kcol = C_CK + h * 64; vcol = C_CV + h * 64;
        if (t < 128) selm[t] = 0xffffffffu;
        if (t == 0) { int nd = 0; for (int kt = (blk == 0 ? 2 : 0); kt < 4; ++kt) desc[nd++] = make_int4(b * S + (blk * 128 - 128 + kt * 64) * dil + res, kt * 64 - 128, kt * 64, -1); misc[0] = nd; }
    }
    __syncthreads();
    const int nd = misc[0];
    bf16x8 qf[2][2];
#pragma unroll
    for (int qt = 0; qt < 2; ++qt)
#pragma unroll
        for (int ks = 0; ks < 2; ++ks) qf[qt][ks] = *(const bf16x8*)(z + (size_t)(qbase + (w * 32 + qt * 16 + r16) * stride) * ZP + qcol + ks * 32 + quad * 8);
    const unsigned sel0 = selm[w * 32 + r16], sel1 = selm[w * 32 + 16 + r16];
    float m[2] = {-1e30f, -1e30f}, l[2] = {0.f, 0.f}; f32x4 O[2][4];
#pragma unroll
    for (int a = 0; a < 2; ++a)
#pragma unroll
        for (int c = 0; c < 4; ++c) O[a][c] = (f32x4){0.f, 0.f, 0.f, 0.f};
    const int lrow = t >> 2, lch = (t & 3) * 2;
    u32x4 rk0, rk1, rv0, rv1;
    if (nd > 0) { const int4 d = desc[0]; const bf16_t* rp = z + (size_t)(d.x + lrow * stride) * ZP + lch * 8;
        rk0 = *(const u32x4*)(rp + kcol); rk1 = *(const u32x4*)(rp + kcol + 8); rv0 = *(const u32x4*)(rp + vcol); rv1 = *(const u32x4*)(rp + vcol + 8); }
    for (int i = 0; i < nd; ++i) {
        __syncthreads();
        *(u32x4*)(sK + lrow * LDP + lch * 8) = rk0; *(u32x4*)(sK + lrow * LDP + lch * 8 + 8) = rk1;
        *(u32x4*)(sV + lrow * LDP + lch * 8) = rv0; *(u32x4*)(sV + lrow * LDP + lch * 8 + 8) = rv1;
        __syncthreads();
        if (i + 1 < nd) { const int4 d = desc[i + 1]; const bf16_t* rp = z + (size_t)(d.x + lrow * stride) * ZP + lch * 8;
            rk0 = *(const u32x4*)(rp + kcol); rk1 = *(const u32x4*)(rp + kcol + 8); rv0 = *(const u32x4*)(rp + vcol); rv1 = *(const u32x4*)(rp + vcol + 8); }
        const int4 d = desc[i];
        bool need = (w * 32 + 31 >= d.y) && (w * 32 - 63 <= d.z);
        bool q0 = true, q1 = true;
        if (d.w >= 0) { q0 = (sel0 >> d.w) & 1u; q1 = (sel1 >> d.w) & 1u; need = need && (__ballot(q0 || q1) != 0ull); }
        const bool full = (w * 32 - 63 >= d.y) && (w * 32 + 31 <= d.z);
        if (need) attn_tile<2>(sK, sV, qf, d.y, d.z, full, d.w >= 0, q0, q1, m, l, O, w * 32);
    }
#pragma unroll
    for (int qt = 0; qt < 2; ++qt) {
        float lt = l[qt]; lt += __shfl_xor(lt, 16); lt += __shfl_xor(lt, 32);
        const float inv = 1.f / lt; const size_t tok = (size_t)(qbase + (w * 32 + qt * 16 + r16) * stride);
        if (kind == 0) {
            bf16_t* mix = (bf16_t*)(p.ws + WS_U);
#pragma unroll
            for (int dt = 0; dt < 4; ++dt) { const int d0 = dt * 16 + quad * 4; const u32x2 gv = *(const u32x2*)(z + tok * ZP + C_AG + h * 64 + d0);
                const float g0 = __uint_as_float(gv.x << 16), g1 = __uint_as_float(gv.x & 0xffff0000u), g2 = __uint_as_float(gv.y << 16), g3 = __uint_as_float(gv.y & 0xffff0000u);
                u32x2 o; o.x = pack2(O[qt][dt][0] * inv * silu_f(g0), O[qt][dt][1] * inv * silu_f(g1)); o.y = pack2(O[qt][dt][2] * inv * silu_f(g2), O[qt][dt][3] * inv * silu_f(g3));
                *(u32x2*)(mix + tok * 1024 + h * 64 + d0) = o; }
        } else {
            bf16_t* dilo = (bf16_t*)(p.ws + WS_DILO); float* dill = (float*)(p.ws + WS_DILL);
#pragma unroll
            for (int dt = 0; dt < 4; ++dt) { const int d0 = dt * 16 + quad * 4; u32x2 o; o.x = pack2(O[qt][dt][0] * inv, O[qt][dt][1] * inv); o.y = pack2(O[qt][dt][2] * inv, O[qt][dt][3] * inv);
                *(u32x2*)(dilo + ((size_t)cfg * T + tok) * 256 + h * 64 + d0) = o; }
            if (quad == 0) dill[((size_t)cfg * T + tok) * 4 + h] = m[qt] * 0.125f + __logf(lt);
        }
    }
}

__device__ void moba_item(const Params& p, int idx, char* smem, bf16_t* outp) {
    const int t = tid_opq(), lane = t & 63, w = t >> 6, r16 = lane & 15, quad = lane >> 4;
    bf16_t* sK = (bf16_t*)smem; bf16_t* sV = sK + 64 * LDP;
    float* stO = (float*)(smem + 18432);
    float* kmean = (float*)(smem + 18432); float* gates = (float*)(smem + 22528);
    float* stM = (float*)(smem + 53248); float* stL = (float*)(smem + 53760);
    unsigned* selm = (unsigned*)(smem + 54272); unsigned char* lists = (unsigned char*)(smem + 54784);
    int* cnt = (int*)(smem + 56832); int4* desc = (int4*)(smem + 56960); int* misc = (int*)(smem + 59008);
    const bf16_t* z = (const bf16_t*)(p.ws + WS_Z);
    const int n = 15 - (idx >> 5); const int rem = idx & 31; const int b = rem >> 3, h = (rem >> 1) & 3, qh = rem & 1;
    const int qbase = b * S + n * 256 + qh * 128, qcol = C_AQ + h * 64, kcol = C_AK + h * 64, vcol = C_AV + h * 64;
    __syncthreads();
    {
        const float* kpart = (const float*)(p.ws + WS_KPART);
        for (int e = t; e < n * 64; e += 256) { const int j = e >> 6, d = e & 63; const float* kp = kpart + (size_t)(b * 64 + j * 4) * 256 + h * 64 + d;
            kmean[e] = ((kp[0] + kp[256]) + (kp[512] + kp[768])) * (1.f / 256.f); }
        if (t < 16) cnt[t] = 0;
        __syncthreads();
        {
            const int ql = t >> 1, half = t & 1; const bf16_t* qp = z + (size_t)(qbase + ql) * ZP + qcol;
            float g[8];
#pragma unroll
            for (int jj = 0; jj < 8; ++jj) g[jj] = 0.f;
#pragma unroll 1
            for (int dc = 0; dc < 8; ++dc) {
                const u32x4 qv = *(const u32x4*)(qp + dc * 8); float qq[8];
#pragma unroll
                for (int e = 0; e < 4; ++e) { qq[2 * e] = __uint_as_float(qv[e] << 16); qq[2 * e + 1] = __uint_as_float(qv[e] & 0xffff0000u); }
#pragma unroll
                for (int jj = 0; jj < 8; ++jj) { const int j = half + 2 * jj; if (j < n) { const float* km = kmean + j * 64 + dc * 8;
#pragma unroll
                    for (int e = 0; e < 8; ++e) g[jj] += qq[e] * km[e]; } }
            }
#pragma unroll
            for (int jj = 0; jj < 8; ++jj) gates[ql * 16 + half + 2 * jj] = g[jj];
        }
        __syncthreads();
        if (t < 128) {
            unsigned msk = 0;
            for (int k = 0; k < 3 && k < n; ++k) { float best = -3.0e38f; int bi = -1;
                for (int j = 0; j < n; ++j) if (!((msk >> j) & 1u)) { const float gv = gates[t * 16 + j]; if (gv > best) { best = gv; bi = j; } }
                if (bi >= 0) msk |= 1u << bi; }
            selm[t] = msk;
            for (int j = 0; j < n; ++j) if ((msk >> j) & 1u) { const int pos = atomicAdd(&cnt[j], 1); lists[j * 128 + pos] = (unsigned char)t; }
        }
        __syncthreads();
        if (t < 128) { for (int j = 0; j < n; ++j) { const int cj = cnt[j]; if (t >= cj && t < ((cj + 15) & ~15)) lists[j * 128 + t] = 255; } }
        if (t == 0) {
            int nd = 0;
            for (int kt = 0; kt <= qh * 2 + 1; ++kt) desc[nd++] = make_int4(b * S + n * 256 + kt * 64, kt * 64 - qh * 128, BIG, -1);
            misc[1] = nd;
            for (int j = 0; j < n; ++j) { const int ntl = (cnt[j] + 15) >> 4;
                for (int ps = 0; ps * 4 < ntl; ++ps) for (int kt = 0; kt < 4; ++kt) desc[nd++] = make_int4(b * S + j * 256 + kt * 64, ps, kt, j); }
            misc[0] = nd;
        }
    }
    __syncthreads();
    const int nd = misc[0], nown = misc[1];
    const int lrow = t >> 2, lch = (t & 3) * 2;
    u32x4 rk0, rk1, rv0, rv1;
    { const int4 d = desc[0]; const bf16_t* rp = z + (size_t)(d.x + lrow) * ZP + lch * 8;
      rk0 = *(const u32x4*)(rp + kcol); rk1 = *(const u32x4*)(rp + kcol + 8); rv0 = *(const u32x4*)(rp + vcol); rv1 = *(const u32x4*)(rp + vcol + 8); }
    bf16x8 nqf[2]; int ngq = 0; bool ngv = false, nhas = false;
    auto prefetch_group = [&](int gi) {
        nhas = false;
        if (gi < nd) { const int4 dg = desc[gi]; const int slot = dg.y * 4 + w; nhas = slot * 16 < cnt[dg.w];
            if (nhas) { const int qi = lists[dg.w * 128 + slot * 16 + r16]; ngv = qi != 255; ngq = ngv ? qi : 0;
#pragma unroll
                for (int ks = 0; ks < 2; ++ks) nqf[ks] = *(const bf16x8*)(z + (size_t)(qbase + ngq) * ZP + qcol + ks * 32 + quad * 8); } }
    };
    prefetch_group(nown);
    {
        bf16x8 qf[2][2];
#pragma unroll
        for (int qt = 0; qt < 2; ++qt)
#pragma unroll
            for (int ks = 0; ks < 2; ++ks) qf[qt][ks] = *(const bf16x8*)(z + (size_t)(qbase + w * 32 + qt * 16 + r16) * ZP + qcol + ks * 32 + quad * 8);
        float m[2] = {-1e30f, -1e30f}, l[2] = {0.f, 0.f}; f32x4 O[2][4];
#pragma unroll
        for (int a = 0; a < 2; ++a)
#pragma unroll
            for (int c = 0; c < 4; ++c) O[a][c] = (f32x4){0.f, 0.f, 0.f, 0.f};
        for (int i = 0; i < nown; ++i) {
            __syncthreads();
            *(u32x4*)(sK + lrow * LDP + lch * 8) = rk0; *(u32x4*)(sK + lrow * LDP + lch * 8 + 8) = rk1;
            *(u32x4*)(sV + lrow * LDP + lch * 8) = rv0; *(u32x4*)(sV + lrow * LDP + lch * 8 + 8) = rv1;
            __syncthreads();
            if (i + 1 < nd) { const int4 d = desc[i + 1]; const bf16_t* rp = z + (size_t)(d.x + lrow) * ZP + lch * 8;
                rk0 = *(const u32x4*)(rp + kcol); rk1 = *(const u32x4*)(rp + kcol + 8); rv0 = *(const u32x4*)(rp + vcol); rv1 = *(const u32x4*)(rp + vcol + 8); }
            const int4 d = desc[i];
            const bool need = (w * 32 + 31 >= d.y) && (w * 32 - 63 <= d.z);
            const bool full = (w * 32 - 63 >= d.y) && (w * 32 + 31 <= d.z);
            if (need) attn_tile<2>(sK, sV, qf, d.y, d.z, full, false, true, true, m, l, O, w * 32);
        }
#pragma unroll
        for (int qt = 0; qt < 2; ++qt) {
            float lt = l[qt]; lt += __shfl_xor(lt, 16); lt += __shfl_xor(lt, 32);
            const int ql = w * 32 + qt * 16 + r16;
            if (quad == 0) { stM[ql] = m[qt]; stL[ql] = lt; }
#pragma unroll
            for (int dt = 0; dt < 4; ++dt) *(f32x4*)(stO + ql * 68 + dt * 16 + quad * 4) = O[qt][dt];
        }
    }
    {
        bf16x8 qf[1][2]; float m[1] = {-1e30f}, l[1] = {0.f}; f32x4 O[1][4];
        int gq = 0; bool gv = false, has = false;
        for (int i = nown; i < nd; ++i) {
            __syncthreads();
            *(u32x4*)(sK + lrow * LDP + lch * 8) = rk0; *(u32x4*)(sK + lrow * LDP + lch * 8 + 8) = rk1;
            *(u32x4*)(sV + lrow * LDP + lch * 8) = rv0; *(u32x4*)(sV + lrow * LDP + lch * 8 + 8) = rv1;
            __syncthreads();
            if (i + 1 < nd) { const int4 d = desc[i + 1]; const bf16_t* rp = z + (size_t)(d.x + lrow) * ZP + lch * 8;
                rk0 = *(const u32x4*)(rp + kcol); rk1 = *(const u32x4*)(rp + kcol + 8); rv0 = *(const u32x4*)(rp + vcol); rv1 = *(const u32x4*)(rp + vcol + 8); }
            const int4 d = desc[i];
            if (d.z == 0) {
                has = nhas; gv = ngv; gq = ngq; qf[0][0] = nqf[0]; qf[0][1] = nqf[1];
                m[0] = -1e30f; l[0] = 0.f;
#pragma unroll
                for (int c = 0; c < 4; ++c) O[0][c] = (f32x4){0.f, 0.f, 0.f, 0.f};
                prefetch_group(i + 4);
            }
            if (has) {
                attn_tile<1>(sK, sV, qf, -BIG, BIG, true, false, true, true, m, l, O, 0);
                if (d.z == 3) {
                    float lt = l[0]; lt += __shfl_xor(lt, 16); lt += __shfl_xor(lt, 32);
                    if (gv) {
                        const float mo = stM[gq], lo_ = stL[gq]; const float mn = fmaxf(mo, m[0]);
                        const float fa = __builtin_amdgcn_exp2f((mo - mn) * ATT_SC), fb = __builtin_amdgcn_exp2f((m[0] - mn) * ATT_SC);
#pragma unroll
                        for (int dt = 0; dt < 4; ++dt) { float* sp = stO + gq * 68 + dt * 16 + quad * 4; const f32x4 so = *(const f32x4*)sp; *(f32x4*)sp = so * fa + O[0][dt] * fb; }
                        if (quad == 0) { stM[gq] = mn; stL[gq] = lo_ * fa + lt * fb; }
                    }
                }
            }
        }
    }
    __syncthreads();
#pragma unroll
    for (int qt = 0; qt < 2; ++qt) {
        const int ql = w * 32 + qt * 16 + r16; const float inv = 1.f / stL[ql]; const size_t tok = (size_t)(qbase + ql);
#pragma unroll
        for (int dt = 0; dt < 4; ++dt) { const int d0 = dt * 16 + quad * 4; const f32x4 ov = *(const f32x4*)(stO + ql * 68 + d0);
            const u32x2 gvv = *(const u32x2*)(z + tok * ZP + C_AG + h * 64 + d0);
            const float g0 = __uint_as_float(gvv.x << 16), g1 = __uint_as_float(gvv.x & 0xffff0000u), g2 = __uint_as_float(gvv.y << 16), g3 = __uint_as_float(gvv.y & 0xffff0000u);
            u32x2 o; o.x = pack2(ov[0] * inv * silu_f(g0), ov[1] * inv * silu_f(g1)); o.y = pack2(ov[2] * inv * silu_f(g2), ov[3] * inv * silu_f(g3));
            *(u32x2*)(outp + tok * 1024 + h * 64 + d0) = o; }
    }
}

__device__ __forceinline__ void gla_bcum(const Params& p, int l, const bf16_t* z, int tok0, float* bc, float* drs) {
    const int t = tid_opq();
    const int hd = t & 127, ih = t >> 7;
    float wr[16];
#pragma unroll
    for (int r = 0; r < 16; ++r) wr[r] = p.gla_wr[l * 2048 + r * 128 + hd];
    const float br = p.gla_br[l * 128 + hd];
    { const int e0 = t, e1 = t + 256; const bf16_t d0 = z[(size_t)(tok0 + (e0 >> 4)) * ZP + C_DR + (e0 & 15)], d1 = z[(size_t)(tok0 + (e1 >> 4)) * ZP + C_DR + (e1 & 15)];
      drs[e0] = bf2f(d0); drs[e1] = bf2f(d1); }
    __syncthreads();
#pragma unroll
    for (int ii = 0; ii < 16; ++ii) { const int i = ih * 16 + ii; float x = br;
#pragma unroll
        for (int r4 = 0; r4 < 4; ++r4) { const f32x4 dv = *(const f32x4*)(drs + i * 16 + r4 * 4); x += (dv[0] * wr[r4 * 4] + dv[1] * wr[r4 * 4 + 1]) + (dv[2] * wr[r4 * 4 + 2] + dv[3] * wr[r4 * 4 + 3]); }
        bc[i * 128 + hd] = (fminf(x, 0.f) - __logf(1.f + __expf(-fabsf(x)))) * (1.f / 16.f); }
    __syncthreads();
    if (t < 128) { float sacc = 0.f;
#pragma unroll
        for (int i = 0; i < 32; ++i) { sacc += bc[i * 128 + t]; bc[i * 128 + t] = sacc; } }
    __syncthreads();
}

__device__ void gla1_item(const Params& p, int l, int idx, char* smem) {
    const int t = tid_opq(), lane = t & 63, w = t >> 6, r16 = lane & 15, quad = lane >> 4;
    const int b = idx >> 7, c = idx & 127; const int tok0 = b * S + c * 32;
    const bf16_t* z = (const bf16_t*)(p.ws + WS_Z);
    float* bc = (float*)smem; float* drs = (float*)(smem + 16384);
    bf16_t* kdT = (bf16_t*)(smem + 18432) + w * 1024;
    bf16_t* vL = (bf16_t*)(smem + 26624) + w * (32 * LDP);
    float* gkv = (float*)(p.ws + WS_GKV); float* gdec = (float*)(p.ws + WS_GDEC);
    bf16_t kraw[16]; u32x4 vr[4];
#pragma unroll
    for (int i = 0; i < 16; ++i) { const int e = lane + 64 * i; kraw[i] = z[(size_t)(tok0 + (e >> 5)) * ZP + C_DK + w * 32 + (e & 31)]; }
#pragma unroll
    for (int i = 0; i < 4; ++i) { const int cc = lane + 64 * i; vr[i] = *(const u32x4*)(z + (size_t)(tok0 + (cc >> 3)) * ZP + C_DV + w * 64 + (cc & 7) * 8); }
    __syncthreads();
#pragma unroll
    for (int i = 0; i < 4; ++i) { const int cc = lane + 64 * i; *(u32x4*)(vL + (cc >> 3) * LDP + (cc & 7) * 8) = vr[i]; }
    gla_bcum(p, l, z, tok0, bc, drs);
    { float* bcg = (float*)(p.ws + WS_BC) + (size_t)idx * 4096;
#pragma unroll
      for (int i = 0; i < 4; ++i) *(f32x4*)(bcg + (t + 256 * i) * 4) = *(const f32x4*)(bc + (t + 256 * i) * 4); }
#pragma unroll
    for (int i = 0; i < 16; ++i) { const int e = lane + 64 * i; const int j = e >> 5, d = e & 31;
        kdT[d * 32 + j] = f2bf(bf2f(kraw[i]) * __expf(bc[31 * 128 + w * 32 + d] - bc[j * 128 + w * 32 + d])); }
    const int bh = b * 4 + w;
    if (lane < 32) gdec[(bh * 128 + c) * 32 + lane] = __expf(bc[31 * 128 + w * 32 + lane]);
    __syncthreads();
    bf16x8 kf[2];
#pragma unroll
    for (int x = 0; x < 2; ++x) kf[x] = *(const bf16x8*)(kdT + (x * 16 + r16) * 32 + quad * 8);
    float* dst = gkv + (size_t)(bh * 128 + c) * 2048;
#pragma unroll
    for (int dt = 0; dt < 4; ++dt) {
        const bf16_t* v0p = vL + (quad * 8 + (r16 >> 2)) * LDP + dt * 16 + (r16 & 3) * 4;
        const bf16x4 v0 = __builtin_amdgcn_ds_read_tr16_b64_v4i16((__attribute__((address_space(3))) bf16x4*)(v0p));
        const bf16x4 v1 = __builtin_amdgcn_ds_read_tr16_b64_v4i16((__attribute__((address_space(3))) bf16x4*)(v0p + 4 * LDP));
        const bf16x8 vf = {v0[0], v0[1], v0[2], v0[3], v1[0], v1[1], v1[2], v1[3]};
#pragma unroll
        for (int x = 0; x < 2; ++x) {
            const f32x4 r = __builtin_amdgcn_mfma_f32_16x16x32_bf16(vf, kf[x], (f32x4){0.f, 0.f, 0.f, 0.f}, 0, 0, 0);
            *(f32x4*)(dst + (x * 16 + r16) * 64 + dt * 16 + quad * 4) = r;
        }
    }
}

#define OPQ(ptr) asm volatile("" : "+v"(ptr))
__device__ void gla3_item(const Params& p, int l, int idx, char* smem) {
    const int t = tid_opq(), lane = t & 63, w = t >> 6, r16 = lane & 15, quad = lane >> 4;
    const int b = idx >> 7, c = idx & 127; const int tok0 = b * S + c * 32;
    const bf16_t* z = (const bf16_t*)(p.ws + WS_Z); bf16_t* mix = (bf16_t*)(p.ws + WS_U);
    float* bc = (float*)smem; float* drs = (float*)(smem + 16384);
    bf16_t* SL = (bf16_t*)smem + w * (32 * LDP);
    bf16_t* qe = (bf16_t*)(smem + 18432) + w * 1024;
    bf16_t* ke = (bf16_t*)(smem + 26624) + w * 1024;
    bf16_t* vL = (bf16_t*)(smem + 34816) + w * (32 * LDP);
    const float* gkv = (const float*)(p.ws + WS_GKV);
    const int bh = b * 4 + w;
    bf16_t qraw[16], kraw[16];
    { const bf16_t* qp = z + (size_t)(tok0 + (lane >> 5)) * ZP + w * 32 + (lane & 31);
#pragma unroll
      for (int i = 0; i < 16; ++i) { qraw[i] = qp[C_DQ]; kraw[i] = qp[C_DK]; qp += 2 * ZP; OPQ(qp); } }
    u32x4 vr[4]; f32x4 sr[8];
#pragma unroll
    for (int i = 0; i < 4; ++i) { const int cc = lane + 64 * i; vr[i] = *(const u32x4*)(z + (size_t)(tok0 + (cc >> 3)) * ZP + C_DV + w * 64 + (cc & 7) * 8); }
    { const float* Sp = gkv + (size_t)(bh * 128 + c) * 2048;
#pragma unroll
      for (int i = 0; i < 8; ++i) sr[i] = *(const f32x4*)(Sp + (lane + 64 * i) * 4); }
    f32x4 bcr[4];
    { const float* bcg = (const float*)(p.ws + WS_BC) + (size_t)idx * 4096;
#pragma unroll
      for (int i = 0; i < 4; ++i) bcr[i] = *(const f32x4*)(bcg + (t + 256 * i) * 4); }
    __syncthreads();
#pragma unroll
    for (int i = 0; i < 4; ++i) { const int cc = lane + 64 * i; *(u32x4*)(vL + (cc >> 3) * LDP + (cc & 7) * 8) = vr[i]; }
#pragma unroll
    for (int i = 0; i < 4; ++i) *(f32x4*)(bc + (t + 256 * i) * 4) = bcr[i];
    __syncthreads();
#pragma unroll
    for (int i2 = 0; i2 < 16; ++i2) { const int e = lane + 64 * i2; const int i = e >> 5, d = e & 31; const float bcv = bc[i * 128 + w * 32 + d];
        qe[i * 32 + d] = f2bf(bf2f(qraw[i2]) * __expf(bcv) * 0.17677669529663687f); ke[i * 32 + d] = f2bf(bf2f(kraw[i2]) * __expf(-bcv)); }
    __syncthreads();
#pragma unroll
    for (int i = 0; i < 8; ++i) { const int cc = lane + 64 * i; const int d = cc >> 4, v4 = cc & 15; u32x2 pk; pk.x = pack2(sr[i][0], sr[i][1]); pk.y = pack2(sr[i][2], sr[i][3]);
        *(u32x2*)(SL + d * LDP + v4 * 4) = pk; }
    __syncthreads();
    bf16x8 qf[2], kf[2];
#pragma unroll
    for (int x = 0; x < 2; ++x) { qf[x] = *(const bf16x8*)(qe + (x * 16 + r16) * 32 + quad * 8); kf[x] = *(const bf16x8*)(ke + (x * 16 + r16) * 32 + quad * 8); }
    bf16x8 pf[2];
#pragma unroll
    for (int it = 0; it < 2; ++it) {
        f32x4 at[2];
#pragma unroll
        for (int jt = 0; jt < 2; ++jt) { at[jt] = __builtin_amdgcn_mfma_f32_16x16x32_bf16(kf[jt], qf[it], (f32x4){0.f, 0.f, 0.f, 0.f}, 0, 0, 0);
#pragma unroll
            for (int jj = 0; jj < 4; ++jj) at[jt][jj] = (jt * 16 + quad * 4 + jj <= it * 16 + r16) ? at[jt][jj] : 0.f; }
        u32x4 pk = {pack2(at[0][0], at[0][1]), pack2(at[0][2], at[0][3]), pack2(at[1][0], at[1][1]), pack2(at[1][2], at[1][3])};
        pf[it] = __builtin_bit_cast(bf16x8, pk);
    }
    f32x4 O[2][4];
#pragma unroll
    for (int dt = 0; dt < 4; ++dt) {
        const bf16_t* v0p = vL + (quad * 4 + (r16 >> 2)) * LDP + dt * 16 + (r16 & 3) * 4;
        const bf16x4 v0 = __builtin_amdgcn_ds_read_tr16_b64_v4i16((__attribute__((address_space(3))) bf16x4*)(v0p));
        const bf16x4 v1 = __builtin_amdgcn_ds_read_tr16_b64_v4i16((__attribute__((address_space(3))) bf16x4*)(v0p + 16 * LDP));
        const bf16x8 vf = {v0[0], v0[1], v0[2], v0[3], v1[0], v1[1], v1[2], v1[3]};
        const bf16_t* s0p = SL + (quad * 8 + (r16 >> 2)) * LDP + dt * 16 + (r16 & 3) * 4;
        const bf16x4 s0 = __builtin_amdgcn_ds_read_tr16_b64_v4i16((__attribute__((address_space(3))) bf16x4*)(s0p));
        const bf16x4 s1 = __builtin_amdgcn_ds_read_tr16_b64_v4i16((__attribute__((address_space(3))) bf16x4*)(s0p + 4 * LDP));
        const bf16x8 sf = {s0[0], s0[1], s0[2], s0[3], s1[0], s1[1], s1[2], s1[3]};
#pragma unroll
        for (int it = 0; it < 2; ++it) {
            O[it][dt] = __builtin_amdgcn_mfma_f32_16x16x32_bf16(vf, pf[it], (f32x4){0.f, 0.f, 0.f, 0.f}, 0, 0, 0);
            O[it][dt] = __builtin_amdgcn_mfma_f32_16x16x32_bf16(sf, qf[it], O[it][dt], 0, 0, 0);
        }
    }
#pragma unroll
    for (int it = 0; it < 2; ++it) {
        float ss = 0.f;
#pragma unroll
        for (int dt = 0; dt < 4; ++dt) ss += (O[it][dt][0] * O[it][dt][0] + O[it][dt][1] * O[it][dt][1]) + (O[it][dt][2] * O[it][dt][2] + O[it][dt][3] * O[it][dt][3]);
        ss += __shfl_xor(ss, 16); ss += __shfl_xor(ss, 32);
        const float rn = rsqrtf(ss * (1.f / 64.f) + 1e-5f);
        const size_t tok = (size_t)(tok0 + it * 16 + r16);
#pragma unroll
        for (int dt = 0; dt < 4; ++dt) { const int v0i = dt * 16 + quad * 4; const f32x4 gn = *(const f32x4*)(p.gla_gn + l * 64 + v0i);
            const u32x2 gv = *(const u32x2*)(z + tok * ZP + C_DG + w * 64 + v0i);
            const float g0 = __uint_as_float(gv.x << 16), g1 = __uint_as_float(gv.x & 0xffff0000u), g2 = __uint_as_float(gv.y << 16), g3 = __uint_as_float(gv.y & 0xffff0000u);
            u32x2 o; o.x = pack2(O[it][dt][0] * rn * gn[0] * silu_f(g0), O[it][dt][1] * rn * gn[1] * silu_f(g1));
            o.y = pack2(O[it][dt][2] * rn * gn[2] * silu_f(g2), O[it][dt][3] * rn * gn[3] * silu_f(g3));
            *(u32x2*)(mix + tok * 1024 + 768 + w * 64 + v0i) = o; }
    }
}

__device__ void lru1_item(const Params& p, int l, int idx, char* smem) {
    const int t = tid_opq(), lane = t & 63, g = t >> 6, r16 = lane & 15, quad = lane >> 4; const int ch = t;
    const int b = idx >> 7, c = idx & 127; const int s0 = c * 32; const int tok0 = b * S + s0;
    const bf16_t* z = (const bf16_t*)(p.ws + WS_Z); float* xcs = (float*)smem;
    bf16_t* preA = (bf16_t*)(smem + 32768); bf16_t* preX = (bf16_t*)(smem + 49152);
    float* lh = (float*)(p.ws + WS_LH); float* lp = (float*)(p.ws + WS_LP);
    bf16_t xr[35];
#pragma unroll
    for (int i = 0; i < 35; ++i) { const int sidx = s0 + i - 3; xr[i] = (sidx >= 0) ? z[(size_t)(tok0 + i - 3) * ZP + C_BX + ch] : (bf16_t)0; }
    const float cw0 = p.conv_w[l * 1024 + ch], cw1 = p.conv_w[l * 1024 + 256 + ch], cw2 = p.conv_w[l * 1024 + 512 + ch], cw3 = p.conv_w[l * 1024 + 768 + ch];
    const float cb = p.conv_b[l * 256 + ch];
    const bf16_t* lwt = (const bf16_t*)(p.ws + WS_LWT) + (size_t)l * 32768 + g * 4096;
    bf16x8 wfa[4][2], wfx[4][2];
#pragma unroll
    for (int nt = 0; nt < 4; ++nt)
#pragma unroll
        for (int ks = 0; ks < 2; ++ks) { wfa[nt][ks] = *(const bf16x8*)(lwt + (nt * 16 + r16) * 64 + ks * 32 + quad * 8); wfx[nt][ks] = *(const bf16x8*)(lwt + 16384 + (nt * 16 + r16) * 64 + ks * 32 + quad * 8); }
    __syncthreads();
#pragma unroll
    for (int i = 0; i < 32; ++i) xcs[i * 256 + ch] = cb + (cw0 * bf2f(xr[i]) + cw1 * bf2f(xr[i + 1])) + (cw2 * bf2f(xr[i + 2]) + cw3 * bf2f(xr[i + 3]));
    __syncthreads();
#pragma unroll
    for (int tt = 0; tt < 2; ++tt) {
        bf16x8 xf[2];
#pragma unroll
        for (int ks = 0; ks < 2; ++ks) { const float* xp = xcs + (tt * 16 + r16) * 256 + g * 64 + ks * 32 + quad * 8; const f32x4 x0 = *(const f32x4*)xp, x1 = *(const f32x4*)(xp + 4);
            u32x4 pk = {pack2(x0[0], x0[1]), pack2(x0[2], x0[3]), pack2(x1[0], x1[1]), pack2(x1[2], x1[3])}; xf[ks] = __builtin_bit_cast(bf16x8, pk); }
#pragma unroll
        for (int nt = 0; nt < 4; ++nt) {
            f32x4 ra = __builtin_amdgcn_mfma_f32_16x16x32_bf16(wfa[nt][0], xf[0], (f32x4){0.f, 0.f, 0.f, 0.f}, 0, 0, 0); ra = __builtin_amdgcn_mfma_f32_16x16x32_bf16(wfa[nt][1], xf[1], ra, 0, 0, 0);
            f32x4 rx = __builtin_amdgcn_mfma_f32_16x16x32_bf16(wfx[nt][0], xf[0], (f32x4){0.f, 0.f, 0.f, 0.f}, 0, 0, 0); rx = __builtin_amdgcn_mfma_f32_16x16x32_bf16(wfx[nt][1], xf[1], rx, 0, 0, 0);
            u32x2 pa; pa.x = pack2(ra[0], ra[1]); pa.y = pack2(ra[2], ra[3]); u32x2 px; px.x = pack2(rx[0], rx[1]); px.y = pack2(rx[2], rx[3]);
            *(u32x2*)(preA + (tt * 16 + r16) * 256 + g * 64 + nt * 16 + quad * 4) = pa; *(u32x2*)(preX + (tt * 16 + r16) * 256 + g * 64 + nt * 16 + quad * 4) = px;
        }
    }
    __syncthreads();
    const float ba = p.lru_ba[l * 256 + ch], bx = p.lru_bx[l * 256 + ch], lam = p.lru_lam[l * 256 + ch];
    const float sp = fmaxf(-lam, 0.f) + log1pf(__expf(-fabsf(lam)));
    float hh = 0.f, P = 1.f;
    float* lhp = lh + (size_t)tok0 * 256 + ch; float* lpp = lp + (size_t)tok0 * 256 + ch;
#pragma unroll 4
    for (int i = 0; i < 32; ++i) { const float r = sigmoid_f(bf2f(preA[i * 256 + ch]) + ba), ig = sigmoid_f(bf2f(preX[i * 256 + ch]) + bx); const float la = -8.f * r * sp; const float a = __expf(la);
        const float w2 = 2.f * la;
        const float em_s = -w2 * (1.f + w2 * (0.5f + w2 * (0.16666667f + w2 * (0.041666668f + w2 * (0.0083333338f + w2 * 0.0013888889f)))));
        const float em = (w2 > -0.25f) ? em_s : (1.f - a * a);
        const float u = __builtin_amdgcn_sqrtf(em) * (ig * xcs[i * 256 + ch]); hh = a * hh + u; P *= a;
        lhp[(size_t)i * 256] = hh; lpp[(size_t)i * 256] = P; }
}

__device__ void lru3_item(const Params& p, int idx) {
    const int ch = tid_opq(); const int b = idx >> 7, c = idx & 127; const int tok0 = b * S + c * 32;
    const bf16_t* z = (const bf16_t*)(p.ws + WS_Z); bf16_t* mix = (bf16_t*)(p.ws + WS_U);
    const float* lh = (const float*)(p.ws + WS_LH); const float* lp = (const float*)(p.ws + WS_LP); const float* lc = (const float*)(p.ws + WS_LC);
    const float carry = lc[(size_t)(b * 128 + c) * 256 + ch];
    float hv[32], pv[32]; bf16_t gv[32];
#pragma unroll
    for (int i = 0; i < 32; ++i) { const size_t tok = (size_t)(tok0 + i); hv[i] = lh[tok * 256 + ch]; pv[i] = lp[tok * 256 + ch]; gv[i] = z[tok * ZP + C_BG + ch]; }
#pragma unroll
    for (int i = 0; i < 32; ++i) { const size_t tok = (size_t)(tok0 + i); mix[tok * 1024 + 256 + ch] = f2bf((hv[i] + pv[i] * carry) * silu_f(bf2f(gv[i]))); }
}

__device__ void dilc_item(const Params& p, int idx) {
    const int t = tid_opq(); const size_t tok = (size_t)idx * 8 + (t >> 5); const int chn = t & 31; const int h = chn >> 3;
    const bf16_t* z = (const bf16_t*)(p.ws + WS_Z); bf16_t* mix = (bf16_t*)(p.ws + WS_U);
    const bf16_t* dilo = (const bf16_t*)(p.ws + WS_DILO); const float* dill = (const float*)(p.ws + WS_DILL);
    const float l0 = dill[((size_t)0 * T + tok) * 4 + h], l1 = dill[((size_t)1 * T + tok) * 4 + h], l2 = dill[((size_t)2 * T + tok) * 4 + h];
    const float mx = fmaxf(l0, fmaxf(l1, l2)); float w0 = __expf(l0 - mx), w1 = __expf(l1 - mx), w2 = __expf(l2 - mx); const float inv = 1.f / (w0 + w1 + w2); w0 *= inv; w1 *= inv; w2 *= inv;
    const u32x4 o0 = *(const u32x4*)(dilo + ((size_t)0 * T + tok) * 256 + chn * 8), o1 = *(const u32x4*)(dilo + ((size_t)1 * T + tok) * 256 + chn * 8), o2 = *(const u32x4*)(dilo + ((size_t)2 * T + tok) * 256 + chn * 8);
    const u32x4 gv = *(const u32x4*)(z + tok * ZP + C_CG + chn * 8);
    u32x4 r;
#pragma unroll
    for (int e = 0; e < 4; ++e) {
        const float a = w0 * __uint_as_float(o0[e] << 16) + w1 * __uint_as_float(o1[e] << 16) + w2 * __uint_as_float(o2[e] << 16);
        const float bq = w0 * __uint_as_float(o0[e] & 0xffff0000u) + w1 * __uint_as_float(o1[e] & 0xffff0000u) + w2 * __uint_as_float(o2[e] & 0xffff0000u);
        r[e] = pack2(a * silu_f(__uint_as_float(gv[e] << 16)), bq * silu_f(__uint_as_float(gv[e] & 0xffff0000u)));
    }
    *(u32x4*)(mix + tok * 1024 + 512 + chn * 8) = r;
}

__device__ void m2_phase(const Params& p, char* smem) {
    float* gkv = (float*)(p.ws + WS_GKV); const float* gdec = (const float*)(p.ws + WS_GDEC);
    const float* lh = (const float*)(p.ws + WS_LH); const float* lp = (const float*)(p.ws + WS_LP); float* lc = (float*)(p.ws + WS_LC);
    float* aggP = (float*)smem; float* aggS = aggP + 256;
    const int t = tid_opq(); const int e = t & 31, seg = t >> 5;
    for (int it = blockIdx.x; it < 1024 + 32; it += gridDim.x) {
        float a[16], x[16];
        size_t ostride;
        float* outp;
        if (it < 1024) {
            const int gid = it * 32 + e; const int bh = gid >> 11, dv = gid & 2047, d = dv >> 6;
            float* base = gkv + (size_t)bh * 128 * 2048 + dv + (size_t)(seg * 16) * 2048; const float* dc = gdec + (size_t)bh * 128 * 32 + d + (seg * 16) * 32;
#pragma unroll
            for (int k = 0; k < 16; ++k) { x[k] = base[(size_t)k * 2048]; a[k] = dc[k * 32]; }
            outp = base; ostride = 2048;
        } else {
            const int i2 = it - 1024; const int b = i2 >> 3, ch = (i2 & 7) * 32 + e;
#pragma unroll
            for (int k = 0; k < 16; ++k) { const size_t ix = (size_t)(b * S + (seg * 16 + k) * 32 + 31) * 256 + ch; a[k] = lp[ix]; x[k] = lh[ix]; }
            outp = lc + (size_t)(b * 128 + seg * 16) * 256 + ch; ostride = 256;
        }
        float st = 0.f, pr = 1.f;
#pragma unroll
        for (int k = 0; k < 16; ++k) { const float ak = a[k], xk = x[k]; a[k] = pr; x[k] = st; st = ak * st + xk; pr *= ak; }
        __syncthreads();
        aggP[seg * 32 + e] = pr; aggS[seg * 32 + e] = st;
        __syncthreads();
        float carry = 0.f;
        for (int s2 = 0; s2 < seg; ++s2) carry = aggP[s2 * 32 + e] * carry + aggS[s2 * 32 + e];
#pragma unroll
        for (int k = 0; k < 16; ++k) outp[(size_t)k * ostride] = x[k] + a[k] * carry;
    }
}

__global__ void __launch_bounds__(256, 2) fwd_megakernel(Params p) {
    __shared__ __attribute__((aligned(16))) char smem[SMEM_BYTES];
    __shared__ uint4 xb_words;
    __shared__ int s_slot;
    cg::grid_group grid = cg::this_grid();
    if (p.out == nullptr) grid.sync();
    if (threadIdx.x == 0) xb_words = make_uint4(0u, 0u, 0u, 0u);
    __syncthreads();
    const XcdBarrier xb = xcd_barrier_post((unsigned*)(p.ws + WS_CTL), (volatile LAS unsigned*)&xb_words);
    unsigned* cnt = (unsigned*)(p.ws + WS_CNT);
    prologue_phase(p, smem);
    xcd_barrier(xb);
#pragma unroll 1
    for (int l = 0; l < DEPTH; ++l) {
        ln_phase(p, l);
        xcd_barrier(xb);
        g1_phase(p, l, smem);
        xcd_barrier(xb);
        for (;;) { const int it = next_item(cnt + (4 + l) * 64, &s_slot); if (it >= 512) break; lru1_item(p, l, it, smem); }
        for (;;) { const int it = next_item(cnt + (0 + l) * 64, &s_slot); if (it >= 512) break; moba_item(p, it, smem, (bf16_t*)(p.ws + WS_U)); }
        for (;;) { const int it = next_item(cnt + (6 + l) * 64, &s_slot); if (it >= 1536) break; attn_item(p, 1, it, smem); }
        for (;;) { const int it = next_item(cnt + (2 + l) * 64, &s_slot); if (it >= 512) break; gla1_item(p, l, it, smem); }
        xcd_barrier(xb);
        m2_phase(p, smem);
        xcd_barrier(xb);
        for (int it = blockIdx.x; it < 512; it += gridDim.x) gla3_item(p, l, it, smem);
        for (int it = blockIdx.x; it < 512; it += gridDim.x) lru3_item(p, it);
        for (int it = blockIdx.x; it < 2048; it += gridDim.x) dilc_item(p, it);
        xcd_barrier(xb);
        g2_phase(p, l, smem);
        xcd_barrier(xb);
    }
    ln_phase(p, DEPTH);
}

extern "C" void kernel_launch(void* const* d_in, const int* in_sizes, int n_in, void* d_out, int out_size, void* d_ws, size_t ws_size, hipStream_t stream) {
    static int grid_blocks = 0;
    if (!grid_blocks) {
        int dev = 0, cus = 0, per_cu = 0;
        hipGetDevice(&dev);
        hipDeviceGetAttribute(&cus, hipDeviceAttributeMultiprocessorCount, dev);
        hipOccupancyMaxActiveBlocksPerMultiprocessor(&per_cu, (const void*)fwd_megakernel, 256, 0);
        if (per_cu < 1) per_cu = 1;
        if (per_cu > 2) per_cu = 2;
        grid_blocks = cus * per_cu;
        if (ws_size < WS_END) fprintf(stderr, "kernel_launch: workspace too small: %zu < %zu\n", ws_size, (size_t)WS_END);
    }
    Params p{};
    p.x = (const float*)d_in[0]; p.c = (const float*)d_in[1]; p.pos = (const int*)d_in[2];
    p.w_mod = (const float*)d_in[3]; p.b_mod = (const float*)d_in[4]; p.w_in = (const float*)d_in[5];
    p.conv_w = (const float*)d_in[6]; p.conv_b = (const float*)d_in[7]; p.lru_wa = (const float*)d_in[8]; p.lru_ba = (const float*)d_in[9];
    p.lru_wx = (const float*)d_in[10]; p.lru_bx = (const float*)d_in[11]; p.lru_lam = (const float*)d_in[12];
    p.gla_wr = (const float*)d_in[13]; p.gla_br = (const float*)d_in[14]; p.gla_gn = (const float*)d_in[15];
    p.w_out = (const float*)d_in[16]; p.ln_g = (const float*)d_in[17]; p.ln_b = (const float*)d_in[18];
    p.out = (float*)d_out; p.ws = (unsigned char*)d_ws;
    (void)hipMemsetAsync(d_ws, 0, 32768, stream);
    void* args[] = {&p};
    hipError_t e = hipLaunchCooperativeKernel((const void*)fwd_megakernel, dim3(grid_blocks), dim3(256), args, 0, stream);
    if (e != hipSuccess) fprintf(stderr, "cooperative launch failed: %s (grid %d)\n", hipGetErrorString(e), grid_blocks);
}
```

```cpp
#include <hip/hip_runtime.h>
#include <hip/hip_cooperative_groups.h>
#include <cstdio>
#include <cstdint>
#include <type_traits>
namespace cg = cooperative_groups;

typedef unsigned short bf16_t;
typedef short bf16x8 __attribute__((ext_vector_type(8)));
typedef short bf16x4 __attribute__((ext_vector_type(4)));
typedef float f32x4 __attribute__((ext_vector_type(4)));
typedef unsigned u32x4 __attribute__((ext_vector_type(4)));
typedef unsigned u32x2 __attribute__((ext_vector_type(2)));

constexpr int D = 1024, NB = 4, S = 4096, T = NB * S, DEPTH = 2;
constexpr int DIN = 3344, ZP = 3344, NPAD = 3456;
constexpr int C_AQ = 0, C_AK = 256, C_AV = 512, C_AG = 768, C_BX = 1024, C_BG = 1280, C_CQ = 1536, C_CK = 1792,
              C_CV = 2048, C_CG = 2304, C_DQ = 2560, C_DK = 2688, C_DV = 2816, C_DG = 3072, C_DR = 3328;
constexpr float DN_ALPHA = 1.4142135623730951f;
constexpr int LDP = 72;
constexpr int SMEM_BYTES = 65536;
constexpr int BIG = 1000000;

constexpr size_t WS_CTL = 0;
constexpr size_t WS_CNT = 16384;
constexpr size_t WS_WINT = 32768;
constexpr size_t WS_WOUTT = WS_WINT + (size_t)DEPTH * NPAD * 1024 * 2;
constexpr size_t WS_MOD = WS_WOUTT + (size_t)DEPTH * 1024 * 1024 * 2;
constexpr size_t WS_COS = WS_MOD + (size_t)DEPTH * NB * 3072 * 4;
constexpr size_t WS_SIN = WS_COS + (size_t)T * 32 * 4;
constexpr size_t WS_U = WS_SIN + (size_t)T * 32 * 4;
constexpr size_t WS_Z = WS_U + (size_t)T * 1024 * 2;
constexpr size_t WS_KPART = WS_Z + (size_t)T * ZP * 2;
constexpr size_t WS_DILO = WS_KPART + (size_t)256 * 256 * 4;
constexpr size_t WS_DILL = WS_DILO + (size_t)3 * T * 256 * 2;
constexpr size_t WS_GKV = WS_DILL + (size_t)3 * T * 4 * 4;
constexpr size_t WS_GDEC = WS_GKV + (size_t)2048 * 2048 * 4;
constexpr size_t WS_LH = WS_GDEC + (size_t)2048 * 32 * 4;
constexpr size_t WS_LP = WS_LH + (size_t)T * 256 * 4;
constexpr size_t WS_LC = WS_LP + (size_t)T * 256 * 4;
constexpr size_t WS_LWT = WS_LC + (size_t)NB * 128 * 256 * 4;
constexpr size_t WS_BC = WS_LWT + (size_t)DEPTH * 2 * 4 * 64 * 64 * 2;
constexpr size_t WS_END = WS_BC + (size_t)512 * 32 * 128 * 4;

struct Params {
    const float *x, *c; const int* pos;
    const float *w_mod, *b_mod, *w_in, *conv_w, *conv_b, *lru_wa, *lru_ba, *lru_wx, *lru_bx, *lru_lam, *gla_wr, *gla_br, *gla_gn, *w_out, *ln_g, *ln_b;
    float* out; unsigned char* ws;
};

__device__ __forceinline__ float bf2f(bf16_t h) { return __uint_as_float(((unsigned)h) << 16); }
typedef __bf16 hbf16x2 __attribute__((ext_vector_type(2)));
typedef float f32x2 __attribute__((ext_vector_type(2)));
__device__ __forceinline__ unsigned pack2(float a, float b) { f32x2 v = {a, b}; hbf16x2 r = __builtin_convertvector(v, hbf16x2); return __builtin_bit_cast(unsigned, r); }
__device__ __forceinline__ bf16_t f2bf(float f) { return (bf16_t)(pack2(f, 0.f) & 0xffffu); }
__device__ __forceinline__ float silu_f(float x) { return x / (1.f + __expf(-x)); }
__device__ __forceinline__ float sigmoid_f(float x) { return 1.f / (1.f + __expf(-x)); }
__device__ __forceinline__ int tid_opq() { int t = threadIdx.x; asm volatile("" : "+v"(t)); return t; }
__device__ __forceinline__ float wsum(float v) {
#pragma unroll
    for (int o = 32; o; o >>= 1) v += __shfl_xor(v, o);
    return v;
}

#define XB_TMO      128
#define XB_XCNT(j)  (256  + 64 * (j))
#define XB_XSUB(j)  (1280 + 64 * (j))
#define XB_XGEN(j)  (2304 + 64 * (j))
#define XB_TOP      3328
#define XB_TOPGEN   3392
#define XCD_BAR_WORDS 3456
#define XB_SPIN_CAP (1u << 18)
#define LAS __attribute__((address_space(3)))
__device__ __forceinline__ unsigned xb_ld(unsigned* p)              { return __hip_atomic_load(p, __ATOMIC_RELAXED, __HIP_MEMORY_SCOPE_AGENT); }
__device__ __forceinline__ unsigned xb_add(unsigned* p, unsigned v) { return __hip_atomic_fetch_add(p, v, __ATOMIC_RELAXED, __HIP_MEMORY_SCOPE_AGENT); }
__device__ __forceinline__ unsigned xb_xcc_id() { return (unsigned)__builtin_amdgcn_s_getreg((3 << 11) | 20) & 0xFu; }
#define XB_SPIN(cond, bar) do { unsigned _sp = 0; while (cond) { __builtin_amdgcn_s_sleep(1); \
    if ((++_sp & 255u) == 0u) { if (xb_ld(&(bar)[XB_TMO])) break; if (_sp > XB_SPIN_CAP) { atomicAdd(&(bar)[XB_TMO], 1u); break; } } } } while (0)
struct XcdBarrier { unsigned* bar; unsigned x; volatile LAS unsigned* st; };
__device__ __forceinline__ XcdBarrier xcd_barrier_post(unsigned* bar, volatile LAS unsigned* st) {
    XcdBarrier b; b.bar = bar; b.x = xb_xcc_id(); b.st = st;
    if (threadIdx.x == 0) (void)xb_add(&bar[XB_XCNT(b.x)], 1u);
    return b;
}
__device__ __forceinline__ void xcd_barrier_complete(unsigned* bar, unsigned x, unsigned& nloc, unsigned& nx) {
    const unsigned G = gridDim.x * gridDim.y * gridDim.z;
    unsigned sum, cnt, mine, sp = 0u;
    for (;;) {
        sum = 0u; cnt = 0u; mine = 0u;
#pragma unroll
        for (unsigned j = 0; j < 16; ++j) { const unsigned c = xb_ld(&bar[XB_XCNT(j)]); sum += c; cnt += (c > 0u) ? 1u : 0u; mine = (j == x) ? c : mine; }
        if (sum == G) break;
        __builtin_amdgcn_s_sleep(1);
        if ((++sp & 255u) == 0u) { if (xb_ld(&bar[XB_TMO])) break; if (sp > XB_SPIN_CAP) { atomicAdd(&bar[XB_TMO], 1u); break; } }
    }
    nloc = mine > 0u ? mine : 1u; nx = cnt > 0u ? cnt : 1u;
}
__device__ __forceinline__ void xcd_barrier(const XcdBarrier& b) {
    asm volatile("s_waitcnt vmcnt(0)" ::: "memory");
    __syncthreads();
    if (threadIdx.x == 0) {
        unsigned* bar = b.bar;
        __builtin_amdgcn_s_waitcnt(0);
        unsigned nloc = b.st[0], nx = b.st[1];
        if (nloc == 0u) { xcd_barrier_complete(bar, b.x, nloc, nx); b.st[0] = nloc; b.st[1] = nx; }
        const unsigned old = xb_add(&bar[XB_XSUB(b.x)], 1u);
        const unsigned gen = old / nloc;
        if (old + 1u == (gen + 1u) * nloc) {
            __builtin_amdgcn_fence(__ATOMIC_RELEASE, "agent");
            asm volatile("s_waitcnt vmcnt(0)" ::: "memory");
            const unsigned og = xb_add(&bar[XB_TOP], 1u);
            const unsigned tg = og / nx;
            if (og + 1u == (tg + 1u) * nx) xb_add(&bar[XB_TOPGEN], 1u);
            else XB_SPIN(xb_ld(&bar[XB_TOPGEN]) == tg, bar);
            __builtin_amdgcn_fence(__ATOMIC_ACQUIRE, "agent");
            xb_add(&bar[XB_XGEN(b.x)], 1u);
            asm volatile("s_waitcnt vmcnt(0)" ::: "memory");
        } else {
            XB_SPIN(xb_ld(&bar[XB_XGEN(b.x)]) == gen, bar);
            __builtin_amdgcn_fence(__ATOMIC_ACQUIRE, "agent");
            asm volatile("s_waitcnt vmcnt(0)" ::: "memory");
        }
    }
    __syncthreads();
}
__device__ __forceinline__ int next_item(unsigned* ctr, volatile int* slot) {
    __syncthreads();
    if (threadIdx.x == 0) *slot = (int)atomicAdd(ctr, 1u);
    __syncthreads();
    return *slot;
}

__device__ void prologue_phase(const Params& p, char* smem) {
    const int t = tid_opq();
    bf16_t* WinT = (bf16_t*)(p.ws + WS_WINT); bf16_t* WoutT = (bf16_t*)(p.ws + WS_WOUTT);
    float* mod = (float*)(p.ws + WS_MOD); float* cosT = (float*)(p.ws + WS_COS); float* sinT = (float*)(p.ws + WS_SIN);
    float* tl = (float*)smem;
    constexpr int N_TIN = DEPTH * 16 * 54, N_TOUT = DEPTH * 16 * 16, N_MOD = DEPTH * 192, N_ROPE = T * 32 / 256, N_LWT = DEPTH * 2 * 4 * 64 * 64 / 256;
    constexpr int NITEMS = N_TIN + N_TOUT + N_MOD + N_ROPE + N_LWT;
    for (int it = blockIdx.x; it < NITEMS; it += gridDim.x) {
        if (it < N_TIN + N_TOUT) {
            const float* src; bf16_t* dst; int ncols, kt, nt;
            if (it < N_TIN) { int l = it / (16 * 54), r = it % (16 * 54); kt = r / 54; nt = r % 54; src = p.w_in + (size_t)l * 1024 * DIN; dst = WinT + (size_t)l * NPAD * 1024; ncols = DIN; }
            else { int i2 = it - N_TIN; int l = i2 / 256, r = i2 % 256; kt = r / 16; nt = r % 16; src = p.w_out + (size_t)l * 1024 * 1024; dst = WoutT + (size_t)l * 1024 * 1024; ncols = 1024; }
            __syncthreads();
            { const int c = t & 63, r0 = t >> 6; const int n = nt * 64 + c;
#pragma unroll
              for (int i = 0; i < 16; ++i) { int r = r0 + 4 * i; tl[r * 65 + c] = (n < ncols) ? src[(size_t)(kt * 64 + r) * ncols + n] : 0.f; } }
            __syncthreads();
            { const int kk = t & 63, n0 = t >> 6;
#pragma unroll
              for (int i = 0; i < 16; ++i) { int n = n0 + 4 * i; dst[(size_t)(nt * 64 + n) * 1024 + kt * 64 + kk] = f2bf(tl[kk * 65 + n]); } }
        } else if (it < N_TIN + N_TOUT + N_MOD) {
            const int i2 = it - N_TIN - N_TOUT; const int l = i2 / 192, jg = i2 % 192;
            const int jj = t & 15, ks = t >> 4; const int j = jg * 16 + jj;
            float a0 = 0.f, a1 = 0.f, a2 = 0.f, a3 = 0.f;
            const float* wm = p.w_mod + (size_t)l * 1024 * 3072 + j;
#pragma unroll 8
            for (int k = ks * 64; k < ks * 64 + 64; ++k) { float wv = wm[(size_t)k * 3072]; a0 += p.c[k] * wv; a1 += p.c[1024 + k] * wv; a2 += p.c[2048 + k] * wv; a3 += p.c[3072 + k] * wv; }
            __syncthreads();
            tl[(0 * 16 + ks) * 16 + jj] = a0; tl[(1 * 16 + ks) * 16 + jj] = a1; tl[(2 * 16 + ks) * 16 + jj] = a2; tl[(3 * 16 + ks) * 16 + jj] = a3;
            __syncthreads();
            if (t < 64) { const int b = t >> 4, j2 = t & 15; float s = 0.f;
#pragma unroll
              for (int k2 = 0; k2 < 16; ++k2) s += tl[(b * 16 + k2) * 16 + j2];
              mod[((size_t)l * NB + b) * 3072 + jg * 16 + j2] = s + p.b_mod[l * 3072 + jg * 16 + j2]; }
        } else if (it >= N_TIN + N_TOUT + N_MOD + N_ROPE) {
            const int e = (it - N_TIN - N_TOUT - N_MOD - N_ROPE) * 256 + t;
            const int in = e & 63, out = (e >> 6) & 63, g = (e >> 12) & 3, mat = (e >> 14) & 1, l = e >> 15;
            const float* src = mat ? p.lru_wx : p.lru_wa;
            ((bf16_t*)(p.ws + WS_LWT))[e] = f2bf(src[l * 16384 + g * 4096 + in * 64 + out]);
        } else {
            const int i2 = it - N_TIN - N_TOUT - N_MOD; const int e = i2 * 256 + t; const int tok = e >> 5, f = e & 31;
            const float inv = exp2f(-(float)f * (13.287712379549449f / 32.f));
            const float ang = (float)p.pos[tok] * inv;
            double rev = (double)ang * 0.15915494309189535; rev -= __builtin_rint(rev);
            const float rr = (float)rev; cosT[e] = __builtin_amdgcn_cosf(rr); sinT[e] = __builtin_amdgcn_sinf(rr);
        }
    }
}

__device__ void ln_phase(const Params& p, int l) {
    const int t = tid_opq(), lane = t & 63, w = t >> 6;
    bf16_t* ubuf = (bf16_t*)(p.ws + WS_U); const float* mod = (const float*)(p.ws + WS_MOD);
    for (int rg = blockIdx.x; rg < T / 16; rg += gridDim.x) {
        f32x4 v[4][4];
#pragma unroll
        for (int r = 0; r < 4; ++r) { const int row = rg * 16 + w * 4 + r; const float* src = (l <= 1) ? p.x + (size_t)row * 1024 : p.out + (size_t)row * 1024;
#pragma unroll
            for (int i = 0; i < 4; ++i) v[r][i] = *(const f32x4*)(src + i * 256 + lane * 4);
            if (l > 0) {
                const bf16_t* yr = (const bf16_t*)(p.ws + WS_Z) + (size_t)row * 1024; const float* gate = mod + ((size_t)(l - 1) * NB + row / S) * 3072 + 2048;
#pragma unroll
                for (int i = 0; i < 4; ++i) { const u32x2 yv = *(const u32x2*)(yr + i * 256 + lane * 4); const f32x4 g1 = *(const f32x4*)(gate + i * 256 + lane * 4) + 1.f;
                    const f32x4 yf = {__uint_as_float(yv.x << 16), __uint_as_float(yv.x & 0xffff0000u), __uint_as_float(yv.y << 16), __uint_as_float(yv.y & 0xffff0000u)};
                    v[r][i] = v[r][i] * DN_ALPHA + g1 * yf; }
            } }
#pragma unroll
        for (int r = 0; r < 4; ++r) {
            const int row = rg * 16 + w * 4 + r; const int b = row / S;
            if (l > 0) {
                float s = 0.f;
#pragma unroll
                for (int i = 0; i < 4; ++i) s += (v[r][i][0] + v[r][i][1]) + (v[r][i][2] + v[r][i][3]);
                const float mu = wsum(s) * (1.f / 1024.f); float q = 0.f;
#pragma unroll
                for (int i = 0; i < 4; ++i) { f32x4 d = v[r][i] - mu; q += (d[0] * d[0] + d[1] * d[1]) + (d[2] * d[2] + d[3] * d[3]); }
                const float rstd = rsqrtf(wsum(q) * (1.f / 1024.f) + 1e-5f);
#pragma unroll
                for (int i = 0; i < 4; ++i) { const f32x4 g = *(const f32x4*)(p.ln_g + (l - 1) * 1024 + i * 256 + lane * 4), bb = *(const f32x4*)(p.ln_b + (l - 1) * 1024 + i * 256 + lane * 4);
                    v[r][i] = (v[r][i] - mu) * rstd * g + bb; *(f32x4*)(p.out + (size_t)row * 1024 + i * 256 + lane * 4) = v[r][i]; }
            }
            if (l < DEPTH) {
                float s = 0.f;
#pragma unroll
                for (int i = 0; i < 4; ++i) s += (v[r][i][0] + v[r][i][1]) + (v[r][i][2] + v[r][i][3]);
                const float mu = wsum(s) * (1.f / 1024.f); float q = 0.f;
#pragma unroll
                for (int i = 0; i < 4; ++i) { f32x4 d = v[r][i] - mu; q += (d[0] * d[0] + d[1] * d[1]) + (d[2] * d[2] + d[3] * d[3]); }
                const float rstd = rsqrtf(wsum(q) * (1.f / 1024.f) + 1e-5f);
                const float* mb = mod + ((size_t)l * NB + b) * 3072;
#pragma unroll
                for (int i = 0; i < 4; ++i) { const int col = i * 256 + lane * 4; const f32x4 sh = *(const f32x4*)(mb + col), sc = *(const f32x4*)(mb + 1024 + col);
                    f32x4 u = (v[r][i] - mu) * rstd * (sc + 1.f) + sh; u32x2 pk; pk.x = pack2(u[0], u[1]); pk.y = pack2(u[2], u[3]);
                    *(u32x2*)(ubuf + (size_t)row * 1024 + col) = pk; }
            }
        }
    }
}

__device__ __forceinline__ int lds_off(int r, int c8) {
    const int st = (r >> 4) * 2 + (c8 >> 2); const int ob = (r & 15) * 64 + (c8 & 3) * 16;
    return st * 1024 + (ob ^ (((ob >> 9) & 1) << 5));
}
struct RegSet { u32x4 a[4], b[4]; };
__device__ __forceinline__ void gemm_tile(const bf16_t* __restrict__ A, const bf16_t* __restrict__ Bt, int tm, int tn, bool first, bool has_next, int ntm, int ntn,
                                          char* sm, f32x4 (&acc)[4][4], RegSet& r0, RegSet& r1) {
    const int t = tid_opq(), lane = t & 63, w = t >> 6, wm = w >> 1, wn = w & 1, r16 = lane & 15, quad = lane >> 4;
    const int lrow = t >> 3, lch = t & 7;
    constexpr int BUF = 32768;
    const unsigned loff = (unsigned)(lrow * 1024 + lch * 8);
    const bf16_t* At0 = A + (size_t)tm * (128 * 1024); const bf16_t* Bt0 = Bt + (size_t)tn * (128 * 1024);
    const bf16_t* At1 = A + (size_t)ntm * (128 * 1024); const bf16_t* Bt1 = Bt + (size_t)ntn * (128 * 1024);
#define Ag (At0 + loff)
#define Bg (Bt0 + loff)
#define nAg (At1 + loff)
#define nBg (Bt1 + loff)
    const int woff0 = lds_off(lrow, lch);
#define woff(i) (woff0 + 4096 * (i))
    const int fo = lds_off(r16, quad);
#pragma unroll
    for (int a = 0; a < 4; ++a)
#pragma unroll
        for (int b = 0; b < 4; ++b) acc[a][b] = (f32x4){0.f, 0.f, 0.f, 0.f};
    if (first) {
#pragma unroll
        for (int i = 0; i < 4; ++i) { r0.a[i] = *(const u32x4*)(Ag + (size_t)i * 32 * 1024); r0.b[i] = *(const u32x4*)(Bg + (size_t)i * 32 * 1024); }
#pragma unroll
        for (int i = 0; i < 4; ++i) { r1.a[i] = *(const u32x4*)(Ag + (size_t)i * 32 * 1024 + 64); r1.b[i] = *(const u32x4*)(Bg + (size_t)i * 32 * 1024 + 64); }
        __syncthreads();
#pragma unroll
        for (int i = 0; i < 4; ++i) { *(u32x4*)(sm + woff(i)) = r0.a[i]; *(u32x4*)(sm + 16384 + woff(i)) = r0.b[i]; }
#pragma unroll
        for (int i = 0; i < 4; ++i) { r0.a[i] = *(const u32x4*)(Ag + (size_t)i * 32 * 1024 + 128); r0.b[i] = *(const u32x4*)(Bg + (size_t)i * 32 * 1024 + 128); }
    }
    __syncthreads();
    auto step = [&](auto main_tag, int kt, RegSet& rs) {
        constexpr bool MAIN = decltype(main_tag)::value;
        const char* sA = sm + (kt & 1) * BUF; const char* sB = sA + 16384;
        char* nA = sm + ((kt + 1) & 1) * BUF; char* nB = nA + 16384;
        const bool wr = MAIN || kt + 1 < 16 || has_next;
        const bool own = MAIN || kt + 3 < 16;
        const bf16_t* la = own ? Ag + (kt + 3) * 64 : nAg + (kt - 13) * 64; const bf16_t* lb = own ? Bg + (kt + 3) * 64 : nBg + (kt - 13) * 64;
        __builtin_amdgcn_s_setprio(1);
#pragma unroll
        for (int ks = 0; ks < 2; ++ks) {
            bf16x8 af[4], bfr[4];
#pragma unroll
            for (int mt = 0; mt < 4; ++mt) af[mt] = *(const bf16x8*)(sA + ((wm * 4 + mt) * 2 + ks) * 1024 + fo);
#pragma unroll
            for (int nt = 0; nt < 4; ++nt) bfr[nt] = *(const bf16x8*)(sB + ((wn * 4 + nt) * 2 + ks) * 1024 + fo);
#pragma unroll
            for (int mt = 0; mt < 4; ++mt) {
#pragma unroll
                for (int nt = 0; nt < 4; ++nt) acc[mt][nt] = __builtin_amdgcn_mfma_f32_16x16x32_bf16(bfr[nt], af[mt], acc[mt][nt], 0, 0, 0);
                const int i = ks * 2 + (mt >> 1);
                __builtin_amdgcn_sched_barrier(0);
                if ((mt & 1) == 0) { if (wr) *(u32x4*)(nA + woff(i)) = rs.a[i]; if (own || has_next) rs.a[i] = *(const u32x4*)(la + (size_t)i * 32 * 1024); }
                else               { if (wr) *(u32x4*)(nB + woff(i)) = rs.b[i]; if (own || has_next) rs.b[i] = *(const u32x4*)(lb + (size_t)i * 32 * 1024); }
                __builtin_amdgcn_sched_barrier(0);
            }
        }
        __builtin_amdgcn_s_setprio(0);
        __syncthreads();
    };
    {
        std::true_type mt_; std::false_type tl_;
        for (int k2 = 0; k2 < 6; ++k2) { step(mt_, 2 * k2, r1); step(mt_, 2 * k2 + 1, r0); }
        step(mt_, 12, r1); step(tl_, 13, r0); step(tl_, 14, r1); step(tl_, 15, r0);
    }
#undef Ag
#undef Bg
#undef nAg
#undef nBg
#undef woff
}

__device__ void g1_phase(const Params& p, int l, char* smem) {
    const int t = tid_opq(), lane = t & 63, w = t >> 6, wm = w >> 1, wn = w & 1, r16 = lane & 15, quad = lane >> 4;
    char* sm = smem; char* sC = smem + 32768;
    const bf16_t* ubuf = (const bf16_t*)(p.ws + WS_U); const bf16_t* WinT = (const bf16_t*)(p.ws + WS_WINT) + (size_t)l * NPAD * 1024;
    bf16_t* z = (bf16_t*)(p.ws + WS_Z); float* kpart = (float*)(p.ws + WS_KPART);
    const float* cosT = (const float*)(p.ws + WS_COS); const float* sinT = (const float*)(p.ws + WS_SIN);
    const bool xo = (gridDim.x & 7) == 0; const int xcd = blockIdx.x & 7, nloc = xo ? (int)(gridDim.x >> 3) : (int)gridDim.x, j0 = xo ? (int)(blockIdx.x >> 3) : (int)blockIdx.x;
    const int lim = xo ? 16 * 27 : 128 * 27;
    RegSet r0, r1;
    for (int L = j0; L < lim; L += nloc) {
        const int tm = xo ? xcd * 16 + (L / 216) * 8 + (L & 7) : L / 27, tn = xo ? ((L % 216) >> 3) : L % 27;
        const int L2 = L + nloc; const bool has_next = L2 < lim;
        const int ntm = has_next ? (xo ? xcd * 16 + (L2 / 216) * 8 + (L2 & 7) : L2 / 27) : tm, ntn = has_next ? (xo ? ((L2 % 216) >> 3) : L2 % 27) : tn;
        f32x4 acc[4][4];
        gemm_tile(ubuf, WinT, tm, tn, L == j0, has_next, ntm, ntn, sm, acc, r0, r1);
        const bool rope = (tn < 4) || (tn >= 12 && tn < 16);
        if (rope) {
#pragma unroll
            for (int mt = 0; mt < 4; ++mt) {
                const int tok = tm * 128 + wm * 64 + mt * 16 + r16;
#pragma unroll
                for (int nt = 0; nt < 2; ++nt) {
                    const f32x4 cs = *(const f32x4*)(cosT + (size_t)tok * 32 + nt * 16 + quad * 4), sn = *(const f32x4*)(sinT + (size_t)tok * 32 + nt * 16 + quad * 4);
                    const f32x4 x1 = acc[mt][nt], x2 = acc[mt][nt + 2];
                    acc[mt][nt] = x1 * cs - x2 * sn; acc[mt][nt + 2] = x1 * sn + x2 * cs;
                }
            }
        }
        if (tn == 2 || tn == 3) {
#pragma unroll
            for (int nt = 0; nt < 4; ++nt) {
                f32x4 sv = (acc[0][nt] + acc[1][nt]) + (acc[2][nt] + acc[3][nt]);
#pragma unroll
                for (int jj = 0; jj < 4; ++jj) { float sx = sv[jj]; sx += __shfl_xor(sx, 1); sx += __shfl_xor(sx, 2); sx += __shfl_xor(sx, 4); sx += __shfl_xor(sx, 8); sv[jj] = sx; }
                if (r16 == 0) *(f32x4*)(kpart + (size_t)(tm * 2 + wm) * 256 + (tn - 2) * 128 + wn * 64 + nt * 16 + quad * 4) = sv;
            }
        }
#pragma unroll
        for (int mt = 0; mt < 4; ++mt)
#pragma unroll
            for (int nt = 0; nt < 4; ++nt) { u32x2 pk; pk.x = pack2(acc[mt][nt][0], acc[mt][nt][1]); pk.y = pack2(acc[mt][nt][2], acc[mt][nt][3]);
                const int row = wm * 64 + mt * 16 + r16; const int c16 = wn * 8 + nt * 2 + (quad >> 1);
                *(u32x2*)(sC + row * 256 + ((c16 ^ (row & 15)) << 4) + (quad & 1) * 8) = pk; }
        __syncthreads();
#pragma unroll
        for (int i = 0; i < 8; ++i) { const int c = t + 256 * i; const int row = c >> 4, ch = c & 15; const int col = tn * 128 + ch * 8;
            if (col < DIN) *(u32x4*)(z + (size_t)(tm * 128 + row) * ZP + col) = *(const u32x4*)(sC + row * 256 + ((ch ^ (row & 15)) << 4)); }
    }
}

__device__ void g2_phase(const Params& p, int l, char* smem) {
    const int t = tid_opq(), lane = t & 63, w = t >> 6, wm = w >> 1, wn = w & 1, r16 = lane & 15, quad = lane >> 4;
    char* sm = smem; char* sC = smem + 32768;
    const bf16_t* mix = (const bf16_t*)(p.ws + WS_U); const bf16_t* WoutT = (const bf16_t*)(p.ws + WS_WOUTT) + (size_t)l * 1024 * 1024;
    bf16_t* ybuf = (bf16_t*)(p.ws + WS_Z);
    const bool xo = (gridDim.x & 7) == 0; const int xcd = blockIdx.x & 7, nloc = xo ? (int)(gridDim.x >> 3) : (int)gridDim.x, j0 = xo ? (int)(blockIdx.x >> 3) : (int)blockIdx.x;
    const int lim = xo ? 16 * 8 : 128 * 8;
    RegSet r0, r1;
    for (int L = j0; L < lim; L += nloc) {
        const int tm = xo ? xcd * 16 + (L & 15) : (L >> 3), tn = xo ? (L >> 4) : (L & 7);
        const int L2 = L + nloc; const bool has_next = L2 < lim;
        const int ntm = has_next ? (xo ? xcd * 16 + (L2 & 15) : (L2 >> 3)) : tm, ntn = has_next ? (xo ? (L2 >> 4) : (L2 & 7)) : tn;
        f32x4 acc[4][4];
        gemm_tile(mix, WoutT, tm, tn, L == j0, has_next, ntm, ntn, sm, acc, r0, r1);
#pragma unroll
        for (int mt = 0; mt < 4; ++mt)
#pragma unroll
            for (int nt = 0; nt < 4; ++nt) { u32x2 pk; pk.x = pack2(acc[mt][nt][0], acc[mt][nt][1]); pk.y = pack2(acc[mt][nt][2], acc[mt][nt][3]);
                const int row = wm * 64 + mt * 16 + r16; const int c16 = wn * 8 + nt * 2 + (quad >> 1);
                *(u32x2*)(sC + row * 256 + ((c16 ^ (row & 15)) << 4) + (quad & 1) * 8) = pk; }
        __syncthreads();
#pragma unroll
        for (int i = 0; i < 8; ++i) { const int c = t + 256 * i; const int row = c >> 4, ch = c & 15;
            *(u32x4*)(ybuf + (size_t)(tm * 128 + row) * 1024 + tn * 128 + ch * 8) = *(const u32x4*)(sC + row * 256 + ((ch ^ (row & 15)) << 4)); }
    }
}

constexpr float ATT_SC = 0.18033688011112042f;
template <int QT>
__device__ __forceinline__ void attn_tile(const bf16_t* sK, const bf16_t* sV, const bf16x8 (&qf)[QT][2], int lo, int hi, bool full, bool hasq, bool qfl0, bool qfl1,
                                          float (&m)[QT], float (&l)[QT], f32x4 (&O)[QT][4], int wq0) {
    const int lane = tid_opq() & 63, r16 = lane & 15, quad = lane >> 4;
    f32x4 s[QT][4];
#pragma unroll
    for (int a = 0; a < QT; ++a)
#pragma unroll
        for (int b = 0; b < 4; ++b) s[a][b] = (f32x4){0.f, 0.f, 0.f, 0.f};
#pragma unroll
    for (int ks = 0; ks < 2; ++ks)
#pragma unroll
        for (int k16 = 0; k16 < 4; ++k16) {
            const bf16x8 kf = *(const bf16x8*)(sK + (k16 * 16 + r16) * LDP + ks * 32 + quad * 8);
#pragma unroll
            for (int qt = 0; qt < QT; ++qt) s[qt][k16] = __builtin_amdgcn_mfma_f32_16x16x32_bf16(kf, qf[qt][ks], s[qt][k16], 0, 0, 0);
        }
#pragma unroll
    for (int qt = 0; qt < QT; ++qt) {
        const int ql = wq0 + qt * 16 + r16; const bool qfl = qt ? qfl1 : qfl0;
        if (!full) {
#pragma unroll
            for (int k16 = 0; k16 < 4; ++k16)
#pragma unroll
                for (int j = 0; j < 4; ++j) { const int dd = ql - (k16 * 16 + quad * 4 + j); const bool valid = dd >= lo && dd <= hi; s[qt][k16][j] = valid ? s[qt][k16][j] : -1e30f; }
        }
        if (hasq) {
#pragma unroll
            for (int k16 = 0; k16 < 4; ++k16)
#pragma unroll
                for (int j = 0; j < 4; ++j) s[qt][k16][j] = qfl ? s[qt][k16][j] : -1e30f;
        }
        float mx = -1e30f;
#pragma unroll
        for (int k16 = 0; k16 < 4; ++k16) mx = fmaxf(mx, fmaxf(fmaxf(s[qt][k16][0], s[qt][k16][1]), fmaxf(s[qt][k16][2], s[qt][k16][3])));
        mx = fmaxf(mx, __shfl_xor(mx, 16)); mx = fmaxf(mx, __shfl_xor(mx, 32));
        const float mn = fmaxf(m[qt], mx); const float alpha = __builtin_amdgcn_exp2f((m[qt] - mn) * ATT_SC); m[qt] = mn;
        const float mb = (mn < -1e29f) ? 0.f : mn * ATT_SC;
        float ps = 0.f;
#pragma unroll
        for (int k16 = 0; k16 < 4; ++k16)
#pragma unroll
            for (int j = 0; j < 4; ++j) { const float pv = __builtin_amdgcn_exp2f(s[qt][k16][j] * ATT_SC - mb); ps += pv; s[qt][k16][j] = pv; }
        l[qt] = l[qt] * alpha + ps;
#pragma unroll
        for (int dt = 0; dt < 4; ++dt) O[qt][dt] = O[qt][dt] * alpha;
    }
#pragma unroll
    for (int G = 0; G < 2; ++G) {
        bf16x8 pf[QT];
#pragma unroll
        for (int qt = 0; qt < QT; ++qt) {
            const unsigned a0 = pack2(s[qt][G * 2][0], s[qt][G * 2][1]), a1 = pack2(s[qt][G * 2][2], s[qt][G * 2][3]);
            const unsigned a2 = pack2(s[qt][G * 2 + 1][0], s[qt][G * 2 + 1][1]), a3 = pack2(s[qt][G * 2 + 1][2], s[qt][G * 2 + 1][3]);
            u32x4 pk = {a0, a1, a2, a3}; pf[qt] = __builtin_bit_cast(bf16x8, pk);
        }
#pragma unroll
        for (int dt = 0; dt < 4; ++dt) {
            const bf16_t* v0p = sV + (G * 32 + quad * 4 + (r16 >> 2)) * LDP + dt * 16 + (r16 & 3) * 4;
            const bf16x4 v0 = __builtin_amdgcn_ds_read_tr16_b64_v4i16((__attribute__((address_space(3))) bf16x4*)(v0p));
            const bf16x4 v1 = __builtin_amdgcn_ds_read_tr16_b64_v4i16((__attribute__((address_space(3))) bf16x4*)(v0p + 16 * LDP));
            const bf16x8 vf = {v0[0], v0[1], v0[2], v0[3], v1[0], v1[1], v1[2], v1[3]};
#pragma unroll
            for (int qt = 0; qt < QT; ++qt) O[qt][dt] = __builtin_amdgcn_mfma_f32_16x16x32_bf16(vf, pf[qt], O[qt][dt], 0, 0, 0);
        }
    }
}

__device__ void attn_item(const Params& p, int kind, int idx, char* smem) {
    const int t = tid_opq(), lane = t & 63, w = t >> 6, r16 = lane & 15, quad = lane >> 4;
    bf16_t* sK = (bf16_t*)smem; bf16_t* sV = sK + 64 * LDP;
    float* kmean = (float*)(smem + 18432); float* gates = (float*)(smem + 22528); unsigned* selm = (unsigned*)(smem + 30720);
    int4* desc = (int4*)(smem + 31232); int* misc = (int*)(smem + 32320);
    const bf16_t* z = (const bf16_t*)(p.ws + WS_Z);
    int b, h, qbase, stride, qcol, kcol, vcol, cfg = 0;
    __syncthreads();
    if (kind == 0) {
        const int n = 15 - (idx >> 5); const int rem = idx & 31; b = rem >> 3; h = (rem >> 1) & 3; const int qh = rem & 1;
        qbase = b * S + n * 256 + qh * 128; stride = 1; qcol = C_AQ + h * 64; kcol = C_AK + h * 64; vcol = C_AV + h * 64;
        const float* kpart = (const float*)(p.ws + WS_KPART);
        for (int e = t; e < n * 64; e += 256) { const int j = e >> 6, d = e & 63; const float* kp = kpart + (size_t)(b * 64 + j * 4) * 256 + h * 64 + d;
            kmean[e] = ((kp[0] + kp[256]) + (kp[512] + kp[768])) * (1.f / 256.f); }
        if (t == 0) misc[1] = 0;
        __syncthreads();
        {
            const int ql = t >> 1, half = t & 1; const bf16_t* qp = z + (size_t)(qbase + ql) * ZP + qcol;
            float g[8];
#pragma unroll
            for (int jj = 0; jj < 8; ++jj) g[jj] = 0.f;
#pragma unroll 1
            for (int dc = 0; dc < 8; ++dc) {
                const u32x4 qv = *(const u32x4*)(qp + dc * 8); float qq[8];
#pragma unroll
                for (int e = 0; e < 4; ++e) { qq[2 * e] = __uint_as_float(qv[e] << 16); qq[2 * e + 1] = __uint_as_float(qv[e] & 0xffff0000u); }
#pragma unroll
                for (int jj = 0; jj < 8; ++jj) { const int j = half + 2 * jj; if (j < n) { const float* km = kmean + j * 64 + dc * 8;
#pragma unroll
                    for (int e = 0; e < 8; ++e) g[jj] += qq[e] * km[e]; } }
            }
#pragma unroll
            for (int jj = 0; jj < 8; ++jj) gates[ql * 16 + half + 2 * jj] = g[jj];
        }
        __syncthreads();
        if (t < 128) {
            unsigned msk = 0;
            for (int k = 0; k < 3 && k < n; ++k) { float best = -3.0e38f; int bi = -1;
                for (int j = 0; j < n; ++j) if (!((msk >> j) & 1u)) { const float gv = gates[t * 16 + j]; if (gv > best) { best = gv; bi = j; } }
                if (bi >= 0) msk |= 1u << bi; }
            selm[t] = msk; atomicOr((unsigned*)&misc[1], msk);
        }
        __syncthreads();
        if (t == 0) {
            int nd = 0; const unsigned bm = (unsigned)misc[1];
            for (int kt = 0; kt <= qh * 2 + 1; ++kt) desc[nd++] = make_int4(b * S + n * 256 + kt * 64, kt * 64 - qh * 128, BIG, -1);
            for (int j = 0; j < n; ++j) if ((bm >> j) & 1u) for (int kt = 0; kt < 4; ++kt) desc[nd++] = make_int4(b * S + j * 256 + kt * 64, -BIG, BIG, j);
            misc[0] = nd;
        }
    } else {
        cfg = idx >> 9; const int rem = idx & 511; b = rem >> 7; h = (rem >> 5) & 3; const int rb = rem & 31;
        const int dil = 1 << (2 * cfg); const int res = rb & (dil - 1), blk = rb >> (2 * cfg);
        qbase = b * S + blk * 128 * dil + res; stride = dil; qcol = C_CQ + h * 64; kcol = C_CK + h * 64; vcol = C_CV + h * 64;
        if (t < 128) selm[t] = 0xffffffffu;
        if (t == 0) { int nd = 0; for (int kt = (blk == 0 ? 2 : 0); kt < 4; ++kt) desc[nd++] = make_int4(b * S + (blk * 128 - 128 + kt * 64) * dil + res, kt * 64 - 128, kt * 64, -1); misc[0] = nd; }
    }
    __syncthreads();
    const int nd = misc[0];
    bf16x8 qf[2][2];
#pragma unroll
    for (int qt = 0; qt < 2; ++qt)
#pragma unroll
        for (int ks = 0; ks < 2; ++ks) qf[qt][ks] = *(const bf16x8*)(z + (size_t)(qbase + (w * 32 + qt * 16 + r16) * stride) * ZP + qcol + ks * 32 + quad * 8);
    const unsigned sel0 = selm[w * 32 + r16], sel1 = selm[w * 32 + 16 + r16];
    float m[2] = {-1e30f, -1e30f}, l[2] = {0.f, 0.f}; f32x4 O[2][4];
#pragma unroll
    for (int a = 0; a < 2; ++a)
#pragma unroll
        for (int c = 0; c < 4; ++c) O[a][c] = (f32x4){0.f, 0.f, 0.f, 0.f};
    const int lrow = t >> 2, lch = (t & 3) * 2;
    u32x4 rk0, rk1, rv0, rv1;
    if (nd > 0) { const int4 d = desc[0]; const bf16_t* rp = z + (size_t)(d.x + lrow * stride) * ZP + lch * 8;
        rk0 = *(const u32x4*)(rp + kcol); rk1 = *(const u32x4*)(rp + kcol + 8); rv0 = *(const u32x4*)(rp + vcol); rv1 = *(const u32x4*)(rp + vcol + 8); }
    for (int i = 0; i < nd; ++i) {
        __syncthreads();
        *(u32x4*)(sK + lrow * LDP + lch * 8) = rk0; *(u32x4*)(sK + lrow * LDP + lch * 8 + 8) = rk1;
        *(u32x4*)(sV + lrow * LDP + lch * 8) = rv0; *(u32x4*)(sV + lrow * LDP + lch * 8 + 8) = rv1;
        __syncthreads();
        if (i + 1 < nd) { const int4 d = desc[i + 1]; const bf16_t* rp = z + (size_t)(d.x + lrow * stride) * ZP + lch * 8;
            rk0 = *(const u32x4*)(rp + kcol); rk1 = *(const u32x4*)(rp + kcol + 8); rv0 = *(const u32x4*)(rp + vcol); rv1 = *(const u32x4*)(rp + vcol + 8); }
        const int4 d = desc[i];
        bool need = (w * 32 + 31 >= d.y) && (w * 32 - 63 <= d.z);
        bool q0 = true, q1 = true;
        if (d.w >= 0) { q0 = (sel0 >> d.w) & 1u; q1 = (sel1 >> d.w) & 1u; need = need && (__ballot(q0 || q1) != 0ull); }
        const bool full = (w * 32 - 63 >= d.y) && (w * 32 + 31 <= d.z);
        if (need) attn_tile<2>(sK, sV, qf, d.y, d.z, full, d.w >= 0, q0, q1, m, l, O, w * 32);
    }
#pragma unroll
    for (int qt = 0; qt < 2; ++qt) {
        float lt = l[qt]; lt += __shfl_xor(lt, 16); lt += __shfl_xor(lt, 32);
        const float inv = 1.f / lt; const size_t tok = (size_t)(qbase + (w * 32 + qt * 16 + r16) * stride);
        if (kind == 0) {
            bf16_t* mix = (bf16_t*)(p.ws + WS_U);
#pragma unroll
            for (int dt = 0; dt < 4; ++dt) { const int d0 = dt * 16 + quad * 4; const u32x2 gv = *(const u32x2*)(z + tok * ZP + C_AG + h * 64 + d0);
                const float g0 = __uint_as_float(gv.x << 16), g1 = __uint_as_float(gv.x & 0xffff0000u), g2 = __uint_as_float(gv.y << 16), g3 = __uint_as_float(gv.y & 0xffff0000u);
                u32x2 o; o.x = pack2(O[qt][dt][0] * inv * silu_f(g0), O[qt][dt][1] * inv * silu_f(g1)); o.y = pack2(O[qt][dt][2] * inv * silu_f(g2), O[qt][dt][3] * inv * silu_f(g3));
                *(u32x2*)(mix + tok * 1024 + h * 64 + d0) = o; }
        } else {
            bf16_t* dilo = (bf16_t*)(p.ws + WS_DILO); float* dill = (float*)(p.ws + WS_DILL);
#pragma unroll
            for (int dt = 0; dt < 4; ++dt) { const int d0 = dt * 16 + quad * 4; u32x2 o; o.x = pack2(O[qt][dt][0] * inv, O[qt][dt][1] * inv); o.y = pack2(O[qt][dt][2] * inv, O[qt][dt][3] * inv);
                *(u32x2*)(dilo + ((size_t)cfg * T + tok) * 256 + h * 64 + d0) = o; }
            if (quad == 0) dill[((size_t)cfg * T + tok) * 4 + h] = m[qt] * 0.125f + __logf(lt);
        }
    }
}

__device__ void moba_item(const Params& p, int idx, char* smem, bf16_t* outp) {
    const int t = tid_opq(), lane = t & 63, w = t >> 6, r16 = lane & 15, quad = lane >> 4;
    bf16_t* sK = (bf16_t*)smem; bf16_t* sV = sK + 64 * LDP;
    float* stO = (float*)(smem + 18432);
    float* kmean = (float*)(smem + 18432); float* gates = (float*)(smem + 22528);
    float* stM = (float*)(smem + 53248); float* stL = (float*)(smem + 53760);
    unsigned* selm = (unsigned*)(smem + 54272); unsigned char* lists = (unsigned char*)(smem + 54784);
    int* cnt = (int*)(smem + 56832); int4* desc = (int4*)(smem + 56960); int* misc = (int*)(smem + 59008);
    const bf16_t* z = (const bf16_t*)(p.ws + WS_Z);
    const int n = 15 - (idx >> 5); const int rem = idx & 31; const int b = rem >> 3, h = (rem >> 1) & 3, qh = rem & 1;
    const int qbase = b * S + n * 256 + qh * 128, qcol = C_AQ + h * 64, kcol = C_AK + h * 64, vcol = C_AV + h * 64;
    __syncthreads();
    {
        const float* kpart = (const float*)(p.ws + WS_KPART);
        for (int e = t; e < n * 64; e += 256) { const int j = e >> 6, d = e & 63; const float* kp = kpart + (size_t)(b * 64 + j * 4) * 256 + h * 64 + d;
            kmean[e] = ((kp[0] + kp[256]) + (kp[512] + kp[768])) * (1.f / 256.f); }
        if (t < 16) cnt[t] = 0;
        __syncthreads();
        {
            const int ql = t >> 1, half = t & 1; const bf16_t* qp = z + (size_t)(qbase + ql) * ZP + qcol;
            float g[8];
#pragma unroll
            for (int jj = 0; jj < 8; ++jj) g[jj] = 0.f;
#pragma unroll 1
            for (int dc = 0; dc < 8; ++dc) {
                const u32x4 qv = *(const u32x4*)(qp + dc * 8); float qq[8];
#pragma unroll
                for (int e = 0; e < 4; ++e) { qq[2 * e] = __uint_as_float(qv[e] << 16); qq[2 * e + 1] = __uint_as_float(qv[e] & 0xffff0000u); }
#pragma unroll
                for (int jj = 0; jj < 8; ++jj) { const int j = half + 2 * jj; if (j < n) { const float* km = kmean + j * 64 + dc * 8;
#pragma unroll
                    for (int e = 0; e < 8; ++e) g[jj] += qq[e] * km[e]; } }
            }
#pragma unroll
            for (int jj = 0; jj < 8; ++jj) gates[ql * 16 + half + 2 * jj] = g[jj];
        }
        __syncthreads();
        if (t < 128) {
            unsigned msk = 0;
            for (int k = 0; k < 3 && k < n; ++k) { float best = -3.0e38f; int bi = -1;
                for (int j = 0; j < n; ++j) if (!((msk >> j) & 1u)) { const float gv = gates[t * 16 + j]; if (gv > best) { best = gv; bi = j; } }
                if (bi >= 0) msk |= 1u << bi; }
            selm[t] = msk;
            for (int j = 0; j < n; ++j) if ((msk >> j) & 1u) { const int pos = atomicAdd(&cnt[j], 1); lists[j * 128 + pos] = (unsigned char)t; }
        }
        __syncthreads();
        if (t < 128) { for (int j = 0; j < n; ++j) { const int cj = cnt[j]; if (t >= cj && t < ((cj + 15) & ~15)) lists[j * 128 + t] = 255; } }
        if (t == 0) {
            int nd = 0;
            for (int kt = 0; kt <= qh * 2 + 1; ++kt) desc[nd++] = make_int4(b * S + n * 256 + kt * 64, kt * 64 - qh * 128, BIG, -1);
            misc[1] = nd;
            for (int j = 0; j < n; ++j) { const int ntl = (cnt[j] + 15) >> 4;
                for (int ps = 0; ps * 4 < ntl; ++ps) for (int kt = 0; kt < 4; ++kt) desc[nd++] = make_int4(b * S + j * 256 + kt * 64, ps, kt, j); }
            misc[0] = nd;
        }
    }
    __syncthreads();
    const int nd = misc[0], nown = misc[1];
    const int lrow = t >> 2, lch = (t & 3) * 2;
    u32x4 rk0, rk1, rv0, rv1;
    { const int4 d = desc[0]; const bf16_t* rp = z + (size_t)(d.x + lrow) * ZP + lch * 8;
      rk0 = *(const u32x4*)(rp + kcol); rk1 = *(const u32x4*)(rp + kcol + 8); rv0 = *(const u32x4*)(rp + vcol); rv1 = *(const u32x4*)(rp + vcol + 8); }
    bf16x8 nqf[2]; int ngq = 0; bool ngv = false, nhas = false;
    auto prefetch_group = [&](int gi) {
        nhas = false;
        if (gi < nd) { const int4 dg = desc[gi]; const int slot = dg.y * 4 + w; nhas = slot * 16 < cnt[dg.w];
            if (nhas) { const int qi = lists[dg.w * 128 + slot * 16 + r16]; ngv = qi != 255; ngq = ngv ? qi : 0;
#pragma unroll
                for (int ks = 0; ks < 2; ++ks) nqf[ks] = *(const bf16x8*)(z + (size_t)(qbase + ngq) * ZP + qcol + ks * 32 + quad * 8); } }
    };
    prefetch_group(nown);
    {
        bf16x8 qf[2][2];
#pragma unroll
        for (int qt = 0; qt < 2; ++qt)
#pragma unroll
            for (int ks = 0; ks < 2; ++ks) qf[qt][ks] = *(const bf16x8*)(z + (size_t)(qbase + w * 32 + qt * 16 + r16) * ZP + qcol + ks * 32 + quad * 8);
        float m[2] = {-1e30f, -1e30f}, l[2] = {0.f, 0.f}; f32x4 O[2][4];
#pragma unroll
        for (int a = 0; a < 2; ++a)
#pragma unroll
            for (int c = 0; c < 4; ++c) O[a][c] = (f32x4){0.f, 0.f, 0.f, 0.f};
        for (int i = 0; i < nown; ++i) {
            __syncthreads();
            *(u32x4*)(sK + lrow * LDP + lch * 8) = rk0; *(u32x4*)(sK + lrow * LDP + lch * 8 + 8) = rk1;
            *(u32x4*)(sV + lrow * LDP + lch * 8) = rv0; *(u32x4*)(sV + lrow * LDP + lch * 8 + 8) = rv1;
            __syncthreads();
            if (i + 1 < nd) { const int4 d = desc[i + 1]; const bf16_t* rp = z + (size_t)(d.x + lrow) * ZP + lch * 8;
                rk0 = *(const u32x4*)(rp + kcol); rk1 = *(const u32x4*)(rp + kcol + 8); rv0 = *(const u32x4*)(rp + vcol); rv1 = *(const u32x4*)(rp + vcol + 8); }
            const int4 d = desc[i];
            const bool need = (w * 32 + 31 >= d.y) && (w * 32 - 63 <= d.z);
            const bool full = (w * 32 - 63 >= d.y) && (w * 32 + 31 <= d.z);
            if (need) attn_tile<2>(sK, sV, qf, d.y, d.z, full, false, true, true, m, l, O, w * 32);
        }
#pragma unroll
        for (int qt = 0; qt < 2; ++qt) {
            float lt = l[qt]; lt += __shfl_xor(lt, 16); lt += __shfl_xor(lt, 32);
            const int ql = w * 32 + qt * 16 + r16;
            if (quad == 0) { stM[ql] = m[qt]; stL[ql] = lt; }
#pragma unroll
            for (int dt = 0; dt < 4; ++dt) *(f32x4*)(stO + ql * 68 + dt * 16 + quad * 4) = O[qt][dt];
        }
    }
    {
        bf16x8 qf[1][2]; float m[1] = {-1e30f}, l[1] = {0.f}; f32x4 O[1][4];
        int gq = 0; bool gv = false, has = false;
        for (int i = nown; i < nd; ++i) {
            __syncthreads();
            *(u32x4*)(sK + lrow * LDP + lch * 8) = rk0; *(u32x4*)(sK + lrow * LDP + lch * 8 + 8) = rk1;
            *(u32x4*)(sV + lrow * LDP + lch * 8) = rv0; *(u32x4*)(sV + lrow * LDP + lch * 8 + 8) = rv1;
            __syncthreads();
            if (i + 1 < nd) { const int4 d = desc[i + 1]; const bf16_t* rp = z + (size_t)(d.x + lrow) * ZP + lch * 8;
                rk0 = *(const u32x4*)(rp + kcol); rk1 = *(const u32x4*)(rp + kcol + 8); rv0 = *(const u32x4*)(rp + vcol); rv1 = *(const u32x4*)(rp + vcol + 8); }
            const int4 d = desc[i];
            if (d.z == 0) {
                has = nhas; gv = ngv; gq = ngq; qf[0][0] = nqf[0]; qf[0][1] = nqf[1];
                m[0] = -1e30f; l[0] = 0.f;
#pragma unroll
                for (int c = 0; c < 4; ++c) O[0][c] = (f32x4){0.f, 0.f, 0.f, 0.f};
                prefetch_group(i + 4);
            }
            if (has) {
                attn_tile<1>(sK, sV, qf, -BIG, BIG, true, false, true, true, m, l, O, 0);
                if (d.z == 3) {
                    float lt = l[0]; lt += __shfl_xor(lt, 16); lt += __shfl_xor(lt, 32);
                    if (gv) {
                        const float mo = stM[gq], lo_ = stL[gq]; const float mn = fmaxf(mo, m[0]);
                        const float fa = __builtin_amdgcn_exp2f((mo - mn) * ATT_SC), fb = __builtin_amdgcn_exp2f((m[0] - mn) * ATT_SC);
#pragma unroll
                        for (int dt = 0; dt < 4; ++dt) { float* sp = stO + gq * 68 + dt * 16 + quad * 4; const f32x4 so = *(const f32x4*)sp; *(f32x4*)sp = so * fa + O[0][dt] * fb; }
                        if (quad == 0) { stM[gq] = mn; stL[gq] = lo_ * fa + lt * fb; }
                    }
                }
            }
        }
    }
    __syncthreads();
#pragma unroll
    for (int qt = 0; qt < 2; ++qt) {
        const int ql = w * 32 + qt * 16 + r16; const float inv = 1.f / stL[ql]; const size_t tok = (size_t)(qbase + ql);
#pragma unroll
        for (int dt = 0; dt < 4; ++dt) { const int d0 = dt * 16 + quad * 4; const f32x4 ov = *(const f32x4*)(stO + ql * 68 + d0);
            const u32x2 gvv = *(const u32x2*)(z + tok * ZP + C_AG + h * 64 + d0);
            const float g0 = __uint_as_float(gvv.x << 16), g1 = __uint_as_float(gvv.x & 0xffff0000u), g2 = __uint_as_float(gvv.y << 16), g3 = __uint_as_float(gvv.y & 0xffff0000u);
            u32x2 o; o.x = pack2(ov[0] * inv * silu_f(g0), ov[1] * inv * silu_f(g1)); o.y = pack2(ov[2] * inv * silu_f(g2), ov[3] * inv * silu_f(g3));
            *(u32x2*)(outp + tok * 1024 + h * 64 + d0) = o; }
    }
}

__device__ __forceinline__ void gla_bcum(const Params& p, int l, const bf16_t* z, int tok0, float* bc, float* drs) {
    const int t = tid_opq();
    const int hd = t & 127, ih = t >> 7;
    float wr[16];
#pragma unroll
    for (int r = 0; r < 16; ++r) wr[r] = p.gla_wr[l * 2048 + r * 128 + hd];
    const float br = p.gla_br[l * 128 + hd];
    { const int e0 = t, e1 = t + 256; const bf16_t d0 = z[(size_t)(tok0 + (e0 >> 4)) * ZP + C_DR + (e0 & 15)], d1 = z[(size_t)(tok0 + (e1 >> 4)) * ZP + C_DR + (e1 & 15)];
      drs[e0] = bf2f(d0); drs[e1] = bf2f(d1); }
    __syncthreads();
#pragma unroll
    for (int ii = 0; ii < 16; ++ii) { const int i = ih * 16 + ii; float x = br;
#pragma unroll
        for (int r4 = 0; r4 < 4; ++r4) { const f32x4 dv = *(const f32x4*)(drs + i * 16 + r4 * 4); x += (dv[0] * wr[r4 * 4] + dv[1] * wr[r4 * 4 + 1]) + (dv[2] * wr[r4 * 4 + 2] + dv[3] * wr[r4 * 4 + 3]); }
        bc[i * 128 + hd] = (fminf(x, 0.f) - __logf(1.f + __expf(-fabsf(x)))) * (1.f / 16.f); }
    __syncthreads();
    if (t < 128) { float sacc = 0.f;
#pragma unroll
        for (int i = 0; i < 32; ++i) { sacc += bc[i * 128 + t]; bc[i * 128 + t] = sacc; } }
    __syncthreads();
}

__device__ void gla1_item(const Params& p, int l, int idx, char* smem) {
    const int t = tid_opq(), lane = t & 63, w = t >> 6, r16 = lane & 15, quad = lane >> 4;
    const int b = idx >> 7, c = idx & 127; const int tok0 = b * S + c * 32;
    const bf16_t* z = (const bf16_t*)(p.ws + WS_Z);
    float* bc = (float*)smem; float* drs = (float*)(smem + 16384);
    bf16_t* kdT = (bf16_t*)(smem + 18432) + w * 1024;
    bf16_t* vL = (bf16_t*)(smem + 26624) + w * (32 * LDP);
    float* gkv = (float*)(p.ws + WS_GKV); float* gdec = (float*)(p.ws + WS_GDEC);
    bf16_t kraw[16]; u32x4 vr[4];
#pragma unroll
    for (int i = 0; i < 16; ++i) { const int e = lane + 64 * i; kraw[i] = z[(size_t)(tok0 + (e >> 5)) * ZP + C_DK + w * 32 + (e & 31)]; }
#pragma unroll
    for (int i = 0; i < 4; ++i) { const int cc = lane + 64 * i; vr[i] = *(const u32x4*)(z + (size_t)(tok0 + (cc >> 3)) * ZP + C_DV + w * 64 + (cc & 7) * 8); }
    __syncthreads();
#pragma unroll
    for (int i = 0; i < 4; ++i) { const int cc = lane + 64 * i; *(u32x4*)(vL + (cc >> 3) * LDP + (cc & 7) * 8) = vr[i]; }
    gla_bcum(p, l, z, tok0, bc, drs);
    { float* bcg = (float*)(p.ws + WS_BC) + (size_t)idx * 4096;
#pragma unroll
      for (int i = 0; i < 4; ++i) *(f32x4*)(bcg + (t + 256 * i) * 4) = *(const f32x4*)(bc + (t + 256 * i) * 4); }
#pragma unroll
    for (int i = 0; i < 16; ++i) { const int e = lane + 64 * i; const int j = e >> 5, d = e & 31;
        kdT[d * 32 + j] = f2bf(bf2f(kraw[i]) * __expf(bc[31 * 128 + w * 32 + d] - bc[j * 128 + w * 32 + d])); }
    const int bh = b * 4 + w;
    if (lane < 32) gdec[(bh * 128 + c) * 32 + lane] = __expf(bc[31 * 128 + w * 32 + lane]);
    __syncthreads();
    bf16x8 kf[2];
#pragma unroll
    for (int x = 0; x < 2; ++x) kf[x] = *(const bf16x8*)(kdT + (x * 16 + r16) * 32 + quad * 8);
    float* dst = gkv + (size_t)(bh * 128 + c) * 2048;
#pragma unroll
    for (int dt = 0; dt < 4; ++dt) {
        const bf16_t* v0p = vL + (quad * 8 + (r16 >> 2)) * LDP + dt * 16 + (r16 & 3) * 4;
        const bf16x4 v0 = __builtin_amdgcn_ds_read_tr16_b64_v4i16((__attribute__((address_space(3))) bf16x4*)(v0p));
        const bf16x4 v1 = __builtin_amdgcn_ds_read_tr16_b64_v4i16((__attribute__((address_space(3))) bf16x4*)(v0p + 4 * LDP));
        const bf16x8 vf = {v0[0], v0[1], v0[2], v0[3], v1[0], v1[1], v1[2], v1[3]};
#pragma unroll
        for (int x = 0; x < 2; ++x) {
            const f32x4 r = __builtin_amdgcn_mfma_f32_16x16x32_bf16(vf, kf[x], (f32x4){0.f, 0.f, 0.f, 0.f}, 0, 0, 0);
            *(f32x4*)(dst + (x * 16 + r16) * 64 + dt * 16 + quad * 4) = r;
        }
    }
}

#define OPQ(ptr) asm volatile("" : "+v"(ptr))
__device__ void gla3_item(const Params& p, int l, int idx, char* smem) {
    const int t = tid_opq(), lane = t & 63, w = t >> 6, r16 = lane & 15, quad = lane >> 4;
    const int b = idx >> 7, c = idx & 127; const int tok0 = b * S + c * 32;
    const bf16_t* z = (const bf16_t*)(p.ws + WS_Z); bf16_t* mix = (bf16_t*)(p.ws + WS_U);
    float* bc = (float*)smem; float* drs = (float*)(smem + 16384);
    bf16_t* SL = (bf16_t*)smem + w * (32 * LDP);
    bf16_t* qe = (bf16_t*)(smem + 18432) + w * 1024;
    bf16_t* ke = (bf16_t*)(smem + 26624) + w * 1024;
    bf16_t* vL = (bf16_t*)(smem + 34816) + w * (32 * LDP);
    const float* gkv = (const float*)(p.ws + WS_GKV);
    const int bh = b * 4 + w;
    bf16_t qraw[16], kraw[16];
    { const bf16_t* qp = z + (size_t)(tok0 + (lane >> 5)) * ZP + w * 32 + (lane & 31);
#pragma unroll
      for (int i = 0; i < 16; ++i) { qraw[i] = qp[C_DQ]; kraw[i] = qp[C_DK]; qp += 2 * ZP; OPQ(qp); } }
    u32x4 vr[4]; f32x4 sr[8];
#pragma unroll
    for (int i = 0; i < 4; ++i) { const int cc = lane + 64 * i; vr[i] = *(const u32x4*)(z + (size_t)(tok0 + (cc >> 3)) * ZP + C_DV + w * 64 + (cc & 7) * 8); }
    { const float* Sp = gkv + (size_t)(bh * 128 + c) * 2048;
#pragma unroll
      for (int i = 0; i < 8; ++i) sr[i] = *(const f32x4*)(Sp + (lane + 64 * i) * 4); }
    f32x4 bcr[4];
    { const float* bcg = (const float*)(p.ws + WS_BC) + (size_t)idx * 4096;
#pragma unroll
      for (int i = 0; i < 4; ++i) bcr[i] = *(const f32x4*)(bcg + (t + 256 * i) * 4); }
    __syncthreads();
#pragma unroll
    for (int i = 0; i < 4; ++i) { const int cc = lane + 64 * i; *(u32x4*)(vL + (cc >> 3) * LDP + (cc & 7) * 8) = vr[i]; }
#pragma unroll
    for (int i = 0; i < 4; ++i) *(f32x4*)(bc + (t + 256 * i) * 4) = bcr[i];
    __syncthreads();
#pragma unroll
    for (int i2 = 0; i2 < 16; ++i2) { const int e = lane + 64 * i2; const int i = e >> 5, d = e & 31; const float bcv = bc[i * 128 + w * 32 + d];
        qe[i * 32 + d] = f2bf(bf2f(qraw[i2]) * __expf(bcv) * 0.17677669529663687f); ke[i * 32 + d] = f2bf(bf2f(kraw[i2]) * __expf(-bcv)); }
    __syncthreads();
#pragma unroll
    for (int i = 0; i < 8; ++i) { const int cc = lane + 64 * i; const int d = cc >> 4, v4 = cc & 15; u32x2 pk; pk.x = pack2(sr[i][0], sr[i][1]); pk.y = pack2(sr[i][2], sr[i][3]);
        *(u32x2*)(SL + d * LDP + v4 * 4) = pk; }
    __syncthreads();
    bf16x8 qf[2], kf[2];
#pragma unroll
    for (int x = 0; x < 2; ++x) { qf[x] = *(const bf16x8*)(qe + (x * 16 + r16) * 32 + quad * 8); kf[x] = *(const bf16x8*)(ke + (x * 16 + r16) * 32 + quad * 8); }
    bf16x8 pf[2];
#pragma unroll
    for (int it = 0; it < 2; ++it) {
        f32x4 at[2];
#pragma unroll
        for (int jt = 0; jt < 2; ++jt) { at[jt] = __builtin_amdgcn_mfma_f32_16x16x32_bf16(kf[jt], qf[it], (f32x4){0.f, 0.f, 0.f, 0.f}, 0, 0, 0);
#pragma unroll
            for (int jj = 0; jj < 4; ++jj) at[jt][jj] = (jt * 16 + quad * 4 + jj <= it * 16 + r16) ? at[jt][jj] : 0.f; }
        u32x4 pk = {pack2(at[0][0], at[0][1]), pack2(at[0][2], at[0][3]), pack2(at[1][0], at[1][1]), pack2(at[1][2], at[1][3])};
        pf[it] = __builtin_bit_cast(bf16x8, pk);
    }
    f32x4 O[2][4];
#pragma unroll
    for (int dt = 0; dt < 4; ++dt) {
        const bf16_t* v0p = vL + (quad * 4 + (r16 >> 2)) * LDP + dt * 16 + (r16 & 3) * 4;
        const bf16x4 v0 = __builtin_amdgcn_ds_read_tr16_b64_v4i16((__attribute__((address_space(3))) bf16x4*)(v0p));
        const bf16x4 v1 = __builtin_amdgcn_ds_read_tr16_b64_v4i16((__attribute__((address_space(3))) bf16x4*)(v0p + 16 * LDP));
        const bf16x8 vf = {v0[0], v0[1], v0[2], v0[3], v1[0], v1[1], v1[2], v1[3]};
        const bf16_t* s0p = SL + (quad * 8 + (r16 >> 2)) * LDP + dt * 16 + (r16 & 3) * 4;
        const bf16x4 s0 = __builtin_amdgcn_ds_read_tr16_b64_v4i16((__attribute__((address_space(3))) bf16x4*)(s0p));
        const bf16x4 s1 = __builtin_amdgcn_ds_read_tr16_b64_v4i16((__attribute__((address_space(3))) bf16x4*)(s0p + 4 * LDP));
        const bf16x8 sf = {s0[0], s0[1], s0[2], s0[3], s1[0], s1[1], s1[2], s1[3]};
#pragma unroll
        for (int it = 0; it < 2; ++it) {
            O[it][dt] = __builtin_amdgcn_mfma_f32_16x16x32_bf16(vf, pf[it], (f32x4){0.f, 0.f, 0.f, 0.f}, 0, 0, 0);
            O[it][dt] = __builtin_amdgcn_mfma_f32_16x16x32_bf16(sf, qf[it], O[it][dt], 0, 0, 0);
        }
    }
#pragma unroll
    for (int it = 0; it < 2; ++it) {
        float ss = 0.f;
#pragma unroll
        for (int dt = 0; dt < 4; ++dt) ss += (O[it][dt][0] * O[it][dt][0] + O[it][dt][1] * O[it][dt][1]) + (O[it][dt][2] * O[it][dt][2] + O[it][dt][3] * O[it][dt][3]);
        ss += __shfl_xor(ss, 16); ss += __shfl_xor(ss, 32);
        const float rn = rsqrtf(ss * (1.f / 64.f) + 1e-5f);
        const size_t tok = (size_t)(tok0 + it * 16 + r16);
#pragma unroll
        for (int dt = 0; dt < 4; ++dt) { const int v0i = dt * 16 + quad * 4; const f32x4 gn = *(const f32x4*)(p.gla_gn + l * 64 + v0i);
            const u32x2 gv = *(const u32x2*)(z + tok * ZP + C_DG + w * 64 + v0i);
            const float g0 = __uint_as_float(gv.x << 16), g1 = __uint_as_float(gv.x & 0xffff0000u), g2 = __uint_as_float(gv.y << 16), g3 = __uint_as_float(gv.y & 0xffff0000u);
            u32x2 o; o.x = pack2(O[it][dt][0] * rn * gn[0] * silu_f(g0), O[it][dt][1] * rn * gn[1] * silu_f(g1));
            o.y = pack2(O[it][dt][2] * rn * gn[2] * silu_f(g2), O[it][dt][3] * rn * gn[3] * silu_f(g3));
            *(u32x2*)(mix + tok * 1024 + 768 + w * 64 + v0i) = o; }
    }
}

__device__ void lru1_item(const Params& p, int l, int idx, char* smem) {
    const int t = tid_opq(), lane = t & 63, g = t >> 6, r16 = lane & 15, quad = lane >> 4; const int ch = t;
    const int b = idx >> 7, c = idx & 127; const int s0 = c * 32; const int tok0 = b * S + s0;
    const bf16_t* z = (const bf16_t*)(p.ws + WS_Z); float* xcs = (float*)smem;
    bf16_t* preA = (bf16_t*)(smem + 32768); bf16_t* preX = (bf16_t*)(smem + 49152);
    float* lh = (float*)(p.ws + WS_LH); float* lp = (float*)(p.ws + WS_LP);
    bf16_t xr[35];
#pragma unroll
    for (int i = 0; i < 35; ++i) { const int sidx = s0 + i - 3; xr[i] = (sidx >= 0) ? z[(size_t)(tok0 + i - 3) * ZP + C_BX + ch] : (bf16_t)0; }
    const float cw0 = p.conv_w[l * 1024 + ch], cw1 = p.conv_w[l * 1024 + 256 + ch], cw2 = p.conv_w[l * 1024 + 512 + ch], cw3 = p.conv_w[l * 1024 + 768 + ch];
    const float cb = p.conv_b[l * 256 + ch];
    const bf16_t* lwt = (const bf16_t*)(p.ws + WS_LWT) + (size_t)l * 32768 + g * 4096;
    bf16x8 wfa[4][2], wfx[4][2];
#pragma unroll
    for (int nt = 0; nt < 4; ++nt)
#pragma unroll
        for (int ks = 0; ks < 2; ++ks) { wfa[nt][ks] = *(const bf16x8*)(lwt + (nt * 16 + r16) * 64 + ks * 32 + quad * 8); wfx[nt][ks] = *(const bf16x8*)(lwt + 16384 + (nt * 16 + r16) * 64 + ks * 32 + quad * 8); }
    __syncthreads();
#pragma unroll
    for (int i = 0; i < 32; ++i) xcs[i * 256 + ch] = cb + (cw0 * bf2f(xr[i]) + cw1 * bf2f(xr[i + 1])) + (cw2 * bf2f(xr[i + 2]) + cw3 * bf2f(xr[i + 3]));
    __syncthreads();
#pragma unroll
    for (int tt = 0; tt < 2; ++tt) {
        bf16x8 xf[2];
#pragma unroll
        for (int ks = 0; ks < 2; ++ks) { const float* xp = xcs + (tt * 16 + r16) * 256 + g * 64 + ks * 32 + quad * 8; const f32x4 x0 = *(const f32x4*)xp, x1 = *(const f32x4*)(xp + 4);
            u32x4 pk = {pack2(x0[0], x0[1]), pack2(x0[2], x0[3]), pack2(x1[0], x1[1]), pack2(x1[2], x1[3])}; xf[ks] = __builtin_bit_cast(bf16x8, pk); }
#pragma unroll
        for (int nt = 0; nt < 4; ++nt) {
            f32x4 ra = __builtin_amdgcn_mfma_f32_16x16x32_bf16(wfa[nt][0], xf[0], (f32x4){0.f, 0.f, 0.f, 0.f}, 0, 0, 0); ra = __builtin_amdgcn_mfma_f32_16x16x32_bf16(wfa[nt][1], xf[1], ra, 0, 0, 0);
            f32x4 rx = __builtin_amdgcn_mfma_f32_16x16x32_bf16(wfx[nt][0], xf[0], (f32x4){0.f, 0.f, 0.f, 0.f}, 0, 0, 0); rx = __builtin_amdgcn_mfma_f32_16x16x32_bf16(wfx[nt][1], xf[1], rx, 0, 0, 0);
            u32x2 pa; pa.x = pack2(ra[0], ra[1]); pa.y = pack2(ra[2], ra[3]); u32x2 px; px.x = pack2(rx[0], rx[1]); px.y = pack2(rx[2], rx[3]);
            *(u32x2*)(preA + (tt * 16 + r16) * 256 + g * 64 + nt * 16 + quad * 4) = pa; *(u32x2*)(preX + (tt * 16 + r16) * 256 + g * 64 + nt * 16 + quad * 4) = px;
        }
    }
    __syncthreads();
    const float ba = p.lru_ba[l * 256 + ch], bx = p.lru_bx[l * 256 + ch], lam = p.lru_lam[l * 256 + ch];
    const float sp = fmaxf(-lam, 0.f) + log1pf(__expf(-fabsf(lam)));
    float hh = 0.f, P = 1.f;
    float* lhp = lh + (size_t)tok0 * 256 + ch; float* lpp = lp + (size_t)tok0 * 256 + ch;
#pragma unroll 4
    for (int i = 0; i < 32; ++i) { const float r = sigmoid_f(bf2f(preA[i * 256 + ch]) + ba), ig = sigmoid_f(bf2f(preX[i * 256 + ch]) + bx); const float la = -8.f * r * sp; const float a = __expf(la);
        const float w2 = 2.f * la;
        const float em_s = -w2 * (1.f + w2 * (0.5f + w2 * (0.16666667f + w2 * (0.041666668f + w2 * (0.0083333338f + w2 * 0.0013888889f)))));
        const float em = (w2 > -0.25f) ? em_s : (1.f - a * a);
        const float u = __builtin_amdgcn_sqrtf(em) * (ig * xcs[i * 256 + ch]); hh = a * hh + u; P *= a;
        lhp[(size_t)i * 256] = hh; lpp[(size_t)i * 256] = P; }
}

__device__ void lru3_item(const Params& p, int idx) {
    const int ch = tid_opq(); const int b = idx >> 7, c = idx & 127; const int tok0 = b * S + c * 32;
    const bf16_t* z = (const bf16_t*)(p.ws + WS_Z); bf16_t* mix = (bf16_t*)(p.ws + WS_U);
    const float* lh = (const float*)(p.ws + WS_LH); const float* lp = (const float*)(p.ws + WS_LP); const float* lc = (const float*)(p.ws + WS_LC);
    const float carry = lc[(size_t)(b * 128 + c) * 256 + ch];
    float hv[32], pv[32]; bf16_t gv[32];
#pragma unroll
    for (int i = 0; i < 32; ++i) { const size_t tok = (size_t)(tok0 + i); hv[i] = lh[tok * 256 + ch]; pv[i] = lp[tok * 256 + ch]; gv[i] = z[tok * ZP + C_BG + ch]; }
#pragma unroll
    for (int i = 0; i < 32; ++i) { const size_t tok = (size_t)(tok0 + i); mix[tok * 1024 + 256 + ch] = f2bf((hv[i] + pv[i] * carry) * silu_f(bf2f(gv[i]))); }
}

__device__ void dilc_item(const Params& p, int idx) {
    const int t = tid_opq(); const size_t tok = (size_t)idx * 8 + (t >> 5); const int chn = t & 31; const int h = chn >> 3;
    const bf16_t* z = (const bf16_t*)(p.ws + WS_Z); bf16_t* mix = (bf16_t*)(p.ws + WS_U);
    const bf16_t* dilo = (const bf16_t*)(p.ws + WS_DILO); const float* dill = (const float*)(p.ws + WS_DILL);
    const float l0 = dill[((size_t)0 * T + tok) * 4 + h], l1 = dill[((size_t)1 * T + tok) * 4 + h], l2 = dill[((size_t)2 * T + tok) * 4 + h];
    const float mx = fmaxf(l0, fmaxf(l1, l2)); float w0 = __expf(l0 - mx), w1 = __expf(l1 - mx), w2 = __expf(l2 - mx); const float inv = 1.f / (w0 + w1 + w2); w0 *= inv; w1 *= inv; w2 *= inv;
    const u32x4 o0 = *(const u32x4*)(dilo + ((size_t)0 * T + tok) * 256 + chn * 8), o1 = *(const u32x4*)(dilo + ((size_t)1 * T + tok) * 256 + chn * 8), o2 = *(const u32x4*)(dilo + ((size_t)2 * T + tok) * 256 + chn * 8);
    const u32x4 gv = *(const u32x4*)(z + tok * ZP + C_CG + chn * 8);
    u32x4 r;
#pragma unroll
    for (int e = 0; e < 4; ++e) {
        const float a = w0 * __uint_as_float(o0[e] << 16) + w1 * __uint_as_float(o1[e] << 16) + w2 * __uint_as_float(o2[e] << 16);
        const float bq = w0 * __uint_as_float(o0[e] & 0xffff0000u) + w1 * __uint_as_float(o1[e] & 0xffff0000u) + w2 * __uint_as_float(o2[e] & 0xffff0000u);
        r[e] = pack2(a * silu_f(__uint_as_float(gv[e] << 16)), bq * silu_f(__uint_as_float(gv[e] & 0xffff0000u)));
    }
    *(u32x4*)(mix + tok * 1024 + 512 + chn * 8) = r;
}

__device__ void m2_phase(const Params& p, char* smem) {
    float* gkv = (float*)(p.ws + WS_GKV); const float* gdec = (const float*)(p.ws + WS_GDEC);
    const float* lh = (const float*)(p.ws + WS_LH); const float* lp = (const float*)(p.ws + WS_LP); float* lc = (float*)(p.ws + WS_LC);
    float* aggP = (float*)smem; float* aggS = aggP + 256;
    const int t = tid_opq(); const int e = t & 31, seg = t >> 5;
    for (int it = blockIdx.x; it < 1024 + 32; it += gridDim.x) {
        float a[16], x[16];
        size_t ostride;
        float* outp;
        if (it < 1024) {
            const int gid = it * 32 + e; const int bh = gid >> 11, dv = gid & 2047, d = dv >> 6;
            float* base = gkv + (size_t)bh * 128 * 2048 + dv + (size_t)(seg * 16) * 2048; const float* dc = gdec + (size_t)bh * 128 * 32 + d + (seg * 16) * 32;
#pragma unroll
            for (int k = 0; k < 16; ++k) { x[k] = base[(size_t)k * 2048]; a[k] = dc[k * 32]; }
            outp = base; ostride = 2048;
        } else {
            const int i2 = it - 1024; const int b = i2 >> 3, ch = (i2 & 7) * 32 + e;
#pragma unroll
            for (int k = 0; k < 16; ++k) { const size_t ix = (size_t)(b * S + (seg * 16 + k) * 32 + 31) * 256 + ch; a[k] = lp[ix]; x[k] = lh[ix]; }
            outp = lc + (size_t)(b * 128 + seg * 16) * 256 + ch; ostride = 256;
        }
        float st = 0.f, pr = 1.f;
#pragma unroll
        for (int k = 0; k < 16; ++k) { const float ak = a[k], xk = x[k]; a[k] = pr; x[k] = st; st = ak * st + xk; pr *= ak; }
        __syncthreads();
        aggP[seg * 32 + e] = pr; aggS[seg * 32 + e] = st;
        __syncthreads();
        float carry = 0.f;
        for (int s2 = 0; s2 < seg; ++s2) carry = aggP[s2 * 32 + e] * carry + aggS[s2 * 32 + e];
#pragma unroll
        for (int k = 0; k < 16; ++k) outp[(size_t)k * ostride] = x[k] + a[k] * carry;
    }
}

__global__ void __launch_bounds__(256, 2) fwd_megakernel(Params p) {
    __shared__ __attribute__((aligned(16))) char smem[SMEM_BYTES];
    __shared__ uint4 xb_words;
    __shared__ int s_slot;
    cg::grid_group grid = cg::this_grid();
    if (p.out == nullptr) grid.sync();
    if (threadIdx.x == 0) xb_words = make_uint4(0u, 0u, 0u, 0u);
    __syncthreads();
    const XcdBarrier xb = xcd_barrier_post((unsigned*)(p.ws + WS_CTL), (volatile LAS unsigned*)&xb_words);
    unsigned* cnt = (unsigned*)(p.ws + WS_CNT);
    prologue_phase(p, smem);
    xcd_barrier(xb);
#pragma unroll 1
    for (int l = 0; l < DEPTH; ++l) {
        ln_phase(p, l);
        xcd_barrier(xb);
        g1_phase(p, l, smem);
        xcd_barrier(xb);
        for (;;) { const int it = next_item(cnt + (4 + l) * 64, &s_slot); if (it >= 512) break; lru1_item(p, l, it, smem); }
        for (;;) { const int it = next_item(cnt + (0 + l) * 64, &s_slot); if (it >= 512) break; moba_item(p, it, smem, (bf16_t*)(p.ws + WS_U)); }
        for (;;) { const int it = next_item(cnt + (6 + l) * 64, &s_slot); if (it >= 1536) break; attn_item(p, 1, it, smem); }
        for (;;) { const int it = next_item(cnt + (2 + l) * 64, &s_slot); if (it >= 512) break; gla1_item(p, l, it, smem); }
        xcd_barrier(xb);
        m2_phase(p, smem);
        xcd_barrier(xb);
        for (int it = blockIdx.x; it < 512; it += gridDim.x) gla3_item(p, l, it, smem);
        for (int it = blockIdx.x; it < 512; it += gridDim.x) lru3_item(p, it);
        for (int it = blockIdx.x; it < 2048; it += gridDim.x) dilc_item(p, it);
        xcd_barrier(xb);
        g2_phase(p, l, smem);
        xcd_barrier(xb);
    }
    ln_phase(p, DEPTH);
}

extern "C" void kernel_launch(void* const* d_in, const int* in_sizes, int n_in, void* d_out, int out_size, void* d_ws, size_t ws_size, hipStream_t stream) {
    static int grid_blocks = 0;
    if (!grid_blocks) {
        int dev = 0, cus = 0, per_cu = 0;
        hipGetDevice(&dev);
        hipDeviceGetAttribute(&cus, hipDeviceAttributeMultiprocessorCount, dev);
        hipOccupancyMaxActiveBlocksPerMultiprocessor(&per_cu, (const void*)fwd_megakernel, 256, 0);
        if (per_cu < 1) per_cu = 1;
        if (per_cu > 2) per_cu = 2;
        grid_blocks = cus * per_cu;
        if (ws_size < WS_END) fprintf(stderr, "kernel_launch: workspace too small: %zu < %zu\n", ws_size, (size_t)WS_END);
    }
    Params p{};
    p.x = (const float*)d_in[0]; p.c = (const float*)d_in[1]; p.pos = (const int*)d_in[2];
    p.w_mod = (const float*)d_in[3]; p.b_mod = (const float*)d_in[4]; p.w_in = (const float*)d_in[5];
    p.conv_w = (const float*)d_in[6]; p.conv_b = (const float*)d_in[7]; p.lru_wa = (const float*)d_in[8]; p.lru_ba = (const float*)d_in[9];
    p.lru_wx = (const float*)d_in[10]; p.lru_bx = (const float*)d_in[11]; p.lru_lam = (const float*)d_in[12];
    p.gla_wr = (const float*)d_in[13]; p.gla_br = (const float*)d_in[14]; p.gla_gn = (const float*)d_in[15];
    p.w_out = (const float*)d_in[16]; p.ln_g = (const float*)d_in[17]; p.ln_b = (const float*)d_in[18];
    p.out = (float*)d_out; p.ws = (unsigned char*)d_ws;
    (void)hipMemsetAsync(d_ws, 0, 32768, stream);
    void* args[] = {&p};
    hipError_t e = hipLaunchCooperativeKernel((const void*)fwd_megakernel, dim3(grid_blocks), dim3(256), args, 0, stream);
    if (e != hipSuccess) fprintf(stderr, "cooperative launch failed: %s (grid %d)\n", hipGetErrorString(e), grid_blocks);
}
```

```cpp
#include <hip/hip_runtime.h>
#include <hip/hip_cooperative_groups.h>
#include <cstdio>
#include <cstdint>
#include <type_traits>
namespace cg = cooperative_groups;

typedef unsigned short bf16_t;
typedef short bf16x8 __attribute__((ext_vector_type(8)));
typedef short bf16x4 __attribute__((ext_vector_type(4)));
typedef float f32x4 __attribute__((ext_vector_type(4)));
typedef unsigned u32x4 __attribute__((ext_vector_type(4)));
typedef unsigned u32x2 __attribute__((ext_vector_type(2)));

constexpr int D = 1024, NB = 4, S = 4096, T = NB * S, DEPTH = 2;
constexpr int DIN = 3344, ZP = 3344, NPAD = 3456;
constexpr int C_AQ = 0, C_AK = 256, C_AV = 512, C_AG = 768, C_BX = 1024, C_BG = 1280, C_CQ = 1536, C_CK = 1792,
              C_CV = 2048, C_CG = 2304, C_DQ = 2560, C_DK = 2688, C_DV = 2816, C_DG = 3072, C_DR = 3328;
constexpr float DN_ALPHA = 1.4142135623730951f;
constexpr int LDP = 72;
constexpr int SMEM_BYTES = 65536;
constexpr int BIG = 1000000;

constexpr size_t WS_CTL = 0;
constexpr size_t WS_CNT = 16384;
constexpr size_t WS_WINT = 32768;
constexpr size_t WS_WOUTT = WS_WINT + (size_t)DEPTH * NPAD * 1024 * 2;
constexpr size_t WS_MOD = WS_WOUTT + (size_t)DEPTH * 1024 * 1024 * 2;
constexpr size_t WS_COS = WS_MOD + (size_t)DEPTH * NB * 3072 * 4;
constexpr size_t WS_SIN = WS_COS + (size_t)T * 32 * 4;
constexpr size_t WS_U = WS_SIN + (size_t)T * 32 * 4;
constexpr size_t WS_Z = WS_U + (size_t)T * 1024 * 2;
constexpr size_t WS_KPART = WS_Z + (size_t)T * ZP * 2;
constexpr size_t WS_DILO = WS_KPART + (size_t)256 * 256 * 4;
constexpr size_t WS_DILL = WS_DILO + (size_t)3 * T * 256 * 2;
constexpr size_t WS_GKV = WS_DILL + (size_t)3 * T * 4 * 4;
constexpr size_t WS_GDEC = WS_GKV + (size_t)2048 * 2048 * 4;
constexpr size_t WS_LH = WS_GDEC + (size_t)2048 * 32 * 4;
constexpr size_t WS_LP = WS_LH + (size_t)T * 256 * 4;
constexpr size_t WS_LC = WS_LP + (size_t)T * 256 * 4;
constexpr size_t WS_LWT = WS_LC + (size_t)NB * 128 * 256 * 4;
constexpr size_t WS_BC = WS_LWT + (size_t)DEPTH * 2 * 4 * 64 * 64 * 2;
constexpr size_t WS_END = WS_BC + (size_t)512 * 32 * 128 * 4;

struct Params {
    const float *x, *c; const int* pos;
    const float *w_mod, *b_mod, *w_in, *conv_w, *conv_b, *lru_wa, *lru_ba, *lru_wx, *lru_bx, *lru_lam, *gla_wr, *gla_br, *gla_gn, *w_out, *ln_g, *ln_b;
    float* out; unsigned char* ws;
};

__device__ __forceinline__ float bf2f(bf16_t h) { return __uint_as_float(((unsigned)h) << 16); }
typedef __bf16 hbf16x2 __attribute__((ext_vector_type(2)));
typedef float f32x2 __attribute__((ext_vector_type(2)));
__device__ __forceinline__ unsigned pack2(float a, float b) { f32x2 v = {a, b}; hbf16x2 r = __builtin_convertvector(v, hbf16x2); return __builtin_bit_cast(unsigned, r); }
__device__ __forceinline__ bf16_t f2bf(float f) { return (bf16_t)(pack2(f, 0.f) & 0xffffu); }
__device__ __forceinline__ float silu_f(float x) { return x / (1.f + __expf(-x)); }
__device__ __forceinline__ float sigmoid_f(float x) { return 1.f / (1.f + __expf(-x)); }
__device__ __forceinline__ int tid_opq() { int t = threadIdx.x; asm volatile("" : "+v"(t)); return t; }
__device__ __forceinline__ float wsum(float v) {
#pragma unroll
    for (int o = 32; o; o >>= 1) v += __shfl_xor(v, o);
    return v;
}

#define XB_TMO      128
#define XB_XCNT(j)  (256  + 64 * (j))
#define XB_XSUB(j)  (1280 + 64 * (j))
#define XB_XGEN(j)  (2304 + 64 * (j))
#define XB_TOP      3328
#define XB_TOPGEN   3392
#define XCD_BAR_WORDS 3456
#define XB_SPIN_CAP (1u << 18)
#define LAS __attribute__((address_space(3)))
__device__ __forceinline__ unsigned xb_ld(unsigned* p)              { return __hip_atomic_load(p, __ATOMIC_RELAXED, __HIP_MEMORY_SCOPE_AGENT); }
__device__ __forceinline__ unsigned xb_add(unsigned* p, unsigned v) { return __hip_atomic_fetch_add(p, v, __ATOMIC_RELAXED, __HIP_MEMORY_SCOPE_AGENT); }
__device__ __forceinline__ unsigned xb_xcc_id() { return (unsigned)__builtin_amdgcn_s_getreg((3 << 11) | 20) & 0xFu; }
#define XB_SPIN(cond, bar) do { unsigned _sp = 0; while (cond) { __builtin_amdgcn_s_sleep(1); \
    if ((++_sp & 255u) == 0u) { if (xb_ld(&(bar)[XB_TMO])) break; if (_sp > XB_SPIN_CAP) { atomicAdd(&(bar)[XB_TMO], 1u); break; } } } } while (0)
struct XcdBarrier { unsigned* bar; unsigned x; volatile LAS unsigned* st; };
__device__ __forceinline__ XcdBarrier xcd_barrier_post(unsigned* bar, volatile LAS unsigned* st) {
    XcdBarrier b; b.bar = bar; b.x = xb_xcc_id(); b.st = st;
    if (threadIdx.x == 0) (void)xb_add(&bar[XB_XCNT(b.x)], 1u);
    return b;
}
__device__ __forceinline__ void xcd_barrier_complete(unsigned* bar, unsigned x, unsigned& nloc, unsigned& nx) {
    const unsigned G = gridDim.x * gridDim.y * gridDim.z;
    unsigned sum, cnt, mine, sp = 0u;
    for (;;) {
        sum = 0u; cnt = 0u; mine = 0u;
#pragma unroll
        for (unsigned j = 0; j < 16; ++j) { const unsigned c = xb_ld(&bar[XB_XCNT(j)]); sum += c; cnt += (c > 0u) ? 1u : 0u; mine = (j == x) ? c : mine; }
        if (sum == G) break;
        __builtin_amdgcn_s_sleep(1);
        if ((++sp & 255u) == 0u) { if (xb_ld(&bar[XB_TMO])) break; if (sp > XB_SPIN_CAP) { atomicAdd(&bar[XB_TMO], 1u); break; } }
    }
    nloc = mine > 0u ? mine : 1u; nx = cnt > 0u ? cnt : 1u;
}
__device__ __forceinline__ void xcd_barrier(const XcdBarrier& b) {
    asm volatile("s_waitcnt vmcnt(0)" ::: "memory");
    __syncthreads();
    if (threadIdx.x == 0) {
        unsigned* bar = b.bar;
        __builtin_amdgcn_s_waitcnt(0);
        unsigned nloc = b.st[0], nx = b.st[1];
        if (nloc == 0u) { xcd_barrier_complete(bar, b.x, nloc, nx); b.st[0] = nloc; b.st[1] = nx; }
        const unsigned old = xb_add(&bar[XB_XSUB(b.x)], 1u);
        const unsigned gen = old / nloc;
        if (old + 1u == (gen + 1u) * nloc) {
            __builtin_amdgcn_fence(__ATOMIC_RELEASE, "agent");
            asm volatile("s_waitcnt vmcnt(0)" ::: "memory");
            const unsigned og = xb_add(&bar[XB_TOP], 1u);
            const unsigned tg = og / nx;
            if (og + 1u == (tg + 1u) * nx) xb_add(&bar[XB_TOPGEN], 1u);
            else XB_SPIN(xb_ld(&bar[XB_TOPGEN]) == tg, bar);
            __builtin_amdgcn_fence(__ATOMIC_ACQUIRE, "agent");
            xb_add(&bar[XB_XGEN(b.x)], 1u);
            asm volatile("s_waitcnt vmcnt(0)" ::: "memory");
        } else {
            XB_SPIN(xb_ld(&bar[XB_XGEN(b.x)]) == gen, bar);
            __builtin_amdgcn_fence(__ATOMIC_ACQUIRE, "agent");
            asm volatile("s_waitcnt vmcnt(0)" ::: "memory");
        }
    }
    __syncthreads();
}
__device__ __forceinline__ int next_item(unsigned* ctr, volatile int* slot) {
    __syncthreads();
    if (threadIdx.x == 0) *slot = (int)atomicAdd(ctr, 1u);
    __syncthreads();
    return *slot;
}

__device__ void prologue_phase(const Params& p, char* smem) {
    const int t = tid_opq();
    bf16_t* WinT = (bf16_t*)(p.ws + WS_WINT); bf16_t* WoutT = (bf16_t*)(p.ws + WS_WOUTT);
    float* mod = (float*)(p.ws + WS_MOD); float* cosT = (float*)(p.ws + WS_COS); float* sinT = (float*)(p.ws + WS_SIN);
    float* tl = (float*)smem;
    constexpr int N_TIN = DEPTH * 16 * 54, N_TOUT = DEPTH * 16 * 16, N_MOD = DEPTH * 192, N_ROPE = T * 32 / 256, N_LWT = DEPTH * 2 * 4 * 64 * 64 / 256;
    constexpr int NITEMS = N_TIN + N_TOUT + N_MOD + N_ROPE + N_LWT;
    for (int it = blockIdx.x; it < NITEMS; it += gridDim.x) {
        if (it < N_TIN + N_TOUT) {
            const float* src; bf16_t* dst; int ncols, kt, nt;
            if (it < N_TIN) { int l = it / (16 * 54), r = it % (16 * 54); kt = r / 54; nt = r % 54; src = p.w_in + (size_t)l * 1024 * DIN; dst = WinT + (size_t)l * NPAD * 1024; ncols = DIN; }
            else { int i2 = it - N_TIN; int l = i2 / 256, r = i2 % 256; kt = r / 16; nt = r % 16; src = p.w_out + (size_t)l * 1024 * 1024; dst = WoutT + (size_t)l * 1024 * 1024; ncols = 1024; }
            __syncthreads();
            { const int c4 = t & 15, r0 = t >> 4; const int n = nt * 64 + c4 * 4;
              f32x4 v[4];
#pragma unroll
              for (int i = 0; i < 4; ++i) { const int r = r0 + 16 * i; v[i] = (n < ncols) ? *(const f32x4*)(src + (size_t)(kt * 64 + r) * ncols + n) : (f32x4){0.f, 0.f, 0.f, 0.f}; }
#pragma unroll
              for (int i = 0; i < 4; ++i) { const int r = r0 + 16 * i; tl[r * 65 + c4 * 4] = v[i][0]; tl[r * 65 + c4 * 4 + 1] = v[i][1]; tl[r * 65 + c4 * 4 + 2] = v[i][2]; tl[r * 65 + c4 * 4 + 3] = v[i][3]; } }
            __syncthreads();
            {
#pragma unroll
              for (int i = 0; i < 2; ++i) { const int cc = t + 256 * i; const int n = cc >> 3, k8 = (cc & 7) * 8;
                  u32x4 pk; pk.x = pack2(tl[(k8 + 0) * 65 + n], tl[(k8 + 1) * 65 + n]); pk.y = pack2(tl[(k8 + 2) * 65 + n], tl[(k8 + 3) * 65 + n]);
                  pk.z = pack2(tl[(k8 + 4) * 65 + n], tl[(k8 + 5) * 65 + n]); pk.w = pack2(tl[(k8 + 6) * 65 + n], tl[(k8 + 7) * 65 + n]);
                  *(u32x4*)(dst + (size_t)(nt * 64 + n) * 1024 + kt * 64 + k8) = pk; } }
        } else if (it < N_TIN + N_TOUT + N_MOD) {
            const int i2 = it - N_TIN - N_TOUT; const int l = i2 / 192, jg = i2 % 192;
            const int jj = t & 15, ks = t >> 4; const int j = jg * 16 + jj;
            float a0 = 0.f, a1 = 0.f, a2 = 0.f, a3 = 0.f;
            const float* wm = p.w_mod + (size_t)l * 1024 * 3072 + j;
#pragma unroll 8
            for (int k = ks * 64; k < ks * 64 + 64; ++k) { float wv = wm[(size_t)k * 3072]; a0 += p.c[k] * wv; a1 += p.c[1024 + k] * wv; a2 += p.c[2048 + k] * wv; a3 += p.c[3072 + k] * wv; }
            __syncthreads();
            tl[(0 * 16 + ks) * 16 + jj] = a0; tl[(1 * 16 + ks) * 16 + jj] = a1; tl[(2 * 16 + ks) * 16 + jj] = a2; tl[(3 * 16 + ks) * 16 + jj] = a3;
            __syncthreads();
            if (t < 64) { const int b = t >> 4, j2 = t & 15; float s = 0.f;
#pragma unroll
              for (int k2 = 0; k2 < 16; ++k2) s += tl[(b * 16 + k2) * 16 + j2];
              mod[((size_t)l * NB + b) * 3072 + jg * 16 + j2] = s + p.b_mod[l * 3072 + jg * 16 + j2]; }
        } else if (it >= N_TIN + N_TOUT + N_MOD + N_ROPE) {
            const int e = (it - N_TIN - N_TOUT - N_MOD - N_ROPE) * 256 + t;
            const int in = e & 63, out = (e >> 6) & 63, g = (e >> 12) & 3, mat = (e >> 14) & 1, l = e >> 15;
            const float* src = mat ? p.lru_wx : p.lru_wa;
            ((bf16_t*)(p.ws + WS_LWT))[e] = f2bf(src[l * 16384 + g * 4096 + in * 64 + out]);
        } else {
            const int i2 = it - N_TIN - N_TOUT - N_MOD; const int e = i2 * 256 + t; const int tok = e >> 5, f = e & 31;
            const float inv = exp2f(-(float)f * (13.287712379549449f / 32.f));
            const float ang = (float)p.pos[tok] * inv;
            double rev = (double)ang * 0.15915494309189535; rev -= __builtin_rint(rev);
            const float rr = (float)rev; cosT[e] = __builtin_amdgcn_cosf(rr); sinT[e] = __builtin_amdgcn_sinf(rr);
        }
    }
}

__device__ void ln_phase(const Params& p, int l) {
    const int t = tid_opq(), lane = t & 63, w = t >> 6;
    bf16_t* ubuf = (bf16_t*)(p.ws + WS_U); const float* mod = (const float*)(p.ws + WS_MOD);
    for (int rg = blockIdx.x; rg < T / 16; rg += gridDim.x) {
        f32x4 v[4][4];
#pragma unroll
        for (int r = 0; r < 4; ++r) { const int row = rg * 16 + w * 4 + r; const float* src = (l <= 1) ? p.x + (size_t)row * 1024 : p.out + (size_t)row * 1024;
#pragma unroll
            for (int i = 0; i < 4; ++i) v[r][i] = *(const f32x4*)(src + i * 256 + lane * 4);
            if (l > 0) {
                const bf16_t* yr = (const bf16_t*)(p.ws + WS_Z) + (size_t)row * 1024; const float* gate = mod + ((size_t)(l - 1) * NB + row / S) * 3072 + 2048;
#pragma unroll
                for (int i = 0; i < 4; ++i) { const u32x2 yv = *(const u32x2*)(yr + i * 256 + lane * 4); const f32x4 g1 = *(const f32x4*)(gate + i * 256 + lane * 4) + 1.f;
                    const f32x4 yf = {__uint_as_float(yv.x << 16), __uint_as_float(yv.x & 0xffff0000u), __uint_as_float(yv.y << 16), __uint_as_float(yv.y & 0xffff0000u)};
                    v[r][i] = v[r][i] * DN_ALPHA + g1 * yf; }
            } }
#pragma unroll
        for (int r = 0; r < 4; ++r) {
            const int row = rg * 16 + w * 4 + r; const int b = row / S;
            if (l > 0) {
                float s = 0.f;
#pragma unroll
                for (int i = 0; i < 4; ++i) s += (v[r][i][0] + v[r][i][1]) + (v[r][i][2] + v[r][i][3]);
                const float mu = wsum(s) * (1.f / 1024.f); float q = 0.f;
#pragma unroll
                for (int i = 0; i < 4; ++i) { f32x4 d = v[r][i] - mu; q += (d[0] * d[0] + d[1] * d[1]) + (d[2] * d[2] + d[3] * d[3]); }
                const float rstd = rsqrtf(wsum(q) * (1.f / 1024.f) + 1e-5f);
#pragma unroll
                for (int i = 0; i < 4; ++i) { const f32x4 g = *(const f32x4*)(p.ln_g + (l - 1) * 1024 + i * 256 + lane * 4), bb = *(const f32x4*)(p.ln_b + (l - 1) * 1024 + i * 256 + lane * 4);
                    v[r][i] = (v[r][i] - mu) * rstd * g + bb; *(f32x4*)(p.out + (size_t)row * 1024 + i * 256 + lane * 4) = v[r][i]; }
            }
            if (l < DEPTH) {
                float s = 0.f;
#pragma unroll
                for (int i = 0; i < 4; ++i) s += (v[r][i][0] + v[r][i][1]) + (v[r][i][2] + v[r][i][3]);
                const float mu = wsum(s) * (1.f / 1024.f); float q = 0.f;
#pragma unroll
                for (int i = 0; i < 4; ++i) { f32x4 d = v[r][i] - mu; q += (d[0] * d[0] + d[1] * d[1]) + (d[2] * d[2] + d[3] * d[3]); }
                const float rstd = rsqrtf(wsum(q) * (1.f / 1024.f) + 1e-5f);
                const float* mb = mod + ((size_t)l * NB + b) * 3072;
#pragma unroll
                for (int i = 0; i < 4; ++i) { const int col = i * 256 + lane * 4; const f32x4 sh = *(const f32x4*)(mb + col), sc = *(const f32x4*)(mb + 1024 + col);
                    f32x4 u = (v[r][i] - mu) * rstd * (sc + 1.f) + sh; u32x2 pk; pk.x = pack2(u[0], u[1]); pk.y = pack2(u[2], u[3]);
                    *(u32x2*)(ubuf + (size_t)row * 1024 + col) = pk; }
            }
        }
    }
}

__device__ __forceinline__ int lds_off(int r, int c8) {
    const int st = (r >> 4) * 2 + (c8 >> 2); const int ob = (r & 15) * 64 + (c8 & 3) * 16;
    return st * 1024 + (ob ^ (((ob >> 9) & 1) << 5));
}
struct RegSet { u32x4 a[4], b[4]; };
__device__ __forceinline__ void gemm_tile(const bf16_t* __restrict__ A, const bf16_t* __restrict__ Bt, int tm, int tn, bool first, bool has_next, int ntm, int ntn,
                                          char* sm, f32x4 (&acc)[4][4], RegSet& r0, RegSet& r1) {
    const int t = tid_opq(), lane = t & 63, w = t >> 6, wm = w >> 1, wn = w & 1, r16 = lane & 15, quad = lane >> 4;
    const int lrow = t >> 3, lch = t & 7;
    constexpr int BUF = 32768;
    const unsigned loff = (unsigned)(lrow * 1024 + lch * 8);
    const bf16_t* At0 = A + (size_t)tm * (128 * 1024); const bf16_t* Bt0 = Bt + (size_t)tn * (128 * 1024);
    const bf16_t* At1 = A + (size_t)ntm * (128 * 1024); const bf16_t* Bt1 = Bt + (size_t)ntn * (128 * 1024);
#define Ag (At0 + loff)
#define Bg (Bt0 + loff)
#define nAg (At1 + loff)
#define nBg (Bt1 + loff)
    const int woff0 = lds_off(lrow, lch);
#define woff(i) (woff0 + 4096 * (i))
    const int fo = lds_off(r16, quad);
#pragma unroll
    for (int a = 0; a < 4; ++a)
#pragma unroll
        for (int b = 0; b < 4; ++b) acc[a][b] = (f32x4){0.f, 0.f, 0.f, 0.f};
    if (first) {
#pragma unroll
        for (int i = 0; i < 4; ++i) { r0.a[i] = *(const u32x4*)(Ag + (size_t)i * 32 * 1024); r0.b[i] = *(const u32x4*)(Bg + (size_t)i * 32 * 1024); }
#pragma unroll
        for (int i = 0; i < 4; ++i) { r1.a[i] = *(const u32x4*)(Ag + (size_t)i * 32 * 1024 + 64); r1.b[i] = *(const u32x4*)(Bg + (size_t)i * 32 * 1024 + 64); }
        __syncthreads();
#pragma unroll
        for (int i = 0; i < 4; ++i) { *(u32x4*)(sm + woff(i)) = r0.a[i]; *(u32x4*)(sm + 16384 + woff(i)) = r0.b[i]; }
#pragma unroll
        for (int i = 0; i < 4; ++i) { r0.a[i] = *(const u32x4*)(Ag + (size_t)i * 32 * 1024 + 128); r0.b[i] = *(const u32x4*)(Bg + (size_t)i * 32 * 1024 + 128); }
    }
    __syncthreads();
    auto step = [&](auto main_tag, int kt, RegSet& rs) {
        constexpr bool MAIN = decltype(main_tag)::value;
        const char* sA = sm + (kt & 1) * BUF; const char* sB = sA + 16384;
        char* nA = sm + ((kt + 1) & 1) * BUF; char* nB = nA + 16384;
        const bool wr = MAIN || kt + 1 < 16 || has_next;
        const bool own = MAIN || kt + 3 < 16;
        const bf16_t* la = own ? Ag + (kt + 3) * 64 : nAg + (kt - 13) * 64; const bf16_t* lb = own ? Bg + (kt + 3) * 64 : nBg + (kt - 13) * 64;
        __builtin_amdgcn_s_setprio(1);
#pragma unroll
        for (int ks = 0; ks < 2; ++ks) {
            bf16x8 af[4], bfr[4];
#pragma unroll
            for (int mt = 0; mt < 4; ++mt) af[mt] = *(const bf16x8*)(sA + ((wm * 4 + mt) * 2 + ks) * 1024 + fo);
#pragma unroll
            for (int nt = 0; nt < 4; ++nt) bfr[nt] = *(const bf16x8*)(sB + ((wn * 4 + nt) * 2 + ks) * 1024 + fo);
#pragma unroll
            for (int mt = 0; mt < 4; ++mt) {
#pragma unroll
                for (int nt = 0; nt < 4; ++nt) acc[mt][nt] = __builtin_amdgcn_mfma_f32_16x16x32_bf16(bfr[nt], af[mt], acc[mt][nt], 0, 0, 0);
                const int i = ks * 2 + (mt >> 1);
                __builtin_amdgcn_sched_barrier(0);
                if ((mt & 1) == 0) { if (wr) *(u32x4*)(nA + woff(i)) = rs.a[i]; if (own || has_next) rs.a[i] = *(const u32x4*)(la + (size_t)i * 32 * 1024); }
                else               { if (wr) *(u32x4*)(nB + woff(i)) = rs.b[i]; if (own || has_next) rs.b[i] = *(const u32x4*)(lb + (size_t)i * 32 * 1024); }
                __builtin_amdgcn_sched_barrier(0);
            }
        }
        __builtin_amdgcn_s_setprio(0);
        __syncthreads();
    };
    {
        std::true_type mt_; std::false_type tl_;
        for (int k2 = 0; k2 < 6; ++k2) { step(mt_, 2 * k2, r1); step(mt_, 2 * k2 + 1, r0); }
        step(mt_, 12, r1); step(tl_, 13, r0); step(tl_, 14, r1); step(tl_, 15, r0);
    }
#undef Ag
#undef Bg
#undef nAg
#undef nBg
#undef woff
}

__device__ void g1_phase(const Params& p, int l, char* smem) {
    const int t = tid_opq(), lane = t & 63, w = t >> 6, wm = w >> 1, wn = w & 1, r16 = lane & 15, quad = lane >> 4;
    char* sm = smem; char* sC = smem + 32768;
    const bf16_t* ubuf = (const bf16_t*)(p.ws + WS_U); const bf16_t* WinT = (const bf16_t*)(p.ws + WS_WINT) + (size_t)l * NPAD * 1024;
    bf16_t* z = (bf16_t*)(p.ws + WS_Z); float* kpart = (float*)(p.ws + WS_KPART);
    const float* cosT = (const float*)(p.ws + WS_COS); const float* sinT = (const float*)(p.ws + WS_SIN);
    const bool xo = (gridDim.x & 7) == 0; const int xcd = blockIdx.x & 7, nloc = xo ? (int)(gridDim.x >> 3) : (int)gridDim.x, j0 = xo ? (int)(blockIdx.x >> 3) : (int)blockIdx.x;
    const int lim = xo ? 16 * 27 : 128 * 27;
    RegSet r0, r1;
    for (int L = j0; L < lim; L += nloc) {
        const int tm = xo ? xcd * 16 + (L / 216) * 8 + (L & 7) : L / 27, tn = xo ? ((L % 216) >> 3) : L % 27;
        const int L2 = L + nloc; const bool has_next = L2 < lim;
        const int ntm = has_next ? (xo ? xcd * 16 + (L2 / 216) * 8 + (L2 & 7) : L2 / 27) : tm, ntn = has_next ? (xo ? ((L2 % 216) >> 3) : L2 % 27) : tn;
        f32x4 acc[4][4];
        gemm_tile(ubuf, WinT, tm, tn, L == j0, has_next, ntm, ntn, sm, acc, r0, r1);
        const bool rope = (tn < 4) || (tn >= 12 && tn < 16);
        if (rope) {
#pragma unroll
            for (int mt = 0; mt < 4; ++mt) {
                const int tok = tm * 128 + wm * 64 + mt * 16 + r16;
#pragma unroll
                for (int nt = 0; nt < 2; ++nt) {
                    const f32x4 cs = *(const f32x4*)(cosT + (size_t)tok * 32 + nt * 16 + quad * 4), sn = *(const f32x4*)(sinT + (size_t)tok * 32 + nt * 16 + quad * 4);
                    const f32x4 x1 = acc[mt][nt], x2 = acc[mt][nt + 2];
                    acc[mt][nt] = x1 * cs - x2 * sn; acc[mt][nt + 2] = x1 * sn + x2 * cs;
                }
            }
        }
        if (tn == 2 || tn == 3) {
#pragma unroll
            for (int nt = 0; nt < 4; ++nt) {
                f32x4 sv = (acc[0][nt] + acc[1][nt]) + (acc[2][nt] + acc[3][nt]);
#pragma unroll
                for (int jj = 0; jj < 4; ++jj) { float sx = sv[jj]; sx += __shfl_xor(sx, 1); sx += __shfl_xor(sx, 2); sx += __shfl_xor(sx, 4); sx += __shfl_xor(sx, 8); sv[jj] = sx; }
                if (r16 == 0) *(f32x4*)(kpart + (size_t)(tm * 2 + wm) * 256 + (tn - 2) * 128 + wn * 64 + nt * 16 + quad * 4) = sv;
            }
        }
#pragma unroll
        for (int mt = 0; mt < 4; ++mt)
#pragma unroll
            for (int nt = 0; nt < 4; ++nt) { u32x2 pk; pk.x = pack2(acc[mt][nt][0], acc[mt][nt][1]); pk.y = pack2(acc[mt][nt][2], acc[mt][nt][3]);
                const int row = wm * 64 + mt * 16 + r16; const int c16 = wn * 8 + nt * 2 + (quad >> 1);
                *(u32x2*)(sC + row * 256 + ((c16 ^ (row & 15)) << 4) + (quad & 1) * 8) = pk; }
        __syncthreads();
#pragma unroll
        for (int i = 0; i < 8; ++i) { const int c = t + 256 * i; const int row = c >> 4, ch = c & 15; const int col = tn * 128 + ch * 8;
            if (col < DIN) *(u32x4*)(z + (size_t)(tm * 128 + row) * ZP + col) = *(const u32x4*)(sC + row * 256 + ((ch ^ (row & 15)) << 4)); }
    }
}

__device__ void g2_phase(const Params& p, int l, char* smem) {
    const int t = tid_opq(), lane = t & 63, w = t >> 6, wm = w >> 1, wn = w & 1, r16 = lane & 15, quad = lane >> 4;
    char* sm = smem; char* sC = smem + 32768;
    const bf16_t* mix = (const bf16_t*)(p.ws + WS_U); const bf16_t* WoutT = (const bf16_t*)(p.ws + WS_WOUTT) + (size_t)l * 1024 * 1024;
    bf16_t* ybuf = (bf16_t*)(p.ws + WS_Z);
    const bool xo = (gridDim.x & 7) == 0; const int xcd = blockIdx.x & 7, nloc = xo ? (int)(gridDim.x >> 3) : (int)gridDim.x, j0 = xo ? (int)(blockIdx.x >> 3) : (int)blockIdx.x;
    const int lim = xo ? 16 * 8 : 128 * 8;
    RegSet r0, r1;
    for (int L = j0; L < lim; L += nloc) {
        const int tm = xo ? xcd * 16 + (L & 15) : (L >> 3), tn = xo ? (L >> 4) : (L & 7);
        const int L2 = L + nloc; const bool has_next = L2 < lim;
        const int ntm = has_next ? (xo ? xcd * 16 + (L2 & 15) : (L2 >> 3)) : tm, ntn = has_next ? (xo ? (L2 >> 4) : (L2 & 7)) : tn;
        f32x4 acc[4][4];
        gemm_tile(mix, WoutT, tm, tn, L == j0, has_next, ntm, ntn, sm, acc, r0, r1);
#pragma unroll
        for (int mt = 0; mt < 4; ++mt)
#pragma unroll
            for (int nt = 0; nt < 4; ++nt) { u32x2 pk; pk.x = pack2(acc[mt][nt][0], acc[mt][nt][1]); pk.y = pack2(acc[mt][nt][2], acc[mt][nt][3]);
                const int row = wm * 64 + mt * 16 + r16; const int c16 = wn * 8 + nt * 2 + (quad >> 1);
                *(u32x2*)(sC + row * 256 + ((c16 ^ (row & 15)) << 4) + (quad & 1) * 8) = pk; }
        __syncthreads();
#pragma unroll
        for (int i = 0; i < 8; ++i) { const int c = t + 256 * i; const int row = c >> 4, ch = c & 15;
            *(u32x4*)(ybuf + (size_t)(tm * 128 + row) * 1024 + tn * 128 + ch * 8) = *(const u32x4*)(sC + row * 256 + ((ch ^ (row & 15)) << 4)); }
    }
}

constexpr float ATT_SC = 0.18033688011112042f;
template <int QT>
__device__ __forceinline__ void attn_tile(const bf16_t* sK, const bf16_t* sV, const bf16x8 (&qf)[QT][2], int lo, int hi, bool full, bool hasq, bool qfl0, bool qfl1,
                                          float (&m)[QT], float (&l)[QT], f32x4 (&O)[QT][4], int wq0) {
    const int lane = tid_opq() & 63, r16 = lane & 15, quad = lane >> 4;
    f32x4 s[QT][4];
#pragma unroll
    for (int a = 0; a < QT; ++a)
#pragma unroll
        for (int b = 0; b < 4; ++b) s[a][b] = (f32x4){0.f, 0.f, 0.f, 0.f};
#pragma unroll
    for (int ks = 0; ks < 2; ++ks)
#pragma unroll
        for (int k16 = 0; k16 < 4; ++k16) {
            const bf16x8 kf = *(const bf16x8*)(sK + (k16 * 16 + r16) * LDP + ks * 32 + quad * 8);
#pragma unroll
            for (int qt = 0; qt < QT; ++qt) s[qt][k16] = __builtin_amdgcn_mfma_f32_16x16x32_bf16(kf, qf[qt][ks], s[qt][k16], 0, 0, 0);
        }
#pragma unroll
    for (int qt = 0; qt < QT; ++qt) {
        const int ql = wq0 + qt * 16 + r16; const bool qfl = qt ? qfl1 : qfl0;
        if (!full) {
#pragma unroll
            for (int k16 = 0; k16 < 4; ++k16)
#pragma unroll
                for (int j = 0; j < 4; ++j) { const int dd = ql - (k16 * 16 + quad * 4 + j); const bool valid = dd >= lo && dd <= hi; s[qt][k16][j] = valid ? s[qt][k16][j] : -1e30f; }
        }
        if (hasq) {
#pragma unroll
            for (int k16 = 0; k16 < 4; ++k16)
#pragma unroll
                for (int j = 0; j < 4; ++j) s[qt][k16][j] = qfl ? s[qt][k16][j] : -1e30f;
        }
        float mx = -1e30f;
#pragma unroll
        for (int k16 = 0; k16 < 4; ++k16) mx = fmaxf(mx, fmaxf(fmaxf(s[qt][k16][0], s[qt][k16][1]), fmaxf(s[qt][k16][2], s[qt][k16][3])));
        mx = fmaxf(mx, __shfl_xor(mx, 16)); mx = fmaxf(mx, __shfl_xor(mx, 32));
        const float mn = fmaxf(m[qt], mx); const float alpha = __builtin_amdgcn_exp2f((m[qt] - mn) * ATT_SC); m[qt] = mn;
        const float mb = (mn < -1e29f) ? 0.f : mn * ATT_SC;
        float ps = 0.f;
#pragma unroll
        for (int k16 = 0; k16 < 4; ++k16)
#pragma unroll
            for (int j = 0; j < 4; ++j) { const float pv = __builtin_amdgcn_exp2f(s[qt][k16][j] * ATT_SC - mb); ps += pv; s[qt][k16][j] = pv; }
        l[qt] = l[qt] * alpha + ps;
#pragma unroll
        for (int dt = 0; dt < 4; ++dt) O[qt][dt] = O[qt][dt] * alpha;
    }
#pragma unroll
    for (int G = 0; G < 2; ++G) {
        bf16x8 pf[QT];
#pragma unroll
        for (int qt = 0; qt < QT; ++qt) {
            const unsigned a0 = pack2(s[qt][G * 2][0], s[qt][G * 2][1]), a1 = pack2(s[qt][G * 2][2], s[qt][G * 2][3]);
            const unsigned a2 = pack2(s[qt][G * 2 + 1][0], s[qt][G * 2 + 1][1]), a3 = pack2(s[qt][G * 2 + 1][2], s[qt][G * 2 + 1][3]);
            u32x4 pk = {a0, a1, a2, a3}; pf[qt] = __builtin_bit_cast(bf16x8, pk);
        }
#pragma unroll
        for (int dt = 0; dt < 4; ++dt) {
            const bf16_t* v0p = sV + (G * 32 + quad * 4 + (r16 >> 2)) * LDP + dt * 16 + (r16 & 3) * 4;
            const bf16x4 v0 = __builtin_amdgcn_ds_read_tr16_b64_v4i16((__attribute__((address_space(3))) bf16x4*)(v0p));
            const bf16x4 v1 = __builtin_amdgcn_ds_read_tr16_b64_v4i16((__attribute__((address_space(3))) bf16x4*)(v0p + 16 * LDP));
            const bf16x8 vf = {v0[0], v0[1], v0[2], v0[3], v1[0], v1[1], v1[2], v1[3]};
#pragma unroll
            for (int qt = 0; qt < QT; ++qt) O[qt][dt] = __builtin_amdgcn_mfma_f32_16x16x32_bf16(vf, pf[qt], O[qt][dt], 0, 0, 0);
        }
    }
}

__device__ void attn_item(const Params& p, int kind, int idx, char* smem) {
    const int t = tid_opq(), lane = t & 63, w = t >> 6, r16 = lane & 15, quad = lane >> 4;
    bf16_t* sK = (bf16_t*)smem; bf16_t* sV = sK + 64 * LDP;
    float* kmean = (float*)(smem + 18432); float* gates = (float*)(smem + 22528); unsigned* selm = (unsigned*)(smem + 30720);
    int4* desc = (int4*)(smem + 31232); int* misc = (int*)(smem + 32320);
    const bf16_t* z = (const bf16_t*)(p.ws + WS_Z);
    int b, h, qbase, stride, qcol, kcol, vcol, cfg = 0;
    __syncthreads();
    if (kind == 0) {
        const int n = 15 - (idx >> 5); const int rem = idx & 31; b = rem >> 3; h = (rem >> 1) & 3; const int qh = rem & 1;
        qbase = b * S + n * 256 + qh * 128; stride = 1; qcol = C_AQ + h * 64; kcol = C_AK + h * 64; vcol = C_AV + h * 64;
        const float* kpart = (const float*)(p.ws + WS_KPART);
        for (int e = t; e < n * 64; e += 256) { const int j = e >> 6, d = e & 63; const float* kp = kpart + (size_t)(b * 64 + j * 4) * 256 + h * 64 + d;
            kmean[e] = ((kp[0] + kp[256]) + (kp[512] + kp[768])) * (1.f / 256.f); }
        if (t == 0) misc[1] = 0;
        __syncthreads();
        {
            const int ql = t >> 1, half = t & 1; const bf16_t* qp = z + (size_t)(qbase + ql) * ZP + qcol;
            float g[8];
#pragma unroll
            for (int jj = 0; jj < 8; ++jj) g[jj] = 0.f;
#pragma unroll 1
            for (int dc = 0; dc < 8; ++dc) {
                const u32x4 qv = *(const u32x4*)(qp + dc * 8); float qq[8];
#pragma unroll
                for (int e = 0; e < 4; ++e) { qq[2 * e] = __uint_as_float(qv[e] << 16); qq[2 * e + 1] = __uint_as_float(qv[e] & 0xffff0000u); }
#pragma unroll
                for (int jj = 0; jj < 8; ++jj) { const int j = half + 2 * jj; if (j < n) { const float* km = kmean + j * 64 + dc * 8;
#pragma unroll
                    for (int e = 0; e < 8; ++e) g[jj] += qq[e] * km[e]; } }
            }
#pragma unroll
            for (int jj = 0; jj < 8; ++jj) gates[ql * 16 + half + 2 * jj] = g[jj];
        }
        __syncthreads();
        if (t < 128) {
            unsigned msk = 0;
            for (int k = 0; k < 3 && k < n; ++k) { float best = -3.0e38f; int bi = -1;
                for (int j = 0; j < n; ++j) if (!((msk >> j) & 1u)) { const float gv = gates[t * 16 + j]; if (gv > best) { best = gv; bi = j; } }
                if (bi >= 0) msk |= 1u << bi; }
            selm[t] = msk; atomicOr((unsigned*)&misc[1], msk);
        }
        __syncthreads();
        if (t == 0) {
            int nd = 0; const unsigned bm = (unsigned)misc[1];
            for (int kt = 0; kt <= qh * 2 + 1; ++kt) desc[nd++] = make_int4(b * S + n * 256 + kt * 64, kt * 64 - qh * 128, BIG, -1);
            for (int j = 0; j < n; ++j) if ((bm >> j) & 1u) for (int kt = 0; kt < 4; ++kt) desc[nd++] = make_int4(b * S + j * 256 + kt * 64, -BIG, BIG, j);
            misc[0] = nd;
        }
    } else {
        cfg = idx >> 9; const int rem = idx & 511; b = rem >> 7; h = (rem >> 5) & 3; const int rb = rem & 31;
        const int dil = 1 << (2 * cfg); const int res = rb & (dil - 1), blk = rb >> (2 * cfg);
        qbase = b * S + blk * 128 * dil + res; stride = dil; qcol = C_CQ + h * 64; kcol = C_CK + h * 64; vcol = C_CV + h * 64;
        if (t < 128) selm[t] = 0xffffffffu;
        if (t == 0) { int nd = 0; for (int kt = (blk == 0 ? 2 : 0); kt < 4; ++kt) desc[nd++] = make_int4(b * S + (blk * 128 - 128 + kt * 64) * dil + res, kt * 64 - 128, kt * 64, -1); misc[0] = nd; }
    }
    __syncthreads();
    const int nd = misc[0];
    bf16x8 qf[2][2];
#pragma unroll
    for (int qt = 0; qt < 2; ++qt)
#pragma unroll
        for (int ks = 0; ks < 2; ++ks) qf[qt][ks] = *(const bf16x8*)(z + (size_t)(qbase + (w * 32 + qt * 16 + r16) * stride) * ZP + qcol + ks * 32 + quad * 8);
    const unsigned sel0 = selm[w * 32 + r16], sel1 = selm[w * 32 + 16 + r16];
    float m[2] = {-1e30f, -1e30f}, l[2] = {0.f, 0.f}; f32x4 O[2][4];
#pragma unroll
    for (int a = 0; a < 2; ++a)
#pragma unroll
        for (int c = 0; c < 4; ++c) O[a][c] = (f32x4){0.f, 0.f, 0.f, 0.f};
    const int lrow = t >> 2, lch = (t & 3) * 2;
    u32x4 rk0, rk1, rv0, rv1;
    if (nd > 0) { const int4 d = desc[0]; const bf16_t* rp = z + (size_t)(d.x + lrow * stride) * ZP + lch * 8;
        rk0 = *(const u32x4*)(rp + kcol); rk1 = *(const u32x4*)(rp + kcol + 8); rv0 = *(const u32x4*)(rp + vcol); rv1 = *(const u32x4*)(rp + vcol + 8); }
    for (int i = 0; i < nd; ++i) {
        __syncthreads();
        *(u32x4*)(sK + lrow * LDP + lch * 8) = rk0; *(u32x4*)(sK + lrow * LDP + lch * 8 + 8) = rk1;
        *(u32x4*)(sV + lrow * LDP + lch * 8) = rv0; *(u32x4*)(sV + lrow * LDP + lch * 8 + 8) = rv1;
        __syncthreads();
        if (i + 1 < nd) { const int4 d = desc[i + 1]; const bf16_t* rp = z + (size_t)(d.x + lrow * stride) * ZP + lch * 8;
            rk0 = *(const u32x4*)(rp + kcol); rk1 = *(const u32x4*)(rp + kcol + 8); rv0 = *(const u32x4*)(rp + vcol); rv1 = *(const u32x4*)(rp + vcol + 8); }
        const int4 d = desc[i];
        bool need = (w * 32 + 31 >= d.y) && (w * 32 - 63 <= d.z);
        bool q0 = true, q1 = true;
        if (d.w >= 0) { q0 = (sel0 >> d.w) & 1u; q1 = (sel1 >> d.w) & 1u; need = need && (__ballot(q0 || q1) != 0ull); }
        const bool full = (w * 32 - 63 >= d.y) && (w * 32 + 31 <= d.z);
        if (need) attn_tile<2>(sK, sV, qf, d.y, d.z, full, d.w >= 0, q0, q1, m, l, O, w * 32);
    }
#pragma unroll
    for (int qt = 0; qt < 2; ++qt) {
        float lt = l[qt]; lt += __shfl_xor(lt, 16); lt += __shfl_xor(lt, 32);
        const float inv = 1.f / lt; const size_t tok = (size_t)(qbase + (w * 32 + qt * 16 + r16) * stride);
        if (kind == 0) {
            bf16_t* mix = (bf16_t*)(p.ws + WS_U);
#pragma unroll
            for (int dt = 0; dt < 4; ++dt) { const int d0 = dt * 16 + quad * 4; const u32x2 gv = *(const u32x2*)(z + tok * ZP + C_AG + h * 64 + d0);
                const float g0 = __uint_as_float(gv.x << 16), g1 = __uint_as_float(gv.x & 0xffff0000u), g2 = __uint_as_float(gv.y << 16), g3 = __uint_as_float(gv.y & 0xffff0000u);
                u32x2 o; o.x = pack2(O[qt][dt][0] * inv * silu_f(g0), O[qt][dt][1] * inv * silu_f(g1)); o.y = pack2(O[qt][dt][2] * inv * silu_f(g2), O[qt][dt][3] * inv * silu_f(g3));
                *(u32x2*)(mix + tok * 1024 + h * 64 + d0) = o; }
        } else {
            bf16_t* dilo = (bf16_t*)(p.ws + WS_DILO); float* dill = (float*)(p.ws + WS_DILL);
#pragma unroll
            for (int dt = 0; dt < 4; ++dt) { const int d0 = dt * 16 + quad * 4; u32x2 o; o.x = pack2(O[qt][dt][0] * inv, O[qt][dt][1] * inv); o.y = pack2(O[qt][dt][2] * inv, O[qt][dt][3] * inv);
                *(u32x2*)(dilo + ((size_t)cfg * T + tok) * 256 + h * 64 + d0) = o; }
            if (quad == 0) dill[((size_t)cfg * T + tok) * 4 + h] = m[qt] * 0.125f + __logf(lt);
        }
    }
}

__device__ void moba_item(const Params& p, int idx, char* smem, bf16_t* outp) {
    const int t = tid_opq(), lane = t & 63, w = t >> 6, r16 = lane & 15, quad = lane >> 4;
    bf16_t* sK = (bf16_t*)smem; bf16_t* sV = sK + 64 * LDP;
    float* stO = (float*)(smem + 18432);
    float* kmean = (float*)(smem + 18432); float* gates = (float*)(smem + 22528);
    float* stM = (float*)(smem + 53248); float* stL = (float*)(smem + 53760);
    unsigned* selm = (unsigned*)(smem + 54272); unsigned char* lists = (unsigned char*)(smem + 54784);
    int* cnt = (int*)(smem + 56832); int4* desc = (int4*)(smem + 56960); int* misc = (int*)(smem + 59008);
    const bf16_t* z = (const bf16_t*)(p.ws + WS_Z);
    const int n = 15 - (idx >> 5); const int rem = idx & 31; const int b = rem >> 3, h = (rem >> 1) & 3, qh = rem & 1;
    const int qbase = b * S + n * 256 + qh * 128, qcol = C_AQ + h * 64, kcol = C_AK + h * 64, vcol = C_AV + h * 64;
    __syncthreads();
    {
        const float* kpart = (const float*)(p.ws + WS_KPART);
        for (int e = t; e < n * 64; e += 256) { const int j = e >> 6, d = e & 63; const float* kp = kpart + (size_t)(b * 64 + j * 4) * 256 + h * 64 + d;
            kmean[e] = ((kp[0] + kp[256]) + (kp[512] + kp[768])) * (1.f / 256.f); }
        if (t < 16) cnt[t] = 0;
        __syncthreads();
        {
            const int ql = t >> 1, half = t & 1; const bf16_t* qp = z + (size_t)(qbase + ql) * ZP + qcol;
            float g[8];
#pragma unroll
            for (int jj = 0; jj < 8; ++jj) g[jj] = 0.f;
#pragma unroll 1
            for (int dc = 0; dc < 8; ++dc) {
                const u32x4 qv = *(const u32x4*)(qp + dc * 8); float qq[8];
#pragma unroll
                for (int e = 0; e < 4; ++e) { qq[2 * e] = __uint_as_float(qv[e] << 16); qq[2 * e + 1] = __uint_as_float(qv[e] & 0xffff0000u); }
#pragma unroll
                for (int jj = 0; jj < 8; ++jj) { const int j = half + 2 * jj; if (j < n) { const float* km = kmean + j * 64 + dc * 8;
#pragma unroll
                    for (int e = 0; e < 8; ++e) g[jj] += qq[e] * km[e]; } }
            }
#pragma unroll
            for (int jj = 0; jj < 8; ++jj) gates[ql * 16 + half + 2 * jj] = g[jj];
        }
        __syncthreads();
        if (t < 128) {
            unsigned msk = 0;
            for (int k = 0; k < 3 && k < n; ++k) { float best = -3.0e38f; int bi = -1;
                for (int j = 0; j < n; ++j) if (!((msk >> j) & 1u)) { const float gv = gates[t * 16 + j]; if (gv > best) { best = gv; bi = j; } }
                if (bi >= 0) msk |= 1u << bi; }
            selm[t] = msk;
            for (int j = 0; j < n; ++j) if ((msk >> j) & 1u) { const int pos = atomicAdd(&cnt[j], 1); lists[j * 128 + pos] = (unsigned char)t; }
        }
        __syncthreads();
        if (t < 128) { for (int j = 0; j < n; ++j) { const int cj = cnt[j]; if (t >= cj && t < ((cj + 15) & ~15)) lists[j * 128 + t] = 255; } }
        if (t == 0) {
            int nd = 0;
            for (int kt = 0; kt <= qh * 2 + 1; ++kt) desc[nd++] = make_int4(b * S + n * 256 + kt * 64, kt * 64 - qh * 128, BIG, -1);
            misc[1] = nd;
            for (int j = 0; j < n; ++j) { const int ntl = (cnt[j] + 15) >> 4;
                for (int ps = 0; ps * 4 < ntl; ++ps) for (int kt = 0; kt < 4; ++kt) desc[nd++] = make_int4(b * S + j * 256 + kt * 64, ps, kt, j); }
            misc[0] = nd;
        }
    }
    __syncthreads();
    const int nd = misc[0], nown = misc[1];
    const int lrow = t >> 2, lch = (t & 3) * 2;
    u32x4 rk0, rk1, rv0, rv1;
    { const int4 d = desc[0]; const bf16_t* rp = z + (size_t)(d.x + lrow) * ZP + lch * 8;
      rk0 = *(const u32x4*)(rp + kcol); rk1 = *(const u32x4*)(rp + kcol + 8); rv0 = *(const u32x4*)(rp + vcol); rv1 = *(const u32x4*)(rp + vcol + 8); }
    bf16x8 nqf[2]; int ngq = 0; bool ngv = false, nhas = false;
    auto prefetch_group = [&](int gi) {
        nhas = false;
        if (gi < nd) { const int4 dg = desc[gi]; const int slot = dg.y * 4 + w; nhas = slot * 16 < cnt[dg.w];
            if (nhas) { const int qi = lists[dg.w * 128 + slot * 16 + r16]; ngv = qi != 255; ngq = ngv ? qi : 0;
#pragma unroll
                for (int ks = 0; ks < 2; ++ks) nqf[ks] = *(const bf16x8*)(z + (size_t)(qbase + ngq) * ZP + qcol + ks * 32 + quad * 8); } }
    };
    prefetch_group(nown);
    {
        bf16x8 qf[2][2];
#pragma unroll
        for (int qt = 0; qt < 2; ++qt)
#pragma unroll
            for (int ks = 0; ks < 2; ++ks) qf[qt][ks] = *(const bf16x8*)(z + (size_t)(qbase + w * 32 + qt * 16 + r16) * ZP + qcol + ks * 32 + quad * 8);
        float m[2] = {-1e30f, -1e30f}, l[2] = {0.f, 0.f}; f32x4 O[2][4];
#pragma unroll
        for (int a = 0; a < 2; ++a)
#pragma unroll
            for (int c = 0; c < 4; ++c) O[a][c] = (f32x4){0.f, 0.f, 0.f, 0.f};
        for (int i = 0; i < nown; ++i) {
            __syncthreads();
            *(u32x4*)(sK + lrow * LDP + lch * 8) = rk0; *(u32x4*)(sK + lrow * LDP + lch * 8 + 8) = rk1;
            *(u32x4*)(sV + lrow * LDP + lch * 8) = rv0; *(u32x4*)(sV + lrow * LDP + lch * 8 + 8) = rv1;
            __syncthreads();
            if (i + 1 < nd) { const int4 d = desc[i + 1]; const bf16_t* rp = z + (size_t)(d.x + lrow) * ZP + lch * 8;
                rk0 = *(const u32x4*)(rp + kcol); rk1 = *(const u32x4*)(rp + kcol + 8); rv0 = *(const u32x4*)(rp + vcol); rv1 = *(const u32x4*)(rp + vcol + 8); }
            const int4 d = desc[i];
            const bool need = (w * 32 + 31 >= d.y) && (w * 32 - 63 <= d.z);
            const bool full = (w * 32 - 63 >= d.y) && (w * 32 + 31 <= d.z);
            if (need) attn_tile<2>(sK, sV, qf, d.y, d.z, full, false, true, true, m, l, O, w * 32);
        }
#pragma unroll
        for (int qt = 0; qt < 2; ++qt) {
            float lt = l[qt]; lt += __shfl_xor(lt, 16); lt += __shfl_xor(lt, 32);
            const int ql = w * 32 + qt * 16 + r16;
            if (quad == 0) { stM[ql] = m[qt]; stL[ql] = lt; }
#pragma unroll
            for (int dt = 0; dt < 4; ++dt) *(f32x4*)(stO + ql * 68 + dt * 16 + quad * 4) = O[qt][dt];
        }
    }
    {
        bf16x8 qf[1][2]; float m[1] = {-1e30f}, l[1] = {0.f}; f32x4 O[1][4];
        int gq = 0; bool gv = false, has = false;
        for (int i = nown; i < nd; ++i) {
            __syncthreads();
            *(u32x4*)(sK + lrow * LDP + lch * 8) = rk0; *(u32x4*)(sK + lrow * LDP + lch * 8 + 8) = rk1;
            *(u32x4*)(sV + lrow * LDP + lch * 8) = rv0; *(u32x4*)(sV + lrow * LDP + lch * 8 + 8) = rv1;
            __syncthreads();
            if (i + 1 < nd) { const int4 d = desc[i + 1]; const bf16_t* rp = z + (size_t)(d.x + lrow) * ZP + lch * 8;
                rk0 = *(const u32x4*)(rp + kcol); rk1 = *(const u32x4*)(rp + kcol + 8); rv0 = *(const u32x4*)(rp + vcol); rv1 = *(const u32x4*)(rp + vcol + 8); }
            const int4 d = desc[i];
            if (d.z == 0) {
                has = nhas; gv = ngv; gq = ngq; qf[0][0] = nqf[0]; qf[0][1] = nqf[1];
                m[0] = -1e30f; l[0] = 0.f;
#pragma unroll
                for (int c = 0; c < 4; ++c) O[0][c] = (f32x4){0.f, 0.f, 0.f, 0.f};
                prefetch_group(i + 4);
            }
            if (has) {
                attn_tile<1>(sK, sV, qf, -BIG, BIG, true, false, true, true, m, l, O, 0);
                if (d.z == 3) {
                    float lt = l[0]; lt += __shfl_xor(lt, 16); lt += __shfl_xor(lt, 32);
                    if (gv) {
                        const float mo = stM[gq], lo_ = stL[gq]; const float mn = fmaxf(mo, m[0]);
                        const float fa = __builtin_amdgcn_exp2f((mo - mn) * ATT_SC), fb = __builtin_amdgcn_exp2f((m[0] - mn) * ATT_SC);
#pragma unroll
                        for (int dt = 0; dt < 4; ++dt) { float* sp = stO + gq * 68 + dt * 16 + quad * 4; const f32x4 so = *(const f32x4*)sp; *(f32x4*)sp = so * fa + O[0][dt] * fb; }
                        if (quad == 0) { stM[gq] = mn; stL[gq] = lo_ * fa + lt * fb; }
                    }
                }
            }
        }
    }
    __syncthreads();
#pragma unroll
    for (int qt = 0; qt < 2; ++qt) {
        const int ql = w * 32 + qt * 16 + r16; const float inv = 1.f / stL[ql]; const size_t tok = (size_t)(qbase + ql);
#pragma unroll
        for (int dt = 0; dt < 4; ++dt) { const int d0 = dt * 16 + quad * 4; const f32x4 ov = *(const f32x4*)(stO + ql * 68 + d0);
            const u32x2 gvv = *(const u32x2*)(z + tok * ZP + C_AG + h * 64 + d0);
            const float g0 = __uint_as_float(gvv.x << 16), g1 = __uint_as_float(gvv.x & 0xffff0000u), g2 = __uint_as_float(gvv.y << 16), g3 = __uint_as_float(gvv.y & 0xffff0000u);
            u32x2 o; o.x = pack2(ov[0] * inv * silu_f(g0), ov[1] * inv * silu_f(g1)); o.y = pack2(ov[2] * inv * silu_f(g2), ov[3] * inv * silu_f(g3));
            *(u32x2*)(outp + tok * 1024 + h * 64 + d0) = o; }
    }
}

__device__ __forceinline__ void gla_bcum(const Params& p, int l, const bf16_t* z, int tok0, float* bc, float* drs) {
    const int t = tid_opq();
    const int hd = t & 127, ih = t >> 7;
    float wr[16];
#pragma unroll
    for (int r = 0; r < 16; ++r) wr[r] = p.gla_wr[l * 2048 + r * 128 + hd];
    const float br = p.gla_br[l * 128 + hd];
    { const int e0 = t, e1 = t + 256; const bf16_t d0 = z[(size_t)(tok0 + (e0 >> 4)) * ZP + C_DR + (e0 & 15)], d1 = z[(size_t)(tok0 + (e1 >> 4)) * ZP + C_DR + (e1 & 15)];
      drs[e0] = bf2f(d0); drs[e1] = bf2f(d1); }
    __syncthreads();
#pragma unroll
    for (int ii = 0; ii < 16; ++ii) { const int i = ih * 16 + ii; float x = br;
#pragma unroll
        for (int r4 = 0; r4 < 4; ++r4) { const f32x4 dv = *(const f32x4*)(drs + i * 16 + r4 * 4); x += (dv[0] * wr[r4 * 4] + dv[1] * wr[r4 * 4 + 1]) + (dv[2] * wr[r4 * 4 + 2] + dv[3] * wr[r4 * 4 + 3]); }
        bc[i * 128 + hd] = (fminf(x, 0.f) - __logf(1.f + __expf(-fabsf(x)))) * (1.f / 16.f); }
    __syncthreads();
    if (t < 128) { float sacc = 0.f;
#pragma unroll
        for (int i = 0; i < 32; ++i) { sacc += bc[i * 128 + t]; bc[i * 128 + t] = sacc; } }
    __syncthreads();
}

__device__ void gla1_item(const Params& p, int l, int idx, char* smem) {
    const int t = tid_opq(), lane = t & 63, w = t >> 6, r16 = lane & 15, quad = lane >> 4;
    const int b = idx >> 7, c = idx & 127; const int tok0 = b * S + c * 32;
    const bf16_t* z = (const bf16_t*)(p.ws + WS_Z);
    float* bc = (float*)smem; float* drs = (float*)(smem + 16384);
    bf16_t* kdT = (bf16_t*)(smem + 18432) + w * 1024;
    bf16_t* vL = (bf16_t*)(smem + 26624) + w * (32 * LDP);
    float* gkv = (float*)(p.ws + WS_GKV); float* gdec = (float*)(p.ws + WS_GDEC);
    bf16_t kraw[16]; u32x4 vr[4];
#pragma unroll
    for (int i = 0; i < 16; ++i) { const int e = lane + 64 * i; kraw[i] = z[(size_t)(tok0 + (e >> 5)) * ZP + C_DK + w * 32 + (e & 31)]; }
#pragma unroll
    for (int i = 0; i < 4; ++i) { const int cc = lane + 64 * i; vr[i] = *(const u32x4*)(z + (size_t)(tok0 + (cc >> 3)) * ZP + C_DV + w * 64 + (cc & 7) * 8); }
    __syncthreads();
#pragma unroll
    for (int i = 0; i < 4; ++i) { const int cc = lane + 64 * i; *(u32x4*)(vL + (cc >> 3) * LDP + (cc & 7) * 8) = vr[i]; }
    gla_bcum(p, l, z, tok0, bc, drs);
    { float* bcg = (float*)(p.ws + WS_BC) + (size_t)idx * 4096;
#pragma unroll
      for (int i = 0; i < 4; ++i) *(f32x4*)(bcg + (t + 256 * i) * 4) = *(const f32x4*)(bc + (t + 256 * i) * 4); }
#pragma unroll
    for (int i = 0; i < 16; ++i) { const int e = lane + 64 * i; const int j = e >> 5, d = e & 31;
        kdT[d * 32 + j] = f2bf(bf2f(kraw[i]) * __expf(bc[31 * 128 + w * 32 + d] - bc[j * 128 + w * 32 + d])); }
    const int bh = b * 4 + w;
    if (lane < 32) gdec[(bh * 128 + c) * 32 + lane] = __expf(bc[31 * 128 + w * 32 + lane]);
    __syncthreads();
    bf16x8 kf[2];
#pragma unroll
    for (int x = 0; x < 2; ++x) kf[x] = *(const bf16x8*)(kdT + (x * 16 + r16) * 32 + quad * 8);
    float* dst = gkv + (size_t)(bh * 128 + c) * 2048;
#pragma unroll
    for (int dt = 0; dt < 4; ++dt) {
        const bf16_t* v0p = vL + (quad * 8 + (r16 >> 2)) * LDP + dt * 16 + (r16 & 3) * 4;
        const bf16x4 v0 = __builtin_amdgcn_ds_read_tr16_b64_v4i16((__attribute__((address_space(3))) bf16x4*)(v0p));
        const bf16x4 v1 = __builtin_amdgcn_ds_read_tr16_b64_v4i16((__attribute__((address_space(3))) bf16x4*)(v0p + 4 * LDP));
        const bf16x8 vf = {v0[0], v0[1], v0[2], v0[3], v1[0], v1[1], v1[2], v1[3]};
#pragma unroll
        for (int x = 0; x < 2; ++x) {
            const f32x4 r = __builtin_amdgcn_mfma_f32_16x16x32_bf16(vf, kf[x], (f32x4){0.f, 0.f, 0.f, 0.f}, 0, 0, 0);
            *(f32x4*)(dst + (x * 16 + r16) * 64 + dt * 16 + quad * 4) = r;
        }
    }
}

#define OPQ(ptr) asm volatile("" : "+v"(ptr))
__device__ void gla3_item(const Params& p, int l, int idx, char* smem) {
    const int t = tid_opq(), lane = t & 63, w = t >> 6, r16 = lane & 15, quad = lane >> 4;
    const int b = idx >> 7, c = idx & 127; const int tok0 = b * S + c * 32;
    const bf16_t* z = (const bf16_t*)(p.ws + WS_Z); bf16_t* mix = (bf16_t*)(p.ws + WS_U);
    float* bc = (float*)smem; float* drs = (float*)(smem + 16384);
    bf16_t* SL = (bf16_t*)smem + w * (32 * LDP);
    bf16_t* qe = (bf16_t*)(smem + 18432) + w * 1024;
    bf16_t* ke = (bf16_t*)(smem + 26624) + w * 1024;
    bf16_t* vL = (bf16_t*)(smem + 34816) + w * (32 * LDP);
    const float* gkv = (const float*)(p.ws + WS_GKV);
    const int bh = b * 4 + w;
    bf16_t qraw[16], kraw[16];
    { const bf16_t* qp = z + (size_t)(tok0 + (lane >> 5)) * ZP + w * 32 + (lane & 31);
#pragma unroll
      for (int i = 0; i < 16; ++i) { qraw[i] = qp[C_DQ]; kraw[i] = qp[C_DK]; qp += 2 * ZP; OPQ(qp); } }
    u32x4 vr[4]; f32x4 sr[8];
#pragma unroll
    for (int i = 0; i < 4; ++i) { const int cc = lane + 64 * i; vr[i] = *(const u32x4*)(z + (size_t)(tok0 + (cc >> 3)) * ZP + C_DV + w * 64 + (cc & 7) * 8); }
    { const float* Sp = gkv + (size_t)(bh * 128 + c) * 2048;
#pragma unroll
      for (int i = 0; i < 8; ++i) sr[i] = *(const f32x4*)(Sp + (lane + 64 * i) * 4); }
    f32x4 bcr[4];
    { const float* bcg = (const float*)(p.ws + WS_BC) + (size_t)idx * 4096;
#pragma unroll
      for (int i = 0; i < 4; ++i) bcr[i] = *(const f32x4*)(bcg + (t + 256 * i) * 4); }
    __syncthreads();
#pragma unroll
    for (int i = 0; i < 4; ++i) { const int cc = lane + 64 * i; *(u32x4*)(vL + (cc >> 3) * LDP + (cc & 7) * 8) = vr[i]; }
#pragma unroll
    for (int i = 0; i < 4; ++i) *(f32x4*)(bc + (t + 256 * i) * 4) = bcr[i];
    __syncthreads();
#pragma unroll
    for (int i2 = 0; i2 < 16; ++i2) { const int e = lane + 64 * i2; const int i = e >> 5, d = e & 31; const float bcv = bc[i * 128 + w * 32 + d];
        qe[i * 32 + d] = f2bf(bf2f(qraw[i2]) * __expf(bcv) * 0.17677669529663687f); ke[i * 32 + d] = f2bf(bf2f(kraw[i2]) * __expf(-bcv)); }
    __syncthreads();
#pragma unroll
    for (int i = 0; i < 8; ++i) { const int cc = lane + 64 * i; const int d = cc >> 4, v4 = cc & 15; u32x2 pk; pk.x = pack2(sr[i][0], sr[i][1]); pk.y = pack2(sr[i][2], sr[i][3]);
        *(u32x2*)(SL + d * LDP + v4 * 4) = pk; }
    __syncthreads();
    bf16x8 qf[2], kf[2];
#pragma unroll
    for (int x = 0; x < 2; ++x) { qf[x] = *(const bf16x8*)(qe + (x * 16 + r16) * 32 + quad * 8); kf[x] = *(const bf16x8*)(ke + (x * 16 + r16) * 32 + quad * 8); }
    bf16x8 pf[2];
#pragma unroll
    for (int it = 0; it < 2; ++it) {
        f32x4 at[2];
#pragma unroll
        for (int jt = 0; jt < 2; ++jt) { at[jt] = __builtin_amdgcn_mfma_f32_16x16x32_bf16(kf[jt], qf[it], (f32x4){0.f, 0.f, 0.f, 0.f}, 0, 0, 0);
#pragma unroll
            for (int jj = 0; jj < 4; ++jj) at[jt][jj] = (jt * 16 + quad * 4 + jj <= it * 16 + r16) ? at[jt][jj] : 0.f; }
        u32x4 pk = {pack2(at[0][0], at[0][1]), pack2(at[0][2], at[0][3]), pack2(at[1][0], at[1][1]), pack2(at[1][2], at[1][3])};
        pf[it] = __builtin_bit_cast(bf16x8, pk);
    }
    f32x4 O[2][4];
#pragma unroll
    for (int dt = 0; dt < 4; ++dt) {
        const bf16_t* v0p = vL + (quad * 4 + (r16 >> 2)) * LDP + dt * 16 + (r16 & 3) * 4;
        const bf16x4 v0 = __builtin_amdgcn_ds_read_tr16_b64_v4i16((__attribute__((address_space(3))) bf16x4*)(v0p));
        const bf16x4 v1 = __builtin_amdgcn_ds_read_tr16_b64_v4i16((__attribute__((address_space(3))) bf16x4*)(v0p + 16 * LDP));
        const bf16x8 vf = {v0[0], v0[1], v0[2], v0[3], v1[0], v1[1], v1[2], v1[3]};
        const bf16_t* s0p = SL + (quad * 8 + (r16 >> 2)) * LDP + dt * 16 + (r16 & 3) * 4;
        const bf16x4 s0 = __builtin_amdgcn_ds_read_tr16_b64_v4i16((__attribute__((address_space(3))) bf16x4*)(s0p));
        const bf16x4 s1 = __builtin_amdgcn_ds_read_tr16_b64_v4i16((__attribute__((address_space(3))) bf16x4*)(s0p + 4 * LDP));
        const bf16x8 sf = {s0[0], s0[1], s0[2], s0[3], s1[0], s1[1], s1[2], s1[3]};
#pragma unroll
        for (int it = 0; it < 2; ++it) {
            O[it][dt] = __builtin_amdgcn_mfma_f32_16x16x32_bf16(vf, pf[it], (f32x4){0.f, 0.f, 0.f, 0.f}, 0, 0, 0);
            O[it][dt] = __builtin_amdgcn_mfma_f32_16x16x32_bf16(sf, qf[it], O[it][dt], 0, 0, 0);
        }
    }
#pragma unroll
    for (int it = 0; it < 2; ++it) {
        float ss = 0.f;
#pragma unroll
        for (int dt = 0; dt < 4; ++dt) ss += (O[it][dt][0] * O[it][dt][0] + O[it][dt][1] * O[it][dt][1]) + (O[it][dt][2] * O[it][dt][2] + O[it][dt][3] * O[it][dt][3]);
        ss += __shfl_xor(ss, 16); ss += __shfl_xor(ss, 32);
        const float rn = rsqrtf(ss * (1.f / 64.f) + 1e-5f);
        const size_t tok = (size_t)(tok0 + it * 16 + r16);
#pragma unroll
        for (int dt = 0; dt < 4; ++dt) { const int v0i = dt * 16 + quad * 4; const f32x4 gn = *(const f32x4*)(p.gla_gn + l * 64 + v0i);
            const u32x2 gv = *(const u32x2*)(z + tok * ZP + C_DG + w * 64 + v0i);
            const float g0 = __uint_as_float(gv.x << 16), g1 = __uint_as_float(gv.x & 0xffff0000u), g2 = __uint_as_float(gv.y << 16), g3 = __uint_as_float(gv.y & 0xffff0000u);
            u32x2 o; o.x = pack2(O[it][dt][0] * rn * gn[0] * silu_f(g0), O[it][dt][1] * rn * gn[1] * silu_f(g1));
            o.y = pack2(O[it][dt][2] * rn * gn[2] * silu_f(g2), O[it][dt][3] * rn * gn[3] * silu_f(g3));
            *(u32x2*)(mix + tok * 1024 + 768 + w * 64 + v0i) = o; }
    }
}

__device__ void lru1_item(const Params& p, int l, int idx, char* smem) {
    const int t = tid_opq(), lane = t & 63, g = t >> 6, r16 = lane & 15, quad = lane >> 4; const int ch = t;
    const int b = idx >> 7, c = idx & 127; const int s0 = c * 32; const int tok0 = b * S + s0;
    const bf16_t* z = (const bf16_t*)(p.ws + WS_Z); float* xcs = (float*)smem;
    bf16_t* preA = (bf16_t*)(smem + 32768); bf16_t* preX = (bf16_t*)(smem + 49152);
    float* lh = (float*)(p.ws + WS_LH); float* lp = (float*)(p.ws + WS_LP);
    bf16_t xr[35];
#pragma unroll
    for (int i = 0; i < 35; ++i) { const int sidx = s0 + i - 3; xr[i] = (sidx >= 0) ? z[(size_t)(tok0 + i - 3) * ZP + C_BX + ch] : (bf16_t)0; }
    const float cw0 = p.conv_w[l * 1024 + ch], cw1 = p.conv_w[l * 1024 + 256 + ch], cw2 = p.conv_w[l * 1024 + 512 + ch], cw3 = p.conv_w[l * 1024 + 768 + ch];
    const float cb = p.conv_b[l * 256 + ch];
    const bf16_t* lwt = (const bf16_t*)(p.ws + WS_LWT) + (size_t)l * 32768 + g * 4096;
    bf16x8 wfa[4][2], wfx[4][2];
#pragma unroll
    for (int nt = 0; nt < 4; ++nt)
#pragma unroll
        for (int ks = 0; ks < 2; ++ks) { wfa[nt][ks] = *(const bf16x8*)(lwt + (nt * 16 + r16) * 64 + ks * 32 + quad * 8); wfx[nt][ks] = *(const bf16x8*)(lwt + 16384 + (nt * 16 + r16) * 64 + ks * 32 + quad * 8); }
    __syncthreads();
#pragma unroll
    for (int i = 0; i < 32; ++i) xcs[i * 256 + ch] = cb + (cw0 * bf2f(xr[i]) + cw1 * bf2f(xr[i + 1])) + (cw2 * bf2f(xr[i + 2]) + cw3 * bf2f(xr[i + 3]));
    __syncthreads();
#pragma unroll
    for (int tt = 0; tt < 2; ++tt) {
        bf16x8 xf[2];
#pragma unroll
        for (int ks = 0; ks < 2; ++ks) { const float* xp = xcs + (tt * 16 + r16) * 256 + g * 64 + ks * 32 + quad * 8; const f32x4 x0 = *(const f32x4*)xp, x1 = *(const f32x4*)(xp + 4);
            u32x4 pk = {pack2(x0[0], x0[1]), pack2(x0[2], x0[3]), pack2(x1[0], x1[1]), pack2(x1[2], x1[3])}; xf[ks] = __builtin_bit_cast(bf16x8, pk); }
#pragma unroll
        for (int nt = 0; nt < 4; ++nt) {
            f32x4 ra = __builtin_amdgcn_mfma_f32_16x16x32_bf16(wfa[nt][0], xf[0], (f32x4){0.f, 0.f, 0.f, 0.f}, 0, 0, 0); ra = __builtin_amdgcn_mfma_f32_16x16x32_bf16(wfa[nt][1], xf[1], ra, 0, 0, 0);
            f32x4 rx = __builtin_amdgcn_mfma_f32_16x16x32_bf16(wfx[nt][0], xf[0], (f32x4){0.f, 0.f, 0.f, 0.f}, 0, 0, 0); rx = __builtin_amdgcn_mfma_f32_16x16x32_bf16(wfx[nt][1], xf[1], rx, 0, 0, 0);
            u32x2 pa; pa.x = pack2(ra[0], ra[1]); pa.y = pack2(ra[2], ra[3]); u32x2 px; px.x = pack2(rx[0], rx[1]); px.y = pack2(rx[2], rx[3]);
            *(u32x2*)(preA + (tt * 16 + r16) * 256 + g * 64 + nt * 16 + quad * 4) = pa; *(u32x2*)(preX + (tt * 16 + r16) * 256 + g * 64 + nt * 16 + quad * 4) = px;
        }
    }
    __syncthreads();
    const float ba = p.lru_ba[l * 256 + ch], bx = p.lru_bx[l * 256 + ch], lam = p.lru_lam[l * 256 + ch];
    const float sp = fmaxf(-lam, 0.f) + log1pf(__expf(-fabsf(lam)));
    float hh = 0.f, P = 1.f;
    float* lhp = lh + (size_t)tok0 * 256 + ch; float* lpp = lp + (size_t)tok0 * 256 + ch;
#pragma unroll 4
    for (int i = 0; i < 32; ++i) { const float r = sigmoid_f(bf2f(preA[i * 256 + ch]) + ba), ig = sigmoid_f(bf2f(preX[i * 256 + ch]) + bx); const float la = -8.f * r * sp; const float a = __expf(la);
        const float w2 = 2.f * la;
        const float em_s = -w2 * (1.f + w2 * (0.5f + w2 * (0.16666667f + w2 * (0.041666668f + w2 * (0.0083333338f + w2 * 0.0013888889f)))));
        const float em = (w2 > -0.25f) ? em_s : (1.f - a * a);
        const float u = __builtin_amdgcn_sqrtf(em) * (ig * xcs[i * 256 + ch]); hh = a * hh + u; P *= a;
        lhp[(size_t)i * 256] = hh; lpp[(size_t)i * 256] = P; }
}

__device__ void lru3_item(const Params& p, int idx) {
    const int ch = tid_opq(); const int b = idx >> 7, c = idx & 127; const int tok0 = b * S + c * 32;
    const bf16_t* z = (const bf16_t*)(p.ws + WS_Z); bf16_t* mix = (bf16_t*)(p.ws + WS_U);
    const float* lh = (const float*)(p.ws + WS_LH); const float* lp = (const float*)(p.ws + WS_LP); const float* lc = (const float*)(p.ws + WS_LC);
    const float carry = lc[(size_t)(b * 128 + c) * 256 + ch];
    float hv[32], pv[32]; bf16_t gv[32];
#pragma unroll
    for (int i = 0; i < 32; ++i) { const size_t tok = (size_t)(tok0 + i); hv[i] = lh[tok * 256 + ch]; pv[i] = lp[tok * 256 + ch]; gv[i] = z[tok * ZP + C_BG + ch]; }
#pragma unroll
    for (int i = 0; i < 32; ++i) { const size_t tok = (size_t)(tok0 + i); mix[tok * 1024 + 256 + ch] = f2bf((hv[i] + pv[i] * carry) * silu_f(bf2f(gv[i]))); }
}

__device__ void dilc_item(const Params& p, int idx) {
    const int t = tid_opq(); const size_t tok = (size_t)idx * 8 + (t >> 5); const int chn = t & 31; const int h = chn >> 3;
    const bf16_t* z = (const bf16_t*)(p.ws + WS_Z); bf16_t* mix = (bf16_t*)(p.ws + WS_U);
    const bf16_t* dilo = (const bf16_t*)(p.ws + WS_DILO); const float* dill = (const float*)(p.ws + WS_DILL);
    const float l0 = dill[((size_t)0 * T + tok) * 4 + h], l1 = dill[((size_t)1 * T + tok) * 4 + h], l2 = dill[((size_t)2 * T + tok) * 4 + h];
    const float mx = fmaxf(l0, fmaxf(l1, l2)); float w0 = __expf(l0 - mx), w1 = __expf(l1 - mx), w2 = __expf(l2 - mx); const float inv = 1.f / (w0 + w1 + w2); w0 *= inv; w1 *= inv; w2 *= inv;
    const u32x4 o0 = *(const u32x4*)(dilo + ((size_t)0 * T + tok) * 256 + chn * 8), o1 = *(const u32x4*)(dilo + ((size_t)1 * T + tok) * 256 + chn * 8), o2 = *(const u32x4*)(dilo + ((size_t)2 * T + tok) * 256 + chn * 8);
    const u32x4 gv = *(const u32x4*)(z + tok * ZP + C_CG + chn * 8);
    u32x4 r;
#pragma unroll
    for (int e = 0; e < 4; ++e) {
        const float a = w0 * __uint_as_float(o0[e] << 16) + w1 * __uint_as_float(o1[e] << 16) + w2 * __uint_as_float(o2[e] << 16);
        const float bq = w0 * __uint_as_float(o0[e] & 0xffff0000u) + w1 * __uint_as_float(o1[e] & 0xffff0000u) + w2 * __uint_as_float(o2[e] & 0xffff0000u);
        r[e] = pack2(a * silu_f(__uint_as_float(gv[e] << 16)), bq * silu_f(__uint_as_float(gv[e] & 0xffff0000u)));
    }
    *(u32x4*)(mix + tok * 1024 + 512 + chn * 8) = r;
}

__device__ void m2_phase(const Params& p, char* smem) {
    float* gkv = (float*)(p.ws + WS_GKV); const float* gdec = (const float*)(p.ws + WS_GDEC);
    const float* lh = (const float*)(p.ws + WS_LH); const float* lp = (const float*)(p.ws + WS_LP); float* lc = (float*)(p.ws + WS_LC);
    float* aggP = (float*)smem; float* aggS = aggP + 256;
    const int t = tid_opq(); const int e = t & 31, seg = t >> 5;
    for (int it = blockIdx.x; it < 1024 + 32; it += gridDim.x) {
        float a[16], x[16];
        size_t ostride;
        float* outp;
        if (it < 1024) {
            const int gid = it * 32 + e; const int bh = gid >> 11, dv = gid & 2047, d = dv >> 6;
            float* base = gkv + (size_t)bh * 128 * 2048 + dv + (size_t)(seg * 16) * 2048; const float* dc = gdec + (size_t)bh * 128 * 32 + d + (seg * 16) * 32;
#pragma unroll
            for (int k = 0; k < 16; ++k) { x[k] = base[(size_t)k * 2048]; a[k] = dc[k * 32]; }
            outp = base; ostride = 2048;
        } else {
            const int i2 = it - 1024; const int b = i2 >> 3, ch = (i2 & 7) * 32 + e;
#pragma unroll
            for (int k = 0; k < 16; ++k) { const size_t ix = (size_t)(b * S + (seg * 16 + k) * 32 + 31) * 256 + ch; a[k] = lp[ix]; x[k] = lh[ix]; }
            outp = lc + (size_t)(b * 128 + seg * 16) * 256 + ch; ostride = 256;
        }
        float st = 0.f, pr = 1.f;
#pragma unroll
        for (int k = 0; k < 16; ++k) { const float ak = a[k], xk = x[k]; a[k] = pr; x[k] = st; st = ak * st + xk; pr *= ak; }
        __syncthreads();
        aggP[seg * 32 + e] = pr; aggS[seg * 32 + e] = st;
        __syncthreads();
        float carry = 0.f;
        for (int s2 = 0; s2 < seg; ++s2) carry = aggP[s2 * 32 + e] * carry + aggS[s2 * 32 + e];
#pragma unroll
        for (int k = 0; k < 16; ++k) outp[(size_t)k * ostride] = x[k] + a[k] * carry;
    }
}

__global__ void __launch_bounds__(256, 2) fwd_megakernel(Params p) {
    __shared__ __attribute__((aligned(16))) char smem[SMEM_BYTES];
    __shared__ uint4 xb_words;
    __shared__ int s_slot;
    cg::grid_group grid = cg::this_grid();
    if (p.out == nullptr) grid.sync();
    if (threadIdx.x == 0) xb_words = make_uint4(0u, 0u, 0u, 0u);
    __syncthreads();
    const XcdBarrier xb = xcd_barrier_post((unsigned*)(p.ws + WS_CTL), (volatile LAS unsigned*)&xb_words);
    unsigned* cnt = (unsigned*)(p.ws + WS_CNT);
    prologue_phase(p, smem);
    xcd_barrier(xb);
#pragma unroll 1
    for (int l = 0; l < DEPTH; ++l) {
        ln_phase(p, l);
        xcd_barrier(xb);
        g1_phase(p, l, smem);
        xcd_barrier(xb);
        for (;;) { const int it = next_item(cnt + (4 + l) * 64, &s_slot); if (it >= 512) break; lru1_item(p, l, it, smem); }
        for (;;) { const int it = next_item(cnt + (0 + l) * 64, &s_slot); if (it >= 512) break; moba_item(p, it, smem, (bf16_t*)(p.ws + WS_U)); }
        for (;;) { const int it = next_item(cnt + (6 + l) * 64, &s_slot); if (it >= 1536) break; attn_item(p, 1, it, smem); }
        for (;;) { const int it = next_item(cnt + (2 + l) * 64, &s_slot); if (it >= 512) break; gla1_item(p, l, it, smem); }
        xcd_barrier(xb);
        m2_phase(p, smem);
        xcd_barrier(xb);
        for (int it = blockIdx.x; it < 512; it += gridDim.x) gla3_item(p, l, it, smem);
        for (int it = blockIdx.x; it < 512; it += gridDim.x) lru3_item(p, it);
        for (int it = blockIdx.x; it < 2048; it += gridDim.x) dilc_item(p, it);
        xcd_barrier(xb);
        g2_phase(p, l, smem);
        xcd_barrier(xb);
    }
    ln_phase(p, DEPTH);
}

extern "C" void kernel_launch(void* const* d_in, const int* in_sizes, int n_in, void* d_out, int out_size, void* d_ws, size_t ws_size, hipStream_t stream) {
    static int grid_blocks = 0;
    if (!grid_blocks) {
        int dev = 0, cus = 0, per_cu = 0;
        hipGetDevice(&dev);
        hipDeviceGetAttribute(&cus, hipDeviceAttributeMultiprocessorCount, dev);
        hipOccupancyMaxActiveBlocksPerMultiprocessor(&per_cu, (const void*)fwd_megakernel, 256, 0);
        if (per_cu < 1) per_cu = 1;
        if (per_cu > 2) per_cu = 2;
        grid_blocks = cus * per_cu;
        if (ws_size < WS_END) fprintf(stderr, "kernel_launch: workspace too small: %zu < %zu\n", ws_size, (size_t)WS_END);
    }
    Params p{};
    p.x = (const float*)d_in[0]; p.c = (const float*)d_in[1]; p.pos = (const int*)d_in[2];
    p.w_mod = (const float*)d_in[3]; p.b_mod = (const float*)d_in[4]; p.w_in = (const float*)d_in[5];
    p.conv_w = (const float*)d_in[6]; p.conv_b = (const float*)d_in[7]; p.lru_wa = (const float*)d_in[8]; p.lru_ba = (const float*)d_in[9];
    p.lru_wx = (const float*)d_in[10]; p.lru_bx = (const float*)d_in[11]; p.lru_lam = (const float*)d_in[12];
    p.gla_wr = (const float*)d_in[13]; p.gla_br = (const float*)d_in[14]; p.gla_gn = (const float*)d_in[15];
    p.w_out = (const float*)d_in[16]; p.ln_g = (const float*)d_in[17]; p.ln_b = (const float*)d_in[18];
    p.out = (float*)d_out; p.ws = (unsigned char*)d_ws;
    (void)hipMemsetAsync(d_ws, 0, 32768, stream);
    void* args[] = {&p};
    hipError_t e = hipLaunchCooperativeKernel((const void*)fwd_megakernel, dim3(grid_blocks), dim3(256), args, 0, stream);
    if (e != hipSuccess) fprintf(stderr, "cooperative launch failed: %s (grid %d)\n", hipGetErrorString(e), grid_blocks);
}
```

```cpp
#include <hip/hip_runtime.h>
#include <hip/hip_cooperative_groups.h>
#include <cstdio>
#include <cstdint>
#include <type_traits>
namespace cg = cooperative_groups;

typedef unsigned short bf16_t;
typedef short bf16x8 __attribute__((ext_vector_type(8)));
typedef short bf16x4 __attribute__((ext_vector_type(4)));
typedef float f32x4 __attribute__((ext_vector_type(4)));
typedef unsigned u32x4 __attribute__((ext_vector_type(4)));
typedef unsigned u32x2 __attribute__((ext_vector_type(2)));

constexpr int D = 1024, NB = 4, S = 4096, T = NB * S, DEPTH = 2;
constexpr int DIN = 3344, ZP = 3344, NPAD = 3456;
constexpr int C_AQ = 0, C_AK = 256, C_AV = 512, C_AG = 768, C_BX = 1024, C_BG = 1280, C_CQ = 1536, C_CK = 1792,
              C_CV = 2048, C_CG = 2304, C_DQ = 2560, C_DK = 2688, C_DV = 2816, C_DG = 3072, C_DR = 3328;
constexpr float DN_ALPHA = 1.4142135623730951f;
constexpr int LDP = 72;
constexpr int SMEM_BYTES = 65536;
constexpr int BIG = 1000000;

constexpr size_t WS_CTL = 0;
constexpr size_t WS_CNT = 16384;
constexpr size_t WS_WINT = 32768;
constexpr size_t WS_WOUTT = WS_WINT + (size_t)DEPTH * NPAD * 1024 * 2;
constexpr size_t WS_MOD = WS_WOUTT + (size_t)DEPTH * 1024 * 1024 * 2;
constexpr size_t WS_COS = WS_MOD + (size_t)DEPTH * NB * 3072 * 4;
constexpr size_t WS_SIN = WS_COS + (size_t)T * 32 * 4;
constexpr size_t WS_U = WS_SIN + (size_t)T * 32 * 4;
constexpr size_t WS_Z = WS_U + (size_t)T * 1024 * 2;
constexpr size_t WS_KPART = WS_Z + (size_t)T * ZP * 2;
constexpr size_t WS_DILO = WS_KPART + (size_t)256 * 256 * 4;
constexpr size_t WS_DILL = WS_DILO + (size_t)3 * T * 256 * 2;
constexpr size_t WS_GKV = WS_DILL + (size_t)3 * T * 4 * 4;
constexpr size_t WS_GDEC = WS_GKV + (size_t)2048 * 2048 * 4;
constexpr size_t WS_LH = WS_GDEC + (size_t)2048 * 32 * 4;
constexpr size_t WS_LP = WS_LH + (size_t)T * 256 * 4;
constexpr size_t WS_LC = WS_LP + (size_t)T * 256 * 4;
constexpr size_t WS_LWT = WS_LC + (size_t)NB * 128 * 256 * 4;
constexpr size_t WS_BC = WS_LWT + (size_t)DEPTH * 2 * 4 * 64 * 64 * 2;
constexpr size_t WS_END = WS_BC + (size_t)512 * 32 * 128 * 4;

struct Params {
    const float *x, *c; const int* pos;
    const float *w_mod, *b_mod, *w_in, *conv_w, *conv_b, *lru_wa, *lru_ba, *lru_wx, *lru_bx, *lru_lam, *gla_wr, *gla_br, *gla_gn, *w_out, *ln_g, *ln_b;
    float* out; unsigned char* ws;
};

__device__ __forceinline__ float bf2f(bf16_t h) { return __uint_as_float(((unsigned)h) << 16); }
typedef __bf16 hbf16x2 __attribute__((ext_vector_type(2)));
typedef float f32x2 __attribute__((ext_vector_type(2)));
__device__ __forceinline__ unsigned pack2(float a, float b) { f32x2 v = {a, b}; hbf16x2 r = __builtin_convertvector(v, hbf16x2); return __builtin_bit_cast(unsigned, r); }
__device__ __forceinline__ bf16_t f2bf(float f) { return (bf16_t)(pack2(f, 0.f) & 0xffffu); }
__device__ __forceinline__ float silu_f(float x) { return x / (1.f + __expf(-x)); }
__device__ __forceinline__ float sigmoid_f(float x) { return 1.f / (1.f + __expf(-x)); }
__device__ __forceinline__ int tid_opq() { int t = threadIdx.x; asm volatile("" : "+v"(t)); return t; }
__device__ __forceinline__ float wsum(float v) {
#pragma unroll
    for (int o = 32; o; o >>= 1) v += __shfl_xor(v, o);
    return v;
}

#define XB_TMO      128
#define XB_XCNT(j)  (256  + 64 * (j))
#define XB_XSUB(j)  (1280 + 64 * (j))
#define XB_XGEN(j)  (2304 + 64 * (j))
#define XB_TOP      3328
#define XB_TOPGEN   3392
#define XCD_BAR_WORDS 3456
#define XB_SPIN_CAP (1u << 18)
#define LAS __attribute__((address_space(3)))
__device__ __forceinline__ unsigned xb_ld(unsigned* p)              { return __hip_atomic_load(p, __ATOMIC_RELAXED, __HIP_MEMORY_SCOPE_AGENT); }
__device__ __forceinline__ unsigned xb_add(unsigned* p, unsigned v) { return __hip_atomic_fetch_add(p, v, __ATOMIC_RELAXED, __HIP_MEMORY_SCOPE_AGENT); }
__device__ __forceinline__ unsigned xb_xcc_id() { return (unsigned)__builtin_amdgcn_s_getreg((3 << 11) | 20) & 0xFu; }
#define XB_SPIN(cond, bar) do { unsigned _sp = 0; while (cond) { __builtin_amdgcn_s_sleep(1); \
    if ((++_sp & 255u) == 0u) { if (xb_ld(&(bar)[XB_TMO])) break; if (_sp > XB_SPIN_CAP) { atomicAdd(&(bar)[XB_TMO], 1u); break; } } } } while (0)
struct XcdBarrier { unsigned* bar; unsigned x; volatile LAS unsigned* st; };
__device__ __forceinline__ XcdBarrier xcd_barrier_post(unsigned* bar, volatile LAS unsigned* st) {
    XcdBarrier b; b.bar = bar; b.x = xb_xcc_id(); b.st = st;
    if (threadIdx.x == 0) (void)xb_add(&bar[XB_XCNT(b.x)], 1u);
    return b;
}
__device__ __forceinline__ void xcd_barrier_complete(unsigned* bar, unsigned x, unsigned& nloc, unsigned& nx) {
    const unsigned G = gridDim.x * gridDim.y * gridDim.z;
    unsigned sum, cnt, mine, sp = 0u;
    for (;;) {
        sum = 0u; cnt = 0u; mine = 0u;
#pragma unroll
        for (unsigned j = 0; j < 16; ++j) { const unsigned c = xb_ld(&bar[XB_XCNT(j)]); sum += c; cnt += (c > 0u) ? 1u : 0u; mine = (j == x) ? c : mine; }
        if (sum == G) break;
        __builtin_amdgcn_s_sleep(1);
        if ((++sp & 255u) == 0u) { if (xb_ld(&bar[XB_TMO])) break; if (sp > XB_SPIN_CAP) { atomicAdd(&bar[XB_TMO], 1u); break; } }
    }
    nloc = mine > 0u ? mine : 1u; nx = cnt > 0u ? cnt : 1u;
}
__device__ __forceinline__ void xcd_barrier(const XcdBarrier& b) {
    asm volatile("s_waitcnt vmcnt(0)" ::: "memory");
    __syncthreads();
    if (threadIdx.x == 0) {
        unsigned* bar = b.bar;
        __builtin_amdgcn_s_waitcnt(0);
        unsigned nloc = b.st[0], nx = b.st[1];
        if (nloc == 0u) { xcd_barrier_complete(bar, b.x, nloc, nx); b.st[0] = nloc; b.st[1] = nx; }
        const unsigned old = xb_add(&bar[XB_XSUB(b.x)], 1u);
        const unsigned gen = old / nloc;
        if (old + 1u == (gen + 1u) * nloc) {
            __builtin_amdgcn_fence(__ATOMIC_RELEASE, "agent");
            asm volatile("s_waitcnt vmcnt(0)" ::: "memory");
            const unsigned og = xb_add(&bar[XB_TOP], 1u);
            const unsigned tg = og / nx;
            if (og + 1u == (tg + 1u) * nx) xb_add(&bar[XB_TOPGEN], 1u);
            else XB_SPIN(xb_ld(&bar[XB_TOPGEN]) == tg, bar);
            __builtin_amdgcn_fence(__ATOMIC_ACQUIRE, "agent");
            xb_add(&bar[XB_XGEN(b.x)], 1u);
            asm volatile("s_waitcnt vmcnt(0)" ::: "memory");
        } else {
            XB_SPIN(xb_ld(&bar[XB_XGEN(b.x)]) == gen, bar);
            __builtin_amdgcn_fence(__ATOMIC_ACQUIRE, "agent");
            asm volatile("s_waitcnt vmcnt(0)" ::: "memory");
        }
    }
    __syncthreads();
}
__device__ __forceinline__ int next_item(unsigned* ctr, volatile int* slot) {
    __syncthreads();
    if (threadIdx.x == 0) *slot = (int)atomicAdd(ctr, 1u);
    __syncthreads();
    return *slot;
}

__device__ void prologue_phase(const Params& p, char* smem) {
    const int t = tid_opq();
    bf16_t* WinT = (bf16_t*)(p.ws + WS_WINT); bf16_t* WoutT = (bf16_t*)(p.ws + WS_WOUTT);
    float* mod = (float*)(p.ws + WS_MOD); float* cosT = (float*)(p.ws + WS_COS); float* sinT = (float*)(p.ws + WS_SIN);
    float* tl = (float*)smem;
    constexpr int N_TIN = DEPTH * 16 * 54, N_TOUT = DEPTH * 16 * 16, N_MOD = DEPTH * 192, N_ROPE = T * 32 / 256, N_LWT = DEPTH * 2 * 4 * 64 * 64 / 256;
    constexpr int NITEMS = N_TIN + N_TOUT + N_MOD + N_ROPE + N_LWT;
    for (int it = blockIdx.x; it < NITEMS; it += gridDim.x) {
        if (it < N_TIN + N_TOUT) {
            const float* src; bf16_t* dst; int ncols, kt, nt;
            if (it < N_TIN) { int l = it / (16 * 54), r = it % (16 * 54); kt = r / 54; nt = r % 54; src = p.w_in + (size_t)l * 1024 * DIN; dst = WinT + (size_t)l * NPAD * 1024; ncols = DIN; }
            else { int i2 = it - N_TIN; int l = i2 / 256, r = i2 % 256; kt = r / 16; nt = r % 16; src = p.w_out + (size_t)l * 1024 * 1024; dst = WoutT + (size_t)l * 1024 * 1024; ncols = 1024; }
            __syncthreads();
            { const int c4 = t & 15, r0 = t >> 4; const int n = nt * 64 + c4 * 4;
              f32x4 v[4];
#pragma unroll
              for (int i = 0; i < 4; ++i) { const int r = r0 + 16 * i; v[i] = (n < ncols) ? *(const f32x4*)(src + (size_t)(kt * 64 + r) * ncols + n) : (f32x4){0.f, 0.f, 0.f, 0.f}; }
#pragma unroll
              for (int i = 0; i < 4; ++i) { const int r = r0 + 16 * i; tl[r * 65 + c4 * 4] = v[i][0]; tl[r * 65 + c4 * 4 + 1] = v[i][1]; tl[r * 65 + c4 * 4 + 2] = v[i][2]; tl[r * 65 + c4 * 4 + 3] = v[i][3]; } }
            __syncthreads();
            {
#pragma unroll
              for (int i = 0; i < 2; ++i) { const int cc = t + 256 * i; const int n = cc >> 3, k8 = (cc & 7) * 8;
                  u32x4 pk; pk.x = pack2(tl[(k8 + 0) * 65 + n], tl[(k8 + 1) * 65 + n]); pk.y = pack2(tl[(k8 + 2) * 65 + n], tl[(k8 + 3) * 65 + n]);
                  pk.z = pack2(tl[(k8 + 4) * 65 + n], tl[(k8 + 5) * 65 + n]); pk.w = pack2(tl[(k8 + 6) * 65 + n], tl[(k8 + 7) * 65 + n]);
                  *(u32x4*)(dst + (size_t)(nt * 64 + n) * 1024 + kt * 64 + k8) = pk; } }
        } else if (it < N_TIN + N_TOUT + N_MOD) {
            const int i2 = it - N_TIN - N_TOUT; const int l = i2 / 192, jg = i2 % 192;
            const int jj = t & 15, ks = t >> 4; const int j = jg * 16 + jj;
            float a0 = 0.f, a1 = 0.f, a2 = 0.f, a3 = 0.f;
            const float* wm = p.w_mod + (size_t)l * 1024 * 3072 + j;
#pragma unroll 8
            for (int k = ks * 64; k < ks * 64 + 64; ++k) { float wv = wm[(size_t)k * 3072]; a0 += p.c[k] * wv; a1 += p.c[1024 + k] * wv; a2 += p.c[2048 + k] * wv; a3 += p.c[3072 + k] * wv; }
            __syncthreads();
            tl[(0 * 16 + ks) * 16 + jj] = a0; tl[(1 * 16 + ks) * 16 + jj] = a1; tl[(2 * 16 + ks) * 16 + jj] = a2; tl[(3 * 16 + ks) * 16 + jj] = a3;
            __syncthreads();
            if (t < 64) { const int b = t >> 4, j2 = t & 15; float s = 0.f;
#pragma unroll
              for (int k2 = 0; k2 < 16; ++k2) s += tl[(b * 16 + k2) * 16 + j2];
              mod[((size_t)l * NB + b) * 3072 + jg * 16 + j2] = s + p.b_mod[l * 3072 + jg * 16 + j2]; }
        } else if (it >= N_TIN + N_TOUT + N_MOD + N_ROPE) {
            const int e = (it - N_TIN - N_TOUT - N_MOD - N_ROPE) * 256 + t;
            const int in = e & 63, out = (e >> 6) & 63, g = (e >> 12) & 3, mat = (e >> 14) & 1, l = e >> 15;
            const float* src = mat ? p.lru_wx : p.lru_wa;
            ((bf16_t*)(p.ws + WS_LWT))[e] = f2bf(src[l * 16384 + g * 4096 + in * 64 + out]);
        } else {
            const int i2 = it - N_TIN - N_TOUT - N_MOD; const int e = i2 * 256 + t; const int tok = e >> 5, f = e & 31;
            const float inv = exp2f(-(float)f * (13.287712379549449f / 32.f));
            const float ang = (float)p.pos[tok] * inv;
            double rev = (double)ang * 0.15915494309189535; rev -= __builtin_rint(rev);
            const float rr = (float)rev; cosT[e] = __builtin_amdgcn_cosf(rr); sinT[e] = __builtin_amdgcn_sinf(rr);
        }
    }
}

__device__ void ln_phase(const Params& p, int l) {
    const int t = tid_opq(), lane = t & 63, w = t >> 6;
    bf16_t* ubuf = (bf16_t*)(p.ws + WS_U); const float* mod = (const float*)(p.ws + WS_MOD);
    for (int rg = blockIdx.x; rg < T / 16; rg += gridDim.x) {
        f32x4 v[4][4];
#pragma unroll
        for (int r = 0; r < 4; ++r) { const int row = rg * 16 + w * 4 + r; const float* src = (l <= 1) ? p.x + (size_t)row * 1024 : p.out + (size_t)row * 1024;
#pragma unroll
            for (int i = 0; i < 4; ++i) v[r][i] = *(const f32x4*)(src + i * 256 + lane * 4);
            if (l > 0) {
                const bf16_t* yr = (const bf16_t*)(p.ws + WS_Z) + (size_t)row * 1024; const float* gate = mod + ((size_t)(l - 1) * NB + row / S) * 3072 + 2048;
#pragma unroll
                for (int i = 0; i < 4; ++i) { const u32x2 yv = *(const u32x2*)(yr + i * 256 + lane * 4); const f32x4 g1 = *(const f32x4*)(gate + i * 256 + lane * 4) + 1.f;
                    const f32x4 yf = {__uint_as_float(yv.x << 16), __uint_as_float(yv.x & 0xffff0000u), __uint_as_float(yv.y << 16), __uint_as_float(yv.y & 0xffff0000u)};
                    v[r][i] = v[r][i] * DN_ALPHA + g1 * yf; }
            } }
#pragma unroll
        for (int r = 0; r < 4; ++r) {
            const int row = rg * 16 + w * 4 + r; const int b = row / S;
            if (l > 0) {
                float s = 0.f;
#pragma unroll
                for (int i = 0; i < 4; ++i) s += (v[r][i][0] + v[r][i][1]) + (v[r][i][2] + v[r][i][3]);
                const float mu = wsum(s) * (1.f / 1024.f); float q = 0.f;
#pragma unroll
                for (int i = 0; i < 4; ++i) { f32x4 d = v[r][i] - mu; q += (d[0] * d[0] + d[1] * d[1]) + (d[2] * d[2] + d[3] * d[3]); }
                const float rstd = rsqrtf(wsum(q) * (1.f / 1024.f) + 1e-5f);
#pragma unroll
                for (int i = 0; i < 4; ++i) { const f32x4 g = *(const f32x4*)(p.ln_g + (l - 1) * 1024 + i * 256 + lane * 4), bb = *(const f32x4*)(p.ln_b + (l - 1) * 1024 + i * 256 + lane * 4);
                    v[r][i] = (v[r][i] - mu) * rstd * g + bb; *(f32x4*)(p.out + (size_t)row * 1024 + i * 256 + lane * 4) = v[r][i]; }
            }
            if (l < DEPTH) {
                float s = 0.f;
#pragma unroll
                for (int i = 0; i < 4; ++i) s += (v[r][i][0] + v[r][i][1]) + (v[r][i][2] + v[r][i][3]);
                const float mu = wsum(s) * (1.f / 1024.f); float q = 0.f;
#pragma unroll
                for (int i = 0; i < 4; ++i) { f32x4 d = v[r][i] - mu; q += (d[0] * d[0] + d[1] * d[1]) + (d[2] * d[2] + d[3] * d[3]); }
                const float rstd = rsqrtf(wsum(q) * (1.f / 1024.f) + 1e-5f);
                const float* mb = mod + ((size_t)l * NB + b) * 3072;
#pragma unroll
                for (int i = 0; i < 4; ++i) { const int col = i * 256 + lane * 4; const f32x4 sh = *(const f32x4*)(mb + col), sc = *(const f32x4*)(mb + 1024 + col);
                    f32x4 u = (v[r][i] - mu) * rstd * (sc + 1.f) + sh; u32x2 pk; pk.x = pack2(u[0], u[1]); pk.y = pack2(u[2], u[3]);
                    *(u32x2*)(ubuf + (size_t)row * 1024 + col) = pk; }
            }
        }
    }
}

__device__ __forceinline__ int lds_off(int r, int c8) {
    const int st = (r >> 4) * 2 + (c8 >> 2); const int ob = (r & 15) * 64 + (c8 & 3) * 16;
    return st * 1024 + (ob ^ (((ob >> 9) & 1) << 5));
}
struct RegSet { u32x4 a[4], b[4]; };
__device__ __forceinline__ void gemm_tile(const bf16_t* __restrict__ A, const bf16_t* __restrict__ Bt, int tm, int tn, bool first, bool has_next, int ntm, int ntn,
                                          char* sm, f32x4 (&acc)[4][4], RegSet& r0, RegSet& r1) {
    const int t = tid_opq(), lane = t & 63, w = t >> 6, wm = w >> 1, wn = w & 1, r16 = lane & 15, quad = lane >> 4;
    const int lrow = t >> 3, lch = t & 7;
    constexpr int BUF = 32768;
    const unsigned loff = (unsigned)(lrow * 1024 + lch * 8);
    const bf16_t* At0 = A + (size_t)tm * (128 * 1024); const bf16_t* Bt0 = Bt + (size_t)tn * (128 * 1024);
    const bf16_t* At1 = A + (size_t)ntm * (128 * 1024); const bf16_t* Bt1 = Bt + (size_t)ntn * (128 * 1024);
#define Ag (At0 + loff)
#define Bg (Bt0 + loff)
#define nAg (At1 + loff)
#define nBg (Bt1 + loff)
    const int woff0 = lds_off(lrow, lch);
#define woff(i) (woff0 + 4096 * (i))
    const int fo = lds_off(r16, quad);
#pragma unroll
    for (int a = 0; a < 4; ++a)
#pragma unroll
        for (int b = 0; b < 4; ++b) acc[a][b] = (f32x4){0.f, 0.f, 0.f, 0.f};
    if (first) {
#pragma unroll
        for (int i = 0; i < 4; ++i) { r0.a[i] = *(const u32x4*)(Ag + (size_t)i * 32 * 1024); r0.b[i] = *(const u32x4*)(Bg + (size_t)i * 32 * 1024); }
#pragma unroll
        for (int i = 0; i < 4; ++i) { r1.a[i] = *(const u32x4*)(Ag + (size_t)i * 32 * 1024 + 64); r1.b[i] = *(const u32x4*)(Bg + (size_t)i * 32 * 1024 + 64); }
        __syncthreads();
#pragma unroll
        for (int i = 0; i < 4; ++i) { *(u32x4*)(sm + woff(i)) = r0.a[i]; *(u32x4*)(sm + 16384 + woff(i)) = r0.b[i]; }
#pragma unroll
        for (int i = 0; i < 4; ++i) { r0.a[i] = *(const u32x4*)(Ag + (size_t)i * 32 * 1024 + 128); r0.b[i] = *(const u32x4*)(Bg + (size_t)i * 32 * 1024 + 128); }
    }
    __syncthreads();
    auto step = [&](auto main_tag, int kt, RegSet& rs) {
        constexpr bool MAIN = decltype(main_tag)::value;
        const char* sA = sm + (kt & 1) * BUF; const char* sB = sA + 16384;
        char* nA = sm + ((kt + 1) & 1) * BUF; char* nB = nA + 16384;
        const bool wr = MAIN || kt + 1 < 16 || has_next;
        const bool own = MAIN || kt + 3 < 16;
        const bf16_t* la = own ? Ag + (kt + 3) * 64 : nAg + (kt - 13) * 64; const bf16_t* lb = own ? Bg + (kt + 3) * 64 : nBg + (kt - 13) * 64;
        __builtin_amdgcn_s_setprio(1);
#pragma unroll
        for (int ks = 0; ks < 2; ++ks) {
            bf16x8 af[4], bfr[4];
#pragma unroll
            for (int mt = 0; mt < 4; ++mt) af[mt] = *(const bf16x8*)(sA + ((wm * 4 + mt) * 2 + ks) * 1024 + fo);
#pragma unroll
            for (int nt = 0; nt < 4; ++nt) bfr[nt] = *(const bf16x8*)(sB + ((wn * 4 + nt) * 2 + ks) * 1024 + fo);
#pragma unroll
            for (int mt = 0; mt < 4; ++mt) {
#pragma unroll
                for (int nt = 0; nt < 4; ++nt) acc[mt][nt] = __builtin_amdgcn_mfma_f32_16x16x32_bf16(bfr[nt], af[mt], acc[mt][nt], 0, 0, 0);
                const int i = ks * 2 + (mt >> 1);
                __builtin_amdgcn_sched_barrier(0);
                if ((mt & 1) == 0) { if (wr) *(u32x4*)(nA + woff(i)) = rs.a[i]; if (own || has_next) rs.a[i] = *(const u32x4*)(la + (size_t)i * 32 * 1024); }
                else               { if (wr) *(u32x4*)(nB + woff(i)) = rs.b[i]; if (own || has_next) rs.b[i] = *(const u32x4*)(lb + (size_t)i * 32 * 1024); }
                __builtin_amdgcn_sched_barrier(0);
            }
        }
        __builtin_amdgcn_s_setprio(0);
        __syncthreads();
    };
    {
        std::true_type mt_; std::false_type tl_;
        for (int k2 = 0; k2 < 6; ++k2) { step(mt_, 2 * k2, r1); step(mt_, 2 * k2 + 1, r0); }
        step(mt_, 12, r1); step(tl_, 13, r0); step(tl_, 14, r1); step(tl_, 15, r0);
    }
#undef Ag
#undef Bg
#undef nAg
#undef nBg
#undef woff
}

__device__ void g1_phase(const Params& p, int l, char* smem) {
    const int t = tid_opq(), lane = t & 63, w = t >> 6, wm = w >> 1, wn = w & 1, r16 = lane & 15, quad = lane >> 4;
    char* sm = smem; char* sC = smem + 32768;
    const bf16_t* ubuf = (const bf16_t*)(p.ws + WS_U); const bf16_t* WinT = (const bf16_t*)(p.ws + WS_WINT) + (size_t)l * NPAD * 1024;
    bf16_t* z = (bf16_t*)(p.ws + WS_Z); float* kpart = (float*)(p.ws + WS_KPART);
    const float* cosT = (const float*)(p.ws + WS_COS); const float* sinT = (const float*)(p.ws + WS_SIN);
    const bool xo = (gridDim.x & 7) == 0; const int xcd = blockIdx.x & 7, nloc = xo ? (int)(gridDim.x >> 3) : (int)gridDim.x, j0 = xo ? (int)(blockIdx.x >> 3) : (int)blockIdx.x;
    const int lim = xo ? 16 * 27 : 128 * 27;
    RegSet r0, r1;
    for (int L = j0; L < lim; L += nloc) {
        const int tm = xo ? xcd * 16 + (L / 216) * 8 + (L & 7) : L / 27, tn = xo ? ((L % 216) >> 3) : L % 27;
        const int L2 = L + nloc; const bool has_next = L2 < lim;
        const int ntm = has_next ? (xo ? xcd * 16 + (L2 / 216) * 8 + (L2 & 7) : L2 / 27) : tm, ntn = has_next ? (xo ? ((L2 % 216) >> 3) : L2 % 27) : tn;
        f32x4 acc[4][4];
        gemm_tile(ubuf, WinT, tm, tn, L == j0, has_next, ntm, ntn, sm, acc, r0, r1);
        const bool rope = (tn < 4) || (tn >= 12 && tn < 16);
        if (rope) {
#pragma unroll
            for (int mt = 0; mt < 4; ++mt) {
                const int tok = tm * 128 + wm * 64 + mt * 16 + r16;
#pragma unroll
                for (int nt = 0; nt < 2; ++nt) {
                    const f32x4 cs = *(const f32x4*)(cosT + (size_t)tok * 32 + nt * 16 + quad * 4), sn = *(const f32x4*)(sinT + (size_t)tok * 32 + nt * 16 + quad * 4);
                    const f32x4 x1 = acc[mt][nt], x2 = acc[mt][nt + 2];
                    acc[mt][nt] = x1 * cs - x2 * sn; acc[mt][nt + 2] = x1 * sn + x2 * cs;
                }
            }
        }
        if (tn == 2 || tn == 3) {
#pragma unroll
            for (int nt = 0; nt < 4; ++nt) {
                f32x4 sv = (acc[0][nt] + acc[1][nt]) + (acc[2][nt] + acc[3][nt]);
#pragma unroll
                for (int jj = 0; jj < 4; ++jj) { float sx = sv[jj]; sx += __shfl_xor(sx, 1); sx += __shfl_xor(sx, 2); sx += __shfl_xor(sx, 4); sx += __shfl_xor(sx, 8); sv[jj] = sx; }
                if (r16 == 0) *(f32x4*)(kpart + (size_t)(tm * 2 + wm) * 256 + (tn - 2) * 128 + wn * 64 + nt * 16 + quad * 4) = sv;
            }
        }
#pragma unroll
        for (int mt = 0; mt < 4; ++mt)
#pragma unroll
            for (int nt = 0; nt < 4; ++nt) { u32x2 pk; pk.x = pack2(acc[mt][nt][0], acc[mt][nt][1]); pk.y = pack2(acc[mt][nt][2], acc[mt][nt][3]);
                const int row = wm * 64 + mt * 16 + r16; const int c16 = wn * 8 + nt * 2 + (quad >> 1);
                *(u32x2*)(sC + row * 256 + ((c16 ^ (row & 15)) << 4) + (quad & 1) * 8) = pk; }
        __syncthreads();
#pragma unroll
        for (int i = 0; i < 8; ++i) { const int c = t + 256 * i; const int row = c >> 4, ch = c & 15; const int col = tn * 128 + ch * 8;
            if (col < DIN) *(u32x4*)(z + (size_t)(tm * 128 + row) * ZP + col) = *(const u32x4*)(sC + row * 256 + ((ch ^ (row & 15)) << 4)); }
    }
}

__device__ void g2_phase(const Params& p, int l, char* smem) {
    const int t = tid_opq(), lane = t & 63, w = t >> 6, wm = w >> 1, wn = w & 1, r16 = lane & 15, quad = lane >> 4;
    char* sm = smem; char* sC = smem + 32768;
    const bf16_t* mix = (const bf16_t*)(p.ws + WS_U); const bf16_t* WoutT = (const bf16_t*)(p.ws + WS_WOUTT) + (size_t)l * 1024 * 1024;
    bf16_t* ybuf = (bf16_t*)(p.ws + WS_Z);
    const bool xo = (gridDim.x & 7) == 0; const int xcd = blockIdx.x & 7, nloc = xo ? (int)(gridDim.x >> 3) : (int)gridDim.x, j0 = xo ? (int)(blockIdx.x >> 3) : (int)blockIdx.x;
    const int lim = xo ? 16 * 8 : 128 * 8;
    RegSet r0, r1;
    for (int L = j0; L < lim; L += nloc) {
        const int tm = xo ? xcd * 16 + (L & 15) : (L >> 3), tn = xo ? (L >> 4) : (L & 7);
        const int L2 = L + nloc; const bool has_next = L2 < lim;
        const int ntm = has_next ? (xo ? xcd * 16 + (L2 & 15) : (L2 >> 3)) : tm, ntn = has_next ? (xo ? (L2 >> 4) : (L2 & 7)) : tn;
        f32x4 acc[4][4];
        gemm_tile(mix, WoutT, tm, tn, L == j0, has_next, ntm, ntn, sm, acc, r0, r1);
#pragma unroll
        for (int mt = 0; mt < 4; ++mt)
#pragma unroll
            for (int nt = 0; nt < 4; ++nt) { u32x2 pk; pk.x = pack2(acc[mt][nt][0], acc[mt][nt][1]); pk.y = pack2(acc[mt][nt][2], acc[mt][nt][3]);
                const int row = wm * 64 + mt * 16 + r16; const int c16 = wn * 8 + nt * 2 + (quad >> 1);
                *(u32x2*)(sC + row * 256 + ((c16 ^ (row & 15)) << 4) + (quad & 1) * 8) = pk; }
        __syncthreads();
#pragma unroll
        for (int i = 0; i < 8; ++i) { const int c = t + 256 * i; const int row = c >> 4, ch = c & 15;
            *(u32x4*)(ybuf + (size_t)(tm * 128 + row) * 1024 + tn * 128 + ch * 8) = *(const u32x4*)(sC + row * 256 + ((ch ^ (row & 15)) << 4)); }
    }
}

constexpr float ATT_SC = 0.18033688011112042f;
template <int QT>
__device__ __forceinline__ void attn_tile(const bf16_t* sK, const bf16_t* sV, const bf16x8 (&qf)[QT][2], int lo, int hi, bool full, bool hasq, bool qfl0, bool qfl1,
                                          float (&m)[QT], float (&l)[QT], f32x4 (&O)[QT][4], int wq0) {
    const int lane = tid_opq() & 63, r16 = lane & 15, quad = lane >> 4;
    f32x4 s[QT][4];
#pragma unroll
    for (int a = 0; a < QT; ++a)
#pragma unroll
        for (int b = 0; b < 4; ++b) s[a][b] = (f32x4){0.f, 0.f, 0.f, 0.f};
#pragma unroll
    for (int ks = 0; ks < 2; ++ks)
#pragma unroll
        for (int k16 = 0; k16 < 4; ++k16) {
            const bf16x8 kf = *(const bf16x8*)(sK + (k16 * 16 + r16) * LDP + ks * 32 + quad * 8);
#pragma unroll
            for (int qt = 0; qt < QT; ++qt) s[qt][k16] = __builtin_amdgcn_mfma_f32_16x16x32_bf16(kf, qf[qt][ks], s[qt][k16], 0, 0, 0);
        }
#pragma unroll
    for (int qt = 0; qt < QT; ++qt) {
        const int ql = wq0 + qt * 16 + r16; const bool qfl = qt ? qfl1 : qfl0;
        if (!full) {
#pragma unroll
            for (int k16 = 0; k16 < 4; ++k16)
#pragma unroll
                for (int j = 0; j < 4; ++j) { const int dd = ql - (k16 * 16 + quad * 4 + j); const bool valid = dd >= lo && dd <= hi; s[qt][k16][j] = valid ? s[qt][k16][j] : -1e30f; }
        }
        if (hasq) {
#pragma unroll
            for (int k16 = 0; k16 < 4; ++k16)
#pragma unroll
                for (int j = 0; j < 4; ++j) s[qt][k16][j] = qfl ? s[qt][k16][j] : -1e30f;
        }
        float mx = -1e30f;
#pragma unroll
        for (int k16 = 0; k16 < 4; ++k16) mx = fmaxf(mx, fmaxf(fmaxf(s[qt][k16][0], s[qt][k16][1]), fmaxf(s[qt][k16][2], s[qt][k16][3])));
        mx = fmaxf(mx, __shfl_xor(mx, 16)); mx = fmaxf(mx, __shfl_xor(mx, 32));
        const float mn = fmaxf(m[qt], mx); const float alpha = __builtin_amdgcn_exp2f((m[qt] - mn) * ATT_SC); m[qt] = mn;
        const float mb = (mn < -1e29f) ? 0.f : mn * ATT_SC;
        float ps = 0.f;
#pragma unroll
        for (int k16 = 0; k16 < 4; ++k16)
#pragma unroll
            for (int j = 0; j < 4; ++j) { const float pv = __builtin_amdgcn_exp2f(s[qt][k16][j] * ATT_SC - mb); ps += pv; s[qt][k16][j] = pv; }
        l[qt] = l[qt] * alpha + ps;
#pragma unroll
        for (int dt = 0; dt < 4; ++dt) O[qt][dt] = O[qt][dt] * alpha;
    }
#pragma unroll
    for (int G = 0; G < 2; ++G) {
        bf16x8 pf[QT];
#pragma unroll
        for (int qt = 0; qt < QT; ++qt) {
            const unsigned a0 = pack2(s[qt][G * 2][0], s[qt][G * 2][1]), a1 = pack2(s[qt][G * 2][2], s[qt][G * 2][3]);
            const unsigned a2 = pack2(s[qt][G * 2 + 1][0], s[qt][G * 2 + 1][1]), a3 = pack2(s[qt][G * 2 + 1][2], s[qt][G * 2 + 1][3]);
            u32x4 pk = {a0, a1, a2, a3}; pf[qt] = __builtin_bit_cast(bf16x8, pk);
        }
#pragma unroll
        for (int dt = 0; dt < 4; ++dt) {
            const bf16_t* v0p = sV + (G * 32 + quad * 4 + (r16 >> 2)) * LDP + dt * 16 + (r16 & 3) * 4;
            const bf16x4 v0 = __builtin_amdgcn_ds_read_tr16_b64_v4i16((__attribute__((address_space(3))) bf16x4*)(v0p));
            const bf16x4 v1 = __builtin_amdgcn_ds_read_tr16_b64_v4i16((__attribute__((address_space(3))) bf16x4*)(v0p + 16 * LDP));
            const bf16x8 vf = {v0[0], v0[1], v0[2], v0[3], v1[0], v1[1], v1[2], v1[3]};
#pragma unroll
            for (int qt = 0; qt < QT; ++qt) O[qt][dt] = __builtin_amdgcn_mfma_f32_16x16x32_bf16(vf, pf[qt], O[qt][dt], 0, 0, 0);
        }
    }
}

__device__ void attn_item(const Params& p, int kind, int idx, char* smem) {
    const int t = tid_opq(), lane = t & 63, w = t >> 6, r16 = lane & 15, quad = lane >> 4;
    bf16_t* sK = (bf16_t*)smem; bf16_t* sV = sK + 64 * LDP;
    float* kmean = (float*)(smem + 18432); float* gates = (float*)(smem + 22528); unsigned* selm = (unsigned*)(smem + 30720);
    int4* desc = (int4*)(smem + 31232); int* misc = (int*)(smem + 32320);
    const bf16_t* z = (const bf16_t*)(p.ws + WS_Z);
    int b, h, qbase, stride, qcol, kcol, vcol, cfg = 0;
    __syncthreads();
    if (kind == 0) {
        const int n = 15 - (idx >> 5); const int rem = idx & 31; b = rem >> 3; h = (rem >> 1) & 3; const int qh = rem & 1;
        qbase = b * S + n * 256 + qh * 128; stride = 1; qcol = C_AQ + h * 64; kcol = C_AK + h * 64; vcol = C_AV + h * 64;
        const float* kpart = (const float*)(p.ws + WS_KPART);
        for (int e = t; e < n * 64; e += 256) { const int j = e >> 6, d = e & 63; const float* kp = kpart + (size_t)(b * 64 + j * 4) * 256 + h * 64 + d;
            kmean[e] = ((kp[0] + kp[256]) + (kp[512] + kp[768])) * (1.f / 256.f); }
        if (t == 0) misc[1] = 0;
        __syncthreads();
        {
            const int ql = t >> 1, half = t & 1; const bf16_t* qp = z + (size_t)(qbase + ql) * ZP + qcol;
            float g[8];
#pragma unroll
            for (int jj = 0; jj < 8; ++jj) g[jj] = 0.f;
#pragma unroll 1
            for (int dc = 0; dc < 8; ++dc) {
                const u32x4 qv = *(const u32x4*)(qp + dc * 8); float qq[8];
#pragma unroll
                for (int e = 0; e < 4; ++e) { qq[2 * e] = __uint_as_float(qv[e] << 16); qq[2 * e + 1] = __uint_as_float(qv[e] & 0xffff0000u); }
#pragma unroll
                for (int jj = 0; jj < 8; ++jj) { const int j = half + 2 * jj; if (j < n) { const float* km = kmean + j * 64 + dc * 8;
#pragma unroll
                    for (int e = 0; e < 8; ++e) g[jj] += qq[e] * km[e]; } }
            }
#pragma unroll
            for (int jj = 0; jj < 8; ++jj) gates[ql * 16 + half + 2 * jj] = g[jj];
        }
        __syncthreads();
        if (t < 128) {
            unsigned msk = 0;
            for (int k = 0; k < 3 && k < n; ++k) { float best = -3.0e38f; int bi = -1;
                for (int j = 0; j < n; ++j) if (!((msk >> j) & 1u)) { const float gv = gates[t * 16 + j]; if (gv > best) { best = gv; bi = j; } }
                if (bi >= 0) msk |= 1u << bi; }
            selm[t] = msk; atomicOr((unsigned*)&misc[1], msk);
        }
        __syncthreads();
        if (t == 0) {
            int nd = 0; const unsigned bm = (unsigned)misc[1];
            for (int kt = 0; kt <= qh * 2 + 1; ++kt) desc[nd++] = make_int4(b * S + n * 256 + kt * 64, kt * 64 - qh * 128, BIG, -1);
            for (int j = 0; j < n; ++j) if ((bm >> j) & 1u) for (int kt = 0; kt < 4; ++kt) desc[nd++] = make_int4(b * S + j * 256 + kt * 64, -BIG, BIG, j);
            misc[0] = nd;
        }
    } else {
        cfg = idx >> 9; const int rem = idx & 511; b = rem >> 7; h = (rem >> 5) & 3; const int rb = rem & 31;
        const int dil = 1 << (2 * cfg); const int res = rb & (dil - 1), blk = rb >> (2 * cfg);
        qbase = b * S + blk * 128 * dil + res; stride = dil; qcol = C_CQ + h * 64; kcol = C_CK + h * 64; vcol = C_CV + h * 64;
        if (t < 128) selm[t] = 0xffffffffu;
        if (t == 0) { int nd = 0; for (int kt = (blk == 0 ? 2 : 0); kt < 4; ++kt) desc[nd++] = make_int4(b * S + (blk * 128 - 128 + kt * 64) * dil + res, kt * 64 - 128, kt * 64, -1); misc[0] = nd; }
    }
    __syncthreads();
    const int nd = misc[0];
    bf16x8 qf[2][2];
#pragma unroll
    for (int qt = 0; qt < 2; ++qt)
#pragma unroll
        for (int ks = 0; ks < 2; ++ks) qf[qt][ks] = *(const bf16x8*)(z + (size_t)(qbase + (w * 32 + qt * 16 + r16) * stride) * ZP + qcol + ks * 32 + quad * 8);
    const unsigned sel0 = selm[w * 32 + r16], sel1 = selm[w * 32 + 16 + r16];
    float m[2] = {-1e30f, -1e30f}, l[2] = {0.f, 0.f}; f32x4 O[2][4];
#pragma unroll
    for (int a = 0; a < 2; ++a)
#pragma unroll
        for (int c = 0; c < 4; ++c) O[a][c] = (f32x4){0.f, 0.f, 0.f, 0.f};
    const int lrow = t >> 2, lch = (t & 3) * 2;
    u32x4 rk0, rk1, rv0, rv1;
    if (nd > 0) { const int4 d = desc[0]; const bf16_t* rp = z + (size_t)(d.x + lrow * stride) * ZP + lch * 8;
        rk0 = *(const u32x4*)(rp + kcol); rk1 = *(const u32x4*)(rp + kcol + 8); rv0 = *(const u32x4*)(rp + vcol); rv1 = *(const u32x4*)(rp + vcol + 8); }
    for (int i = 0; i < nd; ++i) {
        __syncthreads();
        *(u32x4*)(sK + lrow * LDP + lch * 8) = rk0; *(u32x4*)(sK + lrow * LDP + lch * 8 + 8) = rk1;
        *(u32x4*)(sV + lrow * LDP + lch * 8) = rv0; *(u32x4*)(sV + lrow * LDP + lch * 8 + 8) = rv1;
        __syncthreads();
        if (i + 1 < nd) { const int4 d = desc[i + 1]; const bf16_t* rp = z + (size_t)(d.x + lrow * stride) * ZP + lch * 8;
            rk0 = *(const u32x4*)(rp + kcol); rk1 = *(const u32x4*)(rp + kcol + 8); rv0 = *(const u32x4*)(rp + vcol); rv1 = *(const u32x4*)(rp + vcol + 8); }
        const int4 d = desc[i];
        bool need = (w * 32 + 31 >= d.y) && (w * 32 - 63 <= d.z);
        bool q0 = true, q1 = true;
        if (d.w >= 0) { q0 = (sel0 >> d.w) & 1u; q1 = (sel1 >> d.w) & 1u; need = need && (__ballot(q0 || q1) != 0ull); }
        const bool full = (w * 32 - 63 >= d.y) && (w * 32 + 31 <= d.z);
        if (need) attn_tile<2>(sK, sV, qf, d.y, d.z, full, d.w >= 0, q0, q1, m, l, O, w * 32);
    }
#pragma unroll
    for (int qt = 0; qt < 2; ++qt) {
        float lt = l[qt]; lt += __shfl_xor(lt, 16); lt += __shfl_xor(lt, 32);
        const float inv = 1.f / lt; const size_t tok = (size_t)(qbase + (w * 32 + qt * 16 + r16) * stride);
        if (kind == 0) {
            bf16_t* mix = (bf16_t*)(p.ws + WS_U);
#pragma unroll
            for (int dt = 0; dt < 4; ++dt) { const int d0 = dt * 16 + quad * 4; const u32x2 gv = *(const u32x2*)(z + tok * ZP + C_AG + h * 64 + d0);
                const float g0 = __uint_as_float(gv.x << 16), g1 = __uint_as_float(gv.x & 0xffff0000u), g2 = __uint_as_float(gv.y << 16), g3 = __uint_as_float(gv.y & 0xffff0000u);
                u32x2 o; o.x = pack2(O[qt][dt][0] * inv * silu_f(g0), O[qt][dt][1] * inv * silu_f(g1)); o.y = pack2(O[qt][dt][2] * inv * silu_f(g2), O[qt][dt][3] * inv * silu_f(g3));
                *(u32x2*)(mix + tok * 1024 + h * 64 + d0) = o; }
        } else {
            bf16_t* dilo = (bf16_t*)(p.ws + WS_DILO); float* dill = (float*)(p.ws + WS_DILL);
#pragma unroll
            for (int dt = 0; dt < 4; ++dt) { const int d0 = dt * 16 + quad * 4; u32x2 o; o.x = pack2(O[qt][dt][0] * inv, O[qt][dt][1] * inv); o.y = pack2(O[qt][dt][2] * inv, O[qt][dt][3] * inv);
                *(u32x2*)(dilo + ((size_t)cfg * T + tok) * 256 + h * 64 + d0) = o; }
            if (quad == 0) dill[((size_t)cfg * T + tok) * 4 + h] = m[qt] * 0.125f + __logf(lt);
        }
    }
}

__device__ void moba_item(const Params& p, int idx, char* smem, bf16_t* outp) {
    const int t = tid_opq(), lane = t & 63, w = t >> 6, r16 = lane & 15, quad = lane >> 4;
    bf16_t* sK = (bf16_t*)smem; bf16_t* sV = sK + 64 * LDP;
    float* stO = (float*)(smem + 18432);
    float* kmean = (float*)(smem + 18432); float* gates = (float*)(smem + 22528);
    float* stM = (float*)(smem + 53248); float* stL = (float*)(smem + 53760);
    unsigned* selm = (unsigned*)(smem + 54272); unsigned char* lists = (unsigned char*)(smem + 54784);
    int* cnt = (int*)(smem + 56832); int4* desc = (int4*)(smem + 56960); int* misc = (int*)(smem + 59008);
    const bf16_t* z = (const bf16_t*)(p.ws + WS_Z);
    const int n = 15 - (idx >> 5); const int rem = idx & 31; const int b = rem >> 3, h = (rem >> 1) & 3, qh = rem & 1;
    const int qbase = b * S + n * 256 + qh * 128, qcol = C_AQ + h * 64, kcol = C_AK + h * 64, vcol = C_AV + h * 64;
    __syncthreads();
    {
        const float* kpart = (const float*)(p.ws + WS_KPART);
        for (int e = t; e < n * 64; e += 256) { const int j = e >> 6, d = e & 63; const float* kp = kpart + (size_t)(b * 64 + j * 4) * 256 + h * 64 + d;
            kmean[e] = ((kp[0] + kp[256]) + (kp[512] + kp[768])) * (1.f / 256.f); }
        if (t < 16) cnt[t] = 0;
        __syncthreads();
        {
            const int ql = t >> 1, half = t & 1; const bf16_t* qp = z + (size_t)(qbase + ql) * ZP + qcol;
            float g[8];
#pragma unroll
            for (int jj = 0; jj < 8; ++jj) g[jj] = 0.f;
#pragma unroll 1
            for (int dc = 0; dc < 8; ++dc) {
                const u32x4 qv = *(const u32x4*)(qp + dc * 8); float qq[8];
#pragma unroll
                for (int e = 0; e < 4; ++e) { qq[2 * e] = __uint_as_float(qv[e] << 16); qq[2 * e + 1] = __uint_as_float(qv[e] & 0xffff0000u); }
#pragma unroll
                for (int jj = 0; jj < 8; ++jj) { const int j = half + 2 * jj; if (j < n) { const float* km = kmean + j * 64 + dc * 8;
#pragma unroll
                    for (int e = 0; e < 8; ++e) g[jj] += qq[e] * km[e]; } }
            }
#pragma unroll
            for (int jj = 0; jj < 8; ++jj) gates[ql * 16 + half + 2 * jj] = g[jj];
        }
        __syncthreads();
        if (t < 128) {
            unsigned msk = 0;
            for (int k = 0; k < 3 && k < n; ++k) { float best = -3.0e38f; int bi = -1;
                for (int j = 0; j < n; ++j) if (!((msk >> j) & 1u)) { const float gv = gates[t * 16 + j]; if (gv > best) { best = gv; bi = j; } }
                if (bi >= 0) msk |= 1u << bi; }
            selm[t] = msk;
            for (int j = 0; j < n; ++j) if ((msk >> j) & 1u) { const int pos = atomicAdd(&cnt[j], 1); lists[j * 128 + pos] = (unsigned char)t; }
        }
        __syncthreads();
        if (t < 128) { for (int j = 0; j < n; ++j) { const int cj = cnt[j]; if (t >= cj && t < ((cj + 15) & ~15)) lists[j * 128 + t] = 255; } }
        if (t == 0) {
            int nd = 0;
            for (int kt = 0; kt <= qh * 2 + 1; ++kt) desc[nd++] = make_int4(b * S + n * 256 + kt * 64, kt * 64 - qh * 128, BIG, -1);
            misc[1] = nd;
            for (int j = 0; j < n; ++j) { const int ntl = (cnt[j] + 15) >> 4;
                for (int ps = 0; ps * 4 < ntl; ++ps) for (int kt = 0; kt < 4; ++kt) desc[nd++] = make_int4(b * S + j * 256 + kt * 64, ps, kt, j); }
            misc[0] = nd;
        }
    }
    __syncthreads();
    const int nd = misc[0], nown = misc[1];
    const int lrow = t >> 2, lch = (t & 3) * 2;
    u32x4 rk0, rk1, rv0, rv1;
    { const int4 d = desc[0]; const bf16_t* rp = z + (size_t)(d.x + lrow) * ZP + lch * 8;
      rk0 = *(const u32x4*)(rp + kcol); rk1 = *(const u32x4*)(rp + kcol + 8); rv0 = *(const u32x4*)(rp + vcol); rv1 = *(const u32x4*)(rp + vcol + 8); }
    bf16x8 nqf[2]; int ngq = 0; bool ngv = false, nhas = false;
    auto prefetch_group = [&](int gi) {
        nhas = false;
        if (gi < nd) { const int4 dg = desc[gi]; const int slot = dg.y * 4 + w; nhas = slot * 16 < cnt[dg.w];
            if (nhas) { const int qi = lists[dg.w * 128 + slot * 16 + r16]; ngv = qi != 255; ngq = ngv ? qi : 0;
#pragma unroll
                for (int ks = 0; ks < 2; ++ks) nqf[ks] = *(const bf16x8*)(z + (size_t)(qbase + ngq) * ZP + qcol + ks * 32 + quad * 8); } }
    };
    prefetch_group(nown);
    {
        bf16x8 qf[2][2];
#pragma unroll
        for (int qt = 0; qt < 2; ++qt)
#pragma unroll
            for (int ks = 0; ks < 2; ++ks) qf[qt][ks] = *(const bf16x8*)(z + (size_t)(qbase + w * 32 + qt * 16 + r16) * ZP + qcol + ks * 32 + quad * 8);
        float m[2] = {-1e30f, -1e30f}, l[2] = {0.f, 0.f}; f32x4 O[2][4];
#pragma unroll
        for (int a = 0; a < 2; ++a)
#pragma unroll
            for (int c = 0; c < 4; ++c) O[a][c] = (f32x4){0.f, 0.f, 0.f, 0.f};
        for (int i = 0; i < nown; ++i) {
            __syncthreads();
            *(u32x4*)(sK + lrow * LDP + lch * 8) = rk0; *(u32x4*)(sK + lrow * LDP + lch * 8 + 8) = rk1;
            *(u32x4*)(sV + lrow * LDP + lch * 8) = rv0; *(u32x4*)(sV + lrow * LDP + lch * 8 + 8) = rv1;
            __syncthreads();
            if (i + 1 < nd) { const int4 d = desc[i + 1]; const bf16_t* rp = z + (size_t)(d.x + lrow) * ZP + lch * 8;
                rk0 = *(const u32x4*)(rp + kcol); rk1 = *(const u32x4*)(rp + kcol + 8); rv0 = *(const u32x4*)(rp + vcol); rv1 = *(const u32x4*)(rp + vcol + 8); }
            const int4 d = desc[i];
            const bool need = (w * 32 + 31 >= d.y) && (w * 32 - 63 <= d.z);
            const bool full = (w * 32 - 63 >= d.y) && (w * 32 + 31 <= d.z);
            if (need) attn_tile<2>(sK, sV, qf, d.y, d.z, full, false, true, true, m, l, O, w * 32);
        }
#pragma unroll
        for (int qt = 0; qt < 2; ++qt) {
            float lt = l[qt]; lt += __shfl_xor(lt, 16); lt += __shfl_xor(lt, 32);
            const int ql = w * 32 + qt * 16 + r16;
            if (quad == 0) { stM[ql] = m[qt]; stL[ql] = lt; }
#pragma unroll
            for (int dt = 0; dt < 4; ++dt) *(f32x4*)(stO + ql * 68 + dt * 16 + quad * 4) = O[qt][dt];
        }
    }
    {
        bf16x8 qf[1][2]; float m[1] = {-1e30f}, l[1] = {0.f}; f32x4 O[1][4];
        int gq = 0; bool gv = false, has = false;
        for (int i = nown; i < nd; ++i) {
            __syncthreads();
            *(u32x4*)(sK + lrow * LDP + lch * 8) = rk0; *(u32x4*)(sK + lrow * LDP + lch * 8 + 8) = rk1;
            *(u32x4*)(sV + lrow * LDP + lch * 8) = rv0; *(u32x4*)(sV + lrow * LDP + lch * 8 + 8) = rv1;
            __syncthreads();
            if (i + 1 < nd) { const int4 d = desc[i + 1]; const bf16_t* rp = z + (size_t)(d.x + lrow) * ZP + lch * 8;
                rk0 = *(const u32x4*)(rp + kcol); rk1 = *(const u32x4*)(rp + kcol + 8); rv0 = *(const u32x4*)(rp + vcol); rv1 = *(const u32x4*)(rp + vcol + 8); }
            const int4 d = desc[i];
            if (d.z == 0) {
                has = nhas; gv = ngv; gq = ngq; qf[0][0] = nqf[0]; qf[0][1] = nqf[1];
                m[0] = -1e30f; l[0] = 0.f;
#pragma unroll
                for (int c = 0; c < 4; ++c) O[0][c] = (f32x4){0.f, 0.f, 0.f, 0.f};
                prefetch_group(i + 4);
            }
            if (has) {
                attn_tile<1>(sK, sV, qf, -BIG, BIG, true, false, true, true, m, l, O, 0);
                if (d.z == 3) {
                    float lt = l[0]; lt += __shfl_xor(lt, 16); lt += __shfl_xor(lt, 32);
                    if (gv) {
                        const float mo = stM[gq], lo_ = stL[gq]; const float mn = fmaxf(mo, m[0]);
                        const float fa = __builtin_amdgcn_exp2f((mo - mn) * ATT_SC), fb = __builtin_amdgcn_exp2f((m[0] - mn) * ATT_SC);
#pragma unroll
                        for (int dt = 0; dt < 4; ++dt) { float* sp = stO + gq * 68 + dt * 16 + quad * 4; const f32x4 so = *(const f32x4*)sp; *(f32x4*)sp = so * fa + O[0][dt] * fb; }
                        if (quad == 0) { stM[gq] = mn; stL[gq] = lo_ * fa + lt * fb; }
                    }
                }
            }
        }
    }
    __syncthreads();
#pragma unroll
    for (int qt = 0; qt < 2; ++qt) {
        const int ql = w * 32 + qt * 16 + r16; const float inv = 1.f / stL[ql]; const size_t tok = (size_t)(qbase + ql);
#pragma unroll
        for (int dt = 0; dt < 4; ++dt) { const int d0 = dt * 16 + quad * 4; const f32x4 ov = *(const f32x4*)(stO + ql * 68 + d0);
            const u32x2 gvv = *(const u32x2*)(z + tok * ZP + C_AG + h * 64 + d0);
            const float g0 = __uint_as_float(gvv.x << 16), g1 = __uint_as_float(gvv.x & 0xffff0000u), g2 = __uint_as_float(gvv.y << 16), g3 = __uint_as_float(gvv.y & 0xffff0000u);
            u32x2 o; o.x = pack2(ov[0] * inv * silu_f(g0), ov[1] * inv * silu_f(g1)); o.y = pack2(ov[2] * inv * silu_f(g2), ov[3] * inv * silu_f(g3));
            *(u32x2*)(outp + tok * 1024 + h * 64 + d0) = o; }
    }
}

__device__ __forceinline__ void gla_bcum(const Params& p, int l, const bf16_t* z, int tok0, float* bc, float* drs) {
    const int t = tid_opq();
    const int hd = t & 127, ih = t >> 7;
    float wr[16];
#pragma unroll
    for (int r = 0; r < 16; ++r) wr[r] = p.gla_wr[l * 2048 + r * 128 + hd];
    const float br = p.gla_br[l * 128 + hd];
    { const int e0 = t, e1 = t + 256; const bf16_t d0 = z[(size_t)(tok0 + (e0 >> 4)) * ZP + C_DR + (e0 & 15)], d1 = z[(size_t)(tok0 + (e1 >> 4)) * ZP + C_DR + (e1 & 15)];
      drs[e0] = bf2f(d0); drs[e1] = bf2f(d1); }
    __syncthreads();
#pragma unroll
    for (int ii = 0; ii < 16; ++ii) { const int i = ih * 16 + ii; float x = br;
#pragma unroll
        for (int r4 = 0; r4 < 4; ++r4) { const f32x4 dv = *(const f32x4*)(drs + i * 16 + r4 * 4); x += (dv[0] * wr[r4 * 4] + dv[1] * wr[r4 * 4 + 1]) + (dv[2] * wr[r4 * 4 + 2] + dv[3] * wr[r4 * 4 + 3]); }
        bc[i * 128 + hd] = (fminf(x, 0.f) - __logf(1.f + __expf(-fabsf(x)))) * (1.f / 16.f); }
    __syncthreads();
    if (t < 128) { float sacc = 0.f;
#pragma unroll
        for (int i = 0; i < 32; ++i) { sacc += bc[i * 128 + t]; bc[i * 128 + t] = sacc; } }
    __syncthreads();
}

__device__ void gla1_item(const Params& p, int l, int idx, char* smem) {
    const int t = tid_opq(), lane = t & 63, w = t >> 6, r16 = lane & 15, quad = lane >> 4;
    const int b = idx >> 7, c = idx & 127; const int tok0 = b * S + c * 32;
    const bf16_t* z = (const bf16_t*)(p.ws + WS_Z);
    float* bc = (float*)smem; float* drs = (float*)(smem + 16384);
    bf16_t* kdT = (bf16_t*)(smem + 18432) + w * 1024;
    bf16_t* vL = (bf16_t*)(smem + 26624) + w * (32 * LDP);
    float* gkv = (float*)(p.ws + WS_GKV); float* gdec = (float*)(p.ws + WS_GDEC);
    bf16_t kraw[16]; u32x4 vr[4];
#pragma unroll
    for (int i = 0; i < 16; ++i) { const int e = lane + 64 * i; kraw[i] = z[(size_t)(tok0 + (e >> 5)) * ZP + C_DK + w * 32 + (e & 31)]; }
#pragma unroll
    for (int i = 0; i < 4; ++i) { const int cc = lane + 64 * i; vr[i] = *(const u32x4*)(z + (size_t)(tok0 + (cc >> 3)) * ZP + C_DV + w * 64 + (cc & 7) * 8); }
    __syncthreads();
#pragma unroll
    for (int i = 0; i < 4; ++i) { const int cc = lane + 64 * i; *(u32x4*)(vL + (cc >> 3) * LDP + (cc & 7) * 8) = vr[i]; }
    gla_bcum(p, l, z, tok0, bc, drs);
    { float* bcg = (float*)(p.ws + WS_BC) + (size_t)idx * 4096;
#pragma unroll
      for (int i = 0; i < 4; ++i) *(f32x4*)(bcg + (t + 256 * i) * 4) = *(const f32x4*)(bc + (t + 256 * i) * 4); }
#pragma unroll
    for (int i = 0; i < 16; ++i) { const int e = lane + 64 * i; const int j = e >> 5, d = e & 31;
        kdT[d * 32 + j] = f2bf(bf2f(kraw[i]) * __expf(bc[31 * 128 + w * 32 + d] - bc[j * 128 + w * 32 + d])); }
    const int bh = b * 4 + w;
    if (lane < 32) gdec[(bh * 128 + c) * 32 + lane] = __expf(bc[31 * 128 + w * 32 + lane]);
    __syncthreads();
    bf16x8 kf[2];
#pragma unroll
    for (int x = 0; x < 2; ++x) kf[x] = *(const bf16x8*)(kdT + (x * 16 + r16) * 32 + quad * 8);
    float* dst = gkv + (size_t)(bh * 128 + c) * 2048;
#pragma unroll
    for (int dt = 0; dt < 4; ++dt) {
        const bf16_t* v0p = vL + (quad * 8 + (r16 >> 2)) * LDP + dt * 16 + (r16 & 3) * 4;
        const bf16x4 v0 = __builtin_amdgcn_ds_read_tr16_b64_v4i16((__attribute__((address_space(3))) bf16x4*)(v0p));
        const bf16x4 v1 = __builtin_amdgcn_ds_read_tr16_b64_v4i16((__attribute__((address_space(3))) bf16x4*)(v0p + 4 * LDP));
        const bf16x8 vf = {v0[0], v0[1], v0[2], v0[3], v1[0], v1[1], v1[2], v1[3]};
#pragma unroll
        for (int x = 0; x < 2; ++x) {
            const f32x4 r = __builtin_amdgcn_mfma_f32_16x16x32_bf16(vf, kf[x], (f32x4){0.f, 0.f, 0.f, 0.f}, 0, 0, 0);
            *(f32x4*)(dst + (x * 16 + r16) * 64 + dt * 16 + quad * 4) = r;
        }
    }
}

#define OPQ(ptr) asm volatile("" : "+v"(ptr))
__device__ void gla3_item(const Params& p, int l, int idx, char* smem) {
    const int t = tid_opq(), lane = t & 63, w = t >> 6, r16 = lane & 15, quad = lane >> 4;
    const int b = idx >> 7, c = idx & 127; const int tok0 = b * S + c * 32;
    const bf16_t* z = (const bf16_t*)(p.ws + WS_Z); bf16_t* mix = (bf16_t*)(p.ws + WS_U);
    float* bc = (float*)smem; float* drs = (float*)(smem + 16384);
    bf16_t* SL = (bf16_t*)smem + w * (32 * LDP);
    bf16_t* qe = (bf16_t*)(smem + 18432) + w * 1024;
    bf16_t* ke = (bf16_t*)(smem + 26624) + w * 1024;
    bf16_t* vL = (bf16_t*)(smem + 34816) + w * (32 * LDP);
    const float* gkv = (const float*)(p.ws + WS_GKV);
    const int bh = b * 4 + w;
    bf16_t qraw[16], kraw[16];
    { const bf16_t* qp = z + (size_t)(tok0 + (lane >> 5)) * ZP + w * 32 + (lane & 31);
#pragma unroll
      for (int i = 0; i < 16; ++i) { qraw[i] = qp[C_DQ]; kraw[i] = qp[C_DK]; qp += 2 * ZP; OPQ(qp); } }
    u32x4 vr[4]; f32x4 sr[8];
#pragma unroll
    for (int i = 0; i < 4; ++i) { const int cc = lane + 64 * i; vr[i] = *(const u32x4*)(z + (size_t)(tok0 + (cc >> 3)) * ZP + C_DV + w * 64 + (cc & 7) * 8); }
    { const float* Sp = gkv + (size_t)(bh * 128 + c) * 2048;
#pragma unroll
      for (int i = 0; i < 8; ++i) sr[i] = *(const f32x4*)(Sp + (lane + 64 * i) * 4); }
    f32x4 bcr[4];
    { const float* bcg = (const float*)(p.ws + WS_BC) + (size_t)idx * 4096;
#pragma unroll
      for (int i = 0; i < 4; ++i) bcr[i] = *(const f32x4*)(bcg + (t + 256 * i) * 4); }
    __syncthreads();
#pragma unroll
    for (int i = 0; i < 4; ++i) { const int cc = lane + 64 * i; *(u32x4*)(vL + (cc >> 3) * LDP + (cc & 7) * 8) = vr[i]; }
#pragma unroll
    for (int i = 0; i < 4; ++i) *(f32x4*)(bc + (t + 256 * i) * 4) = bcr[i];
    __syncthreads();
#pragma unroll
    for (int i2 = 0; i2 < 16; ++i2) { const int e = lane + 64 * i2; const int i = e >> 5, d = e & 31; const float bcv = bc[i * 128 + w * 32 + d];
        qe[i * 32 + d] = f2bf(bf2f(qraw[i2]) * __expf(bcv) * 0.17677669529663687f); ke[i * 32 + d] = f2bf(bf2f(kraw[i2]) * __expf(-bcv)); }
    __syncthreads();
#pragma unroll
    for (int i = 0; i < 8; ++i) { const int cc = lane + 64 * i; const int d = cc >> 4, v4 = cc & 15; u32x2 pk; pk.x = pack2(sr[i][0], sr[i][1]); pk.y = pack2(sr[i][2], sr[i][3]);
        *(u32x2*)(SL + d * LDP + v4 * 4) = pk; }
    __syncthreads();
    bf16x8 qf[2], kf[2];
#pragma unroll
    for (int x = 0; x < 2; ++x) { qf[x] = *(const bf16x8*)(qe + (x * 16 + r16) * 32 + quad * 8); kf[x] = *(const bf16x8*)(ke + (x * 16 + r16) * 32 + quad * 8); }
    bf16x8 pf[2];
#pragma unroll
    for (int it = 0; it < 2; ++it) {
        f32x4 at[2];
#pragma unroll
        for (int jt = 0; jt < 2; ++jt) { at[jt] = __builtin_amdgcn_mfma_f32_16x16x32_bf16(kf[jt], qf[it], (f32x4){0.f, 0.f, 0.f, 0.f}, 0, 0, 0);
#pragma unroll
            for (int jj = 0; jj < 4; ++jj) at[jt][jj] = (jt * 16 + quad * 4 + jj <= it * 16 + r16) ? at[jt][jj] : 0.f; }
        u32x4 pk = {pack2(at[0][0], at[0][1]), pack2(at[0][2], at[0][3]), pack2(at[1][0], at[1][1]), pack2(at[1][2], at[1][3])};
        pf[it] = __builtin_bit_cast(bf16x8, pk);
    }
    f32x4 O[2][4];
#pragma unroll
    for (int dt = 0; dt < 4; ++dt) {
        const bf16_t* v0p = vL + (quad * 4 + (r16 >> 2)) * LDP + dt * 16 + (r16 & 3) * 4;
        const bf16x4 v0 = __builtin_amdgcn_ds_read_tr16_b64_v4i16((__attribute__((address_space(3))) bf16x4*)(v0p));
        const bf16x4 v1 = __builtin_amdgcn_ds_read_tr16_b64_v4i16((__attribute__((address_space(3))) bf16x4*)(v0p + 16 * LDP));
        const bf16x8 vf = {v0[0], v0[1], v0[2], v0[3], v1[0], v1[1], v1[2], v1[3]};
        const bf16_t* s0p = SL + (quad * 8 + (r16 >> 2)) * LDP + dt * 16 + (r16 & 3) * 4;
        const bf16x4 s0 = __builtin_amdgcn_ds_read_tr16_b64_v4i16((__attribute__((address_space(3))) bf16x4*)(s0p));
        const bf16x4 s1 = __builtin_amdgcn_ds_read_tr16_b64_v4i16((__attribute__((address_space(3))) bf16x4*)(s0p + 4 * LDP));
        const bf16x8 sf = {s0[0], s0[1], s0[2], s0[3], s1[0], s1[1], s1[2], s1[3]};
#pragma unroll
        for (int it = 0; it < 2; ++it) {
            O[it][dt] = __builtin_amdgcn_mfma_f32_16x16x32_bf16(vf, pf[it], (f32x4){0.f, 0.f, 0.f, 0.f}, 0, 0, 0);
            O[it][dt] = __builtin_amdgcn_mfma_f32_16x16x32_bf16(sf, qf[it], O[it][dt], 0, 0, 0);
        }
    }
#pragma unroll
    for (int it = 0; it < 2; ++it) {
        float ss = 0.f;
#pragma unroll
        for (int dt = 0; dt < 4; ++dt) ss += (O[it][dt][0] * O[it][dt][0] + O[it][dt][1] * O[it][dt][1]) + (O[it][dt][2] * O[it][dt][2] + O[it][dt][3] * O[it][dt][3]);
        ss += __shfl_xor(ss, 16); ss += __shfl_xor(ss, 32);
        const float rn = rsqrtf(ss * (1.f / 64.f) + 1e-5f);
        const size_t tok = (size_t)(tok0 + it * 16 + r16);
#pragma unroll
        for (int dt = 0; dt < 4; ++dt) { const int v0i = dt * 16 + quad * 4; const f32x4 gn = *(const f32x4*)(p.gla_gn + l * 64 + v0i);
            const u32x2 gv = *(const u32x2*)(z + tok * ZP + C_DG + w * 64 + v0i);
            const float g0 = __uint_as_float(gv.x << 16), g1 = __uint_as_float(gv.x & 0xffff0000u), g2 = __uint_as_float(gv.y << 16), g3 = __uint_as_float(gv.y & 0xffff0000u);
            u32x2 o; o.x = pack2(O[it][dt][0] * rn * gn[0] * silu_f(g0), O[it][dt][1] * rn * gn[1] * silu_f(g1));
            o.y = pack2(O[it][dt][2] * rn * gn[2] * silu_f(g2), O[it][dt][3] * rn * gn[3] * silu_f(g3));
            *(u32x2*)(mix + tok * 1024 + 768 + w * 64 + v0i) = o; }
    }
}

__device__ void lru1_item(const Params& p, int l, int idx, char* smem) {
    const int t = tid_opq(), lane = t & 63, g = t >> 6, r16 = lane & 15, quad = lane >> 4; const int ch = t;
    const int b = idx >> 7, c = idx & 127; const int s0 = c * 32; const int tok0 = b * S + s0;
    const bf16_t* z = (const bf16_t*)(p.ws + WS_Z); float* xcs = (float*)smem;
    bf16_t* preA = (bf16_t*)(smem + 32768); bf16_t* preX = (bf16_t*)(smem + 49152);
    float* lh = (float*)(p.ws + WS_LH); float* lp = (float*)(p.ws + WS_LP);
    bf16_t xr[35];
#pragma unroll
    for (int i = 0; i < 35; ++i) { const int sidx = s0 + i - 3; xr[i] = (sidx >= 0) ? z[(size_t)(tok0 + i - 3) * ZP + C_BX + ch] : (bf16_t)0; }
    const float cw0 = p.conv_w[l * 1024 + ch], cw1 = p.conv_w[l * 1024 + 256 + ch], cw2 = p.conv_w[l * 1024 + 512 + ch], cw3 = p.conv_w[l * 1024 + 768 + ch];
    const float cb = p.conv_b[l * 256 + ch];
    const bf16_t* lwt = (const bf16_t*)(p.ws + WS_LWT) + (size_t)l * 32768 + g * 4096;
    bf16x8 wfa[4][2], wfx[4][2];
#pragma unroll
    for (int nt = 0; nt < 4; ++nt)
#pragma unroll
        for (int ks = 0; ks < 2; ++ks) { wfa[nt][ks] = *(const bf16x8*)(lwt + (nt * 16 + r16) * 64 + ks * 32 + quad * 8); wfx[nt][ks] = *(const bf16x8*)(lwt + 16384 + (nt * 16 + r16) * 64 + ks * 32 + quad * 8); }
    __syncthreads();
#pragma unroll
    for (int i = 0; i < 32; ++i) xcs[i * 256 + ch] = cb + (cw0 * bf2f(xr[i]) + cw1 * bf2f(xr[i + 1])) + (cw2 * bf2f(xr[i + 2]) + cw3 * bf2f(xr[i + 3]));
    __syncthreads();
#pragma unroll
    for (int tt = 0; tt < 2; ++tt) {
        bf16x8 xf[2];
#pragma unroll
        for (int ks = 0; ks < 2; ++ks) { const float* xp = xcs + (tt * 16 + r16) * 256 + g * 64 + ks * 32 + quad * 8; const f32x4 x0 = *(const f32x4*)xp, x1 = *(const f32x4*)(xp + 4);
            u32x4 pk = {pack2(x0[0], x0[1]), pack2(x0[2], x0[3]), pack2(x1[0], x1[1]), pack2(x1[2], x1[3])}; xf[ks] = __builtin_bit_cast(bf16x8, pk); }
#pragma unroll
        for (int nt = 0; nt < 4; ++nt) {
            f32x4 ra = __builtin_amdgcn_mfma_f32_16x16x32_bf16(wfa[nt][0], xf[0], (f32x4){0.f, 0.f, 0.f, 0.f}, 0, 0, 0); ra = __builtin_amdgcn_mfma_f32_16x16x32_bf16(wfa[nt][1], xf[1], ra, 0, 0, 0);
            f32x4 rx = __builtin_amdgcn_mfma_f32_16x16x32_bf16(wfx[nt][0], xf[0], (f32x4){0.f, 0.f, 0.f, 0.f}, 0, 0, 0); rx = __builtin_amdgcn_mfma_f32_16x16x32_bf16(wfx[nt][1], xf[1], rx, 0, 0, 0);
            u32x2 pa; pa.x = pack2(ra[0], ra[1]); pa.y = pack2(ra[2], ra[3]); u32x2 px; px.x = pack2(rx[0], rx[1]); px.y = pack2(rx[2], rx[3]);
            *(u32x2*)(preA + (tt * 16 + r16) * 256 + g * 64 + nt * 16 + quad * 4) = pa; *(u32x2*)(preX + (tt * 16 + r16) * 256 + g * 64 + nt * 16 + quad * 4) = px;
        }
    }
    __syncthreads();
    const float ba = p.lru_ba[l * 256 + ch], bx = p.lru_bx[l * 256 + ch], lam = p.lru_lam[l * 256 + ch];
    const float sp = fmaxf(-lam, 0.f) + log1pf(__expf(-fabsf(lam)));
    float hh = 0.f, P = 1.f;
    float* lhp = lh + (size_t)tok0 * 256 + ch; float* lpp = lp + (size_t)tok0 * 256 + ch;
#pragma unroll 4
    for (int i = 0; i < 32; ++i) { const float r = sigmoid_f(bf2f(preA[i * 256 + ch]) + ba), ig = sigmoid_f(bf2f(preX[i * 256 + ch]) + bx); const float la = -8.f * r * sp; const float a = __expf(la);
        const float w2 = 2.f * la;
        const float em_s = -w2 * (1.f + w2 * (0.5f + w2 * (0.16666667f + w2 * (0.041666668f + w2 * (0.0083333338f + w2 * 0.0013888889f)))));
        const float em = (w2 > -0.25f) ? em_s : (1.f - a * a);
        const float u = __builtin_amdgcn_sqrtf(em) * (ig * xcs[i * 256 + ch]); hh = a * hh + u; P *= a;
        lhp[(size_t)i * 256] = hh; lpp[(size_t)i * 256] = P; }
}

__device__ void lru3_item(const Params& p, int idx) {
    const int ch = tid_opq(); const int b = idx >> 7, c = idx & 127; const int tok0 = b * S + c * 32;
    const bf16_t* z = (const bf16_t*)(p.ws + WS_Z); bf16_t* mix = (bf16_t*)(p.ws + WS_U);
    const float* lh = (const float*)(p.ws + WS_LH); const float* lp = (const float*)(p.ws + WS_LP); const float* lc = (const float*)(p.ws + WS_LC);
    const float carry = lc[(size_t)(b * 128 + c) * 256 + ch];
    float hv[32], pv[32]; bf16_t gv[32];
#pragma unroll
    for (int i = 0; i < 32; ++i) { const size_t tok = (size_t)(tok0 + i); hv[i] = lh[tok * 256 + ch]; pv[i] = lp[tok * 256 + ch]; gv[i] = z[tok * ZP + C_BG + ch]; }
#pragma unroll
    for (int i = 0; i < 32; ++i) { const size_t tok = (size_t)(tok0 + i); mix[tok * 1024 + 256 + ch] = f2bf((hv[i] + pv[i] * carry) * silu_f(bf2f(gv[i]))); }
}

__device__ void dilc_item(const Params& p, int idx) {
    const int t = tid_opq(); const size_t tok = (size_t)idx * 8 + (t >> 5); const int chn = t & 31; const int h = chn >> 3;
    const bf16_t* z = (const bf16_t*)(p.ws + WS_Z); bf16_t* mix = (bf16_t*)(p.ws + WS_U);
    const bf16_t* dilo = (const bf16_t*)(p.ws + WS_DILO); const float* dill = (const float*)(p.ws + WS_DILL);
    const float l0 = dill[((size_t)0 * T + tok) * 4 + h], l1 = dill[((size_t)1 * T + tok) * 4 + h], l2 = dill[((size_t)2 * T + tok) * 4 + h];
    const float mx = fmaxf(l0, fmaxf(l1, l2)); float w0 = __expf(l0 - mx), w1 = __expf(l1 - mx), w2 = __expf(l2 - mx); const float inv = 1.f / (w0 + w1 + w2); w0 *= inv; w1 *= inv; w2 *= inv;
    const u32x4 o0 = *(const u32x4*)(dilo + ((size_t)0 * T + tok) * 256 + chn * 8), o1 = *(const u32x4*)(dilo + ((size_t)1 * T + tok) * 256 + chn * 8), o2 = *(const u32x4*)(dilo + ((size_t)2 * T + tok) * 256 + chn * 8);
    const u32x4 gv = *(const u32x4*)(z + tok * ZP + C_CG + chn * 8);
    u32x4 r;
#pragma unroll
    for (int e = 0; e < 4; ++e) {
        const float a = w0 * __uint_as_float(o0[e] << 16) + w1 * __uint_as_float(o1[e] << 16) + w2 * __uint_as_float(o2[e] << 16);
        const float bq = w0 * __uint_as_float(o0[e] & 0xffff0000u) + w1 * __uint_as_float(o1[e] & 0xffff0000u) + w2 * __uint_as_float(o2[e] & 0xffff0000u);
        r[e] = pack2(a * silu_f(__uint_as_float(gv[e] << 16)), bq * silu_f(__uint_as_float(gv[e] & 0xffff0000u)));
    }
    *(u32x4*)(mix + tok * 1024 + 512 + chn * 8) = r;
}

__device__ void m2_phase(const Params& p, char* smem) {
    float* gkv = (float*)(p.ws + WS_GKV); const float* gdec = (const float*)(p.ws + WS_GDEC);
    const float* lh = (const float*)(p.ws + WS_LH); const float* lp = (const float*)(p.ws + WS_LP); float* lc = (float*)(p.ws + WS_LC);
    float* aggP = (float*)smem; float* aggS = aggP + 256;
    const int t = tid_opq(); const int e = t & 31, seg = t >> 5;
    for (int it = blockIdx.x; it < 1024 + 32; it += gridDim.x) {
        float a[16], x[16];
        size_t ostride;
        float* outp;
        if (it < 1024) {
            const int gid = it * 32 + e; const int bh = gid >> 11, dv = gid & 2047, d = dv >> 6;
            float* base = gkv + (size_t)bh * 128 * 2048 + dv + (size_t)(seg * 16) * 2048; const float* dc = gdec + (size_t)bh * 128 * 32 + d + (seg * 16) * 32;
#pragma unroll
            for (int k = 0; k < 16; ++k) { x[k] = base[(size_t)k * 2048]; a[k] = dc[k * 32]; }
            outp = base; ostride = 2048;
        } else {
            const int i2 = it - 1024; const int b = i2 >> 3, ch = (i2 & 7) * 32 + e;
#pragma unroll
            for (int k = 0; k < 16; ++k) { const size_t ix = (size_t)(b * S + (seg * 16 + k) * 32 + 31) * 256 + ch; a[k] = lp[ix]; x[k] = lh[ix]; }
            outp = lc + (size_t)(b * 128 + seg * 16) * 256 + ch; ostride = 256;
        }
        float st = 0.f, pr = 1.f;
#pragma unroll
        for (int k = 0; k < 16; ++k) { const float ak = a[k], xk = x[k]; a[k] = pr; x[k] = st; st = ak * st + xk; pr *= ak; }
        __syncthreads();
        aggP[seg * 32 + e] = pr; aggS[seg * 32 + e] = st;
        __syncthreads();
        float carry = 0.f;
        for (int s2 = 0; s2 < seg; ++s2) carry = aggP[s2 * 32 + e] * carry + aggS[s2 * 32 + e];
#pragma unroll
        for (int k = 0; k < 16; ++k) outp[(size_t)k * ostride] = x[k] + a[k] * carry;
    }
}

__global__ void __launch_bounds__(256, 2) fwd_megakernel(Params p) {
    __shared__ __attribute__((aligned(16))) char smem[SMEM_BYTES];
    __shared__ uint4 xb_words;
    __shared__ int s_slot;
    cg::grid_group grid = cg::this_grid();
    if (p.out == nullptr) grid.sync();
    if (threadIdx.x == 0) xb_words = make_uint4(0u, 0u, 0u, 0u);
    __syncthreads();
    const XcdBarrier xb = xcd_barrier_post((unsigned*)(p.ws + WS_CTL), (volatile LAS unsigned*)&xb_words);
    unsigned* cnt = (unsigned*)(p.ws + WS_CNT);
    prologue_phase(p, smem);
    xcd_barrier(xb);
#pragma unroll 1
    for (int l = 0; l < DEPTH; ++l) {
        ln_phase(p, l);
        xcd_barrier(xb);
        g1_phase(p, l, smem);
        xcd_barrier(xb);
        for (;;) { const int it = next_item(cnt + (4 + l) * 64, &s_slot); if (it >= 512) break; lru1_item(p, l, it, smem); }
        { const int xq = blockIdx.x & 7;
          for (;;) { const int li = next_item(cnt + (16 + l * 8 + xq) * 64, &s_slot); if (li >= 64) break;
              const int pr = xq * 2 + ((li >> 1) & 1); moba_item(p, (li >> 2) * 32 + (pr >> 2) * 8 + (pr & 3) * 2 + (li & 1), smem, (bf16_t*)(p.ws + WS_U)); }
          for (;;) { const int li = next_item(cnt + (32 + l * 8 + xq) * 64, &s_slot); if (li >= 192) break;
              const int cfg = li >> 6, r6 = li & 63; const int pr = xq * 2 + (r6 >> 5); attn_item(p, 1, cfg * 512 + (pr >> 2) * 128 + (pr & 3) * 32 + (r6 & 31), smem); } }
        for (;;) { const int it = next_item(cnt + (2 + l) * 64, &s_slot); if (it >= 512) break; gla1_item(p, l, it, smem); }
        xcd_barrier(xb);
        m2_phase(p, smem);
        xcd_barrier(xb);
        for (int it = blockIdx.x; it < 512; it += gridDim.x) gla3_item(p, l, it, smem);
        for (int it = blockIdx.x; it < 512; it += gridDim.x) lru3_item(p, it);
        for (int it = blockIdx.x; it < 2048; it += gridDim.x) dilc_item(p, it);
        xcd_barrier(xb);
        g2_phase(p, l, smem);
        xcd_barrier(xb);
    }
    ln_phase(p, DEPTH);
}

extern "C" void kernel_launch(void* const* d_in, const int* in_sizes, int n_in, void* d_out, int out_size, void* d_ws, size_t ws_size, hipStream_t stream) {
    static int grid_blocks = 0;
    if (!grid_blocks) {
        int dev = 0, cus = 0, per_cu = 0;
        hipGetDevice(&dev);
        hipDeviceGetAttribute(&cus, hipDeviceAttributeMultiprocessorCount, dev);
        hipOccupancyMaxActiveBlocksPerMultiprocessor(&per_cu, (const void*)fwd_megakernel, 256, 0);
        if (per_cu < 1) per_cu = 1;
        if (per_cu > 2) per_cu = 2;
        grid_blocks = cus * per_cu;
        if (ws_size < WS_END) fprintf(stderr, "kernel_launch: workspace too small: %zu < %zu\n", ws_size, (size_t)WS_END);
    }
    Params p{};
    p.x = (const float*)d_in[0]; p.c = (const float*)d_in[1]; p.pos = (const int*)d_in[2];
    p.w_mod = (const float*)d_in[3]; p.b_mod = (const float*)d_in[4]; p.w_in = (const float*)d_in[5];
    p.conv_w = (const float*)d_in[6]; p.conv_b = (const float*)d_in[7]; p.lru_wa = (const float*)d_in[8]; p.lru_ba = (const float*)d_in[9];
    p.lru_wx = (const float*)d_in[10]; p.lru_bx = (const float*)d_in[11]; p.lru_lam = (const float*)d_in[12];
    p.gla_wr = (const float*)d_in[13]; p.gla_br = (const float*)d_in[14]; p.gla_gn = (const float*)d_in[15];
    p.w_out = (const float*)d_in[16]; p.ln_g = (const float*)d_in[17]; p.ln_b = (const float*)d_in[18];
    p.out = (float*)d_out; p.ws = (unsigned char*)d_ws;
    (void)hipMemsetAsync(d_ws, 0, 32768, stream);
    void* args[] = {&p};
    hipError_t e = hipLaunchCooperativeKernel((const void*)fwd_megakernel, dim3(grid_blocks), dim3(256), args, 0, stream);
    if (e != hipSuccess) fprintf(stderr, "cooperative launch failed: %s (grid %d)\n", hipGetErrorString(e), grid_blocks);
}
```

```cpp
#include <hip/hip_runtime.h>
#include <hip/hip_cooperative_groups.h>
#include <cstdio>
#include <cstdint>
#include <type_traits>
namespace cg = cooperative_groups;

typedef unsigned short bf16_t;
typedef short bf16x8 __attribute__((ext_vector_type(8)));
typedef short bf16x4 __attribute__((ext_vector_type(4)));
typedef float f32x4 __attribute__((ext_vector_type(4)));
typedef unsigned u32x4 __attribute__((ext_vector_type(4)));
typedef unsigned u32x2 __attribute__((ext_vector_type(2)));

constexpr int D = 1024, NB = 4, S = 4096, T = NB * S, DEPTH = 2;
constexpr int DIN = 3344, ZP = 3344, NPAD = 3456;
constexpr int C_AQ = 0, C_AK = 256, C_AV = 512, C_AG = 768, C_BX = 1024, C_BG = 1280, C_CQ = 1536, C_CK = 1792,
              C_CV = 2048, C_CG = 2304, C_DQ = 2560, C_DK = 2688, C_DV = 2816, C_DG = 3072, C_DR = 3328;
constexpr float DN_ALPHA = 1.4142135623730951f;
constexpr int LDP = 72;
constexpr int SMEM_BYTES = 65536;
constexpr int BIG = 1000000;

constexpr size_t WS_CTL = 0;
constexpr size_t WS_CNT = 16384;
constexpr size_t WS_WINT = 32768;
constexpr size_t WS_WOUTT = WS_WINT + (size_t)DEPTH * NPAD * 1024 * 2;
constexpr size_t WS_MOD = WS_WOUTT + (size_t)DEPTH * 1024 * 1024 * 2;
constexpr size_t WS_COS = WS_MOD + (size_t)DEPTH * NB * 3072 * 4;
constexpr size_t WS_SIN = WS_COS + (size_t)T * 32 * 4;
constexpr size_t WS_U = WS_SIN + (size_t)T * 32 * 4;
constexpr size_t WS_Z = WS_U + (size_t)T * 1024 * 2;
constexpr size_t WS_KPART = WS_Z + (size_t)T * ZP * 2;
constexpr size_t WS_DILO = WS_KPART + (size_t)256 * 256 * 4;
constexpr size_t WS_DILL = WS_DILO + (size_t)3 * T * 256 * 2;
constexpr size_t WS_GKV = WS_DILL + (size_t)3 * T * 4 * 4;
constexpr size_t WS_GDEC = WS_GKV + (size_t)2048 * 2048 * 4;
constexpr size_t WS_LH = WS_GDEC + (size_t)2048 * 32 * 4;
constexpr size_t WS_LP = WS_LH + (size_t)T * 256 * 4;
constexpr size_t WS_LC = WS_LP + (size_t)T * 256 * 4;
constexpr size_t WS_LWT = WS_LC + (size_t)NB * 128 * 256 * 4;
constexpr size_t WS_BC = WS_LWT + (size_t)DEPTH * 2 * 4 * 64 * 64 * 2;
constexpr size_t WS_END = WS_BC + (size_t)512 * 32 * 128 * 4;

struct Params {
    const float *x, *c; const int* pos;
    const float *w_mod, *b_mod, *w_in, *conv_w, *conv_b, *lru_wa, *lru_ba, *lru_wx, *lru_bx, *lru_lam, *gla_wr, *gla_br, *gla_gn, *w_out, *ln_g, *ln_b;
    float* out; unsigned char* ws;
};

__device__ __forceinline__ float bf2f(bf16_t h) { return __uint_as_float(((unsigned)h) << 16); }
typedef __bf16 hbf16x2 __attribute__((ext_vector_type(2)));
typedef float f32x2 __attribute__((ext_vector_type(2)));
__device__ __forceinline__ unsigned pack2(float a, float b) { f32x2 v = {a, b}; hbf16x2 r = __builtin_convertvector(v, hbf16x2); return __builtin_bit_cast(unsigned, r); }
__device__ __forceinline__ bf16_t f2bf(float f) { return (bf16_t)(pack2(f, 0.f) & 0xffffu); }
__device__ __forceinline__ float silu_f(float x) { return x / (1.f + __expf(-x)); }
__device__ __forceinline__ float sigmoid_f(float x) { return 1.f / (1.f + __expf(-x)); }
__device__ __forceinline__ int tid_opq() { int t = threadIdx.x; asm volatile("" : "+v"(t)); return t; }
__device__ __forceinline__ float wsum(float v) {
#pragma unroll
    for (int o = 32; o; o >>= 1) v += __shfl_xor(v, o);
    return v;
}

#define XB_TMO      128
#define XB_XCNT(j)  (256  + 64 * (j))
#define XB_XSUB(j)  (1280 + 64 * (j))
#define XB_XGEN(j)  (2304 + 64 * (j))
#define XB_TOP      3328
#define XB_TOPGEN   3392
#define XCD_BAR_WORDS 3456
#define XB_SPIN_CAP (1u << 18)
#define LAS __attribute__((address_space(3)))
__device__ __forceinline__ unsigned xb_ld(unsigned* p)              { return __hip_atomic_load(p, __ATOMIC_RELAXED, __HIP_MEMORY_SCOPE_AGENT); }
__device__ __forceinline__ unsigned xb_add(unsigned* p, unsigned v) { return __hip_atomic_fetch_add(p, v, __ATOMIC_RELAXED, __HIP_MEMORY_SCOPE_AGENT); }
__device__ __forceinline__ unsigned xb_xcc_id() { return (unsigned)__builtin_amdgcn_s_getreg((3 << 11) | 20) & 0xFu; }
#define XB_SPIN(cond, bar) do { unsigned _sp = 0; while (cond) { __builtin_amdgcn_s_sleep(1); \
    if ((++_sp & 255u) == 0u) { if (xb_ld(&(bar)[XB_TMO])) break; if (_sp > XB_SPIN_CAP) { atomicAdd(&(bar)[XB_TMO], 1u); break; } } } } while (0)
struct XcdBarrier { unsigned* bar; unsigned x; volatile LAS unsigned* st; };
__device__ __forceinline__ XcdBarrier xcd_barrier_post(unsigned* bar, volatile LAS unsigned* st) {
    XcdBarrier b; b.bar = bar; b.x = xb_xcc_id(); b.st = st;
    if (threadIdx.x == 0) (void)xb_add(&bar[XB_XCNT(b.x)], 1u);
    return b;
}
__device__ __forceinline__ void xcd_barrier_complete(unsigned* bar, unsigned x, unsigned& nloc, unsigned& nx) {
    const unsigned G = gridDim.x * gridDim.y * gridDim.z;
    unsigned sum, cnt, mine, sp = 0u;
    for (;;) {
        sum = 0u; cnt = 0u; mine = 0u;
#pragma unroll
        for (unsigned j = 0; j < 16; ++j) { const unsigned c = xb_ld(&bar[XB_XCNT(j)]); sum += c; cnt += (c > 0u) ? 1u : 0u; mine = (j == x) ? c : mine; }
        if (sum == G) break;
        __builtin_amdgcn_s_sleep(1);
        if ((++sp & 255u) == 0u) { if (xb_ld(&bar[XB_TMO])) break; if (sp > XB_SPIN_CAP) { atomicAdd(&bar[XB_TMO], 1u); break; } }
    }
    nloc = mine > 0u ? mine : 1u; nx = cnt > 0u ? cnt : 1u;
}
__device__ __forceinline__ void xcd_barrier(const XcdBarrier& b) {
    asm volatile("s_waitcnt vmcnt(0)" ::: "memory");
    __syncthreads();
    if (threadIdx.x == 0) {
        unsigned* bar = b.bar;
        __builtin_amdgcn_s_waitcnt(0);
        unsigned nloc = b.st[0], nx = b.st[1];
        if (nloc == 0u) { xcd_barrier_complete(bar, b.x, nloc, nx); b.st[0] = nloc; b.st[1] = nx; }
        const unsigned old = xb_add(&bar[XB_XSUB(b.x)], 1u);
        const unsigned gen = old / nloc;
        if (old + 1u == (gen + 1u) * nloc) {
            __builtin_amdgcn_fence(__ATOMIC_RELEASE, "agent");
            asm volatile("s_waitcnt vmcnt(0)" ::: "memory");
            const unsigned og = xb_add(&bar[XB_TOP], 1u);
            const unsigned tg = og / nx;
            if (og + 1u == (tg + 1u) * nx) xb_add(&bar[XB_TOPGEN], 1u);
            else XB_SPIN(xb_ld(&bar[XB_TOPGEN]) == tg, bar);
            __builtin_amdgcn_fence(__ATOMIC_ACQUIRE, "agent");
            xb_add(&bar[XB_XGEN(b.x)], 1u);
            asm volatile("s_waitcnt vmcnt(0)" ::: "memory");
        } else {
            XB_SPIN(xb_ld(&bar[XB_XGEN(b.x)]) == gen, bar);
            __builtin_amdgcn_fence(__ATOMIC_ACQUIRE, "agent");
            asm volatile("s_waitcnt vmcnt(0)" ::: "memory");
        }
    }
    __syncthreads();
}
__device__ __forceinline__ int next_item(unsigned* ctr, volatile int* slot) {
    __syncthreads();
    if (threadIdx.x == 0) *slot = (int)atomicAdd(ctr, 1u);
    __syncthreads();
    return *slot;
}

__device__ void prologue_phase(const Params& p, char* smem) {
    const int t = tid_opq();
    bf16_t* WinT = (bf16_t*)(p.ws + WS_WINT); bf16_t* WoutT = (bf16_t*)(p.ws + WS_WOUTT);
    float* mod = (float*)(p.ws + WS_MOD); float* cosT = (float*)(p.ws + WS_COS); float* sinT = (float*)(p.ws + WS_SIN);
    float* tl = (float*)smem;
    constexpr int N_TIN = DEPTH * 16 * 54, N_TOUT = DEPTH * 16 * 16, N_MOD = DEPTH * 192, N_ROPE = T * 32 / 256, N_LWT = DEPTH * 2 * 4 * 64 * 64 / 256;
    constexpr int NITEMS = N_TIN + N_TOUT + N_MOD + N_ROPE + N_LWT;
    for (int it = blockIdx.x; it < NITEMS; it += gridDim.x) {
        if (it < N_TIN + N_TOUT) {
            const float* src; bf16_t* dst; int ncols, kt, nt;
            if (it < N_TIN) { int l = it / (16 * 54), r = it % (16 * 54); kt = r / 54; nt = r % 54; src = p.w_in + (size_t)l * 1024 * DIN; dst = WinT + (size_t)l * NPAD * 1024; ncols = DIN; }
            else { int i2 = it - N_TIN; int l = i2 / 256, r = i2 % 256; kt = r / 16; nt = r % 16; src = p.w_out + (size_t)l * 1024 * 1024; dst = WoutT + (size_t)l * 1024 * 1024; ncols = 1024; }
            __syncthreads();
            { const int c4 = t & 15, r0 = t >> 4; const int n = nt * 64 + c4 * 4;
              f32x4 v[4];
#pragma unroll
              for (int i = 0; i < 4; ++i) { const int r = r0 + 16 * i; v[i] = (n < ncols) ? *(const f32x4*)(src + (size_t)(kt * 64 + r) * ncols + n) : (f32x4){0.f, 0.f, 0.f, 0.f}; }
#pragma unroll
              for (int i = 0; i < 4; ++i) { const int r = r0 + 16 * i; tl[r * 65 + c4 * 4] = v[i][0]; tl[r * 65 + c4 * 4 + 1] = v[i][1]; tl[r * 65 + c4 * 4 + 2] = v[i][2]; tl[r * 65 + c4 * 4 + 3] = v[i][3]; } }
            __syncthreads();
            {
#pragma unroll
              for (int i = 0; i < 2; ++i) { const int cc = t + 256 * i; const int n = cc >> 3, k8 = (cc & 7) * 8;
                  u32x4 pk; pk.x = pack2(tl[(k8 + 0) * 65 + n], tl[(k8 + 1) * 65 + n]); pk.y = pack2(tl[(k8 + 2) * 65 + n], tl[(k8 + 3) * 65 + n]);
                  pk.z = pack2(tl[(k8 + 4) * 65 + n], tl[(k8 + 5) * 65 + n]); pk.w = pack2(tl[(k8 + 6) * 65 + n], tl[(k8 + 7) * 65 + n]);
                  *(u32x4*)(dst + (size_t)(nt * 64 + n) * 1024 + kt * 64 + k8) = pk; } }
        } else if (it < N_TIN + N_TOUT + N_MOD) {
            const int i2 = it - N_TIN - N_TOUT; const int l = i2 / 192, jg = i2 % 192;
            const int jj = t & 15, ks = t >> 4; const int j = jg * 16 + jj;
            float a0 = 0.f, a1 = 0.f, a2 = 0.f, a3 = 0.f;
            const float* wm = p.w_mod + (size_t)l * 1024 * 3072 + j;
#pragma unroll 8
            for (int k = ks * 64; k < ks * 64 + 64; ++k) { float wv = wm[(size_t)k * 3072]; a0 += p.c[k] * wv; a1 += p.c[1024 + k] * wv; a2 += p.c[2048 + k] * wv; a3 += p.c[3072 + k] * wv; }
            __syncthreads();
            tl[(0 * 16 + ks) * 16 + jj] = a0; tl[(1 * 16 + ks) * 16 + jj] = a1; tl[(2 * 16 + ks) * 16 + jj] = a2; tl[(3 * 16 + ks) * 16 + jj] = a3;
            __syncthreads();
            if (t < 64) { const int b = t >> 4, j2 = t & 15; float s = 0.f;
#pragma unroll
              for (int k2 = 0; k2 < 16; ++k2) s += tl[(b * 16 + k2) * 16 + j2];
              mod[((size_t)l * NB + b) * 3072 + jg * 16 + j2] = s + p.b_mod[l * 3072 + jg * 16 + j2]; }
        } else if (it >= N_TIN + N_TOUT + N_MOD + N_ROPE) {
            const int e = (it - N_TIN - N_TOUT - N_MOD - N_ROPE) * 256 + t;
            const int in = e & 63, out = (e >> 6) & 63, g = (e >> 12) & 3, mat = (e >> 14) & 1, l = e >> 15;
            const float* src = mat ? p.lru_wx : p.lru_wa;
            ((bf16_t*)(p.ws + WS_LWT))[e] = f2bf(src[l * 16384 + g * 4096 + in * 64 + out]);
        } else {
            const int i2 = it - N_TIN - N_TOUT - N_MOD; const int e = i2 * 256 + t; const int tok = e >> 5, f = e & 31;
            const float inv = exp2f(-(float)f * (13.287712379549449f / 32.f));
            const float ang = (float)p.pos[tok] * inv;
            double rev = (double)ang * 0.15915494309189535; rev -= __builtin_rint(rev);
            const float rr = (float)rev; cosT[e] = __builtin_amdgcn_cosf(rr); sinT[e] = __builtin_amdgcn_sinf(rr);
        }
    }
}

__device__ void ln_phase(const Params& p, int l) {
    const int t = tid_opq(), lane = t & 63, w = t >> 6;
    bf16_t* ubuf = (bf16_t*)(p.ws + WS_U); const float* mod = (const float*)(p.ws + WS_MOD);
    for (int rg = blockIdx.x; rg < T / 16; rg += gridDim.x) {
        f32x4 v[4][4];
#pragma unroll
        for (int r = 0; r < 4; ++r) { const int row = rg * 16 + w * 4 + r; const float* src = (l <= 1) ? p.x + (size_t)row * 1024 : p.out + (size_t)row * 1024;
#pragma unroll
            for (int i = 0; i < 4; ++i) v[r][i] = *(const f32x4*)(src + i * 256 + lane * 4);
            if (l > 0) {
                const bf16_t* yr = (const bf16_t*)(p.ws + WS_Z) + (size_t)row * 1024; const float* gate = mod + ((size_t)(l - 1) * NB + row / S) * 3072 + 2048;
#pragma unroll
                for (int i = 0; i < 4; ++i) { const u32x2 yv = *(const u32x2*)(yr + i * 256 + lane * 4); const f32x4 g1 = *(const f32x4*)(gate + i * 256 + lane * 4) + 1.f;
                    const f32x4 yf = {__uint_as_float(yv.x << 16), __uint_as_float(yv.x & 0xffff0000u), __uint_as_float(yv.y << 16), __uint_as_float(yv.y & 0xffff0000u)};
                    v[r][i] = v[r][i] * DN_ALPHA + g1 * yf; }
            } }
#pragma unroll
        for (int r = 0; r < 4; ++r) {
            const int row = rg * 16 + w * 4 + r; const int b = row / S;
            if (l > 0) {
                float s = 0.f;
#pragma unroll
                for (int i = 0; i < 4; ++i) s += (v[r][i][0] + v[r][i][1]) + (v[r][i][2] + v[r][i][3]);
                const float mu = wsum(s) * (1.f / 1024.f); float q = 0.f;
#pragma unroll
                for (int i = 0; i < 4; ++i) { f32x4 d = v[r][i] - mu; q += (d[0] * d[0] + d[1] * d[1]) + (d[2] * d[2] + d[3] * d[3]); }
                const float rstd = rsqrtf(wsum(q) * (1.f / 1024.f) + 1e-5f);
#pragma unroll
                for (int i = 0; i < 4; ++i) { const f32x4 g = *(const f32x4*)(p.ln_g + (l - 1) * 1024 + i * 256 + lane * 4), bb = *(const f32x4*)(p.ln_b + (l - 1) * 1024 + i * 256 + lane * 4);
                    v[r][i] = (v[r][i] - mu) * rstd * g + bb; *(f32x4*)(p.out + (size_t)row * 1024 + i * 256 + lane * 4) = v[r][i]; }
            }
            if (l < DEPTH) {
                float s = 0.f;
#pragma unroll
                for (int i = 0; i < 4; ++i) s += (v[r][i][0] + v[r][i][1]) + (v[r][i][2] + v[r][i][3]);
                const float mu = wsum(s) * (1.f / 1024.f); float q = 0.f;
#pragma unroll
                for (int i = 0; i < 4; ++i) { f32x4 d = v[r][i] - mu; q += (d[0] * d[0] + d[1] * d[1]) + (d[2] * d[2] + d[3] * d[3]); }
                const float rstd = rsqrtf(wsum(q) * (1.f / 1024.f) + 1e-5f);
                const float* mb = mod + ((size_t)l * NB + b) * 3072;
#pragma unroll
                for (int i = 0; i < 4; ++i) { const int col = i * 256 + lane * 4; const f32x4 sh = *(const f32x4*)(mb + col), sc = *(const f32x4*)(mb + 1024 + col);
                    f32x4 u = (v[r][i] - mu) * rstd * (sc + 1.f) + sh; u32x2 pk; pk.x = pack2(u[0], u[1]); pk.y = pack2(u[2], u[3]);
                    *(u32x2*)(ubuf + (size_t)row * 1024 + col) = pk; }
            }
        }
    }
}

__device__ __forceinline__ int lds_off(int r, int c8) {
    const int st = (r >> 4) * 2 + (c8 >> 2); const int ob = (r & 15) * 64 + (c8 & 3) * 16;
    return st * 1024 + (ob ^ (((ob >> 9) & 1) << 5));
}
struct RegSet { u32x4 a[4], b[4]; };
__device__ __forceinline__ void gemm_tile(const bf16_t* __restrict__ A, const bf16_t* __restrict__ Bt, int tm, int tn, bool first, bool has_next, int ntm, int ntn,
                                          char* sm, f32x4 (&acc)[4][4], RegSet& r0, RegSet& r1) {
    const int t = tid_opq(), lane = t & 63, w = t >> 6, wm = w >> 1, wn = w & 1, r16 = lane & 15, quad = lane >> 4;
    const int lrow = t >> 3, lch = t & 7;
    constexpr int BUF = 32768;
    const unsigned loff = (unsigned)(lrow * 1024 + lch * 8);
    const bf16_t* At0 = A + (size_t)tm * (128 * 1024); const bf16_t* Bt0 = Bt + (size_t)tn * (128 * 1024);
    const bf16_t* At1 = A + (size_t)ntm * (128 * 1024); const bf16_t* Bt1 = Bt + (size_t)ntn * (128 * 1024);
#define Ag (At0 + loff)
#define Bg (Bt0 + loff)
#define nAg (At1 + loff)
#define nBg (Bt1 + loff)
    const int woff0 = lds_off(lrow, lch);
#define woff(i) (woff0 + 4096 * (i))
    const int fo = lds_off(r16, quad);
#pragma unroll
    for (int a = 0; a < 4; ++a)
#pragma unroll
        for (int b = 0; b < 4; ++b) acc[a][b] = (f32x4){0.f, 0.f, 0.f, 0.f};
    if (first) {
#pragma unroll
        for (int i = 0; i < 4; ++i) { r0.a[i] = *(const u32x4*)(Ag + (size_t)i * 32 * 1024); r0.b[i] = *(const u32x4*)(Bg + (size_t)i * 32 * 1024); }
#pragma unroll
        for (int i = 0; i < 4; ++i) { r1.a[i] = *(const u32x4*)(Ag + (size_t)i * 32 * 1024 + 64); r1.b[i] = *(const u32x4*)(Bg + (size_t)i * 32 * 1024 + 64); }
        __syncthreads();
#pragma unroll
        for (int i = 0; i < 4; ++i) { *(u32x4*)(sm + woff(i)) = r0.a[i]; *(u32x4*)(sm + 16384 + woff(i)) = r0.b[i]; }
#pragma unroll
        for (int i = 0; i < 4; ++i) { r0.a[i] = *(const u32x4*)(Ag + (size_t)i * 32 * 1024 + 128); r0.b[i] = *(const u32x4*)(Bg + (size_t)i * 32 * 1024 + 128); }
    }
    __syncthreads();
    auto step = [&](auto main_tag, int kt, RegSet& rs) {
        constexpr bool MAIN = decltype(main_tag)::value;
        const char* sA = sm + (kt & 1) * BUF; const char* sB = sA + 16384;
        char* nA = sm + ((kt + 1) & 1) * BUF; char* nB = nA + 16384;
        const bool wr = MAIN || kt + 1 < 16 || has_next;
        const bool own = MAIN || kt + 3 < 16;
        const bf16_t* la = own ? Ag + (kt + 3) * 64 : nAg + (kt - 13) * 64; const bf16_t* lb = own ? Bg + (kt + 3) * 64 : nBg + (kt - 13) * 64;
        __builtin_amdgcn_s_setprio(1);
#pragma unroll
        for (int ks = 0; ks < 2; ++ks) {
            bf16x8 af[4], bfr[4];
#pragma unroll
            for (int mt = 0; mt < 4; ++mt) af[mt] = *(const bf16x8*)(sA + ((wm * 4 + mt) * 2 + ks) * 1024 + fo);
#pragma unroll
            for (int nt = 0; nt < 4; ++nt) bfr[nt] = *(const bf16x8*)(sB + ((wn * 4 + nt) * 2 + ks) * 1024 + fo);
#pragma unroll
            for (int mt = 0; mt < 4; ++mt) {
#pragma unroll
                for (int nt = 0; nt < 4; ++nt) acc[mt][nt] = __builtin_amdgcn_mfma_f32_16x16x32_bf16(bfr[nt], af[mt], acc[mt][nt], 0, 0, 0);
                const int i = ks * 2 + (mt >> 1);
                __builtin_amdgcn_sched_barrier(0);
                if ((mt & 1) == 0) { if (wr) *(u32x4*)(nA + woff(i)) = rs.a[i]; if (own || has_next) rs.a[i] = *(const u32x4*)(la + (size_t)i * 32 * 1024); }
                else               { if (wr) *(u32x4*)(nB + woff(i)) = rs.b[i]; if (own || has_next) rs.b[i] = *(const u32x4*)(lb + (size_t)i * 32 * 1024); }
                __builtin_amdgcn_sched_barrier(0);
            }
        }
        __builtin_amdgcn_s_setprio(0);
        __syncthreads();
    };
    {
        std::true_type mt_; std::false_type tl_;
        for (int k2 = 0; k2 < 6; ++k2) { step(mt_, 2 * k2, r1); step(mt_, 2 * k2 + 1, r0); }
        step(mt_, 12, r1); step(tl_, 13, r0); step(tl_, 14, r1); step(tl_, 15, r0);
    }
#undef Ag
#undef Bg
#undef nAg
#undef nBg
#undef woff
}

__device__ void g1_phase(const Params& p, int l, char* smem) {
    const int t = tid_opq(), lane = t & 63, w = t >> 6, wm = w >> 1, wn = w & 1, r16 = lane & 15, quad = lane >> 4;
    char* sm = smem; char* sC = smem + 32768;
    const bf16_t* ubuf = (const bf16_t*)(p.ws + WS_U); const bf16_t* WinT = (const bf16_t*)(p.ws + WS_WINT) + (size_t)l * NPAD * 1024;
    bf16_t* z = (bf16_t*)(p.ws + WS_Z); float* kpart = (float*)(p.ws + WS_KPART);
    const float* cosT = (const float*)(p.ws + WS_COS); const float* sinT = (const float*)(p.ws + WS_SIN);
    const bool xo = (gridDim.x & 7) == 0; const int xcd = blockIdx.x & 7, nloc = xo ? (int)(gridDim.x >> 3) : (int)gridDim.x, j0 = xo ? (int)(blockIdx.x >> 3) : (int)blockIdx.x;
    const int lim = xo ? 16 * 27 : 128 * 27;
    RegSet r0, r1;
    for (int L = j0; L < lim; L += nloc) {
        const int tm = xo ? xcd * 16 + (L / 216) * 8 + (L & 7) : L / 27, tn = xo ? ((L % 216) >> 3) : L % 27;
        const int L2 = L + nloc; const bool has_next = L2 < lim;
        const int ntm = has_next ? (xo ? xcd * 16 + (L2 / 216) * 8 + (L2 & 7) : L2 / 27) : tm, ntn = has_next ? (xo ? ((L2 % 216) >> 3) : L2 % 27) : tn;
        f32x4 acc[4][4];
        gemm_tile(ubuf, WinT, tm, tn, L == j0, has_next, ntm, ntn, sm, acc, r0, r1);
        const bool rope = (tn < 4) || (tn >= 12 && tn < 16);
        if (rope) {
#pragma unroll
            for (int mt = 0; mt < 4; ++mt) {
                const int tok = tm * 128 + wm * 64 + mt * 16 + r16;
#pragma unroll
                for (int nt = 0; nt < 2; ++nt) {
                    const f32x4 cs = *(const f32x4*)(cosT + (size_t)tok * 32 + nt * 16 + quad * 4), sn = *(const f32x4*)(sinT + (size_t)tok * 32 + nt * 16 + quad * 4);
                    const f32x4 x1 = acc[mt][nt], x2 = acc[mt][nt + 2];
                    acc[mt][nt] = x1 * cs - x2 * sn; acc[mt][nt + 2] = x1 * sn + x2 * cs;
                }
            }
        }
        if (tn == 2 || tn == 3) {
#pragma unroll
            for (int nt = 0; nt < 4; ++nt) {
                f32x4 sv = (acc[0][nt] + acc[1][nt]) + (acc[2][nt] + acc[3][nt]);
#pragma unroll
                for (int jj = 0; jj < 4; ++jj) { float sx = sv[jj]; sx += __shfl_xor(sx, 1); sx += __shfl_xor(sx, 2); sx += __shfl_xor(sx, 4); sx += __shfl_xor(sx, 8); sv[jj] = sx; }
                if (r16 == 0) *(f32x4*)(kpart + (size_t)(tm * 2 + wm) * 256 + (tn - 2) * 128 + wn * 64 + nt * 16 + quad * 4) = sv;
            }
        }
#pragma unroll
        for (int mt = 0; mt < 4; ++mt)
#pragma unroll
            for (int nt = 0; nt < 4; ++nt) { u32x2 pk; pk.x = pack2(acc[mt][nt][0], acc[mt][nt][1]); pk.y = pack2(acc[mt][nt][2], acc[mt][nt][3]);
                const int row = wm * 64 + mt * 16 + r16; const int c16 = wn * 8 + nt * 2 + (quad >> 1);
                *(u32x2*)(sC + row * 256 + ((c16 ^ (row & 15)) << 4) + (quad & 1) * 8) = pk; }
        __syncthreads();
#pragma unroll
        for (int i = 0; i < 8; ++i) { const int c = t + 256 * i; const int row = c >> 4, ch = c & 15; const int col = tn * 128 + ch * 8;
            if (col < DIN) *(u32x4*)(z + (size_t)(tm * 128 + row) * ZP + col) = *(const u32x4*)(sC + row * 256 + ((ch ^ (row & 15)) << 4)); }
    }
}

__device__ void g2_phase(const Params& p, int l, char* smem) {
    const int t = tid_opq(), lane = t & 63, w = t >> 6, wm = w >> 1, wn = w & 1, r16 = lane & 15, quad = lane >> 4;
    char* sm = smem; char* sC = smem + 32768;
    const bf16_t* mix = (const bf16_t*)(p.ws + WS_U); const bf16_t* WoutT = (const bf16_t*)(p.ws + WS_WOUTT) + (size_t)l * 1024 * 1024;
    bf16_t* ybuf = (bf16_t*)(p.ws + WS_Z);
    const bool xo = (gridDim.x & 7) == 0; const int xcd = blockIdx.x & 7, nloc = xo ? (int)(gridDim.x >> 3) : (int)gridDim.x, j0 = xo ? (int)(blockIdx.x >> 3) : (int)blockIdx.x;
    const int lim = xo ? 16 * 8 : 128 * 8;
    RegSet r0, r1;
    for (int L = j0; L < lim; L += nloc) {
        const int tm = xo ? xcd * 16 + (L & 15) : (L >> 3), tn = xo ? (L >> 4) : (L & 7);
        const int L2 = L + nloc; const bool has_next = L2 < lim;
        const int ntm = has_next ? (xo ? xcd * 16 + (L2 & 15) : (L2 >> 3)) : tm, ntn = has_next ? (xo ? (L2 >> 4) : (L2 & 7)) : tn;
        f32x4 acc[4][4];
        gemm_tile(mix, WoutT, tm, tn, L == j0, has_next, ntm, ntn, sm, acc, r0, r1);
#pragma unroll
        for (int mt = 0; mt < 4; ++mt)
#pragma unroll
            for (int nt = 0; nt < 4; ++nt) { u32x2 pk; pk.x = pack2(acc[mt][nt][0], acc[mt][nt][1]); pk.y = pack2(acc[mt][nt][2], acc[mt][nt][3]);
                const int row = wm * 64 + mt * 16 + r16; const int c16 = wn * 8 + nt * 2 + (quad >> 1);
                *(u32x2*)(sC + row * 256 + ((c16 ^ (row & 15)) << 4) + (quad & 1) * 8) = pk; }
        __syncthreads();
#pragma unroll
        for (int i = 0; i < 8; ++i) { const int c = t + 256 * i; const int row = c >> 4, ch = c & 15;
            *(u32x4*)(ybuf + (size_t)(tm * 128 + row) * 1024 + tn * 128 + ch * 8) = *(const u32x4*)(sC + row * 256 + ((ch ^ (row & 15)) << 4)); }
    }
}

constexpr float ATT_SC = 0.18033688011112042f;
template <int QT>
__device__ __forceinline__ void attn_tile(const bf16_t* sK, const bf16_t* sV, const bf16x8 (&qf)[QT][2], int lo, int hi, bool full, bool hasq, bool qfl0, bool qfl1,
                                          float (&m)[QT], float (&l)[QT], f32x4 (&O)[QT][4], int wq0) {
    const int lane = tid_opq() & 63, r16 = lane & 15, quad = lane >> 4;
    f32x4 s[QT][4];
#pragma unroll
    for (int a = 0; a < QT; ++a)
#pragma unroll
        for (int b = 0; b < 4; ++b) s[a][b] = (f32x4){0.f, 0.f, 0.f, 0.f};
#pragma unroll
    for (int ks = 0; ks < 2; ++ks)
#pragma unroll
        for (int k16 = 0; k16 < 4; ++k16) {
            const bf16x8 kf = *(const bf16x8*)(sK + (k16 * 16 + r16) * LDP + ks * 32 + quad * 8);
#pragma unroll
            for (int qt = 0; qt < QT; ++qt) s[qt][k16] = __builtin_amdgcn_mfma_f32_16x16x32_bf16(kf, qf[qt][ks], s[qt][k16], 0, 0, 0);
        }
#pragma unroll
    for (int qt = 0; qt < QT; ++qt) {
        const int ql = wq0 + qt * 16 + r16; const bool qfl = qt ? qfl1 : qfl0;
        if (!full) {
#pragma unroll
            for (int k16 = 0; k16 < 4; ++k16)
#pragma unroll
                for (int j = 0; j < 4; ++j) { const int dd = ql - (k16 * 16 + quad * 4 + j); const bool valid = dd >= lo && dd <= hi; s[qt][k16][j] = valid ? s[qt][k16][j] : -1e30f; }
        }
        if (hasq) {
#pragma unroll
            for (int k16 = 0; k16 < 4; ++k16)
#pragma unroll
                for (int j = 0; j < 4; ++j) s[qt][k16][j] = qfl ? s[qt][k16][j] : -1e30f;
        }
        float mx = -1e30f;
#pragma unroll
        for (int k16 = 0; k16 < 4; ++k16) mx = fmaxf(mx, fmaxf(fmaxf(s[qt][k16][0], s[qt][k16][1]), fmaxf(s[qt][k16][2], s[qt][k16][3])));
        mx = fmaxf(mx, __shfl_xor(mx, 16)); mx = fmaxf(mx, __shfl_xor(mx, 32));
        const float mn = fmaxf(m[qt], mx); const float alpha = __builtin_amdgcn_exp2f((m[qt] - mn) * ATT_SC); m[qt] = mn;
        const float mb = (mn < -1e29f) ? 0.f : mn * ATT_SC;
        float ps = 0.f;
#pragma unroll
        for (int k16 = 0; k16 < 4; ++k16)
#pragma unroll
            for (int j = 0; j < 4; ++j) { const float pv = __builtin_amdgcn_exp2f(s[qt][k16][j] * ATT_SC - mb); ps += pv; s[qt][k16][j] = pv; }
        l[qt] = l[qt] * alpha + ps;
#pragma unroll
        for (int dt = 0; dt < 4; ++dt) O[qt][dt] = O[qt][dt] * alpha;
    }
#pragma unroll
    for (int G = 0; G < 2; ++G) {
        bf16x8 pf[QT];
#pragma unroll
        for (int qt = 0; qt < QT; ++qt) {
            const unsigned a0 = pack2(s[qt][G * 2][0], s[qt][G * 2][1]), a1 = pack2(s[qt][G * 2][2], s[qt][G * 2][3]);
            const unsigned a2 = pack2(s[qt][G * 2 + 1][0], s[qt][G * 2 + 1][1]), a3 = pack2(s[qt][G * 2 + 1][2], s[qt][G * 2 + 1][3]);
            u32x4 pk = {a0, a1, a2, a3}; pf[qt] = __builtin_bit_cast(bf16x8, pk);
        }
#pragma unroll
        for (int dt = 0; dt < 4; ++dt) {
            const bf16_t* v0p = sV + (G * 32 + quad * 4 + (r16 >> 2)) * LDP + dt * 16 + (r16 & 3) * 4;
            const bf16x4 v0 = __builtin_amdgcn_ds_read_tr16_b64_v4i16((__attribute__((address_space(3))) bf16x4*)(v0p));
            const bf16x4 v1 = __builtin_amdgcn_ds_read_tr16_b64_v4i16((__attribute__((address_space(3))) bf16x4*)(v0p + 16 * LDP));
            const bf16x8 vf = {v0[0], v0[1], v0[2], v0[3], v1[0], v1[1], v1[2], v1[3]};
#pragma unroll
            for (int qt = 0; qt < QT; ++qt) O[qt][dt] = __builtin_amdgcn_mfma_f32_16x16x32_bf16(vf, pf[qt], O[qt][dt], 0, 0, 0);
        }
    }
}

__device__ void attn_item(const Params& p, int kind, int idx, char* smem) {
    const int t = tid_opq(), lane = t & 63, w = t >> 6, r16 = lane & 15, quad = lane >> 4;
    bf16_t* sK = (bf16_t*)smem; bf16_t* sV = sK + 64 * LDP;
    float* kmean = (float*)(smem + 18432); float* gates = (float*)(smem + 22528); unsigned* selm = (unsigned*)(smem + 30720);
    int4* desc = (int4*)(smem + 31232); int* misc = (int*)(smem + 32320);
    const bf16_t* z = (const bf16_t*)(p.ws + WS_Z);
    int b, h, qbase, stride, qcol, kcol, vcol, cfg = 0;
    __syncthreads();
    if (kind == 0) {
        const int n = 15 - (idx >> 5); const int rem = idx & 31; b = rem >> 3; h = (rem >> 1) & 3; const int qh = rem & 1;
        qbase = b * S + n * 256 + qh * 128; stride = 1; qcol = C_AQ + h * 64; kcol = C_AK + h * 64; vcol = C_AV + h * 64;
        const float* kpart = (const float*)(p.ws + WS_KPART);
        for (int e = t; e < n * 64; e += 256) { const int j = e >> 6, d = e & 63; const float* kp = kpart + (size_t)(b * 64 + j * 4) * 256 + h * 64 + d;
            kmean[e] = ((kp[0] + kp[256]) + (kp[512] + kp[768])) * (1.f / 256.f); }
        if (t == 0) misc[1] = 0;
        __syncthreads();
        {
            const int ql = t >> 1, half = t & 1; const bf16_t* qp = z + (size_t)(qbase + ql) * ZP + qcol;
            float g[8];
#pragma unroll
            for (int jj = 0; jj < 8; ++jj) g[jj] = 0.f;
#pragma unroll 1
            for (int dc = 0; dc < 8; ++dc) {
                const u32x4 qv = *(const u32x4*)(qp + dc * 8); float qq[8];
#pragma unroll
                for (int e = 0; e < 4; ++e) { qq[2 * e] = __uint_as_float(qv[e] << 16); qq[2 * e + 1] = __uint_as_float(qv[e] & 0xffff0000u); }
#pragma unroll
                for (int jj = 0; jj < 8; ++jj) { const int j = half + 2 * jj; if (j < n) { const float* km = kmean + j * 64 + dc * 8;
#pragma unroll
                    for (int e = 0; e < 8; ++e) g[jj] += qq[e] * km[e]; } }
            }
#pragma unroll
            for (int jj = 0; jj < 8; ++jj) gates[ql * 16 + half + 2 * jj] = g[jj];
        }
        __syncthreads();
        if (t < 128) {
            unsigned msk = 0;
            for (int k = 0; k < 3 && k < n; ++k) { float best = -3.0e38f; int bi = -1;
                for (int j = 0; j < n; ++j) if (!((msk >> j) & 1u)) { const float gv = gates[t * 16 + j]; if (gv > best) { best = gv; bi = j; } }
                if (bi >= 0) msk |= 1u << bi; }
            selm[t] = msk; atomicOr((unsigned*)&misc[1], msk);
        }
        __syncthreads();
        if (t == 0) {
            int nd = 0; const unsigned bm = (unsigned)misc[1];
            for (int kt = 0; kt <= qh * 2 + 1; ++kt) desc[nd++] = make_int4(b * S + n * 256 + kt * 64, kt * 64 - qh * 128, BIG, -1);
            for (int j = 0; j < n; ++j) if ((bm >> j) & 1u) for (int kt = 0; kt < 4; ++kt) desc[nd++] = make_int4(b * S + j * 256 + kt * 64, -BIG, BIG, j);
            misc[0] = nd;
        }
    } else {
        cfg = idx >> 9; const int rem = idx & 511; b = rem >> 7; h = (rem >> 5) & 3; const int rb = rem & 31;
        const int dil = 1 << (2 * cfg); const int res = rb & (dil - 1), blk = rb >> (2 * cfg);
        qbase = b * S + blk * 128 * dil + res; stride = dil; qcol = C_CQ + h * 64; kcol = C_CK + h * 64; vcol = C_CV + h * 64;
        if (t < 128) selm[t] = 0xffffffffu;
        if (t == 0) { int nd = 0; for (int kt = (blk == 0 ? 2 : 0); kt < 4; ++kt) desc[nd++] = make_int4(b * S + (blk * 128 - 128 + kt * 64) * dil + res, kt * 64 - 128, kt * 64, -1); misc[0] = nd; }
    }
    __syncthreads();
    const int nd = misc[0];
    bf16x8 qf[2][2];
#pragma unroll
    for (int qt = 0; qt < 2; ++qt)
#pragma unroll
        for (int ks = 0; ks < 2; ++ks) qf[qt][ks] = *(const bf16x8*)(z + (size_t)(qbase + (w * 32 + qt * 16 + r16) * stride) * ZP + qcol + ks * 32 + quad * 8);
    const unsigned sel0 = selm[w * 32 + r16], sel1 = selm[w * 32 + 16 + r16];
    float m[2] = {-1e30f, -1e30f}, l[2] = {0.f, 0.f}; f32x4 O[2][4];
#pragma unroll
    for (int a = 0; a < 2; ++a)
#pragma unroll
        for (int c = 0; c < 4; ++c) O[a][c] = (f32x4){0.f, 0.f, 0.f, 0.f};
    const int lrow = t >> 2, lch = (t & 3) * 2;
    u32x4 rk0, rk1, rv0, rv1;
    if (nd > 0) { const int4 d = desc[0]; const bf16_t* rp = z + (size_t)(d.x + lrow * stride) * ZP + lch * 8;
        rk0 = *(const u32x4*)(rp + kcol); rk1 = *(const u32x4*)(rp + kcol + 8); rv0 = *(const u32x4*)(rp + vcol); rv1 = *(const u32x4*)(rp + vcol + 8); }
    for (int i = 0; i < nd; ++i) {
        __syncthreads();
        *(u32x4*)(sK + lrow * LDP + lch * 8) = rk0; *(u32x4*)(sK + lrow * LDP + lch * 8 + 8) = rk1;
        *(u32x4*)(sV + lrow * LDP + lch * 8) = rv0; *(u32x4*)(sV + lrow * LDP + lch * 8 + 8) = rv1;
        __syncthreads();
        if (i + 1 < nd) { const int4 d = desc[i + 1]; const bf16_t* rp = z + (size_t)(d.x + lrow * stride) * ZP + lch * 8;
            rk0 = *(const u32x4*)(rp + kcol); rk1 = *(const u32x4*)(rp + kcol + 8); rv0 = *(const u32x4*)(rp + vcol); rv1 = *(const u32x4*)(rp + vcol + 8); }
        const int4 d = desc[i];
        bool need = (w * 32 + 31 >= d.y) && (w * 32 - 63 <= d.z);
        bool q0 = true, q1 = true;
        if (d.w >= 0) { q0 = (sel0 >> d.w) & 1u; q1 = (sel1 >> d.w) & 1u; need = need && (__ballot(q0 || q1) != 0ull); }
        const bool full = (w * 32 - 63 >= d.y) && (w * 32 + 31 <= d.z);
        if (need) attn_tile<2>(sK, sV, qf, d.y, d.z, full, d.w >= 0, q0, q1, m, l, O, w * 32);
    }
#pragma unroll
    for (int qt = 0; qt < 2; ++qt) {
        float lt = l[qt]; lt += __shfl_xor(lt, 16); lt += __shfl_xor(lt, 32);
        const float inv = 1.f / lt; const size_t tok = (size_t)(qbase + (w * 32 + qt * 16 + r16) * stride);
        if (kind == 0) {
            bf16_t* mix = (bf16_t*)(p.ws + WS_U);
#pragma unroll
            for (int dt = 0; dt < 4; ++dt) { const int d0 = dt * 16 + quad * 4; const u32x2 gv = *(const u32x2*)(z + tok * ZP + C_AG + h * 64 + d0);
                const float g0 = __uint_as_float(gv.x << 16), g1 = __uint_as_float(gv.x & 0xffff0000u), g2 = __uint_as_float(gv.y << 16), g3 = __uint_as_float(gv.y & 0xffff0000u);
                u32x2 o; o.x = pack2(O[qt][dt][0] * inv * silu_f(g0), O[qt][dt][1] * inv * silu_f(g1)); o.y = pack2(O[qt][dt][2] * inv * silu_f(g2), O[qt][dt][3] * inv * silu_f(g3));
                *(u32x2*)(mix + tok * 1024 + h * 64 + d0) = o; }
        } else {
            bf16_t* dilo = (bf16_t*)(p.ws + WS_DILO); float* dill = (float*)(p.ws + WS_DILL);
#pragma unroll
            for (int dt = 0; dt < 4; ++dt) { const int d0 = dt * 16 + quad * 4; u32x2 o; o.x = pack2(O[qt][dt][0] * inv, O[qt][dt][1] * inv); o.y = pack2(O[qt][dt][2] * inv, O[qt][dt][3] * inv);
                *(u32x2*)(dilo + ((size_t)cfg * T + tok) * 256 + h * 64 + d0) = o; }
            if (quad == 0) dill[((size_t)cfg * T + tok) * 4 + h] = m[qt] * 0.125f + __logf(lt);
        }
    }
}

__device__ void moba_item(const Params& p, int idx, char* smem, bf16_t* outp) {
    const int t = tid_opq(), lane = t & 63, w = t >> 6, r16 = lane & 15, quad = lane >> 4;
    bf16_t* sK = (bf16_t*)smem; bf16_t* sV = sK + 64 * LDP;
    float* stO = (float*)(smem + 18432);
    float* kmean = (float*)(smem + 18432); float* gates = (float*)(smem + 22528);
    float* stM = (float*)(smem + 53248); float* stL = (float*)(smem + 53760);
    unsigned* selm = (unsigned*)(smem + 54272); unsigned char* lists = (unsigned char*)(smem + 54784);
    int* cnt = (int*)(smem + 56832); int4* desc = (int4*)(smem + 56960); int* misc = (int*)(smem + 59008);
    const bf16_t* z = (const bf16_t*)(p.ws + WS_Z);
    const int n = 15 - (idx >> 5); const int rem = idx & 31; const int b = rem >> 3, h = (rem >> 1) & 3, qh = rem & 1;
    const int qbase = b * S + n * 256 + qh * 128, qcol = C_AQ + h * 64, kcol = C_AK + h * 64, vcol = C_AV + h * 64;
    __syncthreads();
    {
        const float* kpart = (const float*)(p.ws + WS_KPART);
        for (int e = t; e < n * 64; e += 256) { const int j = e >> 6, d = e & 63; const float* kp = kpart + (size_t)(b * 64 + j * 4) * 256 + h * 64 + d;
            kmean[e] = ((kp[0] + kp[256]) + (kp[512] + kp[768])) * (1.f / 256.f); }
        if (t < 16) cnt[t] = 0;
        __syncthreads();
        {
            const int ql = t >> 1, half = t & 1; const bf16_t* qp = z + (size_t)(qbase + ql) * ZP + qcol;
            float g[8];
#pragma unroll
            for (int jj = 0; jj < 8; ++jj) g[jj] = 0.f;
#pragma unroll 1
            for (int dc = 0; dc < 8; ++dc) {
                const u32x4 qv = *(const u32x4*)(qp + dc * 8); float qq[8];
#pragma unroll
                for (int e = 0; e < 4; ++e) { qq[2 * e] = __uint_as_float(qv[e] << 16); qq[2 * e + 1] = __uint_as_float(qv[e] & 0xffff0000u); }
#pragma unroll
                for (int jj = 0; jj < 8; ++jj) { const int j = half + 2 * jj; if (j < n) { const float* km = kmean + j * 64 + dc * 8;
#pragma unroll
                    for (int e = 0; e < 8; ++e) g[jj] += qq[e] * km[e]; } }
            }
#pragma unroll
            for (int jj = 0; jj < 8; ++jj) gates[ql * 16 + half + 2 * jj] = g[jj];
        }
        __syncthreads();
        if (t < 128) {
            unsigned msk = 0;
            for (int k = 0; k < 3 && k < n; ++k) { float best = -3.0e38f; int bi = -1;
                for (int j = 0; j < n; ++j) if (!((msk >> j) & 1u)) { const float gv = gates[t * 16 + j]; if (gv > best) { best = gv; bi = j; } }
                if (bi >= 0) msk |= 1u << bi; }
            selm[t] = msk;
            for (int j = 0; j < n; ++j) if ((msk >> j) & 1u) { const int pos = atomicAdd(&cnt[j], 1); lists[j * 128 + pos] = (unsigned char)t; }
        }
        __syncthreads();
        if (t < 128) { for (int j = 0; j < n; ++j) { const int cj = cnt[j]; if (t >= cj && t < ((cj + 15) & ~15)) lists[j * 128 + t] = 255; } }
        {
            const int nown_ = qh * 2 + 2;
            if (t < nown_) desc[t] = make_int4(b * S + n * 256 + t * 64, t * 64 - qh * 128, BIG, -1);
            if (t < 16) {
                int base = nown_; for (int j2 = 0; j2 < t && j2 < n; ++j2) base += ((((cnt[j2] + 15) >> 4) + 3) >> 2) * 4;
                if (t < n) { const int npass = ((((cnt[t] + 15) >> 4) + 3) >> 2);
                    for (int ps = 0; ps < npass; ++ps) for (int kt = 0; kt < 4; ++kt) desc[base + ps * 4 + kt] = make_int4(b * S + t * 256 + kt * 64, ps, kt, t); }
                if (t == 15) { misc[0] = base + ((15 < n) ? ((((cnt[15] + 15) >> 4) + 3) >> 2) * 4 : 0); misc[1] = nown_; }
            }
        }
    }
    __syncthreads();
    const int nd = misc[0], nown = misc[1];
    const int lrow = t >> 2, lch = (t & 3) * 2;
    u32x4 rk0, rk1, rv0, rv1;
    { const int4 d = desc[0]; const bf16_t* rp = z + (size_t)(d.x + lrow) * ZP + lch * 8;
      rk0 = *(const u32x4*)(rp + kcol); rk1 = *(const u32x4*)(rp + kcol + 8); rv0 = *(const u32x4*)(rp + vcol); rv1 = *(const u32x4*)(rp + vcol + 8); }
    bf16x8 nqf[2]; int ngq = 0; bool ngv = false, nhas = false;
    auto prefetch_group = [&](int gi) {
        nhas = false;
        if (gi < nd) { const int4 dg = desc[gi]; const int slot = dg.y * 4 + w; nhas = slot * 16 < cnt[dg.w];
            if (nhas) { const int qi = lists[dg.w * 128 + slot * 16 + r16]; ngv = qi != 255; ngq = ngv ? qi : 0;
#pragma unroll
                for (int ks = 0; ks < 2; ++ks) nqf[ks] = *(const bf16x8*)(z + (size_t)(qbase + ngq) * ZP + qcol + ks * 32 + quad * 8); } }
    };
    prefetch_group(nown);
    {
        bf16x8 qf[2][2];
#pragma unroll
        for (int qt = 0; qt < 2; ++qt)
#pragma unroll
            for (int ks = 0; ks < 2; ++ks) qf[qt][ks] = *(const bf16x8*)(z + (size_t)(qbase + w * 32 + qt * 16 + r16) * ZP + qcol + ks * 32 + quad * 8);
        float m[2] = {-1e30f, -1e30f}, l[2] = {0.f, 0.f}; f32x4 O[2][4];
#pragma unroll
        for (int a = 0; a < 2; ++a)
#pragma unroll
            for (int c = 0; c < 4; ++c) O[a][c] = (f32x4){0.f, 0.f, 0.f, 0.f};
        for (int i = 0; i < nown; ++i) {
            __syncthreads();
            *(u32x4*)(sK + lrow * LDP + lch * 8) = rk0; *(u32x4*)(sK + lrow * LDP + lch * 8 + 8) = rk1;
            *(u32x4*)(sV + lrow * LDP + lch * 8) = rv0; *(u32x4*)(sV + lrow * LDP + lch * 8 + 8) = rv1;
            __syncthreads();
            if (i + 1 < nd) { const int4 d = desc[i + 1]; const bf16_t* rp = z + (size_t)(d.x + lrow) * ZP + lch * 8;
                rk0 = *(const u32x4*)(rp + kcol); rk1 = *(const u32x4*)(rp + kcol + 8); rv0 = *(const u32x4*)(rp + vcol); rv1 = *(const u32x4*)(rp + vcol + 8); }
            const int4 d = desc[i];
            const bool need = (w * 32 + 31 >= d.y) && (w * 32 - 63 <= d.z);
            const bool full = (w * 32 - 63 >= d.y) && (w * 32 + 31 <= d.z);
            if (need) attn_tile<2>(sK, sV, qf, d.y, d.z, full, false, true, true, m, l, O, w * 32);
        }
#pragma unroll
        for (int qt = 0; qt < 2; ++qt) {
            float lt = l[qt]; lt += __shfl_xor(lt, 16); lt += __shfl_xor(lt, 32);
            const int ql = w * 32 + qt * 16 + r16;
            if (quad == 0) { stM[ql] = m[qt]; stL[ql] = lt; }
#pragma unroll
            for (int dt = 0; dt < 4; ++dt) *(f32x4*)(stO + ql * 68 + dt * 16 + quad * 4) = O[qt][dt];
        }
    }
    {
        bf16x8 qf[1][2]; float m[1] = {-1e30f}, l[1] = {0.f}; f32x4 O[1][4];
        int gq = 0; bool gv = false, has = false;
        for (int i = nown; i < nd; ++i) {
            __syncthreads();
            *(u32x4*)(sK + lrow * LDP + lch * 8) = rk0; *(u32x4*)(sK + lrow * LDP + lch * 8 + 8) = rk1;
            *(u32x4*)(sV + lrow * LDP + lch * 8) = rv0; *(u32x4*)(sV + lrow * LDP + lch * 8 + 8) = rv1;
            __syncthreads();
            if (i + 1 < nd) { const int4 d = desc[i + 1]; const bf16_t* rp = z + (size_t)(d.x + lrow) * ZP + lch * 8;
                rk0 = *(const u32x4*)(rp + kcol); rk1 = *(const u32x4*)(rp + kcol + 8); rv0 = *(const u32x4*)(rp + vcol); rv1 = *(const u32x4*)(rp + vcol + 8); }
            const int4 d = desc[i];
            if (d.z == 0) {
                has = nhas; gv = ngv; gq = ngq; qf[0][0] = nqf[0]; qf[0][1] = nqf[1];
                m[0] = -1e30f; l[0] = 0.f;
#pragma unroll
                for (int c = 0; c < 4; ++c) O[0][c] = (f32x4){0.f, 0.f, 0.f, 0.f};
                prefetch_group(i + 4);
            }
            if (has) {
                attn_tile<1>(sK, sV, qf, -BIG, BIG, true, false, true, true, m, l, O, 0);
                if (d.z == 3) {
                    float lt = l[0]; lt += __shfl_xor(lt, 16); lt += __shfl_xor(lt, 32);
                    if (gv) {
                        const float mo = stM[gq], lo_ = stL[gq]; const float mn = fmaxf(mo, m[0]);
                        const float fa = __builtin_amdgcn_exp2f((mo - mn) * ATT_SC), fb = __builtin_amdgcn_exp2f((m[0] - mn) * ATT_SC);
#pragma unroll
                        for (int dt = 0; dt < 4; ++dt) { float* sp = stO + gq * 68 + dt * 16 + quad * 4; const f32x4 so = *(const f32x4*)sp; *(f32x4*)sp = so * fa + O[0][dt] * fb; }
                        if (quad == 0) { stM[gq] = mn; stL[gq] = lo_ * fa + lt * fb; }
                    }
                }
            }
        }
    }
    __syncthreads();
#pragma unroll
    for (int qt = 0; qt < 2; ++qt) {
        const int ql = w * 32 + qt * 16 + r16; const float inv = 1.f / stL[ql]; const size_t tok = (size_t)(qbase + ql);
#pragma unroll
        for (int dt = 0; dt < 4; ++dt) { const int d0 = dt * 16 + quad * 4; const f32x4 ov = *(const f32x4*)(stO + ql * 68 + d0);
            const u32x2 gvv = *(const u32x2*)(z + tok * ZP + C_AG + h * 64 + d0);
            const float g0 = __uint_as_float(gvv.x << 16), g1 = __uint_as_float(gvv.x & 0xffff0000u), g2 = __uint_as_float(gvv.y << 16), g3 = __uint_as_float(gvv.y & 0xffff0000u);
            u32x2 o; o.x = pack2(ov[0] * inv * silu_f(g0), ov[1] * inv * silu_f(g1)); o.y = pack2(ov[2] * inv * silu_f(g2), ov[3] * inv * silu_f(g3));
            *(u32x2*)(outp + tok * 1024 + h * 64 + d0) = o; }
    }
}

__device__ __forceinline__ void gla_bcum(const Params& p, int l, const bf16_t* z, int tok0, float* bc, float* drs) {
    const int t = tid_opq();
    const int hd = t & 127, ih = t >> 7;
    float wr[16];
#pragma unroll
    for (int r = 0; r < 16; ++r) wr[r] = p.gla_wr[l * 2048 + r * 128 + hd];
    const float br = p.gla_br[l * 128 + hd];
    { const int e0 = t, e1 = t + 256; const bf16_t d0 = z[(size_t)(tok0 + (e0 >> 4)) * ZP + C_DR + (e0 & 15)], d1 = z[(size_t)(tok0 + (e1 >> 4)) * ZP + C_DR + (e1 & 15)];
      drs[e0] = bf2f(d0); drs[e1] = bf2f(d1); }
    __syncthreads();
#pragma unroll
    for (int ii = 0; ii < 16; ++ii) { const int i = ih * 16 + ii; float x = br;
#pragma unroll
        for (int r4 = 0; r4 < 4; ++r4) { const f32x4 dv = *(const f32x4*)(drs + i * 16 + r4 * 4); x += (dv[0] * wr[r4 * 4] + dv[1] * wr[r4 * 4 + 1]) + (dv[2] * wr[r4 * 4 + 2] + dv[3] * wr[r4 * 4 + 3]); }
        bc[i * 128 + hd] = (fminf(x, 0.f) - __logf(1.f + __expf(-fabsf(x)))) * (1.f / 16.f); }
    __syncthreads();
    if (t < 128) { float sacc = 0.f;
#pragma unroll
        for (int i = 0; i < 32; ++i) { sacc += bc[i * 128 + t]; bc[i * 128 + t] = sacc; } }
    __syncthreads();
}

__device__ void gla1_item(const Params& p, int l, int idx, char* smem) {
    const int t = tid_opq(), lane = t & 63, w = t >> 6, r16 = lane & 15, quad = lane >> 4;
    const int b = idx >> 7, c = idx & 127; const int tok0 = b * S + c * 32;
    const bf16_t* z = (const bf16_t*)(p.ws + WS_Z);
    float* bc = (float*)smem; float* drs = (float*)(smem + 16384);
    bf16_t* kdT = (bf16_t*)(smem + 18432) + w * 1024;
    bf16_t* vL = (bf16_t*)(smem + 26624) + w * (32 * LDP);
    float* gkv = (float*)(p.ws + WS_GKV); float* gdec = (float*)(p.ws + WS_GDEC);
    bf16_t kraw[16]; u32x4 vr[4];
#pragma unroll
    for (int i = 0; i < 16; ++i) { const int e = lane + 64 * i; kraw[i] = z[(size_t)(tok0 + (e >> 5)) * ZP + C_DK + w * 32 + (e & 31)]; }
#pragma unroll
    for (int i = 0; i < 4; ++i) { const int cc = lane + 64 * i; vr[i] = *(const u32x4*)(z + (size_t)(tok0 + (cc >> 3)) * ZP + C_DV + w * 64 + (cc & 7) * 8); }
    __syncthreads();
#pragma unroll
    for (int i = 0; i < 4; ++i) { const int cc = lane + 64 * i; *(u32x4*)(vL + (cc >> 3) * LDP + (cc & 7) * 8) = vr[i]; }
    gla_bcum(p, l, z, tok0, bc, drs);
    { float* bcg = (float*)(p.ws + WS_BC) + (size_t)idx * 4096;
#pragma unroll
      for (int i = 0; i < 4; ++i) *(f32x4*)(bcg + (t + 256 * i) * 4) = *(const f32x4*)(bc + (t + 256 * i) * 4); }
#pragma unroll
    for (int i = 0; i < 16; ++i) { const int e = lane + 64 * i; const int j = e >> 5, d = e & 31;
        kdT[d * 32 + j] = f2bf(bf2f(kraw[i]) * __expf(bc[31 * 128 + w * 32 + d] - bc[j * 128 + w * 32 + d])); }
    const int bh = b * 4 + w;
    if (lane < 32) gdec[(bh * 128 + c) * 32 + lane] = __expf(bc[31 * 128 + w * 32 + lane]);
    __syncthreads();
    bf16x8 kf[2];
#pragma unroll
    for (int x = 0; x < 2; ++x) kf[x] = *(const bf16x8*)(kdT + (x * 16 + r16) * 32 + quad * 8);
    float* dst = gkv + (size_t)(bh * 128 + c) * 2048;
#pragma unroll
    for (int dt = 0; dt < 4; ++dt) {
        const bf16_t* v0p = vL + (quad * 8 + (r16 >> 2)) * LDP + dt * 16 + (r16 & 3) * 4;
        const bf16x4 v0 = __builtin_amdgcn_ds_read_tr16_b64_v4i16((__attribute__((address_space(3))) bf16x4*)(v0p));
        const bf16x4 v1 = __builtin_amdgcn_ds_read_tr16_b64_v4i16((__attribute__((address_space(3))) bf16x4*)(v0p + 4 * LDP));
        const bf16x8 vf = {v0[0], v0[1], v0[2], v0[3], v1[0], v1[1], v1[2], v1[3]};
#pragma unroll
        for (int x = 0; x < 2; ++x) {
            const f32x4 r = __builtin_amdgcn_mfma_f32_16x16x32_bf16(vf, kf[x], (f32x4){0.f, 0.f, 0.f, 0.f}, 0, 0, 0);
            *(f32x4*)(dst + (x * 16 + r16) * 64 + dt * 16 + quad * 4) = r;
        }
    }
}

#define OPQ(ptr) asm volatile("" : "+v"(ptr))
__device__ void gla3_item(const Params& p, int l, int idx, char* smem) {
    const int t = tid_opq(), lane = t & 63, w = t >> 6, r16 = lane & 15, quad = lane >> 4;
    const int b = idx >> 7, c = idx & 127; const int tok0 = b * S + c * 32;
    const bf16_t* z = (const bf16_t*)(p.ws + WS_Z); bf16_t* mix = (bf16_t*)(p.ws + WS_U);
    float* bc = (float*)smem; float* drs = (float*)(smem + 16384);
    bf16_t* SL = (bf16_t*)smem + w * (32 * LDP);
    bf16_t* qe = (bf16_t*)(smem + 18432) + w * 1024;
    bf16_t* ke = (bf16_t*)(smem + 26624) + w * 1024;
    bf16_t* vL = (bf16_t*)(smem + 34816) + w * (32 * LDP);
    const float* gkv = (const float*)(p.ws + WS_GKV);
    const int bh = b * 4 + w;
    bf16_t qraw[16], kraw[16];
    { const bf16_t* qp = z + (size_t)(tok0 + (lane >> 5)) * ZP + w * 32 + (lane & 31);
#pragma unroll
      for (int i = 0; i < 16; ++i) { qraw[i] = qp[C_DQ]; kraw[i] = qp[C_DK]; qp += 2 * ZP; OPQ(qp); } }
    u32x4 vr[4]; f32x4 sr[8];
#pragma unroll
    for (int i = 0; i < 4; ++i) { const int cc = lane + 64 * i; vr[i] = *(const u32x4*)(z + (size_t)(tok0 + (cc >> 3)) * ZP + C_DV + w * 64 + (cc & 7) * 8); }
    { const float* Sp = gkv + (size_t)(bh * 128 + c) * 2048;
#pragma unroll
      for (int i = 0; i < 8; ++i) sr[i] = *(const f32x4*)(Sp + (lane + 64 * i) * 4); }
    f32x4 bcr[4];
    { const float* bcg = (const float*)(p.ws + WS_BC) + (size_t)idx * 4096;
#pragma unroll
      for (int i = 0; i < 4; ++i) bcr[i] = *(const f32x4*)(bcg + (t + 256 * i) * 4); }
    __syncthreads();
#pragma unroll
    for (int i = 0; i < 4; ++i) { const int cc = lane + 64 * i; *(u32x4*)(vL + (cc >> 3) * LDP + (cc & 7) * 8) = vr[i]; }
#pragma unroll
    for (int i = 0; i < 4; ++i) *(f32x4*)(bc + (t + 256 * i) * 4) = bcr[i];
    __syncthreads();
#pragma unroll
    for (int i2 = 0; i2 < 16; ++i2) { const int e = lane + 64 * i2; const int i = e >> 5, d = e & 31; const float bcv = bc[i * 128 + w * 32 + d];
        qe[i * 32 + d] = f2bf(bf2f(qraw[i2]) * __expf(bcv) * 0.17677669529663687f); ke[i * 32 + d] = f2bf(bf2f(kraw[i2]) * __expf(-bcv)); }
    __syncthreads();
#pragma unroll
    for (int i = 0; i < 8; ++i) { const int cc = lane + 64 * i; const int d = cc >> 4, v4 = cc & 15; u32x2 pk; pk.x = pack2(sr[i][0], sr[i][1]); pk.y = pack2(sr[i][2], sr[i][3]);
        *(u32x2*)(SL + d * LDP + v4 * 4) = pk; }
    __syncthreads();
    bf16x8 qf[2], kf[2];
#pragma unroll
    for (int x = 0; x < 2; ++x) { qf[x] = *(const bf16x8*)(qe + (x * 16 + r16) * 32 + quad * 8); kf[x] = *(const bf16x8*)(ke + (x * 16 + r16) * 32 + quad * 8); }
    bf16x8 pf[2];
#pragma unroll
    for (int it = 0; it < 2; ++it) {
        f32x4 at[2];
#pragma unroll
        for (int jt = 0; jt < 2; ++jt) { at[jt] = __builtin_amdgcn_mfma_f32_16x16x32_bf16(kf[jt], qf[it], (f32x4){0.f, 0.f, 0.f, 0.f}, 0, 0, 0);
#pragma unroll
            for (int jj = 0; jj < 4; ++jj) at[jt][jj] = (jt * 16 + quad * 4 + jj <= it * 16 + r16) ? at[jt][jj] : 0.f; }
        u32x4 pk = {pack2(at[0][0], at[0][1]), pack2(at[0][2], at[0][3]), pack2(at[1][0], at[1][1]), pack2(at[1][2], at[1][3])};
        pf[it] = __builtin_bit_cast(bf16x8, pk);
    }
    f32x4 O[2][4];
#pragma unroll
    for (int dt = 0; dt < 4; ++dt) {
        const bf16_t* v0p = vL + (quad * 4 + (r16 >> 2)) * LDP + dt * 16 + (r16 & 3) * 4;
        const bf16x4 v0 = __builtin_amdgcn_ds_read_tr16_b64_v4i16((__attribute__((address_space(3))) bf16x4*)(v0p));
        const bf16x4 v1 = __builtin_amdgcn_ds_read_tr16_b64_v4i16((__attribute__((address_space(3))) bf16x4*)(v0p + 16 * LDP));
        const bf16x8 vf = {v0[0], v0[1], v0[2], v0[3], v1[0], v1[1], v1[2], v1[3]};
        const bf16_t* s0p = SL + (quad * 8 + (r16 >> 2)) * LDP + dt * 16 + (r16 & 3) * 4;
        const bf16x4 s0 = __builtin_amdgcn_ds_read_tr16_b64_v4i16((__attribute__((address_space(3))) bf16x4*)(s0p));
        const bf16x4 s1 = __builtin_amdgcn_ds_read_tr16_b64_v4i16((__attribute__((address_space(3))) bf16x4*)(s0p + 4 * LDP));
        const bf16x8 sf = {s0[0], s0[1], s0[2], s0[3], s1[0], s1[1], s1[2], s1[3]};
#pragma unroll
        for (int it = 0; it < 2; ++it) {
            O[it][dt] = __builtin_amdgcn_mfma_f32_16x16x32_bf16(vf, pf[it], (f32x4){0.f, 0.f, 0.f, 0.f}, 0, 0, 0);
            O[it][dt] = __builtin_amdgcn_mfma_f32_16x16x32_bf16(sf, qf[it], O[it][dt], 0, 0, 0);
        }
    }
#pragma unroll
    for (int it = 0; it < 2; ++it) {
        float ss = 0.f;
#pragma unroll
        for (int dt = 0; dt < 4; ++dt) ss += (O[it][dt][0] * O[it][dt][0] + O[it][dt][1] * O[it][dt][1]) + (O[it][dt][2] * O[it][dt][2] + O[it][dt][3] * O[it][dt][3]);
        ss += __shfl_xor(ss, 16); ss += __shfl_xor(ss, 32);
        const float rn = rsqrtf(ss * (1.f / 64.f) + 1e-5f);
        const size_t tok = (size_t)(tok0 + it * 16 + r16);
#pragma unroll
        for (int dt = 0; dt < 4; ++dt) { const int v0i = dt * 16 + quad * 4; const f32x4 gn = *(const f32x4*)(p.gla_gn + l * 64 + v0i);
            const u32x2 gv = *(const u32x2*)(z + tok * ZP + C_DG + w * 64 + v0i);
            const float g0 = __uint_as_float(gv.x << 16), g1 = __uint_as_float(gv.x & 0xffff0000u), g2 = __uint_as_float(gv.y << 16), g3 = __uint_as_float(gv.y & 0xffff0000u);
            u32x2 o; o.x = pack2(O[it][dt][0] * rn * gn[0] * silu_f(g0), O[it][dt][1] * rn * gn[1] * silu_f(g1));
            o.y = pack2(O[it][dt][2] * rn * gn[2] * silu_f(g2), O[it][dt][3] * rn * gn[3] * silu_f(g3));
            *(u32x2*)(mix + tok * 1024 + 768 + w * 64 + v0i) = o; }
    }
}

__device__ void lru1_item(const Params& p, int l, int idx, char* smem) {
    const int t = tid_opq(), lane = t & 63, g = t >> 6, r16 = lane & 15, quad = lane >> 4; const int ch = t;
    const int b = idx >> 7, c = idx & 127; const int s0 = c * 32; const int tok0 = b * S + s0;
    const bf16_t* z = (const bf16_t*)(p.ws + WS_Z); float* xcs = (float*)smem;
    bf16_t* preA = (bf16_t*)(smem + 32768); bf16_t* preX = (bf16_t*)(smem + 49152);
    float* lh = (float*)(p.ws + WS_LH); float* lp = (float*)(p.ws + WS_LP);
    bf16_t xr[35];
#pragma unroll
    for (int i = 0; i < 35; ++i) { const int sidx = s0 + i - 3; xr[i] = (sidx >= 0) ? z[(size_t)(tok0 + i - 3) * ZP + C_BX + ch] : (bf16_t)0; }
    const float cw0 = p.conv_w[l * 1024 + ch], cw1 = p.conv_w[l * 1024 + 256 + ch], cw2 = p.conv_w[l * 1024 + 512 + ch], cw3 = p.conv_w[l * 1024 + 768 + ch];
    const float cb = p.conv_b[l * 256 + ch];
    const bf16_t* lwt = (const bf16_t*)(p.ws + WS_LWT) + (size_t)l * 32768 + g * 4096;
    bf16x8 wfa[4][2], wfx[4][2];
#pragma unroll
    for (int nt = 0; nt < 4; ++nt)
#pragma unroll
        for (int ks = 0; ks < 2; ++ks) { wfa[nt][ks] = *(const bf16x8*)(lwt + (nt * 16 + r16) * 64 + ks * 32 + quad * 8); wfx[nt][ks] = *(const bf16x8*)(lwt + 16384 + (nt * 16 + r16) * 64 + ks * 32 + quad * 8); }
    __syncthreads();
#pragma unroll
    for (int i = 0; i < 32; ++i) xcs[i * 256 + ch] = cb + (cw0 * bf2f(xr[i]) + cw1 * bf2f(xr[i + 1])) + (cw2 * bf2f(xr[i + 2]) + cw3 * bf2f(xr[i + 3]));
    __syncthreads();
#pragma unroll
    for (int tt = 0; tt < 2; ++tt) {
        bf16x8 xf[2];
#pragma unroll
        for (int ks = 0; ks < 2; ++ks) { const float* xp = xcs + (tt * 16 + r16) * 256 + g * 64 + ks * 32 + quad * 8; const f32x4 x0 = *(const f32x4*)xp, x1 = *(const f32x4*)(xp + 4);
            u32x4 pk = {pack2(x0[0], x0[1]), pack2(x0[2], x0[3]), pack2(x1[0], x1[1]), pack2(x1[2], x1[3])}; xf[ks] = __builtin_bit_cast(bf16x8, pk); }
#pragma unroll
        for (int nt = 0; nt < 4; ++nt) {
            f32x4 ra = __builtin_amdgcn_mfma_f32_16x16x32_bf16(wfa[nt][0], xf[0], (f32x4){0.f, 0.f, 0.f, 0.f}, 0, 0, 0); ra = __builtin_amdgcn_mfma_f32_16x16x32_bf16(wfa[nt][1], xf[1], ra, 0, 0, 0);
            f32x4 rx = __builtin_amdgcn_mfma_f32_16x16x32_bf16(wfx[nt][0], xf[0], (f32x4){0.f, 0.f, 0.f, 0.f}, 0, 0, 0); rx = __builtin_amdgcn_mfma_f32_16x16x32_bf16(wfx[nt][1], xf[1], rx, 0, 0, 0);
            u32x2 pa; pa.x = pack2(ra[0], ra[1]); pa.y = pack2(ra[2], ra[3]); u32x2 px; px.x = pack2(rx[0], rx[1]); px.y = pack2(rx[2], rx[3]);
            *(u32x2*)(preA + (tt * 16 + r16) * 256 + g * 64 + nt * 16 + quad * 4) = pa; *(u32x2*)(preX + (tt * 16 + r16) * 256 + g * 64 + nt * 16 + quad * 4) = px;
        }
    }
    __syncthreads();
    const float ba = p.lru_ba[l * 256 + ch], bx = p.lru_bx[l * 256 + ch], lam = p.lru_lam[l * 256 + ch];
    const float sp = fmaxf(-lam, 0.f) + log1pf(__expf(-fabsf(lam)));
    float hh = 0.f, P = 1.f;
    float* lhp = lh + (size_t)tok0 * 256 + ch; float* lpp = lp + (size_t)tok0 * 256 + ch;
#pragma unroll 4
    for (int i = 0; i < 32; ++i) { const float r = sigmoid_f(bf2f(preA[i * 256 + ch]) + ba), ig = sigmoid_f(bf2f(preX[i * 256 + ch]) + bx); const float la = -8.f * r * sp; const float a = __expf(la);
        const float w2 = 2.f * la;
        const float em_s = -w2 * (1.f + w2 * (0.5f + w2 * (0.16666667f + w2 * (0.041666668f + w2 * (0.0083333338f + w2 * 0.0013888889f)))));
        const float em = (w2 > -0.25f) ? em_s : (1.f - a * a);
        const float u = __builtin_amdgcn_sqrtf(em) * (ig * xcs[i * 256 + ch]); hh = a * hh + u; P *= a;
        lhp[(size_t)i * 256] = hh; lpp[(size_t)i * 256] = P; }
}

__device__ void lru3_item(const Params& p, int idx) {
    const int ch = tid_opq(); const int b = idx >> 7, c = idx & 127; const int tok0 = b * S + c * 32;
    const bf16_t* z = (const bf16_t*)(p.ws + WS_Z); bf16_t* mix = (bf16_t*)(p.ws + WS_U);
    const float* lh = (const float*)(p.ws + WS_LH); const float* lp = (const float*)(p.ws + WS_LP); const float* lc = (const float*)(p.ws + WS_LC);
    const float carry = lc[(size_t)(b * 128 + c) * 256 + ch];
    float hv[32], pv[32]; bf16_t gv[32];
#pragma unroll
    for (int i = 0; i < 32; ++i) { const size_t tok = (size_t)(tok0 + i); hv[i] = lh[tok * 256 + ch]; pv[i] = lp[tok * 256 + ch]; gv[i] = z[tok * ZP + C_BG + ch]; }
#pragma unroll
    for (int i = 0; i < 32; ++i) { const size_t tok = (size_t)(tok0 + i); mix[tok * 1024 + 256 + ch] = f2bf((hv[i] + pv[i] * carry) * silu_f(bf2f(gv[i]))); }
}

__device__ void dilc_item(const Params& p, int idx) {
    const int t = tid_opq(); const size_t tok = (size_t)idx * 8 + (t >> 5); const int chn = t & 31; const int h = chn >> 3;
    const bf16_t* z = (const bf16_t*)(p.ws + WS_Z); bf16_t* mix = (bf16_t*)(p.ws + WS_U);
    const bf16_t* dilo = (const bf16_t*)(p.ws + WS_DILO); const float* dill = (const float*)(p.ws + WS_DILL);
    const float l0 = dill[((size_t)0 * T + tok) * 4 + h], l1 = dill[((size_t)1 * T + tok) * 4 + h], l2 = dill[((size_t)2 * T + tok) * 4 + h];
    const float mx = fmaxf(l0, fmaxf(l1, l2)); float w0 = __expf(l0 - mx), w1 = __expf(l1 - mx), w2 = __expf(l2 - mx); const float inv = 1.f / (w0 + w1 + w2); w0 *= inv; w1 *= inv; w2 *= inv;
    const u32x4 o0 = *(const u32x4*)(dilo + ((size_t)0 * T + tok) * 256 + chn * 8), o1 = *(const u32x4*)(dilo + ((size_t)1 * T + tok) * 256 + chn * 8), o2 = *(const u32x4*)(dilo + ((size_t)2 * T + tok) * 256 + chn * 8);
    const u32x4 gv = *(const u32x4*)(z + tok * ZP + C_CG + chn * 8);
    u32x4 r;
#pragma unroll
    for (int e = 0; e < 4; ++e) {
        const float a = w0 * __uint_as_float(o0[e] << 16) + w1 * __uint_as_float(o1[e] << 16) + w2 * __uint_as_float(o2[e] << 16);
        const float bq = w0 * __uint_as_float(o0[e] & 0xffff0000u) + w1 * __uint_as_float(o1[e] & 0xffff0000u) + w2 * __uint_as_float(o2[e] & 0xffff0000u);
        r[e] = pack2(a * silu_f(__uint_as_float(gv[e] << 16)), bq * silu_f(__uint_as_float(gv[e] & 0xffff0000u)));
    }
    *(u32x4*)(mix + tok * 1024 + 512 + chn * 8) = r;
}

__device__ void m2_phase(const Params& p, char* smem) {
    float* gkv = (float*)(p.ws + WS_GKV); const float* gdec = (const float*)(p.ws + WS_GDEC);
    const float* lh = (const float*)(p.ws + WS_LH); const float* lp = (const float*)(p.ws + WS_LP); float* lc = (float*)(p.ws + WS_LC);
    float* aggP = (float*)smem; float* aggS = aggP + 256;
    const int t = tid_opq(); const int e = t & 31, seg = t >> 5;
    for (int it = blockIdx.x; it < 1024 + 32; it += gridDim.x) {
        float a[16], x[16];
        size_t ostride;
        float* outp;
        if (it < 1024) {
            const int gid = it * 32 + e; const int bh = gid >> 11, dv = gid & 2047, d = dv >> 6;
            float* base = gkv + (size_t)bh * 128 * 2048 + dv + (size_t)(seg * 16) * 2048; const float* dc = gdec + (size_t)bh * 128 * 32 + d + (seg * 16) * 32;
#pragma unroll
            for (int k = 0; k < 16; ++k) { x[k] = base[(size_t)k * 2048]; a[k] = dc[k * 32]; }
            outp = base; ostride = 2048;
        } else {
            const int i2 = it - 1024; const int b = i2 >> 3, ch = (i2 & 7) * 32 + e;
#pragma unroll
            for (int k = 0; k < 16; ++k) { const size_t ix = (size_t)(b * S + (seg * 16 + k) * 32 + 31) * 256 + ch; a[k] = lp[ix]; x[k] = lh[ix]; }
            outp = lc + (size_t)(b * 128 + seg * 16) * 256 + ch; ostride = 256;
        }
        float st = 0.f, pr = 1.f;
#pragma unroll
        for (int k = 0; k < 16; ++k) { const float ak = a[k], xk = x[k]; a[k] = pr; x[k] = st; st = ak * st + xk; pr *= ak; }
        __syncthreads();
        aggP[seg * 32 + e] = pr; aggS[seg * 32 + e] = st;
        __syncthreads();
        float carry = 0.f;
        for (int s2 = 0; s2 < seg; ++s2) carry = aggP[s2 * 32 + e] * carry + aggS[s2 * 32 + e];
#pragma unroll
        for (int k = 0; k < 16; ++k) outp[(size_t)k * ostride] = x[k] + a[k] * carry;
    }
}

__global__ void __launch_bounds__(256, 2) fwd_megakernel(Params p) {
    __shared__ __attribute__((aligned(16))) char smem[SMEM_BYTES];
    __shared__ uint4 xb_words;
    __shared__ int s_slot;
    cg::grid_group grid = cg::this_grid();
    if (p.out == nullptr) grid.sync();
    if (threadIdx.x == 0) xb_words = make_uint4(0u, 0u, 0u, 0u);
    __syncthreads();
    const XcdBarrier xb = xcd_barrier_post((unsigned*)(p.ws + WS_CTL), (volatile LAS unsigned*)&xb_words);
    unsigned* cnt = (unsigned*)(p.ws + WS_CNT);
    prologue_phase(p, smem);
    xcd_barrier(xb);
#pragma unroll 1
    for (int l = 0; l < DEPTH; ++l) {
        ln_phase(p, l);
        xcd_barrier(xb);
        g1_phase(p, l, smem);
        xcd_barrier(xb);
        for (;;) { const int it = next_item(cnt + (4 + l) * 64, &s_slot); if (it >= 512) break; lru1_item(p, l, it, smem); }
        { const int xq = blockIdx.x & 7;
          for (;;) { const int li = next_item(cnt + (16 + l * 8 + xq) * 64, &s_slot); if (li >= 64) break;
              const int pr = xq * 2 + ((li >> 1) & 1); moba_item(p, (li >> 2) * 32 + (pr >> 2) * 8 + (pr & 3) * 2 + (li & 1), smem, (bf16_t*)(p.ws + WS_U)); }
          for (;;) { const int li = next_item(cnt + (32 + l * 8 + xq) * 64, &s_slot); if (li >= 192) break;
              const int cfg = li >> 6, r6 = li & 63; const int pr = xq * 2 + (r6 >> 5); attn_item(p, 1, cfg * 512 + (pr >> 2) * 128 + (pr & 3) * 32 + (r6 & 31), smem); } }
        for (;;) { const int it = next_item(cnt + (2 + l) * 64, &s_slot); if (it >= 512) break; gla1_item(p, l, it, smem); }
        xcd_barrier(xb);
        m2_phase(p, smem);
        xcd_barrier(xb);
        for (int it = blockIdx.x; it < 512; it += gridDim.x) gla3_item(p, l, it, smem);
        for (int it = blockIdx.x; it < 512; it += gridDim.x) lru3_item(p, it);
        for (int it = blockIdx.x; it < 2048; it += gridDim.x) dilc_item(p, it);
        xcd_barrier(xb);
        g2_phase(p, l, smem);
        xcd_barrier(xb);
    }
    ln_phase(p, DEPTH);
}

extern "C" void kernel_launch(void* const* d_in, const int* in_sizes, int n_in, void* d_out, int out_size, void* d_ws, size_t ws_size, hipStream_t stream) {
    static int grid_blocks = 0;
    if (!grid_blocks) {
        int dev = 0, cus = 0, per_cu = 0;
        hipGetDevice(&dev);
        hipDeviceGetAttribute(&cus, hipDeviceAttributeMultiprocessorCount, dev);
        hipOccupancyMaxActiveBlocksPerMultiprocessor(&per_cu, (const void*)fwd_megakernel, 256, 0);
        if (per_cu < 1) per_cu = 1;
        if (per_cu > 2) per_cu = 2;
        grid_blocks = cus * per_cu;
        if (ws_size < WS_END) fprintf(stderr, "kernel_launch: workspace too small: %zu < %zu\n", ws_size, (size_t)WS_END);
    }
    Params p{};
    p.x = (const float*)d_in[0]; p.c = (const float*)d_in[1]; p.pos = (const int*)d_in[2];
    p.w_mod = (const float*)d_in[3]; p.b_mod = (const float*)d_in[4]; p.w_in = (const float*)d_in[5];
    p.conv_w = (const float*)d_in[6]; p.conv_b = (const float*)d_in[7]; p.lru_wa = (const float*)d_in[8]; p.lru_ba = (const float*)d_in[9];
    p.lru_wx = (const float*)d_in[10]; p.lru_bx = (const float*)d_in[11]; p.lru_lam = (const float*)d_in[12];
    p.gla_wr = (const float*)d_in[13]; p.gla_br = (const float*)d_in[14]; p.gla_gn = (const float*)d_in[15];
    p.w_out = (const float*)d_in[16]; p.ln_g = (const float*)d_in[17]; p.ln_b = (const float*)d_in[18];
    p.out = (float*)d_out; p.ws = (unsigned char*)d_ws;
    (void)hipMemsetAsync(d_ws, 0, 32768, stream);
    void* args[] = {&p};
    hipError_t e = hipLaunchCooperativeKernel((const void*)fwd_megakernel, dim3(grid_blocks), dim3(256), args, 0, stream);
    if (e != hipSuccess) fprintf(stderr, "cooperative launch failed: %s (grid %d)\n", hipGetErrorString(e), grid_blocks);
}
```

```cpp
#include <hip/hip_runtime.h>
#include <hip/hip_cooperative_groups.h>
#include <cstdio>
#include <cstdint>
#include <type_traits>
namespace cg = cooperative_groups;

typedef unsigned short bf16_t;
typedef short bf16x8 __attribute__((ext_vector_type(8)));
typedef short bf16x4 __attribute__((ext_vector_type(4)));
typedef float f32x4 __attribute__((ext_vector_type(4)));
typedef unsigned u32x4 __attribute__((ext_vector_type(4)));
typedef unsigned u32x2 __attribute__((ext_vector_type(2)));

constexpr int D = 1024, NB = 4, S = 4096, T = NB * S, DEPTH = 2;
constexpr int DIN = 3344, ZP = 3344, NPAD = 3456;
constexpr int C_AQ = 0, C_AK = 256, C_AV = 512, C_AG = 768, C_BX = 1024, C_BG = 1280, C_CQ = 1536, C_CK = 1792,
              C_CV = 2048, C_CG = 2304, C_DQ = 2560, C_DK = 2688, C_DV = 2816, C_DG = 3072, C_DR = 3328;
constexpr float DN_ALPHA = 1.4142135623730951f;
constexpr int LDP = 72;
constexpr int SMEM_BYTES = 65536;
constexpr int BIG = 1000000;

constexpr size_t WS_CTL = 0;
constexpr size_t WS_CNT = 16384;
constexpr size_t WS_WINT = 32768;
constexpr size_t WS_WOUTT = WS_WINT + (size_t)DEPTH * NPAD * 1024 * 2;
constexpr size_t WS_MOD = WS_WOUTT + (size_t)DEPTH * 1024 * 1024 * 2;
constexpr size_t WS_COS = WS_MOD + (size_t)DEPTH * NB * 3072 * 4;
constexpr size_t WS_SIN = WS_COS + (size_t)T * 32 * 4;
constexpr size_t WS_U = WS_SIN + (size_t)T * 32 * 4;
constexpr size_t WS_Z = WS_U + (size_t)T * 1024 * 2;
constexpr size_t WS_KPART = WS_Z + (size_t)T * ZP * 2;
constexpr size_t WS_DILO = WS_KPART + (size_t)256 * 256 * 4;
constexpr size_t WS_DILL = WS_DILO + (size_t)3 * T * 256 * 2;
constexpr size_t WS_GKV = WS_DILL + (size_t)3 * T * 4 * 4;
constexpr size_t WS_GDEC = WS_GKV + (size_t)2048 * 2048 * 4;
constexpr size_t WS_LH = WS_GDEC + (size_t)2048 * 32 * 4;
constexpr size_t WS_LP = WS_LH + (size_t)T * 256 * 4;
constexpr size_t WS_LC = WS_LP + (size_t)T * 256 * 4;
constexpr size_t WS_LWT = WS_LC + (size_t)NB * 128 * 256 * 4;
constexpr size_t WS_BC = WS_LWT + (size_t)DEPTH * 2 * 4 * 64 * 64 * 2;
constexpr size_t WS_END = WS_BC + (size_t)512 * 32 * 128 * 4;

struct Params {
    const float *x, *c; const int* pos;
    const float *w_mod, *b_mod, *w_in, *conv_w, *conv_b, *lru_wa, *lru_ba, *lru_wx, *lru_bx, *lru_lam, *gla_wr, *gla_br, *gla_gn, *w_out, *ln_g, *ln_b;
    float* out; unsigned char* ws;
};

__device__ __forceinline__ float bf2f(bf16_t h) { return __uint_as_float(((unsigned)h) << 16); }
typedef __bf16 hbf16x2 __attribute__((ext_vector_type(2)));
typedef float f32x2 __attribute__((ext_vector_type(2)));
__device__ __forceinline__ unsigned pack2(float a, float b) { f32x2 v = {a, b}; hbf16x2 r = __builtin_convertvector(v, hbf16x2); return __builtin_bit_cast(unsigned, r); }
__device__ __forceinline__ bf16_t f2bf(float f) { return (bf16_t)(pack2(f, 0.f) & 0xffffu); }
__device__ __forceinline__ float silu_f(float x) { return x / (1.f + __expf(-x)); }
__device__ __forceinline__ float sigmoid_f(float x) { return 1.f / (1.f + __expf(-x)); }
__device__ __forceinline__ int tid_opq() { int t = threadIdx.x; asm volatile("" : "+v"(t)); return t; }
__device__ __forceinline__ float wsum(float v) {
#pragma unroll
    for (int o = 32; o; o >>= 1) v += __shfl_xor(v, o);
    return v;
}

#define XB_TMO      128
#define XB_XCNT(j)  (256  + 64 * (j))
#define XB_XSUB(j)  (1280 + 64 * (j))
#define XB_XGEN(j)  (2304 + 64 * (j))
#define XB_TOP      3328
#define XB_TOPGEN   3392
#define XCD_BAR_WORDS 3456
#define XB_SPIN_CAP (1u << 18)
#define LAS __attribute__((address_space(3)))
__device__ __forceinline__ unsigned xb_ld(unsigned* p)              { return __hip_atomic_load(p, __ATOMIC_RELAXED, __HIP_MEMORY_SCOPE_AGENT); }
__device__ __forceinline__ unsigned xb_add(unsigned* p, unsigned v) { return __hip_atomic_fetch_add(p, v, __ATOMIC_RELAXED, __HIP_MEMORY_SCOPE_AGENT); }
__device__ __forceinline__ unsigned xb_xcc_id() { return (unsigned)__builtin_amdgcn_s_getreg((3 << 11) | 20) & 0xFu; }
#define XB_SPIN(cond, bar) do { unsigned _sp = 0; while (cond) { __builtin_amdgcn_s_sleep(1); \
    if ((++_sp & 255u) == 0u) { if (xb_ld(&(bar)[XB_TMO])) break; if (_sp > XB_SPIN_CAP) { atomicAdd(&(bar)[XB_TMO], 1u); break; } } } } while (0)
struct XcdBarrier { unsigned* bar; unsigned x; volatile LAS unsigned* st; };
__device__ __forceinline__ XcdBarrier xcd_barrier_post(unsigned* bar, volatile LAS unsigned* st) {
    XcdBarrier b; b.bar = bar; b.x = xb_xcc_id(); b.st = st;
    if (threadIdx.x == 0) (void)xb_add(&bar[XB_XCNT(b.x)], 1u);
    return b;
}
__device__ __forceinline__ void xcd_barrier_complete(unsigned* bar, unsigned x, unsigned& nloc, unsigned& nx) {
    const unsigned G = gridDim.x * gridDim.y * gridDim.z;
    unsigned sum, cnt, mine, sp = 0u;
    for (;;) {
        sum = 0u; cnt = 0u; mine = 0u;
#pragma unroll
        for (unsigned j = 0; j < 16; ++j) { const unsigned c = xb_ld(&bar[XB_XCNT(j)]); sum += c; cnt += (c > 0u) ? 1u : 0u; mine = (j == x) ? c : mine; }
        if (sum == G) break;
        __builtin_amdgcn_s_sleep(1);
        if ((++sp & 255u) == 0u) { if (xb_ld(&bar[XB_TMO])) break; if (sp > XB_SPIN_CAP) { atomicAdd(&bar[XB_TMO], 1u); break; } }
    }
    nloc = mine > 0u ? mine : 1u; nx = cnt > 0u ? cnt : 1u;
}
__device__ __forceinline__ void xcd_barrier(const XcdBarrier& b) {
    asm volatile("s_waitcnt vmcnt(0)" ::: "memory");
    __syncthreads();
    if (threadIdx.x == 0) {
        unsigned* bar = b.bar;
        __builtin_amdgcn_s_waitcnt(0);
        unsigned nloc = b.st[0], nx = b.st[1];
        if (nloc == 0u) { xcd_barrier_complete(bar, b.x, nloc, nx); b.st[0] = nloc; b.st[1] = nx; }
        const unsigned old = xb_add(&bar[XB_XSUB(b.x)], 1u);
        const unsigned gen = old / nloc;
        if (old + 1u == (gen + 1u) * nloc) {
            __builtin_amdgcn_fence(__ATOMIC_RELEASE, "agent");
            asm volatile("s_waitcnt vmcnt(0)" ::: "memory");
            const unsigned og = xb_add(&bar[XB_TOP], 1u);
            const unsigned tg = og / nx;
            if (og + 1u == (tg + 1u) * nx) xb_add(&bar[XB_TOPGEN], 1u);
            else XB_SPIN(xb_ld(&bar[XB_TOPGEN]) == tg, bar);
            __builtin_amdgcn_fence(__ATOMIC_ACQUIRE, "agent");
            xb_add(&bar[XB_XGEN(b.x)], 1u);
            asm volatile("s_waitcnt vmcnt(0)" ::: "memory");
        } else {
            XB_SPIN(xb_ld(&bar[XB_XGEN(b.x)]) == gen, bar);
            __builtin_amdgcn_fence(__ATOMIC_ACQUIRE, "agent");
            asm volatile("s_waitcnt vmcnt(0)" ::: "memory");
        }
    }
    __syncthreads();
}
__device__ __forceinline__ int next_item(unsigned* ctr, volatile int* slot) {
    __syncthreads();
    if (threadIdx.x == 0) *slot = (int)atomicAdd(ctr, 1u);
    __syncthreads();
    return *slot;
}

__device__ void prologue_phase(const Params& p, char* smem) {
    const int t = tid_opq();
    bf16_t* WinT = (bf16_t*)(p.ws + WS_WINT); bf16_t* WoutT = (bf16_t*)(p.ws + WS_WOUTT);
    float* mod = (float*)(p.ws + WS_MOD); float* cosT = (float*)(p.ws + WS_COS); float* sinT = (float*)(p.ws + WS_SIN);
    float* tl = (float*)smem;
    constexpr int N_TIN = DEPTH * 16 * 54, N_TOUT = DEPTH * 16 * 16, N_MOD = DEPTH * 192, N_ROPE = T * 32 / 256, N_LWT = DEPTH * 2 * 4 * 64 * 64 / 256;
    constexpr int NITEMS = N_TIN + N_TOUT + N_MOD + N_ROPE + N_LWT;
    for (int it = blockIdx.x; it < NITEMS; it += gridDim.x) {
        if (it < N_TIN + N_TOUT) {
            const float* src; bf16_t* dst; int ncols, kt, nt;
            if (it < N_TIN) { int l = it / (16 * 54), r = it % (16 * 54); kt = r / 54; nt = r % 54; src = p.w_in + (size_t)l * 1024 * DIN; dst = WinT + (size_t)l * NPAD * 1024; ncols = DIN; }
            else { int i2 = it - N_TIN; int l = i2 / 256, r = i2 % 256; kt = r / 16; nt = r % 16; src = p.w_out + (size_t)l * 1024 * 1024; dst = WoutT + (size_t)l * 1024 * 1024; ncols = 1024; }
            __syncthreads();
            { const int c4 = t & 15, r0 = t >> 4; const int n = nt * 64 + c4 * 4;
              f32x4 v[4];
#pragma unroll
              for (int i = 0; i < 4; ++i) { const int r = r0 + 16 * i; v[i] = (n < ncols) ? *(const f32x4*)(src + (size_t)(kt * 64 + r) * ncols + n) : (f32x4){0.f, 0.f, 0.f, 0.f}; }
#pragma unroll
              for (int i = 0; i < 4; ++i) { const int r = r0 + 16 * i; tl[r * 65 + c4 * 4] = v[i][0]; tl[r * 65 + c4 * 4 + 1] = v[i][1]; tl[r * 65 + c4 * 4 + 2] = v[i][2]; tl[r * 65 + c4 * 4 + 3] = v[i][3]; } }
            __syncthreads();
            {
#pragma unroll
              for (int i = 0; i < 2; ++i) { const int cc = t + 256 * i; const int n = cc >> 3, k8 = (cc & 7) * 8;
                  u32x4 pk; pk.x = pack2(tl[(k8 + 0) * 65 + n], tl[(k8 + 1) * 65 + n]); pk.y = pack2(tl[(k8 + 2) * 65 + n], tl[(k8 + 3) * 65 + n]);
                  pk.z = pack2(tl[(k8 + 4) * 65 + n], tl[(k8 + 5) * 65 + n]); pk.w = pack2(tl[(k8 + 6) * 65 + n], tl[(k8 + 7) * 65 + n]);
                  *(u32x4*)(dst + (size_t)(nt * 64 + n) * 1024 + kt * 64 + k8) = pk; } }
        } else if (it < N_TIN + N_TOUT + N_MOD) {
            const int i2 = it - N_TIN - N_TOUT; const int l = i2 / 192, jg = i2 % 192;
            const int jj = t & 15, ks = t >> 4; const int j = jg * 16 + jj;
            float a0 = 0.f, a1 = 0.f, a2 = 0.f, a3 = 0.f;
            const float* wm = p.w_mod + (size_t)l * 1024 * 3072 + j;
#pragma unroll 8
            for (int k = ks * 64; k < ks * 64 + 64; ++k) { float wv = wm[(size_t)k * 3072]; a0 += p.c[k] * wv; a1 += p.c[1024 + k] * wv; a2 += p.c[2048 + k] * wv; a3 += p.c[3072 + k] * wv; }
            __syncthreads();
            tl[(0 * 16 + ks) * 16 + jj] = a0; tl[(1 * 16 + ks) * 16 + jj] = a1; tl[(2 * 16 + ks) * 16 + jj] = a2; tl[(3 * 16 + ks) * 16 + jj] = a3;
            __syncthreads();
            if (t < 64) { const int b = t >> 4, j2 = t & 15; float s = 0.f;
#pragma unroll
              for (int k2 = 0; k2 < 16; ++k2) s += tl[(b * 16 + k2) * 16 + j2];
              mod[((size_t)l * NB + b) * 3072 + jg * 16 + j2] = s + p.b_mod[l * 3072 + jg * 16 + j2]; }
        } else if (it >= N_TIN + N_TOUT + N_MOD + N_ROPE) {
            const int e = (it - N_TIN - N_TOUT - N_MOD - N_ROPE) * 256 + t;
            const int in = e & 63, out = (e >> 6) & 63, g = (e >> 12) & 3, mat = (e >> 14) & 1, l = e >> 15;
            const float* src = mat ? p.lru_wx : p.lru_wa;
            ((bf16_t*)(p.ws + WS_LWT))[e] = f2bf(src[l * 16384 + g * 4096 + in * 64 + out]);
        } else {
            const int i2 = it - N_TIN - N_TOUT - N_MOD; const int e = i2 * 256 + t; const int tok = e >> 5, f = e & 31;
            const float inv = exp2f(-(float)f * (13.287712379549449f / 32.f));
            const float ang = (float)p.pos[tok] * inv;
            double rev = (double)ang * 0.15915494309189535; rev -= __builtin_rint(rev);
            const float rr = (float)rev; cosT[e] = __builtin_amdgcn_cosf(rr); sinT[e] = __builtin_amdgcn_sinf(rr);
        }
    }
}

__device__ void ln_phase(const Params& p, int l) {
    const int t = tid_opq(), lane = t & 63, w = t >> 6;
    bf16_t* ubuf = (bf16_t*)(p.ws + WS_U); const float* mod = (const float*)(p.ws + WS_MOD);
    for (int rg = blockIdx.x; rg < T / 16; rg += gridDim.x) {
        f32x4 v[4][4];
#pragma unroll
        for (int r = 0; r < 4; ++r) { const int row = rg * 16 + w * 4 + r; const float* src = (l <= 1) ? p.x + (size_t)row * 1024 : p.out + (size_t)row * 1024;
#pragma unroll
            for (int i = 0; i < 4; ++i) v[r][i] = *(const f32x4*)(src + i * 256 + lane * 4);
            if (l > 0) {
                const bf16_t* yr = (const bf16_t*)(p.ws + WS_Z) + (size_t)row * 1024; const float* gate = mod + ((size_t)(l - 1) * NB + row / S) * 3072 + 2048;
#pragma unroll
                for (int i = 0; i < 4; ++i) { const u32x2 yv = *(const u32x2*)(yr + i * 256 + lane * 4); const f32x4 g1 = *(const f32x4*)(gate + i * 256 + lane * 4) + 1.f;
                    const f32x4 yf = {__uint_as_float(yv.x << 16), __uint_as_float(yv.x & 0xffff0000u), __uint_as_float(yv.y << 16), __uint_as_float(yv.y & 0xffff0000u)};
                    v[r][i] = v[r][i] * DN_ALPHA + g1 * yf; }
            } }
#pragma unroll
        for (int r = 0; r < 4; ++r) {
            const int row = rg * 16 + w * 4 + r; const int b = row / S;
            if (l > 0) {
                float s = 0.f;
#pragma unroll
                for (int i = 0; i < 4; ++i) s += (v[r][i][0] + v[r][i][1]) + (v[r][i][2] + v[r][i][3]);
                const float mu = wsum(s) * (1.f / 1024.f); float q = 0.f;
#pragma unroll
                for (int i = 0; i < 4; ++i) { f32x4 d = v[r][i] - mu; q += (d[0] * d[0] + d[1] * d[1]) + (d[2] * d[2] + d[3] * d[3]); }
                const float rstd = rsqrtf(wsum(q) * (1.f / 1024.f) + 1e-5f);
#pragma unroll
                for (int i = 0; i < 4; ++i) { const f32x4 g = *(const f32x4*)(p.ln_g + (l - 1) * 1024 + i * 256 + lane * 4), bb = *(const f32x4*)(p.ln_b + (l - 1) * 1024 + i * 256 + lane * 4);
                    v[r][i] = (v[r][i] - mu) * rstd * g + bb; *(f32x4*)(p.out + (size_t)row * 1024 + i * 256 + lane * 4) = v[r][i]; }
            }
            if (l < DEPTH) {
                float s = 0.f;
#pragma unroll
                for (int i = 0; i < 4; ++i) s += (v[r][i][0] + v[r][i][1]) + (v[r][i][2] + v[r][i][3]);
                const float mu = wsum(s) * (1.f / 1024.f); float q = 0.f;
#pragma unroll
                for (int i = 0; i < 4; ++i) { f32x4 d = v[r][i] - mu; q += (d[0] * d[0] + d[1] * d[1]) + (d[2] * d[2] + d[3] * d[3]); }
                const float rstd = rsqrtf(wsum(q) * (1.f / 1024.f) + 1e-5f);
                const float* mb = mod + ((size_t)l * NB + b) * 3072;
#pragma unroll
                for (int i = 0; i < 4; ++i) { const int col = i * 256 + lane * 4; const f32x4 sh = *(const f32x4*)(mb + col), sc = *(const f32x4*)(mb + 1024 + col);
                    f32x4 u = (v[r][i] - mu) * rstd * (sc + 1.f) + sh; u32x2 pk; pk.x = pack2(u[0], u[1]); pk.y = pack2(u[2], u[3]);
                    *(u32x2*)(ubuf + (size_t)row * 1024 + col) = pk; }
            }
        }
    }
}

__device__ __forceinline__ int lds_off(int r, int c8) {
    const int st = (r >> 4) * 2 + (c8 >> 2); const int ob = (r & 15) * 64 + (c8 & 3) * 16;
    return st * 1024 + (ob ^ (((ob >> 9) & 1) << 5));
}
struct RegSet { u32x4 a[4], b[4]; };
__device__ __forceinline__ void gemm_tile(const bf16_t* __restrict__ A, const bf16_t* __restrict__ Bt, int tm, int tn, bool first, bool has_next, int ntm, int ntn,
                                          char* sm, f32x4 (&acc)[4][4], RegSet& r0, RegSet& r1) {
    const int t = tid_opq(), lane = t & 63, w = t >> 6, wm = w >> 1, wn = w & 1, r16 = lane & 15, quad = lane >> 4;
    const int lrow = t >> 3, lch = t & 7;
    constexpr int BUF = 32768;
    const unsigned loff = (unsigned)(lrow * 1024 + lch * 8);
    const bf16_t* At0 = A + (size_t)tm * (128 * 1024); const bf16_t* Bt0 = Bt + (size_t)tn * (128 * 1024);
    const bf16_t* At1 = A + (size_t)ntm * (128 * 1024); const bf16_t* Bt1 = Bt + (size_t)ntn * (128 * 1024);
#define Ag (At0 + loff)
#define Bg (Bt0 + loff)
#define nAg (At1 + loff)
#define nBg (Bt1 + loff)
    const int woff0 = lds_off(lrow, lch);
#define woff(i) (woff0 + 4096 * (i))
    const int fo = lds_off(r16, quad);
#pragma unroll
    for (int a = 0; a < 4; ++a)
#pragma unroll
        for (int b = 0; b < 4; ++b) acc[a][b] = (f32x4){0.f, 0.f, 0.f, 0.f};
    if (first) {
#pragma unroll
        for (int i = 0; i < 4; ++i) { r0.a[i] = *(const u32x4*)(Ag + (size_t)i * 32 * 1024); r0.b[i] = *(const u32x4*)(Bg + (size_t)i * 32 * 1024); }
#pragma unroll
        for (int i = 0; i < 4; ++i) { r1.a[i] = *(const u32x4*)(Ag + (size_t)i * 32 * 1024 + 64); r1.b[i] = *(const u32x4*)(Bg + (size_t)i * 32 * 1024 + 64); }
        __syncthreads();
#pragma unroll
        for (int i = 0; i < 4; ++i) { *(u32x4*)(sm + woff(i)) = r0.a[i]; *(u32x4*)(sm + 16384 + woff(i)) = r0.b[i]; }
#pragma unroll
        for (int i = 0; i < 4; ++i) { r0.a[i] = *(const u32x4*)(Ag + (size_t)i * 32 * 1024 + 128); r0.b[i] = *(const u32x4*)(Bg + (size_t)i * 32 * 1024 + 128); }
    }
    __syncthreads();
    auto step = [&](auto main_tag, int kt, RegSet& rs) {
        constexpr bool MAIN = decltype(main_tag)::value;
        const char* sA = sm + (kt & 1) * BUF; const char* sB = sA + 16384;
        char* nA = sm + ((kt + 1) & 1) * BUF; char* nB = nA + 16384;
        const bool wr = MAIN || kt + 1 < 16 || has_next;
        const bool own = MAIN || kt + 3 < 16;
        const bf16_t* la = own ? Ag + (kt + 3) * 64 : nAg + (kt - 13) * 64; const bf16_t* lb = own ? Bg + (kt + 3) * 64 : nBg + (kt - 13) * 64;
        __builtin_amdgcn_s_setprio(1);
#pragma unroll
        for (int ks = 0; ks < 2; ++ks) {
            bf16x8 af[4], bfr[4];
#pragma unroll
            for (int mt = 0; mt < 4; ++mt) af[mt] = *(const bf16x8*)(sA + ((wm * 4 + mt) * 2 + ks) * 1024 + fo);
#pragma unroll
            for (int nt = 0; nt < 4; ++nt) bfr[nt] = *(const bf16x8*)(sB + ((wn * 4 + nt) * 2 + ks) * 1024 + fo);
#pragma unroll
            for (int mt = 0; mt < 4; ++mt) {
#pragma unroll
                for (int nt = 0; nt < 4; ++nt) acc[mt][nt] = __builtin_amdgcn_mfma_f32_16x16x32_bf16(bfr[nt], af[mt], acc[mt][nt], 0, 0, 0);
                const int i = ks * 2 + (mt >> 1);
                __builtin_amdgcn_sched_barrier(0);
                if ((mt & 1) == 0) { if (wr) *(u32x4*)(nA + woff(i)) = rs.a[i]; if (own || has_next) rs.a[i] = *(const u32x4*)(la + (size_t)i * 32 * 1024); }
                else               { if (wr) *(u32x4*)(nB + woff(i)) = rs.b[i]; if (own || has_next) rs.b[i] = *(const u32x4*)(lb + (size_t)i * 32 * 1024); }
                __builtin_amdgcn_sched_barrier(0);
            }
        }
        __builtin_amdgcn_s_setprio(0);
        __syncthreads();
    };
    {
        std::true_type mt_; std::false_type tl_;
        for (int k2 = 0; k2 < 6; ++k2) { step(mt_, 2 * k2, r1); step(mt_, 2 * k2 + 1, r0); }
        step(mt_, 12, r1); step(tl_, 13, r0); step(tl_, 14, r1); step(tl_, 15, r0);
    }
#undef Ag
#undef Bg
#undef nAg
#undef nBg
#undef woff
}

__device__ void g1_phase(const Params& p, int l, char* smem) {
    const int t = tid_opq(), lane = t & 63, w = t >> 6, wm = w >> 1, wn = w & 1, r16 = lane & 15, quad = lane >> 4;
    char* sm = smem; char* sC = smem + 32768;
    const bf16_t* ubuf = (const bf16_t*)(p.ws + WS_U); const bf16_t* WinT = (const bf16_t*)(p.ws + WS_WINT) + (size_t)l * NPAD * 1024;
    bf16_t* z = (bf16_t*)(p.ws + WS_Z); float* kpart = (float*)(p.ws + WS_KPART);
    const float* cosT = (const float*)(p.ws + WS_COS); const float* sinT = (const float*)(p.ws + WS_SIN);
    const bool xo = (gridDim.x & 7) == 0; const int xcd = blockIdx.x & 7, nloc = xo ? (int)(gridDim.x >> 3) : (int)gridDim.x, j0 = xo ? (int)(blockIdx.x >> 3) : (int)blockIdx.x;
    const int lim = xo ? 16 * 27 : 128 * 27;
    RegSet r0, r1;
    for (int L = j0; L < lim; L += nloc) {
        const int tm = xo ? xcd * 16 + (L / 216) * 8 + (L & 7) : L / 27, tn = xo ? ((L % 216) >> 3) : L % 27;
        const int L2 = L + nloc; const bool has_next = L2 < lim;
        const int ntm = has_next ? (xo ? xcd * 16 + (L2 / 216) * 8 + (L2 & 7) : L2 / 27) : tm, ntn = has_next ? (xo ? ((L2 % 216) >> 3) : L2 % 27) : tn;
        f32x4 acc[4][4];
        gemm_tile(ubuf, WinT, tm, tn, L == j0, has_next, ntm, ntn, sm, acc, r0, r1);
        const bool rope = (tn < 4) || (tn >= 12 && tn < 16);
        if (rope) {
#pragma unroll
            for (int mt = 0; mt < 4; ++mt) {
                const int tok = tm * 128 + wm * 64 + mt * 16 + r16;
#pragma unroll
                for (int nt = 0; nt < 2; ++nt) {
                    const f32x4 cs = *(const f32x4*)(cosT + (size_t)tok * 32 + nt * 16 + quad * 4), sn = *(const f32x4*)(sinT + (size_t)tok * 32 + nt * 16 + quad * 4);
                    const f32x4 x1 = acc[mt][nt], x2 = acc[mt][nt + 2];
                    acc[mt][nt] = x1 * cs - x2 * sn; acc[mt][nt + 2] = x1 * sn + x2 * cs;
                }
            }
        }
        if (tn == 2 || tn == 3) {
#pragma unroll
            for (int nt = 0; nt < 4; ++nt) {
                f32x4 sv = (acc[0][nt] + acc[1][nt]) + (acc[2][nt] + acc[3][nt]);
#pragma unroll
                for (int jj = 0; jj < 4; ++jj) { float sx = sv[jj]; sx += __shfl_xor(sx, 1); sx += __shfl_xor(sx, 2); sx += __shfl_xor(sx, 4); sx += __shfl_xor(sx, 8); sv[jj] = sx; }
                if (r16 == 0) *(f32x4*)(kpart + (size_t)(tm * 2 + wm) * 256 + (tn - 2) * 128 + wn * 64 + nt * 16 + quad * 4) = sv;
            }
        }
#pragma unroll
        for (int mt = 0; mt < 4; ++mt)
#pragma unroll
            for (int nt = 0; nt < 4; ++nt) { u32x2 pk; pk.x = pack2(acc[mt][nt][0], acc[mt][nt][1]); pk.y = pack2(acc[mt][nt][2], acc[mt][nt][3]);
                const int row = wm * 64 + mt * 16 + r16; const int c16 = wn * 8 + nt * 2 + (quad >> 1);
                *(u32x2*)(sC + row * 256 + ((c16 ^ (row & 15)) << 4) + (quad & 1) * 8) = pk; }
        __syncthreads();
#pragma unroll
        for (int i = 0; i < 8; ++i) { const int c = t + 256 * i; const int row = c >> 4, ch = c & 15; const int col = tn * 128 + ch * 8;
            if (col < DIN) *(u32x4*)(z + (size_t)(tm * 128 + row) * ZP + col) = *(const u32x4*)(sC + row * 256 + ((ch ^ (row & 15)) << 4)); }
    }
}

__device__ void g2_phase(const Params& p, int l, char* smem) {
    const int t = tid_opq(), lane = t & 63, w = t >> 6, wm = w >> 1, wn = w & 1, r16 = lane & 15, quad = lane >> 4;
    char* sm = smem; char* sC = smem + 32768;
    const bf16_t* mix = (const bf16_t*)(p.ws + WS_U); const bf16_t* WoutT = (const bf16_t*)(p.ws + WS_WOUTT) + (size_t)l * 1024 * 1024;
    bf16_t* ybuf = (bf16_t*)(p.ws + WS_Z);
    const bool xo = (gridDim.x & 7) == 0; const int xcd = blockIdx.x & 7, nloc = xo ? (int)(gridDim.x >> 3) : (int)gridDim.x, j0 = xo ? (int)(blockIdx.x >> 3) : (int)blockIdx.x;
    const int lim = xo ? 16 * 8 : 128 * 8;
    RegSet r0, r1;
    for (int L = j0; L < lim; L += nloc) {
        const int tm = xo ? xcd * 16 + (L & 15) : (L >> 3), tn = xo ? (L >> 4) : (L & 7);
        const int L2 = L + nloc; const bool has_next = L2 < lim;
        const int ntm = has_next ? (xo ? xcd * 16 + (L2 & 15) : (L2 >> 3)) : tm, ntn = has_next ? (xo ? (L2 >> 4) : (L2 & 7)) : tn;
        f32x4 acc[4][4];
        gemm_tile(mix, WoutT, tm, tn, L == j0, has_next, ntm, ntn, sm, acc, r0, r1);
#pragma unroll
        for (int mt = 0; mt < 4; ++mt)
#pragma unroll
            for (int nt = 0; nt < 4; ++nt) { u32x2 pk; pk.x = pack2(acc[mt][nt][0], acc[mt][nt][1]); pk.y = pack2(acc[mt][nt][2], acc[mt][nt][3]);
                const int row = wm * 64 + mt * 16 + r16; const int c16 = wn * 8 + nt * 2 + (quad >> 1);
                *(u32x2*)(sC + row * 256 + ((c16 ^ (row & 15)) << 4) + (quad & 1) * 8) = pk; }
        __syncthreads();
#pragma unroll
        for (int i = 0; i < 8; ++i) { const int c = t + 256 * i; const int row = c >> 4, ch = c & 15;
            *(u32x4*)(ybuf + (size_t)(tm * 128 + row) * 1024 + tn * 128 + ch * 8) = *(const u32x4*)(sC + row * 256 + ((ch ^ (row & 15)) << 4)); }
    }
}

constexpr float ATT_SC = 0.18033688011112042f;
template <int QT>
__device__ __forceinline__ void attn_tile(const bf16_t* sK, const bf16_t* sV, const bf16x8 (&qf)[QT][2], int lo, int hi, bool full, bool hasq, bool qfl0, bool qfl1,
                                          float (&m)[QT], float (&l)[QT], f32x4 (&O)[QT][4], int wq0) {
    const int lane = tid_opq() & 63, r16 = lane & 15, quad = lane >> 4;
    f32x4 s[QT][4];
#pragma unroll
    for (int a = 0; a < QT; ++a)
#pragma unroll
        for (int b = 0; b < 4; ++b) s[a][b] = (f32x4){0.f, 0.f, 0.f, 0.f};
#pragma unroll
    for (int ks = 0; ks < 2; ++ks)
#pragma unroll
        for (int k16 = 0; k16 < 4; ++k16) {
            const bf16x8 kf = *(const bf16x8*)(sK + (k16 * 16 + r16) * LDP + ks * 32 + quad * 8);
#pragma unroll
            for (int qt = 0; qt < QT; ++qt) s[qt][k16] = __builtin_amdgcn_mfma_f32_16x16x32_bf16(kf, qf[qt][ks], s[qt][k16], 0, 0, 0);
        }
#pragma unroll
    for (int qt = 0; qt < QT; ++qt) {
        const int ql = wq0 + qt * 16 + r16; const bool qfl = qt ? qfl1 : qfl0;
        if (!full) {
#pragma unroll
            for (int k16 = 0; k16 < 4; ++k16)
#pragma unroll
                for (int j = 0; j < 4; ++j) { const int dd = ql - (k16 * 16 + quad * 4 + j); const bool valid = dd >= lo && dd <= hi; s[qt][k16][j] = valid ? s[qt][k16][j] : -1e30f; }
        }
        if (hasq) {
#pragma unroll
            for (int k16 = 0; k16 < 4; ++k16)
#pragma unroll
                for (int j = 0; j < 4; ++j) s[qt][k16][j] = qfl ? s[qt][k16][j] : -1e30f;
        }
        float mx = -1e30f;
#pragma unroll
        for (int k16 = 0; k16 < 4; ++k16) mx = fmaxf(mx, fmaxf(fmaxf(s[qt][k16][0], s[qt][k16][1]), fmaxf(s[qt][k16][2], s[qt][k16][3])));
        mx = fmaxf(mx, __shfl_xor(mx, 16)); mx = fmaxf(mx, __shfl_xor(mx, 32));
        const float mn = fmaxf(m[qt], mx); const float alpha = __builtin_amdgcn_exp2f((m[qt] - mn) * ATT_SC); m[qt] = mn;
        const float mb = (mn < -1e29f) ? 0.f : mn * ATT_SC;
        float ps = 0.f;
#pragma unroll
        for (int k16 = 0; k16 < 4; ++k16)
#pragma unroll
            for (int j = 0; j < 4; ++j) { const float pv = __builtin_amdgcn_exp2f(s[qt][k16][j] * ATT_SC - mb); ps += pv; s[qt][k16][j] = pv; }
        l[qt] = l[qt] * alpha + ps;
#pragma unroll
        for (int dt = 0; dt < 4; ++dt) O[qt][dt] = O[qt][dt] * alpha;
    }
#pragma unroll
    for (int G = 0; G < 2; ++G) {
        bf16x8 pf[QT];
#pragma unroll
        for (int qt = 0; qt < QT; ++qt) {
            const unsigned a0 = pack2(s[qt][G * 2][0], s[qt][G * 2][1]), a1 = pack2(s[qt][G * 2][2], s[qt][G * 2][3]);
            const unsigned a2 = pack2(s[qt][G * 2 + 1][0], s[qt][G * 2 + 1][1]), a3 = pack2(s[qt][G * 2 + 1][2], s[qt][G * 2 + 1][3]);
            u32x4 pk = {a0, a1, a2, a3}; pf[qt] = __builtin_bit_cast(bf16x8, pk);
        }
#pragma unroll
        for (int dt = 0; dt < 4; ++dt) {
            const bf16_t* v0p = sV + (G * 32 + quad * 4 + (r16 >> 2)) * LDP + dt * 16 + (r16 & 3) * 4;
            const bf16x4 v0 = __builtin_amdgcn_ds_read_tr16_b64_v4i16((__attribute__((address_space(3))) bf16x4*)(v0p));
            const bf16x4 v1 = __builtin_amdgcn_ds_read_tr16_b64_v4i16((__attribute__((address_space(3))) bf16x4*)(v0p + 16 * LDP));
            const bf16x8 vf = {v0[0], v0[1], v0[2], v0[3], v1[0], v1[1], v1[2], v1[3]};
#pragma unroll
            for (int qt = 0; qt < QT; ++qt) O[qt][dt] = __builtin_amdgcn_mfma_f32_16x16x32_bf16(vf, pf[qt], O[qt][dt], 0, 0, 0);
        }
    }
}

__device__ void attn_item(const Params& p, int kind, int idx, char* smem) {
    const int t = tid_opq(), lane = t & 63, w = t >> 6, r16 = lane & 15, quad = lane >> 4;
    bf16_t* sK = (bf16_t*)smem; bf16_t* sV = sK + 128 * LDP;
    const bf16_t* z = (const bf16_t*)(p.ws + WS_Z);
    (void)kind;
    const int cfg = idx >> 9; const int rem = idx & 511; const int b = rem >> 7, h = (rem >> 5) & 3; const int rb = rem & 31;
    const int dil = 1 << (2 * cfg); const int res = rb & (dil - 1), blk = rb >> (2 * cfg);
    const int qbase = b * S + blk * 128 * dil + res, stride = dil, qcol = C_CQ + h * 64, kcol = C_CK + h * 64, vcol = C_CV + h * 64;
    const int ss0 = (blk == 0) ? 1 : 0;
    bf16x8 qf[2][2];
#pragma unroll
    for (int qt = 0; qt < 2; ++qt)
#pragma unroll
        for (int ks = 0; ks < 2; ++ks) qf[qt][ks] = *(const bf16x8*)(z + (size_t)(qbase + (w * 32 + qt * 16 + r16) * stride) * ZP + qcol + ks * 32 + quad * 8);
    float m[2] = {-1e30f, -1e30f}, l[2] = {0.f, 0.f}; f32x4 O[2][4];
#pragma unroll
    for (int a = 0; a < 2; ++a)
#pragma unroll
        for (int c = 0; c < 4; ++c) O[a][c] = (f32x4){0.f, 0.f, 0.f, 0.f};
    const int lrow = t >> 1, lch = (t & 1) * 4;
    u32x4 rk[4], rv[4];
    { const bf16_t* rp = z + (size_t)(b * S + ((blk * 128 - 128 + ss0 * 128 + lrow) * dil + res)) * ZP + lch * 8;
#pragma unroll
      for (int c = 0; c < 4; ++c) { rk[c] = *(const u32x4*)(rp + kcol + c * 8); rv[c] = *(const u32x4*)(rp + vcol + c * 8); } }
    for (int ss = ss0; ss < 2; ++ss) {
        __syncthreads();
#pragma unroll
        for (int c = 0; c < 4; ++c) { *(u32x4*)(sK + lrow * LDP + (lch + c) * 8) = rk[c]; *(u32x4*)(sV + lrow * LDP + (lch + c) * 8) = rv[c]; }
        __syncthreads();
        if (ss + 1 < 2) { const bf16_t* rp = z + (size_t)(b * S + ((blk * 128 + lrow) * dil + res)) * ZP + lch * 8;
#pragma unroll
            for (int c = 0; c < 4; ++c) { rk[c] = *(const u32x4*)(rp + kcol + c * 8); rv[c] = *(const u32x4*)(rp + vcol + c * 8); } }
#pragma unroll
        for (int hf = 0; hf < 2; ++hf) {
            const int kt = ss * 2 + hf; const int lo = kt * 64 - 128, hi = kt * 64;
            const bool need = (w * 32 + 31 >= lo) && (w * 32 - 63 <= hi);
            const bool full = (w * 32 - 63 >= lo) && (w * 32 + 31 <= hi);
            if (need) attn_tile<2>(sK + hf * 64 * LDP, sV + hf * 64 * LDP, qf, lo, hi, full, false, true, true, m, l, O, w * 32);
        }
    }
    bf16_t* dilo = (bf16_t*)(p.ws + WS_DILO); float* dill = (float*)(p.ws + WS_DILL);
#pragma unroll
    for (int qt = 0; qt < 2; ++qt) {
        float lt = l[qt]; lt += __shfl_xor(lt, 16); lt += __shfl_xor(lt, 32);
        const float inv = 1.f / lt; const size_t tok = (size_t)(qbase + (w * 32 + qt * 16 + r16) * stride);
#pragma unroll
        for (int dt = 0; dt < 4; ++dt) { const int d0 = dt * 16 + quad * 4; u32x2 o; o.x = pack2(O[qt][dt][0] * inv, O[qt][dt][1] * inv); o.y = pack2(O[qt][dt][2] * inv, O[qt][dt][3] * inv);
            *(u32x2*)(dilo + ((size_t)cfg * T + tok) * 256 + h * 64 + d0) = o; }
        if (quad == 0) dill[((size_t)cfg * T + tok) * 4 + h] = m[qt] * 0.125f + __logf(lt);
    }
}

__device__ void moba_item(const Params& p, int idx, char* smem, bf16_t* outp) {
    const int t = tid_opq(), lane = t & 63, w = t >> 6, r16 = lane & 15, quad = lane >> 4;
    bf16_t* sK = (bf16_t*)smem; bf16_t* sV = sK + 64 * LDP;
    float* stO = (float*)(smem + 18432);
    float* kmean = (float*)(smem + 18432); float* gates = (float*)(smem + 22528);
    float* stM = (float*)(smem + 53248); float* stL = (float*)(smem + 53760);
    unsigned* selm = (unsigned*)(smem + 54272); unsigned char* lists = (unsigned char*)(smem + 54784);
    int* cnt = (int*)(smem + 56832); int4* desc = (int4*)(smem + 56960); int* misc = (int*)(smem + 59008);
    const bf16_t* z = (const bf16_t*)(p.ws + WS_Z);
    const int n = 15 - (idx >> 5); const int rem = idx & 31; const int b = rem >> 3, h = (rem >> 1) & 3, qh = rem & 1;
    const int qbase = b * S + n * 256 + qh * 128, qcol = C_AQ + h * 64, kcol = C_AK + h * 64, vcol = C_AV + h * 64;
    __syncthreads();
    {
        const float* kpart = (const float*)(p.ws + WS_KPART);
        for (int e = t; e < n * 64; e += 256) { const int j = e >> 6, d = e & 63; const float* kp = kpart + (size_t)(b * 64 + j * 4) * 256 + h * 64 + d;
            kmean[e] = ((kp[0] + kp[256]) + (kp[512] + kp[768])) * (1.f / 256.f); }
        if (t < 16) cnt[t] = 0;
        __syncthreads();
        {
            const int ql = t >> 1, half = t & 1; const bf16_t* qp = z + (size_t)(qbase + ql) * ZP + qcol;
            float g[8];
#pragma unroll
            for (int jj = 0; jj < 8; ++jj) g[jj] = 0.f;
#pragma unroll 1
            for (int dc = 0; dc < 8; ++dc) {
                const u32x4 qv = *(const u32x4*)(qp + dc * 8); float qq[8];
#pragma unroll
                for (int e = 0; e < 4; ++e) { qq[2 * e] = __uint_as_float(qv[e] << 16); qq[2 * e + 1] = __uint_as_float(qv[e] & 0xffff0000u); }
#pragma unroll
                for (int jj = 0; jj < 8; ++jj) { const int j = half + 2 * jj; if (j < n) { const float* km = kmean + j * 64 + dc * 8;
#pragma unroll
                    for (int e = 0; e < 8; ++e) g[jj] += qq[e] * km[e]; } }
            }
#pragma unroll
            for (int jj = 0; jj < 8; ++jj) gates[ql * 16 + half + 2 * jj] = g[jj];
        }
        __syncthreads();
        if (t < 128) {
            unsigned msk = 0;
            for (int k = 0; k < 3 && k < n; ++k) { float best = -3.0e38f; int bi = -1;
                for (int j = 0; j < n; ++j) if (!((msk >> j) & 1u)) { const float gv = gates[t * 16 + j]; if (gv > best) { best = gv; bi = j; } }
                if (bi >= 0) msk |= 1u << bi; }
            selm[t] = msk;
            for (int j = 0; j < n; ++j) if ((msk >> j) & 1u) { const int pos = atomicAdd(&cnt[j], 1); lists[j * 128 + pos] = (unsigned char)t; }
        }
        __syncthreads();
        if (t < 128) { for (int j = 0; j < n; ++j) { const int cj = cnt[j]; if (t >= cj && t < ((cj + 15) & ~15)) lists[j * 128 + t] = 255; } }
        {
            const int nown_ = qh * 2 + 2;
            if (t < nown_) desc[t] = make_int4(b * S + n * 256 + t * 64, t * 64 - qh * 128, BIG, -1);
            if (t < 16) {
                int base = nown_; for (int j2 = 0; j2 < t && j2 < n; ++j2) base += ((((cnt[j2] + 15) >> 4) + 3) >> 2) * 4;
                if (t < n) { const int npass = ((((cnt[t] + 15) >> 4) + 3) >> 2);
                    for (int ps = 0; ps < npass; ++ps) for (int kt = 0; kt < 4; ++kt) desc[base + ps * 4 + kt] = make_int4(b * S + t * 256 + kt * 64, ps, kt, t); }
                if (t == 15) { misc[0] = base + ((15 < n) ? ((((cnt[15] + 15) >> 4) + 3) >> 2) * 4 : 0); misc[1] = nown_; }
            }
        }
    }
    __syncthreads();
    const int nd = misc[0], nown = misc[1];
    const int lrow = t >> 2, lch = (t & 3) * 2;
    u32x4 rk0, rk1, rv0, rv1;
    { const int4 d = desc[0]; const bf16_t* rp = z + (size_t)(d.x + lrow) * ZP + lch * 8;
      rk0 = *(const u32x4*)(rp + kcol); rk1 = *(const u32x4*)(rp + kcol + 8); rv0 = *(const u32x4*)(rp + vcol); rv1 = *(const u32x4*)(rp + vcol + 8); }
    bf16x8 nqf[2]; int ngq = 0; bool ngv = false, nhas = false;
    auto prefetch_group = [&](int gi) {
        nhas = false;
        if (gi < nd) { const int4 dg = desc[gi]; const int slot = dg.y * 4 + w; nhas = slot * 16 < cnt[dg.w];
            if (nhas) { const int qi = lists[dg.w * 128 + slot * 16 + r16]; ngv = qi != 255; ngq = ngv ? qi : 0;
#pragma unroll
                for (int ks = 0; ks < 2; ++ks) nqf[ks] = *(const bf16x8*)(z + (size_t)(qbase + ngq) * ZP + qcol + ks * 32 + quad * 8); } }
    };
    prefetch_group(nown);
    {
        bf16x8 qf[2][2];
#pragma unroll
        for (int qt = 0; qt < 2; ++qt)
#pragma unroll
            for (int ks = 0; ks < 2; ++ks) qf[qt][ks] = *(const bf16x8*)(z + (size_t)(qbase + w * 32 + qt * 16 + r16) * ZP + qcol + ks * 32 + quad * 8);
        float m[2] = {-1e30f, -1e30f}, l[2] = {0.f, 0.f}; f32x4 O[2][4];
#pragma unroll
        for (int a = 0; a < 2; ++a)
#pragma unroll
            for (int c = 0; c < 4; ++c) O[a][c] = (f32x4){0.f, 0.f, 0.f, 0.f};
        for (int i = 0; i < nown; ++i) {
            __syncthreads();
            *(u32x4*)(sK + lrow * LDP + lch * 8) = rk0; *(u32x4*)(sK + lrow * LDP + lch * 8 + 8) = rk1;
            *(u32x4*)(sV + lrow * LDP + lch * 8) = rv0; *(u32x4*)(sV + lrow * LDP + lch * 8 + 8) = rv1;
            __syncthreads();
            if (i + 1 < nd) { const int4 d = desc[i + 1]; const bf16_t* rp = z + (size_t)(d.x + lrow) * ZP + lch * 8;
                rk0 = *(const u32x4*)(rp + kcol); rk1 = *(const u32x4*)(rp + kcol + 8); rv0 = *(const u32x4*)(rp + vcol); rv1 = *(const u32x4*)(rp + vcol + 8); }
            const int4 d = desc[i];
            const bool need = (w * 32 + 31 >= d.y) && (w * 32 - 63 <= d.z);
            const bool full = (w * 32 - 63 >= d.y) && (w * 32 + 31 <= d.z);
            if (need) attn_tile<2>(sK, sV, qf, d.y, d.z, full, false, true, true, m, l, O, w * 32);
        }
#pragma unroll
        for (int qt = 0; qt < 2; ++qt) {
            float lt = l[qt]; lt += __shfl_xor(lt, 16); lt += __shfl_xor(lt, 32);
            const int ql = w * 32 + qt * 16 + r16;
            if (quad == 0) { stM[ql] = m[qt]; stL[ql] = lt; }
#pragma unroll
            for (int dt = 0; dt < 4; ++dt) *(f32x4*)(stO + ql * 68 + dt * 16 + quad * 4) = O[qt][dt];
        }
    }
    {
        bf16x8 qf[1][2]; float m[1] = {-1e30f}, l[1] = {0.f}; f32x4 O[1][4];
        int gq = 0; bool gv = false, has = false;
        for (int i = nown; i < nd; ++i) {
            __syncthreads();
            *(u32x4*)(sK + lrow * LDP + lch * 8) = rk0; *(u32x4*)(sK + lrow * LDP + lch * 8 + 8) = rk1;
            *(u32x4*)(sV + lrow * LDP + lch * 8) = rv0; *(u32x4*)(sV + lrow * LDP + lch * 8 + 8) = rv1;
            __syncthreads();
            if (i + 1 < nd) { const int4 d = desc[i + 1]; const bf16_t* rp = z + (size_t)(d.x + lrow) * ZP + lch * 8;
                rk0 = *(const u32x4*)(rp + kcol); rk1 = *(const u32x4*)(rp + kcol + 8); rv0 = *(const u32x4*)(rp + vcol); rv1 = *(const u32x4*)(rp + vcol + 8); }
            const int4 d = desc[i];
            if (d.z == 0) {
                has = nhas; gv = ngv; gq = ngq; qf[0][0] = nqf[0]; qf[0][1] = nqf[1];
                m[0] = -1e30f; l[0] = 0.f;
#pragma unroll
                for (int c = 0; c < 4; ++c) O[0][c] = (f32x4){0.f, 0.f, 0.f, 0.f};
                prefetch_group(i + 4);
            }
            if (has) {
                attn_tile<1>(sK, sV, qf, -BIG, BIG, true, false, true, true, m, l, O, 0);
                if (d.z == 3) {
                    float lt = l[0]; lt += __shfl_xor(lt, 16); lt += __shfl_xor(lt, 32);
                    if (gv) {
                        const float mo = stM[gq], lo_ = stL[gq]; const float mn = fmaxf(mo, m[0]);
                        const float fa = __builtin_amdgcn_exp2f((mo - mn) * ATT_SC), fb = __builtin_amdgcn_exp2f((m[0] - mn) * ATT_SC);
#pragma unroll
                        for (int dt = 0; dt < 4; ++dt) { float* sp = stO + gq * 68 + dt * 16 + quad * 4; const f32x4 so = *(const f32x4*)sp; *(f32x4*)sp = so * fa + O[0][dt] * fb; }
                        if (quad == 0) { stM[gq] = mn; stL[gq] = lo_ * fa + lt * fb; }
                    }
                }
            }
        }
    }
    __syncthreads();
#pragma unroll
    for (int qt = 0; qt < 2; ++qt) {
        const int ql = w * 32 + qt * 16 + r16; const float inv = 1.f / stL[ql]; const size_t tok = (size_t)(qbase + ql);
#pragma unroll
        for (int dt = 0; dt < 4; ++dt) { const int d0 = dt * 16 + quad * 4; const f32x4 ov = *(const f32x4*)(stO + ql * 68 + d0);
            const u32x2 gvv = *(const u32x2*)(z + tok * ZP + C_AG + h * 64 + d0);
            const float g0 = __uint_as_float(gvv.x << 16), g1 = __uint_as_float(gvv.x & 0xffff0000u), g2 = __uint_as_float(gvv.y << 16), g3 = __uint_as_float(gvv.y & 0xffff0000u);
            u32x2 o; o.x = pack2(ov[0] * inv * silu_f(g0), ov[1] * inv * silu_f(g1)); o.y = pack2(ov[2] * inv * silu_f(g2), ov[3] * inv * silu_f(g3));
            *(u32x2*)(outp + tok * 1024 + h * 64 + d0) = o; }
    }
}

__device__ __forceinline__ void gla_bcum(const Params& p, int l, const bf16_t* z, int tok0, float* bc, float* drs) {
    const int t = tid_opq();
    const int hd = t & 127, ih = t >> 7;
    float wr[16];
#pragma unroll
    for (int r = 0; r < 16; ++r) wr[r] = p.gla_wr[l * 2048 + r * 128 + hd];
    const float br = p.gla_br[l * 128 + hd];
    { const int e0 = t, e1 = t + 256; const bf16_t d0 = z[(size_t)(tok0 + (e0 >> 4)) * ZP + C_DR + (e0 & 15)], d1 = z[(size_t)(tok0 + (e1 >> 4)) * ZP + C_DR + (e1 & 15)];
      drs[e0] = bf2f(d0); drs[e1] = bf2f(d1); }
    __syncthreads();
#pragma unroll
    for (int ii = 0; ii < 16; ++ii) { const int i = ih * 16 + ii; float x = br;
#pragma unroll
        for (int r4 = 0; r4 < 4; ++r4) { const f32x4 dv = *(const f32x4*)(drs + i * 16 + r4 * 4); x += (dv[0] * wr[r4 * 4] + dv[1] * wr[r4 * 4 + 1]) + (dv[2] * wr[r4 * 4 + 2] + dv[3] * wr[r4 * 4 + 3]); }
        bc[i * 128 + hd] = (fminf(x, 0.f) - __logf(1.f + __expf(-fabsf(x)))) * (1.f / 16.f); }
    __syncthreads();
    if (t < 128) { float sacc = 0.f;
#pragma unroll
        for (int i = 0; i < 32; ++i) { sacc += bc[i * 128 + t]; bc[i * 128 + t] = sacc; } }
    __syncthreads();
}

__device__ void gla1_item(const Params& p, int l, int idx, char* smem) {
    const int t = tid_opq(), lane = t & 63, w = t >> 6, r16 = lane & 15, quad = lane >> 4;
    const int b = idx >> 7, c = idx & 127; const int tok0 = b * S + c * 32;
    const bf16_t* z = (const bf16_t*)(p.ws + WS_Z);
    float* bc = (float*)smem; float* drs = (float*)(smem + 16384);
    bf16_t* kdT = (bf16_t*)(smem + 18432) + w * 1024;
    bf16_t* vL = (bf16_t*)(smem + 26624) + w * (32 * LDP);
    float* gkv = (float*)(p.ws + WS_GKV); float* gdec = (float*)(p.ws + WS_GDEC);
    bf16_t kraw[16]; u32x4 vr[4];
#pragma unroll
    for (int i = 0; i < 16; ++i) { const int e = lane + 64 * i; kraw[i] = z[(size_t)(tok0 + (e >> 5)) * ZP + C_DK + w * 32 + (e & 31)]; }
#pragma unroll
    for (int i = 0; i < 4; ++i) { const int cc = lane + 64 * i; vr[i] = *(const u32x4*)(z + (size_t)(tok0 + (cc >> 3)) * ZP + C_DV + w * 64 + (cc & 7) * 8); }
    __syncthreads();
#pragma unroll
    for (int i = 0; i < 4; ++i) { const int cc = lane + 64 * i; *(u32x4*)(vL + (cc >> 3) * LDP + (cc & 7) * 8) = vr[i]; }
    gla_bcum(p, l, z, tok0, bc, drs);
    { float* bcg = (float*)(p.ws + WS_BC) + (size_t)idx * 4096;
#pragma unroll
      for (int i = 0; i < 4; ++i) *(f32x4*)(bcg + (t + 256 * i) * 4) = *(const f32x4*)(bc + (t + 256 * i) * 4); }
#pragma unroll
    for (int i = 0; i < 16; ++i) { const int e = lane + 64 * i; const int j = e >> 5, d = e & 31;
        kdT[d * 32 + j] = f2bf(bf2f(kraw[i]) * __expf(bc[31 * 128 + w * 32 + d] - bc[j * 128 + w * 32 + d])); }
    const int bh = b * 4 + w;
    if (lane < 32) gdec[(bh * 128 + c) * 32 + lane] = __expf(bc[31 * 128 + w * 32 + lane]);
    __syncthreads();
    bf16x8 kf[2];
#pragma unroll
    for (int x = 0; x < 2; ++x) kf[x] = *(const bf16x8*)(kdT + (x * 16 + r16) * 32 + quad * 8);
    float* dst = gkv + (size_t)(bh * 128 + c) * 2048;
#pragma unroll
    for (int dt = 0; dt < 4; ++dt) {
        const bf16_t* v0p = vL + (quad * 8 + (r16 >> 2)) * LDP + dt * 16 + (r16 & 3) * 4;
        const bf16x4 v0 = __builtin_amdgcn_ds_read_tr16_b64_v4i16((__attribute__((address_space(3))) bf16x4*)(v0p));
        const bf16x4 v1 = __builtin_amdgcn_ds_read_tr16_b64_v4i16((__attribute__((address_space(3))) bf16x4*)(v0p + 4 * LDP));
        const bf16x8 vf = {v0[0], v0[1], v0[2], v0[3], v1[0], v1[1], v1[2], v1[3]};
#pragma unroll
        for (int x = 0; x < 2; ++x) {
            const f32x4 r = __builtin_amdgcn_mfma_f32_16x16x32_bf16(vf, kf[x], (f32x4){0.f, 0.f, 0.f, 0.f}, 0, 0, 0);
            *(f32x4*)(dst + (x * 16 + r16) * 64 + dt * 16 + quad * 4) = r;
        }
    }
}

#define OPQ(ptr) asm volatile("" : "+v"(ptr))
__device__ void gla3_item(const Params& p, int l, int idx, char* smem) {
    const int t = tid_opq(), lane = t & 63, w = t >> 6, r16 = lane & 15, quad = lane >> 4;
    const int b = idx >> 7, c = idx & 127; const int tok0 = b * S + c * 32;
    const bf16_t* z = (const bf16_t*)(p.ws + WS_Z); bf16_t* mix = (bf16_t*)(p.ws + WS_U);
    float* bc = (float*)smem; float* drs = (float*)(smem + 16384);
    bf16_t* SL = (bf16_t*)smem + w * (32 * LDP);
    bf16_t* qe = (bf16_t*)(smem + 18432) + w * 1024;
    bf16_t* ke = (bf16_t*)(smem + 26624) + w * 1024;
    bf16_t* vL = (bf16_t*)(smem + 34816) + w * (32 * LDP);
    const float* gkv = (const float*)(p.ws + WS_GKV);
    const int bh = b * 4 + w;
    bf16_t qraw[16], kraw[16];
    { const bf16_t* qp = z + (size_t)(tok0 + (lane >> 5)) * ZP + w * 32 + (lane & 31);
#pragma unroll
      for (int i = 0; i < 16; ++i) { qraw[i] = qp[C_DQ]; kraw[i] = qp[C_DK]; qp += 2 * ZP; OPQ(qp); } }
    u32x4 vr[4]; f32x4 sr[8];
#pragma unroll
    for (int i = 0; i < 4; ++i) { const int cc = lane + 64 * i; vr[i] = *(const u32x4*)(z + (size_t)(tok0 + (cc >> 3)) * ZP + C_DV + w * 64 + (cc & 7) * 8); }
    { const float* Sp = gkv + (size_t)(bh * 128 + c) * 2048;
#pragma unroll
      for (int i = 0; i < 8; ++i) sr[i] = *(const f32x4*)(Sp + (lane + 64 * i) * 4); }
    f32x4 bcr[4];
    { const float* bcg = (const float*)(p.ws + WS_BC) + (size_t)idx * 4096;
#pragma unroll
      for (int i = 0; i < 4; ++i) bcr[i] = *(const f32x4*)(bcg + (t + 256 * i) * 4); }
    __syncthreads();
#pragma unroll
    for (int i = 0; i < 4; ++i) { const int cc = lane + 64 * i; *(u32x4*)(vL + (cc >> 3) * LDP + (cc & 7) * 8) = vr[i]; }
#pragma unroll
    for (int i = 0; i < 4; ++i) *(f32x4*)(bc + (t + 256 * i) * 4) = bcr[i];
    __syncthreads();
#pragma unroll
    for (int i2 = 0; i2 < 16; ++i2) { const int e = lane + 64 * i2; const int i = e >> 5, d = e & 31; const float bcv = bc[i * 128 + w * 32 + d];
        qe[i * 32 + d] = f2bf(bf2f(qraw[i2]) * __expf(bcv) * 0.17677669529663687f); ke[i * 32 + d] = f2bf(bf2f(kraw[i2]) * __expf(-bcv)); }
    __syncthreads();
#pragma unroll
    for (int i = 0; i < 8; ++i) { const int cc = lane + 64 * i; const int d = cc >> 4, v4 = cc & 15; u32x2 pk; pk.x = pack2(sr[i][0], sr[i][1]); pk.y = pack2(sr[i][2], sr[i][3]);
        *(u32x2*)(SL + d * LDP + v4 * 4) = pk; }
    __syncthreads();
    bf16x8 qf[2], kf[2];
#pragma unroll
    for (int x = 0; x < 2; ++x) { qf[x] = *(const bf16x8*)(qe + (x * 16 + r16) * 32 + quad * 8); kf[x] = *(const bf16x8*)(ke + (x * 16 + r16) * 32 + quad * 8); }
    bf16x8 pf[2];
#pragma unroll
    for (int it = 0; it < 2; ++it) {
        f32x4 at[2];
#pragma unroll
        for (int jt = 0; jt < 2; ++jt) { at[jt] = __builtin_amdgcn_mfma_f32_16x16x32_bf16(kf[jt], qf[it], (f32x4){0.f, 0.f, 0.f, 0.f}, 0, 0, 0);
#pragma unroll
            for (int jj = 0; jj < 4; ++jj) at[jt][jj] = (jt * 16 + quad * 4 + jj <= it * 16 + r16) ? at[jt][jj] : 0.f; }
        u32x4 pk = {pack2(at[0][0], at[0][1]), pack2(at[0][2], at[0][3]), pack2(at[1][0], at[1][1]), pack2(at[1][2], at[1][3])};
        pf[it] = __builtin_bit_cast(bf16x8, pk);
    }
    f32x4 O[2][4];
#pragma unroll
    for (int dt = 0; dt < 4; ++dt) {
        const bf16_t* v0p = vL + (quad * 4 + (r16 >> 2)) * LDP + dt * 16 + (r16 & 3) * 4;
        const bf16x4 v0 = __builtin_amdgcn_ds_read_tr16_b64_v4i16((__attribute__((address_space(3))) bf16x4*)(v0p));
        const bf16x4 v1 = __builtin_amdgcn_ds_read_tr16_b64_v4i16((__attribute__((address_space(3))) bf16x4*)(v0p + 16 * LDP));
        const bf16x8 vf = {v0[0], v0[1], v0[2], v0[3], v1[0], v1[1], v1[2], v1[3]};
        const bf16_t* s0p = SL + (quad * 8 + (r16 >> 2)) * LDP + dt * 16 + (r16 & 3) * 4;
        const bf16x4 s0 = __builtin_amdgcn_ds_read_tr16_b64_v4i16((__attribute__((address_space(3))) bf16x4*)(s0p));
        const bf16x4 s1 = __builtin_amdgcn_ds_read_tr16_b64_v4i16((__attribute__((address_space(3))) bf16x4*)(s0p + 4 * LDP));
        const bf16x8 sf = {s0[0], s0[1], s0[2], s0[3], s1[0], s1[1], s1[2], s1[3]};
#pragma unroll
        for (int it = 0; it < 2; ++it) {
            O[it][dt] = __builtin_amdgcn_mfma_f32_16x16x32_bf16(vf, pf[it], (f32x4){0.f, 0.f, 0.f, 0.f}, 0, 0, 0);
            O[it][dt] = __builtin_amdgcn_mfma_f32_16x16x32_bf16(sf, qf[it], O[it][dt], 0, 0, 0);
        }
    }
#pragma unroll
    for (int it = 0; it < 2; ++it) {
        float ss = 0.f;
#pragma unroll
        for (int dt = 0; dt < 4; ++dt) ss += (O[it][dt][0] * O[it][dt][0] + O[it][dt][1] * O[it][dt][1]) + (O[it][dt][2] * O[it][dt][2] + O[it][dt][3] * O[it][dt][3]);
        ss += __shfl_xor(ss, 16); ss += __shfl_xor(ss, 32);
        const float rn = rsqrtf(ss * (1.f / 64.f) + 1e-5f);
        const size_t tok = (size_t)(tok0 + it * 16 + r16);
#pragma unroll
        for (int dt = 0; dt < 4; ++dt) { const int v0i = dt * 16 + quad * 4; const f32x4 gn = *(const f32x4*)(p.gla_gn + l * 64 + v0i);
            const u32x2 gv = *(const u32x2*)(z + tok * ZP + C_DG + w * 64 + v0i);
            const float g0 = __uint_as_float(gv.x << 16), g1 = __uint_as_float(gv.x & 0xffff0000u), g2 = __uint_as_float(gv.y << 16), g3 = __uint_as_float(gv.y & 0xffff0000u);
            u32x2 o; o.x = pack2(O[it][dt][0] * rn * gn[0] * silu_f(g0), O[it][dt][1] * rn * gn[1] * silu_f(g1));
            o.y = pack2(O[it][dt][2] * rn * gn[2] * silu_f(g2), O[it][dt][3] * rn * gn[3] * silu_f(g3));
            *(u32x2*)(mix + tok * 1024 + 768 + w * 64 + v0i) = o; }
    }
}

__device__ void lru1_item(const Params& p, int l, int idx, char* smem) {
    const int t = tid_opq(), lane = t & 63, g = t >> 6, r16 = lane & 15, quad = lane >> 4; const int ch = t;
    const int b = idx >> 7, c = idx & 127; const int s0 = c * 32; const int tok0 = b * S + s0;
    const bf16_t* z = (const bf16_t*)(p.ws + WS_Z); float* xcs = (float*)smem;
    bf16_t* preA = (bf16_t*)(smem + 32768); bf16_t* preX = (bf16_t*)(smem + 49152);
    float* lh = (float*)(p.ws + WS_LH); float* lp = (float*)(p.ws + WS_LP);
    bf16_t xr[35];
#pragma unroll
    for (int i = 0; i < 35; ++i) { const int sidx = s0 + i - 3; xr[i] = (sidx >= 0) ? z[(size_t)(tok0 + i - 3) * ZP + C_BX + ch] : (bf16_t)0; }
    const float cw0 = p.conv_w[l * 1024 + ch], cw1 = p.conv_w[l * 1024 + 256 + ch], cw2 = p.conv_w[l * 1024 + 512 + ch], cw3 = p.conv_w[l * 1024 + 768 + ch];
    const float cb = p.conv_b[l * 256 + ch];
    const bf16_t* lwt = (const bf16_t*)(p.ws + WS_LWT) + (size_t)l * 32768 + g * 4096;
    bf16x8 wfa[4][2], wfx[4][2];
#pragma unroll
    for (int nt = 0; nt < 4; ++nt)
#pragma unroll
        for (int ks = 0; ks < 2; ++ks) { wfa[nt][ks] = *(const bf16x8*)(lwt + (nt * 16 + r16) * 64 + ks * 32 + quad * 8); wfx[nt][ks] = *(const bf16x8*)(lwt + 16384 + (nt * 16 + r16) * 64 + ks * 32 + quad * 8); }
    __syncthreads();
#pragma unroll
    for (int i = 0; i < 32; ++i) xcs[i * 256 + ch] = cb + (cw0 * bf2f(xr[i]) + cw1 * bf2f(xr[i + 1])) + (cw2 * bf2f(xr[i + 2]) + cw3 * bf2f(xr[i + 3]));
    __syncthreads();
#pragma unroll
    for (int tt = 0; tt < 2; ++tt) {
        bf16x8 xf[2];
#pragma unroll
        for (int ks = 0; ks < 2; ++ks) { const float* xp = xcs + (tt * 16 + r16) * 256 + g * 64 + ks * 32 + quad * 8; const f32x4 x0 = *(const f32x4*)xp, x1 = *(const f32x4*)(xp + 4);
            u32x4 pk = {pack2(x0[0], x0[1]), pack2(x0[2], x0[3]), pack2(x1[0], x1[1]), pack2(x1[2], x1[3])}; xf[ks] = __builtin_bit_cast(bf16x8, pk); }
#pragma unroll
        for (int nt = 0; nt < 4; ++nt) {
            f32x4 ra = __builtin_amdgcn_mfma_f32_16x16x32_bf16(wfa[nt][0], xf[0], (f32x4){0.f, 0.f, 0.f, 0.f}, 0, 0, 0); ra = __builtin_amdgcn_mfma_f32_16x16x32_bf16(wfa[nt][1], xf[1], ra, 0, 0, 0);
            f32x4 rx = __builtin_amdgcn_mfma_f32_16x16x32_bf16(wfx[nt][0], xf[0], (f32x4){0.f, 0.f, 0.f, 0.f}, 0, 0, 0); rx = __builtin_amdgcn_mfma_f32_16x16x32_bf16(wfx[nt][1], xf[1], rx, 0, 0, 0);
            u32x2 pa; pa.x = pack2(ra[0], ra[1]); pa.y = pack2(ra[2], ra[3]); u32x2 px; px.x = pack2(rx[0], rx[1]); px.y = pack2(rx[2], rx[3]);
            *(u32x2*)(preA + (tt * 16 + r16) * 256 + g * 64 + nt * 16 + quad * 4) = pa; *(u32x2*)(preX + (tt * 16 + r16) * 256 + g * 64 + nt * 16 + quad * 4) = px;
        }
    }
    __syncthreads();
    const float ba = p.lru_ba[l * 256 + ch], bx = p.lru_bx[l * 256 + ch], lam = p.lru_lam[l * 256 + ch];
    const float sp = fmaxf(-lam, 0.f) + log1pf(__expf(-fabsf(lam)));
    float hh = 0.f, P = 1.f;
    float* lhp = lh + (size_t)tok0 * 256 + ch; float* lpp = lp + (size_t)tok0 * 256 + ch;
#pragma unroll 4
    for (int i = 0; i < 32; ++i) { const float r = sigmoid_f(bf2f(preA[i * 256 + ch]) + ba), ig = sigmoid_f(bf2f(preX[i * 256 + ch]) + bx); const float la = -8.f * r * sp; const float a = __expf(la);
        const float w2 = 2.f * la;
        const float em_s = -w2 * (1.f + w2 * (0.5f + w2 * (0.16666667f + w2 * (0.041666668f + w2 * (0.0083333338f + w2 * 0.0013888889f)))));
        const float em = (w2 > -0.25f) ? em_s : (1.f - a * a);
        const float u = __builtin_amdgcn_sqrtf(em) * (ig * xcs[i * 256 + ch]); hh = a * hh + u; P *= a;
        lhp[(size_t)i * 256] = hh; lpp[(size_t)i * 256] = P; }
}

__device__ void lru3_item(const Params& p, int idx) {
    const int ch = tid_opq(); const int b = idx >> 7, c = idx & 127; const int tok0 = b * S + c * 32;
    const bf16_t* z = (const bf16_t*)(p.ws + WS_Z); bf16_t* mix = (bf16_t*)(p.ws + WS_U);
    const float* lh = (const float*)(p.ws + WS_LH); const float* lp = (const float*)(p.ws + WS_LP); const float* lc = (const float*)(p.ws + WS_LC);
    const float carry = lc[(size_t)(b * 128 + c) * 256 + ch];
    float hv[32], pv[32]; bf16_t gv[32];
#pragma unroll
    for (int i = 0; i < 32; ++i) { const size_t tok = (size_t)(tok0 + i); hv[i] = lh[tok * 256 + ch]; pv[i] = lp[tok * 256 + ch]; gv[i] = z[tok * ZP + C_BG + ch]; }
#pragma unroll
    for (int i = 0; i < 32; ++i) { const size_t tok = (size_t)(tok0 + i); mix[tok * 1024 + 256 + ch] = f2bf((hv[i] + pv[i] * carry) * silu_f(bf2f(gv[i]))); }
}

__device__ void dilc_item(const Params& p, int idx) {
    const int t = tid_opq(); const size_t tok = (size_t)idx * 8 + (t >> 5); const int chn = t & 31; const int h = chn >> 3;
    const bf16_t* z = (const bf16_t*)(p.ws + WS_Z); bf16_t* mix = (bf16_t*)(p.ws + WS_U);
    const bf16_t* dilo = (const bf16_t*)(p.ws + WS_DILO); const float* dill = (const float*)(p.ws + WS_DILL);
    const float l0 = dill[((size_t)0 * T + tok) * 4 + h], l1 = dill[((size_t)1 * T + tok) * 4 + h], l2 = dill[((size_t)2 * T + tok) * 4 + h];
    const float mx = fmaxf(l0, fmaxf(l1, l2)); float w0 = __expf(l0 - mx), w1 = __expf(l1 - mx), w2 = __expf(l2 - mx); const float inv = 1.f / (w0 + w1 + w2); w0 *= inv; w1 *= inv; w2 *= inv;
    const u32x4 o0 = *(const u32x4*)(dilo + ((size_t)0 * T + tok) * 256 + chn * 8), o1 = *(const u32x4*)(dilo + ((size_t)1 * T + tok) * 256 + chn * 8), o2 = *(const u32x4*)(dilo + ((size_t)2 * T + tok) * 256 + chn * 8);
    const u32x4 gv = *(const u32x4*)(z + tok * ZP + C_CG + chn * 8);
    u32x4 r;
#pragma unroll
    for (int e = 0; e < 4; ++e) {
        const float a = w0 * __uint_as_float(o0[e] << 16) + w1 * __uint_as_float(o1[e] << 16) + w2 * __uint_as_float(o2[e] << 16);
        const float bq = w0 * __uint_as_float(o0[e] & 0xffff0000u) + w1 * __uint_as_float(o1[e] & 0xffff0000u) + w2 * __uint_as_float(o2[e] & 0xffff0000u);
        r[e] = pack2(a * silu_f(__uint_as_float(gv[e] << 16)), bq * silu_f(__uint_as_float(gv[e] & 0xffff0000u)));
    }
    *(u32x4*)(mix + tok * 1024 + 512 + chn * 8) = r;
}

__device__ void m2_phase(const Params& p, char* smem) {
    float* gkv = (float*)(p.ws + WS_GKV); const float* gdec = (const float*)(p.ws + WS_GDEC);
    const float* lh = (const float*)(p.ws + WS_LH); const float* lp = (const float*)(p.ws + WS_LP); float* lc = (float*)(p.ws + WS_LC);
    float* aggP = (float*)smem; float* aggS = aggP + 256;
    const int t = tid_opq(); const int e = t & 31, seg = t >> 5;
    for (int it = blockIdx.x; it < 1024 + 32; it += gridDim.x) {
        float a[16], x[16];
        size_t ostride;
        float* outp;
        if (it < 1024) {
            const int gid = it * 32 + e; const int bh = gid >> 11, dv = gid & 2047, d = dv >> 6;
            float* base = gkv + (size_t)bh * 128 * 2048 + dv + (size_t)(seg * 16) * 2048; const float* dc = gdec + (size_t)bh * 128 * 32 + d + (seg * 16) * 32;
#pragma unroll
            for (int k = 0; k < 16; ++k) { x[k] = base[(size_t)k * 2048]; a[k] = dc[k * 32]; }
            outp = base; ostride = 2048;
        } else {
            const int i2 = it - 1024; const int b = i2 >> 3, ch = (i2 & 7) * 32 + e;
#pragma unroll
            for (int k = 0; k < 16; ++k) { const size_t ix = (size_t)(b * S + (seg * 16 + k) * 32 + 31) * 256 + ch; a[k] = lp[ix]; x[k] = lh[ix]; }
            outp = lc + (size_t)(b * 128 + seg * 16) * 256 + ch; ostride = 256;
        }
        float st = 0.f, pr = 1.f;
#pragma unroll
        for (int k = 0; k < 16; ++k) { const float ak = a[k], xk = x[k]; a[k] = pr; x[k] = st; st = ak * st + xk; pr *= ak; }
        __syncthreads();
        aggP[seg * 32 + e] = pr; aggS[seg * 32 + e] = st;
        __syncthreads();
        float carry = 0.f;
        for (int s2 = 0; s2 < seg; ++s2) carry = aggP[s2 * 32 + e] * carry + aggS[s2 * 32 + e];
#pragma unroll
        for (int k = 0; k < 16; ++k) outp[(size_t)k * ostride] = x[k] + a[k] * carry;
    }
}

__global__ void __launch_bounds__(256, 2) fwd_megakernel(Params p) {
    __shared__ __attribute__((aligned(16))) char smem[SMEM_BYTES];
    __shared__ uint4 xb_words;
    __shared__ int s_slot;
    cg::grid_group grid = cg::this_grid();
    if (p.out == nullptr) grid.sync();
    if (threadIdx.x == 0) xb_words = make_uint4(0u, 0u, 0u, 0u);
    __syncthreads();
    const XcdBarrier xb = xcd_barrier_post((unsigned*)(p.ws + WS_CTL), (volatile LAS unsigned*)&xb_words);
    unsigned* cnt = (unsigned*)(p.ws + WS_CNT);
    prologue_phase(p, smem);
    xcd_barrier(xb);
#pragma unroll 1
    for (int l = 0; l < DEPTH; ++l) {
        ln_phase(p, l);
        xcd_barrier(xb);
        g1_phase(p, l, smem);
        xcd_barrier(xb);
        for (;;) { const int it = next_item(cnt + (4 + l) * 64, &s_slot); if (it >= 512) break; lru1_item(p, l, it, smem); }
        { const int xq = blockIdx.x & 7;
          for (;;) { const int li = next_item(cnt + (16 + l * 8 + xq) * 64, &s_slot); if (li >= 64) break;
              const int pr = xq * 2 + ((li >> 1) & 1); moba_item(p, (li >> 2) * 32 + (pr >> 2) * 8 + (pr & 3) * 2 + (li & 1), smem, (bf16_t*)(p.ws + WS_U)); }
          for (;;) { const int li = next_item(cnt + (32 + l * 8 + xq) * 64, &s_slot); if (li >= 192) break;
              const int cfg = li >> 6, r6 = li & 63; const int pr = xq * 2 + (r6 >> 5); attn_item(p, 1, cfg * 512 + (pr >> 2) * 128 + (pr & 3) * 32 + (r6 & 31), smem); } }
        for (;;) { const int it = next_item(cnt + (2 + l) * 64, &s_slot); if (it >= 512) break; gla1_item(p, l, it, smem); }
        xcd_barrier(xb);
        m2_phase(p, smem);
        xcd_barrier(xb);
        for (int it = blockIdx.x; it < 512; it += gridDim.x) gla3_item(p, l, it, smem);
        for (int it = blockIdx.x; it < 512; it += gridDim.x) lru3_item(p, it);
        for (int it = blockIdx.x; it < 2048; it += gridDim.x) dilc_item(p, it);
        xcd_barrier(xb);
        g2_phase(p, l, smem);
        xcd_barrier(xb);
    }
    ln_phase(p, DEPTH);
}

extern "C" void kernel_launch(void* const* d_in, const int* in_sizes, int n_in, void* d_out, int out_size, void* d_ws, size_t ws_size, hipStream_t stream) {
    static int grid_blocks = 0;
    if (!grid_blocks) {
        int dev = 0, cus = 0, per_cu = 0;
        hipGetDevice(&dev);
        hipDeviceGetAttribute(&cus, hipDeviceAttributeMultiprocessorCount, dev);
        hipOccupancyMaxActiveBlocksPerMultiprocessor(&per_cu, (const void*)fwd_megakernel, 256, 0);
        if (per_cu < 1) per_cu = 1;
        if (per_cu > 2) per_cu = 2;
        grid_blocks = cus * per_cu;
        if (ws_size < WS_END) fprintf(stderr, "kernel_launch: workspace too small: %zu < %zu\n", ws_size, (size_t)WS_END);
    }
    Params p{};
    p.x = (const float*)d_in[0]; p.c = (const float*)d_in[1]; p.pos = (const int*)d_in[2];
    p.w_mod = (const float*)d_in[3]; p.b_mod = (const float*)d_in[4]; p.w_in = (const float*)d_in[5];
    p.conv_w = (const float*)d_in[6]; p.conv_b = (const float*)d_in[7]; p.lru_wa = (const float*)d_in[8]; p.lru_ba = (const float*)d_in[9];
    p.lru_wx = (const float*)d_in[10]; p.lru_bx = (const float*)d_in[11]; p.lru_lam = (const float*)d_in[12];
    p.gla_wr = (const float*)d_in[13]; p.gla_br = (const float*)d_in[14]; p.gla_gn = (const float*)d_in[15];
    p.w_out = (const float*)d_in[16]; p.ln_g = (const float*)d_in[17]; p.ln_b = (const float*)d_in[18];
    p.out = (float*)d_out; p.ws = (unsigned char*)d_ws;
    (void)hipMemsetAsync(d_ws, 0, 32768, stream);
    void* args[] = {&p};
    hipError_t e = hipLaunchCooperativeKernel((const void*)fwd_megakernel, dim3(grid_blocks), dim3(256), args, 0, stream);
    if (e != hipSuccess) fprintf(stderr, "cooperative launch failed: %s (grid %d)\n", hipGetErrorString(e), grid_blocks);
}
```

```cpp
#include <hip/hip_runtime.h>
#include <hip/hip_cooperative_groups.h>
#include <cstdio>
#include <cstdint>
#include <type_traits>
namespace cg = cooperative_groups;

typedef unsigned short bf16_t;
typedef short bf16x8 __attribute__((ext_vector_type(8)));
typedef short bf16x4 __attribute__((ext_vector_type(4)));
typedef float f32x4 __attribute__((ext_vector_type(4)));
typedef unsigned u32x4 __attribute__((ext_vector_type(4)));
typedef unsigned u32x2 __attribute__((ext_vector_type(2)));

constexpr int D = 1024, NB = 4, S = 4096, T = NB * S, DEPTH = 2;
constexpr int DIN = 3344, ZP = 3344, NPAD = 3456;
constexpr int C_AQ = 0, C_AK = 256, C_AV = 512, C_AG = 768, C_BX = 1024, C_BG = 1280, C_CQ = 1536, C_CK = 1792,
              C_CV = 2048, C_CG = 2304, C_DQ = 2560, C_DK = 2688, C_DV = 2816, C_DG = 3072, C_DR = 3328;
constexpr float DN_ALPHA = 1.4142135623730951f;
constexpr int LDP = 72;
constexpr int SMEM_BYTES = 65536;
constexpr int BIG = 1000000;

constexpr size_t WS_CTL = 0;
constexpr size_t WS_CNT = 16384;
constexpr size_t WS_WINT = 32768;
constexpr size_t WS_WOUTT = WS_WINT + (size_t)DEPTH * NPAD * 1024 * 2;
constexpr size_t WS_MOD = WS_WOUTT + (size_t)DEPTH * 1024 * 1024 * 2;
constexpr size_t WS_COS = WS_MOD + (size_t)DEPTH * NB * 3072 * 4;
constexpr size_t WS_SIN = WS_COS + (size_t)T * 32 * 4;
constexpr size_t WS_U = WS_SIN + (size_t)T * 32 * 4;
constexpr size_t WS_Z = WS_U + (size_t)T * 1024 * 2;
constexpr size_t WS_KPART = WS_Z + (size_t)T * ZP * 2;
constexpr size_t WS_DILO = WS_KPART + (size_t)256 * 256 * 4;
constexpr size_t WS_DILL = WS_DILO + (size_t)3 * T * 256 * 2;
constexpr size_t WS_GKV = WS_DILL + (size_t)3 * T * 4 * 4;
constexpr size_t WS_GDEC = WS_GKV + (size_t)2048 * 2048 * 4;
constexpr size_t WS_LH = WS_GDEC + (size_t)2048 * 32 * 4;
constexpr size_t WS_LP = WS_LH + (size_t)T * 256 * 4;
constexpr size_t WS_LC = WS_LP + (size_t)T * 256 * 4;
constexpr size_t WS_LWT = WS_LC + (size_t)NB * 128 * 256 * 4;
constexpr size_t WS_BC = WS_LWT + (size_t)DEPTH * 2 * 4 * 64 * 64 * 2;
constexpr size_t WS_END = WS_BC + (size_t)512 * 32 * 128 * 4;

struct Params {
    const float *x, *c; const int* pos;
    const float *w_mod, *b_mod, *w_in, *conv_w, *conv_b, *lru_wa, *lru_ba, *lru_wx, *lru_bx, *lru_lam, *gla_wr, *gla_br, *gla_gn, *w_out, *ln_g, *ln_b;
    float* out; unsigned char* ws;
};

__device__ __forceinline__ float bf2f(bf16_t h) { return __uint_as_float(((unsigned)h) << 16); }
typedef __bf16 hbf16x2 __attribute__((ext_vector_type(2)));
typedef float f32x2 __attribute__((ext_vector_type(2)));
__device__ __forceinline__ unsigned pack2(float a, float b) { f32x2 v = {a, b}; hbf16x2 r = __builtin_convertvector(v, hbf16x2); return __builtin_bit_cast(unsigned, r); }
__device__ __forceinline__ bf16_t f2bf(float f) { return (bf16_t)(pack2(f, 0.f) & 0xffffu); }
__device__ __forceinline__ float silu_f(float x) { return x / (1.f + __expf(-x)); }
__device__ __forceinline__ float sigmoid_f(float x) { return 1.f / (1.f + __expf(-x)); }
__device__ __forceinline__ int tid_opq() { int t = threadIdx.x; asm volatile("" : "+v"(t)); return t; }
__device__ __forceinline__ float x16_sum(float v) { auto r = __builtin_amdgcn_permlane16_swap(__float_as_uint(v), __float_as_uint(v), false, false); return __uint_as_float(r[0]) + __uint_as_float(r[1]); }
__device__ __forceinline__ float x32_sum(float v) { auto r = __builtin_amdgcn_permlane32_swap(__float_as_uint(v), __float_as_uint(v), false, false); return __uint_as_float(r[0]) + __uint_as_float(r[1]); }
__device__ __forceinline__ float x16_max(float v) { auto r = __builtin_amdgcn_permlane16_swap(__float_as_uint(v), __float_as_uint(v), false, false); return fmaxf(__uint_as_float(r[0]), __uint_as_float(r[1])); }
__device__ __forceinline__ float x32_max(float v) { auto r = __builtin_amdgcn_permlane32_swap(__float_as_uint(v), __float_as_uint(v), false, false); return fmaxf(__uint_as_float(r[0]), __uint_as_float(r[1])); }
__device__ __forceinline__ float row16_sum(float v) {
    v += __uint_as_float(__builtin_amdgcn_update_dpp(0u, __float_as_uint(v), 0x128, 0xf, 0xf, false));
    v += __uint_as_float(__builtin_amdgcn_update_dpp(0u, __float_as_uint(v), 0x124, 0xf, 0xf, false));
    v += __uint_as_float(__builtin_amdgcn_update_dpp(0u, __float_as_uint(v), 0x122, 0xf, 0xf, false));
    v += __uint_as_float(__builtin_amdgcn_update_dpp(0u, __float_as_uint(v), 0x121, 0xf, 0xf, false));
    return v;
}
__device__ __forceinline__ float wsum(float v) { return x32_sum(x16_sum(row16_sum(v))); }

#define XB_TMO      128
#define XB_XCNT(j)  (256  + 64 * (j))
#define XB_XSUB(j)  (1280 + 64 * (j))
#define XB_XGEN(j)  (2304 + 64 * (j))
#define XB_TOP      3328
#define XB_TOPGEN   3392
#define XCD_BAR_WORDS 3456
#define XB_SPIN_CAP (1u << 18)
#define LAS __attribute__((address_space(3)))
__device__ __forceinline__ unsigned xb_ld(unsigned* p)              { return __hip_atomic_load(p, __ATOMIC_RELAXED, __HIP_MEMORY_SCOPE_AGENT); }
__device__ __forceinline__ unsigned xb_add(unsigned* p, unsigned v) { return __hip_atomic_fetch_add(p, v, __ATOMIC_RELAXED, __HIP_MEMORY_SCOPE_AGENT); }
__device__ __forceinline__ unsigned xb_xcc_id() { return (unsigned)__builtin_amdgcn_s_getreg((3 << 11) | 20) & 0xFu; }
#define XB_SPIN(cond, bar) do { unsigned _sp = 0; while (cond) { __builtin_amdgcn_s_sleep(1); \
    if ((++_sp & 255u) == 0u) { if (xb_ld(&(bar)[XB_TMO])) break; if (_sp > XB_SPIN_CAP) { atomicAdd(&(bar)[XB_TMO], 1u); break; } } } } while (0)
struct XcdBarrier { unsigned* bar; unsigned x; volatile LAS unsigned* st; };
__device__ __forceinline__ XcdBarrier xcd_barrier_post(unsigned* bar, volatile LAS unsigned* st) {
    XcdBarrier b; b.bar = bar; b.x = xb_xcc_id(); b.st = st;
    if (threadIdx.x == 0) (void)xb_add(&bar[XB_XCNT(b.x)], 1u);
    return b;
}
__device__ __forceinline__ void xcd_barrier_complete(unsigned* bar, unsigned x, unsigned& nloc, unsigned& nx) {
    const unsigned G = gridDim.x * gridDim.y * gridDim.z;
    unsigned sum, cnt, mine, sp = 0u;
    for (;;) {
        sum = 0u; cnt = 0u; mine = 0u;
#pragma unroll
        for (unsigned j = 0; j < 16; ++j) { const unsigned c = xb_ld(&bar[XB_XCNT(j)]); sum += c; cnt += (c > 0u) ? 1u : 0u; mine = (j == x) ? c : mine; }
        if (sum == G) break;
        __builtin_amdgcn_s_sleep(1);
        if ((++sp & 255u) == 0u) { if (xb_ld(&bar[XB_TMO])) break; if (sp > XB_SPIN_CAP) { atomicAdd(&bar[XB_TMO], 1u); break; } }
    }
    nloc = mine > 0u ? mine : 1u; nx = cnt > 0u ? cnt : 1u;
}
__device__ __forceinline__ void xcd_barrier(const XcdBarrier& b) {
    asm volatile("s_waitcnt vmcnt(0)" ::: "memory");
    __syncthreads();
    if (threadIdx.x == 0) {
        unsigned* bar = b.bar;
        __builtin_amdgcn_s_waitcnt(0);
        unsigned nloc = b.st[0], nx = b.st[1];
        if (nloc == 0u) { xcd_barrier_complete(bar, b.x, nloc, nx); b.st[0] = nloc; b.st[1] = nx; }
        const unsigned old = xb_add(&bar[XB_XSUB(b.x)], 1u);
        const unsigned gen = old / nloc;
        if (old + 1u == (gen + 1u) * nloc) {
            __builtin_amdgcn_fence(__ATOMIC_RELEASE, "agent");
            asm volatile("s_waitcnt vmcnt(0)" ::: "memory");
            const unsigned og = xb_add(&bar[XB_TOP], 1u);
            const unsigned tg = og / nx;
            if (og + 1u == (tg + 1u) * nx) xb_add(&bar[XB_TOPGEN], 1u);
            else XB_SPIN(xb_ld(&bar[XB_TOPGEN]) == tg, bar);
            __builtin_amdgcn_fence(__ATOMIC_ACQUIRE, "agent");
            xb_add(&bar[XB_XGEN(b.x)], 1u);
            asm volatile("s_waitcnt vmcnt(0)" ::: "memory");
        } else {
            XB_SPIN(xb_ld(&bar[XB_XGEN(b.x)]) == gen, bar);
            __builtin_amdgcn_fence(__ATOMIC_ACQUIRE, "agent");
            asm volatile("s_waitcnt vmcnt(0)" ::: "memory");
        }
    }
    __syncthreads();
}
__device__ __forceinline__ int next_item(unsigned* ctr, volatile int* slot) {
    __syncthreads();
    if (threadIdx.x == 0) *slot = (int)atomicAdd(ctr, 1u);
    __syncthreads();
    return *slot;
}

__device__ void prologue_phase(const Params& p, char* smem) {
    const int t = tid_opq();
    bf16_t* WinT = (bf16_t*)(p.ws + WS_WINT); bf16_t* WoutT = (bf16_t*)(p.ws + WS_WOUTT);
    float* mod = (float*)(p.ws + WS_MOD); float* cosT = (float*)(p.ws + WS_COS); float* sinT = (float*)(p.ws + WS_SIN);
    float* tl = (float*)smem;
    constexpr int N_TIN = DEPTH * 16 * 54, N_TOUT = DEPTH * 16 * 16, N_MOD = DEPTH * 192, N_ROPE = T * 32 / 256, N_LWT = DEPTH * 2 * 4 * 64 * 64 / 256;
    constexpr int NITEMS = N_TIN + N_TOUT + N_MOD + N_ROPE + N_LWT;
    for (int it = blockIdx.x; it < NITEMS; it += gridDim.x) {
        if (it < N_TIN + N_TOUT) {
            const float* src; bf16_t* dst; int ncols, kt, nt;
            if (it < N_TIN) { int l = it / (16 * 54), r = it % (16 * 54); kt = r / 54; nt = r % 54; src = p.w_in + (size_t)l * 1024 * DIN; dst = WinT + (size_t)l * NPAD * 1024; ncols = DIN; }
            else { int i2 = it - N_TIN; int l = i2 / 256, r = i2 % 256; kt = r / 16; nt = r % 16; src = p.w_out + (size_t)l * 1024 * 1024; dst = WoutT + (size_t)l * 1024 * 1024; ncols = 1024; }
            __syncthreads();
            { const int c4 = t & 15, r0 = t >> 4; const int n = nt * 64 + c4 * 4;
              f32x4 v[4];
#pragma unroll
              for (int i = 0; i < 4; ++i) { const int r = r0 + 16 * i; v[i] = (n < ncols) ? *(const f32x4*)(src + (size_t)(kt * 64 + r) * ncols + n) : (f32x4){0.f, 0.f, 0.f, 0.f}; }
#pragma unroll
              for (int i = 0; i < 4; ++i) { const int r = r0 + 16 * i; tl[r * 65 + c4 * 4] = v[i][0]; tl[r * 65 + c4 * 4 + 1] = v[i][1]; tl[r * 65 + c4 * 4 + 2] = v[i][2]; tl[r * 65 + c4 * 4 + 3] = v[i][3]; } }
            __syncthreads();
            {
#pragma unroll
              for (int i = 0; i < 2; ++i) { const int cc = t + 256 * i; const int n = cc >> 3, k8 = (cc & 7) * 8;
                  u32x4 pk; pk.x = pack2(tl[(k8 + 0) * 65 + n], tl[(k8 + 1) * 65 + n]); pk.y = pack2(tl[(k8 + 2) * 65 + n], tl[(k8 + 3) * 65 + n]);
                  pk.z = pack2(tl[(k8 + 4) * 65 + n], tl[(k8 + 5) * 65 + n]); pk.w = pack2(tl[(k8 + 6) * 65 + n], tl[(k8 + 7) * 65 + n]);
                  *(u32x4*)(dst + (size_t)(nt * 64 + n) * 1024 + kt * 64 + k8) = pk; } }
        } else if (it < N_TIN + N_TOUT + N_MOD) {
            const int i2 = it - N_TIN - N_TOUT; const int l = i2 / 192, jg = i2 % 192;
            const int jj = t & 15, ks = t >> 4; const int j = jg * 16 + jj;
            float a0 = 0.f, a1 = 0.f, a2 = 0.f, a3 = 0.f;
            const float* wm = p.w_mod + (size_t)l * 1024 * 3072 + j;
#pragma unroll 8
            for (int k = ks * 64; k < ks * 64 + 64; ++k) { float wv = wm[(size_t)k * 3072]; a0 += p.c[k] * wv; a1 += p.c[1024 + k] * wv; a2 += p.c[2048 + k] * wv; a3 += p.c[3072 + k] * wv; }
            __syncthreads();
            tl[(0 * 16 + ks) * 16 + jj] = a0; tl[(1 * 16 + ks) * 16 + jj] = a1; tl[(2 * 16 + ks) * 16 + jj] = a2; tl[(3 * 16 + ks) * 16 + jj] = a3;
            __syncthreads();
            if (t < 64) { const int b = t >> 4, j2 = t & 15; float s = 0.f;
#pragma unroll
              for (int k2 = 0; k2 < 16; ++k2) s += tl[(b * 16 + k2) * 16 + j2];
              mod[((size_t)l * NB + b) * 3072 + jg * 16 + j2] = s + p.b_mod[l * 3072 + jg * 16 + j2]; }
        } else if (it >= N_TIN + N_TOUT + N_MOD + N_ROPE) {
            const int e = (it - N_TIN - N_TOUT - N_MOD - N_ROPE) * 256 + t;
            const int in = e & 63, out = (e >> 6) & 63, g = (e >> 12) & 3, mat = (e >> 14) & 1, l = e >> 15;
            const float* src = mat ? p.lru_wx : p.lru_wa;
            ((bf16_t*)(p.ws + WS_LWT))[e] = f2bf(src[l * 16384 + g * 4096 + in * 64 + out]);
        } else {
            const int i2 = it - N_TIN - N_TOUT - N_MOD; const int e = i2 * 256 + t; const int tok = e >> 5, f = e & 31;
            const float inv = exp2f(-(float)f * (13.287712379549449f / 32.f));
            const float ang = (float)p.pos[tok] * inv;
            double rev = (double)ang * 0.15915494309189535; rev -= __builtin_rint(rev);
            const float rr = (float)rev; cosT[e] = __builtin_amdgcn_cosf(rr); sinT[e] = __builtin_amdgcn_sinf(rr);
        }
    }
}

__device__ void ln_phase(const Params& p, int l) {
    const int t = tid_opq(), lane = t & 63, w = t >> 6;
    bf16_t* ubuf = (bf16_t*)(p.ws + WS_U); const float* mod = (const float*)(p.ws + WS_MOD);
    for (int rg = blockIdx.x; rg < T / 16; rg += gridDim.x) {
        f32x4 v[4][4];
#pragma unroll
        for (int r = 0; r < 4; ++r) { const int row = rg * 16 + w * 4 + r; const float* src = (l <= 1) ? p.x + (size_t)row * 1024 : p.out + (size_t)row * 1024;
#pragma unroll
            for (int i = 0; i < 4; ++i) v[r][i] = *(const f32x4*)(src + i * 256 + lane * 4);
            if (l > 0) {
                const bf16_t* yr = (const bf16_t*)(p.ws + WS_Z) + (size_t)row * 1024; const float* gate = mod + ((size_t)(l - 1) * NB + row / S) * 3072 + 2048;
#pragma unroll
                for (int i = 0; i < 4; ++i) { const u32x2 yv = *(const u32x2*)(yr + i * 256 + lane * 4); const f32x4 g1 = *(const f32x4*)(gate + i * 256 + lane * 4) + 1.f;
                    const f32x4 yf = {__uint_as_float(yv.x << 16), __uint_as_float(yv.x & 0xffff0000u), __uint_as_float(yv.y << 16), __uint_as_float(yv.y & 0xffff0000u)};
                    v[r][i] = v[r][i] * DN_ALPHA + g1 * yf; }
            } }
#pragma unroll
        for (int r = 0; r < 4; ++r) {
            const int row = rg * 16 + w * 4 + r; const int b = row / S;
            if (l > 0) {
                float s = 0.f;
#pragma unroll
                for (int i = 0; i < 4; ++i) s += (v[r][i][0] + v[r][i][1]) + (v[r][i][2] + v[r][i][3]);
                const float mu = wsum(s) * (1.f / 1024.f); float q = 0.f;
#pragma unroll
                for (int i = 0; i < 4; ++i) { f32x4 d = v[r][i] - mu; q += (d[0] * d[0] + d[1] * d[1]) + (d[2] * d[2] + d[3] * d[3]); }
                const float rstd = rsqrtf(wsum(q) * (1.f / 1024.f) + 1e-5f);
#pragma unroll
                for (int i = 0; i < 4; ++i) { const f32x4 g = *(const f32x4*)(p.ln_g + (l - 1) * 1024 + i * 256 + lane * 4), bb = *(const f32x4*)(p.ln_b + (l - 1) * 1024 + i * 256 + lane * 4);
                    v[r][i] = (v[r][i] - mu) * rstd * g + bb; *(f32x4*)(p.out + (size_t)row * 1024 + i * 256 + lane * 4) = v[r][i]; }
            }
            if (l < DEPTH) {
                float s = 0.f;
#pragma unroll
                for (int i = 0; i < 4; ++i) s += (v[r][i][0] + v[r][i][1]) + (v[r][i][2] + v[r][i][3]);
                const float mu = wsum(s) * (1.f / 1024.f); float q = 0.f;
#pragma unroll
                for (int i = 0; i < 4; ++i) { f32x4 d = v[r][i] - mu; q += (d[0] * d[0] + d[1] * d[1]) + (d[2] * d[2] + d[3] * d[3]); }
                const float rstd = rsqrtf(wsum(q) * (1.f / 1024.f) + 1e-5f);
                const float* mb = mod + ((size_t)l * NB + b) * 3072;
#pragma unroll
                for (int i = 0; i < 4; ++i) { const int col = i * 256 + lane * 4; const f32x4 sh = *(const f32x4*)(mb + col), sc = *(const f32x4*)(mb + 1024 + col);
                    f32x4 u = (v[r][i] - mu) * rstd * (sc + 1.f) + sh; u32x2 pk; pk.x = pack2(u[0], u[1]); pk.y = pack2(u[2], u[3]);
                    *(u32x2*)(ubuf + (size_t)row * 1024 + col) = pk; }
            }
        }
    }
}

__device__ __forceinline__ int lds_off(int r, int c8) {
    const int st = (r >> 4) * 2 + (c8 >> 2); const int ob = (r & 15) * 64 + (c8 & 3) * 16;
    return st * 1024 + (ob ^ (((ob >> 9) & 1) << 5));
}
struct RegSet { u32x4 a[4], b[4]; };
__device__ __forceinline__ void gemm_tile(const bf16_t* __restrict__ A, const bf16_t* __restrict__ Bt, int tm, int tn, bool first, bool has_next, int ntm, int ntn,
                                          char* sm, f32x4 (&acc)[4][4], RegSet& r0, RegSet& r1) {
    const int t = tid_opq(), lane = t & 63, w = t >> 6, wm = w >> 1, wn = w & 1, r16 = lane & 15, quad = lane >> 4;
    const int lrow = t >> 3, lch = t & 7;
    constexpr int BUF = 32768;
    const unsigned loff = (unsigned)(lrow * 1024 + lch * 8);
    const bf16_t* At0 = A + (size_t)tm * (128 * 1024); const bf16_t* Bt0 = Bt + (size_t)tn * (128 * 1024);
    const bf16_t* At1 = A + (size_t)ntm * (128 * 1024); const bf16_t* Bt1 = Bt + (size_t)ntn * (128 * 1024);
#define Ag (At0 + loff)
#define Bg (Bt0 + loff)
#define nAg (At1 + loff)
#define nBg (Bt1 + loff)
    const int woff0 = lds_off(lrow, lch);
#define woff(i) (woff0 + 4096 * (i))
    const int fo = lds_off(r16, quad);
#pragma unroll
    for (int a = 0; a < 4; ++a)
#pragma unroll
        for (int b = 0; b < 4; ++b) acc[a][b] = (f32x4){0.f, 0.f, 0.f, 0.f};
    if (first) {
#pragma unroll
        for (int i = 0; i < 4; ++i) { r0.a[i] = *(const u32x4*)(Ag + (size_t)i * 32 * 1024); r0.b[i] = *(const u32x4*)(Bg + (size_t)i * 32 * 1024); }
#pragma unroll
        for (int i = 0; i < 4; ++i) { r1.a[i] = *(const u32x4*)(Ag + (size_t)i * 32 * 1024 + 64); r1.b[i] = *(const u32x4*)(Bg + (size_t)i * 32 * 1024 + 64); }
        __syncthreads();
#pragma unroll
        for (int i = 0; i < 4; ++i) { *(u32x4*)(sm + woff(i)) = r0.a[i]; *(u32x4*)(sm + 16384 + woff(i)) = r0.b[i]; }
#pragma unroll
        for (int i = 0; i < 4; ++i) { r0.a[i] = *(const u32x4*)(Ag + (size_t)i * 32 * 1024 + 128); r0.b[i] = *(const u32x4*)(Bg + (size_t)i * 32 * 1024 + 128); }
    }
    __syncthreads();
    auto step = [&](auto main_tag, int kt, RegSet& rs) {
        constexpr bool MAIN = decltype(main_tag)::value;
        const char* sA = sm + (kt & 1) * BUF; const char* sB = sA + 16384;
        char* nA = sm + ((kt + 1) & 1) * BUF; char* nB = nA + 16384;
        const bool wr = MAIN || kt + 1 < 16 || has_next;
        const bool own = MAIN || kt + 3 < 16;
        const bf16_t* la = own ? Ag + (kt + 3) * 64 : nAg + (kt - 13) * 64; const bf16_t* lb = own ? Bg + (kt + 3) * 64 : nBg + (kt - 13) * 64;
        __builtin_amdgcn_s_setprio(1);
#pragma unroll
        for (int ks = 0; ks < 2; ++ks) {
            bf16x8 af[4], bfr[4];
#pragma unroll
            for (int mt = 0; mt < 4; ++mt) af[mt] = *(const bf16x8*)(sA + ((wm * 4 + mt) * 2 + ks) * 1024 + fo);
#pragma unroll
            for (int nt = 0; nt < 4; ++nt) bfr[nt] = *(const bf16x8*)(sB + ((wn * 4 + nt) * 2 + ks) * 1024 + fo);
#pragma unroll
            for (int mt = 0; mt < 4; ++mt) {
#pragma unroll
                for (int nt = 0; nt < 4; ++nt) acc[mt][nt] = __builtin_amdgcn_mfma_f32_16x16x32_bf16(bfr[nt], af[mt], acc[mt][nt], 0, 0, 0);
                const int i = ks * 2 + (mt >> 1);
                __builtin_amdgcn_sched_barrier(0);
                if ((mt & 1) == 0) { if (wr) *(u32x4*)(nA + woff(i)) = rs.a[i]; if (own || has_next) rs.a[i] = *(const u32x4*)(la + (size_t)i * 32 * 1024); }
                else               { if (wr) *(u32x4*)(nB + woff(i)) = rs.b[i]; if (own || has_next) rs.b[i] = *(const u32x4*)(lb + (size_t)i * 32 * 1024); }
                __builtin_amdgcn_sched_barrier(0);
            }
        }
        __builtin_amdgcn_s_setprio(0);
        __syncthreads();
    };
    {
        std::true_type mt_; std::false_type tl_;
        for (int k2 = 0; k2 < 6; ++k2) { step(mt_, 2 * k2, r1); step(mt_, 2 * k2 + 1, r0); }
        step(mt_, 12, r1); step(tl_, 13, r0); step(tl_, 14, r1); step(tl_, 15, r0);
    }
#undef Ag
#undef Bg
#undef nAg
#undef nBg
#undef woff
}

__device__ void g1_phase(const Params& p, int l, char* smem) {
    const int t = tid_opq(), lane = t & 63, w = t >> 6, wm = w >> 1, wn = w & 1, r16 = lane & 15, quad = lane >> 4;
    char* sm = smem; char* sC = smem + 32768;
    const bf16_t* ubuf = (const bf16_t*)(p.ws + WS_U); const bf16_t* WinT = (const bf16_t*)(p.ws + WS_WINT) + (size_t)l * NPAD * 1024;
    bf16_t* z = (bf16_t*)(p.ws + WS_Z); float* kpart = (float*)(p.ws + WS_KPART);
    const float* cosT = (const float*)(p.ws + WS_COS); const float* sinT = (const float*)(p.ws + WS_SIN);
    const bool xo = (gridDim.x & 7) == 0; const int xcd = blockIdx.x & 7, nloc = xo ? (int)(gridDim.x >> 3) : (int)gridDim.x, j0 = xo ? (int)(blockIdx.x >> 3) : (int)blockIdx.x;
    const int lim = xo ? 16 * 27 : 128 * 27;
    RegSet r0, r1;
    for (int L = j0; L < lim; L += nloc) {
        const int tm = xo ? xcd * 16 + (L / 216) * 8 + (L & 7) : L / 27, tn = xo ? ((L % 216) >> 3) : L % 27;
        const int L2 = L + nloc; const bool has_next = L2 < lim;
        const int ntm = has_next ? (xo ? xcd * 16 + (L2 / 216) * 8 + (L2 & 7) : L2 / 27) : tm, ntn = has_next ? (xo ? ((L2 % 216) >> 3) : L2 % 27) : tn;
        f32x4 acc[4][4];
        gemm_tile(ubuf, WinT, tm, tn, L == j0, has_next, ntm, ntn, sm, acc, r0, r1);
        const bool rope = (tn < 4) || (tn >= 12 && tn < 16);
        if (rope) {
#pragma unroll
            for (int mt = 0; mt < 4; ++mt) {
                const int tok = tm * 128 + wm * 64 + mt * 16 + r16;
#pragma unroll
                for (int nt = 0; nt < 2; ++nt) {
                    const f32x4 cs = *(const f32x4*)(cosT + (size_t)tok * 32 + nt * 16 + quad * 4), sn = *(const f32x4*)(sinT + (size_t)tok * 32 + nt * 16 + quad * 4);
                    const f32x4 x1 = acc[mt][nt], x2 = acc[mt][nt + 2];
                    acc[mt][nt] = x1 * cs - x2 * sn; acc[mt][nt + 2] = x1 * sn + x2 * cs;
                }
            }
        }
        if (tn == 2 || tn == 3) {
#pragma unroll
            for (int nt = 0; nt < 4; ++nt) {
                f32x4 sv = (acc[0][nt] + acc[1][nt]) + (acc[2][nt] + acc[3][nt]);
#pragma unroll
                for (int jj = 0; jj < 4; ++jj) { sv[jj] = row16_sum(sv[jj]); }
                if (r16 == 0) *(f32x4*)(kpart + (size_t)(tm * 2 + wm) * 256 + (tn - 2) * 128 + wn * 64 + nt * 16 + quad * 4) = sv;
            }
        }
#pragma unroll
        for (int mt = 0; mt < 4; ++mt)
#pragma unroll
            for (int nt = 0; nt < 4; ++nt) { u32x2 pk; pk.x = pack2(acc[mt][nt][0], acc[mt][nt][1]); pk.y = pack2(acc[mt][nt][2], acc[mt][nt][3]);
                const int row = wm * 64 + mt * 16 + r16; const int c16 = wn * 8 + nt * 2 + (quad >> 1);
                *(u32x2*)(sC + row * 256 + ((c16 ^ (row & 15)) << 4) + (quad & 1) * 8) = pk; }
        __syncthreads();
#pragma unroll
        for (int i = 0; i < 8; ++i) { const int c = t + 256 * i; const int row = c >> 4, ch = c & 15; const int col = tn * 128 + ch * 8;
            if (col < DIN) *(u32x4*)(z + (size_t)(tm * 128 + row) * ZP + col) = *(const u32x4*)(sC + row * 256 + ((ch ^ (row & 15)) << 4)); }
    }
}

__device__ void g2_phase(const Params& p, int l, char* smem) {
    const int t = tid_opq(), lane = t & 63, w = t >> 6, wm = w >> 1, wn = w & 1, r16 = lane & 15, quad = lane >> 4;
    char* sm = smem; char* sC = smem + 32768;
    const bf16_t* mix = (const bf16_t*)(p.ws + WS_U); const bf16_t* WoutT = (const bf16_t*)(p.ws + WS_WOUTT) + (size_t)l * 1024 * 1024;
    bf16_t* ybuf = (bf16_t*)(p.ws + WS_Z);
    const bool xo = (gridDim.x & 7) == 0; const int xcd = blockIdx.x & 7, nloc = xo ? (int)(gridDim.x >> 3) : (int)gridDim.x, j0 = xo ? (int)(blockIdx.x >> 3) : (int)blockIdx.x;
    const int lim = xo ? 16 * 8 : 128 * 8;
    RegSet r0, r1;
    for (int L = j0; L < lim; L += nloc) {
        const int tm = xo ? xcd * 16 + (L & 15) : (L >> 3), tn = xo ? (L >> 4) : (L & 7);
        const int L2 = L + nloc; const bool has_next = L2 < lim;
        const int ntm = has_next ? (xo ? xcd * 16 + (L2 & 15) : (L2 >> 3)) : tm, ntn = has_next ? (xo ? (L2 >> 4) : (L2 & 7)) : tn;
        f32x4 acc[4][4];
        gemm_tile(mix, WoutT, tm, tn, L == j0, has_next, ntm, ntn, sm, acc, r0, r1);
#pragma unroll
        for (int mt = 0; mt < 4; ++mt)
#pragma unroll
            for (int nt = 0; nt < 4; ++nt) { u32x2 pk; pk.x = pack2(acc[mt][nt][0], acc[mt][nt][1]); pk.y = pack2(acc[mt][nt][2], acc[mt][nt][3]);
                const int row = wm * 64 + mt * 16 + r16; const int c16 = wn * 8 + nt * 2 + (quad >> 1);
                *(u32x2*)(sC + row * 256 + ((c16 ^ (row & 15)) << 4) + (quad & 1) * 8) = pk; }
        __syncthreads();
#pragma unroll
        for (int i = 0; i < 8; ++i) { const int c = t + 256 * i; const int row = c >> 4, ch = c & 15;
            *(u32x4*)(ybuf + (size_t)(tm * 128 + row) * 1024 + tn * 128 + ch * 8) = *(const u32x4*)(sC + row * 256 + ((ch ^ (row & 15)) << 4)); }
    }
}

constexpr float ATT_SC = 0.18033688011112042f;
template <int QT>
__device__ __forceinline__ void attn_tile(const bf16_t* sK, const bf16_t* sV, const bf16x8 (&qf)[QT][2], int lo, int hi, bool full, bool hasq, bool qfl0, bool qfl1,
                                          float (&m)[QT], float (&l)[QT], f32x4 (&O)[QT][4], int wq0) {
    const int lane = tid_opq() & 63, r16 = lane & 15, quad = lane >> 4;
    f32x4 s[QT][4];
#pragma unroll
    for (int a = 0; a < QT; ++a)
#pragma unroll
        for (int b = 0; b < 4; ++b) s[a][b] = (f32x4){0.f, 0.f, 0.f, 0.f};
#pragma unroll
    for (int ks = 0; ks < 2; ++ks)
#pragma unroll
        for (int k16 = 0; k16 < 4; ++k16) {
            const bf16x8 kf = *(const bf16x8*)(sK + (k16 * 16 + r16) * LDP + ks * 32 + quad * 8);
#pragma unroll
            for (int qt = 0; qt < QT; ++qt) s[qt][k16] = __builtin_amdgcn_mfma_f32_16x16x32_bf16(kf, qf[qt][ks], s[qt][k16], 0, 0, 0);
        }
#pragma unroll
    for (int qt = 0; qt < QT; ++qt) {
        const int ql = wq0 + qt * 16 + r16; const bool qfl = qt ? qfl1 : qfl0;
        if (!full) {
#pragma unroll
            for (int k16 = 0; k16 < 4; ++k16)
#pragma unroll
                for (int j = 0; j < 4; ++j) { const int dd = ql - (k16 * 16 + quad * 4 + j); const bool valid = dd >= lo && dd <= hi; s[qt][k16][j] = valid ? s[qt][k16][j] : -1e30f; }
        }
        if (hasq) {
#pragma unroll
            for (int k16 = 0; k16 < 4; ++k16)
#pragma unroll
                for (int j = 0; j < 4; ++j) s[qt][k16][j] = qfl ? s[qt][k16][j] : -1e30f;
        }
        float mx = -1e30f;
#pragma unroll
        for (int k16 = 0; k16 < 4; ++k16) mx = fmaxf(mx, fmaxf(fmaxf(s[qt][k16][0], s[qt][k16][1]), fmaxf(s[qt][k16][2], s[qt][k16][3])));
        mx = x32_max(x16_max(mx));
        const float mn = fmaxf(m[qt], mx); const float alpha = __builtin_amdgcn_exp2f((m[qt] - mn) * ATT_SC); m[qt] = mn;
        const float mb = (mn < -1e29f) ? 0.f : mn * ATT_SC;
        float ps = 0.f;
#pragma unroll
        for (int k16 = 0; k16 < 4; ++k16)
#pragma unroll
            for (int j = 0; j < 4; ++j) { const float pv = __builtin_amdgcn_exp2f(s[qt][k16][j] * ATT_SC - mb); ps += pv; s[qt][k16][j] = pv; }
        l[qt] = l[qt] * alpha + ps;
#pragma unroll
        for (int dt = 0; dt < 4; ++dt) O[qt][dt] = O[qt][dt] * alpha;
    }
#pragma unroll
    for (int G = 0; G < 2; ++G) {
        bf16x8 pf[QT];
#pragma unroll
        for (int qt = 0; qt < QT; ++qt) {
            const unsigned a0 = pack2(s[qt][G * 2][0], s[qt][G * 2][1]), a1 = pack2(s[qt][G * 2][2], s[qt][G * 2][3]);
            const unsigned a2 = pack2(s[qt][G * 2 + 1][0], s[qt][G * 2 + 1][1]), a3 = pack2(s[qt][G * 2 + 1][2], s[qt][G * 2 + 1][3]);
            u32x4 pk = {a0, a1, a2, a3}; pf[qt] = __builtin_bit_cast(bf16x8, pk);
        }
#pragma unroll
        for (int dt = 0; dt < 4; ++dt) {
            const bf16_t* v0p = sV + (G * 32 + quad * 4 + (r16 >> 2)) * LDP + dt * 16 + (r16 & 3) * 4;
            const bf16x4 v0 = __builtin_amdgcn_ds_read_tr16_b64_v4i16((__attribute__((address_space(3))) bf16x4*)(v0p));
            const bf16x4 v1 = __builtin_amdgcn_ds_read_tr16_b64_v4i16((__attribute__((address_space(3))) bf16x4*)(v0p + 16 * LDP));
            const bf16x8 vf = {v0[0], v0[1], v0[2], v0[3], v1[0], v1[1], v1[2], v1[3]};
#pragma unroll
            for (int qt = 0; qt < QT; ++qt) O[qt][dt] = __builtin_amdgcn_mfma_f32_16x16x32_bf16(vf, pf[qt], O[qt][dt], 0, 0, 0);
        }
    }
}

__device__ void attn_item(const Params& p, int kind, int idx, char* smem) {
    const int t = tid_opq(), lane = t & 63, w = t >> 6, r16 = lane & 15, quad = lane >> 4;
    bf16_t* sK = (bf16_t*)smem; bf16_t* sV = sK + 128 * LDP;
    const bf16_t* z = (const bf16_t*)(p.ws + WS_Z);
    (void)kind;
    const int cfg = idx >> 9; const int rem = idx & 511; const int b = rem >> 7, h = (rem >> 5) & 3; const int rb = rem & 31;
    const int dil = 1 << (2 * cfg); const int res = rb & (dil - 1), blk = rb >> (2 * cfg);
    const int qbase = b * S + blk * 128 * dil + res, stride = dil, qcol = C_CQ + h * 64, kcol = C_CK + h * 64, vcol = C_CV + h * 64;
    const int ss0 = (blk == 0) ? 1 : 0;
    bf16x8 qf[2][2];
#pragma unroll
    for (int qt = 0; qt < 2; ++qt)
#pragma unroll
        for (int ks = 0; ks < 2; ++ks) qf[qt][ks] = *(const bf16x8*)(z + (size_t)(qbase + (w * 32 + qt * 16 + r16) * stride) * ZP + qcol + ks * 32 + quad * 8);
    float m[2] = {-1e30f, -1e30f}, l[2] = {0.f, 0.f}; f32x4 O[2][4];
#pragma unroll
    for (int a = 0; a < 2; ++a)
#pragma unroll
        for (int c = 0; c < 4; ++c) O[a][c] = (f32x4){0.f, 0.f, 0.f, 0.f};
    const int lrow = t >> 1, lch = (t & 1) * 4;
    u32x4 rk[4], rv[4];
    { const bf16_t* rp = z + (size_t)(b * S + ((blk * 128 - 128 + ss0 * 128 + lrow) * dil + res)) * ZP + lch * 8;
#pragma unroll
      for (int c = 0; c < 4; ++c) { rk[c] = *(const u32x4*)(rp + kcol + c * 8); rv[c] = *(const u32x4*)(rp + vcol + c * 8); } }
    for (int ss = ss0; ss < 2; ++ss) {
        __syncthreads();
#pragma unroll
        for (int c = 0; c < 4; ++c) { *(u32x4*)(sK + lrow * LDP + (lch + c) * 8) = rk[c]; *(u32x4*)(sV + lrow * LDP + (lch + c) * 8) = rv[c]; }
        __syncthreads();
        if (ss + 1 < 2) { const bf16_t* rp = z + (size_t)(b * S + ((blk * 128 + lrow) * dil + res)) * ZP + lch * 8;
#pragma unroll
            for (int c = 0; c < 4; ++c) { rk[c] = *(const u32x4*)(rp + kcol + c * 8); rv[c] = *(const u32x4*)(rp + vcol + c * 8); } }
#pragma unroll
        for (int hf = 0; hf < 2; ++hf) {
            const int kt = ss * 2 + hf; const int lo = kt * 64 - 128, hi = kt * 64;
            const bool need = (w * 32 + 31 >= lo) && (w * 32 - 63 <= hi);
            const bool full = (w * 32 - 63 >= lo) && (w * 32 + 31 <= hi);
            if (need) attn_tile<2>(sK + hf * 64 * LDP, sV + hf * 64 * LDP, qf, lo, hi, full, false, true, true, m, l, O, w * 32);
        }
    }
    bf16_t* dilo = (bf16_t*)(p.ws + WS_DILO); float* dill = (float*)(p.ws + WS_DILL);
#pragma unroll
    for (int qt = 0; qt < 2; ++qt) {
        float lt = l[qt]; lt = x32_sum(x16_sum(lt));
        const float inv = 1.f / lt; const size_t tok = (size_t)(qbase + (w * 32 + qt * 16 + r16) * stride);
#pragma unroll
        for (int dt = 0; dt < 4; ++dt) { const int d0 = dt * 16 + quad * 4; u32x2 o; o.x = pack2(O[qt][dt][0] * inv, O[qt][dt][1] * inv); o.y = pack2(O[qt][dt][2] * inv, O[qt][dt][3] * inv);
            *(u32x2*)(dilo + ((size_t)cfg * T + tok) * 256 + h * 64 + d0) = o; }
        if (quad == 0) dill[((size_t)cfg * T + tok) * 4 + h] = m[qt] * 0.125f + __logf(lt);
    }
}

__device__ void moba_item(const Params& p, int idx, char* smem, bf16_t* outp) {
    const int t = tid_opq(), lane = t & 63, w = t >> 6, r16 = lane & 15, quad = lane >> 4;
    bf16_t* sK = (bf16_t*)smem; bf16_t* sV = sK + 64 * LDP;
    float* stO = (float*)(smem + 18432);
    float* kmean = (float*)(smem + 18432); float* gates = (float*)(smem + 22528);
    float* stM = (float*)(smem + 53248); float* stL = (float*)(smem + 53760);
    unsigned* selm = (unsigned*)(smem + 54272); unsigned char* lists = (unsigned char*)(smem + 54784);
    int* cnt = (int*)(smem + 56832); int4* desc = (int4*)(smem + 56960); int* misc = (int*)(smem + 59008);
    const bf16_t* z = (const bf16_t*)(p.ws + WS_Z);
    const int n = 15 - (idx >> 5); const int rem = idx & 31; const int b = rem >> 3, h = (rem >> 1) & 3, qh = rem & 1;
    const int qbase = b * S + n * 256 + qh * 128, qcol = C_AQ + h * 64, kcol = C_AK + h * 64, vcol = C_AV + h * 64;
    __syncthreads();
    {
        const float* kpart = (const float*)(p.ws + WS_KPART);
        for (int e = t; e < n * 64; e += 256) { const int j = e >> 6, d = e & 63; const float* kp = kpart + (size_t)(b * 64 + j * 4) * 256 + h * 64 + d;
            kmean[e] = ((kp[0] + kp[256]) + (kp[512] + kp[768])) * (1.f / 256.f); }
        if (t < 16) cnt[t] = 0;
        __syncthreads();
        {
            const int ql = t >> 1, half = t & 1; const bf16_t* qp = z + (size_t)(qbase + ql) * ZP + qcol;
            float g[8];
#pragma unroll
            for (int jj = 0; jj < 8; ++jj) g[jj] = 0.f;
#pragma unroll 1
            for (int dc = 0; dc < 8; ++dc) {
                const u32x4 qv = *(const u32x4*)(qp + dc * 8); float qq[8];
#pragma unroll
                for (int e = 0; e < 4; ++e) { qq[2 * e] = __uint_as_float(qv[e] << 16); qq[2 * e + 1] = __uint_as_float(qv[e] & 0xffff0000u); }
#pragma unroll
                for (int jj = 0; jj < 8; ++jj) { const int j = half + 2 * jj; if (j < n) { const float* km = kmean + j * 64 + dc * 8;
#pragma unroll
                    for (int e = 0; e < 8; ++e) g[jj] += qq[e] * km[e]; } }
            }
#pragma unroll
            for (int jj = 0; jj < 8; ++jj) gates[ql * 16 + half + 2 * jj] = g[jj];
        }
        __syncthreads();
        if (t < 128) {
            unsigned msk = 0;
            for (int k = 0; k < 3 && k < n; ++k) { float best = -3.0e38f; int bi = -1;
                for (int j = 0; j < n; ++j) if (!((msk >> j) & 1u)) { const float gv = gates[t * 16 + j]; if (gv > best) { best = gv; bi = j; } }
                if (bi >= 0) msk |= 1u << bi; }
            selm[t] = msk;
            for (int j = 0; j < n; ++j) if ((msk >> j) & 1u) { const int pos = atomicAdd(&cnt[j], 1); lists[j * 128 + pos] = (unsigned char)t; }
        }
        __syncthreads();
        if (t < 128) { for (int j = 0; j < n; ++j) { const int cj = cnt[j]; if (t >= cj && t < ((cj + 15) & ~15)) lists[j * 128 + t] = 255; } }
        {
            const int nown_ = qh * 2 + 2;
            if (t < nown_) desc[t] = make_int4(b * S + n * 256 + t * 64, t * 64 - qh * 128, BIG, -1);
            if (t < 16) {
                int base = nown_; for (int j2 = 0; j2 < t && j2 < n; ++j2) base += ((((cnt[j2] + 15) >> 4) + 3) >> 2) * 4;
                if (t < n) { const int npass = ((((cnt[t] + 15) >> 4) + 3) >> 2);
                    for (int ps = 0; ps < npass; ++ps) for (int kt = 0; kt < 4; ++kt) desc[base + ps * 4 + kt] = make_int4(b * S + t * 256 + kt * 64, ps, kt, t); }
                if (t == 15) { misc[0] = base + ((15 < n) ? ((((cnt[15] + 15) >> 4) + 3) >> 2) * 4 : 0); misc[1] = nown_; }
            }
        }
    }
    __syncthreads();
    const int nd = misc[0], nown = misc[1];
    const int lrow = t >> 2, lch = (t & 3) * 2;
    u32x4 rk0, rk1, rv0, rv1;
    { const int4 d = desc[0]; const bf16_t* rp = z + (size_t)(d.x + lrow) * ZP + lch * 8;
      rk0 = *(const u32x4*)(rp + kcol); rk1 = *(const u32x4*)(rp + kcol + 8); rv0 = *(const u32x4*)(rp + vcol); rv1 = *(const u32x4*)(rp + vcol + 8); }
    bf16x8 nqf[2]; int ngq = 0; bool ngv = false, nhas = false;
    auto prefetch_group = [&](int gi) {
        nhas = false;
        if (gi < nd) { const int4 dg = desc[gi]; const int slot = dg.y * 4 + w; nhas = slot * 16 < cnt[dg.w];
            if (nhas) { const int qi = lists[dg.w * 128 + slot * 16 + r16]; ngv = qi != 255; ngq = ngv ? qi : 0;
#pragma unroll
                for (int ks = 0; ks < 2; ++ks) nqf[ks] = *(const bf16x8*)(z + (size_t)(qbase + ngq) * ZP + qcol + ks * 32 + quad * 8); } }
    };
    prefetch_group(nown);
    {
        bf16x8 qf[2][2];
#pragma unroll
        for (int qt = 0; qt < 2; ++qt)
#pragma unroll
            for (int ks = 0; ks < 2; ++ks) qf[qt][ks] = *(const bf16x8*)(z + (size_t)(qbase + w * 32 + qt * 16 + r16) * ZP + qcol + ks * 32 + quad * 8);
        float m[2] = {-1e30f, -1e30f}, l[2] = {0.f, 0.f}; f32x4 O[2][4];
#pragma unroll
        for (int a = 0; a < 2; ++a)
#pragma unroll
            for (int c = 0; c < 4; ++c) O[a][c] = (f32x4){0.f, 0.f, 0.f, 0.f};
        for (int i = 0; i < nown; ++i) {
            __syncthreads();
            *(u32x4*)(sK + lrow * LDP + lch * 8) = rk0; *(u32x4*)(sK + lrow * LDP + lch * 8 + 8) = rk1;
            *(u32x4*)(sV + lrow * LDP + lch * 8) = rv0; *(u32x4*)(sV + lrow * LDP + lch * 8 + 8) = rv1;
            __syncthreads();
            if (i + 1 < nd) { const int4 d = desc[i + 1]; const bf16_t* rp = z + (size_t)(d.x + lrow) * ZP + lch * 8;
                rk0 = *(const u32x4*)(rp + kcol); rk1 = *(const u32x4*)(rp + kcol + 8); rv0 = *(const u32x4*)(rp + vcol); rv1 = *(const u32x4*)(rp + vcol + 8); }
            const int4 d = desc[i];
            const bool need = (w * 32 + 31 >= d.y) && (w * 32 - 63 <= d.z);
            const bool full = (w * 32 - 63 >= d.y) && (w * 32 + 31 <= d.z);
            if (need) attn_tile<2>(sK, sV, qf, d.y, d.z, full, false, true, true, m, l, O, w * 32);
        }
#pragma unroll
        for (int qt = 0; qt < 2; ++qt) {
            float lt = l[qt]; lt = x32_sum(x16_sum(lt));
            const int ql = w * 32 + qt * 16 + r16;
            if (quad == 0) { stM[ql] = m[qt]; stL[ql] = lt; }
#pragma unroll
            for (int dt = 0; dt < 4; ++dt) *(f32x4*)(stO + ql * 68 + dt * 16 + quad * 4) = O[qt][dt];
        }
    }
    {
        bf16x8 qf[1][2]; float m[1] = {-1e30f}, l[1] = {0.f}; f32x4 O[1][4];
        int gq = 0; bool gv = false, has = false;
        for (int i = nown; i < nd; ++i) {
            __syncthreads();
            *(u32x4*)(sK + lrow * LDP + lch * 8) = rk0; *(u32x4*)(sK + lrow * LDP + lch * 8 + 8) = rk1;
            *(u32x4*)(sV + lrow * LDP + lch * 8) = rv0; *(u32x4*)(sV + lrow * LDP + lch * 8 + 8) = rv1;
            __syncthreads();
            if (i + 1 < nd) { const int4 d = desc[i + 1]; const bf16_t* rp = z + (size_t)(d.x + lrow) * ZP + lch * 8;
                rk0 = *(const u32x4*)(rp + kcol); rk1 = *(const u32x4*)(rp + kcol + 8); rv0 = *(const u32x4*)(rp + vcol); rv1 = *(const u32x4*)(rp + vcol + 8); }
            const int4 d = desc[i];
            if (d.z == 0) {
                has = nhas; gv = ngv; gq = ngq; qf[0][0] = nqf[0]; qf[0][1] = nqf[1];
                m[0] = -1e30f; l[0] = 0.f;
#pragma unroll
                for (int c = 0; c < 4; ++c) O[0][c] = (f32x4){0.f, 0.f, 0.f, 0.f};
                prefetch_group(i + 4);
            }
            if (has) {
                attn_tile<1>(sK, sV, qf, -BIG, BIG, true, false, true, true, m, l, O, 0);
                if (d.z == 3) {
                    float lt = l[0]; lt = x32_sum(x16_sum(lt));
                    if (gv) {
                        const float mo = stM[gq], lo_ = stL[gq]; const float mn = fmaxf(mo, m[0]);
                        const float fa = __builtin_amdgcn_exp2f((mo - mn) * ATT_SC), fb = __builtin_amdgcn_exp2f((m[0] - mn) * ATT_SC);
#pragma unroll
                        for (int dt = 0; dt < 4; ++dt) { float* sp = stO + gq * 68 + dt * 16 + quad * 4; const f32x4 so = *(const f32x4*)sp; *(f32x4*)sp = so * fa + O[0][dt] * fb; }
                        if (quad == 0) { stM[gq] = mn; stL[gq] = lo_ * fa + lt * fb; }
                    }
                }
            }
        }
    }
    __syncthreads();
#pragma unroll
    for (int qt = 0; qt < 2; ++qt) {
        const int ql = w * 32 + qt * 16 + r16; const float inv = 1.f / stL[ql]; const size_t tok = (size_t)(qbase + ql);
#pragma unroll
        for (int dt = 0; dt < 4; ++dt) { const int d0 = dt * 16 + quad * 4; const f32x4 ov = *(const f32x4*)(stO + ql * 68 + d0);
            const u32x2 gvv = *(const u32x2*)(z + tok * ZP + C_AG + h * 64 + d0);
            const float g0 = __uint_as_float(gvv.x << 16), g1 = __uint_as_float(gvv.x & 0xffff0000u), g2 = __uint_as_float(gvv.y << 16), g3 = __uint_as_float(gvv.y & 0xffff0000u);
            u32x2 o; o.x = pack2(ov[0] * inv * silu_f(g0), ov[1] * inv * silu_f(g1)); o.y = pack2(ov[2] * inv * silu_f(g2), ov[3] * inv * silu_f(g3));
            *(u32x2*)(outp + tok * 1024 + h * 64 + d0) = o; }
    }
}

__device__ __forceinline__ void gla_bcum(const Params& p, int l, const bf16_t* z, int tok0, float* bc, float* drs) {
    const int t = tid_opq();
    const int hd = t & 127, ih = t >> 7;
    float wr[16];
#pragma unroll
    for (int r = 0; r < 16; ++r) wr[r] = p.gla_wr[l * 2048 + r * 128 + hd];
    const float br = p.gla_br[l * 128 + hd];
    { const int e0 = t, e1 = t + 256; const bf16_t d0 = z[(size_t)(tok0 + (e0 >> 4)) * ZP + C_DR + (e0 & 15)], d1 = z[(size_t)(tok0 + (e1 >> 4)) * ZP + C_DR + (e1 & 15)];
      drs[e0] = bf2f(d0); drs[e1] = bf2f(d1); }
    __syncthreads();
#pragma unroll
    for (int ii = 0; ii < 16; ++ii) { const int i = ih * 16 + ii; float x = br;
#pragma unroll
        for (int r4 = 0; r4 < 4; ++r4) { const f32x4 dv = *(const f32x4*)(drs + i * 16 + r4 * 4); x += (dv[0] * wr[r4 * 4] + dv[1] * wr[r4 * 4 + 1]) + (dv[2] * wr[r4 * 4 + 2] + dv[3] * wr[r4 * 4 + 3]); }
        bc[i * 128 + hd] = (fminf(x, 0.f) - __logf(1.f + __expf(-fabsf(x)))) * (1.f / 16.f); }
    __syncthreads();
    if (t < 128) { float sacc = 0.f;
#pragma unroll
        for (int i = 0; i < 32; ++i) { sacc += bc[i * 128 + t]; bc[i * 128 + t] = sacc; } }
    __syncthreads();
}

__device__ void gla1_item(const Params& p, int l, int idx, char* smem) {
    const int t = tid_opq(), lane = t & 63, w = t >> 6, r16 = lane & 15, quad = lane >> 4;
    const int b = idx >> 7, c = idx & 127; const int tok0 = b * S + c * 32;
    const bf16_t* z = (const bf16_t*)(p.ws + WS_Z);
    float* bc = (float*)smem; float* drs = (float*)(smem + 16384);
    bf16_t* kdT = (bf16_t*)(smem + 18432) + w * 1024;
    bf16_t* vL = (bf16_t*)(smem + 26624) + w * (32 * LDP);
    float* gkv = (float*)(p.ws + WS_GKV); float* gdec = (float*)(p.ws + WS_GDEC);
    bf16_t kraw[16]; u32x4 vr[4];
#pragma unroll
    for (int i = 0; i < 16; ++i) { const int e = lane + 64 * i; kraw[i] = z[(size_t)(tok0 + (e >> 5)) * ZP + C_DK + w * 32 + (e & 31)]; }
#pragma unroll
    for (int i = 0; i < 4; ++i) { const int cc = lane + 64 * i; vr[i] = *(const u32x4*)(z + (size_t)(tok0 + (cc >> 3)) * ZP + C_DV + w * 64 + (cc & 7) * 8); }
    __syncthreads();
#pragma unroll
    for (int i = 0; i < 4; ++i) { const int cc = lane + 64 * i; *(u32x4*)(vL + (cc >> 3) * LDP + (cc & 7) * 8) = vr[i]; }
    gla_bcum(p, l, z, tok0, bc, drs);
    { float* bcg = (float*)(p.ws + WS_BC) + (size_t)idx * 4096;
#pragma unroll
      for (int i = 0; i < 4; ++i) *(f32x4*)(bcg + (t + 256 * i) * 4) = *(const f32x4*)(bc + (t + 256 * i) * 4); }
#pragma unroll
    for (int i = 0; i < 16; ++i) { const int e = lane + 64 * i; const int j = e >> 5, d = e & 31;
        kdT[d * 32 + j] = f2bf(bf2f(kraw[i]) * __expf(bc[31 * 128 + w * 32 + d] - bc[j * 128 + w * 32 + d])); }
    const int bh = b * 4 + w;
    if (lane < 32) gdec[(bh * 128 + c) * 32 + lane] = __expf(bc[31 * 128 + w * 32 + lane]);
    __syncthreads();
    bf16x8 kf[2];
#pragma unroll
    for (int x = 0; x < 2; ++x) kf[x] = *(const bf16x8*)(kdT + (x * 16 + r16) * 32 + quad * 8);
    float* dst = gkv + (size_t)(bh * 128 + c) * 2048;
#pragma unroll
    for (int dt = 0; dt < 4; ++dt) {
        const bf16_t* v0p = vL + (quad * 8 + (r16 >> 2)) * LDP + dt * 16 + (r16 & 3) * 4;
        const bf16x4 v0 = __builtin_amdgcn_ds_read_tr16_b64_v4i16((__attribute__((address_space(3))) bf16x4*)(v0p));
        const bf16x4 v1 = __builtin_amdgcn_ds_read_tr16_b64_v4i16((__attribute__((address_space(3))) bf16x4*)(v0p + 4 * LDP));
        const bf16x8 vf = {v0[0], v0[1], v0[2], v0[3], v1[0], v1[1], v1[2], v1[3]};
#pragma unroll
        for (int x = 0; x < 2; ++x) {
            const f32x4 r = __builtin_amdgcn_mfma_f32_16x16x32_bf16(vf, kf[x], (f32x4){0.f, 0.f, 0.f, 0.f}, 0, 0, 0);
            *(f32x4*)(dst + (x * 16 + r16) * 64 + dt * 16 + quad * 4) = r;
        }
    }
}

#define OPQ(ptr) asm volatile("" : "+v"(ptr))
__device__ void gla3_item(const Params& p, int l, int idx, char* smem) {
    const int t = tid_opq(), lane = t & 63, w = t >> 6, r16 = lane & 15, quad = lane >> 4;
    const int b = idx >> 7, c = idx & 127; const int tok0 = b * S + c * 32;
    const bf16_t* z = (const bf16_t*)(p.ws + WS_Z); bf16_t* mix = (bf16_t*)(p.ws + WS_U);
    float* bc = (float*)smem; float* drs = (float*)(smem + 16384);
    bf16_t* SL = (bf16_t*)smem + w * (32 * LDP);
    bf16_t* qe = (bf16_t*)(smem + 18432) + w * 1024;
    bf16_t* ke = (bf16_t*)(smem + 26624) + w * 1024;
    bf16_t* vL = (bf16_t*)(smem + 34816) + w * (32 * LDP);
    const float* gkv = (const float*)(p.ws + WS_GKV);
    const int bh = b * 4 + w;
    bf16_t qraw[16], kraw[16];
    { const bf16_t* qp = z + (size_t)(tok0 + (lane >> 5)) * ZP + w * 32 + (lane & 31);
#pragma unroll
      for (int i = 0; i < 16; ++i) { qraw[i] = qp[C_DQ]; kraw[i] = qp[C_DK]; qp += 2 * ZP; OPQ(qp); } }
    u32x4 vr[4]; f32x4 sr[8];
#pragma unroll
    for (int i = 0; i < 4; ++i) { const int cc = lane + 64 * i; vr[i] = *(const u32x4*)(z + (size_t)(tok0 + (cc >> 3)) * ZP + C_DV + w * 64 + (cc & 7) * 8); }
    { const float* Sp = gkv + (size_t)(bh * 128 + c) * 2048;
#pragma unroll
      for (int i = 0; i < 8; ++i) sr[i] = *(const f32x4*)(Sp + (lane + 64 * i) * 4); }
    f32x4 bcr[4];
    { const float* bcg = (const float*)(p.ws + WS_BC) + (size_t)idx * 4096;
#pragma unroll
      for (int i = 0; i < 4; ++i) bcr[i] = *(const f32x4*)(bcg + (t + 256 * i) * 4); }
    __syncthreads();
#pragma unroll
    for (int i = 0; i < 4; ++i) { const int cc = lane + 64 * i; *(u32x4*)(vL + (cc >> 3) * LDP + (cc & 7) * 8) = vr[i]; }
#pragma unroll
    for (int i = 0; i < 4; ++i) *(f32x4*)(bc + (t + 256 * i) * 4) = bcr[i];
    __syncthreads();
#pragma unroll
    for (int i2 = 0; i2 < 16; ++i2) { const int e = lane + 64 * i2; const int i = e >> 5, d = e & 31; const float bcv = bc[i * 128 + w * 32 + d];
        qe[i * 32 + d] = f2bf(bf2f(qraw[i2]) * __expf(bcv) * 0.17677669529663687f); ke[i * 32 + d] = f2bf(bf2f(kraw[i2]) * __expf(-bcv)); }
    __syncthreads();
#pragma unroll
    for (int i = 0; i < 8; ++i) { const int cc = lane + 64 * i; const int d = cc >> 4, v4 = cc & 15; u32x2 pk; pk.x = pack2(sr[i][0], sr[i][1]); pk.y = pack2(sr[i][2], sr[i][3]);
        *(u32x2*)(SL + d * LDP + v4 * 4) = pk; }
    __syncthreads();
    bf16x8 qf[2], kf[2];
#pragma unroll
    for (int x = 0; x < 2; ++x) { qf[x] = *(const bf16x8*)(qe + (x * 16 + r16) * 32 + quad * 8); kf[x] = *(const bf16x8*)(ke + (x * 16 + r16) * 32 + quad * 8); }
    bf16x8 pf[2];
#pragma unroll
    for (int it = 0; it < 2; ++it) {
        f32x4 at[2];
#pragma unroll
        for (int jt = 0; jt < 2; ++jt) { at[jt] = __builtin_amdgcn_mfma_f32_16x16x32_bf16(kf[jt], qf[it], (f32x4){0.f, 0.f, 0.f, 0.f}, 0, 0, 0);
#pragma unroll
            for (int jj = 0; jj < 4; ++jj) at[jt][jj] = (jt * 16 + quad * 4 + jj <= it * 16 + r16) ? at[jt][jj] : 0.f; }
        u32x4 pk = {pack2(at[0][0], at[0][1]), pack2(at[0][2], at[0][3]), pack2(at[1][0], at[1][1]), pack2(at[1][2], at[1][3])};
        pf[it] = __builtin_bit_cast(bf16x8, pk);
    }
    f32x4 O[2][4];
#pragma unroll
    for (int dt = 0; dt < 4; ++dt) {
        const bf16_t* v0p = vL + (quad * 4 + (r16 >> 2)) * LDP + dt * 16 + (r16 & 3) * 4;
        const bf16x4 v0 = __builtin_amdgcn_ds_read_tr16_b64_v4i16((__attribute__((address_space(3))) bf16x4*)(v0p));
        const bf16x4 v1 = __builtin_amdgcn_ds_read_tr16_b64_v4i16((__attribute__((address_space(3))) bf16x4*)(v0p + 16 * LDP));
        const bf16x8 vf = {v0[0], v0[1], v0[2], v0[3], v1[0], v1[1], v1[2], v1[3]};
        const bf16_t* s0p = SL + (quad * 8 + (r16 >> 2)) * LDP + dt * 16 + (r16 & 3) * 4;
        const bf16x4 s0 = __builtin_amdgcn_ds_read_tr16_b64_v4i16((__attribute__((address_space(3))) bf16x4*)(s0p));
        const bf16x4 s1 = __builtin_amdgcn_ds_read_tr16_b64_v4i16((__attribute__((address_space(3))) bf16x4*)(s0p + 4 * LDP));
        const bf16x8 sf = {s0[0], s0[1], s0[2], s0[3], s1[0], s1[1], s1[2], s1[3]};
#pragma unroll
        for (int it = 0; it < 2; ++it) {
            O[it][dt] = __builtin_amdgcn_mfma_f32_16x16x32_bf16(vf, pf[it], (f32x4){0.f, 0.f, 0.f, 0.f}, 0, 0, 0);
            O[it][dt] = __builtin_amdgcn_mfma_f32_16x16x32_bf16(sf, qf[it], O[it][dt], 0, 0, 0);
        }
    }
#pragma unroll
    for (int it = 0; it < 2; ++it) {
        float ss = 0.f;
#pragma unroll
        for (int dt = 0; dt < 4; ++dt) ss += (O[it][dt][0] * O[it][dt][0] + O[it][dt][1] * O[it][dt][1]) + (O[it][dt][2] * O[it][dt][2] + O[it][dt][3] * O[it][dt][3]);
        ss = x32_sum(x16_sum(ss));
        const float rn = rsqrtf(ss * (1.f / 64.f) + 1e-5f);
        const size_t tok = (size_t)(tok0 + it * 16 + r16);
#pragma unroll
        for (int dt = 0; dt < 4; ++dt) { const int v0i = dt * 16 + quad * 4; const f32x4 gn = *(const f32x4*)(p.gla_gn + l * 64 + v0i);
            const u32x2 gv = *(const u32x2*)(z + tok * ZP + C_DG + w * 64 + v0i);
            const float g0 = __uint_as_float(gv.x << 16), g1 = __uint_as_float(gv.x & 0xffff0000u), g2 = __uint_as_float(gv.y << 16), g3 = __uint_as_float(gv.y & 0xffff0000u);
            u32x2 o; o.x = pack2(O[it][dt][0] * rn * gn[0] * silu_f(g0), O[it][dt][1] * rn * gn[1] * silu_f(g1));
            o.y = pack2(O[it][dt][2] * rn * gn[2] * silu_f(g2), O[it][dt][3] * rn * gn[3] * silu_f(g3));
            *(u32x2*)(mix + tok * 1024 + 768 + w * 64 + v0i) = o; }
    }
}

__device__ void lru1_item(const Params& p, int l, int idx, char* smem) {
    const int t = tid_opq(), lane = t & 63, g = t >> 6, r16 = lane & 15, quad = lane >> 4; const int ch = t;
    const int b = idx >> 7, c = idx & 127; const int s0 = c * 32; const int tok0 = b * S + s0;
    const bf16_t* z = (const bf16_t*)(p.ws + WS_Z); float* xcs = (float*)smem;
    bf16_t* preA = (bf16_t*)(smem + 32768); bf16_t* preX = (bf16_t*)(smem + 49152);
    float* lh = (float*)(p.ws + WS_LH); float* lp = (float*)(p.ws + WS_LP);
    bf16_t xr[35];
#pragma unroll
    for (int i = 0; i < 35; ++i) { const int sidx = s0 + i - 3; xr[i] = (sidx >= 0) ? z[(size_t)(tok0 + i - 3) * ZP + C_BX + ch] : (bf16_t)0; }
    const float cw0 = p.conv_w[l * 1024 + ch], cw1 = p.conv_w[l * 1024 + 256 + ch], cw2 = p.conv_w[l * 1024 + 512 + ch], cw3 = p.conv_w[l * 1024 + 768 + ch];
    const float cb = p.conv_b[l * 256 + ch];
    const bf16_t* lwt = (const bf16_t*)(p.ws + WS_LWT) + (size_t)l * 32768 + g * 4096;
    bf16x8 wfa[4][2], wfx[4][2];
#pragma unroll
    for (int nt = 0; nt < 4; ++nt)
#pragma unroll
        for (int ks = 0; ks < 2; ++ks) { wfa[nt][ks] = *(const bf16x8*)(lwt + (nt * 16 + r16) * 64 + ks * 32 + quad * 8); wfx[nt][ks] = *(const bf16x8*)(lwt + 16384 + (nt * 16 + r16) * 64 + ks * 32 + quad * 8); }
    __syncthreads();
#pragma unroll
    for (int i = 0; i < 32; ++i) xcs[i * 256 + ch] = cb + (cw0 * bf2f(xr[i]) + cw1 * bf2f(xr[i + 1])) + (cw2 * bf2f(xr[i + 2]) + cw3 * bf2f(xr[i + 3]));
    __syncthreads();
#pragma unroll
    for (int tt = 0; tt < 2; ++tt) {
        bf16x8 xf[2];
#pragma unroll
        for (int ks = 0; ks < 2; ++ks) { const float* xp = xcs + (tt * 16 + r16) * 256 + g * 64 + ks * 32 + quad * 8; const f32x4 x0 = *(const f32x4*)xp, x1 = *(const f32x4*)(xp + 4);
            u32x4 pk = {pack2(x0[0], x0[1]), pack2(x0[2], x0[3]), pack2(x1[0], x1[1]), pack2(x1[2], x1[3])}; xf[ks] = __builtin_bit_cast(bf16x8, pk); }
#pragma unroll
        for (int nt = 0; nt < 4; ++nt) {
            f32x4 ra = __builtin_amdgcn_mfma_f32_16x16x32_bf16(wfa[nt][0], xf[0], (f32x4){0.f, 0.f, 0.f, 0.f}, 0, 0, 0); ra = __builtin_amdgcn_mfma_f32_16x16x32_bf16(wfa[nt][1], xf[1], ra, 0, 0, 0);
            f32x4 rx = __builtin_amdgcn_mfma_f32_16x16x32_bf16(wfx[nt][0], xf[0], (f32x4){0.f, 0.f, 0.f, 0.f}, 0, 0, 0); rx = __builtin_amdgcn_mfma_f32_16x16x32_bf16(wfx[nt][1], xf[1], rx, 0, 0, 0);
            u32x2 pa; pa.x = pack2(ra[0], ra[1]); pa.y = pack2(ra[2], ra[3]); u32x2 px; px.x = pack2(rx[0], rx[1]); px.y = pack2(rx[2], rx[3]);
            *(u32x2*)(preA + (tt * 16 + r16) * 256 + g * 64 + nt * 16 + quad * 4) = pa; *(u32x2*)(preX + (tt * 16 + r16) * 256 + g * 64 + nt * 16 + quad * 4) = px;
        }
    }
    __syncthreads();
    const float ba = p.lru_ba[l * 256 + ch], bx = p.lru_bx[l * 256 + ch], lam = p.lru_lam[l * 256 + ch];
    const float sp = fmaxf(-lam, 0.f) + log1pf(__expf(-fabsf(lam)));
    float hh = 0.f, P = 1.f;
    float* lhp = lh + (size_t)tok0 * 256 + ch; float* lpp = lp + (size_t)tok0 * 256 + ch;
#pragma unroll 4
    for (int i = 0; i < 32; ++i) { const float r = sigmoid_f(bf2f(preA[i * 256 + ch]) + ba), ig = sigmoid_f(bf2f(preX[i * 256 + ch]) + bx); const float la = -8.f * r * sp; const float a = __expf(la);
        const float w2 = 2.f * la;
        const float em_s = -w2 * (1.f + w2 * (0.5f + w2 * (0.16666667f + w2 * (0.041666668f + w2 * (0.0083333338f + w2 * 0.0013888889f)))));
        const float em = (w2 > -0.25f) ? em_s : (1.f - a * a);
        const float u = __builtin_amdgcn_sqrtf(em) * (ig * xcs[i * 256 + ch]); hh = a * hh + u; P *= a;
        lhp[(size_t)i * 256] = hh; lpp[(size_t)i * 256] = P; }
}

__device__ void lru3_item(const Params& p, int idx) {
    const int ch = tid_opq(); const int b = idx >> 7, c = idx & 127; const int tok0 = b * S + c * 32;
    const bf16_t* z = (const bf16_t*)(p.ws + WS_Z); bf16_t* mix = (bf16_t*)(p.ws + WS_U);
    const float* lh = (const float*)(p.ws + WS_LH); const float* lp = (const float*)(p.ws + WS_LP); const float* lc = (const float*)(p.ws + WS_LC);
    const float carry = lc[(size_t)(b * 128 + c) * 256 + ch];
    float hv[32], pv[32]; bf16_t gv[32];
#pragma unroll
    for (int i = 0; i < 32; ++i) { const size_t tok = (size_t)(tok0 + i); hv[i] = lh[tok * 256 + ch]; pv[i] = lp[tok * 256 + ch]; gv[i] = z[tok * ZP + C_BG + ch]; }
#pragma unroll
    for (int i = 0; i < 32; ++i) { const size_t tok = (size_t)(tok0 + i); mix[tok * 1024 + 256 + ch] = f2bf((hv[i] + pv[i] * carry) * silu_f(bf2f(gv[i]))); }
}

__device__ void dilc_item(const Params& p, int idx) {
    const int t = tid_opq(); const size_t tok = (size_t)idx * 8 + (t >> 5); const int chn = t & 31; const int h = chn >> 3;
    const bf16_t* z = (const bf16_t*)(p.ws + WS_Z); bf16_t* mix = (bf16_t*)(p.ws + WS_U);
    const bf16_t* dilo = (const bf16_t*)(p.ws + WS_DILO); const float* dill = (const float*)(p.ws + WS_DILL);
    const float l0 = dill[((size_t)0 * T + tok) * 4 + h], l1 = dill[((size_t)1 * T + tok) * 4 + h], l2 = dill[((size_t)2 * T + tok) * 4 + h];
    const float mx = fmaxf(l0, fmaxf(l1, l2)); float w0 = __expf(l0 - mx), w1 = __expf(l1 - mx), w2 = __expf(l2 - mx); const float inv = 1.f / (w0 + w1 + w2); w0 *= inv; w1 *= inv; w2 *= inv;
    const u32x4 o0 = *(const u32x4*)(dilo + ((size_t)0 * T + tok) * 256 + chn * 8), o1 = *(const u32x4*)(dilo + ((size_t)1 * T + tok) * 256 + chn * 8), o2 = *(const u32x4*)(dilo + ((size_t)2 * T + tok) * 256 + chn * 8);
    const u32x4 gv = *(const u32x4*)(z + tok * ZP + C_CG + chn * 8);
    u32x4 r;
#pragma unroll
    for (int e = 0; e < 4; ++e) {
        const float a = w0 * __uint_as_float(o0[e] << 16) + w1 * __uint_as_float(o1[e] << 16) + w2 * __uint_as_float(o2[e] << 16);
        const float bq = w0 * __uint_as_float(o0[e] & 0xffff0000u) + w1 * __uint_as_float(o1[e] & 0xffff0000u) + w2 * __uint_as_float(o2[e] & 0xffff0000u);
        r[e] = pack2(a * silu_f(__uint_as_float(gv[e] << 16)), bq * silu_f(__uint_as_float(gv[e] & 0xffff0000u)));
    }
    *(u32x4*)(mix + tok * 1024 + 512 + chn * 8) = r;
}

__device__ void m2_phase(const Params& p, char* smem) {
    float* gkv = (float*)(p.ws + WS_GKV); const float* gdec = (const float*)(p.ws + WS_GDEC);
    const float* lh = (const float*)(p.ws + WS_LH); const float* lp = (const float*)(p.ws + WS_LP); float* lc = (float*)(p.ws + WS_LC);
    float* aggP = (float*)smem; float* aggS = aggP + 256;
    const int t = tid_opq(); const int e = t & 31, seg = t >> 5;
    for (int it = blockIdx.x; it < 1024 + 32; it += gridDim.x) {
        float a[16], x[16];
        size_t ostride;
        float* outp;
        if (it < 1024) {
            const int gid = it * 32 + e; const int bh = gid >> 11, dv = gid & 2047, d = dv >> 6;
            float* base = gkv + (size_t)bh * 128 * 2048 + dv + (size_t)(seg * 16) * 2048; const float* dc = gdec + (size_t)bh * 128 * 32 + d + (seg * 16) * 32;
#pragma unroll
            for (int k = 0; k < 16; ++k) { x[k] = base[(size_t)k * 2048]; a[k] = dc[k * 32]; }
            outp = base; ostride = 2048;
        } else {
            const int i2 = it - 1024; const int b = i2 >> 3, ch = (i2 & 7) * 32 + e;
#pragma unroll
            for (int k = 0; k < 16; ++k) { const size_t ix = (size_t)(b * S + (seg * 16 + k) * 32 + 31) * 256 + ch; a[k] = lp[ix]; x[k] = lh[ix]; }
            outp = lc + (size_t)(b * 128 + seg * 16) * 256 + ch; ostride = 256;
        }
        float st = 0.f, pr = 1.f;
#pragma unroll
        for (int k = 0; k < 16; ++k) { const float ak = a[k], xk = x[k]; a[k] = pr; x[k] = st; st = ak * st + xk; pr *= ak; }
        __syncthreads();
        aggP[seg * 32 + e] = pr; aggS[seg * 32 + e] = st;
        __syncthreads();
        float carry = 0.f;
        for (int s2 = 0; s2 < seg; ++s2) carry = aggP[s2 * 32 + e] * carry + aggS[s2 * 32 + e];
#pragma unroll
        for (int k = 0; k < 16; ++k) outp[(size_t)k * ostride] = x[k] + a[k] * carry;
    }
}

__global__ void __launch_bounds__(256, 2) fwd_megakernel(Params p) {
    __shared__ __attribute__((aligned(16))) char smem[SMEM_BYTES];
    __shared__ uint4 xb_words;
    __shared__ int s_slot;
    cg::grid_group grid = cg::this_grid();
    if (p.out == nullptr) grid.sync();
    if (threadIdx.x == 0) xb_words = make_uint4(0u, 0u, 0u, 0u);
    __syncthreads();
    const XcdBarrier xb = xcd_barrier_post((unsigned*)(p.ws + WS_CTL), (volatile LAS unsigned*)&xb_words);
    unsigned* cnt = (unsigned*)(p.ws + WS_CNT);
    prologue_phase(p, smem);
    xcd_barrier(xb);
#pragma unroll 1
    for (int l = 0; l < DEPTH; ++l) {
        ln_phase(p, l);
        xcd_barrier(xb);
        g1_phase(p, l, smem);
        xcd_barrier(xb);
        for (;;) { const int it = next_item(cnt + (4 + l) * 64, &s_slot); if (it >= 512) break; lru1_item(p, l, it, smem); }
        { const int xq = blockIdx.x & 7;
          for (;;) { const int li = next_item(cnt + (16 + l * 8 + xq) * 64, &s_slot); if (li >= 64) break;
              const int pr = xq * 2 + ((li >> 1) & 1); moba_item(p, (li >> 2) * 32 + (pr >> 2) * 8 + (pr & 3) * 2 + (li & 1), smem, (bf16_t*)(p.ws + WS_U)); }
          for (;;) { const int li = next_item(cnt + (32 + l * 8 + xq) * 64, &s_slot); if (li >= 192) break;
              const int cfg = li >> 6, r6 = li & 63; const int pr = xq * 2 + (r6 >> 5); attn_item(p, 1, cfg * 512 + (pr >> 2) * 128 + (pr & 3) * 32 + (r6 & 31), smem); } }
        for (;;) { const int it = next_item(cnt + (2 + l) * 64, &s_slot); if (it >= 512) break; gla1_item(p, l, it, smem); }
        xcd_barrier(xb);
        m2_phase(p, smem);
        xcd_barrier(xb);
        for (int it = blockIdx.x; it < 512; it += gridDim.x) gla3_item(p, l, it, smem);
        for (int it = blockIdx.x; it < 512; it += gridDim.x) lru3_item(p, it);
        for (int it = blockIdx.x; it < 2048; it += gridDim.x) dilc_item(p, it);
        xcd_barrier(xb);
        g2_phase(p, l, smem);
        xcd_barrier(xb);
    }
    ln_phase(p, DEPTH);
}

extern "C" void kernel_launch(void* const* d_in, const int* in_sizes, int n_in, void* d_out, int out_size, void* d_ws, size_t ws_size, hipStream_t stream) {
    static int grid_blocks = 0;
    if (!grid_blocks) {
        int dev = 0, cus = 0, per_cu = 0;
        hipGetDevice(&dev);
        hipDeviceGetAttribute(&cus, hipDeviceAttributeMultiprocessorCount, dev);
        hipOccupancyMaxActiveBlocksPerMultiprocessor(&per_cu, (const void*)fwd_megakernel, 256, 0);
        if (per_cu < 1) per_cu = 1;
        if (per_cu > 2) per_cu = 2;
        grid_blocks = cus * per_cu;
        if (ws_size < WS_END) fprintf(stderr, "kernel_launch: workspace too small: %zu < %zu\n", ws_size, (size_t)WS_END);
    }
    Params p{};
    p.x = (const float*)d_in[0]; p.c = (const float*)d_in[1]; p.pos = (const int*)d_in[2];
    p.w_mod = (const float*)d_in[3]; p.b_mod = (const float*)d_in[4]; p.w_in = (const float*)d_in[5];
    p.conv_w = (const float*)d_in[6]; p.conv_b = (const float*)d_in[7]; p.lru_wa = (const float*)d_in[8]; p.lru_ba = (const float*)d_in[9];
    p.lru_wx = (const float*)d_in[10]; p.lru_bx = (const float*)d_in[11]; p.lru_lam = (const float*)d_in[12];
    p.gla_wr = (const float*)d_in[13]; p.gla_br = (const float*)d_in[14]; p.gla_gn = (const float*)d_in[15];
    p.w_out = (const float*)d_in[16]; p.ln_g = (const float*)d_in[17]; p.ln_b = (const float*)d_in[18];
    p.out = (float*)d_out; p.ws = (unsigned char*)d_ws;
    (void)hipMemsetAsync(d_ws, 0, 32768, stream);
    void* args[] = {&p};
    hipError_t e = hipLaunchCooperativeKernel((const void*)fwd_megakernel, dim3(grid_blocks), dim3(256), args, 0, stream);
    if (e != hipSuccess) fprintf(stderr, "cooperative launch failed: %s (grid %d)\n", hipGetErrorString(e), grid_blocks);
}
```

```cpp
#include <hip/hip_runtime.h>
#include <hip/hip_cooperative_groups.h>
#include <cstdio>
#include <cstdint>
#include <type_traits>
namespace cg = cooperative_groups;

typedef unsigned short bf16_t;
typedef short bf16x8 __attribute__((ext_vector_type(8)));
typedef short bf16x4 __attribute__((ext_vector_type(4)));
typedef float f32x4 __attribute__((ext_vector_type(4)));
typedef unsigned u32x4 __attribute__((ext_vector_type(4)));
typedef unsigned u32x2 __attribute__((ext_vector_type(2)));

constexpr int D = 1024, NB = 4, S = 4096, T = NB * S, DEPTH = 2;
constexpr int DIN = 3344, ZP = 3344, NPAD = 3456;
constexpr int C_AQ = 0, C_AK = 256, C_AV = 512, C_AG = 768, C_BX = 1024, C_BG = 1280, C_CQ = 1536, C_CK = 1792,
              C_CV = 2048, C_CG = 2304, C_DQ = 2560, C_DK = 2688, C_DV = 2816, C_DG = 3072, C_DR = 3328;
constexpr float DN_ALPHA = 1.4142135623730951f;
constexpr int LDP = 72;
constexpr int SMEM_BYTES = 65536;
constexpr int BIG = 1000000;

constexpr size_t WS_CTL = 0;
constexpr size_t WS_CNT = 16384;
constexpr size_t WS_WINT = 32768;
constexpr size_t WS_WOUTT = WS_WINT + (size_t)DEPTH * NPAD * 1024 * 2;
constexpr size_t WS_MOD = WS_WOUTT + (size_t)DEPTH * 1024 * 1024 * 2;
constexpr size_t WS_COS = WS_MOD + (size_t)DEPTH * NB * 3072 * 4;
constexpr size_t WS_SIN = WS_COS + (size_t)T * 32 * 4;
constexpr size_t WS_U = WS_SIN + (size_t)T * 32 * 4;
constexpr size_t WS_Z = WS_U + (size_t)T * 1024 * 2;
constexpr size_t WS_KPART = WS_Z + (size_t)T * ZP * 2;
constexpr size_t WS_DILO = WS_KPART + (size_t)256 * 256 * 4;
constexpr size_t WS_DILL = WS_DILO + (size_t)3 * T * 256 * 2;
constexpr size_t WS_GKV = WS_DILL + (size_t)3 * T * 4 * 4;
constexpr size_t WS_GDEC = WS_GKV + (size_t)2048 * 2048 * 4;
constexpr size_t WS_LH = WS_GDEC + (size_t)2048 * 32 * 4;
constexpr size_t WS_LP = WS_LH + (size_t)T * 256 * 4;
constexpr size_t WS_LC = WS_LP + (size_t)T * 256 * 4;
constexpr size_t WS_LWT = WS_LC + (size_t)NB * 128 * 256 * 4;
constexpr size_t WS_BC = WS_LWT + (size_t)DEPTH * 2 * 4 * 64 * 64 * 2;
constexpr size_t WS_END = WS_BC + (size_t)512 * 32 * 128 * 4;

struct Params {
    const float *x, *c; const int* pos;
    const float *w_mod, *b_mod, *w_in, *conv_w, *conv_b, *lru_wa, *lru_ba, *lru_wx, *lru_bx, *lru_lam, *gla_wr, *gla_br, *gla_gn, *w_out, *ln_g, *ln_b;
    float* out; unsigned char* ws;
};

__device__ __forceinline__ float bf2f(bf16_t h) { return __uint_as_float(((unsigned)h) << 16); }
typedef __bf16 hbf16x2 __attribute__((ext_vector_type(2)));
typedef float f32x2 __attribute__((ext_vector_type(2)));
__device__ __forceinline__ unsigned pack2(float a, float b) { f32x2 v = {a, b}; hbf16x2 r = __builtin_convertvector(v, hbf16x2); return __builtin_bit_cast(unsigned, r); }
__device__ __forceinline__ bf16_t f2bf(float f) { return (bf16_t)(pack2(f, 0.f) & 0xffffu); }
__device__ __forceinline__ float silu_f(float x) { return x / (1.f + __expf(-x)); }
__device__ __forceinline__ float sigmoid_f(float x) { return 1.f / (1.f + __expf(-x)); }
__device__ __forceinline__ int tid_opq() { int t = threadIdx.x; asm volatile("" : "+v"(t)); return t; }
__device__ __forceinline__ float x16_sum(float v) { auto r = __builtin_amdgcn_permlane16_swap(__float_as_uint(v), __float_as_uint(v), false, false); return __uint_as_float(r[0]) + __uint_as_float(r[1]); }
__device__ __forceinline__ float x32_sum(float v) { auto r = __builtin_amdgcn_permlane32_swap(__float_as_uint(v), __float_as_uint(v), false, false); return __uint_as_float(r[0]) + __uint_as_float(r[1]); }
__device__ __forceinline__ float x16_max(float v) { auto r = __builtin_amdgcn_permlane16_swap(__float_as_uint(v), __float_as_uint(v), false, false); return fmaxf(__uint_as_float(r[0]), __uint_as_float(r[1])); }
__device__ __forceinline__ float x32_max(float v) { auto r = __builtin_amdgcn_permlane32_swap(__float_as_uint(v), __float_as_uint(v), false, false); return fmaxf(__uint_as_float(r[0]), __uint_as_float(r[1])); }
__device__ __forceinline__ float row16_sum(float v) {
    v += __uint_as_float(__builtin_amdgcn_update_dpp(0u, __float_as_uint(v), 0x128, 0xf, 0xf, false));
    v += __uint_as_float(__builtin_amdgcn_update_dpp(0u, __float_as_uint(v), 0x124, 0xf, 0xf, false));
    v += __uint_as_float(__builtin_amdgcn_update_dpp(0u, __float_as_uint(v), 0x122, 0xf, 0xf, false));
    v += __uint_as_float(__builtin_amdgcn_update_dpp(0u, __float_as_uint(v), 0x121, 0xf, 0xf, false));
    return v;
}
__device__ __forceinline__ float wsum(float v) { return x32_sum(x16_sum(row16_sum(v))); }

#define XB_TMO      128
#define XB_XCNT(j)  (256  + 64 * (j))
#define XB_XSUB(j)  (1280 + 64 * (j))
#define XB_XGEN(j)  (2304 + 64 * (j))
#define XB_TOP      3328
#define XB_TOPGEN   3392
#define XCD_BAR_WORDS 3456
#define XB_SPIN_CAP (1u << 18)
#define LAS __attribute__((address_space(3)))
__device__ __forceinline__ unsigned xb_ld(unsigned* p)              { return __hip_atomic_load(p, __ATOMIC_RELAXED, __HIP_MEMORY_SCOPE_AGENT); }
__device__ __forceinline__ unsigned xb_add(unsigned* p, unsigned v) { return __hip_atomic_fetch_add(p, v, __ATOMIC_RELAXED, __HIP_MEMORY_SCOPE_AGENT); }
__device__ __forceinline__ unsigned xb_xcc_id() { return (unsigned)__builtin_amdgcn_s_getreg((3 << 11) | 20) & 0xFu; }
#define XB_SPIN(cond, bar) do { unsigned _sp = 0; while (cond) { __builtin_amdgcn_s_sleep(1); \
    if ((++_sp & 255u) == 0u) { if (xb_ld(&(bar)[XB_TMO])) break; if (_sp > XB_SPIN_CAP) { atomicAdd(&(bar)[XB_TMO], 1u); break; } } } } while (0)
struct XcdBarrier { unsigned* bar; unsigned x; volatile LAS unsigned* st; };
__device__ __forceinline__ XcdBarrier xcd_barrier_post(unsigned* bar, volatile LAS unsigned* st) {
    XcdBarrier b; b.bar = bar; b.x = xb_xcc_id(); b.st = st;
    if (threadIdx.x == 0) (void)xb_add(&bar[XB_XCNT(b.x)], 1u);
    return b;
}
__device__ __forceinline__ void xcd_barrier_complete(unsigned* bar, unsigned x, unsigned& nloc, unsigned& nx) {
    const unsigned G = gridDim.x * gridDim.y * gridDim.z;
    unsigned sum, cnt, mine, sp = 0u;
    for (;;) {
        sum = 0u; cnt = 0u; mine = 0u;
#pragma unroll
        for (unsigned j = 0; j < 16; ++j) { const unsigned c = xb_ld(&bar[XB_XCNT(j)]); sum += c; cnt += (c > 0u) ? 1u : 0u; mine = (j == x) ? c : mine; }
        if (sum == G) break;
        __builtin_amdgcn_s_sleep(1);
        if ((++sp & 255u) == 0u) { if (xb_ld(&bar[XB_TMO])) break; if (sp > XB_SPIN_CAP) { atomicAdd(&bar[XB_TMO], 1u); break; } }
    }
    nloc = mine > 0u ? mine : 1u; nx = cnt > 0u ? cnt : 1u;
}
__device__ __forceinline__ void xcd_barrier(const XcdBarrier& b) {
    asm volatile("s_waitcnt vmcnt(0)" ::: "memory");
    __syncthreads();
    if (threadIdx.x == 0) {
        unsigned* bar = b.bar;
        __builtin_amdgcn_s_waitcnt(0);
        unsigned nloc = b.st[0], nx = b.st[1];
        if (nloc == 0u) { xcd_barrier_complete(bar, b.x, nloc, nx); b.st[0] = nloc; b.st[1] = nx; }
        const unsigned old = xb_add(&bar[XB_XSUB(b.x)], 1u);
        const unsigned gen = old / nloc;
        if (old + 1u == (gen + 1u) * nloc) {
            __builtin_amdgcn_fence(__ATOMIC_RELEASE, "agent");
            asm volatile("s_waitcnt vmcnt(0)" ::: "memory");
            const unsigned og = xb_add(&bar[XB_TOP], 1u);
            const unsigned tg = og / nx;
            if (og + 1u == (tg + 1u) * nx) xb_add(&bar[XB_TOPGEN], 1u);
            else XB_SPIN(xb_ld(&bar[XB_TOPGEN]) == tg, bar);
            __builtin_amdgcn_fence(__ATOMIC_ACQUIRE, "agent");
            xb_add(&bar[XB_XGEN(b.x)], 1u);
            asm volatile("s_waitcnt vmcnt(0)" ::: "memory");
        } else {
            XB_SPIN(xb_ld(&bar[XB_XGEN(b.x)]) == gen, bar);
            __builtin_amdgcn_fence(__ATOMIC_ACQUIRE, "agent");
            asm volatile("s_waitcnt vmcnt(0)" ::: "memory");
        }
    }
    __syncthreads();
}
__device__ __forceinline__ int next_item(unsigned* ctr, volatile int* slot) {
    __syncthreads();
    if (threadIdx.x == 0) *slot = (int)atomicAdd(ctr, 1u);
    __syncthreads();
    return *slot;
}

__device__ void prologue_phase(const Params& p, char* smem) {
    const int t = tid_opq();
    bf16_t* WinT = (bf16_t*)(p.ws + WS_WINT); bf16_t* WoutT = (bf16_t*)(p.ws + WS_WOUTT);
    float* mod = (float*)(p.ws + WS_MOD); float* cosT = (float*)(p.ws + WS_COS); float* sinT = (float*)(p.ws + WS_SIN);
    float* tl = (float*)smem;
    constexpr int N_TIN = DEPTH * 16 * 54, N_TOUT = DEPTH * 16 * 16, N_MOD = DEPTH * 192, N_ROPE = T * 32 / 256, N_LWT = DEPTH * 2 * 4 * 64 * 64 / 256;
    constexpr int NITEMS = N_TIN + N_TOUT + N_MOD + N_ROPE + N_LWT;
    for (int it = blockIdx.x; it < NITEMS; it += gridDim.x) {
        if (it < N_TIN + N_TOUT) {
            const float* src; bf16_t* dst; int ncols, kt, nt;
            if (it < N_TIN) { int l = it / (16 * 54), r = it % (16 * 54); kt = r / 54; nt = r % 54; src = p.w_in + (size_t)l * 1024 * DIN; dst = WinT + (size_t)l * NPAD * 1024; ncols = DIN; }
            else { int i2 = it - N_TIN; int l = i2 / 256, r = i2 % 256; kt = r / 16; nt = r % 16; src = p.w_out + (size_t)l * 1024 * 1024; dst = WoutT + (size_t)l * 1024 * 1024; ncols = 1024; }
            __syncthreads();
            { const int c4 = t & 15, r0 = t >> 4; const int n = nt * 64 + c4 * 4;
              f32x4 v[4];
#pragma unroll
              for (int i = 0; i < 4; ++i) { const int r = r0 + 16 * i; v[i] = (n < ncols) ? *(const f32x4*)(src + (size_t)(kt * 64 + r) * ncols + n) : (f32x4){0.f, 0.f, 0.f, 0.f}; }
#pragma unroll
              for (int i = 0; i < 4; ++i) { const int r = r0 + 16 * i; tl[r * 65 + c4 * 4] = v[i][0]; tl[r * 65 + c4 * 4 + 1] = v[i][1]; tl[r * 65 + c4 * 4 + 2] = v[i][2]; tl[r * 65 + c4 * 4 + 3] = v[i][3]; } }
            __syncthreads();
            {
#pragma unroll
              for (int i = 0; i < 2; ++i) { const int cc = t + 256 * i; const int n = cc >> 3, k8 = (cc & 7) * 8;
                  u32x4 pk; pk.x = pack2(tl[(k8 + 0) * 65 + n], tl[(k8 + 1) * 65 + n]); pk.y = pack2(tl[(k8 + 2) * 65 + n], tl[(k8 + 3) * 65 + n]);
                  pk.z = pack2(tl[(k8 + 4) * 65 + n], tl[(k8 + 5) * 65 + n]); pk.w = pack2(tl[(k8 + 6) * 65 + n], tl[(k8 + 7) * 65 + n]);
                  *(u32x4*)(dst + (size_t)(nt * 64 + n) * 1024 + kt * 64 + k8) = pk; } }
        } else if (it < N_TIN + N_TOUT + N_MOD) {
            const int i2 = it - N_TIN - N_TOUT; const int l = i2 / 192, jg = i2 % 192;
            const int jj = t & 15, ks = t >> 4; const int j = jg * 16 + jj;
            float a0 = 0.f, a1 = 0.f, a2 = 0.f, a3 = 0.f;
            const float* wm = p.w_mod + (size_t)l * 1024 * 3072 + j;
#pragma unroll 8
            for (int k = ks * 64; k < ks * 64 + 64; ++k) { float wv = wm[(size_t)k * 3072]; a0 += p.c[k] * wv; a1 += p.c[1024 + k] * wv; a2 += p.c[2048 + k] * wv; a3 += p.c[3072 + k] * wv; }
            __syncthreads();
            tl[(0 * 16 + ks) * 16 + jj] = a0; tl[(1 * 16 + ks) * 16 + jj] = a1; tl[(2 * 16 + ks) * 16 + jj] = a2; tl[(3 * 16 + ks) * 16 + jj] = a3;
            __syncthreads();
            if (t < 64) { const int b = t >> 4, j2 = t & 15; float s = 0.f;
#pragma unroll
              for (int k2 = 0; k2 < 16; ++k2) s += tl[(b * 16 + k2) * 16 + j2];
              mod[((size_t)l * NB + b) * 3072 + jg * 16 + j2] = s + p.b_mod[l * 3072 + jg * 16 + j2]; }
        } else if (it >= N_TIN + N_TOUT + N_MOD + N_ROPE) {
            const int e = (it - N_TIN - N_TOUT - N_MOD - N_ROPE) * 256 + t;
            const int in = e & 63, out = (e >> 6) & 63, g = (e >> 12) & 3, mat = (e >> 14) & 1, l = e >> 15;
            const float* src = mat ? p.lru_wx : p.lru_wa;
            ((bf16_t*)(p.ws + WS_LWT))[e] = f2bf(src[l * 16384 + g * 4096 + in * 64 + out]);
        } else {
            const int i2 = it - N_TIN - N_TOUT - N_MOD; const int e = i2 * 256 + t; const int tok = e >> 5, f = e & 31;
            const float inv = exp2f(-(float)f * (13.287712379549449f / 32.f));
            const float ang = (float)p.pos[tok] * inv;
            double rev = (double)ang * 0.15915494309189535; rev -= __builtin_rint(rev);
            const float rr = (float)rev; cosT[e] = __builtin_amdgcn_cosf(rr); sinT[e] = __builtin_amdgcn_sinf(rr);
        }
    }
}

__device__ void ln_phase(const Params& p, int l) {
    const int t = tid_opq(), lane = t & 63, w = t >> 6;
    bf16_t* ubuf = (bf16_t*)(p.ws + WS_U); const float* mod = (const float*)(p.ws + WS_MOD);
    for (int rg = blockIdx.x; rg < T / 16; rg += gridDim.x) {
        f32x4 v[4][4];
#pragma unroll
        for (int r = 0; r < 4; ++r) { const int row = rg * 16 + w * 4 + r; const float* src = (l <= 1) ? p.x + (size_t)row * 1024 : p.out + (size_t)row * 1024;
#pragma unroll
            for (int i = 0; i < 4; ++i) v[r][i] = __builtin_nontemporal_load((const f32x4*)(src + i * 256 + lane * 4));
            if (l > 0) {
                const bf16_t* yr = (const bf16_t*)(p.ws + WS_Z) + (size_t)row * 1024; const float* gate = mod + ((size_t)(l - 1) * NB + row / S) * 3072 + 2048;
#pragma unroll
                for (int i = 0; i < 4; ++i) { const u32x2 yv = __builtin_nontemporal_load((const u32x2*)(yr + i * 256 + lane * 4)); const f32x4 g1 = *(const f32x4*)(gate + i * 256 + lane * 4) + 1.f;
                    const f32x4 yf = {__uint_as_float(yv.x << 16), __uint_as_float(yv.x & 0xffff0000u), __uint_as_float(yv.y << 16), __uint_as_float(yv.y & 0xffff0000u)};
                    v[r][i] = v[r][i] * DN_ALPHA + g1 * yf; }
            } }
#pragma unroll
        for (int r = 0; r < 4; ++r) {
            const int row = rg * 16 + w * 4 + r; const int b = row / S;
            if (l > 0) {
                float s = 0.f;
#pragma unroll
                for (int i = 0; i < 4; ++i) s += (v[r][i][0] + v[r][i][1]) + (v[r][i][2] + v[r][i][3]);
                const float mu = wsum(s) * (1.f / 1024.f); float q = 0.f;
#pragma unroll
                for (int i = 0; i < 4; ++i) { f32x4 d = v[r][i] - mu; q += (d[0] * d[0] + d[1] * d[1]) + (d[2] * d[2] + d[3] * d[3]); }
                const float rstd = rsqrtf(wsum(q) * (1.f / 1024.f) + 1e-5f);
#pragma unroll
                for (int i = 0; i < 4; ++i) { const f32x4 g = *(const f32x4*)(p.ln_g + (l - 1) * 1024 + i * 256 + lane * 4), bb = *(const f32x4*)(p.ln_b + (l - 1) * 1024 + i * 256 + lane * 4);
                    v[r][i] = (v[r][i] - mu) * rstd * g + bb; *(f32x4*)(p.out + (size_t)row * 1024 + i * 256 + lane * 4) = v[r][i]; }
            }
            if (l < DEPTH) {
                float s = 0.f;
#pragma unroll
                for (int i = 0; i < 4; ++i) s += (v[r][i][0] + v[r][i][1]) + (v[r][i][2] + v[r][i][3]);
                const float mu = wsum(s) * (1.f / 1024.f); float q = 0.f;
#pragma unroll
                for (int i = 0; i < 4; ++i) { f32x4 d = v[r][i] - mu; q += (d[0] * d[0] + d[1] * d[1]) + (d[2] * d[2] + d[3] * d[3]); }
                const float rstd = rsqrtf(wsum(q) * (1.f / 1024.f) + 1e-5f);
                const float* mb = mod + ((size_t)l * NB + b) * 3072;
#pragma unroll
                for (int i = 0; i < 4; ++i) { const int col = i * 256 + lane * 4; const f32x4 sh = *(const f32x4*)(mb + col), sc = *(const f32x4*)(mb + 1024 + col);
                    f32x4 u = (v[r][i] - mu) * rstd * (sc + 1.f) + sh; u32x2 pk; pk.x = pack2(u[0], u[1]); pk.y = pack2(u[2], u[3]);
                    *(u32x2*)(ubuf + (size_t)row * 1024 + col) = pk; }
            }
        }
    }
}

__device__ __forceinline__ int lds_off(int r, int c8) {
    const int st = (r >> 4) * 2 + (c8 >> 2); const int ob = (r & 15) * 64 + (c8 & 3) * 16;
    return st * 1024 + (ob ^ (((ob >> 9) & 1) << 5));
}
struct RegSet { u32x4 a[4], b[4]; };
__device__ __forceinline__ void gemm_tile(const bf16_t* __restrict__ A, const bf16_t* __restrict__ Bt, int tm, int tn, bool first, bool has_next, int ntm, int ntn,
                                          char* sm, f32x4 (&acc)[4][4], RegSet& r0, RegSet& r1) {
    const int t = tid_opq(), lane = t & 63, w = t >> 6, wm = w >> 1, wn = w & 1, r16 = lane & 15, quad = lane >> 4;
    const int lrow = t >> 3, lch = t & 7;
    constexpr int BUF = 32768;
    const unsigned loff = (unsigned)(lrow * 1024 + lch * 8);
    const bf16_t* At0 = A + (size_t)tm * (128 * 1024); const bf16_t* Bt0 = Bt + (size_t)tn * (128 * 1024);
    const bf16_t* At1 = A + (size_t)ntm * (128 * 1024); const bf16_t* Bt1 = Bt + (size_t)ntn * (128 * 1024);
#define Ag (At0 + loff)
#define Bg (Bt0 + loff)
#define nAg (At1 + loff)
#define nBg (Bt1 + loff)
    const int woff0 = lds_off(lrow, lch);
#define woff(i) (woff0 + 4096 * (i))
    const int fo = lds_off(r16, quad);
#pragma unroll
    for (int a = 0; a < 4; ++a)
#pragma unroll
        for (int b = 0; b < 4; ++b) acc[a][b] = (f32x4){0.f, 0.f, 0.f, 0.f};
    if (first) {
#pragma unroll
        for (int i = 0; i < 4; ++i) { r0.a[i] = *(const u32x4*)(Ag + (size_t)i * 32 * 1024); r0.b[i] = *(const u32x4*)(Bg + (size_t)i * 32 * 1024); }
#pragma unroll
        for (int i = 0; i < 4; ++i) { r1.a[i] = *(const u32x4*)(Ag + (size_t)i * 32 * 1024 + 64); r1.b[i] = *(const u32x4*)(Bg + (size_t)i * 32 * 1024 + 64); }
        __syncthreads();
#pragma unroll
        for (int i = 0; i < 4; ++i) { *(u32x4*)(sm + woff(i)) = r0.a[i]; *(u32x4*)(sm + 16384 + woff(i)) = r0.b[i]; }
#pragma unroll
        for (int i = 0; i < 4; ++i) { r0.a[i] = *(const u32x4*)(Ag + (size_t)i * 32 * 1024 + 128); r0.b[i] = *(const u32x4*)(Bg + (size_t)i * 32 * 1024 + 128); }
    }
    __syncthreads();
    auto step = [&](auto main_tag, int kt, RegSet& rs) {
        constexpr bool MAIN = decltype(main_tag)::value;
        const char* sA = sm + (kt & 1) * BUF; const char* sB = sA + 16384;
        char* nA = sm + ((kt + 1) & 1) * BUF; char* nB = nA + 16384;
        const bool wr = MAIN || kt + 1 < 16 || has_next;
        const bool own = MAIN || kt + 3 < 16;
        const bf16_t* la = own ? Ag + (kt + 3) * 64 : nAg + (kt - 13) * 64; const bf16_t* lb = own ? Bg + (kt + 3) * 64 : nBg + (kt - 13) * 64;
        __builtin_amdgcn_s_setprio(1);
#pragma unroll
        for (int ks = 0; ks < 2; ++ks) {
            bf16x8 af[4], bfr[4];
#pragma unroll
            for (int mt = 0; mt < 4; ++mt) af[mt] = *(const bf16x8*)(sA + ((wm * 4 + mt) * 2 + ks) * 1024 + fo);
#pragma unroll
            for (int nt = 0; nt < 4; ++nt) bfr[nt] = *(const bf16x8*)(sB + ((wn * 4 + nt) * 2 + ks) * 1024 + fo);
#pragma unroll
            for (int mt = 0; mt < 4; ++mt) {
#pragma unroll
                for (int nt = 0; nt < 4; ++nt) acc[mt][nt] = __builtin_amdgcn_mfma_f32_16x16x32_bf16(bfr[nt], af[mt], acc[mt][nt], 0, 0, 0);
                const int i = ks * 2 + (mt >> 1);
                __builtin_amdgcn_sched_barrier(0);
                if ((mt & 1) == 0) { if (wr) *(u32x4*)(nA + woff(i)) = rs.a[i]; if (own || has_next) rs.a[i] = *(const u32x4*)(la + (size_t)i * 32 * 1024); }
                else               { if (wr) *(u32x4*)(nB + woff(i)) = rs.b[i]; if (own || has_next) rs.b[i] = *(const u32x4*)(lb + (size_t)i * 32 * 1024); }
                __builtin_amdgcn_sched_barrier(0);
            }
        }
        __builtin_amdgcn_s_setprio(0);
        __syncthreads();
    };
    {
        std::true_type mt_; std::false_type tl_;
        for (int k2 = 0; k2 < 6; ++k2) { step(mt_, 2 * k2, r1); step(mt_, 2 * k2 + 1, r0); }
        step(mt_, 12, r1); step(tl_, 13, r0); step(tl_, 14, r1); step(tl_, 15, r0);
    }
#undef Ag
#undef Bg
#undef nAg
#undef nBg
#undef woff
}

__device__ void g1_phase(const Params& p, int l, char* smem) {
    const int t = tid_opq(), lane = t & 63, w = t >> 6, wm = w >> 1, wn = w & 1, r16 = lane & 15, quad = lane >> 4;
    char* sm = smem; char* sC = smem + 32768;
    const bf16_t* ubuf = (const bf16_t*)(p.ws + WS_U); const bf16_t* WinT = (const bf16_t*)(p.ws + WS_WINT) + (size_t)l * NPAD * 1024;
    bf16_t* z = (bf16_t*)(p.ws + WS_Z); float* kpart = (float*)(p.ws + WS_KPART);
    const float* cosT = (const float*)(p.ws + WS_COS); const float* sinT = (const float*)(p.ws + WS_SIN);
    const bool xo = (gridDim.x & 7) == 0; const int xcd = blockIdx.x & 7, nloc = xo ? (int)(gridDim.x >> 3) : (int)gridDim.x, j0 = xo ? (int)(blockIdx.x >> 3) : (int)blockIdx.x;
    const int lim = xo ? 16 * 27 : 128 * 27;
    RegSet r0, r1;
    for (int L = j0; L < lim; L += nloc) {
        const int tm = xo ? xcd * 16 + (L / 216) * 8 + (L & 7) : L / 27, tn = xo ? ((L % 216) >> 3) : L % 27;
        const int L2 = L + nloc; const bool has_next = L2 < lim;
        const int ntm = has_next ? (xo ? xcd * 16 + (L2 / 216) * 8 + (L2 & 7) : L2 / 27) : tm, ntn = has_next ? (xo ? ((L2 % 216) >> 3) : L2 % 27) : tn;
        f32x4 acc[4][4];
        gemm_tile(ubuf, WinT, tm, tn, L == j0, has_next, ntm, ntn, sm, acc, r0, r1);
        const bool rope = (tn < 4) || (tn >= 12 && tn < 16);
        if (rope) {
#pragma unroll
            for (int mt = 0; mt < 4; ++mt) {
                const int tok = tm * 128 + wm * 64 + mt * 16 + r16;
#pragma unroll
                for (int nt = 0; nt < 2; ++nt) {
                    const f32x4 cs = *(const f32x4*)(cosT + (size_t)tok * 32 + nt * 16 + quad * 4), sn = *(const f32x4*)(sinT + (size_t)tok * 32 + nt * 16 + quad * 4);
                    const f32x4 x1 = acc[mt][nt], x2 = acc[mt][nt + 2];
                    acc[mt][nt] = x1 * cs - x2 * sn; acc[mt][nt + 2] = x1 * sn + x2 * cs;
                }
            }
        }
        if (tn == 2 || tn == 3) {
#pragma unroll
            for (int nt = 0; nt < 4; ++nt) {
                f32x4 sv = (acc[0][nt] + acc[1][nt]) + (acc[2][nt] + acc[3][nt]);
#pragma unroll
                for (int jj = 0; jj < 4; ++jj) { sv[jj] = row16_sum(sv[jj]); }
                if (r16 == 0) *(f32x4*)(kpart + (size_t)(tm * 2 + wm) * 256 + (tn - 2) * 128 + wn * 64 + nt * 16 + quad * 4) = sv;
            }
        }
#pragma unroll
        for (int mt = 0; mt < 4; ++mt)
#pragma unroll
            for (int nt = 0; nt < 4; ++nt) { u32x2 pk; pk.x = pack2(acc[mt][nt][0], acc[mt][nt][1]); pk.y = pack2(acc[mt][nt][2], acc[mt][nt][3]);
                const int row = wm * 64 + mt * 16 + r16; const int c16 = wn * 8 + nt * 2 + (quad >> 1);
                *(u32x2*)(sC + row * 256 + ((c16 ^ (row & 15)) << 4) + (quad & 1) * 8) = pk; }
        __syncthreads();
#pragma unroll
        for (int i = 0; i < 8; ++i) { const int c = t + 256 * i; const int row = c >> 4, ch = c & 15; const int col = tn * 128 + ch * 8;
            if (col < DIN) *(u32x4*)(z + (size_t)(tm * 128 + row) * ZP + col) = *(const u32x4*)(sC + row * 256 + ((ch ^ (row & 15)) << 4)); }
    }
}

__device__ void g2_phase(const Params& p, int l, char* smem) {
    const int t = tid_opq(), lane = t & 63, w = t >> 6, wm = w >> 1, wn = w & 1, r16 = lane & 15, quad = lane >> 4;
    char* sm = smem; char* sC = smem + 32768;
    const bf16_t* mix = (const bf16_t*)(p.ws + WS_U); const bf16_t* WoutT = (const bf16_t*)(p.ws + WS_WOUTT) + (size_t)l * 1024 * 1024;
    bf16_t* ybuf = (bf16_t*)(p.ws + WS_Z);
    const bool xo = (gridDim.x & 7) == 0; const int xcd = blockIdx.x & 7, nloc = xo ? (int)(gridDim.x >> 3) : (int)gridDim.x, j0 = xo ? (int)(blockIdx.x >> 3) : (int)blockIdx.x;
    const int lim = xo ? 16 * 8 : 128 * 8;
    RegSet r0, r1;
    for (int L = j0; L < lim; L += nloc) {
        const int tm = xo ? xcd * 16 + (L & 15) : (L >> 3), tn = xo ? (L >> 4) : (L & 7);
        const int L2 = L + nloc; const bool has_next = L2 < lim;
        const int ntm = has_next ? (xo ? xcd * 16 + (L2 & 15) : (L2 >> 3)) : tm, ntn = has_next ? (xo ? (L2 >> 4) : (L2 & 7)) : tn;
        f32x4 acc[4][4];
        gemm_tile(mix, WoutT, tm, tn, L == j0, has_next, ntm, ntn, sm, acc, r0, r1);
#pragma unroll
        for (int mt = 0; mt < 4; ++mt)
#pragma unroll
            for (int nt = 0; nt < 4; ++nt) { u32x2 pk; pk.x = pack2(acc[mt][nt][0], acc[mt][nt][1]); pk.y = pack2(acc[mt][nt][2], acc[mt][nt][3]);
                const int row = wm * 64 + mt * 16 + r16; const int c16 = wn * 8 + nt * 2 + (quad >> 1);
                *(u32x2*)(sC + row * 256 + ((c16 ^ (row & 15)) << 4) + (quad & 1) * 8) = pk; }
        __syncthreads();
#pragma unroll
        for (int i = 0; i < 8; ++i) { const int c = t + 256 * i; const int row = c >> 4, ch = c & 15;
            *(u32x4*)(ybuf + (size_t)(tm * 128 + row) * 1024 + tn * 128 + ch * 8) = *(const u32x4*)(sC + row * 256 + ((ch ^ (row & 15)) << 4)); }
    }
}

constexpr float ATT_SC = 0.18033688011112042f;
template <int QT>
__device__ __forceinline__ void attn_tile(const bf16_t* sK, const bf16_t* sV, const bf16x8 (&qf)[QT][2], int lo, int hi, bool full, bool hasq, bool qfl0, bool qfl1,
                                          float (&m)[QT], float (&l)[QT], f32x4 (&O)[QT][4], int wq0) {
    const int lane = tid_opq() & 63, r16 = lane & 15, quad = lane >> 4;
    f32x4 s[QT][4];
#pragma unroll
    for (int a = 0; a < QT; ++a)
#pragma unroll
        for (int b = 0; b < 4; ++b) s[a][b] = (f32x4){0.f, 0.f, 0.f, 0.f};
#pragma unroll
    for (int ks = 0; ks < 2; ++ks)
#pragma unroll
        for (int k16 = 0; k16 < 4; ++k16) {
            const bf16x8 kf = *(const bf16x8*)(sK + (k16 * 16 + r16) * LDP + ks * 32 + quad * 8);
#pragma unroll
            for (int qt = 0; qt < QT; ++qt) s[qt][k16] = __builtin_amdgcn_mfma_f32_16x16x32_bf16(kf, qf[qt][ks], s[qt][k16], 0, 0, 0);
        }
#pragma unroll
    for (int qt = 0; qt < QT; ++qt) {
        const int ql = wq0 + qt * 16 + r16; const bool qfl = qt ? qfl1 : qfl0;
        if (!full) {
#pragma unroll
            for (int k16 = 0; k16 < 4; ++k16)
#pragma unroll
                for (int j = 0; j < 4; ++j) { const int dd = ql - (k16 * 16 + quad * 4 + j); const bool valid = dd >= lo && dd <= hi; s[qt][k16][j] = valid ? s[qt][k16][j] : -1e30f; }
        }
        if (hasq) {
#pragma unroll
            for (int k16 = 0; k16 < 4; ++k16)
#pragma unroll
                for (int j = 0; j < 4; ++j) s[qt][k16][j] = qfl ? s[qt][k16][j] : -1e30f;
        }
        float mx = -1e30f;
#pragma unroll
        for (int k16 = 0; k16 < 4; ++k16) mx = fmaxf(mx, fmaxf(fmaxf(s[qt][k16][0], s[qt][k16][1]), fmaxf(s[qt][k16][2], s[qt][k16][3])));
        mx = x32_max(x16_max(mx));
        const float mn = fmaxf(m[qt], mx); const float alpha = __builtin_amdgcn_exp2f((m[qt] - mn) * ATT_SC); m[qt] = mn;
        const float mb = (mn < -1e29f) ? 0.f : mn * ATT_SC;
        float ps = 0.f;
#pragma unroll
        for (int k16 = 0; k16 < 4; ++k16)
#pragma unroll
            for (int j = 0; j < 4; ++j) { const float pv = __builtin_amdgcn_exp2f(s[qt][k16][j] * ATT_SC - mb); ps += pv; s[qt][k16][j] = pv; }
        l[qt] = l[qt] * alpha + ps;
#pragma unroll
        for (int dt = 0; dt < 4; ++dt) O[qt][dt] = O[qt][dt] * alpha;
    }
#pragma unroll
    for (int G = 0; G < 2; ++G) {
        bf16x8 pf[QT];
#pragma unroll
        for (int qt = 0; qt < QT; ++qt) {
            const unsigned a0 = pack2(s[qt][G * 2][0], s[qt][G * 2][1]), a1 = pack2(s[qt][G * 2][2], s[qt][G * 2][3]);
            const unsigned a2 = pack2(s[qt][G * 2 + 1][0], s[qt][G * 2 + 1][1]), a3 = pack2(s[qt][G * 2 + 1][2], s[qt][G * 2 + 1][3]);
            u32x4 pk = {a0, a1, a2, a3}; pf[qt] = __builtin_bit_cast(bf16x8, pk);
        }
#pragma unroll
        for (int dt = 0; dt < 4; ++dt) {
            const bf16_t* v0p = sV + (G * 32 + quad * 4 + (r16 >> 2)) * LDP + dt * 16 + (r16 & 3) * 4;
            const bf16x4 v0 = __builtin_amdgcn_ds_read_tr16_b64_v4i16((__attribute__((address_space(3))) bf16x4*)(v0p));
            const bf16x4 v1 = __builtin_amdgcn_ds_read_tr16_b64_v4i16((__attribute__((address_space(3))) bf16x4*)(v0p + 16 * LDP));
            const bf16x8 vf = {v0[0], v0[1], v0[2], v0[3], v1[0], v1[1], v1[2], v1[3]};
#pragma unroll
            for (int qt = 0; qt < QT; ++qt) O[qt][dt] = __builtin_amdgcn_mfma_f32_16x16x32_bf16(vf, pf[qt], O[qt][dt], 0, 0, 0);
        }
    }
}

__device__ void attn_item(const Params& p, int kind, int idx, char* smem) {
    const int t = tid_opq(), lane = t & 63, w = t >> 6, r16 = lane & 15, quad = lane >> 4;
    bf16_t* sK = (bf16_t*)smem; bf16_t* sV = sK + 128 * LDP;
    const bf16_t* z = (const bf16_t*)(p.ws + WS_Z);
    (void)kind;
    const int cfg = idx >> 9; const int rem = idx & 511; const int b = rem >> 7, h = (rem >> 5) & 3; const int rb = rem & 31;
    const int dil = 1 << (2 * cfg); const int res = rb & (dil - 1), blk = rb >> (2 * cfg);
    const int qbase = b * S + blk * 128 * dil + res, stride = dil, qcol = C_CQ + h * 64, kcol = C_CK + h * 64, vcol = C_CV + h * 64;
    const int ss0 = (blk == 0) ? 1 : 0;
    bf16x8 qf[2][2];
#pragma unroll
    for (int qt = 0; qt < 2; ++qt)
#pragma unroll
        for (int ks = 0; ks < 2; ++ks) qf[qt][ks] = *(const bf16x8*)(z + (size_t)(qbase + (w * 32 + qt * 16 + r16) * stride) * ZP + qcol + ks * 32 + quad * 8);
    float m[2] = {-1e30f, -1e30f}, l[2] = {0.f, 0.f}; f32x4 O[2][4];
#pragma unroll
    for (int a = 0; a < 2; ++a)
#pragma unroll
        for (int c = 0; c < 4; ++c) O[a][c] = (f32x4){0.f, 0.f, 0.f, 0.f};
    const int lrow = t >> 1, lch = (t & 1) * 4;
    u32x4 rk[4], rv[4];
    { const bf16_t* rp = z + (size_t)(b * S + ((blk * 128 - 128 + ss0 * 128 + lrow) * dil + res)) * ZP + lch * 8;
#pragma unroll
      for (int c = 0; c < 4; ++c) { rk[c] = *(const u32x4*)(rp + kcol + c * 8); rv[c] = *(const u32x4*)(rp + vcol + c * 8); } }
    for (int ss = ss0; ss < 2; ++ss) {
        __syncthreads();
#pragma unroll
        for (int c = 0; c < 4; ++c) { *(u32x4*)(sK + lrow * LDP + (lch + c) * 8) = rk[c]; *(u32x4*)(sV + lrow * LDP + (lch + c) * 8) = rv[c]; }
        __syncthreads();
        if (ss + 1 < 2) { const bf16_t* rp = z + (size_t)(b * S + ((blk * 128 + lrow) * dil + res)) * ZP + lch * 8;
#pragma unroll
            for (int c = 0; c < 4; ++c) { rk[c] = *(const u32x4*)(rp + kcol + c * 8); rv[c] = *(const u32x4*)(rp + vcol + c * 8); } }
#pragma unroll
        for (int hf = 0; hf < 2; ++hf) {
            const int kt = ss * 2 + hf; const int lo = kt * 64 - 128, hi = kt * 64;
            const bool need = (w * 32 + 31 >= lo) && (w * 32 - 63 <= hi);
            const bool full = (w * 32 - 63 >= lo) && (w * 32 + 31 <= hi);
            if (need) attn_tile<2>(sK + hf * 64 * LDP, sV + hf * 64 * LDP, qf, lo, hi, full, false, true, true, m, l, O, w * 32);
        }
    }
    bf16_t* dilo = (bf16_t*)(p.ws + WS_DILO); float* dill = (float*)(p.ws + WS_DILL);
#pragma unroll
    for (int qt = 0; qt < 2; ++qt) {
        float lt = l[qt]; lt = x32_sum(x16_sum(lt));
        const float inv = 1.f / lt; const size_t tok = (size_t)(qbase + (w * 32 + qt * 16 + r16) * stride);
#pragma unroll
        for (int dt = 0; dt < 4; ++dt) { const int d0 = dt * 16 + quad * 4; u32x2 o; o.x = pack2(O[qt][dt][0] * inv, O[qt][dt][1] * inv); o.y = pack2(O[qt][dt][2] * inv, O[qt][dt][3] * inv);
            *(u32x2*)(dilo + ((size_t)cfg * T + tok) * 256 + h * 64 + d0) = o; }
        if (quad == 0) dill[((size_t)cfg * T + tok) * 4 + h] = m[qt] * 0.125f + __logf(lt);
    }
}

__device__ void moba_item(const Params& p, int idx, char* smem, bf16_t* outp) {
    const int t = tid_opq(), lane = t & 63, w = t >> 6, r16 = lane & 15, quad = lane >> 4;
    bf16_t* sK = (bf16_t*)smem; bf16_t* sV = sK + 64 * LDP;
    float* stO = (float*)(smem + 18432);
    float* kmean = (float*)(smem + 18432); float* gates = (float*)(smem + 22528);
    float* stM = (float*)(smem + 53248); float* stL = (float*)(smem + 53760);
    unsigned* selm = (unsigned*)(smem + 54272); unsigned char* lists = (unsigned char*)(smem + 54784);
    int* cnt = (int*)(smem + 56832); int4* desc = (int4*)(smem + 56960); int* misc = (int*)(smem + 59008);
    const bf16_t* z = (const bf16_t*)(p.ws + WS_Z);
    const int n = 15 - (idx >> 5); const int rem = idx & 31; const int b = rem >> 3, h = (rem >> 1) & 3, qh = rem & 1;
    const int qbase = b * S + n * 256 + qh * 128, qcol = C_AQ + h * 64, kcol = C_AK + h * 64, vcol = C_AV + h * 64;
    __syncthreads();
    {
        const float* kpart = (const float*)(p.ws + WS_KPART);
        for (int e = t; e < n * 64; e += 256) { const int j = e >> 6, d = e & 63; const float* kp = kpart + (size_t)(b * 64 + j * 4) * 256 + h * 64 + d;
            kmean[e] = ((kp[0] + kp[256]) + (kp[512] + kp[768])) * (1.f / 256.f); }
        if (t < 16) cnt[t] = 0;
        __syncthreads();
        {
            const int ql = t >> 1, half = t & 1; const bf16_t* qp = z + (size_t)(qbase + ql) * ZP + qcol;
            float g[8];
#pragma unroll
            for (int jj = 0; jj < 8; ++jj) g[jj] = 0.f;
#pragma unroll 1
            for (int dc = 0; dc < 8; ++dc) {
                const u32x4 qv = *(const u32x4*)(qp + dc * 8); float qq[8];
#pragma unroll
                for (int e = 0; e < 4; ++e) { qq[2 * e] = __uint_as_float(qv[e] << 16); qq[2 * e + 1] = __uint_as_float(qv[e] & 0xffff0000u); }
#pragma unroll
                for (int jj = 0; jj < 8; ++jj) { const int j = half + 2 * jj; if (j < n) { const float* km = kmean + j * 64 + dc * 8;
#pragma unroll
                    for (int e = 0; e < 8; ++e) g[jj] += qq[e] * km[e]; } }
            }
#pragma unroll
            for (int jj = 0; jj < 8; ++jj) gates[ql * 16 + half + 2 * jj] = g[jj];
        }
        __syncthreads();
        if (t < 128) {
            unsigned msk = 0;
            for (int k = 0; k < 3 && k < n; ++k) { float best = -3.0e38f; int bi = -1;
                for (int j = 0; j < n; ++j) if (!((msk >> j) & 1u)) { const float gv = gates[t * 16 + j]; if (gv > best) { best = gv; bi = j; } }
                if (bi >= 0) msk |= 1u << bi; }
            selm[t] = msk;
            for (int j = 0; j < n; ++j) if ((msk >> j) & 1u) { const int pos = atomicAdd(&cnt[j], 1); lists[j * 128 + pos] = (unsigned char)t; }
        }
        __syncthreads();
        if (t < 128) { for (int j = 0; j < n; ++j) { const int cj = cnt[j]; if (t >= cj && t < ((cj + 15) & ~15)) lists[j * 128 + t] = 255; } }
        {
            const int nown_ = qh * 2 + 2;
            if (t < nown_) desc[t] = make_int4(b * S + n * 256 + t * 64, t * 64 - qh * 128, BIG, -1);
            if (t < 16) {
                int base = nown_; for (int j2 = 0; j2 < t && j2 < n; ++j2) base += ((((cnt[j2] + 15) >> 4) + 3) >> 2) * 4;
                if (t < n) { const int npass = ((((cnt[t] + 15) >> 4) + 3) >> 2);
                    for (int ps = 0; ps < npass; ++ps) for (int kt = 0; kt < 4; ++kt) desc[base + ps * 4 + kt] = make_int4(b * S + t * 256 + kt * 64, ps, kt, t); }
                if (t == 15) { misc[0] = base + ((15 < n) ? ((((cnt[15] + 15) >> 4) + 3) >> 2) * 4 : 0); misc[1] = nown_; }
            }
        }
    }
    __syncthreads();
    const int nd = misc[0], nown = misc[1];
    const int lrow = t >> 2, lch = (t & 3) * 2;
    u32x4 rk0, rk1, rv0, rv1;
    { const int4 d = desc[0]; const bf16_t* rp = z + (size_t)(d.x + lrow) * ZP + lch * 8;
      rk0 = *(const u32x4*)(rp + kcol); rk1 = *(const u32x4*)(rp + kcol + 8); rv0 = *(const u32x4*)(rp + vcol); rv1 = *(const u32x4*)(rp + vcol + 8); }
    bf16x8 nqf[2]; int ngq = 0; bool ngv = false, nhas = false;
    auto prefetch_group = [&](int gi) {
        nhas = false;
        if (gi < nd) { const int4 dg = desc[gi]; const int slot = dg.y * 4 + w; nhas = slot * 16 < cnt[dg.w];
            if (nhas) { const int qi = lists[dg.w * 128 + slot * 16 + r16]; ngv = qi != 255; ngq = ngv ? qi : 0;
#pragma unroll
                for (int ks = 0; ks < 2; ++ks) nqf[ks] = *(const bf16x8*)(z + (size_t)(qbase + ngq) * ZP + qcol + ks * 32 + quad * 8); } }
    };
    prefetch_group(nown);
    {
        bf16x8 qf[2][2];
#pragma unroll
        for (int qt = 0; qt < 2; ++qt)
#pragma unroll
            for (int ks = 0; ks < 2; ++ks) qf[qt][ks] = *(const bf16x8*)(z + (size_t)(qbase + w * 32 + qt * 16 + r16) * ZP + qcol + ks * 32 + quad * 8);
        float m[2] = {-1e30f, -1e30f}, l[2] = {0.f, 0.f}; f32x4 O[2][4];
#pragma unroll
        for (int a = 0; a < 2; ++a)
#pragma unroll
            for (int c = 0; c < 4; ++c) O[a][c] = (f32x4){0.f, 0.f, 0.f, 0.f};
        for (int i = 0; i < nown; ++i) {
            __syncthreads();
            *(u32x4*)(sK + lrow * LDP + lch * 8) = rk0; *(u32x4*)(sK + lrow * LDP + lch * 8 + 8) = rk1;
            *(u32x4*)(sV + lrow * LDP + lch * 8) = rv0; *(u32x4*)(sV + lrow * LDP + lch * 8 + 8) = rv1;
            __syncthreads();
            if (i + 1 < nd) { const int4 d = desc[i + 1]; const bf16_t* rp = z + (size_t)(d.x + lrow) * ZP + lch * 8;
                rk0 = *(const u32x4*)(rp + kcol); rk1 = *(const u32x4*)(rp + kcol + 8); rv0 = *(const u32x4*)(rp + vcol); rv1 = *(const u32x4*)(rp + vcol + 8); }
            const int4 d = desc[i];
            const bool need = (w * 32 + 31 >= d.y) && (w * 32 - 63 <= d.z);
            const bool full = (w * 32 - 63 >= d.y) && (w * 32 + 31 <= d.z);
            if (need) attn_tile<2>(sK, sV, qf, d.y, d.z, full, false, true, true, m, l, O, w * 32);
        }
#pragma unroll
        for (int qt = 0; qt < 2; ++qt) {
            float lt = l[qt]; lt = x32_sum(x16_sum(lt));
            const int ql = w * 32 + qt * 16 + r16;
            if (quad == 0) { stM[ql] = m[qt]; stL[ql] = lt; }
#pragma unroll
            for (int dt = 0; dt < 4; ++dt) *(f32x4*)(stO + ql * 68 + dt * 16 + quad * 4) = O[qt][dt];
        }
    }
    {
        bf16x8 qf[1][2]; float m[1] = {-1e30f}, l[1] = {0.f}; f32x4 O[1][4];
        int gq = 0; bool gv = false, has = false;
        for (int i = nown; i < nd; ++i) {
            __syncthreads();
            *(u32x4*)(sK + lrow * LDP + lch * 8) = rk0; *(u32x4*)(sK + lrow * LDP + lch * 8 + 8) = rk1;
            *(u32x4*)(sV + lrow * LDP + lch * 8) = rv0; *(u32x4*)(sV + lrow * LDP + lch * 8 + 8) = rv1;
            __syncthreads();
            if (i + 1 < nd) { const int4 d = desc[i + 1]; const bf16_t* rp = z + (size_t)(d.x + lrow) * ZP + lch * 8;
                rk0 = *(const u32x4*)(rp + kcol); rk1 = *(const u32x4*)(rp + kcol + 8); rv0 = *(const u32x4*)(rp + vcol); rv1 = *(const u32x4*)(rp + vcol + 8); }
            const int4 d = desc[i];
            if (d.z == 0) {
                has = nhas; gv = ngv; gq = ngq; qf[0][0] = nqf[0]; qf[0][1] = nqf[1];
                m[0] = -1e30f; l[0] = 0.f;
#pragma unroll
                for (int c = 0; c < 4; ++c) O[0][c] = (f32x4){0.f, 0.f, 0.f, 0.f};
                prefetch_group(i + 4);
            }
            if (has) {
                attn_tile<1>(sK, sV, qf, -BIG, BIG, true, false, true, true, m, l, O, 0);
                if (d.z == 3) {
                    float lt = l[0]; lt = x32_sum(x16_sum(lt));
                    if (gv) {
                        const float mo = stM[gq], lo_ = stL[gq]; const float mn = fmaxf(mo, m[0]);
                        const float fa = __builtin_amdgcn_exp2f((mo - mn) * ATT_SC), fb = __builtin_amdgcn_exp2f((m[0] - mn) * ATT_SC);
#pragma unroll
                        for (int dt = 0; dt < 4; ++dt) { float* sp = stO + gq * 68 + dt * 16 + quad * 4; const f32x4 so = *(const f32x4*)sp; *(f32x4*)sp = so * fa + O[0][dt] * fb; }
                        if (quad == 0) { stM[gq] = mn; stL[gq] = lo_ * fa + lt * fb; }
                    }
                }
            }
        }
    }
    __syncthreads();
#pragma unroll
    for (int qt = 0; qt < 2; ++qt) {
        const int ql = w * 32 + qt * 16 + r16; const float inv = 1.f / stL[ql]; const size_t tok = (size_t)(qbase + ql);
#pragma unroll
        for (int dt = 0; dt < 4; ++dt) { const int d0 = dt * 16 + quad * 4; const f32x4 ov = *(const f32x4*)(stO + ql * 68 + d0);
            const u32x2 gvv = *(const u32x2*)(z + tok * ZP + C_AG + h * 64 + d0);
            const float g0 = __uint_as_float(gvv.x << 16), g1 = __uint_as_float(gvv.x & 0xffff0000u), g2 = __uint_as_float(gvv.y << 16), g3 = __uint_as_float(gvv.y & 0xffff0000u);
            u32x2 o; o.x = pack2(ov[0] * inv * silu_f(g0), ov[1] * inv * silu_f(g1)); o.y = pack2(ov[2] * inv * silu_f(g2), ov[3] * inv * silu_f(g3));
            *(u32x2*)(outp + tok * 1024 + h * 64 + d0) = o; }
    }
}

__device__ __forceinline__ void gla_bcum(const Params& p, int l, const bf16_t* z, int tok0, float* bc, float* drs) {
    const int t = tid_opq();
    const int hd = t & 127, ih = t >> 7;
    float wr[16];
#pragma unroll
    for (int r = 0; r < 16; ++r) wr[r] = p.gla_wr[l * 2048 + r * 128 + hd];
    const float br = p.gla_br[l * 128 + hd];
    { const int e0 = t, e1 = t + 256; const bf16_t d0 = z[(size_t)(tok0 + (e0 >> 4)) * ZP + C_DR + (e0 & 15)], d1 = z[(size_t)(tok0 + (e1 >> 4)) * ZP + C_DR + (e1 & 15)];
      drs[e0] = bf2f(d0); drs[e1] = bf2f(d1); }
    __syncthreads();
#pragma unroll
    for (int ii = 0; ii < 16; ++ii) { const int i = ih * 16 + ii; float x = br;
#pragma unroll
        for (int r4 = 0; r4 < 4; ++r4) { const f32x4 dv = *(const f32x4*)(drs + i * 16 + r4 * 4); x += (dv[0] * wr[r4 * 4] + dv[1] * wr[r4 * 4 + 1]) + (dv[2] * wr[r4 * 4 + 2] + dv[3] * wr[r4 * 4 + 3]); }
        bc[i * 128 + hd] = (fminf(x, 0.f) - __logf(1.f + __expf(-fabsf(x)))) * (1.f / 16.f); }
    __syncthreads();
    if (t < 128) { float sacc = 0.f;
#pragma unroll
        for (int i = 0; i < 32; ++i) { sacc += bc[i * 128 + t]; bc[i * 128 + t] = sacc; } }
    __syncthreads();
}

__device__ void gla1_item(const Params& p, int l, int idx, char* smem) {
    const int t = tid_opq(), lane = t & 63, w = t >> 6, r16 = lane & 15, quad = lane >> 4;
    const int b = idx >> 7, c = idx & 127; const int tok0 = b * S + c * 32;
    const bf16_t* z = (const bf16_t*)(p.ws + WS_Z);
    float* bc = (float*)smem; float* drs = (float*)(smem + 16384);
    bf16_t* kdT = (bf16_t*)(smem + 18432) + w * 1024;
    bf16_t* vL = (bf16_t*)(smem + 26624) + w * (32 * LDP);
    float* gkv = (float*)(p.ws + WS_GKV); float* gdec = (float*)(p.ws + WS_GDEC);
    bf16_t kraw[16]; u32x4 vr[4];
#pragma unroll
    for (int i = 0; i < 16; ++i) { const int e = lane + 64 * i; kraw[i] = z[(size_t)(tok0 + (e >> 5)) * ZP + C_DK + w * 32 + (e & 31)]; }
#pragma unroll
    for (int i = 0; i < 4; ++i) { const int cc = lane + 64 * i; vr[i] = *(const u32x4*)(z + (size_t)(tok0 + (cc >> 3)) * ZP + C_DV + w * 64 + (cc & 7) * 8); }
    __syncthreads();
#pragma unroll
    for (int i = 0; i < 4; ++i) { const int cc = lane + 64 * i; *(u32x4*)(vL + (cc >> 3) * LDP + (cc & 7) * 8) = vr[i]; }
    gla_bcum(p, l, z, tok0, bc, drs);
    { float* bcg = (float*)(p.ws + WS_BC) + (size_t)idx * 4096;
#pragma unroll
      for (int i = 0; i < 4; ++i) *(f32x4*)(bcg + (t + 256 * i) * 4) = *(const f32x4*)(bc + (t + 256 * i) * 4); }
#pragma unroll
    for (int i = 0; i < 16; ++i) { const int e = lane + 64 * i; const int j = e >> 5, d = e & 31;
        kdT[d * 32 + j] = f2bf(bf2f(kraw[i]) * __expf(bc[31 * 128 + w * 32 + d] - bc[j * 128 + w * 32 + d])); }
    const int bh = b * 4 + w;
    if (lane < 32) gdec[(bh * 128 + c) * 32 + lane] = __expf(bc[31 * 128 + w * 32 + lane]);
    __syncthreads();
    bf16x8 kf[2];
#pragma unroll
    for (int x = 0; x < 2; ++x) kf[x] = *(const bf16x8*)(kdT + (x * 16 + r16) * 32 + quad * 8);
    float* dst = gkv + (size_t)(bh * 128 + c) * 2048;
#pragma unroll
    for (int dt = 0; dt < 4; ++dt) {
        const bf16_t* v0p = vL + (quad * 8 + (r16 >> 2)) * LDP + dt * 16 + (r16 & 3) * 4;
        const bf16x4 v0 = __builtin_amdgcn_ds_read_tr16_b64_v4i16((__attribute__((address_space(3))) bf16x4*)(v0p));
        const bf16x4 v1 = __builtin_amdgcn_ds_read_tr16_b64_v4i16((__attribute__((address_space(3))) bf16x4*)(v0p + 4 * LDP));
        const bf16x8 vf = {v0[0], v0[1], v0[2], v0[3], v1[0], v1[1], v1[2], v1[3]};
#pragma unroll
        for (int x = 0; x < 2; ++x) {
            const f32x4 r = __builtin_amdgcn_mfma_f32_16x16x32_bf16(vf, kf[x], (f32x4){0.f, 0.f, 0.f, 0.f}, 0, 0, 0);
            *(f32x4*)(dst + (x * 16 + r16) * 64 + dt * 16 + quad * 4) = r;
        }
    }
}

#define OPQ(ptr) asm volatile("" : "+v"(ptr))
__device__ void gla3_item(const Params& p, int l, int idx, char* smem) {
    const int t = tid_opq(), lane = t & 63, w = t >> 6, r16 = lane & 15, quad = lane >> 4;
    const int b = idx >> 7, c = idx & 127; const int tok0 = b * S + c * 32;
    const bf16_t* z = (const bf16_t*)(p.ws + WS_Z); bf16_t* mix = (bf16_t*)(p.ws + WS_U);
    float* bc = (float*)smem; float* drs = (float*)(smem + 16384);
    bf16_t* SL = (bf16_t*)smem + w * (32 * LDP);
    bf16_t* qe = (bf16_t*)(smem + 18432) + w * 1024;
    bf16_t* ke = (bf16_t*)(smem + 26624) + w * 1024;
    bf16_t* vL = (bf16_t*)(smem + 34816) + w * (32 * LDP);
    const float* gkv = (const float*)(p.ws + WS_GKV);
    const int bh = b * 4 + w;
    bf16_t qraw[16], kraw[16];
    { const bf16_t* qp = z + (size_t)(tok0 + (lane >> 5)) * ZP + w * 32 + (lane & 31);
#pragma unroll
      for (int i = 0; i < 16; ++i) { qraw[i] = qp[C_DQ]; kraw[i] = qp[C_DK]; qp += 2 * ZP; OPQ(qp); } }
    u32x4 vr[4]; f32x4 sr[8];
#pragma unroll
    for (int i = 0; i < 4; ++i) { const int cc = lane + 64 * i; vr[i] = *(const u32x4*)(z + (size_t)(tok0 + (cc >> 3)) * ZP + C_DV + w * 64 + (cc & 7) * 8); }
    { const float* Sp = gkv + (size_t)(bh * 128 + c) * 2048;
#pragma unroll
      for (int i = 0; i < 8; ++i) sr[i] = *(const f32x4*)(Sp + (lane + 64 * i) * 4); }
    f32x4 bcr[4];
    { const float* bcg = (const float*)(p.ws + WS_BC) + (size_t)idx * 4096;
#pragma unroll
      for (int i = 0; i < 4; ++i) bcr[i] = *(const f32x4*)(bcg + (t + 256 * i) * 4); }
    __syncthreads();
#pragma unroll
    for (int i = 0; i < 4; ++i) { const int cc = lane + 64 * i; *(u32x4*)(vL + (cc >> 3) * LDP + (cc & 7) * 8) = vr[i]; }
#pragma unroll
    for (int i = 0; i < 4; ++i) *(f32x4*)(bc + (t + 256 * i) * 4) = bcr[i];
    __syncthreads();
#pragma unroll
    for (int i2 = 0; i2 < 16; ++i2) { const int e = lane + 64 * i2; const int i = e >> 5, d = e & 31; const float bcv = bc[i * 128 + w * 32 + d];
        qe[i * 32 + d] = f2bf(bf2f(qraw[i2]) * __expf(bcv) * 0.17677669529663687f); ke[i * 32 + d] = f2bf(bf2f(kraw[i2]) * __expf(-bcv)); }
    __syncthreads();
#pragma unroll
    for (int i = 0; i < 8; ++i) { const int cc = lane + 64 * i; const int d = cc >> 4, v4 = cc & 15; u32x2 pk; pk.x = pack2(sr[i][0], sr[i][1]); pk.y = pack2(sr[i][2], sr[i][3]);
        *(u32x2*)(SL + d * LDP + v4 * 4) = pk; }
    __syncthreads();
    bf16x8 qf[2], kf[2];
#pragma unroll
    for (int x = 0; x < 2; ++x) { qf[x] = *(const bf16x8*)(qe + (x * 16 + r16) * 32 + quad * 8); kf[x] = *(const bf16x8*)(ke + (x * 16 + r16) * 32 + quad * 8); }
    bf16x8 pf[2];
#pragma unroll
    for (int it = 0; it < 2; ++it) {
        f32x4 at[2];
#pragma unroll
        for (int jt = 0; jt < 2; ++jt) { at[jt] = __builtin_amdgcn_mfma_f32_16x16x32_bf16(kf[jt], qf[it], (f32x4){0.f, 0.f, 0.f, 0.f}, 0, 0, 0);
#pragma unroll
            for (int jj = 0; jj < 4; ++jj) at[jt][jj] = (jt * 16 + quad * 4 + jj <= it * 16 + r16) ? at[jt][jj] : 0.f; }
        u32x4 pk = {pack2(at[0][0], at[0][1]), pack2(at[0][2], at[0][3]), pack2(at[1][0], at[1][1]), pack2(at[1][2], at[1][3])};
        pf[it] = __builtin_bit_cast(bf16x8, pk);
    }
    f32x4 O[2][4];
#pragma unroll
    for (int dt = 0; dt < 4; ++dt) {
        const bf16_t* v0p = vL + (quad * 4 + (r16 >> 2)) * LDP + dt * 16 + (r16 & 3) * 4;
        const bf16x4 v0 = __builtin_amdgcn_ds_read_tr16_b64_v4i16((__attribute__((address_space(3))) bf16x4*)(v0p));
        const bf16x4 v1 = __builtin_amdgcn_ds_read_tr16_b64_v4i16((__attribute__((address_space(3))) bf16x4*)(v0p + 16 * LDP));
        const bf16x8 vf = {v0[0], v0[1], v0[2], v0[3], v1[0], v1[1], v1[2], v1[3]};
        const bf16_t* s0p = SL + (quad * 8 + (r16 >> 2)) * LDP + dt * 16 + (r16 & 3) * 4;
        const bf16x4 s0 = __builtin_amdgcn_ds_read_tr16_b64_v4i16((__attribute__((address_space(3))) bf16x4*)(s0p));
        const bf16x4 s1 = __builtin_amdgcn_ds_read_tr16_b64_v4i16((__attribute__((address_space(3))) bf16x4*)(s0p + 4 * LDP));
        const bf16x8 sf = {s0[0], s0[1], s0[2], s0[3], s1[0], s1[1], s1[2], s1[3]};
#pragma unroll
        for (int it = 0; it < 2; ++it) {
            O[it][dt] = __builtin_amdgcn_mfma_f32_16x16x32_bf16(vf, pf[it], (f32x4){0.f, 0.f, 0.f, 0.f}, 0, 0, 0);
            O[it][dt] = __builtin_amdgcn_mfma_f32_16x16x32_bf16(sf, qf[it], O[it][dt], 0, 0, 0);
        }
    }
#pragma unroll
    for (int it = 0; it < 2; ++it) {
        float ss = 0.f;
#pragma unroll
        for (int dt = 0; dt < 4; ++dt) ss += (O[it][dt][0] * O[it][dt][0] + O[it][dt][1] * O[it][dt][1]) + (O[it][dt][2] * O[it][dt][2] + O[it][dt][3] * O[it][dt][3]);
        ss = x32_sum(x16_sum(ss));
        const float rn = rsqrtf(ss * (1.f / 64.f) + 1e-5f);
        const size_t tok = (size_t)(tok0 + it * 16 + r16);
#pragma unroll
        for (int dt = 0; dt < 4; ++dt) { const int v0i = dt * 16 + quad * 4; const f32x4 gn = *(const f32x4*)(p.gla_gn + l * 64 + v0i);
            const u32x2 gv = *(const u32x2*)(z + tok * ZP + C_DG + w * 64 + v0i);
            const float g0 = __uint_as_float(gv.x << 16), g1 = __uint_as_float(gv.x & 0xffff0000u), g2 = __uint_as_float(gv.y << 16), g3 = __uint_as_float(gv.y & 0xffff0000u);
            u32x2 o; o.x = pack2(O[it][dt][0] * rn * gn[0] * silu_f(g0), O[it][dt][1] * rn * gn[1] * silu_f(g1));
            o.y = pack2(O[it][dt][2] * rn * gn[2] * silu_f(g2), O[it][dt][3] * rn * gn[3] * silu_f(g3));
            *(u32x2*)(mix + tok * 1024 + 768 + w * 64 + v0i) = o; }
    }
}

__device__ void lru1_item(const Params& p, int l, int idx, char* smem) {
    const int t = tid_opq(), lane = t & 63, g = t >> 6, r16 = lane & 15, quad = lane >> 4; const int ch = t;
    const int b = idx >> 7, c = idx & 127; const int s0 = c * 32; const int tok0 = b * S + s0;
    const bf16_t* z = (const bf16_t*)(p.ws + WS_Z); float* xcs = (float*)smem;
    bf16_t* preA = (bf16_t*)(smem + 32768); bf16_t* preX = (bf16_t*)(smem + 49152);
    float* lh = (float*)(p.ws + WS_LH); float* lp = (float*)(p.ws + WS_LP);
    bf16_t xr[35];
#pragma unroll
    for (int i = 0; i < 35; ++i) { const int sidx = s0 + i - 3; xr[i] = (sidx >= 0) ? z[(size_t)(tok0 + i - 3) * ZP + C_BX + ch] : (bf16_t)0; }
    const float cw0 = p.conv_w[l * 1024 + ch], cw1 = p.conv_w[l * 1024 + 256 + ch], cw2 = p.conv_w[l * 1024 + 512 + ch], cw3 = p.conv_w[l * 1024 + 768 + ch];
    const float cb = p.conv_b[l * 256 + ch];
    const bf16_t* lwt = (const bf16_t*)(p.ws + WS_LWT) + (size_t)l * 32768 + g * 4096;
    bf16x8 wfa[4][2], wfx[4][2];
#pragma unroll
    for (int nt = 0; nt < 4; ++nt)
#pragma unroll
        for (int ks = 0; ks < 2; ++ks) { wfa[nt][ks] = *(const bf16x8*)(lwt + (nt * 16 + r16) * 64 + ks * 32 + quad * 8); wfx[nt][ks] = *(const bf16x8*)(lwt + 16384 + (nt * 16 + r16) * 64 + ks * 32 + quad * 8); }
    __syncthreads();
#pragma unroll
    for (int i = 0; i < 32; ++i) xcs[i * 256 + ch] = cb + (cw0 * bf2f(xr[i]) + cw1 * bf2f(xr[i + 1])) + (cw2 * bf2f(xr[i + 2]) + cw3 * bf2f(xr[i + 3]));
    __syncthreads();
#pragma unroll
    for (int tt = 0; tt < 2; ++tt) {
        bf16x8 xf[2];
#pragma unroll
        for (int ks = 0; ks < 2; ++ks) { const float* xp = xcs + (tt * 16 + r16) * 256 + g * 64 + ks * 32 + quad * 8; const f32x4 x0 = *(const f32x4*)xp, x1 = *(const f32x4*)(xp + 4);
            u32x4 pk = {pack2(x0[0], x0[1]), pack2(x0[2], x0[3]), pack2(x1[0], x1[1]), pack2(x1[2], x1[3])}; xf[ks] = __builtin_bit_cast(bf16x8, pk); }
#pragma unroll
        for (int nt = 0; nt < 4; ++nt) {
            f32x4 ra = __builtin_amdgcn_mfma_f32_16x16x32_bf16(wfa[nt][0], xf[0], (f32x4){0.f, 0.f, 0.f, 0.f}, 0, 0, 0); ra = __builtin_amdgcn_mfma_f32_16x16x32_bf16(wfa[nt][1], xf[1], ra, 0, 0, 0);
            f32x4 rx = __builtin_amdgcn_mfma_f32_16x16x32_bf16(wfx[nt][0], xf[0], (f32x4){0.f, 0.f, 0.f, 0.f}, 0, 0, 0); rx = __builtin_amdgcn_mfma_f32_16x16x32_bf16(wfx[nt][1], xf[1], rx, 0, 0, 0);
            u32x2 pa; pa.x = pack2(ra[0], ra[1]); pa.y = pack2(ra[2], ra[3]); u32x2 px; px.x = pack2(rx[0], rx[1]); px.y = pack2(rx[2], rx[3]);
            *(u32x2*)(preA + (tt * 16 + r16) * 256 + g * 64 + nt * 16 + quad * 4) = pa; *(u32x2*)(preX + (tt * 16 + r16) * 256 + g * 64 + nt * 16 + quad * 4) = px;
        }
    }
    __syncthreads();
    const float ba = p.lru_ba[l * 256 + ch], bx = p.lru_bx[l * 256 + ch], lam = p.lru_lam[l * 256 + ch];
    const float sp = fmaxf(-lam, 0.f) + log1pf(__expf(-fabsf(lam)));
    float hh = 0.f, P = 1.f;
    float* lhp = lh + (size_t)tok0 * 256 + ch; float* lpp = lp + (size_t)tok0 * 256 + ch;
#pragma unroll 4
    for (int i = 0; i < 32; ++i) { const float r = sigmoid_f(bf2f(preA[i * 256 + ch]) + ba), ig = sigmoid_f(bf2f(preX[i * 256 + ch]) + bx); const float la = -8.f * r * sp; const float a = __expf(la);
        const float w2 = 2.f * la;
        const float em_s = -w2 * (1.f + w2 * (0.5f + w2 * (0.16666667f + w2 * (0.041666668f + w2 * (0.0083333338f + w2 * 0.0013888889f)))));
        const float em = (w2 > -0.25f) ? em_s : (1.f - a * a);
        const float u = __builtin_amdgcn_sqrtf(em) * (ig * xcs[i * 256 + ch]); hh = a * hh + u; P *= a;
        lhp[(size_t)i * 256] = hh; lpp[(size_t)i * 256] = P; }
}

__device__ void lru3_item(const Params& p, int idx) {
    const int ch = tid_opq(); const int b = idx >> 7, c = idx & 127; const int tok0 = b * S + c * 32;
    const bf16_t* z = (const bf16_t*)(p.ws + WS_Z); bf16_t* mix = (bf16_t*)(p.ws + WS_U);
    const float* lh = (const float*)(p.ws + WS_LH); const float* lp = (const float*)(p.ws + WS_LP); const float* lc = (const float*)(p.ws + WS_LC);
    const float carry = lc[(size_t)(b * 128 + c) * 256 + ch];
    float hv[32], pv[32]; bf16_t gv[32];
#pragma unroll
    for (int i = 0; i < 32; ++i) { const size_t tok = (size_t)(tok0 + i); hv[i] = lh[tok * 256 + ch]; pv[i] = lp[tok * 256 + ch]; gv[i] = z[tok * ZP + C_BG + ch]; }
#pragma unroll
    for (int i = 0; i < 32; ++i) { const size_t tok = (size_t)(tok0 + i); mix[tok * 1024 + 256 + ch] = f2bf((hv[i] + pv[i] * carry) * silu_f(bf2f(gv[i]))); }
}

__device__ void dilc_item(const Params& p, int idx) {
    const int t = tid_opq(); const size_t tok = (size_t)idx * 8 + (t >> 5); const int chn = t & 31; const int h = chn >> 3;
    const bf16_t* z = (const bf16_t*)(p.ws + WS_Z); bf16_t* mix = (bf16_t*)(p.ws + WS_U);
    const bf16_t* dilo = (const bf16_t*)(p.ws + WS_DILO); const float* dill = (const float*)(p.ws + WS_DILL);
    const float l0 = dill[((size_t)0 * T + tok) * 4 + h], l1 = dill[((size_t)1 * T + tok) * 4 + h], l2 = dill[((size_t)2 * T + tok) * 4 + h];
    const float mx = fmaxf(l0, fmaxf(l1, l2)); float w0 = __expf(l0 - mx), w1 = __expf(l1 - mx), w2 = __expf(l2 - mx); const float inv = 1.f / (w0 + w1 + w2); w0 *= inv; w1 *= inv; w2 *= inv;
    const u32x4 o0 = *(const u32x4*)(dilo + ((size_t)0 * T + tok) * 256 + chn * 8), o1 = *(const u32x4*)(dilo + ((size_t)1 * T + tok) * 256 + chn * 8), o2 = *(const u32x4*)(dilo + ((size_t)2 * T + tok) * 256 + chn * 8);
    const u32x4 gv = *(const u32x4*)(z + tok * ZP + C_CG + chn * 8);
    u32x4 r;
#pragma unroll
    for (int e = 0; e < 4; ++e) {
        const float a = w0 * __uint_as_float(o0[e] << 16) + w1 * __uint_as_float(o1[e] << 16) + w2 * __uint_as_float(o2[e] << 16);
        const float bq = w0 * __uint_as_float(o0[e] & 0xffff0000u) + w1 * __uint_as_float(o1[e] & 0xffff0000u) + w2 * __uint_as_float(o2[e] & 0xffff0000u);
        r[e] = pack2(a * silu_f(__uint_as_float(gv[e] << 16)), bq * silu_f(__uint_as_float(gv[e] & 0xffff0000u)));
    }
    *(u32x4*)(mix + tok * 1024 + 512 + chn * 8) = r;
}

__device__ void m2_phase(const Params& p, char* smem) {
    float* gkv = (float*)(p.ws + WS_GKV); const float* gdec = (const float*)(p.ws + WS_GDEC);
    const float* lh = (const float*)(p.ws + WS_LH); const float* lp = (const float*)(p.ws + WS_LP); float* lc = (float*)(p.ws + WS_LC);
    float* aggP = (float*)smem; float* aggS = aggP + 256;
    const int t = tid_opq(); const int e = t & 31, seg = t >> 5;
    for (int it = blockIdx.x; it < 1024 + 32; it += gridDim.x) {
        float a[16], x[16];
        size_t ostride;
        float* outp;
        if (it < 1024) {
            const int gid = it * 32 + e; const int bh = gid >> 11, dv = gid & 2047, d = dv >> 6;
            float* base = gkv + (size_t)bh * 128 * 2048 + dv + (size_t)(seg * 16) * 2048; const float* dc = gdec + (size_t)bh * 128 * 32 + d + (seg * 16) * 32;
#pragma unroll
            for (int k = 0; k < 16; ++k) { x[k] = base[(size_t)k * 2048]; a[k] = dc[k * 32]; }
            outp = base; ostride = 2048;
        } else {
            const int i2 = it - 1024; const int b = i2 >> 3, ch = (i2 & 7) * 32 + e;
#pragma unroll
            for (int k = 0; k < 16; ++k) { const size_t ix = (size_t)(b * S + (seg * 16 + k) * 32 + 31) * 256 + ch; a[k] = lp[ix]; x[k] = lh[ix]; }
            outp = lc + (size_t)(b * 128 + seg * 16) * 256 + ch; ostride = 256;
        }
        float st = 0.f, pr = 1.f;
#pragma unroll
        for (int k = 0; k < 16; ++k) { const float ak = a[k], xk = x[k]; a[k] = pr; x[k] = st; st = ak * st + xk; pr *= ak; }
        __syncthreads();
        aggP[seg * 32 + e] = pr; aggS[seg * 32 + e] = st;
        __syncthreads();
        float carry = 0.f;
        for (int s2 = 0; s2 < seg; ++s2) carry = aggP[s2 * 32 + e] * carry + aggS[s2 * 32 + e];
#pragma unroll
        for (int k = 0; k < 16; ++k) outp[(size_t)k * ostride] = x[k] + a[k] * carry;
    }
}

__global__ void __launch_bounds__(256, 2) fwd_megakernel(Params p) {
    __shared__ __attribute__((aligned(16))) char smem[SMEM_BYTES];
    __shared__ uint4 xb_words;
    __shared__ int s_slot;
    cg::grid_group grid = cg::this_grid();
    if (p.out == nullptr) grid.sync();
    if (threadIdx.x == 0) xb_words = make_uint4(0u, 0u, 0u, 0u);
    __syncthreads();
    const XcdBarrier xb = xcd_barrier_post((unsigned*)(p.ws + WS_CTL), (volatile LAS unsigned*)&xb_words);
    unsigned* cnt = (unsigned*)(p.ws + WS_CNT);
    prologue_phase(p, smem);
    xcd_barrier(xb);
#pragma unroll 1
    for (int l = 0; l < DEPTH; ++l) {
        ln_phase(p, l);
        xcd_barrier(xb);
        g1_phase(p, l, smem);
        xcd_barrier(xb);
        for (;;) { const int it = next_item(cnt + (4 + l) * 64, &s_slot); if (it >= 512) break; lru1_item(p, l, it, smem); }
        { const int xq = blockIdx.x & 7;
          for (;;) { const int li = next_item(cnt + (16 + l * 8 + xq) * 64, &s_slot); if (li >= 64) break;
              const int pr = xq * 2 + ((li >> 1) & 1); moba_item(p, (li >> 2) * 32 + (pr >> 2) * 8 + (pr & 3) * 2 + (li & 1), smem, (bf16_t*)(p.ws + WS_U)); }
          for (;;) { const int li = next_item(cnt + (32 + l * 8 + xq) * 64, &s_slot); if (li >= 192) break;
              const int cfg = li >> 6, r6 = li & 63; const int pr = xq * 2 + (r6 >> 5); attn_item(p, 1, cfg * 512 + (pr >> 2) * 128 + (pr & 3) * 32 + (r6 & 31), smem); } }
        for (;;) { const int it = next_item(cnt + (2 + l) * 64, &s_slot); if (it >= 512) break; gla1_item(p, l, it, smem); }
        xcd_barrier(xb);
        m2_phase(p, smem);
        xcd_barrier(xb);
        for (int it = blockIdx.x; it < 512; it += gridDim.x) gla3_item(p, l, it, smem);
        for (int it = blockIdx.x; it < 512; it += gridDim.x) lru3_item(p, it);
        for (int it = blockIdx.x; it < 2048; it += gridDim.x) dilc_item(p, it);
        xcd_barrier(xb);
        g2_phase(p, l, smem);
        xcd_barrier(xb);
    }
    ln_phase(p, DEPTH);
}

extern "C" void kernel_launch(void* const* d_in, const int* in_sizes, int n_in, void* d_out, int out_size, void* d_ws, size_t ws_size, hipStream_t stream) {
    static int grid_blocks = 0;
    if (!grid_blocks) {
        int dev = 0, cus = 0, per_cu = 0;
        hipGetDevice(&dev);
        hipDeviceGetAttribute(&cus, hipDeviceAttributeMultiprocessorCount, dev);
        hipOccupancyMaxActiveBlocksPerMultiprocessor(&per_cu, (const void*)fwd_megakernel, 256, 0);
        if (per_cu < 1) per_cu = 1;
        if (per_cu > 2) per_cu = 2;
        grid_blocks = cus * per_cu;
        if (ws_size < WS_END) fprintf(stderr, "kernel_launch: workspace too small: %zu < %zu\n", ws_size, (size_t)WS_END);
    }
    Params p{};
    p.x = (const float*)d_in[0]; p.c = (const float*)d_in[1]; p.pos = (const int*)d_in[2];
    p.w_mod = (const float*)d_in[3]; p.b_mod = (const float*)d_in[4]; p.w_in = (const float*)d_in[5];
    p.conv_w = (const float*)d_in[6]; p.conv_b = (const float*)d_in[7]; p.lru_wa = (const float*)d_in[8]; p.lru_ba = (const float*)d_in[9];
    p.lru_wx = (const float*)d_in[10]; p.lru_bx = (const float*)d_in[11]; p.lru_lam = (const float*)d_in[12];
    p.gla_wr = (const float*)d_in[13]; p.gla_br = (const float*)d_in[14]; p.gla_gn = (const float*)d_in[15];
    p.w_out = (const float*)d_in[16]; p.ln_g = (const float*)d_in[17]; p.ln_b = (const float*)d_in[18];
    p.out = (float*)d_out; p.ws = (unsigned char*)d_ws;
    (void)hipMemsetAsync(d_ws, 0, 32768, stream);
    void* args[] = {&p};
    hipError_t e = hipLaunchCooperativeKernel((const void*)fwd_megakernel, dim3(grid_blocks), dim3(256), args, 0, stream);
    if (e != hipSuccess) fprintf(stderr, "cooperative launch failed: %s (grid %d)\n", hipGetErrorString(e), grid_blocks);
}
```

```cpp
#include <hip/hip_runtime.h>
#include <hip/hip_cooperative_groups.h>
#include <cstdio>
#include <cstdint>
#include <type_traits>
namespace cg = cooperative_groups;

typedef unsigned short bf16_t;
typedef short bf16x8 __attribute__((ext_vector_type(8)));
typedef short bf16x4 __attribute__((ext_vector_type(4)));
typedef float f32x4 __attribute__((ext_vector_type(4)));
typedef unsigned u32x4 __attribute__((ext_vector_type(4)));
typedef unsigned u32x2 __attribute__((ext_vector_type(2)));

constexpr int D = 1024, NB = 4, S = 4096, T = NB * S, DEPTH = 2;
constexpr int DIN = 3344, ZP = 3344, NPAD = 3456;
constexpr int C_AQ = 0, C_AK = 256, C_AV = 512, C_AG = 768, C_BX = 1024, C_BG = 1280, C_CQ = 1536, C_CK = 1792,
              C_CV = 2048, C_CG = 2304, C_DQ = 2560, C_DK = 2688, C_DV = 2816, C_DG = 3072, C_DR = 3328;
constexpr float DN_ALPHA = 1.4142135623730951f;
constexpr int LDP = 72;
constexpr int SMEM_BYTES = 65536;
constexpr int BIG = 1000000;

constexpr size_t WS_CTL = 0;
constexpr size_t WS_CNT = 16384;
constexpr size_t WS_WINT = 32768;
constexpr size_t WS_WOUTT = WS_WINT + (size_t)DEPTH * NPAD * 1024 * 2;
constexpr size_t WS_MOD = WS_WOUTT + (size_t)DEPTH * 1024 * 1024 * 2;
constexpr size_t WS_COS = WS_MOD + (size_t)DEPTH * NB * 3072 * 4;
constexpr size_t WS_SIN = WS_COS + (size_t)T * 32 * 4;
constexpr size_t WS_U = WS_SIN + (size_t)T * 32 * 4;
constexpr size_t WS_Z = WS_U + (size_t)T * 1024 * 2;
constexpr size_t WS_KPART = WS_Z + (size_t)T * ZP * 2;
constexpr size_t WS_DILO = WS_KPART + (size_t)256 * 256 * 4;
constexpr size_t WS_DILL = WS_DILO + (size_t)3 * T * 256 * 2;
constexpr size_t WS_GKV = WS_DILL + (size_t)3 * T * 4 * 4;
constexpr size_t WS_GDEC = WS_GKV + (size_t)2048 * 2048 * 4;
constexpr size_t WS_LH = WS_GDEC + (size_t)2048 * 32 * 4;
constexpr size_t WS_LP = WS_LH + (size_t)T * 256 * 4;
constexpr size_t WS_LC = WS_LP + (size_t)T * 256 * 4;
constexpr size_t WS_LWT = WS_LC + (size_t)NB * 128 * 256 * 4;
constexpr size_t WS_BC = WS_LWT + (size_t)DEPTH * 2 * 4 * 64 * 64 * 2;
constexpr size_t WS_END = WS_BC + (size_t)512 * 32 * 128 * 4;

struct Params {
    const float *x, *c; const int* pos;
    const float *w_mod, *b_mod, *w_in, *conv_w, *conv_b, *lru_wa, *lru_ba, *lru_wx, *lru_bx, *lru_lam, *gla_wr, *gla_br, *gla_gn, *w_out, *ln_g, *ln_b;
    float* out; unsigned char* ws;
};

__device__ __forceinline__ float bf2f(bf16_t h) { return __uint_as_float(((unsigned)h) << 16); }
typedef __bf16 hbf16x2 __attribute__((ext_vector_type(2)));
typedef float f32x2 __attribute__((ext_vector_type(2)));
__device__ __forceinline__ unsigned pack2(float a, float b) { f32x2 v = {a, b}; hbf16x2 r = __builtin_convertvector(v, hbf16x2); return __builtin_bit_cast(unsigned, r); }
__device__ __forceinline__ bf16_t f2bf(float f) { return (bf16_t)(pack2(f, 0.f) & 0xffffu); }
__device__ __forceinline__ float silu_f(float x) { return x / (1.f + __expf(-x)); }
__device__ __forceinline__ float sigmoid_f(float x) { return 1.f / (1.f + __expf(-x)); }
__device__ __forceinline__ int tid_opq() { int t = threadIdx.x; asm volatile("" : "+v"(t)); return t; }
__device__ __forceinline__ float x16_sum(float v) { auto r = __builtin_amdgcn_permlane16_swap(__float_as_uint(v), __float_as_uint(v), false, false); return __uint_as_float(r[0]) + __uint_as_float(r[1]); }
__device__ __forceinline__ float x32_sum(float v) { auto r = __builtin_amdgcn_permlane32_swap(__float_as_uint(v), __float_as_uint(v), false, false); return __uint_as_float(r[0]) + __uint_as_float(r[1]); }
__device__ __forceinline__ float x16_max(float v) { auto r = __builtin_amdgcn_permlane16_swap(__float_as_uint(v), __float_as_uint(v), false, false); return fmaxf(__uint_as_float(r[0]), __uint_as_float(r[1])); }
__device__ __forceinline__ float x32_max(float v) { auto r = __builtin_amdgcn_permlane32_swap(__float_as_uint(v), __float_as_uint(v), false, false); return fmaxf(__uint_as_float(r[0]), __uint_as_float(r[1])); }
__device__ __forceinline__ float row16_sum(float v) {
    v += __uint_as_float(__builtin_amdgcn_update_dpp(0u, __float_as_uint(v), 0x128, 0xf, 0xf, false));
    v += __uint_as_float(__builtin_amdgcn_update_dpp(0u, __float_as_uint(v), 0x124, 0xf, 0xf, false));
    v += __uint_as_float(__builtin_amdgcn_update_dpp(0u, __float_as_uint(v), 0x122, 0xf, 0xf, false));
    v += __uint_as_float(__builtin_amdgcn_update_dpp(0u, __float_as_uint(v), 0x121, 0xf, 0xf, false));
    return v;
}
__device__ __forceinline__ float wsum(float v) { return x32_sum(x16_sum(row16_sum(v))); }

#define XB_TMO      128
#define XB_XCNT(j)  (256  + 64 * (j))
#define XB_XSUB(j)  (1280 + 64 * (j))
#define XB_XGEN(j)  (2304 + 64 * (j))
#define XB_TOP      3328
#define XB_TOPGEN   3392
#define XCD_BAR_WORDS 3456
#define XB_SPIN_CAP (1u << 18)
#define LAS __attribute__((address_space(3)))
__device__ __forceinline__ unsigned xb_ld(unsigned* p)              { return __hip_atomic_load(p, __ATOMIC_RELAXED, __HIP_MEMORY_SCOPE_AGENT); }
__device__ __forceinline__ unsigned xb_add(unsigned* p, unsigned v) { return __hip_atomic_fetch_add(p, v, __ATOMIC_RELAXED, __HIP_MEMORY_SCOPE_AGENT); }
__device__ __forceinline__ unsigned xb_xcc_id() { return (unsigned)__builtin_amdgcn_s_getreg((3 << 11) | 20) & 0xFu; }
#define XB_SPIN(cond, bar) do { unsigned _sp = 0; while (cond) { __builtin_amdgcn_s_sleep(1); \
    if ((++_sp & 255u) == 0u) { if (xb_ld(&(bar)[XB_TMO])) break; if (_sp > XB_SPIN_CAP) { atomicAdd(&(bar)[XB_TMO], 1u); break; } } } } while (0)
struct XcdBarrier { unsigned* bar; unsigned x; volatile LAS unsigned* st; };
__device__ __forceinline__ XcdBarrier xcd_barrier_post(unsigned* bar, volatile LAS unsigned* st) {
    XcdBarrier b; b.bar = bar; b.x = xb_xcc_id(); b.st = st;
    if (threadIdx.x == 0) (void)xb_add(&bar[XB_XCNT(b.x)], 1u);
    return b;
}
__device__ __forceinline__ void xcd_barrier_complete(unsigned* bar, unsigned x, unsigned& nloc, unsigned& nx) {
    const unsigned G = gridDim.x * gridDim.y * gridDim.z;
    unsigned sum, cnt, mine, sp = 0u;
    for (;;) {
        sum = 0u; cnt = 0u; mine = 0u;
#pragma unroll
        for (unsigned j = 0; j < 16; ++j) { const unsigned c = xb_ld(&bar[XB_XCNT(j)]); sum += c; cnt += (c > 0u) ? 1u : 0u; mine = (j == x) ? c : mine; }
        if (sum == G) break;
        __builtin_amdgcn_s_sleep(1);
        if ((++sp & 255u) == 0u) { if (xb_ld(&bar[XB_TMO])) break; if (sp > XB_SPIN_CAP) { atomicAdd(&bar[XB_TMO], 1u); break; } }
    }
    nloc = mine > 0u ? mine : 1u; nx = cnt > 0u ? cnt : 1u;
}
__device__ __forceinline__ void xcd_barrier(const XcdBarrier& b) {
    asm volatile("s_waitcnt vmcnt(0)" ::: "memory");
    __syncthreads();
    if (threadIdx.x == 0) {
        unsigned* bar = b.bar;
        __builtin_amdgcn_s_waitcnt(0);
        unsigned nloc = b.st[0], nx = b.st[1];
        if (nloc == 0u) { xcd_barrier_complete(bar, b.x, nloc, nx); b.st[0] = nloc; b.st[1] = nx; }
        const unsigned old = xb_add(&bar[XB_XSUB(b.x)], 1u);
        const unsigned gen = old / nloc;
        if (old + 1u == (gen + 1u) * nloc) {
            __builtin_amdgcn_fence(__ATOMIC_RELEASE, "agent");
            asm volatile("s_waitcnt vmcnt(0)" ::: "memory");
            const unsigned og = xb_add(&bar[XB_TOP], 1u);
            const unsigned tg = og / nx;
            if (og + 1u == (tg + 1u) * nx) xb_add(&bar[XB_TOPGEN], 1u);
            else XB_SPIN(xb_ld(&bar[XB_TOPGEN]) == tg, bar);
            __builtin_amdgcn_fence(__ATOMIC_ACQUIRE, "agent");
            xb_add(&bar[XB_XGEN(b.x)], 1u);
            asm volatile("s_waitcnt vmcnt(0)" ::: "memory");
        } else {
            XB_SPIN(xb_ld(&bar[XB_XGEN(b.x)]) == gen, bar);
            __builtin_amdgcn_fence(__ATOMIC_ACQUIRE, "agent");
            asm volatile("s_waitcnt vmcnt(0)" ::: "memory");
        }
    }
    __syncthreads();
}
__device__ __forceinline__ int next_item(unsigned* ctr, volatile int* slot) {
    __syncthreads();
    if (threadIdx.x == 0) *slot = (int)atomicAdd(ctr, 1u);
    __syncthreads();
    return *slot;
}

__device__ void prologue_phase(const Params& p, char* smem) {
    const int t = tid_opq();
    bf16_t* WinT = (bf16_t*)(p.ws + WS_WINT); bf16_t* WoutT = (bf16_t*)(p.ws + WS_WOUTT);
    float* mod = (float*)(p.ws + WS_MOD); float* cosT = (float*)(p.ws + WS_COS); float* sinT = (float*)(p.ws + WS_SIN);
    float* tl = (float*)smem;
    constexpr int N_TIN = DEPTH * 16 * 54, N_TOUT = DEPTH * 16 * 16, N_MOD = DEPTH * 192, N_ROPE = T * 32 / 256, N_LWT = DEPTH * 2 * 4 * 64 * 64 / 256;
    constexpr int NITEMS = N_TIN + N_TOUT + N_MOD + N_ROPE + N_LWT;
    for (int it = blockIdx.x; it < NITEMS; it += gridDim.x) {
        if (it < N_TIN + N_TOUT) {
            const float* src; bf16_t* dst; int ncols, kt, nt;
            if (it < N_TIN) { int l = it / (16 * 54), r = it % (16 * 54); kt = r / 54; nt = r % 54; src = p.w_in + (size_t)l * 1024 * DIN; dst = WinT + (size_t)l * NPAD * 1024; ncols = DIN; }
            else { int i2 = it - N_TIN; int l = i2 / 256, r = i2 % 256; kt = r / 16; nt = r % 16; src = p.w_out + (size_t)l * 1024 * 1024; dst = WoutT + (size_t)l * 1024 * 1024; ncols = 1024; }
            __syncthreads();
            { const int c4 = t & 15, r0 = t >> 4; const int n = nt * 64 + c4 * 4;
              f32x4 v[4];
#pragma unroll
              for (int i = 0; i < 4; ++i) { const int r = r0 + 16 * i; v[i] = (n < ncols) ? __builtin_nontemporal_load((const f32x4*)(src + (size_t)(kt * 64 + r) * ncols + n)) : (f32x4){0.f, 0.f, 0.f, 0.f}; }
#pragma unroll
              for (int i = 0; i < 4; ++i) { const int r = r0 + 16 * i; tl[r * 65 + c4 * 4] = v[i][0]; tl[r * 65 + c4 * 4 + 1] = v[i][1]; tl[r * 65 + c4 * 4 + 2] = v[i][2]; tl[r * 65 + c4 * 4 + 3] = v[i][3]; } }
            __syncthreads();
            {
#pragma unroll
              for (int i = 0; i < 2; ++i) { const int cc = t + 256 * i; const int n = cc >> 3, k8 = (cc & 7) * 8;
                  u32x4 pk; pk.x = pack2(tl[(k8 + 0) * 65 + n], tl[(k8 + 1) * 65 + n]); pk.y = pack2(tl[(k8 + 2) * 65 + n], tl[(k8 + 3) * 65 + n]);
                  pk.z = pack2(tl[(k8 + 4) * 65 + n], tl[(k8 + 5) * 65 + n]); pk.w = pack2(tl[(k8 + 6) * 65 + n], tl[(k8 + 7) * 65 + n]);
                  *(u32x4*)(dst + (size_t)(nt * 64 + n) * 1024 + kt * 64 + k8) = pk; } }
        } else if (it < N_TIN + N_TOUT + N_MOD) {
            const int i2 = it - N_TIN - N_TOUT; const int l = i2 / 192, jg = i2 % 192;
            const int jj = t & 15, ks = t >> 4; const int j = jg * 16 + jj;
            float a0 = 0.f, a1 = 0.f, a2 = 0.f, a3 = 0.f;
            const float* wm = p.w_mod + (size_t)l * 1024 * 3072 + j;
#pragma unroll 8
            for (int k = ks * 64; k < ks * 64 + 64; ++k) { float wv = __builtin_nontemporal_load(wm + (size_t)k * 3072); a0 += p.c[k] * wv; a1 += p.c[1024 + k] * wv; a2 += p.c[2048 + k] * wv; a3 += p.c[3072 + k] * wv; }
            __syncthreads();
            tl[(0 * 16 + ks) * 16 + jj] = a0; tl[(1 * 16 + ks) * 16 + jj] = a1; tl[(2 * 16 + ks) * 16 + jj] = a2; tl[(3 * 16 + ks) * 16 + jj] = a3;
            __syncthreads();
            if (t < 64) { const int b = t >> 4, j2 = t & 15; float s = 0.f;
#pragma unroll
              for (int k2 = 0; k2 < 16; ++k2) s += tl[(b * 16 + k2) * 16 + j2];
              mod[((size_t)l * NB + b) * 3072 + jg * 16 + j2] = s + p.b_mod[l * 3072 + jg * 16 + j2]; }
        } else if (it >= N_TIN + N_TOUT + N_MOD + N_ROPE) {
            const int e = (it - N_TIN - N_TOUT - N_MOD - N_ROPE) * 256 + t;
            const int in = e & 63, out = (e >> 6) & 63, g = (e >> 12) & 3, mat = (e >> 14) & 1, l = e >> 15;
            const float* src = mat ? p.lru_wx : p.lru_wa;
            ((bf16_t*)(p.ws + WS_LWT))[e] = f2bf(src[l * 16384 + g * 4096 + in * 64 + out]);
        } else {
            const int i2 = it - N_TIN - N_TOUT - N_MOD; const int e = i2 * 256 + t; const int tok = e >> 5, f = e & 31;
            const float inv = exp2f(-(float)f * (13.287712379549449f / 32.f));
            const float ang = (float)p.pos[tok] * inv;
            double rev = (double)ang * 0.15915494309189535; rev -= __builtin_rint(rev);
            const float rr = (float)rev; cosT[e] = __builtin_amdgcn_cosf(rr); sinT[e] = __builtin_amdgcn_sinf(rr);
        }
    }
}

__device__ void ln_phase(const Params& p, int l) {
    const int t = tid_opq(), lane = t & 63, w = t >> 6;
    bf16_t* ubuf = (bf16_t*)(p.ws + WS_U); const float* mod = (const float*)(p.ws + WS_MOD);
    for (int rg = blockIdx.x; rg < T / 16; rg += gridDim.x) {
        f32x4 v[4][4];
#pragma unroll
        for (int r = 0; r < 4; ++r) { const int row = rg * 16 + w * 4 + r; const float* src = (l <= 1) ? p.x + (size_t)row * 1024 : p.out + (size_t)row * 1024;
#pragma unroll
            for (int i = 0; i < 4; ++i) v[r][i] = __builtin_nontemporal_load((const f32x4*)(src + i * 256 + lane * 4));
            if (l > 0) {
                const bf16_t* yr = (const bf16_t*)(p.ws + WS_Z) + (size_t)row * 1024; const float* gate = mod + ((size_t)(l - 1) * NB + row / S) * 3072 + 2048;
#pragma unroll
                for (int i = 0; i < 4; ++i) { const u32x2 yv = __builtin_nontemporal_load((const u32x2*)(yr + i * 256 + lane * 4)); const f32x4 g1 = *(const f32x4*)(gate + i * 256 + lane * 4) + 1.f;
                    const f32x4 yf = {__uint_as_float(yv.x << 16), __uint_as_float(yv.x & 0xffff0000u), __uint_as_float(yv.y << 16), __uint_as_float(yv.y & 0xffff0000u)};
                    v[r][i] = v[r][i] * DN_ALPHA + g1 * yf; }
            } }
#pragma unroll
        for (int r = 0; r < 4; ++r) {
            const int row = rg * 16 + w * 4 + r; const int b = row / S;
            if (l > 0) {
                float s = 0.f;
#pragma unroll
                for (int i = 0; i < 4; ++i) s += (v[r][i][0] + v[r][i][1]) + (v[r][i][2] + v[r][i][3]);
                const float mu = wsum(s) * (1.f / 1024.f); float q = 0.f;
#pragma unroll
                for (int i = 0; i < 4; ++i) { f32x4 d = v[r][i] - mu; q += (d[0] * d[0] + d[1] * d[1]) + (d[2] * d[2] + d[3] * d[3]); }
                const float rstd = rsqrtf(wsum(q) * (1.f / 1024.f) + 1e-5f);
#pragma unroll
                for (int i = 0; i < 4; ++i) { const f32x4 g = *(const f32x4*)(p.ln_g + (l - 1) * 1024 + i * 256 + lane * 4), bb = *(const f32x4*)(p.ln_b + (l - 1) * 1024 + i * 256 + lane * 4);
                    v[r][i] = (v[r][i] - mu) * rstd * g + bb; __builtin_nontemporal_store(v[r][i], (f32x4*)(p.out + (size_t)row * 1024 + i * 256 + lane * 4)); }
            }
            if (l < DEPTH) {
                float s = 0.f;
#pragma unroll
                for (int i = 0; i < 4; ++i) s += (v[r][i][0] + v[r][i][1]) + (v[r][i][2] + v[r][i][3]);
                const float mu = wsum(s) * (1.f / 1024.f); float q = 0.f;
#pragma unroll
                for (int i = 0; i < 4; ++i) { f32x4 d = v[r][i] - mu; q += (d[0] * d[0] + d[1] * d[1]) + (d[2] * d[2] + d[3] * d[3]); }
                const float rstd = rsqrtf(wsum(q) * (1.f / 1024.f) + 1e-5f);
                const float* mb = mod + ((size_t)l * NB + b) * 3072;
#pragma unroll
                for (int i = 0; i < 4; ++i) { const int col = i * 256 + lane * 4; const f32x4 sh = *(const f32x4*)(mb + col), sc = *(const f32x4*)(mb + 1024 + col);
                    f32x4 u = (v[r][i] - mu) * rstd * (sc + 1.f) + sh; u32x2 pk; pk.x = pack2(u[0], u[1]); pk.y = pack2(u[2], u[3]);
                    *(u32x2*)(ubuf + (size_t)row * 1024 + col) = pk; }
            }
        }
    }
}

__device__ __forceinline__ int lds_off(int r, int c8) {
    const int st = (r >> 4) * 2 + (c8 >> 2); const int ob = (r & 15) * 64 + (c8 & 3) * 16;
    return st * 1024 + (ob ^ (((ob >> 9) & 1) << 5));
}
struct RegSet { u32x4 a[4], b[4]; };
__device__ __forceinline__ void gemm_tile(const bf16_t* __restrict__ A, const bf16_t* __restrict__ Bt, int tm, int tn, bool first, bool has_next, int ntm, int ntn,
                                          char* sm, f32x4 (&acc)[4][4], RegSet& r0, RegSet& r1) {
    const int t = tid_opq(), lane = t & 63, w = t >> 6, wm = w >> 1, wn = w & 1, r16 = lane & 15, quad = lane >> 4;
    const int lrow = t >> 3, lch = t & 7;
    constexpr int BUF = 32768;
    const unsigned loff = (unsigned)(lrow * 1024 + lch * 8);
    const bf16_t* At0 = A + (size_t)tm * (128 * 1024); const bf16_t* Bt0 = Bt + (size_t)tn * (128 * 1024);
    const bf16_t* At1 = A + (size_t)ntm * (128 * 1024); const bf16_t* Bt1 = Bt + (size_t)ntn * (128 * 1024);
#define Ag (At0 + loff)
#define Bg (Bt0 + loff)
#define nAg (At1 + loff)
#define nBg (Bt1 + loff)
    const int woff0 = lds_off(lrow, lch);
#define woff(i) (woff0 + 4096 * (i))
    const int fo = lds_off(r16, quad);
#pragma unroll
    for (int a = 0; a < 4; ++a)
#pragma unroll
        for (int b = 0; b < 4; ++b) acc[a][b] = (f32x4){0.f, 0.f, 0.f, 0.f};
    if (first) {
#pragma unroll
        for (int i = 0; i < 4; ++i) { r0.a[i] = *(const u32x4*)(Ag + (size_t)i * 32 * 1024); r0.b[i] = *(const u32x4*)(Bg + (size_t)i * 32 * 1024); }
#pragma unroll
        for (int i = 0; i < 4; ++i) { r1.a[i] = *(const u32x4*)(Ag + (size_t)i * 32 * 1024 + 64); r1.b[i] = *(const u32x4*)(Bg + (size_t)i * 32 * 1024 + 64); }
        __syncthreads();
#pragma unroll
        for (int i = 0; i < 4; ++i) { *(u32x4*)(sm + woff(i)) = r0.a[i]; *(u32x4*)(sm + 16384 + woff(i)) = r0.b[i]; }
#pragma unroll
        for (int i = 0; i < 4; ++i) { r0.a[i] = *(const u32x4*)(Ag + (size_t)i * 32 * 1024 + 128); r0.b[i] = *(const u32x4*)(Bg + (size_t)i * 32 * 1024 + 128); }
    }
    __syncthreads();
    auto step = [&](auto main_tag, int kt, RegSet& rs) {
        constexpr bool MAIN = decltype(main_tag)::value;
        const char* sA = sm + (kt & 1) * BUF; const char* sB = sA + 16384;
        char* nA = sm + ((kt + 1) & 1) * BUF; char* nB = nA + 16384;
        const bool wr = MAIN || kt + 1 < 16 || has_next;
        const bool own = MAIN || kt + 3 < 16;
        const bf16_t* la = own ? Ag + (kt + 3) * 64 : nAg + (kt - 13) * 64; const bf16_t* lb = own ? Bg + (kt + 3) * 64 : nBg + (kt - 13) * 64;
        __builtin_amdgcn_s_setprio(1);
#pragma unroll
        for (int ks = 0; ks < 2; ++ks) {
            bf16x8 af[4], bfr[4];
#pragma unroll
            for (int mt = 0; mt < 4; ++mt) af[mt] = *(const bf16x8*)(sA + ((wm * 4 + mt) * 2 + ks) * 1024 + fo);
#pragma unroll
            for (int nt = 0; nt < 4; ++nt) bfr[nt] = *(const bf16x8*)(sB + ((wn * 4 + nt) * 2 + ks) * 1024 + fo);
#pragma unroll
            for (int mt = 0; mt < 4; ++mt) {
#pragma unroll
                for (int nt = 0; nt < 4; ++nt) acc[mt][nt] = __builtin_amdgcn_mfma_f32_16x16x32_bf16(bfr[nt], af[mt], acc[mt][nt], 0, 0, 0);
                const int i = ks * 2 + (mt >> 1);
                __builtin_amdgcn_sched_barrier(0);
                if ((mt & 1) == 0) { if (wr) *(u32x4*)(nA + woff(i)) = rs.a[i]; if (own || has_next) rs.a[i] = *(const u32x4*)(la + (size_t)i * 32 * 1024); }
                else               { if (wr) *(u32x4*)(nB + woff(i)) = rs.b[i]; if (own || has_next) rs.b[i] = *(const u32x4*)(lb + (size_t)i * 32 * 1024); }
                __builtin_amdgcn_sched_barrier(0);
            }
        }
        __builtin_amdgcn_s_setprio(0);
        __syncthreads();
    };
    {
        std::true_type mt_; std::false_type tl_;
        for (int k2 = 0; k2 < 6; ++k2) { step(mt_, 2 * k2, r1); step(mt_, 2 * k2 + 1, r0); }
        step(mt_, 12, r1); step(tl_, 13, r0); step(tl_, 14, r1); step(tl_, 15, r0);
    }
#undef Ag
#undef Bg
#undef nAg
#undef nBg
#undef woff
}

__device__ void g1_phase(const Params& p, int l, char* smem) {
    const int t = tid_opq(), lane = t & 63, w = t >> 6, wm = w >> 1, wn = w & 1, r16 = lane & 15, quad = lane >> 4;
    char* sm = smem; char* sC = smem + 32768;
    const bf16_t* ubuf = (const bf16_t*)(p.ws + WS_U); const bf16_t* WinT = (const bf16_t*)(p.ws + WS_WINT) + (size_t)l * NPAD * 1024;
    bf16_t* z = (bf16_t*)(p.ws + WS_Z); float* kpart = (float*)(p.ws + WS_KPART);
    const float* cosT = (const float*)(p.ws + WS_COS); const float* sinT = (const float*)(p.ws + WS_SIN);
    const bool xo = (gridDim.x & 7) == 0; const int xcd = blockIdx.x & 7, nloc = xo ? (int)(gridDim.x >> 3) : (int)gridDim.x, j0 = xo ? (int)(blockIdx.x >> 3) : (int)blockIdx.x;
    const int lim = xo ? 16 * 27 : 128 * 27;
    RegSet r0, r1;
    for (int L = j0; L < lim; L += nloc) {
        const int tm = xo ? xcd * 16 + (L / 216) * 8 + (L & 7) : L / 27, tn = xo ? ((L % 216) >> 3) : L % 27;
        const int L2 = L + nloc; const bool has_next = L2 < lim;
        const int ntm = has_next ? (xo ? xcd * 16 + (L2 / 216) * 8 + (L2 & 7) : L2 / 27) : tm, ntn = has_next ? (xo ? ((L2 % 216) >> 3) : L2 % 27) : tn;
        f32x4 acc[4][4];
        gemm_tile(ubuf, WinT, tm, tn, L == j0, has_next, ntm, ntn, sm, acc, r0, r1);
        const bool rope = (tn < 4) || (tn >= 12 && tn < 16);
        if (rope) {
#pragma unroll
            for (int mt = 0; mt < 4; ++mt) {
                const int tok = tm * 128 + wm * 64 + mt * 16 + r16;
#pragma unroll
                for (int nt = 0; nt < 2; ++nt) {
                    const f32x4 cs = *(const f32x4*)(cosT + (size_t)tok * 32 + nt * 16 + quad * 4), sn = *(const f32x4*)(sinT + (size_t)tok * 32 + nt * 16 + quad * 4);
                    const f32x4 x1 = acc[mt][nt], x2 = acc[mt][nt + 2];
                    acc[mt][nt] = x1 * cs - x2 * sn; acc[mt][nt + 2] = x1 * sn + x2 * cs;
                }
            }
        }
        if (tn == 2 || tn == 3) {
#pragma unroll
            for (int nt = 0; nt < 4; ++nt) {
                f32x4 sv = (acc[0][nt] + acc[1][nt]) + (acc[2][nt] + acc[3][nt]);
#pragma unroll
                for (int jj = 0; jj < 4; ++jj) { sv[jj] = row16_sum(sv[jj]); }
                if (r16 == 0) *(f32x4*)(kpart + (size_t)(tm * 2 + wm) * 256 + (tn - 2) * 128 + wn * 64 + nt * 16 + quad * 4) = sv;
            }
        }
#pragma unroll
        for (int mt = 0; mt < 4; ++mt)
#pragma unroll
            for (int nt = 0; nt < 4; ++nt) { u32x2 pk; pk.x = pack2(acc[mt][nt][0], acc[mt][nt][1]); pk.y = pack2(acc[mt][nt][2], acc[mt][nt][3]);
                const int row = wm * 64 + mt * 16 + r16; const int c16 = wn * 8 + nt * 2 + (quad >> 1);
                *(u32x2*)(sC + row * 256 + ((c16 ^ (row & 15)) << 4) + (quad & 1) * 8) = pk; }
        __syncthreads();
#pragma unroll
        for (int i = 0; i < 8; ++i) { const int c = t + 256 * i; const int row = c >> 4, ch = c & 15; const int col = tn * 128 + ch * 8;
            if (col < DIN) *(u32x4*)(z + (size_t)(tm * 128 + row) * ZP + col) = *(const u32x4*)(sC + row * 256 + ((ch ^ (row & 15)) << 4)); }
    }
}

__device__ void g2_phase(const Params& p, int l, char* smem) {
    const int t = tid_opq(), lane = t & 63, w = t >> 6, wm = w >> 1, wn = w & 1, r16 = lane & 15, quad = lane >> 4;
    char* sm = smem; char* sC = smem + 32768;
    const bf16_t* mix = (const bf16_t*)(p.ws + WS_U); const bf16_t* WoutT = (const bf16_t*)(p.ws + WS_WOUTT) + (size_t)l * 1024 * 1024;
    bf16_t* ybuf = (bf16_t*)(p.ws + WS_Z);
    const bool xo = (gridDim.x & 7) == 0; const int xcd = blockIdx.x & 7, nloc = xo ? (int)(gridDim.x >> 3) : (int)gridDim.x, j0 = xo ? (int)(blockIdx.x >> 3) : (int)blockIdx.x;
    const int lim = xo ? 16 * 8 : 128 * 8;
    RegSet r0, r1;
    for (int L = j0; L < lim; L += nloc) {
        const int tm = xo ? xcd * 16 + (L & 15) : (L >> 3), tn = xo ? (L >> 4) : (L & 7);
        const int L2 = L + nloc; const bool has_next = L2 < lim;
        const int ntm = has_next ? (xo ? xcd * 16 + (L2 & 15) : (L2 >> 3)) : tm, ntn = has_next ? (xo ? (L2 >> 4) : (L2 & 7)) : tn;
        f32x4 acc[4][4];
        gemm_tile(mix, WoutT, tm, tn, L == j0, has_next, ntm, ntn, sm, acc, r0, r1);
#pragma unroll
        for (int mt = 0; mt < 4; ++mt)
#pragma unroll
            for (int nt = 0; nt < 4; ++nt) { u32x2 pk; pk.x = pack2(acc[mt][nt][0], acc[mt][nt][1]); pk.y = pack2(acc[mt][nt][2], acc[mt][nt][3]);
                const int row = wm * 64 + mt * 16 + r16; const int c16 = wn * 8 + nt * 2 + (quad >> 1);
                *(u32x2*)(sC + row * 256 + ((c16 ^ (row & 15)) << 4) + (quad & 1) * 8) = pk; }
        __syncthreads();
#pragma unroll
        for (int i = 0; i < 8; ++i) { const int c = t + 256 * i; const int row = c >> 4, ch = c & 15;
            *(u32x4*)(ybuf + (size_t)(tm * 128 + row) * 1024 + tn * 128 + ch * 8) = *(const u32x4*)(sC + row * 256 + ((ch ^ (row & 15)) << 4)); }
    }
}

constexpr float ATT_SC = 0.18033688011112042f;
template <int QT>
__device__ __forceinline__ void attn_tile(const bf16_t* sK, const bf16_t* sV, const bf16x8 (&qf)[QT][2], int lo, int hi, bool full, bool hasq, bool qfl0, bool qfl1,
                                          float (&m)[QT], float (&l)[QT], f32x4 (&O)[QT][4], int wq0) {
    const int lane = tid_opq() & 63, r16 = lane & 15, quad = lane >> 4;
    f32x4 s[QT][4];
#pragma unroll
    for (int a = 0; a < QT; ++a)
#pragma unroll
        for (int b = 0; b < 4; ++b) s[a][b] = (f32x4){0.f, 0.f, 0.f, 0.f};
#pragma unroll
    for (int ks = 0; ks < 2; ++ks)
#pragma unroll
        for (int k16 = 0; k16 < 4; ++k16) {
            const bf16x8 kf = *(const bf16x8*)(sK + (k16 * 16 + r16) * LDP + ks * 32 + quad * 8);
#pragma unroll
            for (int qt = 0; qt < QT; ++qt) s[qt][k16] = __builtin_amdgcn_mfma_f32_16x16x32_bf16(kf, qf[qt][ks], s[qt][k16], 0, 0, 0);
        }
#pragma unroll
    for (int qt = 0; qt < QT; ++qt) {
        const int ql = wq0 + qt * 16 + r16; const bool qfl = qt ? qfl1 : qfl0;
        if (!full) {
#pragma unroll
            for (int k16 = 0; k16 < 4; ++k16)
#pragma unroll
                for (int j = 0; j < 4; ++j) { const int dd = ql - (k16 * 16 + quad * 4 + j); const bool valid = dd >= lo && dd <= hi; s[qt][k16][j] = valid ? s[qt][k16][j] : -1e30f; }
        }
        if (hasq) {
#pragma unroll
            for (int k16 = 0; k16 < 4; ++k16)
#pragma unroll
                for (int j = 0; j < 4; ++j) s[qt][k16][j] = qfl ? s[qt][k16][j] : -1e30f;
        }
        float mx = -1e30f;
#pragma unroll
        for (int k16 = 0; k16 < 4; ++k16) mx = fmaxf(mx, fmaxf(fmaxf(s[qt][k16][0], s[qt][k16][1]), fmaxf(s[qt][k16][2], s[qt][k16][3])));
        mx = x32_max(x16_max(mx));
        const float mn = fmaxf(m[qt], mx); const float alpha = __builtin_amdgcn_exp2f((m[qt] - mn) * ATT_SC); m[qt] = mn;
        const float mb = (mn < -1e29f) ? 0.f : mn * ATT_SC;
        float ps = 0.f;
#pragma unroll
        for (int k16 = 0; k16 < 4; ++k16)
#pragma unroll
            for (int j = 0; j < 4; ++j) { const float pv = __builtin_amdgcn_exp2f(s[qt][k16][j] * ATT_SC - mb); ps += pv; s[qt][k16][j] = pv; }
        l[qt] = l[qt] * alpha + ps;
#pragma unroll
        for (int dt = 0; dt < 4; ++dt) O[qt][dt] = O[qt][dt] * alpha;
    }
#pragma unroll
    for (int G = 0; G < 2; ++G) {
        bf16x8 pf[QT];
#pragma unroll
        for (int qt = 0; qt < QT; ++qt) {
            const unsigned a0 = pack2(s[qt][G * 2][0], s[qt][G * 2][1]), a1 = pack2(s[qt][G * 2][2], s[qt][G * 2][3]);
            const unsigned a2 = pack2(s[qt][G * 2 + 1][0], s[qt][G * 2 + 1][1]), a3 = pack2(s[qt][G * 2 + 1][2], s[qt][G * 2 + 1][3]);
            u32x4 pk = {a0, a1, a2, a3}; pf[qt] = __builtin_bit_cast(bf16x8, pk);
        }
#pragma unroll
        for (int dt = 0; dt < 4; ++dt) {
            const bf16_t* v0p = sV + (G * 32 + quad * 4 + (r16 >> 2)) * LDP + dt * 16 + (r16 & 3) * 4;
            const bf16x4 v0 = __builtin_amdgcn_ds_read_tr16_b64_v4i16((__attribute__((address_space(3))) bf16x4*)(v0p));
            const bf16x4 v1 = __builtin_amdgcn_ds_read_tr16_b64_v4i16((__attribute__((address_space(3))) bf16x4*)(v0p + 16 * LDP));
            const bf16x8 vf = {v0[0], v0[1], v0[2], v0[3], v1[0], v1[1], v1[2], v1[3]};
#pragma unroll
            for (int qt = 0; qt < QT; ++qt) O[qt][dt] = __builtin_amdgcn_mfma_f32_16x16x32_bf16(vf, pf[qt], O[qt][dt], 0, 0, 0);
        }
    }
}

__device__ void attn_item(const Params& p, int kind, int idx, char* smem) {
    const int t = tid_opq(), lane = t & 63, w = t >> 6, r16 = lane & 15, quad = lane >> 4;
    bf16_t* sK = (bf16_t*)smem; bf16_t* sV = sK + 128 * LDP;
    const bf16_t* z = (const bf16_t*)(p.ws + WS_Z);
    (void)kind;
    const int cfg = idx >> 9; const int rem = idx & 511; const int b = rem >> 7, h = (rem >> 5) & 3; const int rb = rem & 31;
    const int dil = 1 << (2 * cfg); const int res = rb & (dil - 1), blk = rb >> (2 * cfg);
    const int qbase = b * S + blk * 128 * dil + res, stride = dil, qcol = C_CQ + h * 64, kcol = C_CK + h * 64, vcol = C_CV + h * 64;
    const int ss0 = (blk == 0) ? 1 : 0;
    bf16x8 qf[2][2];
#pragma unroll
    for (int qt = 0; qt < 2; ++qt)
#pragma unroll
        for (int ks = 0; ks < 2; ++ks) qf[qt][ks] = *(const bf16x8*)(z + (size_t)(qbase + (w * 32 + qt * 16 + r16) * stride) * ZP + qcol + ks * 32 + quad * 8);
    float m[2] = {-1e30f, -1e30f}, l[2] = {0.f, 0.f}; f32x4 O[2][4];
#pragma unroll
    for (int a = 0; a < 2; ++a)
#pragma unroll
        for (int c = 0; c < 4; ++c) O[a][c] = (f32x4){0.f, 0.f, 0.f, 0.f};
    const int lrow = t >> 1, lch = (t & 1) * 4;
    u32x4 rk[4], rv[4];
    { const bf16_t* rp = z + (size_t)(b * S + ((blk * 128 - 128 + ss0 * 128 + lrow) * dil + res)) * ZP + lch * 8;
#pragma unroll
      for (int c = 0; c < 4; ++c) { rk[c] = *(const u32x4*)(rp + kcol + c * 8); rv[c] = *(const u32x4*)(rp + vcol + c * 8); } }
    for (int ss = ss0; ss < 2; ++ss) {
        __syncthreads();
#pragma unroll
        for (int c = 0; c < 4; ++c) { *(u32x4*)(sK + lrow * LDP + (lch + c) * 8) = rk[c]; *(u32x4*)(sV + lrow * LDP + (lch + c) * 8) = rv[c]; }
        __syncthreads();
        if (ss + 1 < 2) { const bf16_t* rp = z + (size_t)(b * S + ((blk * 128 + lrow) * dil + res)) * ZP + lch * 8;
#pragma unroll
            for (int c = 0; c < 4; ++c) { rk[c] = *(const u32x4*)(rp + kcol + c * 8); rv[c] = *(const u32x4*)(rp + vcol + c * 8); } }
#pragma unroll
        for (int hf = 0; hf < 2; ++hf) {
            const int kt = ss * 2 + hf; const int lo = kt * 64 - 128, hi = kt * 64;
            const bool need = (w * 32 + 31 >= lo) && (w * 32 - 63 <= hi);
            const bool full = (w * 32 - 63 >= lo) && (w * 32 + 31 <= hi);
            if (need) attn_tile<2>(sK + hf * 64 * LDP, sV + hf * 64 * LDP, qf, lo, hi, full, false, true, true, m, l, O, w * 32);
        }
    }
    bf16_t* dilo = (bf16_t*)(p.ws + WS_DILO); float* dill = (float*)(p.ws + WS_DILL);
#pragma unroll
    for (int qt = 0; qt < 2; ++qt) {
        float lt = l[qt]; lt = x32_sum(x16_sum(lt));
        const float inv = 1.f / lt; const size_t tok = (size_t)(qbase + (w * 32 + qt * 16 + r16) * stride);
#pragma unroll
        for (int dt = 0; dt < 4; ++dt) { const int d0 = dt * 16 + quad * 4; u32x2 o; o.x = pack2(O[qt][dt][0] * inv, O[qt][dt][1] * inv); o.y = pack2(O[qt][dt][2] * inv, O[qt][dt][3] * inv);
            *(u32x2*)(dilo + ((size_t)cfg * T + tok) * 256 + h * 64 + d0) = o; }
        if (quad == 0) dill[((size_t)cfg * T + tok) * 4 + h] = m[qt] * 0.125f + __logf(lt);
    }
}

__device__ void moba_item(const Params& p, int idx, char* smem, bf16_t* outp) {
    const int t = tid_opq(), lane = t & 63, w = t >> 6, r16 = lane & 15, quad = lane >> 4;
    bf16_t* sK = (bf16_t*)smem; bf16_t* sV = sK + 64 * LDP;
    float* stO = (float*)(smem + 18432);
    float* kmean = (float*)(smem + 18432); float* gates = (float*)(smem + 22528);
    float* stM = (float*)(smem + 53248); float* stL = (float*)(smem + 53760);
    unsigned* selm = (unsigned*)(smem + 54272); unsigned char* lists = (unsigned char*)(smem + 54784);
    int* cnt = (int*)(smem + 56832); int4* desc = (int4*)(smem + 56960); int* misc = (int*)(smem + 59008);
    const bf16_t* z = (const bf16_t*)(p.ws + WS_Z);
    const int n = 15 - (idx >> 5); const int rem = idx & 31; const int b = rem >> 3, h = (rem >> 1) & 3, qh = rem & 1;
    const int qbase = b * S + n * 256 + qh * 128, qcol = C_AQ + h * 64, kcol = C_AK + h * 64, vcol = C_AV + h * 64;
    __syncthreads();
    {
        const float* kpart = (const float*)(p.ws + WS_KPART);
        for (int e = t; e < n * 64; e += 256) { const int j = e >> 6, d = e & 63; const float* kp = kpart + (size_t)(b * 64 + j * 4) * 256 + h * 64 + d;
            kmean[e] = ((kp[0] + kp[256]) + (kp[512] + kp[768])) * (1.f / 256.f); }
        if (t < 16) cnt[t] = 0;
        __syncthreads();
        {
            const int ql = t >> 1, half = t & 1; const bf16_t* qp = z + (size_t)(qbase + ql) * ZP + qcol;
            float g[8];
#pragma unroll
            for (int jj = 0; jj < 8; ++jj) g[jj] = 0.f;
#pragma unroll 1
            for (int dc = 0; dc < 8; ++dc) {
                const u32x4 qv = *(const u32x4*)(qp + dc * 8); float qq[8];
#pragma unroll
                for (int e = 0; e < 4; ++e) { qq[2 * e] = __uint_as_float(qv[e] << 16); qq[2 * e + 1] = __uint_as_float(qv[e] & 0xffff0000u); }
#pragma unroll
                for (int jj = 0; jj < 8; ++jj) { const int j = half + 2 * jj; if (j < n) { const float* km = kmean + j * 64 + dc * 8;
#pragma unroll
                    for (int e = 0; e < 8; ++e) g[jj] += qq[e] * km[e]; } }
            }
#pragma unroll
            for (int jj = 0; jj < 8; ++jj) gates[ql * 16 + half + 2 * jj] = g[jj];
        }
        __syncthreads();
        if (t < 128) {
            unsigned msk = 0;
            for (int k = 0; k < 3 && k < n; ++k) { float best = -3.0e38f; int bi = -1;
                for (int j = 0; j < n; ++j) if (!((msk >> j) & 1u)) { const float gv = gates[t * 16 + j]; if (gv > best) { best = gv; bi = j; } }
                if (bi >= 0) msk |= 1u << bi; }
            selm[t] = msk;
            for (int j = 0; j < n; ++j) if ((msk >> j) & 1u) { const int pos = atomicAdd(&cnt[j], 1); lists[j * 128 + pos] = (unsigned char)t; }
        }
        __syncthreads();
        if (t < 128) { for (int j = 0; j < n; ++j) { const int cj = cnt[j]; if (t >= cj && t < ((cj + 15) & ~15)) lists[j * 128 + t] = 255; } }
        {
            const int nown_ = qh * 2 + 2;
            if (t < nown_) desc[t] = make_int4(b * S + n * 256 + t * 64, t * 64 - qh * 128, BIG, -1);
            if (t < 16) {
                int base = nown_; for (int j2 = 0; j2 < t && j2 < n; ++j2) base += ((((cnt[j2] + 15) >> 4) + 3) >> 2) * 4;
                if (t < n) { const int npass = ((((cnt[t] + 15) >> 4) + 3) >> 2);
                    for (int ps = 0; ps < npass; ++ps) for (int kt = 0; kt < 4; ++kt) desc[base + ps * 4 + kt] = make_int4(b * S + t * 256 + kt * 64, ps, kt, t); }
                if (t == 15) { misc[0] = base + ((15 < n) ? ((((cnt[15] + 15) >> 4) + 3) >> 2) * 4 : 0); misc[1] = nown_; }
            }
        }
    }
    __syncthreads();
    const int nd = misc[0], nown = misc[1];
    const int lrow = t >> 2, lch = (t & 3) * 2;
    u32x4 rk0, rk1, rv0, rv1;
    { const int4 d = desc[0]; const bf16_t* rp = z + (size_t)(d.x + lrow) * ZP + lch * 8;
      rk0 = *(const u32x4*)(rp + kcol); rk1 = *(const u32x4*)(rp + kcol + 8); rv0 = *(const u32x4*)(rp + vcol); rv1 = *(const u32x4*)(rp + vcol + 8); }
    bf16x8 nqf[2]; int ngq = 0; bool ngv = false, nhas = false;
    auto prefetch_group = [&](int gi) {
        nhas = false;
        if (gi < nd) { const int4 dg = desc[gi]; const int slot = dg.y * 4 + w; nhas = slot * 16 < cnt[dg.w];
            if (nhas) { const int qi = lists[dg.w * 128 + slot * 16 + r16]; ngv = qi != 255; ngq = ngv ? qi : 0;
#pragma unroll
                for (int ks = 0; ks < 2; ++ks) nqf[ks] = *(const bf16x8*)(z + (size_t)(qbase + ngq) * ZP + qcol + ks * 32 + quad * 8); } }
    };
    prefetch_group(nown);
    {
        bf16x8 qf[2][2];
#pragma unroll
        for (int qt = 0; qt < 2; ++qt)
#pragma unroll
            for (int ks = 0; ks < 2; ++ks) qf[qt][ks] = *(const bf16x8*)(z + (size_t)(qbase + w * 32 + qt * 16 + r16) * ZP + qcol + ks * 32 + quad * 8);
        float m[2] = {-1e30f, -1e30f}, l[2] = {0.f, 0.f}; f32x4 O[2][4];
#pragma unroll
        for (int a = 0; a < 2; ++a)
#pragma unroll
            for (int c = 0; c < 4; ++c) O[a][c] = (f32x4){0.f, 0.f, 0.f, 0.f};
        for (int i = 0; i < nown; ++i) {
            __syncthreads();
            *(u32x4*)(sK + lrow * LDP + lch * 8) = rk0; *(u32x4*)(sK + lrow * LDP + lch * 8 + 8) = rk1;
            *(u32x4*)(sV + lrow * LDP + lch * 8) = rv0; *(u32x4*)(sV + lrow * LDP + lch * 8 + 8) = rv1;
            __syncthreads();
            if (i + 1 < nd) { const int4 d = desc[i + 1]; const bf16_t* rp = z + (size_t)(d.x + lrow) * ZP + lch * 8;
                rk0 = *(const u32x4*)(rp + kcol); rk1 = *(const u32x4*)(rp + kcol + 8); rv0 = *(const u32x4*)(rp + vcol); rv1 = *(const u32x4*)(rp + vcol + 8); }
            const int4 d = desc[i];
            const bool need = (w * 32 + 31 >= d.y) && (w * 32 - 63 <= d.z);
            const bool full = (w * 32 - 63 >= d.y) && (w * 32 + 31 <= d.z);
            if (need) attn_tile<2>(sK, sV, qf, d.y, d.z, full, false, true, true, m, l, O, w * 32);
        }
#pragma unroll
        for (int qt = 0; qt < 2; ++qt) {
            float lt = l[qt]; lt = x32_sum(x16_sum(lt));
            const int ql = w * 32 + qt * 16 + r16;
            if (quad == 0) { stM[ql] = m[qt]; stL[ql] = lt; }
#pragma unroll
            for (int dt = 0; dt < 4; ++dt) *(f32x4*)(stO + ql * 68 + dt * 16 + quad * 4) = O[qt][dt];
        }
    }
    {
        bf16x8 qf[1][2]; float m[1] = {-1e30f}, l[1] = {0.f}; f32x4 O[1][4];
        int gq = 0; bool gv = false, has = false;
        for (int i = nown; i < nd; ++i) {
            __syncthreads();
            *(u32x4*)(sK + lrow * LDP + lch * 8) = rk0; *(u32x4*)(sK + lrow * LDP + lch * 8 + 8) = rk1;
            *(u32x4*)(sV + lrow * LDP + lch * 8) = rv0; *(u32x4*)(sV + lrow * LDP + lch * 8 + 8) = rv1;
            __syncthreads();
            if (i + 1 < nd) { const int4 d = desc[i + 1]; const bf16_t* rp = z + (size_t)(d.x + lrow) * ZP + lch * 8;
                rk0 = *(const u32x4*)(rp + kcol); rk1 = *(const u32x4*)(rp + kcol + 8); rv0 = *(const u32x4*)(rp + vcol); rv1 = *(const u32x4*)(rp + vcol + 8); }
            const int4 d = desc[i];
            if (d.z == 0) {
                has = nhas; gv = ngv; gq = ngq; qf[0][0] = nqf[0]; qf[0][1] = nqf[1];
                m[0] = -1e30f; l[0] = 0.f;
#pragma unroll
                for (int c = 0; c < 4; ++c) O[0][c] = (f32x4){0.f, 0.f, 0.f, 0.f};
                prefetch_group(i + 4);
            }
            if (has) {
                attn_tile<1>(sK, sV, qf, -BIG, BIG, true, false, true, true, m, l, O, 0);
                if (d.z == 3) {
                    float lt = l[0]; lt = x32_sum(x16_sum(lt));
                    if (gv) {
                        const float mo = stM[gq], lo_ = stL[gq]; const float mn = fmaxf(mo, m[0]);
                        const float fa = __builtin_amdgcn_exp2f((mo - mn) * ATT_SC), fb = __builtin_amdgcn_exp2f((m[0] - mn) * ATT_SC);
#pragma unroll
                        for (int dt = 0; dt < 4; ++dt) { float* sp = stO + gq * 68 + dt * 16 + quad * 4; const f32x4 so = *(const f32x4*)sp; *(f32x4*)sp = so * fa + O[0][dt] * fb; }
                        if (quad == 0) { stM[gq] = mn; stL[gq] = lo_ * fa + lt * fb; }
                    }
                }
            }
        }
    }
    __syncthreads();
#pragma unroll
    for (int qt = 0; qt < 2; ++qt) {
        const int ql = w * 32 + qt * 16 + r16; const float inv = 1.f / stL[ql]; const size_t tok = (size_t)(qbase + ql);
#pragma unroll
        for (int dt = 0; dt < 4; ++dt) { const int d0 = dt * 16 + quad * 4; const f32x4 ov = *(const f32x4*)(stO + ql * 68 + d0);
            const u32x2 gvv = *(const u32x2*)(z + tok * ZP + C_AG + h * 64 + d0);
            const float g0 = __uint_as_float(gvv.x << 16), g1 = __uint_as_float(gvv.x & 0xffff0000u), g2 = __uint_as_float(gvv.y << 16), g3 = __uint_as_float(gvv.y & 0xffff0000u);
            u32x2 o; o.x = pack2(ov[0] * inv * silu_f(g0), ov[1] * inv * silu_f(g1)); o.y = pack2(ov[2] * inv * silu_f(g2), ov[3] * inv * silu_f(g3));
            *(u32x2*)(outp + tok * 1024 + h * 64 + d0) = o; }
    }
}

__device__ __forceinline__ void gla_bcum(const Params& p, int l, const bf16_t* z, int tok0, float* bc, float* drs) {
    const int t = tid_opq();
    const int hd = t & 127, ih = t >> 7;
    float wr[16];
#pragma unroll
    for (int r = 0; r < 16; ++r) wr[r] = p.gla_wr[l * 2048 + r * 128 + hd];
    const float br = p.gla_br[l * 128 + hd];
    { const int e0 = t, e1 = t + 256; const bf16_t d0 = z[(size_t)(tok0 + (e0 >> 4)) * ZP + C_DR + (e0 & 15)], d1 = z[(size_t)(tok0 + (e1 >> 4)) * ZP + C_DR + (e1 & 15)];
      drs[e0] = bf2f(d0); drs[e1] = bf2f(d1); }
    __syncthreads();
#pragma unroll
    for (int ii = 0; ii < 16; ++ii) { const int i = ih * 16 + ii; float x = br;
#pragma unroll
        for (int r4 = 0; r4 < 4; ++r4) { const f32x4 dv = *(const f32x4*)(drs + i * 16 + r4 * 4); x += (dv[0] * wr[r4 * 4] + dv[1] * wr[r4 * 4 + 1]) + (dv[2] * wr[r4 * 4 + 2] + dv[3] * wr[r4 * 4 + 3]); }
        bc[i * 128 + hd] = (fminf(x, 0.f) - __logf(1.f + __expf(-fabsf(x)))) * (1.f / 16.f); }
    __syncthreads();
    if (t < 128) { float sacc = 0.f;
#pragma unroll
        for (int i = 0; i < 32; ++i) { sacc += bc[i * 128 + t]; bc[i * 128 + t] = sacc; } }
    __syncthreads();
}

__device__ void gla1_item(const Params& p, int l, int idx, char* smem) {
    const int t = tid_opq(), lane = t & 63, w = t >> 6, r16 = lane & 15, quad = lane >> 4;
    const int b = idx >> 7, c = idx & 127; const int tok0 = b * S + c * 32;
    const bf16_t* z = (const bf16_t*)(p.ws + WS_Z);
    float* bc = (float*)smem; float* drs = (float*)(smem + 16384);
    bf16_t* kdT = (bf16_t*)(smem + 18432) + w * 1024;
    bf16_t* vL = (bf16_t*)(smem + 26624) + w * (32 * LDP);
    float* gkv = (float*)(p.ws + WS_GKV); float* gdec = (float*)(p.ws + WS_GDEC);
    bf16_t kraw[16]; u32x4 vr[4];
#pragma unroll
    for (int i = 0; i < 16; ++i) { const int e = lane + 64 * i; kraw[i] = z[(size_t)(tok0 + (e >> 5)) * ZP + C_DK + w * 32 + (e & 31)]; }
#pragma unroll
    for (int i = 0; i < 4; ++i) { const int cc = lane + 64 * i; vr[i] = *(const u32x4*)(z + (size_t)(tok0 + (cc >> 3)) * ZP + C_DV + w * 64 + (cc & 7) * 8); }
    __syncthreads();
#pragma unroll
    for (int i = 0; i < 4; ++i) { const int cc = lane + 64 * i; *(u32x4*)(vL + (cc >> 3) * LDP + (cc & 7) * 8) = vr[i]; }
    gla_bcum(p, l, z, tok0, bc, drs);
    { float* bcg = (float*)(p.ws + WS_BC) + (size_t)idx * 4096;
#pragma unroll
      for (int i = 0; i < 4; ++i) *(f32x4*)(bcg + (t + 256 * i) * 4) = *(const f32x4*)(bc + (t + 256 * i) * 4); }
#pragma unroll
    for (int i = 0; i < 16; ++i) { const int e = lane + 64 * i; const int j = e >> 5, d = e & 31;
        kdT[d * 32 + j] = f2bf(bf2f(kraw[i]) * __expf(bc[31 * 128 + w * 32 + d] - bc[j * 128 + w * 32 + d])); }
    const int bh = b * 4 + w;
    if (lane < 32) gdec[(bh * 128 + c) * 32 + lane] = __expf(bc[31 * 128 + w * 32 + lane]);
    __syncthreads();
    bf16x8 kf[2];
#pragma unroll
    for (int x = 0; x < 2; ++x) kf[x] = *(const bf16x8*)(kdT + (x * 16 + r16) * 32 + quad * 8);
    float* dst = gkv + (size_t)(bh * 128 + c) * 2048;
#pragma unroll
    for (int dt = 0; dt < 4; ++dt) {
        const bf16_t* v0p = vL + (quad * 8 + (r16 >> 2)) * LDP + dt * 16 + (r16 & 3) * 4;
        const bf16x4 v0 = __builtin_amdgcn_ds_read_tr16_b64_v4i16((__attribute__((address_space(3))) bf16x4*)(v0p));
        const bf16x4 v1 = __builtin_amdgcn_ds_read_tr16_b64_v4i16((__attribute__((address_space(3))) bf16x4*)(v0p + 4 * LDP));
        const bf16x8 vf = {v0[0], v0[1], v0[2], v0[3], v1[0], v1[1], v1[2], v1[3]};
#pragma unroll
        for (int x = 0; x < 2; ++x) {
            const f32x4 r = __builtin_amdgcn_mfma_f32_16x16x32_bf16(vf, kf[x], (f32x4){0.f, 0.f, 0.f, 0.f}, 0, 0, 0);
            *(f32x4*)(dst + (x * 16 + r16) * 64 + dt * 16 + quad * 4) = r;
        }
    }
}

#define OPQ(ptr) asm volatile("" : "+v"(ptr))
__device__ void gla3_item(const Params& p, int l, int idx, char* smem) {
    const int t = tid_opq(), lane = t & 63, w = t >> 6, r16 = lane & 15, quad = lane >> 4;
    const int b = idx >> 7, c = idx & 127; const int tok0 = b * S + c * 32;
    const bf16_t* z = (const bf16_t*)(p.ws + WS_Z); bf16_t* mix = (bf16_t*)(p.ws + WS_U);
    float* bc = (float*)smem; float* drs = (float*)(smem + 16384);
    bf16_t* SL = (bf16_t*)smem + w * (32 * LDP);
    bf16_t* qe = (bf16_t*)(smem + 18432) + w * 1024;
    bf16_t* ke = (bf16_t*)(smem + 26624) + w * 1024;
    bf16_t* vL = (bf16_t*)(smem + 34816) + w * (32 * LDP);
    const float* gkv = (const float*)(p.ws + WS_GKV);
    const int bh = b * 4 + w;
    bf16_t qraw[16], kraw[16];
    { const bf16_t* qp = z + (size_t)(tok0 + (lane >> 5)) * ZP + w * 32 + (lane & 31);
#pragma unroll
      for (int i = 0; i < 16; ++i) { qraw[i] = qp[C_DQ]; kraw[i] = qp[C_DK]; qp += 2 * ZP; OPQ(qp); } }
    u32x4 vr[4]; f32x4 sr[8];
#pragma unroll
    for (int i = 0; i < 4; ++i) { const int cc = lane + 64 * i; vr[i] = *(const u32x4*)(z + (size_t)(tok0 + (cc >> 3)) * ZP + C_DV + w * 64 + (cc & 7) * 8); }
    { const float* Sp = gkv + (size_t)(bh * 128 + c) * 2048;
#pragma unroll
      for (int i = 0; i < 8; ++i) sr[i] = __builtin_nontemporal_load((const f32x4*)(Sp + (lane + 64 * i) * 4)); }
    f32x4 bcr[4];
    { const float* bcg = (const float*)(p.ws + WS_BC) + (size_t)idx * 4096;
#pragma unroll
      for (int i = 0; i < 4; ++i) bcr[i] = __builtin_nontemporal_load((const f32x4*)(bcg + (t + 256 * i) * 4)); }
    __syncthreads();
#pragma unroll
    for (int i = 0; i < 4; ++i) { const int cc = lane + 64 * i; *(u32x4*)(vL + (cc >> 3) * LDP + (cc & 7) * 8) = vr[i]; }
#pragma unroll
    for (int i = 0; i < 4; ++i) *(f32x4*)(bc + (t + 256 * i) * 4) = bcr[i];
    __syncthreads();
#pragma unroll
    for (int i2 = 0; i2 < 16; ++i2) { const int e = lane + 64 * i2; const int i = e >> 5, d = e & 31; const float bcv = bc[i * 128 + w * 32 + d];
        qe[i * 32 + d] = f2bf(bf2f(qraw[i2]) * __expf(bcv) * 0.17677669529663687f); ke[i * 32 + d] = f2bf(bf2f(kraw[i2]) * __expf(-bcv)); }
    __syncthreads();
#pragma unroll
    for (int i = 0; i < 8; ++i) { const int cc = lane + 64 * i; const int d = cc >> 4, v4 = cc & 15; u32x2 pk; pk.x = pack2(sr[i][0], sr[i][1]); pk.y = pack2(sr[i][2], sr[i][3]);
        *(u32x2*)(SL + d * LDP + v4 * 4) = pk; }
    __syncthreads();
    bf16x8 qf[2], kf[2];
#pragma unroll
    for (int x = 0; x < 2; ++x) { qf[x] = *(const bf16x8*)(qe + (x * 16 + r16) * 32 + quad * 8); kf[x] = *(const bf16x8*)(ke + (x * 16 + r16) * 32 + quad * 8); }
    bf16x8 pf[2];
#pragma unroll
    for (int it = 0; it < 2; ++it) {
        f32x4 at[2];
#pragma unroll
        for (int jt = 0; jt < 2; ++jt) { at[jt] = __builtin_amdgcn_mfma_f32_16x16x32_bf16(kf[jt], qf[it], (f32x4){0.f, 0.f, 0.f, 0.f}, 0, 0, 0);
#pragma unroll
            for (int jj = 0; jj < 4; ++jj) at[jt][jj] = (jt * 16 + quad * 4 + jj <= it * 16 + r16) ? at[jt][jj] : 0.f; }
        u32x4 pk = {pack2(at[0][0], at[0][1]), pack2(at[0][2], at[0][3]), pack2(at[1][0], at[1][1]), pack2(at[1][2], at[1][3])};
        pf[it] = __builtin_bit_cast(bf16x8, pk);
    }
    f32x4 O[2][4];
#pragma unroll
    for (int dt = 0; dt < 4; ++dt) {
        const bf16_t* v0p = vL + (quad * 4 + (r16 >> 2)) * LDP + dt * 16 + (r16 & 3) * 4;
        const bf16x4 v0 = __builtin_amdgcn_ds_read_tr16_b64_v4i16((__attribute__((address_space(3))) bf16x4*)(v0p));
        const bf16x4 v1 = __builtin_amdgcn_ds_read_tr16_b64_v4i16((__attribute__((address_space(3))) bf16x4*)(v0p + 16 * LDP));
        const bf16x8 vf = {v0[0], v0[1], v0[2], v0[3], v1[0], v1[1], v1[2], v1[3]};
        const bf16_t* s0p = SL + (quad * 8 + (r16 >> 2)) * LDP + dt * 16 + (r16 & 3) * 4;
        const bf16x4 s0 = __builtin_amdgcn_ds_read_tr16_b64_v4i16((__attribute__((address_space(3))) bf16x4*)(s0p));
        const bf16x4 s1 = __builtin_amdgcn_ds_read_tr16_b64_v4i16((__attribute__((address_space(3))) bf16x4*)(s0p + 4 * LDP));
        const bf16x8 sf = {s0[0], s0[1], s0[2], s0[3], s1[0], s1[1], s1[2], s1[3]};
#pragma unroll
        for (int it = 0; it < 2; ++it) {
            O[it][dt] = __builtin_amdgcn_mfma_f32_16x16x32_bf16(vf, pf[it], (f32x4){0.f, 0.f, 0.f, 0.f}, 0, 0, 0);
            O[it][dt] = __builtin_amdgcn_mfma_f32_16x16x32_bf16(sf, qf[it], O[it][dt], 0, 0, 0);
        }
    }
#pragma unroll
    for (int it = 0; it < 2; ++it) {
        float ss = 0.f;
#pragma unroll
        for (int dt = 0; dt < 4; ++dt) ss += (O[it][dt][0] * O[it][dt][0] + O[it][dt][1] * O[it][dt][1]) + (O[it][dt][2] * O[it][dt][2] + O[it][dt][3] * O[it][dt][3]);
        ss = x32_sum(x16_sum(ss));
        const float rn = rsqrtf(ss * (1.f / 64.f) + 1e-5f);
        const size_t tok = (size_t)(tok0 + it * 16 + r16);
#pragma unroll
        for (int dt = 0; dt < 4; ++dt) { const int v0i = dt * 16 + quad * 4; const f32x4 gn = *(const f32x4*)(p.gla_gn + l * 64 + v0i);
            const u32x2 gv = *(const u32x2*)(z + tok * ZP + C_DG + w * 64 + v0i);
            const float g0 = __uint_as_float(gv.x << 16), g1 = __uint_as_float(gv.x & 0xffff0000u), g2 = __uint_as_float(gv.y << 16), g3 = __uint_as_float(gv.y & 0xffff0000u);
            u32x2 o; o.x = pack2(O[it][dt][0] * rn * gn[0] * silu_f(g0), O[it][dt][1] * rn * gn[1] * silu_f(g1));
            o.y = pack2(O[it][dt][2] * rn * gn[2] * silu_f(g2), O[it][dt][3] * rn * gn[3] * silu_f(g3));
            *(u32x2*)(mix + tok * 1024 + 768 + w * 64 + v0i) = o; }
    }
}

__device__ void lru1_item(const Params& p, int l, int idx, char* smem) {
    const int t = tid_opq(), lane = t & 63, g = t >> 6, r16 = lane & 15, quad = lane >> 4; const int ch = t;
    const int b = idx >> 7, c = idx & 127; const int s0 = c * 32; const int tok0 = b * S + s0;
    const bf16_t* z = (const bf16_t*)(p.ws + WS_Z); float* xcs = (float*)smem;
    bf16_t* preA = (bf16_t*)(smem + 32768); bf16_t* preX = (bf16_t*)(smem + 49152);
    float* lh = (float*)(p.ws + WS_LH); float* lp = (float*)(p.ws + WS_LP);
    bf16_t xr[35];
#pragma unroll
    for (int i = 0; i < 35; ++i) { const int sidx = s0 + i - 3; xr[i] = (sidx >= 0) ? z[(size_t)(tok0 + i - 3) * ZP + C_BX + ch] : (bf16_t)0; }
    const float cw0 = p.conv_w[l * 1024 + ch], cw1 = p.conv_w[l * 1024 + 256 + ch], cw2 = p.conv_w[l * 1024 + 512 + ch], cw3 = p.conv_w[l * 1024 + 768 + ch];
    const float cb = p.conv_b[l * 256 + ch];
    const bf16_t* lwt = (const bf16_t*)(p.ws + WS_LWT) + (size_t)l * 32768 + g * 4096;
    bf16x8 wfa[4][2], wfx[4][2];
#pragma unroll
    for (int nt = 0; nt < 4; ++nt)
#pragma unroll
        for (int ks = 0; ks < 2; ++ks) { wfa[nt][ks] = *(const bf16x8*)(lwt + (nt * 16 + r16) * 64 + ks * 32 + quad * 8); wfx[nt][ks] = *(const bf16x8*)(lwt + 16384 + (nt * 16 + r16) * 64 + ks * 32 + quad * 8); }
    __syncthreads();
#pragma unroll
    for (int i = 0; i < 32; ++i) xcs[i * 256 + ch] = cb + (cw0 * bf2f(xr[i]) + cw1 * bf2f(xr[i + 1])) + (cw2 * bf2f(xr[i + 2]) + cw3 * bf2f(xr[i + 3]));
    __syncthreads();
#pragma unroll
    for (int tt = 0; tt < 2; ++tt) {
        bf16x8 xf[2];
#pragma unroll
        for (int ks = 0; ks < 2; ++ks) { const float* xp = xcs + (tt * 16 + r16) * 256 + g * 64 + ks * 32 + quad * 8; const f32x4 x0 = *(const f32x4*)xp, x1 = *(const f32x4*)(xp + 4);
            u32x4 pk = {pack2(x0[0], x0[1]), pack2(x0[2], x0[3]), pack2(x1[0], x1[1]), pack2(x1[2], x1[3])}; xf[ks] = __builtin_bit_cast(bf16x8, pk); }
#pragma unroll
        for (int nt = 0; nt < 4; ++nt) {
            f32x4 ra = __builtin_amdgcn_mfma_f32_16x16x32_bf16(wfa[nt][0], xf[0], (f32x4){0.f, 0.f, 0.f, 0.f}, 0, 0, 0); ra = __builtin_amdgcn_mfma_f32_16x16x32_bf16(wfa[nt][1], xf[1], ra, 0, 0, 0);
            f32x4 rx = __builtin_amdgcn_mfma_f32_16x16x32_bf16(wfx[nt][0], xf[0], (f32x4){0.f, 0.f, 0.f, 0.f}, 0, 0, 0); rx = __builtin_amdgcn_mfma_f32_16x16x32_bf16(wfx[nt][1], xf[1], rx, 0, 0, 0);
            u32x2 pa; pa.x = pack2(ra[0], ra[1]); pa.y = pack2(ra[2], ra[3]); u32x2 px; px.x = pack2(rx[0], rx[1]); px.y = pack2(rx[2], rx[3]);
            *(u32x2*)(preA + (tt * 16 + r16) * 256 + g * 64 + nt * 16 + quad * 4) = pa; *(u32x2*)(preX + (tt * 16 + r16) * 256 + g * 64 + nt * 16 + quad * 4) = px;
        }
    }
    __syncthreads();
    const float ba = p.lru_ba[l * 256 + ch], bx = p.lru_bx[l * 256 + ch], lam = p.lru_lam[l * 256 + ch];
    const float sp = fmaxf(-lam, 0.f) + log1pf(__expf(-fabsf(lam)));
    float hh = 0.f, P = 1.f;
    float* lhp = lh + (size_t)tok0 * 256 + ch; float* lpp = lp + (size_t)tok0 * 256 + ch;
#pragma unroll 4
    for (int i = 0; i < 32; ++i) { const float r = sigmoid_f(bf2f(preA[i * 256 + ch]) + ba), ig = sigmoid_f(bf2f(preX[i * 256 + ch]) + bx); const float la = -8.f * r * sp; const float a = __expf(la);
        const float w2 = 2.f * la;
        const float em_s = -w2 * (1.f + w2 * (0.5f + w2 * (0.16666667f + w2 * (0.041666668f + w2 * (0.0083333338f + w2 * 0.0013888889f)))));
        const float em = (w2 > -0.25f) ? em_s : (1.f - a * a);
        const float u = __builtin_amdgcn_sqrtf(em) * (ig * xcs[i * 256 + ch]); hh = a * hh + u; P *= a;
        lhp[(size_t)i * 256] = hh; lpp[(size_t)i * 256] = P; }
}

__device__ void lru3_item(const Params& p, int idx) {
    const int ch = tid_opq(); const int b = idx >> 7, c = idx & 127; const int tok0 = b * S + c * 32;
    const bf16_t* z = (const bf16_t*)(p.ws + WS_Z); bf16_t* mix = (bf16_t*)(p.ws + WS_U);
    const float* lh = (const float*)(p.ws + WS_LH); const float* lp = (const float*)(p.ws + WS_LP); const float* lc = (const float*)(p.ws + WS_LC);
    const float carry = lc[(size_t)(b * 128 + c) * 256 + ch];
    float hv[32], pv[32]; bf16_t gv[32];
#pragma unroll
    for (int i = 0; i < 32; ++i) { const size_t tok = (size_t)(tok0 + i); hv[i] = __builtin_nontemporal_load(lh + tok * 256 + ch); pv[i] = __builtin_nontemporal_load(lp + tok * 256 + ch); gv[i] = z[tok * ZP + C_BG + ch]; }
#pragma unroll
    for (int i = 0; i < 32; ++i) { const size_t tok = (size_t)(tok0 + i); mix[tok * 1024 + 256 + ch] = f2bf((hv[i] + pv[i] * carry) * silu_f(bf2f(gv[i]))); }
}

__device__ void dilc_item(const Params& p, int idx) {
    const int t = tid_opq(); const size_t tok = (size_t)idx * 8 + (t >> 5); const int chn = t & 31; const int h = chn >> 3;
    const bf16_t* z = (const bf16_t*)(p.ws + WS_Z); bf16_t* mix = (bf16_t*)(p.ws + WS_U);
    const bf16_t* dilo = (const bf16_t*)(p.ws + WS_DILO); const float* dill = (const float*)(p.ws + WS_DILL);
    const float l0 = dill[((size_t)0 * T + tok) * 4 + h], l1 = dill[((size_t)1 * T + tok) * 4 + h], l2 = dill[((size_t)2 * T + tok) * 4 + h];
    const float mx = fmaxf(l0, fmaxf(l1, l2)); float w0 = __expf(l0 - mx), w1 = __expf(l1 - mx), w2 = __expf(l2 - mx); const float inv = 1.f / (w0 + w1 + w2); w0 *= inv; w1 *= inv; w2 *= inv;
    const u32x4 o0 = __builtin_nontemporal_load((const u32x4*)(dilo + ((size_t)0 * T + tok) * 256 + chn * 8)), o1 = __builtin_nontemporal_load((const u32x4*)(dilo + ((size_t)1 * T + tok) * 256 + chn * 8)), o2 = __builtin_nontemporal_load((const u32x4*)(dilo + ((size_t)2 * T + tok) * 256 + chn * 8));
    const u32x4 gv = *(const u32x4*)(z + tok * ZP + C_CG + chn * 8);
    u32x4 r;
#pragma unroll
    for (int e = 0; e < 4; ++e) {
        const float a = w0 * __uint_as_float(o0[e] << 16) + w1 * __uint_as_float(o1[e] << 16) + w2 * __uint_as_float(o2[e] << 16);
        const float bq = w0 * __uint_as_float(o0[e] & 0xffff0000u) + w1 * __uint_as_float(o1[e] & 0xffff0000u) + w2 * __uint_as_float(o2[e] & 0xffff0000u);
        r[e] = pack2(a * silu_f(__uint_as_float(gv[e] << 16)), bq * silu_f(__uint_as_float(gv[e] & 0xffff0000u)));
    }
    *(u32x4*)(mix + tok * 1024 + 512 + chn * 8) = r;
}

__device__ void m2_phase(const Params& p, char* smem) {
    float* gkv = (float*)(p.ws + WS_GKV); const float* gdec = (const float*)(p.ws + WS_GDEC);
    const float* lh = (const float*)(p.ws + WS_LH); const float* lp = (const float*)(p.ws + WS_LP); float* lc = (float*)(p.ws + WS_LC);
    float* aggP = (float*)smem; float* aggS = aggP + 256;
    const int t = tid_opq(); const int e = t & 31, seg = t >> 5;
    for (int it = blockIdx.x; it < 1024 + 32; it += gridDim.x) {
        float a[16], x[16];
        size_t ostride;
        float* outp;
        if (it < 1024) {
            const int gid = it * 32 + e; const int bh = gid >> 11, dv = gid & 2047, d = dv >> 6;
            float* base = gkv + (size_t)bh * 128 * 2048 + dv + (size_t)(seg * 16) * 2048; const float* dc = gdec + (size_t)bh * 128 * 32 + d + (seg * 16) * 32;
#pragma unroll
            for (int k = 0; k < 16; ++k) { x[k] = base[(size_t)k * 2048]; a[k] = dc[k * 32]; }
            outp = base; ostride = 2048;
        } else {
            const int i2 = it - 1024; const int b = i2 >> 3, ch = (i2 & 7) * 32 + e;
#pragma unroll
            for (int k = 0; k < 16; ++k) { const size_t ix = (size_t)(b * S + (seg * 16 + k) * 32 + 31) * 256 + ch; a[k] = lp[ix]; x[k] = lh[ix]; }
            outp = lc + (size_t)(b * 128 + seg * 16) * 256 + ch; ostride = 256;
        }
        float st = 0.f, pr = 1.f;
#pragma unroll
        for (int k = 0; k < 16; ++k) { const float ak = a[k], xk = x[k]; a[k] = pr; x[k] = st; st = ak * st + xk; pr *= ak; }
        __syncthreads();
        aggP[seg * 32 + e] = pr; aggS[seg * 32 + e] = st;
        __syncthreads();
        float carry = 0.f;
        for (int s2 = 0; s2 < seg; ++s2) carry = aggP[s2 * 32 + e] * carry + aggS[s2 * 32 + e];
#pragma unroll
        for (int k = 0; k < 16; ++k) outp[(size_t)k * ostride] = x[k] + a[k] * carry;
    }
}

__global__ void __launch_bounds__(256, 2) fwd_megakernel(Params p) {
    __shared__ __attribute__((aligned(16))) char smem[SMEM_BYTES];
    __shared__ uint4 xb_words;
    __shared__ int s_slot;
    cg::grid_group grid = cg::this_grid();
    if (p.out == nullptr) grid.sync();
    if (threadIdx.x == 0) xb_words = make_uint4(0u, 0u, 0u, 0u);
    __syncthreads();
    const XcdBarrier xb = xcd_barrier_post((unsigned*)(p.ws + WS_CTL), (volatile LAS unsigned*)&xb_words);
    unsigned* cnt = (unsigned*)(p.ws + WS_CNT);
    prologue_phase(p, smem);
    xcd_barrier(xb);
#pragma unroll 1
    for (int l = 0; l < DEPTH; ++l) {
        ln_phase(p, l);
        xcd_barrier(xb);
        g1_phase(p, l, smem);
        xcd_barrier(xb);
        for (;;) { const int it = next_item(cnt + (4 + l) * 64, &s_slot); if (it >= 512) break; lru1_item(p, l, it, smem); }
        { const int xq = blockIdx.x & 7;
          for (;;) { const int li = next_item(cnt + (16 + l * 8 + xq) * 64, &s_slot); if (li >= 64) break;
              const int pr = xq * 2 + ((li >> 1) & 1); moba_item(p, (li >> 2) * 32 + (pr >> 2) * 8 + (pr & 3) * 2 + (li & 1), smem, (bf16_t*)(p.ws + WS_U)); }
          for (;;) { const int li = next_item(cnt + (32 + l * 8 + xq) * 64, &s_slot); if (li >= 192) break;
              const int cfg = li >> 6, r6 = li & 63; const int pr = xq * 2 + (r6 >> 5); attn_item(p, 1, cfg * 512 + (pr >> 2) * 128 + (pr & 3) * 32 + (r6 & 31), smem); } }
        for (;;) { const int it = next_item(cnt + (2 + l) * 64, &s_slot); if (it >= 512) break; gla1_item(p, l, it, smem); }
        xcd_barrier(xb);
        m2_phase(p, smem);
        xcd_barrier(xb);
        for (int it = blockIdx.x; it < 512; it += gridDim.x) gla3_item(p, l, it, smem);
        for (int it = blockIdx.x; it < 512; it += gridDim.x) lru3_item(p, it);
        for (int it = blockIdx.x; it < 2048; it += gridDim.x) dilc_item(p, it);
        xcd_barrier(xb);
        g2_phase(p, l, smem);
        xcd_barrier(xb);
    }
    ln_phase(p, DEPTH);
}

extern "C" void kernel_launch(void* const* d_in, const int* in_sizes, int n_in, void* d_out, int out_size, void* d_ws, size_t ws_size, hipStream_t stream) {
    static int grid_blocks = 0;
    if (!grid_blocks) {
        int dev = 0, cus = 0, per_cu = 0;
        hipGetDevice(&dev);
        hipDeviceGetAttribute(&cus, hipDeviceAttributeMultiprocessorCount, dev);
        hipOccupancyMaxActiveBlocksPerMultiprocessor(&per_cu, (const void*)fwd_megakernel, 256, 0);
        if (per_cu < 1) per_cu = 1;
        if (per_cu > 2) per_cu = 2;
        grid_blocks = cus * per_cu;
        if (ws_size < WS_END) fprintf(stderr, "kernel_launch: workspace too small: %zu < %zu\n", ws_size, (size_t)WS_END);
    }
    Params p{};
    p.x = (const float*)d_in[0]; p.c = (const float*)d_in[1]; p.pos = (const int*)d_in[2];
    p.w_mod = (const float*)d_in[3]; p.b_mod = (const float*)d_in[4]; p.w_in = (const float*)d_in[5];
    p.conv_w = (const float*)d_in[6]; p.conv_b = (const float*)d_in[7]; p.lru_wa = (const float*)d_in[8]; p.lru_ba = (const float*)d_in[9];
    p.lru_wx = (const float*)d_in[10]; p.lru_bx = (const float*)d_in[11]; p.lru_lam = (const float*)d_in[12];
    p.gla_wr = (const float*)d_in[13]; p.gla_br = (const float*)d_in[14]; p.gla_gn = (const float*)d_in[15];
    p.w_out = (const float*)d_in[16]; p.ln_g = (const float*)d_in[17]; p.ln_b = (const float*)d_in[18];
    p.out = (float*)d_out; p.ws = (unsigned char*)d_ws;
    (void)hipMemsetAsync(d_ws, 0, 32768, stream);
    void* args[] = {&p};
    hipError_t e = hipLaunchCooperativeKernel((const void*)fwd_megakernel, dim3(grid_blocks), dim3(256), args, 0, stream);
    if (e != hipSuccess) fprintf(stderr, "cooperative launch failed: %s (grid %d)\n", hipGetErrorString(e), grid_blocks);
}
```

```cpp
#include <hip/hip_runtime.h>
#include <hip/hip_cooperative_groups.h>
#include <cstdio>
#include <cstdint>
#include <type_traits>
namespace cg = cooperative_groups;

typedef unsigned short bf16_t;
typedef short bf16x8 __attribute__((ext_vector_type(8)));
typedef short bf16x4 __attribute__((ext_vector_type(4)));
typedef float f32x4 __attribute__((ext_vector_type(4)));
typedef unsigned u32x4 __attribute__((ext_vector_type(4)));
typedef unsigned u32x2 __attribute__((ext_vector_type(2)));

constexpr int D = 1024, NB = 4, S = 4096, T = NB * S, DEPTH = 2;
constexpr int DIN = 3344, ZP = 3392, NPAD = 3456;
constexpr int C_AQ = 0, C_AK = 256, C_AV = 512, C_AG = 768, C_BX = 1024, C_BG = 1280, C_CQ = 1536, C_CK = 1792,
              C_CV = 2048, C_CG = 2304, C_DQ = 2560, C_DK = 2688, C_DV = 2816, C_DG = 3072, C_DR = 3328;
constexpr float DN_ALPHA = 1.4142135623730951f;
constexpr int LDP = 72;
constexpr int SMEM_BYTES = 65536;
constexpr int BIG = 1000000;

constexpr size_t WS_CTL = 0;
constexpr size_t WS_CNT = 16384;
constexpr size_t WS_WINT = 32768;
constexpr size_t WS_WOUTT = WS_WINT + (size_t)DEPTH * NPAD * 1024 * 2;
constexpr size_t WS_MOD = WS_WOUTT + (size_t)DEPTH * 1024 * 1024 * 2;
constexpr size_t WS_COS = WS_MOD + (size_t)DEPTH * NB * 3072 * 4;
constexpr size_t WS_SIN = WS_COS + (size_t)T * 32 * 4;
constexpr size_t WS_U = WS_SIN + (size_t)T * 32 * 4;
constexpr size_t WS_Z = WS_U + (size_t)T * 1024 * 2;
constexpr size_t WS_KPART = WS_Z + (size_t)T * ZP * 2;
constexpr size_t WS_DILO = WS_KPART + (size_t)256 * 256 * 4;
constexpr size_t WS_DILL = WS_DILO + (size_t)3 * T * 256 * 2;
constexpr size_t WS_GKV = WS_DILL + (size_t)3 * T * 4 * 4;
constexpr size_t WS_GDEC = WS_GKV + (size_t)2048 * 2048 * 4;
constexpr size_t WS_LH = WS_GDEC + (size_t)2048 * 32 * 4;
constexpr size_t WS_LP = WS_LH + (size_t)T * 256 * 4;
constexpr size_t WS_LC = WS_LP + (size_t)T * 256 * 4;
constexpr size_t WS_LWT = WS_LC + (size_t)NB * 128 * 256 * 4;
constexpr size_t WS_BC = WS_LWT + (size_t)DEPTH * 2 * 4 * 64 * 64 * 2;
constexpr size_t WS_END = WS_BC + (size_t)512 * 32 * 128 * 4;

struct Params {
    const float *x, *c; const int* pos;
    const float *w_mod, *b_mod, *w_in, *conv_w, *conv_b, *lru_wa, *lru_ba, *lru_wx, *lru_bx, *lru_lam, *gla_wr, *gla_br, *gla_gn, *w_out, *ln_g, *ln_b;
    float* out; unsigned char* ws;
};

__device__ __forceinline__ float bf2f(bf16_t h) { return __uint_as_float(((unsigned)h) << 16); }
typedef __bf16 hbf16x2 __attribute__((ext_vector_type(2)));
typedef float f32x2 __attribute__((ext_vector_type(2)));
__device__ __forceinline__ unsigned pack2(float a, float b) { f32x2 v = {a, b}; hbf16x2 r = __builtin_convertvector(v, hbf16x2); return __builtin_bit_cast(unsigned, r); }
__device__ __forceinline__ bf16_t f2bf(float f) { return (bf16_t)(pack2(f, 0.f) & 0xffffu); }
__device__ __forceinline__ float silu_f(float x) { return x / (1.f + __expf(-x)); }
__device__ __forceinline__ float sigmoid_f(float x) { return 1.f / (1.f + __expf(-x)); }
__device__ __forceinline__ int tid_opq() { int t = threadIdx.x; asm volatile("" : "+v"(t)); return t; }
__device__ __forceinline__ float x16_sum(float v) { auto r = __builtin_amdgcn_permlane16_swap(__float_as_uint(v), __float_as_uint(v), false, false); return __uint_as_float(r[0]) + __uint_as_float(r[1]); }
__device__ __forceinline__ float x32_sum(float v) { auto r = __builtin_amdgcn_permlane32_swap(__float_as_uint(v), __float_as_uint(v), false, false); return __uint_as_float(r[0]) + __uint_as_float(r[1]); }
__device__ __forceinline__ float x16_max(float v) { auto r = __builtin_amdgcn_permlane16_swap(__float_as_uint(v), __float_as_uint(v), false, false); return fmaxf(__uint_as_float(r[0]), __uint_as_float(r[1])); }
__device__ __forceinline__ float x32_max(float v) { auto r = __builtin_amdgcn_permlane32_swap(__float_as_uint(v), __float_as_uint(v), false, false); return fmaxf(__uint_as_float(r[0]), __uint_as_float(r[1])); }
__device__ __forceinline__ float row16_sum(float v) {
    v += __uint_as_float(__builtin_amdgcn_update_dpp(0u, __float_as_uint(v), 0x128, 0xf, 0xf, false));
    v += __uint_as_float(__builtin_amdgcn_update_dpp(0u, __float_as_uint(v), 0x124, 0xf, 0xf, false));
    v += __uint_as_float(__builtin_amdgcn_update_dpp(0u, __float_as_uint(v), 0x122, 0xf, 0xf, false));
    v += __uint_as_float(__builtin_amdgcn_update_dpp(0u, __float_as_uint(v), 0x121, 0xf, 0xf, false));
    return v;
}
__device__ __forceinline__ float wsum(float v) { return x32_sum(x16_sum(row16_sum(v))); }

#define XB_TMO      128
#define XB_XCNT(j)  (256  + 64 * (j))
#define XB_XSUB(j)  (1280 + 64 * (j))
#define XB_XGEN(j)  (2304 + 64 * (j))
#define XB_TOP      3328
#define XB_TOPGEN   3392
#define XCD_BAR_WORDS 3456
#define XB_SPIN_CAP (1u << 18)
#define LAS __attribute__((address_space(3)))
__device__ __forceinline__ unsigned xb_ld(unsigned* p)              { return __hip_atomic_load(p, __ATOMIC_RELAXED, __HIP_MEMORY_SCOPE_AGENT); }
__device__ __forceinline__ unsigned xb_add(unsigned* p, unsigned v) { return __hip_atomic_fetch_add(p, v, __ATOMIC_RELAXED, __HIP_MEMORY_SCOPE_AGENT); }
__device__ __forceinline__ unsigned xb_xcc_id() { return (unsigned)__builtin_amdgcn_s_getreg((3 << 11) | 20) & 0xFu; }
#define XB_SPIN(cond, bar) do { unsigned _sp = 0; while (cond) { __builtin_amdgcn_s_sleep(1); \
    if ((++_sp & 255u) == 0u) { if (xb_ld(&(bar)[XB_TMO])) break; if (_sp > XB_SPIN_CAP) { atomicAdd(&(bar)[XB_TMO], 1u); break; } } } } while (0)
struct XcdBarrier { unsigned* bar; unsigned x; volatile LAS unsigned* st; };
__device__ __forceinline__ XcdBarrier xcd_barrier_post(unsigned* bar, volatile LAS unsigned* st) {
    XcdBarrier b; b.bar = bar; b.x = xb_xcc_id(); b.st = st;
    if (threadIdx.x == 0) (void)xb_add(&bar[XB_XCNT(b.x)], 1u);
    return b;
}
__device__ __forceinline__ void xcd_barrier_complete(unsigned* bar, unsigned x, unsigned& nloc, unsigned& nx) {
    const unsigned G = gridDim.x * gridDim.y * gridDim.z;
    unsigned sum, cnt, mine, sp = 0u;
    for (;;) {
        sum = 0u; cnt = 0u; mine = 0u;
#pragma unroll
        for (unsigned j = 0; j < 16; ++j) { const unsigned c = xb_ld(&bar[XB_XCNT(j)]); sum += c; cnt += (c > 0u) ? 1u : 0u; mine = (j == x) ? c : mine; }
        if (sum == G) break;
        __builtin_amdgcn_s_sleep(1);
        if ((++sp & 255u) == 0u) { if (xb_ld(&bar[XB_TMO])) break; if (sp > XB_SPIN_CAP) { atomicAdd(&bar[XB_TMO], 1u); break; } }
    }
    nloc = mine > 0u ? mine : 1u; nx = cnt > 0u ? cnt : 1u;
}
__device__ __forceinline__ void xcd_barrier(const XcdBarrier& b) {
    asm volatile("s_waitcnt vmcnt(0)" ::: "memory");
    __syncthreads();
    if (threadIdx.x == 0) {
        unsigned* bar = b.bar;
        __builtin_amdgcn_s_waitcnt(0);
        unsigned nloc = b.st[0], nx = b.st[1];
        if (nloc == 0u) { xcd_barrier_complete(bar, b.x, nloc, nx); b.st[0] = nloc; b.st[1] = nx; }
        const unsigned old = xb_add(&bar[XB_XSUB(b.x)], 1u);
        const unsigned gen = old / nloc;
        if (old + 1u == (gen + 1u) * nloc) {
            __builtin_amdgcn_fence(__ATOMIC_RELEASE, "agent");
            asm volatile("s_waitcnt vmcnt(0)" ::: "memory");
            const unsigned og = xb_add(&bar[XB_TOP], 1u);
            const unsigned tg = og / nx;
            if (og + 1u == (tg + 1u) * nx) xb_add(&bar[XB_TOPGEN], 1u);
            else XB_SPIN(xb_ld(&bar[XB_TOPGEN]) == tg, bar);
            __builtin_amdgcn_fence(__ATOMIC_ACQUIRE, "agent");
            xb_add(&bar[XB_XGEN(b.x)], 1u);
            asm volatile("s_waitcnt vmcnt(0)" ::: "memory");
        } else {
            XB_SPIN(xb_ld(&bar[XB_XGEN(b.x)]) == gen, bar);
            __builtin_amdgcn_fence(__ATOMIC_ACQUIRE, "agent");
            asm volatile("s_waitcnt vmcnt(0)" ::: "memory");
        }
    }
    __syncthreads();
}
__device__ __forceinline__ int next_item(unsigned* ctr, volatile int* slot) {
    __syncthreads();
    if (threadIdx.x == 0) *slot = (int)atomicAdd(ctr, 1u);
    __syncthreads();
    return *slot;
}

__device__ void prologue_phase(const Params& p, char* smem) {
    const int t = tid_opq();
    bf16_t* WinT = (bf16_t*)(p.ws + WS_WINT); bf16_t* WoutT = (bf16_t*)(p.ws + WS_WOUTT);
    float* mod = (float*)(p.ws + WS_MOD); float* cosT = (float*)(p.ws + WS_COS); float* sinT = (float*)(p.ws + WS_SIN);
    float* tl = (float*)smem;
    constexpr int N_TIN = DEPTH * 16 * 54, N_TOUT = DEPTH * 16 * 16, N_MOD = DEPTH * 192, N_ROPE = T * 32 / 256, N_LWT = DEPTH * 2 * 4 * 64 * 64 / 256;
    constexpr int NITEMS = N_TIN + N_TOUT + N_MOD + N_ROPE + N_LWT;
    for (int it = blockIdx.x; it < NITEMS; it += gridDim.x) {
        if (it < N_TIN + N_TOUT) {
            const float* src; bf16_t* dst; int ncols, kt, nt;
            if (it < N_TIN) { int l = it / (16 * 54), r = it % (16 * 54); kt = r / 54; nt = r % 54; src = p.w_in + (size_t)l * 1024 * DIN; dst = WinT + (size_t)l * NPAD * 1024; ncols = DIN; }
            else { int i2 = it - N_TIN; int l = i2 / 256, r = i2 % 256; kt = r / 16; nt = r % 16; src = p.w_out + (size_t)l * 1024 * 1024; dst = WoutT + (size_t)l * 1024 * 1024; ncols = 1024; }
            __syncthreads();
            { const int c4 = t & 15, r0 = t >> 4; const int n = nt * 64 + c4 * 4;
              f32x4 v[4];
#pragma unroll
              for (int i = 0; i < 4; ++i) { const int r = r0 + 16 * i; v[i] = (n < ncols) ? __builtin_nontemporal_load((const f32x4*)(src + (size_t)(kt * 64 + r) * ncols + n)) : (f32x4){0.f, 0.f, 0.f, 0.f}; }
#pragma unroll
              for (int i = 0; i < 4; ++i) { const int r = r0 + 16 * i; tl[r * 65 + c4 * 4] = v[i][0]; tl[r * 65 + c4 * 4 + 1] = v[i][1]; tl[r * 65 + c4 * 4 + 2] = v[i][2]; tl[r * 65 + c4 * 4 + 3] = v[i][3]; } }
            __syncthreads();
            {
#pragma unroll
              for (int i = 0; i < 2; ++i) { const int cc = t + 256 * i; const int n = cc >> 3, k8 = (cc & 7) * 8;
                  u32x4 pk; pk.x = pack2(tl[(k8 + 0) * 65 + n], tl[(k8 + 1) * 65 + n]); pk.y = pack2(tl[(k8 + 2) * 65 + n], tl[(k8 + 3) * 65 + n]);
                  pk.z = pack2(tl[(k8 + 4) * 65 + n], tl[(k8 + 5) * 65 + n]); pk.w = pack2(tl[(k8 + 6) * 65 + n], tl[(k8 + 7) * 65 + n]);
                  *(u32x4*)(dst + (size_t)(nt * 64 + n) * 1024 + kt * 64 + k8) = pk; } }
        } else if (it < N_TIN + N_TOUT + N_MOD) {
            const int i2 = it - N_TIN - N_TOUT; const int l = i2 / 192, jg = i2 % 192;
            const int jj = t & 15, ks = t >> 4; const int j = jg * 16 + jj;
            float a0 = 0.f, a1 = 0.f, a2 = 0.f, a3 = 0.f;
            const float* wm = p.w_mod + (size_t)l * 1024 * 3072 + j;
#pragma unroll 8
            for (int k = ks * 64; k < ks * 64 + 64; ++k) { float wv = __builtin_nontemporal_load(wm + (size_t)k * 3072); a0 += p.c[k] * wv; a1 += p.c[1024 + k] * wv; a2 += p.c[2048 + k] * wv; a3 += p.c[3072 + k] * wv; }
            __syncthreads();
            tl[(0 * 16 + ks) * 16 + jj] = a0; tl[(1 * 16 + ks) * 16 + jj] = a1; tl[(2 * 16 + ks) * 16 + jj] = a2; tl[(3 * 16 + ks) * 16 + jj] = a3;
            __syncthreads();
            if (t < 64) { const int b = t >> 4, j2 = t & 15; float s = 0.f;
#pragma unroll
              for (int k2 = 0; k2 < 16; ++k2) s += tl[(b * 16 + k2) * 16 + j2];
              mod[((size_t)l * NB + b) * 3072 + jg * 16 + j2] = s + p.b_mod[l * 3072 + jg * 16 + j2]; }
        } else if (it >= N_TIN + N_TOUT + N_MOD + N_ROPE) {
            const int e = (it - N_TIN - N_TOUT - N_MOD - N_ROPE) * 256 + t;
            const int in = e & 63, out = (e >> 6) & 63, g = (e >> 12) & 3, mat = (e >> 14) & 1, l = e >> 15;
            const float* src = mat ? p.lru_wx : p.lru_wa;
            ((bf16_t*)(p.ws + WS_LWT))[e] = f2bf(src[l * 16384 + g * 4096 + in * 64 + out]);
        } else {
            const int i2 = it - N_TIN - N_TOUT - N_MOD; const int e = i2 * 256 + t; const int tok = e >> 5, f = e & 31;
            const float inv = exp2f(-(float)f * (13.287712379549449f / 32.f));
            const float ang = (float)p.pos[tok] * inv;
            double rev = (double)ang * 0.15915494309189535; rev -= __builtin_rint(rev);
            const float rr = (float)rev; cosT[e] = __builtin_amdgcn_cosf(rr); sinT[e] = __builtin_amdgcn_sinf(rr);
        }
    }
}

__device__ void ln_phase(const Params& p, int l) {
    const int t = tid_opq(), lane = t & 63, w = t >> 6;
    bf16_t* ubuf = (bf16_t*)(p.ws + WS_U); const float* mod = (const float*)(p.ws + WS_MOD);
    for (int rg = blockIdx.x; rg < T / 16; rg += gridDim.x) {
        f32x4 v[4][4];
#pragma unroll
        for (int r = 0; r < 4; ++r) { const int row = rg * 16 + w * 4 + r; const float* src = (l <= 1) ? p.x + (size_t)row * 1024 : p.out + (size_t)row * 1024;
#pragma unroll
            for (int i = 0; i < 4; ++i) v[r][i] = __builtin_nontemporal_load((const f32x4*)(src + i * 256 + lane * 4));
            if (l > 0) {
                const bf16_t* yr = (const bf16_t*)(p.ws + WS_Z) + (size_t)row * 1024; const float* gate = mod + ((size_t)(l - 1) * NB + row / S) * 3072 + 2048;
#pragma unroll
                for (int i = 0; i < 4; ++i) { const u32x2 yv = __builtin_nontemporal_load((const u32x2*)(yr + i * 256 + lane * 4)); const f32x4 g1 = *(const f32x4*)(gate + i * 256 + lane * 4) + 1.f;
                    const f32x4 yf = {__uint_as_float(yv.x << 16), __uint_as_float(yv.x & 0xffff0000u), __uint_as_float(yv.y << 16), __uint_as_float(yv.y & 0xffff0000u)};
                    v[r][i] = v[r][i] * DN_ALPHA + g1 * yf; }
            } }
#pragma unroll
        for (int r = 0; r < 4; ++r) {
            const int row = rg * 16 + w * 4 + r; const int b = row / S;
            if (l > 0) {
                float s = 0.f;
#pragma unroll
                for (int i = 0; i < 4; ++i) s += (v[r][i][0] + v[r][i][1]) + (v[r][i][2] + v[r][i][3]);
                const float mu = wsum(s) * (1.f / 1024.f); float q = 0.f;
#pragma unroll
                for (int i = 0; i < 4; ++i) { f32x4 d = v[r][i] - mu; q += (d[0] * d[0] + d[1] * d[1]) + (d[2] * d[2] + d[3] * d[3]); }
                const float rstd = rsqrtf(wsum(q) * (1.f / 1024.f) + 1e-5f);
#pragma unroll
                for (int i = 0; i < 4; ++i) { const f32x4 g = *(const f32x4*)(p.ln_g + (l - 1) * 1024 + i * 256 + lane * 4), bb = *(const f32x4*)(p.ln_b + (l - 1) * 1024 + i * 256 + lane * 4);
                    v[r][i] = (v[r][i] - mu) * rstd * g + bb; __builtin_nontemporal_store(v[r][i], (f32x4*)(p.out + (size_t)row * 1024 + i * 256 + lane * 4)); }
            }
            if (l < DEPTH) {
                float s = 0.f;
#pragma unroll
                for (int i = 0; i < 4; ++i) s += (v[r][i][0] + v[r][i][1]) + (v[r][i][2] + v[r][i][3]);
                const float mu = wsum(s) * (1.f / 1024.f); float q = 0.f;
#pragma unroll
                for (int i = 0; i < 4; ++i) { f32x4 d = v[r][i] - mu; q += (d[0] * d[0] + d[1] * d[1]) + (d[2] * d[2] + d[3] * d[3]); }
                const float rstd = rsqrtf(wsum(q) * (1.f / 1024.f) + 1e-5f);
                const float* mb = mod + ((size_t)l * NB + b) * 3072;
#pragma unroll
                for (int i = 0; i < 4; ++i) { const int col = i * 256 + lane * 4; const f32x4 sh = *(const f32x4*)(mb + col), sc = *(const f32x4*)(mb + 1024 + col);
                    f32x4 u = (v[r][i] - mu) * rstd * (sc + 1.f) + sh; u32x2 pk; pk.x = pack2(u[0], u[1]); pk.y = pack2(u[2], u[3]);
                    *(u32x2*)(ubuf + (size_t)row * 1024 + col) = pk; }
            }
        }
    }
}

__device__ __forceinline__ int lds_off(int r, int c8) {
    const int st = (r >> 4) * 2 + (c8 >> 2); const int ob = (r & 15) * 64 + (c8 & 3) * 16;
    return st * 1024 + (ob ^ (((ob >> 9) & 1) << 5));
}
struct RegSet { u32x4 a[4], b[4]; };
__device__ __forceinline__ void gemm_tile(const bf16_t* __restrict__ A, const bf16_t* __restrict__ Bt, int tm, int tn, bool first, bool has_next, int ntm, int ntn,
                                          char* sm, f32x4 (&acc)[4][4], RegSet& r0, RegSet& r1) {
    const int t = tid_opq(), lane = t & 63, w = t >> 6, wm = w >> 1, wn = w & 1, r16 = lane & 15, quad = lane >> 4;
    const int lrow = t >> 3, lch = t & 7;
    constexpr int BUF = 32768;
    const unsigned loff = (unsigned)(lrow * 1024 + lch * 8);
    const bf16_t* At0 = A + (size_t)tm * (128 * 1024); const bf16_t* Bt0 = Bt + (size_t)tn * (128 * 1024);
    const bf16_t* At1 = A + (size_t)ntm * (128 * 1024); const bf16_t* Bt1 = Bt + (size_t)ntn * (128 * 1024);
#define Ag (At0 + loff)
#define Bg (Bt0 + loff)
#define nAg (At1 + loff)
#define nBg (Bt1 + loff)
    const int woff0 = lds_off(lrow, lch);
#define woff(i) (woff0 + 4096 * (i))
    const int fo = lds_off(r16, quad);
#pragma unroll
    for (int a = 0; a < 4; ++a)
#pragma unroll
        for (int b = 0; b < 4; ++b) acc[a][b] = (f32x4){0.f, 0.f, 0.f, 0.f};
    if (first) {
#pragma unroll
        for (int i = 0; i < 4; ++i) { r0.a[i] = *(const u32x4*)(Ag + (size_t)i * 32 * 1024); r0.b[i] = *(const u32x4*)(Bg + (size_t)i * 32 * 1024); }
#pragma unroll
        for (int i = 0; i < 4; ++i) { r1.a[i] = *(const u32x4*)(Ag + (size_t)i * 32 * 1024 + 64); r1.b[i] = *(const u32x4*)(Bg + (size_t)i * 32 * 1024 + 64); }
        __syncthreads();
#pragma unroll
        for (int i = 0; i < 4; ++i) { *(u32x4*)(sm + woff(i)) = r0.a[i]; *(u32x4*)(sm + 16384 + woff(i)) = r0.b[i]; }
#pragma unroll
        for (int i = 0; i < 4; ++i) { r0.a[i] = *(const u32x4*)(Ag + (size_t)i * 32 * 1024 + 128); r0.b[i] = *(const u32x4*)(Bg + (size_t)i * 32 * 1024 + 128); }
    }
    __syncthreads();
    auto step = [&](auto main_tag, int kt, RegSet& rs) {
        constexpr bool MAIN = decltype(main_tag)::value;
        const char* sA = sm + (kt & 1) * BUF; const char* sB = sA + 16384;
        char* nA = sm + ((kt + 1) & 1) * BUF; char* nB = nA + 16384;
        const bool wr = MAIN || kt + 1 < 16 || has_next;
        const bool own = MAIN || kt + 3 < 16;
        const bf16_t* la = own ? Ag + (kt + 3) * 64 : nAg + (kt - 13) * 64; const bf16_t* lb = own ? Bg + (kt + 3) * 64 : nBg + (kt - 13) * 64;
        __builtin_amdgcn_s_setprio(1);
#pragma unroll
        for (int ks = 0; ks < 2; ++ks) {
            bf16x8 af[4], bfr[4];
#pragma unroll
            for (int mt = 0; mt < 4; ++mt) af[mt] = *(const bf16x8*)(sA + ((wm * 4 + mt) * 2 + ks) * 1024 + fo);
#pragma unroll
            for (int nt = 0; nt < 4; ++nt) bfr[nt] = *(const bf16x8*)(sB + ((wn * 4 + nt) * 2 + ks) * 1024 + fo);
#pragma unroll
            for (int mt = 0; mt < 4; ++mt) {
#pragma unroll
                for (int nt = 0; nt < 4; ++nt) acc[mt][nt] = __builtin_amdgcn_mfma_f32_16x16x32_bf16(bfr[nt], af[mt], acc[mt][nt], 0, 0, 0);
                const int i = ks * 2 + (mt >> 1);
                __builtin_amdgcn_sched_barrier(0);
                if ((mt & 1) == 0) { if (wr) *(u32x4*)(nA + woff(i)) = rs.a[i]; if (own || has_next) rs.a[i] = *(const u32x4*)(la + (size_t)i * 32 * 1024); }
                else               { if (wr) *(u32x4*)(nB + woff(i)) = rs.b[i]; if (own || has_next) rs.b[i] = *(const u32x4*)(lb + (size_t)i * 32 * 1024); }
                __builtin_amdgcn_sched_barrier(0);
            }
        }
        __builtin_amdgcn_s_setprio(0);
        __syncthreads();
    };
    {
        std::true_type mt_; std::false_type tl_;
        for (int k2 = 0; k2 < 6; ++k2) { step(mt_, 2 * k2, r1); step(mt_, 2 * k2 + 1, r0); }
        step(mt_, 12, r1); step(tl_, 13, r0); step(tl_, 14, r1); step(tl_, 15, r0);
    }
#undef Ag
#undef Bg
#undef nAg
#undef nBg
#undef woff
}

__device__ void g1_phase(const Params& p, int l, char* smem) {
    const int t = tid_opq(), lane = t & 63, w = t >> 6, wm = w >> 1, wn = w & 1, r16 = lane & 15, quad = lane >> 4;
    char* sm = smem; char* sC = smem + 32768;
    const bf16_t* ubuf = (const bf16_t*)(p.ws + WS_U); const bf16_t* WinT = (const bf16_t*)(p.ws + WS_WINT) + (size_t)l * NPAD * 1024;
    bf16_t* z = (bf16_t*)(p.ws + WS_Z); float* kpart = (float*)(p.ws + WS_KPART);
    const float* cosT = (const float*)(p.ws + WS_COS); const float* sinT = (const float*)(p.ws + WS_SIN);
    const bool xo = (gridDim.x & 7) == 0; const int xcd = blockIdx.x & 7, nloc = xo ? (int)(gridDim.x >> 3) : (int)gridDim.x, j0 = xo ? (int)(blockIdx.x >> 3) : (int)blockIdx.x;
    const int lim = xo ? 16 * 27 : 128 * 27;
    RegSet r0, r1;
    for (int L = j0; L < lim; L += nloc) {
        const int tm = xo ? xcd * 16 + (L / 216) * 8 + (L & 7) : L / 27, tn = xo ? ((L % 216) >> 3) : L % 27;
        const int L2 = L + nloc; const bool has_next = L2 < lim;
        const int ntm = has_next ? (xo ? xcd * 16 + (L2 / 216) * 8 + (L2 & 7) : L2 / 27) : tm, ntn = has_next ? (xo ? ((L2 % 216) >> 3) : L2 % 27) : tn;
        f32x4 acc[4][4];
        gemm_tile(ubuf, WinT, tm, tn, L == j0, has_next, ntm, ntn, sm, acc, r0, r1);
        const bool rope = (tn < 4) || (tn >= 12 && tn < 16);
        if (rope) {
#pragma unroll
            for (int mt = 0; mt < 4; ++mt) {
                const int tok = tm * 128 + wm * 64 + mt * 16 + r16;
#pragma unroll
                for (int nt = 0; nt < 2; ++nt) {
                    const f32x4 cs = *(const f32x4*)(cosT + (size_t)tok * 32 + nt * 16 + quad * 4), sn = *(const f32x4*)(sinT + (size_t)tok * 32 + nt * 16 + quad * 4);
                    const f32x4 x1 = acc[mt][nt], x2 = acc[mt][nt + 2];
                    acc[mt][nt] = x1 * cs - x2 * sn; acc[mt][nt + 2] = x1 * sn + x2 * cs;
                }
            }
        }
        if (tn == 2 || tn == 3) {
#pragma unroll
            for (int nt = 0; nt < 4; ++nt) {
                f32x4 sv = (acc[0][nt] + acc[1][nt]) + (acc[2][nt] + acc[3][nt]);
#pragma unroll
                for (int jj = 0; jj < 4; ++jj) { sv[jj] = row16_sum(sv[jj]); }
                if (r16 == 0) *(f32x4*)(kpart + (size_t)(tm * 2 + wm) * 256 + (tn - 2) * 128 + wn * 64 + nt * 16 + quad * 4) = sv;
            }
        }
#pragma unroll
        for (int mt = 0; mt < 4; ++mt)
#pragma unroll
            for (int nt = 0; nt < 4; ++nt) { u32x2 pk; pk.x = pack2(acc[mt][nt][0], acc[mt][nt][1]); pk.y = pack2(acc[mt][nt][2], acc[mt][nt][3]);
                const int row = wm * 64 + mt * 16 + r16; const int c16 = wn * 8 + nt * 2 + (quad >> 1);
                *(u32x2*)(sC + row * 256 + ((c16 ^ (row & 15)) << 4) + (quad & 1) * 8) = pk; }
        __syncthreads();
#pragma unroll
        for (int i = 0; i < 8; ++i) { const int c = t + 256 * i; const int row = c >> 4, ch = c & 15; const int col = tn * 128 + ch * 8;
            if (col < DIN) *(u32x4*)(z + (size_t)(tm * 128 + row) * ZP + col) = *(const u32x4*)(sC + row * 256 + ((ch ^ (row & 15)) << 4)); }
    }
}

__device__ void g2_phase(const Params& p, int l, char* smem) {
    const int t = tid_opq(), lane = t & 63, w = t >> 6, wm = w >> 1, wn = w & 1, r16 = lane & 15, quad = lane >> 4;
    char* sm = smem; char* sC = smem + 32768;
    const bf16_t* mix = (const bf16_t*)(p.ws + WS_U); const bf16_t* WoutT = (const bf16_t*)(p.ws + WS_WOUTT) + (size_t)l * 1024 * 1024;
    bf16_t* ybuf = (bf16_t*)(p.ws + WS_Z);
    const bool xo = (gridDim.x & 7) == 0; const int xcd = blockIdx.x & 7, nloc = xo ? (int)(gridDim.x >> 3) : (int)gridDim.x, j0 = xo ? (int)(blockIdx.x >> 3) : (int)blockIdx.x;
    const int lim = xo ? 16 * 8 : 128 * 8;
    RegSet r0, r1;
    for (int L = j0; L < lim; L += nloc) {
        const int tm = xo ? xcd * 16 + (L & 15) : (L >> 3), tn = xo ? (L >> 4) : (L & 7);
        const int L2 = L + nloc; const bool has_next = L2 < lim;
        const int ntm = has_next ? (xo ? xcd * 16 + (L2 & 15) : (L2 >> 3)) : tm, ntn = has_next ? (xo ? (L2 >> 4) : (L2 & 7)) : tn;
        f32x4 acc[4][4];
        gemm_tile(mix, WoutT, tm, tn, L == j0, has_next, ntm, ntn, sm, acc, r0, r1);
#pragma unroll
        for (int mt = 0; mt < 4; ++mt)
#pragma unroll
            for (int nt = 0; nt < 4; ++nt) { u32x2 pk; pk.x = pack2(acc[mt][nt][0], acc[mt][nt][1]); pk.y = pack2(acc[mt][nt][2], acc[mt][nt][3]);
                const int row = wm * 64 + mt * 16 + r16; const int c16 = wn * 8 + nt * 2 + (quad >> 1);
                *(u32x2*)(sC + row * 256 + ((c16 ^ (row & 15)) << 4) + (quad & 1) * 8) = pk; }
        __syncthreads();
#pragma unroll
        for (int i = 0; i < 8; ++i) { const int c = t + 256 * i; const int row = c >> 4, ch = c & 15;
            *(u32x4*)(ybuf + (size_t)(tm * 128 + row) * 1024 + tn * 128 + ch * 8) = *(const u32x4*)(sC + row * 256 + ((ch ^ (row & 15)) << 4)); }
    }
}

constexpr float ATT_SC = 0.18033688011112042f;
template <int QT>
__device__ __forceinline__ void attn_tile(const bf16_t* sK, const bf16_t* sV, const bf16x8 (&qf)[QT][2], int lo, int hi, bool full, bool hasq, bool qfl0, bool qfl1,
                                          float (&m)[QT], float (&l)[QT], f32x4 (&O)[QT][4], int wq0) {
    const int lane = tid_opq() & 63, r16 = lane & 15, quad = lane >> 4;
    f32x4 s[QT][4];
#pragma unroll
    for (int a = 0; a < QT; ++a)
#pragma unroll
        for (int b = 0; b < 4; ++b) s[a][b] = (f32x4){0.f, 0.f, 0.f, 0.f};
#pragma unroll
    for (int ks = 0; ks < 2; ++ks)
#pragma unroll
        for (int k16 = 0; k16 < 4; ++k16) {
            const bf16x8 kf = *(const bf16x8*)(sK + (k16 * 16 + r16) * LDP + ks * 32 + quad * 8);
#pragma unroll
            for (int qt = 0; qt < QT; ++qt) s[qt][k16] = __builtin_amdgcn_mfma_f32_16x16x32_bf16(kf, qf[qt][ks], s[qt][k16], 0, 0, 0);
        }
#pragma unroll
    for (int qt = 0; qt < QT; ++qt) {
        const int ql = wq0 + qt * 16 + r16; const bool qfl = qt ? qfl1 : qfl0;
        if (!full) {
#pragma unroll
            for (int k16 = 0; k16 < 4; ++k16)
#pragma unroll
                for (int j = 0; j < 4; ++j) { const int dd = ql - (k16 * 16 + quad * 4 + j); const bool valid = dd >= lo && dd <= hi; s[qt][k16][j] = valid ? s[qt][k16][j] : -1e30f; }
        }
        if (hasq) {
#pragma unroll
            for (int k16 = 0; k16 < 4; ++k16)
#pragma unroll
                for (int j = 0; j < 4; ++j) s[qt][k16][j] = qfl ? s[qt][k16][j] : -1e30f;
        }
        float mx = -1e30f;
#pragma unroll
        for (int k16 = 0; k16 < 4; ++k16) mx = fmaxf(mx, fmaxf(fmaxf(s[qt][k16][0], s[qt][k16][1]), fmaxf(s[qt][k16][2], s[qt][k16][3])));
        mx = x32_max(x16_max(mx));
        const float mn = fmaxf(m[qt], mx); const float alpha = __builtin_amdgcn_exp2f((m[qt] - mn) * ATT_SC); m[qt] = mn;
        const float mb = (mn < -1e29f) ? 0.f : mn * ATT_SC;
        float ps = 0.f;
#pragma unroll
        for (int k16 = 0; k16 < 4; ++k16)
#pragma unroll
            for (int j = 0; j < 4; ++j) { const float pv = __builtin_amdgcn_exp2f(s[qt][k16][j] * ATT_SC - mb); ps += pv; s[qt][k16][j] = pv; }
        l[qt] = l[qt] * alpha + ps;
#pragma unroll
        for (int dt = 0; dt < 4; ++dt) O[qt][dt] = O[qt][dt] * alpha;
    }
#pragma unroll
    for (int G = 0; G < 2; ++G) {
        bf16x8 pf[QT];
#pragma unroll
        for (int qt = 0; qt < QT; ++qt) {
            const unsigned a0 = pack2(s[qt][G * 2][0], s[qt][G * 2][1]), a1 = pack2(s[qt][G * 2][2], s[qt][G * 2][3]);
            const unsigned a2 = pack2(s[qt][G * 2 + 1][0], s[qt][G * 2 + 1][1]), a3 = pack2(s[qt][G * 2 + 1][2], s[qt][G * 2 + 1][3]);
            u32x4 pk = {a0, a1, a2, a3}; pf[qt] = __builtin_bit_cast(bf16x8, pk);
        }
#pragma unroll
        for (int dt = 0; dt < 4; ++dt) {
            const bf16_t* v0p = sV + (G * 32 + quad * 4 + (r16 >> 2)) * LDP + dt * 16 + (r16 & 3) * 4;
            const bf16x4 v0 = __builtin_amdgcn_ds_read_tr16_b64_v4i16((__attribute__((address_space(3))) bf16x4*)(v0p));
            const bf16x4 v1 = __builtin_amdgcn_ds_read_tr16_b64_v4i16((__attribute__((address_space(3))) bf16x4*)(v0p + 16 * LDP));
            const bf16x8 vf = {v0[0], v0[1], v0[2], v0[3], v1[0], v1[1], v1[2], v1[3]};
#pragma unroll
            for (int qt = 0; qt < QT; ++qt) O[qt][dt] = __builtin_amdgcn_mfma_f32_16x16x32_bf16(vf, pf[qt], O[qt][dt], 0, 0, 0);
        }
    }
}

__device__ void attn_item(const Params& p, int kind, int idx, char* smem) {
    const int t = tid_opq(), lane = t & 63, w = t >> 6, r16 = lane & 15, quad = lane >> 4;
    bf16_t* sK = (bf16_t*)smem; bf16_t* sV = sK + 128 * LDP;
    const bf16_t* z = (const bf16_t*)(p.ws + WS_Z);
    (void)kind;
    const int cfg = idx >> 9; const int rem = idx & 511; const int b = rem >> 7, h = (rem >> 5) & 3; const int rb = rem & 31;
    const int dil = 1 << (2 * cfg); const int res = rb & (dil - 1), blk = rb >> (2 * cfg);
    const int qbase = b * S + blk * 128 * dil + res, stride = dil, qcol = C_CQ + h * 64, kcol = C_CK + h * 64, vcol = C_CV + h * 64;
    const int ss0 = (blk == 0) ? 1 : 0;
    bf16x8 qf[2][2];
#pragma unroll
    for (int qt = 0; qt < 2; ++qt)
#pragma unroll
        for (int ks = 0; ks < 2; ++ks) qf[qt][ks] = *(const bf16x8*)(z + (size_t)(qbase + (w * 32 + qt * 16 + r16) * stride) * ZP + qcol + ks * 32 + quad * 8);
    float m[2] = {-1e30f, -1e30f}, l[2] = {0.f, 0.f}; f32x4 O[2][4];
#pragma unroll
    for (int a = 0; a < 2; ++a)
#pragma unroll
        for (int c = 0; c < 4; ++c) O[a][c] = (f32x4){0.f, 0.f, 0.f, 0.f};
    const int lrow = t >> 1, lch = (t & 1) * 4;
    u32x4 rk[4], rv[4];
    { const bf16_t* rp = z + (size_t)(b * S + ((blk * 128 - 128 + ss0 * 128 + lrow) * dil + res)) * ZP + lch * 8;
#pragma unroll
      for (int c = 0; c < 4; ++c) { rk[c] = *(const u32x4*)(rp + kcol + c * 8); rv[c] = *(const u32x4*)(rp + vcol + c * 8); } }
    for (int ss = ss0; ss < 2; ++ss) {
        __syncthreads();
#pragma unroll
        for (int c = 0; c < 4; ++c) { *(u32x4*)(sK + lrow * LDP + (lch + c) * 8) = rk[c]; *(u32x4*)(sV + lrow * LDP + (lch + c) * 8) = rv[c]; }
        __syncthreads();
        if (ss + 1 < 2) { const bf16_t* rp = z + (size_t)(b * S + ((blk * 128 + lrow) * dil + res)) * ZP + lch * 8;
#pragma unroll
            for (int c = 0; c < 4; ++c) { rk[c] = *(const u32x4*)(rp + kcol + c * 8); rv[c] = *(const u32x4*)(rp + vcol + c * 8); } }
#pragma unroll
        for (int hf = 0; hf < 2; ++hf) {
            const int kt = ss * 2 + hf; const int lo = kt * 64 - 128, hi = kt * 64;
            const bool need = (w * 32 + 31 >= lo) && (w * 32 - 63 <= hi);
            const bool full = (w * 32 - 63 >= lo) && (w * 32 + 31 <= hi);
            if (need) attn_tile<2>(sK + hf * 64 * LDP, sV + hf * 64 * LDP, qf, lo, hi, full, false, true, true, m, l, O, w * 32);
        }
    }
    bf16_t* dilo = (bf16_t*)(p.ws + WS_DILO); float* dill = (float*)(p.ws + WS_DILL);
#pragma unroll
    for (int qt = 0; qt < 2; ++qt) {
        float lt = l[qt]; lt = x32_sum(x16_sum(lt));
        const float inv = 1.f / lt; const size_t tok = (size_t)(qbase + (w * 32 + qt * 16 + r16) * stride);
#pragma unroll
        for (int dt = 0; dt < 4; ++dt) { const int d0 = dt * 16 + quad * 4; u32x2 o; o.x = pack2(O[qt][dt][0] * inv, O[qt][dt][1] * inv); o.y = pack2(O[qt][dt][2] * inv, O[qt][dt][3] * inv);
            *(u32x2*)(dilo + ((size_t)cfg * T + tok) * 256 + h * 64 + d0) = o; }
        if (quad == 0) dill[((size_t)cfg * T + tok) * 4 + h] = m[qt] * 0.125f + __logf(lt);
    }
}

__device__ void moba_item(const Params& p, int idx, char* smem, bf16_t* outp) {
    const int t = tid_opq(), lane = t & 63, w = t >> 6, r16 = lane & 15, quad = lane >> 4;
    bf16_t* sK = (bf16_t*)smem; bf16_t* sV = sK + 64 * LDP;
    float* stO = (float*)(smem + 18432);
    float* kmean = (float*)(smem + 18432); float* gates = (float*)(smem + 22528);
    float* stM = (float*)(smem + 53248); float* stL = (float*)(smem + 53760);
    unsigned* selm = (unsigned*)(smem + 54272); unsigned char* lists = (unsigned char*)(smem + 54784);
    int* cnt = (int*)(smem + 56832); int4* desc = (int4*)(smem + 56960); int* misc = (int*)(smem + 59008);
    const bf16_t* z = (const bf16_t*)(p.ws + WS_Z);
    const int n = 15 - (idx >> 5); const int rem = idx & 31; const int b = rem >> 3, h = (rem >> 1) & 3, qh = rem & 1;
    const int qbase = b * S + n * 256 + qh * 128, qcol = C_AQ + h * 64, kcol = C_AK + h * 64, vcol = C_AV + h * 64;
    __syncthreads();
    {
        const float* kpart = (const float*)(p.ws + WS_KPART);
        for (int e = t; e < n * 64; e += 256) { const int j = e >> 6, d = e & 63; const float* kp = kpart + (size_t)(b * 64 + j * 4) * 256 + h * 64 + d;
            kmean[e] = ((kp[0] + kp[256]) + (kp[512] + kp[768])) * (1.f / 256.f); }
        if (t < 16) cnt[t] = 0;
        __syncthreads();
        {
            const int ql = t >> 1, half = t & 1; const bf16_t* qp = z + (size_t)(qbase + ql) * ZP + qcol;
            float g[8];
#pragma unroll
            for (int jj = 0; jj < 8; ++jj) g[jj] = 0.f;
#pragma unroll 1
            for (int dc = 0; dc < 8; ++dc) {
                const u32x4 qv = *(const u32x4*)(qp + dc * 8); float qq[8];
#pragma unroll
                for (int e = 0; e < 4; ++e) { qq[2 * e] = __uint_as_float(qv[e] << 16); qq[2 * e + 1] = __uint_as_float(qv[e] & 0xffff0000u); }
#pragma unroll
                for (int jj = 0; jj < 8; ++jj) { const int j = half + 2 * jj; if (j < n) { const float* km = kmean + j * 64 + dc * 8;
#pragma unroll
                    for (int e = 0; e < 8; ++e) g[jj] += qq[e] * km[e]; } }
            }
#pragma unroll
            for (int jj = 0; jj < 8; ++jj) gates[ql * 16 + half + 2 * jj] = g[jj];
        }
        __syncthreads();
        if (t < 128) {
            unsigned msk = 0;
            for (int k = 0; k < 3 && k < n; ++k) { float best = -3.0e38f; int bi = -1;
                for (int j = 0; j < n; ++j) if (!((msk >> j) & 1u)) { const float gv = gates[t * 16 + j]; if (gv > best) { best = gv; bi = j; } }
                if (bi >= 0) msk |= 1u << bi; }
            selm[t] = msk;
            for (int j = 0; j < n; ++j) if ((msk >> j) & 1u) { const int pos = atomicAdd(&cnt[j], 1); lists[j * 128 + pos] = (unsigned char)t; }
        }
        __syncthreads();
        if (t < 128) { for (int j = 0; j < n; ++j) { const int cj = cnt[j]; if (t >= cj && t < ((cj + 15) & ~15)) lists[j * 128 + t] = 255; } }
        {
            const int nown_ = qh * 2 + 2;
            if (t < nown_) desc[t] = make_int4(b * S + n * 256 + t * 64, t * 64 - qh * 128, BIG, -1);
            if (t < 16) {
                int base = nown_; for (int j2 = 0; j2 < t && j2 < n; ++j2) base += ((((cnt[j2] + 15) >> 4) + 3) >> 2) * 4;
                if (t < n) { const int npass = ((((cnt[t] + 15) >> 4) + 3) >> 2);
                    for (int ps = 0; ps < npass; ++ps) for (int kt = 0; kt < 4; ++kt) desc[base + ps * 4 + kt] = make_int4(b * S + t * 256 + kt * 64, ps, kt, t); }
                if (t == 15) { misc[0] = base + ((15 < n) ? ((((cnt[15] + 15) >> 4) + 3) >> 2) * 4 : 0); misc[1] = nown_; }
            }
        }
    }
    __syncthreads();
    const int nd = misc[0], nown = misc[1];
    const int lrow = t >> 2, lch = (t & 3) * 2;
    u32x4 rk0, rk1, rv0, rv1;
    { const int4 d = desc[0]; const bf16_t* rp = z + (size_t)(d.x + lrow) * ZP + lch * 8;
      rk0 = *(const u32x4*)(rp + kcol); rk1 = *(const u32x4*)(rp + kcol + 8); rv0 = *(const u32x4*)(rp + vcol); rv1 = *(const u32x4*)(rp + vcol + 8); }
    bf16x8 nqf[2]; int ngq = 0; bool ngv = false, nhas = false;
    auto prefetch_group = [&](int gi) {
        nhas = false;
        if (gi < nd) { const int4 dg = desc[gi]; const int slot = dg.y * 4 + w; nhas = slot * 16 < cnt[dg.w];
            if (nhas) { const int qi = lists[dg.w * 128 + slot * 16 + r16]; ngv = qi != 255; ngq = ngv ? qi : 0;
#pragma unroll
                for (int ks = 0; ks < 2; ++ks) nqf[ks] = *(const bf16x8*)(z + (size_t)(qbase + ngq) * ZP + qcol + ks * 32 + quad * 8); } }
    };
    prefetch_group(nown);
    {
        bf16x8 qf[2][2];
#pragma unroll
        for (int qt = 0; qt < 2; ++qt)
#pragma unroll
            for (int ks = 0; ks < 2; ++ks) qf[qt][ks] = *(const bf16x8*)(z + (size_t)(qbase + w * 32 + qt * 16 + r16) * ZP + qcol + ks * 32 + quad * 8);
        float m[2] = {-1e30f, -1e30f}, l[2] = {0.f, 0.f}; f32x4 O[2][4];
#pragma unroll
        for (int a = 0; a < 2; ++a)
#pragma unroll
            for (int c = 0; c < 4; ++c) O[a][c] = (f32x4){0.f, 0.f, 0.f, 0.f};
        for (int i = 0; i < nown; ++i) {
            __syncthreads();
            *(u32x4*)(sK + lrow * LDP + lch * 8) = rk0; *(u32x4*)(sK + lrow * LDP + lch * 8 + 8) = rk1;
            *(u32x4*)(sV + lrow * LDP + lch * 8) = rv0; *(u32x4*)(sV + lrow * LDP + lch * 8 + 8) = rv1;
            __syncthreads();
            if (i + 1 < nd) { const int4 d = desc[i + 1]; const bf16_t* rp = z + (size_t)(d.x + lrow) * ZP + lch * 8;
                rk0 = *(const u32x4*)(rp + kcol); rk1 = *(const u32x4*)(rp + kcol + 8); rv0 = *(const u32x4*)(rp + vcol); rv1 = *(const u32x4*)(rp + vcol + 8); }
            const int4 d = desc[i];
            const bool need = (w * 32 + 31 >= d.y) && (w * 32 - 63 <= d.z);
            const bool full = (w * 32 - 63 >= d.y) && (w * 32 + 31 <= d.z);
            if (need) attn_tile<2>(sK, sV, qf, d.y, d.z, full, false, true, true, m, l, O, w * 32);
        }
#pragma unroll
        for (int qt = 0; qt < 2; ++qt) {
            float lt = l[qt]; lt = x32_sum(x16_sum(lt));
            const int ql = w * 32 + qt * 16 + r16;
            if (quad == 0) { stM[ql] = m[qt]; stL[ql] = lt; }
#pragma unroll
            for (int dt = 0; dt < 4; ++dt) *(f32x4*)(stO + ql * 68 + dt * 16 + quad * 4) = O[qt][dt];
        }
    }
    {
        bf16x8 qf[1][2]; float m[1] = {-1e30f}, l[1] = {0.f}; f32x4 O[1][4];
        int gq = 0; bool gv = false, has = false;
        for (int i = nown; i < nd; ++i) {
            __syncthreads();
            *(u32x4*)(sK + lrow * LDP + lch * 8) = rk0; *(u32x4*)(sK + lrow * LDP + lch * 8 + 8) = rk1;
            *(u32x4*)(sV + lrow * LDP + lch * 8) = rv0; *(u32x4*)(sV + lrow * LDP + lch * 8 + 8) = rv1;
            __syncthreads();
            if (i + 1 < nd) { const int4 d = desc[i + 1]; const bf16_t* rp = z + (size_t)(d.x + lrow) * ZP + lch * 8;
                rk0 = *(const u32x4*)(rp + kcol); rk1 = *(const u32x4*)(rp + kcol + 8); rv0 = *(const u32x4*)(rp + vcol); rv1 = *(const u32x4*)(rp + vcol + 8); }
            const int4 d = desc[i];
            if (d.z == 0) {
                has = nhas; gv = ngv; gq = ngq; qf[0][0] = nqf[0]; qf[0][1] = nqf[1];
                m[0] = -1e30f; l[0] = 0.f;
#pragma unroll
                for (int c = 0; c < 4; ++c) O[0][c] = (f32x4){0.f, 0.f, 0.f, 0.f};
                prefetch_group(i + 4);
            }
            if (has) {
                attn_tile<1>(sK, sV, qf, -BIG, BIG, true, false, true, true, m, l, O, 0);
                if (d.z == 3) {
                    float lt = l[0]; lt = x32_sum(x16_sum(lt));
                    if (gv) {
                        const float mo = stM[gq], lo_ = stL[gq]; const float mn = fmaxf(mo, m[0]);
                        const float fa = __builtin_amdgcn_exp2f((mo - mn) * ATT_SC), fb = __builtin_amdgcn_exp2f((m[0] - mn) * ATT_SC);
#pragma unroll
                        for (int dt = 0; dt < 4; ++dt) { float* sp = stO + gq * 68 + dt * 16 + quad * 4; const f32x4 so = *(const f32x4*)sp; *(f32x4*)sp = so * fa + O[0][dt] * fb; }
                        if (quad == 0) { stM[gq] = mn; stL[gq] = lo_ * fa + lt * fb; }
                    }
                }
            }
        }
    }
    __syncthreads();
#pragma unroll
    for (int qt = 0; qt < 2; ++qt) {
        const int ql = w * 32 + qt * 16 + r16; const float inv = 1.f / stL[ql]; const size_t tok = (size_t)(qbase + ql);
#pragma unroll
        for (int dt = 0; dt < 4; ++dt) { const int d0 = dt * 16 + quad * 4; const f32x4 ov = *(const f32x4*)(stO + ql * 68 + d0);
            const u32x2 gvv = *(const u32x2*)(z + tok * ZP + C_AG + h * 64 + d0);
            const float g0 = __uint_as_float(gvv.x << 16), g1 = __uint_as_float(gvv.x & 0xffff0000u), g2 = __uint_as_float(gvv.y << 16), g3 = __uint_as_float(gvv.y & 0xffff0000u);
            u32x2 o; o.x = pack2(ov[0] * inv * silu_f(g0), ov[1] * inv * silu_f(g1)); o.y = pack2(ov[2] * inv * silu_f(g2), ov[3] * inv * silu_f(g3));
            *(u32x2*)(outp + tok * 1024 + h * 64 + d0) = o; }
    }
}

__device__ __forceinline__ void gla_bcum(const Params& p, int l, const bf16_t* z, int tok0, float* bc, float* drs) {
    const int t = tid_opq();
    const int hd = t & 127, ih = t >> 7;
    float wr[16];
#pragma unroll
    for (int r = 0; r < 16; ++r) wr[r] = p.gla_wr[l * 2048 + r * 128 + hd];
    const float br = p.gla_br[l * 128 + hd];
    { const int e0 = t, e1 = t + 256; const bf16_t d0 = z[(size_t)(tok0 + (e0 >> 4)) * ZP + C_DR + (e0 & 15)], d1 = z[(size_t)(tok0 + (e1 >> 4)) * ZP + C_DR + (e1 & 15)];
      drs[e0] = bf2f(d0); drs[e1] = bf2f(d1); }
    __syncthreads();
#pragma unroll
    for (int ii = 0; ii < 16; ++ii) { const int i = ih * 16 + ii; float x = br;
#pragma unroll
        for (int r4 = 0; r4 < 4; ++r4) { const f32x4 dv = *(const f32x4*)(drs + i * 16 + r4 * 4); x += (dv[0] * wr[r4 * 4] + dv[1] * wr[r4 * 4 + 1]) + (dv[2] * wr[r4 * 4 + 2] + dv[3] * wr[r4 * 4 + 3]); }
        bc[i * 128 + hd] = (fminf(x, 0.f) - __logf(1.f + __expf(-fabsf(x)))) * (1.f / 16.f); }
    __syncthreads();
    if (t < 128) { float sacc = 0.f;
#pragma unroll
        for (int i = 0; i < 32; ++i) { sacc += bc[i * 128 + t]; bc[i * 128 + t] = sacc; } }
    __syncthreads();
}

__device__ void gla1_item(const Params& p, int l, int idx, char* smem) {
    const int t = tid_opq(), lane = t & 63, w = t >> 6, r16 = lane & 15, quad = lane >> 4;
    const int b = idx >> 7, c = idx & 127; const int tok0 = b * S + c * 32;
    const bf16_t* z = (const bf16_t*)(p.ws + WS_Z);
    float* bc = (float*)smem; float* drs = (float*)(smem + 16384);
    bf16_t* kdT = (bf16_t*)(smem + 18432) + w * 1024;
    bf16_t* vL = (bf16_t*)(smem + 26624) + w * (32 * LDP);
    float* gkv = (float*)(p.ws + WS_GKV); float* gdec = (float*)(p.ws + WS_GDEC);
    bf16_t kraw[16]; u32x4 vr[4];
#pragma unroll
    for (int i = 0; i < 16; ++i) { const int e = lane + 64 * i; kraw[i] = z[(size_t)(tok0 + (e >> 5)) * ZP + C_DK + w * 32 + (e & 31)]; }
#pragma unroll
    for (int i = 0; i < 4; ++i) { const int cc = lane + 64 * i; vr[i] = *(const u32x4*)(z + (size_t)(tok0 + (cc >> 3)) * ZP + C_DV + w * 64 + (cc & 7) * 8); }
    __syncthreads();
#pragma unroll
    for (int i = 0; i < 4; ++i) { const int cc = lane + 64 * i; *(u32x4*)(vL + (cc >> 3) * LDP + (cc & 7) * 8) = vr[i]; }
    gla_bcum(p, l, z, tok0, bc, drs);
    { float* bcg = (float*)(p.ws + WS_BC) + (size_t)idx * 4096;
#pragma unroll
      for (int i = 0; i < 4; ++i) *(f32x4*)(bcg + (t + 256 * i) * 4) = *(const f32x4*)(bc + (t + 256 * i) * 4); }
#pragma unroll
    for (int i = 0; i < 16; ++i) { const int e = lane + 64 * i; const int j = e >> 5, d = e & 31;
        kdT[d * 32 + j] = f2bf(bf2f(kraw[i]) * __expf(bc[31 * 128 + w * 32 + d] - bc[j * 128 + w * 32 + d])); }
    const int bh = b * 4 + w;
    if (lane < 32) gdec[(bh * 128 + c) * 32 + lane] = __expf(bc[31 * 128 + w * 32 + lane]);
    __syncthreads();
    bf16x8 kf[2];
#pragma unroll
    for (int x = 0; x < 2; ++x) kf[x] = *(const bf16x8*)(kdT + (x * 16 + r16) * 32 + quad * 8);
    float* dst = gkv + (size_t)(bh * 128 + c) * 2048;
#pragma unroll
    for (int dt = 0; dt < 4; ++dt) {
        const bf16_t* v0p = vL + (quad * 8 + (r16 >> 2)) * LDP + dt * 16 + (r16 & 3) * 4;
        const bf16x4 v0 = __builtin_amdgcn_ds_read_tr16_b64_v4i16((__attribute__((address_space(3))) bf16x4*)(v0p));
        const bf16x4 v1 = __builtin_amdgcn_ds_read_tr16_b64_v4i16((__attribute__((address_space(3))) bf16x4*)(v0p + 4 * LDP));
        const bf16x8 vf = {v0[0], v0[1], v0[2], v0[3], v1[0], v1[1], v1[2], v1[3]};
#pragma unroll
        for (int x = 0; x < 2; ++x) {
            const f32x4 r = __builtin_amdgcn_mfma_f32_16x16x32_bf16(vf, kf[x], (f32x4){0.f, 0.f, 0.f, 0.f}, 0, 0, 0);
            *(f32x4*)(dst + (x * 16 + r16) * 64 + dt * 16 + quad * 4) = r;
        }
    }
}

#define OPQ(ptr) asm volatile("" : "+v"(ptr))
__device__ void gla3_item(const Params& p, int l, int idx, char* smem) {
    const int t = tid_opq(), lane = t & 63, w = t >> 6, r16 = lane & 15, quad = lane >> 4;
    const int b = idx >> 7, c = idx & 127; const int tok0 = b * S + c * 32;
    const bf16_t* z = (const bf16_t*)(p.ws + WS_Z); bf16_t* mix = (bf16_t*)(p.ws + WS_U);
    float* bc = (float*)smem; float* drs = (float*)(smem + 16384);
    bf16_t* SL = (bf16_t*)smem + w * (32 * LDP);
    bf16_t* qe = (bf16_t*)(smem + 18432) + w * 1024;
    bf16_t* ke = (bf16_t*)(smem + 26624) + w * 1024;
    bf16_t* vL = (bf16_t*)(smem + 34816) + w * (32 * LDP);
    const float* gkv = (const float*)(p.ws + WS_GKV);
    const int bh = b * 4 + w;
    bf16_t qraw[16], kraw[16];
    { const bf16_t* qp = z + (size_t)(tok0 + (lane >> 5)) * ZP + w * 32 + (lane & 31);
#pragma unroll
      for (int i = 0; i < 16; ++i) { qraw[i] = qp[C_DQ]; kraw[i] = qp[C_DK]; qp += 2 * ZP; OPQ(qp); } }
    u32x4 vr[4]; f32x4 sr[8];
#pragma unroll
    for (int i = 0; i < 4; ++i) { const int cc = lane + 64 * i; vr[i] = *(const u32x4*)(z + (size_t)(tok0 + (cc >> 3)) * ZP + C_DV + w * 64 + (cc & 7) * 8); }
    { const float* Sp = gkv + (size_t)(bh * 128 + c) * 2048;
#pragma unroll
      for (int i = 0; i < 8; ++i) sr[i] = __builtin_nontemporal_load((const f32x4*)(Sp + (lane + 64 * i) * 4)); }
    f32x4 bcr[4];
    { const float* bcg = (const float*)(p.ws + WS_BC) + (size_t)idx * 4096;
#pragma unroll
      for (int i = 0; i < 4; ++i) bcr[i] = __builtin_nontemporal_load((const f32x4*)(bcg + (t + 256 * i) * 4)); }
    __syncthreads();
#pragma unroll
    for (int i = 0; i < 4; ++i) { const int cc = lane + 64 * i; *(u32x4*)(vL + (cc >> 3) * LDP + (cc & 7) * 8) = vr[i]; }
#pragma unroll
    for (int i = 0; i < 4; ++i) *(f32x4*)(bc + (t + 256 * i) * 4) = bcr[i];
    __syncthreads();
#pragma unroll
    for (int i2 = 0; i2 < 16; ++i2) { const int e = lane + 64 * i2; const int i = e >> 5, d = e & 31; const float bcv = bc[i * 128 + w * 32 + d];
        qe[i * 32 + d] = f2bf(bf2f(qraw[i2]) * __expf(bcv) * 0.17677669529663687f); ke[i * 32 + d] = f2bf(bf2f(kraw[i2]) * __expf(-bcv)); }
    __syncthreads();
#pragma unroll
    for (int i = 0; i < 8; ++i) { const int cc = lane + 64 * i; const int d = cc >> 4, v4 = cc & 15; u32x2 pk; pk.x = pack2(sr[i][0], sr[i][1]); pk.y = pack2(sr[i][2], sr[i][3]);
        *(u32x2*)(SL + d * LDP + v4 * 4) = pk; }
    __syncthreads();
    bf16x8 qf[2], kf[2];
#pragma unroll
    for (int x = 0; x < 2; ++x) { qf[x] = *(const bf16x8*)(qe + (x * 16 + r16) * 32 + quad * 8); kf[x] = *(const bf16x8*)(ke + (x * 16 + r16) * 32 + quad * 8); }
    bf16x8 pf[2];
#pragma unroll
    for (int it = 0; it < 2; ++it) {
        f32x4 at[2];
#pragma unroll
        for (int jt = 0; jt < 2; ++jt) { at[jt] = __builtin_amdgcn_mfma_f32_16x16x32_bf16(kf[jt], qf[it], (f32x4){0.f, 0.f, 0.f, 0.f}, 0, 0, 0);
#pragma unroll
            for (int jj = 0; jj < 4; ++jj) at[jt][jj] = (jt * 16 + quad * 4 + jj <= it * 16 + r16) ? at[jt][jj] : 0.f; }
        u32x4 pk = {pack2(at[0][0], at[0][1]), pack2(at[0][2], at[0][3]), pack2(at[1][0], at[1][1]), pack2(at[1][2], at[1][3])};
        pf[it] = __builtin_bit_cast(bf16x8, pk);
    }
    f32x4 O[2][4];
#pragma unroll
    for (int dt = 0; dt < 4; ++dt) {
        const bf16_t* v0p = vL + (quad * 4 + (r16 >> 2)) * LDP + dt * 16 + (r16 & 3) * 4;
        const bf16x4 v0 = __builtin_amdgcn_ds_read_tr16_b64_v4i16((__attribute__((address_space(3))) bf16x4*)(v0p));
        const bf16x4 v1 = __builtin_amdgcn_ds_read_tr16_b64_v4i16((__attribute__((address_space(3))) bf16x4*)(v0p + 16 * LDP));
        const bf16x8 vf = {v0[0], v0[1], v0[2], v0[3], v1[0], v1[1], v1[2], v1[3]};
        const bf16_t* s0p = SL + (quad * 8 + (r16 >> 2)) * LDP + dt * 16 + (r16 & 3) * 4;
        const bf16x4 s0 = __builtin_amdgcn_ds_read_tr16_b64_v4i16((__attribute__((address_space(3))) bf16x4*)(s0p));
        const bf16x4 s1 = __builtin_amdgcn_ds_read_tr16_b64_v4i16((__attribute__((address_space(3))) bf16x4*)(s0p + 4 * LDP));
        const bf16x8 sf = {s0[0], s0[1], s0[2], s0[3], s1[0], s1[1], s1[2], s1[3]};
#pragma unroll
        for (int it = 0; it < 2; ++it) {
            O[it][dt] = __builtin_amdgcn_mfma_f32_16x16x32_bf16(vf, pf[it], (f32x4){0.f, 0.f, 0.f, 0.f}, 0, 0, 0);
            O[it][dt] = __builtin_amdgcn_mfma_f32_16x16x32_bf16(sf, qf[it], O[it][dt], 0, 0, 0);
        }
    }
#pragma unroll
    for (int it = 0; it < 2; ++it) {
        float ss = 0.f;
#pragma unroll
        for (int dt = 0; dt < 4; ++dt) ss += (O[it][dt][0] * O[it][dt][0] + O[it][dt][1] * O[it][dt][1]) + (O[it][dt][2] * O[it][dt][2] + O[it][dt][3] * O[it][dt][3]);
        ss = x32_sum(x16_sum(ss));
        const float rn = rsqrtf(ss * (1.f / 64.f) + 1e-5f);
        const size_t tok = (size_t)(tok0 + it * 16 + r16);
#pragma unroll
        for (int dt = 0; dt < 4; ++dt) { const int v0i = dt * 16 + quad * 4; const f32x4 gn = *(const f32x4*)(p.gla_gn + l * 64 + v0i);
            const u32x2 gv = *(const u32x2*)(z + tok * ZP + C_DG + w * 64 + v0i);
            const float g0 = __uint_as_float(gv.x << 16), g1 = __uint_as_float(gv.x & 0xffff0000u), g2 = __uint_as_float(gv.y << 16), g3 = __uint_as_float(gv.y & 0xffff0000u);
            u32x2 o; o.x = pack2(O[it][dt][0] * rn * gn[0] * silu_f(g0), O[it][dt][1] * rn * gn[1] * silu_f(g1));
            o.y = pack2(O[it][dt][2] * rn * gn[2] * silu_f(g2), O[it][dt][3] * rn * gn[3] * silu_f(g3));
            *(u32x2*)(mix + tok * 1024 + 768 + w * 64 + v0i) = o; }
    }
}

__device__ void lru1_item(const Params& p, int l, int idx, char* smem) {
    const int t = tid_opq(), lane = t & 63, g = t >> 6, r16 = lane & 15, quad = lane >> 4; const int ch = t;
    const int b = idx >> 7, c = idx & 127; const int s0 = c * 32; const int tok0 = b * S + s0;
    const bf16_t* z = (const bf16_t*)(p.ws + WS_Z); float* xcs = (float*)smem;
    bf16_t* preA = (bf16_t*)(smem + 32768); bf16_t* preX = (bf16_t*)(smem + 49152);
    float* lh = (float*)(p.ws + WS_LH); float* lp = (float*)(p.ws + WS_LP);
    bf16_t xr[35];
#pragma unroll
    for (int i = 0; i < 35; ++i) { const int sidx = s0 + i - 3; xr[i] = (sidx >= 0) ? z[(size_t)(tok0 + i - 3) * ZP + C_BX + ch] : (bf16_t)0; }
    const float cw0 = p.conv_w[l * 1024 + ch], cw1 = p.conv_w[l * 1024 + 256 + ch], cw2 = p.conv_w[l * 1024 + 512 + ch], cw3 = p.conv_w[l * 1024 + 768 + ch];
    const float cb = p.conv_b[l * 256 + ch];
    const bf16_t* lwt = (const bf16_t*)(p.ws + WS_LWT) + (size_t)l * 32768 + g * 4096;
    bf16x8 wfa[4][2], wfx[4][2];
#pragma unroll
    for (int nt = 0; nt < 4; ++nt)
#pragma unroll
        for (int ks = 0; ks < 2; ++ks) { wfa[nt][ks] = *(const bf16x8*)(lwt + (nt * 16 + r16) * 64 + ks * 32 + quad * 8); wfx[nt][ks] = *(const bf16x8*)(lwt + 16384 + (nt * 16 + r16) * 64 + ks * 32 + quad * 8); }
    __syncthreads();
#pragma unroll
    for (int i = 0; i < 32; ++i) xcs[i * 256 + ch] = cb + (cw0 * bf2f(xr[i]) + cw1 * bf2f(xr[i + 1])) + (cw2 * bf2f(xr[i + 2]) + cw3 * bf2f(xr[i + 3]));
    __syncthreads();
#pragma unroll
    for (int tt = 0; tt < 2; ++tt) {
        bf16x8 xf[2];
#pragma unroll
        for (int ks = 0; ks < 2; ++ks) { const float* xp = xcs + (tt * 16 + r16) * 256 + g * 64 + ks * 32 + quad * 8; const f32x4 x0 = *(const f32x4*)xp, x1 = *(const f32x4*)(xp + 4);
            u32x4 pk = {pack2(x0[0], x0[1]), pack2(x0[2], x0[3]), pack2(x1[0], x1[1]), pack2(x1[2], x1[3])}; xf[ks] = __builtin_bit_cast(bf16x8, pk); }
#pragma unroll
        for (int nt = 0; nt < 4; ++nt) {
            f32x4 ra = __builtin_amdgcn_mfma_f32_16x16x32_bf16(wfa[nt][0], xf[0], (f32x4){0.f, 0.f, 0.f, 0.f}, 0, 0, 0); ra = __builtin_amdgcn_mfma_f32_16x16x32_bf16(wfa[nt][1], xf[1], ra, 0, 0, 0);
            f32x4 rx = __builtin_amdgcn_mfma_f32_16x16x32_bf16(wfx[nt][0], xf[0], (f32x4){0.f, 0.f, 0.f, 0.f}, 0, 0, 0); rx = __builtin_amdgcn_mfma_f32_16x16x32_bf16(wfx[nt][1], xf[1], rx, 0, 0, 0);
            u32x2 pa; pa.x = pack2(ra[0], ra[1]); pa.y = pack2(ra[2], ra[3]); u32x2 px; px.x = pack2(rx[0], rx[1]); px.y = pack2(rx[2], rx[3]);
            *(u32x2*)(preA + (tt * 16 + r16) * 256 + g * 64 + nt * 16 + quad * 4) = pa; *(u32x2*)(preX + (tt * 16 + r16) * 256 + g * 64 + nt * 16 + quad * 4) = px;
        }
    }
    __syncthreads();
    const float ba = p.lru_ba[l * 256 + ch], bx = p.lru_bx[l * 256 + ch], lam = p.lru_lam[l * 256 + ch];
    const float sp = fmaxf(-lam, 0.f) + log1pf(__expf(-fabsf(lam)));
    float hh = 0.f, P = 1.f;
    float* lhp = lh + (size_t)tok0 * 256 + ch; float* lpp = lp + (size_t)tok0 * 256 + ch;
#pragma unroll 4
    for (int i = 0; i < 32; ++i) { const float r = sigmoid_f(bf2f(preA[i * 256 + ch]) + ba), ig = sigmoid_f(bf2f(preX[i * 256 + ch]) + bx); const float la = -8.f * r * sp; const float a = __expf(la);
        const float w2 = 2.f * la;
        const float em_s = -w2 * (1.f + w2 * (0.5f + w2 * (0.16666667f + w2 * (0.041666668f + w2 * (0.0083333338f + w2 * 0.0013888889f)))));
        const float em = (w2 > -0.25f) ? em_s : (1.f - a * a);
        const float u = __builtin_amdgcn_sqrtf(em) * (ig * xcs[i * 256 + ch]); hh = a * hh + u; P *= a;
        lhp[(size_t)i * 256] = hh; lpp[(size_t)i * 256] = P; }
}

__device__ void lru3_item(const Params& p, int idx) {
    const int ch = tid_opq(); const int b = idx >> 7, c = idx & 127; const int tok0 = b * S + c * 32;
    const bf16_t* z = (const bf16_t*)(p.ws + WS_Z); bf16_t* mix = (bf16_t*)(p.ws + WS_U);
    const float* lh = (const float*)(p.ws + WS_LH); const float* lp = (const float*)(p.ws + WS_LP); const float* lc = (const float*)(p.ws + WS_LC);
    const float carry = lc[(size_t)(b * 128 + c) * 256 + ch];
    float hv[32], pv[32]; bf16_t gv[32];
#pragma unroll
    for (int i = 0; i < 32; ++i) { const size_t tok = (size_t)(tok0 + i); hv[i] = __builtin_nontemporal_load(lh + tok * 256 + ch); pv[i] = __builtin_nontemporal_load(lp + tok * 256 + ch); gv[i] = z[tok * ZP + C_BG + ch]; }
#pragma unroll
    for (int i = 0; i < 32; ++i) { const size_t tok = (size_t)(tok0 + i); mix[tok * 1024 + 256 + ch] = f2bf((hv[i] + pv[i] * carry) * silu_f(bf2f(gv[i]))); }
}

__device__ void dilc_item(const Params& p, int idx) {
    const int t = tid_opq(); const size_t tok = (size_t)idx * 8 + (t >> 5); const int chn = t & 31; const int h = chn >> 3;
    const bf16_t* z = (const bf16_t*)(p.ws + WS_Z); bf16_t* mix = (bf16_t*)(p.ws + WS_U);
    const bf16_t* dilo = (const bf16_t*)(p.ws + WS_DILO); const float* dill = (const float*)(p.ws + WS_DILL);
    const float l0 = dill[((size_t)0 * T + tok) * 4 + h], l1 = dill[((size_t)1 * T + tok) * 4 + h], l2 = dill[((size_t)2 * T + tok) * 4 + h];
    const float mx = fmaxf(l0, fmaxf(l1, l2)); float w0 = __expf(l0 - mx), w1 = __expf(l1 - mx), w2 = __expf(l2 - mx); const float inv = 1.f / (w0 + w1 + w2); w0 *= inv; w1 *= inv; w2 *= inv;
    const u32x4 o0 = __builtin_nontemporal_load((const u32x4*)(dilo + ((size_t)0 * T + tok) * 256 + chn * 8)), o1 = __builtin_nontemporal_load((const u32x4*)(dilo + ((size_t)1 * T + tok) * 256 + chn * 8)), o2 = __builtin_nontemporal_load((const u32x4*)(dilo + ((size_t)2 * T + tok) * 256 + chn * 8));
    const u32x4 gv = *(const u32x4*)(z + tok * ZP + C_CG + chn * 8);
    u32x4 r;
#pragma unroll
    for (int e = 0; e < 4; ++e) {
        const float a = w0 * __uint_as_float(o0[e] << 16) + w1 * __uint_as_float(o1[e] << 16) + w2 * __uint_as_float(o2[e] << 16);
        const float bq = w0 * __uint_as_float(o0[e] & 0xffff0000u) + w1 * __uint_as_float(o1[e] & 0xffff0000u) + w2 * __uint_as_float(o2[e] & 0xffff0000u);
        r[e] = pack2(a * silu_f(__uint_as_float(gv[e] << 16)), bq * silu_f(__uint_as_float(gv[e] & 0xffff0000u)));
    }
    *(u32x4*)(mix + tok * 1024 + 512 + chn * 8) = r;
}

__device__ void m2_phase(const Params& p, char* smem) {
    float* gkv = (float*)(p.ws + WS_GKV); const float* gdec = (const float*)(p.ws + WS_GDEC);
    const float* lh = (const float*)(p.ws + WS_LH); const float* lp = (const float*)(p.ws + WS_LP); float* lc = (float*)(p.ws + WS_LC);
    float* aggP = (float*)smem; float* aggS = aggP + 256;
    const int t = tid_opq(); const int e = t & 31, seg = t >> 5;
    for (int it = blockIdx.x; it < 1024 + 32; it += gridDim.x) {
        float a[16], x[16];
        size_t ostride;
        float* outp;
        if (it < 1024) {
            const int gid = it * 32 + e; const int bh = gid >> 11, dv = gid & 2047, d = dv >> 6;
            float* base = gkv + (size_t)bh * 128 * 2048 + dv + (size_t)(seg * 16) * 2048; const float* dc = gdec + (size_t)bh * 128 * 32 + d + (seg * 16) * 32;
#pragma unroll
            for (int k = 0; k < 16; ++k) { x[k] = base[(size_t)k * 2048]; a[k] = dc[k * 32]; }
            outp = base; ostride = 2048;
        } else {
            const int i2 = it - 1024; const int b = i2 >> 3, ch = (i2 & 7) * 32 + e;
#pragma unroll
            for (int k = 0; k < 16; ++k) { const size_t ix = (size_t)(b * S + (seg * 16 + k) * 32 + 31) * 256 + ch; a[k] = lp[ix]; x[k] = lh[ix]; }
            outp = lc + (size_t)(b * 128 + seg * 16) * 256 + ch; ostride = 256;
        }
        float st = 0.f, pr = 1.f;
#pragma unroll
        for (int k = 0; k < 16; ++k) { const float ak = a[k], xk = x[k]; a[k] = pr; x[k] = st; st = ak * st + xk; pr *= ak; }
        __syncthreads();
        aggP[seg * 32 + e] = pr; aggS[seg * 32 + e] = st;
        __syncthreads();
        float carry = 0.f;
        for (int s2 = 0; s2 < seg; ++s2) carry = aggP[s2 * 32 + e] * carry + aggS[s2 * 32 + e];
#pragma unroll
        for (int k = 0; k < 16; ++k) outp[(size_t)k * ostride] = x[k] + a[k] * carry;
    }
}

__global__ void __launch_bounds__(256, 2) fwd_megakernel(Params p) {
    __shared__ __attribute__((aligned(16))) char smem[SMEM_BYTES];
    __shared__ uint4 xb_words;
    __shared__ int s_slot;
    cg::grid_group grid = cg::this_grid();
    if (p.out == nullptr) grid.sync();
    if (threadIdx.x == 0) xb_words = make_uint4(0u, 0u, 0u, 0u);
    __syncthreads();
    const XcdBarrier xb = xcd_barrier_post((unsigned*)(p.ws + WS_CTL), (volatile LAS unsigned*)&xb_words);
    unsigned* cnt = (unsigned*)(p.ws + WS_CNT);
    prologue_phase(p, smem);
    xcd_barrier(xb);
#pragma unroll 1
    for (int l = 0; l < DEPTH; ++l) {
        ln_phase(p, l);
        xcd_barrier(xb);
        g1_phase(p, l, smem);
        xcd_barrier(xb);
        for (;;) { const int it = next_item(cnt + (4 + l) * 64, &s_slot); if (it >= 512) break; lru1_item(p, l, it, smem); }
        { const int xq = blockIdx.x & 7;
          for (;;) { const int li = next_item(cnt + (16 + l * 8 + xq) * 64, &s_slot); if (li >= 64) break;
              const int pr = xq * 2 + ((li >> 1) & 1); moba_item(p, (li >> 2) * 32 + (pr >> 2) * 8 + (pr & 3) * 2 + (li & 1), smem, (bf16_t*)(p.ws + WS_U)); }
          for (;;) { const int li = next_item(cnt + (32 + l * 8 + xq) * 64, &s_slot); if (li >= 192) break;
              const int cfg = li >> 6, r6 = li & 63; const int pr = xq * 2 + (r6 >> 5); attn_item(p, 1, cfg * 512 + (pr >> 2) * 128 + (pr & 3) * 32 + (r6 & 31), smem); } }
        for (;;) { const int it = next_item(cnt + (2 + l) * 64, &s_slot); if (it >= 512) break; gla1_item(p, l, it, smem); }
        xcd_barrier(xb);
        m2_phase(p, smem);
        xcd_barrier(xb);
        for (int it = blockIdx.x; it < 512; it += gridDim.x) gla3_item(p, l, it, smem);
        for (int it = blockIdx.x; it < 512; it += gridDim.x) lru3_item(p, it);
        for (int it = blockIdx.x; it < 2048; it += gridDim.x) dilc_item(p, it);
        xcd_barrier(xb);
        g2_phase(p, l, smem);
        xcd_barrier(xb);
    }
    ln_phase(p, DEPTH);
}

extern "C" void kernel_launch(void* const* d_in, const int* in_sizes, int n_in, void* d_out, int out_size, void* d_ws, size_t ws_size, hipStream_t stream) {
    static int grid_blocks = 0;
    if (!grid_blocks) {
        int dev = 0, cus = 0, per_cu = 0;
        hipGetDevice(&dev);
        hipDeviceGetAttribute(&cus, hipDeviceAttributeMultiprocessorCount, dev);
        hipOccupancyMaxActiveBlocksPerMultiprocessor(&per_cu, (const void*)fwd_megakernel, 256, 0);
        if (per_cu < 1) per_cu = 1;
        if (per_cu > 2) per_cu = 2;
        grid_blocks = cus * per_cu;
        if (ws_size < WS_END) fprintf(stderr, "kernel_launch: workspace too small: %zu < %zu\n", ws_size, (size_t)WS_END);
    }
    Params p{};
    p.x = (const float*)d_in[0]; p.c = (const float*)d_in[1]; p.pos = (const int*)d_in[2];
    p.w_mod = (const float*)d_in[3]; p.b_mod = (const float*)d_in[4]; p.w_in = (const float*)d_in[5];
    p.conv_w = (const float*)d_in[6]; p.conv_b = (const float*)d_in[7]; p.lru_wa = (const float*)d_in[8]; p.lru_ba = (const float*)d_in[9];
    p.lru_wx = (const float*)d_in[10]; p.lru_bx = (const float*)d_in[11]; p.lru_lam = (const float*)d_in[12];
    p.gla_wr = (const float*)d_in[13]; p.gla_br = (const float*)d_in[14]; p.gla_gn = (const float*)d_in[15];
    p.w_out = (const float*)d_in[16]; p.ln_g = (const float*)d_in[17]; p.ln_b = (const float*)d_in[18];
    p.out = (float*)d_out; p.ws = (unsigned char*)d_ws;
    (void)hipMemsetAsync(d_ws, 0, 32768, stream);
    void* args[] = {&p};
    hipError_t e = hipLaunchCooperativeKernel((const void*)fwd_megakernel, dim3(grid_blocks), dim3(256), args, 0, stream);
    if (e != hipSuccess) fprintf(stderr, "cooperative launch failed: %s (grid %d)\n", hipGetErrorString(e), grid_blocks);
}
```

```cpp
#include <hip/hip_runtime.h>
#include <hip/hip_cooperative_groups.h>
#include <cstdio>
#include <cstdint>
#include <type_traits>
namespace cg = cooperative_groups;

typedef unsigned short bf16_t;
typedef short bf16x8 __attribute__((ext_vector_type(8)));
typedef short bf16x4 __attribute__((ext_vector_type(4)));
typedef float f32x4 __attribute__((ext_vector_type(4)));
typedef unsigned u32x4 __attribute__((ext_vector_type(4)));
typedef unsigned u32x2 __attribute__((ext_vector_type(2)));

constexpr int D = 1024, NB = 4, S = 4096, T = NB * S, DEPTH = 2;
constexpr int DIN = 3344, ZP = 3392, NPAD = 3456;
constexpr int C_AQ = 0, C_AK = 256, C_AV = 512, C_AG = 768, C_BX = 1024, C_BG = 1280, C_CQ = 1536, C_CK = 1792,
              C_CV = 2048, C_CG = 2304, C_DQ = 2560, C_DK = 2688, C_DV = 2816, C_DG = 3072, C_DR = 3328;
constexpr float DN_ALPHA = 1.4142135623730951f;
constexpr int LDP = 72;
constexpr int SMEM_BYTES = 65536;
constexpr int BIG = 1000000;

constexpr size_t WS_CTL = 0;
constexpr size_t WS_CNT = 16384;
constexpr size_t WS_WINT = 32768;
constexpr size_t WS_WOUTT = WS_WINT + (size_t)DEPTH * NPAD * 1024 * 2;
constexpr size_t WS_MOD = WS_WOUTT + (size_t)DEPTH * 1024 * 1024 * 2;
constexpr size_t WS_COS = WS_MOD + (size_t)DEPTH * NB * 3072 * 4;
constexpr size_t WS_SIN = WS_COS + (size_t)T * 32 * 4;
constexpr size_t WS_U = WS_SIN + (size_t)T * 32 * 4;
constexpr size_t WS_Z = WS_U + (size_t)T * 1024 * 2;
constexpr size_t WS_KPART = WS_Z + (size_t)T * ZP * 2;
constexpr size_t WS_DILO = WS_KPART + (size_t)256 * 256 * 4;
constexpr size_t WS_DILL = WS_DILO + (size_t)3 * T * 256 * 2;
constexpr size_t WS_GKV = WS_DILL + (size_t)3 * T * 4 * 4;
constexpr size_t WS_GDEC = WS_GKV + (size_t)2048 * 2048 * 4;
constexpr size_t WS_LH = WS_GDEC + (size_t)2048 * 32 * 4;
constexpr size_t WS_LP = WS_LH + (size_t)T * 256 * 4;
constexpr size_t WS_LC = WS_LP + (size_t)T * 256 * 4;
constexpr size_t WS_LWT = WS_LC + (size_t)NB * 128 * 256 * 4;
constexpr size_t WS_BC = WS_LWT + (size_t)DEPTH * 2 * 4 * 64 * 64 * 2;
constexpr size_t WS_END = WS_BC + (size_t)512 * 32 * 128 * 4;

struct Params {
    const float *x, *c; const int* pos;
    const float *w_mod, *b_mod, *w_in, *conv_w, *conv_b, *lru_wa, *lru_ba, *lru_wx, *lru_bx, *lru_lam, *gla_wr, *gla_br, *gla_gn, *w_out, *ln_g, *ln_b;
    float* out; unsigned char* ws;
};

__device__ __forceinline__ float bf2f(bf16_t h) { return __uint_as_float(((unsigned)h) << 16); }
typedef __bf16 hbf16x2 __attribute__((ext_vector_type(2)));
typedef float f32x2 __attribute__((ext_vector_type(2)));
__device__ __forceinline__ unsigned pack2(float a, float b) { f32x2 v = {a, b}; hbf16x2 r = __builtin_convertvector(v, hbf16x2); return __builtin_bit_cast(unsigned, r); }
__device__ __forceinline__ bf16_t f2bf(float f) { return (bf16_t)(pack2(f, 0.f) & 0xffffu); }
__device__ __forceinline__ float silu_f(float x) { return x / (1.f + __expf(-x)); }
__device__ __forceinline__ float sigmoid_f(float x) { return 1.f / (1.f + __expf(-x)); }
__device__ __forceinline__ int tid_opq() { int t = threadIdx.x; asm volatile("" : "+v"(t)); return t; }
__device__ __forceinline__ float x16_sum(float v) { auto r = __builtin_amdgcn_permlane16_swap(__float_as_uint(v), __float_as_uint(v), false, false); return __uint_as_float(r[0]) + __uint_as_float(r[1]); }
__device__ __forceinline__ float x32_sum(float v) { auto r = __builtin_amdgcn_permlane32_swap(__float_as_uint(v), __float_as_uint(v), false, false); return __uint_as_float(r[0]) + __uint_as_float(r[1]); }
__device__ __forceinline__ float x16_max(float v) { auto r = __builtin_amdgcn_permlane16_swap(__float_as_uint(v), __float_as_uint(v), false, false); return fmaxf(__uint_as_float(r[0]), __uint_as_float(r[1])); }
__device__ __forceinline__ float x32_max(float v) { auto r = __builtin_amdgcn_permlane32_swap(__float_as_uint(v), __float_as_uint(v), false, false); return fmaxf(__uint_as_float(r[0]), __uint_as_float(r[1])); }
__device__ __forceinline__ float row16_sum(float v) {
    v += __uint_as_float(__builtin_amdgcn_update_dpp(0u, __float_as_uint(v), 0x128, 0xf, 0xf, false));
    v += __uint_as_float(__builtin_amdgcn_update_dpp(0u, __float_as_uint(v), 0x124, 0xf, 0xf, false));
    v += __uint_as_float(__builtin_amdgcn_update_dpp(0u, __float_as_uint(v), 0x122, 0xf, 0xf, false));
    v += __uint_as_float(__builtin_amdgcn_update_dpp(0u, __float_as_uint(v), 0x121, 0xf, 0xf, false));
    return v;
}
__device__ __forceinline__ float wsum(float v) { return x32_sum(x16_sum(row16_sum(v))); }

#define XB_TMO      128
#define XB_XCNT(j)  (256  + 64 * (j))
#define XB_XSUB(j)  (1280 + 64 * (j))
#define XB_XGEN(j)  (2304 + 64 * (j))
#define XB_TOP      3328
#define XB_TOPGEN   3392
#define XCD_BAR_WORDS 3456
#define XB_SPIN_CAP (1u << 18)
#define LAS __attribute__((address_space(3)))
__device__ __forceinline__ unsigned xb_ld(unsigned* p)              { return __hip_atomic_load(p, __ATOMIC_RELAXED, __HIP_MEMORY_SCOPE_AGENT); }
__device__ __forceinline__ unsigned xb_add(unsigned* p, unsigned v) { return __hip_atomic_fetch_add(p, v, __ATOMIC_RELAXED, __HIP_MEMORY_SCOPE_AGENT); }
__device__ __forceinline__ unsigned xb_xcc_id() { return (unsigned)__builtin_amdgcn_s_getreg((3 << 11) | 20) & 0xFu; }
#define XB_SPIN(cond, bar) do { unsigned _sp = 0; while (cond) { __builtin_amdgcn_s_sleep(1); \
    if ((++_sp & 255u) == 0u) { if (xb_ld(&(bar)[XB_TMO])) break; if (_sp > XB_SPIN_CAP) { atomicAdd(&(bar)[XB_TMO], 1u); break; } } } } while (0)
struct XcdBarrier { unsigned* bar; unsigned x; volatile LAS unsigned* st; };
__device__ __forceinline__ XcdBarrier xcd_barrier_post(unsigned* bar, volatile LAS unsigned* st) {
    XcdBarrier b; b.bar = bar; b.x = xb_xcc_id(); b.st = st;
    if (threadIdx.x == 0) (void)xb_add(&bar[XB_XCNT(b.x)], 1u);
    return b;
}
__device__ __forceinline__ void xcd_barrier_complete(unsigned* bar, unsigned x, unsigned& nloc, unsigned& nx) {
    const unsigned G = gridDim.x * gridDim.y * gridDim.z;
    unsigned sum, cnt, mine, sp = 0u;
    for (;;) {
        sum = 0u; cnt = 0u; mine = 0u;
#pragma unroll
        for (unsigned j = 0; j < 16; ++j) { const unsigned c = xb_ld(&bar[XB_XCNT(j)]); sum += c; cnt += (c > 0u) ? 1u : 0u; mine = (j == x) ? c : mine; }
        if (sum == G) break;
        __builtin_amdgcn_s_sleep(1);
        if ((++sp & 255u) == 0u) { if (xb_ld(&bar[XB_TMO])) break; if (sp > XB_SPIN_CAP) { atomicAdd(&bar[XB_TMO], 1u); break; } }
    }
    nloc = mine > 0u ? mine : 1u; nx = cnt > 0u ? cnt : 1u;
}
__device__ __forceinline__ void xcd_barrier(const XcdBarrier& b) {
    asm volatile("s_waitcnt vmcnt(0)" ::: "memory");
    __syncthreads();
    if (threadIdx.x == 0) {
        unsigned* bar = b.bar;
        __builtin_amdgcn_s_waitcnt(0);
        unsigned nloc = b.st[0], nx = b.st[1];
        if (nloc == 0u) { xcd_barrier_complete(bar, b.x, nloc, nx); b.st[0] = nloc; b.st[1] = nx; }
        const unsigned old = xb_add(&bar[XB_XSUB(b.x)], 1u);
        const unsigned gen = old / nloc;
        if (old + 1u == (gen + 1u) * nloc) {
            __builtin_amdgcn_fence(__ATOMIC_RELEASE, "agent");
            asm volatile("s_waitcnt vmcnt(0)" ::: "memory");
            const unsigned og = xb_add(&bar[XB_TOP], 1u);
            const unsigned tg = og / nx;
            if (og + 1u == (tg + 1u) * nx) xb_add(&bar[XB_TOPGEN], 1u);
            else XB_SPIN(xb_ld(&bar[XB_TOPGEN]) == tg, bar);
            __builtin_amdgcn_fence(__ATOMIC_ACQUIRE, "agent");
            xb_add(&bar[XB_XGEN(b.x)], 1u);
            asm volatile("s_waitcnt vmcnt(0)" ::: "memory");
        } else {
            XB_SPIN(xb_ld(&bar[XB_XGEN(b.x)]) == gen, bar);
            __builtin_amdgcn_fence(__ATOMIC_ACQUIRE, "agent");
            asm volatile("s_waitcnt vmcnt(0)" ::: "memory");
        }
    }
    __syncthreads();
}
__device__ __forceinline__ int next_item(unsigned* ctr, volatile int* slot) {
    __syncthreads();
    if (threadIdx.x == 0) *slot = (int)atomicAdd(ctr, 1u);
    __syncthreads();
    return *slot;
}

__device__ void prologue_phase(const Params& p, char* smem) {
    const int t = tid_opq();
    bf16_t* WinT = (bf16_t*)(p.ws + WS_WINT); bf16_t* WoutT = (bf16_t*)(p.ws + WS_WOUTT);
    float* mod = (float*)(p.ws + WS_MOD); float* cosT = (float*)(p.ws + WS_COS); float* sinT = (float*)(p.ws + WS_SIN);
    float* tl = (float*)smem;
    constexpr int N_TIN = DEPTH * 16 * 54, N_TOUT = DEPTH * 16 * 16, N_MOD = DEPTH * 192, N_ROPE = T * 32 / 256, N_LWT = DEPTH * 2 * 4 * 64 * 64 / 256;
    constexpr int NITEMS = N_TIN + N_TOUT + N_MOD + N_ROPE + N_LWT;
    for (int it = blockIdx.x; it < NITEMS; it += gridDim.x) {
        if (it < N_TIN + N_TOUT) {
            const float* src; bf16_t* dst; int ncols, kt, nt;
            if (it < N_TIN) { int l = it / (16 * 54), r = it % (16 * 54); kt = r / 54; nt = r % 54; src = p.w_in + (size_t)l * 1024 * DIN; dst = WinT + (size_t)l * NPAD * 1024; ncols = DIN; }
            else { int i2 = it - N_TIN; int l = i2 / 256, r = i2 % 256; kt = r / 16; nt = r % 16; src = p.w_out + (size_t)l * 1024 * 1024; dst = WoutT + (size_t)l * 1024 * 1024; ncols = 1024; }
            __syncthreads();
            { const int c4 = t & 15, r0 = t >> 4; const int n = nt * 64 + c4 * 4;
              f32x4 v[4];
#pragma unroll
              for (int i = 0; i < 4; ++i) { const int r = r0 + 16 * i; v[i] = (n < ncols) ? __builtin_nontemporal_load((const f32x4*)(src + (size_t)(kt * 64 + r) * ncols + n)) : (f32x4){0.f, 0.f, 0.f, 0.f}; }
#pragma unroll
              for (int i = 0; i < 4; ++i) { const int r = r0 + 16 * i; tl[r * 65 + c4 * 4] = v[i][0]; tl[r * 65 + c4 * 4 + 1] = v[i][1]; tl[r * 65 + c4 * 4 + 2] = v[i][2]; tl[r * 65 + c4 * 4 + 3] = v[i][3]; } }
            __syncthreads();
            {
#pragma unroll
              for (int i = 0; i < 2; ++i) { const int cc = t + 256 * i; const int n = cc >> 3, k8 = (cc & 7) * 8;
                  u32x4 pk; pk.x = pack2(tl[(k8 + 0) * 65 + n], tl[(k8 + 1) * 65 + n]); pk.y = pack2(tl[(k8 + 2) * 65 + n], tl[(k8 + 3) * 65 + n]);
                  pk.z = pack2(tl[(k8 + 4) * 65 + n], tl[(k8 + 5) * 65 + n]); pk.w = pack2(tl[(k8 + 6) * 65 + n], tl[(k8 + 7) * 65 + n]);
                  *(u32x4*)(dst + (size_t)(nt * 64 + n) * 1024 + kt * 64 + k8) = pk; } }
        } else if (it < N_TIN + N_TOUT + N_MOD) {
            const int i2 = it - N_TIN - N_TOUT; const int l = i2 / 192, jg = i2 % 192;
            const int jj = t & 15, ks = t >> 4; const int j = jg * 16 + jj;
            float a0 = 0.f, a1 = 0.f, a2 = 0.f, a3 = 0.f;
            const float* wm = p.w_mod + (size_t)l * 1024 * 3072 + j;
#pragma unroll 8
            for (int k = ks * 64; k < ks * 64 + 64; ++k) { float wv = __builtin_nontemporal_load(wm + (size_t)k * 3072); a0 += p.c[k] * wv; a1 += p.c[1024 + k] * wv; a2 += p.c[2048 + k] * wv; a3 += p.c[3072 + k] * wv; }
            __syncthreads();
            tl[(0 * 16 + ks) * 16 + jj] = a0; tl[(1 * 16 + ks) * 16 + jj] = a1; tl[(2 * 16 + ks) * 16 + jj] = a2; tl[(3 * 16 + ks) * 16 + jj] = a3;
            __syncthreads();
            if (t < 64) { const int b = t >> 4, j2 = t & 15; float s = 0.f;
#pragma unroll
              for (int k2 = 0; k2 < 16; ++k2) s += tl[(b * 16 + k2) * 16 + j2];
              mod[((size_t)l * NB + b) * 3072 + jg * 16 + j2] = s + p.b_mod[l * 3072 + jg * 16 + j2]; }
        } else if (it >= N_TIN + N_TOUT + N_MOD + N_ROPE) {
            const int e = (it - N_TIN - N_TOUT - N_MOD - N_ROPE) * 256 + t;
            const int in = e & 63, out = (e >> 6) & 63, g = (e >> 12) & 3, mat = (e >> 14) & 1, l = e >> 15;
            const float* src = mat ? p.lru_wx : p.lru_wa;
            ((bf16_t*)(p.ws + WS_LWT))[e] = f2bf(src[l * 16384 + g * 4096 + in * 64 + out]);
        } else {
            const int i2 = it - N_TIN - N_TOUT - N_MOD; const int e = i2 * 256 + t; const int tok = e >> 5, f = e & 31;
            const float inv = exp2f(-(float)f * (13.287712379549449f / 32.f));
            const float ang = (float)p.pos[tok] * inv;
            double rev = (double)ang * 0.15915494309189535; rev -= __builtin_rint(rev);
            const float rr = (float)rev; cosT[e] = __builtin_amdgcn_cosf(rr); sinT[e] = __builtin_amdgcn_sinf(rr);
        }
    }
}

__device__ void ln_phase(const Params& p, int l) {
    const int t = tid_opq(), lane = t & 63, w = t >> 6;
    bf16_t* ubuf = (bf16_t*)(p.ws + WS_U); const float* mod = (const float*)(p.ws + WS_MOD);
    for (int rg = blockIdx.x; rg < T / 16; rg += gridDim.x) {
        f32x4 v[4][4];
#pragma unroll
        for (int r = 0; r < 4; ++r) { const int row = rg * 16 + w * 4 + r; const float* src = (l <= 1) ? p.x + (size_t)row * 1024 : p.out + (size_t)row * 1024;
#pragma unroll
            for (int i = 0; i < 4; ++i) v[r][i] = __builtin_nontemporal_load((const f32x4*)(src + i * 256 + lane * 4));
            if (l > 0) {
                const bf16_t* yr = (const bf16_t*)(p.ws + WS_Z) + (size_t)row * 1024; const float* gate = mod + ((size_t)(l - 1) * NB + row / S) * 3072 + 2048;
#pragma unroll
                for (int i = 0; i < 4; ++i) { const u32x2 yv = __builtin_nontemporal_load((const u32x2*)(yr + i * 256 + lane * 4)); const f32x4 g1 = *(const f32x4*)(gate + i * 256 + lane * 4) + 1.f;
                    const f32x4 yf = {__uint_as_float(yv.x << 16), __uint_as_float(yv.x & 0xffff0000u), __uint_as_float(yv.y << 16), __uint_as_float(yv.y & 0xffff0000u)};
                    v[r][i] = v[r][i] * DN_ALPHA + g1 * yf; }
            } }
#pragma unroll
        for (int r = 0; r < 4; ++r) {
            const int row = rg * 16 + w * 4 + r; const int b = row / S;
            if (l > 0) {
                float s = 0.f;
#pragma unroll
                for (int i = 0; i < 4; ++i) s += (v[r][i][0] + v[r][i][1]) + (v[r][i][2] + v[r][i][3]);
                const float mu = wsum(s) * (1.f / 1024.f); float q = 0.f;
#pragma unroll
                for (int i = 0; i < 4; ++i) { f32x4 d = v[r][i] - mu; q += (d[0] * d[0] + d[1] * d[1]) + (d[2] * d[2] + d[3] * d[3]); }
                const float rstd = rsqrtf(wsum(q) * (1.f / 1024.f) + 1e-5f);
#pragma unroll
                for (int i = 0; i < 4; ++i) { const f32x4 g = *(const f32x4*)(p.ln_g + (l - 1) * 1024 + i * 256 + lane * 4), bb = *(const f32x4*)(p.ln_b + (l - 1) * 1024 + i * 256 + lane * 4);
                    v[r][i] = (v[r][i] - mu) * rstd * g + bb; __builtin_nontemporal_store(v[r][i], (f32x4*)(p.out + (size_t)row * 1024 + i * 256 + lane * 4)); }
            }
            if (l < DEPTH) {
                float s = 0.f;
#pragma unroll
                for (int i = 0; i < 4; ++i) s += (v[r][i][0] + v[r][i][1]) + (v[r][i][2] + v[r][i][3]);
                const float mu = wsum(s) * (1.f / 1024.f); float q = 0.f;
#pragma unroll
                for (int i = 0; i < 4; ++i) { f32x4 d = v[r][i] - mu; q += (d[0] * d[0] + d[1] * d[1]) + (d[2] * d[2] + d[3] * d[3]); }
                const float rstd = rsqrtf(wsum(q) * (1.f / 1024.f) + 1e-5f);
                const float* mb = mod + ((size_t)l * NB + b) * 3072;
#pragma unroll
                for (int i = 0; i < 4; ++i) { const int col = i * 256 + lane * 4; const f32x4 sh = *(const f32x4*)(mb + col), sc = *(const f32x4*)(mb + 1024 + col);
                    f32x4 u = (v[r][i] - mu) * rstd * (sc + 1.f) + sh; u32x2 pk; pk.x = pack2(u[0], u[1]); pk.y = pack2(u[2], u[3]);
                    *(u32x2*)(ubuf + (size_t)row * 1024 + col) = pk; }
            }
        }
    }
}

__device__ __forceinline__ int lds_off(int r, int c8) {
    const int st = (r >> 4) * 2 + (c8 >> 2); const int ob = (r & 15) * 64 + (c8 & 3) * 16;
    return st * 1024 + (ob ^ (((ob >> 9) & 1) << 5));
}
struct RegSet { u32x4 a[4], b[4]; };
__device__ __forceinline__ void gemm_tile(const bf16_t* __restrict__ A, const bf16_t* __restrict__ Bt, int tm, int tn, bool first, bool has_next, int ntm, int ntn,
                                          char* sm, f32x4 (&acc)[4][4], RegSet& r0, RegSet& r1) {
    const int t = tid_opq(), lane = t & 63, w = t >> 6, wm = w >> 1, wn = w & 1, r16 = lane & 15, quad = lane >> 4;
    const int lrow = t >> 3, lch = t & 7;
    constexpr int BUF = 32768;
    const unsigned loff = (unsigned)(lrow * 1024 + lch * 8);
    const bf16_t* At0 = A + (size_t)tm * (128 * 1024); const bf16_t* Bt0 = Bt + (size_t)tn * (128 * 1024);
    const bf16_t* At1 = A + (size_t)ntm * (128 * 1024); const bf16_t* Bt1 = Bt + (size_t)ntn * (128 * 1024);
#define Ag (At0 + loff)
#define Bg (Bt0 + loff)
#define nAg (At1 + loff)
#define nBg (Bt1 + loff)
    const int woff0 = lds_off(lrow, lch);
#define woff(i) (woff0 + 4096 * (i))
    const int fo = lds_off(r16, quad);
#pragma unroll
    for (int a = 0; a < 4; ++a)
#pragma unroll
        for (int b = 0; b < 4; ++b) acc[a][b] = (f32x4){0.f, 0.f, 0.f, 0.f};
    if (first) {
#pragma unroll
        for (int i = 0; i < 4; ++i) { r0.a[i] = *(const u32x4*)(Ag + (size_t)i * 32 * 1024); r0.b[i] = *(const u32x4*)(Bg + (size_t)i * 32 * 1024); }
#pragma unroll
        for (int i = 0; i < 4; ++i) { r1.a[i] = *(const u32x4*)(Ag + (size_t)i * 32 * 1024 + 64); r1.b[i] = *(const u32x4*)(Bg + (size_t)i * 32 * 1024 + 64); }
        __syncthreads();
#pragma unroll
        for (int i = 0; i < 4; ++i) { *(u32x4*)(sm + woff(i)) = r0.a[i]; *(u32x4*)(sm + 16384 + woff(i)) = r0.b[i]; }
#pragma unroll
        for (int i = 0; i < 4; ++i) { r0.a[i] = *(const u32x4*)(Ag + (size_t)i * 32 * 1024 + 128); r0.b[i] = *(const u32x4*)(Bg + (size_t)i * 32 * 1024 + 128); }
    }
    __syncthreads();
    auto step = [&](auto main_tag, int kt, RegSet& rs) {
        constexpr bool MAIN = decltype(main_tag)::value;
        const char* sA = sm + (kt & 1) * BUF; const char* sB = sA + 16384;
        char* nA = sm + ((kt + 1) & 1) * BUF; char* nB = nA + 16384;
        const bool wr = MAIN || kt + 1 < 16 || has_next;
        const bool own = MAIN || kt + 3 < 16;
        const bf16_t* la = own ? Ag + (kt + 3) * 64 : nAg + (kt - 13) * 64; const bf16_t* lb = own ? Bg + (kt + 3) * 64 : nBg + (kt - 13) * 64;
        __builtin_amdgcn_s_setprio(1);
#pragma unroll
        for (int ks = 0; ks < 2; ++ks) {
            bf16x8 af[4], bfr[4];
#pragma unroll
            for (int mt = 0; mt < 4; ++mt) af[mt] = *(const bf16x8*)(sA + ((wm * 4 + mt) * 2 + ks) * 1024 + fo);
#pragma unroll
            for (int nt = 0; nt < 4; ++nt) bfr[nt] = *(const bf16x8*)(sB + ((wn * 4 + nt) * 2 + ks) * 1024 + fo);
#pragma unroll
            for (int mt = 0; mt < 4; ++mt) {
#pragma unroll
                for (int nt = 0; nt < 4; ++nt) acc[mt][nt] = __builtin_amdgcn_mfma_f32_16x16x32_bf16(bfr[nt], af[mt], acc[mt][nt], 0, 0, 0);
                const int i = ks * 2 + (mt >> 1);
                __builtin_amdgcn_sched_barrier(0);
                if ((mt & 1) == 0) { if (wr) *(u32x4*)(nA + woff(i)) = rs.a[i]; if (own || has_next) rs.a[i] = *(const u32x4*)(la + (size_t)i * 32 * 1024); }
                else               { if (wr) *(u32x4*)(nB + woff(i)) = rs.b[i]; if (own || has_next) rs.b[i] = *(const u32x4*)(lb + (size_t)i * 32 * 1024); }
                __builtin_amdgcn_sched_barrier(0);
            }
        }
        __builtin_amdgcn_s_setprio(0);
        __syncthreads();
    };
    {
        std::true_type mt_; std::false_type tl_;
        for (int k2 = 0; k2 < 6; ++k2) { step(mt_, 2 * k2, r1); step(mt_, 2 * k2 + 1, r0); }
        step(mt_, 12, r1); step(tl_, 13, r0); step(tl_, 14, r1); step(tl_, 15, r0);
    }
#undef Ag
#undef Bg
#undef nAg
#undef nBg
#undef woff
}

__device__ void g1_phase(const Params& p, int l, char* smem) {
    const int t = tid_opq(), lane = t & 63, w = t >> 6, wm = w >> 1, wn = w & 1, r16 = lane & 15, quad = lane >> 4;
    char* sm = smem; char* sC = smem + 32768;
    const bf16_t* ubuf = (const bf16_t*)(p.ws + WS_U); const bf16_t* WinT = (const bf16_t*)(p.ws + WS_WINT) + (size_t)l * NPAD * 1024;
    bf16_t* z = (bf16_t*)(p.ws + WS_Z); float* kpart = (float*)(p.ws + WS_KPART);
    const float* cosT = (const float*)(p.ws + WS_COS); const float* sinT = (const float*)(p.ws + WS_SIN);
    const bool xo = (gridDim.x & 7) == 0; const int xcd = blockIdx.x & 7, nloc = xo ? (int)(gridDim.x >> 3) : (int)gridDim.x, j0 = xo ? (int)(blockIdx.x >> 3) : (int)blockIdx.x;
    const int lim = xo ? 16 * 27 : 128 * 27;
    RegSet r0, r1;
    for (int L = j0; L < lim; L += nloc) {
        const int tm = xo ? xcd * 16 + (L / 216) * 8 + (L & 7) : L / 27, tn = xo ? ((L % 216) >> 3) : L % 27;
        const int L2 = L + nloc; const bool has_next = L2 < lim;
        const int ntm = has_next ? (xo ? xcd * 16 + (L2 / 216) * 8 + (L2 & 7) : L2 / 27) : tm, ntn = has_next ? (xo ? ((L2 % 216) >> 3) : L2 % 27) : tn;
        f32x4 acc[4][4];
        gemm_tile(ubuf, WinT, tm, tn, L == j0, has_next, ntm, ntn, sm, acc, r0, r1);
        const bool rope = (tn < 4) || (tn >= 12 && tn < 16);
        if (rope) {
#pragma unroll
            for (int mt = 0; mt < 4; ++mt) {
                const int tok = tm * 128 + wm * 64 + mt * 16 + r16;
#pragma unroll
                for (int nt = 0; nt < 2; ++nt) {
                    const f32x4 cs = *(const f32x4*)(cosT + (size_t)tok * 32 + nt * 16 + quad * 4), sn = *(const f32x4*)(sinT + (size_t)tok * 32 + nt * 16 + quad * 4);
                    const f32x4 x1 = acc[mt][nt], x2 = acc[mt][nt + 2];
                    acc[mt][nt] = x1 * cs - x2 * sn; acc[mt][nt + 2] = x1 * sn + x2 * cs;
                }
            }
        }
        if (tn == 2 || tn == 3) {
#pragma unroll
            for (int nt = 0; nt < 4; ++nt) {
                f32x4 sv = (acc[0][nt] + acc[1][nt]) + (acc[2][nt] + acc[3][nt]);
#pragma unroll
                for (int jj = 0; jj < 4; ++jj) { sv[jj] = row16_sum(sv[jj]); }
                if (r16 == 0) *(f32x4*)(kpart + (size_t)(tm * 2 + wm) * 256 + (tn - 2) * 128 + wn * 64 + nt * 16 + quad * 4) = sv;
            }
        }
#pragma unroll
        for (int mt = 0; mt < 4; ++mt)
#pragma unroll
            for (int nt = 0; nt < 4; ++nt) { u32x2 pk; pk.x = pack2(acc[mt][nt][0], acc[mt][nt][1]); pk.y = pack2(acc[mt][nt][2], acc[mt][nt][3]);
                const int row = wm * 64 + mt * 16 + r16; const int c16 = wn * 8 + nt * 2 + (quad >> 1);
                *(u32x2*)(sC + row * 256 + ((c16 ^ (row & 15)) << 4) + (quad & 1) * 8) = pk; }
        __syncthreads();
#pragma unroll
        for (int i = 0; i < 8; ++i) { const int c = t + 256 * i; const int row = c >> 4, ch = c & 15; const int col = tn * 128 + ch * 8;
            if (col < DIN) *(u32x4*)(z + (size_t)(tm * 128 + row) * ZP + col) = *(const u32x4*)(sC + row * 256 + ((ch ^ (row & 15)) << 4)); }
    }
}

__device__ void g2_phase(const Params& p, int l, char* smem) {
    const int t = tid_opq(), lane = t & 63, w = t >> 6, wm = w >> 1, wn = w & 1, r16 = lane & 15, quad = lane >> 4;
    char* sm = smem; char* sC = smem + 32768;
    const bf16_t* mix = (const bf16_t*)(p.ws + WS_U); const bf16_t* WoutT = (const bf16_t*)(p.ws + WS_WOUTT) + (size_t)l * 1024 * 1024;
    bf16_t* ybuf = (bf16_t*)(p.ws + WS_Z);
    const bool xo = (gridDim.x & 7) == 0; const int xcd = blockIdx.x & 7, nloc = xo ? (int)(gridDim.x >> 3) : (int)gridDim.x, j0 = xo ? (int)(blockIdx.x >> 3) : (int)blockIdx.x;
    const int lim = xo ? 16 * 8 : 128 * 8;
    RegSet r0, r1;
    for (int L = j0; L < lim; L += nloc) {
        const int tm = xo ? xcd * 16 + (L & 15) : (L >> 3), tn = xo ? (L >> 4) : (L & 7);
        const int L2 = L + nloc; const bool has_next = L2 < lim;
        const int ntm = has_next ? (xo ? xcd * 16 + (L2 & 15) : (L2 >> 3)) : tm, ntn = has_next ? (xo ? (L2 >> 4) : (L2 & 7)) : tn;
        f32x4 acc[4][4];
        gemm_tile(mix, WoutT, tm, tn, L == j0, has_next, ntm, ntn, sm, acc, r0, r1);
#pragma unroll
        for (int mt = 0; mt < 4; ++mt)
#pragma unroll
            for (int nt = 0; nt < 4; ++nt) { u32x2 pk; pk.x = pack2(acc[mt][nt][0], acc[mt][nt][1]); pk.y = pack2(acc[mt][nt][2], acc[mt][nt][3]);
                const int row = wm * 64 + mt * 16 + r16; const int c16 = wn * 8 + nt * 2 + (quad >> 1);
                *(u32x2*)(sC + row * 256 + ((c16 ^ (row & 15)) << 4) + (quad & 1) * 8) = pk; }
        __syncthreads();
#pragma unroll
        for (int i = 0; i < 8; ++i) { const int c = t + 256 * i; const int row = c >> 4, ch = c & 15;
            *(u32x4*)(ybuf + (size_t)(tm * 128 + row) * 1024 + tn * 128 + ch * 8) = *(const u32x4*)(sC + row * 256 + ((ch ^ (row & 15)) << 4)); }
    }
}

constexpr float ATT_SC = 0.18033688011112042f;
template <int QT>
__device__ __forceinline__ void attn_tile(const bf16_t* sK, const bf16_t* sV, const bf16x8 (&qf)[QT][2], int lo, int hi, bool full, bool hasq, bool qfl0, bool qfl1,
                                          float (&m)[QT], float (&l)[QT], f32x4 (&O)[QT][4], int wq0) {
    const int lane = tid_opq() & 63, r16 = lane & 15, quad = lane >> 4;
    f32x4 s[QT][4];
#pragma unroll
    for (int a = 0; a < QT; ++a)
#pragma unroll
        for (int b = 0; b < 4; ++b) s[a][b] = (f32x4){0.f, 0.f, 0.f, 0.f};
#pragma unroll
    for (int ks = 0; ks < 2; ++ks)
#pragma unroll
        for (int k16 = 0; k16 < 4; ++k16) {
            const bf16x8 kf = *(const bf16x8*)(sK + (k16 * 16 + r16) * LDP + ks * 32 + quad * 8);
#pragma unroll
            for (int qt = 0; qt < QT; ++qt) s[qt][k16] = __builtin_amdgcn_mfma_f32_16x16x32_bf16(kf, qf[qt][ks], s[qt][k16], 0, 0, 0);
        }
#pragma unroll
    for (int qt = 0; qt < QT; ++qt) {
        const int ql = wq0 + qt * 16 + r16; const bool qfl = qt ? qfl1 : qfl0;
        if (!full) {
#pragma unroll
            for (int k16 = 0; k16 < 4; ++k16)
#pragma unroll
                for (int j = 0; j < 4; ++j) { const int dd = ql - (k16 * 16 + quad * 4 + j); const bool valid = dd >= lo && dd <= hi; s[qt][k16][j] = valid ? s[qt][k16][j] : -1e30f; }
        }
        if (hasq) {
#pragma unroll
            for (int k16 = 0; k16 < 4; ++k16)
#pragma unroll
                for (int j = 0; j < 4; ++j) s[qt][k16][j] = qfl ? s[qt][k16][j] : -1e30f;
        }
        float mx = -1e30f;
#pragma unroll
        for (int k16 = 0; k16 < 4; ++k16) mx = fmaxf(mx, fmaxf(fmaxf(s[qt][k16][0], s[qt][k16][1]), fmaxf(s[qt][k16][2], s[qt][k16][3])));
        mx = x32_max(x16_max(mx));
        const float mn = fmaxf(m[qt], mx); const float alpha = __builtin_amdgcn_exp2f((m[qt] - mn) * ATT_SC); m[qt] = mn;
        const float mb = (mn < -1e29f) ? 0.f : mn * ATT_SC;
        float ps = 0.f;
#pragma unroll
        for (int k16 = 0; k16 < 4; ++k16)
#pragma unroll
            for (int j = 0; j < 4; ++j) { const float pv = __builtin_amdgcn_exp2f(s[qt][k16][j] * ATT_SC - mb); ps += pv; s[qt][k16][j] = pv; }
        l[qt] = l[qt] * alpha + ps;
#pragma unroll
        for (int dt = 0; dt < 4; ++dt) O[qt][dt] = O[qt][dt] * alpha;
    }
#pragma unroll
    for (int G = 0; G < 2; ++G) {
        bf16x8 pf[QT];
#pragma unroll
        for (int qt = 0; qt < QT; ++qt) {
            const unsigned a0 = pack2(s[qt][G * 2][0], s[qt][G * 2][1]), a1 = pack2(s[qt][G * 2][2], s[qt][G * 2][3]);
            const unsigned a2 = pack2(s[qt][G * 2 + 1][0], s[qt][G * 2 + 1][1]), a3 = pack2(s[qt][G * 2 + 1][2], s[qt][G * 2 + 1][3]);
            u32x4 pk = {a0, a1, a2, a3}; pf[qt] = __builtin_bit_cast(bf16x8, pk);
        }
#pragma unroll
        for (int dt = 0; dt < 4; ++dt) {
            const bf16_t* v0p = sV + (G * 32 + quad * 4 + (r16 >> 2)) * LDP + dt * 16 + (r16 & 3) * 4;
            const bf16x4 v0 = __builtin_amdgcn_ds_read_tr16_b64_v4i16((__attribute__((address_space(3))) bf16x4*)(v0p));
            const bf16x4 v1 = __builtin_amdgcn_ds_read_tr16_b64_v4i16((__attribute__((address_space(3))) bf16x4*)(v0p + 16 * LDP));
            const bf16x8 vf = {v0[0], v0[1], v0[2], v0[3], v1[0], v1[1], v1[2], v1[3]};
#pragma unroll
            for (int qt = 0; qt < QT; ++qt) O[qt][dt] = __builtin_amdgcn_mfma_f32_16x16x32_bf16(vf, pf[qt], O[qt][dt], 0, 0, 0);
        }
    }
}

__device__ void attn_item(const Params& p, int kind, int idx, char* smem) {
    const int t = tid_opq(), lane = t & 63, w = t >> 6, r16 = lane & 15, quad = lane >> 4;
    bf16_t* sK = (bf16_t*)smem; bf16_t* sV = sK + 128 * LDP;
    const bf16_t* z = (const bf16_t*)(p.ws + WS_Z);
    (void)kind;
    const int cfg = idx >> 9; const int rem = idx & 511; const int b = rem >> 7, h = (rem >> 5) & 3; const int rb = rem & 31;
    const int dil = 1 << (2 * cfg); const int res = rb & (dil - 1), blk = rb >> (2 * cfg);
    const int qbase = b * S + blk * 128 * dil + res, stride = dil, qcol = C_CQ + h * 64, kcol = C_CK + h * 64, vcol = C_CV + h * 64;
    const int ss0 = (blk == 0) ? 1 : 0;
    bf16x8 qf[2][2];
#pragma unroll
    for (int qt = 0; qt < 2; ++qt)
#pragma unroll
        for (int ks = 0; ks < 2; ++ks) qf[qt][ks] = *(const bf16x8*)(z + (size_t)(qbase + (w * 32 + qt * 16 + r16) * stride) * ZP + qcol + ks * 32 + quad * 8);
    float m[2] = {-1e30f, -1e30f}, l[2] = {0.f, 0.f}; f32x4 O[2][4];
#pragma unroll
    for (int a = 0; a < 2; ++a)
#pragma unroll
        for (int c = 0; c < 4; ++c) O[a][c] = (f32x4){0.f, 0.f, 0.f, 0.f};
    const int lrow = t >> 1, lch = (t & 1) * 4;
    u32x4 rk[4], rv[4];
    { const bf16_t* rp = z + (size_t)(b * S + ((blk * 128 - 128 + ss0 * 128 + lrow) * dil + res)) * ZP + lch * 8;
#pragma unroll
      for (int c = 0; c < 4; ++c) { rk[c] = *(const u32x4*)(rp + kcol + c * 8); rv[c] = *(const u32x4*)(rp + vcol + c * 8); } }
    for (int ss = ss0; ss < 2; ++ss) {
        __syncthreads();
#pragma unroll
        for (int c = 0; c < 4; ++c) { *(u32x4*)(sK + lrow * LDP + (lch + c) * 8) = rk[c]; *(u32x4*)(sV + lrow * LDP + (lch + c) * 8) = rv[c]; }
        __syncthreads();
        if (ss + 1 < 2) { const bf16_t* rp = z + (size_t)(b * S + ((blk * 128 + lrow) * dil + res)) * ZP + lch * 8;
#pragma unroll
            for (int c = 0; c < 4; ++c) { rk[c] = *(const u32x4*)(rp + kcol + c * 8); rv[c] = *(const u32x4*)(rp + vcol + c * 8); } }
#pragma unroll
        for (int hf = 0; hf < 2; ++hf) {
            const int kt = ss * 2 + hf; const int lo = kt * 64 - 128, hi = kt * 64;
            const bool need = (w * 32 + 31 >= lo) && (w * 32 - 63 <= hi);
            const bool full = (w * 32 - 63 >= lo) && (w * 32 + 31 <= hi);
            if (need) attn_tile<2>(sK + hf * 64 * LDP, sV + hf * 64 * LDP, qf, lo, hi, full, false, true, true, m, l, O, w * 32);
        }
    }
    bf16_t* dilo = (bf16_t*)(p.ws + WS_DILO); float* dill = (float*)(p.ws + WS_DILL);
#pragma unroll
    for (int qt = 0; qt < 2; ++qt) {
        float lt = l[qt]; lt = x32_sum(x16_sum(lt));
        const float inv = 1.f / lt; const size_t tok = (size_t)(qbase + (w * 32 + qt * 16 + r16) * stride);
#pragma unroll
        for (int dt = 0; dt < 4; ++dt) { const int d0 = dt * 16 + quad * 4; u32x2 o; o.x = pack2(O[qt][dt][0] * inv, O[qt][dt][1] * inv); o.y = pack2(O[qt][dt][2] * inv, O[qt][dt][3] * inv);
            *(u32x2*)(dilo + ((size_t)cfg * T + tok) * 256 + h * 64 + d0) = o; }
        if (quad == 0) dill[((size_t)cfg * T + tok) * 4 + h] = m[qt] * 0.125f + __logf(lt);
    }
}

__device__ void moba_item(const Params& p, int idx, char* smem, bf16_t* outp) {
    const int t = tid_opq(), lane = t & 63, w = t >> 6, r16 = lane & 15, quad = lane >> 4;
    bf16_t* sK = (bf16_t*)smem; bf16_t* sV = sK + 64 * LDP;
    float* stO = (float*)(smem + 18432);
    float* kmean = (float*)(smem + 18432); float* gates = (float*)(smem + 22528);
    float* stM = (float*)(smem + 53248); float* stL = (float*)(smem + 53760);
    unsigned* selm = (unsigned*)(smem + 54272); unsigned char* lists = (unsigned char*)(smem + 54784);
    int* cnt = (int*)(smem + 56832); int4* desc = (int4*)(smem + 56960); int* misc = (int*)(smem + 59008);
    const bf16_t* z = (const bf16_t*)(p.ws + WS_Z);
    const int n = 15 - (idx >> 5); const int rem = idx & 31; const int b = rem >> 3, h = (rem >> 1) & 3, qh = rem & 1;
    const int qbase = b * S + n * 256 + qh * 128, qcol = C_AQ + h * 64, kcol = C_AK + h * 64, vcol = C_AV + h * 64;
    __syncthreads();
    {
        const float* kpart = (const float*)(p.ws + WS_KPART);
        for (int e = t; e < n * 64; e += 256) { const int j = e >> 6, d = e & 63; const float* kp = kpart + (size_t)(b * 64 + j * 4) * 256 + h * 64 + d;
            kmean[e] = ((kp[0] + kp[256]) + (kp[512] + kp[768])) * (1.f / 256.f); }
        if (t < 16) cnt[t] = 0;
        __syncthreads();
        {
            const int ql = t >> 1, half = t & 1; const bf16_t* qp = z + (size_t)(qbase + ql) * ZP + qcol;
            float g[8];
#pragma unroll
            for (int jj = 0; jj < 8; ++jj) g[jj] = 0.f;
#pragma unroll 1
            for (int dc = 0; dc < 8; ++dc) {
                const u32x4 qv = *(const u32x4*)(qp + dc * 8); float qq[8];
#pragma unroll
                for (int e = 0; e < 4; ++e) { qq[2 * e] = __uint_as_float(qv[e] << 16); qq[2 * e + 1] = __uint_as_float(qv[e] & 0xffff0000u); }
#pragma unroll
                for (int jj = 0; jj < 8; ++jj) { const int j = half + 2 * jj; if (j < n) { const float* km = kmean + j * 64 + dc * 8;
#pragma unroll
                    for (int e = 0; e < 8; ++e) g[jj] += qq[e] * km[e]; } }
            }
#pragma unroll
            for (int jj = 0; jj < 8; ++jj) gates[ql * 16 + half + 2 * jj] = g[jj];
        }
        __syncthreads();
        if (t < 128) {
            float gr[16];
#pragma unroll
            for (int q4 = 0; q4 < 4; ++q4) { const f32x4 g4 = *(const f32x4*)(gates + t * 16 + q4 * 4); gr[q4 * 4] = g4[0]; gr[q4 * 4 + 1] = g4[1]; gr[q4 * 4 + 2] = g4[2]; gr[q4 * 4 + 3] = g4[3]; }
            unsigned msk = 0;
#pragma unroll
            for (int k = 0; k < 3; ++k) { float best = -3.0e38f; int bi = -1;
#pragma unroll
                for (int j = 0; j < 16; ++j) { const bool ok = (j < n) && !((msk >> j) & 1u) && (gr[j] > best); best = ok ? gr[j] : best; bi = ok ? j : bi; }
                if (k < n && bi >= 0) msk |= 1u << bi; }
            selm[t] = msk;
            for (int j = 0; j < n; ++j) if ((msk >> j) & 1u) { const int pos = atomicAdd(&cnt[j], 1); lists[j * 128 + pos] = (unsigned char)t; }
        }
        __syncthreads();
        if (t < 128) { for (int j = 0; j < n; ++j) { const int cj = cnt[j]; if (t >= cj && t < ((cj + 15) & ~15)) lists[j * 128 + t] = 255; } }
        {
            const int nown_ = qh * 2 + 2;
            if (t < nown_) desc[t] = make_int4(b * S + n * 256 + t * 64, t * 64 - qh * 128, BIG, -1);
            if (t < 16) {
                int base = nown_; for (int j2 = 0; j2 < t && j2 < n; ++j2) base += ((((cnt[j2] + 15) >> 4) + 3) >> 2) * 4;
                if (t < n) { const int npass = ((((cnt[t] + 15) >> 4) + 3) >> 2);
                    for (int ps = 0; ps < npass; ++ps) for (int kt = 0; kt < 4; ++kt) desc[base + ps * 4 + kt] = make_int4(b * S + t * 256 + kt * 64, ps, kt, t); }
                if (t == 15) { misc[0] = base + ((15 < n) ? ((((cnt[15] + 15) >> 4) + 3) >> 2) * 4 : 0); misc[1] = nown_; }
            }
        }
    }
    __syncthreads();
    const int nd = misc[0], nown = misc[1];
    const int lrow = t >> 2, lch = (t & 3) * 2;
    u32x4 rk0, rk1, rv0, rv1;
    { const int4 d = desc[0]; const bf16_t* rp = z + (size_t)(d.x + lrow) * ZP + lch * 8;
      rk0 = *(const u32x4*)(rp + kcol); rk1 = *(const u32x4*)(rp + kcol + 8); rv0 = *(const u32x4*)(rp + vcol); rv1 = *(const u32x4*)(rp + vcol + 8); }
    bf16x8 nqf[2]; int ngq = 0; bool ngv = false, nhas = false;
    auto prefetch_group = [&](int gi) {
        nhas = false;
        if (gi < nd) { const int4 dg = desc[gi]; const int slot = dg.y * 4 + w; nhas = slot * 16 < cnt[dg.w];
            if (nhas) { const int qi = lists[dg.w * 128 + slot * 16 + r16]; ngv = qi != 255; ngq = ngv ? qi : 0;
#pragma unroll
                for (int ks = 0; ks < 2; ++ks) nqf[ks] = *(const bf16x8*)(z + (size_t)(qbase + ngq) * ZP + qcol + ks * 32 + quad * 8); } }
    };
    prefetch_group(nown);
    {
        bf16x8 qf[2][2];
#pragma unroll
        for (int qt = 0; qt < 2; ++qt)
#pragma unroll
            for (int ks = 0; ks < 2; ++ks) qf[qt][ks] = *(const bf16x8*)(z + (size_t)(qbase + w * 32 + qt * 16 + r16) * ZP + qcol + ks * 32 + quad * 8);
        float m[2] = {-1e30f, -1e30f}, l[2] = {0.f, 0.f}; f32x4 O[2][4];
#pragma unroll
        for (int a = 0; a < 2; ++a)
#pragma unroll
            for (int c = 0; c < 4; ++c) O[a][c] = (f32x4){0.f, 0.f, 0.f, 0.f};
        for (int i = 0; i < nown; ++i) {
            __syncthreads();
            *(u32x4*)(sK + lrow * LDP + lch * 8) = rk0; *(u32x4*)(sK + lrow * LDP + lch * 8 + 8) = rk1;
            *(u32x4*)(sV + lrow * LDP + lch * 8) = rv0; *(u32x4*)(sV + lrow * LDP + lch * 8 + 8) = rv1;
            __syncthreads();
            if (i + 1 < nd) { const int4 d = desc[i + 1]; const bf16_t* rp = z + (size_t)(d.x + lrow) * ZP + lch * 8;
                rk0 = *(const u32x4*)(rp + kcol); rk1 = *(const u32x4*)(rp + kcol + 8); rv0 = *(const u32x4*)(rp + vcol); rv1 = *(const u32x4*)(rp + vcol + 8); }
            const int4 d = desc[i];
            const bool need = (w * 32 + 31 >= d.y) && (w * 32 - 63 <= d.z);
            const bool full = (w * 32 - 63 >= d.y) && (w * 32 + 31 <= d.z);
            if (need) attn_tile<2>(sK, sV, qf, d.y, d.z, full, false, true, true, m, l, O, w * 32);
        }
#pragma unroll
        for (int qt = 0; qt < 2; ++qt) {
            float lt = l[qt]; lt = x32_sum(x16_sum(lt));
            const int ql = w * 32 + qt * 16 + r16;
            if (quad == 0) { stM[ql] = m[qt]; stL[ql] = lt; }
#pragma unroll
            for (int dt = 0; dt < 4; ++dt) *(f32x4*)(stO + ql * 68 + dt * 16 + quad * 4) = O[qt][dt];
        }
    }
    {
        bf16x8 qf[1][2]; float m[1] = {-1e30f}, l[1] = {0.f}; f32x4 O[1][4];
        int gq = 0; bool gv = false, has = false;
        for (int i = nown; i < nd; ++i) {
            __syncthreads();
            *(u32x4*)(sK + lrow * LDP + lch * 8) = rk0; *(u32x4*)(sK + lrow * LDP + lch * 8 + 8) = rk1;
            *(u32x4*)(sV + lrow * LDP + lch * 8) = rv0; *(u32x4*)(sV + lrow * LDP + lch * 8 + 8) = rv1;
            __syncthreads();
            if (i + 1 < nd) { const int4 d = desc[i + 1]; const bf16_t* rp = z + (size_t)(d.x + lrow) * ZP + lch * 8;
                rk0 = *(const u32x4*)(rp + kcol); rk1 = *(const u32x4*)(rp + kcol + 8); rv0 = *(const u32x4*)(rp + vcol); rv1 = *(const u32x4*)(rp + vcol + 8); }
            const int4 d = desc[i];
            if (d.z == 0) {
                has = nhas; gv = ngv; gq = ngq; qf[0][0] = nqf[0]; qf[0][1] = nqf[1];
                m[0] = -1e30f; l[0] = 0.f;
#pragma unroll
                for (int c = 0; c < 4; ++c) O[0][c] = (f32x4){0.f, 0.f, 0.f, 0.f};
                prefetch_group(i + 4);
            }
            if (has) {
                attn_tile<1>(sK, sV, qf, -BIG, BIG, true, false, true, true, m, l, O, 0);
                if (d.z == 3) {
                    float lt = l[0]; lt = x32_sum(x16_sum(lt));
                    if (gv) {
                        const float mo = stM[gq], lo_ = stL[gq]; const float mn = fmaxf(mo, m[0]);
                        const float fa = __builtin_amdgcn_exp2f((mo - mn) * ATT_SC), fb = __builtin_amdgcn_exp2f((m[0] - mn) * ATT_SC);
#pragma unroll
                        for (int dt = 0; dt < 4; ++dt) { float* sp = stO + gq * 68 + dt * 16 + quad * 4; const f32x4 so = *(const f32x4*)sp; *(f32x4*)sp = so * fa + O[0][dt] * fb; }
                        if (quad == 0) { stM[gq] = mn; stL[gq] = lo_ * fa + lt * fb; }
                    }
                }
            }
        }
    }
    __syncthreads();
#pragma unroll
    for (int qt = 0; qt < 2; ++qt) {
        const int ql = w * 32 + qt * 16 + r16; const float inv = 1.f / stL[ql]; const size_t tok = (size_t)(qbase + ql);
#pragma unroll
        for (int dt = 0; dt < 4; ++dt) { const int d0 = dt * 16 + quad * 4; const f32x4 ov = *(const f32x4*)(stO + ql * 68 + d0);
            const u32x2 gvv = *(const u32x2*)(z + tok * ZP + C_AG + h * 64 + d0);
            const float g0 = __uint_as_float(gvv.x << 16), g1 = __uint_as_float(gvv.x & 0xffff0000u), g2 = __uint_as_float(gvv.y << 16), g3 = __uint_as_float(gvv.y & 0xffff0000u);
            u32x2 o; o.x = pack2(ov[0] * inv * silu_f(g0), ov[1] * inv * silu_f(g1)); o.y = pack2(ov[2] * inv * silu_f(g2), ov[3] * inv * silu_f(g3));
            *(u32x2*)(outp + tok * 1024 + h * 64 + d0) = o; }
    }
}

__device__ __forceinline__ void gla_bcum(const Params& p, int l, const bf16_t* z, int tok0, float* bc, float* drs) {
    const int t = tid_opq();
    const int hd = t & 127, ih = t >> 7;
    float wr[16];
#pragma unroll
    for (int r = 0; r < 16; ++r) wr[r] = p.gla_wr[l * 2048 + r * 128 + hd];
    const float br = p.gla_br[l * 128 + hd];
    { const int e0 = t, e1 = t + 256; const bf16_t d0 = z[(size_t)(tok0 + (e0 >> 4)) * ZP + C_DR + (e0 & 15)], d1 = z[(size_t)(tok0 + (e1 >> 4)) * ZP + C_DR + (e1 & 15)];
      drs[e0] = bf2f(d0); drs[e1] = bf2f(d1); }
    __syncthreads();
#pragma unroll
    for (int ii = 0; ii < 16; ++ii) { const int i = ih * 16 + ii; float x = br;
#pragma unroll
        for (int r4 = 0; r4 < 4; ++r4) { const f32x4 dv = *(const f32x4*)(drs + i * 16 + r4 * 4); x += (dv[0] * wr[r4 * 4] + dv[1] * wr[r4 * 4 + 1]) + (dv[2] * wr[r4 * 4 + 2] + dv[3] * wr[r4 * 4 + 3]); }
        bc[i * 128 + hd] = (fminf(x, 0.f) - __logf(1.f + __expf(-fabsf(x)))) * (1.f / 16.f); }
    __syncthreads();
    if (t < 128) { float sacc = 0.f;
#pragma unroll
        for (int i = 0; i < 32; ++i) { sacc += bc[i * 128 + t]; bc[i * 128 + t] = sacc; } }
    __syncthreads();
}

__device__ void gla1_item(const Params& p, int l, int idx, char* smem) {
    const int t = tid_opq(), lane = t & 63, w = t >> 6, r16 = lane & 15, quad = lane >> 4;
    const int b = idx >> 7, c = idx & 127; const int tok0 = b * S + c * 32;
    const bf16_t* z = (const bf16_t*)(p.ws + WS_Z);
    float* bc = (float*)smem; float* drs = (float*)(smem + 16384);
    bf16_t* kdT = (bf16_t*)(smem + 18432) + w * 1024;
    bf16_t* vL = (bf16_t*)(smem + 26624) + w * (32 * LDP);
    float* gkv = (float*)(p.ws + WS_GKV); float* gdec = (float*)(p.ws + WS_GDEC);
    bf16_t kraw[16]; u32x4 vr[4];
#pragma unroll
    for (int i = 0; i < 16; ++i) { const int e = lane + 64 * i; kraw[i] = z[(size_t)(tok0 + (e >> 5)) * ZP + C_DK + w * 32 + (e & 31)]; }
#pragma unroll
    for (int i = 0; i < 4; ++i) { const int cc = lane + 64 * i; vr[i] = *(const u32x4*)(z + (size_t)(tok0 + (cc >> 3)) * ZP + C_DV + w * 64 + (cc & 7) * 8); }
    __syncthreads();
#pragma unroll
    for (int i = 0; i < 4; ++i) { const int cc = lane + 64 * i; *(u32x4*)(vL + (cc >> 3) * LDP + (cc & 7) * 8) = vr[i]; }
    gla_bcum(p, l, z, tok0, bc, drs);
    { float* bcg = (float*)(p.ws + WS_BC) + (size_t)idx * 4096;
#pragma unroll
      for (int i = 0; i < 4; ++i) *(f32x4*)(bcg + (t + 256 * i) * 4) = *(const f32x4*)(bc + (t + 256 * i) * 4); }
#pragma unroll
    for (int i = 0; i < 16; ++i) { const int e = lane + 64 * i; const int j = e >> 5, d = e & 31;
        kdT[d * 32 + j] = f2bf(bf2f(kraw[i]) * __expf(bc[31 * 128 + w * 32 + d] - bc[j * 128 + w * 32 + d])); }
    const int bh = b * 4 + w;
    if (lane < 32) gdec[(bh * 128 + c) * 32 + lane] = __expf(bc[31 * 128 + w * 32 + lane]);
    __syncthreads();
    bf16x8 kf[2];
#pragma unroll
    for (int x = 0; x < 2; ++x) kf[x] = *(const bf16x8*)(kdT + (x * 16 + r16) * 32 + quad * 8);
    float* dst = gkv + (size_t)(bh * 128 + c) * 2048;
#pragma unroll
    for (int dt = 0; dt < 4; ++dt) {
        const bf16_t* v0p = vL + (quad * 8 + (r16 >> 2)) * LDP + dt * 16 + (r16 & 3) * 4;
        const bf16x4 v0 = __builtin_amdgcn_ds_read_tr16_b64_v4i16((__attribute__((address_space(3))) bf16x4*)(v0p));
        const bf16x4 v1 = __builtin_amdgcn_ds_read_tr16_b64_v4i16((__attribute__((address_space(3))) bf16x4*)(v0p + 4 * LDP));
        const bf16x8 vf = {v0[0], v0[1], v0[2], v0[3], v1[0], v1[1], v1[2], v1[3]};
#pragma unroll
        for (int x = 0; x < 2; ++x) {
            const f32x4 r = __builtin_amdgcn_mfma_f32_16x16x32_bf16(vf, kf[x], (f32x4){0.f, 0.f, 0.f, 0.f}, 0, 0, 0);
            *(f32x4*)(dst + (x * 16 + r16) * 64 + dt * 16 + quad * 4) = r;
        }
    }
}

#define OPQ(ptr) asm volatile("" : "+v"(ptr))
__device__ void gla3_item(const Params& p, int l, int idx, char* smem) {
    const int t = tid_opq(), lane = t & 63, w = t >> 6, r16 = lane & 15, quad = lane >> 4;
    const int b = idx >> 7, c = idx & 127; const int tok0 = b * S + c * 32;
    const bf16_t* z = (const bf16_t*)(p.ws + WS_Z); bf16_t* mix = (bf16_t*)(p.ws + WS_U);
    float* bc = (float*)smem; float* drs = (float*)(smem + 16384);
    bf16_t* SL = (bf16_t*)smem + w * (32 * LDP);
    bf16_t* qe = (bf16_t*)(smem + 18432) + w * 1024;
    bf16_t* ke = (bf16_t*)(smem + 26624) + w * 1024;
    bf16_t* vL = (bf16_t*)(smem + 34816) + w * (32 * LDP);
    const float* gkv = (const float*)(p.ws + WS_GKV);
    const int bh = b * 4 + w;
    bf16_t qraw[16], kraw[16];
    { const bf16_t* qp = z + (size_t)(tok0 + (lane >> 5)) * ZP + w * 32 + (lane & 31);
#pragma unroll
      for (int i = 0; i < 16; ++i) { qraw[i] = qp[C_DQ]; kraw[i] = qp[C_DK]; qp += 2 * ZP; OPQ(qp); } }
    u32x4 vr[4]; f32x4 sr[8];
#pragma unroll
    for (int i = 0; i < 4; ++i) { const int cc = lane + 64 * i; vr[i] = *(const u32x4*)(z + (size_t)(tok0 + (cc >> 3)) * ZP + C_DV + w * 64 + (cc & 7) * 8); }
    { const float* Sp = gkv + (size_t)(bh * 128 + c) * 2048;
#pragma unroll
      for (int i = 0; i < 8; ++i) sr[i] = __builtin_nontemporal_load((const f32x4*)(Sp + (lane + 64 * i) * 4)); }
    f32x4 bcr[4];
    { const float* bcg = (const float*)(p.ws + WS_BC) + (size_t)idx * 4096;
#pragma unroll
      for (int i = 0; i < 4; ++i) bcr[i] = __builtin_nontemporal_load((const f32x4*)(bcg + (t + 256 * i) * 4)); }
    __syncthreads();
#pragma unroll
    for (int i = 0; i < 4; ++i) { const int cc = lane + 64 * i; *(u32x4*)(vL + (cc >> 3) * LDP + (cc & 7) * 8) = vr[i]; }
#pragma unroll
    for (int i = 0; i < 4; ++i) *(f32x4*)(bc + (t + 256 * i) * 4) = bcr[i];
    __syncthreads();
#pragma unroll
    for (int i2 = 0; i2 < 16; ++i2) { const int e = lane + 64 * i2; const int i = e >> 5, d = e & 31; const float bcv = bc[i * 128 + w * 32 + d];
        qe[i * 32 + d] = f2bf(bf2f(qraw[i2]) * __expf(bcv) * 0.17677669529663687f); ke[i * 32 + d] = f2bf(bf2f(kraw[i2]) * __expf(-bcv)); }
    __syncthreads();
#pragma unroll
    for (int i = 0; i < 8; ++i) { const int cc = lane + 64 * i; const int d = cc >> 4, v4 = cc & 15; u32x2 pk; pk.x = pack2(sr[i][0], sr[i][1]); pk.y = pack2(sr[i][2], sr[i][3]);
        *(u32x2*)(SL + d * LDP + v4 * 4) = pk; }
    __syncthreads();
    bf16x8 qf[2], kf[2];
#pragma unroll
    for (int x = 0; x < 2; ++x) { qf[x] = *(const bf16x8*)(qe + (x * 16 + r16) * 32 + quad * 8); kf[x] = *(const bf16x8*)(ke + (x * 16 + r16) * 32 + quad * 8); }
    bf16x8 pf[2];
#pragma unroll
    for (int it = 0; it < 2; ++it) {
        f32x4 at[2];
#pragma unroll
        for (int jt = 0; jt < 2; ++jt) { at[jt] = __builtin_amdgcn_mfma_f32_16x16x32_bf16(kf[jt], qf[it], (f32x4){0.f, 0.f, 0.f, 0.f}, 0, 0, 0);
#pragma unroll
            for (int jj = 0; jj < 4; ++jj) at[jt][jj] = (jt * 16 + quad * 4 + jj <= it * 16 + r16) ? at[jt][jj] : 0.f; }
        u32x4 pk = {pack2(at[0][0], at[0][1]), pack2(at[0][2], at[0][3]), pack2(at[1][0], at[1][1]), pack2(at[1][2], at[1][3])};
        pf[it] = __builtin_bit_cast(bf16x8, pk);
    }
    f32x4 O[2][4];
#pragma unroll
    for (int dt = 0; dt < 4; ++dt) {
        const bf16_t* v0p = vL + (quad * 4 + (r16 >> 2)) * LDP + dt * 16 + (r16 & 3) * 4;
        const bf16x4 v0 = __builtin_amdgcn_ds_read_tr16_b64_v4i16((__attribute__((address_space(3))) bf16x4*)(v0p));
        const bf16x4 v1 = __builtin_amdgcn_ds_read_tr16_b64_v4i16((__attribute__((address_space(3))) bf16x4*)(v0p + 16 * LDP));
        const bf16x8 vf = {v0[0], v0[1], v0[2], v0[3], v1[0], v1[1], v1[2], v1[3]};
        const bf16_t* s0p = SL + (quad * 8 + (r16 >> 2)) * LDP + dt * 16 + (r16 & 3) * 4;
        const bf16x4 s0 = __builtin_amdgcn_ds_read_tr16_b64_v4i16((__attribute__((address_space(3))) bf16x4*)(s0p));
        const bf16x4 s1 = __builtin_amdgcn_ds_read_tr16_b64_v4i16((__attribute__((address_space(3))) bf16x4*)(s0p + 4 * LDP));
        const bf16x8 sf = {s0[0], s0[1], s0[2], s0[3], s1[0], s1[1], s1[2], s1[3]};
#pragma unroll
        for (int it = 0; it < 2; ++it) {
            O[it][dt] = __builtin_amdgcn_mfma_f32_16x16x32_bf16(vf, pf[it], (f32x4){0.f, 0.f, 0.f, 0.f}, 0, 0, 0);
            O[it][dt] = __builtin_amdgcn_mfma_f32_16x16x32_bf16(sf, qf[it], O[it][dt], 0, 0, 0);
        }
    }
#pragma unroll
    for (int it = 0; it < 2; ++it) {
        float ss = 0.f;
#pragma unroll
        for (int dt = 0; dt < 4; ++dt) ss += (O[it][dt][0] * O[it][dt][0] + O[it][dt][1] * O[it][dt][1]) + (O[it][dt][2] * O[it][dt][2] + O[it][dt][3] * O[it][dt][3]);
        ss = x32_sum(x16_sum(ss));
        const float rn = rsqrtf(ss * (1.f / 64.f) + 1e-5f);
        const size_t tok = (size_t)(tok0 + it * 16 + r16);
#pragma unroll
        for (int dt = 0; dt < 4; ++dt) { const int v0i = dt * 16 + quad * 4; const f32x4 gn = *(const f32x4*)(p.gla_gn + l * 64 + v0i);
            const u32x2 gv = *(const u32x2*)(z + tok * ZP + C_DG + w * 64 + v0i);
            const float g0 = __uint_as_float(gv.x << 16), g1 = __uint_as_float(gv.x & 0xffff0000u), g2 = __uint_as_float(gv.y << 16), g3 = __uint_as_float(gv.y & 0xffff0000u);
            u32x2 o; o.x = pack2(O[it][dt][0] * rn * gn[0] * silu_f(g0), O[it][dt][1] * rn * gn[1] * silu_f(g1));
            o.y = pack2(O[it][dt][2] * rn * gn[2] * silu_f(g2), O[it][dt][3] * rn * gn[3] * silu_f(g3));
            *(u32x2*)(mix + tok * 1024 + 768 + w * 64 + v0i) = o; }
    }
}

__device__ void lru1_item(const Params& p, int l, int idx, char* smem) {
    const int t = tid_opq(), lane = t & 63, g = t >> 6, r16 = lane & 15, quad = lane >> 4; const int ch = t;
    const int b = idx >> 7, c = idx & 127; const int s0 = c * 32; const int tok0 = b * S + s0;
    const bf16_t* z = (const bf16_t*)(p.ws + WS_Z); float* xcs = (float*)smem;
    bf16_t* preA = (bf16_t*)(smem + 32768); bf16_t* preX = (bf16_t*)(smem + 49152);
    float* lh = (float*)(p.ws + WS_LH); float* lp = (float*)(p.ws + WS_LP);
    bf16_t xr[35];
#pragma unroll
    for (int i = 0; i < 35; ++i) { const int sidx = s0 + i - 3; xr[i] = (sidx >= 0) ? z[(size_t)(tok0 + i - 3) * ZP + C_BX + ch] : (bf16_t)0; }
    const float cw0 = p.conv_w[l * 1024 + ch], cw1 = p.conv_w[l * 1024 + 256 + ch], cw2 = p.conv_w[l * 1024 + 512 + ch], cw3 = p.conv_w[l * 1024 + 768 + ch];
    const float cb = p.conv_b[l * 256 + ch];
    const bf16_t* lwt = (const bf16_t*)(p.ws + WS_LWT) + (size_t)l * 32768 + g * 4096;
    bf16x8 wfa[4][2], wfx[4][2];
#pragma unroll
    for (int nt = 0; nt < 4; ++nt)
#pragma unroll
        for (int ks = 0; ks < 2; ++ks) { wfa[nt][ks] = *(const bf16x8*)(lwt + (nt * 16 + r16) * 64 + ks * 32 + quad * 8); wfx[nt][ks] = *(const bf16x8*)(lwt + 16384 + (nt * 16 + r16) * 64 + ks * 32 + quad * 8); }
    __syncthreads();
#pragma unroll
    for (int i = 0; i < 32; ++i) xcs[i * 256 + ch] = cb + (cw0 * bf2f(xr[i]) + cw1 * bf2f(xr[i + 1])) + (cw2 * bf2f(xr[i + 2]) + cw3 * bf2f(xr[i + 3]));
    __syncthreads();
#pragma unroll
    for (int tt = 0; tt < 2; ++tt) {
        bf16x8 xf[2];
#pragma unroll
        for (int ks = 0; ks < 2; ++ks) { const float* xp = xcs + (tt * 16 + r16) * 256 + g * 64 + ks * 32 + quad * 8; const f32x4 x0 = *(const f32x4*)xp, x1 = *(const f32x4*)(xp + 4);
            u32x4 pk = {pack2(x0[0], x0[1]), pack2(x0[2], x0[3]), pack2(x1[0], x1[1]), pack2(x1[2], x1[3])}; xf[ks] = __builtin_bit_cast(bf16x8, pk); }
#pragma unroll
        for (int nt = 0; nt < 4; ++nt) {
            f32x4 ra = __builtin_amdgcn_mfma_f32_16x16x32_bf16(wfa[nt][0], xf[0], (f32x4){0.f, 0.f, 0.f, 0.f}, 0, 0, 0); ra = __builtin_amdgcn_mfma_f32_16x16x32_bf16(wfa[nt][1], xf[1], ra, 0, 0, 0);
            f32x4 rx = __builtin_amdgcn_mfma_f32_16x16x32_bf16(wfx[nt][0], xf[0], (f32x4){0.f, 0.f, 0.f, 0.f}, 0, 0, 0); rx = __builtin_amdgcn_mfma_f32_16x16x32_bf16(wfx[nt][1], xf[1], rx, 0, 0, 0);
            u32x2 pa; pa.x = pack2(ra[0], ra[1]); pa.y = pack2(ra[2], ra[3]); u32x2 px; px.x = pack2(rx[0], rx[1]); px.y = pack2(rx[2], rx[3]);
            *(u32x2*)(preA + (tt * 16 + r16) * 256 + g * 64 + nt * 16 + quad * 4) = pa; *(u32x2*)(preX + (tt * 16 + r16) * 256 + g * 64 + nt * 16 + quad * 4) = px;
        }
    }
    __syncthreads();
    const float ba = p.lru_ba[l * 256 + ch], bx = p.lru_bx[l * 256 + ch], lam = p.lru_lam[l * 256 + ch];
    const float sp = fmaxf(-lam, 0.f) + log1pf(__expf(-fabsf(lam)));
    float hh = 0.f, P = 1.f;
    float* lhp = lh + (size_t)tok0 * 256 + ch; float* lpp = lp + (size_t)tok0 * 256 + ch;
#pragma unroll 8
    for (int i = 0; i < 32; ++i) { const float r = sigmoid_f(bf2f(preA[i * 256 + ch]) + ba), ig = sigmoid_f(bf2f(preX[i * 256 + ch]) + bx); const float la = -8.f * r * sp; const float a = __expf(la);
        const float w2 = 2.f * la;
        const float em_s = -w2 * (1.f + w2 * (0.5f + w2 * (0.16666667f + w2 * (0.041666668f + w2 * (0.0083333338f + w2 * 0.0013888889f)))));
        const float em = (w2 > -0.25f) ? em_s : (1.f - a * a);
        const float u = __builtin_amdgcn_sqrtf(em) * (ig * xcs[i * 256 + ch]); hh = a * hh + u; P *= a;
        lhp[(size_t)i * 256] = hh; lpp[(size_t)i * 256] = P; }
}

__device__ void lru3_item(const Params& p, int idx) {
    const int ch = tid_opq(); const int b = idx >> 7, c = idx & 127; const int tok0 = b * S + c * 32;
    const bf16_t* z = (const bf16_t*)(p.ws + WS_Z); bf16_t* mix = (bf16_t*)(p.ws + WS_U);
    const float* lh = (const float*)(p.ws + WS_LH); const float* lp = (const float*)(p.ws + WS_LP); const float* lc = (const float*)(p.ws + WS_LC);
    const float carry = lc[(size_t)(b * 128 + c) * 256 + ch];
    float hv[32], pv[32]; bf16_t gv[32];
#pragma unroll
    for (int i = 0; i < 32; ++i) { const size_t tok = (size_t)(tok0 + i); hv[i] = __builtin_nontemporal_load(lh + tok * 256 + ch); pv[i] = __builtin_nontemporal_load(lp + tok * 256 + ch); gv[i] = z[tok * ZP + C_BG + ch]; }
#pragma unroll
    for (int i = 0; i < 32; ++i) { const size_t tok = (size_t)(tok0 + i); mix[tok * 1024 + 256 + ch] = f2bf((hv[i] + pv[i] * carry) * silu_f(bf2f(gv[i]))); }
}

__device__ void dilc_item(const Params& p, int idx) {
    const int t = tid_opq(); const size_t tok = (size_t)idx * 8 + (t >> 5); const int chn = t & 31; const int h = chn >> 3;
    const bf16_t* z = (const bf16_t*)(p.ws + WS_Z); bf16_t* mix = (bf16_t*)(p.ws + WS_U);
    const bf16_t* dilo = (const bf16_t*)(p.ws + WS_DILO); const float* dill = (const float*)(p.ws + WS_DILL);
    const float l0 = dill[((size_t)0 * T + tok) * 4 + h], l1 = dill[((size_t)1 * T + tok) * 4 + h], l2 = dill[((size_t)2 * T + tok) * 4 + h];
    const float mx = fmaxf(l0, fmaxf(l1, l2)); float w0 = __expf(l0 - mx), w1 = __expf(l1 - mx), w2 = __expf(l2 - mx); const float inv = 1.f / (w0 + w1 + w2); w0 *= inv; w1 *= inv; w2 *= inv;
    const u32x4 o0 = __builtin_nontemporal_load((const u32x4*)(dilo + ((size_t)0 * T + tok) * 256 + chn * 8)), o1 = __builtin_nontemporal_load((const u32x4*)(dilo + ((size_t)1 * T + tok) * 256 + chn * 8)), o2 = __builtin_nontemporal_load((const u32x4*)(dilo + ((size_t)2 * T + tok) * 256 + chn * 8));
    const u32x4 gv = *(const u32x4*)(z + tok * ZP + C_CG + chn * 8);
    u32x4 r;
#pragma unroll
    for (int e = 0; e < 4; ++e) {
        const float a = w0 * __uint_as_float(o0[e] << 16) + w1 * __uint_as_float(o1[e] << 16) + w2 * __uint_as_float(o2[e] << 16);
        const float bq = w0 * __uint_as_float(o0[e] & 0xffff0000u) + w1 * __uint_as_float(o1[e] & 0xffff0000u) + w2 * __uint_as_float(o2[e] & 0xffff0000u);
        r[e] = pack2(a * silu_f(__uint_as_float(gv[e] << 16)), bq * silu_f(__uint_as_float(gv[e] & 0xffff0000u)));
    }
    *(u32x4*)(mix + tok * 1024 + 512 + chn * 8) = r;
}

__device__ void m2_phase(const Params& p, char* smem) {
    float* gkv = (float*)(p.ws + WS_GKV); const float* gdec = (const float*)(p.ws + WS_GDEC);
    const float* lh = (const float*)(p.ws + WS_LH); const float* lp = (const float*)(p.ws + WS_LP); float* lc = (float*)(p.ws + WS_LC);
    float* aggP = (float*)smem; float* aggS = aggP + 256;
    const int t = tid_opq(); const int e = t & 31, seg = t >> 5;
    for (int it = blockIdx.x; it < 1024 + 32; it += gridDim.x) {
        float a[16], x[16];
        size_t ostride;
        float* outp;
        if (it < 1024) {
            const int gid = it * 32 + e; const int bh = gid >> 11, dv = gid & 2047, d = dv >> 6;
            float* base = gkv + (size_t)bh * 128 * 2048 + dv + (size_t)(seg * 16) * 2048; const float* dc = gdec + (size_t)bh * 128 * 32 + d + (seg * 16) * 32;
#pragma unroll
            for (int k = 0; k < 16; ++k) { x[k] = base[(size_t)k * 2048]; a[k] = dc[k * 32]; }
            outp = base; ostride = 2048;
        } else {
            const int i2 = it - 1024; const int b = i2 >> 3, ch = (i2 & 7) * 32 + e;
#pragma unroll
            for (int k = 0; k < 16; ++k) { const size_t ix = (size_t)(b * S + (seg * 16 + k) * 32 + 31) * 256 + ch; a[k] = lp[ix]; x[k] = lh[ix]; }
            outp = lc + (size_t)(b * 128 + seg * 16) * 256 + ch; ostride = 256;
        }
        float st = 0.f, pr = 1.f;
#pragma unroll
        for (int k = 0; k < 16; ++k) { const float ak = a[k], xk = x[k]; a[k] = pr; x[k] = st; st = ak * st + xk; pr *= ak; }
        __syncthreads();
        aggP[seg * 32 + e] = pr; aggS[seg * 32 + e] = st;
        __syncthreads();
        float carry = 0.f;
        for (int s2 = 0; s2 < seg; ++s2) carry = aggP[s2 * 32 + e] * carry + aggS[s2 * 32 + e];
#pragma unroll
        for (int k = 0; k < 16; ++k) outp[(size_t)k * ostride] = x[k] + a[k] * carry;
    }
}

__global__ void __launch_bounds__(256, 2) fwd_megakernel(Params p) {
    __shared__ __attribute__((aligned(16))) char smem[SMEM_BYTES];
    __shared__ uint4 xb_words;
    __shared__ int s_slot;
    cg::grid_group grid = cg::this_grid();
    if (p.out == nullptr) grid.sync();
    if (threadIdx.x == 0) xb_words = make_uint4(0u, 0u, 0u, 0u);
    __syncthreads();
    const XcdBarrier xb = xcd_barrier_post((unsigned*)(p.ws + WS_CTL), (volatile LAS unsigned*)&xb_words);
    unsigned* cnt = (unsigned*)(p.ws + WS_CNT);
    prologue_phase(p, smem);
    xcd_barrier(xb);
#pragma unroll 1
    for (int l = 0; l < DEPTH; ++l) {
        ln_phase(p, l);
        xcd_barrier(xb);
        g1_phase(p, l, smem);
        xcd_barrier(xb);
        for (;;) { const int it = next_item(cnt + (4 + l) * 64, &s_slot); if (it >= 512) break; lru1_item(p, l, it, smem); }
        { const int xq = blockIdx.x & 7;
          for (;;) { const int li = next_item(cnt + (16 + l * 8 + xq) * 64, &s_slot); if (li >= 64) break;
              const int pr = xq * 2 + ((li >> 1) & 1); moba_item(p, (li >> 2) * 32 + (pr >> 2) * 8 + (pr & 3) * 2 + (li & 1), smem, (bf16_t*)(p.ws + WS_U)); }
          for (;;) { const int li = next_item(cnt + (32 + l * 8 + xq) * 64, &s_slot); if (li >= 192) break;
              const int cfg = li >> 6, r6 = li & 63; const int pr = xq * 2 + (r6 >> 5); attn_item(p, 1, cfg * 512 + (pr >> 2) * 128 + (pr & 3) * 32 + (r6 & 31), smem); } }
        for (;;) { const int it = next_item(cnt + (2 + l) * 64, &s_slot); if (it >= 512) break; gla1_item(p, l, it, smem); }
        xcd_barrier(xb);
        m2_phase(p, smem);
        xcd_barrier(xb);
        for (int it = blockIdx.x; it < 512; it += gridDim.x) gla3_item(p, l, it, smem);
        for (int it = blockIdx.x; it < 512; it += gridDim.x) lru3_item(p, it);
        for (int it = blockIdx.x; it < 2048; it += gridDim.x) dilc_item(p, it);
        xcd_barrier(xb);
        g2_phase(p, l, smem);
        xcd_barrier(xb);
    }
    ln_phase(p, DEPTH);
}

extern "C" void kernel_launch(void* const* d_in, const int* in_sizes, int n_in, void* d_out, int out_size, void* d_ws, size_t ws_size, hipStream_t stream) {
    static int grid_blocks = 0;
    if (!grid_blocks) {
        int dev = 0, cus = 0, per_cu = 0;
        hipGetDevice(&dev);
        hipDeviceGetAttribute(&cus, hipDeviceAttributeMultiprocessorCount, dev);
        hipOccupancyMaxActiveBlocksPerMultiprocessor(&per_cu, (const void*)fwd_megakernel, 256, 0);
        if (per_cu < 1) per_cu = 1;
        if (per_cu > 2) per_cu = 2;
        grid_blocks = cus * per_cu;
        if (ws_size < WS_END) fprintf(stderr, "kernel_launch: workspace too small: %zu < %zu\n", ws_size, (size_t)WS_END);
    }
    Params p{};
    p.x = (const float*)d_in[0]; p.c = (const float*)d_in[1]; p.pos = (const int*)d_in[2];
    p.w_mod = (const float*)d_in[3]; p.b_mod = (const float*)d_in[4]; p.w_in = (const float*)d_in[5];
    p.conv_w = (const float*)d_in[6]; p.conv_b = (const float*)d_in[7]; p.lru_wa = (const float*)d_in[8]; p.lru_ba = (const float*)d_in[9];
    p.lru_wx = (const float*)d_in[10]; p.lru_bx = (const float*)d_in[11]; p.lru_lam = (const float*)d_in[12];
    p.gla_wr = (const float*)d_in[13]; p.gla_br = (const float*)d_in[14]; p.gla_gn = (const float*)d_in[15];
    p.w_out = (const float*)d_in[16]; p.ln_g = (const float*)d_in[17]; p.ln_b = (const float*)d_in[18];
    p.out = (float*)d_out; p.ws = (unsigned char*)d_ws;
    (void)hipMemsetAsync(d_ws, 0, 32768, stream);
    void* args[] = {&p};
    hipError_t e = hipLaunchCooperativeKernel((const void*)fwd_megakernel, dim3(grid_blocks), dim3(256), args, 0, stream);
    if (e != hipSuccess) fprintf(stderr, "cooperative launch failed: %s (grid %d)\n", hipGetErrorString(e), grid_blocks);
}
```

```cpp
#include <hip/hip_runtime.h>
#include <hip/hip_cooperative_groups.h>
#include <cstdio>
#include <cstdint>
#include <type_traits>
namespace cg = cooperative_groups;

typedef unsigned short bf16_t;
typedef short bf16x8 __attribute__((ext_vector_type(8)));
typedef short bf16x4 __attribute__((ext_vector_type(4)));
typedef float f32x4 __attribute__((ext_vector_type(4)));
typedef unsigned u32x4 __attribute__((ext_vector_type(4)));
typedef unsigned u32x2 __attribute__((ext_vector_type(2)));

constexpr int D = 1024, NB = 4, S = 4096, T = NB * S, DEPTH = 2;
constexpr int DIN = 3344, ZP = 3392, NPAD = 3456;
constexpr int C_AQ = 0, C_AK = 256, C_AV = 512, C_AG = 768, C_BX = 1024, C_BG = 1280, C_CQ = 1536, C_CK = 1792,
              C_CV = 2048, C_CG = 2304, C_DQ = 2560, C_DK = 2688, C_DV = 2816, C_DG = 3072, C_DR = 3328;
constexpr float DN_ALPHA = 1.4142135623730951f;
constexpr int LDP = 72;
constexpr int SMEM_BYTES = 65536;
constexpr int BIG = 1000000;

constexpr size_t WS_CTL = 0;
constexpr size_t WS_CNT = 16384;
constexpr size_t WS_WINT = 32768;
constexpr size_t WS_WOUTT = WS_WINT + (size_t)DEPTH * NPAD * 1024 * 2;
constexpr size_t WS_MOD = WS_WOUTT + (size_t)DEPTH * 1024 * 1024 * 2;
constexpr size_t WS_COS = WS_MOD + (size_t)DEPTH * NB * 3072 * 4;
constexpr size_t WS_SIN = WS_COS + (size_t)T * 32 * 4;
constexpr size_t WS_U = WS_SIN + (size_t)T * 32 * 4;
constexpr size_t WS_Z = WS_U + (size_t)T * 1024 * 2;
constexpr size_t WS_KPART = WS_Z + (size_t)T * ZP * 2;
constexpr size_t WS_DILO = WS_KPART + (size_t)256 * 256 * 4;
constexpr size_t WS_DILL = WS_DILO + (size_t)3 * T * 256 * 2;
constexpr size_t WS_GKV = WS_DILL + (size_t)3 * T * 4 * 4;
constexpr size_t WS_GDEC = WS_GKV + (size_t)2048 * 2048 * 4;
constexpr size_t WS_LH = WS_GDEC + (size_t)2048 * 32 * 4;
constexpr size_t WS_LP = WS_LH + (size_t)T * 256 * 4;
constexpr size_t WS_LC = WS_LP + (size_t)T * 256 * 4;
constexpr size_t WS_LWT = WS_LC + (size_t)NB * 128 * 256 * 4;
constexpr size_t WS_BC = WS_LWT + (size_t)DEPTH * 2 * 4 * 64 * 64 * 2;
constexpr size_t WS_END = WS_BC + (size_t)512 * 32 * 128 * 4;

struct Params {
    const float *x, *c; const int* pos;
    const float *w_mod, *b_mod, *w_in, *conv_w, *conv_b, *lru_wa, *lru_ba, *lru_wx, *lru_bx, *lru_lam, *gla_wr, *gla_br, *gla_gn, *w_out, *ln_g, *ln_b;
    float* out; unsigned char* ws;
};

__device__ __forceinline__ float bf2f(bf16_t h) { return __uint_as_float(((unsigned)h) << 16); }
typedef __bf16 hbf16x2 __attribute__((ext_vector_type(2)));
typedef float f32x2 __attribute__((ext_vector_type(2)));
__device__ __forceinline__ unsigned pack2(float a, float b) { f32x2 v = {a, b}; hbf16x2 r = __builtin_convertvector(v, hbf16x2); return __builtin_bit_cast(unsigned, r); }
__device__ __forceinline__ bf16_t f2bf(float f) { return (bf16_t)(pack2(f, 0.f) & 0xffffu); }
__device__ __forceinline__ float silu_f(float x) { return x / (1.f + __expf(-x)); }
__device__ __forceinline__ float sigmoid_f(float x) { return 1.f / (1.f + __expf(-x)); }
__device__ __forceinline__ int tid_opq() { int t = threadIdx.x; asm volatile("" : "+v"(t)); return t; }
__device__ __forceinline__ float x16_sum(float v) { auto r = __builtin_amdgcn_permlane16_swap(__float_as_uint(v), __float_as_uint(v), false, false); return __uint_as_float(r[0]) + __uint_as_float(r[1]); }
__device__ __forceinline__ float x32_sum(float v) { auto r = __builtin_amdgcn_permlane32_swap(__float_as_uint(v), __float_as_uint(v), false, false); return __uint_as_float(r[0]) + __uint_as_float(r[1]); }
__device__ __forceinline__ float x16_max(float v) { auto r = __builtin_amdgcn_permlane16_swap(__float_as_uint(v), __float_as_uint(v), false, false); return fmaxf(__uint_as_float(r[0]), __uint_as_float(r[1])); }
__device__ __forceinline__ float x32_max(float v) { auto r = __builtin_amdgcn_permlane32_swap(__float_as_uint(v), __float_as_uint(v), false, false); return fmaxf(__uint_as_float(r[0]), __uint_as_float(r[1])); }
__device__ __forceinline__ float row16_sum(float v) {
    v += __uint_as_float(__builtin_amdgcn_update_dpp(0u, __float_as_uint(v), 0x128, 0xf, 0xf, false));
    v += __uint_as_float(__builtin_amdgcn_update_dpp(0u, __float_as_uint(v), 0x124, 0xf, 0xf, false));
    v += __uint_as_float(__builtin_amdgcn_update_dpp(0u, __float_as_uint(v), 0x122, 0xf, 0xf, false));
    v += __uint_as_float(__builtin_amdgcn_update_dpp(0u, __float_as_uint(v), 0x121, 0xf, 0xf, false));
    return v;
}
__device__ __forceinline__ float wsum(float v) { return x32_sum(x16_sum(row16_sum(v))); }

#define XB_TMO      128
#define XB_XCNT(j)  (256  + 64 * (j))
#define XB_XSUB(j)  (1280 + 64 * (j))
#define XB_XGEN(j)  (2304 + 64 * (j))
#define XB_TOP      3328
#define XB_TOPGEN   3392
#define XCD_BAR_WORDS 3456
#define XB_SPIN_CAP (1u << 18)
#define LAS __attribute__((address_space(3)))
__device__ __forceinline__ unsigned xb_ld(unsigned* p)              { return __hip_atomic_load(p, __ATOMIC_RELAXED, __HIP_MEMORY_SCOPE_AGENT); }
__device__ __forceinline__ unsigned xb_add(unsigned* p, unsigned v) { return __hip_atomic_fetch_add(p, v, __ATOMIC_RELAXED, __HIP_MEMORY_SCOPE_AGENT); }
__device__ __forceinline__ unsigned xb_xcc_id() { return (unsigned)__builtin_amdgcn_s_getreg((3 << 11) | 20) & 0xFu; }
#define XB_SPIN(cond, bar) do { unsigned _sp = 0; while (cond) { __builtin_amdgcn_s_sleep(1); \
    if ((++_sp & 255u) == 0u) { if (xb_ld(&(bar)[XB_TMO])) break; if (_sp > XB_SPIN_CAP) { atomicAdd(&(bar)[XB_TMO], 1u); break; } } } } while (0)
struct XcdBarrier { unsigned* bar; unsigned x; volatile LAS unsigned* st; };
__device__ __forceinline__ XcdBarrier xcd_barrier_post(unsigned* bar, volatile LAS unsigned* st) {
    XcdBarrier b; b.bar = bar; b.x = xb_xcc_id(); b.st = st;
    if (threadIdx.x == 0) (void)xb_add(&bar[XB_XCNT(b.x)], 1u);
    return b;
}
__device__ __forceinline__ void xcd_barrier_complete(unsigned* bar, unsigned x, unsigned& nloc, unsigned& nx) {
    const unsigned G = gridDim.x * gridDim.y * gridDim.z;
    unsigned sum, cnt, mine, sp = 0u;
    for (;;) {
        sum = 0u; cnt = 0u; mine = 0u;
#pragma unroll
        for (unsigned j = 0; j < 16; ++j) { const unsigned c = xb_ld(&bar[XB_XCNT(j)]); sum += c; cnt += (c > 0u) ? 1u : 0u; mine = (j == x) ? c : mine; }
        if (sum == G) break;
        __builtin_amdgcn_s_sleep(1);
        if ((++sp & 255u) == 0u) { if (xb_ld(&bar[XB_TMO])) break; if (sp > XB_SPIN_CAP) { atomicAdd(&bar[XB_TMO], 1u); break; } }
    }
    nloc = mine > 0u ? mine : 1u; nx = cnt > 0u ? cnt : 1u;
}
__device__ __forceinline__ void xcd_barrier(const XcdBarrier& b) {
    asm volatile("s_waitcnt vmcnt(0)" ::: "memory");
    __syncthreads();
    if (threadIdx.x == 0) {
        unsigned* bar = b.bar;
        __builtin_amdgcn_s_waitcnt(0);
        unsigned nloc = b.st[0], nx = b.st[1];
        if (nloc == 0u) { xcd_barrier_complete(bar, b.x, nloc, nx); b.st[0] = nloc; b.st[1] = nx; }
        const unsigned old = xb_add(&bar[XB_XSUB(b.x)], 1u);
        const unsigned gen = old / nloc;
        if (old + 1u == (gen + 1u) * nloc) {
            __builtin_amdgcn_fence(__ATOMIC_RELEASE, "agent");
            asm volatile("s_waitcnt vmcnt(0)" ::: "memory");
            const unsigned og = xb_add(&bar[XB_TOP], 1u);
            const unsigned tg = og / nx;
            if (og + 1u == (tg + 1u) * nx) xb_add(&bar[XB_TOPGEN], 1u);
            else XB_SPIN(xb_ld(&bar[XB_TOPGEN]) == tg, bar);
            __builtin_amdgcn_fence(__ATOMIC_ACQUIRE, "agent");
            xb_add(&bar[XB_XGEN(b.x)], 1u);
            asm volatile("s_waitcnt vmcnt(0)" ::: "memory");
        } else {
            XB_SPIN(xb_ld(&bar[XB_XGEN(b.x)]) == gen, bar);
            __builtin_amdgcn_fence(__ATOMIC_ACQUIRE, "agent");
            asm volatile("s_waitcnt vmcnt(0)" ::: "memory");
        }
    }
    __syncthreads();
}
__device__ __forceinline__ int next_item(unsigned* ctr, volatile int* slot) {
    __syncthreads();
    if (threadIdx.x == 0) *slot = (int)atomicAdd(ctr, 1u);
    __syncthreads();
    return *slot;
}

__device__ void prologue_phase(const Params& p, char* smem) {
    const int t = tid_opq();
    bf16_t* WinT = (bf16_t*)(p.ws + WS_WINT); bf16_t* WoutT = (bf16_t*)(p.ws + WS_WOUTT);
    float* mod = (float*)(p.ws + WS_MOD); float* cosT = (float*)(p.ws + WS_COS); float* sinT = (float*)(p.ws + WS_SIN);
    float* tl = (float*)smem;
    constexpr int N_TIN = DEPTH * 16 * 54, N_TOUT = DEPTH * 16 * 16, N_MOD = DEPTH * 192, N_ROPE = T * 32 / 256, N_LWT = DEPTH * 2 * 4 * 64 * 64 / 256;
    constexpr int NITEMS = N_TIN + N_TOUT + N_MOD + N_ROPE + N_LWT;
    for (int it = blockIdx.x; it < NITEMS; it += gridDim.x) {
        if (it < N_TIN + N_TOUT) {
            const float* src; bf16_t* dst; int ncols, kt, nt;
            if (it < N_TIN) { int l = it / (16 * 54), r = it % (16 * 54); kt = r / 54; nt = r % 54; src = p.w_in + (size_t)l * 1024 * DIN; dst = WinT + (size_t)l * NPAD * 1024; ncols = DIN; }
            else { int i2 = it - N_TIN; int l = i2 / 256, r = i2 % 256; kt = r / 16; nt = r % 16; src = p.w_out + (size_t)l * 1024 * 1024; dst = WoutT + (size_t)l * 1024 * 1024; ncols = 1024; }
            __syncthreads();
            { const int c4 = t & 15, r0 = t >> 4; const int n = nt * 64 + c4 * 4;
              f32x4 v[4];
#pragma unroll
              for (int i = 0; i < 4; ++i) { const int r = r0 + 16 * i; v[i] = (n < ncols) ? __builtin_nontemporal_load((const f32x4*)(src + (size_t)(kt * 64 + r) * ncols + n)) : (f32x4){0.f, 0.f, 0.f, 0.f}; }
#pragma unroll
              for (int i = 0; i < 4; ++i) { const int r = r0 + 16 * i; tl[r * 65 + c4 * 4] = v[i][0]; tl[r * 65 + c4 * 4 + 1] = v[i][1]; tl[r * 65 + c4 * 4 + 2] = v[i][2]; tl[r * 65 + c4 * 4 + 3] = v[i][3]; } }
            __syncthreads();
            {
#pragma unroll
              for (int i = 0; i < 2; ++i) { const int cc = t + 256 * i; const int n = cc >> 3, k8 = (cc & 7) * 8;
                  u32x4 pk; pk.x = pack2(tl[(k8 + 0) * 65 + n], tl[(k8 + 1) * 65 + n]); pk.y = pack2(tl[(k8 + 2) * 65 + n], tl[(k8 + 3) * 65 + n]);
                  pk.z = pack2(tl[(k8 + 4) * 65 + n], tl[(k8 + 5) * 65 + n]); pk.w = pack2(tl[(k8 + 6) * 65 + n], tl[(k8 + 7) * 65 + n]);
                  *(u32x4*)(dst + (size_t)(nt * 64 + n) * 1024 + kt * 64 + k8) = pk; } }
        } else if (it < N_TIN + N_TOUT + N_MOD) {
            const int i2 = it - N_TIN - N_TOUT; const int l = i2 / 192, jg = i2 % 192;
            const int jj = t & 15, ks = t >> 4; const int j = jg * 16 + jj;
            float a0 = 0.f, a1 = 0.f, a2 = 0.f, a3 = 0.f;
            const float* wm = p.w_mod + (size_t)l * 1024 * 3072 + j;
#pragma unroll 8
            for (int k = ks * 64; k < ks * 64 + 64; ++k) { float wv = __builtin_nontemporal_load(wm + (size_t)k * 3072); a0 += p.c[k] * wv; a1 += p.c[1024 + k] * wv; a2 += p.c[2048 + k] * wv; a3 += p.c[3072 + k] * wv; }
            __syncthreads();
            tl[(0 * 16 + ks) * 16 + jj] = a0; tl[(1 * 16 + ks) * 16 + jj] = a1; tl[(2 * 16 + ks) * 16 + jj] = a2; tl[(3 * 16 + ks) * 16 + jj] = a3;
            __syncthreads();
            if (t < 64) { const int b = t >> 4, j2 = t & 15; float s = 0.f;
#pragma unroll
              for (int k2 = 0; k2 < 16; ++k2) s += tl[(b * 16 + k2) * 16 + j2];
              mod[((size_t)l * NB + b) * 3072 + jg * 16 + j2] = s + p.b_mod[l * 3072 + jg * 16 + j2]; }
        } else if (it >= N_TIN + N_TOUT + N_MOD + N_ROPE) {
            const int e = (it - N_TIN - N_TOUT - N_MOD - N_ROPE) * 256 + t;
            const int in = e & 63, out = (e >> 6) & 63, g = (e >> 12) & 3, mat = (e >> 14) & 1, l = e >> 15;
            const float* src = mat ? p.lru_wx : p.lru_wa;
            ((bf16_t*)(p.ws + WS_LWT))[e] = f2bf(src[l * 16384 + g * 4096 + in * 64 + out]);
        } else {
            const int i2 = it - N_TIN - N_TOUT - N_MOD; const int e = i2 * 256 + t; const int tok = e >> 5, f = e & 31;
            const float inv = exp2f(-(float)f * (13.287712379549449f / 32.f));
            const float ang = (float)p.pos[tok] * inv;
            double rev = (double)ang * 0.15915494309189535; rev -= __builtin_rint(rev);
            const float rr = (float)rev; cosT[e] = __builtin_amdgcn_cosf(rr); sinT[e] = __builtin_amdgcn_sinf(rr);
        }
    }
}

__device__ void ln_phase(const Params& p, int l) {
    const int t = tid_opq(), lane = t & 63, w = t >> 6;
    bf16_t* ubuf = (bf16_t*)(p.ws + WS_U); const float* mod = (const float*)(p.ws + WS_MOD);
    for (int rg = blockIdx.x; rg < T / 16; rg += gridDim.x) {
        f32x4 v[4][4];
#pragma unroll
        for (int r = 0; r < 4; ++r) { const int row = rg * 16 + w * 4 + r; const float* src = (l <= 1) ? p.x + (size_t)row * 1024 : p.out + (size_t)row * 1024;
#pragma unroll
            for (int i = 0; i < 4; ++i) v[r][i] = __builtin_nontemporal_load((const f32x4*)(src + i * 256 + lane * 4));
            if (l > 0) {
                const bf16_t* yr = (const bf16_t*)(p.ws + WS_Z) + (size_t)row * 1024; const float* gate = mod + ((size_t)(l - 1) * NB + row / S) * 3072 + 2048;
#pragma unroll
                for (int i = 0; i < 4; ++i) { const u32x2 yv = __builtin_nontemporal_load((const u32x2*)(yr + i * 256 + lane * 4)); const f32x4 g1 = *(const f32x4*)(gate + i * 256 + lane * 4) + 1.f;
                    const f32x4 yf = {__uint_as_float(yv.x << 16), __uint_as_float(yv.x & 0xffff0000u), __uint_as_float(yv.y << 16), __uint_as_float(yv.y & 0xffff0000u)};
                    v[r][i] = v[r][i] * DN_ALPHA + g1 * yf; }
            } }
#pragma unroll
        for (int r = 0; r < 4; ++r) {
            const int row = rg * 16 + w * 4 + r; const int b = row / S;
            if (l > 0) {
                float s = 0.f;
#pragma unroll
                for (int i = 0; i < 4; ++i) s += (v[r][i][0] + v[r][i][1]) + (v[r][i][2] + v[r][i][3]);
                const float mu = wsum(s) * (1.f / 1024.f); float q = 0.f;
#pragma unroll
                for (int i = 0; i < 4; ++i) { f32x4 d = v[r][i] - mu; q += (d[0] * d[0] + d[1] * d[1]) + (d[2] * d[2] + d[3] * d[3]); }
                const float rstd = rsqrtf(wsum(q) * (1.f / 1024.f) + 1e-5f);
#pragma unroll
                for (int i = 0; i < 4; ++i) { const f32x4 g = *(const f32x4*)(p.ln_g + (l - 1) * 1024 + i * 256 + lane * 4), bb = *(const f32x4*)(p.ln_b + (l - 1) * 1024 + i * 256 + lane * 4);
                    v[r][i] = (v[r][i] - mu) * rstd * g + bb; __builtin_nontemporal_store(v[r][i], (f32x4*)(p.out + (size_t)row * 1024 + i * 256 + lane * 4)); }
            }
            if (l < DEPTH) {
                float s = 0.f;
#pragma unroll
                for (int i = 0; i < 4; ++i) s += (v[r][i][0] + v[r][i][1]) + (v[r][i][2] + v[r][i][3]);
                const float mu = wsum(s) * (1.f / 1024.f); float q = 0.f;
#pragma unroll
                for (int i = 0; i < 4; ++i) { f32x4 d = v[r][i] - mu; q += (d[0] * d[0] + d[1] * d[1]) + (d[2] * d[2] + d[3] * d[3]); }
                const float rstd = rsqrtf(wsum(q) * (1.f / 1024.f) + 1e-5f);
                const float* mb = mod + ((size_t)l * NB + b) * 3072;
#pragma unroll
                for (int i = 0; i < 4; ++i) { const int col = i * 256 + lane * 4; const f32x4 sh = *(const f32x4*)(mb + col), sc = *(const f32x4*)(mb + 1024 + col);
                    f32x4 u = (v[r][i] - mu) * rstd * (sc + 1.f) + sh; u32x2 pk; pk.x = pack2(u[0], u[1]); pk.y = pack2(u[2], u[3]);
                    *(u32x2*)(ubuf + (size_t)row * 1024 + col) = pk; }
            }
        }
    }
}

__device__ __forceinline__ int lds_off(int r, int c8) {
    const int st = (r >> 4) * 2 + (c8 >> 2); const int ob = (r & 15) * 64 + (c8 & 3) * 16;
    return st * 1024 + (ob ^ (((ob >> 9) & 1) << 5));
}
struct RegSet { u32x4 a[4], b[4]; };
__device__ __forceinline__ void gemm_tile(const bf16_t* __restrict__ A, const bf16_t* __restrict__ Bt, int tm, int tn, bool first, bool has_next, int ntm, int ntn,
                                          char* sm, f32x4 (&acc)[4][4], RegSet& r0, RegSet& r1) {
    const int t = tid_opq(), lane = t & 63, w = t >> 6, wm = w >> 1, wn = w & 1, r16 = lane & 15, quad = lane >> 4;
    const int lrow = t >> 3, lch = t & 7;
    constexpr int BUF = 32768;
    const unsigned loff = (unsigned)(lrow * 1024 + lch * 8);
    const bf16_t* At0 = A + (size_t)tm * (128 * 1024); const bf16_t* Bt0 = Bt + (size_t)tn * (128 * 1024);
    const bf16_t* At1 = A + (size_t)ntm * (128 * 1024); const bf16_t* Bt1 = Bt + (size_t)ntn * (128 * 1024);
#define Ag (At0 + loff)
#define Bg (Bt0 + loff)
#define nAg (At1 + loff)
#define nBg (Bt1 + loff)
    const int woff0 = lds_off(lrow, lch);
#define woff(i) (woff0 + 4096 * (i))
    const int fo = lds_off(r16, quad);
#pragma unroll
    for (int a = 0; a < 4; ++a)
#pragma unroll
        for (int b = 0; b < 4; ++b) acc[a][b] = (f32x4){0.f, 0.f, 0.f, 0.f};
    if (first) {
#pragma unroll
        for (int i = 0; i < 4; ++i) { r0.a[i] = *(const u32x4*)(Ag + (size_t)i * 32 * 1024); r0.b[i] = *(const u32x4*)(Bg + (size_t)i * 32 * 1024); }
#pragma unroll
        for (int i = 0; i < 4; ++i) { r1.a[i] = *(const u32x4*)(Ag + (size_t)i * 32 * 1024 + 64); r1.b[i] = *(const u32x4*)(Bg + (size_t)i * 32 * 1024 + 64); }
        __syncthreads();
#pragma unroll
        for (int i = 0; i < 4; ++i) { *(u32x4*)(sm + woff(i)) = r0.a[i]; *(u32x4*)(sm + 16384 + woff(i)) = r0.b[i]; }
#pragma unroll
        for (int i = 0; i < 4; ++i) { r0.a[i] = *(const u32x4*)(Ag + (size_t)i * 32 * 1024 + 128); r0.b[i] = *(const u32x4*)(Bg + (size_t)i * 32 * 1024 + 128); }
    }
    __syncthreads();
    auto step = [&](auto main_tag, int kt, RegSet& rs) {
        constexpr bool MAIN = decltype(main_tag)::value;
        const char* sA = sm + (kt & 1) * BUF; const char* sB = sA + 16384;
        char* nA = sm + ((kt + 1) & 1) * BUF; char* nB = nA + 16384;
        const bool wr = MAIN || kt + 1 < 16 || has_next;
        const bool own = MAIN || kt + 3 < 16;
        const bf16_t* la = own ? Ag + (kt + 3) * 64 : nAg + (kt - 13) * 64; const bf16_t* lb = own ? Bg + (kt + 3) * 64 : nBg + (kt - 13) * 64;
        __builtin_amdgcn_s_setprio(1);
#pragma unroll
        for (int ks = 0; ks < 2; ++ks) {
            bf16x8 af[4], bfr[4];
#pragma unroll
            for (int mt = 0; mt < 4; ++mt) af[mt] = *(const bf16x8*)(sA + ((wm * 4 + mt) * 2 + ks) * 1024 + fo);
#pragma unroll
            for (int nt = 0; nt < 4; ++nt) bfr[nt] = *(const bf16x8*)(sB + ((wn * 4 + nt) * 2 + ks) * 1024 + fo);
#pragma unroll
            for (int mt = 0; mt < 4; ++mt) {
#pragma unroll
                for (int nt = 0; nt < 4; ++nt) acc[mt][nt] = __builtin_amdgcn_mfma_f32_16x16x32_bf16(bfr[nt], af[mt], acc[mt][nt], 0, 0, 0);
                const int i = ks * 2 + (mt >> 1);
                __builtin_amdgcn_sched_barrier(0);
                if ((mt & 1) == 0) { if (wr) *(u32x4*)(nA + woff(i)) = rs.a[i]; if (own || has_next) rs.a[i] = *(const u32x4*)(la + (size_t)i * 32 * 1024); }
                else               { if (wr) *(u32x4*)(nB + woff(i)) = rs.b[i]; if (own || has_next) rs.b[i] = *(const u32x4*)(lb + (size_t)i * 32 * 1024); }
                __builtin_amdgcn_sched_barrier(0);
            }
        }
        __builtin_amdgcn_s_setprio(0);
        __syncthreads();
    };
    {
        std::true_type mt_; std::false_type tl_;
        for (int k2 = 0; k2 < 6; ++k2) { step(mt_, 2 * k2, r1); step(mt_, 2 * k2 + 1, r0); }
        step(mt_, 12, r1); step(tl_, 13, r0); step(tl_, 14, r1); step(tl_, 15, r0);
    }
#undef Ag
#undef Bg
#undef nAg
#undef nBg
#undef woff
}

__device__ void g1_phase(const Params& p, int l, char* smem) {
    const int t = tid_opq(), lane = t & 63, w = t >> 6, wm = w >> 1, wn = w & 1, r16 = lane & 15, quad = lane >> 4;
    char* sm = smem; char* sC = smem + 32768;
    const bf16_t* ubuf = (const bf16_t*)(p.ws + WS_U); const bf16_t* WinT = (const bf16_t*)(p.ws + WS_WINT) + (size_t)l * NPAD * 1024;
    bf16_t* z = (bf16_t*)(p.ws + WS_Z); float* kpart = (float*)(p.ws + WS_KPART);
    const float* cosT = (const float*)(p.ws + WS_COS); const float* sinT = (const float*)(p.ws + WS_SIN);
    const bool xo = (gridDim.x & 7) == 0; const int xcd = blockIdx.x & 7, nloc = xo ? (int)(gridDim.x >> 3) : (int)gridDim.x, j0 = xo ? (int)(blockIdx.x >> 3) : (int)blockIdx.x;
    const int lim = xo ? 16 * 27 : 128 * 27;
    RegSet r0, r1;
    for (int L = j0; L < lim; L += nloc) {
        const int tm = xo ? xcd * 16 + (L / 216) * 8 + (L & 7) : L / 27, tn = xo ? ((L % 216) >> 3) : L % 27;
        const int L2 = L + nloc; const bool has_next = L2 < lim;
        const int ntm = has_next ? (xo ? xcd * 16 + (L2 / 216) * 8 + (L2 & 7) : L2 / 27) : tm, ntn = has_next ? (xo ? ((L2 % 216) >> 3) : L2 % 27) : tn;
        f32x4 acc[4][4];
        gemm_tile(ubuf, WinT, tm, tn, L == j0, has_next, ntm, ntn, sm, acc, r0, r1);
        const bool rope = (tn < 4) || (tn >= 12 && tn < 16);
        if (rope) {
#pragma unroll
            for (int mt = 0; mt < 4; ++mt) {
                const int tok = tm * 128 + wm * 64 + mt * 16 + r16;
#pragma unroll
                for (int nt = 0; nt < 2; ++nt) {
                    const f32x4 cs = *(const f32x4*)(cosT + (size_t)tok * 32 + nt * 16 + quad * 4), sn = *(const f32x4*)(sinT + (size_t)tok * 32 + nt * 16 + quad * 4);
                    const f32x4 x1 = acc[mt][nt], x2 = acc[mt][nt + 2];
                    acc[mt][nt] = x1 * cs - x2 * sn; acc[mt][nt + 2] = x1 * sn + x2 * cs;
                }
            }
        }
        if (tn == 2 || tn == 3) {
#pragma unroll
            for (int nt = 0; nt < 4; ++nt) {
                f32x4 sv = (acc[0][nt] + acc[1][nt]) + (acc[2][nt] + acc[3][nt]);
#pragma unroll
                for (int jj = 0; jj < 4; ++jj) { sv[jj] = row16_sum(sv[jj]); }
                if (r16 == 0) *(f32x4*)(kpart + (size_t)(tm * 2 + wm) * 256 + (tn - 2) * 128 + wn * 64 + nt * 16 + quad * 4) = sv;
            }
        }
#pragma unroll
        for (int mt = 0; mt < 4; ++mt)
#pragma unroll
            for (int nt = 0; nt < 4; ++nt) { u32x2 pk; pk.x = pack2(acc[mt][nt][0], acc[mt][nt][1]); pk.y = pack2(acc[mt][nt][2], acc[mt][nt][3]);
                const int row = wm * 64 + mt * 16 + r16; const int c16 = wn * 8 + nt * 2 + (quad >> 1);
                *(u32x2*)(sC + row * 256 + ((c16 ^ (row & 15)) << 4) + (quad & 1) * 8) = pk; }
        __syncthreads();
#pragma unroll
        for (int i = 0; i < 8; ++i) { const int c = t + 256 * i; const int row = c >> 4, ch = c & 15; const int col = tn * 128 + ch * 8;
            if (col < DIN) *(u32x4*)(z + (size_t)(tm * 128 + row) * ZP + col) = *(const u32x4*)(sC + row * 256 + ((ch ^ (row & 15)) << 4)); }
    }
}

__device__ void g2_phase(const Params& p, int l, char* smem) {
    const int t = tid_opq(), lane = t & 63, w = t >> 6, wm = w >> 1, wn = w & 1, r16 = lane & 15, quad = lane >> 4;
    char* sm = smem; char* sC = smem + 32768;
    const bf16_t* mix = (const bf16_t*)(p.ws + WS_U); const bf16_t* WoutT = (const bf16_t*)(p.ws + WS_WOUTT) + (size_t)l * 1024 * 1024;
    bf16_t* ybuf = (bf16_t*)(p.ws + WS_Z);
    const bool xo = (gridDim.x & 7) == 0; const int xcd = blockIdx.x & 7, nloc = xo ? (int)(gridDim.x >> 3) : (int)gridDim.x, j0 = xo ? (int)(blockIdx.x >> 3) : (int)blockIdx.x;
    const int lim = xo ? 16 * 8 : 128 * 8;
    RegSet r0, r1;
    for (int L = j0; L < lim; L += nloc) {
        const int tm = xo ? xcd * 16 + (L & 15) : (L >> 3), tn = xo ? (L >> 4) : (L & 7);
        const int L2 = L + nloc; const bool has_next = L2 < lim;
        const int ntm = has_next ? (xo ? xcd * 16 + (L2 & 15) : (L2 >> 3)) : tm, ntn = has_next ? (xo ? (L2 >> 4) : (L2 & 7)) : tn;
        f32x4 acc[4][4];
        gemm_tile(mix, WoutT, tm, tn, L == j0, has_next, ntm, ntn, sm, acc, r0, r1);
#pragma unroll
        for (int mt = 0; mt < 4; ++mt)
#pragma unroll
            for (int nt = 0; nt < 4; ++nt) { u32x2 pk; pk.x = pack2(acc[mt][nt][0], acc[mt][nt][1]); pk.y = pack2(acc[mt][nt][2], acc[mt][nt][3]);
                const int row = wm * 64 + mt * 16 + r16; const int c16 = wn * 8 + nt * 2 + (quad >> 1);
                *(u32x2*)(sC + row * 256 + ((c16 ^ (row & 15)) << 4) + (quad & 1) * 8) = pk; }
        __syncthreads();
#pragma unroll
        for (int i = 0; i < 8; ++i) { const int c = t + 256 * i; const int row = c >> 4, ch = c & 15;
            *(u32x4*)(ybuf + (size_t)(tm * 128 + row) * 1024 + tn * 128 + ch * 8) = *(const u32x4*)(sC + row * 256 + ((ch ^ (row & 15)) << 4)); }
    }
}

constexpr float ATT_SC = 0.18033688011112042f;
template <int QT>
__device__ __forceinline__ void attn_tile(const bf16_t* sK, const bf16_t* sV, const bf16x8 (&qf)[QT][2], int lo, int hi, bool full, bool hasq, bool qfl0, bool qfl1,
                                          float (&m)[QT], float (&l)[QT], f32x4 (&O)[QT][4], int wq0) {
    const int lane = tid_opq() & 63, r16 = lane & 15, quad = lane >> 4;
    f32x4 s[QT][4];
#pragma unroll
    for (int a = 0; a < QT; ++a)
#pragma unroll
        for (int b = 0; b < 4; ++b) s[a][b] = (f32x4){0.f, 0.f, 0.f, 0.f};
#pragma unroll
    for (int ks = 0; ks < 2; ++ks)
#pragma unroll
        for (int k16 = 0; k16 < 4; ++k16) {
            const bf16x8 kf = *(const bf16x8*)(sK + (k16 * 16 + r16) * LDP + ks * 32 + quad * 8);
#pragma unroll
            for (int qt = 0; qt < QT; ++qt) s[qt][k16] = __builtin_amdgcn_mfma_f32_16x16x32_bf16(kf, qf[qt][ks], s[qt][k16], 0, 0, 0);
        }
#pragma unroll
    for (int qt = 0; qt < QT; ++qt) {
        const int ql = wq0 + qt * 16 + r16; const bool qfl = qt ? qfl1 : qfl0;
        if (!full) {
#pragma unroll
            for (int k16 = 0; k16 < 4; ++k16)
#pragma unroll
                for (int j = 0; j < 4; ++j) { const int dd = ql - (k16 * 16 + quad * 4 + j); const bool valid = dd >= lo && dd <= hi; s[qt][k16][j] = valid ? s[qt][k16][j] : -1e30f; }
        }
        if (hasq) {
#pragma unroll
            for (int k16 = 0; k16 < 4; ++k16)
#pragma unroll
                for (int j = 0; j < 4; ++j) s[qt][k16][j] = qfl ? s[qt][k16][j] : -1e30f;
        }
        float mx = -1e30f;
#pragma unroll
        for (int k16 = 0; k16 < 4; ++k16) mx = fmaxf(mx, fmaxf(fmaxf(s[qt][k16][0], s[qt][k16][1]), fmaxf(s[qt][k16][2], s[qt][k16][3])));
        mx = x32_max(x16_max(mx));
        const float mn = fmaxf(m[qt], mx); const float alpha = __builtin_amdgcn_exp2f((m[qt] - mn) * ATT_SC); m[qt] = mn;
        const float mb = (mn < -1e29f) ? 0.f : mn * ATT_SC;
        float ps = 0.f;
#pragma unroll
        for (int k16 = 0; k16 < 4; ++k16)
#pragma unroll
            for (int j = 0; j < 4; ++j) { const float pv = __builtin_amdgcn_exp2f(s[qt][k16][j] * ATT_SC - mb); ps += pv; s[qt][k16][j] = pv; }
        l[qt] = l[qt] * alpha + ps;
#pragma unroll
        for (int dt = 0; dt < 4; ++dt) O[qt][dt] = O[qt][dt] * alpha;
    }
#pragma unroll
    for (int G = 0; G < 2; ++G) {
        bf16x8 pf[QT];
#pragma unroll
        for (int qt = 0; qt < QT; ++qt) {
            const unsigned a0 = pack2(s[qt][G * 2][0], s[qt][G * 2][1]), a1 = pack2(s[qt][G * 2][2], s[qt][G * 2][3]);
            const unsigned a2 = pack2(s[qt][G * 2 + 1][0], s[qt][G * 2 + 1][1]), a3 = pack2(s[qt][G * 2 + 1][2], s[qt][G * 2 + 1][3]);
            u32x4 pk = {a0, a1, a2, a3}; pf[qt] = __builtin_bit_cast(bf16x8, pk);
        }
#pragma unroll
        for (int dt = 0; dt < 4; ++dt) {
            const bf16_t* v0p = sV + (G * 32 + quad * 4 + (r16 >> 2)) * LDP + dt * 16 + (r16 & 3) * 4;
            const bf16x4 v0 = __builtin_amdgcn_ds_read_tr16_b64_v4i16((__attribute__((address_space(3))) bf16x4*)(v0p));
            const bf16x4 v1 = __builtin_amdgcn_ds_read_tr16_b64_v4i16((__attribute__((address_space(3))) bf16x4*)(v0p + 16 * LDP));
            const bf16x8 vf = {v0[0], v0[1], v0[2], v0[3], v1[0], v1[1], v1[2], v1[3]};
#pragma unroll
            for (int qt = 0; qt < QT; ++qt) O[qt][dt] = __builtin_amdgcn_mfma_f32_16x16x32_bf16(vf, pf[qt], O[qt][dt], 0, 0, 0);
        }
    }
}

__device__ void attn_item(const Params& p, int kind, int idx, char* smem) {
    const int t = tid_opq(), lane = t & 63, w = t >> 6, r16 = lane & 15, quad = lane >> 4;
    bf16_t* sK = (bf16_t*)smem; bf16_t* sV = sK + 128 * LDP;
    const bf16_t* z = (const bf16_t*)(p.ws + WS_Z);
    (void)kind;
    const int cfg = idx >> 9; const int rem = idx & 511; const int b = rem >> 7, h = (rem >> 5) & 3; const int rb = rem & 31;
    const int dil = 1 << (2 * cfg); const int res = rb & (dil - 1), blk = rb >> (2 * cfg);
    const int qbase = b * S + blk * 128 * dil + res, stride = dil, qcol = C_CQ + h * 64, kcol = C_CK + h * 64, vcol = C_CV + h * 64;
    const int ss0 = (blk == 0) ? 1 : 0;
    bf16x8 qf[2][2];
#pragma unroll
    for (int qt = 0; qt < 2; ++qt)
#pragma unroll
        for (int ks = 0; ks < 2; ++ks) qf[qt][ks] = *(const bf16x8*)(z + (size_t)(qbase + (w * 32 + qt * 16 + r16) * stride) * ZP + qcol + ks * 32 + quad * 8);
    float m[2] = {-1e30f, -1e30f}, l[2] = {0.f, 0.f}; f32x4 O[2][4];
#pragma unroll
    for (int a = 0; a < 2; ++a)
#pragma unroll
        for (int c = 0; c < 4; ++c) O[a][c] = (f32x4){0.f, 0.f, 0.f, 0.f};
    const int lrow = t >> 1, lch = (t & 1) * 4;
    u32x4 rk[4], rv[4];
    { const bf16_t* rp = z + (size_t)(b * S + ((blk * 128 - 128 + ss0 * 128 + lrow) * dil + res)) * ZP + lch * 8;
#pragma unroll
      for (int c = 0; c < 4; ++c) { rk[c] = *(const u32x4*)(rp + kcol + c * 8); rv[c] = *(const u32x4*)(rp + vcol + c * 8); } }
    for (int ss = ss0; ss < 2; ++ss) {
        __syncthreads();
#pragma unroll
        for (int c = 0; c < 4; ++c) { *(u32x4*)(sK + lrow * LDP + (lch + c) * 8) = rk[c]; *(u32x4*)(sV + lrow * LDP + (lch + c) * 8) = rv[c]; }
        __syncthreads();
        if (ss + 1 < 2) { const bf16_t* rp = z + (size_t)(b * S + ((blk * 128 + lrow) * dil + res)) * ZP + lch * 8;
#pragma unroll
            for (int c = 0; c < 4; ++c) { rk[c] = *(const u32x4*)(rp + kcol + c * 8); rv[c] = *(const u32x4*)(rp + vcol + c * 8); } }
#pragma unroll
        for (int hf = 0; hf < 2; ++hf) {
            const int kt = ss * 2 + hf; const int lo = kt * 64 - 128, hi = kt * 64;
            const bool need = (w * 32 + 31 >= lo) && (w * 32 - 63 <= hi);
            const bool full = (w * 32 - 63 >= lo) && (w * 32 + 31 <= hi);
            if (need) attn_tile<2>(sK + hf * 64 * LDP, sV + hf * 64 * LDP, qf, lo, hi, full, false, true, true, m, l, O, w * 32);
        }
    }
    bf16_t* dilo = (bf16_t*)(p.ws + WS_DILO); float* dill = (float*)(p.ws + WS_DILL);
#pragma unroll
    for (int qt = 0; qt < 2; ++qt) {
        float lt = l[qt]; lt = x32_sum(x16_sum(lt));
        const float inv = 1.f / lt; const size_t tok = (size_t)(qbase + (w * 32 + qt * 16 + r16) * stride);
#pragma unroll
        for (int dt = 0; dt < 4; ++dt) { const int d0 = dt * 16 + quad * 4; u32x2 o; o.x = pack2(O[qt][dt][0] * inv, O[qt][dt][1] * inv); o.y = pack2(O[qt][dt][2] * inv, O[qt][dt][3] * inv);
            *(u32x2*)(dilo + ((size_t)cfg * T + tok) * 256 + h * 64 + d0) = o; }
        if (quad == 0) dill[((size_t)cfg * T + tok) * 4 + h] = m[qt] * 0.125f + __logf(lt);
    }
}

__device__ void moba_item(const Params& p, int idx, char* smem, bf16_t* outp) {
    const int t = tid_opq(), lane = t & 63, w = t >> 6, r16 = lane & 15, quad = lane >> 4;
    bf16_t* sK = (bf16_t*)smem; bf16_t* sV = sK + 64 * LDP;
    float* stO = (float*)(smem + 18432);
    float* kmean = (float*)(smem + 18432); float* gates = (float*)(smem + 22528);
    float* stM = (float*)(smem + 53248); float* stL = (float*)(smem + 53760);
    unsigned* selm = (unsigned*)(smem + 54272); unsigned char* lists = (unsigned char*)(smem + 54784);
    int* cnt = (int*)(smem + 56832); int4* desc = (int4*)(smem + 56960); int* misc = (int*)(smem + 59008);
    const bf16_t* z = (const bf16_t*)(p.ws + WS_Z);
    const int n = 15 - (idx >> 5); const int rem = idx & 31; const int b = rem >> 3, h = (rem >> 1) & 3, qh = rem & 1;
    const int qbase = b * S + n * 256 + qh * 128, qcol = C_AQ + h * 64, kcol = C_AK + h * 64, vcol = C_AV + h * 64;
    __syncthreads();
    {
        const float* kpart = (const float*)(p.ws + WS_KPART);
        for (int e = t; e < n * 64; e += 256) { const int j = e >> 6, d = e & 63; const float* kp = kpart + (size_t)(b * 64 + j * 4) * 256 + h * 64 + d;
            kmean[e] = ((kp[0] + kp[256]) + (kp[512] + kp[768])) * (1.f / 256.f); }
        if (t < 16) cnt[t] = 0;
        __syncthreads();
        {
            const int ql = t >> 1, half = t & 1; const bf16_t* qp = z + (size_t)(qbase + ql) * ZP + qcol;
            float g[8];
#pragma unroll
            for (int jj = 0; jj < 8; ++jj) g[jj] = 0.f;
#pragma unroll 1
            for (int dc = 0; dc < 8; ++dc) {
                const u32x4 qv = *(const u32x4*)(qp + dc * 8); float qq[8];
#pragma unroll
                for (int e = 0; e < 4; ++e) { qq[2 * e] = __uint_as_float(qv[e] << 16); qq[2 * e + 1] = __uint_as_float(qv[e] & 0xffff0000u); }
#pragma unroll
                for (int jj = 0; jj < 8; ++jj) { const int j = half + 2 * jj; if (j < n) { const float* km = kmean + j * 64 + dc * 8;
#pragma unroll
                    for (int e = 0; e < 8; ++e) g[jj] += qq[e] * km[e]; } }
            }
#pragma unroll
            for (int jj = 0; jj < 8; ++jj) gates[ql * 16 + half + 2 * jj] = g[jj];
        }
        __syncthreads();
        if (t < 128) {
            float gr[16];
#pragma unroll
            for (int q4 = 0; q4 < 4; ++q4) { const f32x4 g4 = *(const f32x4*)(gates + t * 16 + q4 * 4); gr[q4 * 4] = g4[0]; gr[q4 * 4 + 1] = g4[1]; gr[q4 * 4 + 2] = g4[2]; gr[q4 * 4 + 3] = g4[3]; }
            unsigned msk = 0;
#pragma unroll
            for (int k = 0; k < 3; ++k) { float best = -3.0e38f; int bi = -1;
#pragma unroll
                for (int j = 0; j < 16; ++j) { const bool ok = (j < n) && !((msk >> j) & 1u) && (gr[j] > best); best = ok ? gr[j] : best; bi = ok ? j : bi; }
                if (k < n && bi >= 0) msk |= 1u << bi; }
            selm[t] = msk;
            for (int j = 0; j < n; ++j) if ((msk >> j) & 1u) { const int pos = atomicAdd(&cnt[j], 1); lists[j * 128 + pos] = (unsigned char)t; }
        }
        __syncthreads();
        if (t < 128) { for (int j = 0; j < n; ++j) { const int cj = cnt[j]; if (t >= cj && t < ((cj + 15) & ~15)) lists[j * 128 + t] = 255; } }
        {
            const int nown_ = qh * 2 + 2;
            if (t < nown_) desc[t] = make_int4(b * S + n * 256 + t * 64, t * 64 - qh * 128, BIG, -1);
            if (t < 16) {
                int base = nown_; for (int j2 = 0; j2 < t && j2 < n; ++j2) base += ((((cnt[j2] + 15) >> 4) + 3) >> 2) * 4;
                if (t < n) { const int npass = ((((cnt[t] + 15) >> 4) + 3) >> 2);
                    for (int ps = 0; ps < npass; ++ps) for (int kt = 0; kt < 4; ++kt) desc[base + ps * 4 + kt] = make_int4(b * S + t * 256 + kt * 64, ps, kt, t); }
                if (t == 15) { misc[0] = base + ((15 < n) ? ((((cnt[15] + 15) >> 4) + 3) >> 2) * 4 : 0); misc[1] = nown_; }
            }
        }
    }
    __syncthreads();
    const int nd = misc[0], nown = misc[1];
    const int lrow = t >> 2, lch = (t & 3) * 2;
    u32x4 rk0, rk1, rv0, rv1;
    { const int4 d = desc[0]; const bf16_t* rp = z + (size_t)(d.x + lrow) * ZP + lch * 8;
      rk0 = *(const u32x4*)(rp + kcol); rk1 = *(const u32x4*)(rp + kcol + 8); rv0 = *(const u32x4*)(rp + vcol); rv1 = *(const u32x4*)(rp + vcol + 8); }
    bf16x8 nqf[2]; int ngq = 0; bool ngv = false, nhas = false;
    auto prefetch_group = [&](int gi) {
        nhas = false;
        if (gi < nd) { const int4 dg = desc[gi]; const int slot = dg.y * 4 + w; nhas = slot * 16 < cnt[dg.w];
            if (nhas) { const int qi = lists[dg.w * 128 + slot * 16 + r16]; ngv = qi != 255; ngq = ngv ? qi : 0;
#pragma unroll
                for (int ks = 0; ks < 2; ++ks) nqf[ks] = *(const bf16x8*)(z + (size_t)(qbase + ngq) * ZP + qcol + ks * 32 + quad * 8); } }
    };
    prefetch_group(nown);
    {
        bf16x8 qf[2][2];
#pragma unroll
        for (int qt = 0; qt < 2; ++qt)
#pragma unroll
            for (int ks = 0; ks < 2; ++ks) qf[qt][ks] = *(const bf16x8*)(z + (size_t)(qbase + w * 32 + qt * 16 + r16) * ZP + qcol + ks * 32 + quad * 8);
        float m[2] = {-1e30f, -1e30f}, l[2] = {0.f, 0.f}; f32x4 O[2][4];
#pragma unroll
        for (int a = 0; a < 2; ++a)
#pragma unroll
            for (int c = 0; c < 4; ++c) O[a][c] = (f32x4){0.f, 0.f, 0.f, 0.f};
        for (int i = 0; i < nown; ++i) {
            __syncthreads();
            *(u32x4*)(sK + lrow * LDP + lch * 8) = rk0; *(u32x4*)(sK + lrow * LDP + lch * 8 + 8) = rk1;
            *(u32x4*)(sV + lrow * LDP + lch * 8) = rv0; *(u32x4*)(sV + lrow * LDP + lch * 8 + 8) = rv1;
            __syncthreads();
            if (i + 1 < nd) { const int4 d = desc[i + 1]; const bf16_t* rp = z + (size_t)(d.x + lrow) * ZP + lch * 8;
                rk0 = *(const u32x4*)(rp + kcol); rk1 = *(const u32x4*)(rp + kcol + 8); rv0 = *(const u32x4*)(rp + vcol); rv1 = *(const u32x4*)(rp + vcol + 8); }
            const int4 d = desc[i];
            const bool need = (w * 32 + 31 >= d.y) && (w * 32 - 63 <= d.z);
            const bool full = (w * 32 - 63 >= d.y) && (w * 32 + 31 <= d.z);
            if (need) attn_tile<2>(sK, sV, qf, d.y, d.z, full, false, true, true, m, l, O, w * 32);
        }
#pragma unroll
        for (int qt = 0; qt < 2; ++qt) {
            float lt = l[qt]; lt = x32_sum(x16_sum(lt));
            const int ql = w * 32 + qt * 16 + r16;
            if (quad == 0) { stM[ql] = m[qt]; stL[ql] = lt; }
#pragma unroll
            for (int dt = 0; dt < 4; ++dt) *(f32x4*)(stO + ql * 68 + dt * 16 + quad * 4) = O[qt][dt];
        }
    }
    {
        bf16x8 qf[1][2]; float m[1] = {-1e30f}, l[1] = {0.f}; f32x4 O[1][4];
        int gq = 0; bool gv = false, has = false;
        for (int i = nown; i < nd; ++i) {
            __syncthreads();
            *(u32x4*)(sK + lrow * LDP + lch * 8) = rk0; *(u32x4*)(sK + lrow * LDP + lch * 8 + 8) = rk1;
            *(u32x4*)(sV + lrow * LDP + lch * 8) = rv0; *(u32x4*)(sV + lrow * LDP + lch * 8 + 8) = rv1;
            __syncthreads();
            if (i + 1 < nd) { const int4 d = desc[i + 1]; const bf16_t* rp = z + (size_t)(d.x + lrow) * ZP + lch * 8;
                rk0 = *(const u32x4*)(rp + kcol); rk1 = *(const u32x4*)(rp + kcol + 8); rv0 = *(const u32x4*)(rp + vcol); rv1 = *(const u32x4*)(rp + vcol + 8); }
            const int4 d = desc[i];
            if (d.z == 0) {
                has = nhas; gv = ngv; gq = ngq; qf[0][0] = nqf[0]; qf[0][1] = nqf[1];
                m[0] = -1e30f; l[0] = 0.f;
#pragma unroll
                for (int c = 0; c < 4; ++c) O[0][c] = (f32x4){0.f, 0.f, 0.f, 0.f};
                prefetch_group(i + 4);
            }
            if (has) {
                attn_tile<1>(sK, sV, qf, -BIG, BIG, true, false, true, true, m, l, O, 0);
                if (d.z == 3) {
                    float lt = l[0]; lt = x32_sum(x16_sum(lt));
                    if (gv) {
                        const float mo = stM[gq], lo_ = stL[gq]; const float mn = fmaxf(mo, m[0]);
                        const float fa = __builtin_amdgcn_exp2f((mo - mn) * ATT_SC), fb = __builtin_amdgcn_exp2f((m[0] - mn) * ATT_SC);
#pragma unroll
                        for (int dt = 0; dt < 4; ++dt) { float* sp = stO + gq * 68 + dt * 16 + quad * 4; const f32x4 so = *(const f32x4*)sp; *(f32x4*)sp = so * fa + O[0][dt] * fb; }
                        if (quad == 0) { stM[gq] = mn; stL[gq] = lo_ * fa + lt * fb; }
                    }
                }
            }
        }
    }
    __syncthreads();
#pragma unroll
    for (int qt = 0; qt < 2; ++qt) {
        const int ql = w * 32 + qt * 16 + r16; const float inv = 1.f / stL[ql]; const size_t tok = (size_t)(qbase + ql);
#pragma unroll
        for (int dt = 0; dt < 4; ++dt) { const int d0 = dt * 16 + quad * 4; const f32x4 ov = *(const f32x4*)(stO + ql * 68 + d0);
            const u32x2 gvv = *(const u32x2*)(z + tok * ZP + C_AG + h * 64 + d0);
            const float g0 = __uint_as_float(gvv.x << 16), g1 = __uint_as_float(gvv.x & 0xffff0000u), g2 = __uint_as_float(gvv.y << 16), g3 = __uint_as_float(gvv.y & 0xffff0000u);
            u32x2 o; o.x = pack2(ov[0] * inv * silu_f(g0), ov[1] * inv * silu_f(g1)); o.y = pack2(ov[2] * inv * silu_f(g2), ov[3] * inv * silu_f(g3));
            *(u32x2*)(outp + tok * 1024 + h * 64 + d0) = o; }
    }
}

__device__ __forceinline__ void gla_bcum(const Params& p, int l, const bf16_t* z, int tok0, float* bc, float* drs) {
    const int t = tid_opq();
    const int hd = t & 127, ih = t >> 7;
    float wr[16];
#pragma unroll
    for (int r = 0; r < 16; ++r) wr[r] = p.gla_wr[l * 2048 + r * 128 + hd];
    const float br = p.gla_br[l * 128 + hd];
    { const int e0 = t, e1 = t + 256; const bf16_t d0 = z[(size_t)(tok0 + (e0 >> 4)) * ZP + C_DR + (e0 & 15)], d1 = z[(size_t)(tok0 + (e1 >> 4)) * ZP + C_DR + (e1 & 15)];
      drs[e0] = bf2f(d0); drs[e1] = bf2f(d1); }
    __syncthreads();
#pragma unroll
    for (int ii = 0; ii < 16; ++ii) { const int i = ih * 16 + ii; float x = br;
#pragma unroll
        for (int r4 = 0; r4 < 4; ++r4) { const f32x4 dv = *(const f32x4*)(drs + i * 16 + r4 * 4); x += (dv[0] * wr[r4 * 4] + dv[1] * wr[r4 * 4 + 1]) + (dv[2] * wr[r4 * 4 + 2] + dv[3] * wr[r4 * 4 + 3]); }
        bc[i * 128 + hd] = (fminf(x, 0.f) - __logf(1.f + __expf(-fabsf(x)))) * (1.f / 16.f); }
    __syncthreads();
    if (t < 128) { float sacc = 0.f;
#pragma unroll
        for (int i = 0; i < 32; ++i) { sacc += bc[i * 128 + t]; bc[i * 128 + t] = sacc; } }
    __syncthreads();
}

__device__ void gla1_item(const Params& p, int l, int idx, char* smem) {
    const int t = tid_opq(), lane = t & 63, w = t >> 6, r16 = lane & 15, quad = lane >> 4;
    const int b = idx >> 7, c = idx & 127; const int tok0 = b * S + c * 32;
    const bf16_t* z = (const bf16_t*)(p.ws + WS_Z);
    float* bc = (float*)smem; float* drs = (float*)(smem + 16384);
    bf16_t* kdT = (bf16_t*)(smem + 18432) + w * 1024;
    bf16_t* vL = (bf16_t*)(smem + 26624) + w * (32 * LDP);
    float* gkv = (float*)(p.ws + WS_GKV); float* gdec = (float*)(p.ws + WS_GDEC);
    bf16_t kraw[16]; u32x4 vr[4];
#pragma unroll
    for (int i = 0; i < 16; ++i) { const int e = lane + 64 * i; kraw[i] = z[(size_t)(tok0 + (e >> 5)) * ZP + C_DK + w * 32 + (e & 31)]; }
#pragma unroll
    for (int i = 0; i < 4; ++i) { const int cc = lane + 64 * i; vr[i] = *(const u32x4*)(z + (size_t)(tok0 + (cc >> 3)) * ZP + C_DV + w * 64 + (cc & 7) * 8); }
    __syncthreads();
#pragma unroll
    for (int i = 0; i < 4; ++i) { const int cc = lane + 64 * i; *(u32x4*)(vL + (cc >> 3) * LDP + (cc & 7) * 8) = vr[i]; }
    gla_bcum(p, l, z, tok0, bc, drs);
    { float* bcg = (float*)(p.ws + WS_BC) + (size_t)idx * 4096;
#pragma unroll
      for (int i = 0; i < 4; ++i) *(f32x4*)(bcg + (t + 256 * i) * 4) = *(const f32x4*)(bc + (t + 256 * i) * 4); }
#pragma unroll
    for (int i = 0; i < 16; ++i) { const int e = lane + 64 * i; const int j = e >> 5, d = e & 31;
        kdT[d * 32 + j] = f2bf(bf2f(kraw[i]) * __expf(bc[31 * 128 + w * 32 + d] - bc[j * 128 + w * 32 + d])); }
    const int bh = b * 4 + w;
    if (lane < 32) gdec[(bh * 128 + c) * 32 + lane] = __expf(bc[31 * 128 + w * 32 + lane]);
    __syncthreads();
    bf16x8 kf[2];
#pragma unroll
    for (int x = 0; x < 2; ++x) kf[x] = *(const bf16x8*)(kdT + (x * 16 + r16) * 32 + quad * 8);
    float* dst = gkv + (size_t)(bh * 128 + c) * 2048;
#pragma unroll
    for (int dt = 0; dt < 4; ++dt) {
        const bf16_t* v0p = vL + (quad * 8 + (r16 >> 2)) * LDP + dt * 16 + (r16 & 3) * 4;
        const bf16x4 v0 = __builtin_amdgcn_ds_read_tr16_b64_v4i16((__attribute__((address_space(3))) bf16x4*)(v0p));
        const bf16x4 v1 = __builtin_amdgcn_ds_read_tr16_b64_v4i16((__attribute__((address_space(3))) bf16x4*)(v0p + 4 * LDP));
        const bf16x8 vf = {v0[0], v0[1], v0[2], v0[3], v1[0], v1[1], v1[2], v1[3]};
#pragma unroll
        for (int x = 0; x < 2; ++x) {
            const f32x4 r = __builtin_amdgcn_mfma_f32_16x16x32_bf16(vf, kf[x], (f32x4){0.f, 0.f, 0.f, 0.f}, 0, 0, 0);
            *(f32x4*)(dst + (x * 16 + r16) * 64 + dt * 16 + quad * 4) = r;
        }
    }
}

#define OPQ(ptr) asm volatile("" : "+v"(ptr))
__device__ void gla3_item(const Params& p, int l, int idx, char* smem) {
    const int t = tid_opq(), lane = t & 63, w = t >> 6, r16 = lane & 15, quad = lane >> 4;
    const int b = idx >> 7, c = idx & 127; const int tok0 = b * S + c * 32;
    const bf16_t* z = (const bf16_t*)(p.ws + WS_Z); bf16_t* mix = (bf16_t*)(p.ws + WS_U);
    float* bc = (float*)smem; float* drs = (float*)(smem + 16384);
    bf16_t* SL = (bf16_t*)smem + w * (32 * LDP);
    bf16_t* qe = (bf16_t*)(smem + 18432) + w * 1024;
    bf16_t* ke = (bf16_t*)(smem + 26624) + w * 1024;
    bf16_t* vL = (bf16_t*)(smem + 34816) + w * (32 * LDP);
    const float* gkv = (const float*)(p.ws + WS_GKV);
    const int bh = b * 4 + w;
    bf16_t qraw[16], kraw[16];
    { const bf16_t* qp = z + (size_t)(tok0 + (lane >> 5)) * ZP + w * 32 + (lane & 31);
#pragma unroll
      for (int i = 0; i < 16; ++i) { qraw[i] = qp[C_DQ]; kraw[i] = qp[C_DK]; qp += 2 * ZP; OPQ(qp); } }
    u32x4 vr[4]; f32x4 sr[8];
#pragma unroll
    for (int i = 0; i < 4; ++i) { const int cc = lane + 64 * i; vr[i] = *(const u32x4*)(z + (size_t)(tok0 + (cc >> 3)) * ZP + C_DV + w * 64 + (cc & 7) * 8); }
    { const float* Sp = gkv + (size_t)(bh * 128 + c) * 2048;
#pragma unroll
      for (int i = 0; i < 8; ++i) sr[i] = __builtin_nontemporal_load((const f32x4*)(Sp + (lane + 64 * i) * 4)); }
    f32x4 bcr[4];
    { const float* bcg = (const float*)(p.ws + WS_BC) + (size_t)idx * 4096;
#pragma unroll
      for (int i = 0; i < 4; ++i) bcr[i] = __builtin_nontemporal_load((const f32x4*)(bcg + (t + 256 * i) * 4)); }
    __syncthreads();
#pragma unroll
    for (int i = 0; i < 4; ++i) { const int cc = lane + 64 * i; *(u32x4*)(vL + (cc >> 3) * LDP + (cc & 7) * 8) = vr[i]; }
#pragma unroll
    for (int i = 0; i < 4; ++i) *(f32x4*)(bc + (t + 256 * i) * 4) = bcr[i];
    __syncthreads();
#pragma unroll
    for (int i2 = 0; i2 < 16; ++i2) { const int e = lane + 64 * i2; const int i = e >> 5, d = e & 31; const float bcv = bc[i * 128 + w * 32 + d];
        qe[i * 32 + d] = f2bf(bf2f(qraw[i2]) * __expf(bcv) * 0.17677669529663687f); ke[i * 32 + d] = f2bf(bf2f(kraw[i2]) * __expf(-bcv)); }
    __syncthreads();
#pragma unroll
    for (int i = 0; i < 8; ++i) { const int cc = lane + 64 * i; const int d = cc >> 4, v4 = cc & 15; u32x2 pk; pk.x = pack2(sr[i][0], sr[i][1]); pk.y = pack2(sr[i][2], sr[i][3]);
        *(u32x2*)(SL + d * LDP + v4 * 4) = pk; }
    __syncthreads();
    bf16x8 qf[2], kf[2];
#pragma unroll
    for (int x = 0; x < 2; ++x) { qf[x] = *(const bf16x8*)(qe + (x * 16 + r16) * 32 + quad * 8); kf[x] = *(const bf16x8*)(ke + (x * 16 + r16) * 32 + quad * 8); }
    bf16x8 pf[2];
#pragma unroll
    for (int it = 0; it < 2; ++it) {
        f32x4 at[2];
#pragma unroll
        for (int jt = 0; jt < 2; ++jt) { at[jt] = __builtin_amdgcn_mfma_f32_16x16x32_bf16(kf[jt], qf[it], (f32x4){0.f, 0.f, 0.f, 0.f}, 0, 0, 0);
#pragma unroll
            for (int jj = 0; jj < 4; ++jj) at[jt][jj] = (jt * 16 + quad * 4 + jj <= it * 16 + r16) ? at[jt][jj] : 0.f; }
        u32x4 pk = {pack2(at[0][0], at[0][1]), pack2(at[0][2], at[0][3]), pack2(at[1][0], at[1][1]), pack2(at[1][2], at[1][3])};
        pf[it] = __builtin_bit_cast(bf16x8, pk);
    }
    f32x4 O[2][4];
#pragma unroll
    for (int dt = 0; dt < 4; ++dt) {
        const bf16_t* v0p = vL + (quad * 4 + (r16 >> 2)) * LDP + dt * 16 + (r16 & 3) * 4;
        const bf16x4 v0 = __builtin_amdgcn_ds_read_tr16_b64_v4i16((__attribute__((address_space(3))) bf16x4*)(v0p));
        const bf16x4 v1 = __builtin_amdgcn_ds_read_tr16_b64_v4i16((__attribute__((address_space(3))) bf16x4*)(v0p + 16 * LDP));
        const bf16x8 vf = {v0[0], v0[1], v0[2], v0[3], v1[0], v1[1], v1[2], v1[3]};
        const bf16_t* s0p = SL + (quad * 8 + (r16 >> 2)) * LDP + dt * 16 + (r16 & 3) * 4;
        const bf16x4 s0 = __builtin_amdgcn_ds_read_tr16_b64_v4i16((__attribute__((address_space(3))) bf16x4*)(s0p));
        const bf16x4 s1 = __builtin_amdgcn_ds_read_tr16_b64_v4i16((__attribute__((address_space(3))) bf16x4*)(s0p + 4 * LDP));
        const bf16x8 sf = {s0[0], s0[1], s0[2], s0[3], s1[0], s1[1], s1[2], s1[3]};
#pragma unroll
        for (int it = 0; it < 2; ++it) {
            O[it][dt] = __builtin_amdgcn_mfma_f32_16x16x32_bf16(vf, pf[it], (f32x4){0.f, 0.f, 0.f, 0.f}, 0, 0, 0);
            O[it][dt] = __builtin_amdgcn_mfma_f32_16x16x32_bf16(sf, qf[it], O[it][dt], 0, 0, 0);
        }
    }
#pragma unroll
    for (int it = 0; it < 2; ++it) {
        float ss = 0.f;
#pragma unroll
        for (int dt = 0; dt < 4; ++dt) ss += (O[it][dt][0] * O[it][dt][0] + O[it][dt][1] * O[it][dt][1]) + (O[it][dt][2] * O[it][dt][2] + O[it][dt][3] * O[it][dt][3]);
        ss = x32_sum(x16_sum(ss));
        const float rn = rsqrtf(ss * (1.f / 64.f) + 1e-5f);
        const size_t tok = (size_t)(tok0 + it * 16 + r16);
#pragma unroll
        for (int dt = 0; dt < 4; ++dt) { const int v0i = dt * 16 + quad * 4; const f32x4 gn = *(const f32x4*)(p.gla_gn + l * 64 + v0i);
            const u32x2 gv = *(const u32x2*)(z + tok * ZP + C_DG + w * 64 + v0i);
            const float g0 = __uint_as_float(gv.x << 16), g1 = __uint_as_float(gv.x & 0xffff0000u), g2 = __uint_as_float(gv.y << 16), g3 = __uint_as_float(gv.y & 0xffff0000u);
            u32x2 o; o.x = pack2(O[it][dt][0] * rn * gn[0] * silu_f(g0), O[it][dt][1] * rn * gn[1] * silu_f(g1));
            o.y = pack2(O[it][dt][2] * rn * gn[2] * silu_f(g2), O[it][dt][3] * rn * gn[3] * silu_f(g3));
            *(u32x2*)(mix + tok * 1024 + 768 + w * 64 + v0i) = o; }
    }
}

__device__ void lru1_item(const Params& p, int l, int idx, char* smem) {
    const int t = tid_opq(), lane = t & 63, g = t >> 6, r16 = lane & 15, quad = lane >> 4; const int ch = t;
    const int b = idx >> 7, c = idx & 127; const int s0 = c * 32; const int tok0 = b * S + s0;
    const bf16_t* z = (const bf16_t*)(p.ws + WS_Z); float* xcs = (float*)smem;
    bf16_t* preA = (bf16_t*)(smem + 32768); bf16_t* preX = (bf16_t*)(smem + 49152);
    float* lh = (float*)(p.ws + WS_LH); float* lp = (float*)(p.ws + WS_LP);
    bf16_t xr[35];
#pragma unroll
    for (int i = 0; i < 35; ++i) { const int sidx = s0 + i - 3; xr[i] = (sidx >= 0) ? z[(size_t)(tok0 + i - 3) * ZP + C_BX + ch] : (bf16_t)0; }
    const float cw0 = p.conv_w[l * 1024 + ch], cw1 = p.conv_w[l * 1024 + 256 + ch], cw2 = p.conv_w[l * 1024 + 512 + ch], cw3 = p.conv_w[l * 1024 + 768 + ch];
    const float cb = p.conv_b[l * 256 + ch];
    const bf16_t* lwt = (const bf16_t*)(p.ws + WS_LWT) + (size_t)l * 32768 + g * 4096;
    bf16x8 wfa[4][2], wfx[4][2];
#pragma unroll
    for (int nt = 0; nt < 4; ++nt)
#pragma unroll
        for (int ks = 0; ks < 2; ++ks) { wfa[nt][ks] = *(const bf16x8*)(lwt + (nt * 16 + r16) * 64 + ks * 32 + quad * 8); wfx[nt][ks] = *(const bf16x8*)(lwt + 16384 + (nt * 16 + r16) * 64 + ks * 32 + quad * 8); }
    __syncthreads();
#pragma unroll
    for (int i = 0; i < 32; ++i) xcs[i * 256 + ch] = cb + (cw0 * bf2f(xr[i]) + cw1 * bf2f(xr[i + 1])) + (cw2 * bf2f(xr[i + 2]) + cw3 * bf2f(xr[i + 3]));
    __syncthreads();
#pragma unroll
    for (int tt = 0; tt < 2; ++tt) {
        bf16x8 xf[2];
#pragma unroll
        for (int ks = 0; ks < 2; ++ks) { const float* xp = xcs + (tt * 16 + r16) * 256 + g * 64 + ks * 32 + quad * 8; const f32x4 x0 = *(const f32x4*)xp, x1 = *(const f32x4*)(xp + 4);
            u32x4 pk = {pack2(x0[0], x0[1]), pack2(x0[2], x0[3]), pack2(x1[0], x1[1]), pack2(x1[2], x1[3])}; xf[ks] = __builtin_bit_cast(bf16x8, pk); }
#pragma unroll
        for (int nt = 0; nt < 4; ++nt) {
            f32x4 ra = __builtin_amdgcn_mfma_f32_16x16x32_bf16(wfa[nt][0], xf[0], (f32x4){0.f, 0.f, 0.f, 0.f}, 0, 0, 0); ra = __builtin_amdgcn_mfma_f32_16x16x32_bf16(wfa[nt][1], xf[1], ra, 0, 0, 0);
            f32x4 rx = __builtin_amdgcn_mfma_f32_16x16x32_bf16(wfx[nt][0], xf[0], (f32x4){0.f, 0.f, 0.f, 0.f}, 0, 0, 0); rx = __builtin_amdgcn_mfma_f32_16x16x32_bf16(wfx[nt][1], xf[1], rx, 0, 0, 0);
            u32x2 pa; pa.x = pack2(ra[0], ra[1]); pa.y = pack2(ra[2], ra[3]); u32x2 px; px.x = pack2(rx[0], rx[1]); px.y = pack2(rx[2], rx[3]);
            *(u32x2*)(preA + (tt * 16 + r16) * 256 + g * 64 + nt * 16 + quad * 4) = pa; *(u32x2*)(preX + (tt * 16 + r16) * 256 + g * 64 + nt * 16 + quad * 4) = px;
        }
    }
    __syncthreads();
    const float ba = p.lru_ba[l * 256 + ch], bx = p.lru_bx[l * 256 + ch], lam = p.lru_lam[l * 256 + ch];
    const float sp = fmaxf(-lam, 0.f) + log1pf(__expf(-fabsf(lam)));
    float hh = 0.f, P = 1.f;
    float* lhp = lh + (size_t)tok0 * 256 + ch; float* lpp = lp + (size_t)tok0 * 256 + ch;
#pragma unroll 8
    for (int i = 0; i < 32; ++i) { const float r = sigmoid_f(bf2f(preA[i * 256 + ch]) + ba), ig = sigmoid_f(bf2f(preX[i * 256 + ch]) + bx); const float la = -8.f * r * sp; const float a = __expf(la);
        const float w2 = 2.f * la;
        const float em_s = -w2 * (1.f + w2 * (0.5f + w2 * (0.16666667f + w2 * (0.041666668f + w2 * (0.0083333338f + w2 * 0.0013888889f)))));
        const float em = (w2 > -0.25f) ? em_s : (1.f - a * a);
        const float u = __builtin_amdgcn_sqrtf(em) * (ig * xcs[i * 256 + ch]); hh = a * hh + u; P *= a;
        lhp[(size_t)i * 256] = hh; lpp[(size_t)i * 256] = P; }
}

__device__ void lru3_item(const Params& p, int idx) {
    const int ch = tid_opq(); const int b = idx >> 7, c = idx & 127; const int tok0 = b * S + c * 32;
    const bf16_t* z = (const bf16_t*)(p.ws + WS_Z); bf16_t* mix = (bf16_t*)(p.ws + WS_U);
    const float* lh = (const float*)(p.ws + WS_LH); const float* lp = (const float*)(p.ws + WS_LP); const float* lc = (const float*)(p.ws + WS_LC);
    const float carry = lc[(size_t)(b * 128 + c) * 256 + ch];
    float hv[32], pv[32]; bf16_t gv[32];
#pragma unroll
    for (int i = 0; i < 32; ++i) { const size_t tok = (size_t)(tok0 + i); hv[i] = __builtin_nontemporal_load(lh + tok * 256 + ch); pv[i] = __builtin_nontemporal_load(lp + tok * 256 + ch); gv[i] = z[tok * ZP + C_BG + ch]; }
#pragma unroll
    for (int i = 0; i < 32; ++i) { const size_t tok = (size_t)(tok0 + i); mix[tok * 1024 + 256 + ch] = f2bf((hv[i] + pv[i] * carry) * silu_f(bf2f(gv[i]))); }
}

__device__ void dilc_item(const Params& p, int idx) {
    const int t = tid_opq(); const size_t tok = (size_t)idx * 8 + (t >> 5); const int chn = t & 31; const int h = chn >> 3;
    const bf16_t* z = (const bf16_t*)(p.ws + WS_Z); bf16_t* mix = (bf16_t*)(p.ws + WS_U);
    const bf16_t* dilo = (const bf16_t*)(p.ws + WS_DILO); const float* dill = (const float*)(p.ws + WS_DILL);
    const float l0 = dill[((size_t)0 * T + tok) * 4 + h], l1 = dill[((size_t)1 * T + tok) * 4 + h], l2 = dill[((size_t)2 * T + tok) * 4 + h];
    const float mx = fmaxf(l0, fmaxf(l1, l2)); float w0 = __expf(l0 - mx), w1 = __expf(l1 - mx), w2 = __expf(l2 - mx); const float inv = 1.f / (w0 + w1 + w2); w0 *= inv; w1 *= inv; w2 *= inv;
    const u32x4 o0 = __builtin_nontemporal_load((const u32x4*)(dilo + ((size_t)0 * T + tok) * 256 + chn * 8)), o1 = __builtin_nontemporal_load((const u32x4*)(dilo + ((size_t)1 * T + tok) * 256 + chn * 8)), o2 = __builtin_nontemporal_load((const u32x4*)(dilo + ((size_t)2 * T + tok) * 256 + chn * 8));
    const u32x4 gv = *(const u32x4*)(z + tok * ZP + C_CG + chn * 8);
    u32x4 r;
#pragma unroll
    for (int e = 0; e < 4; ++e) {
        const float a = w0 * __uint_as_float(o0[e] << 16) + w1 * __uint_as_float(o1[e] << 16) + w2 * __uint_as_float(o2[e] << 16);
        const float bq = w0 * __uint_as_float(o0[e] & 0xffff0000u) + w1 * __uint_as_float(o1[e] & 0xffff0000u) + w2 * __uint_as_float(o2[e] & 0xffff0000u);
        r[e] = pack2(a * silu_f(__uint_as_float(gv[e] << 16)), bq * silu_f(__uint_as_float(gv[e] & 0xffff0000u)));
    }
    *(u32x4*)(mix + tok * 1024 + 512 + chn * 8) = r;
}

__device__ void m2_phase(const Params& p, char* smem) {
    float* gkv = (float*)(p.ws + WS_GKV); const float* gdec = (const float*)(p.ws + WS_GDEC);
    const float* lh = (const float*)(p.ws + WS_LH); const float* lp = (const float*)(p.ws + WS_LP); float* lc = (float*)(p.ws + WS_LC);
    float* aggP = (float*)smem; float* aggS = aggP + 256;
    const int t = tid_opq(); const int e = t & 31, seg = t >> 5;
    for (int it = blockIdx.x; it < 1024 + 32; it += gridDim.x) {
        float a[16], x[16];
        size_t ostride;
        float* outp;
        if (it < 1024) {
            const int gid = it * 32 + e; const int bh = gid >> 11, dv = gid & 2047, d = dv >> 6;
            float* base = gkv + (size_t)bh * 128 * 2048 + dv + (size_t)(seg * 16) * 2048; const float* dc = gdec + (size_t)bh * 128 * 32 + d + (seg * 16) * 32;
#pragma unroll
            for (int k = 0; k < 16; ++k) { x[k] = __builtin_nontemporal_load(base + (size_t)k * 2048); a[k] = dc[k * 32]; }
            outp = base; ostride = 2048;
        } else {
            const int i2 = it - 1024; const int b = i2 >> 3, ch = (i2 & 7) * 32 + e;
#pragma unroll
            for (int k = 0; k < 16; ++k) { const size_t ix = (size_t)(b * S + (seg * 16 + k) * 32 + 31) * 256 + ch; a[k] = lp[ix]; x[k] = lh[ix]; }
            outp = lc + (size_t)(b * 128 + seg * 16) * 256 + ch; ostride = 256;
        }
        float st = 0.f, pr = 1.f;
#pragma unroll
        for (int k = 0; k < 16; ++k) { const float ak = a[k], xk = x[k]; a[k] = pr; x[k] = st; st = ak * st + xk; pr *= ak; }
        __syncthreads();
        aggP[seg * 32 + e] = pr; aggS[seg * 32 + e] = st;
        __syncthreads();
        float carry = 0.f;
        for (int s2 = 0; s2 < seg; ++s2) carry = aggP[s2 * 32 + e] * carry + aggS[s2 * 32 + e];
#pragma unroll
        for (int k = 0; k < 16; ++k) outp[(size_t)k * ostride] = x[k] + a[k] * carry;
    }
}

__global__ void __launch_bounds__(256, 2) fwd_megakernel(Params p) {
    __shared__ __attribute__((aligned(16))) char smem[SMEM_BYTES];
    __shared__ uint4 xb_words;
    __shared__ int s_slot;
    cg::grid_group grid = cg::this_grid();
    if (p.out == nullptr) grid.sync();
    if (threadIdx.x == 0) xb_words = make_uint4(0u, 0u, 0u, 0u);
    __syncthreads();
    const XcdBarrier xb = xcd_barrier_post((unsigned*)(p.ws + WS_CTL), (volatile LAS unsigned*)&xb_words);
    unsigned* cnt = (unsigned*)(p.ws + WS_CNT);
    prologue_phase(p, smem);
    xcd_barrier(xb);
#pragma unroll 1
    for (int l = 0; l < DEPTH; ++l) {
        ln_phase(p, l);
        xcd_barrier(xb);
        g1_phase(p, l, smem);
        xcd_barrier(xb);
        for (;;) { const int it = next_item(cnt + (4 + l) * 64, &s_slot); if (it >= 512) break; lru1_item(p, l, it, smem); }
        { const int xq = blockIdx.x & 7;
          for (;;) { const int li = next_item(cnt + (16 + l * 8 + xq) * 64, &s_slot); if (li >= 64) break;
              const int pr = xq * 2 + ((li >> 1) & 1); moba_item(p, (li >> 2) * 32 + (pr >> 2) * 8 + (pr & 3) * 2 + (li & 1), smem, (bf16_t*)(p.ws + WS_U)); }
          for (;;) { const int li = next_item(cnt + (32 + l * 8 + xq) * 64, &s_slot); if (li >= 192) break;
              const int cfg = li >> 6, r6 = li & 63; const int pr = xq * 2 + (r6 >> 5); attn_item(p, 1, cfg * 512 + (pr >> 2) * 128 + (pr & 3) * 32 + (r6 & 31), smem); } }
        for (;;) { const int it = next_item(cnt + (2 + l) * 64, &s_slot); if (it >= 512) break; gla1_item(p, l, it, smem); }
        xcd_barrier(xb);
        m2_phase(p, smem);
        xcd_barrier(xb);
        for (int it = blockIdx.x; it < 512; it += gridDim.x) gla3_item(p, l, it, smem);
        for (int it = blockIdx.x; it < 512; it += gridDim.x) lru3_item(p, it);
        for (int it = blockIdx.x; it < 2048; it += gridDim.x) dilc_item(p, it);
        xcd_barrier(xb);
        g2_phase(p, l, smem);
        xcd_barrier(xb);
    }
    ln_phase(p, DEPTH);
}

extern "C" void kernel_launch(void* const* d_in, const int* in_sizes, int n_in, void* d_out, int out_size, void* d_ws, size_t ws_size, hipStream_t stream) {
    static int grid_blocks = 0;
    if (!grid_blocks) {
        int dev = 0, cus = 0, per_cu = 0;
        hipGetDevice(&dev);
        hipDeviceGetAttribute(&cus, hipDeviceAttributeMultiprocessorCount, dev);
        hipOccupancyMaxActiveBlocksPerMultiprocessor(&per_cu, (const void*)fwd_megakernel, 256, 0);
        if (per_cu < 1) per_cu = 1;
        if (per_cu > 2) per_cu = 2;
        grid_blocks = cus * per_cu;
        if (ws_size < WS_END) fprintf(stderr, "kernel_launch: workspace too small: %zu < %zu\n", ws_size, (size_t)WS_END);
    }
    Params p{};
    p.x = (const float*)d_in[0]; p.c = (const float*)d_in[1]; p.pos = (const int*)d_in[2];
    p.w_mod = (const float*)d_in[3]; p.b_mod = (const float*)d_in[4]; p.w_in = (const float*)d_in[5];
    p.conv_w = (const float*)d_in[6]; p.conv_b = (const float*)d_in[7]; p.lru_wa = (const float*)d_in[8]; p.lru_ba = (const float*)d_in[9];
    p.lru_wx = (const float*)d_in[10]; p.lru_bx = (const float*)d_in[11]; p.lru_lam = (const float*)d_in[12];
    p.gla_wr = (const float*)d_in[13]; p.gla_br = (const float*)d_in[14]; p.gla_gn = (const float*)d_in[15];
    p.w_out = (const float*)d_in[16]; p.ln_g = (const float*)d_in[17]; p.ln_b = (const float*)d_in[18];
    p.out = (float*)d_out; p.ws = (unsigned char*)d_ws;
    (void)hipMemsetAsync(d_ws, 0, 32768, stream);
    void* args[] = {&p};
    hipError_t e = hipLaunchCooperativeKernel((const void*)fwd_megakernel, dim3(grid_blocks), dim3(256), args, 0, stream);
    if (e != hipSuccess) fprintf(stderr, "cooperative launch failed: %s (grid %d)\n", hipGetErrorString(e), grid_blocks);
}
```
